# Optimizing an MI355X kernel written in HIP

```python
import jax, jax.numpy as jnp
from jax import lax
import numpy as np

D_MODEL = 2048
BATCH = 8
SEQ = 2048
DEPTH = 2

GRID_W = 64
CTX_LEN = 256
HEAD_DIM = 128
AXIS_DIM = HEAD_DIM // 2
ROPE_THETA = 10000.0
Q_BLOCK = 128
A_HEADS = 6
A_KV = 2
B_HEADS = 6
B_KV = 2
WINDOW = 128
C_GROUPS = 4
C_GROUP_DIM = 128
CHUNK = 128
A_WIDTH = A_HEADS * HEAD_DIM
B_WIDTH = B_HEADS * HEAD_DIM
C_WIDTH = C_GROUPS * C_GROUP_DIM
MIX_WIDTH = A_WIDTH + B_WIDTH + C_WIDTH
A_KV_WIDTH = A_KV * HEAD_DIM
B_KV_WIDTH = B_KV * HEAD_DIM
PROJ_SPLITS = [
    A_WIDTH,
    A_WIDTH + A_KV_WIDTH,
    A_WIDTH + 2 * A_KV_WIDTH,
    A_WIDTH + 2 * A_KV_WIDTH + B_WIDTH,
    A_WIDTH + 2 * A_KV_WIDTH + B_WIDTH + B_KV_WIDTH,
    A_WIDTH + 2 * A_KV_WIDTH + B_WIDTH + 2 * B_KV_WIDTH,
    A_WIDTH + 2 * A_KV_WIDTH + B_WIDTH + 2 * B_KV_WIDTH + C_WIDTH,
]
IN_WIDTH = A_WIDTH + 2 * A_KV_WIDTH + B_WIDTH + 2 * B_KV_WIDTH + 2 * C_WIDTH
PEER_HEADS = 8
PEER_KEYS = 128
PEER_EXPERTS = PEER_KEYS * PEER_KEYS
PEER_QDIM = 256
PEER_HALF = PEER_QDIM // 2
PEER_TOPK = 16
TOKEN_BLOCK = 128
N_MOD = 6
EPS = 1e-6
NEG_INF = -1e30
F32 = jnp.float32

kernel_name = "hybrid_dit_gqa_swa_gmlp_peer"


def rms_unit(x):
    xf = x.astype(F32)
    return (xf * lax.rsqrt(jnp.mean(jnp.square(xf), -1, keepdims=True) + EPS)).astype(x.dtype)


def rmsnorm(x, g):
    return rms_unit(x) * g


def modulate(h, g, shift, scale):
    return rmsnorm(h, g) * (1.0 + scale) + shift


def axial_rope(rows):
    t = jnp.arange(rows * GRID_W)
    row = (t // GRID_W).astype(F32)
    col = (t % GRID_W).astype(F32)
    inv = ROPE_THETA ** (-jnp.arange(AXIS_DIM // 2, dtype=F32) / (AXIS_DIM // 2))
    ar, ac = row[:, None] * inv, col[:, None] * inv
    ang = jnp.concatenate([ar, ar, ac, ac], -1)
    return jnp.cos(ang), jnp.sin(ang)


def apply_rope(x, rope):
    cos, sin = rope
    xf = x.astype(F32)
    x1, x2, x3, x4 = jnp.split(xf, 4, -1)
    rot = jnp.concatenate([-x2, x1, -x4, x3], -1)
    return (xf * cos[None, :, None, :] + rot * sin[None, :, None, :]).astype(x.dtype)


def prep_heads(t, n_heads, gain, rope):
    b, l, _ = t.shape
    t = rmsnorm(t.reshape(b, l, n_heads, HEAD_DIM), gain)
    return t if rope is None else apply_rope(t, rope)


def attend(q, k, v, sink=None):
    s = jnp.einsum('bqkgd,btkd->bkgqt', q, k).astype(F32) * (HEAD_DIM ** -0.5)
    if sink is not None:
        sk = jnp.broadcast_to(sink.astype(F32)[None, :, :, None, None], s.shape[:-1] + (1,))
        s = jnp.concatenate([s, sk], -1)
    p = jax.nn.softmax(s, -1)[..., :k.shape[1]].astype(v.dtype)
    return jnp.einsum('bkgqt,btkd->bqkgd', p, v)


def global_attention(q, k_all, v_all):
    b, l = q.shape[:2]
    nblk = l // Q_BLOCK
    qb = q.reshape(b, nblk, Q_BLOCK, A_KV, A_HEADS // A_KV, HEAD_DIM).transpose(1, 0, 2, 3, 4, 5)
    out = lax.map(lambda blk: attend(blk, k_all, v_all), qb)
    return out.transpose(1, 0, 2, 3, 4, 5).reshape(b, l, A_WIDTH)


def window_attention(q, k, v, k_ctx, v_ctx, sink):
    b, l = q.shape[:2]
    nblk = l // Q_BLOCK
    g = B_HEADS // B_KV
    qb = q.reshape(b, nblk, Q_BLOCK, B_KV, g, HEAD_DIM)

    def band(t):
        tp = jnp.pad(t, ((0, 0), (Q_BLOCK, Q_BLOCK), (0, 0), (0, 0))).reshape(b, nblk + 2, Q_BLOCK, B_KV, HEAD_DIM)
        return jnp.concatenate([tp[:, :-2], tp[:, 1:-1], tp[:, 2:]], axis=2)

    kw, vw = band(k), band(v)
    blk = jnp.arange(nblk)[:, None, None] * Q_BLOCK
    qpos = blk + jnp.arange(Q_BLOCK)[None, :, None]
    kpos = blk - Q_BLOCK + jnp.arange(3 * Q_BLOCK)[None, None, :]
    valid = (jnp.abs(kpos - qpos) <= WINDOW) & (kpos >= 0) & (kpos < l)
    scale = HEAD_DIM ** -0.5
    s_w = jnp.einsum('bnqkgd,bnskd->bnkgqs', qb, kw).astype(F32) * scale
    s_w = jnp.where(valid[None, :, None, None], s_w, NEG_INF)
    s_c = jnp.einsum('bnqkgd,bskd->bnkgqs', qb, k_ctx).astype(F32) * scale
    s_s = jnp.broadcast_to(sink.astype(F32).reshape(1, 1, B_KV, g, 1, 1), s_c.shape[:-1] + (1,))
    p = jax.nn.softmax(jnp.concatenate([s_w, s_c, s_s], -1), -1).astype(v.dtype)
    nw, nc = 3 * Q_BLOCK, k_ctx.shape[1]
    o = (jnp.einsum('bnkgqs,bnskd->bnqkgd', p[..., :nw], vw)
         + jnp.einsum('bnkgqs,bskd->bnqkgd', p[..., nw:nw + nc], v_ctx))
    return o.reshape(b, l, B_WIDTH)


def chunk_mlp(u, v, vn_g, ws, bs):
    b, l, _ = u.shape
    n = l // CHUNK
    u = jax.nn.gelu(u).reshape(b, n, CHUNK, C_GROUPS, C_GROUP_DIM)
    v = rmsnorm(jax.nn.gelu(v).reshape(b, l, C_GROUPS, C_GROUP_DIM), vn_g.reshape(C_GROUPS, C_GROUP_DIM))
    v = v.reshape(b, n, CHUNK, C_GROUPS, C_GROUP_DIM)
    s = jnp.einsum('gpq,bnqgc->bnpgc', ws, v) + bs.T[None, None, :, :, None]
    return (u * s).reshape(b, l, C_WIDTH)


def merge(ya, yb, yc, g, w_out):
    y = jnp.concatenate([rms_unit(ya), rms_unit(yb), rms_unit(yc)], -1) * g
    return y @ w_out


def peer_ffn(h, wq, keys, u_tab, v_tab):
    b, l, d = h.shape
    n_tok = b * l
    t = h.reshape(n_tok, d)
    q = (t @ wq).reshape(n_tok, PEER_HEADS, 2, PEER_HALF).astype(F32)
    s = jnp.einsum('thpc,hpkc->thpk', q, keys.astype(F32))
    v1, i1 = lax.top_k(s[:, :, 0], PEER_TOPK)
    v2, i2 = lax.top_k(s[:, :, 1], PEER_TOPK)
    cand = (v1[..., :, None] + v2[..., None, :]).reshape(n_tok, PEER_HEADS, PEER_TOPK * PEER_TOPK)
    vals, ci = lax.top_k(cand, PEER_TOPK)
    e = (jnp.take_along_axis(i1, ci // PEER_TOPK, -1) * PEER_KEYS
         + jnp.take_along_axis(i2, ci % PEER_TOPK, -1))
    g = jax.nn.softmax(vals, -1).astype(h.dtype)
    nb = n_tok // TOKEN_BLOCK

    def block(args):
        tb, eb, gb = args
        hid = jnp.einsum('td,tkd->tk', tb, u_tab[eb])
        return jnp.einsum('tk,tkd->td', jax.nn.gelu(hid) * gb, v_tab[eb])

    out = lax.map(block, (t.reshape(nb, TOKEN_BLOCK, d),
                          e.reshape(nb, TOKEN_BLOCK, PEER_HEADS * PEER_TOPK),
                          g.reshape(nb, TOKEN_BLOCK, PEER_HEADS * PEER_TOPK)))
    return out.reshape(b, l, d)


def setup_inputs(seed: int = 0) -> dict:
    key = jax.random.key(seed)
    ks = jax.random.split(key, 24)
    D, L = D_MODEL, DEPTH

    def nrm(k, shape, s):
        return jax.random.normal(k, shape, F32) * s

    return {
        "x": nrm(ks[0], (BATCH, SEQ, D), 1.0),
        "c": nrm(ks[1], (BATCH, D), 1.0),
        "ctx": nrm(ks[2], (BATCH, CTX_LEN, D), 1.0),
        "c_ctx": nrm(ks[3], (D,), 1.0),
        "w_ada": nrm(ks[4], (L, D, N_MOD * D), D ** -0.5),
        "b_ada": nrm(ks[5], (L, N_MOD * D), 0.01),
        "norm1_g": 1.0 + nrm(ks[6], (L, D), 0.01),
        "norm2_g": 1.0 + nrm(ks[7], (L, D), 0.01),
        "w_in": nrm(ks[8], (L, D, IN_WIDTH), D ** -0.5),
        "qn_a": 1.0 + nrm(ks[9], (L, HEAD_DIM), 0.01),
        "kn_a": 1.0 + nrm(ks[10], (L, HEAD_DIM), 0.01),
        "qn_b": 1.0 + nrm(ks[11], (L, HEAD_DIM), 0.01),
        "kn_b": 1.0 + nrm(ks[12], (L, HEAD_DIM), 0.01),
        "sink_b": nrm(ks[13], (L, B_HEADS), 0.5),
        "vn_c": 1.0 + nrm(ks[14], (L, C_WIDTH), 0.01),
        "ws_c": nrm(ks[15], (L, C_GROUPS, CHUNK, CHUNK), CHUNK ** -0.5),
        "bs_c": 1.0 + nrm(ks[16], (L, C_GROUPS, CHUNK), 0.01),
        "g_group": 1.0 + nrm(ks[17], (L, MIX_WIDTH), 0.01),
        "w_out": nrm(ks[18], (L, MIX_WIDTH, D), MIX_WIDTH ** -0.5),
        "peer_wq": nrm(ks[19], (L, D, PEER_HEADS * PEER_QDIM), D ** -0.5),
        "peer_keys": nrm(ks[20], (L, PEER_HEADS, 2, PEER_KEYS, PEER_HALF), PEER_HALF ** -0.5),
        "peer_u": nrm(ks[21], (L, PEER_EXPERTS, D), D ** -0.5),
        "peer_v": nrm(ks[22], (L, PEER_EXPERTS, D), 0.5),
    }


def reference(x, c, ctx, c_ctx, w_ada, b_ada, norm1_g, norm2_g, w_in, qn_a, kn_a, qn_b, kn_b,
              sink_b, vn_c, ws_c, bs_c, g_group, w_out, peer_wq, peer_keys, peer_u, peer_v):
    b = x.shape[0]
    rows = x.shape[1] // GRID_W
    rope = axial_rope(rows)
    n_ctx = ctx.shape[1]
    ga = A_HEADS // A_KV
    gb = B_HEADS // B_KV
    h, hc = x, ctx
    for l in range(DEPTH):
        last = l == DEPTH - 1
        ml = [m[:, None, :] for m in jnp.split(jax.nn.silu(c) @ w_ada[l] + b_ada[l], N_MOD, -1)]
        mc = jnp.split(jax.nn.silu(c_ctx) @ w_ada[l] + b_ada[l], N_MOD, -1)
        xn = modulate(h, norm1_g[l], ml[0], ml[1])
        cn = modulate(hc, norm1_g[l], mc[0], mc[1])
        qa, ka, va, qb, kb, vb, uc, vc = jnp.split(xn @ w_in[l], PROJ_SPLITS, -1)
        cqa, cka, cva, cqb, ckb, cvb, cuc, cvc = jnp.split(cn @ w_in[l], PROJ_SPLITS, -1)
        cka_h = prep_heads(cka, A_KV, kn_a[l], None)
        cva_h = cva.reshape(b, n_ctx, A_KV, HEAD_DIM)
        ckb_h = prep_heads(ckb, B_KV, kn_b[l], None)
        cvb_h = cvb.reshape(b, n_ctx, B_KV, HEAD_DIM)
        qa_h = prep_heads(qa, A_HEADS, qn_a[l], rope)
        ka_h = prep_heads(ka, A_KV, kn_a[l], rope)
        va_h = va.reshape(b, -1, A_KV, HEAD_DIM)
        ya = global_attention(qa_h, jnp.concatenate([cka_h, ka_h], 1), jnp.concatenate([cva_h, va_h], 1))
        qb_h = prep_heads(qb, B_HEADS, qn_b[l], rope)
        kb_h = prep_heads(kb, B_KV, kn_b[l], rope)
        vb_h = vb.reshape(b, -1, B_KV, HEAD_DIM)
        yb = window_attention(qb_h, kb_h, vb_h, ckb_h, cvb_h, sink_b[l])
        yc = chunk_mlp(uc, vc, vn_c[l], ws_c[l], bs_c[l])
        h = h + ml[2] * merge(ya, yb, yc, g_group[l], w_out[l])
        h = h + ml[5] * peer_ffn(modulate(h, norm2_g[l], ml[3], ml[4]), peer_wq[l], peer_keys[l], peer_u[l], peer_v[l])
        if not last:
            cqa_h = prep_heads(cqa, A_HEADS, qn_a[l], None).reshape(b, n_ctx, A_KV, ga, HEAD_DIM)
            cya = attend(cqa_h, cka_h, cva_h).reshape(b, n_ctx, A_WIDTH)
            cqb_h = prep_heads(cqb, B_HEADS, qn_b[l], None).reshape(b, n_ctx, B_KV, gb, HEAD_DIM)
            cyb = attend(cqb_h, ckb_h, cvb_h, sink_b[l].reshape(B_KV, gb)).reshape(b, n_ctx, B_WIDTH)
            cyc = chunk_mlp(cuc, cvc, vn_c[l], ws_c[l], bs_c[l])
            hc = hc + mc[2] * merge(cya, cyb, cyc, g_group[l], w_out[l])
            hc = hc + mc[5] * peer_ffn(modulate(hc, norm2_g[l], mc[3], mc[4]), peer_wq[l], peer_keys[l], peer_u[l], peer_v[l])
    return h
```

```cpp
#include <hip/hip_runtime.h>
#include <hip/hip_cooperative_groups.h>
#include <cstdio>
#include <cstdint>
namespace cg = cooperative_groups;

constexpr int DM = 2048, NB = 8, SEQ = 2048, NCTX = 256, DEPTH = 2;
constexpr int NLAT = NB * SEQ;
constexpr int NCT = NB * NCTX;
constexpr int MTOT = NLAT + NCT;
constexpr int INW = 3584;
constexpr int C_QA = 0, C_KA = 768, C_VA = 1024, C_QB = 1280, C_KB = 2048, C_VB = 2304, C_UC = 2560, C_VC = 3072;
constexpr int NEXP = 16384;
constexpr float EPS = 1e-6f;
constexpr float ATT_SCALE = 0.088388347648318440f;
constexpr int NTHREADS = 512, NWAVES = 8;

constexpr size_t MiB = 1u << 20;
constexpr size_t WS_CTL = 0;
constexpr size_t WS_MOD = 1 * MiB;
constexpr size_t WS_ROPE = 2 * MiB;
constexpr size_t WS_KEYS = 3 * MiB;
constexpr size_t WS_WSC = 4 * MiB;
constexpr size_t WS_USC = 5 * MiB;
constexpr size_t WS_VSC = 6 * MiB;
constexpr size_t WS_WIN = 8 * MiB;
constexpr size_t WS_WOUT = 36 * MiB;
constexpr size_t WS_WQ = 52 * MiB;
constexpr size_t WS_HC = 68 * MiB;
constexpr size_t WS_EID = 84 * MiB;
constexpr size_t WS_GATE = 93 * MiB;
constexpr size_t WS_XN = 104 * MiB;
constexpr size_t WS_Y = 176 * MiB;
constexpr size_t WS_P = 248 * MiB;
constexpr size_t WS_UT = 376 * MiB;
constexpr size_t WS_VT = 504 * MiB;
constexpr size_t WS_DUMMY = 640 * MiB;
constexpr size_t WS_END = 632 * MiB;

constexpr int LDS_BYTES = 147456;

typedef unsigned short bf16_t;
typedef float f32x4 __attribute__((ext_vector_type(4)));
typedef unsigned u32x4 __attribute__((ext_vector_type(4)));
typedef unsigned u32x2 __attribute__((ext_vector_type(2)));

struct Params {
    const float *x, *c, *ctx, *c_ctx, *w_ada, *b_ada, *norm1_g, *norm2_g, *w_in, *qn_a, *kn_a, *qn_b, *kn_b, *sink_b, *vn_c, *ws_c, *bs_c,
        *g_group, *w_out, *peer_wq, *peer_keys, *peer_u, *peer_v;
    float* out;
    unsigned char* ws;
    int ph_lo, ph_hi;
};

__device__ __forceinline__ float bf2f(unsigned v) { return __uint_as_float(v << 16); }
__device__ __forceinline__ float bflo(unsigned w) { return __uint_as_float(w << 16); }
__device__ __forceinline__ float bfhi(unsigned w) { return __uint_as_float(w & 0xffff0000u); }
__device__ __forceinline__ unsigned f2bf(float f) { unsigned u = __float_as_uint(f); return (u + 0x7fffu + ((u >> 16) & 1u)) >> 16; }
__device__ __forceinline__ unsigned pk2(float lo, float hi) { return f2bf(lo) | (f2bf(hi) << 16); }
__device__ __forceinline__ float wave_sum(float v) {
#pragma unroll
    for (int o = 32; o >= 1; o >>= 1) v += __shfl_xor(v, o);
    return v;
}
__device__ __forceinline__ float wave_max(float v) {
#pragma unroll
    for (int o = 32; o >= 1; o >>= 1) v = fmaxf(v, __shfl_xor(v, o));
    return v;
}
__device__ __forceinline__ float gelu_tanh(float x) {
    const float y = 0.7978845608028654f * (x + 0.044715f * x * x * x);
    const float t = 1.f - 2.f / (__expf(2.f * y) + 1.f);
    return 0.5f * x * (1.f + t);
}
__device__ __forceinline__ float silu(float x) { return x / (1.f + __expf(-x)); }
#define LDS_WAIT() asm volatile("s_waitcnt lgkmcnt(0)" ::: "memory")
#ifndef GATHER_I8
#define GATHER_I8 1
#endif
#ifndef GATHER_4BIT
#define GATHER_4BIT 1
#endif
constexpr int ROW4 = 1152;
#ifndef FUSE_ROUTE
#define FUSE_ROUTE 1
#endif
#ifndef QPREP_IN_UNIT
#define QPREP_IN_UNIT 1
#endif
#ifndef CPREP_IN_UNIT
#define CPREP_IN_UNIT 1
#endif
#ifndef REP_MASK
#define REP_MASK 0
#endif

__device__ __forceinline__ void transpose_item(const float* W, int K, int N, bf16_t* WT, const float* gk, float* scr, int item, int lane) {
    const int nblk = N / 32, kb = item / nblk, nb = item % nblk, k0 = 64 * kb, n0 = 32 * nb;
#pragma unroll 8
    for (int i = 0; i < 32; ++i) {
        const int kk = 2 * i + (lane >> 5);
        float v = W[(size_t)(k0 + kk) * N + n0 + (lane & 31)];
        if (gk) v *= gk[k0 + kk];
        scr[kk * 33 + (lane & 31)] = v;
    }
    LDS_WAIT();
    const int c = lane & 7;
#pragma unroll
    for (int j = 0; j < 4; ++j) {
        const int n = (lane >> 3) + 8 * j;
        const float* s = scr + (8 * c) * 33 + n;
        u32x4 o;
        o.x = pk2(s[0 * 33], s[1 * 33]); o.y = pk2(s[2 * 33], s[3 * 33]); o.z = pk2(s[4 * 33], s[5 * 33]); o.w = pk2(s[6 * 33], s[7 * 33]);
        *(u32x4*)(WT + (size_t)(n0 + n) * K + k0 + 8 * c) = o;
    }
    LDS_WAIT();
}
__device__ __forceinline__ void cvt_range(const float* src, bf16_t* dst, size_t n8, size_t gtid, size_t gthreads) {
    for (size_t i = gtid; i < n8; i += gthreads) {
        const f32x4 a = *(const f32x4*)(src + i * 8), b = *(const f32x4*)(src + i * 8 + 4);
        u32x4 o; o.x = pk2(a.x, a.y); o.y = pk2(a.z, a.w); o.z = pk2(b.x, b.y); o.w = pk2(b.z, b.w);
        *(u32x4*)(dst + i * 8) = o;
    }
}

#if GATHER_I8 && GATHER_4BIT
__device__ __forceinline__ void conv4_row(const f32x4 (&v)[8], const bool isv, unsigned char* drow, int lane) {
    float am = 0.f;
#pragma unroll
    for (int i = 0; i < 8; ++i) am = fmaxf(am, fmaxf(fmaxf(fabsf(v[i].x), fabsf(v[i].y)), fmaxf(fabsf(v[i].z), fabsf(v[i].w))));
    const float s0 = am > 0.f ? am * (isv ? (1.f / 6.f) : (1.f / 7.f)) : 1.f;
    const unsigned sb = (__float_as_uint(s0) + 0xffffu) >> 16;
    const float inv = 1.f / __uint_as_float(sb << 16);
    u32x4 o; unsigned w[4];
#pragma unroll
    for (int d = 0; d < 4; ++d) {
        const f32x4 a = v[2 * d], b = v[2 * d + 1];
        const float e[8] = {a.x * inv, a.y * inv, a.z * inv, a.w * inv, b.x * inv, b.y * inv, b.z * inv, b.w * inv};
        unsigned acc = 0u;
        if (isv) {
            acc = __builtin_amdgcn_cvt_scalef32_pk_fp4_f32(acc, e[0], e[1], 1.0f, 0);
            acc = __builtin_amdgcn_cvt_scalef32_pk_fp4_f32(acc, e[2], e[3], 1.0f, 1);
            acc = __builtin_amdgcn_cvt_scalef32_pk_fp4_f32(acc, e[4], e[5], 1.0f, 2);
            acc = __builtin_amdgcn_cvt_scalef32_pk_fp4_f32(acc, e[6], e[7], 1.0f, 3);
        } else {
#pragma unroll
            for (int i = 0; i < 8; ++i) {
                const int q = (int)fminf(fmaxf(rintf(e[i]), -7.f), 7.f);
                acc |= ((unsigned)q & 0xFu) << (8 * (i >> 1) + 4 * (i & 1));
            }
        }
        w[d] = acc;
    }
    o.x = w[0]; o.y = w[1]; o.z = w[2]; o.w = w[3];
    *(u32x4*)(drow + lane * 16) = o;
    *(unsigned short*)(drow + 1024 + lane * 2) = (unsigned short)sb;
}
#endif
#if GATHER_I8 && GATHER_4BIT
#ifndef TABLES_IN_GAPS
#define TABLES_IN_GAPS 1
#endif
__device__ __forceinline__ void conv4_tables(const Params& p, int r0, int r1, unsigned* ctr, unsigned char* lds) {
    const int tid = threadIdx.x, lane = tid & 63, wave = tid >> 6;
    unsigned char* ws = p.ws;
    volatile unsigned* shw = (volatile unsigned*)(lds + LDS_BYTES - 64);
    const int nchunk = (r1 - r0) / 64;
    for (int it = 0;; ++it) {
        int cbeg, cstep, cend;
        if (ctr) {
            __syncthreads();
            if (tid == 0) *shw = atomicAdd(ctr, 1u);
            __syncthreads();
            const int c = (int)*shw; if (c >= nchunk) break;
            cbeg = r0 + c * 64 + wave; cstep = NWAVES; cend = r0 + c * 64 + 64;
        } else {
            if (it > 0) break;
            cbeg = r0 + blockIdx.x * NWAVES + wave; cstep = gridDim.x * NWAVES; cend = r1;
        }
        for (int r = cbeg; r < cend; r += 2 * cstep) {
            const int r2 = r + cstep; const bool has2 = r2 < cend; const int rb = has2 ? r2 : r;
            const bool isvA = r >= 2 * NEXP, isvB = rb >= 2 * NEXP; const int rrA = isvA ? r - 2 * NEXP : r, rrB = isvB ? rb - 2 * NEXP : rb;
            const float* srowA = (isvA ? p.peer_v : p.peer_u) + (size_t)rrA * DM;
            const float* srowB = (isvB ? p.peer_v : p.peer_u) + (size_t)rrB * DM;
            f32x4 va[8], vb[8];
#pragma unroll
            for (int j = 0; j < 2; ++j)
#pragma unroll
                for (int k = 0; k < 4; ++k) { va[j * 4 + k] = *(const f32x4*)(srowA + j * 1024 + lane * 16 + k * 4); vb[j * 4 + k] = *(const f32x4*)(srowB + j * 1024 + lane * 16 + k * 4); }
            conv4_row(va, isvA, (unsigned char*)(ws + (isvA ? WS_VT : WS_UT)) + (size_t)rrA * ROW4, lane);
            if (has2) conv4_row(vb, isvB, (unsigned char*)(ws + (isvB ? WS_VT : WS_UT)) + (size_t)rrB * ROW4, lane);
        }
    }
}
#endif
__device__ __forceinline__ void ph_prologue(const Params& p, unsigned char* lds) {
    const int tid = threadIdx.x, lane = tid & 63, wave = tid >> 6;
    const int gw = blockIdx.x * NWAVES + wave, NGW = gridDim.x * NWAVES;
    unsigned char* ws = p.ws;
    {
        float* sT = (float*)lds;
        float* red = (float*)(lds + 2048 * 12 * 4);
        for (int i = tid; i < 2048 * 9; i += NTHREADS) {
            const int k = i / 9, bb = i % 9;
            const float v = bb < 8 ? p.c[bb * DM + k] : p.c_ctx[k];
            sT[k * 12 + bb] = silu(v);
        }
        __syncthreads();
        const int cq = lane & 7, ks = tid >> 3;
        for (int u = blockIdx.x; u < 768; u += gridDim.x) {
            const int l = u / 384, n0 = (u % 384) * 32;
            const float* W = p.w_ada + (size_t)l * DM * 12288 + n0 + cq * 4;
            float acc[9][4];
#pragma unroll
            for (int b = 0; b < 9; ++b)
#pragma unroll
                for (int j = 0; j < 4; ++j) acc[b][j] = 0.f;
#pragma unroll 8
            for (int i = 0; i < 32; ++i) {
                const int k = ks + 64 * i;
                const f32x4 w = *(const f32x4*)(W + (size_t)k * 12288);
                const f32x4 s0 = *(const f32x4*)(sT + k * 12), s1 = *(const f32x4*)(sT + k * 12 + 4);
                const float s8 = sT[k * 12 + 8];
                const float sv[9] = {s0.x, s0.y, s0.z, s0.w, s1.x, s1.y, s1.z, s1.w, s8};
#pragma unroll
                for (int b = 0; b < 9; ++b) { acc[b][0] += sv[b] * w.x; acc[b][1] += sv[b] * w.y; acc[b][2] += sv[b] * w.z; acc[b][3] += sv[b] * w.w; }
            }
#pragma unroll
            for (int b = 0; b < 9; ++b)
#pragma unroll
                for (int j = 0; j < 4; ++j) {
                    float v = acc[b][j];
                    v += __shfl_xor(v, 8); v += __shfl_xor(v, 16); v += __shfl_xor(v, 32);
                    acc[b][j] = v;
                }
            if (lane < 8) {
#pragma unroll
                for (int b = 0; b < 9; ++b)
#pragma unroll
                    for (int j = 0; j < 4; ++j) red[(wave * 8 + cq) * 36 + b * 4 + j] = acc[b][j];
            }
            __syncthreads();
            if (tid < 288) {
                const int b = tid / 32, col = tid % 32, q = col >> 2, j = col & 3;
                float s = 0.f;
#pragma unroll
                for (int w = 0; w < 8; ++w) s += red[(w * 8 + q) * 36 + b * 4 + j];
                const int n = n0 + col;
                ((float*)(ws + WS_MOD))[(size_t)(l * 9 + b) * 12288 + n] = s + p.b_ada[l * 12288 + n];
            }
            __syncthreads();
        }
    }
    __syncthreads();
    {
        float* scr = (float*)(lds + wave * 8704);
        constexpr int I_IN = 32 * 112, I_SQ = 32 * 64, I_L = I_IN + 2 * I_SQ;
        for (int it = gw; it < 2 * I_L; it += NGW) {
            const int l = it / I_L; int r = it % I_L;
            if (r < I_IN) { transpose_item(p.w_in + (size_t)l * DM * INW, DM, INW, (bf16_t*)(ws + WS_WIN) + (size_t)l * INW * DM, nullptr, scr, r, lane); continue; }
            r -= I_IN;
            if (r < I_SQ) { transpose_item(p.w_out + (size_t)l * DM * DM, DM, DM, (bf16_t*)(ws + WS_WOUT) + (size_t)l * DM * DM, p.g_group + l * DM, scr, r, lane); continue; }
            r -= I_SQ;
            transpose_item(p.peer_wq + (size_t)l * DM * DM, DM, DM, (bf16_t*)(ws + WS_WQ) + (size_t)l * DM * DM, nullptr, scr, r, lane);
        }
    }
    {
        const size_t gtid = (size_t)blockIdx.x * NTHREADS + tid, gth = (size_t)gridDim.x * NTHREADS;
        cvt_range(p.peer_keys, (bf16_t*)(ws + WS_KEYS), (size_t)2 * 8 * 2 * 128 * 128 / 8, gtid, gth);
        cvt_range(p.ws_c, (bf16_t*)(ws + WS_WSC), (size_t)2 * 4 * 128 * 128 / 8, gtid, gth);
#if GATHER_I8 && GATHER_4BIT
        if (!TABLES_IN_GAPS) conv4_tables(p, 0, 4 * NEXP, nullptr, lds);
#elif GATHER_I8
        for (int r = gw; r < 4 * NEXP; r += NGW) {
            const bool isv = r >= 2 * NEXP; const int rr = isv ? r - 2 * NEXP : r;
            const float* srow = (isv ? p.peer_v : p.peer_u) + (size_t)rr * DM;
            f32x4 v[8]; float am = 0.f;
#pragma unroll
            for (int j = 0; j < 2; ++j)
#pragma unroll
                for (int k = 0; k < 4; ++k) {
                    v[j * 4 + k] = *(const f32x4*)(srow + j * 1024 + lane * 16 + k * 4);
                    am = fmaxf(am, fmaxf(fmaxf(fabsf(v[j * 4 + k].x), fabsf(v[j * 4 + k].y)), fmaxf(fabsf(v[j * 4 + k].z), fabsf(v[j * 4 + k].w))));
                }
            am = wave_max(am);
            const float s = am > 0.f ? am * (isv ? (1.f / 443.f) : (1.f / 127.f)) : 1.f, inv = 1.f / s;
            unsigned char* drow = (unsigned char*)(ws + (isv ? WS_VT : WS_UT)) + (size_t)rr * DM;
#pragma unroll
            for (int j = 0; j < 2; ++j) {
                u32x4 o; unsigned w[4];
#pragma unroll
                for (int k = 0; k < 4; ++k) {
                    const f32x4 a = v[j * 4 + k];
                    if (isv) {
                        int pk = __builtin_amdgcn_cvt_pk_fp8_f32(a.x * inv, a.y * inv, 0, false);
                        pk = __builtin_amdgcn_cvt_pk_fp8_f32(a.z * inv, a.w * inv, pk, true);
                        w[k] = (unsigned)pk;
                    } else {
                        const int q0 = (int)rintf(a.x * inv), q1 = (int)rintf(a.y * inv), q2 = (int)rintf(a.z * inv), q3 = (int)rintf(a.w * inv);
                        w[k] = ((unsigned)q0 & 0xffu) | (((unsigned)q1 & 0xffu) << 8) | (((unsigned)q2 & 0xffu) << 16) | ((unsigned)q3 << 24);
                    }
                }
                o.x = w[0]; o.y = w[1]; o.z = w[2]; o.w = w[3];
                *(u32x4*)(drow + j * 1024 + lane * 16) = o;
            }
            if (lane == 0) ((float*)(ws + (isv ? WS_VSC : WS_USC)))[rr] = s;
        }
#else
        cvt_range(p.peer_u, (bf16_t*)(ws + WS_UT), (size_t)2 * NEXP * DM / 8, gtid, gth);
        cvt_range(p.peer_v, (bf16_t*)(ws + WS_VT), (size_t)2 * NEXP * DM / 8, gtid, gth);
#endif
        float* rope = (float*)(ws + WS_ROPE);
        for (size_t i = gtid; i < (size_t)2048 * 64; i += gth) {
            const int t = (int)(i >> 6), f = (int)(i & 63), fi = f & 31;
            const float pos = (f < 32) ? (float)(t >> 6) : (float)(t & 63);
            const float inv = powf(10000.0f, -(float)fi / 32.0f);
            const float ang = pos * inv;
            rope[i * 2] = cosf(ang); rope[i * 2 + 1] = sinf(ang);
        }
    }
}

__device__ __forceinline__ void modulate_store(const f32x4 (&v)[8], float rstd, const float* g, const float* shift, const float* scale, bf16_t* dst, int lane) {
#pragma unroll
    for (int j = 0; j < 8; ++j) {
        const int col = j * 256 + lane * 4;
        const f32x4 gg = *(const f32x4*)(g + col), sc = *(const f32x4*)(scale + col), sh = *(const f32x4*)(shift + col);
        const f32x4 o = v[j] * rstd * gg * (1.f + sc) + sh;
        u32x2 w; w.x = pk2(o.x, o.y); w.y = pk2(o.z, o.w);
        *(u32x2*)(dst + col) = w;
    }
}
__device__ __forceinline__ void ph_modulate(const Params& p, int l, int which) {
    const int tid = threadIdx.x, lane = tid & 63, wave = tid >> 6;
    const int gw = blockIdx.x * NWAVES + wave, NGW = gridDim.x * NWAVES;
    const int nrows = (which == 1 && l == DEPTH - 1) ? NLAT : MTOT;
    const float* g = (which == 0 ? p.norm1_g : p.norm2_g) + l * DM;
    const float* mod = (const float*)(p.ws + WS_MOD) + (size_t)l * 9 * 12288;
    const float* srcLat = (which == 0 && l == 0) ? p.x : p.out;
    const float* srcCtx = (which == 0 && l == 0) ? p.ctx : (const float*)(p.ws + WS_HC);
    bf16_t* XN = (bf16_t*)(p.ws + WS_XN);
    const int moff = (which == 0 ? 0 : 3) * DM;
#pragma unroll 1
    for (int r = gw; r < nrows; r += 2 * NGW) {
        const int r2 = r + NGW; const bool has2 = r2 < nrows; const int rb = has2 ? r2 : r;
        const float* srcA = r < NLAT ? srcLat + (size_t)r * DM : srcCtx + (size_t)(r - NLAT) * DM;
        const float* srcB = rb < NLAT ? srcLat + (size_t)rb * DM : srcCtx + (size_t)(rb - NLAT) * DM;
        f32x4 va[8], vb[8]; float sa = 0.f, sb = 0.f;
#pragma unroll
        for (int j = 0; j < 8; ++j) { va[j] = *(const f32x4*)(srcA + j * 256 + lane * 4); vb[j] = *(const f32x4*)(srcB + j * 256 + lane * 4); }
#pragma unroll
        for (int j = 0; j < 8; ++j) { sa += va[j].x * va[j].x + va[j].y * va[j].y + va[j].z * va[j].z + va[j].w * va[j].w; sb += vb[j].x * vb[j].x + vb[j].y * vb[j].y + vb[j].z * vb[j].z + vb[j].w * vb[j].w; }
        sa = wave_sum(sa); sb = wave_sum(sb);
        const float* shA = mod + (size_t)(r < NLAT ? (r >> 11) : 8) * 12288 + moff;
        modulate_store(va, rsqrtf(sa * (1.f / DM) + EPS), g, shA, shA + DM, XN + (size_t)r * DM, lane);
        if (has2) {
            const float* shB = mod + (size_t)(r2 < NLAT ? (r2 >> 11) : 8) * 12288 + moff;
            modulate_store(vb, rsqrtf(sb * (1.f / DM) + EPS), g, shB, shB + DM, XN + (size_t)r2 * DM, lane);
        }
    }
}

struct EpiBf16Store {
    bf16_t* O; int ldc;
    __device__ __forceinline__ void operator()(int row, int col, const float* a) const {
        u32x4 w; w.x = pk2(a[0], a[1]); w.y = pk2(a[2], a[3]); w.z = pk2(a[4], a[5]); w.w = pk2(a[6], a[7]);
        *(u32x4*)(O + (size_t)row * ldc + col) = w;
    }
};
struct EpiResGate {
    const float *resLat, *resCtx; float *outLat, *outCtx; const float* gate;
    __device__ __forceinline__ void operator()(int row, int col, const float* a) const {
        const int bb = row < NLAT ? (row >> 11) : 8;
        const float* gp = gate + (size_t)bb * 12288 + col;
        const float* rp = row < NLAT ? resLat + (size_t)row * DM + col : resCtx + (size_t)(row - NLAT) * DM + col;
        float* op = row < NLAT ? outLat + (size_t)row * DM + col : outCtx + (size_t)(row - NLAT) * DM + col;
        const f32x4 g0 = *(const f32x4*)gp, g1 = *(const f32x4*)(gp + 4), r0 = *(const f32x4*)rp, r1 = *(const f32x4*)(rp + 4);
        f32x4 o0, o1;
        o0.x = r0.x + g0.x * a[0]; o0.y = r0.y + g0.y * a[1]; o0.z = r0.z + g0.z * a[2]; o0.w = r0.w + g0.w * a[3];
        o1.x = r1.x + g1.x * a[4]; o1.y = r1.y + g1.y * a[5]; o1.z = r1.z + g1.z * a[6]; o1.w = r1.w + g1.w * a[7];
        *(f32x4*)op = o0; *(f32x4*)(op + 4) = o1;
    }
};
template <class Epi>
__device__ __forceinline__ void gemm_naive(unsigned char* lds, const bf16_t* A, const bf16_t* Bt, int M, int N, int K, const Epi& E) {
    float* As = (float*)lds;
    float* Bs = As + 32 * 132;
    const int tid = threadIdx.x, tx = tid & 15, ty = tid >> 4;
    const int lrow = tid >> 2, lkc = (tid & 3) * 8;
    const int nM = M / 128, nN = N / 128;
    for (int u = blockIdx.x; u < nM * nN; u += gridDim.x) {
        const int pm = u / nN, pn = u % nN, m0 = pm * 128, n0 = pn * 128;
        float acc[4][8];
#pragma unroll
        for (int i = 0; i < 4; ++i)
#pragma unroll
            for (int j = 0; j < 8; ++j) acc[i][j] = 0.f;
        for (int k0 = 0; k0 < K; k0 += 32) {
            const u32x4 av = *(const u32x4*)(A + (size_t)(m0 + lrow) * K + k0 + lkc);
            const u32x4 bv = *(const u32x4*)(Bt + (size_t)(n0 + lrow) * K + k0 + lkc);
            __syncthreads();
            As[(lkc + 0) * 132 + lrow] = bflo(av.x); As[(lkc + 1) * 132 + lrow] = bfhi(av.x);
            As[(lkc + 2) * 132 + lrow] = bflo(av.y); As[(lkc + 3) * 132 + lrow] = bfhi(av.y);
            As[(lkc + 4) * 132 + lrow] = bflo(av.z); As[(lkc + 5) * 132 + lrow] = bfhi(av.z);
            As[(lkc + 6) * 132 + lrow] = bflo(av.w); As[(lkc + 7) * 132 + lrow] = bfhi(av.w);
            Bs[(lkc + 0) * 132 + lrow] = bflo(bv.x); Bs[(lkc + 1) * 132 + lrow] = bfhi(bv.x);
            Bs[(lkc + 2) * 132 + lrow] = bflo(bv.y); Bs[(lkc + 3) * 132 + lrow] = bfhi(bv.y);
            Bs[(lkc + 4) * 132 + lrow] = bflo(bv.z); Bs[(lkc + 5) * 132 + lrow] = bfhi(bv.z);
            Bs[(lkc + 6) * 132 + lrow] = bflo(bv.w); Bs[(lkc + 7) * 132 + lrow] = bfhi(bv.w);
            __syncthreads();
#pragma unroll 8
            for (int k = 0; k < 32; ++k) {
                const f32x4 a = *(const f32x4*)(As + k * 132 + ty * 4);
                const f32x4 b0 = *(const f32x4*)(Bs + k * 132 + tx * 8), b1 = *(const f32x4*)(Bs + k * 132 + tx * 8 + 4);
                const float av4[4] = {a.x, a.y, a.z, a.w};
                const float bv8[8] = {b0.x, b0.y, b0.z, b0.w, b1.x, b1.y, b1.z, b1.w};
#pragma unroll
                for (int i = 0; i < 4; ++i)
#pragma unroll
                    for (int j = 0; j < 8; ++j) acc[i][j] += av4[i] * bv8[j];
            }
        }
#pragma unroll
        for (int i = 0; i < 4; ++i) E(m0 + ty * 4 + i, n0 + tx * 8, acc[i]);
    }
}

namespace pg8 {
#define PG8_LAS __attribute__((address_space(3)))
typedef unsigned short bf16_t;
typedef short bf16x8 __attribute__((ext_vector_type(8)));
typedef float f32x4 __attribute__((ext_vector_type(4)));
typedef unsigned u32x4 __attribute__((ext_vector_type(4)));
constexpr int BM = 256, BK = 64, HALF = 128, HTB = HALF * BK * 2  , STAGE_BYTES = 8 * HTB, NXCD = 8, WGM = 8;

__host__ __device__ __forceinline__ int lds_byte(int r, int c) { const int st = (r >> 4) * 2 + (c >> 5), rr = r & 15, cc = c & 31, ob = rr * 64 + cc * 2; return st * 1024 + (ob ^ (((ob >> 9) & 1) << 5)); }
__host__ __device__ __forceinline__ void stage_rc(int b, int& R, int& C) { const int st = b / 1024, sb = b % 1024, swz = sb ^ (((sb >> 9) & 1) << 5); R = (st >> 1) * 16 + swz / 64; C = (st & 1) * 32 + (swz % 64) / 2; }
__host__ __device__ __forceinline__ int perm32(int rho) { const int n = rho >> 4, i = rho & 15; return 8 * (i >> 2) + 4 * n + (i & 3); }

struct Unit { int pm, pn; };
struct Gemm { const bf16_t* A; const bf16_t* Bt; int M, N, K; };

struct StaticOrder {
    int nM, nN, nwg, G, c;
    __host__ __device__ void init(int M, int N, int G_, int c_) { nM = M / BM; nN = N / BM; nwg = nM * nN; G = G_; c = c_; }
    __host__ __device__ bool next(int i, Unit& u) const {
        const long L = (long)i * G + c; if (L >= nwg) return false;
        int wgid = (int)L; { const int q = nwg / NXCD, r = nwg % NXCD, xcd = wgid % NXCD, off = wgid / NXCD; wgid = (xcd < r ? xcd * (q + 1) : r * (q + 1) + (xcd - r) * q) + off; }
        const int nig = WGM * nN, gid = wgid / nig, fm = gid * WGM, gsz = (nM - fm) < WGM ? (nM - fm) : WGM;
        u.pm = fm + ((wgid % nig) % gsz); u.pn = (wgid % nig) / gsz; return true;
    }
    __device__ __forceinline__ void a_ready(const Unit&) const {}
    __device__ __forceinline__ void done(const Unit&) const {}
};

__device__ __forceinline__ unsigned cvt_pk_bf16(float lo, float hi) { unsigned r; asm volatile("v_cvt_pk_bf16_f32 %0, %1, %2" : "=v"(r) : "v"(lo), "v"(hi)); return r; }
typedef float f32x2 __attribute__((ext_vector_type(2)));
__device__ __forceinline__ f32x2 gelu_pk(f32x2 v) {
    const f32x2 av = __builtin_elementwise_abs(v), d = av * 0.2316418882f + 1.0f;
    f32x2 t; t.x = __builtin_amdgcn_rcpf(d.x); t.y = __builtin_amdgcn_rcpf(d.y);
    f32x2 q = t * 0.5307027145f + (-0.7265760135f); q = q * t + 0.7107068705f; q = q * t + (-0.142248368f); q = q * t + 0.127414796f; q = q * t;
    const f32x2 s = (v * v) * (-0.72134752044f);
    f32x2 e; e.x = __builtin_amdgcn_exp2f(s.x); e.y = __builtin_amdgcn_exp2f(s.y);
    const f32x2 m = v * (q * e), r = v - m;
    f32x2 o; o.x = v.x < 0.f ? m.x : r.x; o.y = v.y < 0.f ? m.y : r.y; return o;
}

template <int ACT  > struct EpiBf16 {
    static constexpr bool PERM = true, AFTER_DRAIN = false; static_assert(ACT == 0 || ACT == 1, "EpiBf16: ACT is 0 (none) or 1 (gelu_pk)");
    bf16_t* O; int ldc; const float* bias; int split_cols; size_t split_stride; float scale0;
    __device__ __forceinline__ void operator()(const f32x4 (&acc)[2][2][4][2], const Unit& u, int wr, int wc, int fr, int fq) const {
        const int row0 = u.pm * BM + wr * 64 + fr; int colt = u.pn * BM; bf16_t* base = O;
        float sc = 1.f; if (split_cols) { const int t = colt / split_cols; base += (size_t)t * split_stride; colt -= t * split_cols; if (t == 0) sc = scale0; }
        const int col0 = colt + wc * 32 + 8 * fq, bcol0 = u.pn * BM + wc * 32 + 8 * fq;
        f32x4 bv[2][2];
#pragma unroll
        for (int bj = 0; bj < 2; ++bj)
#pragma unroll
            for (int n = 0; n < 2; ++n) bv[bj][n] = bias ? *(const f32x4*)(bias + bcol0 + bj * HALF + 4 * n) : (f32x4){0.f, 0.f, 0.f, 0.f};
#pragma unroll
        for (int ai = 0; ai < 2; ++ai)
#pragma unroll
            for (int m = 0; m < 4; ++m) { bf16_t* rowp = base + (size_t)(row0 + ai * HALF + m * 16) * ldc + col0;
#pragma unroll
                for (int bj = 0; bj < 2; ++bj) { f32x4 v0 = acc[ai][bj][m][0] + bv[bj][0], v1 = acc[ai][bj][m][1] + bv[bj][1];
                    if (ACT == 1) { f32x2 a = gelu_pk((f32x2){v0[0], v0[1]}), b = gelu_pk((f32x2){v0[2], v0[3]}), c = gelu_pk((f32x2){v1[0], v1[1]}), d = gelu_pk((f32x2){v1[2], v1[3]});
                        v0 = (f32x4){a.x, a.y, b.x, b.y}; v1 = (f32x4){c.x, c.y, d.x, d.y}; }
                    v0 = v0 * sc; v1 = v1 * sc; u32x4 w; w.x = cvt_pk_bf16(v0[0], v0[1]); w.y = cvt_pk_bf16(v0[2], v0[3]); w.z = cvt_pk_bf16(v1[0], v1[1]); w.w = cvt_pk_bf16(v1[2], v1[3]);
                    *(u32x4*)(rowp + bj * HALF) = w; } }
    }
};
template <class Epi, class Sched, bool ALIGN_EPI = false, bool SP2 = false>
__device__ __forceinline__ void gemm_phase(PG8_LAS unsigned char* lds, const Gemm g, const Sched& S, const Epi& E) {
    const int tid = threadIdx.x, wid = __builtin_amdgcn_readfirstlane(tid >> 6), lane = tid & 63, wr = wid >> 2, wc = wid & 3, fr = lane & 15, fq = lane >> 4;
    const int K = g.K, nt = K / BK;
    unsigned voffA[2], voffB[2];
#pragma unroll
    for (int i = 0; i < 2; ++i) { int R, C; stage_rc(tid * 16 + i * 8192, R, C); const int Rb = Epi::PERM ? ((R & ~31) + perm32(R & 31)) : R;
        voffA[i] = (unsigned)(R * K + C) * 2u; voffB[i] = (unsigned)(Rb * K + C) * 2u; }
    const size_t kstep = (size_t)(BK * 2);
    const size_t hstep = (size_t)HALF * K * 2;
    const size_t tstep = 2 * hstep;
    const unsigned ldsw = (unsigned)wid * 1024u;
    const int aoff = lds_byte(wr * 64 + fr, fq * 8), boff = lds_byte(wc * 32 + fr, fq * 8);
#define PG8_SA(b, h) (((b) * 2 + (h)) * HTB)
#define PG8_SB(b, h) ((4 + (b) * 2 + (h)) * HTB)
#define PG8_STAGE(bufoff, gbase, voff) do { _Pragma("unroll") for (int _i = 0; _i < 2; ++_i) \
        __builtin_amdgcn_global_load_lds((const unsigned*)((const char*)(gbase) + (voff)[_i]), (PG8_LAS unsigned*)(lds + (bufoff) + ldsw + _i * 8192), 16, 0, 0); } while (0)
#define PG8_LDA(dst, b, h) do { _Pragma("unroll") for (int m = 0; m < 4; ++m) _Pragma("unroll") for (int k = 0; k < 2; ++k) dst[m][k] = *(const PG8_LAS bf16x8*)(lds + PG8_SA(b, h) + aoff + m * 2048 + k * 1024); } while (0)
#define PG8_LDB(dst, b, h) do { _Pragma("unroll") for (int n = 0; n < 2; ++n) _Pragma("unroll") for (int k = 0; k < 2; ++k) dst[n][k] = *(const PG8_LAS bf16x8*)(lds + PG8_SB(b, h) + boff + n * 2048 + k * 1024); } while (0)
#define PG8_MMA(ai, bj, At, Bt) do { __builtin_amdgcn_s_setprio(1); _Pragma("unroll") for (int m = 0; m < 4; ++m) _Pragma("unroll") for (int n = 0; n < 2; ++n) _Pragma("unroll") for (int k = 0; k < 2; ++k) \
        acc[ai][bj][m][n] = __builtin_amdgcn_mfma_f32_16x16x32_bf16(Bt[n][k], At[m][k], acc[ai][bj][m][n], 0, 0, 0); __builtin_amdgcn_s_setprio(0); } while (0)
#define PG8_WAIT_V(n) asm volatile("s_waitcnt vmcnt(" #n ")" ::: "memory")
#define PG8_WAIT_L(n) asm volatile("s_waitcnt lgkmcnt(" #n ")" ::: "memory")
#define PG8_BAR __builtin_amdgcn_s_barrier()
#define PG8_SCHED __builtin_amdgcn_sched_barrier(0)
    Unit cur, nxt; int ui = 0;
    if (!S.next(0, cur)) return;
    f32x4 acc[2][2][4][2];
#pragma unroll
    for (int a = 0; a < 2; ++a)
#pragma unroll
        for (int b = 0; b < 2; ++b)
#pragma unroll
            for (int m = 0; m < 4; ++m)
#pragma unroll
                for (int n = 0; n < 2; ++n) acc[a][b][m][n] = (f32x4){0.f, 0.f, 0.f, 0.f};
    bf16x8 At[4][2], B0[2][2], B1[2][2];
    const char* cA = (const char*)g.A + (size_t)cur.pm * tstep; const char* cB = (const char*)g.Bt + (size_t)cur.pn * tstep;
    S.a_ready(cur);
    if constexpr (SP2) {
        PG8_STAGE(PG8_SB(0, 0), cB, voffB); PG8_STAGE(PG8_SB(0, 1), cB + hstep, voffB); PG8_STAGE(PG8_SA(0, 0), cA, voffA); PG8_STAGE(PG8_SA(0, 1), cA + hstep, voffA);
        if (wr == 1) PG8_BAR;
        PG8_WAIT_V(2); PG8_BAR;
        PG8_STAGE(PG8_SB(1, 0), cB + kstep, voffB); PG8_STAGE(PG8_SA(1, 0), cA + kstep, voffA); PG8_STAGE(PG8_SB(1, 1), cB + hstep + kstep, voffB);
        PG8_WAIT_V(6); PG8_BAR;
    } else {
        PG8_STAGE(PG8_SB(0, 0), cB, voffB); PG8_STAGE(PG8_SA(0, 0), cA, voffA); PG8_STAGE(PG8_SB(0, 1), cB + hstep, voffB); PG8_STAGE(PG8_SA(0, 1), cA + hstep, voffA);
        if (wr == 1) PG8_BAR;
        PG8_WAIT_V(4); PG8_BAR;
        PG8_STAGE(PG8_SB(1, 0), cB + kstep, voffB); PG8_STAGE(PG8_SA(1, 0), cA + kstep, voffA); PG8_STAGE(PG8_SB(1, 1), cB + hstep + kstep, voffB);
        PG8_WAIT_V(6); PG8_BAR;
    }
    for (;;) {
        const bool has_next = S.next(ui + 1, nxt);
        const char* nA = has_next ? (const char*)g.A + (size_t)nxt.pm * tstep : cA; const char* nB = has_next ? (const char*)g.Bt + (size_t)nxt.pn * tstep : cB;
        for (int t = 0; t < nt; t += 2) {
            const bool last = (t == nt - 2);
            const char* a1 = cA + (size_t)(t + 1) * kstep;
            const char* a2 = last ? nA : cA + (size_t)(t + 2) * kstep; const char* b2 = last ? nB : cB + (size_t)(t + 2) * kstep;
            const char* a3 = a2 + kstep; const char* b3 = b2 + kstep;
            if (last && has_next) S.a_ready(nxt);
            if constexpr (SP2) {
            PG8_LDB(B0, 0, 0); PG8_LDB(B1, 0, 1); PG8_SCHED; PG8_LDA(At, 0, 0); PG8_STAGE(PG8_SA(1, 1), a1 + hstep, voffA);
            PG8_WAIT_V(8); PG8_WAIT_L(0); PG8_BAR; PG8_MMA(0, 0, At, B0); PG8_MMA(0, 1, At, B1); PG8_BAR; PG8_SCHED;
            PG8_LDA(At, 0, 1); PG8_STAGE(PG8_SB(0, 0), b2, voffB); PG8_STAGE(PG8_SB(0, 1), b2 + hstep, voffB); PG8_STAGE(PG8_SA(0, 0), a2, voffA);
            PG8_WAIT_V(8); PG8_WAIT_L(0); PG8_BAR; PG8_MMA(1, 0, At, B0); PG8_MMA(1, 1, At, B1); PG8_BAR; PG8_SCHED;
            PG8_LDB(B0, 1, 0); PG8_LDB(B1, 1, 1); PG8_SCHED; PG8_LDA(At, 1, 0); PG8_STAGE(PG8_SA(0, 1), a2 + hstep, voffA);
            PG8_WAIT_V(8); PG8_WAIT_L(0); PG8_BAR; PG8_MMA(0, 0, At, B0); PG8_MMA(0, 1, At, B1); PG8_BAR; PG8_SCHED;
            PG8_LDA(At, 1, 1); PG8_STAGE(PG8_SB(1, 0), b3, voffB); PG8_STAGE(PG8_SB(1, 1), b3 + hstep, voffB); PG8_STAGE(PG8_SA(1, 0), a3, voffA);
            PG8_WAIT_V(8); PG8_WAIT_L(0); PG8_BAR; PG8_MMA(1, 0, At, B0); PG8_MMA(1, 1, At, B1); PG8_BAR; PG8_SCHED;
            } else {
            PG8_LDB(B0, 0, 0); PG8_SCHED; PG8_LDA(At, 0, 0); PG8_STAGE(PG8_SA(1, 1), a1 + hstep, voffA);
            PG8_WAIT_L(8); PG8_BAR; PG8_WAIT_L(0); PG8_MMA(0, 0, At, B0); PG8_BAR; PG8_SCHED;
            PG8_LDB(B1, 0, 1); PG8_STAGE(PG8_SB(0, 0), b2, voffB);
            PG8_BAR; PG8_WAIT_L(0); PG8_MMA(0, 1, At, B1); PG8_BAR;
            PG8_LDA(At, 0, 1); PG8_STAGE(PG8_SA(0, 0), a2, voffA);
            PG8_BAR; PG8_WAIT_L(0); PG8_MMA(1, 0, At, B0); PG8_BAR; PG8_SCHED;
            PG8_STAGE(PG8_SB(0, 1), b2 + hstep, voffB);
            PG8_WAIT_V(6); PG8_BAR; PG8_MMA(1, 1, At, B1); PG8_BAR;
            PG8_LDB(B0, 1, 0); PG8_SCHED; PG8_LDA(At, 1, 0); PG8_STAGE(PG8_SA(0, 1), a2 + hstep, voffA);
            PG8_WAIT_L(8); PG8_BAR; PG8_WAIT_L(0); PG8_MMA(0, 0, At, B0); PG8_BAR; PG8_SCHED;
            PG8_LDB(B1, 1, 1); PG8_STAGE(PG8_SB(1, 0), b3, voffB);
            PG8_BAR; PG8_WAIT_L(0); PG8_MMA(0, 1, At, B1); PG8_BAR;
            PG8_LDA(At, 1, 1); PG8_STAGE(PG8_SA(1, 0), a3, voffA);
            PG8_BAR; PG8_WAIT_L(0); PG8_MMA(1, 0, At, B0); PG8_BAR; PG8_SCHED;
            PG8_STAGE(PG8_SB(1, 1), b3 + hstep, voffB);
            PG8_WAIT_V(6); PG8_BAR; PG8_MMA(1, 1, At, B1); PG8_BAR;
            }
        }
        if constexpr (ALIGN_EPI) { if (wr == 0) PG8_BAR; }
        if constexpr (!Epi::AFTER_DRAIN) { E(acc, cur, wr, wc, fr, fq); S.done(cur); }
        if (!has_next) break;
#pragma unroll
        for (int a = 0; a < 2; ++a)
#pragma unroll
            for (int b = 0; b < 2; ++b)
#pragma unroll
                for (int m = 0; m < 4; ++m)
#pragma unroll
                    for (int n = 0; n < 2; ++n) acc[a][b][m][n] = (f32x4){0.f, 0.f, 0.f, 0.f};
        cur = nxt; cA = nA; cB = nB; ++ui;
        if constexpr (ALIGN_EPI) { if (wr == 1) PG8_BAR; }
    }
    PG8_WAIT_V(0);
    if constexpr (!ALIGN_EPI) { if (wr == 0) PG8_BAR; }
    PG8_BAR;
    if constexpr (Epi::AFTER_DRAIN) { E.fused(acc, cur, wr, wc, fr, fq, lds, wid, lane); S.done(cur); }
#undef PG8_SA
#undef PG8_SB
#undef PG8_STAGE
#undef PG8_LDA
#undef PG8_LDB
#undef PG8_MMA
#undef PG8_WAIT_V
#undef PG8_WAIT_L
#undef PG8_BAR
#undef PG8_SCHED
}

struct EpiResGateT {
    static constexpr bool PERM = false, AFTER_DRAIN = false;
    const float *resLat, *resCtx; float *outLat, *outCtx; const float* gate;
    __device__ __forceinline__ void operator()(const f32x4 (&acc)[2][2][4][2], const Unit& u, int wr, int wc, int fr, int fq) const {
        const int trow = u.pm * BM, row0 = trow + wr * 64 + fr, col0 = u.pn * BM + wc * 32 + 4 * fq;
        const bool lat = trow < 16384;
        const int bb = lat ? (trow >> 11) : 8;
        const float* rbase = lat ? resLat + (size_t)row0 * 2048 : resCtx + (size_t)(row0 - 16384) * 2048;
        float* obase = lat ? outLat + (size_t)row0 * 2048 : outCtx + (size_t)(row0 - 16384) * 2048;
        f32x4 gv[2][2];
#pragma unroll
        for (int bj = 0; bj < 2; ++bj)
#pragma unroll
            for (int n = 0; n < 2; ++n) gv[bj][n] = *(const f32x4*)(gate + (size_t)bb * 12288 + col0 + bj * HALF + n * 16);
#pragma unroll
        for (int ai = 0; ai < 2; ++ai)
#pragma unroll
            for (int m = 0; m < 4; ++m) {
                const size_t off = (size_t)(ai * HALF + m * 16) * 2048 + col0;
#pragma unroll
                for (int bj = 0; bj < 2; ++bj)
#pragma unroll
                    for (int n = 0; n < 2; ++n) {
                        const f32x4 r = *(const f32x4*)(rbase + off + bj * HALF + n * 16);
                        *(f32x4*)(obase + off + bj * HALF + n * 16) = r + gv[bj][n] * acc[ai][bj][m][n];
                    }
            }
    }
};
}
#ifndef USE_PG8
#define USE_PG8 1
#endif

__device__ __forceinline__ float sum16(float v) { v += __shfl_xor(v, 1); v += __shfl_xor(v, 2); v += __shfl_xor(v, 4); v += __shfl_xor(v, 8); return v; }
__device__ __forceinline__ void ph_prep(const Params& p, int l, const bool dry) {
    const int tid = threadIdx.x, lane = tid & 63, wave = tid >> 6, sub = lane >> 4, li = lane & 15;
    const int gw = blockIdx.x * NWAVES + wave, NGW = gridDim.x * NWAVES;
    bf16_t* P = (bf16_t*)(p.ws + WS_P);
    const float* rope = (const float*)(p.ws + WS_ROPE);
    const bool last = (l == DEPTH - 1);
    const int f0 = (li >= 8 ? 32 : 0) + 8 * (li & 3);
    const float sg = (li & 4) ? 1.f : -1.f;
#pragma unroll 1
    for (int r = gw; r < MTOT; r += NGW) {
        bf16_t* row = P + (size_t)r * INW;
        bf16_t* wrow = dry ? (bf16_t*)(p.ws + WS_DUMMY) + (size_t)r * INW : row;
        const bool isctx = r >= NLAT;
        const int t = r & (SEQ - 1);
        float cs[8], sn[8];
        if (!isctx) {
            const f32x4* rp = (const f32x4*)(rope + ((size_t)t * 64 + f0) * 2);
            const f32x4 a = rp[0], b = rp[1], c = rp[2], d = rp[3];
            cs[0] = a.x; sn[0] = a.y; cs[1] = a.z; sn[1] = a.w; cs[2] = b.x; sn[2] = b.y; cs[3] = b.z; sn[3] = b.w;
            cs[4] = c.x; sn[4] = c.y; cs[5] = c.z; sn[5] = c.w; cs[6] = d.x; sn[6] = d.y; cs[7] = d.z; sn[7] = d.w;
        } else {
#pragma unroll
            for (int i = 0; i < 8; ++i) { cs[i] = 1.f; sn[i] = 0.f; }
        }
        constexpr int NGRP = CPREP_IN_UNIT ? 5 : 7;
        u32x4 raw[NGRP];
#pragma unroll
        for (int gI = 0; gI < NGRP; ++gI) raw[gI] = *(const u32x4*)(row + (gI * 4 + sub) * 128 + li * 8);
#pragma unroll
        for (int gI = 0; gI < NGRP; ++gI) {
            const int slot = gI * 4 + sub;
            const int kind = slot < 8 ? 0 : slot < 10 ? 1 : slot < 18 ? 0 : slot < 20 ? 1 : slot < 24 ? 2 : 3;
            const bool isq = slot < 6 || (slot >= 10 && slot < 16);
            float x[8];
            x[0] = bflo(raw[gI].x); x[1] = bfhi(raw[gI].x); x[2] = bflo(raw[gI].y); x[3] = bfhi(raw[gI].y);
            x[4] = bflo(raw[gI].z); x[5] = bfhi(raw[gI].z); x[6] = bflo(raw[gI].w); x[7] = bfhi(raw[gI].w);
            if (kind >= 2) {
#pragma unroll
                for (int i = 0; i < 8; ++i) x[i] = gelu_tanh(x[i]);
            }
            float ss = 0.f;
#pragma unroll
            for (int i = 0; i < 8; ++i) ss += x[i] * x[i];
            ss = sum16(ss);
            const float rstd = rsqrtf(ss * (1.f / 128.f) + EPS);
            const float* gain = slot < 6 ? p.qn_a + l * 128 : slot < 8 ? p.kn_a + l * 128 : slot < 16 ? p.qn_b + l * 128 : slot < 20 ? p.kn_b + l * 128 : p.vn_c + l * 512 + (slot - 24) * 128;
            if (kind == 0 || kind == 3) {
                const f32x4 g0 = *(const f32x4*)(gain + li * 8), g1 = *(const f32x4*)(gain + li * 8 + 4);
                x[0] *= rstd * g0.x; x[1] *= rstd * g0.y; x[2] *= rstd * g0.z; x[3] *= rstd * g0.w;
                x[4] *= rstd * g1.x; x[5] *= rstd * g1.y; x[6] *= rstd * g1.z; x[7] *= rstd * g1.w;
            }
            float px[8];
#pragma unroll
            for (int i = 0; i < 8; ++i) px[i] = __shfl_xor(x[i], 4);
            if (kind == 0) {
#pragma unroll
                for (int i = 0; i < 8; ++i) x[i] = x[i] * cs[i] + sg * px[i] * sn[i];
            }
            bool wr = kind != 1;
            if (isctx && last && (isq || kind >= 2)) wr = false;
            if (wr) { u32x4 o; o.x = pk2(x[0], x[1]); o.y = pk2(x[2], x[3]); o.z = pk2(x[4], x[5]); o.w = pk2(x[6], x[7]); *(u32x4*)(wrow + slot * 128 + li * 8) = o; }
        }
    }
}


__device__ __forceinline__ void ph_prep_k(const Params& p, int l, const bool dry) {
    const int tid = threadIdx.x, lane = tid & 63, wave = tid >> 6, sub = lane >> 4, li = lane & 15;
    const int gw = blockIdx.x * NWAVES + wave, NGW = gridDim.x * NWAVES;
    bf16_t* P = (bf16_t*)(p.ws + WS_P);
    const float* rope = (const float*)(p.ws + WS_ROPE);
    const int f0 = (li >= 8 ? 32 : 0) + 8 * (li & 3);
    const float sg = (li & 4) ? 1.f : -1.f;
    const int slot = sub < 2 ? 6 + sub : 14 + sub;
    const float* gain = (sub < 2 ? p.kn_a : p.kn_b) + l * 128 + li * 8;
    const f32x4 g0 = *(const f32x4*)gain, g1 = *(const f32x4*)(gain + 4);
#pragma unroll 1
    for (int r = gw; r < MTOT; r += 2 * NGW) {
        const int r2 = r + NGW; const bool has2 = r2 < MTOT; const int rb = has2 ? r2 : r;
        const u32x4 rawA = *(const u32x4*)(P + (size_t)r * INW + slot * 128 + li * 8), rawB = *(const u32x4*)(P + (size_t)rb * INW + slot * 128 + li * 8);
        f32x4 ra[4], rbv[4];
        const bool ctxA = r >= NLAT, ctxB = rb >= NLAT;
        if (!ctxA) { const f32x4* rp = (const f32x4*)(rope + ((size_t)(r & (SEQ - 1)) * 64 + f0) * 2); ra[0] = rp[0]; ra[1] = rp[1]; ra[2] = rp[2]; ra[3] = rp[3]; }
        if (!ctxB) { const f32x4* rp = (const f32x4*)(rope + ((size_t)(rb & (SEQ - 1)) * 64 + f0) * 2); rbv[0] = rp[0]; rbv[1] = rp[1]; rbv[2] = rp[2]; rbv[3] = rp[3]; }
#pragma unroll
        for (int which = 0; which < 2; ++which) {
            const u32x4 raw = which ? rawB : rawA; const bool isctx = which ? ctxB : ctxA; const int rr = which ? rb : r;
            if (which && !has2) break;
            float x[8];
            x[0] = bflo(raw.x); x[1] = bfhi(raw.x); x[2] = bflo(raw.y); x[3] = bfhi(raw.y); x[4] = bflo(raw.z); x[5] = bfhi(raw.z); x[6] = bflo(raw.w); x[7] = bfhi(raw.w);
            float ss = 0.f;
#pragma unroll
            for (int i = 0; i < 8; ++i) ss += x[i] * x[i];
            ss = sum16(ss);
            const float rstd = rsqrtf(ss * (1.f / 128.f) + EPS);
            x[0] *= rstd * g0.x; x[1] *= rstd * g0.y; x[2] *= rstd * g0.z; x[3] *= rstd * g0.w;
            x[4] *= rstd * g1.x; x[5] *= rstd * g1.y; x[6] *= rstd * g1.z; x[7] *= rstd * g1.w;
            float px[8];
#pragma unroll
            for (int i = 0; i < 8; ++i) px[i] = __shfl_xor(x[i], 4);
            if (!isctx) {
                const f32x4* cs4 = which ? rbv : ra;
                const float cs[8] = {cs4[0].x, cs4[0].z, cs4[1].x, cs4[1].z, cs4[2].x, cs4[2].z, cs4[3].x, cs4[3].z};
                const float sn[8] = {cs4[0].y, cs4[0].w, cs4[1].y, cs4[1].w, cs4[2].y, cs4[2].w, cs4[3].y, cs4[3].w};
#pragma unroll
                for (int i = 0; i < 8; ++i) x[i] = x[i] * cs[i] + sg * px[i] * sn[i];
            }
            bf16_t* wrow = dry ? (bf16_t*)(p.ws + WS_DUMMY) + (size_t)rr * INW : P + (size_t)rr * INW;
            u32x4 o; o.x = pk2(x[0], x[1]); o.y = pk2(x[2], x[3]); o.z = pk2(x[4], x[5]); o.w = pk2(x[6], x[7]);
            *(u32x4*)(wrow + slot * 128 + li * 8) = o;
        }
    }
}

__device__ __forceinline__ void attn_row_naive(const bf16_t* q, const bf16_t* kc, const bf16_t* vc, const bf16_t* kl, const bf16_t* vl, int j0, int j1,
                                               bool has_sink, float sink, bf16_t* o, int lane) {
    const unsigned qq = *(const unsigned*)(q + 2 * lane);
    const float q0 = bflo(qq), q1 = bfhi(qq);
    float m = -INFINITY, lsum = 0.f, o0 = 0.f, o1 = 0.f;
    const int ntot = NCTX + (j1 - j0);
    for (int j = 0; j < ntot; ++j) {
        const bf16_t* kp = j < NCTX ? kc + (size_t)j * INW : kl + (size_t)(j0 + j - NCTX) * INW;
        const bf16_t* vp = j < NCTX ? vc + (size_t)j * INW : vl + (size_t)(j0 + j - NCTX) * INW;
        const unsigned kk = *(const unsigned*)(kp + 2 * lane), vv = *(const unsigned*)(vp + 2 * lane);
        const float s = wave_sum(q0 * bflo(kk) + q1 * bfhi(kk)) * ATT_SCALE;
        const float mn = fmaxf(m, s);
        const float a = __expf(m - mn), pp = __expf(s - mn);
        lsum = lsum * a + pp; o0 = o0 * a + pp * bflo(vv); o1 = o1 * a + pp * bfhi(vv);
        m = mn;
    }
    if (has_sink) {
        const float mn = fmaxf(m, sink);
        const float a = __expf(m - mn);
        lsum = lsum * a + __expf(sink - mn); o0 *= a; o1 *= a;
    }
    const float inv = 1.f / lsum;
    *(unsigned*)(o + 2 * lane) = pk2(o0 * inv, o1 * inv);
}

__device__ __forceinline__ void ph_mixers_naive(const Params& p, int l, unsigned char* lds) {
    const int tid = threadIdx.x, lane = tid & 63, wave = tid >> 6;
    const int gw = blockIdx.x * NWAVES + wave, NGW = gridDim.x * NWAVES;
    const bf16_t* P = (const bf16_t*)(p.ws + WS_P);
    bf16_t* Y = (bf16_t*)(p.ws + WS_Y);
    const bool last = (l == DEPTH - 1);
    const int T_LA = NLAT * 6, T_LB = NLAT * 6, T_CA = last ? 0 : NCT * 6, T_CB = last ? 0 : NCT * 6;
    const int ntask = T_LA + T_LB + T_CA + T_CB;
    for (int tk = gw; tk < ntask; tk += NGW) {
        int r = tk;
        if (r < T_LA + T_LB) {
            const bool isB = r >= T_LA; if (isB) r -= T_LA;
            const int b = r / (6 * SEQ), h = (r / SEQ) % 6, t = r % SEQ, kv = h / 3;
            const size_t row = (size_t)b * SEQ + t, crow0 = (size_t)NLAT + (size_t)b * NCTX, lrow0 = (size_t)b * SEQ;
            const int cq = isB ? C_QB : C_QA, ck = isB ? C_KB : C_KA, cvv = isB ? C_VB : C_VA;
            int j0 = 0, j1 = SEQ;
            if (isB) { j0 = t - 128 < 0 ? 0 : t - 128; j1 = t + 129 > SEQ ? SEQ : t + 129; }
            attn_row_naive(P + row * INW + cq + h * 128, P + crow0 * INW + ck + kv * 128, P + crow0 * INW + cvv + kv * 128,
                           P + lrow0 * INW + ck + kv * 128, P + lrow0 * INW + cvv + kv * 128, j0, j1, isB, isB ? p.sink_b[l * 6 + h] : 0.f,
                           Y + row * DM + (isB ? 768 : 0) + h * 128, lane);
        } else {
            r -= T_LA + T_LB;
            const bool isB = r >= T_CA; if (isB) r -= T_CA;
            const int b = r / (6 * NCTX), h = (r / NCTX) % 6, t = r % NCTX, kv = h / 3;
            const size_t crow0 = (size_t)NLAT + (size_t)b * NCTX, row = crow0 + t;
            const int cq = isB ? C_QB : C_QA, ck = isB ? C_KB : C_KA, cvv = isB ? C_VB : C_VA;
            attn_row_naive(P + row * INW + cq + h * 128, P + crow0 * INW + ck + kv * 128, P + crow0 * INW + cvv + kv * 128,
                           P, P, 0, 0, isB, isB ? p.sink_b[l * 6 + h] : 0.f, Y + row * DM + (isB ? 768 : 0) + h * 128, lane);
        }
    }
    __syncthreads();
    float* Wl = (float*)lds;
    float* Vl = Wl + 128 * 128;
    const int nchunk = last ? NLAT / 128 : MTOT / 128;
    for (int u = blockIdx.x; u < nchunk * 4; u += gridDim.x) {
        const int ch = u >> 2, g = u & 3; const size_t row0 = (size_t)ch * 128;
        __syncthreads();
        for (int i = tid; i < 128 * 128; i += NTHREADS) {
            Wl[i] = p.ws_c[((size_t)l * 4 + g) * 16384 + i];
            const int q = i >> 7, c = i & 127;
            Vl[i] = bf2f(P[(row0 + q) * INW + C_VC + g * 128 + c]);
        }
        __syncthreads();
        const int c = tid & 127, pg = tid >> 7;
        for (int pp = pg * 32; pp < pg * 32 + 32; ++pp) {
            float s = 0.f;
#pragma unroll 8
            for (int q = 0; q < 128; ++q) s += Wl[pp * 128 + q] * Vl[q * 128 + c];
            s += p.bs_c[((size_t)l * 4 + g) * 128 + pp];
            const float uu = bf2f(P[(row0 + pp) * INW + C_UC + g * 128 + c]);
            Y[(row0 + pp) * DM + 1536 + g * 128 + c] = (bf16_t)f2bf(uu * s);
        }
    }
}


namespace att {
constexpr float SCALE = 0.088388347648318440f;
constexpr float THR = 8.f;
constexpr int D = 128, NW = 8, QBLK = 32, KVBLK = 64;
#ifndef ATT_SDEPTH
#define ATT_SDEPTH 1
#endif
constexpr int SDEPTH = ATT_SDEPTH;
constexpr int LDQ = INW, LDK = INW, LDO = DM;
constexpr size_t SHM_V = KVBLK * D * 2, SHM_K = KVBLK * D * 2, SHM_ATTN = 2 * SHM_V + 2 * SHM_K + NW * 64 * 4;
using bf16x8 = __attribute__((ext_vector_type(8))) short;
using s16x4  = __attribute__((ext_vector_type(4))) short;
using f32x16 = __attribute__((ext_vector_type(16))) float;
using f32x8  = __attribute__((ext_vector_type(8))) float;

#define KSWZ(row, colB) ((row) * 256 + ((colB) ^ (((row) & 7) << 4)))
#define SBAR() __builtin_amdgcn_sched_barrier(0)
__device__ __forceinline__ int crow(int r, int hi) { return (r & 3) + 8 * (r >> 2) + 4 * hi; }
__device__ __forceinline__ unsigned cvtpk(float lo, float hi) {
  unsigned r; asm volatile("v_cvt_pk_bf16_f32 %0, %1, %2" : "=v"(r) : "v"(lo), "v"(hi)); return r;
}

__device__ __forceinline__ void partialSM(f32x16& p0, f32x16& p1, float& m_reg, float& mn, float& alpha) {
  constexpr float C = SCALE * 1.4426950408889634f;
  float pmax = p0[0]; for (int r = 1; r < 16; ++r) pmax = fmaxf(pmax, p0[r]); for (int r = 0; r < 16; ++r) pmax = fmaxf(pmax, p1[r]);
  { auto rr = __builtin_amdgcn_permlane32_swap(__float_as_uint(pmax), __float_as_uint(pmax), false, false);
    pmax = fmaxf(__uint_as_float(rr[0]), __uint_as_float(rr[1])); }
  if (__builtin_expect(__all(pmax - m_reg <= THR / SCALE), 1)) { mn = m_reg; alpha = 1.f; }
  else { mn = fmaxf(m_reg, pmax); alpha = __builtin_amdgcn_exp2f((m_reg - mn) * C); m_reg = mn; }
  float mnC = -mn * C;
  for (int r = 0; r < 16; ++r) p0[r] = fmaf(p0[r], C, mnC); for (int r = 0; r < 16; ++r) p1[r] = fmaf(p1[r], C, mnC);
  for (int r = 0; r < 16; ++r) p0[r] = __builtin_amdgcn_exp2f(p0[r]);
}
__device__ __forceinline__ void finishSM(f32x16& p0, f32x16& p1, float alpha, float& l_reg, bf16x8& pa0, bf16x8& pa1, bf16x8& pa2, bf16x8& pa3) {
  for (int r = 0; r < 16; ++r) p1[r] = __builtin_amdgcn_exp2f(p1[r]);
  float ps = 0; for (int r = 0; r < 16; ++r) ps += p0[r]; for (int r = 0; r < 16; ++r) ps += p1[r];
  { auto rr = __builtin_amdgcn_permlane32_swap(__float_as_uint(ps), __float_as_uint(ps), false, false);
    ps = __uint_as_float(rr[0]) + __uint_as_float(rr[1]); }
  l_reg = l_reg * alpha + ps;
#define PK4(P, BASE, OUT) do { unsigned a0 = cvtpk(P[BASE + 0], P[BASE + 1]), a1 = cvtpk(P[BASE + 2], P[BASE + 3]);   \
    unsigned b0 = cvtpk(P[BASE + 4], P[BASE + 5]), b1 = cvtpk(P[BASE + 6], P[BASE + 7]);                              \
    auto r0 = __builtin_amdgcn_permlane32_swap(a0, b0, false, false); auto r1 = __builtin_amdgcn_permlane32_swap(a1, b1, false, false); \
    u32x4 w = {r0[0], r1[0], r0[1], r1[1]}; OUT = *reinterpret_cast<bf16x8*>(&w); } while (0)
  PK4(p0, 0, pa0); PK4(p0, 8, pa1); PK4(p1, 0, pa2); PK4(p1, 8, pa3);
#undef PK4
}
__device__ __forceinline__ void qkt(f32x16& p0, f32x16& p1, const bf16_t* Ks, const bf16x8* qr, int r32, int hi) {
  p0 = f32x16{}; p1 = f32x16{};
  for (int d0 = 0; d0 < 8; ++d0) { int cb = (d0 * 16 + hi * 8) * 2;
    bf16x8 b0 = *reinterpret_cast<const bf16x8*>((const char*)Ks + KSWZ(r32, cb));
    bf16x8 b1 = *reinterpret_cast<const bf16x8*>((const char*)Ks + KSWZ(32 + r32, cb));
    p0 = __builtin_amdgcn_mfma_f32_32x32x16_bf16(b0, qr[d0], p0, 0, 0, 0);
    p1 = __builtin_amdgcn_mfma_f32_32x32x16_bf16(b1, qr[d0], p1, 0, 0, 0); }
}
__device__ __forceinline__ int v_st(int k, int c) { const int kk = (k & ~0xC) | ((k & 4) << 1) | ((k & 8) >> 1); return ((kk >> 3) * 4 + (c >> 5)) * 512 + ((kk & 7) * 32 + (c & 31)) * 2; }
__device__ __forceinline__ int v_rd_base(int lane) { return ((lane & 3) << 3) | (((lane >> 2) & 3) << 6) | (((lane >> 4) & 1) << 5) | (((lane >> 5) & 1) << 8); }
constexpr int v_rd_off(int d0, int ks, int half) { return d0 * 512 + ks * 4096 + half * 2048; }
template <int OFF> __device__ __forceinline__ s16x4 tr_read(int vb) {
  s16x4 r; asm volatile("ds_read_b64_tr_b16 %0, %1 offset:%2" : "=&v"(r) : "v"(vb), "i"(OFF) : "memory"); return r;
}
template <int D0> __device__ __forceinline__ void pv_one(f32x16& od, int vb, bf16x8 pa0, bf16x8 pa1, bf16x8 pa2, bf16x8 pa3) {
  const s16x4 l0 = tr_read<v_rd_off(D0, 0, 0)>(vb), h0 = tr_read<v_rd_off(D0, 0, 1)>(vb), l1 = tr_read<v_rd_off(D0, 1, 0)>(vb), h1 = tr_read<v_rd_off(D0, 1, 1)>(vb);
  const s16x4 l2 = tr_read<v_rd_off(D0, 2, 0)>(vb), h2 = tr_read<v_rd_off(D0, 2, 1)>(vb), l3 = tr_read<v_rd_off(D0, 3, 0)>(vb), h3 = tr_read<v_rd_off(D0, 3, 1)>(vb);
  asm volatile("s_waitcnt lgkmcnt(0)" ::: "memory"); SBAR();
#define PK(L, H) (bf16x8){L[0], L[1], L[2], L[3], H[0], H[1], H[2], H[3]}
  od = __builtin_amdgcn_mfma_f32_32x32x16_bf16(pa0, PK(l0, h0), od, 0, 0, 0);
  od = __builtin_amdgcn_mfma_f32_32x32x16_bf16(pa1, PK(l1, h1), od, 0, 0, 0);
  od = __builtin_amdgcn_mfma_f32_32x32x16_bf16(pa2, PK(l2, h2), od, 0, 0, 0);
  od = __builtin_amdgcn_mfma_f32_32x32x16_bf16(pa3, PK(l3, h3), od, 0, 0, 0);
#undef PK
}
__device__ __forceinline__ void pv_d0(f32x16* o, int vb, bf16x8 pa0, bf16x8 pa1, bf16x8 pa2, bf16x8 pa3) {
  pv_one<0>(o[0], vb, pa0, pa1, pa2, pa3); pv_one<1>(o[1], vb, pa0, pa1, pa2, pa3); pv_one<2>(o[2], vb, pa0, pa1, pa2, pa3); pv_one<3>(o[3], vb, pa0, pa1, pa2, pa3);
}

__device__ __forceinline__ void attn_unit(const bool MASK, const bf16_t* __restrict__ Qb, const bf16_t* __restrict__ Kc, const bf16_t* __restrict__ Vc,
                                          const bf16_t* __restrict__ Kl, const bf16_t* __restrict__ Vl, int nlt, int qpos0, int kpos0,
                                          bool has_sink, float sink, bf16_t* __restrict__ Ob, const float* qgain, const float* qrope, char* lds) {
  int tid_ = threadIdx.x; asm volatile("" : "+v"(tid_));
  const int tid = tid_, wid = tid >> 6, lane = tid & 63, r32 = lane & 31, hi = lane >> 5;
  bf16_t* V_lds = (bf16_t*)lds; bf16_t* K_lds = (bf16_t*)(lds + 2 * SHM_V);
  float* ws = (float*)(lds + 2 * SHM_V + 2 * SHM_K) + wid * 64; float* li_l = ws; float* al_l = ws + 32;
  float m_reg = -1e30f, l_reg = 0; f32x16 o[4] = {}; bf16x8 qr[8];
  const bf16_t* Qw = Qb + (long)(wid * QBLK + r32) * LDQ + hi * 8;
#pragma unroll
  for (int d0 = 0; d0 < 8; ++d0) qr[d0] = *reinterpret_cast<const bf16x8*>(Qw + d0 * 16);
  if (qgain) {
    float ss = 0.f;
#pragma unroll
    for (int d0 = 0; d0 < 8; ++d0)
#pragma unroll
      for (int i = 0; i < 8; ++i) { const float f = __uint_as_float(((unsigned)(unsigned short)qr[d0][i]) << 16); ss += f * f; }
    ss += __shfl_xor(ss, 32);
    const float rstd = rsqrtf(ss * (1.f / 128.f) + 1e-6f);
#pragma unroll
    for (int pr = 0; pr < 4; ++pr) {
      const int da = (pr & 1) + 4 * (pr >> 1), db = da + 2;
      const f32x4 ga0 = *(const f32x4*)(qgain + da * 16 + hi * 8), ga1 = *(const f32x4*)(qgain + da * 16 + hi * 8 + 4);
      const f32x4 gb0 = *(const f32x4*)(qgain + db * 16 + hi * 8), gb1 = *(const f32x4*)(qgain + db * 16 + hi * 8 + 4);
      const float ga[8] = {ga0.x, ga0.y, ga0.z, ga0.w, ga1.x, ga1.y, ga1.z, ga1.w}, gb[8] = {gb0.x, gb0.y, gb0.z, gb0.w, gb1.x, gb1.y, gb1.z, gb1.w};
      float cs[8], sn[8];
      if (qrope) {
        const f32x4* rp = (const f32x4*)(qrope + ((pr >> 1) * 32 + (pr & 1) * 16 + hi * 8) * 2);
        const f32x4 c0 = rp[0], c1 = rp[1], c2 = rp[2], c3 = rp[3];
        cs[0] = c0.x; sn[0] = c0.y; cs[1] = c0.z; sn[1] = c0.w; cs[2] = c1.x; sn[2] = c1.y; cs[3] = c1.z; sn[3] = c1.w;
        cs[4] = c2.x; sn[4] = c2.y; cs[5] = c2.z; sn[5] = c2.w; cs[6] = c3.x; sn[6] = c3.y; cs[7] = c3.z; sn[7] = c3.w;
      } else {
#pragma unroll
        for (int i = 0; i < 8; ++i) { cs[i] = 1.f; sn[i] = 0.f; }
      }
      unsigned wa_[4], wb_[4];
#pragma unroll
      for (int i = 0; i < 8; i += 2) {
        float a0 = __uint_as_float(((unsigned)(unsigned short)qr[da][i]) << 16) * rstd * ga[i], a1 = __uint_as_float(((unsigned)(unsigned short)qr[da][i + 1]) << 16) * rstd * ga[i + 1];
        float b0 = __uint_as_float(((unsigned)(unsigned short)qr[db][i]) << 16) * rstd * gb[i], b1 = __uint_as_float(((unsigned)(unsigned short)qr[db][i + 1]) << 16) * rstd * gb[i + 1];
        const float na0 = a0 * cs[i] - b0 * sn[i], nb0 = b0 * cs[i] + a0 * sn[i], na1 = a1 * cs[i + 1] - b1 * sn[i + 1], nb1 = b1 * cs[i + 1] + a1 * sn[i + 1];
        wa_[i >> 1] = cvtpk(na0, na1); wb_[i >> 1] = cvtpk(nb0, nb1);
      }
      u32x4 va_ = {wa_[0], wa_[1], wa_[2], wa_[3]}, vb_ = {wb_[0], wb_[1], wb_[2], wb_[3]};
      qr[da] = *reinterpret_cast<bf16x8*>(&va_); qr[db] = *reinterpret_cast<bf16x8*>(&vb_);
    }
  }
  const int sr = tid >> 4, sc = (tid & 15) * 8, vst0 = v_st(sr, sc), vst1 = v_st(32 + sr, sc);
  const int vb0 = (int)(uintptr_t)V_lds + v_rd_base(lane);
  struct { bf16x8 vs0, vs1, ks0, ks1; } sr_[SDEPTH];
  const int qpos = qpos0 + wid * QBLK + r32;
#define KVP(t, KP, VP) const bf16_t* KP = ((t) < 4 ? Kc + (long)(t) * KVBLK * LDK : Kl + (long)((t) - 4) * KVBLK * LDK); const bf16_t* VP = ((t) < 4 ? Vc + (long)(t) * KVBLK * LDK : Vl + (long)((t) - 4) * KVBLK * LDK)
#define SLOAD(i, t) do { KVP(t, kp_, vp_); sr_[i].vs0 = *reinterpret_cast<const bf16x8*>(&vp_[(long)sr * LDK + sc]); sr_[i].vs1 = *reinterpret_cast<const bf16x8*>(&vp_[(long)(32 + sr) * LDK + sc]); \
    sr_[i].ks0 = *reinterpret_cast<const bf16x8*>(&kp_[(long)sr * LDK + sc]); sr_[i].ks1 = *reinterpret_cast<const bf16x8*>(&kp_[(long)(32 + sr) * LDK + sc]); } while (0)
#define SWRITE(b, i) do { *(bf16x8*)((char*)V_lds + (b) * SHM_V + vst0) = sr_[i].vs0;          \
    *(bf16x8*)((char*)V_lds + (b) * SHM_V + vst1) = sr_[i].vs1; int kc = sc * 2;               \
    *(bf16x8*)((char*)K_lds + (b) * SHM_K + KSWZ(sr, kc)) = sr_[i].ks0;                       \
    *(bf16x8*)((char*)K_lds + (b) * SHM_K + KSWZ(32 + sr, kc)) = sr_[i].ks1; } while (0)
#define SWAIT() do { if constexpr (SDEPTH == 2) asm volatile("s_waitcnt vmcnt(4)" ::: "memory"); else asm volatile("s_waitcnt vmcnt(0)" ::: "memory"); } while (0)
#define RESC(a) do { if (__any((a) < 1.f)) { if (hi == 0) al_l[r32] = (a); asm volatile("s_waitcnt lgkmcnt(0)" ::: "memory"); \
    for (int d = 0; d < 4; ++d) for (int r = 0; r < 16; ++r) o[d][r] *= al_l[crow(r, hi)]; } } while (0)
#define WMASK(P0, P1, t) do { if (MASK && (t) >= 4) { const int kb_ = kpos0 + ((t) - 4) * KVBLK + 4 * hi - qpos; \
    _Pragma("unroll") for (int r = 0; r < 16; ++r) { const int dk = kb_ + (r & 3) + 8 * (r >> 2); \
      if (dk > 128 || dk < -128) P0[r] = -1e30f; if (dk + 32 > 128 || dk + 32 < -128) P1[r] = -1e30f; } } } while (0)
  f32x16 pA0, pA1, pB0, pB1; float mnA, mnB, alA, alB; bf16x8 pa0, pa1, pa2, pa3; const int NT = 4 + nlt;
  constexpr int SE = 0, SO = SDEPTH - 1;
  SLOAD(SE, 0); asm volatile("s_waitcnt vmcnt(0)" ::: "memory"); SWRITE(0, SE); __syncthreads();
  qkt(pA0, pA1, K_lds, qr, r32, hi); partialSM(pA0, pA1, m_reg, mnA, alA);
  SLOAD(SO, 1); if constexpr (SDEPTH == 2) { if (2 < NT) SLOAD(SE, 2); }
  SWAIT(); SWRITE(1, SO); __syncthreads();
  for (int j = 1; j + 1 < NT; j += 2) {
    SBAR(); qkt(pB0, pB1, (bf16_t*)((char*)K_lds + SHM_K), qr, r32, hi); WMASK(pB0, pB1, j);
    finishSM(pA0, pA1, alA, l_reg, pa0, pa1, pa2, pa3); SBAR();
    SLOAD(SO, j + SDEPTH); SBAR();
    pv_d0(o, vb0, pa0, pa1, pa2, pa3); partialSM(pB0, pB1, m_reg, mnB, alB);
    __syncthreads(); SWAIT(); SWRITE(0, SE);
    RESC(alB); __syncthreads();
    SBAR(); qkt(pA0, pA1, K_lds, qr, r32, hi); WMASK(pA0, pA1, j + 1);
    finishSM(pB0, pB1, alB, l_reg, pa0, pa1, pa2, pa3); SBAR();
    if (SDEPTH == 1 || j + 3 < NT) SLOAD(SE, j + 1 + SDEPTH); SBAR();
    pv_d0(o, vb0 + (int)SHM_V, pa0, pa1, pa2, pa3); partialSM(pA0, pA1, m_reg, mnA, alA);
    __syncthreads(); SWAIT(); SWRITE(1, SO);
    RESC(alA); __syncthreads();
  }
  SBAR(); qkt(pB0, pB1, (bf16_t*)((char*)K_lds + SHM_K), qr, r32, hi); WMASK(pB0, pB1, NT - 1);
  finishSM(pA0, pA1, alA, l_reg, pa0, pa1, pa2, pa3); SBAR();
  pv_d0(o, vb0, pa0, pa1, pa2, pa3); partialSM(pB0, pB1, m_reg, mnB, alB);
  __syncthreads(); RESC(alB);
  finishSM(pB0, pB1, alB, l_reg, pa0, pa1, pa2, pa3); SBAR();
  pv_d0(o, vb0 + (int)SHM_V, pa0, pa1, pa2, pa3);
  if (has_sink) l_reg += __builtin_amdgcn_exp2f(sink * 1.4426950408889634f - m_reg * (SCALE * 1.4426950408889634f));
  if (hi == 0) li_l[r32] = l_reg; asm volatile("s_waitcnt lgkmcnt(0)" ::: "memory");
  float rli[16];
#pragma unroll
  for (int r = 0; r < 16; ++r) rli[r] = __builtin_amdgcn_rcpf(li_l[crow(r, hi)]);
  bf16_t* Ow = Ob + (long)(wid * QBLK) * LDO;
#pragma unroll
  for (int r = 0; r < 16; ++r) { int orow = crow(r, hi);
#pragma unroll
    for (int d0 = 0; d0 < 4; ++d0) Ow[(long)orow * LDO + d0 * 32 + r32] = (bf16_t)f2bf(o[d0][r] * rli[r]); }
  __syncthreads();
#undef KVP
#undef SLOAD
#undef SWRITE
#undef SWAIT
#undef RESC
#undef WMASK
}
#undef KSWZ
#undef SBAR
}


__device__ __forceinline__ void cmlp_unit_naive(const Params& p, int l, int ch, int g, unsigned char* lds) {
    int tid_ = threadIdx.x; asm volatile("" : "+v"(tid_));
    const int tid = tid_;
    const bf16_t* P = (const bf16_t*)(p.ws + WS_P);
    bf16_t* Y = (bf16_t*)(p.ws + WS_Y);
    float* Wl = (float*)lds;
    float* Vl = Wl + 128 * 128;
    const size_t row0 = (size_t)ch * 128;
    __syncthreads();
    for (int i = tid; i < 128 * 128; i += NTHREADS) {
        Wl[i] = p.ws_c[((size_t)l * 4 + g) * 16384 + i];
        const int q = i >> 7, c = i & 127;
        Vl[i] = bf2f(P[(row0 + q) * INW + C_VC + g * 128 + c]);
    }
    __syncthreads();
    const int c = tid & 127, pg = tid >> 7;
    for (int pp = pg * 32; pp < pg * 32 + 32; ++pp) {
        float s = 0.f;
#pragma unroll 8
        for (int q = 0; q < 128; ++q) s += Wl[pp * 128 + q] * Vl[q * 128 + c];
        s += p.bs_c[((size_t)l * 4 + g) * 128 + pp];
        const float uu = bf2f(P[(row0 + pp) * INW + C_UC + g * 128 + c]);
        Y[(row0 + pp) * DM + 1536 + g * 128 + c] = (bf16_t)f2bf(uu * s);
    }
    __syncthreads();
}


__device__ __forceinline__ void cmlp_unit_fast(const Params& p, int l, int ch, int g, unsigned char* lds) {
    typedef short bf16x8 __attribute__((ext_vector_type(8)));
    typedef float f32x16 __attribute__((ext_vector_type(16)));
    int tid_ = threadIdx.x; asm volatile("" : "+v"(tid_));
    const int tid = tid_, lane = tid & 63, wave = tid >> 6, r32 = lane & 31, hh = lane >> 5;
    const bf16_t* P = (const bf16_t*)(p.ws + WS_P);
    bf16_t* Y = (bf16_t*)(p.ws + WS_Y);
    const bf16_t* W = (const bf16_t*)(p.ws + WS_WSC) + ((size_t)l * 4 + g) * 16384;
    bf16_t* VT = (bf16_t*)lds;
    const size_t row0 = (size_t)ch * 128;
    __syncthreads();
#pragma unroll
    for (int it = 0; it < 4; ++it) {
        const int q = it * 32 + (tid >> 4), c0 = (tid & 15) * 8;
        const u32x4 v = *(const u32x4*)(P + (row0 + q) * INW + C_VC + g * 128 + c0);
        unsigned w[4] = {v.x, v.y, v.z, v.w};
#if CPREP_IN_UNIT
        {
            float x[8]; float ss = 0.f;
#pragma unroll
            for (int i = 0; i < 4; ++i) { x[2 * i] = gelu_tanh(bflo(w[i])); x[2 * i + 1] = gelu_tanh(bfhi(w[i])); }
#pragma unroll
            for (int i = 0; i < 8; ++i) ss += x[i] * x[i];
            ss += __shfl_xor(ss, 1); ss += __shfl_xor(ss, 2); ss += __shfl_xor(ss, 4); ss += __shfl_xor(ss, 8);
            const float rstd = rsqrtf(ss * (1.f / 128.f) + EPS);
            const float* gn = p.vn_c + l * 512 + g * 128 + c0;
#pragma unroll
            for (int i = 0; i < 4; ++i) w[i] = pk2(x[2 * i] * rstd * gn[2 * i], x[2 * i + 1] * rstd * gn[2 * i + 1]);
        }
#endif
#pragma unroll
        for (int i = 0; i < 4; ++i) { VT[(c0 + 2 * i) * 136 + q] = (bf16_t)(w[i] & 0xffffu); VT[(c0 + 2 * i + 1) * 136 + q] = (bf16_t)(w[i] >> 16); }
    }
    __syncthreads();
    const int cb = wave & 3, pb0 = (wave >> 2) * 2;
    f32x16 acc0 = {}, acc1 = {};
#pragma unroll
    for (int s = 0; s < 8; ++s) {
        const bf16x8 b = *(const bf16x8*)(VT + (cb * 32 + r32) * 136 + 16 * s + 8 * hh);
        const bf16x8 a0 = *(const bf16x8*)(W + (size_t)(pb0 * 32 + r32) * 128 + 16 * s + 8 * hh);
        const bf16x8 a1 = *(const bf16x8*)(W + (size_t)(pb0 * 32 + 32 + r32) * 128 + 16 * s + 8 * hh);
        acc0 = __builtin_amdgcn_mfma_f32_32x32x16_bf16(a0, b, acc0, 0, 0, 0);
        acc1 = __builtin_amdgcn_mfma_f32_32x32x16_bf16(a1, b, acc1, 0, 0, 0);
    }
    const int c = cb * 32 + r32;
    const float* bs = p.bs_c + ((size_t)l * 4 + g) * 128;
#pragma unroll
    for (int r = 0; r < 16; ++r) {
        const int pr = (r & 3) + 8 * (r >> 2) + 4 * hh;
        const int p0 = pb0 * 32 + pr, p1 = p0 + 32;
        float u0 = bf2f(P[(row0 + p0) * INW + C_UC + g * 128 + c]), u1 = bf2f(P[(row0 + p1) * INW + C_UC + g * 128 + c]);
        if (CPREP_IN_UNIT) { u0 = gelu_tanh(u0); u1 = gelu_tanh(u1); }
        Y[(row0 + p0) * DM + 1536 + g * 128 + c] = (bf16_t)f2bf(u0 * (acc0[r] + bs[p0]));
        Y[(row0 + p1) * DM + 1536 + g * 128 + c] = (bf16_t)f2bf(u1 * (acc1[r] + bs[p1]));
    }
}
#ifndef USE_FAST_CMLP
#define USE_FAST_CMLP 1
#endif

__device__ __forceinline__ void ph_mixers_fast(const Params& p, int l, unsigned char* lds, const bool dry) {
    const int tid = threadIdx.x;
    const bf16_t* P = (const bf16_t*)(p.ws + WS_P);
    bf16_t* Y = (bf16_t*)(p.ws + WS_Y);
    const bool last = (l == DEPTH - 1);
    const int b = blockIdx.x & 7;
    unsigned* ctr = (unsigned*)(p.ws + WS_CTL) + (dry ? 2048 : 0) + (l * 8 + b) * 64;
    volatile unsigned* shw = (volatile unsigned*)(lds + LDS_BYTES - 64);
    const int nAttn = last ? 96 : 108, nC = last ? 64 : 72, total = nAttn + nC;
    const size_t lrow0 = (size_t)b * SEQ, crow0 = (size_t)NLAT + (size_t)b * NCTX;
    for (;;) {
        __syncthreads();
        if (tid == 0) *shw = atomicAdd(ctr, 1u);
        __syncthreads();
        const int u = (int)*shw;
        if (u >= total) break;
        if (u < nAttn) {
            const bf16_t *Qb, *Kc, *Vc, *Kl, *Vl; bf16_t* Ob; int nlt = 0, qpos0 = 0, kpos0 = 0, qabs = 0; bool mask = false, has_sink = false, isBunit = false; int hsink = 0;
            if (u < 48) {
                const int h = u >> 3, qb = u & 7, kv = h / 3;
                Qb = P + (lrow0 + qb * 256) * INW + C_QA + h * 128; Kc = P + crow0 * INW + C_KA + kv * 128; Vc = P + crow0 * INW + C_VA + kv * 128;
                Kl = P + lrow0 * INW + C_KA + kv * 128; Vl = P + lrow0 * INW + C_VA + kv * 128; nlt = 32;
                Ob = Y + (lrow0 + qb * 256) * DM + h * 128; qabs = qb * 256;
            } else if (u < 96) {
                const int v = u - 48, h = v >> 3, qb = v & 7, kv = h / 3;
                const int kstart = qb == 0 ? 0 : qb * 256 - 128; nlt = (qb == 0 || qb == 7) ? 6 : 8;
                Qb = P + (lrow0 + qb * 256) * INW + C_QB + h * 128; Kc = P + crow0 * INW + C_KB + kv * 128; Vc = P + crow0 * INW + C_VB + kv * 128;
                Kl = P + (lrow0 + kstart) * INW + C_KB + kv * 128; Vl = P + (lrow0 + kstart) * INW + C_VB + kv * 128;
                qpos0 = qb * 256; kpos0 = kstart; mask = true; has_sink = true; hsink = h; isBunit = true; qabs = qb * 256;
                Ob = Y + (lrow0 + qb * 256) * DM + 768 + h * 128;
            } else {
                const int v = u - 96; const bool isB = v >= 6; const int h = isB ? v - 6 : v, kv = h / 3;
                const int cq = isB ? C_QB : C_QA, ck = isB ? C_KB : C_KA, cv = isB ? C_VB : C_VA;
                Qb = P + crow0 * INW + cq + h * 128; Kc = P + crow0 * INW + ck + kv * 128; Vc = P + crow0 * INW + cv + kv * 128; Kl = Kc; Vl = Vc;
                has_sink = isB; hsink = h; Ob = Y + crow0 * DM + (isB ? 768 : 0) + h * 128; isBunit = isB;
            }
            const float* qgain = nullptr; const float* qrope = nullptr;
            if (QPREP_IN_UNIT) {
                qgain = (isBunit ? p.qn_b : p.qn_a) + l * 128;
                if (u < 96) qrope = (const float*)(p.ws + WS_ROPE) + (size_t)(qabs + (tid >> 6) * 32 + (tid & 31)) * 128;
            }
            att::attn_unit(mask, Qb, Kc, Vc, Kl, Vl, nlt, qpos0, kpos0, has_sink, has_sink ? p.sink_b[l * 6 + hsink] : 0.f, Ob, qgain, qrope, (char*)lds);
        } else {
            const int v = u - nAttn;
            const int ch = v < 64 ? b * 16 + (v >> 2) : 128 + b * 2 + ((v - 64) >> 2);
#if USE_FAST_CMLP
            cmlp_unit_fast(p, l, ch, v & 3, lds);
#else
            cmlp_unit_naive(p, l, ch, v & 3, lds);
#endif
        }
    }
}
#ifndef USE_FAST_ATT
#define USE_FAST_ATT 1
#endif

__device__ __forceinline__ void ynorm_row(bf16_t* yrow, const u32x4 (&v)[4], int lane) {
    float sq[4];
#pragma unroll
    for (int j = 0; j < 4; ++j) {
        const float a0 = bflo(v[j].x), a1 = bfhi(v[j].x), a2 = bflo(v[j].y), a3 = bfhi(v[j].y), a4 = bflo(v[j].z), a5 = bfhi(v[j].z), a6 = bflo(v[j].w), a7 = bfhi(v[j].w);
        sq[j] = a0 * a0 + a1 * a1 + a2 * a2 + a3 * a3 + a4 * a4 + a5 * a5 + a6 * a6 + a7 * a7;
    }
    const float sA = wave_sum(sq[0] + (lane < 32 ? sq[1] : 0.f));
    const float sB = wave_sum((lane >= 32 ? sq[1] : 0.f) + sq[2]);
    const float sC = wave_sum(sq[3]);
    const float rA = rsqrtf(sA * (1.f / 768.f) + EPS), rB = rsqrtf(sB * (1.f / 768.f) + EPS), rC = rsqrtf(sC * (1.f / 512.f) + EPS);
#pragma unroll
    for (int j = 0; j < 4; ++j) {
        const float sc = (j == 0) ? rA : (j == 1) ? (lane < 32 ? rA : rB) : (j == 2) ? rB : rC;
        u32x4 o;
        o.x = pk2(bflo(v[j].x) * sc, bfhi(v[j].x) * sc); o.y = pk2(bflo(v[j].y) * sc, bfhi(v[j].y) * sc);
        o.z = pk2(bflo(v[j].z) * sc, bfhi(v[j].z) * sc); o.w = pk2(bflo(v[j].w) * sc, bfhi(v[j].w) * sc);
        *(u32x4*)(yrow + j * 512 + lane * 8) = o;
    }
}
__device__ __forceinline__ void ph_ynorm(const Params& p, int l) {
    const int tid = threadIdx.x, lane = tid & 63, wave = tid >> 6;
    const int gw = blockIdx.x * NWAVES + wave, NGW = gridDim.x * NWAVES;
    bf16_t* Y = (bf16_t*)(p.ws + WS_Y);
    const int nrows = (l == DEPTH - 1) ? NLAT : MTOT;
#pragma unroll 1
    for (int r = gw; r < nrows; r += 2 * NGW) {
        const int r2 = r + NGW; const bool has2 = r2 < nrows; const int rb = has2 ? r2 : r;
        u32x4 va[4], vb[4];
#pragma unroll
        for (int j = 0; j < 4; ++j) { va[j] = *(const u32x4*)(Y + (size_t)r * DM + j * 512 + lane * 8); vb[j] = *(const u32x4*)(Y + (size_t)rb * DM + j * 512 + lane * 8); }
        ynorm_row(Y + (size_t)r * DM, va, lane);
        if (has2) ynorm_row(Y + (size_t)r2 * DM, vb, lane);
    }
}

__device__ __forceinline__ void wave_argmax(float& bv, int& bi) {
#pragma unroll
    for (int o = 32; o >= 1; o >>= 1) {
        const float ov = __shfl_xor(bv, o); const int oi = __shfl_xor(bi, o);
        if (ov > bv || (ov == bv && oi < bi)) { bv = ov; bi = oi; }
    }
}
__device__ __forceinline__ void route_half(const bf16_t* qh, const bf16_t* kh, int lane, float& tv, int& ti) {
    const unsigned qq = *(const unsigned*)(qh + 2 * lane);
    const float qa = bflo(qq), qb = bfhi(qq);
    const bf16_t* k0 = kh + (size_t)lane * 128;
    const bf16_t* k1 = k0 + 64 * 128;
    float d0 = 0.f, d1 = 0.f;
#pragma unroll 2
    for (int cb = 0; cb < 16; ++cb) {
        const u32x4 a = *(const u32x4*)(k0 + cb * 8), b = *(const u32x4*)(k1 + cb * 8);
        const unsigned aw[4] = {a.x, a.y, a.z, a.w}, bw[4] = {b.x, b.y, b.z, b.w};
#pragma unroll
        for (int i = 0; i < 4; ++i) {
            const int src = cb * 4 + i;
            const float x0 = __shfl(qa, src), x1 = __shfl(qb, src);
            d0 += x0 * bflo(aw[i]) + x1 * bfhi(aw[i]);
            d1 += x0 * bflo(bw[i]) + x1 * bfhi(bw[i]);
        }
    }
    float va = d0, vb = d1; tv = 0.f; ti = 0;
#pragma unroll 1
    for (int r = 0; r < 16; ++r) {
        float bv; int bi;
        if (va >= vb) { bv = va; bi = lane; } else { bv = vb; bi = lane + 64; }
        wave_argmax(bv, bi);
        if (lane == r) { tv = bv; ti = bi; }
        if (bi == lane) va = -INFINITY; else if (bi == lane + 64) vb = -INFINITY;
    }
}
__device__ __forceinline__ void ph_route_naive(const Params& p, int l) {
    const int tid = threadIdx.x, lane = tid & 63, wave = tid >> 6;
    const int gw = blockIdx.x * NWAVES + wave, NGW = gridDim.x * NWAVES;
    const bf16_t* QP = (const bf16_t*)(p.ws + WS_P);
    const bf16_t* KEYS = (const bf16_t*)(p.ws + WS_KEYS) + (size_t)l * 8 * 2 * 128 * 128;
    int* EID = (int*)(p.ws + WS_EID); float* GATE = (float*)(p.ws + WS_GATE);
    const int nrows = (l == DEPTH - 1) ? NLAT : MTOT;
#pragma unroll 1
    for (int tk = gw; tk < nrows * 8; tk += NGW) {
        const int t = tk >> 3, h = tk & 7;
        const bf16_t* qrow = QP + (size_t)t * DM + h * 256;
        float tv0, tv1; int ti0, ti1;
        route_half(qrow, KEYS + (size_t)(h * 2 + 0) * 128 * 128, lane, tv0, ti0);
        route_half(qrow + 128, KEYS + (size_t)(h * 2 + 1) * 128 * 128, lane, tv1, ti1);
        const float v1 = __shfl(tv0, lane >> 2);
        float c0 = v1 + __shfl(tv1, (lane & 3) * 4 + 0), c1 = v1 + __shfl(tv1, (lane & 3) * 4 + 1);
        float c2 = v1 + __shfl(tv1, (lane & 3) * 4 + 2), c3 = v1 + __shfl(tv1, (lane & 3) * 4 + 3);
        float myv = 0.f; int myc = 0;
#pragma unroll 1
        for (int r = 0; r < 16; ++r) {
            float bv = c0; int bi = lane * 4;
            if (c1 > bv) { bv = c1; bi = lane * 4 + 1; }
            if (c2 > bv) { bv = c2; bi = lane * 4 + 2; }
            if (c3 > bv) { bv = c3; bi = lane * 4 + 3; }
            wave_argmax(bv, bi);
            if (lane == r) { myv = bv; myc = bi; }
            if ((bi >> 2) == lane) {
                const int u = bi & 3;
                if (u == 0) c0 = -INFINITY; else if (u == 1) c1 = -INFINITY; else if (u == 2) c2 = -INFINITY; else c3 = -INFINITY;
            }
        }
        float mx = lane < 16 ? myv : -INFINITY;
        mx = fmaxf(mx, __shfl_xor(mx, 8)); mx = fmaxf(mx, __shfl_xor(mx, 4)); mx = fmaxf(mx, __shfl_xor(mx, 2)); mx = fmaxf(mx, __shfl_xor(mx, 1));
        const float e = lane < 16 ? __expf(myv - mx) : 0.f;
        float sm = e; sm += __shfl_xor(sm, 8); sm += __shfl_xor(sm, 4); sm += __shfl_xor(sm, 2); sm += __shfl_xor(sm, 1);
        const int i1 = __shfl(ti0, myc >> 4), i2 = __shfl(ti1, myc & 15);
        if (lane < 16) { EID[(size_t)t * 128 + h * 16 + lane] = i1 * 128 + i2; GATE[(size_t)t * 128 + h * 16 + lane] = e / sm; }
    }
}


namespace rt {
typedef short bf16x8 __attribute__((ext_vector_type(8)));
typedef float f32x16 __attribute__((ext_vector_type(16)));
__device__ __forceinline__ void insert16(float (&t)[16], float x) {
#pragma unroll
    for (int j = 15; j >= 1; --j) t[j] = __builtin_amdgcn_fmed3f(t[j - 1], t[j], x);
    t[0] = fmaxf(t[0], x);
}
__device__ __forceinline__ void half_top16(const unsigned char* klds, const bf16_t* qrow, int r32, int hh, float (&t)[16]) {
    bf16x8 qf[8];
#pragma unroll
    for (int s = 0; s < 8; ++s) qf[s] = *(const bf16x8*)(qrow + 16 * s);
#pragma unroll
    for (int k = 0; k < 16; ++k) t[k] = -3.0e38f;
    const unsigned hh4 = (unsigned)hh << 2;
#pragma unroll
    for (int kb = 0; kb < 4; ++kb) {
        f32x16 acc = {};
        const int row = kb * 32 + r32;
#pragma unroll
        for (int s = 0; s < 8; ++s) {
            const bf16x8 a = *(const bf16x8*)(klds + row * 256 + ((32 * s + 16 * hh) ^ ((row & 7) << 4)));
            acc = __builtin_amdgcn_mfma_f32_32x32x16_bf16(a, qf[s], acc, 0, 0, 0);
        }
#pragma unroll
        for (int r = 0; r < 16; ++r) {
            const unsigned key = (unsigned)(kb * 32 + (r & 3) + 8 * (r >> 2)) | hh4;
            insert16(t, __uint_as_float((__float_as_uint(acc[r]) & ~127u) | key));
        }
    }
    float o[16];
#pragma unroll
    for (int k = 0; k < 16; ++k) o[k] = __shfl_xor(t[k], 32);
#pragma unroll
    for (int k = 0; k < 16; ++k) insert16(t, o[k]);
}
}
template <bool OWN_UNITS>
__device__ __forceinline__ void ph_route_fast(const Params& p, int l, unsigned char* lds) {
    int tid_ = threadIdx.x; asm volatile("" : "+v"(tid_));
    const int tid = tid_, lane = tid & 63, wave = tid >> 6, r32 = lane & 31, hh = lane >> 5;
    const bf16_t* QP = (const bf16_t*)(p.ws + WS_P);
    const bf16_t* KEYS = (const bf16_t*)(p.ws + WS_KEYS) + (size_t)l * 8 * 2 * 128 * 128;
    int* EID = (int*)(p.ws + WS_EID); float* GATE = (float*)(p.ws + WS_GATE);
    const int ntile = ((l == DEPTH - 1) ? NLAT : MTOT) / 256;
    unsigned* tab = (unsigned*)(lds + 65536) + wave * 2048;
    pg8::StaticOrder So; So.init(ntile * 256, DM, (int)gridDim.x, (int)blockIdx.x);
#pragma unroll 1
    for (int ui = 0;; ++ui) {
        int tile, h;
        if (OWN_UNITS) { pg8::Unit uu; if (!So.next(ui, uu)) break; tile = uu.pm; h = uu.pn; }
        else { const int u = blockIdx.x + ui * (int)gridDim.x; if (u >= ntile * 8) break; tile = u >> 3; h = u & 7; }
        __syncthreads();
        const u32x4* ksrc = (const u32x4*)(KEYS + (size_t)h * 2 * 128 * 128);
#pragma unroll
        for (int i = 0; i < 8; ++i) { const int c = tid + i * 512, row = c >> 4, cc = c & 15; *(u32x4*)(lds + row * 256 + ((cc * 16) ^ ((row & 7) << 4))) = ksrc[c]; }
        __syncthreads();
        const int tok = tile * 256 + wave * 32 + r32;
        const bf16_t* qrow = QP + (size_t)tok * DM + h * 256 + hh * 8;
        float v1[16], v2[16];
        rt::half_top16(lds, qrow, r32, hh, v1);
        rt::half_top16(lds + 32768, qrow + 128, r32, hh, v2);
        float c[16];
#pragma unroll
        for (int k = 0; k < 16; ++k) c[k] = -3.0e38f;
#pragma unroll
        for (int i = 0; i < 16; ++i)
#pragma unroll
            for (int j = 0; j < 16; ++j)
                if ((i + 1) * (j + 1) <= 16) rt::insert16(c, __uint_as_float((__float_as_uint(v1[i] + v2[j]) & ~255u) | (unsigned)(i * 16 + j)));
#pragma unroll
        for (int k = 0; k < 16; ++k) { tab[k * 64 + lane] = __float_as_uint(v1[k]); tab[(16 + k) * 64 + lane] = __float_as_uint(v2[k]); }
        LDS_WAIT();
        float e[16], sum = 0.f;
#pragma unroll
        for (int k = 0; k < 16; ++k) { e[k] = __expf(c[k] - c[0]); sum += e[k]; }
        const float inv = 1.f / sum;
        unsigned out[16];
#pragma unroll
        for (int k = 0; k < 16; ++k) {
            const unsigned code = __float_as_uint(c[k]) & 255u;
            const unsigned i1 = tab[(code >> 4) * 64 + lane] & 127u, i2 = tab[(16 + (code & 15u)) * 64 + lane] & 127u;
            out[k] = hh == 0 ? (i1 * 128u + i2) : __float_as_uint(e[k] * inv);
        }
        unsigned* dst = (hh == 0 ? (unsigned*)EID : (unsigned*)GATE) + (size_t)tok * 128 + h * 16;
#pragma unroll
        for (int k = 0; k < 4; ++k) { u32x4 w; w.x = out[4 * k]; w.y = out[4 * k + 1]; w.z = out[4 * k + 2]; w.w = out[4 * k + 3]; *(u32x4*)(dst + 4 * k) = w; }
        LDS_WAIT();
    }
}
#ifndef USE_FAST_ROUTE
#define USE_FAST_ROUTE 1
#endif


#if GATHER_I8
__device__ __forceinline__ float dpp_shr(float v, int n) {
    const int iv = __builtin_bit_cast(int, v); int r;
    switch (n) { case 1: r = __builtin_amdgcn_update_dpp(0, iv, 0x111, 0xf, 0xf, true); break; case 2: r = __builtin_amdgcn_update_dpp(0, iv, 0x112, 0xf, 0xf, true); break;
                 case 4: r = __builtin_amdgcn_update_dpp(0, iv, 0x114, 0xf, 0xf, true); break; default: r = __builtin_amdgcn_update_dpp(0, iv, 0x118, 0xf, 0xf, true); break; }
    return __builtin_bit_cast(float, r);
}
__device__ __forceinline__ float wave_total(float v) {
    v += dpp_shr(v, 1); v += dpp_shr(v, 2); v += dpp_shr(v, 4); v += dpp_shr(v, 8);
    v += __builtin_bit_cast(float, __builtin_amdgcn_update_dpp(0, __builtin_bit_cast(int, v), 0x142, 0xa, 0xf, false));
    v += __builtin_bit_cast(float, __builtin_amdgcn_update_dpp(0, __builtin_bit_cast(int, v), 0x143, 0xc, 0xf, false));
    return __uint_as_float(__builtin_amdgcn_readlane(__float_as_uint(v), 63));
}
#define UB0(w) ((float)((w) & 0xffu))
#define UB1(w) ((float)(((w) >> 8) & 0xffu))
#define UB2(w) ((float)(((w) >> 16) & 0xffu))
#define UB3(w) ((float)((w) >> 24))

__device__ __forceinline__ float dpp_xor1(float v) { return __builtin_bit_cast(float, __builtin_amdgcn_update_dpp(0, __builtin_bit_cast(int, v), 0xB1, 0xf, 0xf, false)); }
__device__ __forceinline__ float dpp_xor2(float v) { return __builtin_bit_cast(float, __builtin_amdgcn_update_dpp(0, __builtin_bit_cast(int, v), 0x4E, 0xf, 0xf, false)); }
__device__ __forceinline__ float dpp_xor8(float v) { return __builtin_bit_cast(float, __builtin_amdgcn_update_dpp(0, __builtin_bit_cast(int, v), 0x128, 0xf, 0xf, false)); }
__device__ __forceinline__ float reduce8_rows(const float (&d)[8], int lane) {
    const bool b0 = lane & 1, b1 = lane & 2, b2 = lane & 4;
    float r[4];
#pragma unroll
    for (int k = 0; k < 4; ++k) r[k] = (b0 ? d[2 * k + 1] : d[2 * k]) + dpp_xor1(b0 ? d[2 * k] : d[2 * k + 1]);
    float t[2];
#pragma unroll
    for (int k = 0; k < 2; ++k) t[k] = (b1 ? r[2 * k + 1] : r[2 * k]) + dpp_xor2(b1 ? r[2 * k] : r[2 * k + 1]);
    float u = (b2 ? t[1] : t[0]) + __shfl_xor(b2 ? t[0] : t[1], 4);
    u += dpp_xor8(u);
    u += __shfl_xor(u, 16);
    u += __shfl_xor(u, 32);
    return u;
}
#if GATHER_4BIT
#ifndef DRY_MODE
#define DRY_MODE 0
#endif
typedef float f32x2 __attribute__((ext_vector_type(2)));
__device__ __forceinline__ void ph_gather(const Params& p, int l, const bool dry) {
    const int tid = threadIdx.x, lane = tid & 63, wave = tid >> 6;
    const int gw = blockIdx.x * NWAVES + wave, NGW = gridDim.x * NWAVES;
    const bf16_t* XN = (const bf16_t*)(p.ws + WS_XN);
    const unsigned char* UT = (const unsigned char*)(p.ws + WS_UT) + (size_t)l * NEXP * ROW4;
    const unsigned char* VT = (const unsigned char*)(p.ws + WS_VT) + (size_t)l * NEXP * ROW4;
    const int* EID = (const int*)(p.ws + WS_EID); const float* GATE = (const float*)(p.ws + WS_GATE);
    const float* mod = (const float*)(p.ws + WS_MOD) + (size_t)l * 9 * 12288;
    const int nrows = (l == DEPTH - 1) ? NLAT : MTOT;
#pragma unroll 1
    for (int t = gw; t < nrows; t += NGW) {
        int xh[4], xl[4]; float sxl;
        {
            float x[32]; float am = 0.f;
#pragma unroll
            for (int j = 0; j < 2; ++j)
#pragma unroll
                for (int k = 0; k < 2; ++k) {
                    const u32x4 q = *(const u32x4*)(XN + (size_t)t * DM + j * 1024 + lane * 16 + k * 8);
                    float* xx = x + j * 16 + k * 8;
                    xx[0] = bflo(q.x); xx[1] = bfhi(q.x); xx[2] = bflo(q.y); xx[3] = bfhi(q.y); xx[4] = bflo(q.z); xx[5] = bfhi(q.z); xx[6] = bflo(q.w); xx[7] = bfhi(q.w);
                }
#pragma unroll
            for (int i = 0; i < 32; ++i) am = fmaxf(am, fabsf(x[i]));
            sxl = am > 0.f ? am * (1.f / 119.f) : 1.f;
            const float inv = 1.f / sxl;
#pragma unroll
            for (int d = 0; d < 4; ++d) {
                unsigned h = 0u, lo = 0u;
#pragma unroll
                for (int k = 0; k < 8; ++k) {
                    const int q = (int)rintf(x[8 * d + k] * inv);
                    const int ql = ((q + 8) & 15) - 8, qh = (q - ql) >> 4;
                    h |= ((unsigned)qh & 15u) << (4 * k); lo |= ((unsigned)ql & 15u) << (4 * k);
                }
                xh[d] = (int)h; xl[d] = (int)lo;
            }
        }
        const int e0 = EID[(size_t)t * 128 + lane], e1 = EID[(size_t)t * 128 + 64 + lane];
        const float g0 = GATE[(size_t)t * 128 + lane], g1 = GATE[(size_t)t * 128 + 64 + lane];
        float hid0 = 0.f, hid1 = 0.f;
        constexpr int GB = 8;
#define G_LOAD(W, S, TAB, EB) do { _Pragma("unroll") for (int i = 0; i < GB; ++i) { \
            const int id_ = __builtin_amdgcn_readlane((EB) < 64 ? e0 : e1, ((EB) + i) & 63); \
            const unsigned char* row_ = (TAB) + (size_t)id_ * ROW4; \
            W[i] = *(const u32x4*)(row_ + lane * 16); S[i] = *(const unsigned short*)(row_ + 1024 + lane * 2); } } while (0)
#define G_DOT(W, S, EB) do { float dd_[8]; _Pragma("unroll") for (int i = 0; i < GB; ++i) { int sh_ = 0, sl_ = 0; \
            const unsigned ww[4] = {W[i].x, W[i].y, W[i].z, W[i].w}; \
            _Pragma("unroll") for (int d = 0; d < 4; ++d) { \
                sh_ = __builtin_amdgcn_sdot8((int)ww[d], xh[d], sh_, false); \
                sl_ = __builtin_amdgcn_sdot8((int)ww[d], xl[d], sl_, false); } \
            dd_[i] = (float)((sh_ << 4) + sl_) * (sxl * bf2f(S[i])); } \
            const float tot = reduce8_rows(dd_, lane);              \
            if ((lane & 56) == ((EB) & 63)) { if ((EB) < 64) hid0 = tot; else hid1 = tot; } } while (0)
#define G_AXPY(W, S, EB) do { _Pragma("unroll") for (int i = 0; i < GB; ++i) { \
            const float m_ = __uint_as_float(__builtin_amdgcn_readlane(__float_as_uint((EB) < 64 ? cf0 : cf1), ((EB) + i) & 63)) * bf2f(S[i]); \
            const f32x2 mm = {m_, m_}; \
            const unsigned ww[4] = {W[i].x, W[i].y, W[i].z, W[i].w}; \
            _Pragma("unroll") for (int d = 0; d < 4; ++d) { \
                acc[4 * d + 0] += mm * __builtin_amdgcn_cvt_scalef32_pk_f32_fp4(ww[d], 1.0f, 0); \
                acc[4 * d + 1] += mm * __builtin_amdgcn_cvt_scalef32_pk_f32_fp4(ww[d], 1.0f, 1); \
                acc[4 * d + 2] += mm * __builtin_amdgcn_cvt_scalef32_pk_f32_fp4(ww[d], 1.0f, 2); \
                acc[4 * d + 3] += mm * __builtin_amdgcn_cvt_scalef32_pk_f32_fp4(ww[d], 1.0f, 3); } } } while (0)
        u32x4 wa[GB], wb[GB]; unsigned sa[GB], sb[GB];
        const bool do_u = !(dry && (DRY_MODE == 4 || DRY_MODE == 5)), do_v = !(dry && (DRY_MODE == 3 || DRY_MODE == 5));
        if (do_u) G_LOAD(wa, sa, UT, 0); else G_LOAD(wa, sa, VT, 0);
#pragma unroll 1
        for (int eb = 0; eb < (do_u ? 128 : 0); eb += 2 * GB) {
            G_LOAD(wb, sb, UT, eb + GB);
            G_DOT(wa, sa, eb);
            if (eb + 2 * GB < 128) G_LOAD(wa, sa, UT, eb + 2 * GB); else G_LOAD(wa, sa, VT, 0);
            G_DOT(wb, sb, eb + GB);
        }
        const float cf0 = gelu_tanh(hid0) * g0, cf1 = gelu_tanh(hid1) * g1;
        f32x2 acc[16];
#pragma unroll
        for (int i = 0; i < 16; ++i) acc[i] = (f32x2){0.f, 0.f};
#pragma unroll 1
        for (int eb = 0; eb < (do_v ? 128 : 0); eb += 2 * GB) {
            G_LOAD(wb, sb, VT, eb + GB);
            G_AXPY(wa, sa, eb);
            if (eb + 2 * GB < 128) G_LOAD(wa, sa, VT, eb + 2 * GB);
            G_AXPY(wb, sb, eb + GB);
        }
#undef G_LOAD
#undef G_DOT
#undef G_AXPY
        float hn[32];
        float* hrow = t < NLAT ? p.out + (size_t)t * DM : (float*)(p.ws + WS_HC) + (size_t)(t - NLAT) * DM;
        const int bb = t < NLAT ? (t >> 11) : 8;
        const float* gate = mod + (size_t)bb * 12288 + 5 * DM;
#pragma unroll
        for (int j = 0; j < 2; ++j)
#pragma unroll
            for (int k = 0; k < 4; ++k) {
                const int col = j * 1024 + lane * 16 + k * 4;
                const f32x4 hv = *(const f32x4*)(hrow + col), gv = *(const f32x4*)(gate + col);
                const f32x2 a0 = acc[j * 8 + k * 2], a1 = acc[j * 8 + k * 2 + 1];
                f32x4 o;
                o.x = hv.x + gv.x * a0.x; o.y = hv.y + gv.y * a0.y; o.z = hv.z + gv.z * a1.x; o.w = hv.w + gv.w * a1.y;
                *(f32x4*)((dry ? (float*)(p.ws + WS_DUMMY) + (size_t)(t & 16383) * DM : hrow) + col) = o;
                hn[j * 16 + k * 4 + 0] = o.x; hn[j * 16 + k * 4 + 1] = o.y; hn[j * 16 + k * 4 + 2] = o.z; hn[j * 16 + k * 4 + 3] = o.w;
            }
        if (l + 1 < DEPTH) {
            float ss = 0.f;
#pragma unroll
            for (int i = 0; i < 32; ++i) ss += hn[i] * hn[i];
            const float rstd = rsqrtf(wave_total(ss) * (1.f / DM) + EPS);
            const float* g1n = p.norm1_g + (l + 1) * DM;
            const float* shift = mod + (size_t)9 * 12288 + (size_t)bb * 12288;
            const float* scale = shift + DM;
            bf16_t* xo = (dry ? (bf16_t*)(p.ws + WS_DUMMY) + (size_t)(t & 16383) * DM : (bf16_t*)(p.ws + WS_XN) + (size_t)t * DM);
#pragma unroll
            for (int j = 0; j < 2; ++j)
#pragma unroll
                for (int k = 0; k < 2; ++k) {
                    const int col = j * 1024 + lane * 16 + k * 8;
                    float xv[8];
#pragma unroll
                    for (int i = 0; i < 8; ++i) xv[i] = hn[j * 16 + k * 8 + i] * rstd * g1n[col + i] * (1.f + scale[col + i]) + shift[col + i];
                    u32x4 w; w.x = pk2(xv[0], xv[1]); w.y = pk2(xv[2], xv[3]); w.z = pk2(xv[4], xv[5]); w.w = pk2(xv[6], xv[7]);
                    *(u32x4*)(xo + col) = w;
                }
        }
    }
}
#else
#ifndef DRY_MODE
#define DRY_MODE 0
#endif
typedef float f32x2 __attribute__((ext_vector_type(2)));
__device__ __forceinline__ void ph_gather(const Params& p, int l, const bool dry) {
    const int tid = threadIdx.x, lane = tid & 63, wave = tid >> 6;
    const int gw = blockIdx.x * NWAVES + wave, NGW = gridDim.x * NWAVES;
    const bf16_t* XN = (const bf16_t*)(p.ws + WS_XN);
    const unsigned char* UT = (const unsigned char*)(p.ws + WS_UT) + (size_t)l * NEXP * DM;
    const unsigned char* VT = (const unsigned char*)(p.ws + WS_VT) + (size_t)l * NEXP * DM;
    const float* USC = (const float*)(p.ws + WS_USC) + l * NEXP; const float* VSC = (const float*)(p.ws + WS_VSC) + l * NEXP;
    const int* EID = (const int*)(p.ws + WS_EID); const float* GATE = (const float*)(p.ws + WS_GATE);
    const float* mod = (const float*)(p.ws + WS_MOD) + (size_t)l * 9 * 12288;
    const int nrows = (l == DEPTH - 1) ? NLAT : MTOT;
#pragma unroll 1
    for (int t = gw; t < nrows; t += NGW) {
        int xq[8]; float sxl;
        {
            float x[32]; float am = 0.f;
#pragma unroll
            for (int j = 0; j < 2; ++j)
#pragma unroll
                for (int k = 0; k < 2; ++k) {
                    const u32x4 q = *(const u32x4*)(XN + (size_t)t * DM + j * 1024 + lane * 16 + k * 8);
                    float* xx = x + j * 16 + k * 8;
                    xx[0] = bflo(q.x); xx[1] = bfhi(q.x); xx[2] = bflo(q.y); xx[3] = bfhi(q.y); xx[4] = bflo(q.z); xx[5] = bfhi(q.z); xx[6] = bflo(q.w); xx[7] = bfhi(q.w);
                }
#pragma unroll
            for (int i = 0; i < 32; ++i) am = fmaxf(am, fabsf(x[i]));
            sxl = am > 0.f ? am * (1.f / 127.f) : 1.f;
            const float inv = 1.f / sxl;
#pragma unroll
            for (int d = 0; d < 8; ++d) {
                const int q0 = (int)rintf(x[4 * d] * inv), q1 = (int)rintf(x[4 * d + 1] * inv), q2 = (int)rintf(x[4 * d + 2] * inv), q3 = (int)rintf(x[4 * d + 3] * inv);
                xq[d] = (int)(((unsigned)q0 & 0xffu) | (((unsigned)q1 & 0xffu) << 8) | (((unsigned)q2 & 0xffu) << 16) | ((unsigned)q3 << 24));
            }
        }
        const int e0 = EID[(size_t)t * 128 + lane], e1 = EID[(size_t)t * 128 + 64 + lane];
        const float g0 = GATE[(size_t)t * 128 + lane], g1 = GATE[(size_t)t * 128 + 64 + lane];
        const float us0 = USC[e0], us1 = USC[e1], vs0 = VSC[e0], vs1 = VSC[e1];
        float hid0 = 0.f, hid1 = 0.f;
        constexpr int GBU = 8, GBV = 4;
#define G_LOAD(W, TAB, EB, NB) do { _Pragma("unroll") for (int i = 0; i < NB; ++i) { \
            const int id_ = __builtin_amdgcn_readlane((EB) < 64 ? e0 : e1, ((EB) + i) & 63); \
            const unsigned char* row_ = (TAB) + (size_t)id_ * DM + lane * 16; \
            W[i][0] = *(const u32x4*)row_; W[i][1] = *(const u32x4*)(row_ + 1024); } } while (0)
#define G_DOT(W, EB) do { _Pragma("unroll") for (int i = 0; i < GBU; ++i) { int s_ = 0; \
            s_ = __builtin_amdgcn_sdot4((int)W[i][0].x, xq[0], s_, false); s_ = __builtin_amdgcn_sdot4((int)W[i][0].y, xq[1], s_, false); \
            s_ = __builtin_amdgcn_sdot4((int)W[i][0].z, xq[2], s_, false); s_ = __builtin_amdgcn_sdot4((int)W[i][0].w, xq[3], s_, false); \
            s_ = __builtin_amdgcn_sdot4((int)W[i][1].x, xq[4], s_, false); s_ = __builtin_amdgcn_sdot4((int)W[i][1].y, xq[5], s_, false); \
            s_ = __builtin_amdgcn_sdot4((int)W[i][1].z, xq[6], s_, false); s_ = __builtin_amdgcn_sdot4((int)W[i][1].w, xq[7], s_, false); \
            const float tot = wave_total((float)s_ * sxl); \
            if ((((EB) + i) & 63) == lane) { if ((EB) < 64) hid0 = tot; else hid1 = tot; } } } while (0)
#define G_AXPY(W, EB) do { _Pragma("unroll") for (int i = 0; i < GBV; ++i) { \
            const float cf_ = __uint_as_float(__builtin_amdgcn_readlane(__float_as_uint((EB) < 64 ? cf0 : cf1), ((EB) + i) & 63)); \
            const f32x2 mm = {cf_, cf_}; \
            _Pragma("unroll") for (int j = 0; j < 2; ++j) { const unsigned ww[4] = {W[i][j].x, W[i][j].y, W[i][j].z, W[i][j].w}; \
                _Pragma("unroll") for (int k = 0; k < 4; ++k) { \
                    acc[j * 8 + k * 2] += mm * __builtin_amdgcn_cvt_pk_f32_fp8((int)ww[k], false); \
                    acc[j * 8 + k * 2 + 1] += mm * __builtin_amdgcn_cvt_pk_f32_fp8((int)ww[k], true); } } } } while (0)
        u32x4 wa[GBU][2], wb[GBU][2];
        const bool do_u = !(dry && (DRY_MODE == 4 || DRY_MODE == 5)), do_v = !(dry && (DRY_MODE == 3 || DRY_MODE == 5));
        if (do_u) G_LOAD(wa, UT, 0, GBU); else G_LOAD(wa, VT, 0, GBV);
#pragma unroll 1
        for (int eb = 0; eb < (do_u ? 128 : 0); eb += 2 * GBU) {
            G_LOAD(wb, UT, eb + GBU, GBU);
            G_DOT(wa, eb);
            if (eb + 2 * GBU < 128) G_LOAD(wa, UT, eb + 2 * GBU, GBU); else G_LOAD(wa, VT, 0, GBV);
            G_DOT(wb, eb + GBU);
        }
        const float cf0 = gelu_tanh(hid0 * us0) * g0 * vs0, cf1 = gelu_tanh(hid1 * us1) * g1 * vs1;
        f32x2 acc[16];
#pragma unroll
        for (int i = 0; i < 16; ++i) acc[i] = (f32x2){0.f, 0.f};
#pragma unroll 1
        for (int eb = 0; eb < (do_v ? 128 : 0); eb += 2 * GBV) {
            G_LOAD(wb, VT, eb + GBV, GBV);
            G_AXPY(wa, eb);
            if (eb + 2 * GBV < 128) G_LOAD(wa, VT, eb + 2 * GBV, GBV);
            G_AXPY(wb, eb + GBV);
        }
#undef G_LOAD
#undef G_DOT
#undef G_AXPY
        float hn[32];
        float* hrow = t < NLAT ? p.out + (size_t)t * DM : (float*)(p.ws + WS_HC) + (size_t)(t - NLAT) * DM;
        const int bb = t < NLAT ? (t >> 11) : 8;
        const float* gate = mod + (size_t)bb * 12288 + 5 * DM;
#pragma unroll
        for (int j = 0; j < 2; ++j)
#pragma unroll
            for (int k = 0; k < 4; ++k) {
                const int col = j * 1024 + lane * 16 + k * 4;
                const f32x4 hv = *(const f32x4*)(hrow + col), gv = *(const f32x4*)(gate + col);
                const f32x2 a0 = acc[j * 8 + k * 2], a1 = acc[j * 8 + k * 2 + 1];
                f32x4 o;
                o.x = hv.x + gv.x * a0.x; o.y = hv.y + gv.y * a0.y; o.z = hv.z + gv.z * a1.x; o.w = hv.w + gv.w * a1.y;
                *(f32x4*)((dry ? (float*)(p.ws + WS_DUMMY) + (size_t)(t & 16383) * DM : hrow) + col) = o;
                hn[j * 16 + k * 4 + 0] = o.x; hn[j * 16 + k * 4 + 1] = o.y; hn[j * 16 + k * 4 + 2] = o.z; hn[j * 16 + k * 4 + 3] = o.w;
            }
        if (l + 1 < DEPTH) {
            float ss = 0.f;
#pragma unroll
            for (int i = 0; i < 32; ++i) ss += hn[i] * hn[i];
            const float rstd = rsqrtf(wave_total(ss) * (1.f / DM) + EPS);
            const float* g1n = p.norm1_g + (l + 1) * DM;
            const float* shift = mod + (size_t)9 * 12288 + (size_t)bb * 12288;
            const float* scale = shift + DM;
            bf16_t* xo = (dry ? (bf16_t*)(p.ws + WS_DUMMY) + (size_t)(t & 16383) * DM : (bf16_t*)(p.ws + WS_XN) + (size_t)t * DM);
#pragma unroll
            for (int j = 0; j < 2; ++j)
#pragma unroll
                for (int k = 0; k < 2; ++k) {
                    const int col = j * 1024 + lane * 16 + k * 8;
                    float xv[8];
#pragma unroll
                    for (int i = 0; i < 8; ++i) xv[i] = hn[j * 16 + k * 8 + i] * rstd * g1n[col + i] * (1.f + scale[col + i]) + shift[col + i];
                    u32x4 w; w.x = pk2(xv[0], xv[1]); w.y = pk2(xv[2], xv[3]); w.z = pk2(xv[4], xv[5]); w.w = pk2(xv[6], xv[7]);
                    *(u32x4*)(xo + col) = w;
                }
        }
    }
}
#endif
#else
__device__ __forceinline__ float dot8(const u32x4 u, const u32x4 x) {
    float d = bflo(u.x) * bflo(x.x) + bfhi(u.x) * bfhi(x.x);
    d += bflo(u.y) * bflo(x.y) + bfhi(u.y) * bfhi(x.y);
    d += bflo(u.z) * bflo(x.z) + bfhi(u.z) * bfhi(x.z);
    d += bflo(u.w) * bflo(x.w) + bfhi(u.w) * bfhi(x.w);
    return d;
}
__device__ __forceinline__ void ph_gather(const Params& p, int l, const bool dry) {
    const int tid = threadIdx.x, lane = tid & 63, wave = tid >> 6;
    const int gw = blockIdx.x * NWAVES + wave, NGW = gridDim.x * NWAVES;
    const bf16_t* XN = (const bf16_t*)(p.ws + WS_XN);
    const bf16_t* UT = (const bf16_t*)(p.ws + WS_UT) + (size_t)l * NEXP * DM;
    const bf16_t* VT = (const bf16_t*)(p.ws + WS_VT) + (size_t)l * NEXP * DM;
    const int* EID = (const int*)(p.ws + WS_EID); const float* GATE = (const float*)(p.ws + WS_GATE);
    const float* mod = (const float*)(p.ws + WS_MOD) + (size_t)l * 9 * 12288;
    const int nrows = (l == DEPTH - 1) ? NLAT : MTOT;
    for (int t = gw; t < nrows; t += NGW) {
        u32x4 xq[4];
#pragma unroll
        for (int j = 0; j < 4; ++j) xq[j] = *(const u32x4*)(XN + (size_t)t * DM + j * 512 + lane * 8);
        const int e0 = EID[(size_t)t * 128 + lane], e1 = EID[(size_t)t * 128 + 64 + lane];
        const float g0 = GATE[(size_t)t * 128 + lane], g1 = GATE[(size_t)t * 128 + 64 + lane];
        float hid0 = 0.f, hid1 = 0.f;
#pragma unroll 1
        for (int eb = 0; eb < 128; eb += 4) {
            u32x4 uu[4][4];
#pragma unroll
            for (int i = 0; i < 4; ++i) {
                const int e = eb + i;
                const int id = __builtin_amdgcn_readlane(eb < 64 ? e0 : e1, e & 63);
                const u32x4* ur = (const u32x4*)(UT + (size_t)id * DM) + lane;
#pragma unroll
                for (int j = 0; j < 4; ++j) uu[i][j] = ur[j * 64];
            }
#pragma unroll
            for (int i = 0; i < 4; ++i) {
                const int e = eb + i;
                float d = dot8(uu[i][0], xq[0]) + dot8(uu[i][1], xq[1]) + dot8(uu[i][2], xq[2]) + dot8(uu[i][3], xq[3]);
                d = wave_sum(d);
                if ((e & 63) == lane) { if (eb < 64) hid0 = d; else hid1 = d; }
            }
        }
        const float cf0 = gelu_tanh(hid0) * g0, cf1 = gelu_tanh(hid1) * g1;
        float acc[32];
#pragma unroll
        for (int i = 0; i < 32; ++i) acc[i] = 0.f;
#pragma unroll 1
        for (int eb = 0; eb < 128; eb += 4) {
            u32x4 vv[4][4]; float cf[4];
#pragma unroll
            for (int i = 0; i < 4; ++i) {
                const int e = eb + i;
                const int id = __builtin_amdgcn_readlane(eb < 64 ? e0 : e1, e & 63);
                cf[i] = __uint_as_float(__builtin_amdgcn_readlane(__float_as_uint(eb < 64 ? cf0 : cf1), e & 63));
                const u32x4* vr = (const u32x4*)(VT + (size_t)id * DM) + lane;
#pragma unroll
                for (int j = 0; j < 4; ++j) vv[i][j] = vr[j * 64];
            }
#pragma unroll
            for (int i = 0; i < 4; ++i)
#pragma unroll
                for (int j = 0; j < 4; ++j) {
                    acc[j * 8 + 0] += cf[i] * bflo(vv[i][j].x); acc[j * 8 + 1] += cf[i] * bfhi(vv[i][j].x);
                    acc[j * 8 + 2] += cf[i] * bflo(vv[i][j].y); acc[j * 8 + 3] += cf[i] * bfhi(vv[i][j].y);
                    acc[j * 8 + 4] += cf[i] * bflo(vv[i][j].z); acc[j * 8 + 5] += cf[i] * bfhi(vv[i][j].z);
                    acc[j * 8 + 6] += cf[i] * bflo(vv[i][j].w); acc[j * 8 + 7] += cf[i] * bfhi(vv[i][j].w);
                }
        }
        float* hrow = t < NLAT ? p.out + (size_t)t * DM : (float*)(p.ws + WS_HC) + (size_t)(t - NLAT) * DM;
        const int bb = t < NLAT ? (t >> 11) : 8;
        const float* gate = mod + (size_t)bb * 12288 + 5 * DM;
#pragma unroll
        for (int j = 0; j < 4; ++j) {
            const int col = j * 512 + lane * 8;
#pragma unroll
            for (int hh = 0; hh < 2; ++hh) {
                const f32x4 hv = *(const f32x4*)(hrow + col + hh * 4), gv = *(const f32x4*)(gate + col + hh * 4);
                f32x4 o;
                o.x = hv.x + gv.x * acc[j * 8 + hh * 4 + 0]; o.y = hv.y + gv.y * acc[j * 8 + hh * 4 + 1];
                o.z = hv.z + gv.z * acc[j * 8 + hh * 4 + 2]; o.w = hv.w + gv.w * acc[j * 8 + hh * 4 + 3];
                *(f32x4*)(hrow + col + hh * 4) = o;
            }
        }
    }
}

#endif

#define LAS __attribute__((address_space(3)))
#define XB_TMO      128
#define XB_XCNT(j)  (256  + 64 * (j))
#define XB_XSUB(j)  (1280 + 64 * (j))
#define XB_XGEN(j)  (2304 + 64 * (j))
#define XB_TOP      3328
#define XB_TOPGEN   3392
#define XCD_BAR_WORDS 3456
#define XB_SPIN_CAP (1u << 18)

__device__ __forceinline__ unsigned xb_ld(unsigned* p)              { return __hip_atomic_load(p, __ATOMIC_RELAXED, __HIP_MEMORY_SCOPE_AGENT); }
__device__ __forceinline__ unsigned xb_add(unsigned* p, unsigned v) { return __hip_atomic_fetch_add(p, v, __ATOMIC_RELAXED, __HIP_MEMORY_SCOPE_AGENT); }
__device__ __forceinline__ unsigned xb_xcc_id() { return (unsigned)__builtin_amdgcn_s_getreg((3 << 11) | 20) & 0xFu; }
#define XB_SPIN(cond, bar) do { unsigned _sp = 0; while (cond) { __builtin_amdgcn_s_sleep(1); \
    if ((++_sp & 255u) == 0u) { if (xb_ld(&(bar)[XB_TMO])) break; if (_sp > XB_SPIN_CAP) { atomicAdd(&(bar)[XB_TMO], 1u); break; } } } } while (0)

struct XcdBarrier {
    unsigned* bar; unsigned x;
    volatile LAS unsigned* st;
};

__device__ __forceinline__ XcdBarrier xcd_barrier_post(unsigned* bar, volatile LAS unsigned* st) {
    XcdBarrier b; b.bar = bar; b.x = xb_xcc_id(); b.st = st;
    if (threadIdx.x == 0) (void)xb_add(&bar[XB_XCNT(b.x)], 1u);
    return b;
}
__device__ __forceinline__ void xcd_barrier_complete(unsigned* bar, unsigned x, unsigned& nloc, unsigned& nx) {
    const unsigned G = gridDim.x * gridDim.y * gridDim.z;
    unsigned sum, cnt, mine, sp = 0u;
    for (;;) {
        sum = 0u; cnt = 0u; mine = 0u;
#pragma unroll
        for (unsigned j = 0; j < 16; ++j) { const unsigned c = xb_ld(&bar[XB_XCNT(j)]); sum += c; cnt += (c > 0u) ? 1u : 0u; mine = (j == x) ? c : mine; }
        if (sum == G) break;
        __builtin_amdgcn_s_sleep(1);
        if ((++sp & 255u) == 0u) { if (xb_ld(&bar[XB_TMO])) break; if (sp > XB_SPIN_CAP) { atomicAdd(&bar[XB_TMO], 1u); break; } }
    }
    nloc = mine > 0u ? mine : 1u; nx = cnt > 0u ? cnt : 1u;
}

__device__ __forceinline__ void xcd_barrier(const XcdBarrier& b) {
    asm volatile("s_waitcnt vmcnt(0)" ::: "memory");
    __syncthreads();
    if (threadIdx.x == 0) {
        unsigned* bar = b.bar;
        __builtin_amdgcn_s_waitcnt(0);
        unsigned nloc = b.st[0], nx = b.st[1];
        if (nloc == 0u) { xcd_barrier_complete(bar, b.x, nloc, nx); b.st[0] = nloc; b.st[1] = nx; }
        const unsigned old = xb_add(&bar[XB_XSUB(b.x)], 1u);
        const unsigned gen = old / nloc;
        if (old + 1u == (gen + 1u) * nloc) {
            __builtin_amdgcn_fence(__ATOMIC_RELEASE, "agent");
            asm volatile("s_waitcnt vmcnt(0)" ::: "memory");
            const unsigned og = xb_add(&bar[XB_TOP], 1u);
            const unsigned tg = og / nx;
            if (og + 1u == (tg + 1u) * nx) xb_add(&bar[XB_TOPGEN], 1u);
            else XB_SPIN(xb_ld(&bar[XB_TOPGEN]) == tg, bar);
            __builtin_amdgcn_fence(__ATOMIC_ACQUIRE, "agent");
            xb_add(&bar[XB_XGEN(b.x)], 1u);
            asm volatile("s_waitcnt vmcnt(0)" ::: "memory");
        } else {
            XB_SPIN(xb_ld(&bar[XB_XGEN(b.x)]) == gen, bar);
            __builtin_amdgcn_fence(__ATOMIC_ACQUIRE, "agent");
            asm volatile("s_waitcnt vmcnt(0)" ::: "memory");
        }
    }
    __syncthreads();
}

constexpr int NPHASE = 1 + 10 * DEPTH;
template <int S>
__device__ __forceinline__ void run_stage(const Params& p, int l, unsigned char* lds, const bool dry) {
    const bool last = (l == DEPTH - 1);
    const float* mod = (const float*)(p.ws + WS_MOD) + (size_t)l * 9 * 12288;
    if constexpr (S == 1) { if (l == 0) ph_modulate(p, l, 0); }
    if constexpr (S == 2) {
#if USE_PG8
        pg8::Gemm g{(const bf16_t*)(p.ws + WS_XN), (const bf16_t*)(p.ws + WS_WIN) + (size_t)l * INW * DM, MTOT, INW, DM};
        pg8::StaticOrder So; So.init(MTOT, INW, (int)gridDim.x, (int)blockIdx.x);
        pg8::EpiBf16<0> E{(bf16_t*)(p.ws + WS_P), INW, nullptr, 0, 0, 1.f};
        pg8::gemm_phase<pg8::EpiBf16<0>, pg8::StaticOrder, true, true>((PG8_LAS unsigned char*)lds, g, So, E);
#else
        EpiBf16Store E{(bf16_t*)(p.ws + WS_P), INW};
        gemm_naive(lds, (const bf16_t*)(p.ws + WS_XN), (const bf16_t*)(p.ws + WS_WIN) + (size_t)l * INW * DM, MTOT, INW, DM, E);
#endif
    }
    if constexpr (S == 3) { if (QPREP_IN_UNIT && CPREP_IN_UNIT) ph_prep_k(p, l, dry); else ph_prep(p, l, dry); }
    if constexpr (S == 4) {
#if USE_FAST_ATT
        ph_mixers_fast(p, l, lds, dry);
#else
        ph_mixers_naive(p, l, lds);
#endif
    }
    if constexpr (S == 5) ph_ynorm(p, l);
    if constexpr (S == 6) {
#if USE_PG8
        const int M = last ? NLAT : MTOT;
        pg8::Gemm g{(const bf16_t*)(p.ws + WS_Y), (const bf16_t*)(p.ws + WS_WOUT) + (size_t)l * DM * DM, M, DM, DM};
        pg8::StaticOrder So; So.init(M, DM, (int)gridDim.x, (int)blockIdx.x);
        pg8::EpiResGateT E{l == 0 ? p.x : p.out, l == 0 ? p.ctx : (const float*)(p.ws + WS_HC), dry ? (float*)(p.ws + WS_DUMMY) : p.out, dry ? (float*)(p.ws + WS_DUMMY) : (float*)(p.ws + WS_HC), mod + 2 * DM};
        pg8::gemm_phase<pg8::EpiResGateT, pg8::StaticOrder, true, true>((PG8_LAS unsigned char*)lds, g, So, E);
#if GATHER_I8 && GATHER_4BIT
        if (TABLES_IN_GAPS && l == 0 && !dry) conv4_tables(p, 0, 2 * NEXP, (unsigned*)(p.ws + WS_CTL) + 6144, lds);
#endif
#else
        EpiResGate E{l == 0 ? p.x : p.out, l == 0 ? p.ctx : (const float*)(p.ws + WS_HC), p.out, (float*)(p.ws + WS_HC), mod + 2 * DM};
        gemm_naive(lds, (const bf16_t*)(p.ws + WS_Y), (const bf16_t*)(p.ws + WS_WOUT) + (size_t)l * DM * DM, last ? NLAT : MTOT, DM, DM, E);
#endif
    }
    if constexpr (S == 7) ph_modulate(p, l, 1);
    if constexpr (S == 8) {
#if USE_PG8
        const int M = last ? NLAT : MTOT;
        pg8::Gemm g{(const bf16_t*)(p.ws + WS_XN), (const bf16_t*)(p.ws + WS_WQ) + (size_t)l * DM * DM, M, DM, DM};
        pg8::StaticOrder So; So.init(M, DM, (int)gridDim.x, (int)blockIdx.x);
        pg8::EpiBf16<0> E{(bf16_t*)(p.ws + WS_P), DM, nullptr, 0, 0, 1.f};
        pg8::gemm_phase<pg8::EpiBf16<0>, pg8::StaticOrder, true, true>((PG8_LAS unsigned char*)lds, g, So, E);
#if FUSE_ROUTE
        asm volatile("s_waitcnt vmcnt(0)" ::: "memory");
        __syncthreads();
        ph_route_fast<true>(p, l, lds);
#endif
#if GATHER_I8 && GATHER_4BIT
        if (TABLES_IN_GAPS && l == 0 && !dry) conv4_tables(p, 2 * NEXP, 4 * NEXP, (unsigned*)(p.ws + WS_CTL) + 6208, lds);
#endif
#else
        EpiBf16Store E{(bf16_t*)(p.ws + WS_P), DM};
        gemm_naive(lds, (const bf16_t*)(p.ws + WS_XN), (const bf16_t*)(p.ws + WS_WQ) + (size_t)l * DM * DM, last ? NLAT : MTOT, DM, DM, E);
#endif
    }
    if constexpr (S == 9) {
#if USE_FAST_ROUTE
        if (!FUSE_ROUTE) ph_route_fast<false>(p, l, lds);
#else
        ph_route_naive(p, l);
#endif
    }
    if constexpr (S == 10) ph_gather(p, l, dry);
}
__global__ void __launch_bounds__(NTHREADS) fwd_kernel(Params p) {
    extern __shared__ __attribute__((aligned(16))) unsigned char lds[];
    cg::grid_group grid = cg::this_grid();
    const int lo = p.ph_lo, hi = p.ph_hi;
    volatile LAS unsigned* stw = (volatile LAS unsigned*)((LAS unsigned char*)lds + (LDS_BYTES - 128));
    if (threadIdx.x < 2) stw[threadIdx.x] = 0u;
    __syncthreads();
    const XcdBarrier bar = xcd_barrier_post((unsigned*)(p.ws + WS_CTL + 32768), stw);
#define IN(k) (lo <= (k) && (k) < hi)
#define SEAM(k) do { if (IN(k) && IN((k) + 1)) { if ((k) == 0) grid.sync(); else xcd_barrier(bar); } } while (0)
#define STAGE(S, l) do { constexpr int k_ = 1 + 10 * (l) + (S) - 1; if (IN(k_)) { if constexpr ((REP_MASK >> k_) & 1) { run_stage<S>(p, l, lds, true); xcd_barrier(bar); } run_stage<S>(p, l, lds, false); } SEAM(k_); } while (0)
#define LAYER(l) do { if ((l) == 0) { STAGE(1, l); } STAGE(2, l); STAGE(3, l); STAGE(4, l); STAGE(5, l); STAGE(6, l); STAGE(7, l); STAGE(8, l); if (!FUSE_ROUTE) { STAGE(9, l); } STAGE(10, l); } while (0)
    if (IN(0)) { if constexpr (REP_MASK & 1) { ph_prologue(p, lds); grid.sync(); } ph_prologue(p, lds); }
    SEAM(0);
    LAYER(0);
    LAYER(1);
#undef IN
#undef SEAM
#undef STAGE
#undef LAYER
}

extern "C" void kernel_launch(void* const* d_in, const int* in_sizes, int n_in, void* d_out, int out_size, void* d_ws, size_t ws_size, hipStream_t stream) {
    static int grid_blocks = 0;
    if (grid_blocks == 0) {
        if (n_in != 23 || out_size != NLAT * DM || ws_size < WS_END) { fprintf(stderr, "kernel_launch: unexpected shapes n_in %d out %d ws %zu\n", n_in, out_size, ws_size); grid_blocks = -1; return; }
        if (hipFuncSetAttribute((const void*)fwd_kernel, hipFuncAttributeMaxDynamicSharedMemorySize, LDS_BYTES) != hipSuccess) { fprintf(stderr, "kernel_launch: hipFuncSetAttribute failed\n"); grid_blocks = -1; return; }
        int dev = 0, cus = 0, per_cu = 0;
        hipGetDevice(&dev);
        hipDeviceGetAttribute(&cus, hipDeviceAttributeMultiprocessorCount, dev);
        hipOccupancyMaxActiveBlocksPerMultiprocessor(&per_cu, (const void*)fwd_kernel, NTHREADS, LDS_BYTES);
        if (per_cu < 1 || cus < 1) { fprintf(stderr, "kernel_launch: occupancy query failed (%d per CU, %d CUs)\n", per_cu, cus); grid_blocks = -1; return; }
        grid_blocks = cus * per_cu;
    }
    if (grid_blocks < 0) return;
    Params p{};
    const float** pp = (const float**)&p;
    for (int i = 0; i < 23; ++i) pp[i] = (const float*)d_in[i];
    p.out = (float*)d_out; p.ws = (unsigned char*)d_ws;
    p.ph_lo = 0; p.ph_hi = NPHASE;
    hipMemsetAsync((char*)d_ws + WS_CTL, 0, 65536, stream);
    void* args[] = {&p};
    hipError_t e = hipLaunchCooperativeKernel((const void*)fwd_kernel, dim3(grid_blocks), dim3(NTHREADS), args, LDS_BYTES, stream);
    if (e != hipSuccess) fprintf(stderr, "cooperative launch failed: %s (grid %d)\n", hipGetErrorString(e), grid_blocks);
}
```

```cpp
#include <hip/hip_runtime.h>
#include <hip/hip_cooperative_groups.h>
#include <cstdio>
#include <cstdint>
namespace cg = cooperative_groups;

constexpr int DM = 2048, NB = 8, SEQ = 2048, NCTX = 256, DEPTH = 2;
constexpr int NLAT = NB * SEQ;
constexpr int NCT = NB * NCTX;
constexpr int MTOT = NLAT + NCT;
constexpr int INW = 3584;
constexpr int C_QA = 0, C_KA = 768, C_VA = 1024, C_QB = 1280, C_KB = 2048, C_VB = 2304, C_UC = 2560, C_VC = 3072;
constexpr int NEXP = 16384;
constexpr float EPS = 1e-6f;
constexpr float ATT_SCALE = 0.088388347648318440f;
constexpr int NTHREADS = 512, NWAVES = 8;

constexpr size_t MiB = 1u << 20;
constexpr size_t WS_CTL = 0;
constexpr size_t WS_MOD = 1 * MiB;
constexpr size_t WS_ROPE = 2 * MiB;
constexpr size_t WS_KEYS = 3 * MiB;
constexpr size_t WS_WSC = 4 * MiB;
constexpr size_t WS_USC = 5 * MiB;
constexpr size_t WS_VSC = 6 * MiB;
constexpr size_t WS_WIN = 8 * MiB;
constexpr size_t WS_WOUT = 36 * MiB;
constexpr size_t WS_WQ = 52 * MiB;
constexpr size_t WS_HC = 68 * MiB;
constexpr size_t WS_EID = 84 * MiB;
constexpr size_t WS_GATE = 93 * MiB;
constexpr size_t WS_XN = 104 * MiB;
constexpr size_t WS_Y = 176 * MiB;
constexpr size_t WS_P = 248 * MiB;
constexpr size_t WS_UT = 376 * MiB;
constexpr size_t WS_VT = 504 * MiB;
constexpr size_t WS_SCL = 102 * MiB;
constexpr size_t SCL_WIN = 0, SCL_WOUT = 2 * 3584, SCL_XN = SCL_WOUT + 2 * 2048, SCL_Y = SCL_XN + 18432;
constexpr size_t WS_XN8 = 784 * MiB;
constexpr size_t CTL_COLMAX = 65536;
constexpr size_t WS_DUMMY = 640 * MiB;
constexpr size_t WS_END = 820 * MiB;

constexpr int LDS_BYTES = 147456;

typedef unsigned short bf16_t;
typedef float f32x4 __attribute__((ext_vector_type(4)));
typedef unsigned u32x4 __attribute__((ext_vector_type(4)));
typedef unsigned u32x2 __attribute__((ext_vector_type(2)));

struct Params {
    const float *x, *c, *ctx, *c_ctx, *w_ada, *b_ada, *norm1_g, *norm2_g, *w_in, *qn_a, *kn_a, *qn_b, *kn_b, *sink_b, *vn_c, *ws_c, *bs_c,
        *g_group, *w_out, *peer_wq, *peer_keys, *peer_u, *peer_v;
    float* out;
    unsigned char* ws;
    int ph_lo, ph_hi;
};

__device__ __forceinline__ float bf2f(unsigned v) { return __uint_as_float(v << 16); }
__device__ __forceinline__ float bflo(unsigned w) { return __uint_as_float(w << 16); }
__device__ __forceinline__ float bfhi(unsigned w) { return __uint_as_float(w & 0xffff0000u); }
__device__ __forceinline__ unsigned f2bf(float f) { unsigned u = __float_as_uint(f); return (u + 0x7fffu + ((u >> 16) & 1u)) >> 16; }
__device__ __forceinline__ unsigned pk2(float lo, float hi) { return f2bf(lo) | (f2bf(hi) << 16); }
__device__ __forceinline__ float wave_sum(float v) {
#pragma unroll
    for (int o = 32; o >= 1; o >>= 1) v += __shfl_xor(v, o);
    return v;
}
__device__ __forceinline__ float wave_max(float v) {
#pragma unroll
    for (int o = 32; o >= 1; o >>= 1) v = fmaxf(v, __shfl_xor(v, o));
    return v;
}
__device__ __forceinline__ float gelu_tanh(float x) {
    const float y = 0.7978845608028654f * (x + 0.044715f * x * x * x);
    const float t = 1.f - 2.f / (__expf(2.f * y) + 1.f);
    return 0.5f * x * (1.f + t);
}
__device__ __forceinline__ float silu(float x) { return x / (1.f + __expf(-x)); }
#define LDS_WAIT() asm volatile("s_waitcnt lgkmcnt(0)" ::: "memory")
#ifndef GATHER_I8
#define GATHER_I8 1
#endif
#ifndef GATHER_4BIT
#define GATHER_4BIT 1
#endif
constexpr int ROW4 = 1152;
#ifndef FUSE_ROUTE
#define FUSE_ROUTE 1
#endif
#ifndef GEMM_I8
#define GEMM_I8 1
#endif
#ifndef REP_MASK
#define REP_MASK 0
#endif

__device__ __forceinline__ void transpose_item(const float* W, int K, int N, bf16_t* WT, const float* gk, float* scr, int item, int lane) {
    const int nblk = N / 32, kb = item / nblk, nb = item % nblk, k0 = 64 * kb, n0 = 32 * nb;
#pragma unroll 8
    for (int i = 0; i < 32; ++i) {
        const int kk = 2 * i + (lane >> 5);
        float v = W[(size_t)(k0 + kk) * N + n0 + (lane & 31)];
        if (gk) v *= gk[k0 + kk];
        scr[kk * 33 + (lane & 31)] = v;
    }
    LDS_WAIT();
    const int c = lane & 7;
#pragma unroll
    for (int j = 0; j < 4; ++j) {
        const int n = (lane >> 3) + 8 * j;
        const float* s = scr + (8 * c) * 33 + n;
        u32x4 o;
        o.x = pk2(s[0 * 33], s[1 * 33]); o.y = pk2(s[2 * 33], s[3 * 33]); o.z = pk2(s[4 * 33], s[5 * 33]); o.w = pk2(s[6 * 33], s[7 * 33]);
        *(u32x4*)(WT + (size_t)(n0 + n) * K + k0 + 8 * c) = o;
    }
    LDS_WAIT();
}

__device__ __forceinline__ void colmax_item(const float* W, int N, const float* gk, unsigned* cmax, int item, int lane) {
    const int nblk = N / 32, kb = item / nblk, nb = item % nblk, k0 = 64 * kb, n0 = 32 * nb;
    f32x4 v[8];
#pragma unroll
    for (int i = 0; i < 8; ++i) v[i] = *(const f32x4*)(W + (size_t)(k0 + 8 * i + (lane >> 3)) * N + n0 + 4 * (lane & 7));
    float m0 = 0.f, m1 = 0.f, m2 = 0.f, m3 = 0.f;
#pragma unroll
    for (int i = 0; i < 8; ++i) {
        const float g = gk ? fabsf(gk[k0 + 8 * i + (lane >> 3)]) : 1.f;
        m0 = fmaxf(m0, fabsf(v[i].x) * g); m1 = fmaxf(m1, fabsf(v[i].y) * g); m2 = fmaxf(m2, fabsf(v[i].z) * g); m3 = fmaxf(m3, fabsf(v[i].w) * g);
    }
#pragma unroll
    for (int o = 8; o <= 32; o <<= 1) { m0 = fmaxf(m0, __shfl_xor(m0, o)); m1 = fmaxf(m1, __shfl_xor(m1, o)); m2 = fmaxf(m2, __shfl_xor(m2, o)); m3 = fmaxf(m3, __shfl_xor(m3, o)); }
    if (lane < 8) {
        unsigned* c = cmax + n0 + 4 * lane;
        atomicMax(c + 0, __float_as_uint(m0)); atomicMax(c + 1, __float_as_uint(m1)); atomicMax(c + 2, __float_as_uint(m2)); atomicMax(c + 3, __float_as_uint(m3));
    }
}
__device__ __forceinline__ void transpose_item_i8(const float* W, int K, int N, unsigned char* W8, const float* gk, const unsigned* cmax, float* scr, int item, int lane) {
    const int nblk = N / 32, kb = item / nblk, nb = item % nblk, k0 = 64 * kb, n0 = 32 * nb;
    f32x4 v[8];
#pragma unroll
    for (int i = 0; i < 8; ++i) v[i] = *(const f32x4*)(W + (size_t)(k0 + 8 * i + (lane >> 3)) * N + n0 + 4 * (lane & 7));
    float inv[4];
#pragma unroll
    for (int c = 0; c < 4; ++c) { const float m = __uint_as_float(cmax[n0 + 4 * (lane & 7) + c]); inv[c] = m > 0.f ? 127.f / m : 0.f; }
#pragma unroll
    for (int i = 0; i < 8; ++i) {
        const int kk = 8 * i + (lane >> 3);
        const float g = gk ? gk[k0 + kk] : 1.f;
        float* d = scr + kk * 33 + 4 * (lane & 7);
        d[0] = rintf(v[i].x * g * inv[0]); d[1] = rintf(v[i].y * g * inv[1]); d[2] = rintf(v[i].z * g * inv[2]); d[3] = rintf(v[i].w * g * inv[3]);
    }
    LDS_WAIT();
    const int c = lane & 7;
#pragma unroll
    for (int j = 0; j < 4; ++j) {
        const int n = (lane >> 3) + 8 * j;
        const float* s = scr + (8 * c) * 33 + n;
        unsigned lo = 0u, hi = 0u;
#pragma unroll
        for (int i = 0; i < 4; ++i) { lo |= ((unsigned)(int)s[i * 33] & 0xffu) << (8 * i); hi |= ((unsigned)(int)s[(4 + i) * 33] & 0xffu) << (8 * i); }
        u32x2 o; o.x = lo; o.y = hi;
        *(u32x2*)(W8 + (size_t)(n0 + n) * K + k0 + 8 * c) = o;
    }
    LDS_WAIT();
}
__device__ __forceinline__ void ph_weights_i8(const Params& p, unsigned char* lds) {
    const int tid = threadIdx.x, lane = tid & 63, wave = tid >> 6;
    const int gw = blockIdx.x * NWAVES + wave, NGW = gridDim.x * NWAVES;
    float* scr = (float*)(lds + wave * 8704);
    const unsigned* cm = (const unsigned*)(p.ws + WS_CTL + CTL_COLMAX);
    constexpr int I_IN = 32 * 112, I_SQ = 32 * 64, I_L = I_IN + I_SQ;
    for (int it = gw; it < 2 * I_L; it += NGW) {
        const int l = it / I_L; const int r = it % I_L;
        if (r < I_IN) transpose_item_i8(p.w_in + (size_t)l * DM * INW, DM, INW, (unsigned char*)(p.ws + WS_WIN) + (size_t)l * INW * DM, nullptr, cm + l * (INW + DM), scr, r, lane);
        else transpose_item_i8(p.w_out + (size_t)l * DM * DM, DM, DM, (unsigned char*)(p.ws + WS_WOUT) + (size_t)l * DM * DM, p.g_group + l * DM, cm + l * (INW + DM) + INW, scr, r - I_IN, lane);
    }
    float* S = (float*)(p.ws + WS_SCL);
    for (int i = blockIdx.x * NTHREADS + tid; i < 2 * (INW + DM); i += gridDim.x * NTHREADS) {
        const int l = i / (INW + DM), n = i % (INW + DM);
        const float m = __uint_as_float(cm[i]); const float s = m > 0.f ? m * (1.f / 127.f) : 1.f;
        if (n < INW) S[SCL_WIN + l * INW + n] = s; else S[SCL_WOUT + l * DM + (n - INW)] = s;
    }
}
__device__ __forceinline__ void cvt_range(const float* src, bf16_t* dst, size_t n8, size_t gtid, size_t gthreads) {
    for (size_t i = gtid; i < n8; i += gthreads) {
        const f32x4 a = *(const f32x4*)(src + i * 8), b = *(const f32x4*)(src + i * 8 + 4);
        u32x4 o; o.x = pk2(a.x, a.y); o.y = pk2(a.z, a.w); o.z = pk2(b.x, b.y); o.w = pk2(b.z, b.w);
        *(u32x4*)(dst + i * 8) = o;
    }
}

#if GATHER_I8 && GATHER_4BIT
__device__ __forceinline__ void conv4_row(const f32x4 (&v)[8], const bool isv, unsigned char* drow, int lane) {
    float am = 0.f;
#pragma unroll
    for (int i = 0; i < 8; ++i) am = fmaxf(am, fmaxf(fmaxf(fabsf(v[i].x), fabsf(v[i].y)), fmaxf(fabsf(v[i].z), fabsf(v[i].w))));
    const float s0 = am > 0.f ? am * (isv ? (1.f / 6.f) : (1.f / 7.f)) : 1.f;
    const unsigned sb = (__float_as_uint(s0) + 0xffffu) >> 16;
    const float inv = 1.f / __uint_as_float(sb << 16);
    u32x4 o; unsigned w[4];
#pragma unroll
    for (int d = 0; d < 4; ++d) {
        const f32x4 a = v[2 * d], b = v[2 * d + 1];
        const float e[8] = {a.x * inv, a.y * inv, a.z * inv, a.w * inv, b.x * inv, b.y * inv, b.z * inv, b.w * inv};
        unsigned acc = 0u;
        if (isv) {
            acc = __builtin_amdgcn_cvt_scalef32_pk_fp4_f32(acc, e[0], e[1], 1.0f, 0);
            acc = __builtin_amdgcn_cvt_scalef32_pk_fp4_f32(acc, e[2], e[3], 1.0f, 1);
            acc = __builtin_amdgcn_cvt_scalef32_pk_fp4_f32(acc, e[4], e[5], 1.0f, 2);
            acc = __builtin_amdgcn_cvt_scalef32_pk_fp4_f32(acc, e[6], e[7], 1.0f, 3);
        } else {
#pragma unroll
            for (int i = 0; i < 8; ++i) {
                const int q = (int)fminf(fmaxf(rintf(e[i]), -7.f), 7.f);
                acc |= ((unsigned)q & 0xFu) << (8 * (i >> 1) + 4 * (i & 1));
            }
        }
        w[d] = acc;
    }
    o.x = w[0]; o.y = w[1]; o.z = w[2]; o.w = w[3];
    *(u32x4*)(drow + lane * 16) = o;
    *(unsigned short*)(drow + 1024 + lane * 2) = (unsigned short)sb;
}
#endif
#if GATHER_I8 && GATHER_4BIT
#ifndef TABLES_IN_GAPS
#define TABLES_IN_GAPS 1
#endif
__device__ __forceinline__ void conv4_tables(const Params& p, int r0, int r1, unsigned* ctr, unsigned char* lds) {
    const int tid = threadIdx.x, lane = tid & 63, wave = tid >> 6;
    unsigned char* ws = p.ws;
    volatile unsigned* shw = (volatile unsigned*)(lds + LDS_BYTES - 64);
    const int nchunk = (r1 - r0) / 64;
    for (int it = 0;; ++it) {
        int cbeg, cstep, cend;
        if (ctr) {
            __syncthreads();
            if (tid == 0) *shw = atomicAdd(ctr, 1u);
            __syncthreads();
            const int c = (int)*shw; if (c >= nchunk) break;
            cbeg = r0 + c * 64 + wave; cstep = NWAVES; cend = r0 + c * 64 + 64;
        } else {
            if (it > 0) break;
            cbeg = r0 + blockIdx.x * NWAVES + wave; cstep = gridDim.x * NWAVES; cend = r1;
        }
        for (int r = cbeg; r < cend; r += 2 * cstep) {
            const int r2 = r + cstep; const bool has2 = r2 < cend; const int rb = has2 ? r2 : r;
            const bool isvA = r >= 2 * NEXP, isvB = rb >= 2 * NEXP; const int rrA = isvA ? r - 2 * NEXP : r, rrB = isvB ? rb - 2 * NEXP : rb;
            const float* srowA = (isvA ? p.peer_v : p.peer_u) + (size_t)rrA * DM;
            const float* srowB = (isvB ? p.peer_v : p.peer_u) + (size_t)rrB * DM;
            f32x4 va[8], vb[8];
#pragma unroll
            for (int j = 0; j < 2; ++j)
#pragma unroll
                for (int k = 0; k < 4; ++k) { va[j * 4 + k] = *(const f32x4*)(srowA + j * 1024 + lane * 16 + k * 4); vb[j * 4 + k] = *(const f32x4*)(srowB + j * 1024 + lane * 16 + k * 4); }
            conv4_row(va, isvA, (unsigned char*)(ws + (isvA ? WS_VT : WS_UT)) + (size_t)rrA * ROW4, lane);
            if (has2) conv4_row(vb, isvB, (unsigned char*)(ws + (isvB ? WS_VT : WS_UT)) + (size_t)rrB * ROW4, lane);
        }
    }
}
#endif
__device__ __forceinline__ void ph_prologue(const Params& p, unsigned char* lds) {
    const int tid = threadIdx.x, lane = tid & 63, wave = tid >> 6;
    const int gw = blockIdx.x * NWAVES + wave, NGW = gridDim.x * NWAVES;
    unsigned char* ws = p.ws;
    {
        float* sT = (float*)lds;
        float* red = (float*)(lds + 2048 * 12 * 4);
        for (int i = tid; i < 2048 * 9; i += NTHREADS) {
            const int k = i / 9, bb = i % 9;
            const float v = bb < 8 ? p.c[bb * DM + k] : p.c_ctx[k];
            sT[k * 12 + bb] = silu(v);
        }
        __syncthreads();
        const int cq = lane & 7, ks = tid >> 3;
        for (int u = blockIdx.x; u < 768; u += gridDim.x) {
            const int l = u / 384, n0 = (u % 384) * 32;
            const float* W = p.w_ada + (size_t)l * DM * 12288 + n0 + cq * 4;
            float acc[9][4];
#pragma unroll
            for (int b = 0; b < 9; ++b)
#pragma unroll
                for (int j = 0; j < 4; ++j) acc[b][j] = 0.f;
#pragma unroll 8
            for (int i = 0; i < 32; ++i) {
                const int k = ks + 64 * i;
                const f32x4 w = *(const f32x4*)(W + (size_t)k * 12288);
                const f32x4 s0 = *(const f32x4*)(sT + k * 12), s1 = *(const f32x4*)(sT + k * 12 + 4);
                const float s8 = sT[k * 12 + 8];
                const float sv[9] = {s0.x, s0.y, s0.z, s0.w, s1.x, s1.y, s1.z, s1.w, s8};
#pragma unroll
                for (int b = 0; b < 9; ++b) { acc[b][0] += sv[b] * w.x; acc[b][1] += sv[b] * w.y; acc[b][2] += sv[b] * w.z; acc[b][3] += sv[b] * w.w; }
            }
#pragma unroll
            for (int b = 0; b < 9; ++b)
#pragma unroll
                for (int j = 0; j < 4; ++j) {
                    float v = acc[b][j];
                    v += __shfl_xor(v, 8); v += __shfl_xor(v, 16); v += __shfl_xor(v, 32);
                    acc[b][j] = v;
                }
            if (lane < 8) {
#pragma unroll
                for (int b = 0; b < 9; ++b)
#pragma unroll
                    for (int j = 0; j < 4; ++j) red[(wave * 8 + cq) * 36 + b * 4 + j] = acc[b][j];
            }
            __syncthreads();
            if (tid < 288) {
                const int b = tid / 32, col = tid % 32, q = col >> 2, j = col & 3;
                float s = 0.f;
#pragma unroll
                for (int w = 0; w < 8; ++w) s += red[(w * 8 + q) * 36 + b * 4 + j];
                const int n = n0 + col;
                ((float*)(ws + WS_MOD))[(size_t)(l * 9 + b) * 12288 + n] = s + p.b_ada[l * 12288 + n];
            }
            __syncthreads();
        }
    }
    __syncthreads();
    {
        float* scr = (float*)(lds + wave * 8704);
        constexpr int I_IN = 32 * 112, I_SQ = 32 * 64, I_L = I_IN + 2 * I_SQ;
        unsigned* cm = (unsigned*)(ws + WS_CTL + CTL_COLMAX);
        for (int it = gw; it < 2 * I_L; it += NGW) {
            const int l = it / I_L; int r = it % I_L;
            if (r < I_IN) {
                if (GEMM_I8) colmax_item(p.w_in + (size_t)l * DM * INW, INW, nullptr, cm + l * (INW + DM), r, lane);
                else transpose_item(p.w_in + (size_t)l * DM * INW, DM, INW, (bf16_t*)(ws + WS_WIN) + (size_t)l * INW * DM, nullptr, scr, r, lane);
                continue; }
            r -= I_IN;
            if (r < I_SQ) {
                if (GEMM_I8) colmax_item(p.w_out + (size_t)l * DM * DM, DM, p.g_group + l * DM, cm + l * (INW + DM) + INW, r, lane);
                else transpose_item(p.w_out + (size_t)l * DM * DM, DM, DM, (bf16_t*)(ws + WS_WOUT) + (size_t)l * DM * DM, p.g_group + l * DM, scr, r, lane);
                continue; }
            r -= I_SQ;
            transpose_item(p.peer_wq + (size_t)l * DM * DM, DM, DM, (bf16_t*)(ws + WS_WQ) + (size_t)l * DM * DM, nullptr, scr, r, lane);
        }
    }
    {
        const size_t gtid = (size_t)blockIdx.x * NTHREADS + tid, gth = (size_t)gridDim.x * NTHREADS;
        cvt_range(p.peer_keys, (bf16_t*)(ws + WS_KEYS), (size_t)2 * 8 * 2 * 128 * 128 / 8, gtid, gth);
        cvt_range(p.ws_c, (bf16_t*)(ws + WS_WSC), (size_t)2 * 4 * 128 * 128 / 8, gtid, gth);
#if GATHER_I8 && GATHER_4BIT
        if (!TABLES_IN_GAPS) conv4_tables(p, 0, 4 * NEXP, nullptr, lds);
#elif GATHER_I8
        for (int r = gw; r < 4 * NEXP; r += NGW) {
            const bool isv = r >= 2 * NEXP; const int rr = isv ? r - 2 * NEXP : r;
            const float* srow = (isv ? p.peer_v : p.peer_u) + (size_t)rr * DM;
            f32x4 v[8]; float am = 0.f;
#pragma unroll
            for (int j = 0; j < 2; ++j)
#pragma unroll
                for (int k = 0; k < 4; ++k) {
                    v[j * 4 + k] = *(const f32x4*)(srow + j * 1024 + lane * 16 + k * 4);
                    am = fmaxf(am, fmaxf(fmaxf(fabsf(v[j * 4 + k].x), fabsf(v[j * 4 + k].y)), fmaxf(fabsf(v[j * 4 + k].z), fabsf(v[j * 4 + k].w))));
                }
            am = wave_max(am);
            const float s = am > 0.f ? am * (isv ? (1.f / 443.f) : (1.f / 127.f)) : 1.f, inv = 1.f / s;
            unsigned char* drow = (unsigned char*)(ws + (isv ? WS_VT : WS_UT)) + (size_t)rr * DM;
#pragma unroll
            for (int j = 0; j < 2; ++j) {
                u32x4 o; unsigned w[4];
#pragma unroll
                for (int k = 0; k < 4; ++k) {
                    const f32x4 a = v[j * 4 + k];
                    if (isv) {
                        int pk = __builtin_amdgcn_cvt_pk_fp8_f32(a.x * inv, a.y * inv, 0, false);
                        pk = __builtin_amdgcn_cvt_pk_fp8_f32(a.z * inv, a.w * inv, pk, true);
                        w[k] = (unsigned)pk;
                    } else {
                        const int q0 = (int)rintf(a.x * inv), q1 = (int)rintf(a.y * inv), q2 = (int)rintf(a.z * inv), q3 = (int)rintf(a.w * inv);
                        w[k] = ((unsigned)q0 & 0xffu) | (((unsigned)q1 & 0xffu) << 8) | (((unsigned)q2 & 0xffu) << 16) | ((unsigned)q3 << 24);
                    }
                }
                o.x = w[0]; o.y = w[1]; o.z = w[2]; o.w = w[3];
                *(u32x4*)(drow + j * 1024 + lane * 16) = o;
            }
            if (lane == 0) ((float*)(ws + (isv ? WS_VSC : WS_USC)))[rr] = s;
        }
#else
        cvt_range(p.peer_u, (bf16_t*)(ws + WS_UT), (size_t)2 * NEXP * DM / 8, gtid, gth);
        cvt_range(p.peer_v, (bf16_t*)(ws + WS_VT), (size_t)2 * NEXP * DM / 8, gtid, gth);
#endif
        float* rope = (float*)(ws + WS_ROPE);
        for (size_t i = gtid; i < (size_t)2048 * 64; i += gth) {
            const int t = (int)(i >> 6), f = (int)(i & 63), fi = f & 31;
            const float pos = (f < 32) ? (float)(t >> 6) : (float)(t & 63);
            const float inv = powf(10000.0f, -(float)fi / 32.0f);
            const float ang = pos * inv;
            rope[i * 2] = cosf(ang); rope[i * 2 + 1] = sinf(ang);
        }
    }
}


__device__ __forceinline__ unsigned q8pack4(float a, float b, float c, float d, float inv) {
    const int q0 = (int)rintf(a * inv), q1 = (int)rintf(b * inv), q2 = (int)rintf(c * inv), q3 = (int)rintf(d * inv);
    return ((unsigned)q0 & 0xffu) | (((unsigned)q1 & 0xffu) << 8) | (((unsigned)q2 & 0xffu) << 16) | ((unsigned)q3 << 24);
}
__device__ __forceinline__ void modulate_store(const f32x4 (&v)[8], float rstd, const float* g, const float* shift, const float* scale, bf16_t* dst, int lane) {
#pragma unroll
    for (int j = 0; j < 8; ++j) {
        const int col = j * 256 + lane * 4;
        const f32x4 gg = *(const f32x4*)(g + col), sc = *(const f32x4*)(scale + col), sh = *(const f32x4*)(shift + col);
        const f32x4 o = v[j] * rstd * gg * (1.f + sc) + sh;
        u32x2 w; w.x = pk2(o.x, o.y); w.y = pk2(o.z, o.w);
        *(u32x2*)(dst + col) = w;
    }
}
__device__ __forceinline__ void modulate_store_i8(const f32x4 (&v)[8], float rstd, const float* g, const float* shift, const float* scale, unsigned char* dst, float* sdst, int lane) {
    f32x4 o[8]; float am = 0.f;
#pragma unroll
    for (int j = 0; j < 8; ++j) {
        const int col = j * 256 + lane * 4;
        const f32x4 gg = *(const f32x4*)(g + col), sc = *(const f32x4*)(scale + col), sh = *(const f32x4*)(shift + col);
        o[j] = v[j] * rstd * gg * (1.f + sc) + sh;
        am = fmaxf(am, fmaxf(fmaxf(fabsf(o[j].x), fabsf(o[j].y)), fmaxf(fabsf(o[j].z), fabsf(o[j].w))));
    }
    am = wave_max(am);
    const float s = am > 0.f ? am * (1.f / 127.f) : 1.f, inv = 1.f / s;
#pragma unroll
    for (int j = 0; j < 8; ++j) *(unsigned*)(dst + j * 256 + lane * 4) = q8pack4(o[j].x, o[j].y, o[j].z, o[j].w, inv);
    if (lane == 0) *sdst = s;
}
__device__ __forceinline__ void ph_modulate(const Params& p, int l, int which) {
    const int tid = threadIdx.x, lane = tid & 63, wave = tid >> 6;
    const int gw = blockIdx.x * NWAVES + wave, NGW = gridDim.x * NWAVES;
    const int nrows = (which == 1 && l == DEPTH - 1) ? NLAT : MTOT;
    const float* g = (which == 0 ? p.norm1_g : p.norm2_g) + l * DM;
    const float* mod = (const float*)(p.ws + WS_MOD) + (size_t)l * 9 * 12288;
    const float* srcLat = (which == 0 && l == 0) ? p.x : p.out;
    const float* srcCtx = (which == 0 && l == 0) ? p.ctx : (const float*)(p.ws + WS_HC);
    bf16_t* XN = (bf16_t*)(p.ws + WS_XN);
    const int moff = (which == 0 ? 0 : 3) * DM;
#pragma unroll 1
    for (int r = gw; r < nrows; r += 2 * NGW) {
        const int r2 = r + NGW; const bool has2 = r2 < nrows; const int rb = has2 ? r2 : r;
        const float* srcA = r < NLAT ? srcLat + (size_t)r * DM : srcCtx + (size_t)(r - NLAT) * DM;
        const float* srcB = rb < NLAT ? srcLat + (size_t)rb * DM : srcCtx + (size_t)(rb - NLAT) * DM;
        f32x4 va[8], vb[8]; float sa = 0.f, sb = 0.f;
#pragma unroll
        for (int j = 0; j < 8; ++j) { va[j] = *(const f32x4*)(srcA + j * 256 + lane * 4); vb[j] = *(const f32x4*)(srcB + j * 256 + lane * 4); }
#pragma unroll
        for (int j = 0; j < 8; ++j) { sa += va[j].x * va[j].x + va[j].y * va[j].y + va[j].z * va[j].z + va[j].w * va[j].w; sb += vb[j].x * vb[j].x + vb[j].y * vb[j].y + vb[j].z * vb[j].z + vb[j].w * vb[j].w; }
        sa = wave_sum(sa); sb = wave_sum(sb);
        const float* shA = mod + (size_t)(r < NLAT ? (r >> 11) : 8) * 12288 + moff;
        const bool i8 = GEMM_I8 && which == 0;
        unsigned char* XN8 = (unsigned char*)(p.ws + WS_XN8); float* SXN = (float*)(p.ws + WS_SCL) + SCL_XN;
        if (i8) modulate_store_i8(va, rsqrtf(sa * (1.f / DM) + EPS), g, shA, shA + DM, XN8 + (size_t)r * DM, SXN + r, lane);
        else modulate_store(va, rsqrtf(sa * (1.f / DM) + EPS), g, shA, shA + DM, XN + (size_t)r * DM, lane);
        if (has2) {
            const float* shB = mod + (size_t)(r2 < NLAT ? (r2 >> 11) : 8) * 12288 + moff;
            if (i8) modulate_store_i8(vb, rsqrtf(sb * (1.f / DM) + EPS), g, shB, shB + DM, XN8 + (size_t)r2 * DM, SXN + r2, lane);
            else modulate_store(vb, rsqrtf(sb * (1.f / DM) + EPS), g, shB, shB + DM, XN + (size_t)r2 * DM, lane);
        }
    }
}

struct EpiBf16Store {
    bf16_t* O; int ldc;
    __device__ __forceinline__ void operator()(int row, int col, const float* a) const {
        u32x4 w; w.x = pk2(a[0], a[1]); w.y = pk2(a[2], a[3]); w.z = pk2(a[4], a[5]); w.w = pk2(a[6], a[7]);
        *(u32x4*)(O + (size_t)row * ldc + col) = w;
    }
};
struct EpiResGate {
    const float *resLat, *resCtx; float *outLat, *outCtx; const float* gate;
    __device__ __forceinline__ void operator()(int row, int col, const float* a) const {
        const int bb = row < NLAT ? (row >> 11) : 8;
        const float* gp = gate + (size_t)bb * 12288 + col;
        const float* rp = row < NLAT ? resLat + (size_t)row * DM + col : resCtx + (size_t)(row - NLAT) * DM + col;
        float* op = row < NLAT ? outLat + (size_t)row * DM + col : outCtx + (size_t)(row - NLAT) * DM + col;
        const f32x4 g0 = *(const f32x4*)gp, g1 = *(const f32x4*)(gp + 4), r0 = *(const f32x4*)rp, r1 = *(const f32x4*)(rp + 4);
        f32x4 o0, o1;
        o0.x = r0.x + g0.x * a[0]; o0.y = r0.y + g0.y * a[1]; o0.z = r0.z + g0.z * a[2]; o0.w = r0.w + g0.w * a[3];
        o1.x = r1.x + g1.x * a[4]; o1.y = r1.y + g1.y * a[5]; o1.z = r1.z + g1.z * a[6]; o1.w = r1.w + g1.w * a[7];
        *(f32x4*)op = o0; *(f32x4*)(op + 4) = o1;
    }
};
template <class Epi>
__device__ __forceinline__ void gemm_naive(unsigned char* lds, const bf16_t* A, const bf16_t* Bt, int M, int N, int K, const Epi& E) {
    float* As = (float*)lds;
    float* Bs = As + 32 * 132;
    const int tid = threadIdx.x, tx = tid & 15, ty = tid >> 4;
    const int lrow = tid >> 2, lkc = (tid & 3) * 8;
    const int nM = M / 128, nN = N / 128;
    for (int u = blockIdx.x; u < nM * nN; u += gridDim.x) {
        const int pm = u / nN, pn = u % nN, m0 = pm * 128, n0 = pn * 128;
        float acc[4][8];
#pragma unroll
        for (int i = 0; i < 4; ++i)
#pragma unroll
            for (int j = 0; j < 8; ++j) acc[i][j] = 0.f;
        for (int k0 = 0; k0 < K; k0 += 32) {
            const u32x4 av = *(const u32x4*)(A + (size_t)(m0 + lrow) * K + k0 + lkc);
            const u32x4 bv = *(const u32x4*)(Bt + (size_t)(n0 + lrow) * K + k0 + lkc);
            __syncthreads();
            As[(lkc + 0) * 132 + lrow] = bflo(av.x); As[(lkc + 1) * 132 + lrow] = bfhi(av.x);
            As[(lkc + 2) * 132 + lrow] = bflo(av.y); As[(lkc + 3) * 132 + lrow] = bfhi(av.y);
            As[(lkc + 4) * 132 + lrow] = bflo(av.z); As[(lkc + 5) * 132 + lrow] = bfhi(av.z);
            As[(lkc + 6) * 132 + lrow] = bflo(av.w); As[(lkc + 7) * 132 + lrow] = bfhi(av.w);
            Bs[(lkc + 0) * 132 + lrow] = bflo(bv.x); Bs[(lkc + 1) * 132 + lrow] = bfhi(bv.x);
            Bs[(lkc + 2) * 132 + lrow] = bflo(bv.y); Bs[(lkc + 3) * 132 + lrow] = bfhi(bv.y);
            Bs[(lkc + 4) * 132 + lrow] = bflo(bv.z); Bs[(lkc + 5) * 132 + lrow] = bfhi(bv.z);
            Bs[(lkc + 6) * 132 + lrow] = bflo(bv.w); Bs[(lkc + 7) * 132 + lrow] = bfhi(bv.w);
            __syncthreads();
#pragma unroll 8
            for (int k = 0; k < 32; ++k) {
                const f32x4 a = *(const f32x4*)(As + k * 132 + ty * 4);
                const f32x4 b0 = *(const f32x4*)(Bs + k * 132 + tx * 8), b1 = *(const f32x4*)(Bs + k * 132 + tx * 8 + 4);
                const float av4[4] = {a.x, a.y, a.z, a.w};
                const float bv8[8] = {b0.x, b0.y, b0.z, b0.w, b1.x, b1.y, b1.z, b1.w};
#pragma unroll
                for (int i = 0; i < 4; ++i)
#pragma unroll
                    for (int j = 0; j < 8; ++j) acc[i][j] += av4[i] * bv8[j];
            }
        }
#pragma unroll
        for (int i = 0; i < 4; ++i) E(m0 + ty * 4 + i, n0 + tx * 8, acc[i]);
    }
}

namespace pg8 {
#define PG8_LAS __attribute__((address_space(3)))
typedef unsigned short bf16_t;
typedef short bf16x8 __attribute__((ext_vector_type(8)));
typedef float f32x4 __attribute__((ext_vector_type(4)));
typedef unsigned u32x4 __attribute__((ext_vector_type(4)));
constexpr int BM = 256, BK = 64, HALF = 128, HTB = HALF * BK * 2  , STAGE_BYTES = 8 * HTB, NXCD = 8, WGM = 8;

__host__ __device__ __forceinline__ int lds_byte(int r, int c) { const int st = (r >> 4) * 2 + (c >> 5), rr = r & 15, cc = c & 31, ob = rr * 64 + cc * 2; return st * 1024 + (ob ^ (((ob >> 9) & 1) << 5)); }
__host__ __device__ __forceinline__ void stage_rc(int b, int& R, int& C) { const int st = b / 1024, sb = b % 1024, swz = sb ^ (((sb >> 9) & 1) << 5); R = (st >> 1) * 16 + swz / 64; C = (st & 1) * 32 + (swz % 64) / 2; }
__host__ __device__ __forceinline__ int perm32(int rho) { const int n = rho >> 4, i = rho & 15; return 8 * (i >> 2) + 4 * n + (i & 3); }

struct Unit { int pm, pn; };
struct Gemm { const bf16_t* A; const bf16_t* Bt; int M, N, K; };

struct StaticOrder {
    int nM, nN, nwg, G, c;
    __host__ __device__ void init(int M, int N, int G_, int c_) { nM = M / BM; nN = N / BM; nwg = nM * nN; G = G_; c = c_; }
    __host__ __device__ bool next(int i, Unit& u) const {
        const long L = (long)i * G + c; if (L >= nwg) return false;
        int wgid = (int)L; { const int q = nwg / NXCD, r = nwg % NXCD, xcd = wgid % NXCD, off = wgid / NXCD; wgid = (xcd < r ? xcd * (q + 1) : r * (q + 1) + (xcd - r) * q) + off; }
        const int nig = WGM * nN, gid = wgid / nig, fm = gid * WGM, gsz = (nM - fm) < WGM ? (nM - fm) : WGM;
        u.pm = fm + ((wgid % nig) % gsz); u.pn = (wgid % nig) / gsz; return true;
    }
    __device__ __forceinline__ void a_ready(const Unit&) const {}
    __device__ __forceinline__ void done(const Unit&) const {}
};

__device__ __forceinline__ unsigned cvt_pk_bf16(float lo, float hi) { unsigned r; asm volatile("v_cvt_pk_bf16_f32 %0, %1, %2" : "=v"(r) : "v"(lo), "v"(hi)); return r; }
typedef float f32x2 __attribute__((ext_vector_type(2)));
__device__ __forceinline__ f32x2 gelu_pk(f32x2 v) {
    const f32x2 av = __builtin_elementwise_abs(v), d = av * 0.2316418882f + 1.0f;
    f32x2 t; t.x = __builtin_amdgcn_rcpf(d.x); t.y = __builtin_amdgcn_rcpf(d.y);
    f32x2 q = t * 0.5307027145f + (-0.7265760135f); q = q * t + 0.7107068705f; q = q * t + (-0.142248368f); q = q * t + 0.127414796f; q = q * t;
    const f32x2 s = (v * v) * (-0.72134752044f);
    f32x2 e; e.x = __builtin_amdgcn_exp2f(s.x); e.y = __builtin_amdgcn_exp2f(s.y);
    const f32x2 m = v * (q * e), r = v - m;
    f32x2 o; o.x = v.x < 0.f ? m.x : r.x; o.y = v.y < 0.f ? m.y : r.y; return o;
}

template <int ACT  > struct EpiBf16 {
    static constexpr bool PERM = true, AFTER_DRAIN = false; static_assert(ACT == 0 || ACT == 1, "EpiBf16: ACT is 0 (none) or 1 (gelu_pk)");
    bf16_t* O; int ldc; const float* bias; int split_cols; size_t split_stride; float scale0;
    __device__ __forceinline__ void operator()(const f32x4 (&acc)[2][2][4][2], const Unit& u, int wr, int wc, int fr, int fq) const {
        const int row0 = u.pm * BM + wr * 64 + fr; int colt = u.pn * BM; bf16_t* base = O;
        float sc = 1.f; if (split_cols) { const int t = colt / split_cols; base += (size_t)t * split_stride; colt -= t * split_cols; if (t == 0) sc = scale0; }
        const int col0 = colt + wc * 32 + 8 * fq, bcol0 = u.pn * BM + wc * 32 + 8 * fq;
        f32x4 bv[2][2];
#pragma unroll
        for (int bj = 0; bj < 2; ++bj)
#pragma unroll
            for (int n = 0; n < 2; ++n) bv[bj][n] = bias ? *(const f32x4*)(bias + bcol0 + bj * HALF + 4 * n) : (f32x4){0.f, 0.f, 0.f, 0.f};
#pragma unroll
        for (int ai = 0; ai < 2; ++ai)
#pragma unroll
            for (int m = 0; m < 4; ++m) { bf16_t* rowp = base + (size_t)(row0 + ai * HALF + m * 16) * ldc + col0;
#pragma unroll
                for (int bj = 0; bj < 2; ++bj) { f32x4 v0 = acc[ai][bj][m][0] + bv[bj][0], v1 = acc[ai][bj][m][1] + bv[bj][1];
                    if (ACT == 1) { f32x2 a = gelu_pk((f32x2){v0[0], v0[1]}), b = gelu_pk((f32x2){v0[2], v0[3]}), c = gelu_pk((f32x2){v1[0], v1[1]}), d = gelu_pk((f32x2){v1[2], v1[3]});
                        v0 = (f32x4){a.x, a.y, b.x, b.y}; v1 = (f32x4){c.x, c.y, d.x, d.y}; }
                    v0 = v0 * sc; v1 = v1 * sc; u32x4 w; w.x = cvt_pk_bf16(v0[0], v0[1]); w.y = cvt_pk_bf16(v0[2], v0[3]); w.z = cvt_pk_bf16(v1[0], v1[1]); w.w = cvt_pk_bf16(v1[2], v1[3]);
                    *(u32x4*)(rowp + bj * HALF) = w; } }
    }
};
typedef int i32x4 __attribute__((ext_vector_type(4)));
template <bool I8> struct AccSel { typedef f32x4 type; };
template <> struct AccSel<true> { typedef i32x4 type; };
template <class Epi, class Sched, bool ALIGN_EPI = false, bool SP2 = false, bool I8 = false>
__device__ __forceinline__ void gemm_phase(PG8_LAS unsigned char* lds, const Gemm g, const Sched& S, const Epi& E) {
    const int tid = threadIdx.x, wid = __builtin_amdgcn_readfirstlane(tid >> 6), lane = tid & 63, wr = wid >> 2, wc = wid & 3, fr = lane & 15, fq = lane >> 4;
    const int K = g.K, nt = K / BK;
    unsigned voffA[2], voffB[2];
#pragma unroll
    for (int i = 0; i < 2; ++i) { int R, C; stage_rc(tid * 16 + i * 8192, R, C); const int Rb = Epi::PERM ? ((R & ~31) + perm32(R & 31)) : R;
        voffA[i] = (unsigned)(R * K + C) * 2u; voffB[i] = (unsigned)(Rb * K + C) * 2u; }
    const size_t kstep = (size_t)(BK * 2);
    const size_t hstep = (size_t)HALF * K * 2;
    const size_t tstep = 2 * hstep;
    const unsigned ldsw = (unsigned)wid * 1024u;
    const int aoff = lds_byte(wr * 64 + fr, fq * 8), boff = lds_byte(wc * 32 + fr, fq * 8);
#define PG8_SA(b, h) (((b) * 2 + (h)) * HTB)
#define PG8_SB(b, h) ((4 + (b) * 2 + (h)) * HTB)
#define PG8_STAGE(bufoff, gbase, voff) do { _Pragma("unroll") for (int _i = 0; _i < 2; ++_i) \
        __builtin_amdgcn_global_load_lds((const unsigned*)((const char*)(gbase) + (voff)[_i]), (PG8_LAS unsigned*)(lds + (bufoff) + ldsw + _i * 8192), 16, 0, 0); } while (0)
#define PG8_LDA(dst, b, h) do { _Pragma("unroll") for (int m = 0; m < 4; ++m) _Pragma("unroll") for (int k = 0; k < 2; ++k) dst[m][k] = *(const PG8_LAS bf16x8*)(lds + PG8_SA(b, h) + aoff + m * 2048 + k * 1024); } while (0)
#define PG8_LDB(dst, b, h) do { _Pragma("unroll") for (int n = 0; n < 2; ++n) _Pragma("unroll") for (int k = 0; k < 2; ++k) dst[n][k] = *(const PG8_LAS bf16x8*)(lds + PG8_SB(b, h) + boff + n * 2048 + k * 1024); } while (0)
#define PG8_MMA(ai, bj, At, Bt) do { __builtin_amdgcn_s_setprio(1); _Pragma("unroll") for (int m = 0; m < 4; ++m) _Pragma("unroll") for (int n = 0; n < 2; ++n) _Pragma("unroll") for (int k = 0; k < 2; ++k) \
        { if constexpr (I8) acc[ai][bj][m][n] = __builtin_amdgcn_mfma_i32_16x16x64_i8(__builtin_bit_cast(i32x4, Bt[n][k]), __builtin_bit_cast(i32x4, At[m][k]), acc[ai][bj][m][n], 0, 0, 0); \
          else acc[ai][bj][m][n] = __builtin_amdgcn_mfma_f32_16x16x32_bf16(Bt[n][k], At[m][k], acc[ai][bj][m][n], 0, 0, 0); } __builtin_amdgcn_s_setprio(0); } while (0)
#define PG8_WAIT_V(n) asm volatile("s_waitcnt vmcnt(" #n ")" ::: "memory")
#define PG8_WAIT_L(n) asm volatile("s_waitcnt lgkmcnt(" #n ")" ::: "memory")
#define PG8_BAR __builtin_amdgcn_s_barrier()
#define PG8_SCHED __builtin_amdgcn_sched_barrier(0)
    Unit cur, nxt; int ui = 0;
    if (!S.next(0, cur)) return;
    typedef typename AccSel<I8>::type acc_t; const acc_t zero_ = {};
    acc_t acc[2][2][4][2];
#pragma unroll
    for (int a = 0; a < 2; ++a)
#pragma unroll
        for (int b = 0; b < 2; ++b)
#pragma unroll
            for (int m = 0; m < 4; ++m)
#pragma unroll
                for (int n = 0; n < 2; ++n) acc[a][b][m][n] = zero_;
    bf16x8 At[4][2], B0[2][2], B1[2][2];
    const char* cA = (const char*)g.A + (size_t)cur.pm * tstep; const char* cB = (const char*)g.Bt + (size_t)cur.pn * tstep;
    S.a_ready(cur);
    if constexpr (SP2) {
        PG8_STAGE(PG8_SB(0, 0), cB, voffB); PG8_STAGE(PG8_SB(0, 1), cB + hstep, voffB); PG8_STAGE(PG8_SA(0, 0), cA, voffA); PG8_STAGE(PG8_SA(0, 1), cA + hstep, voffA);
        if (wr == 1) PG8_BAR;
        PG8_WAIT_V(2); PG8_BAR;
        PG8_STAGE(PG8_SB(1, 0), cB + kstep, voffB); PG8_STAGE(PG8_SA(1, 0), cA + kstep, voffA); PG8_STAGE(PG8_SB(1, 1), cB + hstep + kstep, voffB);
        PG8_WAIT_V(6); PG8_BAR;
    } else {
        PG8_STAGE(PG8_SB(0, 0), cB, voffB); PG8_STAGE(PG8_SA(0, 0), cA, voffA); PG8_STAGE(PG8_SB(0, 1), cB + hstep, voffB); PG8_STAGE(PG8_SA(0, 1), cA + hstep, voffA);
        if (wr == 1) PG8_BAR;
        PG8_WAIT_V(4); PG8_BAR;
        PG8_STAGE(PG8_SB(1, 0), cB + kstep, voffB); PG8_STAGE(PG8_SA(1, 0), cA + kstep, voffA); PG8_STAGE(PG8_SB(1, 1), cB + hstep + kstep, voffB);
        PG8_WAIT_V(6); PG8_BAR;
    }
    for (;;) {
        const bool has_next = S.next(ui + 1, nxt);
        const char* nA = has_next ? (const char*)g.A + (size_t)nxt.pm * tstep : cA; const char* nB = has_next ? (const char*)g.Bt + (size_t)nxt.pn * tstep : cB;
        for (int t = 0; t < nt; t += 2) {
            const bool last = (t == nt - 2);
            const char* a1 = cA + (size_t)(t + 1) * kstep;
            const char* a2 = last ? nA : cA + (size_t)(t + 2) * kstep; const char* b2 = last ? nB : cB + (size_t)(t + 2) * kstep;
            const char* a3 = a2 + kstep; const char* b3 = b2 + kstep;
            if (last && has_next) S.a_ready(nxt);
            if constexpr (SP2) {
            PG8_LDB(B0, 0, 0); PG8_LDB(B1, 0, 1); PG8_SCHED; PG8_LDA(At, 0, 0); PG8_STAGE(PG8_SA(1, 1), a1 + hstep, voffA);
            PG8_WAIT_V(8); PG8_WAIT_L(0); PG8_BAR; PG8_MMA(0, 0, At, B0); PG8_MMA(0, 1, At, B1); PG8_BAR; PG8_SCHED;
            PG8_LDA(At, 0, 1); PG8_STAGE(PG8_SB(0, 0), b2, voffB); PG8_STAGE(PG8_SB(0, 1), b2 + hstep, voffB); PG8_STAGE(PG8_SA(0, 0), a2, voffA);
            PG8_WAIT_V(8); PG8_WAIT_L(0); PG8_BAR; PG8_MMA(1, 0, At, B0); PG8_MMA(1, 1, At, B1); PG8_BAR; PG8_SCHED;
            PG8_LDB(B0, 1, 0); PG8_LDB(B1, 1, 1); PG8_SCHED; PG8_LDA(At, 1, 0); PG8_STAGE(PG8_SA(0, 1), a2 + hstep, voffA);
            PG8_WAIT_V(8); PG8_WAIT_L(0); PG8_BAR; PG8_MMA(0, 0, At, B0); PG8_MMA(0, 1, At, B1); PG8_BAR; PG8_SCHED;
            PG8_LDA(At, 1, 1); PG8_STAGE(PG8_SB(1, 0), b3, voffB); PG8_STAGE(PG8_SB(1, 1), b3 + hstep, voffB); PG8_STAGE(PG8_SA(1, 0), a3, voffA);
            PG8_WAIT_V(8); PG8_WAIT_L(0); PG8_BAR; PG8_MMA(1, 0, At, B0); PG8_MMA(1, 1, At, B1); PG8_BAR; PG8_SCHED;
            } else {
            PG8_LDB(B0, 0, 0); PG8_SCHED; PG8_LDA(At, 0, 0); PG8_STAGE(PG8_SA(1, 1), a1 + hstep, voffA);
            PG8_WAIT_L(8); PG8_BAR; PG8_WAIT_L(0); PG8_MMA(0, 0, At, B0); PG8_BAR; PG8_SCHED;
            PG8_LDB(B1, 0, 1); PG8_STAGE(PG8_SB(0, 0), b2, voffB);
            PG8_BAR; PG8_WAIT_L(0); PG8_MMA(0, 1, At, B1); PG8_BAR;
            PG8_LDA(At, 0, 1); PG8_STAGE(PG8_SA(0, 0), a2, voffA);
            PG8_BAR; PG8_WAIT_L(0); PG8_MMA(1, 0, At, B0); PG8_BAR; PG8_SCHED;
            PG8_STAGE(PG8_SB(0, 1), b2 + hstep, voffB);
            PG8_WAIT_V(6); PG8_BAR; PG8_MMA(1, 1, At, B1); PG8_BAR;
            PG8_LDB(B0, 1, 0); PG8_SCHED; PG8_LDA(At, 1, 0); PG8_STAGE(PG8_SA(0, 1), a2 + hstep, voffA);
            PG8_WAIT_L(8); PG8_BAR; PG8_WAIT_L(0); PG8_MMA(0, 0, At, B0); PG8_BAR; PG8_SCHED;
            PG8_LDB(B1, 1, 1); PG8_STAGE(PG8_SB(1, 0), b3, voffB);
            PG8_BAR; PG8_WAIT_L(0); PG8_MMA(0, 1, At, B1); PG8_BAR;
            PG8_LDA(At, 1, 1); PG8_STAGE(PG8_SA(1, 0), a3, voffA);
            PG8_BAR; PG8_WAIT_L(0); PG8_MMA(1, 0, At, B0); PG8_BAR; PG8_SCHED;
            PG8_STAGE(PG8_SB(1, 1), b3 + hstep, voffB);
            PG8_WAIT_V(6); PG8_BAR; PG8_MMA(1, 1, At, B1); PG8_BAR;
            }
        }
        if constexpr (ALIGN_EPI) { if (wr == 0) PG8_BAR; }
        if constexpr (!Epi::AFTER_DRAIN) { E(acc, cur, wr, wc, fr, fq); S.done(cur); }
        if (!has_next) break;
#pragma unroll
        for (int a = 0; a < 2; ++a)
#pragma unroll
            for (int b = 0; b < 2; ++b)
#pragma unroll
                for (int m = 0; m < 4; ++m)
#pragma unroll
                    for (int n = 0; n < 2; ++n) acc[a][b][m][n] = zero_;
        cur = nxt; cA = nA; cB = nB; ++ui;
        if constexpr (ALIGN_EPI) { if (wr == 1) PG8_BAR; }
    }
    PG8_WAIT_V(0);
    if constexpr (!ALIGN_EPI) { if (wr == 0) PG8_BAR; }
    PG8_BAR;
    if constexpr (Epi::AFTER_DRAIN) { E.fused(acc, cur, wr, wc, fr, fq, lds, wid, lane); S.done(cur); }
#undef PG8_SA
#undef PG8_SB
#undef PG8_STAGE
#undef PG8_LDA
#undef PG8_LDB
#undef PG8_MMA
#undef PG8_WAIT_V
#undef PG8_WAIT_L
#undef PG8_BAR
#undef PG8_SCHED
}

struct EpiResGateT {
    static constexpr bool PERM = false, AFTER_DRAIN = false;
    const float *resLat, *resCtx; float *outLat, *outCtx; const float* gate;
    __device__ __forceinline__ void operator()(const f32x4 (&acc)[2][2][4][2], const Unit& u, int wr, int wc, int fr, int fq) const {
        const int trow = u.pm * BM, row0 = trow + wr * 64 + fr, col0 = u.pn * BM + wc * 32 + 4 * fq;
        const bool lat = trow < 16384;
        const int bb = lat ? (trow >> 11) : 8;
        const float* rbase = lat ? resLat + (size_t)row0 * 2048 : resCtx + (size_t)(row0 - 16384) * 2048;
        float* obase = lat ? outLat + (size_t)row0 * 2048 : outCtx + (size_t)(row0 - 16384) * 2048;
        f32x4 gv[2][2];
#pragma unroll
        for (int bj = 0; bj < 2; ++bj)
#pragma unroll
            for (int n = 0; n < 2; ++n) gv[bj][n] = *(const f32x4*)(gate + (size_t)bb * 12288 + col0 + bj * HALF + n * 16);
#pragma unroll
        for (int ai = 0; ai < 2; ++ai)
#pragma unroll
            for (int m = 0; m < 4; ++m) {
                const size_t off = (size_t)(ai * HALF + m * 16) * 2048 + col0;
#pragma unroll
                for (int bj = 0; bj < 2; ++bj)
#pragma unroll
                    for (int n = 0; n < 2; ++n) {
                        const f32x4 r = *(const f32x4*)(rbase + off + bj * HALF + n * 16);
                        *(f32x4*)(obase + off + bj * HALF + n * 16) = r + gv[bj][n] * acc[ai][bj][m][n];
                    }
            }
    }
};

struct EpiBf16I8 {
    static constexpr bool PERM = true, AFTER_DRAIN = false;
    bf16_t* O; int ldc; const float* sa; const float* sb;
    __device__ __forceinline__ void operator()(const i32x4 (&acc)[2][2][4][2], const Unit& u, int wr, int wc, int fr, int fq) const {
        const int row0 = u.pm * BM + wr * 64 + fr, col0 = u.pn * BM + wc * 32 + 8 * fq;
        f32x4 sv[2][2];
#pragma unroll
        for (int bj = 0; bj < 2; ++bj)
#pragma unroll
            for (int n = 0; n < 2; ++n) sv[bj][n] = *(const f32x4*)(sb + col0 + bj * HALF + 4 * n);
#pragma unroll
        for (int ai = 0; ai < 2; ++ai)
#pragma unroll
            for (int m = 0; m < 4; ++m) {
                const int row = row0 + ai * HALF + m * 16; const float s = sa[row];
                bf16_t* rowp = O + (size_t)row * ldc + col0;
#pragma unroll
                for (int bj = 0; bj < 2; ++bj) {
                    const i32x4 a0 = acc[ai][bj][m][0], a1 = acc[ai][bj][m][1];
                    const f32x4 v0 = (f32x4){(float)a0.x, (float)a0.y, (float)a0.z, (float)a0.w} * s * sv[bj][0];
                    const f32x4 v1 = (f32x4){(float)a1.x, (float)a1.y, (float)a1.z, (float)a1.w} * s * sv[bj][1];
                    u32x4 w; w.x = cvt_pk_bf16(v0[0], v0[1]); w.y = cvt_pk_bf16(v0[2], v0[3]); w.z = cvt_pk_bf16(v1[0], v1[1]); w.w = cvt_pk_bf16(v1[2], v1[3]);
                    *(u32x4*)(rowp + bj * HALF) = w;
                }
            }
    }
};
struct EpiResGateI8 {
    static constexpr bool PERM = false, AFTER_DRAIN = false;
    const float *resLat, *resCtx; float *outLat, *outCtx; const float* gate; const float* sa; const float* sb;
    __device__ __forceinline__ void operator()(const i32x4 (&acc)[2][2][4][2], const Unit& u, int wr, int wc, int fr, int fq) const {
        const int trow = u.pm * BM, row0 = trow + wr * 64 + fr, col0 = u.pn * BM + wc * 32 + 4 * fq;
        const bool lat = trow < 16384;
        const int bb = lat ? (trow >> 11) : 8;
        const float* rbase = lat ? resLat + (size_t)row0 * 2048 : resCtx + (size_t)(row0 - 16384) * 2048;
        float* obase = lat ? outLat + (size_t)row0 * 2048 : outCtx + (size_t)(row0 - 16384) * 2048;
        f32x4 gv[2][2];
#pragma unroll
        for (int bj = 0; bj < 2; ++bj)
#pragma unroll
            for (int n = 0; n < 2; ++n) gv[bj][n] = *(const f32x4*)(gate + (size_t)bb * 12288 + col0 + bj * HALF + n * 16) * *(const f32x4*)(sb + col0 + bj * HALF + n * 16);
#pragma unroll
        for (int ai = 0; ai < 2; ++ai)
#pragma unroll
            for (int m = 0; m < 4; ++m) {
                const size_t off = (size_t)(ai * HALF + m * 16) * 2048 + col0;
                const float s = sa[row0 + ai * HALF + m * 16];
#pragma unroll
                for (int bj = 0; bj < 2; ++bj)
#pragma unroll
                    for (int n = 0; n < 2; ++n) {
                        const f32x4 r = *(const f32x4*)(rbase + off + bj * HALF + n * 16);
                        const i32x4 a = acc[ai][bj][m][n];
                        *(f32x4*)(obase + off + bj * HALF + n * 16) = r + gv[bj][n] * ((f32x4){(float)a.x, (float)a.y, (float)a.z, (float)a.w} * s);
                    }
            }
    }
};
}
#ifndef USE_PG8
#define USE_PG8 1
#endif

__device__ __forceinline__ float sum16(float v) { v += __shfl_xor(v, 1); v += __shfl_xor(v, 2); v += __shfl_xor(v, 4); v += __shfl_xor(v, 8); return v; }
__device__ __forceinline__ void ph_prep(const Params& p, int l, const bool dry) {
    const int tid = threadIdx.x, lane = tid & 63, wave = tid >> 6, sub = lane >> 4, li = lane & 15;
    const int gw = blockIdx.x * NWAVES + wave, NGW = gridDim.x * NWAVES;
    bf16_t* P = (bf16_t*)(p.ws + WS_P);
    const float* rope = (const float*)(p.ws + WS_ROPE);
    const bool last = (l == DEPTH - 1);
    const int f0 = (li >= 8 ? 32 : 0) + 8 * (li & 3);
    const float sg = (li & 4) ? 1.f : -1.f;
#pragma unroll 1
    for (int r = gw; r < MTOT; r += NGW) {
        bf16_t* row = P + (size_t)r * INW;
        bf16_t* wrow = dry ? (bf16_t*)(p.ws + WS_DUMMY) + (size_t)r * INW : row;
        const bool isctx = r >= NLAT;
        const int t = r & (SEQ - 1);
        float cs[8], sn[8];
        if (!isctx) {
            const f32x4* rp = (const f32x4*)(rope + ((size_t)t * 64 + f0) * 2);
            const f32x4 a = rp[0], b = rp[1], c = rp[2], d = rp[3];
            cs[0] = a.x; sn[0] = a.y; cs[1] = a.z; sn[1] = a.w; cs[2] = b.x; sn[2] = b.y; cs[3] = b.z; sn[3] = b.w;
            cs[4] = c.x; sn[4] = c.y; cs[5] = c.z; sn[5] = c.w; cs[6] = d.x; sn[6] = d.y; cs[7] = d.z; sn[7] = d.w;
        } else {
#pragma unroll
            for (int i = 0; i < 8; ++i) { cs[i] = 1.f; sn[i] = 0.f; }
        }
        u32x4 raw[7];
#pragma unroll
        for (int gI = 0; gI < 7; ++gI) raw[gI] = *(const u32x4*)(row + (gI * 4 + sub) * 128 + li * 8);
#pragma unroll
        for (int gI = 0; gI < 7; ++gI) {
            const int slot = gI * 4 + sub;
            const int kind = slot < 8 ? 0 : slot < 10 ? 1 : slot < 18 ? 0 : slot < 20 ? 1 : slot < 24 ? 2 : 3;
            const bool isq = slot < 6 || (slot >= 10 && slot < 16);
            float x[8];
            x[0] = bflo(raw[gI].x); x[1] = bfhi(raw[gI].x); x[2] = bflo(raw[gI].y); x[3] = bfhi(raw[gI].y);
            x[4] = bflo(raw[gI].z); x[5] = bfhi(raw[gI].z); x[6] = bflo(raw[gI].w); x[7] = bfhi(raw[gI].w);
            if (kind >= 2) {
#pragma unroll
                for (int i = 0; i < 8; ++i) x[i] = gelu_tanh(x[i]);
            }
            float ss = 0.f;
#pragma unroll
            for (int i = 0; i < 8; ++i) ss += x[i] * x[i];
            ss = sum16(ss);
            const float rstd = rsqrtf(ss * (1.f / 128.f) + EPS);
            const float* gain = slot < 6 ? p.qn_a + l * 128 : slot < 8 ? p.kn_a + l * 128 : slot < 16 ? p.qn_b + l * 128 : slot < 20 ? p.kn_b + l * 128 : p.vn_c + l * 512 + (slot - 24) * 128;
            if (kind == 0 || kind == 3) {
                const f32x4 g0 = *(const f32x4*)(gain + li * 8), g1 = *(const f32x4*)(gain + li * 8 + 4);
                x[0] *= rstd * g0.x; x[1] *= rstd * g0.y; x[2] *= rstd * g0.z; x[3] *= rstd * g0.w;
                x[4] *= rstd * g1.x; x[5] *= rstd * g1.y; x[6] *= rstd * g1.z; x[7] *= rstd * g1.w;
            }
            float px[8];
#pragma unroll
            for (int i = 0; i < 8; ++i) px[i] = __shfl_xor(x[i], 4);
            if (kind == 0) {
#pragma unroll
                for (int i = 0; i < 8; ++i) x[i] = x[i] * cs[i] + sg * px[i] * sn[i];
            }
            bool wr = kind != 1;
            if (isctx && last && (isq || kind >= 2)) wr = false;
            if (wr) { u32x4 o; o.x = pk2(x[0], x[1]); o.y = pk2(x[2], x[3]); o.z = pk2(x[4], x[5]); o.w = pk2(x[6], x[7]); *(u32x4*)(wrow + slot * 128 + li * 8) = o; }
        }
    }
}

__device__ __forceinline__ void attn_row_naive(const bf16_t* q, const bf16_t* kc, const bf16_t* vc, const bf16_t* kl, const bf16_t* vl, int j0, int j1,
                                               bool has_sink, float sink, bf16_t* o, int lane) {
    const unsigned qq = *(const unsigned*)(q + 2 * lane);
    const float q0 = bflo(qq), q1 = bfhi(qq);
    float m = -INFINITY, lsum = 0.f, o0 = 0.f, o1 = 0.f;
    const int ntot = NCTX + (j1 - j0);
    for (int j = 0; j < ntot; ++j) {
        const bf16_t* kp = j < NCTX ? kc + (size_t)j * INW : kl + (size_t)(j0 + j - NCTX) * INW;
        const bf16_t* vp = j < NCTX ? vc + (size_t)j * INW : vl + (size_t)(j0 + j - NCTX) * INW;
        const unsigned kk = *(const unsigned*)(kp + 2 * lane), vv = *(const unsigned*)(vp + 2 * lane);
        const float s = wave_sum(q0 * bflo(kk) + q1 * bfhi(kk)) * ATT_SCALE;
        const float mn = fmaxf(m, s);
        const float a = __expf(m - mn), pp = __expf(s - mn);
        lsum = lsum * a + pp; o0 = o0 * a + pp * bflo(vv); o1 = o1 * a + pp * bfhi(vv);
        m = mn;
    }
    if (has_sink) {
        const float mn = fmaxf(m, sink);
        const float a = __expf(m - mn);
        lsum = lsum * a + __expf(sink - mn); o0 *= a; o1 *= a;
    }
    const float inv = 1.f / lsum;
    *(unsigned*)(o + 2 * lane) = pk2(o0 * inv, o1 * inv);
}

__device__ __forceinline__ void ph_mixers_naive(const Params& p, int l, unsigned char* lds) {
    const int tid = threadIdx.x, lane = tid & 63, wave = tid >> 6;
    const int gw = blockIdx.x * NWAVES + wave, NGW = gridDim.x * NWAVES;
    const bf16_t* P = (const bf16_t*)(p.ws + WS_P);
    bf16_t* Y = (bf16_t*)(p.ws + WS_Y);
    const bool last = (l == DEPTH - 1);
    const int T_LA = NLAT * 6, T_LB = NLAT * 6, T_CA = last ? 0 : NCT * 6, T_CB = last ? 0 : NCT * 6;
    const int ntask = T_LA + T_LB + T_CA + T_CB;
    for (int tk = gw; tk < ntask; tk += NGW) {
        int r = tk;
        if (r < T_LA + T_LB) {
            const bool isB = r >= T_LA; if (isB) r -= T_LA;
            const int b = r / (6 * SEQ), h = (r / SEQ) % 6, t = r % SEQ, kv = h / 3;
            const size_t row = (size_t)b * SEQ + t, crow0 = (size_t)NLAT + (size_t)b * NCTX, lrow0 = (size_t)b * SEQ;
            const int cq = isB ? C_QB : C_QA, ck = isB ? C_KB : C_KA, cvv = isB ? C_VB : C_VA;
            int j0 = 0, j1 = SEQ;
            if (isB) { j0 = t - 128 < 0 ? 0 : t - 128; j1 = t + 129 > SEQ ? SEQ : t + 129; }
            attn_row_naive(P + row * INW + cq + h * 128, P + crow0 * INW + ck + kv * 128, P + crow0 * INW + cvv + kv * 128,
                           P + lrow0 * INW + ck + kv * 128, P + lrow0 * INW + cvv + kv * 128, j0, j1, isB, isB ? p.sink_b[l * 6 + h] : 0.f,
                           Y + row * DM + (isB ? 768 : 0) + h * 128, lane);
        } else {
            r -= T_LA + T_LB;
            const bool isB = r >= T_CA; if (isB) r -= T_CA;
            const int b = r / (6 * NCTX), h = (r / NCTX) % 6, t = r % NCTX, kv = h / 3;
            const size_t crow0 = (size_t)NLAT + (size_t)b * NCTX, row = crow0 + t;
            const int cq = isB ? C_QB : C_QA, ck = isB ? C_KB : C_KA, cvv = isB ? C_VB : C_VA;
            attn_row_naive(P + row * INW + cq + h * 128, P + crow0 * INW + ck + kv * 128, P + crow0 * INW + cvv + kv * 128,
                           P, P, 0, 0, isB, isB ? p.sink_b[l * 6 + h] : 0.f, Y + row * DM + (isB ? 768 : 0) + h * 128, lane);
        }
    }
    __syncthreads();
    float* Wl = (float*)lds;
    float* Vl = Wl + 128 * 128;
    const int nchunk = last ? NLAT / 128 : MTOT / 128;
    for (int u = blockIdx.x; u < nchunk * 4; u += gridDim.x) {
        const int ch = u >> 2, g = u & 3; const size_t row0 = (size_t)ch * 128;
        __syncthreads();
        for (int i = tid; i < 128 * 128; i += NTHREADS) {
            Wl[i] = p.ws_c[((size_t)l * 4 + g) * 16384 + i];
            const int q = i >> 7, c = i & 127;
            Vl[i] = bf2f(P[(row0 + q) * INW + C_VC + g * 128 + c]);
        }
        __syncthreads();
        const int c = tid & 127, pg = tid >> 7;
        for (int pp = pg * 32; pp < pg * 32 + 32; ++pp) {
            float s = 0.f;
#pragma unroll 8
            for (int q = 0; q < 128; ++q) s += Wl[pp * 128 + q] * Vl[q * 128 + c];
            s += p.bs_c[((size_t)l * 4 + g) * 128 + pp];
            const float uu = bf2f(P[(row0 + pp) * INW + C_UC + g * 128 + c]);
            Y[(row0 + pp) * DM + 1536 + g * 128 + c] = (bf16_t)f2bf(uu * s);
        }
    }
}


namespace att {
constexpr float SCALE = 0.088388347648318440f;
constexpr float THR = 8.f;
constexpr int D = 128, NW = 8, QBLK = 32, KVBLK = 64;
#ifndef ATT_SDEPTH
#define ATT_SDEPTH 2
#endif
constexpr int SDEPTH = ATT_SDEPTH;
constexpr int LDQ = INW, LDK = INW, LDO = DM;
constexpr size_t SHM_V = KVBLK * D * 2, SHM_K = KVBLK * D * 2, SHM_ATTN = 2 * SHM_V + 2 * SHM_K + NW * 64 * 4;
using bf16x8 = __attribute__((ext_vector_type(8))) short;
using s16x4  = __attribute__((ext_vector_type(4))) short;
using f32x16 = __attribute__((ext_vector_type(16))) float;
using f32x8  = __attribute__((ext_vector_type(8))) float;

#define KSWZ(row, colB) ((row) * 256 + ((colB) ^ (((row) & 7) << 4)))
#define SBAR() __builtin_amdgcn_sched_barrier(0)
__device__ __forceinline__ int crow(int r, int hi) { return (r & 3) + 8 * (r >> 2) + 4 * hi; }
__device__ __forceinline__ unsigned cvtpk(float lo, float hi) {
  unsigned r; asm volatile("v_cvt_pk_bf16_f32 %0, %1, %2" : "=v"(r) : "v"(lo), "v"(hi)); return r;
}

__device__ __forceinline__ void partialSM(f32x16& p0, f32x16& p1, float& m_reg, float& mn, float& alpha) {
  constexpr float C = SCALE * 1.4426950408889634f;
  float pmax = p0[0]; for (int r = 1; r < 16; ++r) pmax = fmaxf(pmax, p0[r]); for (int r = 0; r < 16; ++r) pmax = fmaxf(pmax, p1[r]);
  { auto rr = __builtin_amdgcn_permlane32_swap(__float_as_uint(pmax), __float_as_uint(pmax), false, false);
    pmax = fmaxf(__uint_as_float(rr[0]), __uint_as_float(rr[1])); }
  if (__builtin_expect(__all(pmax - m_reg <= THR / SCALE), 1)) { mn = m_reg; alpha = 1.f; }
  else { mn = fmaxf(m_reg, pmax); alpha = __builtin_amdgcn_exp2f((m_reg - mn) * C); m_reg = mn; }
  float mnC = -mn * C;
  for (int r = 0; r < 16; ++r) p0[r] = fmaf(p0[r], C, mnC); for (int r = 0; r < 16; ++r) p1[r] = fmaf(p1[r], C, mnC);
  for (int r = 0; r < 16; ++r) p0[r] = __builtin_amdgcn_exp2f(p0[r]);
}
__device__ __forceinline__ void finishSM(f32x16& p0, f32x16& p1, float alpha, float& l_reg, bf16x8& pa0, bf16x8& pa1, bf16x8& pa2, bf16x8& pa3) {
  for (int r = 0; r < 16; ++r) p1[r] = __builtin_amdgcn_exp2f(p1[r]);
  float ps = 0; for (int r = 0; r < 16; ++r) ps += p0[r]; for (int r = 0; r < 16; ++r) ps += p1[r];
  { auto rr = __builtin_amdgcn_permlane32_swap(__float_as_uint(ps), __float_as_uint(ps), false, false);
    ps = __uint_as_float(rr[0]) + __uint_as_float(rr[1]); }
  l_reg = l_reg * alpha + ps;
#define PK4(P, BASE, OUT) do { unsigned a0 = cvtpk(P[BASE + 0], P[BASE + 1]), a1 = cvtpk(P[BASE + 2], P[BASE + 3]);   \
    unsigned b0 = cvtpk(P[BASE + 4], P[BASE + 5]), b1 = cvtpk(P[BASE + 6], P[BASE + 7]);                              \
    auto r0 = __builtin_amdgcn_permlane32_swap(a0, b0, false, false); auto r1 = __builtin_amdgcn_permlane32_swap(a1, b1, false, false); \
    u32x4 w = {r0[0], r1[0], r0[1], r1[1]}; OUT = *reinterpret_cast<bf16x8*>(&w); } while (0)
  PK4(p0, 0, pa0); PK4(p0, 8, pa1); PK4(p1, 0, pa2); PK4(p1, 8, pa3);
#undef PK4
}
__device__ __forceinline__ void qkt(f32x16& p0, f32x16& p1, const bf16_t* Ks, const bf16x8* qr, int r32, int hi) {
  p0 = f32x16{}; p1 = f32x16{};
  for (int d0 = 0; d0 < 8; ++d0) { int cb = (d0 * 16 + hi * 8) * 2;
    bf16x8 b0 = *reinterpret_cast<const bf16x8*>((const char*)Ks + KSWZ(r32, cb));
    bf16x8 b1 = *reinterpret_cast<const bf16x8*>((const char*)Ks + KSWZ(32 + r32, cb));
    p0 = __builtin_amdgcn_mfma_f32_32x32x16_bf16(b0, qr[d0], p0, 0, 0, 0);
    p1 = __builtin_amdgcn_mfma_f32_32x32x16_bf16(b1, qr[d0], p1, 0, 0, 0); }
}
__device__ __forceinline__ int v_st(int k, int c) { const int kk = (k & ~0xC) | ((k & 4) << 1) | ((k & 8) >> 1); return ((kk >> 3) * 4 + (c >> 5)) * 512 + ((kk & 7) * 32 + (c & 31)) * 2; }
__device__ __forceinline__ int v_rd_base(int lane) { return ((lane & 3) << 3) | (((lane >> 2) & 3) << 6) | (((lane >> 4) & 1) << 5) | (((lane >> 5) & 1) << 8); }
constexpr int v_rd_off(int d0, int ks, int half) { return d0 * 512 + ks * 4096 + half * 2048; }
template <int OFF> __device__ __forceinline__ s16x4 tr_read(int vb) {
  s16x4 r; asm volatile("ds_read_b64_tr_b16 %0, %1 offset:%2" : "=&v"(r) : "v"(vb), "i"(OFF) : "memory"); return r;
}
template <int D0> __device__ __forceinline__ void pv_one(f32x16& od, int vb, bf16x8 pa0, bf16x8 pa1, bf16x8 pa2, bf16x8 pa3) {
  const s16x4 l0 = tr_read<v_rd_off(D0, 0, 0)>(vb), h0 = tr_read<v_rd_off(D0, 0, 1)>(vb), l1 = tr_read<v_rd_off(D0, 1, 0)>(vb), h1 = tr_read<v_rd_off(D0, 1, 1)>(vb);
  const s16x4 l2 = tr_read<v_rd_off(D0, 2, 0)>(vb), h2 = tr_read<v_rd_off(D0, 2, 1)>(vb), l3 = tr_read<v_rd_off(D0, 3, 0)>(vb), h3 = tr_read<v_rd_off(D0, 3, 1)>(vb);
  asm volatile("s_waitcnt lgkmcnt(0)" ::: "memory"); SBAR();
#define PK(L, H) (bf16x8){L[0], L[1], L[2], L[3], H[0], H[1], H[2], H[3]}
  od = __builtin_amdgcn_mfma_f32_32x32x16_bf16(pa0, PK(l0, h0), od, 0, 0, 0);
  od = __builtin_amdgcn_mfma_f32_32x32x16_bf16(pa1, PK(l1, h1), od, 0, 0, 0);
  od = __builtin_amdgcn_mfma_f32_32x32x16_bf16(pa2, PK(l2, h2), od, 0, 0, 0);
  od = __builtin_amdgcn_mfma_f32_32x32x16_bf16(pa3, PK(l3, h3), od, 0, 0, 0);
#undef PK
}
__device__ __forceinline__ void pv_d0(f32x16* o, int vb, bf16x8 pa0, bf16x8 pa1, bf16x8 pa2, bf16x8 pa3) {
  pv_one<0>(o[0], vb, pa0, pa1, pa2, pa3); pv_one<1>(o[1], vb, pa0, pa1, pa2, pa3); pv_one<2>(o[2], vb, pa0, pa1, pa2, pa3); pv_one<3>(o[3], vb, pa0, pa1, pa2, pa3);
}

__device__ __forceinline__ void attn_unit(const bool MASK, const bf16_t* __restrict__ Qb, const bf16_t* __restrict__ Kc, const bf16_t* __restrict__ Vc,
                                          const bf16_t* __restrict__ Kl, const bf16_t* __restrict__ Vl, int nlt, int qpos0, int kpos0,
                                          bool has_sink, float sink, bf16_t* __restrict__ Ob, char* lds) {
  int tid_ = threadIdx.x; asm volatile("" : "+v"(tid_));
  const int tid = tid_, wid = tid >> 6, lane = tid & 63, r32 = lane & 31, hi = lane >> 5;
  bf16_t* V_lds = (bf16_t*)lds; bf16_t* K_lds = (bf16_t*)(lds + 2 * SHM_V);
  float* ws = (float*)(lds + 2 * SHM_V + 2 * SHM_K) + wid * 64; float* li_l = ws; float* al_l = ws + 32;
  float m_reg = -1e30f, l_reg = 0; f32x16 o[4] = {}; bf16x8 qr[8];
  const bf16_t* Qw = Qb + (long)(wid * QBLK + r32) * LDQ + hi * 8;
#pragma unroll
  for (int d0 = 0; d0 < 8; ++d0) qr[d0] = *reinterpret_cast<const bf16x8*>(Qw + d0 * 16);
  const int sr = tid >> 4, sc = (tid & 15) * 8, vst0 = v_st(sr, sc), vst1 = v_st(32 + sr, sc);
  const int vb0 = (int)(uintptr_t)V_lds + v_rd_base(lane);
  struct { bf16x8 vs0, vs1, ks0, ks1; } sr_[SDEPTH];
  const int qpos = qpos0 + wid * QBLK + r32;
#define KVP(t, KP, VP) const bf16_t* KP = ((t) < 4 ? Kc + (long)(t) * KVBLK * LDK : Kl + (long)((t) - 4) * KVBLK * LDK); const bf16_t* VP = ((t) < 4 ? Vc + (long)(t) * KVBLK * LDK : Vl + (long)((t) - 4) * KVBLK * LDK)
#define SLOAD(i, t) do { KVP(t, kp_, vp_); sr_[i].vs0 = *reinterpret_cast<const bf16x8*>(&vp_[(long)sr * LDK + sc]); sr_[i].vs1 = *reinterpret_cast<const bf16x8*>(&vp_[(long)(32 + sr) * LDK + sc]); \
    sr_[i].ks0 = *reinterpret_cast<const bf16x8*>(&kp_[(long)sr * LDK + sc]); sr_[i].ks1 = *reinterpret_cast<const bf16x8*>(&kp_[(long)(32 + sr) * LDK + sc]); } while (0)
#define SWRITE(b, i) do { *(bf16x8*)((char*)V_lds + (b) * SHM_V + vst0) = sr_[i].vs0;          \
    *(bf16x8*)((char*)V_lds + (b) * SHM_V + vst1) = sr_[i].vs1; int kc = sc * 2;               \
    *(bf16x8*)((char*)K_lds + (b) * SHM_K + KSWZ(sr, kc)) = sr_[i].ks0;                       \
    *(bf16x8*)((char*)K_lds + (b) * SHM_K + KSWZ(32 + sr, kc)) = sr_[i].ks1; } while (0)
#define SWAIT() do { if constexpr (SDEPTH == 2) asm volatile("s_waitcnt vmcnt(4)" ::: "memory"); else asm volatile("s_waitcnt vmcnt(0)" ::: "memory"); } while (0)
#define RESC(a) do { if (__any((a) < 1.f)) { if (hi == 0) al_l[r32] = (a); asm volatile("s_waitcnt lgkmcnt(0)" ::: "memory"); \
    for (int d = 0; d < 4; ++d) for (int r = 0; r < 16; ++r) o[d][r] *= al_l[crow(r, hi)]; } } while (0)
#define WMASK(P0, P1, t) do { if (MASK && (t) >= 4) { const int kb_ = kpos0 + ((t) - 4) * KVBLK + 4 * hi - qpos; \
    _Pragma("unroll") for (int r = 0; r < 16; ++r) { const int dk = kb_ + (r & 3) + 8 * (r >> 2); \
      if (dk > 128 || dk < -128) P0[r] = -1e30f; if (dk + 32 > 128 || dk + 32 < -128) P1[r] = -1e30f; } } } while (0)
  f32x16 pA0, pA1, pB0, pB1; float mnA, mnB, alA, alB; bf16x8 pa0, pa1, pa2, pa3; const int NT = 4 + nlt;
  constexpr int SE = 0, SO = SDEPTH - 1;
  SLOAD(SE, 0); asm volatile("s_waitcnt vmcnt(0)" ::: "memory"); SWRITE(0, SE); __syncthreads();
  qkt(pA0, pA1, K_lds, qr, r32, hi); partialSM(pA0, pA1, m_reg, mnA, alA);
  SLOAD(SO, 1); if constexpr (SDEPTH == 2) { if (2 < NT) SLOAD(SE, 2); }
  SWAIT(); SWRITE(1, SO); __syncthreads();
  for (int j = 1; j + 1 < NT; j += 2) {
    SBAR(); qkt(pB0, pB1, (bf16_t*)((char*)K_lds + SHM_K), qr, r32, hi); WMASK(pB0, pB1, j);
    finishSM(pA0, pA1, alA, l_reg, pa0, pa1, pa2, pa3); SBAR();
    SLOAD(SO, j + SDEPTH); SBAR();
    pv_d0(o, vb0, pa0, pa1, pa2, pa3); partialSM(pB0, pB1, m_reg, mnB, alB);
    __syncthreads(); SWAIT(); SWRITE(0, SE);
    RESC(alB); __syncthreads();
    SBAR(); qkt(pA0, pA1, K_lds, qr, r32, hi); WMASK(pA0, pA1, j + 1);
    finishSM(pB0, pB1, alB, l_reg, pa0, pa1, pa2, pa3); SBAR();
    if (SDEPTH == 1 || j + 3 < NT) SLOAD(SE, j + 1 + SDEPTH); SBAR();
    pv_d0(o, vb0 + (int)SHM_V, pa0, pa1, pa2, pa3); partialSM(pA0, pA1, m_reg, mnA, alA);
    __syncthreads(); SWAIT(); SWRITE(1, SO);
    RESC(alA); __syncthreads();
  }
  SBAR(); qkt(pB0, pB1, (bf16_t*)((char*)K_lds + SHM_K), qr, r32, hi); WMASK(pB0, pB1, NT - 1);
  finishSM(pA0, pA1, alA, l_reg, pa0, pa1, pa2, pa3); SBAR();
  pv_d0(o, vb0, pa0, pa1, pa2, pa3); partialSM(pB0, pB1, m_reg, mnB, alB);
  __syncthreads(); RESC(alB);
  finishSM(pB0, pB1, alB, l_reg, pa0, pa1, pa2, pa3); SBAR();
  pv_d0(o, vb0 + (int)SHM_V, pa0, pa1, pa2, pa3);
  if (has_sink) l_reg += __builtin_amdgcn_exp2f(sink * 1.4426950408889634f - m_reg * (SCALE * 1.4426950408889634f));
  if (hi == 0) li_l[r32] = l_reg; asm volatile("s_waitcnt lgkmcnt(0)" ::: "memory");
  float rli[16];
#pragma unroll
  for (int r = 0; r < 16; ++r) rli[r] = __builtin_amdgcn_rcpf(li_l[crow(r, hi)]);
  bf16_t* Ow = Ob + (long)(wid * QBLK) * LDO;
#pragma unroll
  for (int r = 0; r < 16; ++r) { int orow = crow(r, hi);
#pragma unroll
    for (int d0 = 0; d0 < 4; ++d0) Ow[(long)orow * LDO + d0 * 32 + r32] = (bf16_t)f2bf(o[d0][r] * rli[r]); }
  __syncthreads();
#undef KVP
#undef SLOAD
#undef SWRITE
#undef SWAIT
#undef RESC
#undef WMASK
}
#undef KSWZ
#undef SBAR
}


__device__ __forceinline__ void cmlp_unit_naive(const Params& p, int l, int ch, int g, unsigned char* lds) {
    int tid_ = threadIdx.x; asm volatile("" : "+v"(tid_));
    const int tid = tid_;
    const bf16_t* P = (const bf16_t*)(p.ws + WS_P);
    bf16_t* Y = (bf16_t*)(p.ws + WS_Y);
    float* Wl = (float*)lds;
    float* Vl = Wl + 128 * 128;
    const size_t row0 = (size_t)ch * 128;
    __syncthreads();
    for (int i = tid; i < 128 * 128; i += NTHREADS) {
        Wl[i] = p.ws_c[((size_t)l * 4 + g) * 16384 + i];
        const int q = i >> 7, c = i & 127;
        Vl[i] = bf2f(P[(row0 + q) * INW + C_VC + g * 128 + c]);
    }
    __syncthreads();
    const int c = tid & 127, pg = tid >> 7;
    for (int pp = pg * 32; pp < pg * 32 + 32; ++pp) {
        float s = 0.f;
#pragma unroll 8
        for (int q = 0; q < 128; ++q) s += Wl[pp * 128 + q] * Vl[q * 128 + c];
        s += p.bs_c[((size_t)l * 4 + g) * 128 + pp];
        const float uu = bf2f(P[(row0 + pp) * INW + C_UC + g * 128 + c]);
        Y[(row0 + pp) * DM + 1536 + g * 128 + c] = (bf16_t)f2bf(uu * s);
    }
    __syncthreads();
}


__device__ __forceinline__ void cmlp_unit_fast(const Params& p, int l, int ch, int g, unsigned char* lds) {
    typedef short bf16x8 __attribute__((ext_vector_type(8)));
    typedef float f32x16 __attribute__((ext_vector_type(16)));
    int tid_ = threadIdx.x; asm volatile("" : "+v"(tid_));
    const int tid = tid_, lane = tid & 63, wave = tid >> 6, r32 = lane & 31, hh = lane >> 5;
    const bf16_t* P = (const bf16_t*)(p.ws + WS_P);
    bf16_t* Y = (bf16_t*)(p.ws + WS_Y);
    const bf16_t* W = (const bf16_t*)(p.ws + WS_WSC) + ((size_t)l * 4 + g) * 16384;
    bf16_t* VT = (bf16_t*)lds;
    const size_t row0 = (size_t)ch * 128;
    __syncthreads();
#pragma unroll
    for (int it = 0; it < 4; ++it) {
        const int q = it * 32 + (tid >> 4), c0 = (tid & 15) * 8;
        const u32x4 v = *(const u32x4*)(P + (row0 + q) * INW + C_VC + g * 128 + c0);
        const unsigned w[4] = {v.x, v.y, v.z, v.w};
#pragma unroll
        for (int i = 0; i < 4; ++i) { VT[(c0 + 2 * i) * 136 + q] = (bf16_t)(w[i] & 0xffffu); VT[(c0 + 2 * i + 1) * 136 + q] = (bf16_t)(w[i] >> 16); }
    }
    __syncthreads();
    const int cb = wave & 3, pb0 = (wave >> 2) * 2;
    f32x16 acc0 = {}, acc1 = {};
#pragma unroll
    for (int s = 0; s < 8; ++s) {
        const bf16x8 b = *(const bf16x8*)(VT + (cb * 32 + r32) * 136 + 16 * s + 8 * hh);
        const bf16x8 a0 = *(const bf16x8*)(W + (size_t)(pb0 * 32 + r32) * 128 + 16 * s + 8 * hh);
        const bf16x8 a1 = *(const bf16x8*)(W + (size_t)(pb0 * 32 + 32 + r32) * 128 + 16 * s + 8 * hh);
        acc0 = __builtin_amdgcn_mfma_f32_32x32x16_bf16(a0, b, acc0, 0, 0, 0);
        acc1 = __builtin_amdgcn_mfma_f32_32x32x16_bf16(a1, b, acc1, 0, 0, 0);
    }
    const int c = cb * 32 + r32;
    const float* bs = p.bs_c + ((size_t)l * 4 + g) * 128;
#pragma unroll
    for (int r = 0; r < 16; ++r) {
        const int pr = (r & 3) + 8 * (r >> 2) + 4 * hh;
        const int p0 = pb0 * 32 + pr, p1 = p0 + 32;
        const float u0 = bf2f(P[(row0 + p0) * INW + C_UC + g * 128 + c]), u1 = bf2f(P[(row0 + p1) * INW + C_UC + g * 128 + c]);
        Y[(row0 + p0) * DM + 1536 + g * 128 + c] = (bf16_t)f2bf(u0 * (acc0[r] + bs[p0]));
        Y[(row0 + p1) * DM + 1536 + g * 128 + c] = (bf16_t)f2bf(u1 * (acc1[r] + bs[p1]));
    }
}
#ifndef USE_FAST_CMLP
#define USE_FAST_CMLP 1
#endif

__device__ __forceinline__ void ph_mixers_fast(const Params& p, int l, unsigned char* lds, const bool dry) {
    const int tid = threadIdx.x;
    const bf16_t* P = (const bf16_t*)(p.ws + WS_P);
    bf16_t* Y = (bf16_t*)(p.ws + WS_Y);
    const bool last = (l == DEPTH - 1);
    const int b = blockIdx.x & 7;
    unsigned* ctr = (unsigned*)(p.ws + WS_CTL) + (dry ? 2048 : 0) + (l * 8 + b) * 64;
    volatile unsigned* shw = (volatile unsigned*)(lds + LDS_BYTES - 64);
    const int nAttn = last ? 96 : 108, nC = last ? 64 : 72, total = nAttn + nC;
    const size_t lrow0 = (size_t)b * SEQ, crow0 = (size_t)NLAT + (size_t)b * NCTX;
    for (;;) {
        __syncthreads();
        if (tid == 0) *shw = atomicAdd(ctr, 1u);
        __syncthreads();
        const int u = (int)*shw;
        if (u >= total) break;
        if (u < nAttn) {
            const bf16_t *Qb, *Kc, *Vc, *Kl, *Vl; bf16_t* Ob; int nlt = 0, qpos0 = 0, kpos0 = 0; bool mask = false, has_sink = false; int hsink = 0;
            if (u < 48) {
                const int h = u >> 3, qb = u & 7, kv = h / 3;
                Qb = P + (lrow0 + qb * 256) * INW + C_QA + h * 128; Kc = P + crow0 * INW + C_KA + kv * 128; Vc = P + crow0 * INW + C_VA + kv * 128;
                Kl = P + lrow0 * INW + C_KA + kv * 128; Vl = P + lrow0 * INW + C_VA + kv * 128; nlt = 32;
                Ob = Y + (lrow0 + qb * 256) * DM + h * 128;
            } else if (u < 96) {
                const int v = u - 48, h = v >> 3, qb = v & 7, kv = h / 3;
                const int kstart = qb == 0 ? 0 : qb * 256 - 128; nlt = (qb == 0 || qb == 7) ? 6 : 8;
                Qb = P + (lrow0 + qb * 256) * INW + C_QB + h * 128; Kc = P + crow0 * INW + C_KB + kv * 128; Vc = P + crow0 * INW + C_VB + kv * 128;
                Kl = P + (lrow0 + kstart) * INW + C_KB + kv * 128; Vl = P + (lrow0 + kstart) * INW + C_VB + kv * 128;
                qpos0 = qb * 256; kpos0 = kstart; mask = true; has_sink = true; hsink = h;
                Ob = Y + (lrow0 + qb * 256) * DM + 768 + h * 128;
            } else {
                const int v = u - 96; const bool isB = v >= 6; const int h = isB ? v - 6 : v, kv = h / 3;
                const int cq = isB ? C_QB : C_QA, ck = isB ? C_KB : C_KA, cv = isB ? C_VB : C_VA;
                Qb = P + crow0 * INW + cq + h * 128; Kc = P + crow0 * INW + ck + kv * 128; Vc = P + crow0 * INW + cv + kv * 128; Kl = Kc; Vl = Vc;
                has_sink = isB; hsink = h; Ob = Y + crow0 * DM + (isB ? 768 : 0) + h * 128;
            }
            att::attn_unit(mask, Qb, Kc, Vc, Kl, Vl, nlt, qpos0, kpos0, has_sink, has_sink ? p.sink_b[l * 6 + hsink] : 0.f, Ob, (char*)lds);
        } else {
            const int v = u - nAttn;
            const int ch = v < 64 ? b * 16 + (v >> 2) : 128 + b * 2 + ((v - 64) >> 2);
#if USE_FAST_CMLP
            cmlp_unit_fast(p, l, ch, v & 3, lds);
#else
            cmlp_unit_naive(p, l, ch, v & 3, lds);
#endif
        }
    }
}
#ifndef USE_FAST_ATT
#define USE_FAST_ATT 1
#endif

__device__ __forceinline__ void ynorm_row(bf16_t* yrow, const u32x4 (&v)[4], int lane, unsigned char* y8row, float* sdst) {
    float sq[4];
#pragma unroll
    for (int j = 0; j < 4; ++j) {
        const float a0 = bflo(v[j].x), a1 = bfhi(v[j].x), a2 = bflo(v[j].y), a3 = bfhi(v[j].y), a4 = bflo(v[j].z), a5 = bfhi(v[j].z), a6 = bflo(v[j].w), a7 = bfhi(v[j].w);
        sq[j] = a0 * a0 + a1 * a1 + a2 * a2 + a3 * a3 + a4 * a4 + a5 * a5 + a6 * a6 + a7 * a7;
    }
    const float sA = wave_sum(sq[0] + (lane < 32 ? sq[1] : 0.f));
    const float sB = wave_sum((lane >= 32 ? sq[1] : 0.f) + sq[2]);
    const float sC = wave_sum(sq[3]);
    const float rA = rsqrtf(sA * (1.f / 768.f) + EPS), rB = rsqrtf(sB * (1.f / 768.f) + EPS), rC = rsqrtf(sC * (1.f / 512.f) + EPS);
    if (GEMM_I8) {
        float x[4][8]; float am = 0.f;
#pragma unroll
        for (int j = 0; j < 4; ++j) {
            const float sc = (j == 0) ? rA : (j == 1) ? (lane < 32 ? rA : rB) : (j == 2) ? rB : rC;
            x[j][0] = bflo(v[j].x) * sc; x[j][1] = bfhi(v[j].x) * sc; x[j][2] = bflo(v[j].y) * sc; x[j][3] = bfhi(v[j].y) * sc;
            x[j][4] = bflo(v[j].z) * sc; x[j][5] = bfhi(v[j].z) * sc; x[j][6] = bflo(v[j].w) * sc; x[j][7] = bfhi(v[j].w) * sc;
#pragma unroll
            for (int i = 0; i < 8; ++i) am = fmaxf(am, fabsf(x[j][i]));
        }
        am = wave_max(am);
        const float s = am > 0.f ? am * (1.f / 127.f) : 1.f, inv = 1.f / s;
#pragma unroll
        for (int j = 0; j < 4; ++j) {
            u32x2 o; o.x = q8pack4(x[j][0], x[j][1], x[j][2], x[j][3], inv); o.y = q8pack4(x[j][4], x[j][5], x[j][6], x[j][7], inv);
            *(u32x2*)(y8row + j * 512 + lane * 8) = o;
        }
        if (lane == 0) *sdst = s;
        return;
    }
#pragma unroll
    for (int j = 0; j < 4; ++j) {
        const float sc = (j == 0) ? rA : (j == 1) ? (lane < 32 ? rA : rB) : (j == 2) ? rB : rC;
        u32x4 o;
        o.x = pk2(bflo(v[j].x) * sc, bfhi(v[j].x) * sc); o.y = pk2(bflo(v[j].y) * sc, bfhi(v[j].y) * sc);
        o.z = pk2(bflo(v[j].z) * sc, bfhi(v[j].z) * sc); o.w = pk2(bflo(v[j].w) * sc, bfhi(v[j].w) * sc);
        *(u32x4*)(yrow + j * 512 + lane * 8) = o;
    }
}
__device__ __forceinline__ void ph_ynorm(const Params& p, int l) {
    const int tid = threadIdx.x, lane = tid & 63, wave = tid >> 6;
    const int gw = blockIdx.x * NWAVES + wave, NGW = gridDim.x * NWAVES;
    bf16_t* Y = (bf16_t*)(p.ws + WS_Y);
    const int nrows = (l == DEPTH - 1) ? NLAT : MTOT;
#pragma unroll 1
    for (int r = gw; r < nrows; r += 2 * NGW) {
        const int r2 = r + NGW; const bool has2 = r2 < nrows; const int rb = has2 ? r2 : r;
        u32x4 va[4], vb[4];
#pragma unroll
        for (int j = 0; j < 4; ++j) { va[j] = *(const u32x4*)(Y + (size_t)r * DM + j * 512 + lane * 8); vb[j] = *(const u32x4*)(Y + (size_t)rb * DM + j * 512 + lane * 8); }
        unsigned char* Y8 = (unsigned char*)(p.ws + WS_XN8); float* SY = (float*)(p.ws + WS_SCL) + SCL_Y;
        ynorm_row(Y + (size_t)r * DM, va, lane, Y8 + (size_t)r * DM, SY + r);
        if (has2) ynorm_row(Y + (size_t)r2 * DM, vb, lane, Y8 + (size_t)r2 * DM, SY + r2);
    }
}

__device__ __forceinline__ void wave_argmax(float& bv, int& bi) {
#pragma unroll
    for (int o = 32; o >= 1; o >>= 1) {
        const float ov = __shfl_xor(bv, o); const int oi = __shfl_xor(bi, o);
        if (ov > bv || (ov == bv && oi < bi)) { bv = ov; bi = oi; }
    }
}
__device__ __forceinline__ void route_half(const bf16_t* qh, const bf16_t* kh, int lane, float& tv, int& ti) {
    const unsigned qq = *(const unsigned*)(qh + 2 * lane);
    const float qa = bflo(qq), qb = bfhi(qq);
    const bf16_t* k0 = kh + (size_t)lane * 128;
    const bf16_t* k1 = k0 + 64 * 128;
    float d0 = 0.f, d1 = 0.f;
#pragma unroll 2
    for (int cb = 0; cb < 16; ++cb) {
        const u32x4 a = *(const u32x4*)(k0 + cb * 8), b = *(const u32x4*)(k1 + cb * 8);
        const unsigned aw[4] = {a.x, a.y, a.z, a.w}, bw[4] = {b.x, b.y, b.z, b.w};
#pragma unroll
        for (int i = 0; i < 4; ++i) {
            const int src = cb * 4 + i;
            const float x0 = __shfl(qa, src), x1 = __shfl(qb, src);
            d0 += x0 * bflo(aw[i]) + x1 * bfhi(aw[i]);
            d1 += x0 * bflo(bw[i]) + x1 * bfhi(bw[i]);
        }
    }
    float va = d0, vb = d1; tv = 0.f; ti = 0;
#pragma unroll 1
    for (int r = 0; r < 16; ++r) {
        float bv; int bi;
        if (va >= vb) { bv = va; bi = lane; } else { bv = vb; bi = lane + 64; }
        wave_argmax(bv, bi);
        if (lane == r) { tv = bv; ti = bi; }
        if (bi == lane) va = -INFINITY; else if (bi == lane + 64) vb = -INFINITY;
    }
}
__device__ __forceinline__ void ph_route_naive(const Params& p, int l) {
    const int tid = threadIdx.x, lane = tid & 63, wave = tid >> 6;
    const int gw = blockIdx.x * NWAVES + wave, NGW = gridDim.x * NWAVES;
    const bf16_t* QP = (const bf16_t*)(p.ws + WS_P);
    const bf16_t* KEYS = (const bf16_t*)(p.ws + WS_KEYS) + (size_t)l * 8 * 2 * 128 * 128;
    int* EID = (int*)(p.ws + WS_EID); float* GATE = (float*)(p.ws + WS_GATE);
    const int nrows = (l == DEPTH - 1) ? NLAT : MTOT;
#pragma unroll 1
    for (int tk = gw; tk < nrows * 8; tk += NGW) {
        const int t = tk >> 3, h = tk & 7;
        const bf16_t* qrow = QP + (size_t)t * DM + h * 256;
        float tv0, tv1; int ti0, ti1;
        route_half(qrow, KEYS + (size_t)(h * 2 + 0) * 128 * 128, lane, tv0, ti0);
        route_half(qrow + 128, KEYS + (size_t)(h * 2 + 1) * 128 * 128, lane, tv1, ti1);
        const float v1 = __shfl(tv0, lane >> 2);
        float c0 = v1 + __shfl(tv1, (lane & 3) * 4 + 0), c1 = v1 + __shfl(tv1, (lane & 3) * 4 + 1);
        float c2 = v1 + __shfl(tv1, (lane & 3) * 4 + 2), c3 = v1 + __shfl(tv1, (lane & 3) * 4 + 3);
        float myv = 0.f; int myc = 0;
#pragma unroll 1
        for (int r = 0; r < 16; ++r) {
            float bv = c0; int bi = lane * 4;
            if (c1 > bv) { bv = c1; bi = lane * 4 + 1; }
            if (c2 > bv) { bv = c2; bi = lane * 4 + 2; }
            if (c3 > bv) { bv = c3; bi = lane * 4 + 3; }
            wave_argmax(bv, bi);
            if (lane == r) { myv = bv; myc = bi; }
            if ((bi >> 2) == lane) {
                const int u = bi & 3;
                if (u == 0) c0 = -INFINITY; else if (u == 1) c1 = -INFINITY; else if (u == 2) c2 = -INFINITY; else c3 = -INFINITY;
            }
        }
        float mx = lane < 16 ? myv : -INFINITY;
        mx = fmaxf(mx, __shfl_xor(mx, 8)); mx = fmaxf(mx, __shfl_xor(mx, 4)); mx = fmaxf(mx, __shfl_xor(mx, 2)); mx = fmaxf(mx, __shfl_xor(mx, 1));
        const float e = lane < 16 ? __expf(myv - mx) : 0.f;
        float sm = e; sm += __shfl_xor(sm, 8); sm += __shfl_xor(sm, 4); sm += __shfl_xor(sm, 2); sm += __shfl_xor(sm, 1);
        const int i1 = __shfl(ti0, myc >> 4), i2 = __shfl(ti1, myc & 15);
        if (lane < 16) { EID[(size_t)t * 128 + h * 16 + lane] = i1 * 128 + i2; GATE[(size_t)t * 128 + h * 16 + lane] = e / sm; }
    }
}


namespace rt {
typedef short bf16x8 __attribute__((ext_vector_type(8)));
typedef float f32x16 __attribute__((ext_vector_type(16)));
__device__ __forceinline__ void insert16(float (&t)[16], float x) {
#pragma unroll
    for (int j = 15; j >= 1; --j) t[j] = __builtin_amdgcn_fmed3f(t[j - 1], t[j], x);
    t[0] = fmaxf(t[0], x);
}
__device__ __forceinline__ void half_top16(const unsigned char* klds, const bf16_t* qrow, int r32, int hh, float (&t)[16]) {
    bf16x8 qf[8];
#pragma unroll
    for (int s = 0; s < 8; ++s) qf[s] = *(const bf16x8*)(qrow + 16 * s);
#pragma unroll
    for (int k = 0; k < 16; ++k) t[k] = -3.0e38f;
    const unsigned hh4 = (unsigned)hh << 2;
#pragma unroll
    for (int kb = 0; kb < 4; ++kb) {
        f32x16 acc = {};
        const int row = kb * 32 + r32;
#pragma unroll
        for (int s = 0; s < 8; ++s) {
            const bf16x8 a = *(const bf16x8*)(klds + row * 256 + ((32 * s + 16 * hh) ^ ((row & 7) << 4)));
            acc = __builtin_amdgcn_mfma_f32_32x32x16_bf16(a, qf[s], acc, 0, 0, 0);
        }
#pragma unroll
        for (int r = 0; r < 16; ++r) {
            const unsigned key = (unsigned)(kb * 32 + (r & 3) + 8 * (r >> 2)) | hh4;
            insert16(t, __uint_as_float((__float_as_uint(acc[r]) & ~127u) | key));
        }
    }
    float o[16];
#pragma unroll
    for (int k = 0; k < 16; ++k) o[k] = __shfl_xor(t[k], 32);
#pragma unroll
    for (int k = 0; k < 16; ++k) insert16(t, o[k]);
}
}
template <bool OWN_UNITS>
__device__ __forceinline__ void ph_route_fast(const Params& p, int l, unsigned char* lds) {
    int tid_ = threadIdx.x; asm volatile("" : "+v"(tid_));
    const int tid = tid_, lane = tid & 63, wave = tid >> 6, r32 = lane & 31, hh = lane >> 5;
    const bf16_t* QP = (const bf16_t*)(p.ws + WS_P);
    const bf16_t* KEYS = (const bf16_t*)(p.ws + WS_KEYS) + (size_t)l * 8 * 2 * 128 * 128;
    int* EID = (int*)(p.ws + WS_EID); float* GATE = (float*)(p.ws + WS_GATE);
    const int ntile = ((l == DEPTH - 1) ? NLAT : MTOT) / 256;
    unsigned* tab = (unsigned*)(lds + 65536) + wave * 2048;
    pg8::StaticOrder So; So.init(ntile * 256, DM, (int)gridDim.x, (int)blockIdx.x);
#pragma unroll 1
    for (int ui = 0;; ++ui) {
        int tile, h;
        if (OWN_UNITS) { pg8::Unit uu; if (!So.next(ui, uu)) break; tile = uu.pm; h = uu.pn; }
        else { const int u = blockIdx.x + ui * (int)gridDim.x; if (u >= ntile * 8) break; tile = u >> 3; h = u & 7; }
        __syncthreads();
        const u32x4* ksrc = (const u32x4*)(KEYS + (size_t)h * 2 * 128 * 128);
#pragma unroll
        for (int i = 0; i < 8; ++i) { const int c = tid + i * 512, row = c >> 4, cc = c & 15; *(u32x4*)(lds + row * 256 + ((cc * 16) ^ ((row & 7) << 4))) = ksrc[c]; }
        __syncthreads();
        const int tok = tile * 256 + wave * 32 + r32;
        const bf16_t* qrow = QP + (size_t)tok * DM + h * 256 + hh * 8;
        float v1[16], v2[16];
        rt::half_top16(lds, qrow, r32, hh, v1);
        rt::half_top16(lds + 32768, qrow + 128, r32, hh, v2);
        float c[16];
#pragma unroll
        for (int k = 0; k < 16; ++k) c[k] = -3.0e38f;
#pragma unroll
        for (int i = 0; i < 16; ++i)
#pragma unroll
            for (int j = 0; j < 16; ++j)
                if ((i + 1) * (j + 1) <= 16) rt::insert16(c, __uint_as_float((__float_as_uint(v1[i] + v2[j]) & ~255u) | (unsigned)(i * 16 + j)));
#pragma unroll
        for (int k = 0; k < 16; ++k) { tab[k * 64 + lane] = __float_as_uint(v1[k]); tab[(16 + k) * 64 + lane] = __float_as_uint(v2[k]); }
        LDS_WAIT();
        float e[16], sum = 0.f;
#pragma unroll
        for (int k = 0; k < 16; ++k) { e[k] = __expf(c[k] - c[0]); sum += e[k]; }
        const float inv = 1.f / sum;
        unsigned out[16];
#pragma unroll
        for (int k = 0; k < 16; ++k) {
            const unsigned code = __float_as_uint(c[k]) & 255u;
            const unsigned i1 = tab[(code >> 4) * 64 + lane] & 127u, i2 = tab[(16 + (code & 15u)) * 64 + lane] & 127u;
            out[k] = hh == 0 ? (i1 * 128u + i2) : __float_as_uint(e[k] * inv);
        }
        unsigned* dst = (hh == 0 ? (unsigned*)EID : (unsigned*)GATE) + (size_t)tok * 128 + h * 16;
#pragma unroll
        for (int k = 0; k < 4; ++k) { u32x4 w; w.x = out[4 * k]; w.y = out[4 * k + 1]; w.z = out[4 * k + 2]; w.w = out[4 * k + 3]; *(u32x4*)(dst + 4 * k) = w; }
        LDS_WAIT();
    }
}
#ifndef USE_FAST_ROUTE
#define USE_FAST_ROUTE 1
#endif


#if GATHER_I8
__device__ __forceinline__ float dpp_shr(float v, int n) {
    const int iv = __builtin_bit_cast(int, v); int r;
    switch (n) { case 1: r = __builtin_amdgcn_update_dpp(0, iv, 0x111, 0xf, 0xf, true); break; case 2: r = __builtin_amdgcn_update_dpp(0, iv, 0x112, 0xf, 0xf, true); break;
                 case 4: r = __builtin_amdgcn_update_dpp(0, iv, 0x114, 0xf, 0xf, true); break; default: r = __builtin_amdgcn_update_dpp(0, iv, 0x118, 0xf, 0xf, true); break; }
    return __builtin_bit_cast(float, r);
}
__device__ __forceinline__ float wave_total(float v) {
    v += dpp_shr(v, 1); v += dpp_shr(v, 2); v += dpp_shr(v, 4); v += dpp_shr(v, 8);
    v += __builtin_bit_cast(float, __builtin_amdgcn_update_dpp(0, __builtin_bit_cast(int, v), 0x142, 0xa, 0xf, false));
    v += __builtin_bit_cast(float, __builtin_amdgcn_update_dpp(0, __builtin_bit_cast(int, v), 0x143, 0xc, 0xf, false));
    return __uint_as_float(__builtin_amdgcn_readlane(__float_as_uint(v), 63));
}
#define UB0(w) ((float)((w) & 0xffu))
#define UB1(w) ((float)(((w) >> 8) & 0xffu))
#define UB2(w) ((float)(((w) >> 16) & 0xffu))
#define UB3(w) ((float)((w) >> 24))

__device__ __forceinline__ float dpp_xor1(float v) { return __builtin_bit_cast(float, __builtin_amdgcn_update_dpp(0, __builtin_bit_cast(int, v), 0xB1, 0xf, 0xf, false)); }
__device__ __forceinline__ float dpp_xor2(float v) { return __builtin_bit_cast(float, __builtin_amdgcn_update_dpp(0, __builtin_bit_cast(int, v), 0x4E, 0xf, 0xf, false)); }
__device__ __forceinline__ float dpp_xor8(float v) { return __builtin_bit_cast(float, __builtin_amdgcn_update_dpp(0, __builtin_bit_cast(int, v), 0x128, 0xf, 0xf, false)); }
__device__ __forceinline__ float reduce8_rows(const float (&d)[8], int lane) {
    const bool b0 = lane & 1, b1 = lane & 2, b2 = lane & 4;
    float r[4];
#pragma unroll
    for (int k = 0; k < 4; ++k) r[k] = (b0 ? d[2 * k + 1] : d[2 * k]) + dpp_xor1(b0 ? d[2 * k] : d[2 * k + 1]);
    float t[2];
#pragma unroll
    for (int k = 0; k < 2; ++k) t[k] = (b1 ? r[2 * k + 1] : r[2 * k]) + dpp_xor2(b1 ? r[2 * k] : r[2 * k + 1]);
    float u = (b2 ? t[1] : t[0]) + __shfl_xor(b2 ? t[0] : t[1], 4);
    u += dpp_xor8(u);
    u += __shfl_xor(u, 16);
    u += __shfl_xor(u, 32);
    return u;
}
#if GATHER_4BIT
#ifndef DRY_MODE
#define DRY_MODE 0
#endif
typedef float f32x2 __attribute__((ext_vector_type(2)));
__device__ __forceinline__ void ph_gather(const Params& p, int l, const bool dry) {
    const int tid = threadIdx.x, lane = tid & 63, wave = tid >> 6;
    const int gw = blockIdx.x * NWAVES + wave, NGW = gridDim.x * NWAVES;
    const bf16_t* XN = (const bf16_t*)(p.ws + WS_XN);
    const unsigned char* UT = (const unsigned char*)(p.ws + WS_UT) + (size_t)l * NEXP * ROW4;
    const unsigned char* VT = (const unsigned char*)(p.ws + WS_VT) + (size_t)l * NEXP * ROW4;
    const int* EID = (const int*)(p.ws + WS_EID); const float* GATE = (const float*)(p.ws + WS_GATE);
    const float* mod = (const float*)(p.ws + WS_MOD) + (size_t)l * 9 * 12288;
    const int nrows = (l == DEPTH - 1) ? NLAT : MTOT;
#pragma unroll 1
    for (int t = gw; t < nrows; t += NGW) {
        int xh[4], xl[4]; float sxl;
        {
            float x[32]; float am = 0.f;
#pragma unroll
            for (int j = 0; j < 2; ++j)
#pragma unroll
                for (int k = 0; k < 2; ++k) {
                    const u32x4 q = *(const u32x4*)(XN + (size_t)t * DM + j * 1024 + lane * 16 + k * 8);
                    float* xx = x + j * 16 + k * 8;
                    xx[0] = bflo(q.x); xx[1] = bfhi(q.x); xx[2] = bflo(q.y); xx[3] = bfhi(q.y); xx[4] = bflo(q.z); xx[5] = bfhi(q.z); xx[6] = bflo(q.w); xx[7] = bfhi(q.w);
                }
#pragma unroll
            for (int i = 0; i < 32; ++i) am = fmaxf(am, fabsf(x[i]));
            sxl = am > 0.f ? am * (1.f / 119.f) : 1.f;
            const float inv = 1.f / sxl;
#pragma unroll
            for (int d = 0; d < 4; ++d) {
                unsigned h = 0u, lo = 0u;
#pragma unroll
                for (int k = 0; k < 8; ++k) {
                    const int q = (int)rintf(x[8 * d + k] * inv);
                    const int ql = ((q + 8) & 15) - 8, qh = (q - ql) >> 4;
                    h |= ((unsigned)qh & 15u) << (4 * k); lo |= ((unsigned)ql & 15u) << (4 * k);
                }
                xh[d] = (int)h; xl[d] = (int)lo;
            }
        }
        const int e0 = EID[(size_t)t * 128 + lane], e1 = EID[(size_t)t * 128 + 64 + lane];
        const float g0 = GATE[(size_t)t * 128 + lane], g1 = GATE[(size_t)t * 128 + 64 + lane];
        float hid0 = 0.f, hid1 = 0.f;
        constexpr int GB = 8;
#define G_LOAD(W, S, TAB, EB) do { _Pragma("unroll") for (int i = 0; i < GB; ++i) { \
            const int id_ = __builtin_amdgcn_readlane((EB) < 64 ? e0 : e1, ((EB) + i) & 63); \
            const unsigned char* row_ = (TAB) + (size_t)id_ * ROW4; \
            W[i] = *(const u32x4*)(row_ + lane * 16); S[i] = *(const unsigned short*)(row_ + 1024 + lane * 2); } } while (0)
#define G_DOT(W, S, EB) do { float dd_[8]; _Pragma("unroll") for (int i = 0; i < GB; ++i) { int sh_ = 0, sl_ = 0; \
            const unsigned ww[4] = {W[i].x, W[i].y, W[i].z, W[i].w}; \
            _Pragma("unroll") for (int d = 0; d < 4; ++d) { \
                sh_ = __builtin_amdgcn_sdot8((int)ww[d], xh[d], sh_, false); \
                sl_ = __builtin_amdgcn_sdot8((int)ww[d], xl[d], sl_, false); } \
            dd_[i] = (float)((sh_ << 4) + sl_) * (sxl * bf2f(S[i])); } \
            const float tot = reduce8_rows(dd_, lane);              \
            if ((lane & 56) == ((EB) & 63)) { if ((EB) < 64) hid0 = tot; else hid1 = tot; } } while (0)
#define G_AXPY(W, S, EB) do { _Pragma("unroll") for (int i = 0; i < GB; ++i) { \
            const float m_ = __uint_as_float(__builtin_amdgcn_readlane(__float_as_uint((EB) < 64 ? cf0 : cf1), ((EB) + i) & 63)) * bf2f(S[i]); \
            const f32x2 mm = {m_, m_}; \
            const unsigned ww[4] = {W[i].x, W[i].y, W[i].z, W[i].w}; \
            _Pragma("unroll") for (int d = 0; d < 4; ++d) { \
                acc[4 * d + 0] += mm * __builtin_amdgcn_cvt_scalef32_pk_f32_fp4(ww[d], 1.0f, 0); \
                acc[4 * d + 1] += mm * __builtin_amdgcn_cvt_scalef32_pk_f32_fp4(ww[d], 1.0f, 1); \
                acc[4 * d + 2] += mm * __builtin_amdgcn_cvt_scalef32_pk_f32_fp4(ww[d], 1.0f, 2); \
                acc[4 * d + 3] += mm * __builtin_amdgcn_cvt_scalef32_pk_f32_fp4(ww[d], 1.0f, 3); } } } while (0)
        u32x4 wa[GB], wb[GB]; unsigned sa[GB], sb[GB];
        const bool do_u = !(dry && (DRY_MODE == 4 || DRY_MODE == 5)), do_v = !(dry && (DRY_MODE == 3 || DRY_MODE == 5));
        if (do_u) G_LOAD(wa, sa, UT, 0); else G_LOAD(wa, sa, VT, 0);
#pragma unroll 1
        for (int eb = 0; eb < (do_u ? 128 : 0); eb += 2 * GB) {
            G_LOAD(wb, sb, UT, eb + GB);
            G_DOT(wa, sa, eb);
            if (eb + 2 * GB < 128) G_LOAD(wa, sa, UT, eb + 2 * GB); else G_LOAD(wa, sa, VT, 0);
            G_DOT(wb, sb, eb + GB);
        }
        const float cf0 = gelu_tanh(hid0) * g0, cf1 = gelu_tanh(hid1) * g1;
        f32x2 acc[16];
#pragma unroll
        for (int i = 0; i < 16; ++i) acc[i] = (f32x2){0.f, 0.f};
#pragma unroll 1
        for (int eb = 0; eb < (do_v ? 128 : 0); eb += 2 * GB) {
            G_LOAD(wb, sb, VT, eb + GB);
            G_AXPY(wa, sa, eb);
            if (eb + 2 * GB < 128) G_LOAD(wa, sa, VT, eb + 2 * GB);
            G_AXPY(wb, sb, eb + GB);
        }
#undef G_LOAD
#undef G_DOT
#undef G_AXPY
        float hn[32];
        float* hrow = t < NLAT ? p.out + (size_t)t * DM : (float*)(p.ws + WS_HC) + (size_t)(t - NLAT) * DM;
        const int bb = t < NLAT ? (t >> 11) : 8;
        const float* gate = mod + (size_t)bb * 12288 + 5 * DM;
#pragma unroll
        for (int j = 0; j < 2; ++j)
#pragma unroll
            for (int k = 0; k < 4; ++k) {
                const int col = j * 1024 + lane * 16 + k * 4;
                const f32x4 hv = *(const f32x4*)(hrow + col), gv = *(const f32x4*)(gate + col);
                const f32x2 a0 = acc[j * 8 + k * 2], a1 = acc[j * 8 + k * 2 + 1];
                f32x4 o;
                o.x = hv.x + gv.x * a0.x; o.y = hv.y + gv.y * a0.y; o.z = hv.z + gv.z * a1.x; o.w = hv.w + gv.w * a1.y;
                *(f32x4*)((dry ? (float*)(p.ws + WS_DUMMY) + (size_t)(t & 16383) * DM : hrow) + col) = o;
                hn[j * 16 + k * 4 + 0] = o.x; hn[j * 16 + k * 4 + 1] = o.y; hn[j * 16 + k * 4 + 2] = o.z; hn[j * 16 + k * 4 + 3] = o.w;
            }
        if (l + 1 < DEPTH) {
            float ss = 0.f;
#pragma unroll
            for (int i = 0; i < 32; ++i) ss += hn[i] * hn[i];
            const float rstd = rsqrtf(wave_total(ss) * (1.f / DM) + EPS);
            const float* g1n = p.norm1_g + (l + 1) * DM;
            const float* shift = mod + (size_t)9 * 12288 + (size_t)bb * 12288;
            const float* scale = shift + DM;
            if (GEMM_I8) {
                float am = 0.f;
#pragma unroll
                for (int j = 0; j < 2; ++j)
#pragma unroll
                    for (int i = 0; i < 16; ++i) { const int col = j * 1024 + lane * 16 + i; hn[j * 16 + i] = hn[j * 16 + i] * rstd * g1n[col] * (1.f + scale[col]) + shift[col]; am = fmaxf(am, fabsf(hn[j * 16 + i])); }
                am = wave_max(am);
                const float s8 = am > 0.f ? am * (1.f / 127.f) : 1.f, inv8 = 1.f / s8;
                unsigned char* xo8 = (dry ? (unsigned char*)(p.ws + WS_DUMMY) + (size_t)(t & 16383) * DM : (unsigned char*)(p.ws + WS_XN8) + (size_t)t * DM);
#pragma unroll
                for (int j = 0; j < 2; ++j) {
                    u32x4 w;
                    w.x = q8pack4(hn[j * 16 + 0], hn[j * 16 + 1], hn[j * 16 + 2], hn[j * 16 + 3], inv8); w.y = q8pack4(hn[j * 16 + 4], hn[j * 16 + 5], hn[j * 16 + 6], hn[j * 16 + 7], inv8);
                    w.z = q8pack4(hn[j * 16 + 8], hn[j * 16 + 9], hn[j * 16 + 10], hn[j * 16 + 11], inv8); w.w = q8pack4(hn[j * 16 + 12], hn[j * 16 + 13], hn[j * 16 + 14], hn[j * 16 + 15], inv8);
                    *(u32x4*)(xo8 + j * 1024 + lane * 16) = w;
                }
                if (lane == 0 && !dry) ((float*)(p.ws + WS_SCL))[SCL_XN + t] = s8;
            } else {
            bf16_t* xo = (dry ? (bf16_t*)(p.ws + WS_DUMMY) + (size_t)(t & 16383) * DM : (bf16_t*)(p.ws + WS_XN) + (size_t)t * DM);
#pragma unroll
            for (int j = 0; j < 2; ++j)
#pragma unroll
                for (int k = 0; k < 2; ++k) {
                    const int col = j * 1024 + lane * 16 + k * 8;
                    float xv[8];
#pragma unroll
                    for (int i = 0; i < 8; ++i) xv[i] = hn[j * 16 + k * 8 + i] * rstd * g1n[col + i] * (1.f + scale[col + i]) + shift[col + i];
                    u32x4 w; w.x = pk2(xv[0], xv[1]); w.y = pk2(xv[2], xv[3]); w.z = pk2(xv[4], xv[5]); w.w = pk2(xv[6], xv[7]);
                    *(u32x4*)(xo + col) = w;
                }
            }
        }
    }
}
#else
#ifndef DRY_MODE
#define DRY_MODE 0
#endif
typedef float f32x2 __attribute__((ext_vector_type(2)));
__device__ __forceinline__ void ph_gather(const Params& p, int l, const bool dry) {
    const int tid = threadIdx.x, lane = tid & 63, wave = tid >> 6;
    const int gw = blockIdx.x * NWAVES + wave, NGW = gridDim.x * NWAVES;
    const bf16_t* XN = (const bf16_t*)(p.ws + WS_XN);
    const unsigned char* UT = (const unsigned char*)(p.ws + WS_UT) + (size_t)l * NEXP * DM;
    const unsigned char* VT = (const unsigned char*)(p.ws + WS_VT) + (size_t)l * NEXP * DM;
    const float* USC = (const float*)(p.ws + WS_USC) + l * NEXP; const float* VSC = (const float*)(p.ws + WS_VSC) + l * NEXP;
    const int* EID = (const int*)(p.ws + WS_EID); const float* GATE = (const float*)(p.ws + WS_GATE);
    const float* mod = (const float*)(p.ws + WS_MOD) + (size_t)l * 9 * 12288;
    const int nrows = (l == DEPTH - 1) ? NLAT : MTOT;
#pragma unroll 1
    for (int t = gw; t < nrows; t += NGW) {
        int xq[8]; float sxl;
        {
            float x[32]; float am = 0.f;
#pragma unroll
            for (int j = 0; j < 2; ++j)
#pragma unroll
                for (int k = 0; k < 2; ++k) {
                    const u32x4 q = *(const u32x4*)(XN + (size_t)t * DM + j * 1024 + lane * 16 + k * 8);
                    float* xx = x + j * 16 + k * 8;
                    xx[0] = bflo(q.x); xx[1] = bfhi(q.x); xx[2] = bflo(q.y); xx[3] = bfhi(q.y); xx[4] = bflo(q.z); xx[5] = bfhi(q.z); xx[6] = bflo(q.w); xx[7] = bfhi(q.w);
                }
#pragma unroll
            for (int i = 0; i < 32; ++i) am = fmaxf(am, fabsf(x[i]));
            sxl = am > 0.f ? am * (1.f / 127.f) : 1.f;
            const float inv = 1.f / sxl;
#pragma unroll
            for (int d = 0; d < 8; ++d) {
                const int q0 = (int)rintf(x[4 * d] * inv), q1 = (int)rintf(x[4 * d + 1] * inv), q2 = (int)rintf(x[4 * d + 2] * inv), q3 = (int)rintf(x[4 * d + 3] * inv);
                xq[d] = (int)(((unsigned)q0 & 0xffu) | (((unsigned)q1 & 0xffu) << 8) | (((unsigned)q2 & 0xffu) << 16) | ((unsigned)q3 << 24));
            }
        }
        const int e0 = EID[(size_t)t * 128 + lane], e1 = EID[(size_t)t * 128 + 64 + lane];
        const float g0 = GATE[(size_t)t * 128 + lane], g1 = GATE[(size_t)t * 128 + 64 + lane];
        const float us0 = USC[e0], us1 = USC[e1], vs0 = VSC[e0], vs1 = VSC[e1];
        float hid0 = 0.f, hid1 = 0.f;
        constexpr int GBU = 8, GBV = 4;
#define G_LOAD(W, TAB, EB, NB) do { _Pragma("unroll") for (int i = 0; i < NB; ++i) { \
            const int id_ = __builtin_amdgcn_readlane((EB) < 64 ? e0 : e1, ((EB) + i) & 63); \
            const unsigned char* row_ = (TAB) + (size_t)id_ * DM + lane * 16; \
            W[i][0] = *(const u32x4*)row_; W[i][1] = *(const u32x4*)(row_ + 1024); } } while (0)
#define G_DOT(W, EB) do { _Pragma("unroll") for (int i = 0; i < GBU; ++i) { int s_ = 0; \
            s_ = __builtin_amdgcn_sdot4((int)W[i][0].x, xq[0], s_, false); s_ = __builtin_amdgcn_sdot4((int)W[i][0].y, xq[1], s_, false); \
            s_ = __builtin_amdgcn_sdot4((int)W[i][0].z, xq[2], s_, false); s_ = __builtin_amdgcn_sdot4((int)W[i][0].w, xq[3], s_, false); \
            s_ = __builtin_amdgcn_sdot4((int)W[i][1].x, xq[4], s_, false); s_ = __builtin_amdgcn_sdot4((int)W[i][1].y, xq[5], s_, false); \
            s_ = __builtin_amdgcn_sdot4((int)W[i][1].z, xq[6], s_, false); s_ = __builtin_amdgcn_sdot4((int)W[i][1].w, xq[7], s_, false); \
            const float tot = wave_total((float)s_ * sxl); \
            if ((((EB) + i) & 63) == lane) { if ((EB) < 64) hid0 = tot; else hid1 = tot; } } } while (0)
#define G_AXPY(W, EB) do { _Pragma("unroll") for (int i = 0; i < GBV; ++i) { \
            const float cf_ = __uint_as_float(__builtin_amdgcn_readlane(__float_as_uint((EB) < 64 ? cf0 : cf1), ((EB) + i) & 63)); \
            const f32x2 mm = {cf_, cf_}; \
            _Pragma("unroll") for (int j = 0; j < 2; ++j) { const unsigned ww[4] = {W[i][j].x, W[i][j].y, W[i][j].z, W[i][j].w}; \
                _Pragma("unroll") for (int k = 0; k < 4; ++k) { \
                    acc[j * 8 + k * 2] += mm * __builtin_amdgcn_cvt_pk_f32_fp8((int)ww[k], false); \
                    acc[j * 8 + k * 2 + 1] += mm * __builtin_amdgcn_cvt_pk_f32_fp8((int)ww[k], true); } } } } while (0)
        u32x4 wa[GBU][2], wb[GBU][2];
        const bool do_u = !(dry && (DRY_MODE == 4 || DRY_MODE == 5)), do_v = !(dry && (DRY_MODE == 3 || DRY_MODE == 5));
        if (do_u) G_LOAD(wa, UT, 0, GBU); else G_LOAD(wa, VT, 0, GBV);
#pragma unroll 1
        for (int eb = 0; eb < (do_u ? 128 : 0); eb += 2 * GBU) {
            G_LOAD(wb, UT, eb + GBU, GBU);
            G_DOT(wa, eb);
            if (eb + 2 * GBU < 128) G_LOAD(wa, UT, eb + 2 * GBU, GBU); else G_LOAD(wa, VT, 0, GBV);
            G_DOT(wb, eb + GBU);
        }
        const float cf0 = gelu_tanh(hid0 * us0) * g0 * vs0, cf1 = gelu_tanh(hid1 * us1) * g1 * vs1;
        f32x2 acc[16];
#pragma unroll
        for (int i = 0; i < 16; ++i) acc[i] = (f32x2){0.f, 0.f};
#pragma unroll 1
        for (int eb = 0; eb < (do_v ? 128 : 0); eb += 2 * GBV) {
            G_LOAD(wb, VT, eb + GBV, GBV);
            G_AXPY(wa, eb);
            if (eb + 2 * GBV < 128) G_LOAD(wa, VT, eb + 2 * GBV, GBV);
            G_AXPY(wb, eb + GBV);
        }
#undef G_LOAD
#undef G_DOT
#undef G_AXPY
        float hn[32];
        float* hrow = t < NLAT ? p.out + (size_t)t * DM : (float*)(p.ws + WS_HC) + (size_t)(t - NLAT) * DM;
        const int bb = t < NLAT ? (t >> 11) : 8;
        const float* gate = mod + (size_t)bb * 12288 + 5 * DM;
#pragma unroll
        for (int j = 0; j < 2; ++j)
#pragma unroll
            for (int k = 0; k < 4; ++k) {
                const int col = j * 1024 + lane * 16 + k * 4;
                const f32x4 hv = *(const f32x4*)(hrow + col), gv = *(const f32x4*)(gate + col);
                const f32x2 a0 = acc[j * 8 + k * 2], a1 = acc[j * 8 + k * 2 + 1];
                f32x4 o;
                o.x = hv.x + gv.x * a0.x; o.y = hv.y + gv.y * a0.y; o.z = hv.z + gv.z * a1.x; o.w = hv.w + gv.w * a1.y;
                *(f32x4*)((dry ? (float*)(p.ws + WS_DUMMY) + (size_t)(t & 16383) * DM : hrow) + col) = o;
                hn[j * 16 + k * 4 + 0] = o.x; hn[j * 16 + k * 4 + 1] = o.y; hn[j * 16 + k * 4 + 2] = o.z; hn[j * 16 + k * 4 + 3] = o.w;
            }
        if (l + 1 < DEPTH) {
            float ss = 0.f;
#pragma unroll
            for (int i = 0; i < 32; ++i) ss += hn[i] * hn[i];
            const float rstd = rsqrtf(wave_total(ss) * (1.f / DM) + EPS);
            const float* g1n = p.norm1_g + (l + 1) * DM;
            const float* shift = mod + (size_t)9 * 12288 + (size_t)bb * 12288;
            const float* scale = shift + DM;
            bf16_t* xo = (dry ? (bf16_t*)(p.ws + WS_DUMMY) + (size_t)(t & 16383) * DM : (bf16_t*)(p.ws + WS_XN) + (size_t)t * DM);
#pragma unroll
            for (int j = 0; j < 2; ++j)
#pragma unroll
                for (int k = 0; k < 2; ++k) {
                    const int col = j * 1024 + lane * 16 + k * 8;
                    float xv[8];
#pragma unroll
                    for (int i = 0; i < 8; ++i) xv[i] = hn[j * 16 + k * 8 + i] * rstd * g1n[col + i] * (1.f + scale[col + i]) + shift[col + i];
                    u32x4 w; w.x = pk2(xv[0], xv[1]); w.y = pk2(xv[2], xv[3]); w.z = pk2(xv[4], xv[5]); w.w = pk2(xv[6], xv[7]);
                    *(u32x4*)(xo + col) = w;
                }
        }
    }
}
#endif
#else
__device__ __forceinline__ float dot8(const u32x4 u, const u32x4 x) {
    float d = bflo(u.x) * bflo(x.x) + bfhi(u.x) * bfhi(x.x);
    d += bflo(u.y) * bflo(x.y) + bfhi(u.y) * bfhi(x.y);
    d += bflo(u.z) * bflo(x.z) + bfhi(u.z) * bfhi(x.z);
    d += bflo(u.w) * bflo(x.w) + bfhi(u.w) * bfhi(x.w);
    return d;
}
__device__ __forceinline__ void ph_gather(const Params& p, int l, const bool dry) {
    const int tid = threadIdx.x, lane = tid & 63, wave = tid >> 6;
    const int gw = blockIdx.x * NWAVES + wave, NGW = gridDim.x * NWAVES;
    const bf16_t* XN = (const bf16_t*)(p.ws + WS_XN);
    const bf16_t* UT = (const bf16_t*)(p.ws + WS_UT) + (size_t)l * NEXP * DM;
    const bf16_t* VT = (const bf16_t*)(p.ws + WS_VT) + (size_t)l * NEXP * DM;
    const int* EID = (const int*)(p.ws + WS_EID); const float* GATE = (const float*)(p.ws + WS_GATE);
    const float* mod = (const float*)(p.ws + WS_MOD) + (size_t)l * 9 * 12288;
    const int nrows = (l == DEPTH - 1) ? NLAT : MTOT;
    for (int t = gw; t < nrows; t += NGW) {
        u32x4 xq[4];
#pragma unroll
        for (int j = 0; j < 4; ++j) xq[j] = *(const u32x4*)(XN + (size_t)t * DM + j * 512 + lane * 8);
        const int e0 = EID[(size_t)t * 128 + lane], e1 = EID[(size_t)t * 128 + 64 + lane];
        const float g0 = GATE[(size_t)t * 128 + lane], g1 = GATE[(size_t)t * 128 + 64 + lane];
        float hid0 = 0.f, hid1 = 0.f;
#pragma unroll 1
        for (int eb = 0; eb < 128; eb += 4) {
            u32x4 uu[4][4];
#pragma unroll
            for (int i = 0; i < 4; ++i) {
                const int e = eb + i;
                const int id = __builtin_amdgcn_readlane(eb < 64 ? e0 : e1, e & 63);
                const u32x4* ur = (const u32x4*)(UT + (size_t)id * DM) + lane;
#pragma unroll
                for (int j = 0; j < 4; ++j) uu[i][j] = ur[j * 64];
            }
#pragma unroll
            for (int i = 0; i < 4; ++i) {
                const int e = eb + i;
                float d = dot8(uu[i][0], xq[0]) + dot8(uu[i][1], xq[1]) + dot8(uu[i][2], xq[2]) + dot8(uu[i][3], xq[3]);
                d = wave_sum(d);
                if ((e & 63) == lane) { if (eb < 64) hid0 = d; else hid1 = d; }
            }
        }
        const float cf0 = gelu_tanh(hid0) * g0, cf1 = gelu_tanh(hid1) * g1;
        float acc[32];
#pragma unroll
        for (int i = 0; i < 32; ++i) acc[i] = 0.f;
#pragma unroll 1
        for (int eb = 0; eb < 128; eb += 4) {
            u32x4 vv[4][4]; float cf[4];
#pragma unroll
            for (int i = 0; i < 4; ++i) {
                const int e = eb + i;
                const int id = __builtin_amdgcn_readlane(eb < 64 ? e0 : e1, e & 63);
                cf[i] = __uint_as_float(__builtin_amdgcn_readlane(__float_as_uint(eb < 64 ? cf0 : cf1), e & 63));
                const u32x4* vr = (const u32x4*)(VT + (size_t)id * DM) + lane;
#pragma unroll
                for (int j = 0; j < 4; ++j) vv[i][j] = vr[j * 64];
            }
#pragma unroll
            for (int i = 0; i < 4; ++i)
#pragma unroll
                for (int j = 0; j < 4; ++j) {
                    acc[j * 8 + 0] += cf[i] * bflo(vv[i][j].x); acc[j * 8 + 1] += cf[i] * bfhi(vv[i][j].x);
                    acc[j * 8 + 2] += cf[i] * bflo(vv[i][j].y); acc[j * 8 + 3] += cf[i] * bfhi(vv[i][j].y);
                    acc[j * 8 + 4] += cf[i] * bflo(vv[i][j].z); acc[j * 8 + 5] += cf[i] * bfhi(vv[i][j].z);
                    acc[j * 8 + 6] += cf[i] * bflo(vv[i][j].w); acc[j * 8 + 7] += cf[i] * bfhi(vv[i][j].w);
                }
        }
        float* hrow = t < NLAT ? p.out + (size_t)t * DM : (float*)(p.ws + WS_HC) + (size_t)(t - NLAT) * DM;
        const int bb = t < NLAT ? (t >> 11) : 8;
        const float* gate = mod + (size_t)bb * 12288 + 5 * DM;
#pragma unroll
        for (int j = 0; j < 4; ++j) {
            const int col = j * 512 + lane * 8;
#pragma unroll
            for (int hh = 0; hh < 2; ++hh) {
                const f32x4 hv = *(const f32x4*)(hrow + col + hh * 4), gv = *(const f32x4*)(gate + col + hh * 4);
                f32x4 o;
                o.x = hv.x + gv.x * acc[j * 8 + hh * 4 + 0]; o.y = hv.y + gv.y * acc[j * 8 + hh * 4 + 1];
                o.z = hv.z + gv.z * acc[j * 8 + hh * 4 + 2]; o.w = hv.w + gv.w * acc[j * 8 + hh * 4 + 3];
                *(f32x4*)(hrow + col + hh * 4) = o;
            }
        }
    }
}

#endif

#define LAS __attribute__((address_space(3)))
#define XB_TMO      128
#define XB_XCNT(j)  (256  + 64 * (j))
#define XB_XSUB(j)  (1280 + 64 * (j))
#define XB_XGEN(j)  (2304 + 64 * (j))
#define XB_TOP      3328
#define XB_TOPGEN   3392
#define XCD_BAR_WORDS 3456
#define XB_SPIN_CAP (1u << 18)

__device__ __forceinline__ unsigned xb_ld(unsigned* p)              { return __hip_atomic_load(p, __ATOMIC_RELAXED, __HIP_MEMORY_SCOPE_AGENT); }
__device__ __forceinline__ unsigned xb_add(unsigned* p, unsigned v) { return __hip_atomic_fetch_add(p, v, __ATOMIC_RELAXED, __HIP_MEMORY_SCOPE_AGENT); }
__device__ __forceinline__ unsigned xb_xcc_id() { return (unsigned)__builtin_amdgcn_s_getreg((3 << 11) | 20) & 0xFu; }
#define XB_SPIN(cond, bar) do { unsigned _sp = 0; while (cond) { __builtin_amdgcn_s_sleep(1); \
    if ((++_sp & 255u) == 0u) { if (xb_ld(&(bar)[XB_TMO])) break; if (_sp > XB_SPIN_CAP) { atomicAdd(&(bar)[XB_TMO], 1u); break; } } } } while (0)

struct XcdBarrier {
    unsigned* bar; unsigned x;
    volatile LAS unsigned* st;
};

__device__ __forceinline__ XcdBarrier xcd_barrier_post(unsigned* bar, volatile LAS unsigned* st) {
    XcdBarrier b; b.bar = bar; b.x = xb_xcc_id(); b.st = st;
    if (threadIdx.x == 0) (void)xb_add(&bar[XB_XCNT(b.x)], 1u);
    return b;
}
__device__ __forceinline__ void xcd_barrier_complete(unsigned* bar, unsigned x, unsigned& nloc, unsigned& nx) {
    const unsigned G = gridDim.x * gridDim.y * gridDim.z;
    unsigned sum, cnt, mine, sp = 0u;
    for (;;) {
        sum = 0u; cnt = 0u; mine = 0u;
#pragma unroll
        for (unsigned j = 0; j < 16; ++j) { const unsigned c = xb_ld(&bar[XB_XCNT(j)]); sum += c; cnt += (c > 0u) ? 1u : 0u; mine = (j == x) ? c : mine; }
        if (sum == G) break;
        __builtin_amdgcn_s_sleep(1);
        if ((++sp & 255u) == 0u) { if (xb_ld(&bar[XB_TMO])) break; if (sp > XB_SPIN_CAP) { atomicAdd(&bar[XB_TMO], 1u); break; } }
    }
    nloc = mine > 0u ? mine : 1u; nx = cnt > 0u ? cnt : 1u;
}

__device__ __forceinline__ void xcd_barrier(const XcdBarrier& b) {
    asm volatile("s_waitcnt vmcnt(0)" ::: "memory");
    __syncthreads();
    if (threadIdx.x == 0) {
        unsigned* bar = b.bar;
        __builtin_amdgcn_s_waitcnt(0);
        unsigned nloc = b.st[0], nx = b.st[1];
        if (nloc == 0u) { xcd_barrier_complete(bar, b.x, nloc, nx); b.st[0] = nloc; b.st[1] = nx; }
        const unsigned old = xb_add(&bar[XB_XSUB(b.x)], 1u);
        const unsigned gen = old / nloc;
        if (old + 1u == (gen + 1u) * nloc) {
            __builtin_amdgcn_fence(__ATOMIC_RELEASE, "agent");
            asm volatile("s_waitcnt vmcnt(0)" ::: "memory");
            const unsigned og = xb_add(&bar[XB_TOP], 1u);
            const unsigned tg = og / nx;
            if (og + 1u == (tg + 1u) * nx) xb_add(&bar[XB_TOPGEN], 1u);
            else XB_SPIN(xb_ld(&bar[XB_TOPGEN]) == tg, bar);
            __builtin_amdgcn_fence(__ATOMIC_ACQUIRE, "agent");
            xb_add(&bar[XB_XGEN(b.x)], 1u);
            asm volatile("s_waitcnt vmcnt(0)" ::: "memory");
        } else {
            XB_SPIN(xb_ld(&bar[XB_XGEN(b.x)]) == gen, bar);
            __builtin_amdgcn_fence(__ATOMIC_ACQUIRE, "agent");
            asm volatile("s_waitcnt vmcnt(0)" ::: "memory");
        }
    }
    __syncthreads();
}

constexpr int NPHASE = 1 + 10 * DEPTH;
template <int S>
__device__ __forceinline__ void run_stage(const Params& p, int l, unsigned char* lds, const bool dry) {
    const bool last = (l == DEPTH - 1);
    const float* mod = (const float*)(p.ws + WS_MOD) + (size_t)l * 9 * 12288;
    if constexpr (S == 1) { if (l == 0) { ph_modulate(p, l, 0); if (GEMM_I8 && !dry) ph_weights_i8(p, lds); } }
    if constexpr (S == 2) {
#if USE_PG8
        pg8::StaticOrder So; So.init(MTOT, INW, (int)gridDim.x, (int)blockIdx.x);
#if GEMM_I8
        pg8::Gemm g{(const bf16_t*)(p.ws + WS_XN8), (const bf16_t*)(p.ws + WS_WIN + (size_t)l * INW * DM), MTOT, INW, DM / 2};
        pg8::EpiBf16I8 E{(bf16_t*)(p.ws + WS_P), INW, (const float*)(p.ws + WS_SCL) + SCL_XN, (const float*)(p.ws + WS_SCL) + SCL_WIN + l * INW};
        pg8::gemm_phase<pg8::EpiBf16I8, pg8::StaticOrder, true, true, true>((PG8_LAS unsigned char*)lds, g, So, E);
#else
        pg8::Gemm g{(const bf16_t*)(p.ws + WS_XN), (const bf16_t*)(p.ws + WS_WIN) + (size_t)l * INW * DM, MTOT, INW, DM};
        pg8::EpiBf16<0> E{(bf16_t*)(p.ws + WS_P), INW, nullptr, 0, 0, 1.f};
        pg8::gemm_phase<pg8::EpiBf16<0>, pg8::StaticOrder, true, true>((PG8_LAS unsigned char*)lds, g, So, E);
#endif
#else
        EpiBf16Store E{(bf16_t*)(p.ws + WS_P), INW};
        gemm_naive(lds, (const bf16_t*)(p.ws + WS_XN), (const bf16_t*)(p.ws + WS_WIN) + (size_t)l * INW * DM, MTOT, INW, DM, E);
#endif
    }
    if constexpr (S == 3) ph_prep(p, l, dry);
    if constexpr (S == 4) {
#if USE_FAST_ATT
        ph_mixers_fast(p, l, lds, dry);
#else
        ph_mixers_naive(p, l, lds);
#endif
    }
    if constexpr (S == 5) ph_ynorm(p, l);
    if constexpr (S == 6) {
#if USE_PG8
        const int M = last ? NLAT : MTOT;
        pg8::StaticOrder So; So.init(M, DM, (int)gridDim.x, (int)blockIdx.x);
#if GEMM_I8
        pg8::Gemm g{(const bf16_t*)(p.ws + WS_XN8), (const bf16_t*)(p.ws + WS_WOUT + (size_t)l * DM * DM), M, DM, DM / 2};
        pg8::EpiResGateI8 E{l == 0 ? p.x : p.out, l == 0 ? p.ctx : (const float*)(p.ws + WS_HC), dry ? (float*)(p.ws + WS_DUMMY) : p.out, dry ? (float*)(p.ws + WS_DUMMY) : (float*)(p.ws + WS_HC), mod + 2 * DM,
                            (const float*)(p.ws + WS_SCL) + SCL_Y, (const float*)(p.ws + WS_SCL) + SCL_WOUT + l * DM};
        pg8::gemm_phase<pg8::EpiResGateI8, pg8::StaticOrder, true, true, true>((PG8_LAS unsigned char*)lds, g, So, E);
#else
        pg8::Gemm g{(const bf16_t*)(p.ws + WS_Y), (const bf16_t*)(p.ws + WS_WOUT) + (size_t)l * DM * DM, M, DM, DM};
        pg8::EpiResGateT E{l == 0 ? p.x : p.out, l == 0 ? p.ctx : (const float*)(p.ws + WS_HC), dry ? (float*)(p.ws + WS_DUMMY) : p.out, dry ? (float*)(p.ws + WS_DUMMY) : (float*)(p.ws + WS_HC), mod + 2 * DM};
        pg8::gemm_phase<pg8::EpiResGateT, pg8::StaticOrder, true, true>((PG8_LAS unsigned char*)lds, g, So, E);
#endif
#if GATHER_I8 && GATHER_4BIT
        if (TABLES_IN_GAPS && l == 0 && !dry) conv4_tables(p, 0, 2 * NEXP, (unsigned*)(p.ws + WS_CTL) + 6144, lds);
#endif
#else
        EpiResGate E{l == 0 ? p.x : p.out, l == 0 ? p.ctx : (const float*)(p.ws + WS_HC), p.out, (float*)(p.ws + WS_HC), mod + 2 * DM};
        gemm_naive(lds, (const bf16_t*)(p.ws + WS_Y), (const bf16_t*)(p.ws + WS_WOUT) + (size_t)l * DM * DM, last ? NLAT : MTOT, DM, DM, E);
#endif
    }
    if constexpr (S == 7) ph_modulate(p, l, 1);
    if constexpr (S == 8) {
#if USE_PG8
        const int M = last ? NLAT : MTOT;
        pg8::Gemm g{(const bf16_t*)(p.ws + WS_XN), (const bf16_t*)(p.ws + WS_WQ) + (size_t)l * DM * DM, M, DM, DM};
        pg8::StaticOrder So; So.init(M, DM, (int)gridDim.x, (int)blockIdx.x);
        pg8::EpiBf16<0> E{(bf16_t*)(p.ws + WS_P), DM, nullptr, 0, 0, 1.f};
        pg8::gemm_phase<pg8::EpiBf16<0>, pg8::StaticOrder, true, true>((PG8_LAS unsigned char*)lds, g, So, E);
#if FUSE_ROUTE
        asm volatile("s_waitcnt vmcnt(0)" ::: "memory");
        __syncthreads();
        ph_route_fast<true>(p, l, lds);
#endif
#if GATHER_I8 && GATHER_4BIT
        if (TABLES_IN_GAPS && l == 0 && !dry) conv4_tables(p, 2 * NEXP, 4 * NEXP, (unsigned*)(p.ws + WS_CTL) + 6208, lds);
#endif
#else
        EpiBf16Store E{(bf16_t*)(p.ws + WS_P), DM};
        gemm_naive(lds, (const bf16_t*)(p.ws + WS_XN), (const bf16_t*)(p.ws + WS_WQ) + (size_t)l * DM * DM, last ? NLAT : MTOT, DM, DM, E);
#endif
    }
    if constexpr (S == 9) {
#if USE_FAST_ROUTE
        if (!FUSE_ROUTE) ph_route_fast<false>(p, l, lds);
#else
        ph_route_naive(p, l);
#endif
    }
    if constexpr (S == 10) ph_gather(p, l, dry);
}
__global__ void __launch_bounds__(NTHREADS) fwd_kernel(Params p) {
    extern __shared__ __attribute__((aligned(16))) unsigned char lds[];
    cg::grid_group grid = cg::this_grid();
    const int lo = p.ph_lo, hi = p.ph_hi;
    volatile LAS unsigned* stw = (volatile LAS unsigned*)((LAS unsigned char*)lds + (LDS_BYTES - 128));
    if (threadIdx.x < 2) stw[threadIdx.x] = 0u;
    __syncthreads();
    const XcdBarrier bar = xcd_barrier_post((unsigned*)(p.ws + WS_CTL + 32768), stw);
#define IN(k) (lo <= (k) && (k) < hi)
#define SEAM(k) do { if (IN(k) && IN((k) + 1)) { if ((k) == 0) grid.sync(); else xcd_barrier(bar); } } while (0)
#define STAGE(S, l) do { constexpr int k_ = 1 + 10 * (l) + (S) - 1; if (IN(k_)) { if constexpr ((REP_MASK >> k_) & 1) { run_stage<S>(p, l, lds, true); xcd_barrier(bar); } run_stage<S>(p, l, lds, false); } SEAM(k_); } while (0)
#define LAYER(l) do { if ((l) == 0) { STAGE(1, l); } STAGE(2, l); STAGE(3, l); STAGE(4, l); STAGE(5, l); STAGE(6, l); STAGE(7, l); STAGE(8, l); if (!FUSE_ROUTE) { STAGE(9, l); } STAGE(10, l); } while (0)
    if (IN(0)) { if constexpr (REP_MASK & 1) { ph_prologue(p, lds); grid.sync(); } ph_prologue(p, lds); }
    SEAM(0);
    LAYER(0);
    LAYER(1);
#undef IN
#undef SEAM
#undef STAGE
#undef LAYER
}

extern "C" void kernel_launch(void* const* d_in, const int* in_sizes, int n_in, void* d_out, int out_size, void* d_ws, size_t ws_size, hipStream_t stream) {
    static int grid_blocks = 0;
    if (grid_blocks == 0) {
        if (n_in != 23 || out_size != NLAT * DM || ws_size < WS_END) { fprintf(stderr, "kernel_launch: unexpected shapes n_in %d out %d ws %zu\n", n_in, out_size, ws_size); grid_blocks = -1; return; }
        if (hipFuncSetAttribute((const void*)fwd_kernel, hipFuncAttributeMaxDynamicSharedMemorySize, LDS_BYTES) != hipSuccess) { fprintf(stderr, "kernel_launch: hipFuncSetAttribute failed\n"); grid_blocks = -1; return; }
        int dev = 0, cus = 0, per_cu = 0;
        hipGetDevice(&dev);
        hipDeviceGetAttribute(&cus, hipDeviceAttributeMultiprocessorCount, dev);
        hipOccupancyMaxActiveBlocksPerMultiprocessor(&per_cu, (const void*)fwd_kernel, NTHREADS, LDS_BYTES);
        if (per_cu < 1 || cus < 1) { fprintf(stderr, "kernel_launch: occupancy query failed (%d per CU, %d CUs)\n", per_cu, cus); grid_blocks = -1; return; }
        grid_blocks = cus * per_cu;
    }
    if (grid_blocks < 0) return;
    Params p{};
    const float** pp = (const float**)&p;
    for (int i = 0; i < 23; ++i) pp[i] = (const float*)d_in[i];
    p.out = (float*)d_out; p.ws = (unsigned char*)d_ws;
    p.ph_lo = 0; p.ph_hi = NPHASE;
    hipMemsetAsync((char*)d_ws + WS_CTL, 0, 131072, stream);
    void* args[] = {&p};
    hipError_t e = hipLaunchCooperativeKernel((const void*)fwd_kernel, dim3(grid_blocks), dim3(NTHREADS), args, LDS_BYTES, stream);
    if (e != hipSuccess) fprintf(stderr, "cooperative launch failed: %s (grid %d)\n", hipGetErrorString(e), grid_blocks);
}
```

```cpp
#include <hip/hip_runtime.h>
#include <hip/hip_cooperative_groups.h>
#include <cstdio>
#include <cstdint>
namespace cg = cooperative_groups;

constexpr int DM = 2048, NB = 8, SEQ = 2048, NCTX = 256, DEPTH = 2;
constexpr int NLAT = NB * SEQ;
constexpr int NCT = NB * NCTX;
constexpr int MTOT = NLAT + NCT;
constexpr int INW = 3584;
constexpr int C_QA = 0, C_KA = 768, C_VA = 1024, C_QB = 1280, C_KB = 2048, C_VB = 2304, C_UC = 2560, C_VC = 3072;
constexpr int NEXP = 16384;
constexpr float EPS = 1e-6f;
constexpr float ATT_SCALE = 0.088388347648318440f;
constexpr int NTHREADS = 512, NWAVES = 8;

constexpr size_t MiB = 1u << 20;
constexpr size_t WS_CTL = 0;
constexpr size_t WS_MOD = 1 * MiB;
constexpr size_t WS_ROPE = 2 * MiB;
constexpr size_t WS_KEYS = 3 * MiB;
constexpr size_t WS_WSC = 4 * MiB;
constexpr size_t WS_USC = 5 * MiB;
constexpr size_t WS_VSC = 6 * MiB;
constexpr size_t WS_WIN = 8 * MiB;
constexpr size_t WS_WOUT = 36 * MiB;
constexpr size_t WS_WQ = 52 * MiB;
constexpr size_t WS_HC = 68 * MiB;
constexpr size_t WS_EID = 84 * MiB;
constexpr size_t WS_GATE = 93 * MiB;
constexpr size_t WS_XN = 104 * MiB;
constexpr size_t WS_Y = 176 * MiB;
constexpr size_t WS_P = 248 * MiB;
constexpr size_t WS_UT = 376 * MiB;
constexpr size_t WS_VT = 504 * MiB;
constexpr size_t WS_SCL = 102 * MiB;
constexpr size_t SCL_WIN = 0, SCL_WOUT = 2 * 3584, SCL_XN = SCL_WOUT + 2 * 2048, SCL_Y = SCL_XN + 18432, SCL_WQ = SCL_Y + 18432;
constexpr int NCM = 3584 + 2048 + 2048;
constexpr size_t WS_XN8 = 784 * MiB;
constexpr size_t CTL_COLMAX = 65536;
constexpr size_t WS_DUMMY = 640 * MiB;
constexpr size_t WS_END = 820 * MiB;

constexpr int LDS_BYTES = 147456;

typedef unsigned short bf16_t;
typedef float f32x4 __attribute__((ext_vector_type(4)));
typedef unsigned u32x4 __attribute__((ext_vector_type(4)));
typedef unsigned u32x2 __attribute__((ext_vector_type(2)));

struct Params {
    const float *x, *c, *ctx, *c_ctx, *w_ada, *b_ada, *norm1_g, *norm2_g, *w_in, *qn_a, *kn_a, *qn_b, *kn_b, *sink_b, *vn_c, *ws_c, *bs_c,
        *g_group, *w_out, *peer_wq, *peer_keys, *peer_u, *peer_v;
    float* out;
    unsigned char* ws;
    int ph_lo, ph_hi;
};

__device__ __forceinline__ float bf2f(unsigned v) { return __uint_as_float(v << 16); }
__device__ __forceinline__ float bflo(unsigned w) { return __uint_as_float(w << 16); }
__device__ __forceinline__ float bfhi(unsigned w) { return __uint_as_float(w & 0xffff0000u); }
__device__ __forceinline__ unsigned f2bf(float f) { unsigned u = __float_as_uint(f); return (u + 0x7fffu + ((u >> 16) & 1u)) >> 16; }
__device__ __forceinline__ unsigned pk2(float lo, float hi) { return f2bf(lo) | (f2bf(hi) << 16); }
__device__ __forceinline__ float wave_sum(float v) {
#pragma unroll
    for (int o = 32; o >= 1; o >>= 1) v += __shfl_xor(v, o);
    return v;
}
__device__ __forceinline__ float wave_max(float v) {
#pragma unroll
    for (int o = 32; o >= 1; o >>= 1) v = fmaxf(v, __shfl_xor(v, o));
    return v;
}
__device__ __forceinline__ float gelu_tanh(float x) {
    const float y = 0.7978845608028654f * (x + 0.044715f * x * x * x);
    const float t = 1.f - 2.f / (__expf(2.f * y) + 1.f);
    return 0.5f * x * (1.f + t);
}
__device__ __forceinline__ float silu(float x) { return x / (1.f + __expf(-x)); }
#define LDS_WAIT() asm volatile("s_waitcnt lgkmcnt(0)" ::: "memory")
#ifndef GATHER_I8
#define GATHER_I8 1
#endif
#ifndef GATHER_4BIT
#define GATHER_4BIT 1
#endif
constexpr int ROW4 = 1152;
#ifndef FUSE_ROUTE
#define FUSE_ROUTE 1
#endif
#ifndef GEMM_I8
#define GEMM_I8 1
#endif
#ifndef GEMM3_I8
#define GEMM3_I8 1
#endif
#ifndef REP_MASK
#define REP_MASK 0
#endif

__device__ __forceinline__ void transpose_item(const float* W, int K, int N, bf16_t* WT, const float* gk, float* scr, int item, int lane) {
    const int nblk = N / 32, kb = item / nblk, nb = item % nblk, k0 = 64 * kb, n0 = 32 * nb;
#pragma unroll 8
    for (int i = 0; i < 32; ++i) {
        const int kk = 2 * i + (lane >> 5);
        float v = W[(size_t)(k0 + kk) * N + n0 + (lane & 31)];
        if (gk) v *= gk[k0 + kk];
        scr[kk * 33 + (lane & 31)] = v;
    }
    LDS_WAIT();
    const int c = lane & 7;
#pragma unroll
    for (int j = 0; j < 4; ++j) {
        const int n = (lane >> 3) + 8 * j;
        const float* s = scr + (8 * c) * 33 + n;
        u32x4 o;
        o.x = pk2(s[0 * 33], s[1 * 33]); o.y = pk2(s[2 * 33], s[3 * 33]); o.z = pk2(s[4 * 33], s[5 * 33]); o.w = pk2(s[6 * 33], s[7 * 33]);
        *(u32x4*)(WT + (size_t)(n0 + n) * K + k0 + 8 * c) = o;
    }
    LDS_WAIT();
}

__device__ __forceinline__ void colmax_item(const float* W, int N, const float* gk, unsigned* cmax, int item, int lane) {
    const int nblk = N / 32, kb = item / nblk, nb = item % nblk, k0 = 64 * kb, n0 = 32 * nb;
    f32x4 v[8];
#pragma unroll
    for (int i = 0; i < 8; ++i) v[i] = *(const f32x4*)(W + (size_t)(k0 + 8 * i + (lane >> 3)) * N + n0 + 4 * (lane & 7));
    float m0 = 0.f, m1 = 0.f, m2 = 0.f, m3 = 0.f;
#pragma unroll
    for (int i = 0; i < 8; ++i) {
        const float g = gk ? fabsf(gk[k0 + 8 * i + (lane >> 3)]) : 1.f;
        m0 = fmaxf(m0, fabsf(v[i].x) * g); m1 = fmaxf(m1, fabsf(v[i].y) * g); m2 = fmaxf(m2, fabsf(v[i].z) * g); m3 = fmaxf(m3, fabsf(v[i].w) * g);
    }
#pragma unroll
    for (int o = 8; o <= 32; o <<= 1) { m0 = fmaxf(m0, __shfl_xor(m0, o)); m1 = fmaxf(m1, __shfl_xor(m1, o)); m2 = fmaxf(m2, __shfl_xor(m2, o)); m3 = fmaxf(m3, __shfl_xor(m3, o)); }
    if (lane < 8) {
        unsigned* c = cmax + n0 + 4 * lane;
        atomicMax(c + 0, __float_as_uint(m0)); atomicMax(c + 1, __float_as_uint(m1)); atomicMax(c + 2, __float_as_uint(m2)); atomicMax(c + 3, __float_as_uint(m3));
    }
}
__device__ __forceinline__ void transpose_item_i8(const float* W, int K, int N, unsigned char* W8, const float* gk, const unsigned* cmax, float* scr, int item, int lane) {
    const int nblk = N / 32, kb = item / nblk, nb = item % nblk, k0 = 64 * kb, n0 = 32 * nb;
    f32x4 v[8];
#pragma unroll
    for (int i = 0; i < 8; ++i) v[i] = *(const f32x4*)(W + (size_t)(k0 + 8 * i + (lane >> 3)) * N + n0 + 4 * (lane & 7));
    float inv[4];
#pragma unroll
    for (int c = 0; c < 4; ++c) { const float m = __uint_as_float(cmax[n0 + 4 * (lane & 7) + c]); inv[c] = m > 0.f ? 127.f / m : 0.f; }
#pragma unroll
    for (int i = 0; i < 8; ++i) {
        const int kk = 8 * i + (lane >> 3);
        const float g = gk ? gk[k0 + kk] : 1.f;
        float* d = scr + kk * 33 + 4 * (lane & 7);
        d[0] = rintf(v[i].x * g * inv[0]); d[1] = rintf(v[i].y * g * inv[1]); d[2] = rintf(v[i].z * g * inv[2]); d[3] = rintf(v[i].w * g * inv[3]);
    }
    LDS_WAIT();
    const int c = lane & 7;
#pragma unroll
    for (int j = 0; j < 4; ++j) {
        const int n = (lane >> 3) + 8 * j;
        const float* s = scr + (8 * c) * 33 + n;
        unsigned lo = 0u, hi = 0u;
#pragma unroll
        for (int i = 0; i < 4; ++i) { lo |= ((unsigned)(int)s[i * 33] & 0xffu) << (8 * i); hi |= ((unsigned)(int)s[(4 + i) * 33] & 0xffu) << (8 * i); }
        u32x2 o; o.x = lo; o.y = hi;
        *(u32x2*)(W8 + (size_t)(n0 + n) * K + k0 + 8 * c) = o;
    }
    LDS_WAIT();
}
__device__ __forceinline__ void ph_weights_i8(const Params& p, unsigned char* lds) {
    const int tid = threadIdx.x, lane = tid & 63, wave = tid >> 6;
    const int gw = blockIdx.x * NWAVES + wave, NGW = gridDim.x * NWAVES;
    float* scr = (float*)(lds + wave * 8704);
    const unsigned* cm = (const unsigned*)(p.ws + WS_CTL + CTL_COLMAX);
    constexpr int I_IN = 32 * 112, I_SQ = 32 * 64, I_L = I_IN + I_SQ + (GEMM3_I8 ? I_SQ : 0);
    for (int it = gw; it < 2 * I_L; it += NGW) {
        const int l = it / I_L; const int r = it % I_L;
        if (r < I_IN) transpose_item_i8(p.w_in + (size_t)l * DM * INW, DM, INW, (unsigned char*)(p.ws + WS_WIN) + (size_t)l * INW * DM, nullptr, cm + l * NCM, scr, r, lane);
        else if (r < I_IN + I_SQ) transpose_item_i8(p.w_out + (size_t)l * DM * DM, DM, DM, (unsigned char*)(p.ws + WS_WOUT) + (size_t)l * DM * DM, p.g_group + l * DM, cm + l * NCM + INW, scr, r - I_IN, lane);
        else transpose_item_i8(p.peer_wq + (size_t)l * DM * DM, DM, DM, (unsigned char*)(p.ws + WS_WQ) + (size_t)l * DM * DM, nullptr, cm + l * NCM + INW + DM, scr, r - I_IN - I_SQ, lane);
    }
    float* S = (float*)(p.ws + WS_SCL);
    for (int i = blockIdx.x * NTHREADS + tid; i < 2 * NCM; i += gridDim.x * NTHREADS) {
        const int l = i / NCM, n = i % NCM;
        const float m = __uint_as_float(cm[i]); const float s = m > 0.f ? m * (1.f / 127.f) : 1.f;
        if (n < INW) S[SCL_WIN + l * INW + n] = s; else if (n < INW + DM) S[SCL_WOUT + l * DM + (n - INW)] = s; else S[SCL_WQ + l * DM + (n - INW - DM)] = s;
    }
}
__device__ __forceinline__ void cvt_range(const float* src, bf16_t* dst, size_t n8, size_t gtid, size_t gthreads) {
    for (size_t i = gtid; i < n8; i += gthreads) {
        const f32x4 a = *(const f32x4*)(src + i * 8), b = *(const f32x4*)(src + i * 8 + 4);
        u32x4 o; o.x = pk2(a.x, a.y); o.y = pk2(a.z, a.w); o.z = pk2(b.x, b.y); o.w = pk2(b.z, b.w);
        *(u32x4*)(dst + i * 8) = o;
    }
}

#if GATHER_I8 && GATHER_4BIT
__device__ __forceinline__ void conv4_row(const f32x4 (&v)[8], const bool isv, unsigned char* drow, int lane) {
    float am = 0.f;
#pragma unroll
    for (int i = 0; i < 8; ++i) am = fmaxf(am, fmaxf(fmaxf(fabsf(v[i].x), fabsf(v[i].y)), fmaxf(fabsf(v[i].z), fabsf(v[i].w))));
    const float s0 = am > 0.f ? am * (isv ? (1.f / 6.f) : (1.f / 7.f)) : 1.f;
    const unsigned sb = (__float_as_uint(s0) + 0xffffu) >> 16;
    const float inv = 1.f / __uint_as_float(sb << 16);
    u32x4 o; unsigned w[4];
#pragma unroll
    for (int d = 0; d < 4; ++d) {
        const f32x4 a = v[2 * d], b = v[2 * d + 1];
        const float e[8] = {a.x * inv, a.y * inv, a.z * inv, a.w * inv, b.x * inv, b.y * inv, b.z * inv, b.w * inv};
        unsigned acc = 0u;
        if (isv) {
            acc = __builtin_amdgcn_cvt_scalef32_pk_fp4_f32(acc, e[0], e[1], 1.0f, 0);
            acc = __builtin_amdgcn_cvt_scalef32_pk_fp4_f32(acc, e[2], e[3], 1.0f, 1);
            acc = __builtin_amdgcn_cvt_scalef32_pk_fp4_f32(acc, e[4], e[5], 1.0f, 2);
            acc = __builtin_amdgcn_cvt_scalef32_pk_fp4_f32(acc, e[6], e[7], 1.0f, 3);
        } else {
#pragma unroll
            for (int i = 0; i < 8; ++i) {
                const int q = (int)fminf(fmaxf(rintf(e[i]), -7.f), 7.f);
                acc |= ((unsigned)q & 0xFu) << (8 * (i >> 1) + 4 * (i & 1));
            }
        }
        w[d] = acc;
    }
    o.x = w[0]; o.y = w[1]; o.z = w[2]; o.w = w[3];
    *(u32x4*)(drow + lane * 16) = o;
    *(unsigned short*)(drow + 1024 + lane * 2) = (unsigned short)sb;
}
#endif
#if GATHER_I8 && GATHER_4BIT
#ifndef TABLES_IN_GAPS
#define TABLES_IN_GAPS 1
#endif
__device__ __forceinline__ void conv4_tables(const Params& p, int r0, int r1, unsigned* ctr, unsigned char* lds) {
    const int tid = threadIdx.x, lane = tid & 63, wave = tid >> 6;
    unsigned char* ws = p.ws;
    volatile unsigned* shw = (volatile unsigned*)(lds + LDS_BYTES - 64);
    const int nchunk = (r1 - r0) / 64;
    for (int it = 0;; ++it) {
        int cbeg, cstep, cend;
        if (ctr) {
            __syncthreads();
            if (tid == 0) *shw = atomicAdd(ctr, 1u);
            __syncthreads();
            const int c = (int)*shw; if (c >= nchunk) break;
            cbeg = r0 + c * 64 + wave; cstep = NWAVES; cend = r0 + c * 64 + 64;
        } else {
            if (it > 0) break;
            cbeg = r0 + blockIdx.x * NWAVES + wave; cstep = gridDim.x * NWAVES; cend = r1;
        }
        for (int r = cbeg; r < cend; r += 2 * cstep) {
            const int r2 = r + cstep; const bool has2 = r2 < cend; const int rb = has2 ? r2 : r;
            const bool isvA = r >= 2 * NEXP, isvB = rb >= 2 * NEXP; const int rrA = isvA ? r - 2 * NEXP : r, rrB = isvB ? rb - 2 * NEXP : rb;
            const float* srowA = (isvA ? p.peer_v : p.peer_u) + (size_t)rrA * DM;
            const float* srowB = (isvB ? p.peer_v : p.peer_u) + (size_t)rrB * DM;
            f32x4 va[8], vb[8];
#pragma unroll
            for (int j = 0; j < 2; ++j)
#pragma unroll
                for (int k = 0; k < 4; ++k) { va[j * 4 + k] = *(const f32x4*)(srowA + j * 1024 + lane * 16 + k * 4); vb[j * 4 + k] = *(const f32x4*)(srowB + j * 1024 + lane * 16 + k * 4); }
            conv4_row(va, isvA, (unsigned char*)(ws + (isvA ? WS_VT : WS_UT)) + (size_t)rrA * ROW4, lane);
            if (has2) conv4_row(vb, isvB, (unsigned char*)(ws + (isvB ? WS_VT : WS_UT)) + (size_t)rrB * ROW4, lane);
        }
    }
}
#endif
__device__ __forceinline__ void ph_prologue(const Params& p, unsigned char* lds) {
    const int tid = threadIdx.x, lane = tid & 63, wave = tid >> 6;
    const int gw = blockIdx.x * NWAVES + wave, NGW = gridDim.x * NWAVES;
    unsigned char* ws = p.ws;
    {
        float* sT = (float*)lds;
        float* red = (float*)(lds + 2048 * 12 * 4);
        for (int i = tid; i < 2048 * 9; i += NTHREADS) {
            const int k = i / 9, bb = i % 9;
            const float v = bb < 8 ? p.c[bb * DM + k] : p.c_ctx[k];
            sT[k * 12 + bb] = silu(v);
        }
        __syncthreads();
        const int cq = lane & 7, ks = tid >> 3;
        for (int u = blockIdx.x; u < 768; u += gridDim.x) {
            const int l = u / 384, n0 = (u % 384) * 32;
            const float* W = p.w_ada + (size_t)l * DM * 12288 + n0 + cq * 4;
            float acc[9][4];
#pragma unroll
            for (int b = 0; b < 9; ++b)
#pragma unroll
                for (int j = 0; j < 4; ++j) acc[b][j] = 0.f;
#pragma unroll 8
            for (int i = 0; i < 32; ++i) {
                const int k = ks + 64 * i;
                const f32x4 w = *(const f32x4*)(W + (size_t)k * 12288);
                const f32x4 s0 = *(const f32x4*)(sT + k * 12), s1 = *(const f32x4*)(sT + k * 12 + 4);
                const float s8 = sT[k * 12 + 8];
                const float sv[9] = {s0.x, s0.y, s0.z, s0.w, s1.x, s1.y, s1.z, s1.w, s8};
#pragma unroll
                for (int b = 0; b < 9; ++b) { acc[b][0] += sv[b] * w.x; acc[b][1] += sv[b] * w.y; acc[b][2] += sv[b] * w.z; acc[b][3] += sv[b] * w.w; }
            }
#pragma unroll
            for (int b = 0; b < 9; ++b)
#pragma unroll
                for (int j = 0; j < 4; ++j) {
                    float v = acc[b][j];
                    v += __shfl_xor(v, 8); v += __shfl_xor(v, 16); v += __shfl_xor(v, 32);
                    acc[b][j] = v;
                }
            if (lane < 8) {
#pragma unroll
                for (int b = 0; b < 9; ++b)
#pragma unroll
                    for (int j = 0; j < 4; ++j) red[(wave * 8 + cq) * 36 + b * 4 + j] = acc[b][j];
            }
            __syncthreads();
            if (tid < 288) {
                const int b = tid / 32, col = tid % 32, q = col >> 2, j = col & 3;
                float s = 0.f;
#pragma unroll
                for (int w = 0; w < 8; ++w) s += red[(w * 8 + q) * 36 + b * 4 + j];
                const int n = n0 + col;
                ((float*)(ws + WS_MOD))[(size_t)(l * 9 + b) * 12288 + n] = s + p.b_ada[l * 12288 + n];
            }
            __syncthreads();
        }
    }
    __syncthreads();
    {
        float* scr = (float*)(lds + wave * 8704);
        constexpr int I_IN = 32 * 112, I_SQ = 32 * 64, I_L = I_IN + 2 * I_SQ;
        unsigned* cm = (unsigned*)(ws + WS_CTL + CTL_COLMAX);
        for (int it = gw; it < 2 * I_L; it += NGW) {
            const int l = it / I_L; int r = it % I_L;
            if (r < I_IN) {
                if (GEMM_I8) colmax_item(p.w_in + (size_t)l * DM * INW, INW, nullptr, cm + l * NCM, r, lane);
                else transpose_item(p.w_in + (size_t)l * DM * INW, DM, INW, (bf16_t*)(ws + WS_WIN) + (size_t)l * INW * DM, nullptr, scr, r, lane);
                continue; }
            r -= I_IN;
            if (r < I_SQ) {
                if (GEMM_I8) colmax_item(p.w_out + (size_t)l * DM * DM, DM, p.g_group + l * DM, cm + l * NCM + INW, r, lane);
                else transpose_item(p.w_out + (size_t)l * DM * DM, DM, DM, (bf16_t*)(ws + WS_WOUT) + (size_t)l * DM * DM, p.g_group + l * DM, scr, r, lane);
                continue; }
            r -= I_SQ;
            if (GEMM_I8 && GEMM3_I8) colmax_item(p.peer_wq + (size_t)l * DM * DM, DM, nullptr, cm + l * NCM + INW + DM, r, lane);
            else transpose_item(p.peer_wq + (size_t)l * DM * DM, DM, DM, (bf16_t*)(ws + WS_WQ) + (size_t)l * DM * DM, nullptr, scr, r, lane);
        }
    }
    {
        const size_t gtid = (size_t)blockIdx.x * NTHREADS + tid, gth = (size_t)gridDim.x * NTHREADS;
        cvt_range(p.peer_keys, (bf16_t*)(ws + WS_KEYS), (size_t)2 * 8 * 2 * 128 * 128 / 8, gtid, gth);
        cvt_range(p.ws_c, (bf16_t*)(ws + WS_WSC), (size_t)2 * 4 * 128 * 128 / 8, gtid, gth);
#if GATHER_I8 && GATHER_4BIT
        if (!TABLES_IN_GAPS) conv4_tables(p, 0, 4 * NEXP, nullptr, lds);
#elif GATHER_I8
        for (int r = gw; r < 4 * NEXP; r += NGW) {
            const bool isv = r >= 2 * NEXP; const int rr = isv ? r - 2 * NEXP : r;
            const float* srow = (isv ? p.peer_v : p.peer_u) + (size_t)rr * DM;
            f32x4 v[8]; float am = 0.f;
#pragma unroll
            for (int j = 0; j < 2; ++j)
#pragma unroll
                for (int k = 0; k < 4; ++k) {
                    v[j * 4 + k] = *(const f32x4*)(srow + j * 1024 + lane * 16 + k * 4);
                    am = fmaxf(am, fmaxf(fmaxf(fabsf(v[j * 4 + k].x), fabsf(v[j * 4 + k].y)), fmaxf(fabsf(v[j * 4 + k].z), fabsf(v[j * 4 + k].w))));
                }
            am = wave_max(am);
            const float s = am > 0.f ? am * (isv ? (1.f / 443.f) : (1.f / 127.f)) : 1.f, inv = 1.f / s;
            unsigned char* drow = (unsigned char*)(ws + (isv ? WS_VT : WS_UT)) + (size_t)rr * DM;
#pragma unroll
            for (int j = 0; j < 2; ++j) {
                u32x4 o; unsigned w[4];
#pragma unroll
                for (int k = 0; k < 4; ++k) {
                    const f32x4 a = v[j * 4 + k];
                    if (isv) {
                        int pk = __builtin_amdgcn_cvt_pk_fp8_f32(a.x * inv, a.y * inv, 0, false);
                        pk = __builtin_amdgcn_cvt_pk_fp8_f32(a.z * inv, a.w * inv, pk, true);
                        w[k] = (unsigned)pk;
                    } else {
                        const int q0 = (int)rintf(a.x * inv), q1 = (int)rintf(a.y * inv), q2 = (int)rintf(a.z * inv), q3 = (int)rintf(a.w * inv);
                        w[k] = ((unsigned)q0 & 0xffu) | (((unsigned)q1 & 0xffu) << 8) | (((unsigned)q2 & 0xffu) << 16) | ((unsigned)q3 << 24);
                    }
                }
                o.x = w[0]; o.y = w[1]; o.z = w[2]; o.w = w[3];
                *(u32x4*)(drow + j * 1024 + lane * 16) = o;
            }
            if (lane == 0) ((float*)(ws + (isv ? WS_VSC : WS_USC)))[rr] = s;
        }
#else
        cvt_range(p.peer_u, (bf16_t*)(ws + WS_UT), (size_t)2 * NEXP * DM / 8, gtid, gth);
        cvt_range(p.peer_v, (bf16_t*)(ws + WS_VT), (size_t)2 * NEXP * DM / 8, gtid, gth);
#endif
        float* rope = (float*)(ws + WS_ROPE);
        for (size_t i = gtid; i < (size_t)2048 * 64; i += gth) {
            const int t = (int)(i >> 6), f = (int)(i & 63), fi = f & 31;
            const float pos = (f < 32) ? (float)(t >> 6) : (float)(t & 63);
            const float inv = powf(10000.0f, -(float)fi / 32.0f);
            const float ang = pos * inv;
            rope[i * 2] = cosf(ang); rope[i * 2 + 1] = sinf(ang);
        }
    }
}


__device__ __forceinline__ unsigned q8pack4(float a, float b, float c, float d, float inv) {
    const int q0 = (int)rintf(a * inv), q1 = (int)rintf(b * inv), q2 = (int)rintf(c * inv), q3 = (int)rintf(d * inv);
    return ((unsigned)q0 & 0xffu) | (((unsigned)q1 & 0xffu) << 8) | (((unsigned)q2 & 0xffu) << 16) | ((unsigned)q3 << 24);
}
__device__ __forceinline__ void modulate_store(const f32x4 (&v)[8], float rstd, const float* g, const float* shift, const float* scale, bf16_t* dst, int lane) {
#pragma unroll
    for (int j = 0; j < 8; ++j) {
        const int col = j * 256 + lane * 4;
        const f32x4 gg = *(const f32x4*)(g + col), sc = *(const f32x4*)(scale + col), sh = *(const f32x4*)(shift + col);
        const f32x4 o = v[j] * rstd * gg * (1.f + sc) + sh;
        u32x2 w; w.x = pk2(o.x, o.y); w.y = pk2(o.z, o.w);
        *(u32x2*)(dst + col) = w;
    }
}
__device__ __forceinline__ void modulate_store_i8(const f32x4 (&v)[8], float rstd, const float* g, const float* shift, const float* scale, unsigned char* dst, float* sdst, int lane, const float levels) {
    f32x4 o[8]; float am = 0.f;
#pragma unroll
    for (int j = 0; j < 8; ++j) {
        const int col = j * 256 + lane * 4;
        const f32x4 gg = *(const f32x4*)(g + col), sc = *(const f32x4*)(scale + col), sh = *(const f32x4*)(shift + col);
        o[j] = v[j] * rstd * gg * (1.f + sc) + sh;
        am = fmaxf(am, fmaxf(fmaxf(fabsf(o[j].x), fabsf(o[j].y)), fmaxf(fabsf(o[j].z), fabsf(o[j].w))));
    }
    am = wave_max(am);
    const float s = am > 0.f ? am / levels : 1.f, inv = 1.f / s;
#pragma unroll
    for (int j = 0; j < 8; ++j) *(unsigned*)(dst + j * 256 + lane * 4) = q8pack4(o[j].x, o[j].y, o[j].z, o[j].w, inv);
    if (lane == 0) *sdst = s;
}
__device__ __forceinline__ void ph_modulate(const Params& p, int l, int which) {
    const int tid = threadIdx.x, lane = tid & 63, wave = tid >> 6;
    const int gw = blockIdx.x * NWAVES + wave, NGW = gridDim.x * NWAVES;
    const int nrows = (which == 1 && l == DEPTH - 1) ? NLAT : MTOT;
    const float* g = (which == 0 ? p.norm1_g : p.norm2_g) + l * DM;
    const float* mod = (const float*)(p.ws + WS_MOD) + (size_t)l * 9 * 12288;
    const float* srcLat = (which == 0 && l == 0) ? p.x : p.out;
    const float* srcCtx = (which == 0 && l == 0) ? p.ctx : (const float*)(p.ws + WS_HC);
    bf16_t* XN = (bf16_t*)(p.ws + WS_XN);
    const int moff = (which == 0 ? 0 : 3) * DM;
#pragma unroll 1
    for (int r = gw; r < nrows; r += 2 * NGW) {
        const int r2 = r + NGW; const bool has2 = r2 < nrows; const int rb = has2 ? r2 : r;
        const float* srcA = r < NLAT ? srcLat + (size_t)r * DM : srcCtx + (size_t)(r - NLAT) * DM;
        const float* srcB = rb < NLAT ? srcLat + (size_t)rb * DM : srcCtx + (size_t)(rb - NLAT) * DM;
        f32x4 va[8], vb[8]; float sa = 0.f, sb = 0.f;
#pragma unroll
        for (int j = 0; j < 8; ++j) { va[j] = *(const f32x4*)(srcA + j * 256 + lane * 4); vb[j] = *(const f32x4*)(srcB + j * 256 + lane * 4); }
#pragma unroll
        for (int j = 0; j < 8; ++j) { sa += va[j].x * va[j].x + va[j].y * va[j].y + va[j].z * va[j].z + va[j].w * va[j].w; sb += vb[j].x * vb[j].x + vb[j].y * vb[j].y + vb[j].z * vb[j].z + vb[j].w * vb[j].w; }
        sa = wave_sum(sa); sb = wave_sum(sb);
        const float* shA = mod + (size_t)(r < NLAT ? (r >> 11) : 8) * 12288 + moff;
        const bool i8 = GEMM_I8 && (which == 0 || GEMM3_I8); const float lv = which == 0 ? 127.f : 119.f;
        unsigned char* XN8 = (unsigned char*)(p.ws + WS_XN8); float* SXN = (float*)(p.ws + WS_SCL) + SCL_XN;
        if (i8) modulate_store_i8(va, rsqrtf(sa * (1.f / DM) + EPS), g, shA, shA + DM, XN8 + (size_t)r * DM, SXN + r, lane, lv);
        else modulate_store(va, rsqrtf(sa * (1.f / DM) + EPS), g, shA, shA + DM, XN + (size_t)r * DM, lane);
        if (has2) {
            const float* shB = mod + (size_t)(r2 < NLAT ? (r2 >> 11) : 8) * 12288 + moff;
            if (i8) modulate_store_i8(vb, rsqrtf(sb * (1.f / DM) + EPS), g, shB, shB + DM, XN8 + (size_t)r2 * DM, SXN + r2, lane, lv);
            else modulate_store(vb, rsqrtf(sb * (1.f / DM) + EPS), g, shB, shB + DM, XN + (size_t)r2 * DM, lane);
        }
    }
}

struct EpiBf16Store {
    bf16_t* O; int ldc;
    __device__ __forceinline__ void operator()(int row, int col, const float* a) const {
        u32x4 w; w.x = pk2(a[0], a[1]); w.y = pk2(a[2], a[3]); w.z = pk2(a[4], a[5]); w.w = pk2(a[6], a[7]);
        *(u32x4*)(O + (size_t)row * ldc + col) = w;
    }
};
struct EpiResGate {
    const float *resLat, *resCtx; float *outLat, *outCtx; const float* gate;
    __device__ __forceinline__ void operator()(int row, int col, const float* a) const {
        const int bb = row < NLAT ? (row >> 11) : 8;
        const float* gp = gate + (size_t)bb * 12288 + col;
        const float* rp = row < NLAT ? resLat + (size_t)row * DM + col : resCtx + (size_t)(row - NLAT) * DM + col;
        float* op = row < NLAT ? outLat + (size_t)row * DM + col : outCtx + (size_t)(row - NLAT) * DM + col;
        const f32x4 g0 = *(const f32x4*)gp, g1 = *(const f32x4*)(gp + 4), r0 = *(const f32x4*)rp, r1 = *(const f32x4*)(rp + 4);
        f32x4 o0, o1;
        o0.x = r0.x + g0.x * a[0]; o0.y = r0.y + g0.y * a[1]; o0.z = r0.z + g0.z * a[2]; o0.w = r0.w + g0.w * a[3];
        o1.x = r1.x + g1.x * a[4]; o1.y = r1.y + g1.y * a[5]; o1.z = r1.z + g1.z * a[6]; o1.w = r1.w + g1.w * a[7];
        *(f32x4*)op = o0; *(f32x4*)(op + 4) = o1;
    }
};
template <class Epi>
__device__ __forceinline__ void gemm_naive(unsigned char* lds, const bf16_t* A, const bf16_t* Bt, int M, int N, int K, const Epi& E) {
    float* As = (float*)lds;
    float* Bs = As + 32 * 132;
    const int tid = threadIdx.x, tx = tid & 15, ty = tid >> 4;
    const int lrow = tid >> 2, lkc = (tid & 3) * 8;
    const int nM = M / 128, nN = N / 128;
    for (int u = blockIdx.x; u < nM * nN; u += gridDim.x) {
        const int pm = u / nN, pn = u % nN, m0 = pm * 128, n0 = pn * 128;
        float acc[4][8];
#pragma unroll
        for (int i = 0; i < 4; ++i)
#pragma unroll
            for (int j = 0; j < 8; ++j) acc[i][j] = 0.f;
        for (int k0 = 0; k0 < K; k0 += 32) {
            const u32x4 av = *(const u32x4*)(A + (size_t)(m0 + lrow) * K + k0 + lkc);
            const u32x4 bv = *(const u32x4*)(Bt + (size_t)(n0 + lrow) * K + k0 + lkc);
            __syncthreads();
            As[(lkc + 0) * 132 + lrow] = bflo(av.x); As[(lkc + 1) * 132 + lrow] = bfhi(av.x);
            As[(lkc + 2) * 132 + lrow] = bflo(av.y); As[(lkc + 3) * 132 + lrow] = bfhi(av.y);
            As[(lkc + 4) * 132 + lrow] = bflo(av.z); As[(lkc + 5) * 132 + lrow] = bfhi(av.z);
            As[(lkc + 6) * 132 + lrow] = bflo(av.w); As[(lkc + 7) * 132 + lrow] = bfhi(av.w);
            Bs[(lkc + 0) * 132 + lrow] = bflo(bv.x); Bs[(lkc + 1) * 132 + lrow] = bfhi(bv.x);
            Bs[(lkc + 2) * 132 + lrow] = bflo(bv.y); Bs[(lkc + 3) * 132 + lrow] = bfhi(bv.y);
            Bs[(lkc + 4) * 132 + lrow] = bflo(bv.z); Bs[(lkc + 5) * 132 + lrow] = bfhi(bv.z);
            Bs[(lkc + 6) * 132 + lrow] = bflo(bv.w); Bs[(lkc + 7) * 132 + lrow] = bfhi(bv.w);
            __syncthreads();
#pragma unroll 8
            for (int k = 0; k < 32; ++k) {
                const f32x4 a = *(const f32x4*)(As + k * 132 + ty * 4);
                const f32x4 b0 = *(const f32x4*)(Bs + k * 132 + tx * 8), b1 = *(const f32x4*)(Bs + k * 132 + tx * 8 + 4);
                const float av4[4] = {a.x, a.y, a.z, a.w};
                const float bv8[8] = {b0.x, b0.y, b0.z, b0.w, b1.x, b1.y, b1.z, b1.w};
#pragma unroll
                for (int i = 0; i < 4; ++i)
#pragma unroll
                    for (int j = 0; j < 8; ++j) acc[i][j] += av4[i] * bv8[j];
            }
        }
#pragma unroll
        for (int i = 0; i < 4; ++i) E(m0 + ty * 4 + i, n0 + tx * 8, acc[i]);
    }
}

namespace pg8 {
#define PG8_LAS __attribute__((address_space(3)))
typedef unsigned short bf16_t;
typedef short bf16x8 __attribute__((ext_vector_type(8)));
typedef float f32x4 __attribute__((ext_vector_type(4)));
typedef unsigned u32x4 __attribute__((ext_vector_type(4)));
constexpr int BM = 256, BK = 64, HALF = 128, HTB = HALF * BK * 2  , STAGE_BYTES = 8 * HTB, NXCD = 8, WGM = 8;

__host__ __device__ __forceinline__ int lds_byte(int r, int c) { const int st = (r >> 4) * 2 + (c >> 5), rr = r & 15, cc = c & 31, ob = rr * 64 + cc * 2; return st * 1024 + (ob ^ (((ob >> 9) & 1) << 5)); }
__host__ __device__ __forceinline__ void stage_rc(int b, int& R, int& C) { const int st = b / 1024, sb = b % 1024, swz = sb ^ (((sb >> 9) & 1) << 5); R = (st >> 1) * 16 + swz / 64; C = (st & 1) * 32 + (swz % 64) / 2; }
__host__ __device__ __forceinline__ int perm32(int rho) { const int n = rho >> 4, i = rho & 15; return 8 * (i >> 2) + 4 * n + (i & 3); }

struct Unit { int pm, pn; };
struct Gemm { const bf16_t* A; const bf16_t* Bt; int M, N, K; };

struct StaticOrder {
    int nM, nN, nwg, G, c;
    __host__ __device__ void init(int M, int N, int G_, int c_) { nM = M / BM; nN = N / BM; nwg = nM * nN; G = G_; c = c_; }
    __host__ __device__ bool next(int i, Unit& u) const {
        const long L = (long)i * G + c; if (L >= nwg) return false;
        int wgid = (int)L; { const int q = nwg / NXCD, r = nwg % NXCD, xcd = wgid % NXCD, off = wgid / NXCD; wgid = (xcd < r ? xcd * (q + 1) : r * (q + 1) + (xcd - r) * q) + off; }
        const int nig = WGM * nN, gid = wgid / nig, fm = gid * WGM, gsz = (nM - fm) < WGM ? (nM - fm) : WGM;
        u.pm = fm + ((wgid % nig) % gsz); u.pn = (wgid % nig) / gsz; return true;
    }
    __device__ __forceinline__ void a_ready(const Unit&) const {}
    __device__ __forceinline__ void done(const Unit&) const {}
};

__device__ __forceinline__ unsigned cvt_pk_bf16(float lo, float hi) { unsigned r; asm volatile("v_cvt_pk_bf16_f32 %0, %1, %2" : "=v"(r) : "v"(lo), "v"(hi)); return r; }
typedef float f32x2 __attribute__((ext_vector_type(2)));
__device__ __forceinline__ f32x2 gelu_pk(f32x2 v) {
    const f32x2 av = __builtin_elementwise_abs(v), d = av * 0.2316418882f + 1.0f;
    f32x2 t; t.x = __builtin_amdgcn_rcpf(d.x); t.y = __builtin_amdgcn_rcpf(d.y);
    f32x2 q = t * 0.5307027145f + (-0.7265760135f); q = q * t + 0.7107068705f; q = q * t + (-0.142248368f); q = q * t + 0.127414796f; q = q * t;
    const f32x2 s = (v * v) * (-0.72134752044f);
    f32x2 e; e.x = __builtin_amdgcn_exp2f(s.x); e.y = __builtin_amdgcn_exp2f(s.y);
    const f32x2 m = v * (q * e), r = v - m;
    f32x2 o; o.x = v.x < 0.f ? m.x : r.x; o.y = v.y < 0.f ? m.y : r.y; return o;
}

template <int ACT  > struct EpiBf16 {
    static constexpr bool PERM = true, AFTER_DRAIN = false; static_assert(ACT == 0 || ACT == 1, "EpiBf16: ACT is 0 (none) or 1 (gelu_pk)");
    bf16_t* O; int ldc; const float* bias; int split_cols; size_t split_stride; float scale0;
    __device__ __forceinline__ void operator()(const f32x4 (&acc)[2][2][4][2], const Unit& u, int wr, int wc, int fr, int fq) const {
        const int row0 = u.pm * BM + wr * 64 + fr; int colt = u.pn * BM; bf16_t* base = O;
        float sc = 1.f; if (split_cols) { const int t = colt / split_cols; base += (size_t)t * split_stride; colt -= t * split_cols; if (t == 0) sc = scale0; }
        const int col0 = colt + wc * 32 + 8 * fq, bcol0 = u.pn * BM + wc * 32 + 8 * fq;
        f32x4 bv[2][2];
#pragma unroll
        for (int bj = 0; bj < 2; ++bj)
#pragma unroll
            for (int n = 0; n < 2; ++n) bv[bj][n] = bias ? *(const f32x4*)(bias + bcol0 + bj * HALF + 4 * n) : (f32x4){0.f, 0.f, 0.f, 0.f};
#pragma unroll
        for (int ai = 0; ai < 2; ++ai)
#pragma unroll
            for (int m = 0; m < 4; ++m) { bf16_t* rowp = base + (size_t)(row0 + ai * HALF + m * 16) * ldc + col0;
#pragma unroll
                for (int bj = 0; bj < 2; ++bj) { f32x4 v0 = acc[ai][bj][m][0] + bv[bj][0], v1 = acc[ai][bj][m][1] + bv[bj][1];
                    if (ACT == 1) { f32x2 a = gelu_pk((f32x2){v0[0], v0[1]}), b = gelu_pk((f32x2){v0[2], v0[3]}), c = gelu_pk((f32x2){v1[0], v1[1]}), d = gelu_pk((f32x2){v1[2], v1[3]});
                        v0 = (f32x4){a.x, a.y, b.x, b.y}; v1 = (f32x4){c.x, c.y, d.x, d.y}; }
                    v0 = v0 * sc; v1 = v1 * sc; u32x4 w; w.x = cvt_pk_bf16(v0[0], v0[1]); w.y = cvt_pk_bf16(v0[2], v0[3]); w.z = cvt_pk_bf16(v1[0], v1[1]); w.w = cvt_pk_bf16(v1[2], v1[3]);
                    *(u32x4*)(rowp + bj * HALF) = w; } }
    }
};
typedef int i32x4 __attribute__((ext_vector_type(4)));
template <bool I8> struct AccSel { typedef f32x4 type; };
template <> struct AccSel<true> { typedef i32x4 type; };
template <class Epi, class Sched, bool ALIGN_EPI = false, bool SP2 = false, bool I8 = false>
__device__ __forceinline__ void gemm_phase(PG8_LAS unsigned char* lds, const Gemm g, const Sched& S, const Epi& E) {
    const int tid = threadIdx.x, wid = __builtin_amdgcn_readfirstlane(tid >> 6), lane = tid & 63, wr = wid >> 2, wc = wid & 3, fr = lane & 15, fq = lane >> 4;
    const int K = g.K, nt = K / BK;
    unsigned voffA[2], voffB[2];
#pragma unroll
    for (int i = 0; i < 2; ++i) { int R, C; stage_rc(tid * 16 + i * 8192, R, C); const int Rb = Epi::PERM ? ((R & ~31) + perm32(R & 31)) : R;
        voffA[i] = (unsigned)(R * K + C) * 2u; voffB[i] = (unsigned)(Rb * K + C) * 2u; }
    const size_t kstep = (size_t)(BK * 2);
    const size_t hstep = (size_t)HALF * K * 2;
    const size_t tstep = 2 * hstep;
    const unsigned ldsw = (unsigned)wid * 1024u;
    const int aoff = lds_byte(wr * 64 + fr, fq * 8), boff = lds_byte(wc * 32 + fr, fq * 8);
#define PG8_SA(b, h) (((b) * 2 + (h)) * HTB)
#define PG8_SB(b, h) ((4 + (b) * 2 + (h)) * HTB)
#define PG8_STAGE(bufoff, gbase, voff) do { _Pragma("unroll") for (int _i = 0; _i < 2; ++_i) \
        __builtin_amdgcn_global_load_lds((const unsigned*)((const char*)(gbase) + (voff)[_i]), (PG8_LAS unsigned*)(lds + (bufoff) + ldsw + _i * 8192), 16, 0, 0); } while (0)
#define PG8_LDA(dst, b, h) do { _Pragma("unroll") for (int m = 0; m < 4; ++m) _Pragma("unroll") for (int k = 0; k < 2; ++k) dst[m][k] = *(const PG8_LAS bf16x8*)(lds + PG8_SA(b, h) + aoff + m * 2048 + k * 1024); } while (0)
#define PG8_LDB(dst, b, h) do { _Pragma("unroll") for (int n = 0; n < 2; ++n) _Pragma("unroll") for (int k = 0; k < 2; ++k) dst[n][k] = *(const PG8_LAS bf16x8*)(lds + PG8_SB(b, h) + boff + n * 2048 + k * 1024); } while (0)
#define PG8_MMA(ai, bj, At, Bt) do { __builtin_amdgcn_s_setprio(1); _Pragma("unroll") for (int m = 0; m < 4; ++m) _Pragma("unroll") for (int n = 0; n < 2; ++n) _Pragma("unroll") for (int k = 0; k < 2; ++k) \
        { if constexpr (I8) acc[ai][bj][m][n] = __builtin_amdgcn_mfma_i32_16x16x64_i8(__builtin_bit_cast(i32x4, Bt[n][k]), __builtin_bit_cast(i32x4, At[m][k]), acc[ai][bj][m][n], 0, 0, 0); \
          else acc[ai][bj][m][n] = __builtin_amdgcn_mfma_f32_16x16x32_bf16(Bt[n][k], At[m][k], acc[ai][bj][m][n], 0, 0, 0); } __builtin_amdgcn_s_setprio(0); } while (0)
#define PG8_WAIT_V(n) asm volatile("s_waitcnt vmcnt(" #n ")" ::: "memory")
#define PG8_WAIT_L(n) asm volatile("s_waitcnt lgkmcnt(" #n ")" ::: "memory")
#define PG8_BAR __builtin_amdgcn_s_barrier()
#define PG8_SCHED __builtin_amdgcn_sched_barrier(0)
    Unit cur, nxt; int ui = 0;
    if (!S.next(0, cur)) return;
    typedef typename AccSel<I8>::type acc_t; const acc_t zero_ = {};
    acc_t acc[2][2][4][2];
#pragma unroll
    for (int a = 0; a < 2; ++a)
#pragma unroll
        for (int b = 0; b < 2; ++b)
#pragma unroll
            for (int m = 0; m < 4; ++m)
#pragma unroll
                for (int n = 0; n < 2; ++n) acc[a][b][m][n] = zero_;
    bf16x8 At[4][2], B0[2][2], B1[2][2];
    const char* cA = (const char*)g.A + (size_t)cur.pm * tstep; const char* cB = (const char*)g.Bt + (size_t)cur.pn * tstep;
    S.a_ready(cur);
    if constexpr (SP2) {
        PG8_STAGE(PG8_SB(0, 0), cB, voffB); PG8_STAGE(PG8_SB(0, 1), cB + hstep, voffB); PG8_STAGE(PG8_SA(0, 0), cA, voffA); PG8_STAGE(PG8_SA(0, 1), cA + hstep, voffA);
        if (wr == 1) PG8_BAR;
        PG8_WAIT_V(2); PG8_BAR;
        PG8_STAGE(PG8_SB(1, 0), cB + kstep, voffB); PG8_STAGE(PG8_SA(1, 0), cA + kstep, voffA); PG8_STAGE(PG8_SB(1, 1), cB + hstep + kstep, voffB);
        PG8_WAIT_V(6); PG8_BAR;
    } else {
        PG8_STAGE(PG8_SB(0, 0), cB, voffB); PG8_STAGE(PG8_SA(0, 0), cA, voffA); PG8_STAGE(PG8_SB(0, 1), cB + hstep, voffB); PG8_STAGE(PG8_SA(0, 1), cA + hstep, voffA);
        if (wr == 1) PG8_BAR;
        PG8_WAIT_V(4); PG8_BAR;
        PG8_STAGE(PG8_SB(1, 0), cB + kstep, voffB); PG8_STAGE(PG8_SA(1, 0), cA + kstep, voffA); PG8_STAGE(PG8_SB(1, 1), cB + hstep + kstep, voffB);
        PG8_WAIT_V(6); PG8_BAR;
    }
    for (;;) {
        const bool has_next = S.next(ui + 1, nxt);
        const char* nA = has_next ? (const char*)g.A + (size_t)nxt.pm * tstep : cA; const char* nB = has_next ? (const char*)g.Bt + (size_t)nxt.pn * tstep : cB;
        for (int t = 0; t < nt; t += 2) {
            const bool last = (t == nt - 2);
            const char* a1 = cA + (size_t)(t + 1) * kstep;
            const char* a2 = last ? nA : cA + (size_t)(t + 2) * kstep; const char* b2 = last ? nB : cB + (size_t)(t + 2) * kstep;
            const char* a3 = a2 + kstep; const char* b3 = b2 + kstep;
            if (last && has_next) S.a_ready(nxt);
            if constexpr (SP2) {
            PG8_LDB(B0, 0, 0); PG8_LDB(B1, 0, 1); PG8_SCHED; PG8_LDA(At, 0, 0); PG8_STAGE(PG8_SA(1, 1), a1 + hstep, voffA);
            PG8_WAIT_V(8); PG8_WAIT_L(0); PG8_BAR; PG8_MMA(0, 0, At, B0); PG8_MMA(0, 1, At, B1); PG8_BAR; PG8_SCHED;
            PG8_LDA(At, 0, 1); PG8_STAGE(PG8_SB(0, 0), b2, voffB); PG8_STAGE(PG8_SB(0, 1), b2 + hstep, voffB); PG8_STAGE(PG8_SA(0, 0), a2, voffA);
            PG8_WAIT_V(8); PG8_WAIT_L(0); PG8_BAR; PG8_MMA(1, 0, At, B0); PG8_MMA(1, 1, At, B1); PG8_BAR; PG8_SCHED;
            PG8_LDB(B0, 1, 0); PG8_LDB(B1, 1, 1); PG8_SCHED; PG8_LDA(At, 1, 0); PG8_STAGE(PG8_SA(0, 1), a2 + hstep, voffA);
            PG8_WAIT_V(8); PG8_WAIT_L(0); PG8_BAR; PG8_MMA(0, 0, At, B0); PG8_MMA(0, 1, At, B1); PG8_BAR; PG8_SCHED;
            PG8_LDA(At, 1, 1); PG8_STAGE(PG8_SB(1, 0), b3, voffB); PG8_STAGE(PG8_SB(1, 1), b3 + hstep, voffB); PG8_STAGE(PG8_SA(1, 0), a3, voffA);
            PG8_WAIT_V(8); PG8_WAIT_L(0); PG8_BAR; PG8_MMA(1, 0, At, B0); PG8_MMA(1, 1, At, B1); PG8_BAR; PG8_SCHED;
            } else {
            PG8_LDB(B0, 0, 0); PG8_SCHED; PG8_LDA(At, 0, 0); PG8_STAGE(PG8_SA(1, 1), a1 + hstep, voffA);
            PG8_WAIT_L(8); PG8_BAR; PG8_WAIT_L(0); PG8_MMA(0, 0, At, B0); PG8_BAR; PG8_SCHED;
            PG8_LDB(B1, 0, 1); PG8_STAGE(PG8_SB(0, 0), b2, voffB);
            PG8_BAR; PG8_WAIT_L(0); PG8_MMA(0, 1, At, B1); PG8_BAR;
            PG8_LDA(At, 0, 1); PG8_STAGE(PG8_SA(0, 0), a2, voffA);
            PG8_BAR; PG8_WAIT_L(0); PG8_MMA(1, 0, At, B0); PG8_BAR; PG8_SCHED;
            PG8_STAGE(PG8_SB(0, 1), b2 + hstep, voffB);
            PG8_WAIT_V(6); PG8_BAR; PG8_MMA(1, 1, At, B1); PG8_BAR;
            PG8_LDB(B0, 1, 0); PG8_SCHED; PG8_LDA(At, 1, 0); PG8_STAGE(PG8_SA(0, 1), a2 + hstep, voffA);
            PG8_WAIT_L(8); PG8_BAR; PG8_WAIT_L(0); PG8_MMA(0, 0, At, B0); PG8_BAR; PG8_SCHED;
            PG8_LDB(B1, 1, 1); PG8_STAGE(PG8_SB(1, 0), b3, voffB);
            PG8_BAR; PG8_WAIT_L(0); PG8_MMA(0, 1, At, B1); PG8_BAR;
            PG8_LDA(At, 1, 1); PG8_STAGE(PG8_SA(1, 0), a3, voffA);
            PG8_BAR; PG8_WAIT_L(0); PG8_MMA(1, 0, At, B0); PG8_BAR; PG8_SCHED;
            PG8_STAGE(PG8_SB(1, 1), b3 + hstep, voffB);
            PG8_WAIT_V(6); PG8_BAR; PG8_MMA(1, 1, At, B1); PG8_BAR;
            }
        }
        if constexpr (ALIGN_EPI) { if (wr == 0) PG8_BAR; }
        if constexpr (!Epi::AFTER_DRAIN) { E(acc, cur, wr, wc, fr, fq); S.done(cur); }
        if (!has_next) break;
#pragma unroll
        for (int a = 0; a < 2; ++a)
#pragma unroll
            for (int b = 0; b < 2; ++b)
#pragma unroll
                for (int m = 0; m < 4; ++m)
#pragma unroll
                    for (int n = 0; n < 2; ++n) acc[a][b][m][n] = zero_;
        cur = nxt; cA = nA; cB = nB; ++ui;
        if constexpr (ALIGN_EPI) { if (wr == 1) PG8_BAR; }
    }
    PG8_WAIT_V(0);
    if constexpr (!ALIGN_EPI) { if (wr == 0) PG8_BAR; }
    PG8_BAR;
    if constexpr (Epi::AFTER_DRAIN) { E.fused(acc, cur, wr, wc, fr, fq, lds, wid, lane); S.done(cur); }
#undef PG8_SA
#undef PG8_SB
#undef PG8_STAGE
#undef PG8_LDA
#undef PG8_LDB
#undef PG8_MMA
#undef PG8_WAIT_V
#undef PG8_WAIT_L
#undef PG8_BAR
#undef PG8_SCHED
}

struct EpiResGateT {
    static constexpr bool PERM = false, AFTER_DRAIN = false;
    const float *resLat, *resCtx; float *outLat, *outCtx; const float* gate;
    __device__ __forceinline__ void operator()(const f32x4 (&acc)[2][2][4][2], const Unit& u, int wr, int wc, int fr, int fq) const {
        const int trow = u.pm * BM, row0 = trow + wr * 64 + fr, col0 = u.pn * BM + wc * 32 + 4 * fq;
        const bool lat = trow < 16384;
        const int bb = lat ? (trow >> 11) : 8;
        const float* rbase = lat ? resLat + (size_t)row0 * 2048 : resCtx + (size_t)(row0 - 16384) * 2048;
        float* obase = lat ? outLat + (size_t)row0 * 2048 : outCtx + (size_t)(row0 - 16384) * 2048;
        f32x4 gv[2][2];
#pragma unroll
        for (int bj = 0; bj < 2; ++bj)
#pragma unroll
            for (int n = 0; n < 2; ++n) gv[bj][n] = *(const f32x4*)(gate + (size_t)bb * 12288 + col0 + bj * HALF + n * 16);
#pragma unroll
        for (int ai = 0; ai < 2; ++ai)
#pragma unroll
            for (int m = 0; m < 4; ++m) {
                const size_t off = (size_t)(ai * HALF + m * 16) * 2048 + col0;
#pragma unroll
                for (int bj = 0; bj < 2; ++bj)
#pragma unroll
                    for (int n = 0; n < 2; ++n) {
                        const f32x4 r = *(const f32x4*)(rbase + off + bj * HALF + n * 16);
                        *(f32x4*)(obase + off + bj * HALF + n * 16) = r + gv[bj][n] * acc[ai][bj][m][n];
                    }
            }
    }
};

struct EpiBf16I8 {
    static constexpr bool PERM = true, AFTER_DRAIN = false;
    bf16_t* O; int ldc; const float* sa; const float* sb;
    __device__ __forceinline__ void operator()(const i32x4 (&acc)[2][2][4][2], const Unit& u, int wr, int wc, int fr, int fq) const {
        const int row0 = u.pm * BM + wr * 64 + fr, col0 = u.pn * BM + wc * 32 + 8 * fq;
        f32x4 sv[2][2];
#pragma unroll
        for (int bj = 0; bj < 2; ++bj)
#pragma unroll
            for (int n = 0; n < 2; ++n) sv[bj][n] = *(const f32x4*)(sb + col0 + bj * HALF + 4 * n);
#pragma unroll
        for (int ai = 0; ai < 2; ++ai)
#pragma unroll
            for (int m = 0; m < 4; ++m) {
                const int row = row0 + ai * HALF + m * 16; const float s = sa[row];
                bf16_t* rowp = O + (size_t)row * ldc + col0;
#pragma unroll
                for (int bj = 0; bj < 2; ++bj) {
                    const i32x4 a0 = acc[ai][bj][m][0], a1 = acc[ai][bj][m][1];
                    const f32x4 v0 = (f32x4){(float)a0.x, (float)a0.y, (float)a0.z, (float)a0.w} * s * sv[bj][0];
                    const f32x4 v1 = (f32x4){(float)a1.x, (float)a1.y, (float)a1.z, (float)a1.w} * s * sv[bj][1];
                    u32x4 w; w.x = cvt_pk_bf16(v0[0], v0[1]); w.y = cvt_pk_bf16(v0[2], v0[3]); w.z = cvt_pk_bf16(v1[0], v1[1]); w.w = cvt_pk_bf16(v1[2], v1[3]);
                    *(u32x4*)(rowp + bj * HALF) = w;
                }
            }
    }
};
struct EpiResGateI8 {
    static constexpr bool PERM = false, AFTER_DRAIN = false;
    const float *resLat, *resCtx; float *outLat, *outCtx; const float* gate; const float* sa; const float* sb;
    __device__ __forceinline__ void operator()(const i32x4 (&acc)[2][2][4][2], const Unit& u, int wr, int wc, int fr, int fq) const {
        const int trow = u.pm * BM, row0 = trow + wr * 64 + fr, col0 = u.pn * BM + wc * 32 + 4 * fq;
        const bool lat = trow < 16384;
        const int bb = lat ? (trow >> 11) : 8;
        const float* rbase = lat ? resLat + (size_t)row0 * 2048 : resCtx + (size_t)(row0 - 16384) * 2048;
        float* obase = lat ? outLat + (size_t)row0 * 2048 : outCtx + (size_t)(row0 - 16384) * 2048;
        f32x4 gv[2][2];
#pragma unroll
        for (int bj = 0; bj < 2; ++bj)
#pragma unroll
            for (int n = 0; n < 2; ++n) gv[bj][n] = *(const f32x4*)(gate + (size_t)bb * 12288 + col0 + bj * HALF + n * 16) * *(const f32x4*)(sb + col0 + bj * HALF + n * 16);
#pragma unroll
        for (int ai = 0; ai < 2; ++ai)
#pragma unroll
            for (int m = 0; m < 4; ++m) {
                const size_t off = (size_t)(ai * HALF + m * 16) * 2048 + col0;
                const float s = sa[row0 + ai * HALF + m * 16];
#pragma unroll
                for (int bj = 0; bj < 2; ++bj)
#pragma unroll
                    for (int n = 0; n < 2; ++n) {
                        const f32x4 r = *(const f32x4*)(rbase + off + bj * HALF + n * 16);
                        const i32x4 a = acc[ai][bj][m][n];
                        *(f32x4*)(obase + off + bj * HALF + n * 16) = r + gv[bj][n] * ((f32x4){(float)a.x, (float)a.y, (float)a.z, (float)a.w} * s);
                    }
            }
    }
};
}
#ifndef USE_PG8
#define USE_PG8 1
#endif

__device__ __forceinline__ float sum16(float v) { v += __shfl_xor(v, 1); v += __shfl_xor(v, 2); v += __shfl_xor(v, 4); v += __shfl_xor(v, 8); return v; }
__device__ __forceinline__ void ph_prep(const Params& p, int l, const bool dry) {
    const int tid = threadIdx.x, lane = tid & 63, wave = tid >> 6, sub = lane >> 4, li = lane & 15;
    const int gw = blockIdx.x * NWAVES + wave, NGW = gridDim.x * NWAVES;
    bf16_t* P = (bf16_t*)(p.ws + WS_P);
    const float* rope = (const float*)(p.ws + WS_ROPE);
    const bool last = (l == DEPTH - 1);
    const int f0 = (li >= 8 ? 32 : 0) + 8 * (li & 3);
    const float sg = (li & 4) ? 1.f : -1.f;
#pragma unroll 1
    for (int r = gw; r < MTOT; r += NGW) {
        bf16_t* row = P + (size_t)r * INW;
        bf16_t* wrow = dry ? (bf16_t*)(p.ws + WS_DUMMY) + (size_t)r * INW : row;
        const bool isctx = r >= NLAT;
        const int t = r & (SEQ - 1);
        float cs[8], sn[8];
        if (!isctx) {
            const f32x4* rp = (const f32x4*)(rope + ((size_t)t * 64 + f0) * 2);
            const f32x4 a = rp[0], b = rp[1], c = rp[2], d = rp[3];
            cs[0] = a.x; sn[0] = a.y; cs[1] = a.z; sn[1] = a.w; cs[2] = b.x; sn[2] = b.y; cs[3] = b.z; sn[3] = b.w;
            cs[4] = c.x; sn[4] = c.y; cs[5] = c.z; sn[5] = c.w; cs[6] = d.x; sn[6] = d.y; cs[7] = d.z; sn[7] = d.w;
        } else {
#pragma unroll
            for (int i = 0; i < 8; ++i) { cs[i] = 1.f; sn[i] = 0.f; }
        }
        u32x4 raw[7];
#pragma unroll
        for (int gI = 0; gI < 7; ++gI) raw[gI] = *(const u32x4*)(row + (gI * 4 + sub) * 128 + li * 8);
#pragma unroll
        for (int gI = 0; gI < 7; ++gI) {
            const int slot = gI * 4 + sub;
            const int kind = slot < 8 ? 0 : slot < 10 ? 1 : slot < 18 ? 0 : slot < 20 ? 1 : slot < 24 ? 2 : 3;
            const bool isq = slot < 6 || (slot >= 10 && slot < 16);
            float x[8];
            x[0] = bflo(raw[gI].x); x[1] = bfhi(raw[gI].x); x[2] = bflo(raw[gI].y); x[3] = bfhi(raw[gI].y);
            x[4] = bflo(raw[gI].z); x[5] = bfhi(raw[gI].z); x[6] = bflo(raw[gI].w); x[7] = bfhi(raw[gI].w);
            if (kind >= 2) {
#pragma unroll
                for (int i = 0; i < 8; ++i) x[i] = gelu_tanh(x[i]);
            }
            float ss = 0.f;
#pragma unroll
            for (int i = 0; i < 8; ++i) ss += x[i] * x[i];
            ss = sum16(ss);
            const float rstd = rsqrtf(ss * (1.f / 128.f) + EPS);
            const float* gain = slot < 6 ? p.qn_a + l * 128 : slot < 8 ? p.kn_a + l * 128 : slot < 16 ? p.qn_b + l * 128 : slot < 20 ? p.kn_b + l * 128 : p.vn_c + l * 512 + (slot - 24) * 128;
            if (kind == 0 || kind == 3) {
                const f32x4 g0 = *(const f32x4*)(gain + li * 8), g1 = *(const f32x4*)(gain + li * 8 + 4);
                x[0] *= rstd * g0.x; x[1] *= rstd * g0.y; x[2] *= rstd * g0.z; x[3] *= rstd * g0.w;
                x[4] *= rstd * g1.x; x[5] *= rstd * g1.y; x[6] *= rstd * g1.z; x[7] *= rstd * g1.w;
            }
            float px[8];
#pragma unroll
            for (int i = 0; i < 8; ++i) px[i] = __shfl_xor(x[i], 4);
            if (kind == 0) {
#pragma unroll
                for (int i = 0; i < 8; ++i) x[i] = x[i] * cs[i] + sg * px[i] * sn[i];
            }
            bool wr = kind != 1;
            if (isctx && last && (isq || kind >= 2)) wr = false;
            if (wr) { u32x4 o; o.x = pk2(x[0], x[1]); o.y = pk2(x[2], x[3]); o.z = pk2(x[4], x[5]); o.w = pk2(x[6], x[7]); *(u32x4*)(wrow + slot * 128 + li * 8) = o; }
        }
    }
}

__device__ __forceinline__ void attn_row_naive(const bf16_t* q, const bf16_t* kc, const bf16_t* vc, const bf16_t* kl, const bf16_t* vl, int j0, int j1,
                                               bool has_sink, float sink, bf16_t* o, int lane) {
    const unsigned qq = *(const unsigned*)(q + 2 * lane);
    const float q0 = bflo(qq), q1 = bfhi(qq);
    float m = -INFINITY, lsum = 0.f, o0 = 0.f, o1 = 0.f;
    const int ntot = NCTX + (j1 - j0);
    for (int j = 0; j < ntot; ++j) {
        const bf16_t* kp = j < NCTX ? kc + (size_t)j * INW : kl + (size_t)(j0 + j - NCTX) * INW;
        const bf16_t* vp = j < NCTX ? vc + (size_t)j * INW : vl + (size_t)(j0 + j - NCTX) * INW;
        const unsigned kk = *(const unsigned*)(kp + 2 * lane), vv = *(const unsigned*)(vp + 2 * lane);
        const float s = wave_sum(q0 * bflo(kk) + q1 * bfhi(kk)) * ATT_SCALE;
        const float mn = fmaxf(m, s);
        const float a = __expf(m - mn), pp = __expf(s - mn);
        lsum = lsum * a + pp; o0 = o0 * a + pp * bflo(vv); o1 = o1 * a + pp * bfhi(vv);
        m = mn;
    }
    if (has_sink) {
        const float mn = fmaxf(m, sink);
        const float a = __expf(m - mn);
        lsum = lsum * a + __expf(sink - mn); o0 *= a; o1 *= a;
    }
    const float inv = 1.f / lsum;
    *(unsigned*)(o + 2 * lane) = pk2(o0 * inv, o1 * inv);
}

__device__ __forceinline__ void ph_mixers_naive(const Params& p, int l, unsigned char* lds) {
    const int tid = threadIdx.x, lane = tid & 63, wave = tid >> 6;
    const int gw = blockIdx.x * NWAVES + wave, NGW = gridDim.x * NWAVES;
    const bf16_t* P = (const bf16_t*)(p.ws + WS_P);
    bf16_t* Y = (bf16_t*)(p.ws + WS_Y);
    const bool last = (l == DEPTH - 1);
    const int T_LA = NLAT * 6, T_LB = NLAT * 6, T_CA = last ? 0 : NCT * 6, T_CB = last ? 0 : NCT * 6;
    const int ntask = T_LA + T_LB + T_CA + T_CB;
    for (int tk = gw; tk < ntask; tk += NGW) {
        int r = tk;
        if (r < T_LA + T_LB) {
            const bool isB = r >= T_LA; if (isB) r -= T_LA;
            const int b = r / (6 * SEQ), h = (r / SEQ) % 6, t = r % SEQ, kv = h / 3;
            const size_t row = (size_t)b * SEQ + t, crow0 = (size_t)NLAT + (size_t)b * NCTX, lrow0 = (size_t)b * SEQ;
            const int cq = isB ? C_QB : C_QA, ck = isB ? C_KB : C_KA, cvv = isB ? C_VB : C_VA;
            int j0 = 0, j1 = SEQ;
            if (isB) { j0 = t - 128 < 0 ? 0 : t - 128; j1 = t + 129 > SEQ ? SEQ : t + 129; }
            attn_row_naive(P + row * INW + cq + h * 128, P + crow0 * INW + ck + kv * 128, P + crow0 * INW + cvv + kv * 128,
                           P + lrow0 * INW + ck + kv * 128, P + lrow0 * INW + cvv + kv * 128, j0, j1, isB, isB ? p.sink_b[l * 6 + h] : 0.f,
                           Y + row * DM + (isB ? 768 : 0) + h * 128, lane);
        } else {
            r -= T_LA + T_LB;
            const bool isB = r >= T_CA; if (isB) r -= T_CA;
            const int b = r / (6 * NCTX), h = (r / NCTX) % 6, t = r % NCTX, kv = h / 3;
            const size_t crow0 = (size_t)NLAT + (size_t)b * NCTX, row = crow0 + t;
            const int cq = isB ? C_QB : C_QA, ck = isB ? C_KB : C_KA, cvv = isB ? C_VB : C_VA;
            attn_row_naive(P + row * INW + cq + h * 128, P + crow0 * INW + ck + kv * 128, P + crow0 * INW + cvv + kv * 128,
                           P, P, 0, 0, isB, isB ? p.sink_b[l * 6 + h] : 0.f, Y + row * DM + (isB ? 768 : 0) + h * 128, lane);
        }
    }
    __syncthreads();
    float* Wl = (float*)lds;
    float* Vl = Wl + 128 * 128;
    const int nchunk = last ? NLAT / 128 : MTOT / 128;
    for (int u = blockIdx.x; u < nchunk * 4; u += gridDim.x) {
        const int ch = u >> 2, g = u & 3; const size_t row0 = (size_t)ch * 128;
        __syncthreads();
        for (int i = tid; i < 128 * 128; i += NTHREADS) {
            Wl[i] = p.ws_c[((size_t)l * 4 + g) * 16384 + i];
            const int q = i >> 7, c = i & 127;
            Vl[i] = bf2f(P[(row0 + q) * INW + C_VC + g * 128 + c]);
        }
        __syncthreads();
        const int c = tid & 127, pg = tid >> 7;
        for (int pp = pg * 32; pp < pg * 32 + 32; ++pp) {
            float s = 0.f;
#pragma unroll 8
            for (int q = 0; q < 128; ++q) s += Wl[pp * 128 + q] * Vl[q * 128 + c];
            s += p.bs_c[((size_t)l * 4 + g) * 128 + pp];
            const float uu = bf2f(P[(row0 + pp) * INW + C_UC + g * 128 + c]);
            Y[(row0 + pp) * DM + 1536 + g * 128 + c] = (bf16_t)f2bf(uu * s);
        }
    }
}


namespace att {
constexpr float SCALE = 0.088388347648318440f;
constexpr float THR = 8.f;
constexpr int D = 128, NW = 8, QBLK = 32, KVBLK = 64;
#ifndef ATT_SDEPTH
#define ATT_SDEPTH 2
#endif
constexpr int SDEPTH = ATT_SDEPTH;
constexpr int LDQ = INW, LDK = INW, LDO = DM;
constexpr size_t SHM_V = KVBLK * D * 2, SHM_K = KVBLK * D * 2, SHM_ATTN = 2 * SHM_V + 2 * SHM_K + NW * 64 * 4;
using bf16x8 = __attribute__((ext_vector_type(8))) short;
using s16x4  = __attribute__((ext_vector_type(4))) short;
using f32x16 = __attribute__((ext_vector_type(16))) float;
using f32x8  = __attribute__((ext_vector_type(8))) float;

#define KSWZ(row, colB) ((row) * 256 + ((colB) ^ (((row) & 7) << 4)))
#define SBAR() __builtin_amdgcn_sched_barrier(0)
__device__ __forceinline__ int crow(int r, int hi) { return (r & 3) + 8 * (r >> 2) + 4 * hi; }
__device__ __forceinline__ unsigned cvtpk(float lo, float hi) {
  unsigned r; asm volatile("v_cvt_pk_bf16_f32 %0, %1, %2" : "=v"(r) : "v"(lo), "v"(hi)); return r;
}

__device__ __forceinline__ void partialSM(f32x16& p0, f32x16& p1, float& m_reg, float& mn, float& alpha) {
  constexpr float C = SCALE * 1.4426950408889634f;
  float pmax = p0[0]; for (int r = 1; r < 16; ++r) pmax = fmaxf(pmax, p0[r]); for (int r = 0; r < 16; ++r) pmax = fmaxf(pmax, p1[r]);
  { auto rr = __builtin_amdgcn_permlane32_swap(__float_as_uint(pmax), __float_as_uint(pmax), false, false);
    pmax = fmaxf(__uint_as_float(rr[0]), __uint_as_float(rr[1])); }
  if (__builtin_expect(__all(pmax - m_reg <= THR / SCALE), 1)) { mn = m_reg; alpha = 1.f; }
  else { mn = fmaxf(m_reg, pmax); alpha = __builtin_amdgcn_exp2f((m_reg - mn) * C); m_reg = mn; }
  float mnC = -mn * C;
  for (int r = 0; r < 16; ++r) p0[r] = fmaf(p0[r], C, mnC); for (int r = 0; r < 16; ++r) p1[r] = fmaf(p1[r], C, mnC);
  for (int r = 0; r < 16; ++r) p0[r] = __builtin_amdgcn_exp2f(p0[r]);
}
__device__ __forceinline__ void finishSM(f32x16& p0, f32x16& p1, float alpha, float& l_reg, bf16x8& pa0, bf16x8& pa1, bf16x8& pa2, bf16x8& pa3) {
  for (int r = 0; r < 16; ++r) p1[r] = __builtin_amdgcn_exp2f(p1[r]);
  float ps = 0; for (int r = 0; r < 16; ++r) ps += p0[r]; for (int r = 0; r < 16; ++r) ps += p1[r];
  { auto rr = __builtin_amdgcn_permlane32_swap(__float_as_uint(ps), __float_as_uint(ps), false, false);
    ps = __uint_as_float(rr[0]) + __uint_as_float(rr[1]); }
  l_reg = l_reg * alpha + ps;
#define PK4(P, BASE, OUT) do { unsigned a0 = cvtpk(P[BASE + 0], P[BASE + 1]), a1 = cvtpk(P[BASE + 2], P[BASE + 3]);   \
    unsigned b0 = cvtpk(P[BASE + 4], P[BASE + 5]), b1 = cvtpk(P[BASE + 6], P[BASE + 7]);                              \
    auto r0 = __builtin_amdgcn_permlane32_swap(a0, b0, false, false); auto r1 = __builtin_amdgcn_permlane32_swap(a1, b1, false, false); \
    u32x4 w = {r0[0], r1[0], r0[1], r1[1]}; OUT = *reinterpret_cast<bf16x8*>(&w); } while (0)
  PK4(p0, 0, pa0); PK4(p0, 8, pa1); PK4(p1, 0, pa2); PK4(p1, 8, pa3);
#undef PK4
}
__device__ __forceinline__ void qkt(f32x16& p0, f32x16& p1, const bf16_t* Ks, const bf16x8* qr, int r32, int hi) {
  p0 = f32x16{}; p1 = f32x16{};
  for (int d0 = 0; d0 < 8; ++d0) { int cb = (d0 * 16 + hi * 8) * 2;
    bf16x8 b0 = *reinterpret_cast<const bf16x8*>((const char*)Ks + KSWZ(r32, cb));
    bf16x8 b1 = *reinterpret_cast<const bf16x8*>((const char*)Ks + KSWZ(32 + r32, cb));
    p0 = __builtin_amdgcn_mfma_f32_32x32x16_bf16(b0, qr[d0], p0, 0, 0, 0);
    p1 = __builtin_amdgcn_mfma_f32_32x32x16_bf16(b1, qr[d0], p1, 0, 0, 0); }
}
__device__ __forceinline__ int v_st(int k, int c) { const int kk = (k & ~0xC) | ((k & 4) << 1) | ((k & 8) >> 1); return ((kk >> 3) * 4 + (c >> 5)) * 512 + ((kk & 7) * 32 + (c & 31)) * 2; }
__device__ __forceinline__ int v_rd_base(int lane) { return ((lane & 3) << 3) | (((lane >> 2) & 3) << 6) | (((lane >> 4) & 1) << 5) | (((lane >> 5) & 1) << 8); }
constexpr int v_rd_off(int d0, int ks, int half) { return d0 * 512 + ks * 4096 + half * 2048; }
template <int OFF> __device__ __forceinline__ s16x4 tr_read(int vb) {
  s16x4 r; asm volatile("ds_read_b64_tr_b16 %0, %1 offset:%2" : "=&v"(r) : "v"(vb), "i"(OFF) : "memory"); return r;
}
template <int D0> __device__ __forceinline__ void pv_one(f32x16& od, int vb, bf16x8 pa0, bf16x8 pa1, bf16x8 pa2, bf16x8 pa3) {
  const s16x4 l0 = tr_read<v_rd_off(D0, 0, 0)>(vb), h0 = tr_read<v_rd_off(D0, 0, 1)>(vb), l1 = tr_read<v_rd_off(D0, 1, 0)>(vb), h1 = tr_read<v_rd_off(D0, 1, 1)>(vb);
  const s16x4 l2 = tr_read<v_rd_off(D0, 2, 0)>(vb), h2 = tr_read<v_rd_off(D0, 2, 1)>(vb), l3 = tr_read<v_rd_off(D0, 3, 0)>(vb), h3 = tr_read<v_rd_off(D0, 3, 1)>(vb);
  asm volatile("s_waitcnt lgkmcnt(0)" ::: "memory"); SBAR();
#define PK(L, H) (bf16x8){L[0], L[1], L[2], L[3], H[0], H[1], H[2], H[3]}
  od = __builtin_amdgcn_mfma_f32_32x32x16_bf16(pa0, PK(l0, h0), od, 0, 0, 0);
  od = __builtin_amdgcn_mfma_f32_32x32x16_bf16(pa1, PK(l1, h1), od, 0, 0, 0);
  od = __builtin_amdgcn_mfma_f32_32x32x16_bf16(pa2, PK(l2, h2), od, 0, 0, 0);
  od = __builtin_amdgcn_mfma_f32_32x32x16_bf16(pa3, PK(l3, h3), od, 0, 0, 0);
#undef PK
}
__device__ __forceinline__ void pv_d0(f32x16* o, int vb, bf16x8 pa0, bf16x8 pa1, bf16x8 pa2, bf16x8 pa3) {
  pv_one<0>(o[0], vb, pa0, pa1, pa2, pa3); pv_one<1>(o[1], vb, pa0, pa1, pa2, pa3); pv_one<2>(o[2], vb, pa0, pa1, pa2, pa3); pv_one<3>(o[3], vb, pa0, pa1, pa2, pa3);
}

__device__ __forceinline__ void attn_unit(const bool MASK, const bf16_t* __restrict__ Qb, const bf16_t* __restrict__ Kc, const bf16_t* __restrict__ Vc,
                                          const bf16_t* __restrict__ Kl, const bf16_t* __restrict__ Vl, int nlt, int qpos0, int kpos0,
                                          bool has_sink, float sink, bf16_t* __restrict__ Ob, char* lds) {
  int tid_ = threadIdx.x; asm volatile("" : "+v"(tid_));
  const int tid = tid_, wid = tid >> 6, lane = tid & 63, r32 = lane & 31, hi = lane >> 5;
  bf16_t* V_lds = (bf16_t*)lds; bf16_t* K_lds = (bf16_t*)(lds + 2 * SHM_V);
  float* ws = (float*)(lds + 2 * SHM_V + 2 * SHM_K) + wid * 64; float* li_l = ws; float* al_l = ws + 32;
  float m_reg = -1e30f, l_reg = 0; f32x16 o[4] = {}; bf16x8 qr[8];
  const bf16_t* Qw = Qb + (long)(wid * QBLK + r32) * LDQ + hi * 8;
#pragma unroll
  for (int d0 = 0; d0 < 8; ++d0) qr[d0] = *reinterpret_cast<const bf16x8*>(Qw + d0 * 16);
  const int sr = tid >> 4, sc = (tid & 15) * 8, vst0 = v_st(sr, sc), vst1 = v_st(32 + sr, sc);
  const int vb0 = (int)(uintptr_t)V_lds + v_rd_base(lane);
  struct { bf16x8 vs0, vs1, ks0, ks1; } sr_[SDEPTH];
  const int qpos = qpos0 + wid * QBLK + r32;
#define KVP(t, KP, VP) const bf16_t* KP = ((t) < 4 ? Kc + (long)(t) * KVBLK * LDK : Kl + (long)((t) - 4) * KVBLK * LDK); const bf16_t* VP = ((t) < 4 ? Vc + (long)(t) * KVBLK * LDK : Vl + (long)((t) - 4) * KVBLK * LDK)
#define SLOAD(i, t) do { KVP(t, kp_, vp_); sr_[i].vs0 = *reinterpret_cast<const bf16x8*>(&vp_[(long)sr * LDK + sc]); sr_[i].vs1 = *reinterpret_cast<const bf16x8*>(&vp_[(long)(32 + sr) * LDK + sc]); \
    sr_[i].ks0 = *reinterpret_cast<const bf16x8*>(&kp_[(long)sr * LDK + sc]); sr_[i].ks1 = *reinterpret_cast<const bf16x8*>(&kp_[(long)(32 + sr) * LDK + sc]); } while (0)
#define SWRITE(b, i) do { *(bf16x8*)((char*)V_lds + (b) * SHM_V + vst0) = sr_[i].vs0;          \
    *(bf16x8*)((char*)V_lds + (b) * SHM_V + vst1) = sr_[i].vs1; int kc = sc * 2;               \
    *(bf16x8*)((char*)K_lds + (b) * SHM_K + KSWZ(sr, kc)) = sr_[i].ks0;                       \
    *(bf16x8*)((char*)K_lds + (b) * SHM_K + KSWZ(32 + sr, kc)) = sr_[i].ks1; } while (0)
#define SWAIT() do { if constexpr (SDEPTH == 2) asm volatile("s_waitcnt vmcnt(4)" ::: "memory"); else asm volatile("s_waitcnt vmcnt(0)" ::: "memory"); } while (0)
#define RESC(a) do { if (__any((a) < 1.f)) { if (hi == 0) al_l[r32] = (a); asm volatile("s_waitcnt lgkmcnt(0)" ::: "memory"); \
    for (int d = 0; d < 4; ++d) for (int r = 0; r < 16; ++r) o[d][r] *= al_l[crow(r, hi)]; } } while (0)
#define WMASK(P0, P1, t) do { if (MASK && (t) >= 4) { const int kb_ = kpos0 + ((t) - 4) * KVBLK + 4 * hi - qpos; \
    _Pragma("unroll") for (int r = 0; r < 16; ++r) { const int dk = kb_ + (r & 3) + 8 * (r >> 2); \
      if (dk > 128 || dk < -128) P0[r] = -1e30f; if (dk + 32 > 128 || dk + 32 < -128) P1[r] = -1e30f; } } } while (0)
  f32x16 pA0, pA1, pB0, pB1; float mnA, mnB, alA, alB; bf16x8 pa0, pa1, pa2, pa3; const int NT = 4 + nlt;
  constexpr int SE = 0, SO = SDEPTH - 1;
  SLOAD(SE, 0); asm volatile("s_waitcnt vmcnt(0)" ::: "memory"); SWRITE(0, SE); __syncthreads();
  qkt(pA0, pA1, K_lds, qr, r32, hi); partialSM(pA0, pA1, m_reg, mnA, alA);
  SLOAD(SO, 1); if constexpr (SDEPTH == 2) { if (2 < NT) SLOAD(SE, 2); }
  SWAIT(); SWRITE(1, SO); __syncthreads();
  for (int j = 1; j + 1 < NT; j += 2) {
    SBAR(); qkt(pB0, pB1, (bf16_t*)((char*)K_lds + SHM_K), qr, r32, hi); WMASK(pB0, pB1, j);
    finishSM(pA0, pA1, alA, l_reg, pa0, pa1, pa2, pa3); SBAR();
    SLOAD(SO, j + SDEPTH); SBAR();
    pv_d0(o, vb0, pa0, pa1, pa2, pa3); partialSM(pB0, pB1, m_reg, mnB, alB);
    __syncthreads(); SWAIT(); SWRITE(0, SE);
    RESC(alB); __syncthreads();
    SBAR(); qkt(pA0, pA1, K_lds, qr, r32, hi); WMASK(pA0, pA1, j + 1);
    finishSM(pB0, pB1, alB, l_reg, pa0, pa1, pa2, pa3); SBAR();
    if (SDEPTH == 1 || j + 3 < NT) SLOAD(SE, j + 1 + SDEPTH); SBAR();
    pv_d0(o, vb0 + (int)SHM_V, pa0, pa1, pa2, pa3); partialSM(pA0, pA1, m_reg, mnA, alA);
    __syncthreads(); SWAIT(); SWRITE(1, SO);
    RESC(alA); __syncthreads();
  }
  SBAR(); qkt(pB0, pB1, (bf16_t*)((char*)K_lds + SHM_K), qr, r32, hi); WMASK(pB0, pB1, NT - 1);
  finishSM(pA0, pA1, alA, l_reg, pa0, pa1, pa2, pa3); SBAR();
  pv_d0(o, vb0, pa0, pa1, pa2, pa3); partialSM(pB0, pB1, m_reg, mnB, alB);
  __syncthreads(); RESC(alB);
  finishSM(pB0, pB1, alB, l_reg, pa0, pa1, pa2, pa3); SBAR();
  pv_d0(o, vb0 + (int)SHM_V, pa0, pa1, pa2, pa3);
  if (has_sink) l_reg += __builtin_amdgcn_exp2f(sink * 1.4426950408889634f - m_reg * (SCALE * 1.4426950408889634f));
  if (hi == 0) li_l[r32] = l_reg; asm volatile("s_waitcnt lgkmcnt(0)" ::: "memory");
  float rli[16];
#pragma unroll
  for (int r = 0; r < 16; ++r) rli[r] = __builtin_amdgcn_rcpf(li_l[crow(r, hi)]);
  bf16_t* Ow = Ob + (long)(wid * QBLK) * LDO;
#pragma unroll
  for (int r = 0; r < 16; ++r) { int orow = crow(r, hi);
#pragma unroll
    for (int d0 = 0; d0 < 4; ++d0) Ow[(long)orow * LDO + d0 * 32 + r32] = (bf16_t)f2bf(o[d0][r] * rli[r]); }
  __syncthreads();
#undef KVP
#undef SLOAD
#undef SWRITE
#undef SWAIT
#undef RESC
#undef WMASK
}
#undef KSWZ
#undef SBAR
}


__device__ __forceinline__ void cmlp_unit_naive(const Params& p, int l, int ch, int g, unsigned char* lds) {
    int tid_ = threadIdx.x; asm volatile("" : "+v"(tid_));
    const int tid = tid_;
    const bf16_t* P = (const bf16_t*)(p.ws + WS_P);
    bf16_t* Y = (bf16_t*)(p.ws + WS_Y);
    float* Wl = (float*)lds;
    float* Vl = Wl + 128 * 128;
    const size_t row0 = (size_t)ch * 128;
    __syncthreads();
    for (int i = tid; i < 128 * 128; i += NTHREADS) {
        Wl[i] = p.ws_c[((size_t)l * 4 + g) * 16384 + i];
        const int q = i >> 7, c = i & 127;
        Vl[i] = bf2f(P[(row0 + q) * INW + C_VC + g * 128 + c]);
    }
    __syncthreads();
    const int c = tid & 127, pg = tid >> 7;
    for (int pp = pg * 32; pp < pg * 32 + 32; ++pp) {
        float s = 0.f;
#pragma unroll 8
        for (int q = 0; q < 128; ++q) s += Wl[pp * 128 + q] * Vl[q * 128 + c];
        s += p.bs_c[((size_t)l * 4 + g) * 128 + pp];
        const float uu = bf2f(P[(row0 + pp) * INW + C_UC + g * 128 + c]);
        Y[(row0 + pp) * DM + 1536 + g * 128 + c] = (bf16_t)f2bf(uu * s);
    }
    __syncthreads();
}


__device__ __forceinline__ void cmlp_unit_fast(const Params& p, int l, int ch, int g, unsigned char* lds) {
    typedef short bf16x8 __attribute__((ext_vector_type(8)));
    typedef float f32x16 __attribute__((ext_vector_type(16)));
    int tid_ = threadIdx.x; asm volatile("" : "+v"(tid_));
    const int tid = tid_, lane = tid & 63, wave = tid >> 6, r32 = lane & 31, hh = lane >> 5;
    const bf16_t* P = (const bf16_t*)(p.ws + WS_P);
    bf16_t* Y = (bf16_t*)(p.ws + WS_Y);
    const bf16_t* W = (const bf16_t*)(p.ws + WS_WSC) + ((size_t)l * 4 + g) * 16384;
    bf16_t* VT = (bf16_t*)lds;
    const size_t row0 = (size_t)ch * 128;
    __syncthreads();
#pragma unroll
    for (int it = 0; it < 4; ++it) {
        const int q = it * 32 + (tid >> 4), c0 = (tid & 15) * 8;
        const u32x4 v = *(const u32x4*)(P + (row0 + q) * INW + C_VC + g * 128 + c0);
        const unsigned w[4] = {v.x, v.y, v.z, v.w};
#pragma unroll
        for (int i = 0; i < 4; ++i) { VT[(c0 + 2 * i) * 136 + q] = (bf16_t)(w[i] & 0xffffu); VT[(c0 + 2 * i + 1) * 136 + q] = (bf16_t)(w[i] >> 16); }
    }
    __syncthreads();
    const int cb = wave & 3, pb0 = (wave >> 2) * 2;
    f32x16 acc0 = {}, acc1 = {};
#pragma unroll
    for (int s = 0; s < 8; ++s) {
        const bf16x8 b = *(const bf16x8*)(VT + (cb * 32 + r32) * 136 + 16 * s + 8 * hh);
        const bf16x8 a0 = *(const bf16x8*)(W + (size_t)(pb0 * 32 + r32) * 128 + 16 * s + 8 * hh);
        const bf16x8 a1 = *(const bf16x8*)(W + (size_t)(pb0 * 32 + 32 + r32) * 128 + 16 * s + 8 * hh);
        acc0 = __builtin_amdgcn_mfma_f32_32x32x16_bf16(a0, b, acc0, 0, 0, 0);
        acc1 = __builtin_amdgcn_mfma_f32_32x32x16_bf16(a1, b, acc1, 0, 0, 0);
    }
    const int c = cb * 32 + r32;
    const float* bs = p.bs_c + ((size_t)l * 4 + g) * 128;
#pragma unroll
    for (int r = 0; r < 16; ++r) {
        const int pr = (r & 3) + 8 * (r >> 2) + 4 * hh;
        const int p0 = pb0 * 32 + pr, p1 = p0 + 32;
        const float u0 = bf2f(P[(row0 + p0) * INW + C_UC + g * 128 + c]), u1 = bf2f(P[(row0 + p1) * INW + C_UC + g * 128 + c]);
        Y[(row0 + p0) * DM + 1536 + g * 128 + c] = (bf16_t)f2bf(u0 * (acc0[r] + bs[p0]));
        Y[(row0 + p1) * DM + 1536 + g * 128 + c] = (bf16_t)f2bf(u1 * (acc1[r] + bs[p1]));
    }
}
#ifndef USE_FAST_CMLP
#define USE_FAST_CMLP 1
#endif

__device__ __forceinline__ void ph_mixers_fast(const Params& p, int l, unsigned char* lds, const bool dry) {
    const int tid = threadIdx.x;
    const bf16_t* P = (const bf16_t*)(p.ws + WS_P);
    bf16_t* Y = (bf16_t*)(p.ws + WS_Y);
    const bool last = (l == DEPTH - 1);
    const int b = blockIdx.x & 7;
    unsigned* ctr = (unsigned*)(p.ws + WS_CTL) + (dry ? 2048 : 0) + (l * 8 + b) * 64;
    volatile unsigned* shw = (volatile unsigned*)(lds + LDS_BYTES - 64);
    const int nAttn = last ? 96 : 108, nC = last ? 64 : 72, total = nAttn + nC;
    const size_t lrow0 = (size_t)b * SEQ, crow0 = (size_t)NLAT + (size_t)b * NCTX;
    for (;;) {
        __syncthreads();
        if (tid == 0) *shw = atomicAdd(ctr, 1u);
        __syncthreads();
        const int u = (int)*shw;
        if (u >= total) break;
        if (u < nAttn) {
            const bf16_t *Qb, *Kc, *Vc, *Kl, *Vl; bf16_t* Ob; int nlt = 0, qpos0 = 0, kpos0 = 0; bool mask = false, has_sink = false; int hsink = 0;
            if (u < 48) {
                const int h = u >> 3, qb = u & 7, kv = h / 3;
                Qb = P + (lrow0 + qb * 256) * INW + C_QA + h * 128; Kc = P + crow0 * INW + C_KA + kv * 128; Vc = P + crow0 * INW + C_VA + kv * 128;
                Kl = P + lrow0 * INW + C_KA + kv * 128; Vl = P + lrow0 * INW + C_VA + kv * 128; nlt = 32;
                Ob = Y + (lrow0 + qb * 256) * DM + h * 128;
            } else if (u < 96) {
                const int v = u - 48, h = v >> 3, qb = v & 7, kv = h / 3;
                const int kstart = qb == 0 ? 0 : qb * 256 - 128; nlt = (qb == 0 || qb == 7) ? 6 : 8;
                Qb = P + (lrow0 + qb * 256) * INW + C_QB + h * 128; Kc = P + crow0 * INW + C_KB + kv * 128; Vc = P + crow0 * INW + C_VB + kv * 128;
                Kl = P + (lrow0 + kstart) * INW + C_KB + kv * 128; Vl = P + (lrow0 + kstart) * INW + C_VB + kv * 128;
                qpos0 = qb * 256; kpos0 = kstart; mask = true; has_sink = true; hsink = h;
                Ob = Y + (lrow0 + qb * 256) * DM + 768 + h * 128;
            } else {
                const int v = u - 96; const bool isB = v >= 6; const int h = isB ? v - 6 : v, kv = h / 3;
                const int cq = isB ? C_QB : C_QA, ck = isB ? C_KB : C_KA, cv = isB ? C_VB : C_VA;
                Qb = P + crow0 * INW + cq + h * 128; Kc = P + crow0 * INW + ck + kv * 128; Vc = P + crow0 * INW + cv + kv * 128; Kl = Kc; Vl = Vc;
                has_sink = isB; hsink = h; Ob = Y + crow0 * DM + (isB ? 768 : 0) + h * 128;
            }
            att::attn_unit(mask, Qb, Kc, Vc, Kl, Vl, nlt, qpos0, kpos0, has_sink, has_sink ? p.sink_b[l * 6 + hsink] : 0.f, Ob, (char*)lds);
        } else {
            const int v = u - nAttn;
            const int ch = v < 64 ? b * 16 + (v >> 2) : 128 + b * 2 + ((v - 64) >> 2);
#if USE_FAST_CMLP
            cmlp_unit_fast(p, l, ch, v & 3, lds);
#else
            cmlp_unit_naive(p, l, ch, v & 3, lds);
#endif
        }
    }
}
#ifndef USE_FAST_ATT
#define USE_FAST_ATT 1
#endif

__device__ __forceinline__ void ynorm_row(bf16_t* yrow, const u32x4 (&v)[4], int lane, unsigned char* y8row, float* sdst) {
    float sq[4];
#pragma unroll
    for (int j = 0; j < 4; ++j) {
        const float a0 = bflo(v[j].x), a1 = bfhi(v[j].x), a2 = bflo(v[j].y), a3 = bfhi(v[j].y), a4 = bflo(v[j].z), a5 = bfhi(v[j].z), a6 = bflo(v[j].w), a7 = bfhi(v[j].w);
        sq[j] = a0 * a0 + a1 * a1 + a2 * a2 + a3 * a3 + a4 * a4 + a5 * a5 + a6 * a6 + a7 * a7;
    }
    const float sA = wave_sum(sq[0] + (lane < 32 ? sq[1] : 0.f));
    const float sB = wave_sum((lane >= 32 ? sq[1] : 0.f) + sq[2]);
    const float sC = wave_sum(sq[3]);
    const float rA = rsqrtf(sA * (1.f / 768.f) + EPS), rB = rsqrtf(sB * (1.f / 768.f) + EPS), rC = rsqrtf(sC * (1.f / 512.f) + EPS);
    if (GEMM_I8) {
        float x[4][8]; float am = 0.f;
#pragma unroll
        for (int j = 0; j < 4; ++j) {
            const float sc = (j == 0) ? rA : (j == 1) ? (lane < 32 ? rA : rB) : (j == 2) ? rB : rC;
            x[j][0] = bflo(v[j].x) * sc; x[j][1] = bfhi(v[j].x) * sc; x[j][2] = bflo(v[j].y) * sc; x[j][3] = bfhi(v[j].y) * sc;
            x[j][4] = bflo(v[j].z) * sc; x[j][5] = bfhi(v[j].z) * sc; x[j][6] = bflo(v[j].w) * sc; x[j][7] = bfhi(v[j].w) * sc;
#pragma unroll
            for (int i = 0; i < 8; ++i) am = fmaxf(am, fabsf(x[j][i]));
        }
        am = wave_max(am);
        const float s = am > 0.f ? am * (1.f / 127.f) : 1.f, inv = 1.f / s;
#pragma unroll
        for (int j = 0; j < 4; ++j) {
            u32x2 o; o.x = q8pack4(x[j][0], x[j][1], x[j][2], x[j][3], inv); o.y = q8pack4(x[j][4], x[j][5], x[j][6], x[j][7], inv);
            *(u32x2*)(y8row + j * 512 + lane * 8) = o;
        }
        if (lane == 0) *sdst = s;
        return;
    }
#pragma unroll
    for (int j = 0; j < 4; ++j) {
        const float sc = (j == 0) ? rA : (j == 1) ? (lane < 32 ? rA : rB) : (j == 2) ? rB : rC;
        u32x4 o;
        o.x = pk2(bflo(v[j].x) * sc, bfhi(v[j].x) * sc); o.y = pk2(bflo(v[j].y) * sc, bfhi(v[j].y) * sc);
        o.z = pk2(bflo(v[j].z) * sc, bfhi(v[j].z) * sc); o.w = pk2(bflo(v[j].w) * sc, bfhi(v[j].w) * sc);
        *(u32x4*)(yrow + j * 512 + lane * 8) = o;
    }
}
__device__ __forceinline__ void ph_ynorm(const Params& p, int l) {
    const int tid = threadIdx.x, lane = tid & 63, wave = tid >> 6;
    const int gw = blockIdx.x * NWAVES + wave, NGW = gridDim.x * NWAVES;
    bf16_t* Y = (bf16_t*)(p.ws + WS_Y);
    const int nrows = (l == DEPTH - 1) ? NLAT : MTOT;
#pragma unroll 1
    for (int r = gw; r < nrows; r += 2 * NGW) {
        const int r2 = r + NGW; const bool has2 = r2 < nrows; const int rb = has2 ? r2 : r;
        u32x4 va[4], vb[4];
#pragma unroll
        for (int j = 0; j < 4; ++j) { va[j] = *(const u32x4*)(Y + (size_t)r * DM + j * 512 + lane * 8); vb[j] = *(const u32x4*)(Y + (size_t)rb * DM + j * 512 + lane * 8); }
        unsigned char* Y8 = (unsigned char*)(p.ws + WS_XN8); float* SY = (float*)(p.ws + WS_SCL) + SCL_Y;
        ynorm_row(Y + (size_t)r * DM, va, lane, Y8 + (size_t)r * DM, SY + r);
        if (has2) ynorm_row(Y + (size_t)r2 * DM, vb, lane, Y8 + (size_t)r2 * DM, SY + r2);
    }
}

__device__ __forceinline__ void wave_argmax(float& bv, int& bi) {
#pragma unroll
    for (int o = 32; o >= 1; o >>= 1) {
        const float ov = __shfl_xor(bv, o); const int oi = __shfl_xor(bi, o);
        if (ov > bv || (ov == bv && oi < bi)) { bv = ov; bi = oi; }
    }
}
__device__ __forceinline__ void route_half(const bf16_t* qh, const bf16_t* kh, int lane, float& tv, int& ti) {
    const unsigned qq = *(const unsigned*)(qh + 2 * lane);
    const float qa = bflo(qq), qb = bfhi(qq);
    const bf16_t* k0 = kh + (size_t)lane * 128;
    const bf16_t* k1 = k0 + 64 * 128;
    float d0 = 0.f, d1 = 0.f;
#pragma unroll 2
    for (int cb = 0; cb < 16; ++cb) {
        const u32x4 a = *(const u32x4*)(k0 + cb * 8), b = *(const u32x4*)(k1 + cb * 8);
        const unsigned aw[4] = {a.x, a.y, a.z, a.w}, bw[4] = {b.x, b.y, b.z, b.w};
#pragma unroll
        for (int i = 0; i < 4; ++i) {
            const int src = cb * 4 + i;
            const float x0 = __shfl(qa, src), x1 = __shfl(qb, src);
            d0 += x0 * bflo(aw[i]) + x1 * bfhi(aw[i]);
            d1 += x0 * bflo(bw[i]) + x1 * bfhi(bw[i]);
        }
    }
    float va = d0, vb = d1; tv = 0.f; ti = 0;
#pragma unroll 1
    for (int r = 0; r < 16; ++r) {
        float bv; int bi;
        if (va >= vb) { bv = va; bi = lane; } else { bv = vb; bi = lane + 64; }
        wave_argmax(bv, bi);
        if (lane == r) { tv = bv; ti = bi; }
        if (bi == lane) va = -INFINITY; else if (bi == lane + 64) vb = -INFINITY;
    }
}
__device__ __forceinline__ void ph_route_naive(const Params& p, int l) {
    const int tid = threadIdx.x, lane = tid & 63, wave = tid >> 6;
    const int gw = blockIdx.x * NWAVES + wave, NGW = gridDim.x * NWAVES;
    const bf16_t* QP = (const bf16_t*)(p.ws + WS_P);
    const bf16_t* KEYS = (const bf16_t*)(p.ws + WS_KEYS) + (size_t)l * 8 * 2 * 128 * 128;
    int* EID = (int*)(p.ws + WS_EID); float* GATE = (float*)(p.ws + WS_GATE);
    const int nrows = (l == DEPTH - 1) ? NLAT : MTOT;
#pragma unroll 1
    for (int tk = gw; tk < nrows * 8; tk += NGW) {
        const int t = tk >> 3, h = tk & 7;
        const bf16_t* qrow = QP + (size_t)t * DM + h * 256;
        float tv0, tv1; int ti0, ti1;
        route_half(qrow, KEYS + (size_t)(h * 2 + 0) * 128 * 128, lane, tv0, ti0);
        route_half(qrow + 128, KEYS + (size_t)(h * 2 + 1) * 128 * 128, lane, tv1, ti1);
        const float v1 = __shfl(tv0, lane >> 2);
        float c0 = v1 + __shfl(tv1, (lane & 3) * 4 + 0), c1 = v1 + __shfl(tv1, (lane & 3) * 4 + 1);
        float c2 = v1 + __shfl(tv1, (lane & 3) * 4 + 2), c3 = v1 + __shfl(tv1, (lane & 3) * 4 + 3);
        float myv = 0.f; int myc = 0;
#pragma unroll 1
        for (int r = 0; r < 16; ++r) {
            float bv = c0; int bi = lane * 4;
            if (c1 > bv) { bv = c1; bi = lane * 4 + 1; }
            if (c2 > bv) { bv = c2; bi = lane * 4 + 2; }
            if (c3 > bv) { bv = c3; bi = lane * 4 + 3; }
            wave_argmax(bv, bi);
            if (lane == r) { myv = bv; myc = bi; }
            if ((bi >> 2) == lane) {
                const int u = bi & 3;
                if (u == 0) c0 = -INFINITY; else if (u == 1) c1 = -INFINITY; else if (u == 2) c2 = -INFINITY; else c3 = -INFINITY;
            }
        }
        float mx = lane < 16 ? myv : -INFINITY;
        mx = fmaxf(mx, __shfl_xor(mx, 8)); mx = fmaxf(mx, __shfl_xor(mx, 4)); mx = fmaxf(mx, __shfl_xor(mx, 2)); mx = fmaxf(mx, __shfl_xor(mx, 1));
        const float e = lane < 16 ? __expf(myv - mx) : 0.f;
        float sm = e; sm += __shfl_xor(sm, 8); sm += __shfl_xor(sm, 4); sm += __shfl_xor(sm, 2); sm += __shfl_xor(sm, 1);
        const int i1 = __shfl(ti0, myc >> 4), i2 = __shfl(ti1, myc & 15);
        if (lane < 16) { EID[(size_t)t * 128 + h * 16 + lane] = i1 * 128 + i2; GATE[(size_t)t * 128 + h * 16 + lane] = e / sm; }
    }
}


namespace rt {
typedef short bf16x8 __attribute__((ext_vector_type(8)));
typedef float f32x16 __attribute__((ext_vector_type(16)));
__device__ __forceinline__ void insert16(float (&t)[16], float x) {
#pragma unroll
    for (int j = 15; j >= 1; --j) t[j] = __builtin_amdgcn_fmed3f(t[j - 1], t[j], x);
    t[0] = fmaxf(t[0], x);
}
__device__ __forceinline__ void half_top16(const unsigned char* klds, const bf16_t* qrow, int r32, int hh, float (&t)[16]) {
    bf16x8 qf[8];
#pragma unroll
    for (int s = 0; s < 8; ++s) qf[s] = *(const bf16x8*)(qrow + 16 * s);
#pragma unroll
    for (int k = 0; k < 16; ++k) t[k] = -3.0e38f;
    const unsigned hh4 = (unsigned)hh << 2;
#pragma unroll
    for (int kb = 0; kb < 4; ++kb) {
        f32x16 acc = {};
        const int row = kb * 32 + r32;
#pragma unroll
        for (int s = 0; s < 8; ++s) {
            const bf16x8 a = *(const bf16x8*)(klds + row * 256 + ((32 * s + 16 * hh) ^ ((row & 7) << 4)));
            acc = __builtin_amdgcn_mfma_f32_32x32x16_bf16(a, qf[s], acc, 0, 0, 0);
        }
#pragma unroll
        for (int r = 0; r < 16; ++r) {
            const unsigned key = (unsigned)(kb * 32 + (r & 3) + 8 * (r >> 2)) | hh4;
            insert16(t, __uint_as_float((__float_as_uint(acc[r]) & ~127u) | key));
        }
    }
    float o[16];
#pragma unroll
    for (int k = 0; k < 16; ++k) o[k] = __shfl_xor(t[k], 32);
#pragma unroll
    for (int k = 0; k < 16; ++k) insert16(t, o[k]);
}
}
template <bool OWN_UNITS>
__device__ __forceinline__ void ph_route_fast(const Params& p, int l, unsigned char* lds) {
    int tid_ = threadIdx.x; asm volatile("" : "+v"(tid_));
    const int tid = tid_, lane = tid & 63, wave = tid >> 6, r32 = lane & 31, hh = lane >> 5;
    const bf16_t* QP = (const bf16_t*)(p.ws + WS_P);
    const bf16_t* KEYS = (const bf16_t*)(p.ws + WS_KEYS) + (size_t)l * 8 * 2 * 128 * 128;
    int* EID = (int*)(p.ws + WS_EID); float* GATE = (float*)(p.ws + WS_GATE);
    const int ntile = ((l == DEPTH - 1) ? NLAT : MTOT) / 256;
    unsigned* tab = (unsigned*)(lds + 65536) + wave * 2048;
    pg8::StaticOrder So; So.init(ntile * 256, DM, (int)gridDim.x, (int)blockIdx.x);
#pragma unroll 1
    for (int ui = 0;; ++ui) {
        int tile, h;
        if (OWN_UNITS) { pg8::Unit uu; if (!So.next(ui, uu)) break; tile = uu.pm; h = uu.pn; }
        else { const int u = blockIdx.x + ui * (int)gridDim.x; if (u >= ntile * 8) break; tile = u >> 3; h = u & 7; }
        __syncthreads();
        const u32x4* ksrc = (const u32x4*)(KEYS + (size_t)h * 2 * 128 * 128);
#pragma unroll
        for (int i = 0; i < 8; ++i) { const int c = tid + i * 512, row = c >> 4, cc = c & 15; *(u32x4*)(lds + row * 256 + ((cc * 16) ^ ((row & 7) << 4))) = ksrc[c]; }
        __syncthreads();
        const int tok = tile * 256 + wave * 32 + r32;
        const bf16_t* qrow = QP + (size_t)tok * DM + h * 256 + hh * 8;
        float v1[16], v2[16];
        rt::half_top16(lds, qrow, r32, hh, v1);
        rt::half_top16(lds + 32768, qrow + 128, r32, hh, v2);
        float c[16];
#pragma unroll
        for (int k = 0; k < 16; ++k) c[k] = -3.0e38f;
#pragma unroll
        for (int i = 0; i < 16; ++i)
#pragma unroll
            for (int j = 0; j < 16; ++j)
                if ((i + 1) * (j + 1) <= 16) rt::insert16(c, __uint_as_float((__float_as_uint(v1[i] + v2[j]) & ~255u) | (unsigned)(i * 16 + j)));
#pragma unroll
        for (int k = 0; k < 16; ++k) { tab[k * 64 + lane] = __float_as_uint(v1[k]); tab[(16 + k) * 64 + lane] = __float_as_uint(v2[k]); }
        LDS_WAIT();
        float e[16], sum = 0.f;
#pragma unroll
        for (int k = 0; k < 16; ++k) { e[k] = __expf(c[k] - c[0]); sum += e[k]; }
        const float inv = 1.f / sum;
        unsigned out[16];
#pragma unroll
        for (int k = 0; k < 16; ++k) {
            const unsigned code = __float_as_uint(c[k]) & 255u;
            const unsigned i1 = tab[(code >> 4) * 64 + lane] & 127u, i2 = tab[(16 + (code & 15u)) * 64 + lane] & 127u;
            out[k] = hh == 0 ? (i1 * 128u + i2) : __float_as_uint(e[k] * inv);
        }
        unsigned* dst = (hh == 0 ? (unsigned*)EID : (unsigned*)GATE) + (size_t)tok * 128 + h * 16;
#pragma unroll
        for (int k = 0; k < 4; ++k) { u32x4 w; w.x = out[4 * k]; w.y = out[4 * k + 1]; w.z = out[4 * k + 2]; w.w = out[4 * k + 3]; *(u32x4*)(dst + 4 * k) = w; }
        LDS_WAIT();
    }
}
#ifndef USE_FAST_ROUTE
#define USE_FAST_ROUTE 1
#endif


#if GATHER_I8
__device__ __forceinline__ float dpp_shr(float v, int n) {
    const int iv = __builtin_bit_cast(int, v); int r;
    switch (n) { case 1: r = __builtin_amdgcn_update_dpp(0, iv, 0x111, 0xf, 0xf, true); break; case 2: r = __builtin_amdgcn_update_dpp(0, iv, 0x112, 0xf, 0xf, true); break;
                 case 4: r = __builtin_amdgcn_update_dpp(0, iv, 0x114, 0xf, 0xf, true); break; default: r = __builtin_amdgcn_update_dpp(0, iv, 0x118, 0xf, 0xf, true); break; }
    return __builtin_bit_cast(float, r);
}
__device__ __forceinline__ float wave_total(float v) {
    v += dpp_shr(v, 1); v += dpp_shr(v, 2); v += dpp_shr(v, 4); v += dpp_shr(v, 8);
    v += __builtin_bit_cast(float, __builtin_amdgcn_update_dpp(0, __builtin_bit_cast(int, v), 0x142, 0xa, 0xf, false));
    v += __builtin_bit_cast(float, __builtin_amdgcn_update_dpp(0, __builtin_bit_cast(int, v), 0x143, 0xc, 0xf, false));
    return __uint_as_float(__builtin_amdgcn_readlane(__float_as_uint(v), 63));
}
#define UB0(w) ((float)((w) & 0xffu))
#define UB1(w) ((float)(((w) >> 8) & 0xffu))
#define UB2(w) ((float)(((w) >> 16) & 0xffu))
#define UB3(w) ((float)((w) >> 24))

__device__ __forceinline__ float dpp_xor1(float v) { return __builtin_bit_cast(float, __builtin_amdgcn_update_dpp(0, __builtin_bit_cast(int, v), 0xB1, 0xf, 0xf, false)); }
__device__ __forceinline__ float dpp_xor2(float v) { return __builtin_bit_cast(float, __builtin_amdgcn_update_dpp(0, __builtin_bit_cast(int, v), 0x4E, 0xf, 0xf, false)); }
__device__ __forceinline__ float dpp_xor8(float v) { return __builtin_bit_cast(float, __builtin_amdgcn_update_dpp(0, __builtin_bit_cast(int, v), 0x128, 0xf, 0xf, false)); }
__device__ __forceinline__ float reduce8_rows(const float (&d)[8], int lane) {
    const bool b0 = lane & 1, b1 = lane & 2, b2 = lane & 4;
    float r[4];
#pragma unroll
    for (int k = 0; k < 4; ++k) r[k] = (b0 ? d[2 * k + 1] : d[2 * k]) + dpp_xor1(b0 ? d[2 * k] : d[2 * k + 1]);
    float t[2];
#pragma unroll
    for (int k = 0; k < 2; ++k) t[k] = (b1 ? r[2 * k + 1] : r[2 * k]) + dpp_xor2(b1 ? r[2 * k] : r[2 * k + 1]);
    float u = (b2 ? t[1] : t[0]) + __shfl_xor(b2 ? t[0] : t[1], 4);
    u += dpp_xor8(u);
    u += __shfl_xor(u, 16);
    u += __shfl_xor(u, 32);
    return u;
}
#if GATHER_4BIT
#ifndef DRY_MODE
#define DRY_MODE 0
#endif
typedef float f32x2 __attribute__((ext_vector_type(2)));
__device__ __forceinline__ void ph_gather(const Params& p, int l, const bool dry) {
    const int tid = threadIdx.x, lane = tid & 63, wave = tid >> 6;
    const int gw = blockIdx.x * NWAVES + wave, NGW = gridDim.x * NWAVES;
    const bf16_t* XN = (const bf16_t*)(p.ws + WS_XN);
    const unsigned char* UT = (const unsigned char*)(p.ws + WS_UT) + (size_t)l * NEXP * ROW4;
    const unsigned char* VT = (const unsigned char*)(p.ws + WS_VT) + (size_t)l * NEXP * ROW4;
    const int* EID = (const int*)(p.ws + WS_EID); const float* GATE = (const float*)(p.ws + WS_GATE);
    const float* mod = (const float*)(p.ws + WS_MOD) + (size_t)l * 9 * 12288;
    const int nrows = (l == DEPTH - 1) ? NLAT : MTOT;
#pragma unroll 1
    for (int t = gw; t < nrows; t += NGW) {
        int xh[4], xl[4]; float sxl;
#if GEMM_I8 && GEMM3_I8
        {
            sxl = ((const float*)(p.ws + WS_SCL))[SCL_XN + t];
            const unsigned char* x8 = (const unsigned char*)(p.ws + WS_XN8) + (size_t)t * DM;
#pragma unroll
            for (int j = 0; j < 2; ++j) {
                const u32x4 q4 = *(const u32x4*)(x8 + j * 1024 + lane * 16);
                const unsigned ww[4] = {q4.x, q4.y, q4.z, q4.w};
#pragma unroll
                for (int dd = 0; dd < 2; ++dd) {
                    unsigned h = 0u, lo = 0u;
#pragma unroll
                    for (int k = 0; k < 8; ++k) {
                        const int q = (int)(signed char)((ww[dd * 2 + (k >> 2)] >> (8 * (k & 3))) & 0xffu);
                        const int ql = ((q + 8) & 15) - 8, qh = (q - ql) >> 4;
                        h |= ((unsigned)qh & 15u) << (4 * k); lo |= ((unsigned)ql & 15u) << (4 * k);
                    }
                    xh[j * 2 + dd] = (int)h; xl[j * 2 + dd] = (int)lo;
                }
            }
        }
#else
        {
            float x[32]; float am = 0.f;
#pragma unroll
            for (int j = 0; j < 2; ++j)
#pragma unroll
                for (int k = 0; k < 2; ++k) {
                    const u32x4 q = *(const u32x4*)(XN + (size_t)t * DM + j * 1024 + lane * 16 + k * 8);
                    float* xx = x + j * 16 + k * 8;
                    xx[0] = bflo(q.x); xx[1] = bfhi(q.x); xx[2] = bflo(q.y); xx[3] = bfhi(q.y); xx[4] = bflo(q.z); xx[5] = bfhi(q.z); xx[6] = bflo(q.w); xx[7] = bfhi(q.w);
                }
#pragma unroll
            for (int i = 0; i < 32; ++i) am = fmaxf(am, fabsf(x[i]));
            sxl = am > 0.f ? am * (1.f / 119.f) : 1.f;
            const float inv = 1.f / sxl;
#pragma unroll
            for (int d = 0; d < 4; ++d) {
                unsigned h = 0u, lo = 0u;
#pragma unroll
                for (int k = 0; k < 8; ++k) {
                    const int q = (int)rintf(x[8 * d + k] * inv);
                    const int ql = ((q + 8) & 15) - 8, qh = (q - ql) >> 4;
                    h |= ((unsigned)qh & 15u) << (4 * k); lo |= ((unsigned)ql & 15u) << (4 * k);
                }
                xh[d] = (int)h; xl[d] = (int)lo;
            }
        }
#endif
        const int e0 = EID[(size_t)t * 128 + lane], e1 = EID[(size_t)t * 128 + 64 + lane];
        const float g0 = GATE[(size_t)t * 128 + lane], g1 = GATE[(size_t)t * 128 + 64 + lane];
        float hid0 = 0.f, hid1 = 0.f;
        constexpr int GB = 8;
#define G_LOAD(W, S, TAB, EB) do { _Pragma("unroll") for (int i = 0; i < GB; ++i) { \
            const int id_ = __builtin_amdgcn_readlane((EB) < 64 ? e0 : e1, ((EB) + i) & 63); \
            const unsigned char* row_ = (TAB) + (size_t)id_ * ROW4; \
            W[i] = *(const u32x4*)(row_ + lane * 16); S[i] = *(const unsigned short*)(row_ + 1024 + lane * 2); } } while (0)
#define G_DOT(W, S, EB) do { float dd_[8]; _Pragma("unroll") for (int i = 0; i < GB; ++i) { int sh_ = 0, sl_ = 0; \
            const unsigned ww[4] = {W[i].x, W[i].y, W[i].z, W[i].w}; \
            _Pragma("unroll") for (int d = 0; d < 4; ++d) { \
                sh_ = __builtin_amdgcn_sdot8((int)ww[d], xh[d], sh_, false); \
                sl_ = __builtin_amdgcn_sdot8((int)ww[d], xl[d], sl_, false); } \
            dd_[i] = (float)((sh_ << 4) + sl_) * (sxl * bf2f(S[i])); } \
            const float tot = reduce8_rows(dd_, lane);              \
            if ((lane & 56) == ((EB) & 63)) { if ((EB) < 64) hid0 = tot; else hid1 = tot; } } while (0)
#define G_AXPY(W, S, EB) do { _Pragma("unroll") for (int i = 0; i < GB; ++i) { \
            const float m_ = __uint_as_float(__builtin_amdgcn_readlane(__float_as_uint((EB) < 64 ? cf0 : cf1), ((EB) + i) & 63)) * bf2f(S[i]); \
            const f32x2 mm = {m_, m_}; \
            const unsigned ww[4] = {W[i].x, W[i].y, W[i].z, W[i].w}; \
            _Pragma("unroll") for (int d = 0; d < 4; ++d) { \
                acc[4 * d + 0] += mm * __builtin_amdgcn_cvt_scalef32_pk_f32_fp4(ww[d], 1.0f, 0); \
                acc[4 * d + 1] += mm * __builtin_amdgcn_cvt_scalef32_pk_f32_fp4(ww[d], 1.0f, 1); \
                acc[4 * d + 2] += mm * __builtin_amdgcn_cvt_scalef32_pk_f32_fp4(ww[d], 1.0f, 2); \
                acc[4 * d + 3] += mm * __builtin_amdgcn_cvt_scalef32_pk_f32_fp4(ww[d], 1.0f, 3); } } } while (0)
        u32x4 wa[GB], wb[GB]; unsigned sa[GB], sb[GB];
        const bool do_u = !(dry && (DRY_MODE == 4 || DRY_MODE == 5)), do_v = !(dry && (DRY_MODE == 3 || DRY_MODE == 5));
        if (do_u) G_LOAD(wa, sa, UT, 0); else G_LOAD(wa, sa, VT, 0);
#pragma unroll 1
        for (int eb = 0; eb < (do_u ? 128 : 0); eb += 2 * GB) {
            G_LOAD(wb, sb, UT, eb + GB);
            G_DOT(wa, sa, eb);
            if (eb + 2 * GB < 128) G_LOAD(wa, sa, UT, eb + 2 * GB); else G_LOAD(wa, sa, VT, 0);
            G_DOT(wb, sb, eb + GB);
        }
        const float cf0 = gelu_tanh(hid0) * g0, cf1 = gelu_tanh(hid1) * g1;
        f32x2 acc[16];
#pragma unroll
        for (int i = 0; i < 16; ++i) acc[i] = (f32x2){0.f, 0.f};
#pragma unroll 1
        for (int eb = 0; eb < (do_v ? 128 : 0); eb += 2 * GB) {
            G_LOAD(wb, sb, VT, eb + GB);
            G_AXPY(wa, sa, eb);
            if (eb + 2 * GB < 128) G_LOAD(wa, sa, VT, eb + 2 * GB);
            G_AXPY(wb, sb, eb + GB);
        }
#undef G_LOAD
#undef G_DOT
#undef G_AXPY
        float hn[32];
        float* hrow = t < NLAT ? p.out + (size_t)t * DM : (float*)(p.ws + WS_HC) + (size_t)(t - NLAT) * DM;
        const int bb = t < NLAT ? (t >> 11) : 8;
        const float* gate = mod + (size_t)bb * 12288 + 5 * DM;
#pragma unroll
        for (int j = 0; j < 2; ++j)
#pragma unroll
            for (int k = 0; k < 4; ++k) {
                const int col = j * 1024 + lane * 16 + k * 4;
                const f32x4 hv = *(const f32x4*)(hrow + col), gv = *(const f32x4*)(gate + col);
                const f32x2 a0 = acc[j * 8 + k * 2], a1 = acc[j * 8 + k * 2 + 1];
                f32x4 o;
                o.x = hv.x + gv.x * a0.x; o.y = hv.y + gv.y * a0.y; o.z = hv.z + gv.z * a1.x; o.w = hv.w + gv.w * a1.y;
                *(f32x4*)((dry ? (float*)(p.ws + WS_DUMMY) + (size_t)(t & 16383) * DM : hrow) + col) = o;
                hn[j * 16 + k * 4 + 0] = o.x; hn[j * 16 + k * 4 + 1] = o.y; hn[j * 16 + k * 4 + 2] = o.z; hn[j * 16 + k * 4 + 3] = o.w;
            }
        if (l + 1 < DEPTH) {
            float ss = 0.f;
#pragma unroll
            for (int i = 0; i < 32; ++i) ss += hn[i] * hn[i];
            const float rstd = rsqrtf(wave_total(ss) * (1.f / DM) + EPS);
            const float* g1n = p.norm1_g + (l + 1) * DM;
            const float* shift = mod + (size_t)9 * 12288 + (size_t)bb * 12288;
            const float* scale = shift + DM;
            if (GEMM_I8) {
                float am = 0.f;
#pragma unroll
                for (int j = 0; j < 2; ++j)
#pragma unroll
                    for (int i = 0; i < 16; ++i) { const int col = j * 1024 + lane * 16 + i; hn[j * 16 + i] = hn[j * 16 + i] * rstd * g1n[col] * (1.f + scale[col]) + shift[col]; am = fmaxf(am, fabsf(hn[j * 16 + i])); }
                am = wave_max(am);
                const float s8 = am > 0.f ? am * (1.f / 127.f) : 1.f, inv8 = 1.f / s8;
                unsigned char* xo8 = (dry ? (unsigned char*)(p.ws + WS_DUMMY) + (size_t)(t & 16383) * DM : (unsigned char*)(p.ws + WS_XN8) + (size_t)t * DM);
#pragma unroll
                for (int j = 0; j < 2; ++j) {
                    u32x4 w;
                    w.x = q8pack4(hn[j * 16 + 0], hn[j * 16 + 1], hn[j * 16 + 2], hn[j * 16 + 3], inv8); w.y = q8pack4(hn[j * 16 + 4], hn[j * 16 + 5], hn[j * 16 + 6], hn[j * 16 + 7], inv8);
                    w.z = q8pack4(hn[j * 16 + 8], hn[j * 16 + 9], hn[j * 16 + 10], hn[j * 16 + 11], inv8); w.w = q8pack4(hn[j * 16 + 12], hn[j * 16 + 13], hn[j * 16 + 14], hn[j * 16 + 15], inv8);
                    *(u32x4*)(xo8 + j * 1024 + lane * 16) = w;
                }
                if (lane == 0 && !dry) ((float*)(p.ws + WS_SCL))[SCL_XN + t] = s8;
            } else {
            bf16_t* xo = (dry ? (bf16_t*)(p.ws + WS_DUMMY) + (size_t)(t & 16383) * DM : (bf16_t*)(p.ws + WS_XN) + (size_t)t * DM);
#pragma unroll
            for (int j = 0; j < 2; ++j)
#pragma unroll
                for (int k = 0; k < 2; ++k) {
                    const int col = j * 1024 + lane * 16 + k * 8;
                    float xv[8];
#pragma unroll
                    for (int i = 0; i < 8; ++i) xv[i] = hn[j * 16 + k * 8 + i] * rstd * g1n[col + i] * (1.f + scale[col + i]) + shift[col + i];
                    u32x4 w; w.x = pk2(xv[0], xv[1]); w.y = pk2(xv[2], xv[3]); w.z = pk2(xv[4], xv[5]); w.w = pk2(xv[6], xv[7]);
                    *(u32x4*)(xo + col) = w;
                }
            }
        }
    }
}
#else
#ifndef DRY_MODE
#define DRY_MODE 0
#endif
typedef float f32x2 __attribute__((ext_vector_type(2)));
__device__ __forceinline__ void ph_gather(const Params& p, int l, const bool dry) {
    const int tid = threadIdx.x, lane = tid & 63, wave = tid >> 6;
    const int gw = blockIdx.x * NWAVES + wave, NGW = gridDim.x * NWAVES;
    const bf16_t* XN = (const bf16_t*)(p.ws + WS_XN);
    const unsigned char* UT = (const unsigned char*)(p.ws + WS_UT) + (size_t)l * NEXP * DM;
    const unsigned char* VT = (const unsigned char*)(p.ws + WS_VT) + (size_t)l * NEXP * DM;
    const float* USC = (const float*)(p.ws + WS_USC) + l * NEXP; const float* VSC = (const float*)(p.ws + WS_VSC) + l * NEXP;
    const int* EID = (const int*)(p.ws + WS_EID); const float* GATE = (const float*)(p.ws + WS_GATE);
    const float* mod = (const float*)(p.ws + WS_MOD) + (size_t)l * 9 * 12288;
    const int nrows = (l == DEPTH - 1) ? NLAT : MTOT;
#pragma unroll 1
    for (int t = gw; t < nrows; t += NGW) {
        int xq[8]; float sxl;
        {
            float x[32]; float am = 0.f;
#pragma unroll
            for (int j = 0; j < 2; ++j)
#pragma unroll
                for (int k = 0; k < 2; ++k) {
                    const u32x4 q = *(const u32x4*)(XN + (size_t)t * DM + j * 1024 + lane * 16 + k * 8);
                    float* xx = x + j * 16 + k * 8;
                    xx[0] = bflo(q.x); xx[1] = bfhi(q.x); xx[2] = bflo(q.y); xx[3] = bfhi(q.y); xx[4] = bflo(q.z); xx[5] = bfhi(q.z); xx[6] = bflo(q.w); xx[7] = bfhi(q.w);
                }
#pragma unroll
            for (int i = 0; i < 32; ++i) am = fmaxf(am, fabsf(x[i]));
            sxl = am > 0.f ? am * (1.f / 127.f) : 1.f;
            const float inv = 1.f / sxl;
#pragma unroll
            for (int d = 0; d < 8; ++d) {
                const int q0 = (int)rintf(x[4 * d] * inv), q1 = (int)rintf(x[4 * d + 1] * inv), q2 = (int)rintf(x[4 * d + 2] * inv), q3 = (int)rintf(x[4 * d + 3] * inv);
                xq[d] = (int)(((unsigned)q0 & 0xffu) | (((unsigned)q1 & 0xffu) << 8) | (((unsigned)q2 & 0xffu) << 16) | ((unsigned)q3 << 24));
            }
        }
        const int e0 = EID[(size_t)t * 128 + lane], e1 = EID[(size_t)t * 128 + 64 + lane];
        const float g0 = GATE[(size_t)t * 128 + lane], g1 = GATE[(size_t)t * 128 + 64 + lane];
        const float us0 = USC[e0], us1 = USC[e1], vs0 = VSC[e0], vs1 = VSC[e1];
        float hid0 = 0.f, hid1 = 0.f;
        constexpr int GBU = 8, GBV = 4;
#define G_LOAD(W, TAB, EB, NB) do { _Pragma("unroll") for (int i = 0; i < NB; ++i) { \
            const int id_ = __builtin_amdgcn_readlane((EB) < 64 ? e0 : e1, ((EB) + i) & 63); \
            const unsigned char* row_ = (TAB) + (size_t)id_ * DM + lane * 16; \
            W[i][0] = *(const u32x4*)row_; W[i][1] = *(const u32x4*)(row_ + 1024); } } while (0)
#define G_DOT(W, EB) do { _Pragma("unroll") for (int i = 0; i < GBU; ++i) { int s_ = 0; \
            s_ = __builtin_amdgcn_sdot4((int)W[i][0].x, xq[0], s_, false); s_ = __builtin_amdgcn_sdot4((int)W[i][0].y, xq[1], s_, false); \
            s_ = __builtin_amdgcn_sdot4((int)W[i][0].z, xq[2], s_, false); s_ = __builtin_amdgcn_sdot4((int)W[i][0].w, xq[3], s_, false); \
            s_ = __builtin_amdgcn_sdot4((int)W[i][1].x, xq[4], s_, false); s_ = __builtin_amdgcn_sdot4((int)W[i][1].y, xq[5], s_, false); \
            s_ = __builtin_amdgcn_sdot4((int)W[i][1].z, xq[6], s_, false); s_ = __builtin_amdgcn_sdot4((int)W[i][1].w, xq[7], s_, false); \
            const float tot = wave_total((float)s_ * sxl); \
            if ((((EB) + i) & 63) == lane) { if ((EB) < 64) hid0 = tot; else hid1 = tot; } } } while (0)
#define G_AXPY(W, EB) do { _Pragma("unroll") for (int i = 0; i < GBV; ++i) { \
            const float cf_ = __uint_as_float(__builtin_amdgcn_readlane(__float_as_uint((EB) < 64 ? cf0 : cf1), ((EB) + i) & 63)); \
            const f32x2 mm = {cf_, cf_}; \
            _Pragma("unroll") for (int j = 0; j < 2; ++j) { const unsigned ww[4] = {W[i][j].x, W[i][j].y, W[i][j].z, W[i][j].w}; \
                _Pragma("unroll") for (int k = 0; k < 4; ++k) { \
                    acc[j * 8 + k * 2] += mm * __builtin_amdgcn_cvt_pk_f32_fp8((int)ww[k], false); \
                    acc[j * 8 + k * 2 + 1] += mm * __builtin_amdgcn_cvt_pk_f32_fp8((int)ww[k], true); } } } } while (0)
        u32x4 wa[GBU][2], wb[GBU][2];
        const bool do_u = !(dry && (DRY_MODE == 4 || DRY_MODE == 5)), do_v = !(dry && (DRY_MODE == 3 || DRY_MODE == 5));
        if (do_u) G_LOAD(wa, UT, 0, GBU); else G_LOAD(wa, VT, 0, GBV);
#pragma unroll 1
        for (int eb = 0; eb < (do_u ? 128 : 0); eb += 2 * GBU) {
            G_LOAD(wb, UT, eb + GBU, GBU);
            G_DOT(wa, eb);
            if (eb + 2 * GBU < 128) G_LOAD(wa, UT, eb + 2 * GBU, GBU); else G_LOAD(wa, VT, 0, GBV);
            G_DOT(wb, eb + GBU);
        }
        const float cf0 = gelu_tanh(hid0 * us0) * g0 * vs0, cf1 = gelu_tanh(hid1 * us1) * g1 * vs1;
        f32x2 acc[16];
#pragma unroll
        for (int i = 0; i < 16; ++i) acc[i] = (f32x2){0.f, 0.f};
#pragma unroll 1
        for (int eb = 0; eb < (do_v ? 128 : 0); eb += 2 * GBV) {
            G_LOAD(wb, VT, eb + GBV, GBV);
            G_AXPY(wa, eb);
            if (eb + 2 * GBV < 128) G_LOAD(wa, VT, eb + 2 * GBV, GBV);
            G_AXPY(wb, eb + GBV);
        }
#undef G_LOAD
#undef G_DOT
#undef G_AXPY
        float hn[32];
        float* hrow = t < NLAT ? p.out + (size_t)t * DM : (float*)(p.ws + WS_HC) + (size_t)(t - NLAT) * DM;
        const int bb = t < NLAT ? (t >> 11) : 8;
        const float* gate = mod + (size_t)bb * 12288 + 5 * DM;
#pragma unroll
        for (int j = 0; j < 2; ++j)
#pragma unroll
            for (int k = 0; k < 4; ++k) {
                const int col = j * 1024 + lane * 16 + k * 4;
                const f32x4 hv = *(const f32x4*)(hrow + col), gv = *(const f32x4*)(gate + col);
                const f32x2 a0 = acc[j * 8 + k * 2], a1 = acc[j * 8 + k * 2 + 1];
                f32x4 o;
                o.x = hv.x + gv.x * a0.x; o.y = hv.y + gv.y * a0.y; o.z = hv.z + gv.z * a1.x; o.w = hv.w + gv.w * a1.y;
                *(f32x4*)((dry ? (float*)(p.ws + WS_DUMMY) + (size_t)(t & 16383) * DM : hrow) + col) = o;
                hn[j * 16 + k * 4 + 0] = o.x; hn[j * 16 + k * 4 + 1] = o.y; hn[j * 16 + k * 4 + 2] = o.z; hn[j * 16 + k * 4 + 3] = o.w;
            }
        if (l + 1 < DEPTH) {
            float ss = 0.f;
#pragma unroll
            for (int i = 0; i < 32; ++i) ss += hn[i] * hn[i];
            const float rstd = rsqrtf(wave_total(ss) * (1.f / DM) + EPS);
            const float* g1n = p.norm1_g + (l + 1) * DM;
            const float* shift = mod + (size_t)9 * 12288 + (size_t)bb * 12288;
            const float* scale = shift + DM;
            bf16_t* xo = (dry ? (bf16_t*)(p.ws + WS_DUMMY) + (size_t)(t & 16383) * DM : (bf16_t*)(p.ws + WS_XN) + (size_t)t * DM);
#pragma unroll
            for (int j = 0; j < 2; ++j)
#pragma unroll
                for (int k = 0; k < 2; ++k) {
                    const int col = j * 1024 + lane * 16 + k * 8;
                    float xv[8];
#pragma unroll
                    for (int i = 0; i < 8; ++i) xv[i] = hn[j * 16 + k * 8 + i] * rstd * g1n[col + i] * (1.f + scale[col + i]) + shift[col + i];
                    u32x4 w; w.x = pk2(xv[0], xv[1]); w.y = pk2(xv[2], xv[3]); w.z = pk2(xv[4], xv[5]); w.w = pk2(xv[6], xv[7]);
                    *(u32x4*)(xo + col) = w;
                }
        }
    }
}
#endif
#else
__device__ __forceinline__ float dot8(const u32x4 u, const u32x4 x) {
    float d = bflo(u.x) * bflo(x.x) + bfhi(u.x) * bfhi(x.x);
    d += bflo(u.y) * bflo(x.y) + bfhi(u.y) * bfhi(x.y);
    d += bflo(u.z) * bflo(x.z) + bfhi(u.z) * bfhi(x.z);
    d += bflo(u.w) * bflo(x.w) + bfhi(u.w) * bfhi(x.w);
    return d;
}
__device__ __forceinline__ void ph_gather(const Params& p, int l, const bool dry) {
    const int tid = threadIdx.x, lane = tid & 63, wave = tid >> 6;
    const int gw = blockIdx.x * NWAVES + wave, NGW = gridDim.x * NWAVES;
    const bf16_t* XN = (const bf16_t*)(p.ws + WS_XN);
    const bf16_t* UT = (const bf16_t*)(p.ws + WS_UT) + (size_t)l * NEXP * DM;
    const bf16_t* VT = (const bf16_t*)(p.ws + WS_VT) + (size_t)l * NEXP * DM;
    const int* EID = (const int*)(p.ws + WS_EID); const float* GATE = (const float*)(p.ws + WS_GATE);
    const float* mod = (const float*)(p.ws + WS_MOD) + (size_t)l * 9 * 12288;
    const int nrows = (l == DEPTH - 1) ? NLAT : MTOT;
    for (int t = gw; t < nrows; t += NGW) {
        u32x4 xq[4];
#pragma unroll
        for (int j = 0; j < 4; ++j) xq[j] = *(const u32x4*)(XN + (size_t)t * DM + j * 512 + lane * 8);
        const int e0 = EID[(size_t)t * 128 + lane], e1 = EID[(size_t)t * 128 + 64 + lane];
        const float g0 = GATE[(size_t)t * 128 + lane], g1 = GATE[(size_t)t * 128 + 64 + lane];
        float hid0 = 0.f, hid1 = 0.f;
#pragma unroll 1
        for (int eb = 0; eb < 128; eb += 4) {
            u32x4 uu[4][4];
#pragma unroll
            for (int i = 0; i < 4; ++i) {
                const int e = eb + i;
                const int id = __builtin_amdgcn_readlane(eb < 64 ? e0 : e1, e & 63);
                const u32x4* ur = (const u32x4*)(UT + (size_t)id * DM) + lane;
#pragma unroll
                for (int j = 0; j < 4; ++j) uu[i][j] = ur[j * 64];
            }
#pragma unroll
            for (int i = 0; i < 4; ++i) {
                const int e = eb + i;
                float d = dot8(uu[i][0], xq[0]) + dot8(uu[i][1], xq[1]) + dot8(uu[i][2], xq[2]) + dot8(uu[i][3], xq[3]);
                d = wave_sum(d);
                if ((e & 63) == lane) { if (eb < 64) hid0 = d; else hid1 = d; }
            }
        }
        const float cf0 = gelu_tanh(hid0) * g0, cf1 = gelu_tanh(hid1) * g1;
        float acc[32];
#pragma unroll
        for (int i = 0; i < 32; ++i) acc[i] = 0.f;
#pragma unroll 1
        for (int eb = 0; eb < 128; eb += 4) {
            u32x4 vv[4][4]; float cf[4];
#pragma unroll
            for (int i = 0; i < 4; ++i) {
                const int e = eb + i;
                const int id = __builtin_amdgcn_readlane(eb < 64 ? e0 : e1, e & 63);
                cf[i] = __uint_as_float(__builtin_amdgcn_readlane(__float_as_uint(eb < 64 ? cf0 : cf1), e & 63));
                const u32x4* vr = (const u32x4*)(VT + (size_t)id * DM) + lane;
#pragma unroll
                for (int j = 0; j < 4; ++j) vv[i][j] = vr[j * 64];
            }
#pragma unroll
            for (int i = 0; i < 4; ++i)
#pragma unroll
                for (int j = 0; j < 4; ++j) {
                    acc[j * 8 + 0] += cf[i] * bflo(vv[i][j].x); acc[j * 8 + 1] += cf[i] * bfhi(vv[i][j].x);
                    acc[j * 8 + 2] += cf[i] * bflo(vv[i][j].y); acc[j * 8 + 3] += cf[i] * bfhi(vv[i][j].y);
                    acc[j * 8 + 4] += cf[i] * bflo(vv[i][j].z); acc[j * 8 + 5] += cf[i] * bfhi(vv[i][j].z);
                    acc[j * 8 + 6] += cf[i] * bflo(vv[i][j].w); acc[j * 8 + 7] += cf[i] * bfhi(vv[i][j].w);
                }
        }
        float* hrow = t < NLAT ? p.out + (size_t)t * DM : (float*)(p.ws + WS_HC) + (size_t)(t - NLAT) * DM;
        const int bb = t < NLAT ? (t >> 11) : 8;
        const float* gate = mod + (size_t)bb * 12288 + 5 * DM;
#pragma unroll
        for (int j = 0; j < 4; ++j) {
            const int col = j * 512 + lane * 8;
#pragma unroll
            for (int hh = 0; hh < 2; ++hh) {
                const f32x4 hv = *(const f32x4*)(hrow + col + hh * 4), gv = *(const f32x4*)(gate + col + hh * 4);
                f32x4 o;
                o.x = hv.x + gv.x * acc[j * 8 + hh * 4 + 0]; o.y = hv.y + gv.y * acc[j * 8 + hh * 4 + 1];
                o.z = hv.z + gv.z * acc[j * 8 + hh * 4 + 2]; o.w = hv.w + gv.w * acc[j * 8 + hh * 4 + 3];
                *(f32x4*)(hrow + col + hh * 4) = o;
            }
        }
    }
}

#endif

#define LAS __attribute__((address_space(3)))
#define XB_TMO      128
#define XB_XCNT(j)  (256  + 64 * (j))
#define XB_XSUB(j)  (1280 + 64 * (j))
#define XB_XGEN(j)  (2304 + 64 * (j))
#define XB_TOP      3328
#define XB_TOPGEN   3392
#define XCD_BAR_WORDS 3456
#define XB_SPIN_CAP (1u << 18)

__device__ __forceinline__ unsigned xb_ld(unsigned* p)              { return __hip_atomic_load(p, __ATOMIC_RELAXED, __HIP_MEMORY_SCOPE_AGENT); }
__device__ __forceinline__ unsigned xb_add(unsigned* p, unsigned v) { return __hip_atomic_fetch_add(p, v, __ATOMIC_RELAXED, __HIP_MEMORY_SCOPE_AGENT); }
__device__ __forceinline__ unsigned xb_xcc_id() { return (unsigned)__builtin_amdgcn_s_getreg((3 << 11) | 20) & 0xFu; }
#define XB_SPIN(cond, bar) do { unsigned _sp = 0; while (cond) { __builtin_amdgcn_s_sleep(1); \
    if ((++_sp & 255u) == 0u) { if (xb_ld(&(bar)[XB_TMO])) break; if (_sp > XB_SPIN_CAP) { atomicAdd(&(bar)[XB_TMO], 1u); break; } } } } while (0)

struct XcdBarrier {
    unsigned* bar; unsigned x;
    volatile LAS unsigned* st;
};

__device__ __forceinline__ XcdBarrier xcd_barrier_post(unsigned* bar, volatile LAS unsigned* st) {
    XcdBarrier b; b.bar = bar; b.x = xb_xcc_id(); b.st = st;
    if (threadIdx.x == 0) (void)xb_add(&bar[XB_XCNT(b.x)], 1u);
    return b;
}
__device__ __forceinline__ void xcd_barrier_complete(unsigned* bar, unsigned x, unsigned& nloc, unsigned& nx) {
    const unsigned G = gridDim.x * gridDim.y * gridDim.z;
    unsigned sum, cnt, mine, sp = 0u;
    for (;;) {
        sum = 0u; cnt = 0u; mine = 0u;
#pragma unroll
        for (unsigned j = 0; j < 16; ++j) { const unsigned c = xb_ld(&bar[XB_XCNT(j)]); sum += c; cnt += (c > 0u) ? 1u : 0u; mine = (j == x) ? c : mine; }
        if (sum == G) break;
        __builtin_amdgcn_s_sleep(1);
        if ((++sp & 255u) == 0u) { if (xb_ld(&bar[XB_TMO])) break; if (sp > XB_SPIN_CAP) { atomicAdd(&bar[XB_TMO], 1u); break; } }
    }
    nloc = mine > 0u ? mine : 1u; nx = cnt > 0u ? cnt : 1u;
}

__device__ __forceinline__ void xcd_barrier(const XcdBarrier& b) {
    asm volatile("s_waitcnt vmcnt(0)" ::: "memory");
    __syncthreads();
    if (threadIdx.x == 0) {
        unsigned* bar = b.bar;
        __builtin_amdgcn_s_waitcnt(0);
        unsigned nloc = b.st[0], nx = b.st[1];
        if (nloc == 0u) { xcd_barrier_complete(bar, b.x, nloc, nx); b.st[0] = nloc; b.st[1] = nx; }
        const unsigned old = xb_add(&bar[XB_XSUB(b.x)], 1u);
        const unsigned gen = old / nloc;
        if (old + 1u == (gen + 1u) * nloc) {
            __builtin_amdgcn_fence(__ATOMIC_RELEASE, "agent");
            asm volatile("s_waitcnt vmcnt(0)" ::: "memory");
            const unsigned og = xb_add(&bar[XB_TOP], 1u);
            const unsigned tg = og / nx;
            if (og + 1u == (tg + 1u) * nx) xb_add(&bar[XB_TOPGEN], 1u);
            else XB_SPIN(xb_ld(&bar[XB_TOPGEN]) == tg, bar);
            __builtin_amdgcn_fence(__ATOMIC_ACQUIRE, "agent");
            xb_add(&bar[XB_XGEN(b.x)], 1u);
            asm volatile("s_waitcnt vmcnt(0)" ::: "memory");
        } else {
            XB_SPIN(xb_ld(&bar[XB_XGEN(b.x)]) == gen, bar);
            __builtin_amdgcn_fence(__ATOMIC_ACQUIRE, "agent");
            asm volatile("s_waitcnt vmcnt(0)" ::: "memory");
        }
    }
    __syncthreads();
}

constexpr int NPHASE = 1 + 10 * DEPTH;
template <int S>
__device__ __forceinline__ void run_stage(const Params& p, int l, unsigned char* lds, const bool dry) {
    const bool last = (l == DEPTH - 1);
    const float* mod = (const float*)(p.ws + WS_MOD) + (size_t)l * 9 * 12288;
    if constexpr (S == 1) { if (l == 0) { ph_modulate(p, l, 0); if (GEMM_I8 && !dry) ph_weights_i8(p, lds); } }
    if constexpr (S == 2) {
#if USE_PG8
        pg8::StaticOrder So; So.init(MTOT, INW, (int)gridDim.x, (int)blockIdx.x);
#if GEMM_I8
        pg8::Gemm g{(const bf16_t*)(p.ws + WS_XN8), (const bf16_t*)(p.ws + WS_WIN + (size_t)l * INW * DM), MTOT, INW, DM / 2};
        pg8::EpiBf16I8 E{(bf16_t*)(p.ws + WS_P), INW, (const float*)(p.ws + WS_SCL) + SCL_XN, (const float*)(p.ws + WS_SCL) + SCL_WIN + l * INW};
        pg8::gemm_phase<pg8::EpiBf16I8, pg8::StaticOrder, true, true, true>((PG8_LAS unsigned char*)lds, g, So, E);
#else
        pg8::Gemm g{(const bf16_t*)(p.ws + WS_XN), (const bf16_t*)(p.ws + WS_WIN) + (size_t)l * INW * DM, MTOT, INW, DM};
        pg8::EpiBf16<0> E{(bf16_t*)(p.ws + WS_P), INW, nullptr, 0, 0, 1.f};
        pg8::gemm_phase<pg8::EpiBf16<0>, pg8::StaticOrder, true, true>((PG8_LAS unsigned char*)lds, g, So, E);
#endif
#else
        EpiBf16Store E{(bf16_t*)(p.ws + WS_P), INW};
        gemm_naive(lds, (const bf16_t*)(p.ws + WS_XN), (const bf16_t*)(p.ws + WS_WIN) + (size_t)l * INW * DM, MTOT, INW, DM, E);
#endif
    }
    if constexpr (S == 3) ph_prep(p, l, dry);
    if constexpr (S == 4) {
#if USE_FAST_ATT
        ph_mixers_fast(p, l, lds, dry);
#else
        ph_mixers_naive(p, l, lds);
#endif
    }
    if constexpr (S == 5) ph_ynorm(p, l);
    if constexpr (S == 6) {
#if USE_PG8
        const int M = last ? NLAT : MTOT;
        pg8::StaticOrder So; So.init(M, DM, (int)gridDim.x, (int)blockIdx.x);
#if GEMM_I8
        pg8::Gemm g{(const bf16_t*)(p.ws + WS_XN8), (const bf16_t*)(p.ws + WS_WOUT + (size_t)l * DM * DM), M, DM, DM / 2};
        pg8::EpiResGateI8 E{l == 0 ? p.x : p.out, l == 0 ? p.ctx : (const float*)(p.ws + WS_HC), dry ? (float*)(p.ws + WS_DUMMY) : p.out, dry ? (float*)(p.ws + WS_DUMMY) : (float*)(p.ws + WS_HC), mod + 2 * DM,
                            (const float*)(p.ws + WS_SCL) + SCL_Y, (const float*)(p.ws + WS_SCL) + SCL_WOUT + l * DM};
        pg8::gemm_phase<pg8::EpiResGateI8, pg8::StaticOrder, true, true, true>((PG8_LAS unsigned char*)lds, g, So, E);
#else
        pg8::Gemm g{(const bf16_t*)(p.ws + WS_Y), (const bf16_t*)(p.ws + WS_WOUT) + (size_t)l * DM * DM, M, DM, DM};
        pg8::EpiResGateT E{l == 0 ? p.x : p.out, l == 0 ? p.ctx : (const float*)(p.ws + WS_HC), dry ? (float*)(p.ws + WS_DUMMY) : p.out, dry ? (float*)(p.ws + WS_DUMMY) : (float*)(p.ws + WS_HC), mod + 2 * DM};
        pg8::gemm_phase<pg8::EpiResGateT, pg8::StaticOrder, true, true>((PG8_LAS unsigned char*)lds, g, So, E);
#endif
#if GATHER_I8 && GATHER_4BIT
        if (TABLES_IN_GAPS && l == 0 && !dry) conv4_tables(p, 0, 2 * NEXP, (unsigned*)(p.ws + WS_CTL) + 6144, lds);
#endif
#else
        EpiResGate E{l == 0 ? p.x : p.out, l == 0 ? p.ctx : (const float*)(p.ws + WS_HC), p.out, (float*)(p.ws + WS_HC), mod + 2 * DM};
        gemm_naive(lds, (const bf16_t*)(p.ws + WS_Y), (const bf16_t*)(p.ws + WS_WOUT) + (size_t)l * DM * DM, last ? NLAT : MTOT, DM, DM, E);
#endif
    }
    if constexpr (S == 7) ph_modulate(p, l, 1);
    if constexpr (S == 8) {
#if USE_PG8
        const int M = last ? NLAT : MTOT;
        pg8::StaticOrder So; So.init(M, DM, (int)gridDim.x, (int)blockIdx.x);
#if GEMM_I8 && GEMM3_I8
        pg8::Gemm g{(const bf16_t*)(p.ws + WS_XN8), (const bf16_t*)(p.ws + WS_WQ + (size_t)l * DM * DM), M, DM, DM / 2};
        pg8::EpiBf16I8 E{(bf16_t*)(p.ws + WS_P), DM, (const float*)(p.ws + WS_SCL) + SCL_XN, (const float*)(p.ws + WS_SCL) + SCL_WQ + l * DM};
        pg8::gemm_phase<pg8::EpiBf16I8, pg8::StaticOrder, true, true, true>((PG8_LAS unsigned char*)lds, g, So, E);
#else
        pg8::Gemm g{(const bf16_t*)(p.ws + WS_XN), (const bf16_t*)(p.ws + WS_WQ) + (size_t)l * DM * DM, M, DM, DM};
        pg8::EpiBf16<0> E{(bf16_t*)(p.ws + WS_P), DM, nullptr, 0, 0, 1.f};
        pg8::gemm_phase<pg8::EpiBf16<0>, pg8::StaticOrder, true, true>((PG8_LAS unsigned char*)lds, g, So, E);
#endif
#if FUSE_ROUTE
        asm volatile("s_waitcnt vmcnt(0)" ::: "memory");
        __syncthreads();
        ph_route_fast<true>(p, l, lds);
#endif
#if GATHER_I8 && GATHER_4BIT
        if (TABLES_IN_GAPS && l == 0 && !dry) conv4_tables(p, 2 * NEXP, 4 * NEXP, (unsigned*)(p.ws + WS_CTL) + 6208, lds);
#endif
#else
        EpiBf16Store E{(bf16_t*)(p.ws + WS_P), DM};
        gemm_naive(lds, (const bf16_t*)(p.ws + WS_XN), (const bf16_t*)(p.ws + WS_WQ) + (size_t)l * DM * DM, last ? NLAT : MTOT, DM, DM, E);
#endif
    }
    if constexpr (S == 9) {
#if USE_FAST_ROUTE
        if (!FUSE_ROUTE) ph_route_fast<false>(p, l, lds);
#else
        ph_route_naive(p, l);
#endif
    }
    if constexpr (S == 10) ph_gather(p, l, dry);
}
__global__ void __launch_bounds__(NTHREADS) fwd_kernel(Params p) {
    extern __shared__ __attribute__((aligned(16))) unsigned char lds[];
    cg::grid_group grid = cg::this_grid();
    const int lo = p.ph_lo, hi = p.ph_hi;
    volatile LAS unsigned* stw = (volatile LAS unsigned*)((LAS unsigned char*)lds + (LDS_BYTES - 128));
    if (threadIdx.x < 2) stw[threadIdx.x] = 0u;
    __syncthreads();
    const XcdBarrier bar = xcd_barrier_post((unsigned*)(p.ws + WS_CTL + 32768), stw);
#define IN(k) (lo <= (k) && (k) < hi)
#define SEAM(k) do { if (IN(k) && IN((k) + 1)) { if ((k) == 0) grid.sync(); else xcd_barrier(bar); } } while (0)
#define STAGE(S, l) do { constexpr int k_ = 1 + 10 * (l) + (S) - 1; if (IN(k_)) { if constexpr ((REP_MASK >> k_) & 1) { run_stage<S>(p, l, lds, true); xcd_barrier(bar); } run_stage<S>(p, l, lds, false); } SEAM(k_); } while (0)
#define LAYER(l) do { if ((l) == 0) { STAGE(1, l); } STAGE(2, l); STAGE(3, l); STAGE(4, l); STAGE(5, l); STAGE(6, l); STAGE(7, l); STAGE(8, l); if (!FUSE_ROUTE) { STAGE(9, l); } STAGE(10, l); } while (0)
    if (IN(0)) { if constexpr (REP_MASK & 1) { ph_prologue(p, lds); grid.sync(); } ph_prologue(p, lds); }
    SEAM(0);
    LAYER(0);
    LAYER(1);
#undef IN
#undef SEAM
#undef STAGE
#undef LAYER
}

extern "C" void kernel_launch(void* const* d_in, const int* in_sizes, int n_in, void* d_out, int out_size, void* d_ws, size_t ws_size, hipStream_t stream) {
    static int grid_blocks = 0;
    if (grid_blocks == 0) {
        if (n_in != 23 || out_size != NLAT * DM || ws_size < WS_END) { fprintf(stderr, "kernel_launch: unexpected shapes n_in %d out %d ws %zu\n", n_in, out_size, ws_size); grid_blocks = -1; return; }
        if (hipFuncSetAttribute((const void*)fwd_kernel, hipFuncAttributeMaxDynamicSharedMemorySize, LDS_BYTES) != hipSuccess) { fprintf(stderr, "kernel_launch: hipFuncSetAttribute failed\n"); grid_blocks = -1; return; }
        int dev = 0, cus = 0, per_cu = 0;
        hipGetDevice(&dev);
        hipDeviceGetAttribute(&cus, hipDeviceAttributeMultiprocessorCount, dev);
        hipOccupancyMaxActiveBlocksPerMultiprocessor(&per_cu, (const void*)fwd_kernel, NTHREADS, LDS_BYTES);
        if (per_cu < 1 || cus < 1) { fprintf(stderr, "kernel_launch: occupancy query failed (%d per CU, %d CUs)\n", per_cu, cus); grid_blocks = -1; return; }
        grid_blocks = cus * per_cu;
    }
    if (grid_blocks < 0) return;
    Params p{};
    const float** pp = (const float**)&p;
    for (int i = 0; i < 23; ++i) pp[i] = (const float*)d_in[i];
    p.out = (float*)d_out; p.ws = (unsigned char*)d_ws;
    p.ph_lo = 0; p.ph_hi = NPHASE;
    hipMemsetAsync((char*)d_ws + WS_CTL, 0, 131072, stream);
    void* args[] = {&p};
    hipError_t e = hipLaunchCooperativeKernel((const void*)fwd_kernel, dim3(grid_blocks), dim3(NTHREADS), args, LDS_BYTES, stream);
    if (e != hipSuccess) fprintf(stderr, "cooperative launch failed: %s (grid %d)\n", hipGetErrorString(e), grid_blocks);
}
```

```cpp
#include <hip/hip_runtime.h>
#include <hip/hip_cooperative_groups.h>
#include <cstdio>
#include <cstdint>
namespace cg = cooperative_groups;

constexpr int DM = 2048, NB = 8, SEQ = 2048, NCTX = 256, DEPTH = 2;
constexpr int NLAT = NB * SEQ;
constexpr int NCT = NB * NCTX;
constexpr int MTOT = NLAT + NCT;
constexpr int INW = 3584;
constexpr int C_QA = 0, C_KA = 768, C_VA = 1024, C_QB = 1280, C_KB = 2048, C_VB = 2304, C_UC = 2560, C_VC = 3072;
constexpr int NEXP = 16384;
constexpr float EPS = 1e-6f;
constexpr float ATT_SCALE = 0.088388347648318440f;
constexpr int NTHREADS = 512, NWAVES = 8;

constexpr size_t MiB = 1u << 20;
constexpr size_t WS_CTL = 0;
constexpr size_t WS_MOD = 1 * MiB;
constexpr size_t WS_ROPE = 2 * MiB;
constexpr size_t WS_KEYS = 3 * MiB;
constexpr size_t WS_WSC = 4 * MiB;
constexpr size_t WS_USC = 5 * MiB;
constexpr size_t WS_VSC = 6 * MiB;
constexpr size_t WS_WIN = 8 * MiB;
constexpr size_t WS_WOUT = 36 * MiB;
constexpr size_t WS_WQ = 52 * MiB;
constexpr size_t WS_HC = 68 * MiB;
constexpr size_t WS_EID = 84 * MiB;
constexpr size_t WS_GATE = 93 * MiB;
constexpr size_t WS_XN = 104 * MiB;
constexpr size_t WS_HB = WS_XN;
constexpr size_t WS_Y = 176 * MiB;
constexpr size_t WS_P = 248 * MiB;
constexpr size_t WS_UT = 376 * MiB;
constexpr size_t WS_VT = 504 * MiB;
constexpr size_t WS_SCL = 102 * MiB;
constexpr size_t SCL_WIN = 0, SCL_WOUT = 2 * 3584, SCL_XN = SCL_WOUT + 2 * 2048, SCL_Y = SCL_XN + 18432, SCL_WQ = SCL_Y + 18432;
constexpr int NCM = 3584 + 2048 + 2048;
constexpr size_t WS_XN8 = 784 * MiB;
constexpr size_t CTL_COLMAX = 65536;
constexpr size_t WS_DUMMY = 640 * MiB;
constexpr size_t WS_END = 820 * MiB;

constexpr int LDS_BYTES = 147456;

typedef unsigned short bf16_t;
typedef float f32x4 __attribute__((ext_vector_type(4)));
typedef unsigned u32x4 __attribute__((ext_vector_type(4)));
typedef unsigned u32x2 __attribute__((ext_vector_type(2)));

struct Params {
    const float *x, *c, *ctx, *c_ctx, *w_ada, *b_ada, *norm1_g, *norm2_g, *w_in, *qn_a, *kn_a, *qn_b, *kn_b, *sink_b, *vn_c, *ws_c, *bs_c,
        *g_group, *w_out, *peer_wq, *peer_keys, *peer_u, *peer_v;
    float* out;
    unsigned char* ws;
    int ph_lo, ph_hi;
};

__device__ __forceinline__ float bf2f(unsigned v) { return __uint_as_float(v << 16); }
__device__ __forceinline__ float bflo(unsigned w) { return __uint_as_float(w << 16); }
__device__ __forceinline__ float bfhi(unsigned w) { return __uint_as_float(w & 0xffff0000u); }
__device__ __forceinline__ unsigned f2bf(float f) { unsigned u = __float_as_uint(f); return (u + 0x7fffu + ((u >> 16) & 1u)) >> 16; }
__device__ __forceinline__ unsigned pk2(float lo, float hi) { return f2bf(lo) | (f2bf(hi) << 16); }
__device__ __forceinline__ float wave_sum(float v) {
#pragma unroll
    for (int o = 32; o >= 1; o >>= 1) v += __shfl_xor(v, o);
    return v;
}
__device__ __forceinline__ float wave_max(float v) {
#pragma unroll
    for (int o = 32; o >= 1; o >>= 1) v = fmaxf(v, __shfl_xor(v, o));
    return v;
}
__device__ __forceinline__ float gelu_tanh(float x) {
    const float y = 0.7978845608028654f * (x + 0.044715f * x * x * x);
    const float t = 1.f - 2.f / (__expf(2.f * y) + 1.f);
    return 0.5f * x * (1.f + t);
}
__device__ __forceinline__ float silu(float x) { return x / (1.f + __expf(-x)); }
#define LDS_WAIT() asm volatile("s_waitcnt lgkmcnt(0)" ::: "memory")
#ifndef GATHER_I8
#define GATHER_I8 1
#endif
#ifndef GATHER_4BIT
#define GATHER_4BIT 1
#endif
constexpr int ROW4 = 1152;
#ifndef FUSE_ROUTE
#define FUSE_ROUTE 1
#endif
#ifndef GEMM_I8
#define GEMM_I8 1
#endif
#ifndef GEMM3_I8
#define GEMM3_I8 1
#endif
#ifndef H_BF16
#define H_BF16 1
#endif
#ifndef REP_MASK
#define REP_MASK 0
#endif

__device__ __forceinline__ void transpose_item(const float* W, int K, int N, bf16_t* WT, const float* gk, float* scr, int item, int lane) {
    const int nblk = N / 32, kb = item / nblk, nb = item % nblk, k0 = 64 * kb, n0 = 32 * nb;
#pragma unroll 8
    for (int i = 0; i < 32; ++i) {
        const int kk = 2 * i + (lane >> 5);
        float v = W[(size_t)(k0 + kk) * N + n0 + (lane & 31)];
        if (gk) v *= gk[k0 + kk];
        scr[kk * 33 + (lane & 31)] = v;
    }
    LDS_WAIT();
    const int c = lane & 7;
#pragma unroll
    for (int j = 0; j < 4; ++j) {
        const int n = (lane >> 3) + 8 * j;
        const float* s = scr + (8 * c) * 33 + n;
        u32x4 o;
        o.x = pk2(s[0 * 33], s[1 * 33]); o.y = pk2(s[2 * 33], s[3 * 33]); o.z = pk2(s[4 * 33], s[5 * 33]); o.w = pk2(s[6 * 33], s[7 * 33]);
        *(u32x4*)(WT + (size_t)(n0 + n) * K + k0 + 8 * c) = o;
    }
    LDS_WAIT();
}

__device__ __forceinline__ void colmax_item(const float* W, int N, const float* gk, unsigned* cmax, int item, int lane) {
    const int nblk = N / 32, kb = item / nblk, nb = item % nblk, k0 = 64 * kb, n0 = 32 * nb;
    f32x4 v[8];
#pragma unroll
    for (int i = 0; i < 8; ++i) v[i] = *(const f32x4*)(W + (size_t)(k0 + 8 * i + (lane >> 3)) * N + n0 + 4 * (lane & 7));
    float m0 = 0.f, m1 = 0.f, m2 = 0.f, m3 = 0.f;
#pragma unroll
    for (int i = 0; i < 8; ++i) {
        const float g = gk ? fabsf(gk[k0 + 8 * i + (lane >> 3)]) : 1.f;
        m0 = fmaxf(m0, fabsf(v[i].x) * g); m1 = fmaxf(m1, fabsf(v[i].y) * g); m2 = fmaxf(m2, fabsf(v[i].z) * g); m3 = fmaxf(m3, fabsf(v[i].w) * g);
    }
#pragma unroll
    for (int o = 8; o <= 32; o <<= 1) { m0 = fmaxf(m0, __shfl_xor(m0, o)); m1 = fmaxf(m1, __shfl_xor(m1, o)); m2 = fmaxf(m2, __shfl_xor(m2, o)); m3 = fmaxf(m3, __shfl_xor(m3, o)); }
    if (lane < 8) {
        unsigned* c = cmax + n0 + 4 * lane;
        atomicMax(c + 0, __float_as_uint(m0)); atomicMax(c + 1, __float_as_uint(m1)); atomicMax(c + 2, __float_as_uint(m2)); atomicMax(c + 3, __float_as_uint(m3));
    }
}
__device__ __forceinline__ void transpose_item_i8(const float* W, int K, int N, unsigned char* W8, const float* gk, const unsigned* cmax, float* scr, int item, int lane) {
    const int nblk = N / 32, kb = item / nblk, nb = item % nblk, k0 = 64 * kb, n0 = 32 * nb;
    f32x4 v[8];
#pragma unroll
    for (int i = 0; i < 8; ++i) v[i] = *(const f32x4*)(W + (size_t)(k0 + 8 * i + (lane >> 3)) * N + n0 + 4 * (lane & 7));
    float inv[4];
#pragma unroll
    for (int c = 0; c < 4; ++c) { const float m = __uint_as_float(cmax[n0 + 4 * (lane & 7) + c]); inv[c] = m > 0.f ? 127.f / m : 0.f; }
#pragma unroll
    for (int i = 0; i < 8; ++i) {
        const int kk = 8 * i + (lane >> 3);
        const float g = gk ? gk[k0 + kk] : 1.f;
        float* d = scr + kk * 33 + 4 * (lane & 7);
        d[0] = rintf(v[i].x * g * inv[0]); d[1] = rintf(v[i].y * g * inv[1]); d[2] = rintf(v[i].z * g * inv[2]); d[3] = rintf(v[i].w * g * inv[3]);
    }
    LDS_WAIT();
    const int c = lane & 7;
#pragma unroll
    for (int j = 0; j < 4; ++j) {
        const int n = (lane >> 3) + 8 * j;
        const float* s = scr + (8 * c) * 33 + n;
        unsigned lo = 0u, hi = 0u;
#pragma unroll
        for (int i = 0; i < 4; ++i) { lo |= ((unsigned)(int)s[i * 33] & 0xffu) << (8 * i); hi |= ((unsigned)(int)s[(4 + i) * 33] & 0xffu) << (8 * i); }
        u32x2 o; o.x = lo; o.y = hi;
        *(u32x2*)(W8 + (size_t)(n0 + n) * K + k0 + 8 * c) = o;
    }
    LDS_WAIT();
}
__device__ __forceinline__ void ph_weights_i8(const Params& p, unsigned char* lds) {
    const int tid = threadIdx.x, lane = tid & 63, wave = tid >> 6;
    const int gw = blockIdx.x * NWAVES + wave, NGW = gridDim.x * NWAVES;
    float* scr = (float*)(lds + wave * 8704);
    const unsigned* cm = (const unsigned*)(p.ws + WS_CTL + CTL_COLMAX);
    constexpr int I_IN = 32 * 112, I_SQ = 32 * 64, I_L = I_IN + I_SQ + (GEMM3_I8 ? I_SQ : 0);
    for (int it = gw; it < 2 * I_L; it += NGW) {
        const int l = it / I_L; const int r = it % I_L;
        if (r < I_IN) transpose_item_i8(p.w_in + (size_t)l * DM * INW, DM, INW, (unsigned char*)(p.ws + WS_WIN) + (size_t)l * INW * DM, nullptr, cm + l * NCM, scr, r, lane);
        else if (r < I_IN + I_SQ) transpose_item_i8(p.w_out + (size_t)l * DM * DM, DM, DM, (unsigned char*)(p.ws + WS_WOUT) + (size_t)l * DM * DM, p.g_group + l * DM, cm + l * NCM + INW, scr, r - I_IN, lane);
        else transpose_item_i8(p.peer_wq + (size_t)l * DM * DM, DM, DM, (unsigned char*)(p.ws + WS_WQ) + (size_t)l * DM * DM, nullptr, cm + l * NCM + INW + DM, scr, r - I_IN - I_SQ, lane);
    }
    float* S = (float*)(p.ws + WS_SCL);
    for (int i = blockIdx.x * NTHREADS + tid; i < 2 * NCM; i += gridDim.x * NTHREADS) {
        const int l = i / NCM, n = i % NCM;
        const float m = __uint_as_float(cm[i]); const float s = m > 0.f ? m * (1.f / 127.f) : 1.f;
        if (n < INW) S[SCL_WIN + l * INW + n] = s; else if (n < INW + DM) S[SCL_WOUT + l * DM + (n - INW)] = s; else S[SCL_WQ + l * DM + (n - INW - DM)] = s;
    }
}
__device__ __forceinline__ void cvt_range(const float* src, bf16_t* dst, size_t n8, size_t gtid, size_t gthreads) {
    for (size_t i = gtid; i < n8; i += gthreads) {
        const f32x4 a = *(const f32x4*)(src + i * 8), b = *(const f32x4*)(src + i * 8 + 4);
        u32x4 o; o.x = pk2(a.x, a.y); o.y = pk2(a.z, a.w); o.z = pk2(b.x, b.y); o.w = pk2(b.z, b.w);
        *(u32x4*)(dst + i * 8) = o;
    }
}

#if GATHER_I8 && GATHER_4BIT
__device__ __forceinline__ void conv4_row(const f32x4 (&v)[8], const bool isv, unsigned char* drow, int lane) {
    float am = 0.f;
#pragma unroll
    for (int i = 0; i < 8; ++i) am = fmaxf(am, fmaxf(fmaxf(fabsf(v[i].x), fabsf(v[i].y)), fmaxf(fabsf(v[i].z), fabsf(v[i].w))));
    const float s0 = am > 0.f ? am * (isv ? (1.f / 6.f) : (1.f / 7.f)) : 1.f;
    const unsigned sb = (__float_as_uint(s0) + 0xffffu) >> 16;
    const float inv = 1.f / __uint_as_float(sb << 16);
    u32x4 o; unsigned w[4];
#pragma unroll
    for (int d = 0; d < 4; ++d) {
        const f32x4 a = v[2 * d], b = v[2 * d + 1];
        const float e[8] = {a.x * inv, a.y * inv, a.z * inv, a.w * inv, b.x * inv, b.y * inv, b.z * inv, b.w * inv};
        unsigned acc = 0u;
        if (isv) {
            acc = __builtin_amdgcn_cvt_scalef32_pk_fp4_f32(acc, e[0], e[1], 1.0f, 0);
            acc = __builtin_amdgcn_cvt_scalef32_pk_fp4_f32(acc, e[2], e[3], 1.0f, 1);
            acc = __builtin_amdgcn_cvt_scalef32_pk_fp4_f32(acc, e[4], e[5], 1.0f, 2);
            acc = __builtin_amdgcn_cvt_scalef32_pk_fp4_f32(acc, e[6], e[7], 1.0f, 3);
        } else {
#pragma unroll
            for (int i = 0; i < 8; ++i) {
                const int q = (int)fminf(fmaxf(rintf(e[i]), -7.f), 7.f);
                acc |= ((unsigned)q & 0xFu) << (8 * (i >> 1) + 4 * (i & 1));
            }
        }
        w[d] = acc;
    }
    o.x = w[0]; o.y = w[1]; o.z = w[2]; o.w = w[3];
    *(u32x4*)(drow + lane * 16) = o;
    *(unsigned short*)(drow + 1024 + lane * 2) = (unsigned short)sb;
}
#endif
#if GATHER_I8 && GATHER_4BIT
#ifndef TABLES_IN_GAPS
#define TABLES_IN_GAPS 1
#endif
__device__ __forceinline__ void conv4_tables(const Params& p, int r0, int r1, unsigned* ctr, unsigned char* lds) {
    const int tid = threadIdx.x, lane = tid & 63, wave = tid >> 6;
    unsigned char* ws = p.ws;
    volatile unsigned* shw = (volatile unsigned*)(lds + LDS_BYTES - 64);
    const int nchunk = (r1 - r0) / 64;
    for (int it = 0;; ++it) {
        int cbeg, cstep, cend;
        if (ctr) {
            __syncthreads();
            if (tid == 0) *shw = atomicAdd(ctr, 1u);
            __syncthreads();
            const int c = (int)*shw; if (c >= nchunk) break;
            cbeg = r0 + c * 64 + wave; cstep = NWAVES; cend = r0 + c * 64 + 64;
        } else {
            if (it > 0) break;
            cbeg = r0 + blockIdx.x * NWAVES + wave; cstep = gridDim.x * NWAVES; cend = r1;
        }
        for (int r = cbeg; r < cend; r += 2 * cstep) {
            const int r2 = r + cstep; const bool has2 = r2 < cend; const int rb = has2 ? r2 : r;
            const bool isvA = r >= 2 * NEXP, isvB = rb >= 2 * NEXP; const int rrA = isvA ? r - 2 * NEXP : r, rrB = isvB ? rb - 2 * NEXP : rb;
            const float* srowA = (isvA ? p.peer_v : p.peer_u) + (size_t)rrA * DM;
            const float* srowB = (isvB ? p.peer_v : p.peer_u) + (size_t)rrB * DM;
            f32x4 va[8], vb[8];
#pragma unroll
            for (int j = 0; j < 2; ++j)
#pragma unroll
                for (int k = 0; k < 4; ++k) { va[j * 4 + k] = *(const f32x4*)(srowA + j * 1024 + lane * 16 + k * 4); vb[j * 4 + k] = *(const f32x4*)(srowB + j * 1024 + lane * 16 + k * 4); }
            conv4_row(va, isvA, (unsigned char*)(ws + (isvA ? WS_VT : WS_UT)) + (size_t)rrA * ROW4, lane);
            if (has2) conv4_row(vb, isvB, (unsigned char*)(ws + (isvB ? WS_VT : WS_UT)) + (size_t)rrB * ROW4, lane);
        }
    }
}
#endif
__device__ __forceinline__ void ph_prologue(const Params& p, unsigned char* lds) {
    const int tid = threadIdx.x, lane = tid & 63, wave = tid >> 6;
    const int gw = blockIdx.x * NWAVES + wave, NGW = gridDim.x * NWAVES;
    unsigned char* ws = p.ws;
    {
        float* sT = (float*)lds;
        float* red = (float*)(lds + 2048 * 12 * 4);
        for (int i = tid; i < 2048 * 9; i += NTHREADS) {
            const int k = i / 9, bb = i % 9;
            const float v = bb < 8 ? p.c[bb * DM + k] : p.c_ctx[k];
            sT[k * 12 + bb] = silu(v);
        }
        __syncthreads();
        const int cq = lane & 7, ks = tid >> 3;
        for (int u = blockIdx.x; u < 768; u += gridDim.x) {
            const int l = u / 384, n0 = (u % 384) * 32;
            const float* W = p.w_ada + (size_t)l * DM * 12288 + n0 + cq * 4;
            float acc[9][4];
#pragma unroll
            for (int b = 0; b < 9; ++b)
#pragma unroll
                for (int j = 0; j < 4; ++j) acc[b][j] = 0.f;
#pragma unroll 8
            for (int i = 0; i < 32; ++i) {
                const int k = ks + 64 * i;
                const f32x4 w = *(const f32x4*)(W + (size_t)k * 12288);
                const f32x4 s0 = *(const f32x4*)(sT + k * 12), s1 = *(const f32x4*)(sT + k * 12 + 4);
                const float s8 = sT[k * 12 + 8];
                const float sv[9] = {s0.x, s0.y, s0.z, s0.w, s1.x, s1.y, s1.z, s1.w, s8};
#pragma unroll
                for (int b = 0; b < 9; ++b) { acc[b][0] += sv[b] * w.x; acc[b][1] += sv[b] * w.y; acc[b][2] += sv[b] * w.z; acc[b][3] += sv[b] * w.w; }
            }
#pragma unroll
            for (int b = 0; b < 9; ++b)
#pragma unroll
                for (int j = 0; j < 4; ++j) {
                    float v = acc[b][j];
                    v += __shfl_xor(v, 8); v += __shfl_xor(v, 16); v += __shfl_xor(v, 32);
                    acc[b][j] = v;
                }
            if (lane < 8) {
#pragma unroll
                for (int b = 0; b < 9; ++b)
#pragma unroll
                    for (int j = 0; j < 4; ++j) red[(wave * 8 + cq) * 36 + b * 4 + j] = acc[b][j];
            }
            __syncthreads();
            if (tid < 288) {
                const int b = tid / 32, col = tid % 32, q = col >> 2, j = col & 3;
                float s = 0.f;
#pragma unroll
                for (int w = 0; w < 8; ++w) s += red[(w * 8 + q) * 36 + b * 4 + j];
                const int n = n0 + col;
                ((float*)(ws + WS_MOD))[(size_t)(l * 9 + b) * 12288 + n] = s + p.b_ada[l * 12288 + n];
            }
            __syncthreads();
        }
    }
    __syncthreads();
    {
        float* scr = (float*)(lds + wave * 8704);
        constexpr int I_IN = 32 * 112, I_SQ = 32 * 64, I_L = I_IN + 2 * I_SQ;
        unsigned* cm = (unsigned*)(ws + WS_CTL + CTL_COLMAX);
        for (int it = gw; it < 2 * I_L; it += NGW) {
            const int l = it / I_L; int r = it % I_L;
            if (r < I_IN) {
                if (GEMM_I8) colmax_item(p.w_in + (size_t)l * DM * INW, INW, nullptr, cm + l * NCM, r, lane);
                else transpose_item(p.w_in + (size_t)l * DM * INW, DM, INW, (bf16_t*)(ws + WS_WIN) + (size_t)l * INW * DM, nullptr, scr, r, lane);
                continue; }
            r -= I_IN;
            if (r < I_SQ) {
                if (GEMM_I8) colmax_item(p.w_out + (size_t)l * DM * DM, DM, p.g_group + l * DM, cm + l * NCM + INW, r, lane);
                else transpose_item(p.w_out + (size_t)l * DM * DM, DM, DM, (bf16_t*)(ws + WS_WOUT) + (size_t)l * DM * DM, p.g_group + l * DM, scr, r, lane);
                continue; }
            r -= I_SQ;
            if (GEMM_I8 && GEMM3_I8) colmax_item(p.peer_wq + (size_t)l * DM * DM, DM, nullptr, cm + l * NCM + INW + DM, r, lane);
            else transpose_item(p.peer_wq + (size_t)l * DM * DM, DM, DM, (bf16_t*)(ws + WS_WQ) + (size_t)l * DM * DM, nullptr, scr, r, lane);
        }
    }
    {
        const size_t gtid = (size_t)blockIdx.x * NTHREADS + tid, gth = (size_t)gridDim.x * NTHREADS;
        cvt_range(p.peer_keys, (bf16_t*)(ws + WS_KEYS), (size_t)2 * 8 * 2 * 128 * 128 / 8, gtid, gth);
        cvt_range(p.ws_c, (bf16_t*)(ws + WS_WSC), (size_t)2 * 4 * 128 * 128 / 8, gtid, gth);
#if GATHER_I8 && GATHER_4BIT
        if (!TABLES_IN_GAPS) conv4_tables(p, 0, 4 * NEXP, nullptr, lds);
#elif GATHER_I8
        for (int r = gw; r < 4 * NEXP; r += NGW) {
            const bool isv = r >= 2 * NEXP; const int rr = isv ? r - 2 * NEXP : r;
            const float* srow = (isv ? p.peer_v : p.peer_u) + (size_t)rr * DM;
            f32x4 v[8]; float am = 0.f;
#pragma unroll
            for (int j = 0; j < 2; ++j)
#pragma unroll
                for (int k = 0; k < 4; ++k) {
                    v[j * 4 + k] = *(const f32x4*)(srow + j * 1024 + lane * 16 + k * 4);
                    am = fmaxf(am, fmaxf(fmaxf(fabsf(v[j * 4 + k].x), fabsf(v[j * 4 + k].y)), fmaxf(fabsf(v[j * 4 + k].z), fabsf(v[j * 4 + k].w))));
                }
            am = wave_max(am);
            const float s = am > 0.f ? am * (isv ? (1.f / 443.f) : (1.f / 127.f)) : 1.f, inv = 1.f / s;
            unsigned char* drow = (unsigned char*)(ws + (isv ? WS_VT : WS_UT)) + (size_t)rr * DM;
#pragma unroll
            for (int j = 0; j < 2; ++j) {
                u32x4 o; unsigned w[4];
#pragma unroll
                for (int k = 0; k < 4; ++k) {
                    const f32x4 a = v[j * 4 + k];
                    if (isv) {
                        int pk = __builtin_amdgcn_cvt_pk_fp8_f32(a.x * inv, a.y * inv, 0, false);
                        pk = __builtin_amdgcn_cvt_pk_fp8_f32(a.z * inv, a.w * inv, pk, true);
                        w[k] = (unsigned)pk;
                    } else {
                        const int q0 = (int)rintf(a.x * inv), q1 = (int)rintf(a.y * inv), q2 = (int)rintf(a.z * inv), q3 = (int)rintf(a.w * inv);
                        w[k] = ((unsigned)q0 & 0xffu) | (((unsigned)q1 & 0xffu) << 8) | (((unsigned)q2 & 0xffu) << 16) | ((unsigned)q3 << 24);
                    }
                }
                o.x = w[0]; o.y = w[1]; o.z = w[2]; o.w = w[3];
                *(u32x4*)(drow + j * 1024 + lane * 16) = o;
            }
            if (lane == 0) ((float*)(ws + (isv ? WS_VSC : WS_USC)))[rr] = s;
        }
#else
        cvt_range(p.peer_u, (bf16_t*)(ws + WS_UT), (size_t)2 * NEXP * DM / 8, gtid, gth);
        cvt_range(p.peer_v, (bf16_t*)(ws + WS_VT), (size_t)2 * NEXP * DM / 8, gtid, gth);
#endif
        float* rope = (float*)(ws + WS_ROPE);
        for (size_t i = gtid; i < (size_t)2048 * 64; i += gth) {
            const int t = (int)(i >> 6), f = (int)(i & 63), fi = f & 31;
            const float pos = (f < 32) ? (float)(t >> 6) : (float)(t & 63);
            const float inv = powf(10000.0f, -(float)fi / 32.0f);
            const float ang = pos * inv;
            rope[i * 2] = cosf(ang); rope[i * 2 + 1] = sinf(ang);
        }
    }
}


__device__ __forceinline__ unsigned q8pack4(float a, float b, float c, float d, float inv) {
    const int q0 = (int)rintf(a * inv), q1 = (int)rintf(b * inv), q2 = (int)rintf(c * inv), q3 = (int)rintf(d * inv);
    return ((unsigned)q0 & 0xffu) | (((unsigned)q1 & 0xffu) << 8) | (((unsigned)q2 & 0xffu) << 16) | ((unsigned)q3 << 24);
}
__device__ __forceinline__ void modulate_store(const f32x4 (&v)[8], float rstd, const float* g, const float* shift, const float* scale, bf16_t* dst, int lane) {
#pragma unroll
    for (int j = 0; j < 8; ++j) {
        const int col = j * 256 + lane * 4;
        const f32x4 gg = *(const f32x4*)(g + col), sc = *(const f32x4*)(scale + col), sh = *(const f32x4*)(shift + col);
        const f32x4 o = v[j] * rstd * gg * (1.f + sc) + sh;
        u32x2 w; w.x = pk2(o.x, o.y); w.y = pk2(o.z, o.w);
        *(u32x2*)(dst + col) = w;
    }
}
__device__ __forceinline__ void modulate_store_i8(const f32x4 (&v)[8], float rstd, const float* g, const float* shift, const float* scale, unsigned char* dst, float* sdst, int lane, const float levels) {
    f32x4 o[8]; float am = 0.f;
#pragma unroll
    for (int j = 0; j < 8; ++j) {
        const int col = j * 256 + lane * 4;
        const f32x4 gg = *(const f32x4*)(g + col), sc = *(const f32x4*)(scale + col), sh = *(const f32x4*)(shift + col);
        o[j] = v[j] * rstd * gg * (1.f + sc) + sh;
        am = fmaxf(am, fmaxf(fmaxf(fabsf(o[j].x), fabsf(o[j].y)), fmaxf(fabsf(o[j].z), fabsf(o[j].w))));
    }
    am = wave_max(am);
    const float s = am > 0.f ? am / levels : 1.f, inv = 1.f / s;
#pragma unroll
    for (int j = 0; j < 8; ++j) *(unsigned*)(dst + j * 256 + lane * 4) = q8pack4(o[j].x, o[j].y, o[j].z, o[j].w, inv);
    if (lane == 0) *sdst = s;
}
__device__ __forceinline__ void ph_modulate(const Params& p, int l, int which) {
    const int tid = threadIdx.x, lane = tid & 63, wave = tid >> 6;
    const int gw = blockIdx.x * NWAVES + wave, NGW = gridDim.x * NWAVES;
    const int nrows = (which == 1 && l == DEPTH - 1) ? NLAT : MTOT;
    const float* g = (which == 0 ? p.norm1_g : p.norm2_g) + l * DM;
    const float* mod = (const float*)(p.ws + WS_MOD) + (size_t)l * 9 * 12288;
    const float* srcLat = (which == 0 && l == 0) ? p.x : p.out;
    const float* srcCtx = (which == 0 && l == 0) ? p.ctx : (const float*)(p.ws + WS_HC);
    bf16_t* XN = (bf16_t*)(p.ws + WS_XN);
    const int moff = (which == 0 ? 0 : 3) * DM;
#pragma unroll 1
    for (int r = gw; r < nrows; r += 2 * NGW) {
        const int r2 = r + NGW; const bool has2 = r2 < nrows; const int rb = has2 ? r2 : r;
        const float* srcA = r < NLAT ? srcLat + (size_t)r * DM : srcCtx + (size_t)(r - NLAT) * DM;
        const float* srcB = rb < NLAT ? srcLat + (size_t)rb * DM : srcCtx + (size_t)(rb - NLAT) * DM;
        f32x4 va[8], vb[8]; float sa = 0.f, sb = 0.f;
        if (H_BF16 && GEMM_I8 && GEMM3_I8 && which == 1) {
            const bf16_t* HB = (const bf16_t*)(p.ws + WS_HB);
#pragma unroll
            for (int j = 0; j < 8; ++j) {
                const u32x2 ra = *(const u32x2*)(HB + (size_t)r * DM + j * 256 + lane * 4), rb2 = *(const u32x2*)(HB + (size_t)rb * DM + j * 256 + lane * 4);
                va[j] = (f32x4){bflo(ra.x), bfhi(ra.x), bflo(ra.y), bfhi(ra.y)}; vb[j] = (f32x4){bflo(rb2.x), bfhi(rb2.x), bflo(rb2.y), bfhi(rb2.y)};
            }
        } else {
#pragma unroll
        for (int j = 0; j < 8; ++j) { va[j] = *(const f32x4*)(srcA + j * 256 + lane * 4); vb[j] = *(const f32x4*)(srcB + j * 256 + lane * 4); }
        }
#pragma unroll
        for (int j = 0; j < 8; ++j) { sa += va[j].x * va[j].x + va[j].y * va[j].y + va[j].z * va[j].z + va[j].w * va[j].w; sb += vb[j].x * vb[j].x + vb[j].y * vb[j].y + vb[j].z * vb[j].z + vb[j].w * vb[j].w; }
        sa = wave_sum(sa); sb = wave_sum(sb);
        const float* shA = mod + (size_t)(r < NLAT ? (r >> 11) : 8) * 12288 + moff;
        const bool i8 = GEMM_I8 && (which == 0 || GEMM3_I8); const float lv = which == 0 ? 127.f : 119.f;
        unsigned char* XN8 = (unsigned char*)(p.ws + WS_XN8); float* SXN = (float*)(p.ws + WS_SCL) + SCL_XN;
        if (i8) modulate_store_i8(va, rsqrtf(sa * (1.f / DM) + EPS), g, shA, shA + DM, XN8 + (size_t)r * DM, SXN + r, lane, lv);
        else modulate_store(va, rsqrtf(sa * (1.f / DM) + EPS), g, shA, shA + DM, XN + (size_t)r * DM, lane);
        if (has2) {
            const float* shB = mod + (size_t)(r2 < NLAT ? (r2 >> 11) : 8) * 12288 + moff;
            if (i8) modulate_store_i8(vb, rsqrtf(sb * (1.f / DM) + EPS), g, shB, shB + DM, XN8 + (size_t)r2 * DM, SXN + r2, lane, lv);
            else modulate_store(vb, rsqrtf(sb * (1.f / DM) + EPS), g, shB, shB + DM, XN + (size_t)r2 * DM, lane);
        }
    }
}

struct EpiBf16Store {
    bf16_t* O; int ldc;
    __device__ __forceinline__ void operator()(int row, int col, const float* a) const {
        u32x4 w; w.x = pk2(a[0], a[1]); w.y = pk2(a[2], a[3]); w.z = pk2(a[4], a[5]); w.w = pk2(a[6], a[7]);
        *(u32x4*)(O + (size_t)row * ldc + col) = w;
    }
};
struct EpiResGate {
    const float *resLat, *resCtx; float *outLat, *outCtx; const float* gate;
    __device__ __forceinline__ void operator()(int row, int col, const float* a) const {
        const int bb = row < NLAT ? (row >> 11) : 8;
        const float* gp = gate + (size_t)bb * 12288 + col;
        const float* rp = row < NLAT ? resLat + (size_t)row * DM + col : resCtx + (size_t)(row - NLAT) * DM + col;
        float* op = row < NLAT ? outLat + (size_t)row * DM + col : outCtx + (size_t)(row - NLAT) * DM + col;
        const f32x4 g0 = *(const f32x4*)gp, g1 = *(const f32x4*)(gp + 4), r0 = *(const f32x4*)rp, r1 = *(const f32x4*)(rp + 4);
        f32x4 o0, o1;
        o0.x = r0.x + g0.x * a[0]; o0.y = r0.y + g0.y * a[1]; o0.z = r0.z + g0.z * a[2]; o0.w = r0.w + g0.w * a[3];
        o1.x = r1.x + g1.x * a[4]; o1.y = r1.y + g1.y * a[5]; o1.z = r1.z + g1.z * a[6]; o1.w = r1.w + g1.w * a[7];
        *(f32x4*)op = o0; *(f32x4*)(op + 4) = o1;
    }
};
template <class Epi>
__device__ __forceinline__ void gemm_naive(unsigned char* lds, const bf16_t* A, const bf16_t* Bt, int M, int N, int K, const Epi& E) {
    float* As = (float*)lds;
    float* Bs = As + 32 * 132;
    const int tid = threadIdx.x, tx = tid & 15, ty = tid >> 4;
    const int lrow = tid >> 2, lkc = (tid & 3) * 8;
    const int nM = M / 128, nN = N / 128;
    for (int u = blockIdx.x; u < nM * nN; u += gridDim.x) {
        const int pm = u / nN, pn = u % nN, m0 = pm * 128, n0 = pn * 128;
        float acc[4][8];
#pragma unroll
        for (int i = 0; i < 4; ++i)
#pragma unroll
            for (int j = 0; j < 8; ++j) acc[i][j] = 0.f;
        for (int k0 = 0; k0 < K; k0 += 32) {
            const u32x4 av = *(const u32x4*)(A + (size_t)(m0 + lrow) * K + k0 + lkc);
            const u32x4 bv = *(const u32x4*)(Bt + (size_t)(n0 + lrow) * K + k0 + lkc);
            __syncthreads();
            As[(lkc + 0) * 132 + lrow] = bflo(av.x); As[(lkc + 1) * 132 + lrow] = bfhi(av.x);
            As[(lkc + 2) * 132 + lrow] = bflo(av.y); As[(lkc + 3) * 132 + lrow] = bfhi(av.y);
            As[(lkc + 4) * 132 + lrow] = bflo(av.z); As[(lkc + 5) * 132 + lrow] = bfhi(av.z);
            As[(lkc + 6) * 132 + lrow] = bflo(av.w); As[(lkc + 7) * 132 + lrow] = bfhi(av.w);
            Bs[(lkc + 0) * 132 + lrow] = bflo(bv.x); Bs[(lkc + 1) * 132 + lrow] = bfhi(bv.x);
            Bs[(lkc + 2) * 132 + lrow] = bflo(bv.y); Bs[(lkc + 3) * 132 + lrow] = bfhi(bv.y);
            Bs[(lkc + 4) * 132 + lrow] = bflo(bv.z); Bs[(lkc + 5) * 132 + lrow] = bfhi(bv.z);
            Bs[(lkc + 6) * 132 + lrow] = bflo(bv.w); Bs[(lkc + 7) * 132 + lrow] = bfhi(bv.w);
            __syncthreads();
#pragma unroll 8
            for (int k = 0; k < 32; ++k) {
                const f32x4 a = *(const f32x4*)(As + k * 132 + ty * 4);
                const f32x4 b0 = *(const f32x4*)(Bs + k * 132 + tx * 8), b1 = *(const f32x4*)(Bs + k * 132 + tx * 8 + 4);
                const float av4[4] = {a.x, a.y, a.z, a.w};
                const float bv8[8] = {b0.x, b0.y, b0.z, b0.w, b1.x, b1.y, b1.z, b1.w};
#pragma unroll
                for (int i = 0; i < 4; ++i)
#pragma unroll
                    for (int j = 0; j < 8; ++j) acc[i][j] += av4[i] * bv8[j];
            }
        }
#pragma unroll
        for (int i = 0; i < 4; ++i) E(m0 + ty * 4 + i, n0 + tx * 8, acc[i]);
    }
}

namespace pg8 {
#define PG8_LAS __attribute__((address_space(3)))
typedef unsigned short bf16_t;
typedef short bf16x8 __attribute__((ext_vector_type(8)));
typedef float f32x4 __attribute__((ext_vector_type(4)));
typedef unsigned u32x4 __attribute__((ext_vector_type(4)));
constexpr int BM = 256, BK = 64, HALF = 128, HTB = HALF * BK * 2  , STAGE_BYTES = 8 * HTB, NXCD = 8, WGM = 8;

__host__ __device__ __forceinline__ int lds_byte(int r, int c) { const int st = (r >> 4) * 2 + (c >> 5), rr = r & 15, cc = c & 31, ob = rr * 64 + cc * 2; return st * 1024 + (ob ^ (((ob >> 9) & 1) << 5)); }
__host__ __device__ __forceinline__ void stage_rc(int b, int& R, int& C) { const int st = b / 1024, sb = b % 1024, swz = sb ^ (((sb >> 9) & 1) << 5); R = (st >> 1) * 16 + swz / 64; C = (st & 1) * 32 + (swz % 64) / 2; }
__host__ __device__ __forceinline__ int perm32(int rho) { const int n = rho >> 4, i = rho & 15; return 8 * (i >> 2) + 4 * n + (i & 3); }

struct Unit { int pm, pn; };
struct Gemm { const bf16_t* A; const bf16_t* Bt; int M, N, K; };

struct StaticOrder {
    int nM, nN, nwg, G, c;
    __host__ __device__ void init(int M, int N, int G_, int c_) { nM = M / BM; nN = N / BM; nwg = nM * nN; G = G_; c = c_; }
    __host__ __device__ bool next(int i, Unit& u) const {
        const long L = (long)i * G + c; if (L >= nwg) return false;
        int wgid = (int)L; { const int q = nwg / NXCD, r = nwg % NXCD, xcd = wgid % NXCD, off = wgid / NXCD; wgid = (xcd < r ? xcd * (q + 1) : r * (q + 1) + (xcd - r) * q) + off; }
        const int nig = WGM * nN, gid = wgid / nig, fm = gid * WGM, gsz = (nM - fm) < WGM ? (nM - fm) : WGM;
        u.pm = fm + ((wgid % nig) % gsz); u.pn = (wgid % nig) / gsz; return true;
    }
    __device__ __forceinline__ void a_ready(const Unit&) const {}
    __device__ __forceinline__ void done(const Unit&) const {}
};

__device__ __forceinline__ unsigned cvt_pk_bf16(float lo, float hi) { unsigned r; asm volatile("v_cvt_pk_bf16_f32 %0, %1, %2" : "=v"(r) : "v"(lo), "v"(hi)); return r; }
typedef float f32x2 __attribute__((ext_vector_type(2)));
__device__ __forceinline__ f32x2 gelu_pk(f32x2 v) {
    const f32x2 av = __builtin_elementwise_abs(v), d = av * 0.2316418882f + 1.0f;
    f32x2 t; t.x = __builtin_amdgcn_rcpf(d.x); t.y = __builtin_amdgcn_rcpf(d.y);
    f32x2 q = t * 0.5307027145f + (-0.7265760135f); q = q * t + 0.7107068705f; q = q * t + (-0.142248368f); q = q * t + 0.127414796f; q = q * t;
    const f32x2 s = (v * v) * (-0.72134752044f);
    f32x2 e; e.x = __builtin_amdgcn_exp2f(s.x); e.y = __builtin_amdgcn_exp2f(s.y);
    const f32x2 m = v * (q * e), r = v - m;
    f32x2 o; o.x = v.x < 0.f ? m.x : r.x; o.y = v.y < 0.f ? m.y : r.y; return o;
}

template <int ACT  > struct EpiBf16 {
    static constexpr bool PERM = true, AFTER_DRAIN = false; static_assert(ACT == 0 || ACT == 1, "EpiBf16: ACT is 0 (none) or 1 (gelu_pk)");
    bf16_t* O; int ldc; const float* bias; int split_cols; size_t split_stride; float scale0;
    __device__ __forceinline__ void operator()(const f32x4 (&acc)[2][2][4][2], const Unit& u, int wr, int wc, int fr, int fq) const {
        const int row0 = u.pm * BM + wr * 64 + fr; int colt = u.pn * BM; bf16_t* base = O;
        float sc = 1.f; if (split_cols) { const int t = colt / split_cols; base += (size_t)t * split_stride; colt -= t * split_cols; if (t == 0) sc = scale0; }
        const int col0 = colt + wc * 32 + 8 * fq, bcol0 = u.pn * BM + wc * 32 + 8 * fq;
        f32x4 bv[2][2];
#pragma unroll
        for (int bj = 0; bj < 2; ++bj)
#pragma unroll
            for (int n = 0; n < 2; ++n) bv[bj][n] = bias ? *(const f32x4*)(bias + bcol0 + bj * HALF + 4 * n) : (f32x4){0.f, 0.f, 0.f, 0.f};
#pragma unroll
        for (int ai = 0; ai < 2; ++ai)
#pragma unroll
            for (int m = 0; m < 4; ++m) { bf16_t* rowp = base + (size_t)(row0 + ai * HALF + m * 16) * ldc + col0;
#pragma unroll
                for (int bj = 0; bj < 2; ++bj) { f32x4 v0 = acc[ai][bj][m][0] + bv[bj][0], v1 = acc[ai][bj][m][1] + bv[bj][1];
                    if (ACT == 1) { f32x2 a = gelu_pk((f32x2){v0[0], v0[1]}), b = gelu_pk((f32x2){v0[2], v0[3]}), c = gelu_pk((f32x2){v1[0], v1[1]}), d = gelu_pk((f32x2){v1[2], v1[3]});
                        v0 = (f32x4){a.x, a.y, b.x, b.y}; v1 = (f32x4){c.x, c.y, d.x, d.y}; }
                    v0 = v0 * sc; v1 = v1 * sc; u32x4 w; w.x = cvt_pk_bf16(v0[0], v0[1]); w.y = cvt_pk_bf16(v0[2], v0[3]); w.z = cvt_pk_bf16(v1[0], v1[1]); w.w = cvt_pk_bf16(v1[2], v1[3]);
                    *(u32x4*)(rowp + bj * HALF) = w; } }
    }
};
typedef int i32x4 __attribute__((ext_vector_type(4)));
template <bool I8> struct AccSel { typedef f32x4 type; };
template <> struct AccSel<true> { typedef i32x4 type; };
template <class Epi, class Sched, bool ALIGN_EPI = false, bool SP2 = false, bool I8 = false>
__device__ __forceinline__ void gemm_phase(PG8_LAS unsigned char* lds, const Gemm g, const Sched& S, const Epi& E) {
    const int tid = threadIdx.x, wid = __builtin_amdgcn_readfirstlane(tid >> 6), lane = tid & 63, wr = wid >> 2, wc = wid & 3, fr = lane & 15, fq = lane >> 4;
    const int K = g.K, nt = K / BK;
    unsigned voffA[2], voffB[2];
#pragma unroll
    for (int i = 0; i < 2; ++i) { int R, C; stage_rc(tid * 16 + i * 8192, R, C); const int Rb = Epi::PERM ? ((R & ~31) + perm32(R & 31)) : R;
        voffA[i] = (unsigned)(R * K + C) * 2u; voffB[i] = (unsigned)(Rb * K + C) * 2u; }
    const size_t kstep = (size_t)(BK * 2);
    const size_t hstep = (size_t)HALF * K * 2;
    const size_t tstep = 2 * hstep;
    const unsigned ldsw = (unsigned)wid * 1024u;
    const int aoff = lds_byte(wr * 64 + fr, fq * 8), boff = lds_byte(wc * 32 + fr, fq * 8);
#define PG8_SA(b, h) (((b) * 2 + (h)) * HTB)
#define PG8_SB(b, h) ((4 + (b) * 2 + (h)) * HTB)
#define PG8_STAGE(bufoff, gbase, voff) do { _Pragma("unroll") for (int _i = 0; _i < 2; ++_i) \
        __builtin_amdgcn_global_load_lds((const unsigned*)((const char*)(gbase) + (voff)[_i]), (PG8_LAS unsigned*)(lds + (bufoff) + ldsw + _i * 8192), 16, 0, 0); } while (0)
#define PG8_LDA(dst, b, h) do { _Pragma("unroll") for (int m = 0; m < 4; ++m) _Pragma("unroll") for (int k = 0; k < 2; ++k) dst[m][k] = *(const PG8_LAS bf16x8*)(lds + PG8_SA(b, h) + aoff + m * 2048 + k * 1024); } while (0)
#define PG8_LDB(dst, b, h) do { _Pragma("unroll") for (int n = 0; n < 2; ++n) _Pragma("unroll") for (int k = 0; k < 2; ++k) dst[n][k] = *(const PG8_LAS bf16x8*)(lds + PG8_SB(b, h) + boff + n * 2048 + k * 1024); } while (0)
#define PG8_MMA(ai, bj, At, Bt) do { __builtin_amdgcn_s_setprio(1); _Pragma("unroll") for (int m = 0; m < 4; ++m) _Pragma("unroll") for (int n = 0; n < 2; ++n) _Pragma("unroll") for (int k = 0; k < 2; ++k) \
        { if constexpr (I8) acc[ai][bj][m][n] = __builtin_amdgcn_mfma_i32_16x16x64_i8(__builtin_bit_cast(i32x4, Bt[n][k]), __builtin_bit_cast(i32x4, At[m][k]), acc[ai][bj][m][n], 0, 0, 0); \
          else acc[ai][bj][m][n] = __builtin_amdgcn_mfma_f32_16x16x32_bf16(Bt[n][k], At[m][k], acc[ai][bj][m][n], 0, 0, 0); } __builtin_amdgcn_s_setprio(0); } while (0)
#define PG8_WAIT_V(n) asm volatile("s_waitcnt vmcnt(" #n ")" ::: "memory")
#define PG8_WAIT_L(n) asm volatile("s_waitcnt lgkmcnt(" #n ")" ::: "memory")
#define PG8_BAR __builtin_amdgcn_s_barrier()
#define PG8_SCHED __builtin_amdgcn_sched_barrier(0)
    Unit cur, nxt; int ui = 0;
    if (!S.next(0, cur)) return;
    typedef typename AccSel<I8>::type acc_t; const acc_t zero_ = {};
    acc_t acc[2][2][4][2];
#pragma unroll
    for (int a = 0; a < 2; ++a)
#pragma unroll
        for (int b = 0; b < 2; ++b)
#pragma unroll
            for (int m = 0; m < 4; ++m)
#pragma unroll
                for (int n = 0; n < 2; ++n) acc[a][b][m][n] = zero_;
    bf16x8 At[4][2], B0[2][2], B1[2][2];
    const char* cA = (const char*)g.A + (size_t)cur.pm * tstep; const char* cB = (const char*)g.Bt + (size_t)cur.pn * tstep;
    S.a_ready(cur);
    if constexpr (SP2) {
        PG8_STAGE(PG8_SB(0, 0), cB, voffB); PG8_STAGE(PG8_SB(0, 1), cB + hstep, voffB); PG8_STAGE(PG8_SA(0, 0), cA, voffA); PG8_STAGE(PG8_SA(0, 1), cA + hstep, voffA);
        if (wr == 1) PG8_BAR;
        PG8_WAIT_V(2); PG8_BAR;
        PG8_STAGE(PG8_SB(1, 0), cB + kstep, voffB); PG8_STAGE(PG8_SA(1, 0), cA + kstep, voffA); PG8_STAGE(PG8_SB(1, 1), cB + hstep + kstep, voffB);
        PG8_WAIT_V(6); PG8_BAR;
    } else {
        PG8_STAGE(PG8_SB(0, 0), cB, voffB); PG8_STAGE(PG8_SA(0, 0), cA, voffA); PG8_STAGE(PG8_SB(0, 1), cB + hstep, voffB); PG8_STAGE(PG8_SA(0, 1), cA + hstep, voffA);
        if (wr == 1) PG8_BAR;
        PG8_WAIT_V(4); PG8_BAR;
        PG8_STAGE(PG8_SB(1, 0), cB + kstep, voffB); PG8_STAGE(PG8_SA(1, 0), cA + kstep, voffA); PG8_STAGE(PG8_SB(1, 1), cB + hstep + kstep, voffB);
        PG8_WAIT_V(6); PG8_BAR;
    }
    for (;;) {
        const bool has_next = S.next(ui + 1, nxt);
        const char* nA = has_next ? (const char*)g.A + (size_t)nxt.pm * tstep : cA; const char* nB = has_next ? (const char*)g.Bt + (size_t)nxt.pn * tstep : cB;
        for (int t = 0; t < nt; t += 2) {
            const bool last = (t == nt - 2);
            const char* a1 = cA + (size_t)(t + 1) * kstep;
            const char* a2 = last ? nA : cA + (size_t)(t + 2) * kstep; const char* b2 = last ? nB : cB + (size_t)(t + 2) * kstep;
            const char* a3 = a2 + kstep; const char* b3 = b2 + kstep;
            if (last && has_next) S.a_ready(nxt);
            if constexpr (SP2) {
            PG8_LDB(B0, 0, 0); PG8_LDB(B1, 0, 1); PG8_SCHED; PG8_LDA(At, 0, 0); PG8_STAGE(PG8_SA(1, 1), a1 + hstep, voffA);
            PG8_WAIT_V(8); PG8_WAIT_L(0); PG8_BAR; PG8_MMA(0, 0, At, B0); PG8_MMA(0, 1, At, B1); PG8_BAR; PG8_SCHED;
            PG8_LDA(At, 0, 1); PG8_STAGE(PG8_SB(0, 0), b2, voffB); PG8_STAGE(PG8_SB(0, 1), b2 + hstep, voffB); PG8_STAGE(PG8_SA(0, 0), a2, voffA);
            PG8_WAIT_V(8); PG8_WAIT_L(0); PG8_BAR; PG8_MMA(1, 0, At, B0); PG8_MMA(1, 1, At, B1); PG8_BAR; PG8_SCHED;
            PG8_LDB(B0, 1, 0); PG8_LDB(B1, 1, 1); PG8_SCHED; PG8_LDA(At, 1, 0); PG8_STAGE(PG8_SA(0, 1), a2 + hstep, voffA);
            PG8_WAIT_V(8); PG8_WAIT_L(0); PG8_BAR; PG8_MMA(0, 0, At, B0); PG8_MMA(0, 1, At, B1); PG8_BAR; PG8_SCHED;
            PG8_LDA(At, 1, 1); PG8_STAGE(PG8_SB(1, 0), b3, voffB); PG8_STAGE(PG8_SB(1, 1), b3 + hstep, voffB); PG8_STAGE(PG8_SA(1, 0), a3, voffA);
            PG8_WAIT_V(8); PG8_WAIT_L(0); PG8_BAR; PG8_MMA(1, 0, At, B0); PG8_MMA(1, 1, At, B1); PG8_BAR; PG8_SCHED;
            } else {
            PG8_LDB(B0, 0, 0); PG8_SCHED; PG8_LDA(At, 0, 0); PG8_STAGE(PG8_SA(1, 1), a1 + hstep, voffA);
            PG8_WAIT_L(8); PG8_BAR; PG8_WAIT_L(0); PG8_MMA(0, 0, At, B0); PG8_BAR; PG8_SCHED;
            PG8_LDB(B1, 0, 1); PG8_STAGE(PG8_SB(0, 0), b2, voffB);
            PG8_BAR; PG8_WAIT_L(0); PG8_MMA(0, 1, At, B1); PG8_BAR;
            PG8_LDA(At, 0, 1); PG8_STAGE(PG8_SA(0, 0), a2, voffA);
            PG8_BAR; PG8_WAIT_L(0); PG8_MMA(1, 0, At, B0); PG8_BAR; PG8_SCHED;
            PG8_STAGE(PG8_SB(0, 1), b2 + hstep, voffB);
            PG8_WAIT_V(6); PG8_BAR; PG8_MMA(1, 1, At, B1); PG8_BAR;
            PG8_LDB(B0, 1, 0); PG8_SCHED; PG8_LDA(At, 1, 0); PG8_STAGE(PG8_SA(0, 1), a2 + hstep, voffA);
            PG8_WAIT_L(8); PG8_BAR; PG8_WAIT_L(0); PG8_MMA(0, 0, At, B0); PG8_BAR; PG8_SCHED;
            PG8_LDB(B1, 1, 1); PG8_STAGE(PG8_SB(1, 0), b3, voffB);
            PG8_BAR; PG8_WAIT_L(0); PG8_MMA(0, 1, At, B1); PG8_BAR;
            PG8_LDA(At, 1, 1); PG8_STAGE(PG8_SA(1, 0), a3, voffA);
            PG8_BAR; PG8_WAIT_L(0); PG8_MMA(1, 0, At, B0); PG8_BAR; PG8_SCHED;
            PG8_STAGE(PG8_SB(1, 1), b3 + hstep, voffB);
            PG8_WAIT_V(6); PG8_BAR; PG8_MMA(1, 1, At, B1); PG8_BAR;
            }
        }
        if constexpr (ALIGN_EPI) { if (wr == 0) PG8_BAR; }
        if constexpr (!Epi::AFTER_DRAIN) { E(acc, cur, wr, wc, fr, fq); S.done(cur); }
        if (!has_next) break;
#pragma unroll
        for (int a = 0; a < 2; ++a)
#pragma unroll
            for (int b = 0; b < 2; ++b)
#pragma unroll
                for (int m = 0; m < 4; ++m)
#pragma unroll
                    for (int n = 0; n < 2; ++n) acc[a][b][m][n] = zero_;
        cur = nxt; cA = nA; cB = nB; ++ui;
        if constexpr (ALIGN_EPI) { if (wr == 1) PG8_BAR; }
    }
    PG8_WAIT_V(0);
    if constexpr (!ALIGN_EPI) { if (wr == 0) PG8_BAR; }
    PG8_BAR;
    if constexpr (Epi::AFTER_DRAIN) { E.fused(acc, cur, wr, wc, fr, fq, lds, wid, lane); S.done(cur); }
#undef PG8_SA
#undef PG8_SB
#undef PG8_STAGE
#undef PG8_LDA
#undef PG8_LDB
#undef PG8_MMA
#undef PG8_WAIT_V
#undef PG8_WAIT_L
#undef PG8_BAR
#undef PG8_SCHED
}

struct EpiResGateT {
    static constexpr bool PERM = false, AFTER_DRAIN = false;
    const float *resLat, *resCtx; float *outLat, *outCtx; const float* gate;
    __device__ __forceinline__ void operator()(const f32x4 (&acc)[2][2][4][2], const Unit& u, int wr, int wc, int fr, int fq) const {
        const int trow = u.pm * BM, row0 = trow + wr * 64 + fr, col0 = u.pn * BM + wc * 32 + 4 * fq;
        const bool lat = trow < 16384;
        const int bb = lat ? (trow >> 11) : 8;
        const float* rbase = lat ? resLat + (size_t)row0 * 2048 : resCtx + (size_t)(row0 - 16384) * 2048;
        float* obase = lat ? outLat + (size_t)row0 * 2048 : outCtx + (size_t)(row0 - 16384) * 2048;
        f32x4 gv[2][2];
#pragma unroll
        for (int bj = 0; bj < 2; ++bj)
#pragma unroll
            for (int n = 0; n < 2; ++n) gv[bj][n] = *(const f32x4*)(gate + (size_t)bb * 12288 + col0 + bj * HALF + n * 16);
#pragma unroll
        for (int ai = 0; ai < 2; ++ai)
#pragma unroll
            for (int m = 0; m < 4; ++m) {
                const size_t off = (size_t)(ai * HALF + m * 16) * 2048 + col0;
#pragma unroll
                for (int bj = 0; bj < 2; ++bj)
#pragma unroll
                    for (int n = 0; n < 2; ++n) {
                        const f32x4 r = *(const f32x4*)(rbase + off + bj * HALF + n * 16);
                        *(f32x4*)(obase + off + bj * HALF + n * 16) = r + gv[bj][n] * acc[ai][bj][m][n];
                    }
            }
    }
};

struct EpiBf16I8 {
    static constexpr bool PERM = true, AFTER_DRAIN = false;
    bf16_t* O; int ldc; const float* sa; const float* sb;
    __device__ __forceinline__ void operator()(const i32x4 (&acc)[2][2][4][2], const Unit& u, int wr, int wc, int fr, int fq) const {
        const int row0 = u.pm * BM + wr * 64 + fr, col0 = u.pn * BM + wc * 32 + 8 * fq;
        f32x4 sv[2][2];
#pragma unroll
        for (int bj = 0; bj < 2; ++bj)
#pragma unroll
            for (int n = 0; n < 2; ++n) sv[bj][n] = *(const f32x4*)(sb + col0 + bj * HALF + 4 * n);
#pragma unroll
        for (int ai = 0; ai < 2; ++ai)
#pragma unroll
            for (int m = 0; m < 4; ++m) {
                const int row = row0 + ai * HALF + m * 16; const float s = sa[row];
                bf16_t* rowp = O + (size_t)row * ldc + col0;
#pragma unroll
                for (int bj = 0; bj < 2; ++bj) {
                    const i32x4 a0 = acc[ai][bj][m][0], a1 = acc[ai][bj][m][1];
                    const f32x4 v0 = (f32x4){(float)a0.x, (float)a0.y, (float)a0.z, (float)a0.w} * s * sv[bj][0];
                    const f32x4 v1 = (f32x4){(float)a1.x, (float)a1.y, (float)a1.z, (float)a1.w} * s * sv[bj][1];
                    u32x4 w; w.x = cvt_pk_bf16(v0[0], v0[1]); w.y = cvt_pk_bf16(v0[2], v0[3]); w.z = cvt_pk_bf16(v1[0], v1[1]); w.w = cvt_pk_bf16(v1[2], v1[3]);
                    *(u32x4*)(rowp + bj * HALF) = w;
                }
            }
    }
};
struct EpiResGateI8 {
    static constexpr bool PERM = false, AFTER_DRAIN = false;
    const float *resLat, *resCtx; float *outLat, *outCtx; const float* gate; const float* sa; const float* sb;
    __device__ __forceinline__ void operator()(const i32x4 (&acc)[2][2][4][2], const Unit& u, int wr, int wc, int fr, int fq) const {
        const int trow = u.pm * BM, row0 = trow + wr * 64 + fr, col0 = u.pn * BM + wc * 32 + 4 * fq;
        const bool lat = trow < 16384;
        const int bb = lat ? (trow >> 11) : 8;
        const float* rbase = lat ? resLat + (size_t)row0 * 2048 : resCtx + (size_t)(row0 - 16384) * 2048;
        float* obase = lat ? outLat + (size_t)row0 * 2048 : outCtx + (size_t)(row0 - 16384) * 2048;
        f32x4 gv[2][2];
#pragma unroll
        for (int bj = 0; bj < 2; ++bj)
#pragma unroll
            for (int n = 0; n < 2; ++n) gv[bj][n] = *(const f32x4*)(gate + (size_t)bb * 12288 + col0 + bj * HALF + n * 16) * *(const f32x4*)(sb + col0 + bj * HALF + n * 16);
#pragma unroll
        for (int ai = 0; ai < 2; ++ai)
#pragma unroll
            for (int m = 0; m < 4; ++m) {
                const size_t off = (size_t)(ai * HALF + m * 16) * 2048 + col0;
                const float s = sa[row0 + ai * HALF + m * 16];
#pragma unroll
                for (int bj = 0; bj < 2; ++bj)
#pragma unroll
                    for (int n = 0; n < 2; ++n) {
                        const f32x4 r = *(const f32x4*)(rbase + off + bj * HALF + n * 16);
                        const i32x4 a = acc[ai][bj][m][n];
                        *(f32x4*)(obase + off + bj * HALF + n * 16) = r + gv[bj][n] * ((f32x4){(float)a.x, (float)a.y, (float)a.z, (float)a.w} * s);
                    }
            }
    }
};

struct EpiResGateI8B {
    static constexpr bool PERM = true, AFTER_DRAIN = false;
    const float *resLat, *resCtx;
    bf16_t* hb; const float* gate; const float* sa; const float* sb;
    __device__ __forceinline__ void operator()(const i32x4 (&acc)[2][2][4][2], const Unit& u, int wr, int wc, int fr, int fq) const {
        const int trow = u.pm * BM, row0 = trow + wr * 64 + fr, col0 = u.pn * BM + wc * 32 + 8 * fq;
        const bool lat = trow < 16384;
        const int bb = lat ? (trow >> 11) : 8;
        f32x4 gv[2][2];
#pragma unroll
        for (int bj = 0; bj < 2; ++bj)
#pragma unroll
            for (int n = 0; n < 2; ++n) gv[bj][n] = *(const f32x4*)(gate + (size_t)bb * 12288 + col0 + bj * HALF + 4 * n) * *(const f32x4*)(sb + col0 + bj * HALF + 4 * n);
#pragma unroll
        for (int ai = 0; ai < 2; ++ai)
#pragma unroll
            for (int m = 0; m < 4; ++m) {
                const int row = row0 + ai * HALF + m * 16; const float s = sa[row];
                bf16_t* hp = hb + (size_t)row * 2048 + col0;
#pragma unroll
                for (int bj = 0; bj < 2; ++bj) {
                    f32x4 r0, r1;
                    if (resLat) {
                        const float* rp = (lat ? resLat + (size_t)row * 2048 : resCtx + (size_t)(row - 16384) * 2048) + col0 + bj * HALF;
                        r0 = *(const f32x4*)rp; r1 = *(const f32x4*)(rp + 4);
                    } else {
                        const u32x4 q = *(const u32x4*)(hp + bj * HALF);
                        r0 = (f32x4){__uint_as_float(q.x << 16), __uint_as_float(q.x & 0xffff0000u), __uint_as_float(q.y << 16), __uint_as_float(q.y & 0xffff0000u)};
                        r1 = (f32x4){__uint_as_float(q.z << 16), __uint_as_float(q.z & 0xffff0000u), __uint_as_float(q.w << 16), __uint_as_float(q.w & 0xffff0000u)};
                    }
                    const i32x4 a0 = acc[ai][bj][m][0], a1 = acc[ai][bj][m][1];
                    const f32x4 v0 = r0 + (gv[bj][0] * s) * (f32x4){(float)a0.x, (float)a0.y, (float)a0.z, (float)a0.w};
                    const f32x4 v1 = r1 + (gv[bj][1] * s) * (f32x4){(float)a1.x, (float)a1.y, (float)a1.z, (float)a1.w};
                    u32x4 w; w.x = cvt_pk_bf16(v0[0], v0[1]); w.y = cvt_pk_bf16(v0[2], v0[3]); w.z = cvt_pk_bf16(v1[0], v1[1]); w.w = cvt_pk_bf16(v1[2], v1[3]);
                    *(u32x4*)(hp + bj * HALF) = w;
                }
            }
    }
};
}
#ifndef USE_PG8
#define USE_PG8 1
#endif

__device__ __forceinline__ float sum16(float v) { v += __shfl_xor(v, 1); v += __shfl_xor(v, 2); v += __shfl_xor(v, 4); v += __shfl_xor(v, 8); return v; }
__device__ __forceinline__ void ph_prep(const Params& p, int l, const bool dry) {
    const int tid = threadIdx.x, lane = tid & 63, wave = tid >> 6, sub = lane >> 4, li = lane & 15;
    const int gw = blockIdx.x * NWAVES + wave, NGW = gridDim.x * NWAVES;
    bf16_t* P = (bf16_t*)(p.ws + WS_P);
    const float* rope = (const float*)(p.ws + WS_ROPE);
    const bool last = (l == DEPTH - 1);
    const int f0 = (li >= 8 ? 32 : 0) + 8 * (li & 3);
    const float sg = (li & 4) ? 1.f : -1.f;
#pragma unroll 1
    for (int r = gw; r < MTOT; r += NGW) {
        bf16_t* row = P + (size_t)r * INW;
        bf16_t* wrow = dry ? (bf16_t*)(p.ws + WS_DUMMY) + (size_t)r * INW : row;
        const bool isctx = r >= NLAT;
        const int t = r & (SEQ - 1);
        float cs[8], sn[8];
        if (!isctx) {
            const f32x4* rp = (const f32x4*)(rope + ((size_t)t * 64 + f0) * 2);
            const f32x4 a = rp[0], b = rp[1], c = rp[2], d = rp[3];
            cs[0] = a.x; sn[0] = a.y; cs[1] = a.z; sn[1] = a.w; cs[2] = b.x; sn[2] = b.y; cs[3] = b.z; sn[3] = b.w;
            cs[4] = c.x; sn[4] = c.y; cs[5] = c.z; sn[5] = c.w; cs[6] = d.x; sn[6] = d.y; cs[7] = d.z; sn[7] = d.w;
        } else {
#pragma unroll
            for (int i = 0; i < 8; ++i) { cs[i] = 1.f; sn[i] = 0.f; }
        }
        u32x4 raw[7];
#pragma unroll
        for (int gI = 0; gI < 7; ++gI) raw[gI] = *(const u32x4*)(row + (gI * 4 + sub) * 128 + li * 8);
#pragma unroll
        for (int gI = 0; gI < 7; ++gI) {
            const int slot = gI * 4 + sub;
            const int kind = slot < 8 ? 0 : slot < 10 ? 1 : slot < 18 ? 0 : slot < 20 ? 1 : slot < 24 ? 2 : 3;
            const bool isq = slot < 6 || (slot >= 10 && slot < 16);
            float x[8];
            x[0] = bflo(raw[gI].x); x[1] = bfhi(raw[gI].x); x[2] = bflo(raw[gI].y); x[3] = bfhi(raw[gI].y);
            x[4] = bflo(raw[gI].z); x[5] = bfhi(raw[gI].z); x[6] = bflo(raw[gI].w); x[7] = bfhi(raw[gI].w);
            if (kind >= 2) {
#pragma unroll
                for (int i = 0; i < 8; ++i) x[i] = gelu_tanh(x[i]);
            }
            float ss = 0.f;
#pragma unroll
            for (int i = 0; i < 8; ++i) ss += x[i] * x[i];
            ss = sum16(ss);
            const float rstd = rsqrtf(ss * (1.f / 128.f) + EPS);
            const float* gain = slot < 6 ? p.qn_a + l * 128 : slot < 8 ? p.kn_a + l * 128 : slot < 16 ? p.qn_b + l * 128 : slot < 20 ? p.kn_b + l * 128 : p.vn_c + l * 512 + (slot - 24) * 128;
            if (kind == 0 || kind == 3) {
                const f32x4 g0 = *(const f32x4*)(gain + li * 8), g1 = *(const f32x4*)(gain + li * 8 + 4);
                x[0] *= rstd * g0.x; x[1] *= rstd * g0.y; x[2] *= rstd * g0.z; x[3] *= rstd * g0.w;
                x[4] *= rstd * g1.x; x[5] *= rstd * g1.y; x[6] *= rstd * g1.z; x[7] *= rstd * g1.w;
            }
            float px[8];
#pragma unroll
            for (int i = 0; i < 8; ++i) px[i] = __shfl_xor(x[i], 4);
            if (kind == 0) {
#pragma unroll
                for (int i = 0; i < 8; ++i) x[i] = x[i] * cs[i] + sg * px[i] * sn[i];
            }
            bool wr = kind != 1;
            if (isctx && last && (isq || kind >= 2)) wr = false;
            if (wr) { u32x4 o; o.x = pk2(x[0], x[1]); o.y = pk2(x[2], x[3]); o.z = pk2(x[4], x[5]); o.w = pk2(x[6], x[7]); *(u32x4*)(wrow + slot * 128 + li * 8) = o; }
        }
    }
}

__device__ __forceinline__ void attn_row_naive(const bf16_t* q, const bf16_t* kc, const bf16_t* vc, const bf16_t* kl, const bf16_t* vl, int j0, int j1,
                                               bool has_sink, float sink, bf16_t* o, int lane) {
    const unsigned qq = *(const unsigned*)(q + 2 * lane);
    const float q0 = bflo(qq), q1 = bfhi(qq);
    float m = -INFINITY, lsum = 0.f, o0 = 0.f, o1 = 0.f;
    const int ntot = NCTX + (j1 - j0);
    for (int j = 0; j < ntot; ++j) {
        const bf16_t* kp = j < NCTX ? kc + (size_t)j * INW : kl + (size_t)(j0 + j - NCTX) * INW;
        const bf16_t* vp = j < NCTX ? vc + (size_t)j * INW : vl + (size_t)(j0 + j - NCTX) * INW;
        const unsigned kk = *(const unsigned*)(kp + 2 * lane), vv = *(const unsigned*)(vp + 2 * lane);
        const float s = wave_sum(q0 * bflo(kk) + q1 * bfhi(kk)) * ATT_SCALE;
        const float mn = fmaxf(m, s);
        const float a = __expf(m - mn), pp = __expf(s - mn);
        lsum = lsum * a + pp; o0 = o0 * a + pp * bflo(vv); o1 = o1 * a + pp * bfhi(vv);
        m = mn;
    }
    if (has_sink) {
        const float mn = fmaxf(m, sink);
        const float a = __expf(m - mn);
        lsum = lsum * a + __expf(sink - mn); o0 *= a; o1 *= a;
    }
    const float inv = 1.f / lsum;
    *(unsigned*)(o + 2 * lane) = pk2(o0 * inv, o1 * inv);
}

__device__ __forceinline__ void ph_mixers_naive(const Params& p, int l, unsigned char* lds) {
    const int tid = threadIdx.x, lane = tid & 63, wave = tid >> 6;
    const int gw = blockIdx.x * NWAVES + wave, NGW = gridDim.x * NWAVES;
    const bf16_t* P = (const bf16_t*)(p.ws + WS_P);
    bf16_t* Y = (bf16_t*)(p.ws + WS_Y);
    const bool last = (l == DEPTH - 1);
    const int T_LA = NLAT * 6, T_LB = NLAT * 6, T_CA = last ? 0 : NCT * 6, T_CB = last ? 0 : NCT * 6;
    const int ntask = T_LA + T_LB + T_CA + T_CB;
    for (int tk = gw; tk < ntask; tk += NGW) {
        int r = tk;
        if (r < T_LA + T_LB) {
            const bool isB = r >= T_LA; if (isB) r -= T_LA;
            const int b = r / (6 * SEQ), h = (r / SEQ) % 6, t = r % SEQ, kv = h / 3;
            const size_t row = (size_t)b * SEQ + t, crow0 = (size_t)NLAT + (size_t)b * NCTX, lrow0 = (size_t)b * SEQ;
            const int cq = isB ? C_QB : C_QA, ck = isB ? C_KB : C_KA, cvv = isB ? C_VB : C_VA;
            int j0 = 0, j1 = SEQ;
            if (isB) { j0 = t - 128 < 0 ? 0 : t - 128; j1 = t + 129 > SEQ ? SEQ : t + 129; }
            attn_row_naive(P + row * INW + cq + h * 128, P + crow0 * INW + ck + kv * 128, P + crow0 * INW + cvv + kv * 128,
                           P + lrow0 * INW + ck + kv * 128, P + lrow0 * INW + cvv + kv * 128, j0, j1, isB, isB ? p.sink_b[l * 6 + h] : 0.f,
                           Y + row * DM + (isB ? 768 : 0) + h * 128, lane);
        } else {
            r -= T_LA + T_LB;
            const bool isB = r >= T_CA; if (isB) r -= T_CA;
            const int b = r / (6 * NCTX), h = (r / NCTX) % 6, t = r % NCTX, kv = h / 3;
            const size_t crow0 = (size_t)NLAT + (size_t)b * NCTX, row = crow0 + t;
            const int cq = isB ? C_QB : C_QA, ck = isB ? C_KB : C_KA, cvv = isB ? C_VB : C_VA;
            attn_row_naive(P + row * INW + cq + h * 128, P + crow0 * INW + ck + kv * 128, P + crow0 * INW + cvv + kv * 128,
                           P, P, 0, 0, isB, isB ? p.sink_b[l * 6 + h] : 0.f, Y + row * DM + (isB ? 768 : 0) + h * 128, lane);
        }
    }
    __syncthreads();
    float* Wl = (float*)lds;
    float* Vl = Wl + 128 * 128;
    const int nchunk = last ? NLAT / 128 : MTOT / 128;
    for (int u = blockIdx.x; u < nchunk * 4; u += gridDim.x) {
        const int ch = u >> 2, g = u & 3; const size_t row0 = (size_t)ch * 128;
        __syncthreads();
        for (int i = tid; i < 128 * 128; i += NTHREADS) {
            Wl[i] = p.ws_c[((size_t)l * 4 + g) * 16384 + i];
            const int q = i >> 7, c = i & 127;
            Vl[i] = bf2f(P[(row0 + q) * INW + C_VC + g * 128 + c]);
        }
        __syncthreads();
        const int c = tid & 127, pg = tid >> 7;
        for (int pp = pg * 32; pp < pg * 32 + 32; ++pp) {
            float s = 0.f;
#pragma unroll 8
            for (int q = 0; q < 128; ++q) s += Wl[pp * 128 + q] * Vl[q * 128 + c];
            s += p.bs_c[((size_t)l * 4 + g) * 128 + pp];
            const float uu = bf2f(P[(row0 + pp) * INW + C_UC + g * 128 + c]);
            Y[(row0 + pp) * DM + 1536 + g * 128 + c] = (bf16_t)f2bf(uu * s);
        }
    }
}


namespace att {
constexpr float SCALE = 0.088388347648318440f;
constexpr float THR = 8.f;
constexpr int D = 128, NW = 8, QBLK = 32, KVBLK = 64;
#ifndef ATT_SDEPTH
#define ATT_SDEPTH 2
#endif
constexpr int SDEPTH = ATT_SDEPTH;
constexpr int LDQ = INW, LDK = INW, LDO = DM;
constexpr size_t SHM_V = KVBLK * D * 2, SHM_K = KVBLK * D * 2, SHM_ATTN = 2 * SHM_V + 2 * SHM_K + NW * 64 * 4;
using bf16x8 = __attribute__((ext_vector_type(8))) short;
using s16x4  = __attribute__((ext_vector_type(4))) short;
using f32x16 = __attribute__((ext_vector_type(16))) float;
using f32x8  = __attribute__((ext_vector_type(8))) float;

#define KSWZ(row, colB) ((row) * 256 + ((colB) ^ (((row) & 7) << 4)))
#define SBAR() __builtin_amdgcn_sched_barrier(0)
__device__ __forceinline__ int crow(int r, int hi) { return (r & 3) + 8 * (r >> 2) + 4 * hi; }
__device__ __forceinline__ unsigned cvtpk(float lo, float hi) {
  unsigned r; asm volatile("v_cvt_pk_bf16_f32 %0, %1, %2" : "=v"(r) : "v"(lo), "v"(hi)); return r;
}

__device__ __forceinline__ void partialSM(f32x16& p0, f32x16& p1, float& m_reg, float& mn, float& alpha) {
  constexpr float C = SCALE * 1.4426950408889634f;
  float pmax = p0[0]; for (int r = 1; r < 16; ++r) pmax = fmaxf(pmax, p0[r]); for (int r = 0; r < 16; ++r) pmax = fmaxf(pmax, p1[r]);
  { auto rr = __builtin_amdgcn_permlane32_swap(__float_as_uint(pmax), __float_as_uint(pmax), false, false);
    pmax = fmaxf(__uint_as_float(rr[0]), __uint_as_float(rr[1])); }
  if (__builtin_expect(__all(pmax - m_reg <= THR / SCALE), 1)) { mn = m_reg; alpha = 1.f; }
  else { mn = fmaxf(m_reg, pmax); alpha = __builtin_amdgcn_exp2f((m_reg - mn) * C); m_reg = mn; }
  float mnC = -mn * C;
  for (int r = 0; r < 16; ++r) p0[r] = fmaf(p0[r], C, mnC); for (int r = 0; r < 16; ++r) p1[r] = fmaf(p1[r], C, mnC);
  for (int r = 0; r < 16; ++r) p0[r] = __builtin_amdgcn_exp2f(p0[r]);
}
__device__ __forceinline__ void finishSM(f32x16& p0, f32x16& p1, float alpha, float& l_reg, bf16x8& pa0, bf16x8& pa1, bf16x8& pa2, bf16x8& pa3) {
  for (int r = 0; r < 16; ++r) p1[r] = __builtin_amdgcn_exp2f(p1[r]);
  float ps = 0; for (int r = 0; r < 16; ++r) ps += p0[r]; for (int r = 0; r < 16; ++r) ps += p1[r];
  { auto rr = __builtin_amdgcn_permlane32_swap(__float_as_uint(ps), __float_as_uint(ps), false, false);
    ps = __uint_as_float(rr[0]) + __uint_as_float(rr[1]); }
  l_reg = l_reg * alpha + ps;
#define PK4(P, BASE, OUT) do { unsigned a0 = cvtpk(P[BASE + 0], P[BASE + 1]), a1 = cvtpk(P[BASE + 2], P[BASE + 3]);   \
    unsigned b0 = cvtpk(P[BASE + 4], P[BASE + 5]), b1 = cvtpk(P[BASE + 6], P[BASE + 7]);                              \
    auto r0 = __builtin_amdgcn_permlane32_swap(a0, b0, false, false); auto r1 = __builtin_amdgcn_permlane32_swap(a1, b1, false, false); \
    u32x4 w = {r0[0], r1[0], r0[1], r1[1]}; OUT = *reinterpret_cast<bf16x8*>(&w); } while (0)
  PK4(p0, 0, pa0); PK4(p0, 8, pa1); PK4(p1, 0, pa2); PK4(p1, 8, pa3);
#undef PK4
}
__device__ __forceinline__ void qkt(f32x16& p0, f32x16& p1, const bf16_t* Ks, const bf16x8* qr, int r32, int hi) {
  p0 = f32x16{}; p1 = f32x16{};
  for (int d0 = 0; d0 < 8; ++d0) { int cb = (d0 * 16 + hi * 8) * 2;
    bf16x8 b0 = *reinterpret_cast<const bf16x8*>((const char*)Ks + KSWZ(r32, cb));
    bf16x8 b1 = *reinterpret_cast<const bf16x8*>((const char*)Ks + KSWZ(32 + r32, cb));
    p0 = __builtin_amdgcn_mfma_f32_32x32x16_bf16(b0, qr[d0], p0, 0, 0, 0);
    p1 = __builtin_amdgcn_mfma_f32_32x32x16_bf16(b1, qr[d0], p1, 0, 0, 0); }
}
__device__ __forceinline__ int v_st(int k, int c) { const int kk = (k & ~0xC) | ((k & 4) << 1) | ((k & 8) >> 1); return ((kk >> 3) * 4 + (c >> 5)) * 512 + ((kk & 7) * 32 + (c & 31)) * 2; }
__device__ __forceinline__ int v_rd_base(int lane) { return ((lane & 3) << 3) | (((lane >> 2) & 3) << 6) | (((lane >> 4) & 1) << 5) | (((lane >> 5) & 1) << 8); }
constexpr int v_rd_off(int d0, int ks, int half) { return d0 * 512 + ks * 4096 + half * 2048; }
template <int OFF> __device__ __forceinline__ s16x4 tr_read(int vb) {
  s16x4 r; asm volatile("ds_read_b64_tr_b16 %0, %1 offset:%2" : "=&v"(r) : "v"(vb), "i"(OFF) : "memory"); return r;
}
template <int D0> __device__ __forceinline__ void pv_one(f32x16& od, int vb, bf16x8 pa0, bf16x8 pa1, bf16x8 pa2, bf16x8 pa3) {
  const s16x4 l0 = tr_read<v_rd_off(D0, 0, 0)>(vb), h0 = tr_read<v_rd_off(D0, 0, 1)>(vb), l1 = tr_read<v_rd_off(D0, 1, 0)>(vb), h1 = tr_read<v_rd_off(D0, 1, 1)>(vb);
  const s16x4 l2 = tr_read<v_rd_off(D0, 2, 0)>(vb), h2 = tr_read<v_rd_off(D0, 2, 1)>(vb), l3 = tr_read<v_rd_off(D0, 3, 0)>(vb), h3 = tr_read<v_rd_off(D0, 3, 1)>(vb);
  asm volatile("s_waitcnt lgkmcnt(0)" ::: "memory"); SBAR();
#define PK(L, H) (bf16x8){L[0], L[1], L[2], L[3], H[0], H[1], H[2], H[3]}
  od = __builtin_amdgcn_mfma_f32_32x32x16_bf16(pa0, PK(l0, h0), od, 0, 0, 0);
  od = __builtin_amdgcn_mfma_f32_32x32x16_bf16(pa1, PK(l1, h1), od, 0, 0, 0);
  od = __builtin_amdgcn_mfma_f32_32x32x16_bf16(pa2, PK(l2, h2), od, 0, 0, 0);
  od = __builtin_amdgcn_mfma_f32_32x32x16_bf16(pa3, PK(l3, h3), od, 0, 0, 0);
#undef PK
}
__device__ __forceinline__ void pv_d0(f32x16* o, int vb, bf16x8 pa0, bf16x8 pa1, bf16x8 pa2, bf16x8 pa3) {
  pv_one<0>(o[0], vb, pa0, pa1, pa2, pa3); pv_one<1>(o[1], vb, pa0, pa1, pa2, pa3); pv_one<2>(o[2], vb, pa0, pa1, pa2, pa3); pv_one<3>(o[3], vb, pa0, pa1, pa2, pa3);
}

__device__ __forceinline__ void attn_unit(const bool MASK, const bf16_t* __restrict__ Qb, const bf16_t* __restrict__ Kc, const bf16_t* __restrict__ Vc,
                                          const bf16_t* __restrict__ Kl, const bf16_t* __restrict__ Vl, int nlt, int qpos0, int kpos0,
                                          bool has_sink, float sink, bf16_t* __restrict__ Ob, char* lds) {
  int tid_ = threadIdx.x; asm volatile("" : "+v"(tid_));
  const int tid = tid_, wid = tid >> 6, lane = tid & 63, r32 = lane & 31, hi = lane >> 5;
  bf16_t* V_lds = (bf16_t*)lds; bf16_t* K_lds = (bf16_t*)(lds + 2 * SHM_V);
  float* ws = (float*)(lds + 2 * SHM_V + 2 * SHM_K) + wid * 64; float* li_l = ws; float* al_l = ws + 32;
  float m_reg = -1e30f, l_reg = 0; f32x16 o[4] = {}; bf16x8 qr[8];
  const bf16_t* Qw = Qb + (long)(wid * QBLK + r32) * LDQ + hi * 8;
#pragma unroll
  for (int d0 = 0; d0 < 8; ++d0) qr[d0] = *reinterpret_cast<const bf16x8*>(Qw + d0 * 16);
  const int sr = tid >> 4, sc = (tid & 15) * 8, vst0 = v_st(sr, sc), vst1 = v_st(32 + sr, sc);
  const int vb0 = (int)(uintptr_t)V_lds + v_rd_base(lane);
  struct { bf16x8 vs0, vs1, ks0, ks1; } sr_[SDEPTH];
  const int qpos = qpos0 + wid * QBLK + r32;
#define KVP(t, KP, VP) const bf16_t* KP = ((t) < 4 ? Kc + (long)(t) * KVBLK * LDK : Kl + (long)((t) - 4) * KVBLK * LDK); const bf16_t* VP = ((t) < 4 ? Vc + (long)(t) * KVBLK * LDK : Vl + (long)((t) - 4) * KVBLK * LDK)
#define SLOAD(i, t) do { KVP(t, kp_, vp_); sr_[i].vs0 = *reinterpret_cast<const bf16x8*>(&vp_[(long)sr * LDK + sc]); sr_[i].vs1 = *reinterpret_cast<const bf16x8*>(&vp_[(long)(32 + sr) * LDK + sc]); \
    sr_[i].ks0 = *reinterpret_cast<const bf16x8*>(&kp_[(long)sr * LDK + sc]); sr_[i].ks1 = *reinterpret_cast<const bf16x8*>(&kp_[(long)(32 + sr) * LDK + sc]); } while (0)
#define SWRITE(b, i) do { *(bf16x8*)((char*)V_lds + (b) * SHM_V + vst0) = sr_[i].vs0;          \
    *(bf16x8*)((char*)V_lds + (b) * SHM_V + vst1) = sr_[i].vs1; int kc = sc * 2;               \
    *(bf16x8*)((char*)K_lds + (b) * SHM_K + KSWZ(sr, kc)) = sr_[i].ks0;                       \
    *(bf16x8*)((char*)K_lds + (b) * SHM_K + KSWZ(32 + sr, kc)) = sr_[i].ks1; } while (0)
#define SWAIT() do { if constexpr (SDEPTH == 2) asm volatile("s_waitcnt vmcnt(4)" ::: "memory"); else asm volatile("s_waitcnt vmcnt(0)" ::: "memory"); } while (0)
#define RESC(a) do { if (__any((a) < 1.f)) { if (hi == 0) al_l[r32] = (a); asm volatile("s_waitcnt lgkmcnt(0)" ::: "memory"); \
    for (int d = 0; d < 4; ++d) for (int r = 0; r < 16; ++r) o[d][r] *= al_l[crow(r, hi)]; } } while (0)
#define WMASK(P0, P1, t) do { if (MASK && (t) >= 4) { const int kb_ = kpos0 + ((t) - 4) * KVBLK + 4 * hi - qpos; \
    _Pragma("unroll") for (int r = 0; r < 16; ++r) { const int dk = kb_ + (r & 3) + 8 * (r >> 2); \
      if (dk > 128 || dk < -128) P0[r] = -1e30f; if (dk + 32 > 128 || dk + 32 < -128) P1[r] = -1e30f; } } } while (0)
  f32x16 pA0, pA1, pB0, pB1; float mnA, mnB, alA, alB; bf16x8 pa0, pa1, pa2, pa3; const int NT = 4 + nlt;
  constexpr int SE = 0, SO = SDEPTH - 1;
  SLOAD(SE, 0); asm volatile("s_waitcnt vmcnt(0)" ::: "memory"); SWRITE(0, SE); __syncthreads();
  qkt(pA0, pA1, K_lds, qr, r32, hi); partialSM(pA0, pA1, m_reg, mnA, alA);
  SLOAD(SO, 1); if constexpr (SDEPTH == 2) { if (2 < NT) SLOAD(SE, 2); }
  SWAIT(); SWRITE(1, SO); __syncthreads();
  for (int j = 1; j + 1 < NT; j += 2) {
    SBAR(); qkt(pB0, pB1, (bf16_t*)((char*)K_lds + SHM_K), qr, r32, hi); WMASK(pB0, pB1, j);
    finishSM(pA0, pA1, alA, l_reg, pa0, pa1, pa2, pa3); SBAR();
    SLOAD(SO, j + SDEPTH); SBAR();
    pv_d0(o, vb0, pa0, pa1, pa2, pa3); partialSM(pB0, pB1, m_reg, mnB, alB);
    __syncthreads(); SWAIT(); SWRITE(0, SE);
    RESC(alB); __syncthreads();
    SBAR(); qkt(pA0, pA1, K_lds, qr, r32, hi); WMASK(pA0, pA1, j + 1);
    finishSM(pB0, pB1, alB, l_reg, pa0, pa1, pa2, pa3); SBAR();
    if (SDEPTH == 1 || j + 3 < NT) SLOAD(SE, j + 1 + SDEPTH); SBAR();
    pv_d0(o, vb0 + (int)SHM_V, pa0, pa1, pa2, pa3); partialSM(pA0, pA1, m_reg, mnA, alA);
    __syncthreads(); SWAIT(); SWRITE(1, SO);
    RESC(alA); __syncthreads();
  }
  SBAR(); qkt(pB0, pB1, (bf16_t*)((char*)K_lds + SHM_K), qr, r32, hi); WMASK(pB0, pB1, NT - 1);
  finishSM(pA0, pA1, alA, l_reg, pa0, pa1, pa2, pa3); SBAR();
  pv_d0(o, vb0, pa0, pa1, pa2, pa3); partialSM(pB0, pB1, m_reg, mnB, alB);
  __syncthreads(); RESC(alB);
  finishSM(pB0, pB1, alB, l_reg, pa0, pa1, pa2, pa3); SBAR();
  pv_d0(o, vb0 + (int)SHM_V, pa0, pa1, pa2, pa3);
  if (has_sink) l_reg += __builtin_amdgcn_exp2f(sink * 1.4426950408889634f - m_reg * (SCALE * 1.4426950408889634f));
  if (hi == 0) li_l[r32] = l_reg; asm volatile("s_waitcnt lgkmcnt(0)" ::: "memory");
  float rli[16];
#pragma unroll
  for (int r = 0; r < 16; ++r) rli[r] = __builtin_amdgcn_rcpf(li_l[crow(r, hi)]);
  bf16_t* Ow = Ob + (long)(wid * QBLK) * LDO;
#pragma unroll
  for (int r = 0; r < 16; ++r) { int orow = crow(r, hi);
#pragma unroll
    for (int d0 = 0; d0 < 4; ++d0) Ow[(long)orow * LDO + d0 * 32 + r32] = (bf16_t)f2bf(o[d0][r] * rli[r]); }
  __syncthreads();
#undef KVP
#undef SLOAD
#undef SWRITE
#undef SWAIT
#undef RESC
#undef WMASK
}
#undef KSWZ
#undef SBAR
}


__device__ __forceinline__ void cmlp_unit_naive(const Params& p, int l, int ch, int g, unsigned char* lds) {
    int tid_ = threadIdx.x; asm volatile("" : "+v"(tid_));
    const int tid = tid_;
    const bf16_t* P = (const bf16_t*)(p.ws + WS_P);
    bf16_t* Y = (bf16_t*)(p.ws + WS_Y);
    float* Wl = (float*)lds;
    float* Vl = Wl + 128 * 128;
    const size_t row0 = (size_t)ch * 128;
    __syncthreads();
    for (int i = tid; i < 128 * 128; i += NTHREADS) {
        Wl[i] = p.ws_c[((size_t)l * 4 + g) * 16384 + i];
        const int q = i >> 7, c = i & 127;
        Vl[i] = bf2f(P[(row0 + q) * INW + C_VC + g * 128 + c]);
    }
    __syncthreads();
    const int c = tid & 127, pg = tid >> 7;
    for (int pp = pg * 32; pp < pg * 32 + 32; ++pp) {
        float s = 0.f;
#pragma unroll 8
        for (int q = 0; q < 128; ++q) s += Wl[pp * 128 + q] * Vl[q * 128 + c];
        s += p.bs_c[((size_t)l * 4 + g) * 128 + pp];
        const float uu = bf2f(P[(row0 + pp) * INW + C_UC + g * 128 + c]);
        Y[(row0 + pp) * DM + 1536 + g * 128 + c] = (bf16_t)f2bf(uu * s);
    }
    __syncthreads();
}


__device__ __forceinline__ void cmlp_unit_fast(const Params& p, int l, int ch, int g, unsigned char* lds) {
    typedef short bf16x8 __attribute__((ext_vector_type(8)));
    typedef float f32x16 __attribute__((ext_vector_type(16)));
    int tid_ = threadIdx.x; asm volatile("" : "+v"(tid_));
    const int tid = tid_, lane = tid & 63, wave = tid >> 6, r32 = lane & 31, hh = lane >> 5;
    const bf16_t* P = (const bf16_t*)(p.ws + WS_P);
    bf16_t* Y = (bf16_t*)(p.ws + WS_Y);
    const bf16_t* W = (const bf16_t*)(p.ws + WS_WSC) + ((size_t)l * 4 + g) * 16384;
    bf16_t* VT = (bf16_t*)lds;
    const size_t row0 = (size_t)ch * 128;
    __syncthreads();
#pragma unroll
    for (int it = 0; it < 4; ++it) {
        const int q = it * 32 + (tid >> 4), c0 = (tid & 15) * 8;
        const u32x4 v = *(const u32x4*)(P + (row0 + q) * INW + C_VC + g * 128 + c0);
        const unsigned w[4] = {v.x, v.y, v.z, v.w};
#pragma unroll
        for (int i = 0; i < 4; ++i) { VT[(c0 + 2 * i) * 136 + q] = (bf16_t)(w[i] & 0xffffu); VT[(c0 + 2 * i + 1) * 136 + q] = (bf16_t)(w[i] >> 16); }
    }
    __syncthreads();
    const int cb = wave & 3, pb0 = (wave >> 2) * 2;
    f32x16 acc0 = {}, acc1 = {};
#pragma unroll
    for (int s = 0; s < 8; ++s) {
        const bf16x8 b = *(const bf16x8*)(VT + (cb * 32 + r32) * 136 + 16 * s + 8 * hh);
        const bf16x8 a0 = *(const bf16x8*)(W + (size_t)(pb0 * 32 + r32) * 128 + 16 * s + 8 * hh);
        const bf16x8 a1 = *(const bf16x8*)(W + (size_t)(pb0 * 32 + 32 + r32) * 128 + 16 * s + 8 * hh);
        acc0 = __builtin_amdgcn_mfma_f32_32x32x16_bf16(a0, b, acc0, 0, 0, 0);
        acc1 = __builtin_amdgcn_mfma_f32_32x32x16_bf16(a1, b, acc1, 0, 0, 0);
    }
    const int c = cb * 32 + r32;
    const float* bs = p.bs_c + ((size_t)l * 4 + g) * 128;
#pragma unroll
    for (int r = 0; r < 16; ++r) {
        const int pr = (r & 3) + 8 * (r >> 2) + 4 * hh;
        const int p0 = pb0 * 32 + pr, p1 = p0 + 32;
        const float u0 = bf2f(P[(row0 + p0) * INW + C_UC + g * 128 + c]), u1 = bf2f(P[(row0 + p1) * INW + C_UC + g * 128 + c]);
        Y[(row0 + p0) * DM + 1536 + g * 128 + c] = (bf16_t)f2bf(u0 * (acc0[r] + bs[p0]));
        Y[(row0 + p1) * DM + 1536 + g * 128 + c] = (bf16_t)f2bf(u1 * (acc1[r] + bs[p1]));
    }
}
#ifndef USE_FAST_CMLP
#define USE_FAST_CMLP 1
#endif

__device__ __forceinline__ void ph_mixers_fast(const Params& p, int l, unsigned char* lds, const bool dry) {
    const int tid = threadIdx.x;
    const bf16_t* P = (const bf16_t*)(p.ws + WS_P);
    bf16_t* Y = (bf16_t*)(p.ws + WS_Y);
    const bool last = (l == DEPTH - 1);
    const int b = blockIdx.x & 7;
    unsigned* ctr = (unsigned*)(p.ws + WS_CTL) + (dry ? 2048 : 0) + (l * 8 + b) * 64;
    volatile unsigned* shw = (volatile unsigned*)(lds + LDS_BYTES - 64);
    const int nAttn = last ? 96 : 108, nC = last ? 64 : 72, total = nAttn + nC;
    const size_t lrow0 = (size_t)b * SEQ, crow0 = (size_t)NLAT + (size_t)b * NCTX;
    for (;;) {
        __syncthreads();
        if (tid == 0) *shw = atomicAdd(ctr, 1u);
        __syncthreads();
        const int u = (int)*shw;
        if (u >= total) break;
        if (u < nAttn) {
            const bf16_t *Qb, *Kc, *Vc, *Kl, *Vl; bf16_t* Ob; int nlt = 0, qpos0 = 0, kpos0 = 0; bool mask = false, has_sink = false; int hsink = 0;
            if (u < 48) {
                const int h = u >> 3, qb = u & 7, kv = h / 3;
                Qb = P + (lrow0 + qb * 256) * INW + C_QA + h * 128; Kc = P + crow0 * INW + C_KA + kv * 128; Vc = P + crow0 * INW + C_VA + kv * 128;
                Kl = P + lrow0 * INW + C_KA + kv * 128; Vl = P + lrow0 * INW + C_VA + kv * 128; nlt = 32;
                Ob = Y + (lrow0 + qb * 256) * DM + h * 128;
            } else if (u < 96) {
                const int v = u - 48, h = v >> 3, qb = v & 7, kv = h / 3;
                const int kstart = qb == 0 ? 0 : qb * 256 - 128; nlt = (qb == 0 || qb == 7) ? 6 : 8;
                Qb = P + (lrow0 + qb * 256) * INW + C_QB + h * 128; Kc = P + crow0 * INW + C_KB + kv * 128; Vc = P + crow0 * INW + C_VB + kv * 128;
                Kl = P + (lrow0 + kstart) * INW + C_KB + kv * 128; Vl = P + (lrow0 + kstart) * INW + C_VB + kv * 128;
                qpos0 = qb * 256; kpos0 = kstart; mask = true; has_sink = true; hsink = h;
                Ob = Y + (lrow0 + qb * 256) * DM + 768 + h * 128;
            } else {
                const int v = u - 96; const bool isB = v >= 6; const int h = isB ? v - 6 : v, kv = h / 3;
                const int cq = isB ? C_QB : C_QA, ck = isB ? C_KB : C_KA, cv = isB ? C_VB : C_VA;
                Qb = P + crow0 * INW + cq + h * 128; Kc = P + crow0 * INW + ck + kv * 128; Vc = P + crow0 * INW + cv + kv * 128; Kl = Kc; Vl = Vc;
                has_sink = isB; hsink = h; Ob = Y + crow0 * DM + (isB ? 768 : 0) + h * 128;
            }
            att::attn_unit(mask, Qb, Kc, Vc, Kl, Vl, nlt, qpos0, kpos0, has_sink, has_sink ? p.sink_b[l * 6 + hsink] : 0.f, Ob, (char*)lds);
        } else {
            const int v = u - nAttn;
            const int ch = v < 64 ? b * 16 + (v >> 2) : 128 + b * 2 + ((v - 64) >> 2);
#if USE_FAST_CMLP
            cmlp_unit_fast(p, l, ch, v & 3, lds);
#else
            cmlp_unit_naive(p, l, ch, v & 3, lds);
#endif
        }
    }
}
#ifndef USE_FAST_ATT
#define USE_FAST_ATT 1
#endif

__device__ __forceinline__ void ynorm_row(bf16_t* yrow, const u32x4 (&v)[4], int lane, unsigned char* y8row, float* sdst) {
    float sq[4];
#pragma unroll
    for (int j = 0; j < 4; ++j) {
        const float a0 = bflo(v[j].x), a1 = bfhi(v[j].x), a2 = bflo(v[j].y), a3 = bfhi(v[j].y), a4 = bflo(v[j].z), a5 = bfhi(v[j].z), a6 = bflo(v[j].w), a7 = bfhi(v[j].w);
        sq[j] = a0 * a0 + a1 * a1 + a2 * a2 + a3 * a3 + a4 * a4 + a5 * a5 + a6 * a6 + a7 * a7;
    }
    const float sA = wave_sum(sq[0] + (lane < 32 ? sq[1] : 0.f));
    const float sB = wave_sum((lane >= 32 ? sq[1] : 0.f) + sq[2]);
    const float sC = wave_sum(sq[3]);
    const float rA = rsqrtf(sA * (1.f / 768.f) + EPS), rB = rsqrtf(sB * (1.f / 768.f) + EPS), rC = rsqrtf(sC * (1.f / 512.f) + EPS);
    if (GEMM_I8) {
        float x[4][8]; float am = 0.f;
#pragma unroll
        for (int j = 0; j < 4; ++j) {
            const float sc = (j == 0) ? rA : (j == 1) ? (lane < 32 ? rA : rB) : (j == 2) ? rB : rC;
            x[j][0] = bflo(v[j].x) * sc; x[j][1] = bfhi(v[j].x) * sc; x[j][2] = bflo(v[j].y) * sc; x[j][3] = bfhi(v[j].y) * sc;
            x[j][4] = bflo(v[j].z) * sc; x[j][5] = bfhi(v[j].z) * sc; x[j][6] = bflo(v[j].w) * sc; x[j][7] = bfhi(v[j].w) * sc;
#pragma unroll
            for (int i = 0; i < 8; ++i) am = fmaxf(am, fabsf(x[j][i]));
        }
        am = wave_max(am);
        const float s = am > 0.f ? am * (1.f / 127.f) : 1.f, inv = 1.f / s;
#pragma unroll
        for (int j = 0; j < 4; ++j) {
            u32x2 o; o.x = q8pack4(x[j][0], x[j][1], x[j][2], x[j][3], inv); o.y = q8pack4(x[j][4], x[j][5], x[j][6], x[j][7], inv);
            *(u32x2*)(y8row + j * 512 + lane * 8) = o;
        }
        if (lane == 0) *sdst = s;
        return;
    }
#pragma unroll
    for (int j = 0; j < 4; ++j) {
        const float sc = (j == 0) ? rA : (j == 1) ? (lane < 32 ? rA : rB) : (j == 2) ? rB : rC;
        u32x4 o;
        o.x = pk2(bflo(v[j].x) * sc, bfhi(v[j].x) * sc); o.y = pk2(bflo(v[j].y) * sc, bfhi(v[j].y) * sc);
        o.z = pk2(bflo(v[j].z) * sc, bfhi(v[j].z) * sc); o.w = pk2(bflo(v[j].w) * sc, bfhi(v[j].w) * sc);
        *(u32x4*)(yrow + j * 512 + lane * 8) = o;
    }
}
__device__ __forceinline__ void ph_ynorm(const Params& p, int l) {
    const int tid = threadIdx.x, lane = tid & 63, wave = tid >> 6;
    const int gw = blockIdx.x * NWAVES + wave, NGW = gridDim.x * NWAVES;
    bf16_t* Y = (bf16_t*)(p.ws + WS_Y);
    const int nrows = (l == DEPTH - 1) ? NLAT : MTOT;
#pragma unroll 1
    for (int r = gw; r < nrows; r += 2 * NGW) {
        const int r2 = r + NGW; const bool has2 = r2 < nrows; const int rb = has2 ? r2 : r;
        u32x4 va[4], vb[4];
#pragma unroll
        for (int j = 0; j < 4; ++j) { va[j] = *(const u32x4*)(Y + (size_t)r * DM + j * 512 + lane * 8); vb[j] = *(const u32x4*)(Y + (size_t)rb * DM + j * 512 + lane * 8); }
        unsigned char* Y8 = (unsigned char*)(p.ws + WS_XN8); float* SY = (float*)(p.ws + WS_SCL) + SCL_Y;
        ynorm_row(Y + (size_t)r * DM, va, lane, Y8 + (size_t)r * DM, SY + r);
        if (has2) ynorm_row(Y + (size_t)r2 * DM, vb, lane, Y8 + (size_t)r2 * DM, SY + r2);
    }
}

__device__ __forceinline__ void wave_argmax(float& bv, int& bi) {
#pragma unroll
    for (int o = 32; o >= 1; o >>= 1) {
        const float ov = __shfl_xor(bv, o); const int oi = __shfl_xor(bi, o);
        if (ov > bv || (ov == bv && oi < bi)) { bv = ov; bi = oi; }
    }
}
__device__ __forceinline__ void route_half(const bf16_t* qh, const bf16_t* kh, int lane, float& tv, int& ti) {
    const unsigned qq = *(const unsigned*)(qh + 2 * lane);
    const float qa = bflo(qq), qb = bfhi(qq);
    const bf16_t* k0 = kh + (size_t)lane * 128;
    const bf16_t* k1 = k0 + 64 * 128;
    float d0 = 0.f, d1 = 0.f;
#pragma unroll 2
    for (int cb = 0; cb < 16; ++cb) {
        const u32x4 a = *(const u32x4*)(k0 + cb * 8), b = *(const u32x4*)(k1 + cb * 8);
        const unsigned aw[4] = {a.x, a.y, a.z, a.w}, bw[4] = {b.x, b.y, b.z, b.w};
#pragma unroll
        for (int i = 0; i < 4; ++i) {
            const int src = cb * 4 + i;
            const float x0 = __shfl(qa, src), x1 = __shfl(qb, src);
            d0 += x0 * bflo(aw[i]) + x1 * bfhi(aw[i]);
            d1 += x0 * bflo(bw[i]) + x1 * bfhi(bw[i]);
        }
    }
    float va = d0, vb = d1; tv = 0.f; ti = 0;
#pragma unroll 1
    for (int r = 0; r < 16; ++r) {
        float bv; int bi;
        if (va >= vb) { bv = va; bi = lane; } else { bv = vb; bi = lane + 64; }
        wave_argmax(bv, bi);
        if (lane == r) { tv = bv; ti = bi; }
        if (bi == lane) va = -INFINITY; else if (bi == lane + 64) vb = -INFINITY;
    }
}
__device__ __forceinline__ void ph_route_naive(const Params& p, int l) {
    const int tid = threadIdx.x, lane = tid & 63, wave = tid >> 6;
    const int gw = blockIdx.x * NWAVES + wave, NGW = gridDim.x * NWAVES;
    const bf16_t* QP = (const bf16_t*)(p.ws + WS_P);
    const bf16_t* KEYS = (const bf16_t*)(p.ws + WS_KEYS) + (size_t)l * 8 * 2 * 128 * 128;
    int* EID = (int*)(p.ws + WS_EID); float* GATE = (float*)(p.ws + WS_GATE);
    const int nrows = (l == DEPTH - 1) ? NLAT : MTOT;
#pragma unroll 1
    for (int tk = gw; tk < nrows * 8; tk += NGW) {
        const int t = tk >> 3, h = tk & 7;
        const bf16_t* qrow = QP + (size_t)t * DM + h * 256;
        float tv0, tv1; int ti0, ti1;
        route_half(qrow, KEYS + (size_t)(h * 2 + 0) * 128 * 128, lane, tv0, ti0);
        route_half(qrow + 128, KEYS + (size_t)(h * 2 + 1) * 128 * 128, lane, tv1, ti1);
        const float v1 = __shfl(tv0, lane >> 2);
        float c0 = v1 + __shfl(tv1, (lane & 3) * 4 + 0), c1 = v1 + __shfl(tv1, (lane & 3) * 4 + 1);
        float c2 = v1 + __shfl(tv1, (lane & 3) * 4 + 2), c3 = v1 + __shfl(tv1, (lane & 3) * 4 + 3);
        float myv = 0.f; int myc = 0;
#pragma unroll 1
        for (int r = 0; r < 16; ++r) {
            float bv = c0; int bi = lane * 4;
            if (c1 > bv) { bv = c1; bi = lane * 4 + 1; }
            if (c2 > bv) { bv = c2; bi = lane * 4 + 2; }
            if (c3 > bv) { bv = c3; bi = lane * 4 + 3; }
            wave_argmax(bv, bi);
            if (lane == r) { myv = bv; myc = bi; }
            if ((bi >> 2) == lane) {
                const int u = bi & 3;
                if (u == 0) c0 = -INFINITY; else if (u == 1) c1 = -INFINITY; else if (u == 2) c2 = -INFINITY; else c3 = -INFINITY;
            }
        }
        float mx = lane < 16 ? myv : -INFINITY;
        mx = fmaxf(mx, __shfl_xor(mx, 8)); mx = fmaxf(mx, __shfl_xor(mx, 4)); mx = fmaxf(mx, __shfl_xor(mx, 2)); mx = fmaxf(mx, __shfl_xor(mx, 1));
        const float e = lane < 16 ? __expf(myv - mx) : 0.f;
        float sm = e; sm += __shfl_xor(sm, 8); sm += __shfl_xor(sm, 4); sm += __shfl_xor(sm, 2); sm += __shfl_xor(sm, 1);
        const int i1 = __shfl(ti0, myc >> 4), i2 = __shfl(ti1, myc & 15);
        if (lane < 16) { EID[(size_t)t * 128 + h * 16 + lane] = i1 * 128 + i2; GATE[(size_t)t * 128 + h * 16 + lane] = e / sm; }
    }
}


namespace rt {
typedef short bf16x8 __attribute__((ext_vector_type(8)));
typedef float f32x16 __attribute__((ext_vector_type(16)));
__device__ __forceinline__ void insert16(float (&t)[16], float x) {
#pragma unroll
    for (int j = 15; j >= 1; --j) t[j] = __builtin_amdgcn_fmed3f(t[j - 1], t[j], x);
    t[0] = fmaxf(t[0], x);
}
__device__ __forceinline__ void half_top16(const unsigned char* klds, const bf16_t* qrow, int r32, int hh, float (&t)[16]) {
    bf16x8 qf[8];
#pragma unroll
    for (int s = 0; s < 8; ++s) qf[s] = *(const bf16x8*)(qrow + 16 * s);
#pragma unroll
    for (int k = 0; k < 16; ++k) t[k] = -3.0e38f;
    const unsigned hh4 = (unsigned)hh << 2;
#pragma unroll
    for (int kb = 0; kb < 4; ++kb) {
        f32x16 acc = {};
        const int row = kb * 32 + r32;
#pragma unroll
        for (int s = 0; s < 8; ++s) {
            const bf16x8 a = *(const bf16x8*)(klds + row * 256 + ((32 * s + 16 * hh) ^ ((row & 7) << 4)));
            acc = __builtin_amdgcn_mfma_f32_32x32x16_bf16(a, qf[s], acc, 0, 0, 0);
        }
#pragma unroll
        for (int r = 0; r < 16; ++r) {
            const unsigned key = (unsigned)(kb * 32 + (r & 3) + 8 * (r >> 2)) | hh4;
            insert16(t, __uint_as_float((__float_as_uint(acc[r]) & ~127u) | key));
        }
    }
    float o[16];
#pragma unroll
    for (int k = 0; k < 16; ++k) o[k] = __shfl_xor(t[k], 32);
#pragma unroll
    for (int k = 0; k < 16; ++k) insert16(t, o[k]);
}
}
template <bool OWN_UNITS>
__device__ __forceinline__ void ph_route_fast(const Params& p, int l, unsigned char* lds) {
    int tid_ = threadIdx.x; asm volatile("" : "+v"(tid_));
    const int tid = tid_, lane = tid & 63, wave = tid >> 6, r32 = lane & 31, hh = lane >> 5;
    const bf16_t* QP = (const bf16_t*)(p.ws + WS_P);
    const bf16_t* KEYS = (const bf16_t*)(p.ws + WS_KEYS) + (size_t)l * 8 * 2 * 128 * 128;
    int* EID = (int*)(p.ws + WS_EID); float* GATE = (float*)(p.ws + WS_GATE);
    const int ntile = ((l == DEPTH - 1) ? NLAT : MTOT) / 256;
    unsigned* tab = (unsigned*)(lds + 65536) + wave * 2048;
    pg8::StaticOrder So; So.init(ntile * 256, DM, (int)gridDim.x, (int)blockIdx.x);
#pragma unroll 1
    for (int ui = 0;; ++ui) {
        int tile, h;
        if (OWN_UNITS) { pg8::Unit uu; if (!So.next(ui, uu)) break; tile = uu.pm; h = uu.pn; }
        else { const int u = blockIdx.x + ui * (int)gridDim.x; if (u >= ntile * 8) break; tile = u >> 3; h = u & 7; }
        __syncthreads();
        const u32x4* ksrc = (const u32x4*)(KEYS + (size_t)h * 2 * 128 * 128);
#pragma unroll
        for (int i = 0; i < 8; ++i) { const int c = tid + i * 512, row = c >> 4, cc = c & 15; *(u32x4*)(lds + row * 256 + ((cc * 16) ^ ((row & 7) << 4))) = ksrc[c]; }
        __syncthreads();
        const int tok = tile * 256 + wave * 32 + r32;
        const bf16_t* qrow = QP + (size_t)tok * DM + h * 256 + hh * 8;
        float v1[16], v2[16];
        rt::half_top16(lds, qrow, r32, hh, v1);
        rt::half_top16(lds + 32768, qrow + 128, r32, hh, v2);
        float c[16];
#pragma unroll
        for (int k = 0; k < 16; ++k) c[k] = -3.0e38f;
#pragma unroll
        for (int i = 0; i < 16; ++i)
#pragma unroll
            for (int j = 0; j < 16; ++j)
                if ((i + 1) * (j + 1) <= 16) rt::insert16(c, __uint_as_float((__float_as_uint(v1[i] + v2[j]) & ~255u) | (unsigned)(i * 16 + j)));
#pragma unroll
        for (int k = 0; k < 16; ++k) { tab[k * 64 + lane] = __float_as_uint(v1[k]); tab[(16 + k) * 64 + lane] = __float_as_uint(v2[k]); }
        LDS_WAIT();
        float e[16], sum = 0.f;
#pragma unroll
        for (int k = 0; k < 16; ++k) { e[k] = __expf(c[k] - c[0]); sum += e[k]; }
        const float inv = 1.f / sum;
        unsigned out[16];
#pragma unroll
        for (int k = 0; k < 16; ++k) {
            const unsigned code = __float_as_uint(c[k]) & 255u;
            const unsigned i1 = tab[(code >> 4) * 64 + lane] & 127u, i2 = tab[(16 + (code & 15u)) * 64 + lane] & 127u;
            out[k] = hh == 0 ? (i1 * 128u + i2) : __float_as_uint(e[k] * inv);
        }
        unsigned* dst = (hh == 0 ? (unsigned*)EID : (unsigned*)GATE) + (size_t)tok * 128 + h * 16;
#pragma unroll
        for (int k = 0; k < 4; ++k) { u32x4 w; w.x = out[4 * k]; w.y = out[4 * k + 1]; w.z = out[4 * k + 2]; w.w = out[4 * k + 3]; *(u32x4*)(dst + 4 * k) = w; }
        LDS_WAIT();
    }
}
#ifndef USE_FAST_ROUTE
#define USE_FAST_ROUTE 1
#endif


#if GATHER_I8
__device__ __forceinline__ float dpp_shr(float v, int n) {
    const int iv = __builtin_bit_cast(int, v); int r;
    switch (n) { case 1: r = __builtin_amdgcn_update_dpp(0, iv, 0x111, 0xf, 0xf, true); break; case 2: r = __builtin_amdgcn_update_dpp(0, iv, 0x112, 0xf, 0xf, true); break;
                 case 4: r = __builtin_amdgcn_update_dpp(0, iv, 0x114, 0xf, 0xf, true); break; default: r = __builtin_amdgcn_update_dpp(0, iv, 0x118, 0xf, 0xf, true); break; }
    return __builtin_bit_cast(float, r);
}
__device__ __forceinline__ float wave_total(float v) {
    v += dpp_shr(v, 1); v += dpp_shr(v, 2); v += dpp_shr(v, 4); v += dpp_shr(v, 8);
    v += __builtin_bit_cast(float, __builtin_amdgcn_update_dpp(0, __builtin_bit_cast(int, v), 0x142, 0xa, 0xf, false));
    v += __builtin_bit_cast(float, __builtin_amdgcn_update_dpp(0, __builtin_bit_cast(int, v), 0x143, 0xc, 0xf, false));
    return __uint_as_float(__builtin_amdgcn_readlane(__float_as_uint(v), 63));
}
#define UB0(w) ((float)((w) & 0xffu))
#define UB1(w) ((float)(((w) >> 8) & 0xffu))
#define UB2(w) ((float)(((w) >> 16) & 0xffu))
#define UB3(w) ((float)((w) >> 24))

__device__ __forceinline__ float dpp_xor1(float v) { return __builtin_bit_cast(float, __builtin_amdgcn_update_dpp(0, __builtin_bit_cast(int, v), 0xB1, 0xf, 0xf, false)); }
__device__ __forceinline__ float dpp_xor2(float v) { return __builtin_bit_cast(float, __builtin_amdgcn_update_dpp(0, __builtin_bit_cast(int, v), 0x4E, 0xf, 0xf, false)); }
__device__ __forceinline__ float dpp_xor8(float v) { return __builtin_bit_cast(float, __builtin_amdgcn_update_dpp(0, __builtin_bit_cast(int, v), 0x128, 0xf, 0xf, false)); }
__device__ __forceinline__ float reduce8_rows(const float (&d)[8], int lane) {
    const bool b0 = lane & 1, b1 = lane & 2, b2 = lane & 4;
    float r[4];
#pragma unroll
    for (int k = 0; k < 4; ++k) r[k] = (b0 ? d[2 * k + 1] : d[2 * k]) + dpp_xor1(b0 ? d[2 * k] : d[2 * k + 1]);
    float t[2];
#pragma unroll
    for (int k = 0; k < 2; ++k) t[k] = (b1 ? r[2 * k + 1] : r[2 * k]) + dpp_xor2(b1 ? r[2 * k] : r[2 * k + 1]);
    float u = (b2 ? t[1] : t[0]) + __shfl_xor(b2 ? t[0] : t[1], 4);
    u += dpp_xor8(u);
    u += __shfl_xor(u, 16);
    u += __shfl_xor(u, 32);
    return u;
}
#if GATHER_4BIT
#ifndef DRY_MODE
#define DRY_MODE 0
#endif
typedef float f32x2 __attribute__((ext_vector_type(2)));
__device__ __forceinline__ void ph_gather(const Params& p, int l, const bool dry) {
    const int tid = threadIdx.x, lane = tid & 63, wave = tid >> 6;
    const int gw = blockIdx.x * NWAVES + wave, NGW = gridDim.x * NWAVES;
    const bf16_t* XN = (const bf16_t*)(p.ws + WS_XN);
    const unsigned char* UT = (const unsigned char*)(p.ws + WS_UT) + (size_t)l * NEXP * ROW4;
    const unsigned char* VT = (const unsigned char*)(p.ws + WS_VT) + (size_t)l * NEXP * ROW4;
    const int* EID = (const int*)(p.ws + WS_EID); const float* GATE = (const float*)(p.ws + WS_GATE);
    const float* mod = (const float*)(p.ws + WS_MOD) + (size_t)l * 9 * 12288;
    const int nrows = (l == DEPTH - 1) ? NLAT : MTOT;
#pragma unroll 1
    for (int t = gw; t < nrows; t += NGW) {
        int xh[4], xl[4]; float sxl;
#if GEMM_I8 && GEMM3_I8
        {
            sxl = ((const float*)(p.ws + WS_SCL))[SCL_XN + t];
            const unsigned char* x8 = (const unsigned char*)(p.ws + WS_XN8) + (size_t)t * DM;
#pragma unroll
            for (int j = 0; j < 2; ++j) {
                const u32x4 q4 = *(const u32x4*)(x8 + j * 1024 + lane * 16);
                const unsigned ww[4] = {q4.x, q4.y, q4.z, q4.w};
#pragma unroll
                for (int dd = 0; dd < 2; ++dd) {
                    unsigned h = 0u, lo = 0u;
#pragma unroll
                    for (int k = 0; k < 8; ++k) {
                        const int q = (int)(signed char)((ww[dd * 2 + (k >> 2)] >> (8 * (k & 3))) & 0xffu);
                        const int ql = ((q + 8) & 15) - 8, qh = (q - ql) >> 4;
                        h |= ((unsigned)qh & 15u) << (4 * k); lo |= ((unsigned)ql & 15u) << (4 * k);
                    }
                    xh[j * 2 + dd] = (int)h; xl[j * 2 + dd] = (int)lo;
                }
            }
        }
#else
        {
            float x[32]; float am = 0.f;
#pragma unroll
            for (int j = 0; j < 2; ++j)
#pragma unroll
                for (int k = 0; k < 2; ++k) {
                    const u32x4 q = *(const u32x4*)(XN + (size_t)t * DM + j * 1024 + lane * 16 + k * 8);
                    float* xx = x + j * 16 + k * 8;
                    xx[0] = bflo(q.x); xx[1] = bfhi(q.x); xx[2] = bflo(q.y); xx[3] = bfhi(q.y); xx[4] = bflo(q.z); xx[5] = bfhi(q.z); xx[6] = bflo(q.w); xx[7] = bfhi(q.w);
                }
#pragma unroll
            for (int i = 0; i < 32; ++i) am = fmaxf(am, fabsf(x[i]));
            sxl = am > 0.f ? am * (1.f / 119.f) : 1.f;
            const float inv = 1.f / sxl;
#pragma unroll
            for (int d = 0; d < 4; ++d) {
                unsigned h = 0u, lo = 0u;
#pragma unroll
                for (int k = 0; k < 8; ++k) {
                    const int q = (int)rintf(x[8 * d + k] * inv);
                    const int ql = ((q + 8) & 15) - 8, qh = (q - ql) >> 4;
                    h |= ((unsigned)qh & 15u) << (4 * k); lo |= ((unsigned)ql & 15u) << (4 * k);
                }
                xh[d] = (int)h; xl[d] = (int)lo;
            }
        }
#endif
        const int e0 = EID[(size_t)t * 128 + lane], e1 = EID[(size_t)t * 128 + 64 + lane];
        const float g0 = GATE[(size_t)t * 128 + lane], g1 = GATE[(size_t)t * 128 + 64 + lane];
        float hid0 = 0.f, hid1 = 0.f;
        constexpr int GB = 8;
#define G_LOAD(W, S, TAB, EB) do { _Pragma("unroll") for (int i = 0; i < GB; ++i) { \
            const int id_ = __builtin_amdgcn_readlane((EB) < 64 ? e0 : e1, ((EB) + i) & 63); \
            const unsigned char* row_ = (TAB) + (size_t)id_ * ROW4; \
            W[i] = *(const u32x4*)(row_ + lane * 16); S[i] = *(const unsigned short*)(row_ + 1024 + lane * 2); } } while (0)
#define G_DOT(W, S, EB) do { float dd_[8]; _Pragma("unroll") for (int i = 0; i < GB; ++i) { int sh_ = 0, sl_ = 0; \
            const unsigned ww[4] = {W[i].x, W[i].y, W[i].z, W[i].w}; \
            _Pragma("unroll") for (int d = 0; d < 4; ++d) { \
                sh_ = __builtin_amdgcn_sdot8((int)ww[d], xh[d], sh_, false); \
                sl_ = __builtin_amdgcn_sdot8((int)ww[d], xl[d], sl_, false); } \
            dd_[i] = (float)((sh_ << 4) + sl_) * (sxl * bf2f(S[i])); } \
            const float tot = reduce8_rows(dd_, lane);              \
            if ((lane & 56) == ((EB) & 63)) { if ((EB) < 64) hid0 = tot; else hid1 = tot; } } while (0)
#define G_AXPY(W, S, EB) do { _Pragma("unroll") for (int i = 0; i < GB; ++i) { \
            const float m_ = __uint_as_float(__builtin_amdgcn_readlane(__float_as_uint((EB) < 64 ? cf0 : cf1), ((EB) + i) & 63)) * bf2f(S[i]); \
            const f32x2 mm = {m_, m_}; \
            const unsigned ww[4] = {W[i].x, W[i].y, W[i].z, W[i].w}; \
            _Pragma("unroll") for (int d = 0; d < 4; ++d) { \
                acc[4 * d + 0] += mm * __builtin_amdgcn_cvt_scalef32_pk_f32_fp4(ww[d], 1.0f, 0); \
                acc[4 * d + 1] += mm * __builtin_amdgcn_cvt_scalef32_pk_f32_fp4(ww[d], 1.0f, 1); \
                acc[4 * d + 2] += mm * __builtin_amdgcn_cvt_scalef32_pk_f32_fp4(ww[d], 1.0f, 2); \
                acc[4 * d + 3] += mm * __builtin_amdgcn_cvt_scalef32_pk_f32_fp4(ww[d], 1.0f, 3); } } } while (0)
        u32x4 wa[GB], wb[GB]; unsigned sa[GB], sb[GB];
        const bool do_u = !(dry && (DRY_MODE == 4 || DRY_MODE == 5)), do_v = !(dry && (DRY_MODE == 3 || DRY_MODE == 5));
        if (do_u) G_LOAD(wa, sa, UT, 0); else G_LOAD(wa, sa, VT, 0);
#pragma unroll 1
        for (int eb = 0; eb < (do_u ? 128 : 0); eb += 2 * GB) {
            G_LOAD(wb, sb, UT, eb + GB);
            G_DOT(wa, sa, eb);
            if (eb + 2 * GB < 128) G_LOAD(wa, sa, UT, eb + 2 * GB); else G_LOAD(wa, sa, VT, 0);
            G_DOT(wb, sb, eb + GB);
        }
        const float cf0 = gelu_tanh(hid0) * g0, cf1 = gelu_tanh(hid1) * g1;
        f32x2 acc[16];
#pragma unroll
        for (int i = 0; i < 16; ++i) acc[i] = (f32x2){0.f, 0.f};
#pragma unroll 1
        for (int eb = 0; eb < (do_v ? 128 : 0); eb += 2 * GB) {
            G_LOAD(wb, sb, VT, eb + GB);
            G_AXPY(wa, sa, eb);
            if (eb + 2 * GB < 128) G_LOAD(wa, sa, VT, eb + 2 * GB);
            G_AXPY(wb, sb, eb + GB);
        }
#undef G_LOAD
#undef G_DOT
#undef G_AXPY
        float hn[32];
        const int bb = t < NLAT ? (t >> 11) : 8;
        const float* gate = mod + (size_t)bb * 12288 + 5 * DM;
#if H_BF16 && GEMM_I8 && GEMM3_I8
        {
            bf16_t* hbrow = (bf16_t*)(p.ws + WS_HB) + (size_t)t * DM;
            const bool fin = (l == DEPTH - 1);
#pragma unroll
            for (int j = 0; j < 2; ++j) {
                const u32x4 q0 = *(const u32x4*)(hbrow + j * 1024 + lane * 16), q1 = *(const u32x4*)(hbrow + j * 1024 + lane * 16 + 8);
                const unsigned qq[8] = {q0.x, q0.y, q0.z, q0.w, q1.x, q1.y, q1.z, q1.w};
#pragma unroll
                for (int k = 0; k < 4; ++k) {
                    const f32x4 gv = *(const f32x4*)(gate + j * 1024 + lane * 16 + k * 4);
                    const f32x2 a0 = acc[j * 8 + k * 2], a1 = acc[j * 8 + k * 2 + 1];
                    hn[j * 16 + k * 4 + 0] = bflo(qq[2 * k]) + gv.x * a0.x; hn[j * 16 + k * 4 + 1] = bfhi(qq[2 * k]) + gv.y * a0.y;
                    hn[j * 16 + k * 4 + 2] = bflo(qq[2 * k + 1]) + gv.z * a1.x; hn[j * 16 + k * 4 + 3] = bfhi(qq[2 * k + 1]) + gv.w * a1.y;
                }
                if (fin) {
                    float* orow = (dry ? (float*)(p.ws + WS_DUMMY) + (size_t)(t & 16383) * DM : p.out + (size_t)t * DM) + j * 1024 + lane * 16;
#pragma unroll
                    for (int k = 0; k < 4; ++k) *(f32x4*)(orow + k * 4) = (f32x4){hn[j * 16 + k * 4], hn[j * 16 + k * 4 + 1], hn[j * 16 + k * 4 + 2], hn[j * 16 + k * 4 + 3]};
                } else {
                    bf16_t* orow = (dry ? (bf16_t*)(p.ws + WS_DUMMY) + (size_t)(t & 16383) * DM : hbrow) + j * 1024 + lane * 16;
                    u32x4 w0, w1;
                    w0.x = pk2(hn[j * 16 + 0], hn[j * 16 + 1]); w0.y = pk2(hn[j * 16 + 2], hn[j * 16 + 3]); w0.z = pk2(hn[j * 16 + 4], hn[j * 16 + 5]); w0.w = pk2(hn[j * 16 + 6], hn[j * 16 + 7]);
                    w1.x = pk2(hn[j * 16 + 8], hn[j * 16 + 9]); w1.y = pk2(hn[j * 16 + 10], hn[j * 16 + 11]); w1.z = pk2(hn[j * 16 + 12], hn[j * 16 + 13]); w1.w = pk2(hn[j * 16 + 14], hn[j * 16 + 15]);
                    *(u32x4*)orow = w0; *(u32x4*)(orow + 8) = w1;
                }
            }
        }
#else
        float* hrow = t < NLAT ? p.out + (size_t)t * DM : (float*)(p.ws + WS_HC) + (size_t)(t - NLAT) * DM;
#pragma unroll
        for (int j = 0; j < 2; ++j)
#pragma unroll
            for (int k = 0; k < 4; ++k) {
                const int col = j * 1024 + lane * 16 + k * 4;
                const f32x4 hv = *(const f32x4*)(hrow + col), gv = *(const f32x4*)(gate + col);
                const f32x2 a0 = acc[j * 8 + k * 2], a1 = acc[j * 8 + k * 2 + 1];
                f32x4 o;
                o.x = hv.x + gv.x * a0.x; o.y = hv.y + gv.y * a0.y; o.z = hv.z + gv.z * a1.x; o.w = hv.w + gv.w * a1.y;
                *(f32x4*)((dry ? (float*)(p.ws + WS_DUMMY) + (size_t)(t & 16383) * DM : hrow) + col) = o;
                hn[j * 16 + k * 4 + 0] = o.x; hn[j * 16 + k * 4 + 1] = o.y; hn[j * 16 + k * 4 + 2] = o.z; hn[j * 16 + k * 4 + 3] = o.w;
            }
#endif
        if (l + 1 < DEPTH) {
            float ss = 0.f;
#pragma unroll
            for (int i = 0; i < 32; ++i) ss += hn[i] * hn[i];
            const float rstd = rsqrtf(wave_total(ss) * (1.f / DM) + EPS);
            const float* g1n = p.norm1_g + (l + 1) * DM;
            const float* shift = mod + (size_t)9 * 12288 + (size_t)bb * 12288;
            const float* scale = shift + DM;
            if (GEMM_I8) {
                float am = 0.f;
#pragma unroll
                for (int j = 0; j < 2; ++j)
#pragma unroll
                    for (int i = 0; i < 16; ++i) { const int col = j * 1024 + lane * 16 + i; hn[j * 16 + i] = hn[j * 16 + i] * rstd * g1n[col] * (1.f + scale[col]) + shift[col]; am = fmaxf(am, fabsf(hn[j * 16 + i])); }
                am = wave_max(am);
                const float s8 = am > 0.f ? am * (1.f / 127.f) : 1.f, inv8 = 1.f / s8;
                unsigned char* xo8 = (dry ? (unsigned char*)(p.ws + WS_DUMMY) + (size_t)(t & 16383) * DM : (unsigned char*)(p.ws + WS_XN8) + (size_t)t * DM);
#pragma unroll
                for (int j = 0; j < 2; ++j) {
                    u32x4 w;
                    w.x = q8pack4(hn[j * 16 + 0], hn[j * 16 + 1], hn[j * 16 + 2], hn[j * 16 + 3], inv8); w.y = q8pack4(hn[j * 16 + 4], hn[j * 16 + 5], hn[j * 16 + 6], hn[j * 16 + 7], inv8);
                    w.z = q8pack4(hn[j * 16 + 8], hn[j * 16 + 9], hn[j * 16 + 10], hn[j * 16 + 11], inv8); w.w = q8pack4(hn[j * 16 + 12], hn[j * 16 + 13], hn[j * 16 + 14], hn[j * 16 + 15], inv8);
                    *(u32x4*)(xo8 + j * 1024 + lane * 16) = w;
                }
                if (lane == 0 && !dry) ((float*)(p.ws + WS_SCL))[SCL_XN + t] = s8;
            } else {
            bf16_t* xo = (dry ? (bf16_t*)(p.ws + WS_DUMMY) + (size_t)(t & 16383) * DM : (bf16_t*)(p.ws + WS_XN) + (size_t)t * DM);
#pragma unroll
            for (int j = 0; j < 2; ++j)
#pragma unroll
                for (int k = 0; k < 2; ++k) {
                    const int col = j * 1024 + lane * 16 + k * 8;
                    float xv[8];
#pragma unroll
                    for (int i = 0; i < 8; ++i) xv[i] = hn[j * 16 + k * 8 + i] * rstd * g1n[col + i] * (1.f + scale[col + i]) + shift[col + i];
                    u32x4 w; w.x = pk2(xv[0], xv[1]); w.y = pk2(xv[2], xv[3]); w.z = pk2(xv[4], xv[5]); w.w = pk2(xv[6], xv[7]);
                    *(u32x4*)(xo + col) = w;
                }
            }
        }
    }
}
#else
#ifndef DRY_MODE
#define DRY_MODE 0
#endif
typedef float f32x2 __attribute__((ext_vector_type(2)));
__device__ __forceinline__ void ph_gather(const Params& p, int l, const bool dry) {
    const int tid = threadIdx.x, lane = tid & 63, wave = tid >> 6;
    const int gw = blockIdx.x * NWAVES + wave, NGW = gridDim.x * NWAVES;
    const bf16_t* XN = (const bf16_t*)(p.ws + WS_XN);
    const unsigned char* UT = (const unsigned char*)(p.ws + WS_UT) + (size_t)l * NEXP * DM;
    const unsigned char* VT = (const unsigned char*)(p.ws + WS_VT) + (size_t)l * NEXP * DM;
    const float* USC = (const float*)(p.ws + WS_USC) + l * NEXP; const float* VSC = (const float*)(p.ws + WS_VSC) + l * NEXP;
    const int* EID = (const int*)(p.ws + WS_EID); const float* GATE = (const float*)(p.ws + WS_GATE);
    const float* mod = (const float*)(p.ws + WS_MOD) + (size_t)l * 9 * 12288;
    const int nrows = (l == DEPTH - 1) ? NLAT : MTOT;
#pragma unroll 1
    for (int t = gw; t < nrows; t += NGW) {
        int xq[8]; float sxl;
        {
            float x[32]; float am = 0.f;
#pragma unroll
            for (int j = 0; j < 2; ++j)
#pragma unroll
                for (int k = 0; k < 2; ++k) {
                    const u32x4 q = *(const u32x4*)(XN + (size_t)t * DM + j * 1024 + lane * 16 + k * 8);
                    float* xx = x + j * 16 + k * 8;
                    xx[0] = bflo(q.x); xx[1] = bfhi(q.x); xx[2] = bflo(q.y); xx[3] = bfhi(q.y); xx[4] = bflo(q.z); xx[5] = bfhi(q.z); xx[6] = bflo(q.w); xx[7] = bfhi(q.w);
                }
#pragma unroll
            for (int i = 0; i < 32; ++i) am = fmaxf(am, fabsf(x[i]));
            sxl = am > 0.f ? am * (1.f / 127.f) : 1.f;
            const float inv = 1.f / sxl;
#pragma unroll
            for (int d = 0; d < 8; ++d) {
                const int q0 = (int)rintf(x[4 * d] * inv), q1 = (int)rintf(x[4 * d + 1] * inv), q2 = (int)rintf(x[4 * d + 2] * inv), q3 = (int)rintf(x[4 * d + 3] * inv);
                xq[d] = (int)(((unsigned)q0 & 0xffu) | (((unsigned)q1 & 0xffu) << 8) | (((unsigned)q2 & 0xffu) << 16) | ((unsigned)q3 << 24));
            }
        }
        const int e0 = EID[(size_t)t * 128 + lane], e1 = EID[(size_t)t * 128 + 64 + lane];
        const float g0 = GATE[(size_t)t * 128 + lane], g1 = GATE[(size_t)t * 128 + 64 + lane];
        const float us0 = USC[e0], us1 = USC[e1], vs0 = VSC[e0], vs1 = VSC[e1];
        float hid0 = 0.f, hid1 = 0.f;
        constexpr int GBU = 8, GBV = 4;
#define G_LOAD(W, TAB, EB, NB) do { _Pragma("unroll") for (int i = 0; i < NB; ++i) { \
            const int id_ = __builtin_amdgcn_readlane((EB) < 64 ? e0 : e1, ((EB) + i) & 63); \
            const unsigned char* row_ = (TAB) + (size_t)id_ * DM + lane * 16; \
            W[i][0] = *(const u32x4*)row_; W[i][1] = *(const u32x4*)(row_ + 1024); } } while (0)
#define G_DOT(W, EB) do { _Pragma("unroll") for (int i = 0; i < GBU; ++i) { int s_ = 0; \
            s_ = __builtin_amdgcn_sdot4((int)W[i][0].x, xq[0], s_, false); s_ = __builtin_amdgcn_sdot4((int)W[i][0].y, xq[1], s_, false); \
            s_ = __builtin_amdgcn_sdot4((int)W[i][0].z, xq[2], s_, false); s_ = __builtin_amdgcn_sdot4((int)W[i][0].w, xq[3], s_, false); \
            s_ = __builtin_amdgcn_sdot4((int)W[i][1].x, xq[4], s_, false); s_ = __builtin_amdgcn_sdot4((int)W[i][1].y, xq[5], s_, false); \
            s_ = __builtin_amdgcn_sdot4((int)W[i][1].z, xq[6], s_, false); s_ = __builtin_amdgcn_sdot4((int)W[i][1].w, xq[7], s_, false); \
            const float tot = wave_total((float)s_ * sxl); \
            if ((((EB) + i) & 63) == lane) { if ((EB) < 64) hid0 = tot; else hid1 = tot; } } } while (0)
#define G_AXPY(W, EB) do { _Pragma("unroll") for (int i = 0; i < GBV; ++i) { \
            const float cf_ = __uint_as_float(__builtin_amdgcn_readlane(__float_as_uint((EB) < 64 ? cf0 : cf1), ((EB) + i) & 63)); \
            const f32x2 mm = {cf_, cf_}; \
            _Pragma("unroll") for (int j = 0; j < 2; ++j) { const unsigned ww[4] = {W[i][j].x, W[i][j].y, W[i][j].z, W[i][j].w}; \
                _Pragma("unroll") for (int k = 0; k < 4; ++k) { \
                    acc[j * 8 + k * 2] += mm * __builtin_amdgcn_cvt_pk_f32_fp8((int)ww[k], false); \
                    acc[j * 8 + k * 2 + 1] += mm * __builtin_amdgcn_cvt_pk_f32_fp8((int)ww[k], true); } } } } while (0)
        u32x4 wa[GBU][2], wb[GBU][2];
        const bool do_u = !(dry && (DRY_MODE == 4 || DRY_MODE == 5)), do_v = !(dry && (DRY_MODE == 3 || DRY_MODE == 5));
        if (do_u) G_LOAD(wa, UT, 0, GBU); else G_LOAD(wa, VT, 0, GBV);
#pragma unroll 1
        for (int eb = 0; eb < (do_u ? 128 : 0); eb += 2 * GBU) {
            G_LOAD(wb, UT, eb + GBU, GBU);
            G_DOT(wa, eb);
            if (eb + 2 * GBU < 128) G_LOAD(wa, UT, eb + 2 * GBU, GBU); else G_LOAD(wa, VT, 0, GBV);
            G_DOT(wb, eb + GBU);
        }
        const float cf0 = gelu_tanh(hid0 * us0) * g0 * vs0, cf1 = gelu_tanh(hid1 * us1) * g1 * vs1;
        f32x2 acc[16];
#pragma unroll
        for (int i = 0; i < 16; ++i) acc[i] = (f32x2){0.f, 0.f};
#pragma unroll 1
        for (int eb = 0; eb < (do_v ? 128 : 0); eb += 2 * GBV) {
            G_LOAD(wb, VT, eb + GBV, GBV);
            G_AXPY(wa, eb);
            if (eb + 2 * GBV < 128) G_LOAD(wa, VT, eb + 2 * GBV, GBV);
            G_AXPY(wb, eb + GBV);
        }
#undef G_LOAD
#undef G_DOT
#undef G_AXPY
        float hn[32];
        float* hrow = t < NLAT ? p.out + (size_t)t * DM : (float*)(p.ws + WS_HC) + (size_t)(t - NLAT) * DM;
        const int bb = t < NLAT ? (t >> 11) : 8;
        const float* gate = mod + (size_t)bb * 12288 + 5 * DM;
#pragma unroll
        for (int j = 0; j < 2; ++j)
#pragma unroll
            for (int k = 0; k < 4; ++k) {
                const int col = j * 1024 + lane * 16 + k * 4;
                const f32x4 hv = *(const f32x4*)(hrow + col), gv = *(const f32x4*)(gate + col);
                const f32x2 a0 = acc[j * 8 + k * 2], a1 = acc[j * 8 + k * 2 + 1];
                f32x4 o;
                o.x = hv.x + gv.x * a0.x; o.y = hv.y + gv.y * a0.y; o.z = hv.z + gv.z * a1.x; o.w = hv.w + gv.w * a1.y;
                *(f32x4*)((dry ? (float*)(p.ws + WS_DUMMY) + (size_t)(t & 16383) * DM : hrow) + col) = o;
                hn[j * 16 + k * 4 + 0] = o.x; hn[j * 16 + k * 4 + 1] = o.y; hn[j * 16 + k * 4 + 2] = o.z; hn[j * 16 + k * 4 + 3] = o.w;
            }
        if (l + 1 < DEPTH) {
            float ss = 0.f;
#pragma unroll
            for (int i = 0; i < 32; ++i) ss += hn[i] * hn[i];
            const float rstd = rsqrtf(wave_total(ss) * (1.f / DM) + EPS);
            const float* g1n = p.norm1_g + (l + 1) * DM;
            const float* shift = mod + (size_t)9 * 12288 + (size_t)bb * 12288;
            const float* scale = shift + DM;
            bf16_t* xo = (dry ? (bf16_t*)(p.ws + WS_DUMMY) + (size_t)(t & 16383) * DM : (bf16_t*)(p.ws + WS_XN) + (size_t)t * DM);
#pragma unroll
            for (int j = 0; j < 2; ++j)
#pragma unroll
                for (int k = 0; k < 2; ++k) {
                    const int col = j * 1024 + lane * 16 + k * 8;
                    float xv[8];
#pragma unroll
                    for (int i = 0; i < 8; ++i) xv[i] = hn[j * 16 + k * 8 + i] * rstd * g1n[col + i] * (1.f + scale[col + i]) + shift[col + i];
                    u32x4 w; w.x = pk2(xv[0], xv[1]); w.y = pk2(xv[2], xv[3]); w.z = pk2(xv[4], xv[5]); w.w = pk2(xv[6], xv[7]);
                    *(u32x4*)(xo + col) = w;
                }
        }
    }
}
#endif
#else
__device__ __forceinline__ float dot8(const u32x4 u, const u32x4 x) {
    float d = bflo(u.x) * bflo(x.x) + bfhi(u.x) * bfhi(x.x);
    d += bflo(u.y) * bflo(x.y) + bfhi(u.y) * bfhi(x.y);
    d += bflo(u.z) * bflo(x.z) + bfhi(u.z) * bfhi(x.z);
    d += bflo(u.w) * bflo(x.w) + bfhi(u.w) * bfhi(x.w);
    return d;
}
__device__ __forceinline__ void ph_gather(const Params& p, int l, const bool dry) {
    const int tid = threadIdx.x, lane = tid & 63, wave = tid >> 6;
    const int gw = blockIdx.x * NWAVES + wave, NGW = gridDim.x * NWAVES;
    const bf16_t* XN = (const bf16_t*)(p.ws + WS_XN);
    const bf16_t* UT = (const bf16_t*)(p.ws + WS_UT) + (size_t)l * NEXP * DM;
    const bf16_t* VT = (const bf16_t*)(p.ws + WS_VT) + (size_t)l * NEXP * DM;
    const int* EID = (const int*)(p.ws + WS_EID); const float* GATE = (const float*)(p.ws + WS_GATE);
    const float* mod = (const float*)(p.ws + WS_MOD) + (size_t)l * 9 * 12288;
    const int nrows = (l == DEPTH - 1) ? NLAT : MTOT;
    for (int t = gw; t < nrows; t += NGW) {
        u32x4 xq[4];
#pragma unroll
        for (int j = 0; j < 4; ++j) xq[j] = *(const u32x4*)(XN + (size_t)t * DM + j * 512 + lane * 8);
        const int e0 = EID[(size_t)t * 128 + lane], e1 = EID[(size_t)t * 128 + 64 + lane];
        const float g0 = GATE[(size_t)t * 128 + lane], g1 = GATE[(size_t)t * 128 + 64 + lane];
        float hid0 = 0.f, hid1 = 0.f;
#pragma unroll 1
        for (int eb = 0; eb < 128; eb += 4) {
            u32x4 uu[4][4];
#pragma unroll
            for (int i = 0; i < 4; ++i) {
                const int e = eb + i;
                const int id = __builtin_amdgcn_readlane(eb < 64 ? e0 : e1, e & 63);
                const u32x4* ur = (const u32x4*)(UT + (size_t)id * DM) + lane;
#pragma unroll
                for (int j = 0; j < 4; ++j) uu[i][j] = ur[j * 64];
            }
#pragma unroll
            for (int i = 0; i < 4; ++i) {
                const int e = eb + i;
                float d = dot8(uu[i][0], xq[0]) + dot8(uu[i][1], xq[1]) + dot8(uu[i][2], xq[2]) + dot8(uu[i][3], xq[3]);
                d = wave_sum(d);
                if ((e & 63) == lane) { if (eb < 64) hid0 = d; else hid1 = d; }
            }
        }
        const float cf0 = gelu_tanh(hid0) * g0, cf1 = gelu_tanh(hid1) * g1;
        float acc[32];
#pragma unroll
        for (int i = 0; i < 32; ++i) acc[i] = 0.f;
#pragma unroll 1
        for (int eb = 0; eb < 128; eb += 4) {
            u32x4 vv[4][4]; float cf[4];
#pragma unroll
            for (int i = 0; i < 4; ++i) {
                const int e = eb + i;
                const int id = __builtin_amdgcn_readlane(eb < 64 ? e0 : e1, e & 63);
                cf[i] = __uint_as_float(__builtin_amdgcn_readlane(__float_as_uint(eb < 64 ? cf0 : cf1), e & 63));
                const u32x4* vr = (const u32x4*)(VT + (size_t)id * DM) + lane;
#pragma unroll
                for (int j = 0; j < 4; ++j) vv[i][j] = vr[j * 64];
            }
#pragma unroll
            for (int i = 0; i < 4; ++i)
#pragma unroll
                for (int j = 0; j < 4; ++j) {
                    acc[j * 8 + 0] += cf[i] * bflo(vv[i][j].x); acc[j * 8 + 1] += cf[i] * bfhi(vv[i][j].x);
                    acc[j * 8 + 2] += cf[i] * bflo(vv[i][j].y); acc[j * 8 + 3] += cf[i] * bfhi(vv[i][j].y);
                    acc[j * 8 + 4] += cf[i] * bflo(vv[i][j].z); acc[j * 8 + 5] += cf[i] * bfhi(vv[i][j].z);
                    acc[j * 8 + 6] += cf[i] * bflo(vv[i][j].w); acc[j * 8 + 7] += cf[i] * bfhi(vv[i][j].w);
                }
        }
        float* hrow = t < NLAT ? p.out + (size_t)t * DM : (float*)(p.ws + WS_HC) + (size_t)(t - NLAT) * DM;
        const int bb = t < NLAT ? (t >> 11) : 8;
        const float* gate = mod + (size_t)bb * 12288 + 5 * DM;
#pragma unroll
        for (int j = 0; j < 4; ++j) {
            const int col = j * 512 + lane * 8;
#pragma unroll
            for (int hh = 0; hh < 2; ++hh) {
                const f32x4 hv = *(const f32x4*)(hrow + col + hh * 4), gv = *(const f32x4*)(gate + col + hh * 4);
                f32x4 o;
                o.x = hv.x + gv.x * acc[j * 8 + hh * 4 + 0]; o.y = hv.y + gv.y * acc[j * 8 + hh * 4 + 1];
                o.z = hv.z + gv.z * acc[j * 8 + hh * 4 + 2]; o.w = hv.w + gv.w * acc[j * 8 + hh * 4 + 3];
                *(f32x4*)(hrow + col + hh * 4) = o;
            }
        }
    }
}

#endif

#define LAS __attribute__((address_space(3)))
#define XB_TMO      128
#define XB_XCNT(j)  (256  + 64 * (j))
#define XB_XSUB(j)  (1280 + 64 * (j))
#define XB_XGEN(j)  (2304 + 64 * (j))
#define XB_TOP      3328
#define XB_TOPGEN   3392
#define XCD_BAR_WORDS 3456
#define XB_SPIN_CAP (1u << 18)

__device__ __forceinline__ unsigned xb_ld(unsigned* p)              { return __hip_atomic_load(p, __ATOMIC_RELAXED, __HIP_MEMORY_SCOPE_AGENT); }
__device__ __forceinline__ unsigned xb_add(unsigned* p, unsigned v) { return __hip_atomic_fetch_add(p, v, __ATOMIC_RELAXED, __HIP_MEMORY_SCOPE_AGENT); }
__device__ __forceinline__ unsigned xb_xcc_id() { return (unsigned)__builtin_amdgcn_s_getreg((3 << 11) | 20) & 0xFu; }
#define XB_SPIN(cond, bar) do { unsigned _sp = 0; while (cond) { __builtin_amdgcn_s_sleep(1); \
    if ((++_sp & 255u) == 0u) { if (xb_ld(&(bar)[XB_TMO])) break; if (_sp > XB_SPIN_CAP) { atomicAdd(&(bar)[XB_TMO], 1u); break; } } } } while (0)

struct XcdBarrier {
    unsigned* bar; unsigned x;
    volatile LAS unsigned* st;
};

__device__ __forceinline__ XcdBarrier xcd_barrier_post(unsigned* bar, volatile LAS unsigned* st) {
    XcdBarrier b; b.bar = bar; b.x = xb_xcc_id(); b.st = st;
    if (threadIdx.x == 0) (void)xb_add(&bar[XB_XCNT(b.x)], 1u);
    return b;
}
__device__ __forceinline__ void xcd_barrier_complete(unsigned* bar, unsigned x, unsigned& nloc, unsigned& nx) {
    const unsigned G = gridDim.x * gridDim.y * gridDim.z;
    unsigned sum, cnt, mine, sp = 0u;
    for (;;) {
        sum = 0u; cnt = 0u; mine = 0u;
#pragma unroll
        for (unsigned j = 0; j < 16; ++j) { const unsigned c = xb_ld(&bar[XB_XCNT(j)]); sum += c; cnt += (c > 0u) ? 1u : 0u; mine = (j == x) ? c : mine; }
        if (sum == G) break;
        __builtin_amdgcn_s_sleep(1);
        if ((++sp & 255u) == 0u) { if (xb_ld(&bar[XB_TMO])) break; if (sp > XB_SPIN_CAP) { atomicAdd(&bar[XB_TMO], 1u); break; } }
    }
    nloc = mine > 0u ? mine : 1u; nx = cnt > 0u ? cnt : 1u;
}

__device__ __forceinline__ void xcd_barrier(const XcdBarrier& b) {
    asm volatile("s_waitcnt vmcnt(0)" ::: "memory");
    __syncthreads();
    if (threadIdx.x == 0) {
        unsigned* bar = b.bar;
        __builtin_amdgcn_s_waitcnt(0);
        unsigned nloc = b.st[0], nx = b.st[1];
        if (nloc == 0u) { xcd_barrier_complete(bar, b.x, nloc, nx); b.st[0] = nloc; b.st[1] = nx; }
        const unsigned old = xb_add(&bar[XB_XSUB(b.x)], 1u);
        const unsigned gen = old / nloc;
        if (old + 1u == (gen + 1u) * nloc) {
            __builtin_amdgcn_fence(__ATOMIC_RELEASE, "agent");
            asm volatile("s_waitcnt vmcnt(0)" ::: "memory");
            const unsigned og = xb_add(&bar[XB_TOP], 1u);
            const unsigned tg = og / nx;
            if (og + 1u == (tg + 1u) * nx) xb_add(&bar[XB_TOPGEN], 1u);
            else XB_SPIN(xb_ld(&bar[XB_TOPGEN]) == tg, bar);
            __builtin_amdgcn_fence(__ATOMIC_ACQUIRE, "agent");
            xb_add(&bar[XB_XGEN(b.x)], 1u);
            asm volatile("s_waitcnt vmcnt(0)" ::: "memory");
        } else {
            XB_SPIN(xb_ld(&bar[XB_XGEN(b.x)]) == gen, bar);
            __builtin_amdgcn_fence(__ATOMIC_ACQUIRE, "agent");
            asm volatile("s_waitcnt vmcnt(0)" ::: "memory");
        }
    }
    __syncthreads();
}

constexpr int NPHASE = 1 + 10 * DEPTH;
template <int S>
__device__ __forceinline__ void run_stage(const Params& p, int l, unsigned char* lds, const bool dry) {
    const bool last = (l == DEPTH - 1);
    const float* mod = (const float*)(p.ws + WS_MOD) + (size_t)l * 9 * 12288;
    if constexpr (S == 1) { if (l == 0) { ph_modulate(p, l, 0); if (GEMM_I8 && !dry) ph_weights_i8(p, lds); } }
    if constexpr (S == 2) {
#if USE_PG8
        pg8::StaticOrder So; So.init(MTOT, INW, (int)gridDim.x, (int)blockIdx.x);
#if GEMM_I8
        pg8::Gemm g{(const bf16_t*)(p.ws + WS_XN8), (const bf16_t*)(p.ws + WS_WIN + (size_t)l * INW * DM), MTOT, INW, DM / 2};
        pg8::EpiBf16I8 E{(bf16_t*)(p.ws + WS_P), INW, (const float*)(p.ws + WS_SCL) + SCL_XN, (const float*)(p.ws + WS_SCL) + SCL_WIN + l * INW};
        pg8::gemm_phase<pg8::EpiBf16I8, pg8::StaticOrder, true, true, true>((PG8_LAS unsigned char*)lds, g, So, E);
#else
        pg8::Gemm g{(const bf16_t*)(p.ws + WS_XN), (const bf16_t*)(p.ws + WS_WIN) + (size_t)l * INW * DM, MTOT, INW, DM};
        pg8::EpiBf16<0> E{(bf16_t*)(p.ws + WS_P), INW, nullptr, 0, 0, 1.f};
        pg8::gemm_phase<pg8::EpiBf16<0>, pg8::StaticOrder, true, true>((PG8_LAS unsigned char*)lds, g, So, E);
#endif
#else
        EpiBf16Store E{(bf16_t*)(p.ws + WS_P), INW};
        gemm_naive(lds, (const bf16_t*)(p.ws + WS_XN), (const bf16_t*)(p.ws + WS_WIN) + (size_t)l * INW * DM, MTOT, INW, DM, E);
#endif
    }
    if constexpr (S == 3) ph_prep(p, l, dry);
    if constexpr (S == 4) {
#if USE_FAST_ATT
        ph_mixers_fast(p, l, lds, dry);
#else
        ph_mixers_naive(p, l, lds);
#endif
    }
    if constexpr (S == 5) ph_ynorm(p, l);
    if constexpr (S == 6) {
#if USE_PG8
        const int M = last ? NLAT : MTOT;
        pg8::StaticOrder So; So.init(M, DM, (int)gridDim.x, (int)blockIdx.x);
#if GEMM_I8
        pg8::Gemm g{(const bf16_t*)(p.ws + WS_XN8), (const bf16_t*)(p.ws + WS_WOUT + (size_t)l * DM * DM), M, DM, DM / 2};
#if H_BF16 && GEMM3_I8
        pg8::EpiResGateI8B E{l == 0 ? p.x : nullptr, p.ctx, (bf16_t*)(p.ws + (dry ? WS_DUMMY : WS_HB)), mod + 2 * DM,
                             (const float*)(p.ws + WS_SCL) + SCL_Y, (const float*)(p.ws + WS_SCL) + SCL_WOUT + l * DM};
        pg8::gemm_phase<pg8::EpiResGateI8B, pg8::StaticOrder, true, true, true>((PG8_LAS unsigned char*)lds, g, So, E);
#else
        pg8::EpiResGateI8 E{l == 0 ? p.x : p.out, l == 0 ? p.ctx : (const float*)(p.ws + WS_HC), dry ? (float*)(p.ws + WS_DUMMY) : p.out, dry ? (float*)(p.ws + WS_DUMMY) : (float*)(p.ws + WS_HC), mod + 2 * DM,
                            (const float*)(p.ws + WS_SCL) + SCL_Y, (const float*)(p.ws + WS_SCL) + SCL_WOUT + l * DM};
        pg8::gemm_phase<pg8::EpiResGateI8, pg8::StaticOrder, true, true, true>((PG8_LAS unsigned char*)lds, g, So, E);
#endif
#else
        pg8::Gemm g{(const bf16_t*)(p.ws + WS_Y), (const bf16_t*)(p.ws + WS_WOUT) + (size_t)l * DM * DM, M, DM, DM};
        pg8::EpiResGateT E{l == 0 ? p.x : p.out, l == 0 ? p.ctx : (const float*)(p.ws + WS_HC), dry ? (float*)(p.ws + WS_DUMMY) : p.out, dry ? (float*)(p.ws + WS_DUMMY) : (float*)(p.ws + WS_HC), mod + 2 * DM};
        pg8::gemm_phase<pg8::EpiResGateT, pg8::StaticOrder, true, true>((PG8_LAS unsigned char*)lds, g, So, E);
#endif
#if GATHER_I8 && GATHER_4BIT
        if (TABLES_IN_GAPS && l == 0 && !dry) conv4_tables(p, 0, 2 * NEXP, (unsigned*)(p.ws + WS_CTL) + 6144, lds);
#endif
#else
        EpiResGate E{l == 0 ? p.x : p.out, l == 0 ? p.ctx : (const float*)(p.ws + WS_HC), p.out, (float*)(p.ws + WS_HC), mod + 2 * DM};
        gemm_naive(lds, (const bf16_t*)(p.ws + WS_Y), (const bf16_t*)(p.ws + WS_WOUT) + (size_t)l * DM * DM, last ? NLAT : MTOT, DM, DM, E);
#endif
    }
    if constexpr (S == 7) ph_modulate(p, l, 1);
    if constexpr (S == 8) {
#if USE_PG8
        const int M = last ? NLAT : MTOT;
        pg8::StaticOrder So; So.init(M, DM, (int)gridDim.x, (int)blockIdx.x);
#if GEMM_I8 && GEMM3_I8
        pg8::Gemm g{(const bf16_t*)(p.ws + WS_XN8), (const bf16_t*)(p.ws + WS_WQ + (size_t)l * DM * DM), M, DM, DM / 2};
        pg8::EpiBf16I8 E{(bf16_t*)(p.ws + WS_P), DM, (const float*)(p.ws + WS_SCL) + SCL_XN, (const float*)(p.ws + WS_SCL) + SCL_WQ + l * DM};
        pg8::gemm_phase<pg8::EpiBf16I8, pg8::StaticOrder, true, true, true>((PG8_LAS unsigned char*)lds, g, So, E);
#else
        pg8::Gemm g{(const bf16_t*)(p.ws + WS_XN), (const bf16_t*)(p.ws + WS_WQ) + (size_t)l * DM * DM, M, DM, DM};
        pg8::EpiBf16<0> E{(bf16_t*)(p.ws + WS_P), DM, nullptr, 0, 0, 1.f};
        pg8::gemm_phase<pg8::EpiBf16<0>, pg8::StaticOrder, true, true>((PG8_LAS unsigned char*)lds, g, So, E);
#endif
#if FUSE_ROUTE
        asm volatile("s_waitcnt vmcnt(0)" ::: "memory");
        __syncthreads();
        ph_route_fast<true>(p, l, lds);
#endif
#if GATHER_I8 && GATHER_4BIT
        if (TABLES_IN_GAPS && l == 0 && !dry) conv4_tables(p, 2 * NEXP, 4 * NEXP, (unsigned*)(p.ws + WS_CTL) + 6208, lds);
#endif
#else
        EpiBf16Store E{(bf16_t*)(p.ws + WS_P), DM};
        gemm_naive(lds, (const bf16_t*)(p.ws + WS_XN), (const bf16_t*)(p.ws + WS_WQ) + (size_t)l * DM * DM, last ? NLAT : MTOT, DM, DM, E);
#endif
    }
    if constexpr (S == 9) {
#if USE_FAST_ROUTE
        if (!FUSE_ROUTE) ph_route_fast<false>(p, l, lds);
#else
        ph_route_naive(p, l);
#endif
    }
    if constexpr (S == 10) ph_gather(p, l, dry);
}
__global__ void __launch_bounds__(NTHREADS) fwd_kernel(Params p) {
    extern __shared__ __attribute__((aligned(16))) unsigned char lds[];
    cg::grid_group grid = cg::this_grid();
    const int lo = p.ph_lo, hi = p.ph_hi;
    volatile LAS unsigned* stw = (volatile LAS unsigned*)((LAS unsigned char*)lds + (LDS_BYTES - 128));
    if (threadIdx.x < 2) stw[threadIdx.x] = 0u;
    __syncthreads();
    const XcdBarrier bar = xcd_barrier_post((unsigned*)(p.ws + WS_CTL + 32768), stw);
#define IN(k) (lo <= (k) && (k) < hi)
#define SEAM(k) do { if (IN(k) && IN((k) + 1)) { if ((k) == 0) grid.sync(); else xcd_barrier(bar); } } while (0)
#define STAGE(S, l) do { constexpr int k_ = 1 + 10 * (l) + (S) - 1; if (IN(k_)) { if constexpr ((REP_MASK >> k_) & 1) { run_stage<S>(p, l, lds, true); xcd_barrier(bar); } run_stage<S>(p, l, lds, false); } SEAM(k_); } while (0)
#define LAYER(l) do { if ((l) == 0) { STAGE(1, l); } STAGE(2, l); STAGE(3, l); STAGE(4, l); STAGE(5, l); STAGE(6, l); STAGE(7, l); STAGE(8, l); if (!FUSE_ROUTE) { STAGE(9, l); } STAGE(10, l); } while (0)
    if (IN(0)) { if constexpr (REP_MASK & 1) { ph_prologue(p, lds); grid.sync(); } ph_prologue(p, lds); }
    SEAM(0);
    LAYER(0);
    LAYER(1);
#undef IN
#undef SEAM
#undef STAGE
#undef LAYER
}

extern "C" void kernel_launch(void* const* d_in, const int* in_sizes, int n_in, void* d_out, int out_size, void* d_ws, size_t ws_size, hipStream_t stream) {
    static int grid_blocks = 0;
    if (grid_blocks == 0) {
        if (n_in != 23 || out_size != NLAT * DM || ws_size < WS_END) { fprintf(stderr, "kernel_launch: unexpected shapes n_in %d out %d ws %zu\n", n_in, out_size, ws_size); grid_blocks = -1; return; }
        if (hipFuncSetAttribute((const void*)fwd_kernel, hipFuncAttributeMaxDynamicSharedMemorySize, LDS_BYTES) != hipSuccess) { fprintf(stderr, "kernel_launch: hipFuncSetAttribute failed\n"); grid_blocks = -1; return; }
        int dev = 0, cus = 0, per_cu = 0;
        hipGetDevice(&dev);
        hipDeviceGetAttribute(&cus, hipDeviceAttributeMultiprocessorCount, dev);
        hipOccupancyMaxActiveBlocksPerMultiprocessor(&per_cu, (const void*)fwd_kernel, NTHREADS, LDS_BYTES);
        if (per_cu < 1 || cus < 1) { fprintf(stderr, "kernel_launch: occupancy query failed (%d per CU, %d CUs)\n", per_cu, cus); grid_blocks = -1; return; }
        grid_blocks = cus * per_cu;
    }
    if (grid_blocks < 0) return;
    Params p{};
    const float** pp = (const float**)&p;
    for (int i = 0; i < 23; ++i) pp[i] = (const float*)d_in[i];
    p.out = (float*)d_out; p.ws = (unsigned char*)d_ws;
    p.ph_lo = 0; p.ph_hi = NPHASE;
    hipMemsetAsync((char*)d_ws + WS_CTL, 0, 131072, stream);
    void* args[] = {&p};
    hipError_t e = hipLaunchCooperativeKernel((const void*)fwd_kernel, dim3(grid_blocks), dim3(NTHREADS), args, LDS_BYTES, stream);
    if (e != hipSuccess) fprintf(stderr, "cooperative launch failed: %s (grid %d)\n", hipGetErrorString(e), grid_blocks);
}
```

```cpp
#include <hip/hip_runtime.h>
#include <hip/hip_cooperative_groups.h>
#include <cstdio>
#include <cstdint>
namespace cg = cooperative_groups;

constexpr int DM = 2048, NB = 8, SEQ = 2048, NCTX = 256, DEPTH = 2;
constexpr int NLAT = NB * SEQ;
constexpr int NCT = NB * NCTX;
constexpr int MTOT = NLAT + NCT;
constexpr int INW = 3584;
constexpr int C_QA = 0, C_KA = 768, C_VA = 1024, C_QB = 1280, C_KB = 2048, C_VB = 2304, C_UC = 2560, C_VC = 3072;
constexpr int NEXP = 16384;
constexpr float EPS = 1e-6f;
constexpr float ATT_SCALE = 0.088388347648318440f;
constexpr int NTHREADS = 512, NWAVES = 8;

constexpr size_t MiB = 1u << 20;
constexpr size_t WS_CTL = 0;
constexpr size_t WS_MOD = 1 * MiB;
constexpr size_t WS_ROPE = 2 * MiB;
constexpr size_t WS_KEYS = 3 * MiB;
constexpr size_t WS_WSC = 4 * MiB;
constexpr size_t WS_USC = 5 * MiB;
constexpr size_t WS_VSC = 6 * MiB;
constexpr size_t WS_WIN = 8 * MiB;
constexpr size_t WS_WOUT = 36 * MiB;
constexpr size_t WS_WQ = 52 * MiB;
constexpr size_t WS_HC = 68 * MiB;
constexpr size_t WS_EID = 84 * MiB;
constexpr size_t WS_GATE = 93 * MiB;
constexpr size_t WS_XN = 104 * MiB;
constexpr size_t WS_HB = WS_XN;
constexpr size_t WS_Y = 176 * MiB;
constexpr size_t WS_P = 248 * MiB;
constexpr size_t WS_UT = 376 * MiB;
constexpr size_t WS_VT = 504 * MiB;
constexpr size_t WS_SCL = 102 * MiB;
constexpr size_t SCL_WIN = 0, SCL_WOUT = 2 * 3584, SCL_XN = SCL_WOUT + 2 * 2048, SCL_Y = SCL_XN + 18432, SCL_WQ = SCL_Y + 18432;
constexpr int NCM = 3584 + 2048 + 2048;
constexpr size_t WS_XN8 = 784 * MiB;
constexpr size_t CTL_COLMAX = 65536;
constexpr size_t WS_DUMMY = 640 * MiB;
constexpr size_t WS_END = 820 * MiB;

constexpr int LDS_BYTES = 147456;

typedef unsigned short bf16_t;
typedef float f32x4 __attribute__((ext_vector_type(4)));
typedef unsigned u32x4 __attribute__((ext_vector_type(4)));
typedef unsigned u32x2 __attribute__((ext_vector_type(2)));

struct Params {
    const float *x, *c, *ctx, *c_ctx, *w_ada, *b_ada, *norm1_g, *norm2_g, *w_in, *qn_a, *kn_a, *qn_b, *kn_b, *sink_b, *vn_c, *ws_c, *bs_c,
        *g_group, *w_out, *peer_wq, *peer_keys, *peer_u, *peer_v;
    float* out;
    unsigned char* ws;
    int ph_lo, ph_hi;
};

__device__ __forceinline__ float bf2f(unsigned v) { return __uint_as_float(v << 16); }
__device__ __forceinline__ float bflo(unsigned w) { return __uint_as_float(w << 16); }
__device__ __forceinline__ float bfhi(unsigned w) { return __uint_as_float(w & 0xffff0000u); }
__device__ __forceinline__ unsigned f2bf(float f) { unsigned u = __float_as_uint(f); return (u + 0x7fffu + ((u >> 16) & 1u)) >> 16; }
__device__ __forceinline__ unsigned pk2(float lo, float hi) { return f2bf(lo) | (f2bf(hi) << 16); }
__device__ __forceinline__ float wave_sum(float v) {
#pragma unroll
    for (int o = 32; o >= 1; o >>= 1) v += __shfl_xor(v, o);
    return v;
}
__device__ __forceinline__ float wave_max(float v) {
#pragma unroll
    for (int o = 32; o >= 1; o >>= 1) v = fmaxf(v, __shfl_xor(v, o));
    return v;
}
__device__ __forceinline__ float gelu_tanh(float x) {
    const float y = 0.7978845608028654f * (x + 0.044715f * x * x * x);
    const float t = 1.f - 2.f / (__expf(2.f * y) + 1.f);
    return 0.5f * x * (1.f + t);
}
__device__ __forceinline__ float silu(float x) { return x / (1.f + __expf(-x)); }
#define LDS_WAIT() asm volatile("s_waitcnt lgkmcnt(0)" ::: "memory")
#ifndef GATHER_I8
#define GATHER_I8 1
#endif
#ifndef GATHER_4BIT
#define GATHER_4BIT 1
#endif
constexpr int ROW4 = 1152;
#ifndef FUSE_ROUTE
#define FUSE_ROUTE 1
#endif
#ifndef GEMM_I8
#define GEMM_I8 1
#endif
#ifndef GEMM3_I8
#define GEMM3_I8 1
#endif
#ifndef H_BF16
#define H_BF16 1
#endif
#ifndef W8_ONEPASS
#define W8_ONEPASS 1
#endif
#ifndef REP_MASK
#define REP_MASK 0
#endif

__device__ __forceinline__ unsigned q8pack4(float a, float b, float c, float d, float inv) {
    const int q0 = (int)rintf(a * inv), q1 = (int)rintf(b * inv), q2 = (int)rintf(c * inv), q3 = (int)rintf(d * inv);
    return ((unsigned)q0 & 0xffu) | (((unsigned)q1 & 0xffu) << 8) | (((unsigned)q2 & 0xffu) << 16) | ((unsigned)q3 << 24);
}

__device__ __forceinline__ void transpose_item(const float* W, int K, int N, bf16_t* WT, const float* gk, float* scr, int item, int lane) {
    const int nblk = N / 32, kb = item / nblk, nb = item % nblk, k0 = 64 * kb, n0 = 32 * nb;
#pragma unroll 8
    for (int i = 0; i < 32; ++i) {
        const int kk = 2 * i + (lane >> 5);
        float v = W[(size_t)(k0 + kk) * N + n0 + (lane & 31)];
        if (gk) v *= gk[k0 + kk];
        scr[kk * 33 + (lane & 31)] = v;
    }
    LDS_WAIT();
    const int c = lane & 7;
#pragma unroll
    for (int j = 0; j < 4; ++j) {
        const int n = (lane >> 3) + 8 * j;
        const float* s = scr + (8 * c) * 33 + n;
        u32x4 o;
        o.x = pk2(s[0 * 33], s[1 * 33]); o.y = pk2(s[2 * 33], s[3 * 33]); o.z = pk2(s[4 * 33], s[5 * 33]); o.w = pk2(s[6 * 33], s[7 * 33]);
        *(u32x4*)(WT + (size_t)(n0 + n) * K + k0 + 8 * c) = o;
    }
    LDS_WAIT();
}

__device__ __forceinline__ void colmax_item(const float* W, int N, const float* gk, unsigned* cmax, int item, int lane) {
    const int nblk = N / 32, kb = item / nblk, nb = item % nblk, k0 = 64 * kb, n0 = 32 * nb;
    f32x4 v[8];
#pragma unroll
    for (int i = 0; i < 8; ++i) v[i] = *(const f32x4*)(W + (size_t)(k0 + 8 * i + (lane >> 3)) * N + n0 + 4 * (lane & 7));
    float m0 = 0.f, m1 = 0.f, m2 = 0.f, m3 = 0.f;
#pragma unroll
    for (int i = 0; i < 8; ++i) {
        const float g = gk ? fabsf(gk[k0 + 8 * i + (lane >> 3)]) : 1.f;
        m0 = fmaxf(m0, fabsf(v[i].x) * g); m1 = fmaxf(m1, fabsf(v[i].y) * g); m2 = fmaxf(m2, fabsf(v[i].z) * g); m3 = fmaxf(m3, fabsf(v[i].w) * g);
    }
#pragma unroll
    for (int o = 8; o <= 32; o <<= 1) { m0 = fmaxf(m0, __shfl_xor(m0, o)); m1 = fmaxf(m1, __shfl_xor(m1, o)); m2 = fmaxf(m2, __shfl_xor(m2, o)); m3 = fmaxf(m3, __shfl_xor(m3, o)); }
    if (lane < 8) {
        unsigned* c = cmax + n0 + 4 * lane;
        atomicMax(c + 0, __float_as_uint(m0)); atomicMax(c + 1, __float_as_uint(m1)); atomicMax(c + 2, __float_as_uint(m2)); atomicMax(c + 3, __float_as_uint(m3));
    }
}
__device__ __forceinline__ void transpose_item_i8(const float* W, int K, int N, unsigned char* W8, const float* gk, const unsigned* cmax, float* scr, int item, int lane) {
    const int nblk = N / 32, kb = item / nblk, nb = item % nblk, k0 = 64 * kb, n0 = 32 * nb;
    f32x4 v[8];
#pragma unroll
    for (int i = 0; i < 8; ++i) v[i] = *(const f32x4*)(W + (size_t)(k0 + 8 * i + (lane >> 3)) * N + n0 + 4 * (lane & 7));
    float inv[4];
#pragma unroll
    for (int c = 0; c < 4; ++c) { const float m = __uint_as_float(cmax[n0 + 4 * (lane & 7) + c]); inv[c] = m > 0.f ? 127.f / m : 0.f; }
#pragma unroll
    for (int i = 0; i < 8; ++i) {
        const int kk = 8 * i + (lane >> 3);
        const float g = gk ? gk[k0 + kk] : 1.f;
        float* d = scr + kk * 33 + 4 * (lane & 7);
        d[0] = rintf(v[i].x * g * inv[0]); d[1] = rintf(v[i].y * g * inv[1]); d[2] = rintf(v[i].z * g * inv[2]); d[3] = rintf(v[i].w * g * inv[3]);
    }
    LDS_WAIT();
    const int c = lane & 7;
#pragma unroll
    for (int j = 0; j < 4; ++j) {
        const int n = (lane >> 3) + 8 * j;
        const float* s = scr + (8 * c) * 33 + n;
        unsigned lo = 0u, hi = 0u;
#pragma unroll
        for (int i = 0; i < 4; ++i) { lo |= ((unsigned)(int)s[i * 33] & 0xffu) << (8 * i); hi |= ((unsigned)(int)s[(4 + i) * 33] & 0xffu) << (8 * i); }
        u32x2 o; o.x = lo; o.y = hi;
        *(u32x2*)(W8 + (size_t)(n0 + n) * K + k0 + 8 * c) = o;
    }
    LDS_WAIT();
}
__device__ __forceinline__ void ph_weights_i8(const Params& p, unsigned char* lds) {
    const int tid = threadIdx.x, lane = tid & 63, wave = tid >> 6;
    const int gw = blockIdx.x * NWAVES + wave, NGW = gridDim.x * NWAVES;
    float* scr = (float*)(lds + wave * 8704);
    const unsigned* cm = (const unsigned*)(p.ws + WS_CTL + CTL_COLMAX);
    constexpr int I_IN = 32 * 112, I_SQ = 32 * 64, I_L = I_IN + I_SQ + (GEMM3_I8 ? I_SQ : 0);
    for (int it = gw; it < 2 * I_L; it += NGW) {
        const int l = it / I_L; const int r = it % I_L;
        if (r < I_IN) transpose_item_i8(p.w_in + (size_t)l * DM * INW, DM, INW, (unsigned char*)(p.ws + WS_WIN) + (size_t)l * INW * DM, nullptr, cm + l * NCM, scr, r, lane);
        else if (r < I_IN + I_SQ) transpose_item_i8(p.w_out + (size_t)l * DM * DM, DM, DM, (unsigned char*)(p.ws + WS_WOUT) + (size_t)l * DM * DM, p.g_group + l * DM, cm + l * NCM + INW, scr, r - I_IN, lane);
        else transpose_item_i8(p.peer_wq + (size_t)l * DM * DM, DM, DM, (unsigned char*)(p.ws + WS_WQ) + (size_t)l * DM * DM, nullptr, cm + l * NCM + INW + DM, scr, r - I_IN - I_SQ, lane);
    }
    float* S = (float*)(p.ws + WS_SCL);
    for (int i = blockIdx.x * NTHREADS + tid; i < 2 * NCM; i += gridDim.x * NTHREADS) {
        const int l = i / NCM, n = i % NCM;
        const float m = __uint_as_float(cm[i]); const float s = m > 0.f ? m * (1.f / 127.f) : 1.f;
        if (n < INW) S[SCL_WIN + l * INW + n] = s; else if (n < INW + DM) S[SCL_WOUT + l * DM + (n - INW)] = s; else S[SCL_WQ + l * DM + (n - INW - DM)] = s;
    }
}

__device__ __forceinline__ void w8_strip(const float* W, int N, int n0, const float* gk, unsigned char* W8, float* scl, unsigned char* lds) {
    constexpr int TP = 2048 + 8;
    bf16_t* T = (bf16_t*)lds;
    unsigned* cmx = (unsigned*)(lds + 32 * TP * 2);
    const int tid = threadIdx.x, nq = tid & 7, kr = tid >> 3;
    __syncthreads();
    if (tid < 32) cmx[tid] = 0u;
    float m0 = 0.f, m1 = 0.f, m2 = 0.f, m3 = 0.f;
#pragma unroll 1
    for (int s0 = 0; s0 < 32; s0 += 8) {
        f32x4 v[8];
#pragma unroll
        for (int i = 0; i < 8; ++i) v[i] = *(const f32x4*)(W + (size_t)((s0 + i) * 64 + kr) * N + n0 + 4 * nq);
#pragma unroll
        for (int i = 0; i < 8; ++i) {
            const int k = (s0 + i) * 64 + kr;
            const float g = gk ? gk[k] : 1.f;
            const float a = v[i].x * g, b = v[i].y * g, c = v[i].z * g, d = v[i].w * g;
            m0 = fmaxf(m0, fabsf(a)); m1 = fmaxf(m1, fabsf(b)); m2 = fmaxf(m2, fabsf(c)); m3 = fmaxf(m3, fabsf(d));
            T[(4 * nq + 0) * TP + k] = (bf16_t)f2bf(a); T[(4 * nq + 1) * TP + k] = (bf16_t)f2bf(b); T[(4 * nq + 2) * TP + k] = (bf16_t)f2bf(c); T[(4 * nq + 3) * TP + k] = (bf16_t)f2bf(d);
        }
    }
    __syncthreads();
    atomicMax(cmx + 4 * nq + 0, __float_as_uint(m0)); atomicMax(cmx + 4 * nq + 1, __float_as_uint(m1));
    atomicMax(cmx + 4 * nq + 2, __float_as_uint(m2)); atomicMax(cmx + 4 * nq + 3, __float_as_uint(m3));
    __syncthreads();
    const int n = tid >> 4, kc = tid & 15;
    const float cm = __uint_as_float(cmx[n]); const float inv = cm > 0.f ? 127.f / cm : 0.f;
    if (kc == 0) scl[n0 + n] = cm > 0.f ? cm * (1.f / 127.f) : 1.f;
#pragma unroll 4
    for (int s = 0; s < 16; ++s) {
        const int k = s * 128 + kc * 8;
        const u32x4 q = *(const u32x4*)(T + n * TP + k);
        u32x2 o;
        o.x = q8pack4(bflo(q.x), bfhi(q.x), bflo(q.y), bfhi(q.y), inv); o.y = q8pack4(bflo(q.z), bfhi(q.z), bflo(q.w), bfhi(q.w), inv);
        *(u32x2*)(W8 + (size_t)(n0 + n) * 2048 + k) = o;
    }
}
__device__ __forceinline__ void cvt_range(const float* src, bf16_t* dst, size_t n8, size_t gtid, size_t gthreads) {
    for (size_t i = gtid; i < n8; i += gthreads) {
        const f32x4 a = *(const f32x4*)(src + i * 8), b = *(const f32x4*)(src + i * 8 + 4);
        u32x4 o; o.x = pk2(a.x, a.y); o.y = pk2(a.z, a.w); o.z = pk2(b.x, b.y); o.w = pk2(b.z, b.w);
        *(u32x4*)(dst + i * 8) = o;
    }
}

#if GATHER_I8 && GATHER_4BIT
__device__ __forceinline__ void conv4_row(const f32x4 (&v)[8], const bool isv, unsigned char* drow, int lane) {
    float am = 0.f;
#pragma unroll
    for (int i = 0; i < 8; ++i) am = fmaxf(am, fmaxf(fmaxf(fabsf(v[i].x), fabsf(v[i].y)), fmaxf(fabsf(v[i].z), fabsf(v[i].w))));
    const float s0 = am > 0.f ? am * (isv ? (1.f / 6.f) : (1.f / 7.f)) : 1.f;
    const unsigned sb = (__float_as_uint(s0) + 0xffffu) >> 16;
    const float inv = 1.f / __uint_as_float(sb << 16);
    u32x4 o; unsigned w[4];
#pragma unroll
    for (int d = 0; d < 4; ++d) {
        const f32x4 a = v[2 * d], b = v[2 * d + 1];
        const float e[8] = {a.x * inv, a.y * inv, a.z * inv, a.w * inv, b.x * inv, b.y * inv, b.z * inv, b.w * inv};
        unsigned acc = 0u;
        if (isv) {
            acc = __builtin_amdgcn_cvt_scalef32_pk_fp4_f32(acc, e[0], e[1], 1.0f, 0);
            acc = __builtin_amdgcn_cvt_scalef32_pk_fp4_f32(acc, e[2], e[3], 1.0f, 1);
            acc = __builtin_amdgcn_cvt_scalef32_pk_fp4_f32(acc, e[4], e[5], 1.0f, 2);
            acc = __builtin_amdgcn_cvt_scalef32_pk_fp4_f32(acc, e[6], e[7], 1.0f, 3);
        } else {
#pragma unroll
            for (int i = 0; i < 8; ++i) {
                const int q = (int)fminf(fmaxf(rintf(e[i]), -7.f), 7.f);
                acc |= ((unsigned)q & 0xFu) << (8 * (i >> 1) + 4 * (i & 1));
            }
        }
        w[d] = acc;
    }
    o.x = w[0]; o.y = w[1]; o.z = w[2]; o.w = w[3];
    *(u32x4*)(drow + lane * 16) = o;
    *(unsigned short*)(drow + 1024 + lane * 2) = (unsigned short)sb;
}
#endif
#if GATHER_I8 && GATHER_4BIT
#ifndef TABLES_IN_GAPS
#define TABLES_IN_GAPS 1
#endif
__device__ __forceinline__ void conv4_tables(const Params& p, int r0, int r1, unsigned* ctr, unsigned char* lds) {
    const int tid = threadIdx.x, lane = tid & 63, wave = tid >> 6;
    unsigned char* ws = p.ws;
    volatile unsigned* shw = (volatile unsigned*)(lds + LDS_BYTES - 64);
    const int nchunk = (r1 - r0) / 64;
    for (int it = 0;; ++it) {
        int cbeg, cstep, cend;
        if (ctr) {
            __syncthreads();
            if (tid == 0) *shw = atomicAdd(ctr, 1u);
            __syncthreads();
            const int c = (int)*shw; if (c >= nchunk) break;
            cbeg = r0 + c * 64 + wave; cstep = NWAVES; cend = r0 + c * 64 + 64;
        } else {
            if (it > 0) break;
            cbeg = r0 + blockIdx.x * NWAVES + wave; cstep = gridDim.x * NWAVES; cend = r1;
        }
        for (int r = cbeg; r < cend; r += 2 * cstep) {
            const int r2 = r + cstep; const bool has2 = r2 < cend; const int rb = has2 ? r2 : r;
            const bool isvA = r >= 2 * NEXP, isvB = rb >= 2 * NEXP; const int rrA = isvA ? r - 2 * NEXP : r, rrB = isvB ? rb - 2 * NEXP : rb;
            const float* srowA = (isvA ? p.peer_v : p.peer_u) + (size_t)rrA * DM;
            const float* srowB = (isvB ? p.peer_v : p.peer_u) + (size_t)rrB * DM;
            f32x4 va[8], vb[8];
#pragma unroll
            for (int j = 0; j < 2; ++j)
#pragma unroll
                for (int k = 0; k < 4; ++k) { va[j * 4 + k] = *(const f32x4*)(srowA + j * 1024 + lane * 16 + k * 4); vb[j * 4 + k] = *(const f32x4*)(srowB + j * 1024 + lane * 16 + k * 4); }
            conv4_row(va, isvA, (unsigned char*)(ws + (isvA ? WS_VT : WS_UT)) + (size_t)rrA * ROW4, lane);
            if (has2) conv4_row(vb, isvB, (unsigned char*)(ws + (isvB ? WS_VT : WS_UT)) + (size_t)rrB * ROW4, lane);
        }
    }
}
#endif
__device__ __forceinline__ void ph_prologue(const Params& p, unsigned char* lds) {
    const int tid = threadIdx.x, lane = tid & 63, wave = tid >> 6;
    const int gw = blockIdx.x * NWAVES + wave, NGW = gridDim.x * NWAVES;
    unsigned char* ws = p.ws;
    {
        float* sT = (float*)lds;
        float* red = (float*)(lds + 2048 * 12 * 4);
        for (int i = tid; i < 2048 * 9; i += NTHREADS) {
            const int k = i / 9, bb = i % 9;
            const float v = bb < 8 ? p.c[bb * DM + k] : p.c_ctx[k];
            sT[k * 12 + bb] = silu(v);
        }
        __syncthreads();
        const int cq = lane & 7, ks = tid >> 3;
        for (int u = blockIdx.x; u < 768; u += gridDim.x) {
            const int l = u / 384, n0 = (u % 384) * 32;
            const float* W = p.w_ada + (size_t)l * DM * 12288 + n0 + cq * 4;
            float acc[9][4];
#pragma unroll
            for (int b = 0; b < 9; ++b)
#pragma unroll
                for (int j = 0; j < 4; ++j) acc[b][j] = 0.f;
#pragma unroll 8
            for (int i = 0; i < 32; ++i) {
                const int k = ks + 64 * i;
                const f32x4 w = *(const f32x4*)(W + (size_t)k * 12288);
                const f32x4 s0 = *(const f32x4*)(sT + k * 12), s1 = *(const f32x4*)(sT + k * 12 + 4);
                const float s8 = sT[k * 12 + 8];
                const float sv[9] = {s0.x, s0.y, s0.z, s0.w, s1.x, s1.y, s1.z, s1.w, s8};
#pragma unroll
                for (int b = 0; b < 9; ++b) { acc[b][0] += sv[b] * w.x; acc[b][1] += sv[b] * w.y; acc[b][2] += sv[b] * w.z; acc[b][3] += sv[b] * w.w; }
            }
#pragma unroll
            for (int b = 0; b < 9; ++b)
#pragma unroll
                for (int j = 0; j < 4; ++j) {
                    float v = acc[b][j];
                    v += __shfl_xor(v, 8); v += __shfl_xor(v, 16); v += __shfl_xor(v, 32);
                    acc[b][j] = v;
                }
            if (lane < 8) {
#pragma unroll
                for (int b = 0; b < 9; ++b)
#pragma unroll
                    for (int j = 0; j < 4; ++j) red[(wave * 8 + cq) * 36 + b * 4 + j] = acc[b][j];
            }
            __syncthreads();
            if (tid < 288) {
                const int b = tid / 32, col = tid % 32, q = col >> 2, j = col & 3;
                float s = 0.f;
#pragma unroll
                for (int w = 0; w < 8; ++w) s += red[(w * 8 + q) * 36 + b * 4 + j];
                const int n = n0 + col;
                ((float*)(ws + WS_MOD))[(size_t)(l * 9 + b) * 12288 + n] = s + p.b_ada[l * 12288 + n];
            }
            __syncthreads();
        }
    }
    __syncthreads();
#if GEMM_I8 && GEMM3_I8 && W8_ONEPASS
    {
        float* S = (float*)(ws + WS_SCL);
        constexpr int ST_IN = INW / 32, ST_SQ = DM / 32, ST_L = ST_IN + 2 * ST_SQ;
        for (int it = blockIdx.x; it < 2 * ST_L; it += gridDim.x) {
            const int l = it / ST_L; int r = it % ST_L;
            if (r < ST_IN) { w8_strip(p.w_in + (size_t)l * DM * INW, INW, r * 32, nullptr, (unsigned char*)(ws + WS_WIN) + (size_t)l * INW * DM, S + SCL_WIN + l * INW, lds); continue; }
            r -= ST_IN;
            if (r < ST_SQ) { w8_strip(p.w_out + (size_t)l * DM * DM, DM, r * 32, p.g_group + l * DM, (unsigned char*)(ws + WS_WOUT) + (size_t)l * DM * DM, S + SCL_WOUT + l * DM, lds); continue; }
            r -= ST_SQ;
            w8_strip(p.peer_wq + (size_t)l * DM * DM, DM, r * 32, nullptr, (unsigned char*)(ws + WS_WQ) + (size_t)l * DM * DM, S + SCL_WQ + l * DM, lds);
        }
        __syncthreads();
    }
#else
    {
        float* scr = (float*)(lds + wave * 8704);
        constexpr int I_IN = 32 * 112, I_SQ = 32 * 64, I_L = I_IN + 2 * I_SQ;
        unsigned* cm = (unsigned*)(ws + WS_CTL + CTL_COLMAX);
        for (int it = gw; it < 2 * I_L; it += NGW) {
            const int l = it / I_L; int r = it % I_L;
            if (r < I_IN) {
                if (GEMM_I8) colmax_item(p.w_in + (size_t)l * DM * INW, INW, nullptr, cm + l * NCM, r, lane);
                else transpose_item(p.w_in + (size_t)l * DM * INW, DM, INW, (bf16_t*)(ws + WS_WIN) + (size_t)l * INW * DM, nullptr, scr, r, lane);
                continue; }
            r -= I_IN;
            if (r < I_SQ) {
                if (GEMM_I8) colmax_item(p.w_out + (size_t)l * DM * DM, DM, p.g_group + l * DM, cm + l * NCM + INW, r, lane);
                else transpose_item(p.w_out + (size_t)l * DM * DM, DM, DM, (bf16_t*)(ws + WS_WOUT) + (size_t)l * DM * DM, p.g_group + l * DM, scr, r, lane);
                continue; }
            r -= I_SQ;
            if (GEMM_I8 && GEMM3_I8) colmax_item(p.peer_wq + (size_t)l * DM * DM, DM, nullptr, cm + l * NCM + INW + DM, r, lane);
            else transpose_item(p.peer_wq + (size_t)l * DM * DM, DM, DM, (bf16_t*)(ws + WS_WQ) + (size_t)l * DM * DM, nullptr, scr, r, lane);
        }
    }
#endif
    {
        const size_t gtid = (size_t)blockIdx.x * NTHREADS + tid, gth = (size_t)gridDim.x * NTHREADS;
        cvt_range(p.peer_keys, (bf16_t*)(ws + WS_KEYS), (size_t)2 * 8 * 2 * 128 * 128 / 8, gtid, gth);
        cvt_range(p.ws_c, (bf16_t*)(ws + WS_WSC), (size_t)2 * 4 * 128 * 128 / 8, gtid, gth);
#if GATHER_I8 && GATHER_4BIT
        if (!TABLES_IN_GAPS) conv4_tables(p, 0, 4 * NEXP, nullptr, lds);
#elif GATHER_I8
        for (int r = gw; r < 4 * NEXP; r += NGW) {
            const bool isv = r >= 2 * NEXP; const int rr = isv ? r - 2 * NEXP : r;
            const float* srow = (isv ? p.peer_v : p.peer_u) + (size_t)rr * DM;
            f32x4 v[8]; float am = 0.f;
#pragma unroll
            for (int j = 0; j < 2; ++j)
#pragma unroll
                for (int k = 0; k < 4; ++k) {
                    v[j * 4 + k] = *(const f32x4*)(srow + j * 1024 + lane * 16 + k * 4);
                    am = fmaxf(am, fmaxf(fmaxf(fabsf(v[j * 4 + k].x), fabsf(v[j * 4 + k].y)), fmaxf(fabsf(v[j * 4 + k].z), fabsf(v[j * 4 + k].w))));
                }
            am = wave_max(am);
            const float s = am > 0.f ? am * (isv ? (1.f / 443.f) : (1.f / 127.f)) : 1.f, inv = 1.f / s;
            unsigned char* drow = (unsigned char*)(ws + (isv ? WS_VT : WS_UT)) + (size_t)rr * DM;
#pragma unroll
            for (int j = 0; j < 2; ++j) {
                u32x4 o; unsigned w[4];
#pragma unroll
                for (int k = 0; k < 4; ++k) {
                    const f32x4 a = v[j * 4 + k];
                    if (isv) {
                        int pk = __builtin_amdgcn_cvt_pk_fp8_f32(a.x * inv, a.y * inv, 0, false);
                        pk = __builtin_amdgcn_cvt_pk_fp8_f32(a.z * inv, a.w * inv, pk, true);
                        w[k] = (unsigned)pk;
                    } else {
                        const int q0 = (int)rintf(a.x * inv), q1 = (int)rintf(a.y * inv), q2 = (int)rintf(a.z * inv), q3 = (int)rintf(a.w * inv);
                        w[k] = ((unsigned)q0 & 0xffu) | (((unsigned)q1 & 0xffu) << 8) | (((unsigned)q2 & 0xffu) << 16) | ((unsigned)q3 << 24);
                    }
                }
                o.x = w[0]; o.y = w[1]; o.z = w[2]; o.w = w[3];
                *(u32x4*)(drow + j * 1024 + lane * 16) = o;
            }
            if (lane == 0) ((float*)(ws + (isv ? WS_VSC : WS_USC)))[rr] = s;
        }
#else
        cvt_range(p.peer_u, (bf16_t*)(ws + WS_UT), (size_t)2 * NEXP * DM / 8, gtid, gth);
        cvt_range(p.peer_v, (bf16_t*)(ws + WS_VT), (size_t)2 * NEXP * DM / 8, gtid, gth);
#endif
        float* rope = (float*)(ws + WS_ROPE);
        for (size_t i = gtid; i < (size_t)2048 * 64; i += gth) {
            const int t = (int)(i >> 6), f = (int)(i & 63), fi = f & 31;
            const float pos = (f < 32) ? (float)(t >> 6) : (float)(t & 63);
            const float inv = powf(10000.0f, -(float)fi / 32.0f);
            const float ang = pos * inv;
            rope[i * 2] = cosf(ang); rope[i * 2 + 1] = sinf(ang);
        }
    }
}


__device__ __forceinline__ void modulate_store(const f32x4 (&v)[8], float rstd, const float* g, const float* shift, const float* scale, bf16_t* dst, int lane) {
#pragma unroll
    for (int j = 0; j < 8; ++j) {
        const int col = j * 256 + lane * 4;
        const f32x4 gg = *(const f32x4*)(g + col), sc = *(const f32x4*)(scale + col), sh = *(const f32x4*)(shift + col);
        const f32x4 o = v[j] * rstd * gg * (1.f + sc) + sh;
        u32x2 w; w.x = pk2(o.x, o.y); w.y = pk2(o.z, o.w);
        *(u32x2*)(dst + col) = w;
    }
}
__device__ __forceinline__ void modulate_store_i8(const f32x4 (&v)[8], float rstd, const float* g, const float* shift, const float* scale, unsigned char* dst, float* sdst, int lane, const float levels) {
    f32x4 o[8]; float am = 0.f;
#pragma unroll
    for (int j = 0; j < 8; ++j) {
        const int col = j * 256 + lane * 4;
        const f32x4 gg = *(const f32x4*)(g + col), sc = *(const f32x4*)(scale + col), sh = *(const f32x4*)(shift + col);
        o[j] = v[j] * rstd * gg * (1.f + sc) + sh;
        am = fmaxf(am, fmaxf(fmaxf(fabsf(o[j].x), fabsf(o[j].y)), fmaxf(fabsf(o[j].z), fabsf(o[j].w))));
    }
    am = wave_max(am);
    const float s = am > 0.f ? am / levels : 1.f, inv = 1.f / s;
#pragma unroll
    for (int j = 0; j < 8; ++j) *(unsigned*)(dst + j * 256 + lane * 4) = q8pack4(o[j].x, o[j].y, o[j].z, o[j].w, inv);
    if (lane == 0) *sdst = s;
}
__device__ __forceinline__ void ph_modulate(const Params& p, int l, int which) {
    const int tid = threadIdx.x, lane = tid & 63, wave = tid >> 6;
    const int gw = blockIdx.x * NWAVES + wave, NGW = gridDim.x * NWAVES;
    const int nrows = (which == 1 && l == DEPTH - 1) ? NLAT : MTOT;
    const float* g = (which == 0 ? p.norm1_g : p.norm2_g) + l * DM;
    const float* mod = (const float*)(p.ws + WS_MOD) + (size_t)l * 9 * 12288;
    const float* srcLat = (which == 0 && l == 0) ? p.x : p.out;
    const float* srcCtx = (which == 0 && l == 0) ? p.ctx : (const float*)(p.ws + WS_HC);
    bf16_t* XN = (bf16_t*)(p.ws + WS_XN);
    const int moff = (which == 0 ? 0 : 3) * DM;
#pragma unroll 1
    for (int r = gw; r < nrows; r += 2 * NGW) {
        const int r2 = r + NGW; const bool has2 = r2 < nrows; const int rb = has2 ? r2 : r;
        const float* srcA = r < NLAT ? srcLat + (size_t)r * DM : srcCtx + (size_t)(r - NLAT) * DM;
        const float* srcB = rb < NLAT ? srcLat + (size_t)rb * DM : srcCtx + (size_t)(rb - NLAT) * DM;
        f32x4 va[8], vb[8]; float sa = 0.f, sb = 0.f;
        if (H_BF16 && GEMM_I8 && GEMM3_I8 && which == 1) {
            const bf16_t* HB = (const bf16_t*)(p.ws + WS_HB);
#pragma unroll
            for (int j = 0; j < 8; ++j) {
                const u32x2 ra = *(const u32x2*)(HB + (size_t)r * DM + j * 256 + lane * 4), rb2 = *(const u32x2*)(HB + (size_t)rb * DM + j * 256 + lane * 4);
                va[j] = (f32x4){bflo(ra.x), bfhi(ra.x), bflo(ra.y), bfhi(ra.y)}; vb[j] = (f32x4){bflo(rb2.x), bfhi(rb2.x), bflo(rb2.y), bfhi(rb2.y)};
            }
        } else {
#pragma unroll
        for (int j = 0; j < 8; ++j) { va[j] = *(const f32x4*)(srcA + j * 256 + lane * 4); vb[j] = *(const f32x4*)(srcB + j * 256 + lane * 4); }
        }
#pragma unroll
        for (int j = 0; j < 8; ++j) { sa += va[j].x * va[j].x + va[j].y * va[j].y + va[j].z * va[j].z + va[j].w * va[j].w; sb += vb[j].x * vb[j].x + vb[j].y * vb[j].y + vb[j].z * vb[j].z + vb[j].w * vb[j].w; }
        sa = wave_sum(sa); sb = wave_sum(sb);
        const float* shA = mod + (size_t)(r < NLAT ? (r >> 11) : 8) * 12288 + moff;
        const bool i8 = GEMM_I8 && (which == 0 || GEMM3_I8); const float lv = which == 0 ? 127.f : 119.f;
        unsigned char* XN8 = (unsigned char*)(p.ws + WS_XN8); float* SXN = (float*)(p.ws + WS_SCL) + SCL_XN;
        if (i8) modulate_store_i8(va, rsqrtf(sa * (1.f / DM) + EPS), g, shA, shA + DM, XN8 + (size_t)r * DM, SXN + r, lane, lv);
        else modulate_store(va, rsqrtf(sa * (1.f / DM) + EPS), g, shA, shA + DM, XN + (size_t)r * DM, lane);
        if (has2) {
            const float* shB = mod + (size_t)(r2 < NLAT ? (r2 >> 11) : 8) * 12288 + moff;
            if (i8) modulate_store_i8(vb, rsqrtf(sb * (1.f / DM) + EPS), g, shB, shB + DM, XN8 + (size_t)r2 * DM, SXN + r2, lane, lv);
            else modulate_store(vb, rsqrtf(sb * (1.f / DM) + EPS), g, shB, shB + DM, XN + (size_t)r2 * DM, lane);
        }
    }
}

struct EpiBf16Store {
    bf16_t* O; int ldc;
    __device__ __forceinline__ void operator()(int row, int col, const float* a) const {
        u32x4 w; w.x = pk2(a[0], a[1]); w.y = pk2(a[2], a[3]); w.z = pk2(a[4], a[5]); w.w = pk2(a[6], a[7]);
        *(u32x4*)(O + (size_t)row * ldc + col) = w;
    }
};
struct EpiResGate {
    const float *resLat, *resCtx; float *outLat, *outCtx; const float* gate;
    __device__ __forceinline__ void operator()(int row, int col, const float* a) const {
        const int bb = row < NLAT ? (row >> 11) : 8;
        const float* gp = gate + (size_t)bb * 12288 + col;
        const float* rp = row < NLAT ? resLat + (size_t)row * DM + col : resCtx + (size_t)(row - NLAT) * DM + col;
        float* op = row < NLAT ? outLat + (size_t)row * DM + col : outCtx + (size_t)(row - NLAT) * DM + col;
        const f32x4 g0 = *(const f32x4*)gp, g1 = *(const f32x4*)(gp + 4), r0 = *(const f32x4*)rp, r1 = *(const f32x4*)(rp + 4);
        f32x4 o0, o1;
        o0.x = r0.x + g0.x * a[0]; o0.y = r0.y + g0.y * a[1]; o0.z = r0.z + g0.z * a[2]; o0.w = r0.w + g0.w * a[3];
        o1.x = r1.x + g1.x * a[4]; o1.y = r1.y + g1.y * a[5]; o1.z = r1.z + g1.z * a[6]; o1.w = r1.w + g1.w * a[7];
        *(f32x4*)op = o0; *(f32x4*)(op + 4) = o1;
    }
};
template <class Epi>
__device__ __forceinline__ void gemm_naive(unsigned char* lds, const bf16_t* A, const bf16_t* Bt, int M, int N, int K, const Epi& E) {
    float* As = (float*)lds;
    float* Bs = As + 32 * 132;
    const int tid = threadIdx.x, tx = tid & 15, ty = tid >> 4;
    const int lrow = tid >> 2, lkc = (tid & 3) * 8;
    const int nM = M / 128, nN = N / 128;
    for (int u = blockIdx.x; u < nM * nN; u += gridDim.x) {
        const int pm = u / nN, pn = u % nN, m0 = pm * 128, n0 = pn * 128;
        float acc[4][8];
#pragma unroll
        for (int i = 0; i < 4; ++i)
#pragma unroll
            for (int j = 0; j < 8; ++j) acc[i][j] = 0.f;
        for (int k0 = 0; k0 < K; k0 += 32) {
            const u32x4 av = *(const u32x4*)(A + (size_t)(m0 + lrow) * K + k0 + lkc);
            const u32x4 bv = *(const u32x4*)(Bt + (size_t)(n0 + lrow) * K + k0 + lkc);
            __syncthreads();
            As[(lkc + 0) * 132 + lrow] = bflo(av.x); As[(lkc + 1) * 132 + lrow] = bfhi(av.x);
            As[(lkc + 2) * 132 + lrow] = bflo(av.y); As[(lkc + 3) * 132 + lrow] = bfhi(av.y);
            As[(lkc + 4) * 132 + lrow] = bflo(av.z); As[(lkc + 5) * 132 + lrow] = bfhi(av.z);
            As[(lkc + 6) * 132 + lrow] = bflo(av.w); As[(lkc + 7) * 132 + lrow] = bfhi(av.w);
            Bs[(lkc + 0) * 132 + lrow] = bflo(bv.x); Bs[(lkc + 1) * 132 + lrow] = bfhi(bv.x);
            Bs[(lkc + 2) * 132 + lrow] = bflo(bv.y); Bs[(lkc + 3) * 132 + lrow] = bfhi(bv.y);
            Bs[(lkc + 4) * 132 + lrow] = bflo(bv.z); Bs[(lkc + 5) * 132 + lrow] = bfhi(bv.z);
            Bs[(lkc + 6) * 132 + lrow] = bflo(bv.w); Bs[(lkc + 7) * 132 + lrow] = bfhi(bv.w);
            __syncthreads();
#pragma unroll 8
            for (int k = 0; k < 32; ++k) {
                const f32x4 a = *(const f32x4*)(As + k * 132 + ty * 4);
                const f32x4 b0 = *(const f32x4*)(Bs + k * 132 + tx * 8), b1 = *(const f32x4*)(Bs + k * 132 + tx * 8 + 4);
                const float av4[4] = {a.x, a.y, a.z, a.w};
                const float bv8[8] = {b0.x, b0.y, b0.z, b0.w, b1.x, b1.y, b1.z, b1.w};
#pragma unroll
                for (int i = 0; i < 4; ++i)
#pragma unroll
                    for (int j = 0; j < 8; ++j) acc[i][j] += av4[i] * bv8[j];
            }
        }
#pragma unroll
        for (int i = 0; i < 4; ++i) E(m0 + ty * 4 + i, n0 + tx * 8, acc[i]);
    }
}

namespace pg8 {
#define PG8_LAS __attribute__((address_space(3)))
typedef unsigned short bf16_t;
typedef short bf16x8 __attribute__((ext_vector_type(8)));
typedef float f32x4 __attribute__((ext_vector_type(4)));
typedef unsigned u32x4 __attribute__((ext_vector_type(4)));
constexpr int BM = 256, BK = 64, HALF = 128, HTB = HALF * BK * 2  , STAGE_BYTES = 8 * HTB, NXCD = 8, WGM = 8;

__host__ __device__ __forceinline__ int lds_byte(int r, int c) { const int st = (r >> 4) * 2 + (c >> 5), rr = r & 15, cc = c & 31, ob = rr * 64 + cc * 2; return st * 1024 + (ob ^ (((ob >> 9) & 1) << 5)); }
__host__ __device__ __forceinline__ void stage_rc(int b, int& R, int& C) { const int st = b / 1024, sb = b % 1024, swz = sb ^ (((sb >> 9) & 1) << 5); R = (st >> 1) * 16 + swz / 64; C = (st & 1) * 32 + (swz % 64) / 2; }
__host__ __device__ __forceinline__ int perm32(int rho) { const int n = rho >> 4, i = rho & 15; return 8 * (i >> 2) + 4 * n + (i & 3); }

struct Unit { int pm, pn; };
struct Gemm { const bf16_t* A; const bf16_t* Bt; int M, N, K; };

struct StaticOrder {
    int nM, nN, nwg, G, c;
    __host__ __device__ void init(int M, int N, int G_, int c_) { nM = M / BM; nN = N / BM; nwg = nM * nN; G = G_; c = c_; }
    __host__ __device__ bool next(int i, Unit& u) const {
        const long L = (long)i * G + c; if (L >= nwg) return false;
        int wgid = (int)L; { const int q = nwg / NXCD, r = nwg % NXCD, xcd = wgid % NXCD, off = wgid / NXCD; wgid = (xcd < r ? xcd * (q + 1) : r * (q + 1) + (xcd - r) * q) + off; }
        const int nig = WGM * nN, gid = wgid / nig, fm = gid * WGM, gsz = (nM - fm) < WGM ? (nM - fm) : WGM;
        u.pm = fm + ((wgid % nig) % gsz); u.pn = (wgid % nig) / gsz; return true;
    }
    __device__ __forceinline__ void a_ready(const Unit&) const {}
    __device__ __forceinline__ void done(const Unit&) const {}
};

__device__ __forceinline__ unsigned cvt_pk_bf16(float lo, float hi) { unsigned r; asm volatile("v_cvt_pk_bf16_f32 %0, %1, %2" : "=v"(r) : "v"(lo), "v"(hi)); return r; }
typedef float f32x2 __attribute__((ext_vector_type(2)));
__device__ __forceinline__ f32x2 gelu_pk(f32x2 v) {
    const f32x2 av = __builtin_elementwise_abs(v), d = av * 0.2316418882f + 1.0f;
    f32x2 t; t.x = __builtin_amdgcn_rcpf(d.x); t.y = __builtin_amdgcn_rcpf(d.y);
    f32x2 q = t * 0.5307027145f + (-0.7265760135f); q = q * t + 0.7107068705f; q = q * t + (-0.142248368f); q = q * t + 0.127414796f; q = q * t;
    const f32x2 s = (v * v) * (-0.72134752044f);
    f32x2 e; e.x = __builtin_amdgcn_exp2f(s.x); e.y = __builtin_amdgcn_exp2f(s.y);
    const f32x2 m = v * (q * e), r = v - m;
    f32x2 o; o.x = v.x < 0.f ? m.x : r.x; o.y = v.y < 0.f ? m.y : r.y; return o;
}

template <int ACT  > struct EpiBf16 {
    static constexpr bool PERM = true, AFTER_DRAIN = false; static_assert(ACT == 0 || ACT == 1, "EpiBf16: ACT is 0 (none) or 1 (gelu_pk)");
    bf16_t* O; int ldc; const float* bias; int split_cols; size_t split_stride; float scale0;
    __device__ __forceinline__ void operator()(const f32x4 (&acc)[2][2][4][2], const Unit& u, int wr, int wc, int fr, int fq) const {
        const int row0 = u.pm * BM + wr * 64 + fr; int colt = u.pn * BM; bf16_t* base = O;
        float sc = 1.f; if (split_cols) { const int t = colt / split_cols; base += (size_t)t * split_stride; colt -= t * split_cols; if (t == 0) sc = scale0; }
        const int col0 = colt + wc * 32 + 8 * fq, bcol0 = u.pn * BM + wc * 32 + 8 * fq;
        f32x4 bv[2][2];
#pragma unroll
        for (int bj = 0; bj < 2; ++bj)
#pragma unroll
            for (int n = 0; n < 2; ++n) bv[bj][n] = bias ? *(const f32x4*)(bias + bcol0 + bj * HALF + 4 * n) : (f32x4){0.f, 0.f, 0.f, 0.f};
#pragma unroll
        for (int ai = 0; ai < 2; ++ai)
#pragma unroll
            for (int m = 0; m < 4; ++m) { bf16_t* rowp = base + (size_t)(row0 + ai * HALF + m * 16) * ldc + col0;
#pragma unroll
                for (int bj = 0; bj < 2; ++bj) { f32x4 v0 = acc[ai][bj][m][0] + bv[bj][0], v1 = acc[ai][bj][m][1] + bv[bj][1];
                    if (ACT == 1) { f32x2 a = gelu_pk((f32x2){v0[0], v0[1]}), b = gelu_pk((f32x2){v0[2], v0[3]}), c = gelu_pk((f32x2){v1[0], v1[1]}), d = gelu_pk((f32x2){v1[2], v1[3]});
                        v0 = (f32x4){a.x, a.y, b.x, b.y}; v1 = (f32x4){c.x, c.y, d.x, d.y}; }
                    v0 = v0 * sc; v1 = v1 * sc; u32x4 w; w.x = cvt_pk_bf16(v0[0], v0[1]); w.y = cvt_pk_bf16(v0[2], v0[3]); w.z = cvt_pk_bf16(v1[0], v1[1]); w.w = cvt_pk_bf16(v1[2], v1[3]);
                    *(u32x4*)(rowp + bj * HALF) = w; } }
    }
};
typedef int i32x4 __attribute__((ext_vector_type(4)));
template <bool I8> struct AccSel { typedef f32x4 type; };
template <> struct AccSel<true> { typedef i32x4 type; };
template <class Epi, class Sched, bool ALIGN_EPI = false, bool SP2 = false, bool I8 = false>
__device__ __forceinline__ void gemm_phase(PG8_LAS unsigned char* lds, const Gemm g, const Sched& S, const Epi& E) {
    const int tid = threadIdx.x, wid = __builtin_amdgcn_readfirstlane(tid >> 6), lane = tid & 63, wr = wid >> 2, wc = wid & 3, fr = lane & 15, fq = lane >> 4;
    const int K = g.K, nt = K / BK;
    unsigned voffA[2], voffB[2];
#pragma unroll
    for (int i = 0; i < 2; ++i) { int R, C; stage_rc(tid * 16 + i * 8192, R, C); const int Rb = Epi::PERM ? ((R & ~31) + perm32(R & 31)) : R;
        voffA[i] = (unsigned)(R * K + C) * 2u; voffB[i] = (unsigned)(Rb * K + C) * 2u; }
    const size_t kstep = (size_t)(BK * 2);
    const size_t hstep = (size_t)HALF * K * 2;
    const size_t tstep = 2 * hstep;
    const unsigned ldsw = (unsigned)wid * 1024u;
    const int aoff = lds_byte(wr * 64 + fr, fq * 8), boff = lds_byte(wc * 32 + fr, fq * 8);
#define PG8_SA(b, h) (((b) * 2 + (h)) * HTB)
#define PG8_SB(b, h) ((4 + (b) * 2 + (h)) * HTB)
#define PG8_STAGE(bufoff, gbase, voff) do { _Pragma("unroll") for (int _i = 0; _i < 2; ++_i) \
        __builtin_amdgcn_global_load_lds((const unsigned*)((const char*)(gbase) + (voff)[_i]), (PG8_LAS unsigned*)(lds + (bufoff) + ldsw + _i * 8192), 16, 0, 0); } while (0)
#define PG8_LDA(dst, b, h) do { _Pragma("unroll") for (int m = 0; m < 4; ++m) _Pragma("unroll") for (int k = 0; k < 2; ++k) dst[m][k] = *(const PG8_LAS bf16x8*)(lds + PG8_SA(b, h) + aoff + m * 2048 + k * 1024); } while (0)
#define PG8_LDB(dst, b, h) do { _Pragma("unroll") for (int n = 0; n < 2; ++n) _Pragma("unroll") for (int k = 0; k < 2; ++k) dst[n][k] = *(const PG8_LAS bf16x8*)(lds + PG8_SB(b, h) + boff + n * 2048 + k * 1024); } while (0)
#define PG8_MMA(ai, bj, At, Bt) do { __builtin_amdgcn_s_setprio(1); _Pragma("unroll") for (int m = 0; m < 4; ++m) _Pragma("unroll") for (int n = 0; n < 2; ++n) _Pragma("unroll") for (int k = 0; k < 2; ++k) \
        { if constexpr (I8) acc[ai][bj][m][n] = __builtin_amdgcn_mfma_i32_16x16x64_i8(__builtin_bit_cast(i32x4, Bt[n][k]), __builtin_bit_cast(i32x4, At[m][k]), acc[ai][bj][m][n], 0, 0, 0); \
          else acc[ai][bj][m][n] = __builtin_amdgcn_mfma_f32_16x16x32_bf16(Bt[n][k], At[m][k], acc[ai][bj][m][n], 0, 0, 0); } __builtin_amdgcn_s_setprio(0); } while (0)
#define PG8_WAIT_V(n) asm volatile("s_waitcnt vmcnt(" #n ")" ::: "memory")
#define PG8_WAIT_L(n) asm volatile("s_waitcnt lgkmcnt(" #n ")" ::: "memory")
#define PG8_BAR __builtin_amdgcn_s_barrier()
#define PG8_SCHED __builtin_amdgcn_sched_barrier(0)
    Unit cur, nxt; int ui = 0;
    if (!S.next(0, cur)) return;
    typedef typename AccSel<I8>::type acc_t; const acc_t zero_ = {};
    acc_t acc[2][2][4][2];
#pragma unroll
    for (int a = 0; a < 2; ++a)
#pragma unroll
        for (int b = 0; b < 2; ++b)
#pragma unroll
            for (int m = 0; m < 4; ++m)
#pragma unroll
                for (int n = 0; n < 2; ++n) acc[a][b][m][n] = zero_;
    bf16x8 At[4][2], B0[2][2], B1[2][2];
    const char* cA = (const char*)g.A + (size_t)cur.pm * tstep; const char* cB = (const char*)g.Bt + (size_t)cur.pn * tstep;
    S.a_ready(cur);
    if constexpr (SP2) {
        PG8_STAGE(PG8_SB(0, 0), cB, voffB); PG8_STAGE(PG8_SB(0, 1), cB + hstep, voffB); PG8_STAGE(PG8_SA(0, 0), cA, voffA); PG8_STAGE(PG8_SA(0, 1), cA + hstep, voffA);
        if (wr == 1) PG8_BAR;
        PG8_WAIT_V(2); PG8_BAR;
        PG8_STAGE(PG8_SB(1, 0), cB + kstep, voffB); PG8_STAGE(PG8_SA(1, 0), cA + kstep, voffA); PG8_STAGE(PG8_SB(1, 1), cB + hstep + kstep, voffB);
        PG8_WAIT_V(6); PG8_BAR;
    } else {
        PG8_STAGE(PG8_SB(0, 0), cB, voffB); PG8_STAGE(PG8_SA(0, 0), cA, voffA); PG8_STAGE(PG8_SB(0, 1), cB + hstep, voffB); PG8_STAGE(PG8_SA(0, 1), cA + hstep, voffA);
        if (wr == 1) PG8_BAR;
        PG8_WAIT_V(4); PG8_BAR;
        PG8_STAGE(PG8_SB(1, 0), cB + kstep, voffB); PG8_STAGE(PG8_SA(1, 0), cA + kstep, voffA); PG8_STAGE(PG8_SB(1, 1), cB + hstep + kstep, voffB);
        PG8_WAIT_V(6); PG8_BAR;
    }
    for (;;) {
        const bool has_next = S.next(ui + 1, nxt);
        const char* nA = has_next ? (const char*)g.A + (size_t)nxt.pm * tstep : cA; const char* nB = has_next ? (const char*)g.Bt + (size_t)nxt.pn * tstep : cB;
        for (int t = 0; t < nt; t += 2) {
            const bool last = (t == nt - 2);
            const char* a1 = cA + (size_t)(t + 1) * kstep;
            const char* a2 = last ? nA : cA + (size_t)(t + 2) * kstep; const char* b2 = last ? nB : cB + (size_t)(t + 2) * kstep;
            const char* a3 = a2 + kstep; const char* b3 = b2 + kstep;
            if (last && has_next) S.a_ready(nxt);
            if constexpr (SP2) {
            PG8_LDB(B0, 0, 0); PG8_LDB(B1, 0, 1); PG8_SCHED; PG8_LDA(At, 0, 0); PG8_STAGE(PG8_SA(1, 1), a1 + hstep, voffA);
            PG8_WAIT_V(8); PG8_WAIT_L(0); PG8_BAR; PG8_MMA(0, 0, At, B0); PG8_MMA(0, 1, At, B1); PG8_BAR; PG8_SCHED;
            PG8_LDA(At, 0, 1); PG8_STAGE(PG8_SB(0, 0), b2, voffB); PG8_STAGE(PG8_SB(0, 1), b2 + hstep, voffB); PG8_STAGE(PG8_SA(0, 0), a2, voffA);
            PG8_WAIT_V(8); PG8_WAIT_L(0); PG8_BAR; PG8_MMA(1, 0, At, B0); PG8_MMA(1, 1, At, B1); PG8_BAR; PG8_SCHED;
            PG8_LDB(B0, 1, 0); PG8_LDB(B1, 1, 1); PG8_SCHED; PG8_LDA(At, 1, 0); PG8_STAGE(PG8_SA(0, 1), a2 + hstep, voffA);
            PG8_WAIT_V(8); PG8_WAIT_L(0); PG8_BAR; PG8_MMA(0, 0, At, B0); PG8_MMA(0, 1, At, B1); PG8_BAR; PG8_SCHED;
            PG8_LDA(At, 1, 1); PG8_STAGE(PG8_SB(1, 0), b3, voffB); PG8_STAGE(PG8_SB(1, 1), b3 + hstep, voffB); PG8_STAGE(PG8_SA(1, 0), a3, voffA);
            PG8_WAIT_V(8); PG8_WAIT_L(0); PG8_BAR; PG8_MMA(1, 0, At, B0); PG8_MMA(1, 1, At, B1); PG8_BAR; PG8_SCHED;
            } else {
            PG8_LDB(B0, 0, 0); PG8_SCHED; PG8_LDA(At, 0, 0); PG8_STAGE(PG8_SA(1, 1), a1 + hstep, voffA);
            PG8_WAIT_L(8); PG8_BAR; PG8_WAIT_L(0); PG8_MMA(0, 0, At, B0); PG8_BAR; PG8_SCHED;
            PG8_LDB(B1, 0, 1); PG8_STAGE(PG8_SB(0, 0), b2, voffB);
            PG8_BAR; PG8_WAIT_L(0); PG8_MMA(0, 1, At, B1); PG8_BAR;
            PG8_LDA(At, 0, 1); PG8_STAGE(PG8_SA(0, 0), a2, voffA);
            PG8_BAR; PG8_WAIT_L(0); PG8_MMA(1, 0, At, B0); PG8_BAR; PG8_SCHED;
            PG8_STAGE(PG8_SB(0, 1), b2 + hstep, voffB);
            PG8_WAIT_V(6); PG8_BAR; PG8_MMA(1, 1, At, B1); PG8_BAR;
            PG8_LDB(B0, 1, 0); PG8_SCHED; PG8_LDA(At, 1, 0); PG8_STAGE(PG8_SA(0, 1), a2 + hstep, voffA);
            PG8_WAIT_L(8); PG8_BAR; PG8_WAIT_L(0); PG8_MMA(0, 0, At, B0); PG8_BAR; PG8_SCHED;
            PG8_LDB(B1, 1, 1); PG8_STAGE(PG8_SB(1, 0), b3, voffB);
            PG8_BAR; PG8_WAIT_L(0); PG8_MMA(0, 1, At, B1); PG8_BAR;
            PG8_LDA(At, 1, 1); PG8_STAGE(PG8_SA(1, 0), a3, voffA);
            PG8_BAR; PG8_WAIT_L(0); PG8_MMA(1, 0, At, B0); PG8_BAR; PG8_SCHED;
            PG8_STAGE(PG8_SB(1, 1), b3 + hstep, voffB);
            PG8_WAIT_V(6); PG8_BAR; PG8_MMA(1, 1, At, B1); PG8_BAR;
            }
        }
        if constexpr (ALIGN_EPI) { if (wr == 0) PG8_BAR; }
        if constexpr (!Epi::AFTER_DRAIN) { E(acc, cur, wr, wc, fr, fq); S.done(cur); }
        if (!has_next) break;
#pragma unroll
        for (int a = 0; a < 2; ++a)
#pragma unroll
            for (int b = 0; b < 2; ++b)
#pragma unroll
                for (int m = 0; m < 4; ++m)
#pragma unroll
                    for (int n = 0; n < 2; ++n) acc[a][b][m][n] = zero_;
        cur = nxt; cA = nA; cB = nB; ++ui;
        if constexpr (ALIGN_EPI) { if (wr == 1) PG8_BAR; }
    }
    PG8_WAIT_V(0);
    if constexpr (!ALIGN_EPI) { if (wr == 0) PG8_BAR; }
    PG8_BAR;
    if constexpr (Epi::AFTER_DRAIN) { E.fused(acc, cur, wr, wc, fr, fq, lds, wid, lane); S.done(cur); }
#undef PG8_SA
#undef PG8_SB
#undef PG8_STAGE
#undef PG8_LDA
#undef PG8_LDB
#undef PG8_MMA
#undef PG8_WAIT_V
#undef PG8_WAIT_L
#undef PG8_BAR
#undef PG8_SCHED
}

struct EpiResGateT {
    static constexpr bool PERM = false, AFTER_DRAIN = false;
    const float *resLat, *resCtx; float *outLat, *outCtx; const float* gate;
    __device__ __forceinline__ void operator()(const f32x4 (&acc)[2][2][4][2], const Unit& u, int wr, int wc, int fr, int fq) const {
        const int trow = u.pm * BM, row0 = trow + wr * 64 + fr, col0 = u.pn * BM + wc * 32 + 4 * fq;
        const bool lat = trow < 16384;
        const int bb = lat ? (trow >> 11) : 8;
        const float* rbase = lat ? resLat + (size_t)row0 * 2048 : resCtx + (size_t)(row0 - 16384) * 2048;
        float* obase = lat ? outLat + (size_t)row0 * 2048 : outCtx + (size_t)(row0 - 16384) * 2048;
        f32x4 gv[2][2];
#pragma unroll
        for (int bj = 0; bj < 2; ++bj)
#pragma unroll
            for (int n = 0; n < 2; ++n) gv[bj][n] = *(const f32x4*)(gate + (size_t)bb * 12288 + col0 + bj * HALF + n * 16);
#pragma unroll
        for (int ai = 0; ai < 2; ++ai)
#pragma unroll
            for (int m = 0; m < 4; ++m) {
                const size_t off = (size_t)(ai * HALF + m * 16) * 2048 + col0;
#pragma unroll
                for (int bj = 0; bj < 2; ++bj)
#pragma unroll
                    for (int n = 0; n < 2; ++n) {
                        const f32x4 r = *(const f32x4*)(rbase + off + bj * HALF + n * 16);
                        *(f32x4*)(obase + off + bj * HALF + n * 16) = r + gv[bj][n] * acc[ai][bj][m][n];
                    }
            }
    }
};

struct EpiBf16I8 {
    static constexpr bool PERM = true, AFTER_DRAIN = false;
    bf16_t* O; int ldc; const float* sa; const float* sb;
    __device__ __forceinline__ void operator()(const i32x4 (&acc)[2][2][4][2], const Unit& u, int wr, int wc, int fr, int fq) const {
        const int row0 = u.pm * BM + wr * 64 + fr, col0 = u.pn * BM + wc * 32 + 8 * fq;
        f32x4 sv[2][2];
#pragma unroll
        for (int bj = 0; bj < 2; ++bj)
#pragma unroll
            for (int n = 0; n < 2; ++n) sv[bj][n] = *(const f32x4*)(sb + col0 + bj * HALF + 4 * n);
#pragma unroll
        for (int ai = 0; ai < 2; ++ai)
#pragma unroll
            for (int m = 0; m < 4; ++m) {
                const int row = row0 + ai * HALF + m * 16; const float s = sa[row];
                bf16_t* rowp = O + (size_t)row * ldc + col0;
#pragma unroll
                for (int bj = 0; bj < 2; ++bj) {
                    const i32x4 a0 = acc[ai][bj][m][0], a1 = acc[ai][bj][m][1];
                    const f32x4 v0 = (f32x4){(float)a0.x, (float)a0.y, (float)a0.z, (float)a0.w} * s * sv[bj][0];
                    const f32x4 v1 = (f32x4){(float)a1.x, (float)a1.y, (float)a1.z, (float)a1.w} * s * sv[bj][1];
                    u32x4 w; w.x = cvt_pk_bf16(v0[0], v0[1]); w.y = cvt_pk_bf16(v0[2], v0[3]); w.z = cvt_pk_bf16(v1[0], v1[1]); w.w = cvt_pk_bf16(v1[2], v1[3]);
                    *(u32x4*)(rowp + bj * HALF) = w;
                }
            }
    }
};
struct EpiResGateI8 {
    static constexpr bool PERM = false, AFTER_DRAIN = false;
    const float *resLat, *resCtx; float *outLat, *outCtx; const float* gate; const float* sa; const float* sb;
    __device__ __forceinline__ void operator()(const i32x4 (&acc)[2][2][4][2], const Unit& u, int wr, int wc, int fr, int fq) const {
        const int trow = u.pm * BM, row0 = trow + wr * 64 + fr, col0 = u.pn * BM + wc * 32 + 4 * fq;
        const bool lat = trow < 16384;
        const int bb = lat ? (trow >> 11) : 8;
        const float* rbase = lat ? resLat + (size_t)row0 * 2048 : resCtx + (size_t)(row0 - 16384) * 2048;
        float* obase = lat ? outLat + (size_t)row0 * 2048 : outCtx + (size_t)(row0 - 16384) * 2048;
        f32x4 gv[2][2];
#pragma unroll
        for (int bj = 0; bj < 2; ++bj)
#pragma unroll
            for (int n = 0; n < 2; ++n) gv[bj][n] = *(const f32x4*)(gate + (size_t)bb * 12288 + col0 + bj * HALF + n * 16) * *(const f32x4*)(sb + col0 + bj * HALF + n * 16);
#pragma unroll
        for (int ai = 0; ai < 2; ++ai)
#pragma unroll
            for (int m = 0; m < 4; ++m) {
                const size_t off = (size_t)(ai * HALF + m * 16) * 2048 + col0;
                const float s = sa[row0 + ai * HALF + m * 16];
#pragma unroll
                for (int bj = 0; bj < 2; ++bj)
#pragma unroll
                    for (int n = 0; n < 2; ++n) {
                        const f32x4 r = *(const f32x4*)(rbase + off + bj * HALF + n * 16);
                        const i32x4 a = acc[ai][bj][m][n];
                        *(f32x4*)(obase + off + bj * HALF + n * 16) = r + gv[bj][n] * ((f32x4){(float)a.x, (float)a.y, (float)a.z, (float)a.w} * s);
                    }
            }
    }
};

struct EpiResGateI8B {
    static constexpr bool PERM = true, AFTER_DRAIN = false;
    const float *resLat, *resCtx;
    bf16_t* hb; const float* gate; const float* sa; const float* sb;
    __device__ __forceinline__ void operator()(const i32x4 (&acc)[2][2][4][2], const Unit& u, int wr, int wc, int fr, int fq) const {
        const int trow = u.pm * BM, row0 = trow + wr * 64 + fr, col0 = u.pn * BM + wc * 32 + 8 * fq;
        const bool lat = trow < 16384;
        const int bb = lat ? (trow >> 11) : 8;
        f32x4 gv[2][2];
#pragma unroll
        for (int bj = 0; bj < 2; ++bj)
#pragma unroll
            for (int n = 0; n < 2; ++n) gv[bj][n] = *(const f32x4*)(gate + (size_t)bb * 12288 + col0 + bj * HALF + 4 * n) * *(const f32x4*)(sb + col0 + bj * HALF + 4 * n);
#pragma unroll
        for (int ai = 0; ai < 2; ++ai)
#pragma unroll
            for (int m = 0; m < 4; ++m) {
                const int row = row0 + ai * HALF + m * 16; const float s = sa[row];
                bf16_t* hp = hb + (size_t)row * 2048 + col0;
#pragma unroll
                for (int bj = 0; bj < 2; ++bj) {
                    f32x4 r0, r1;
                    if (resLat) {
                        const float* rp = (lat ? resLat + (size_t)row * 2048 : resCtx + (size_t)(row - 16384) * 2048) + col0 + bj * HALF;
                        r0 = *(const f32x4*)rp; r1 = *(const f32x4*)(rp + 4);
                    } else {
                        const u32x4 q = *(const u32x4*)(hp + bj * HALF);
                        r0 = (f32x4){__uint_as_float(q.x << 16), __uint_as_float(q.x & 0xffff0000u), __uint_as_float(q.y << 16), __uint_as_float(q.y & 0xffff0000u)};
                        r1 = (f32x4){__uint_as_float(q.z << 16), __uint_as_float(q.z & 0xffff0000u), __uint_as_float(q.w << 16), __uint_as_float(q.w & 0xffff0000u)};
                    }
                    const i32x4 a0 = acc[ai][bj][m][0], a1 = acc[ai][bj][m][1];
                    const f32x4 v0 = r0 + (gv[bj][0] * s) * (f32x4){(float)a0.x, (float)a0.y, (float)a0.z, (float)a0.w};
                    const f32x4 v1 = r1 + (gv[bj][1] * s) * (f32x4){(float)a1.x, (float)a1.y, (float)a1.z, (float)a1.w};
                    u32x4 w; w.x = cvt_pk_bf16(v0[0], v0[1]); w.y = cvt_pk_bf16(v0[2], v0[3]); w.z = cvt_pk_bf16(v1[0], v1[1]); w.w = cvt_pk_bf16(v1[2], v1[3]);
                    *(u32x4*)(hp + bj * HALF) = w;
                }
            }
    }
};
}
#ifndef USE_PG8
#define USE_PG8 1
#endif

__device__ __forceinline__ float sum16(float v) { v += __shfl_xor(v, 1); v += __shfl_xor(v, 2); v += __shfl_xor(v, 4); v += __shfl_xor(v, 8); return v; }
__device__ __forceinline__ void ph_prep(const Params& p, int l, const bool dry) {
    const int tid = threadIdx.x, lane = tid & 63, wave = tid >> 6, sub = lane >> 4, li = lane & 15;
    const int gw = blockIdx.x * NWAVES + wave, NGW = gridDim.x * NWAVES;
    bf16_t* P = (bf16_t*)(p.ws + WS_P);
    const float* rope = (const float*)(p.ws + WS_ROPE);
    const bool last = (l == DEPTH - 1);
    const int f0 = (li >= 8 ? 32 : 0) + 8 * (li & 3);
    const float sg = (li & 4) ? 1.f : -1.f;
#pragma unroll 1
    for (int r = gw; r < MTOT; r += NGW) {
        bf16_t* row = P + (size_t)r * INW;
        bf16_t* wrow = dry ? (bf16_t*)(p.ws + WS_DUMMY) + (size_t)r * INW : row;
        const bool isctx = r >= NLAT;
        const int t = r & (SEQ - 1);
        float cs[8], sn[8];
        if (!isctx) {
            const f32x4* rp = (const f32x4*)(rope + ((size_t)t * 64 + f0) * 2);
            const f32x4 a = rp[0], b = rp[1], c = rp[2], d = rp[3];
            cs[0] = a.x; sn[0] = a.y; cs[1] = a.z; sn[1] = a.w; cs[2] = b.x; sn[2] = b.y; cs[3] = b.z; sn[3] = b.w;
            cs[4] = c.x; sn[4] = c.y; cs[5] = c.z; sn[5] = c.w; cs[6] = d.x; sn[6] = d.y; cs[7] = d.z; sn[7] = d.w;
        } else {
#pragma unroll
            for (int i = 0; i < 8; ++i) { cs[i] = 1.f; sn[i] = 0.f; }
        }
        u32x4 raw[7];
#pragma unroll
        for (int gI = 0; gI < 7; ++gI) raw[gI] = *(const u32x4*)(row + (gI * 4 + sub) * 128 + li * 8);
#pragma unroll
        for (int gI = 0; gI < 7; ++gI) {
            const int slot = gI * 4 + sub;
            const int kind = slot < 8 ? 0 : slot < 10 ? 1 : slot < 18 ? 0 : slot < 20 ? 1 : slot < 24 ? 2 : 3;
            const bool isq = slot < 6 || (slot >= 10 && slot < 16);
            float x[8];
            x[0] = bflo(raw[gI].x); x[1] = bfhi(raw[gI].x); x[2] = bflo(raw[gI].y); x[3] = bfhi(raw[gI].y);
            x[4] = bflo(raw[gI].z); x[5] = bfhi(raw[gI].z); x[6] = bflo(raw[gI].w); x[7] = bfhi(raw[gI].w);
            if (kind >= 2) {
#pragma unroll
                for (int i = 0; i < 8; ++i) x[i] = gelu_tanh(x[i]);
            }
            float ss = 0.f;
#pragma unroll
            for (int i = 0; i < 8; ++i) ss += x[i] * x[i];
            ss = sum16(ss);
            const float rstd = rsqrtf(ss * (1.f / 128.f) + EPS);
            const float* gain = slot < 6 ? p.qn_a + l * 128 : slot < 8 ? p.kn_a + l * 128 : slot < 16 ? p.qn_b + l * 128 : slot < 20 ? p.kn_b + l * 128 : p.vn_c + l * 512 + (slot - 24) * 128;
            if (kind == 0 || kind == 3) {
                const f32x4 g0 = *(const f32x4*)(gain + li * 8), g1 = *(const f32x4*)(gain + li * 8 + 4);
                x[0] *= rstd * g0.x; x[1] *= rstd * g0.y; x[2] *= rstd * g0.z; x[3] *= rstd * g0.w;
                x[4] *= rstd * g1.x; x[5] *= rstd * g1.y; x[6] *= rstd * g1.z; x[7] *= rstd * g1.w;
            }
            float px[8];
#pragma unroll
            for (int i = 0; i < 8; ++i) px[i] = __shfl_xor(x[i], 4);
            if (kind == 0) {
#pragma unroll
                for (int i = 0; i < 8; ++i) x[i] = x[i] * cs[i] + sg * px[i] * sn[i];
            }
            bool wr = kind != 1;
            if (isctx && last && (isq || kind >= 2)) wr = false;
            if (wr) { u32x4 o; o.x = pk2(x[0], x[1]); o.y = pk2(x[2], x[3]); o.z = pk2(x[4], x[5]); o.w = pk2(x[6], x[7]); *(u32x4*)(wrow + slot * 128 + li * 8) = o; }
        }
    }
}

__device__ __forceinline__ void attn_row_naive(const bf16_t* q, const bf16_t* kc, const bf16_t* vc, const bf16_t* kl, const bf16_t* vl, int j0, int j1,
                                               bool has_sink, float sink, bf16_t* o, int lane) {
    const unsigned qq = *(const unsigned*)(q + 2 * lane);
    const float q0 = bflo(qq), q1 = bfhi(qq);
    float m = -INFINITY, lsum = 0.f, o0 = 0.f, o1 = 0.f;
    const int ntot = NCTX + (j1 - j0);
    for (int j = 0; j < ntot; ++j) {
        const bf16_t* kp = j < NCTX ? kc + (size_t)j * INW : kl + (size_t)(j0 + j - NCTX) * INW;
        const bf16_t* vp = j < NCTX ? vc + (size_t)j * INW : vl + (size_t)(j0 + j - NCTX) * INW;
        const unsigned kk = *(const unsigned*)(kp + 2 * lane), vv = *(const unsigned*)(vp + 2 * lane);
        const float s = wave_sum(q0 * bflo(kk) + q1 * bfhi(kk)) * ATT_SCALE;
        const float mn = fmaxf(m, s);
        const float a = __expf(m - mn), pp = __expf(s - mn);
        lsum = lsum * a + pp; o0 = o0 * a + pp * bflo(vv); o1 = o1 * a + pp * bfhi(vv);
        m = mn;
    }
    if (has_sink) {
        const float mn = fmaxf(m, sink);
        const float a = __expf(m - mn);
        lsum = lsum * a + __expf(sink - mn); o0 *= a; o1 *= a;
    }
    const float inv = 1.f / lsum;
    *(unsigned*)(o + 2 * lane) = pk2(o0 * inv, o1 * inv);
}

__device__ __forceinline__ void ph_mixers_naive(const Params& p, int l, unsigned char* lds) {
    const int tid = threadIdx.x, lane = tid & 63, wave = tid >> 6;
    const int gw = blockIdx.x * NWAVES + wave, NGW = gridDim.x * NWAVES;
    const bf16_t* P = (const bf16_t*)(p.ws + WS_P);
    bf16_t* Y = (bf16_t*)(p.ws + WS_Y);
    const bool last = (l == DEPTH - 1);
    const int T_LA = NLAT * 6, T_LB = NLAT * 6, T_CA = last ? 0 : NCT * 6, T_CB = last ? 0 : NCT * 6;
    const int ntask = T_LA + T_LB + T_CA + T_CB;
    for (int tk = gw; tk < ntask; tk += NGW) {
        int r = tk;
        if (r < T_LA + T_LB) {
            const bool isB = r >= T_LA; if (isB) r -= T_LA;
            const int b = r / (6 * SEQ), h = (r / SEQ) % 6, t = r % SEQ, kv = h / 3;
            const size_t row = (size_t)b * SEQ + t, crow0 = (size_t)NLAT + (size_t)b * NCTX, lrow0 = (size_t)b * SEQ;
            const int cq = isB ? C_QB : C_QA, ck = isB ? C_KB : C_KA, cvv = isB ? C_VB : C_VA;
            int j0 = 0, j1 = SEQ;
            if (isB) { j0 = t - 128 < 0 ? 0 : t - 128; j1 = t + 129 > SEQ ? SEQ : t + 129; }
            attn_row_naive(P + row * INW + cq + h * 128, P + crow0 * INW + ck + kv * 128, P + crow0 * INW + cvv + kv * 128,
                           P + lrow0 * INW + ck + kv * 128, P + lrow0 * INW + cvv + kv * 128, j0, j1, isB, isB ? p.sink_b[l * 6 + h] : 0.f,
                           Y + row * DM + (isB ? 768 : 0) + h * 128, lane);
        } else {
            r -= T_LA + T_LB;
            const bool isB = r >= T_CA; if (isB) r -= T_CA;
            const int b = r / (6 * NCTX), h = (r / NCTX) % 6, t = r % NCTX, kv = h / 3;
            const size_t crow0 = (size_t)NLAT + (size_t)b * NCTX, row = crow0 + t;
            const int cq = isB ? C_QB : C_QA, ck = isB ? C_KB : C_KA, cvv = isB ? C_VB : C_VA;
            attn_row_naive(P + row * INW + cq + h * 128, P + crow0 * INW + ck + kv * 128, P + crow0 * INW + cvv + kv * 128,
                           P, P, 0, 0, isB, isB ? p.sink_b[l * 6 + h] : 0.f, Y + row * DM + (isB ? 768 : 0) + h * 128, lane);
        }
    }
    __syncthreads();
    float* Wl = (float*)lds;
    float* Vl = Wl + 128 * 128;
    const int nchunk = last ? NLAT / 128 : MTOT / 128;
    for (int u = blockIdx.x; u < nchunk * 4; u += gridDim.x) {
        const int ch = u >> 2, g = u & 3; const size_t row0 = (size_t)ch * 128;
        __syncthreads();
        for (int i = tid; i < 128 * 128; i += NTHREADS) {
            Wl[i] = p.ws_c[((size_t)l * 4 + g) * 16384 + i];
            const int q = i >> 7, c = i & 127;
            Vl[i] = bf2f(P[(row0 + q) * INW + C_VC + g * 128 + c]);
        }
        __syncthreads();
        const int c = tid & 127, pg = tid >> 7;
        for (int pp = pg * 32; pp < pg * 32 + 32; ++pp) {
            float s = 0.f;
#pragma unroll 8
            for (int q = 0; q < 128; ++q) s += Wl[pp * 128 + q] * Vl[q * 128 + c];
            s += p.bs_c[((size_t)l * 4 + g) * 128 + pp];
            const float uu = bf2f(P[(row0 + pp) * INW + C_UC + g * 128 + c]);
            Y[(row0 + pp) * DM + 1536 + g * 128 + c] = (bf16_t)f2bf(uu * s);
        }
    }
}


namespace att {
constexpr float SCALE = 0.088388347648318440f;
constexpr float THR = 8.f;
constexpr int D = 128, NW = 8, QBLK = 32, KVBLK = 64;
#ifndef ATT_SDEPTH
#define ATT_SDEPTH 2
#endif
constexpr int SDEPTH = ATT_SDEPTH;
constexpr int LDQ = INW, LDK = INW, LDO = DM;
constexpr size_t SHM_V = KVBLK * D * 2, SHM_K = KVBLK * D * 2, SHM_ATTN = 2 * SHM_V + 2 * SHM_K + NW * 64 * 4;
using bf16x8 = __attribute__((ext_vector_type(8))) short;
using s16x4  = __attribute__((ext_vector_type(4))) short;
using f32x16 = __attribute__((ext_vector_type(16))) float;
using f32x8  = __attribute__((ext_vector_type(8))) float;

#define KSWZ(row, colB) ((row) * 256 + ((colB) ^ (((row) & 7) << 4)))
#define SBAR() __builtin_amdgcn_sched_barrier(0)
__device__ __forceinline__ int crow(int r, int hi) { return (r & 3) + 8 * (r >> 2) + 4 * hi; }
__device__ __forceinline__ unsigned cvtpk(float lo, float hi) {
  unsigned r; asm volatile("v_cvt_pk_bf16_f32 %0, %1, %2" : "=v"(r) : "v"(lo), "v"(hi)); return r;
}

__device__ __forceinline__ void partialSM(f32x16& p0, f32x16& p1, float& m_reg, float& mn, float& alpha) {
  constexpr float C = SCALE * 1.4426950408889634f;
  float pmax = p0[0]; for (int r = 1; r < 16; ++r) pmax = fmaxf(pmax, p0[r]); for (int r = 0; r < 16; ++r) pmax = fmaxf(pmax, p1[r]);
  { auto rr = __builtin_amdgcn_permlane32_swap(__float_as_uint(pmax), __float_as_uint(pmax), false, false);
    pmax = fmaxf(__uint_as_float(rr[0]), __uint_as_float(rr[1])); }
  if (__builtin_expect(__all(pmax - m_reg <= THR / SCALE), 1)) { mn = m_reg; alpha = 1.f; }
  else { mn = fmaxf(m_reg, pmax); alpha = __builtin_amdgcn_exp2f((m_reg - mn) * C); m_reg = mn; }
  float mnC = -mn * C;
  for (int r = 0; r < 16; ++r) p0[r] = fmaf(p0[r], C, mnC); for (int r = 0; r < 16; ++r) p1[r] = fmaf(p1[r], C, mnC);
  for (int r = 0; r < 16; ++r) p0[r] = __builtin_amdgcn_exp2f(p0[r]);
}
__device__ __forceinline__ void finishSM(f32x16& p0, f32x16& p1, float alpha, float& l_reg, bf16x8& pa0, bf16x8& pa1, bf16x8& pa2, bf16x8& pa3) {
  for (int r = 0; r < 16; ++r) p1[r] = __builtin_amdgcn_exp2f(p1[r]);
  float ps = 0; for (int r = 0; r < 16; ++r) ps += p0[r]; for (int r = 0; r < 16; ++r) ps += p1[r];
  { auto rr = __builtin_amdgcn_permlane32_swap(__float_as_uint(ps), __float_as_uint(ps), false, false);
    ps = __uint_as_float(rr[0]) + __uint_as_float(rr[1]); }
  l_reg = l_reg * alpha + ps;
#define PK4(P, BASE, OUT) do { unsigned a0 = cvtpk(P[BASE + 0], P[BASE + 1]), a1 = cvtpk(P[BASE + 2], P[BASE + 3]);   \
    unsigned b0 = cvtpk(P[BASE + 4], P[BASE + 5]), b1 = cvtpk(P[BASE + 6], P[BASE + 7]);                              \
    auto r0 = __builtin_amdgcn_permlane32_swap(a0, b0, false, false); auto r1 = __builtin_amdgcn_permlane32_swap(a1, b1, false, false); \
    u32x4 w = {r0[0], r1[0], r0[1], r1[1]}; OUT = *reinterpret_cast<bf16x8*>(&w); } while (0)
  PK4(p0, 0, pa0); PK4(p0, 8, pa1); PK4(p1, 0, pa2); PK4(p1, 8, pa3);
#undef PK4
}
__device__ __forceinline__ void qkt(f32x16& p0, f32x16& p1, const bf16_t* Ks, const bf16x8* qr, int r32, int hi) {
  p0 = f32x16{}; p1 = f32x16{};
  for (int d0 = 0; d0 < 8; ++d0) { int cb = (d0 * 16 + hi * 8) * 2;
    bf16x8 b0 = *reinterpret_cast<const bf16x8*>((const char*)Ks + KSWZ(r32, cb));
    bf16x8 b1 = *reinterpret_cast<const bf16x8*>((const char*)Ks + KSWZ(32 + r32, cb));
    p0 = __builtin_amdgcn_mfma_f32_32x32x16_bf16(b0, qr[d0], p0, 0, 0, 0);
    p1 = __builtin_amdgcn_mfma_f32_32x32x16_bf16(b1, qr[d0], p1, 0, 0, 0); }
}
__device__ __forceinline__ int v_st(int k, int c) { const int kk = (k & ~0xC) | ((k & 4) << 1) | ((k & 8) >> 1); return ((kk >> 3) * 4 + (c >> 5)) * 512 + ((kk & 7) * 32 + (c & 31)) * 2; }
__device__ __forceinline__ int v_rd_base(int lane) { return ((lane & 3) << 3) | (((lane >> 2) & 3) << 6) | (((lane >> 4) & 1) << 5) | (((lane >> 5) & 1) << 8); }
constexpr int v_rd_off(int d0, int ks, int half) { return d0 * 512 + ks * 4096 + half * 2048; }
template <int OFF> __device__ __forceinline__ s16x4 tr_read(int vb) {
  s16x4 r; asm volatile("ds_read_b64_tr_b16 %0, %1 offset:%2" : "=&v"(r) : "v"(vb), "i"(OFF) : "memory"); return r;
}
template <int D0> __device__ __forceinline__ void pv_one(f32x16& od, int vb, bf16x8 pa0, bf16x8 pa1, bf16x8 pa2, bf16x8 pa3) {
  const s16x4 l0 = tr_read<v_rd_off(D0, 0, 0)>(vb), h0 = tr_read<v_rd_off(D0, 0, 1)>(vb), l1 = tr_read<v_rd_off(D0, 1, 0)>(vb), h1 = tr_read<v_rd_off(D0, 1, 1)>(vb);
  const s16x4 l2 = tr_read<v_rd_off(D0, 2, 0)>(vb), h2 = tr_read<v_rd_off(D0, 2, 1)>(vb), l3 = tr_read<v_rd_off(D0, 3, 0)>(vb), h3 = tr_read<v_rd_off(D0, 3, 1)>(vb);
  asm volatile("s_waitcnt lgkmcnt(0)" ::: "memory"); SBAR();
#define PK(L, H) (bf16x8){L[0], L[1], L[2], L[3], H[0], H[1], H[2], H[3]}
  od = __builtin_amdgcn_mfma_f32_32x32x16_bf16(pa0, PK(l0, h0), od, 0, 0, 0);
  od = __builtin_amdgcn_mfma_f32_32x32x16_bf16(pa1, PK(l1, h1), od, 0, 0, 0);
  od = __builtin_amdgcn_mfma_f32_32x32x16_bf16(pa2, PK(l2, h2), od, 0, 0, 0);
  od = __builtin_amdgcn_mfma_f32_32x32x16_bf16(pa3, PK(l3, h3), od, 0, 0, 0);
#undef PK
}
__device__ __forceinline__ void pv_d0(f32x16* o, int vb, bf16x8 pa0, bf16x8 pa1, bf16x8 pa2, bf16x8 pa3) {
  pv_one<0>(o[0], vb, pa0, pa1, pa2, pa3); pv_one<1>(o[1], vb, pa0, pa1, pa2, pa3); pv_one<2>(o[2], vb, pa0, pa1, pa2, pa3); pv_one<3>(o[3], vb, pa0, pa1, pa2, pa3);
}

__device__ __forceinline__ void attn_unit(const bool MASK, const bf16_t* __restrict__ Qb, const bf16_t* __restrict__ Kc, const bf16_t* __restrict__ Vc,
                                          const bf16_t* __restrict__ Kl, const bf16_t* __restrict__ Vl, int nlt, int qpos0, int kpos0,
                                          bool has_sink, float sink, bf16_t* __restrict__ Ob, char* lds) {
  int tid_ = threadIdx.x; asm volatile("" : "+v"(tid_));
  const int tid = tid_, wid = tid >> 6, lane = tid & 63, r32 = lane & 31, hi = lane >> 5;
  bf16_t* V_lds = (bf16_t*)lds; bf16_t* K_lds = (bf16_t*)(lds + 2 * SHM_V);
  float* ws = (float*)(lds + 2 * SHM_V + 2 * SHM_K) + wid * 64; float* li_l = ws; float* al_l = ws + 32;
  float m_reg = -1e30f, l_reg = 0; f32x16 o[4] = {}; bf16x8 qr[8];
  const bf16_t* Qw = Qb + (long)(wid * QBLK + r32) * LDQ + hi * 8;
#pragma unroll
  for (int d0 = 0; d0 < 8; ++d0) qr[d0] = *reinterpret_cast<const bf16x8*>(Qw + d0 * 16);
  const int sr = tid >> 4, sc = (tid & 15) * 8, vst0 = v_st(sr, sc), vst1 = v_st(32 + sr, sc);
  const int vb0 = (int)(uintptr_t)V_lds + v_rd_base(lane);
  struct { bf16x8 vs0, vs1, ks0, ks1; } sr_[SDEPTH];
  const int qpos = qpos0 + wid * QBLK + r32;
#define KVP(t, KP, VP) const bf16_t* KP = ((t) < 4 ? Kc + (long)(t) * KVBLK * LDK : Kl + (long)((t) - 4) * KVBLK * LDK); const bf16_t* VP = ((t) < 4 ? Vc + (long)(t) * KVBLK * LDK : Vl + (long)((t) - 4) * KVBLK * LDK)
#define SLOAD(i, t) do { KVP(t, kp_, vp_); sr_[i].vs0 = *reinterpret_cast<const bf16x8*>(&vp_[(long)sr * LDK + sc]); sr_[i].vs1 = *reinterpret_cast<const bf16x8*>(&vp_[(long)(32 + sr) * LDK + sc]); \
    sr_[i].ks0 = *reinterpret_cast<const bf16x8*>(&kp_[(long)sr * LDK + sc]); sr_[i].ks1 = *reinterpret_cast<const bf16x8*>(&kp_[(long)(32 + sr) * LDK + sc]); } while (0)
#define SWRITE(b, i) do { *(bf16x8*)((char*)V_lds + (b) * SHM_V + vst0) = sr_[i].vs0;          \
    *(bf16x8*)((char*)V_lds + (b) * SHM_V + vst1) = sr_[i].vs1; int kc = sc * 2;               \
    *(bf16x8*)((char*)K_lds + (b) * SHM_K + KSWZ(sr, kc)) = sr_[i].ks0;                       \
    *(bf16x8*)((char*)K_lds + (b) * SHM_K + KSWZ(32 + sr, kc)) = sr_[i].ks1; } while (0)
#define SWAIT() do { if constexpr (SDEPTH == 2) asm volatile("s_waitcnt vmcnt(4)" ::: "memory"); else asm volatile("s_waitcnt vmcnt(0)" ::: "memory"); } while (0)
#define RESC(a) do { if (__any((a) < 1.f)) { if (hi == 0) al_l[r32] = (a); asm volatile("s_waitcnt lgkmcnt(0)" ::: "memory"); \
    for (int d = 0; d < 4; ++d) for (int r = 0; r < 16; ++r) o[d][r] *= al_l[crow(r, hi)]; } } while (0)
#define WMASK(P0, P1, t) do { if (MASK && (t) >= 4) { const int kb_ = kpos0 + ((t) - 4) * KVBLK + 4 * hi - qpos; \
    _Pragma("unroll") for (int r = 0; r < 16; ++r) { const int dk = kb_ + (r & 3) + 8 * (r >> 2); \
      if (dk > 128 || dk < -128) P0[r] = -1e30f; if (dk + 32 > 128 || dk + 32 < -128) P1[r] = -1e30f; } } } while (0)
  f32x16 pA0, pA1, pB0, pB1; float mnA, mnB, alA, alB; bf16x8 pa0, pa1, pa2, pa3; const int NT = 4 + nlt;
  constexpr int SE = 0, SO = SDEPTH - 1;
  SLOAD(SE, 0); asm volatile("s_waitcnt vmcnt(0)" ::: "memory"); SWRITE(0, SE); __syncthreads();
  qkt(pA0, pA1, K_lds, qr, r32, hi); partialSM(pA0, pA1, m_reg, mnA, alA);
  SLOAD(SO, 1); if constexpr (SDEPTH == 2) { if (2 < NT) SLOAD(SE, 2); }
  SWAIT(); SWRITE(1, SO); __syncthreads();
  for (int j = 1; j + 1 < NT; j += 2) {
    SBAR(); qkt(pB0, pB1, (bf16_t*)((char*)K_lds + SHM_K), qr, r32, hi); WMASK(pB0, pB1, j);
    finishSM(pA0, pA1, alA, l_reg, pa0, pa1, pa2, pa3); SBAR();
    SLOAD(SO, j + SDEPTH); SBAR();
    pv_d0(o, vb0, pa0, pa1, pa2, pa3); partialSM(pB0, pB1, m_reg, mnB, alB);
    __syncthreads(); SWAIT(); SWRITE(0, SE);
    RESC(alB); __syncthreads();
    SBAR(); qkt(pA0, pA1, K_lds, qr, r32, hi); WMASK(pA0, pA1, j + 1);
    finishSM(pB0, pB1, alB, l_reg, pa0, pa1, pa2, pa3); SBAR();
    if (SDEPTH == 1 || j + 3 < NT) SLOAD(SE, j + 1 + SDEPTH); SBAR();
    pv_d0(o, vb0 + (int)SHM_V, pa0, pa1, pa2, pa3); partialSM(pA0, pA1, m_reg, mnA, alA);
    __syncthreads(); SWAIT(); SWRITE(1, SO);
    RESC(alA); __syncthreads();
  }
  SBAR(); qkt(pB0, pB1, (bf16_t*)((char*)K_lds + SHM_K), qr, r32, hi); WMASK(pB0, pB1, NT - 1);
  finishSM(pA0, pA1, alA, l_reg, pa0, pa1, pa2, pa3); SBAR();
  pv_d0(o, vb0, pa0, pa1, pa2, pa3); partialSM(pB0, pB1, m_reg, mnB, alB);
  __syncthreads(); RESC(alB);
  finishSM(pB0, pB1, alB, l_reg, pa0, pa1, pa2, pa3); SBAR();
  pv_d0(o, vb0 + (int)SHM_V, pa0, pa1, pa2, pa3);
  if (has_sink) l_reg += __builtin_amdgcn_exp2f(sink * 1.4426950408889634f - m_reg * (SCALE * 1.4426950408889634f));
  if (hi == 0) li_l[r32] = l_reg; asm volatile("s_waitcnt lgkmcnt(0)" ::: "memory");
  float rli[16];
#pragma unroll
  for (int r = 0; r < 16; ++r) rli[r] = __builtin_amdgcn_rcpf(li_l[crow(r, hi)]);
  bf16_t* Ow = Ob + (long)(wid * QBLK) * LDO;
#pragma unroll
  for (int r = 0; r < 16; ++r) { int orow = crow(r, hi);
#pragma unroll
    for (int d0 = 0; d0 < 4; ++d0) Ow[(long)orow * LDO + d0 * 32 + r32] = (bf16_t)f2bf(o[d0][r] * rli[r]); }
  __syncthreads();
#undef KVP
#undef SLOAD
#undef SWRITE
#undef SWAIT
#undef RESC
#undef WMASK
}
#undef KSWZ
#undef SBAR
}


__device__ __forceinline__ void cmlp_unit_naive(const Params& p, int l, int ch, int g, unsigned char* lds) {
    int tid_ = threadIdx.x; asm volatile("" : "+v"(tid_));
    const int tid = tid_;
    const bf16_t* P = (const bf16_t*)(p.ws + WS_P);
    bf16_t* Y = (bf16_t*)(p.ws + WS_Y);
    float* Wl = (float*)lds;
    float* Vl = Wl + 128 * 128;
    const size_t row0 = (size_t)ch * 128;
    __syncthreads();
    for (int i = tid; i < 128 * 128; i += NTHREADS) {
        Wl[i] = p.ws_c[((size_t)l * 4 + g) * 16384 + i];
        const int q = i >> 7, c = i & 127;
        Vl[i] = bf2f(P[(row0 + q) * INW + C_VC + g * 128 + c]);
    }
    __syncthreads();
    const int c = tid & 127, pg = tid >> 7;
    for (int pp = pg * 32; pp < pg * 32 + 32; ++pp) {
        float s = 0.f;
#pragma unroll 8
        for (int q = 0; q < 128; ++q) s += Wl[pp * 128 + q] * Vl[q * 128 + c];
        s += p.bs_c[((size_t)l * 4 + g) * 128 + pp];
        const float uu = bf2f(P[(row0 + pp) * INW + C_UC + g * 128 + c]);
        Y[(row0 + pp) * DM + 1536 + g * 128 + c] = (bf16_t)f2bf(uu * s);
    }
    __syncthreads();
}


__device__ __forceinline__ void cmlp_unit_fast(const Params& p, int l, int ch, int g, unsigned char* lds) {
    typedef short bf16x8 __attribute__((ext_vector_type(8)));
    typedef float f32x16 __attribute__((ext_vector_type(16)));
    int tid_ = threadIdx.x; asm volatile("" : "+v"(tid_));
    const int tid = tid_, lane = tid & 63, wave = tid >> 6, r32 = lane & 31, hh = lane >> 5;
    const bf16_t* P = (const bf16_t*)(p.ws + WS_P);
    bf16_t* Y = (bf16_t*)(p.ws + WS_Y);
    const bf16_t* W = (const bf16_t*)(p.ws + WS_WSC) + ((size_t)l * 4 + g) * 16384;
    bf16_t* VT = (bf16_t*)lds;
    const size_t row0 = (size_t)ch * 128;
    __syncthreads();
#pragma unroll
    for (int it = 0; it < 4; ++it) {
        const int q = it * 32 + (tid >> 4), c0 = (tid & 15) * 8;
        const u32x4 v = *(const u32x4*)(P + (row0 + q) * INW + C_VC + g * 128 + c0);
        const unsigned w[4] = {v.x, v.y, v.z, v.w};
#pragma unroll
        for (int i = 0; i < 4; ++i) { VT[(c0 + 2 * i) * 136 + q] = (bf16_t)(w[i] & 0xffffu); VT[(c0 + 2 * i + 1) * 136 + q] = (bf16_t)(w[i] >> 16); }
    }
    __syncthreads();
    const int cb = wave & 3, pb0 = (wave >> 2) * 2;
    f32x16 acc0 = {}, acc1 = {};
#pragma unroll
    for (int s = 0; s < 8; ++s) {
        const bf16x8 b = *(const bf16x8*)(VT + (cb * 32 + r32) * 136 + 16 * s + 8 * hh);
        const bf16x8 a0 = *(const bf16x8*)(W + (size_t)(pb0 * 32 + r32) * 128 + 16 * s + 8 * hh);
        const bf16x8 a1 = *(const bf16x8*)(W + (size_t)(pb0 * 32 + 32 + r32) * 128 + 16 * s + 8 * hh);
        acc0 = __builtin_amdgcn_mfma_f32_32x32x16_bf16(a0, b, acc0, 0, 0, 0);
        acc1 = __builtin_amdgcn_mfma_f32_32x32x16_bf16(a1, b, acc1, 0, 0, 0);
    }
    const int c = cb * 32 + r32;
    const float* bs = p.bs_c + ((size_t)l * 4 + g) * 128;
#pragma unroll
    for (int r = 0; r < 16; ++r) {
        const int pr = (r & 3) + 8 * (r >> 2) + 4 * hh;
        const int p0 = pb0 * 32 + pr, p1 = p0 + 32;
        const float u0 = bf2f(P[(row0 + p0) * INW + C_UC + g * 128 + c]), u1 = bf2f(P[(row0 + p1) * INW + C_UC + g * 128 + c]);
        Y[(row0 + p0) * DM + 1536 + g * 128 + c] = (bf16_t)f2bf(u0 * (acc0[r] + bs[p0]));
        Y[(row0 + p1) * DM + 1536 + g * 128 + c] = (bf16_t)f2bf(u1 * (acc1[r] + bs[p1]));
    }
}
#ifndef USE_FAST_CMLP
#define USE_FAST_CMLP 1
#endif

__device__ __forceinline__ void ph_mixers_fast(const Params& p, int l, unsigned char* lds, const bool dry) {
    const int tid = threadIdx.x;
    const bf16_t* P = (const bf16_t*)(p.ws + WS_P);
    bf16_t* Y = (bf16_t*)(p.ws + WS_Y);
    const bool last = (l == DEPTH - 1);
    const int b = blockIdx.x & 7;
    unsigned* ctr = (unsigned*)(p.ws + WS_CTL) + (dry ? 2048 : 0) + (l * 8 + b) * 64;
    volatile unsigned* shw = (volatile unsigned*)(lds + LDS_BYTES - 64);
    const int nAttn = last ? 96 : 108, nC = last ? 64 : 72, total = nAttn + nC;
    const size_t lrow0 = (size_t)b * SEQ, crow0 = (size_t)NLAT + (size_t)b * NCTX;
    for (;;) {
        __syncthreads();
        if (tid == 0) *shw = atomicAdd(ctr, 1u);
        __syncthreads();
        const int u = (int)*shw;
        if (u >= total) break;
        if (u < nAttn) {
            const bf16_t *Qb, *Kc, *Vc, *Kl, *Vl; bf16_t* Ob; int nlt = 0, qpos0 = 0, kpos0 = 0; bool mask = false, has_sink = false; int hsink = 0;
            if (u < 48) {
                const int h = u >> 3, qb = u & 7, kv = h / 3;
                Qb = P + (lrow0 + qb * 256) * INW + C_QA + h * 128; Kc = P + crow0 * INW + C_KA + kv * 128; Vc = P + crow0 * INW + C_VA + kv * 128;
                Kl = P + lrow0 * INW + C_KA + kv * 128; Vl = P + lrow0 * INW + C_VA + kv * 128; nlt = 32;
                Ob = Y + (lrow0 + qb * 256) * DM + h * 128;
            } else if (u < 96) {
                const int v = u - 48, h = v >> 3, qb = v & 7, kv = h / 3;
                const int kstart = qb == 0 ? 0 : qb * 256 - 128; nlt = (qb == 0 || qb == 7) ? 6 : 8;
                Qb = P + (lrow0 + qb * 256) * INW + C_QB + h * 128; Kc = P + crow0 * INW + C_KB + kv * 128; Vc = P + crow0 * INW + C_VB + kv * 128;
                Kl = P + (lrow0 + kstart) * INW + C_KB + kv * 128; Vl = P + (lrow0 + kstart) * INW + C_VB + kv * 128;
                qpos0 = qb * 256; kpos0 = kstart; mask = true; has_sink = true; hsink = h;
                Ob = Y + (lrow0 + qb * 256) * DM + 768 + h * 128;
            } else {
                const int v = u - 96; const bool isB = v >= 6; const int h = isB ? v - 6 : v, kv = h / 3;
                const int cq = isB ? C_QB : C_QA, ck = isB ? C_KB : C_KA, cv = isB ? C_VB : C_VA;
                Qb = P + crow0 * INW + cq + h * 128; Kc = P + crow0 * INW + ck + kv * 128; Vc = P + crow0 * INW + cv + kv * 128; Kl = Kc; Vl = Vc;
                has_sink = isB; hsink = h; Ob = Y + crow0 * DM + (isB ? 768 : 0) + h * 128;
            }
            att::attn_unit(mask, Qb, Kc, Vc, Kl, Vl, nlt, qpos0, kpos0, has_sink, has_sink ? p.sink_b[l * 6 + hsink] : 0.f, Ob, (char*)lds);
        } else {
            const int v = u - nAttn;
            const int ch = v < 64 ? b * 16 + (v >> 2) : 128 + b * 2 + ((v - 64) >> 2);
#if USE_FAST_CMLP
            cmlp_unit_fast(p, l, ch, v & 3, lds);
#else
            cmlp_unit_naive(p, l, ch, v & 3, lds);
#endif
        }
    }
}
#ifndef USE_FAST_ATT
#define USE_FAST_ATT 1
#endif

__device__ __forceinline__ void ynorm_row(bf16_t* yrow, const u32x4 (&v)[4], int lane, unsigned char* y8row, float* sdst) {
    float sq[4];
#pragma unroll
    for (int j = 0; j < 4; ++j) {
        const float a0 = bflo(v[j].x), a1 = bfhi(v[j].x), a2 = bflo(v[j].y), a3 = bfhi(v[j].y), a4 = bflo(v[j].z), a5 = bfhi(v[j].z), a6 = bflo(v[j].w), a7 = bfhi(v[j].w);
        sq[j] = a0 * a0 + a1 * a1 + a2 * a2 + a3 * a3 + a4 * a4 + a5 * a5 + a6 * a6 + a7 * a7;
    }
    const float sA = wave_sum(sq[0] + (lane < 32 ? sq[1] : 0.f));
    const float sB = wave_sum((lane >= 32 ? sq[1] : 0.f) + sq[2]);
    const float sC = wave_sum(sq[3]);
    const float rA = rsqrtf(sA * (1.f / 768.f) + EPS), rB = rsqrtf(sB * (1.f / 768.f) + EPS), rC = rsqrtf(sC * (1.f / 512.f) + EPS);
    if (GEMM_I8) {
        float x[4][8]; float am = 0.f;
#pragma unroll
        for (int j = 0; j < 4; ++j) {
            const float sc = (j == 0) ? rA : (j == 1) ? (lane < 32 ? rA : rB) : (j == 2) ? rB : rC;
            x[j][0] = bflo(v[j].x) * sc; x[j][1] = bfhi(v[j].x) * sc; x[j][2] = bflo(v[j].y) * sc; x[j][3] = bfhi(v[j].y) * sc;
            x[j][4] = bflo(v[j].z) * sc; x[j][5] = bfhi(v[j].z) * sc; x[j][6] = bflo(v[j].w) * sc; x[j][7] = bfhi(v[j].w) * sc;
#pragma unroll
            for (int i = 0; i < 8; ++i) am = fmaxf(am, fabsf(x[j][i]));
        }
        am = wave_max(am);
        const float s = am > 0.f ? am * (1.f / 127.f) : 1.f, inv = 1.f / s;
#pragma unroll
        for (int j = 0; j < 4; ++j) {
            u32x2 o; o.x = q8pack4(x[j][0], x[j][1], x[j][2], x[j][3], inv); o.y = q8pack4(x[j][4], x[j][5], x[j][6], x[j][7], inv);
            *(u32x2*)(y8row + j * 512 + lane * 8) = o;
        }
        if (lane == 0) *sdst = s;
        return;
    }
#pragma unroll
    for (int j = 0; j < 4; ++j) {
        const float sc = (j == 0) ? rA : (j == 1) ? (lane < 32 ? rA : rB) : (j == 2) ? rB : rC;
        u32x4 o;
        o.x = pk2(bflo(v[j].x) * sc, bfhi(v[j].x) * sc); o.y = pk2(bflo(v[j].y) * sc, bfhi(v[j].y) * sc);
        o.z = pk2(bflo(v[j].z) * sc, bfhi(v[j].z) * sc); o.w = pk2(bflo(v[j].w) * sc, bfhi(v[j].w) * sc);
        *(u32x4*)(yrow + j * 512 + lane * 8) = o;
    }
}
__device__ __forceinline__ void ph_ynorm(const Params& p, int l) {
    const int tid = threadIdx.x, lane = tid & 63, wave = tid >> 6;
    const int gw = blockIdx.x * NWAVES + wave, NGW = gridDim.x * NWAVES;
    bf16_t* Y = (bf16_t*)(p.ws + WS_Y);
    const int nrows = (l == DEPTH - 1) ? NLAT : MTOT;
#pragma unroll 1
    for (int r = gw; r < nrows; r += 2 * NGW) {
        const int r2 = r + NGW; const bool has2 = r2 < nrows; const int rb = has2 ? r2 : r;
        u32x4 va[4], vb[4];
#pragma unroll
        for (int j = 0; j < 4; ++j) { va[j] = *(const u32x4*)(Y + (size_t)r * DM + j * 512 + lane * 8); vb[j] = *(const u32x4*)(Y + (size_t)rb * DM + j * 512 + lane * 8); }
        unsigned char* Y8 = (unsigned char*)(p.ws + WS_XN8); float* SY = (float*)(p.ws + WS_SCL) + SCL_Y;
        ynorm_row(Y + (size_t)r * DM, va, lane, Y8 + (size_t)r * DM, SY + r);
        if (has2) ynorm_row(Y + (size_t)r2 * DM, vb, lane, Y8 + (size_t)r2 * DM, SY + r2);
    }
}

__device__ __forceinline__ void wave_argmax(float& bv, int& bi) {
#pragma unroll
    for (int o = 32; o >= 1; o >>= 1) {
        const float ov = __shfl_xor(bv, o); const int oi = __shfl_xor(bi, o);
        if (ov > bv || (ov == bv && oi < bi)) { bv = ov; bi = oi; }
    }
}
__device__ __forceinline__ void route_half(const bf16_t* qh, const bf16_t* kh, int lane, float& tv, int& ti) {
    const unsigned qq = *(const unsigned*)(qh + 2 * lane);
    const float qa = bflo(qq), qb = bfhi(qq);
    const bf16_t* k0 = kh + (size_t)lane * 128;
    const bf16_t* k1 = k0 + 64 * 128;
    float d0 = 0.f, d1 = 0.f;
#pragma unroll 2
    for (int cb = 0; cb < 16; ++cb) {
        const u32x4 a = *(const u32x4*)(k0 + cb * 8), b = *(const u32x4*)(k1 + cb * 8);
        const unsigned aw[4] = {a.x, a.y, a.z, a.w}, bw[4] = {b.x, b.y, b.z, b.w};
#pragma unroll
        for (int i = 0; i < 4; ++i) {
            const int src = cb * 4 + i;
            const float x0 = __shfl(qa, src), x1 = __shfl(qb, src);
            d0 += x0 * bflo(aw[i]) + x1 * bfhi(aw[i]);
            d1 += x0 * bflo(bw[i]) + x1 * bfhi(bw[i]);
        }
    }
    float va = d0, vb = d1; tv = 0.f; ti = 0;
#pragma unroll 1
    for (int r = 0; r < 16; ++r) {
        float bv; int bi;
        if (va >= vb) { bv = va; bi = lane; } else { bv = vb; bi = lane + 64; }
        wave_argmax(bv, bi);
        if (lane == r) { tv = bv; ti = bi; }
        if (bi == lane) va = -INFINITY; else if (bi == lane + 64) vb = -INFINITY;
    }
}
__device__ __forceinline__ void ph_route_naive(const Params& p, int l) {
    const int tid = threadIdx.x, lane = tid & 63, wave = tid >> 6;
    const int gw = blockIdx.x * NWAVES + wave, NGW = gridDim.x * NWAVES;
    const bf16_t* QP = (const bf16_t*)(p.ws + WS_P);
    const bf16_t* KEYS = (const bf16_t*)(p.ws + WS_KEYS) + (size_t)l * 8 * 2 * 128 * 128;
    int* EID = (int*)(p.ws + WS_EID); float* GATE = (float*)(p.ws + WS_GATE);
    const int nrows = (l == DEPTH - 1) ? NLAT : MTOT;
#pragma unroll 1
    for (int tk = gw; tk < nrows * 8; tk += NGW) {
        const int t = tk >> 3, h = tk & 7;
        const bf16_t* qrow = QP + (size_t)t * DM + h * 256;
        float tv0, tv1; int ti0, ti1;
        route_half(qrow, KEYS + (size_t)(h * 2 + 0) * 128 * 128, lane, tv0, ti0);
        route_half(qrow + 128, KEYS + (size_t)(h * 2 + 1) * 128 * 128, lane, tv1, ti1);
        const float v1 = __shfl(tv0, lane >> 2);
        float c0 = v1 + __shfl(tv1, (lane & 3) * 4 + 0), c1 = v1 + __shfl(tv1, (lane & 3) * 4 + 1);
        float c2 = v1 + __shfl(tv1, (lane & 3) * 4 + 2), c3 = v1 + __shfl(tv1, (lane & 3) * 4 + 3);
        float myv = 0.f; int myc = 0;
#pragma unroll 1
        for (int r = 0; r < 16; ++r) {
            float bv = c0; int bi = lane * 4;
            if (c1 > bv) { bv = c1; bi = lane * 4 + 1; }
            if (c2 > bv) { bv = c2; bi = lane * 4 + 2; }
            if (c3 > bv) { bv = c3; bi = lane * 4 + 3; }
            wave_argmax(bv, bi);
            if (lane == r) { myv = bv; myc = bi; }
            if ((bi >> 2) == lane) {
                const int u = bi & 3;
                if (u == 0) c0 = -INFINITY; else if (u == 1) c1 = -INFINITY; else if (u == 2) c2 = -INFINITY; else c3 = -INFINITY;
            }
        }
        float mx = lane < 16 ? myv : -INFINITY;
        mx = fmaxf(mx, __shfl_xor(mx, 8)); mx = fmaxf(mx, __shfl_xor(mx, 4)); mx = fmaxf(mx, __shfl_xor(mx, 2)); mx = fmaxf(mx, __shfl_xor(mx, 1));
        const float e = lane < 16 ? __expf(myv - mx) : 0.f;
        float sm = e; sm += __shfl_xor(sm, 8); sm += __shfl_xor(sm, 4); sm += __shfl_xor(sm, 2); sm += __shfl_xor(sm, 1);
        const int i1 = __shfl(ti0, myc >> 4), i2 = __shfl(ti1, myc & 15);
        if (lane < 16) { EID[(size_t)t * 128 + h * 16 + lane] = i1 * 128 + i2; GATE[(size_t)t * 128 + h * 16 + lane] = e / sm; }
    }
}


namespace rt {
typedef short bf16x8 __attribute__((ext_vector_type(8)));
typedef float f32x16 __attribute__((ext_vector_type(16)));
__device__ __forceinline__ void insert16(float (&t)[16], float x) {
#pragma unroll
    for (int j = 15; j >= 1; --j) t[j] = __builtin_amdgcn_fmed3f(t[j - 1], t[j], x);
    t[0] = fmaxf(t[0], x);
}
__device__ __forceinline__ void half_top16(const unsigned char* klds, const bf16_t* qrow, int r32, int hh, float (&t)[16]) {
    bf16x8 qf[8];
#pragma unroll
    for (int s = 0; s < 8; ++s) qf[s] = *(const bf16x8*)(qrow + 16 * s);
#pragma unroll
    for (int k = 0; k < 16; ++k) t[k] = -3.0e38f;
    const unsigned hh4 = (unsigned)hh << 2;
#pragma unroll
    for (int kb = 0; kb < 4; ++kb) {
        f32x16 acc = {};
        const int row = kb * 32 + r32;
#pragma unroll
        for (int s = 0; s < 8; ++s) {
            const bf16x8 a = *(const bf16x8*)(klds + row * 256 + ((32 * s + 16 * hh) ^ ((row & 7) << 4)));
            acc = __builtin_amdgcn_mfma_f32_32x32x16_bf16(a, qf[s], acc, 0, 0, 0);
        }
#pragma unroll
        for (int r = 0; r < 16; ++r) {
            const unsigned key = (unsigned)(kb * 32 + (r & 3) + 8 * (r >> 2)) | hh4;
            insert16(t, __uint_as_float((__float_as_uint(acc[r]) & ~127u) | key));
        }
    }
    float o[16];
#pragma unroll
    for (int k = 0; k < 16; ++k) o[k] = __shfl_xor(t[k], 32);
#pragma unroll
    for (int k = 0; k < 16; ++k) insert16(t, o[k]);
}
}
template <bool OWN_UNITS>
__device__ __forceinline__ void ph_route_fast(const Params& p, int l, unsigned char* lds) {
    int tid_ = threadIdx.x; asm volatile("" : "+v"(tid_));
    const int tid = tid_, lane = tid & 63, wave = tid >> 6, r32 = lane & 31, hh = lane >> 5;
    const bf16_t* QP = (const bf16_t*)(p.ws + WS_P);
    const bf16_t* KEYS = (const bf16_t*)(p.ws + WS_KEYS) + (size_t)l * 8 * 2 * 128 * 128;
    int* EID = (int*)(p.ws + WS_EID); float* GATE = (float*)(p.ws + WS_GATE);
    const int ntile = ((l == DEPTH - 1) ? NLAT : MTOT) / 256;
    unsigned* tab = (unsigned*)(lds + 65536) + wave * 2048;
    pg8::StaticOrder So; So.init(ntile * 256, DM, (int)gridDim.x, (int)blockIdx.x);
#pragma unroll 1
    for (int ui = 0;; ++ui) {
        int tile, h;
        if (OWN_UNITS) { pg8::Unit uu; if (!So.next(ui, uu)) break; tile = uu.pm; h = uu.pn; }
        else { const int u = blockIdx.x + ui * (int)gridDim.x; if (u >= ntile * 8) break; tile = u >> 3; h = u & 7; }
        __syncthreads();
        const u32x4* ksrc = (const u32x4*)(KEYS + (size_t)h * 2 * 128 * 128);
#pragma unroll
        for (int i = 0; i < 8; ++i) { const int c = tid + i * 512, row = c >> 4, cc = c & 15; *(u32x4*)(lds + row * 256 + ((cc * 16) ^ ((row & 7) << 4))) = ksrc[c]; }
        __syncthreads();
        const int tok = tile * 256 + wave * 32 + r32;
        const bf16_t* qrow = QP + (size_t)tok * DM + h * 256 + hh * 8;
        float v1[16], v2[16];
        rt::half_top16(lds, qrow, r32, hh, v1);
        rt::half_top16(lds + 32768, qrow + 128, r32, hh, v2);
        float c[16];
#pragma unroll
        for (int k = 0; k < 16; ++k) c[k] = -3.0e38f;
#pragma unroll
        for (int i = 0; i < 16; ++i)
#pragma unroll
            for (int j = 0; j < 16; ++j)
                if ((i + 1) * (j + 1) <= 16) rt::insert16(c, __uint_as_float((__float_as_uint(v1[i] + v2[j]) & ~255u) | (unsigned)(i * 16 + j)));
#pragma unroll
        for (int k = 0; k < 16; ++k) { tab[k * 64 + lane] = __float_as_uint(v1[k]); tab[(16 + k) * 64 + lane] = __float_as_uint(v2[k]); }
        LDS_WAIT();
        float e[16], sum = 0.f;
#pragma unroll
        for (int k = 0; k < 16; ++k) { e[k] = __expf(c[k] - c[0]); sum += e[k]; }
        const float inv = 1.f / sum;
        unsigned out[16];
#pragma unroll
        for (int k = 0; k < 16; ++k) {
            const unsigned code = __float_as_uint(c[k]) & 255u;
            const unsigned i1 = tab[(code >> 4) * 64 + lane] & 127u, i2 = tab[(16 + (code & 15u)) * 64 + lane] & 127u;
            out[k] = hh == 0 ? (i1 * 128u + i2) : __float_as_uint(e[k] * inv);
        }
        unsigned* dst = (hh == 0 ? (unsigned*)EID : (unsigned*)GATE) + (size_t)tok * 128 + h * 16;
#pragma unroll
        for (int k = 0; k < 4; ++k) { u32x4 w; w.x = out[4 * k]; w.y = out[4 * k + 1]; w.z = out[4 * k + 2]; w.w = out[4 * k + 3]; *(u32x4*)(dst + 4 * k) = w; }
        LDS_WAIT();
    }
}
#ifndef USE_FAST_ROUTE
#define USE_FAST_ROUTE 1
#endif


#if GATHER_I8
__device__ __forceinline__ float dpp_shr(float v, int n) {
    const int iv = __builtin_bit_cast(int, v); int r;
    switch (n) { case 1: r = __builtin_amdgcn_update_dpp(0, iv, 0x111, 0xf, 0xf, true); break; case 2: r = __builtin_amdgcn_update_dpp(0, iv, 0x112, 0xf, 0xf, true); break;
                 case 4: r = __builtin_amdgcn_update_dpp(0, iv, 0x114, 0xf, 0xf, true); break; default: r = __builtin_amdgcn_update_dpp(0, iv, 0x118, 0xf, 0xf, true); break; }
    return __builtin_bit_cast(float, r);
}
__device__ __forceinline__ float wave_total(float v) {
    v += dpp_shr(v, 1); v += dpp_shr(v, 2); v += dpp_shr(v, 4); v += dpp_shr(v, 8);
    v += __builtin_bit_cast(float, __builtin_amdgcn_update_dpp(0, __builtin_bit_cast(int, v), 0x142, 0xa, 0xf, false));
    v += __builtin_bit_cast(float, __builtin_amdgcn_update_dpp(0, __builtin_bit_cast(int, v), 0x143, 0xc, 0xf, false));
    return __uint_as_float(__builtin_amdgcn_readlane(__float_as_uint(v), 63));
}
#define UB0(w) ((float)((w) & 0xffu))
#define UB1(w) ((float)(((w) >> 8) & 0xffu))
#define UB2(w) ((float)(((w) >> 16) & 0xffu))
#define UB3(w) ((float)((w) >> 24))

__device__ __forceinline__ float dpp_xor1(float v) { return __builtin_bit_cast(float, __builtin_amdgcn_update_dpp(0, __builtin_bit_cast(int, v), 0xB1, 0xf, 0xf, false)); }
__device__ __forceinline__ float dpp_xor2(float v) { return __builtin_bit_cast(float, __builtin_amdgcn_update_dpp(0, __builtin_bit_cast(int, v), 0x4E, 0xf, 0xf, false)); }
__device__ __forceinline__ float dpp_xor8(float v) { return __builtin_bit_cast(float, __builtin_amdgcn_update_dpp(0, __builtin_bit_cast(int, v), 0x128, 0xf, 0xf, false)); }
__device__ __forceinline__ float reduce8_rows(const float (&d)[8], int lane) {
    const bool b0 = lane & 1, b1 = lane & 2, b2 = lane & 4;
    float r[4];
#pragma unroll
    for (int k = 0; k < 4; ++k) r[k] = (b0 ? d[2 * k + 1] : d[2 * k]) + dpp_xor1(b0 ? d[2 * k] : d[2 * k + 1]);
    float t[2];
#pragma unroll
    for (int k = 0; k < 2; ++k) t[k] = (b1 ? r[2 * k + 1] : r[2 * k]) + dpp_xor2(b1 ? r[2 * k] : r[2 * k + 1]);
    float u = (b2 ? t[1] : t[0]) + __shfl_xor(b2 ? t[0] : t[1], 4);
    u += dpp_xor8(u);
    u += __shfl_xor(u, 16);
    u += __shfl_xor(u, 32);
    return u;
}
#if GATHER_4BIT
#ifndef DRY_MODE
#define DRY_MODE 0
#endif
typedef float f32x2 __attribute__((ext_vector_type(2)));
__device__ __forceinline__ void ph_gather(const Params& p, int l, const bool dry) {
    const int tid = threadIdx.x, lane = tid & 63, wave = tid >> 6;
    const int gw = blockIdx.x * NWAVES + wave, NGW = gridDim.x * NWAVES;
    const bf16_t* XN = (const bf16_t*)(p.ws + WS_XN);
    const unsigned char* UT = (const unsigned char*)(p.ws + WS_UT) + (size_t)l * NEXP * ROW4;
    const unsigned char* VT = (const unsigned char*)(p.ws + WS_VT) + (size_t)l * NEXP * ROW4;
    const int* EID = (const int*)(p.ws + WS_EID); const float* GATE = (const float*)(p.ws + WS_GATE);
    const float* mod = (const float*)(p.ws + WS_MOD) + (size_t)l * 9 * 12288;
    const int nrows = (l == DEPTH - 1) ? NLAT : MTOT;
#pragma unroll 1
    for (int t = gw; t < nrows; t += NGW) {
        int xh[4], xl[4]; float sxl;
#if GEMM_I8 && GEMM3_I8
        {
            sxl = ((const float*)(p.ws + WS_SCL))[SCL_XN + t];
            const unsigned char* x8 = (const unsigned char*)(p.ws + WS_XN8) + (size_t)t * DM;
#pragma unroll
            for (int j = 0; j < 2; ++j) {
                const u32x4 q4 = *(const u32x4*)(x8 + j * 1024 + lane * 16);
                const unsigned ww[4] = {q4.x, q4.y, q4.z, q4.w};
#pragma unroll
                for (int dd = 0; dd < 2; ++dd) {
                    unsigned h = 0u, lo = 0u;
#pragma unroll
                    for (int k = 0; k < 8; ++k) {
                        const int q = (int)(signed char)((ww[dd * 2 + (k >> 2)] >> (8 * (k & 3))) & 0xffu);
                        const int ql = ((q + 8) & 15) - 8, qh = (q - ql) >> 4;
                        h |= ((unsigned)qh & 15u) << (4 * k); lo |= ((unsigned)ql & 15u) << (4 * k);
                    }
                    xh[j * 2 + dd] = (int)h; xl[j * 2 + dd] = (int)lo;
                }
            }
        }
#else
        {
            float x[32]; float am = 0.f;
#pragma unroll
            for (int j = 0; j < 2; ++j)
#pragma unroll
                for (int k = 0; k < 2; ++k) {
                    const u32x4 q = *(const u32x4*)(XN + (size_t)t * DM + j * 1024 + lane * 16 + k * 8);
                    float* xx = x + j * 16 + k * 8;
                    xx[0] = bflo(q.x); xx[1] = bfhi(q.x); xx[2] = bflo(q.y); xx[3] = bfhi(q.y); xx[4] = bflo(q.z); xx[5] = bfhi(q.z); xx[6] = bflo(q.w); xx[7] = bfhi(q.w);
                }
#pragma unroll
            for (int i = 0; i < 32; ++i) am = fmaxf(am, fabsf(x[i]));
            sxl = am > 0.f ? am * (1.f / 119.f) : 1.f;
            const float inv = 1.f / sxl;
#pragma unroll
            for (int d = 0; d < 4; ++d) {
                unsigned h = 0u, lo = 0u;
#pragma unroll
                for (int k = 0; k < 8; ++k) {
                    const int q = (int)rintf(x[8 * d + k] * inv);
                    const int ql = ((q + 8) & 15) - 8, qh = (q - ql) >> 4;
                    h |= ((unsigned)qh & 15u) << (4 * k); lo |= ((unsigned)ql & 15u) << (4 * k);
                }
                xh[d] = (int)h; xl[d] = (int)lo;
            }
        }
#endif
        const int e0 = EID[(size_t)t * 128 + lane], e1 = EID[(size_t)t * 128 + 64 + lane];
        const float g0 = GATE[(size_t)t * 128 + lane], g1 = GATE[(size_t)t * 128 + 64 + lane];
        float hid0 = 0.f, hid1 = 0.f;
        constexpr int GB = 8;
#define G_LOAD(W, S, TAB, EB) do { _Pragma("unroll") for (int i = 0; i < GB; ++i) { \
            const int id_ = __builtin_amdgcn_readlane((EB) < 64 ? e0 : e1, ((EB) + i) & 63); \
            const unsigned char* row_ = (TAB) + (size_t)id_ * ROW4; \
            W[i] = *(const u32x4*)(row_ + lane * 16); S[i] = *(const unsigned short*)(row_ + 1024 + lane * 2); } } while (0)
#define G_DOT(W, S, EB) do { float dd_[8]; _Pragma("unroll") for (int i = 0; i < GB; ++i) { int sh_ = 0, sl_ = 0; \
            const unsigned ww[4] = {W[i].x, W[i].y, W[i].z, W[i].w}; \
            _Pragma("unroll") for (int d = 0; d < 4; ++d) { \
                sh_ = __builtin_amdgcn_sdot8((int)ww[d], xh[d], sh_, false); \
                sl_ = __builtin_amdgcn_sdot8((int)ww[d], xl[d], sl_, false); } \
            dd_[i] = (float)((sh_ << 4) + sl_) * (sxl * bf2f(S[i])); } \
            const float tot = reduce8_rows(dd_, lane);              \
            if ((lane & 56) == ((EB) & 63)) { if ((EB) < 64) hid0 = tot; else hid1 = tot; } } while (0)
#define G_AXPY(W, S, EB) do { _Pragma("unroll") for (int i = 0; i < GB; ++i) { \
            const float m_ = __uint_as_float(__builtin_amdgcn_readlane(__float_as_uint((EB) < 64 ? cf0 : cf1), ((EB) + i) & 63)) * bf2f(S[i]); \
            const f32x2 mm = {m_, m_}; \
            const unsigned ww[4] = {W[i].x, W[i].y, W[i].z, W[i].w}; \
            _Pragma("unroll") for (int d = 0; d < 4; ++d) { \
                acc[4 * d + 0] += mm * __builtin_amdgcn_cvt_scalef32_pk_f32_fp4(ww[d], 1.0f, 0); \
                acc[4 * d + 1] += mm * __builtin_amdgcn_cvt_scalef32_pk_f32_fp4(ww[d], 1.0f, 1); \
                acc[4 * d + 2] += mm * __builtin_amdgcn_cvt_scalef32_pk_f32_fp4(ww[d], 1.0f, 2); \
                acc[4 * d + 3] += mm * __builtin_amdgcn_cvt_scalef32_pk_f32_fp4(ww[d], 1.0f, 3); } } } while (0)
        u32x4 wa[GB], wb[GB]; unsigned sa[GB], sb[GB];
        const bool do_u = !(dry && (DRY_MODE == 4 || DRY_MODE == 5)), do_v = !(dry && (DRY_MODE == 3 || DRY_MODE == 5));
        if (do_u) G_LOAD(wa, sa, UT, 0); else G_LOAD(wa, sa, VT, 0);
#pragma unroll 1
        for (int eb = 0; eb < (do_u ? 128 : 0); eb += 2 * GB) {
            G_LOAD(wb, sb, UT, eb + GB);
            G_DOT(wa, sa, eb);
            if (eb + 2 * GB < 128) G_LOAD(wa, sa, UT, eb + 2 * GB); else G_LOAD(wa, sa, VT, 0);
            G_DOT(wb, sb, eb + GB);
        }
        const float cf0 = gelu_tanh(hid0) * g0, cf1 = gelu_tanh(hid1) * g1;
        f32x2 acc[16];
#pragma unroll
        for (int i = 0; i < 16; ++i) acc[i] = (f32x2){0.f, 0.f};
#pragma unroll 1
        for (int eb = 0; eb < (do_v ? 128 : 0); eb += 2 * GB) {
            G_LOAD(wb, sb, VT, eb + GB);
            G_AXPY(wa, sa, eb);
            if (eb + 2 * GB < 128) G_LOAD(wa, sa, VT, eb + 2 * GB);
            G_AXPY(wb, sb, eb + GB);
        }
#undef G_LOAD
#undef G_DOT
#undef G_AXPY
        float hn[32];
        const int bb = t < NLAT ? (t >> 11) : 8;
        const float* gate = mod + (size_t)bb * 12288 + 5 * DM;
#if H_BF16 && GEMM_I8 && GEMM3_I8
        {
            bf16_t* hbrow = (bf16_t*)(p.ws + WS_HB) + (size_t)t * DM;
            const bool fin = (l == DEPTH - 1);
#pragma unroll
            for (int j = 0; j < 2; ++j) {
                const u32x4 q0 = *(const u32x4*)(hbrow + j * 1024 + lane * 16), q1 = *(const u32x4*)(hbrow + j * 1024 + lane * 16 + 8);
                const unsigned qq[8] = {q0.x, q0.y, q0.z, q0.w, q1.x, q1.y, q1.z, q1.w};
#pragma unroll
                for (int k = 0; k < 4; ++k) {
                    const f32x4 gv = *(const f32x4*)(gate + j * 1024 + lane * 16 + k * 4);
                    const f32x2 a0 = acc[j * 8 + k * 2], a1 = acc[j * 8 + k * 2 + 1];
                    hn[j * 16 + k * 4 + 0] = bflo(qq[2 * k]) + gv.x * a0.x; hn[j * 16 + k * 4 + 1] = bfhi(qq[2 * k]) + gv.y * a0.y;
                    hn[j * 16 + k * 4 + 2] = bflo(qq[2 * k + 1]) + gv.z * a1.x; hn[j * 16 + k * 4 + 3] = bfhi(qq[2 * k + 1]) + gv.w * a1.y;
                }
                if (fin) {
                    float* orow = (dry ? (float*)(p.ws + WS_DUMMY) + (size_t)(t & 16383) * DM : p.out + (size_t)t * DM) + j * 1024 + lane * 16;
#pragma unroll
                    for (int k = 0; k < 4; ++k) *(f32x4*)(orow + k * 4) = (f32x4){hn[j * 16 + k * 4], hn[j * 16 + k * 4 + 1], hn[j * 16 + k * 4 + 2], hn[j * 16 + k * 4 + 3]};
                } else {
                    bf16_t* orow = (dry ? (bf16_t*)(p.ws + WS_DUMMY) + (size_t)(t & 16383) * DM : hbrow) + j * 1024 + lane * 16;
                    u32x4 w0, w1;
                    w0.x = pk2(hn[j * 16 + 0], hn[j * 16 + 1]); w0.y = pk2(hn[j * 16 + 2], hn[j * 16 + 3]); w0.z = pk2(hn[j * 16 + 4], hn[j * 16 + 5]); w0.w = pk2(hn[j * 16 + 6], hn[j * 16 + 7]);
                    w1.x = pk2(hn[j * 16 + 8], hn[j * 16 + 9]); w1.y = pk2(hn[j * 16 + 10], hn[j * 16 + 11]); w1.z = pk2(hn[j * 16 + 12], hn[j * 16 + 13]); w1.w = pk2(hn[j * 16 + 14], hn[j * 16 + 15]);
                    *(u32x4*)orow = w0; *(u32x4*)(orow + 8) = w1;
                }
            }
        }
#else
        float* hrow = t < NLAT ? p.out + (size_t)t * DM : (float*)(p.ws + WS_HC) + (size_t)(t - NLAT) * DM;
#pragma unroll
        for (int j = 0; j < 2; ++j)
#pragma unroll
            for (int k = 0; k < 4; ++k) {
                const int col = j * 1024 + lane * 16 + k * 4;
                const f32x4 hv = *(const f32x4*)(hrow + col), gv = *(const f32x4*)(gate + col);
                const f32x2 a0 = acc[j * 8 + k * 2], a1 = acc[j * 8 + k * 2 + 1];
                f32x4 o;
                o.x = hv.x + gv.x * a0.x; o.y = hv.y + gv.y * a0.y; o.z = hv.z + gv.z * a1.x; o.w = hv.w + gv.w * a1.y;
                *(f32x4*)((dry ? (float*)(p.ws + WS_DUMMY) + (size_t)(t & 16383) * DM : hrow) + col) = o;
                hn[j * 16 + k * 4 + 0] = o.x; hn[j * 16 + k * 4 + 1] = o.y; hn[j * 16 + k * 4 + 2] = o.z; hn[j * 16 + k * 4 + 3] = o.w;
            }
#endif
        if (l + 1 < DEPTH) {
            float ss = 0.f;
#pragma unroll
            for (int i = 0; i < 32; ++i) ss += hn[i] * hn[i];
            const float rstd = rsqrtf(wave_total(ss) * (1.f / DM) + EPS);
            const float* g1n = p.norm1_g + (l + 1) * DM;
            const float* shift = mod + (size_t)9 * 12288 + (size_t)bb * 12288;
            const float* scale = shift + DM;
            if (GEMM_I8) {
                float am = 0.f;
#pragma unroll
                for (int j = 0; j < 2; ++j)
#pragma unroll
                    for (int i = 0; i < 16; ++i) { const int col = j * 1024 + lane * 16 + i; hn[j * 16 + i] = hn[j * 16 + i] * rstd * g1n[col] * (1.f + scale[col]) + shift[col]; am = fmaxf(am, fabsf(hn[j * 16 + i])); }
                am = wave_max(am);
                const float s8 = am > 0.f ? am * (1.f / 127.f) : 1.f, inv8 = 1.f / s8;
                unsigned char* xo8 = (dry ? (unsigned char*)(p.ws + WS_DUMMY) + (size_t)(t & 16383) * DM : (unsigned char*)(p.ws + WS_XN8) + (size_t)t * DM);
#pragma unroll
                for (int j = 0; j < 2; ++j) {
                    u32x4 w;
                    w.x = q8pack4(hn[j * 16 + 0], hn[j * 16 + 1], hn[j * 16 + 2], hn[j * 16 + 3], inv8); w.y = q8pack4(hn[j * 16 + 4], hn[j * 16 + 5], hn[j * 16 + 6], hn[j * 16 + 7], inv8);
                    w.z = q8pack4(hn[j * 16 + 8], hn[j * 16 + 9], hn[j * 16 + 10], hn[j * 16 + 11], inv8); w.w = q8pack4(hn[j * 16 + 12], hn[j * 16 + 13], hn[j * 16 + 14], hn[j * 16 + 15], inv8);
                    *(u32x4*)(xo8 + j * 1024 + lane * 16) = w;
                }
                if (lane == 0 && !dry) ((float*)(p.ws + WS_SCL))[SCL_XN + t] = s8;
            } else {
            bf16_t* xo = (dry ? (bf16_t*)(p.ws + WS_DUMMY) + (size_t)(t & 16383) * DM : (bf16_t*)(p.ws + WS_XN) + (size_t)t * DM);
#pragma unroll
            for (int j = 0; j < 2; ++j)
#pragma unroll
                for (int k = 0; k < 2; ++k) {
                    const int col = j * 1024 + lane * 16 + k * 8;
                    float xv[8];
#pragma unroll
                    for (int i = 0; i < 8; ++i) xv[i] = hn[j * 16 + k * 8 + i] * rstd * g1n[col + i] * (1.f + scale[col + i]) + shift[col + i];
                    u32x4 w; w.x = pk2(xv[0], xv[1]); w.y = pk2(xv[2], xv[3]); w.z = pk2(xv[4], xv[5]); w.w = pk2(xv[6], xv[7]);
                    *(u32x4*)(xo + col) = w;
                }
            }
        }
    }
}
#else
#ifndef DRY_MODE
#define DRY_MODE 0
#endif
typedef float f32x2 __attribute__((ext_vector_type(2)));
__device__ __forceinline__ void ph_gather(const Params& p, int l, const bool dry) {
    const int tid = threadIdx.x, lane = tid & 63, wave = tid >> 6;
    const int gw = blockIdx.x * NWAVES + wave, NGW = gridDim.x * NWAVES;
    const bf16_t* XN = (const bf16_t*)(p.ws + WS_XN);
    const unsigned char* UT = (const unsigned char*)(p.ws + WS_UT) + (size_t)l * NEXP * DM;
    const unsigned char* VT = (const unsigned char*)(p.ws + WS_VT) + (size_t)l * NEXP * DM;
    const float* USC = (const float*)(p.ws + WS_USC) + l * NEXP; const float* VSC = (const float*)(p.ws + WS_VSC) + l * NEXP;
    const int* EID = (const int*)(p.ws + WS_EID); const float* GATE = (const float*)(p.ws + WS_GATE);
    const float* mod = (const float*)(p.ws + WS_MOD) + (size_t)l * 9 * 12288;
    const int nrows = (l == DEPTH - 1) ? NLAT : MTOT;
#pragma unroll 1
    for (int t = gw; t < nrows; t += NGW) {
        int xq[8]; float sxl;
        {
            float x[32]; float am = 0.f;
#pragma unroll
            for (int j = 0; j < 2; ++j)
#pragma unroll
                for (int k = 0; k < 2; ++k) {
                    const u32x4 q = *(const u32x4*)(XN + (size_t)t * DM + j * 1024 + lane * 16 + k * 8);
                    float* xx = x + j * 16 + k * 8;
                    xx[0] = bflo(q.x); xx[1] = bfhi(q.x); xx[2] = bflo(q.y); xx[3] = bfhi(q.y); xx[4] = bflo(q.z); xx[5] = bfhi(q.z); xx[6] = bflo(q.w); xx[7] = bfhi(q.w);
                }
#pragma unroll
            for (int i = 0; i < 32; ++i) am = fmaxf(am, fabsf(x[i]));
            sxl = am > 0.f ? am * (1.f / 127.f) : 1.f;
            const float inv = 1.f / sxl;
#pragma unroll
            for (int d = 0; d < 8; ++d) {
                const int q0 = (int)rintf(x[4 * d] * inv), q1 = (int)rintf(x[4 * d + 1] * inv), q2 = (int)rintf(x[4 * d + 2] * inv), q3 = (int)rintf(x[4 * d + 3] * inv);
                xq[d] = (int)(((unsigned)q0 & 0xffu) | (((unsigned)q1 & 0xffu) << 8) | (((unsigned)q2 & 0xffu) << 16) | ((unsigned)q3 << 24));
            }
        }
        const int e0 = EID[(size_t)t * 128 + lane], e1 = EID[(size_t)t * 128 + 64 + lane];
        const float g0 = GATE[(size_t)t * 128 + lane], g1 = GATE[(size_t)t * 128 + 64 + lane];
        const float us0 = USC[e0], us1 = USC[e1], vs0 = VSC[e0], vs1 = VSC[e1];
        float hid0 = 0.f, hid1 = 0.f;
        constexpr int GBU = 8, GBV = 4;
#define G_LOAD(W, TAB, EB, NB) do { _Pragma("unroll") for (int i = 0; i < NB; ++i) { \
            const int id_ = __builtin_amdgcn_readlane((EB) < 64 ? e0 : e1, ((EB) + i) & 63); \
            const unsigned char* row_ = (TAB) + (size_t)id_ * DM + lane * 16; \
            W[i][0] = *(const u32x4*)row_; W[i][1] = *(const u32x4*)(row_ + 1024); } } while (0)
#define G_DOT(W, EB) do { _Pragma("unroll") for (int i = 0; i < GBU; ++i) { int s_ = 0; \
            s_ = __builtin_amdgcn_sdot4((int)W[i][0].x, xq[0], s_, false); s_ = __builtin_amdgcn_sdot4((int)W[i][0].y, xq[1], s_, false); \
            s_ = __builtin_amdgcn_sdot4((int)W[i][0].z, xq[2], s_, false); s_ = __builtin_amdgcn_sdot4((int)W[i][0].w, xq[3], s_, false); \
            s_ = __builtin_amdgcn_sdot4((int)W[i][1].x, xq[4], s_, false); s_ = __builtin_amdgcn_sdot4((int)W[i][1].y, xq[5], s_, false); \
            s_ = __builtin_amdgcn_sdot4((int)W[i][1].z, xq[6], s_, false); s_ = __builtin_amdgcn_sdot4((int)W[i][1].w, xq[7], s_, false); \
            const float tot = wave_total((float)s_ * sxl); \
            if ((((EB) + i) & 63) == lane) { if ((EB) < 64) hid0 = tot; else hid1 = tot; } } } while (0)
#define G_AXPY(W, EB) do { _Pragma("unroll") for (int i = 0; i < GBV; ++i) { \
            const float cf_ = __uint_as_float(__builtin_amdgcn_readlane(__float_as_uint((EB) < 64 ? cf0 : cf1), ((EB) + i) & 63)); \
            const f32x2 mm = {cf_, cf_}; \
            _Pragma("unroll") for (int j = 0; j < 2; ++j) { const unsigned ww[4] = {W[i][j].x, W[i][j].y, W[i][j].z, W[i][j].w}; \
                _Pragma("unroll") for (int k = 0; k < 4; ++k) { \
                    acc[j * 8 + k * 2] += mm * __builtin_amdgcn_cvt_pk_f32_fp8((int)ww[k], false); \
                    acc[j * 8 + k * 2 + 1] += mm * __builtin_amdgcn_cvt_pk_f32_fp8((int)ww[k], true); } } } } while (0)
        u32x4 wa[GBU][2], wb[GBU][2];
        const bool do_u = !(dry && (DRY_MODE == 4 || DRY_MODE == 5)), do_v = !(dry && (DRY_MODE == 3 || DRY_MODE == 5));
        if (do_u) G_LOAD(wa, UT, 0, GBU); else G_LOAD(wa, VT, 0, GBV);
#pragma unroll 1
        for (int eb = 0; eb < (do_u ? 128 : 0); eb += 2 * GBU) {
            G_LOAD(wb, UT, eb + GBU, GBU);
            G_DOT(wa, eb);
            if (eb + 2 * GBU < 128) G_LOAD(wa, UT, eb + 2 * GBU, GBU); else G_LOAD(wa, VT, 0, GBV);
            G_DOT(wb, eb + GBU);
        }
        const float cf0 = gelu_tanh(hid0 * us0) * g0 * vs0, cf1 = gelu_tanh(hid1 * us1) * g1 * vs1;
        f32x2 acc[16];
#pragma unroll
        for (int i = 0; i < 16; ++i) acc[i] = (f32x2){0.f, 0.f};
#pragma unroll 1
        for (int eb = 0; eb < (do_v ? 128 : 0); eb += 2 * GBV) {
            G_LOAD(wb, VT, eb + GBV, GBV);
            G_AXPY(wa, eb);
            if (eb + 2 * GBV < 128) G_LOAD(wa, VT, eb + 2 * GBV, GBV);
            G_AXPY(wb, eb + GBV);
        }
#undef G_LOAD
#undef G_DOT
#undef G_AXPY
        float hn[32];
        float* hrow = t < NLAT ? p.out + (size_t)t * DM : (float*)(p.ws + WS_HC) + (size_t)(t - NLAT) * DM;
        const int bb = t < NLAT ? (t >> 11) : 8;
        const float* gate = mod + (size_t)bb * 12288 + 5 * DM;
#pragma unroll
        for (int j = 0; j < 2; ++j)
#pragma unroll
            for (int k = 0; k < 4; ++k) {
                const int col = j * 1024 + lane * 16 + k * 4;
                const f32x4 hv = *(const f32x4*)(hrow + col), gv = *(const f32x4*)(gate + col);
                const f32x2 a0 = acc[j * 8 + k * 2], a1 = acc[j * 8 + k * 2 + 1];
                f32x4 o;
                o.x = hv.x + gv.x * a0.x; o.y = hv.y + gv.y * a0.y; o.z = hv.z + gv.z * a1.x; o.w = hv.w + gv.w * a1.y;
                *(f32x4*)((dry ? (float*)(p.ws + WS_DUMMY) + (size_t)(t & 16383) * DM : hrow) + col) = o;
                hn[j * 16 + k * 4 + 0] = o.x; hn[j * 16 + k * 4 + 1] = o.y; hn[j * 16 + k * 4 + 2] = o.z; hn[j * 16 + k * 4 + 3] = o.w;
            }
        if (l + 1 < DEPTH) {
            float ss = 0.f;
#pragma unroll
            for (int i = 0; i < 32; ++i) ss += hn[i] * hn[i];
            const float rstd = rsqrtf(wave_total(ss) * (1.f / DM) + EPS);
            const float* g1n = p.norm1_g + (l + 1) * DM;
            const float* shift = mod + (size_t)9 * 12288 + (size_t)bb * 12288;
            const float* scale = shift + DM;
            bf16_t* xo = (dry ? (bf16_t*)(p.ws + WS_DUMMY) + (size_t)(t & 16383) * DM : (bf16_t*)(p.ws + WS_XN) + (size_t)t * DM);
#pragma unroll
            for (int j = 0; j < 2; ++j)
#pragma unroll
                for (int k = 0; k < 2; ++k) {
                    const int col = j * 1024 + lane * 16 + k * 8;
                    float xv[8];
#pragma unroll
                    for (int i = 0; i < 8; ++i) xv[i] = hn[j * 16 + k * 8 + i] * rstd * g1n[col + i] * (1.f + scale[col + i]) + shift[col + i];
                    u32x4 w; w.x = pk2(xv[0], xv[1]); w.y = pk2(xv[2], xv[3]); w.z = pk2(xv[4], xv[5]); w.w = pk2(xv[6], xv[7]);
                    *(u32x4*)(xo + col) = w;
                }
        }
    }
}
#endif
#else
__device__ __forceinline__ float dot8(const u32x4 u, const u32x4 x) {
    float d = bflo(u.x) * bflo(x.x) + bfhi(u.x) * bfhi(x.x);
    d += bflo(u.y) * bflo(x.y) + bfhi(u.y) * bfhi(x.y);
    d += bflo(u.z) * bflo(x.z) + bfhi(u.z) * bfhi(x.z);
    d += bflo(u.w) * bflo(x.w) + bfhi(u.w) * bfhi(x.w);
    return d;
}
__device__ __forceinline__ void ph_gather(const Params& p, int l, const bool dry) {
    const int tid = threadIdx.x, lane = tid & 63, wave = tid >> 6;
    const int gw = blockIdx.x * NWAVES + wave, NGW = gridDim.x * NWAVES;
    const bf16_t* XN = (const bf16_t*)(p.ws + WS_XN);
    const bf16_t* UT = (const bf16_t*)(p.ws + WS_UT) + (size_t)l * NEXP * DM;
    const bf16_t* VT = (const bf16_t*)(p.ws + WS_VT) + (size_t)l * NEXP * DM;
    const int* EID = (const int*)(p.ws + WS_EID); const float* GATE = (const float*)(p.ws + WS_GATE);
    const float* mod = (const float*)(p.ws + WS_MOD) + (size_t)l * 9 * 12288;
    const int nrows = (l == DEPTH - 1) ? NLAT : MTOT;
    for (int t = gw; t < nrows; t += NGW) {
        u32x4 xq[4];
#pragma unroll
        for (int j = 0; j < 4; ++j) xq[j] = *(const u32x4*)(XN + (size_t)t * DM + j * 512 + lane * 8);
        const int e0 = EID[(size_t)t * 128 + lane], e1 = EID[(size_t)t * 128 + 64 + lane];
        const float g0 = GATE[(size_t)t * 128 + lane], g1 = GATE[(size_t)t * 128 + 64 + lane];
        float hid0 = 0.f, hid1 = 0.f;
#pragma unroll 1
        for (int eb = 0; eb < 128; eb += 4) {
            u32x4 uu[4][4];
#pragma unroll
            for (int i = 0; i < 4; ++i) {
                const int e = eb + i;
                const int id = __builtin_amdgcn_readlane(eb < 64 ? e0 : e1, e & 63);
                const u32x4* ur = (const u32x4*)(UT + (size_t)id * DM) + lane;
#pragma unroll
                for (int j = 0; j < 4; ++j) uu[i][j] = ur[j * 64];
            }
#pragma unroll
            for (int i = 0; i < 4; ++i) {
                const int e = eb + i;
                float d = dot8(uu[i][0], xq[0]) + dot8(uu[i][1], xq[1]) + dot8(uu[i][2], xq[2]) + dot8(uu[i][3], xq[3]);
                d = wave_sum(d);
                if ((e & 63) == lane) { if (eb < 64) hid0 = d; else hid1 = d; }
            }
        }
        const float cf0 = gelu_tanh(hid0) * g0, cf1 = gelu_tanh(hid1) * g1;
        float acc[32];
#pragma unroll
        for (int i = 0; i < 32; ++i) acc[i] = 0.f;
#pragma unroll 1
        for (int eb = 0; eb < 128; eb += 4) {
            u32x4 vv[4][4]; float cf[4];
#pragma unroll
            for (int i = 0; i < 4; ++i) {
                const int e = eb + i;
                const int id = __builtin_amdgcn_readlane(eb < 64 ? e0 : e1, e & 63);
                cf[i] = __uint_as_float(__builtin_amdgcn_readlane(__float_as_uint(eb < 64 ? cf0 : cf1), e & 63));
                const u32x4* vr = (const u32x4*)(VT + (size_t)id * DM) + lane;
#pragma unroll
                for (int j = 0; j < 4; ++j) vv[i][j] = vr[j * 64];
            }
#pragma unroll
            for (int i = 0; i < 4; ++i)
#pragma unroll
                for (int j = 0; j < 4; ++j) {
                    acc[j * 8 + 0] += cf[i] * bflo(vv[i][j].x); acc[j * 8 + 1] += cf[i] * bfhi(vv[i][j].x);
                    acc[j * 8 + 2] += cf[i] * bflo(vv[i][j].y); acc[j * 8 + 3] += cf[i] * bfhi(vv[i][j].y);
                    acc[j * 8 + 4] += cf[i] * bflo(vv[i][j].z); acc[j * 8 + 5] += cf[i] * bfhi(vv[i][j].z);
                    acc[j * 8 + 6] += cf[i] * bflo(vv[i][j].w); acc[j * 8 + 7] += cf[i] * bfhi(vv[i][j].w);
                }
        }
        float* hrow = t < NLAT ? p.out + (size_t)t * DM : (float*)(p.ws + WS_HC) + (size_t)(t - NLAT) * DM;
        const int bb = t < NLAT ? (t >> 11) : 8;
        const float* gate = mod + (size_t)bb * 12288 + 5 * DM;
#pragma unroll
        for (int j = 0; j < 4; ++j) {
            const int col = j * 512 + lane * 8;
#pragma unroll
            for (int hh = 0; hh < 2; ++hh) {
                const f32x4 hv = *(const f32x4*)(hrow + col + hh * 4), gv = *(const f32x4*)(gate + col + hh * 4);
                f32x4 o;
                o.x = hv.x + gv.x * acc[j * 8 + hh * 4 + 0]; o.y = hv.y + gv.y * acc[j * 8 + hh * 4 + 1];
                o.z = hv.z + gv.z * acc[j * 8 + hh * 4 + 2]; o.w = hv.w + gv.w * acc[j * 8 + hh * 4 + 3];
                *(f32x4*)(hrow + col + hh * 4) = o;
            }
        }
    }
}

#endif

#define LAS __attribute__((address_space(3)))
#define XB_TMO      128
#define XB_XCNT(j)  (256  + 64 * (j))
#define XB_XSUB(j)  (1280 + 64 * (j))
#define XB_XGEN(j)  (2304 + 64 * (j))
#define XB_TOP      3328
#define XB_TOPGEN   3392
#define XCD_BAR_WORDS 3456
#define XB_SPIN_CAP (1u << 18)

__device__ __forceinline__ unsigned xb_ld(unsigned* p)              { return __hip_atomic_load(p, __ATOMIC_RELAXED, __HIP_MEMORY_SCOPE_AGENT); }
__device__ __forceinline__ unsigned xb_add(unsigned* p, unsigned v) { return __hip_atomic_fetch_add(p, v, __ATOMIC_RELAXED, __HIP_MEMORY_SCOPE_AGENT); }
__device__ __forceinline__ unsigned xb_xcc_id() { return (unsigned)__builtin_amdgcn_s_getreg((3 << 11) | 20) & 0xFu; }
#define XB_SPIN(cond, bar) do { unsigned _sp = 0; while (cond) { __builtin_amdgcn_s_sleep(1); \
    if ((++_sp & 255u) == 0u) { if (xb_ld(&(bar)[XB_TMO])) break; if (_sp > XB_SPIN_CAP) { atomicAdd(&(bar)[XB_TMO], 1u); break; } } } } while (0)

struct XcdBarrier {
    unsigned* bar; unsigned x;
    volatile LAS unsigned* st;
};

__device__ __forceinline__ XcdBarrier xcd_barrier_post(unsigned* bar, volatile LAS unsigned* st) {
    XcdBarrier b; b.bar = bar; b.x = xb_xcc_id(); b.st = st;
    if (threadIdx.x == 0) (void)xb_add(&bar[XB_XCNT(b.x)], 1u);
    return b;
}
__device__ __forceinline__ void xcd_barrier_complete(unsigned* bar, unsigned x, unsigned& nloc, unsigned& nx) {
    const unsigned G = gridDim.x * gridDim.y * gridDim.z;
    unsigned sum, cnt, mine, sp = 0u;
    for (;;) {
        sum = 0u; cnt = 0u; mine = 0u;
#pragma unroll
        for (unsigned j = 0; j < 16; ++j) { const unsigned c = xb_ld(&bar[XB_XCNT(j)]); sum += c; cnt += (c > 0u) ? 1u : 0u; mine = (j == x) ? c : mine; }
        if (sum == G) break;
        __builtin_amdgcn_s_sleep(1);
        if ((++sp & 255u) == 0u) { if (xb_ld(&bar[XB_TMO])) break; if (sp > XB_SPIN_CAP) { atomicAdd(&bar[XB_TMO], 1u); break; } }
    }
    nloc = mine > 0u ? mine : 1u; nx = cnt > 0u ? cnt : 1u;
}

__device__ __forceinline__ void xcd_barrier(const XcdBarrier& b) {
    asm volatile("s_waitcnt vmcnt(0)" ::: "memory");
    __syncthreads();
    if (threadIdx.x == 0) {
        unsigned* bar = b.bar;
        __builtin_amdgcn_s_waitcnt(0);
        unsigned nloc = b.st[0], nx = b.st[1];
        if (nloc == 0u) { xcd_barrier_complete(bar, b.x, nloc, nx); b.st[0] = nloc; b.st[1] = nx; }
        const unsigned old = xb_add(&bar[XB_XSUB(b.x)], 1u);
        const unsigned gen = old / nloc;
        if (old + 1u == (gen + 1u) * nloc) {
            __builtin_amdgcn_fence(__ATOMIC_RELEASE, "agent");
            asm volatile("s_waitcnt vmcnt(0)" ::: "memory");
            const unsigned og = xb_add(&bar[XB_TOP], 1u);
            const unsigned tg = og / nx;
            if (og + 1u == (tg + 1u) * nx) xb_add(&bar[XB_TOPGEN], 1u);
            else XB_SPIN(xb_ld(&bar[XB_TOPGEN]) == tg, bar);
            __builtin_amdgcn_fence(__ATOMIC_ACQUIRE, "agent");
            xb_add(&bar[XB_XGEN(b.x)], 1u);
            asm volatile("s_waitcnt vmcnt(0)" ::: "memory");
        } else {
            XB_SPIN(xb_ld(&bar[XB_XGEN(b.x)]) == gen, bar);
            __builtin_amdgcn_fence(__ATOMIC_ACQUIRE, "agent");
            asm volatile("s_waitcnt vmcnt(0)" ::: "memory");
        }
    }
    __syncthreads();
}

constexpr int NPHASE = 1 + 10 * DEPTH;
template <int S>
__device__ __forceinline__ void run_stage(const Params& p, int l, unsigned char* lds, const bool dry) {
    const bool last = (l == DEPTH - 1);
    const float* mod = (const float*)(p.ws + WS_MOD) + (size_t)l * 9 * 12288;
    if constexpr (S == 1) { if (l == 0) { ph_modulate(p, l, 0); if (GEMM_I8 && !(GEMM3_I8 && W8_ONEPASS) && !dry) ph_weights_i8(p, lds); } }
    if constexpr (S == 2) {
#if USE_PG8
        pg8::StaticOrder So; So.init(MTOT, INW, (int)gridDim.x, (int)blockIdx.x);
#if GEMM_I8
        pg8::Gemm g{(const bf16_t*)(p.ws + WS_XN8), (const bf16_t*)(p.ws + WS_WIN + (size_t)l * INW * DM), MTOT, INW, DM / 2};
        pg8::EpiBf16I8 E{(bf16_t*)(p.ws + WS_P), INW, (const float*)(p.ws + WS_SCL) + SCL_XN, (const float*)(p.ws + WS_SCL) + SCL_WIN + l * INW};
        pg8::gemm_phase<pg8::EpiBf16I8, pg8::StaticOrder, true, true, true>((PG8_LAS unsigned char*)lds, g, So, E);
#else
        pg8::Gemm g{(const bf16_t*)(p.ws + WS_XN), (const bf16_t*)(p.ws + WS_WIN) + (size_t)l * INW * DM, MTOT, INW, DM};
        pg8::EpiBf16<0> E{(bf16_t*)(p.ws + WS_P), INW, nullptr, 0, 0, 1.f};
        pg8::gemm_phase<pg8::EpiBf16<0>, pg8::StaticOrder, true, true>((PG8_LAS unsigned char*)lds, g, So, E);
#endif
#else
        EpiBf16Store E{(bf16_t*)(p.ws + WS_P), INW};
        gemm_naive(lds, (const bf16_t*)(p.ws + WS_XN), (const bf16_t*)(p.ws + WS_WIN) + (size_t)l * INW * DM, MTOT, INW, DM, E);
#endif
    }
    if constexpr (S == 3) ph_prep(p, l, dry);
    if constexpr (S == 4) {
#if USE_FAST_ATT
        ph_mixers_fast(p, l, lds, dry);
#else
        ph_mixers_naive(p, l, lds);
#endif
    }
    if constexpr (S == 5) ph_ynorm(p, l);
    if constexpr (S == 6) {
#if USE_PG8
        const int M = last ? NLAT : MTOT;
        pg8::StaticOrder So; So.init(M, DM, (int)gridDim.x, (int)blockIdx.x);
#if GEMM_I8
        pg8::Gemm g{(const bf16_t*)(p.ws + WS_XN8), (const bf16_t*)(p.ws + WS_WOUT + (size_t)l * DM * DM), M, DM, DM / 2};
#if H_BF16 && GEMM3_I8
        pg8::EpiResGateI8B E{l == 0 ? p.x : nullptr, p.ctx, (bf16_t*)(p.ws + (dry ? WS_DUMMY : WS_HB)), mod + 2 * DM,
                             (const float*)(p.ws + WS_SCL) + SCL_Y, (const float*)(p.ws + WS_SCL) + SCL_WOUT + l * DM};
        pg8::gemm_phase<pg8::EpiResGateI8B, pg8::StaticOrder, true, true, true>((PG8_LAS unsigned char*)lds, g, So, E);
#else
        pg8::EpiResGateI8 E{l == 0 ? p.x : p.out, l == 0 ? p.ctx : (const float*)(p.ws + WS_HC), dry ? (float*)(p.ws + WS_DUMMY) : p.out, dry ? (float*)(p.ws + WS_DUMMY) : (float*)(p.ws + WS_HC), mod + 2 * DM,
                            (const float*)(p.ws + WS_SCL) + SCL_Y, (const float*)(p.ws + WS_SCL) + SCL_WOUT + l * DM};
        pg8::gemm_phase<pg8::EpiResGateI8, pg8::StaticOrder, true, true, true>((PG8_LAS unsigned char*)lds, g, So, E);
#endif
#else
        pg8::Gemm g{(const bf16_t*)(p.ws + WS_Y), (const bf16_t*)(p.ws + WS_WOUT) + (size_t)l * DM * DM, M, DM, DM};
        pg8::EpiResGateT E{l == 0 ? p.x : p.out, l == 0 ? p.ctx : (const float*)(p.ws + WS_HC), dry ? (float*)(p.ws + WS_DUMMY) : p.out, dry ? (float*)(p.ws + WS_DUMMY) : (float*)(p.ws + WS_HC), mod + 2 * DM};
        pg8::gemm_phase<pg8::EpiResGateT, pg8::StaticOrder, true, true>((PG8_LAS unsigned char*)lds, g, So, E);
#endif
#if GATHER_I8 && GATHER_4BIT
        if (TABLES_IN_GAPS && l == 0 && !dry) conv4_tables(p, 0, 2 * NEXP, (unsigned*)(p.ws + WS_CTL) + 6144, lds);
#endif
#else
        EpiResGate E{l == 0 ? p.x : p.out, l == 0 ? p.ctx : (const float*)(p.ws + WS_HC), p.out, (float*)(p.ws + WS_HC), mod + 2 * DM};
        gemm_naive(lds, (const bf16_t*)(p.ws + WS_Y), (const bf16_t*)(p.ws + WS_WOUT) + (size_t)l * DM * DM, last ? NLAT : MTOT, DM, DM, E);
#endif
    }
    if constexpr (S == 7) ph_modulate(p, l, 1);
    if constexpr (S == 8) {
#if USE_PG8
        const int M = last ? NLAT : MTOT;
        pg8::StaticOrder So; So.init(M, DM, (int)gridDim.x, (int)blockIdx.x);
#if GEMM_I8 && GEMM3_I8
        pg8::Gemm g{(const bf16_t*)(p.ws + WS_XN8), (const bf16_t*)(p.ws + WS_WQ + (size_t)l * DM * DM), M, DM, DM / 2};
        pg8::EpiBf16I8 E{(bf16_t*)(p.ws + WS_P), DM, (const float*)(p.ws + WS_SCL) + SCL_XN, (const float*)(p.ws + WS_SCL) + SCL_WQ + l * DM};
        pg8::gemm_phase<pg8::EpiBf16I8, pg8::StaticOrder, true, true, true>((PG8_LAS unsigned char*)lds, g, So, E);
#else
        pg8::Gemm g{(const bf16_t*)(p.ws + WS_XN), (const bf16_t*)(p.ws + WS_WQ) + (size_t)l * DM * DM, M, DM, DM};
        pg8::EpiBf16<0> E{(bf16_t*)(p.ws + WS_P), DM, nullptr, 0, 0, 1.f};
        pg8::gemm_phase<pg8::EpiBf16<0>, pg8::StaticOrder, true, true>((PG8_LAS unsigned char*)lds, g, So, E);
#endif
#if FUSE_ROUTE
        asm volatile("s_waitcnt vmcnt(0)" ::: "memory");
        __syncthreads();
        ph_route_fast<true>(p, l, lds);
#endif
#if GATHER_I8 && GATHER_4BIT
        if (TABLES_IN_GAPS && l == 0 && !dry) conv4_tables(p, 2 * NEXP, 4 * NEXP, (unsigned*)(p.ws + WS_CTL) + 6208, lds);
#endif
#else
        EpiBf16Store E{(bf16_t*)(p.ws + WS_P), DM};
        gemm_naive(lds, (const bf16_t*)(p.ws + WS_XN), (const bf16_t*)(p.ws + WS_WQ) + (size_t)l * DM * DM, last ? NLAT : MTOT, DM, DM, E);
#endif
    }
    if constexpr (S == 9) {
#if USE_FAST_ROUTE
        if (!FUSE_ROUTE) ph_route_fast<false>(p, l, lds);
#else
        ph_route_naive(p, l);
#endif
    }
    if constexpr (S == 10) ph_gather(p, l, dry);
}
__global__ void __launch_bounds__(NTHREADS) fwd_kernel(Params p) {
    extern __shared__ __attribute__((aligned(16))) unsigned char lds[];
    cg::grid_group grid = cg::this_grid();
    const int lo = p.ph_lo, hi = p.ph_hi;
    volatile LAS unsigned* stw = (volatile LAS unsigned*)((LAS unsigned char*)lds + (LDS_BYTES - 128));
    if (threadIdx.x < 2) stw[threadIdx.x] = 0u;
    __syncthreads();
    const XcdBarrier bar = xcd_barrier_post((unsigned*)(p.ws + WS_CTL + 32768), stw);
#define IN(k) (lo <= (k) && (k) < hi)
#define SEAM(k) do { if (IN(k) && IN((k) + 1)) xcd_barrier(bar); } while (0)
#define STAGE(S, l) do { constexpr int k_ = 1 + 10 * (l) + (S) - 1; if (IN(k_)) { if constexpr ((REP_MASK >> k_) & 1) { run_stage<S>(p, l, lds, true); xcd_barrier(bar); } run_stage<S>(p, l, lds, false); } SEAM(k_); } while (0)
#define LAYER(l) do { if ((l) == 0) { STAGE(1, l); } STAGE(2, l); STAGE(3, l); STAGE(4, l); STAGE(5, l); STAGE(6, l); STAGE(7, l); STAGE(8, l); if (!FUSE_ROUTE) { STAGE(9, l); } STAGE(10, l); } while (0)
    if (hi > NPHASE) grid.sync();
    if (IN(0)) { if constexpr (REP_MASK & 1) { ph_prologue(p, lds); xcd_barrier(bar); } ph_prologue(p, lds); }
    SEAM(0);
    LAYER(0);
    LAYER(1);
#undef IN
#undef SEAM
#undef STAGE
#undef LAYER
}

extern "C" void kernel_launch(void* const* d_in, const int* in_sizes, int n_in, void* d_out, int out_size, void* d_ws, size_t ws_size, hipStream_t stream) {
    static int grid_blocks = 0;
    if (grid_blocks == 0) {
        if (n_in != 23 || out_size != NLAT * DM || ws_size < WS_END) { fprintf(stderr, "kernel_launch: unexpected shapes n_in %d out %d ws %zu\n", n_in, out_size, ws_size); grid_blocks = -1; return; }
        if (hipFuncSetAttribute((const void*)fwd_kernel, hipFuncAttributeMaxDynamicSharedMemorySize, LDS_BYTES) != hipSuccess) { fprintf(stderr, "kernel_launch: hipFuncSetAttribute failed\n"); grid_blocks = -1; return; }
        int dev = 0, cus = 0, per_cu = 0;
        hipGetDevice(&dev);
        hipDeviceGetAttribute(&cus, hipDeviceAttributeMultiprocessorCount, dev);
        hipOccupancyMaxActiveBlocksPerMultiprocessor(&per_cu, (const void*)fwd_kernel, NTHREADS, LDS_BYTES);
        if (per_cu < 1 || cus < 1) { fprintf(stderr, "kernel_launch: occupancy query failed (%d per CU, %d CUs)\n", per_cu, cus); grid_blocks = -1; return; }
        grid_blocks = cus * per_cu;
    }
    if (grid_blocks < 0) return;
    Params p{};
    const float** pp = (const float**)&p;
    for (int i = 0; i < 23; ++i) pp[i] = (const float*)d_in[i];
    p.out = (float*)d_out; p.ws = (unsigned char*)d_ws;
    p.ph_lo = 0; p.ph_hi = NPHASE;
    hipMemsetAsync((char*)d_ws + WS_CTL, 0, 131072, stream);
    void* args[] = {&p};
    hipError_t e = hipLaunchCooperativeKernel((const void*)fwd_kernel, dim3(grid_blocks), dim3(NTHREADS), args, LDS_BYTES, stream);
    if (e != hipSuccess) fprintf(stderr, "cooperative launch failed: %s (grid %d)\n", hipGetErrorString(e), grid_blocks);
}
```

```cpp
#include <hip/hip_runtime.h>
#include <hip/hip_cooperative_groups.h>
#include <cstdio>
#include <cstdint>
namespace cg = cooperative_groups;

constexpr int DM = 2048, NB = 8, SEQ = 2048, NCTX = 256, DEPTH = 2;
constexpr int NLAT = NB * SEQ;
constexpr int NCT = NB * NCTX;
constexpr int MTOT = NLAT + NCT;
constexpr int INW = 3584;
constexpr int C_QA = 0, C_KA = 768, C_VA = 1024, C_QB = 1280, C_KB = 2048, C_VB = 2304, C_UC = 2560, C_VC = 3072;
constexpr int NEXP = 16384;
constexpr float EPS = 1e-6f;
constexpr float ATT_SCALE = 0.088388347648318440f;
constexpr int NTHREADS = 512, NWAVES = 8;

constexpr size_t MiB = 1u << 20;
constexpr size_t WS_CTL = 0;
constexpr size_t WS_MOD = 1 * MiB;
constexpr size_t WS_ROPE = 2 * MiB;
constexpr size_t WS_KEYS = 3 * MiB;
constexpr size_t WS_WSC = 4 * MiB;
constexpr size_t WS_USC = 5 * MiB;
constexpr size_t WS_VSC = 6 * MiB;
constexpr size_t WS_WIN = 8 * MiB;
constexpr size_t WS_WOUT = 36 * MiB;
constexpr size_t WS_WQ = 52 * MiB;
constexpr size_t WS_HC = 68 * MiB;
constexpr size_t WS_EID = 84 * MiB;
constexpr size_t WS_GATE = 93 * MiB;
constexpr size_t WS_XN = 104 * MiB;
constexpr size_t WS_HB = WS_XN;
constexpr size_t WS_Y = 176 * MiB;
constexpr size_t WS_P = 248 * MiB;
constexpr size_t WS_UT = 376 * MiB;
constexpr size_t WS_VT = 504 * MiB;
constexpr size_t WS_SCL = 102 * MiB;
constexpr size_t SCL_WIN = 0, SCL_WOUT = 2 * 3584, SCL_XN = SCL_WOUT + 2 * 2048, SCL_Y = SCL_XN + 18432, SCL_WQ = SCL_Y + 18432;
constexpr int NCM = 3584 + 2048 + 2048;
constexpr size_t WS_XN8 = 784 * MiB;
constexpr size_t CTL_COLMAX = 65536;
constexpr size_t WS_DUMMY = 640 * MiB;
constexpr size_t WS_END = 820 * MiB;

constexpr int LDS_BYTES = 147456;

typedef unsigned short bf16_t;
typedef float f32x4 __attribute__((ext_vector_type(4)));
typedef unsigned u32x4 __attribute__((ext_vector_type(4)));
typedef unsigned u32x2 __attribute__((ext_vector_type(2)));

struct Params {
    const float *x, *c, *ctx, *c_ctx, *w_ada, *b_ada, *norm1_g, *norm2_g, *w_in, *qn_a, *kn_a, *qn_b, *kn_b, *sink_b, *vn_c, *ws_c, *bs_c,
        *g_group, *w_out, *peer_wq, *peer_keys, *peer_u, *peer_v;
    float* out;
    unsigned char* ws;
    int ph_lo, ph_hi;
};

__device__ __forceinline__ float bf2f(unsigned v) { return __uint_as_float(v << 16); }
__device__ __forceinline__ float bflo(unsigned w) { return __uint_as_float(w << 16); }
__device__ __forceinline__ float bfhi(unsigned w) { return __uint_as_float(w & 0xffff0000u); }
__device__ __forceinline__ unsigned f2bf(float f) { unsigned u = __float_as_uint(f); return (u + 0x7fffu + ((u >> 16) & 1u)) >> 16; }
__device__ __forceinline__ unsigned pk2(float lo, float hi) { return f2bf(lo) | (f2bf(hi) << 16); }
__device__ __forceinline__ float wave_sum(float v) {
#pragma unroll
    for (int o = 32; o >= 1; o >>= 1) v += __shfl_xor(v, o);
    return v;
}
__device__ __forceinline__ float wave_max(float v) {
#pragma unroll
    for (int o = 32; o >= 1; o >>= 1) v = fmaxf(v, __shfl_xor(v, o));
    return v;
}
__device__ __forceinline__ float gelu_tanh(float x) {
    const float y = 0.7978845608028654f * (x + 0.044715f * x * x * x);
    const float t = 1.f - 2.f / (__expf(2.f * y) + 1.f);
    return 0.5f * x * (1.f + t);
}
__device__ __forceinline__ float silu(float x) { return x / (1.f + __expf(-x)); }
#define LDS_WAIT() asm volatile("s_waitcnt lgkmcnt(0)" ::: "memory")
#ifndef GATHER_I8
#define GATHER_I8 1
#endif
#ifndef GATHER_4BIT
#define GATHER_4BIT 1
#endif
constexpr int ROW4 = 1152;
#ifndef FUSE_ROUTE
#define FUSE_ROUTE 1
#endif
#ifndef GEMM_I8
#define GEMM_I8 1
#endif
#ifndef GEMM3_I8
#define GEMM3_I8 1
#endif
#ifndef H_BF16
#define H_BF16 1
#endif
#ifndef W8_ONEPASS
#define W8_ONEPASS 1
#endif
#ifndef DRY_MODE
#define DRY_MODE 0
#endif
#ifndef REP_MASK
#define REP_MASK 0
#endif

__device__ __forceinline__ unsigned q8pack4(float a, float b, float c, float d, float inv) {
    const int q0 = (int)rintf(a * inv), q1 = (int)rintf(b * inv), q2 = (int)rintf(c * inv), q3 = (int)rintf(d * inv);
    return ((unsigned)q0 & 0xffu) | (((unsigned)q1 & 0xffu) << 8) | (((unsigned)q2 & 0xffu) << 16) | ((unsigned)q3 << 24);
}

__device__ __forceinline__ void transpose_item(const float* W, int K, int N, bf16_t* WT, const float* gk, float* scr, int item, int lane) {
    const int nblk = N / 32, kb = item / nblk, nb = item % nblk, k0 = 64 * kb, n0 = 32 * nb;
#pragma unroll 8
    for (int i = 0; i < 32; ++i) {
        const int kk = 2 * i + (lane >> 5);
        float v = W[(size_t)(k0 + kk) * N + n0 + (lane & 31)];
        if (gk) v *= gk[k0 + kk];
        scr[kk * 33 + (lane & 31)] = v;
    }
    LDS_WAIT();
    const int c = lane & 7;
#pragma unroll
    for (int j = 0; j < 4; ++j) {
        const int n = (lane >> 3) + 8 * j;
        const float* s = scr + (8 * c) * 33 + n;
        u32x4 o;
        o.x = pk2(s[0 * 33], s[1 * 33]); o.y = pk2(s[2 * 33], s[3 * 33]); o.z = pk2(s[4 * 33], s[5 * 33]); o.w = pk2(s[6 * 33], s[7 * 33]);
        *(u32x4*)(WT + (size_t)(n0 + n) * K + k0 + 8 * c) = o;
    }
    LDS_WAIT();
}

__device__ __forceinline__ void colmax_item(const float* W, int N, const float* gk, unsigned* cmax, int item, int lane) {
    const int nblk = N / 32, kb = item / nblk, nb = item % nblk, k0 = 64 * kb, n0 = 32 * nb;
    f32x4 v[8];
#pragma unroll
    for (int i = 0; i < 8; ++i) v[i] = *(const f32x4*)(W + (size_t)(k0 + 8 * i + (lane >> 3)) * N + n0 + 4 * (lane & 7));
    float m0 = 0.f, m1 = 0.f, m2 = 0.f, m3 = 0.f;
#pragma unroll
    for (int i = 0; i < 8; ++i) {
        const float g = gk ? fabsf(gk[k0 + 8 * i + (lane >> 3)]) : 1.f;
        m0 = fmaxf(m0, fabsf(v[i].x) * g); m1 = fmaxf(m1, fabsf(v[i].y) * g); m2 = fmaxf(m2, fabsf(v[i].z) * g); m3 = fmaxf(m3, fabsf(v[i].w) * g);
    }
#pragma unroll
    for (int o = 8; o <= 32; o <<= 1) { m0 = fmaxf(m0, __shfl_xor(m0, o)); m1 = fmaxf(m1, __shfl_xor(m1, o)); m2 = fmaxf(m2, __shfl_xor(m2, o)); m3 = fmaxf(m3, __shfl_xor(m3, o)); }
    if (lane < 8) {
        unsigned* c = cmax + n0 + 4 * lane;
        atomicMax(c + 0, __float_as_uint(m0)); atomicMax(c + 1, __float_as_uint(m1)); atomicMax(c + 2, __float_as_uint(m2)); atomicMax(c + 3, __float_as_uint(m3));
    }
}
__device__ __forceinline__ void transpose_item_i8(const float* W, int K, int N, unsigned char* W8, const float* gk, const unsigned* cmax, float* scr, int item, int lane) {
    const int nblk = N / 32, kb = item / nblk, nb = item % nblk, k0 = 64 * kb, n0 = 32 * nb;
    f32x4 v[8];
#pragma unroll
    for (int i = 0; i < 8; ++i) v[i] = *(const f32x4*)(W + (size_t)(k0 + 8 * i + (lane >> 3)) * N + n0 + 4 * (lane & 7));
    float inv[4];
#pragma unroll
    for (int c = 0; c < 4; ++c) { const float m = __uint_as_float(cmax[n0 + 4 * (lane & 7) + c]); inv[c] = m > 0.f ? 127.f / m : 0.f; }
#pragma unroll
    for (int i = 0; i < 8; ++i) {
        const int kk = 8 * i + (lane >> 3);
        const float g = gk ? gk[k0 + kk] : 1.f;
        float* d = scr + kk * 33 + 4 * (lane & 7);
        d[0] = rintf(v[i].x * g * inv[0]); d[1] = rintf(v[i].y * g * inv[1]); d[2] = rintf(v[i].z * g * inv[2]); d[3] = rintf(v[i].w * g * inv[3]);
    }
    LDS_WAIT();
    const int c = lane & 7;
#pragma unroll
    for (int j = 0; j < 4; ++j) {
        const int n = (lane >> 3) + 8 * j;
        const float* s = scr + (8 * c) * 33 + n;
        unsigned lo = 0u, hi = 0u;
#pragma unroll
        for (int i = 0; i < 4; ++i) { lo |= ((unsigned)(int)s[i * 33] & 0xffu) << (8 * i); hi |= ((unsigned)(int)s[(4 + i) * 33] & 0xffu) << (8 * i); }
        u32x2 o; o.x = lo; o.y = hi;
        *(u32x2*)(W8 + (size_t)(n0 + n) * K + k0 + 8 * c) = o;
    }
    LDS_WAIT();
}
__device__ __forceinline__ void ph_weights_i8(const Params& p, unsigned char* lds) {
    const int tid = threadIdx.x, lane = tid & 63, wave = tid >> 6;
    const int gw = blockIdx.x * NWAVES + wave, NGW = gridDim.x * NWAVES;
    float* scr = (float*)(lds + wave * 8704);
    const unsigned* cm = (const unsigned*)(p.ws + WS_CTL + CTL_COLMAX);
    constexpr int I_IN = 32 * 112, I_SQ = 32 * 64, I_L = I_IN + I_SQ + (GEMM3_I8 ? I_SQ : 0);
    for (int it = gw; it < 2 * I_L; it += NGW) {
        const int l = it / I_L; const int r = it % I_L;
        if (r < I_IN) transpose_item_i8(p.w_in + (size_t)l * DM * INW, DM, INW, (unsigned char*)(p.ws + WS_WIN) + (size_t)l * INW * DM, nullptr, cm + l * NCM, scr, r, lane);
        else if (r < I_IN + I_SQ) transpose_item_i8(p.w_out + (size_t)l * DM * DM, DM, DM, (unsigned char*)(p.ws + WS_WOUT) + (size_t)l * DM * DM, p.g_group + l * DM, cm + l * NCM + INW, scr, r - I_IN, lane);
        else transpose_item_i8(p.peer_wq + (size_t)l * DM * DM, DM, DM, (unsigned char*)(p.ws + WS_WQ) + (size_t)l * DM * DM, nullptr, cm + l * NCM + INW + DM, scr, r - I_IN - I_SQ, lane);
    }
    float* S = (float*)(p.ws + WS_SCL);
    for (int i = blockIdx.x * NTHREADS + tid; i < 2 * NCM; i += gridDim.x * NTHREADS) {
        const int l = i / NCM, n = i % NCM;
        const float m = __uint_as_float(cm[i]); const float s = m > 0.f ? m * (1.f / 127.f) : 1.f;
        if (n < INW) S[SCL_WIN + l * INW + n] = s; else if (n < INW + DM) S[SCL_WOUT + l * DM + (n - INW)] = s; else S[SCL_WQ + l * DM + (n - INW - DM)] = s;
    }
}

__device__ __forceinline__ void w8_strip(const float* W, int N, int n0, const float* gk, unsigned char* W8, float* scl, unsigned char* lds) {
    constexpr int TP = 2048 + 8;
    bf16_t* T = (bf16_t*)lds;
    unsigned* cmx = (unsigned*)(lds + 32 * TP * 2);
    const int tid = threadIdx.x, nq = tid & 7, kr = tid >> 3;
    __syncthreads();
    if (tid < 32) cmx[tid] = 0u;
    float m0 = 0.f, m1 = 0.f, m2 = 0.f, m3 = 0.f;
#pragma unroll 1
    for (int s0 = 0; s0 < 32; s0 += 8) {
        f32x4 v[8];
#pragma unroll
        for (int i = 0; i < 8; ++i) v[i] = *(const f32x4*)(W + (size_t)((s0 + i) * 64 + kr) * N + n0 + 4 * nq);
#pragma unroll
        for (int i = 0; i < 8; ++i) {
            const int k = (s0 + i) * 64 + kr;
            const float g = gk ? gk[k] : 1.f;
            const float a = v[i].x * g, b = v[i].y * g, c = v[i].z * g, d = v[i].w * g;
            m0 = fmaxf(m0, fabsf(a)); m1 = fmaxf(m1, fabsf(b)); m2 = fmaxf(m2, fabsf(c)); m3 = fmaxf(m3, fabsf(d));
            T[(4 * nq + 0) * TP + k] = (bf16_t)f2bf(a); T[(4 * nq + 1) * TP + k] = (bf16_t)f2bf(b); T[(4 * nq + 2) * TP + k] = (bf16_t)f2bf(c); T[(4 * nq + 3) * TP + k] = (bf16_t)f2bf(d);
        }
    }
    __syncthreads();
    atomicMax(cmx + 4 * nq + 0, __float_as_uint(m0)); atomicMax(cmx + 4 * nq + 1, __float_as_uint(m1));
    atomicMax(cmx + 4 * nq + 2, __float_as_uint(m2)); atomicMax(cmx + 4 * nq + 3, __float_as_uint(m3));
    __syncthreads();
    const int n = tid >> 4, kc = tid & 15;
    const float cm = __uint_as_float(cmx[n]); const float inv = cm > 0.f ? 127.f / cm : 0.f;
    if (kc == 0) scl[n0 + n] = cm > 0.f ? cm * (1.f / 127.f) : 1.f;
#pragma unroll 4
    for (int s = 0; s < 16; ++s) {
        const int k = s * 128 + kc * 8;
        const u32x4 q = *(const u32x4*)(T + n * TP + k);
        u32x2 o;
        o.x = q8pack4(bflo(q.x), bfhi(q.x), bflo(q.y), bfhi(q.y), inv); o.y = q8pack4(bflo(q.z), bfhi(q.z), bflo(q.w), bfhi(q.w), inv);
        *(u32x2*)(W8 + (size_t)(n0 + n) * 2048 + k) = o;
    }
}
__device__ __forceinline__ void cvt_range(const float* src, bf16_t* dst, size_t n8, size_t gtid, size_t gthreads) {
    for (size_t i = gtid; i < n8; i += gthreads) {
        const f32x4 a = *(const f32x4*)(src + i * 8), b = *(const f32x4*)(src + i * 8 + 4);
        u32x4 o; o.x = pk2(a.x, a.y); o.y = pk2(a.z, a.w); o.z = pk2(b.x, b.y); o.w = pk2(b.z, b.w);
        *(u32x4*)(dst + i * 8) = o;
    }
}

#if GATHER_I8 && GATHER_4BIT
__device__ __forceinline__ void conv4_row(const f32x4 (&v)[8], const bool isv, unsigned char* drow, int lane) {
    float am = 0.f;
#pragma unroll
    for (int i = 0; i < 8; ++i) am = fmaxf(am, fmaxf(fmaxf(fabsf(v[i].x), fabsf(v[i].y)), fmaxf(fabsf(v[i].z), fabsf(v[i].w))));
    const float s0 = am > 0.f ? am * (isv ? (1.f / 6.f) : (1.f / 7.f)) : 1.f;
    const unsigned sb = (__float_as_uint(s0) + 0xffffu) >> 16;
    const float inv = 1.f / __uint_as_float(sb << 16);
    u32x4 o; unsigned w[4];
#pragma unroll
    for (int d = 0; d < 4; ++d) {
        const f32x4 a = v[2 * d], b = v[2 * d + 1];
        const float e[8] = {a.x * inv, a.y * inv, a.z * inv, a.w * inv, b.x * inv, b.y * inv, b.z * inv, b.w * inv};
        unsigned acc = 0u;
        if (isv) {
            acc = __builtin_amdgcn_cvt_scalef32_pk_fp4_f32(acc, e[0], e[1], 1.0f, 0);
            acc = __builtin_amdgcn_cvt_scalef32_pk_fp4_f32(acc, e[2], e[3], 1.0f, 1);
            acc = __builtin_amdgcn_cvt_scalef32_pk_fp4_f32(acc, e[4], e[5], 1.0f, 2);
            acc = __builtin_amdgcn_cvt_scalef32_pk_fp4_f32(acc, e[6], e[7], 1.0f, 3);
        } else {
#pragma unroll
            for (int i = 0; i < 8; ++i) {
                const int q = (int)fminf(fmaxf(rintf(e[i]), -7.f), 7.f);
                acc |= ((unsigned)q & 0xFu) << (8 * (i >> 1) + 4 * (i & 1));
            }
        }
        w[d] = acc;
    }
    o.x = w[0]; o.y = w[1]; o.z = w[2]; o.w = w[3];
    *(u32x4*)(drow + lane * 16) = o;
    *(unsigned short*)(drow + 1024 + lane * 2) = (unsigned short)sb;
}
#endif
#if GATHER_I8 && GATHER_4BIT
#ifndef TABLES_IN_GAPS
#define TABLES_IN_GAPS 1
#endif
__device__ __forceinline__ void conv4_tables(const Params& p, int r0, int r1, unsigned* ctr, unsigned char* lds) {
    const int tid = threadIdx.x, lane = tid & 63, wave = tid >> 6;
    unsigned char* ws = p.ws;
    volatile unsigned* shw = (volatile unsigned*)(lds + LDS_BYTES - 64);
    const int nchunk = (r1 - r0) / 64;
    for (int it = 0;; ++it) {
        int cbeg, cstep, cend;
        if (ctr) {
            __syncthreads();
            if (tid == 0) *shw = atomicAdd(ctr, 1u);
            __syncthreads();
            const int c = (int)*shw; if (c >= nchunk) break;
            cbeg = r0 + c * 64 + wave; cstep = NWAVES; cend = r0 + c * 64 + 64;
        } else {
            if (it > 0) break;
            cbeg = r0 + blockIdx.x * NWAVES + wave; cstep = gridDim.x * NWAVES; cend = r1;
        }
        for (int r = cbeg; r < cend; r += 2 * cstep) {
            const int r2 = r + cstep; const bool has2 = r2 < cend; const int rb = has2 ? r2 : r;
            const bool isvA = r >= 2 * NEXP, isvB = rb >= 2 * NEXP; const int rrA = isvA ? r - 2 * NEXP : r, rrB = isvB ? rb - 2 * NEXP : rb;
            const float* srowA = (isvA ? p.peer_v : p.peer_u) + (size_t)rrA * DM;
            const float* srowB = (isvB ? p.peer_v : p.peer_u) + (size_t)rrB * DM;
            f32x4 va[8], vb[8];
#pragma unroll
            for (int j = 0; j < 2; ++j)
#pragma unroll
                for (int k = 0; k < 4; ++k) { va[j * 4 + k] = *(const f32x4*)(srowA + j * 1024 + lane * 16 + k * 4); vb[j * 4 + k] = *(const f32x4*)(srowB + j * 1024 + lane * 16 + k * 4); }
            conv4_row(va, isvA, (unsigned char*)(ws + (isvA ? WS_VT : WS_UT)) + (size_t)rrA * ROW4, lane);
            if (has2) conv4_row(vb, isvB, (unsigned char*)(ws + (isvB ? WS_VT : WS_UT)) + (size_t)rrB * ROW4, lane);
        }
    }
}
#endif
__device__ __forceinline__ void ph_prologue(const Params& p, unsigned char* lds) {
    const int tid = threadIdx.x, lane = tid & 63, wave = tid >> 6;
    const int gw = blockIdx.x * NWAVES + wave, NGW = gridDim.x * NWAVES;
    unsigned char* ws = p.ws;
    {
        float* sT = (float*)lds;
        float* red = (float*)(lds + 2048 * 12 * 4);
        for (int i = tid; i < 2048 * 9; i += NTHREADS) {
            const int k = i / 9, bb = i % 9;
            const float v = bb < 8 ? p.c[bb * DM + k] : p.c_ctx[k];
            sT[k * 12 + bb] = silu(v);
        }
        __syncthreads();
        const int cq = lane & 7, ks = tid >> 3;
        for (int u = blockIdx.x; u < 768; u += gridDim.x) {
            const int l = u / 384, n0 = (u % 384) * 32;
            const float* W = p.w_ada + (size_t)l * DM * 12288 + n0 + cq * 4;
            float acc[9][4];
#pragma unroll
            for (int b = 0; b < 9; ++b)
#pragma unroll
                for (int j = 0; j < 4; ++j) acc[b][j] = 0.f;
#pragma unroll 8
            for (int i = 0; i < 32; ++i) {
                const int k = ks + 64 * i;
                const f32x4 w = *(const f32x4*)(W + (size_t)k * 12288);
                const f32x4 s0 = *(const f32x4*)(sT + k * 12), s1 = *(const f32x4*)(sT + k * 12 + 4);
                const float s8 = sT[k * 12 + 8];
                const float sv[9] = {s0.x, s0.y, s0.z, s0.w, s1.x, s1.y, s1.z, s1.w, s8};
#pragma unroll
                for (int b = 0; b < 9; ++b) { acc[b][0] += sv[b] * w.x; acc[b][1] += sv[b] * w.y; acc[b][2] += sv[b] * w.z; acc[b][3] += sv[b] * w.w; }
            }
#pragma unroll
            for (int b = 0; b < 9; ++b)
#pragma unroll
                for (int j = 0; j < 4; ++j) {
                    float v = acc[b][j];
                    v += __shfl_xor(v, 8); v += __shfl_xor(v, 16); v += __shfl_xor(v, 32);
                    acc[b][j] = v;
                }
            if (lane < 8) {
#pragma unroll
                for (int b = 0; b < 9; ++b)
#pragma unroll
                    for (int j = 0; j < 4; ++j) red[(wave * 8 + cq) * 36 + b * 4 + j] = acc[b][j];
            }
            __syncthreads();
            if (tid < 288) {
                const int b = tid / 32, col = tid % 32, q = col >> 2, j = col & 3;
                float s = 0.f;
#pragma unroll
                for (int w = 0; w < 8; ++w) s += red[(w * 8 + q) * 36 + b * 4 + j];
                const int n = n0 + col;
                ((float*)(ws + WS_MOD))[(size_t)(l * 9 + b) * 12288 + n] = s + p.b_ada[l * 12288 + n];
            }
            __syncthreads();
        }
    }
    __syncthreads();
#if GEMM_I8 && GEMM3_I8 && W8_ONEPASS
    {
        float* S = (float*)(ws + WS_SCL);
        constexpr int ST_IN = INW / 32, ST_SQ = DM / 32, ST_L = ST_IN + 2 * ST_SQ;
        for (int it = blockIdx.x; it < 2 * ST_L; it += gridDim.x) {
            const int l = it / ST_L; int r = it % ST_L;
            if (r < ST_IN) { w8_strip(p.w_in + (size_t)l * DM * INW, INW, r * 32, nullptr, (unsigned char*)(ws + WS_WIN) + (size_t)l * INW * DM, S + SCL_WIN + l * INW, lds); continue; }
            r -= ST_IN;
            if (r < ST_SQ) { w8_strip(p.w_out + (size_t)l * DM * DM, DM, r * 32, p.g_group + l * DM, (unsigned char*)(ws + WS_WOUT) + (size_t)l * DM * DM, S + SCL_WOUT + l * DM, lds); continue; }
            r -= ST_SQ;
            w8_strip(p.peer_wq + (size_t)l * DM * DM, DM, r * 32, nullptr, (unsigned char*)(ws + WS_WQ) + (size_t)l * DM * DM, S + SCL_WQ + l * DM, lds);
        }
        __syncthreads();
    }
#else
    {
        float* scr = (float*)(lds + wave * 8704);
        constexpr int I_IN = 32 * 112, I_SQ = 32 * 64, I_L = I_IN + 2 * I_SQ;
        unsigned* cm = (unsigned*)(ws + WS_CTL + CTL_COLMAX);
        for (int it = gw; it < 2 * I_L; it += NGW) {
            const int l = it / I_L; int r = it % I_L;
            if (r < I_IN) {
                if (GEMM_I8) colmax_item(p.w_in + (size_t)l * DM * INW, INW, nullptr, cm + l * NCM, r, lane);
                else transpose_item(p.w_in + (size_t)l * DM * INW, DM, INW, (bf16_t*)(ws + WS_WIN) + (size_t)l * INW * DM, nullptr, scr, r, lane);
                continue; }
            r -= I_IN;
            if (r < I_SQ) {
                if (GEMM_I8) colmax_item(p.w_out + (size_t)l * DM * DM, DM, p.g_group + l * DM, cm + l * NCM + INW, r, lane);
                else transpose_item(p.w_out + (size_t)l * DM * DM, DM, DM, (bf16_t*)(ws + WS_WOUT) + (size_t)l * DM * DM, p.g_group + l * DM, scr, r, lane);
                continue; }
            r -= I_SQ;
            if (GEMM_I8 && GEMM3_I8) colmax_item(p.peer_wq + (size_t)l * DM * DM, DM, nullptr, cm + l * NCM + INW + DM, r, lane);
            else transpose_item(p.peer_wq + (size_t)l * DM * DM, DM, DM, (bf16_t*)(ws + WS_WQ) + (size_t)l * DM * DM, nullptr, scr, r, lane);
        }
    }
#endif
    {
        const size_t gtid = (size_t)blockIdx.x * NTHREADS + tid, gth = (size_t)gridDim.x * NTHREADS;
        cvt_range(p.peer_keys, (bf16_t*)(ws + WS_KEYS), (size_t)2 * 8 * 2 * 128 * 128 / 8, gtid, gth);
        cvt_range(p.ws_c, (bf16_t*)(ws + WS_WSC), (size_t)2 * 4 * 128 * 128 / 8, gtid, gth);
#if GATHER_I8 && GATHER_4BIT
        if (!TABLES_IN_GAPS) conv4_tables(p, 0, 4 * NEXP, nullptr, lds);
#elif GATHER_I8
        for (int r = gw; r < 4 * NEXP; r += NGW) {
            const bool isv = r >= 2 * NEXP; const int rr = isv ? r - 2 * NEXP : r;
            const float* srow = (isv ? p.peer_v : p.peer_u) + (size_t)rr * DM;
            f32x4 v[8]; float am = 0.f;
#pragma unroll
            for (int j = 0; j < 2; ++j)
#pragma unroll
                for (int k = 0; k < 4; ++k) {
                    v[j * 4 + k] = *(const f32x4*)(srow + j * 1024 + lane * 16 + k * 4);
                    am = fmaxf(am, fmaxf(fmaxf(fabsf(v[j * 4 + k].x), fabsf(v[j * 4 + k].y)), fmaxf(fabsf(v[j * 4 + k].z), fabsf(v[j * 4 + k].w))));
                }
            am = wave_max(am);
            const float s = am > 0.f ? am * (isv ? (1.f / 443.f) : (1.f / 127.f)) : 1.f, inv = 1.f / s;
            unsigned char* drow = (unsigned char*)(ws + (isv ? WS_VT : WS_UT)) + (size_t)rr * DM;
#pragma unroll
            for (int j = 0; j < 2; ++j) {
                u32x4 o; unsigned w[4];
#pragma unroll
                for (int k = 0; k < 4; ++k) {
                    const f32x4 a = v[j * 4 + k];
                    if (isv) {
                        int pk = __builtin_amdgcn_cvt_pk_fp8_f32(a.x * inv, a.y * inv, 0, false);
                        pk = __builtin_amdgcn_cvt_pk_fp8_f32(a.z * inv, a.w * inv, pk, true);
                        w[k] = (unsigned)pk;
                    } else {
                        const int q0 = (int)rintf(a.x * inv), q1 = (int)rintf(a.y * inv), q2 = (int)rintf(a.z * inv), q3 = (int)rintf(a.w * inv);
                        w[k] = ((unsigned)q0 & 0xffu) | (((unsigned)q1 & 0xffu) << 8) | (((unsigned)q2 & 0xffu) << 16) | ((unsigned)q3 << 24);
                    }
                }
                o.x = w[0]; o.y = w[1]; o.z = w[2]; o.w = w[3];
                *(u32x4*)(drow + j * 1024 + lane * 16) = o;
            }
            if (lane == 0) ((float*)(ws + (isv ? WS_VSC : WS_USC)))[rr] = s;
        }
#else
        cvt_range(p.peer_u, (bf16_t*)(ws + WS_UT), (size_t)2 * NEXP * DM / 8, gtid, gth);
        cvt_range(p.peer_v, (bf16_t*)(ws + WS_VT), (size_t)2 * NEXP * DM / 8, gtid, gth);
#endif
        float* rope = (float*)(ws + WS_ROPE);
        for (size_t i = gtid; i < (size_t)2048 * 64; i += gth) {
            const int t = (int)(i >> 6), f = (int)(i & 63), fi = f & 31;
            const float pos = (f < 32) ? (float)(t >> 6) : (float)(t & 63);
            const float inv = powf(10000.0f, -(float)fi / 32.0f);
            const float ang = pos * inv;
            rope[i * 2] = cosf(ang); rope[i * 2 + 1] = sinf(ang);
        }
    }
}


__device__ __forceinline__ void modulate_store(const f32x4 (&v)[8], float rstd, const float* g, const float* shift, const float* scale, bf16_t* dst, int lane) {
#pragma unroll
    for (int j = 0; j < 8; ++j) {
        const int col = j * 256 + lane * 4;
        const f32x4 gg = *(const f32x4*)(g + col), sc = *(const f32x4*)(scale + col), sh = *(const f32x4*)(shift + col);
        const f32x4 o = v[j] * rstd * gg * (1.f + sc) + sh;
        u32x2 w; w.x = pk2(o.x, o.y); w.y = pk2(o.z, o.w);
        *(u32x2*)(dst + col) = w;
    }
}
__device__ __forceinline__ void modulate_store_i8(const f32x4 (&v)[8], float rstd, const float* g, const float* shift, const float* scale, unsigned char* dst, float* sdst, int lane, const float levels) {
    f32x4 o[8]; float am = 0.f;
#pragma unroll
    for (int j = 0; j < 8; ++j) {
        const int col = j * 256 + lane * 4;
        const f32x4 gg = *(const f32x4*)(g + col), sc = *(const f32x4*)(scale + col), sh = *(const f32x4*)(shift + col);
        o[j] = v[j] * rstd * gg * (1.f + sc) + sh;
        am = fmaxf(am, fmaxf(fmaxf(fabsf(o[j].x), fabsf(o[j].y)), fmaxf(fabsf(o[j].z), fabsf(o[j].w))));
    }
    am = wave_max(am);
    const float s = am > 0.f ? am / levels : 1.f, inv = 1.f / s;
#pragma unroll
    for (int j = 0; j < 8; ++j) *(unsigned*)(dst + j * 256 + lane * 4) = q8pack4(o[j].x, o[j].y, o[j].z, o[j].w, inv);
    if (lane == 0) *sdst = s;
}
__device__ __forceinline__ void ph_modulate(const Params& p, int l, int which) {
    const int tid = threadIdx.x, lane = tid & 63, wave = tid >> 6;
    const int gw = blockIdx.x * NWAVES + wave, NGW = gridDim.x * NWAVES;
    const int nrows = (which == 1 && l == DEPTH - 1) ? NLAT : MTOT;
    const float* g = (which == 0 ? p.norm1_g : p.norm2_g) + l * DM;
    const float* mod = (const float*)(p.ws + WS_MOD) + (size_t)l * 9 * 12288;
    const float* srcLat = (which == 0 && l == 0) ? p.x : p.out;
    const float* srcCtx = (which == 0 && l == 0) ? p.ctx : (const float*)(p.ws + WS_HC);
    bf16_t* XN = (bf16_t*)(p.ws + WS_XN);
    const int moff = (which == 0 ? 0 : 3) * DM;
#pragma unroll 1
    for (int r = gw; r < nrows; r += 2 * NGW) {
        const int r2 = r + NGW; const bool has2 = r2 < nrows; const int rb = has2 ? r2 : r;
        const float* srcA = r < NLAT ? srcLat + (size_t)r * DM : srcCtx + (size_t)(r - NLAT) * DM;
        const float* srcB = rb < NLAT ? srcLat + (size_t)rb * DM : srcCtx + (size_t)(rb - NLAT) * DM;
        f32x4 va[8], vb[8]; float sa = 0.f, sb = 0.f;
        if (H_BF16 && GEMM_I8 && GEMM3_I8 && which == 1) {
            const bf16_t* HB = (const bf16_t*)(p.ws + WS_HB);
#pragma unroll
            for (int j = 0; j < 8; ++j) {
                const u32x2 ra = *(const u32x2*)(HB + (size_t)r * DM + j * 256 + lane * 4), rb2 = *(const u32x2*)(HB + (size_t)rb * DM + j * 256 + lane * 4);
                va[j] = (f32x4){bflo(ra.x), bfhi(ra.x), bflo(ra.y), bfhi(ra.y)}; vb[j] = (f32x4){bflo(rb2.x), bfhi(rb2.x), bflo(rb2.y), bfhi(rb2.y)};
            }
        } else {
#pragma unroll
        for (int j = 0; j < 8; ++j) { va[j] = *(const f32x4*)(srcA + j * 256 + lane * 4); vb[j] = *(const f32x4*)(srcB + j * 256 + lane * 4); }
        }
#pragma unroll
        for (int j = 0; j < 8; ++j) { sa += va[j].x * va[j].x + va[j].y * va[j].y + va[j].z * va[j].z + va[j].w * va[j].w; sb += vb[j].x * vb[j].x + vb[j].y * vb[j].y + vb[j].z * vb[j].z + vb[j].w * vb[j].w; }
        sa = wave_sum(sa); sb = wave_sum(sb);
        const float* shA = mod + (size_t)(r < NLAT ? (r >> 11) : 8) * 12288 + moff;
        const bool i8 = GEMM_I8 && (which == 0 || GEMM3_I8); const float lv = which == 0 ? 127.f : 119.f;
        unsigned char* XN8 = (unsigned char*)(p.ws + WS_XN8); float* SXN = (float*)(p.ws + WS_SCL) + SCL_XN;
        if (i8) modulate_store_i8(va, rsqrtf(sa * (1.f / DM) + EPS), g, shA, shA + DM, XN8 + (size_t)r * DM, SXN + r, lane, lv);
        else modulate_store(va, rsqrtf(sa * (1.f / DM) + EPS), g, shA, shA + DM, XN + (size_t)r * DM, lane);
        if (has2) {
            const float* shB = mod + (size_t)(r2 < NLAT ? (r2 >> 11) : 8) * 12288 + moff;
            if (i8) modulate_store_i8(vb, rsqrtf(sb * (1.f / DM) + EPS), g, shB, shB + DM, XN8 + (size_t)r2 * DM, SXN + r2, lane, lv);
            else modulate_store(vb, rsqrtf(sb * (1.f / DM) + EPS), g, shB, shB + DM, XN + (size_t)r2 * DM, lane);
        }
    }
}

struct EpiBf16Store {
    bf16_t* O; int ldc;
    __device__ __forceinline__ void operator()(int row, int col, const float* a) const {
        u32x4 w; w.x = pk2(a[0], a[1]); w.y = pk2(a[2], a[3]); w.z = pk2(a[4], a[5]); w.w = pk2(a[6], a[7]);
        *(u32x4*)(O + (size_t)row * ldc + col) = w;
    }
};
struct EpiResGate {
    const float *resLat, *resCtx; float *outLat, *outCtx; const float* gate;
    __device__ __forceinline__ void operator()(int row, int col, const float* a) const {
        const int bb = row < NLAT ? (row >> 11) : 8;
        const float* gp = gate + (size_t)bb * 12288 + col;
        const float* rp = row < NLAT ? resLat + (size_t)row * DM + col : resCtx + (size_t)(row - NLAT) * DM + col;
        float* op = row < NLAT ? outLat + (size_t)row * DM + col : outCtx + (size_t)(row - NLAT) * DM + col;
        const f32x4 g0 = *(const f32x4*)gp, g1 = *(const f32x4*)(gp + 4), r0 = *(const f32x4*)rp, r1 = *(const f32x4*)(rp + 4);
        f32x4 o0, o1;
        o0.x = r0.x + g0.x * a[0]; o0.y = r0.y + g0.y * a[1]; o0.z = r0.z + g0.z * a[2]; o0.w = r0.w + g0.w * a[3];
        o1.x = r1.x + g1.x * a[4]; o1.y = r1.y + g1.y * a[5]; o1.z = r1.z + g1.z * a[6]; o1.w = r1.w + g1.w * a[7];
        *(f32x4*)op = o0; *(f32x4*)(op + 4) = o1;
    }
};
template <class Epi>
__device__ __forceinline__ void gemm_naive(unsigned char* lds, const bf16_t* A, const bf16_t* Bt, int M, int N, int K, const Epi& E) {
    float* As = (float*)lds;
    float* Bs = As + 32 * 132;
    const int tid = threadIdx.x, tx = tid & 15, ty = tid >> 4;
    const int lrow = tid >> 2, lkc = (tid & 3) * 8;
    const int nM = M / 128, nN = N / 128;
    for (int u = blockIdx.x; u < nM * nN; u += gridDim.x) {
        const int pm = u / nN, pn = u % nN, m0 = pm * 128, n0 = pn * 128;
        float acc[4][8];
#pragma unroll
        for (int i = 0; i < 4; ++i)
#pragma unroll
            for (int j = 0; j < 8; ++j) acc[i][j] = 0.f;
        for (int k0 = 0; k0 < K; k0 += 32) {
            const u32x4 av = *(const u32x4*)(A + (size_t)(m0 + lrow) * K + k0 + lkc);
            const u32x4 bv = *(const u32x4*)(Bt + (size_t)(n0 + lrow) * K + k0 + lkc);
            __syncthreads();
            As[(lkc + 0) * 132 + lrow] = bflo(av.x); As[(lkc + 1) * 132 + lrow] = bfhi(av.x);
            As[(lkc + 2) * 132 + lrow] = bflo(av.y); As[(lkc + 3) * 132 + lrow] = bfhi(av.y);
            As[(lkc + 4) * 132 + lrow] = bflo(av.z); As[(lkc + 5) * 132 + lrow] = bfhi(av.z);
            As[(lkc + 6) * 132 + lrow] = bflo(av.w); As[(lkc + 7) * 132 + lrow] = bfhi(av.w);
            Bs[(lkc + 0) * 132 + lrow] = bflo(bv.x); Bs[(lkc + 1) * 132 + lrow] = bfhi(bv.x);
            Bs[(lkc + 2) * 132 + lrow] = bflo(bv.y); Bs[(lkc + 3) * 132 + lrow] = bfhi(bv.y);
            Bs[(lkc + 4) * 132 + lrow] = bflo(bv.z); Bs[(lkc + 5) * 132 + lrow] = bfhi(bv.z);
            Bs[(lkc + 6) * 132 + lrow] = bflo(bv.w); Bs[(lkc + 7) * 132 + lrow] = bfhi(bv.w);
            __syncthreads();
#pragma unroll 8
            for (int k = 0; k < 32; ++k) {
                const f32x4 a = *(const f32x4*)(As + k * 132 + ty * 4);
                const f32x4 b0 = *(const f32x4*)(Bs + k * 132 + tx * 8), b1 = *(const f32x4*)(Bs + k * 132 + tx * 8 + 4);
                const float av4[4] = {a.x, a.y, a.z, a.w};
                const float bv8[8] = {b0.x, b0.y, b0.z, b0.w, b1.x, b1.y, b1.z, b1.w};
#pragma unroll
                for (int i = 0; i < 4; ++i)
#pragma unroll
                    for (int j = 0; j < 8; ++j) acc[i][j] += av4[i] * bv8[j];
            }
        }
#pragma unroll
        for (int i = 0; i < 4; ++i) E(m0 + ty * 4 + i, n0 + tx * 8, acc[i]);
    }
}

namespace pg8 {
#define PG8_LAS __attribute__((address_space(3)))
typedef unsigned short bf16_t;
typedef short bf16x8 __attribute__((ext_vector_type(8)));
typedef float f32x4 __attribute__((ext_vector_type(4)));
typedef unsigned u32x4 __attribute__((ext_vector_type(4)));
constexpr int BM = 256, BK = 64, HALF = 128, HTB = HALF * BK * 2  , STAGE_BYTES = 8 * HTB, NXCD = 8, WGM = 8;

__host__ __device__ __forceinline__ int lds_byte(int r, int c) { const int st = (r >> 4) * 2 + (c >> 5), rr = r & 15, cc = c & 31, ob = rr * 64 + cc * 2; return st * 1024 + (ob ^ (((ob >> 9) & 1) << 5)); }
__host__ __device__ __forceinline__ void stage_rc(int b, int& R, int& C) { const int st = b / 1024, sb = b % 1024, swz = sb ^ (((sb >> 9) & 1) << 5); R = (st >> 1) * 16 + swz / 64; C = (st & 1) * 32 + (swz % 64) / 2; }
__host__ __device__ __forceinline__ int perm32(int rho) { const int n = rho >> 4, i = rho & 15; return 8 * (i >> 2) + 4 * n + (i & 3); }

struct Unit { int pm, pn; };
struct Gemm { const bf16_t* A; const bf16_t* Bt; int M, N, K; };

struct StaticOrder {
    int nM, nN, nwg, G, c;
    __host__ __device__ void init(int M, int N, int G_, int c_) { nM = M / BM; nN = N / BM; nwg = nM * nN; G = G_; c = c_; }
    __host__ __device__ bool next(int i, Unit& u) const {
        const long L = (long)i * G + c; if (L >= nwg) return false;
        int wgid = (int)L; { const int q = nwg / NXCD, r = nwg % NXCD, xcd = wgid % NXCD, off = wgid / NXCD; wgid = (xcd < r ? xcd * (q + 1) : r * (q + 1) + (xcd - r) * q) + off; }
        const int nig = WGM * nN, gid = wgid / nig, fm = gid * WGM, gsz = (nM - fm) < WGM ? (nM - fm) : WGM;
        u.pm = fm + ((wgid % nig) % gsz); u.pn = (wgid % nig) / gsz; return true;
    }
    __device__ __forceinline__ void a_ready(const Unit&) const {}
    __device__ __forceinline__ void done(const Unit&) const {}
};

__device__ __forceinline__ unsigned cvt_pk_bf16(float lo, float hi) { unsigned r; asm volatile("v_cvt_pk_bf16_f32 %0, %1, %2" : "=v"(r) : "v"(lo), "v"(hi)); return r; }
typedef float f32x2 __attribute__((ext_vector_type(2)));
__device__ __forceinline__ f32x2 gelu_pk(f32x2 v) {
    const f32x2 av = __builtin_elementwise_abs(v), d = av * 0.2316418882f + 1.0f;
    f32x2 t; t.x = __builtin_amdgcn_rcpf(d.x); t.y = __builtin_amdgcn_rcpf(d.y);
    f32x2 q = t * 0.5307027145f + (-0.7265760135f); q = q * t + 0.7107068705f; q = q * t + (-0.142248368f); q = q * t + 0.127414796f; q = q * t;
    const f32x2 s = (v * v) * (-0.72134752044f);
    f32x2 e; e.x = __builtin_amdgcn_exp2f(s.x); e.y = __builtin_amdgcn_exp2f(s.y);
    const f32x2 m = v * (q * e), r = v - m;
    f32x2 o; o.x = v.x < 0.f ? m.x : r.x; o.y = v.y < 0.f ? m.y : r.y; return o;
}

template <int ACT  > struct EpiBf16 {
    static constexpr bool PERM = true, AFTER_DRAIN = false; static_assert(ACT == 0 || ACT == 1, "EpiBf16: ACT is 0 (none) or 1 (gelu_pk)");
    bf16_t* O; int ldc; const float* bias; int split_cols; size_t split_stride; float scale0;
    __device__ __forceinline__ void operator()(const f32x4 (&acc)[2][2][4][2], const Unit& u, int wr, int wc, int fr, int fq) const {
        const int row0 = u.pm * BM + wr * 64 + fr; int colt = u.pn * BM; bf16_t* base = O;
        float sc = 1.f; if (split_cols) { const int t = colt / split_cols; base += (size_t)t * split_stride; colt -= t * split_cols; if (t == 0) sc = scale0; }
        const int col0 = colt + wc * 32 + 8 * fq, bcol0 = u.pn * BM + wc * 32 + 8 * fq;
        f32x4 bv[2][2];
#pragma unroll
        for (int bj = 0; bj < 2; ++bj)
#pragma unroll
            for (int n = 0; n < 2; ++n) bv[bj][n] = bias ? *(const f32x4*)(bias + bcol0 + bj * HALF + 4 * n) : (f32x4){0.f, 0.f, 0.f, 0.f};
#pragma unroll
        for (int ai = 0; ai < 2; ++ai)
#pragma unroll
            for (int m = 0; m < 4; ++m) { bf16_t* rowp = base + (size_t)(row0 + ai * HALF + m * 16) * ldc + col0;
#pragma unroll
                for (int bj = 0; bj < 2; ++bj) { f32x4 v0 = acc[ai][bj][m][0] + bv[bj][0], v1 = acc[ai][bj][m][1] + bv[bj][1];
                    if (ACT == 1) { f32x2 a = gelu_pk((f32x2){v0[0], v0[1]}), b = gelu_pk((f32x2){v0[2], v0[3]}), c = gelu_pk((f32x2){v1[0], v1[1]}), d = gelu_pk((f32x2){v1[2], v1[3]});
                        v0 = (f32x4){a.x, a.y, b.x, b.y}; v1 = (f32x4){c.x, c.y, d.x, d.y}; }
                    v0 = v0 * sc; v1 = v1 * sc; u32x4 w; w.x = cvt_pk_bf16(v0[0], v0[1]); w.y = cvt_pk_bf16(v0[2], v0[3]); w.z = cvt_pk_bf16(v1[0], v1[1]); w.w = cvt_pk_bf16(v1[2], v1[3]);
                    *(u32x4*)(rowp + bj * HALF) = w; } }
    }
};
typedef int i32x4 __attribute__((ext_vector_type(4)));
template <bool I8> struct AccSel { typedef f32x4 type; };
template <> struct AccSel<true> { typedef i32x4 type; };
template <class Epi, class Sched, bool ALIGN_EPI = false, bool SP2 = false, bool I8 = false>
__device__ __forceinline__ void gemm_phase(PG8_LAS unsigned char* lds, const Gemm g, const Sched& S, const Epi& E) {
    const int tid = threadIdx.x, wid = __builtin_amdgcn_readfirstlane(tid >> 6), lane = tid & 63, wr = wid >> 2, wc = wid & 3, fr = lane & 15, fq = lane >> 4;
    const int K = g.K, nt = K / BK;
    unsigned voffA[2], voffB[2];
#pragma unroll
    for (int i = 0; i < 2; ++i) { int R, C; stage_rc(tid * 16 + i * 8192, R, C); const int Rb = Epi::PERM ? ((R & ~31) + perm32(R & 31)) : R;
        voffA[i] = (unsigned)(R * K + C) * 2u; voffB[i] = (unsigned)(Rb * K + C) * 2u; }
    const size_t kstep = (size_t)(BK * 2);
    const size_t hstep = (size_t)HALF * K * 2;
    const size_t tstep = 2 * hstep;
    const unsigned ldsw = (unsigned)wid * 1024u;
    const int aoff = lds_byte(wr * 64 + fr, fq * 8), boff = lds_byte(wc * 32 + fr, fq * 8);
#define PG8_SA(b, h) (((b) * 2 + (h)) * HTB)
#define PG8_SB(b, h) ((4 + (b) * 2 + (h)) * HTB)
#define PG8_STAGE(bufoff, gbase, voff) do { _Pragma("unroll") for (int _i = 0; _i < 2; ++_i) \
        __builtin_amdgcn_global_load_lds((const unsigned*)((const char*)(gbase) + (voff)[_i]), (PG8_LAS unsigned*)(lds + (bufoff) + ldsw + _i * 8192), 16, 0, 0); } while (0)
#define PG8_LDA(dst, b, h) do { _Pragma("unroll") for (int m = 0; m < 4; ++m) _Pragma("unroll") for (int k = 0; k < 2; ++k) dst[m][k] = *(const PG8_LAS bf16x8*)(lds + PG8_SA(b, h) + aoff + m * 2048 + k * 1024); } while (0)
#define PG8_LDB(dst, b, h) do { _Pragma("unroll") for (int n = 0; n < 2; ++n) _Pragma("unroll") for (int k = 0; k < 2; ++k) dst[n][k] = *(const PG8_LAS bf16x8*)(lds + PG8_SB(b, h) + boff + n * 2048 + k * 1024); } while (0)
#define PG8_MMA(ai, bj, At, Bt) do { __builtin_amdgcn_s_setprio(1); _Pragma("unroll") for (int m = 0; m < 4; ++m) _Pragma("unroll") for (int n = 0; n < 2; ++n) _Pragma("unroll") for (int k = 0; k < 2; ++k) \
        { if constexpr (I8) acc[ai][bj][m][n] = __builtin_amdgcn_mfma_i32_16x16x64_i8(__builtin_bit_cast(i32x4, Bt[n][k]), __builtin_bit_cast(i32x4, At[m][k]), acc[ai][bj][m][n], 0, 0, 0); \
          else acc[ai][bj][m][n] = __builtin_amdgcn_mfma_f32_16x16x32_bf16(Bt[n][k], At[m][k], acc[ai][bj][m][n], 0, 0, 0); } __builtin_amdgcn_s_setprio(0); } while (0)
#define PG8_WAIT_V(n) asm volatile("s_waitcnt vmcnt(" #n ")" ::: "memory")
#define PG8_WAIT_L(n) asm volatile("s_waitcnt lgkmcnt(" #n ")" ::: "memory")
#define PG8_BAR __builtin_amdgcn_s_barrier()
#define PG8_SCHED __builtin_amdgcn_sched_barrier(0)
    Unit cur, nxt; int ui = 0;
    if (!S.next(0, cur)) return;
    typedef typename AccSel<I8>::type acc_t; const acc_t zero_ = {};
    acc_t acc[2][2][4][2];
#pragma unroll
    for (int a = 0; a < 2; ++a)
#pragma unroll
        for (int b = 0; b < 2; ++b)
#pragma unroll
            for (int m = 0; m < 4; ++m)
#pragma unroll
                for (int n = 0; n < 2; ++n) acc[a][b][m][n] = zero_;
    bf16x8 At[4][2], B0[2][2], B1[2][2];
    const char* cA = (const char*)g.A + (size_t)cur.pm * tstep; const char* cB = (const char*)g.Bt + (size_t)cur.pn * tstep;
    S.a_ready(cur);
    if constexpr (SP2) {
        PG8_STAGE(PG8_SB(0, 0), cB, voffB); PG8_STAGE(PG8_SB(0, 1), cB + hstep, voffB); PG8_STAGE(PG8_SA(0, 0), cA, voffA); PG8_STAGE(PG8_SA(0, 1), cA + hstep, voffA);
        if (wr == 1) PG8_BAR;
        PG8_WAIT_V(2); PG8_BAR;
        PG8_STAGE(PG8_SB(1, 0), cB + kstep, voffB); PG8_STAGE(PG8_SA(1, 0), cA + kstep, voffA); PG8_STAGE(PG8_SB(1, 1), cB + hstep + kstep, voffB);
        PG8_WAIT_V(6); PG8_BAR;
    } else {
        PG8_STAGE(PG8_SB(0, 0), cB, voffB); PG8_STAGE(PG8_SA(0, 0), cA, voffA); PG8_STAGE(PG8_SB(0, 1), cB + hstep, voffB); PG8_STAGE(PG8_SA(0, 1), cA + hstep, voffA);
        if (wr == 1) PG8_BAR;
        PG8_WAIT_V(4); PG8_BAR;
        PG8_STAGE(PG8_SB(1, 0), cB + kstep, voffB); PG8_STAGE(PG8_SA(1, 0), cA + kstep, voffA); PG8_STAGE(PG8_SB(1, 1), cB + hstep + kstep, voffB);
        PG8_WAIT_V(6); PG8_BAR;
    }
    for (;;) {
        const bool has_next = S.next(ui + 1, nxt);
        const char* nA = has_next ? (const char*)g.A + (size_t)nxt.pm * tstep : cA; const char* nB = has_next ? (const char*)g.Bt + (size_t)nxt.pn * tstep : cB;
        for (int t = 0; t < nt; t += 2) {
            const bool last = (t == nt - 2);
            const char* a1 = cA + (size_t)(t + 1) * kstep;
            const char* a2 = last ? nA : cA + (size_t)(t + 2) * kstep; const char* b2 = last ? nB : cB + (size_t)(t + 2) * kstep;
            const char* a3 = a2 + kstep; const char* b3 = b2 + kstep;
            if (last && has_next) S.a_ready(nxt);
            if constexpr (SP2) {
            PG8_LDB(B0, 0, 0); PG8_LDB(B1, 0, 1); PG8_SCHED; PG8_LDA(At, 0, 0); PG8_STAGE(PG8_SA(1, 1), a1 + hstep, voffA);
            PG8_WAIT_V(8); PG8_WAIT_L(0); PG8_BAR; PG8_MMA(0, 0, At, B0); PG8_MMA(0, 1, At, B1); PG8_BAR; PG8_SCHED;
            PG8_LDA(At, 0, 1); PG8_STAGE(PG8_SB(0, 0), b2, voffB); PG8_STAGE(PG8_SB(0, 1), b2 + hstep, voffB); PG8_STAGE(PG8_SA(0, 0), a2, voffA);
            PG8_WAIT_V(8); PG8_WAIT_L(0); PG8_BAR; PG8_MMA(1, 0, At, B0); PG8_MMA(1, 1, At, B1); PG8_BAR; PG8_SCHED;
            PG8_LDB(B0, 1, 0); PG8_LDB(B1, 1, 1); PG8_SCHED; PG8_LDA(At, 1, 0); PG8_STAGE(PG8_SA(0, 1), a2 + hstep, voffA);
            PG8_WAIT_V(8); PG8_WAIT_L(0); PG8_BAR; PG8_MMA(0, 0, At, B0); PG8_MMA(0, 1, At, B1); PG8_BAR; PG8_SCHED;
            PG8_LDA(At, 1, 1); PG8_STAGE(PG8_SB(1, 0), b3, voffB); PG8_STAGE(PG8_SB(1, 1), b3 + hstep, voffB); PG8_STAGE(PG8_SA(1, 0), a3, voffA);
            PG8_WAIT_V(8); PG8_WAIT_L(0); PG8_BAR; PG8_MMA(1, 0, At, B0); PG8_MMA(1, 1, At, B1); PG8_BAR; PG8_SCHED;
            } else {
            PG8_LDB(B0, 0, 0); PG8_SCHED; PG8_LDA(At, 0, 0); PG8_STAGE(PG8_SA(1, 1), a1 + hstep, voffA);
            PG8_WAIT_L(8); PG8_BAR; PG8_WAIT_L(0); PG8_MMA(0, 0, At, B0); PG8_BAR; PG8_SCHED;
            PG8_LDB(B1, 0, 1); PG8_STAGE(PG8_SB(0, 0), b2, voffB);
            PG8_BAR; PG8_WAIT_L(0); PG8_MMA(0, 1, At, B1); PG8_BAR;
            PG8_LDA(At, 0, 1); PG8_STAGE(PG8_SA(0, 0), a2, voffA);
            PG8_BAR; PG8_WAIT_L(0); PG8_MMA(1, 0, At, B0); PG8_BAR; PG8_SCHED;
            PG8_STAGE(PG8_SB(0, 1), b2 + hstep, voffB);
            PG8_WAIT_V(6); PG8_BAR; PG8_MMA(1, 1, At, B1); PG8_BAR;
            PG8_LDB(B0, 1, 0); PG8_SCHED; PG8_LDA(At, 1, 0); PG8_STAGE(PG8_SA(0, 1), a2 + hstep, voffA);
            PG8_WAIT_L(8); PG8_BAR; PG8_WAIT_L(0); PG8_MMA(0, 0, At, B0); PG8_BAR; PG8_SCHED;
            PG8_LDB(B1, 1, 1); PG8_STAGE(PG8_SB(1, 0), b3, voffB);
            PG8_BAR; PG8_WAIT_L(0); PG8_MMA(0, 1, At, B1); PG8_BAR;
            PG8_LDA(At, 1, 1); PG8_STAGE(PG8_SA(1, 0), a3, voffA);
            PG8_BAR; PG8_WAIT_L(0); PG8_MMA(1, 0, At, B0); PG8_BAR; PG8_SCHED;
            PG8_STAGE(PG8_SB(1, 1), b3 + hstep, voffB);
            PG8_WAIT_V(6); PG8_BAR; PG8_MMA(1, 1, At, B1); PG8_BAR;
            }
        }
        if constexpr (ALIGN_EPI) { if (wr == 0) PG8_BAR; }
        if constexpr (!Epi::AFTER_DRAIN) { E(acc, cur, wr, wc, fr, fq); S.done(cur); }
        if (!has_next) break;
#pragma unroll
        for (int a = 0; a < 2; ++a)
#pragma unroll
            for (int b = 0; b < 2; ++b)
#pragma unroll
                for (int m = 0; m < 4; ++m)
#pragma unroll
                    for (int n = 0; n < 2; ++n) acc[a][b][m][n] = zero_;
        cur = nxt; cA = nA; cB = nB; ++ui;
        if constexpr (ALIGN_EPI) { if (wr == 1) PG8_BAR; }
    }
    PG8_WAIT_V(0);
    if constexpr (!ALIGN_EPI) { if (wr == 0) PG8_BAR; }
    PG8_BAR;
    if constexpr (Epi::AFTER_DRAIN) { E.fused(acc, cur, wr, wc, fr, fq, lds, wid, lane); S.done(cur); }
#undef PG8_SA
#undef PG8_SB
#undef PG8_STAGE
#undef PG8_LDA
#undef PG8_LDB
#undef PG8_MMA
#undef PG8_WAIT_V
#undef PG8_WAIT_L
#undef PG8_BAR
#undef PG8_SCHED
}

struct EpiResGateT {
    static constexpr bool PERM = false, AFTER_DRAIN = false;
    const float *resLat, *resCtx; float *outLat, *outCtx; const float* gate;
    __device__ __forceinline__ void operator()(const f32x4 (&acc)[2][2][4][2], const Unit& u, int wr, int wc, int fr, int fq) const {
        const int trow = u.pm * BM, row0 = trow + wr * 64 + fr, col0 = u.pn * BM + wc * 32 + 4 * fq;
        const bool lat = trow < 16384;
        const int bb = lat ? (trow >> 11) : 8;
        const float* rbase = lat ? resLat + (size_t)row0 * 2048 : resCtx + (size_t)(row0 - 16384) * 2048;
        float* obase = lat ? outLat + (size_t)row0 * 2048 : outCtx + (size_t)(row0 - 16384) * 2048;
        f32x4 gv[2][2];
#pragma unroll
        for (int bj = 0; bj < 2; ++bj)
#pragma unroll
            for (int n = 0; n < 2; ++n) gv[bj][n] = *(const f32x4*)(gate + (size_t)bb * 12288 + col0 + bj * HALF + n * 16);
#pragma unroll
        for (int ai = 0; ai < 2; ++ai)
#pragma unroll
            for (int m = 0; m < 4; ++m) {
                const size_t off = (size_t)(ai * HALF + m * 16) * 2048 + col0;
#pragma unroll
                for (int bj = 0; bj < 2; ++bj)
#pragma unroll
                    for (int n = 0; n < 2; ++n) {
                        const f32x4 r = *(const f32x4*)(rbase + off + bj * HALF + n * 16);
                        *(f32x4*)(obase + off + bj * HALF + n * 16) = r + gv[bj][n] * acc[ai][bj][m][n];
                    }
            }
    }
};

struct EpiBf16I8 {
    static constexpr bool PERM = true, AFTER_DRAIN = false;
    bf16_t* O; int ldc; const float* sa; const float* sb;
    __device__ __forceinline__ void operator()(const i32x4 (&acc)[2][2][4][2], const Unit& u, int wr, int wc, int fr, int fq) const {
        const int row0 = u.pm * BM + wr * 64 + fr, col0 = u.pn * BM + wc * 32 + 8 * fq;
        f32x4 sv[2][2];
#pragma unroll
        for (int bj = 0; bj < 2; ++bj)
#pragma unroll
            for (int n = 0; n < 2; ++n) sv[bj][n] = *(const f32x4*)(sb + col0 + bj * HALF + 4 * n);
#pragma unroll
        for (int ai = 0; ai < 2; ++ai)
#pragma unroll
            for (int m = 0; m < 4; ++m) {
                const int row = row0 + ai * HALF + m * 16; const float s = sa[row];
                bf16_t* rowp = O + (size_t)row * ldc + col0;
#pragma unroll
                for (int bj = 0; bj < 2; ++bj) {
                    const i32x4 a0 = acc[ai][bj][m][0], a1 = acc[ai][bj][m][1];
                    const f32x4 v0 = (f32x4){(float)a0.x, (float)a0.y, (float)a0.z, (float)a0.w} * s * sv[bj][0];
                    const f32x4 v1 = (f32x4){(float)a1.x, (float)a1.y, (float)a1.z, (float)a1.w} * s * sv[bj][1];
                    u32x4 w; w.x = cvt_pk_bf16(v0[0], v0[1]); w.y = cvt_pk_bf16(v0[2], v0[3]); w.z = cvt_pk_bf16(v1[0], v1[1]); w.w = cvt_pk_bf16(v1[2], v1[3]);
                    *(u32x4*)(rowp + bj * HALF) = w;
                }
            }
    }
};
struct EpiResGateI8 {
    static constexpr bool PERM = false, AFTER_DRAIN = false;
    const float *resLat, *resCtx; float *outLat, *outCtx; const float* gate; const float* sa; const float* sb;
    __device__ __forceinline__ void operator()(const i32x4 (&acc)[2][2][4][2], const Unit& u, int wr, int wc, int fr, int fq) const {
        const int trow = u.pm * BM, row0 = trow + wr * 64 + fr, col0 = u.pn * BM + wc * 32 + 4 * fq;
        const bool lat = trow < 16384;
        const int bb = lat ? (trow >> 11) : 8;
        const float* rbase = lat ? resLat + (size_t)row0 * 2048 : resCtx + (size_t)(row0 - 16384) * 2048;
        float* obase = lat ? outLat + (size_t)row0 * 2048 : outCtx + (size_t)(row0 - 16384) * 2048;
        f32x4 gv[2][2];
#pragma unroll
        for (int bj = 0; bj < 2; ++bj)
#pragma unroll
            for (int n = 0; n < 2; ++n) gv[bj][n] = *(const f32x4*)(gate + (size_t)bb * 12288 + col0 + bj * HALF + n * 16) * *(const f32x4*)(sb + col0 + bj * HALF + n * 16);
#pragma unroll
        for (int ai = 0; ai < 2; ++ai)
#pragma unroll
            for (int m = 0; m < 4; ++m) {
                const size_t off = (size_t)(ai * HALF + m * 16) * 2048 + col0;
                const float s = sa[row0 + ai * HALF + m * 16];
#pragma unroll
                for (int bj = 0; bj < 2; ++bj)
#pragma unroll
                    for (int n = 0; n < 2; ++n) {
                        const f32x4 r = *(const f32x4*)(rbase + off + bj * HALF + n * 16);
                        const i32x4 a = acc[ai][bj][m][n];
                        *(f32x4*)(obase + off + bj * HALF + n * 16) = r + gv[bj][n] * ((f32x4){(float)a.x, (float)a.y, (float)a.z, (float)a.w} * s);
                    }
            }
    }
};

struct EpiResGateI8B {
    static constexpr bool PERM = true, AFTER_DRAIN = false;
    const float *resLat, *resCtx;
    bf16_t* hb; const float* gate; const float* sa; const float* sb;
    __device__ __forceinline__ void operator()(const i32x4 (&acc)[2][2][4][2], const Unit& u, int wr, int wc, int fr, int fq) const {
        const int trow = u.pm * BM, row0 = trow + wr * 64 + fr, col0 = u.pn * BM + wc * 32 + 8 * fq;
        const bool lat = trow < 16384;
        const int bb = lat ? (trow >> 11) : 8;
        f32x4 gv[2][2];
#pragma unroll
        for (int bj = 0; bj < 2; ++bj)
#pragma unroll
            for (int n = 0; n < 2; ++n) gv[bj][n] = *(const f32x4*)(gate + (size_t)bb * 12288 + col0 + bj * HALF + 4 * n) * *(const f32x4*)(sb + col0 + bj * HALF + 4 * n);
#pragma unroll
        for (int ai = 0; ai < 2; ++ai)
#pragma unroll
            for (int m = 0; m < 4; ++m) {
                const int row = row0 + ai * HALF + m * 16; const float s = sa[row];
                bf16_t* hp = hb + (size_t)row * 2048 + col0;
#pragma unroll
                for (int bj = 0; bj < 2; ++bj) {
                    f32x4 r0, r1;
                    if (resLat) {
                        const float* rp = (lat ? resLat + (size_t)row * 2048 : resCtx + (size_t)(row - 16384) * 2048) + col0 + bj * HALF;
                        r0 = *(const f32x4*)rp; r1 = *(const f32x4*)(rp + 4);
                    } else {
                        const u32x4 q = *(const u32x4*)(hp + bj * HALF);
                        r0 = (f32x4){__uint_as_float(q.x << 16), __uint_as_float(q.x & 0xffff0000u), __uint_as_float(q.y << 16), __uint_as_float(q.y & 0xffff0000u)};
                        r1 = (f32x4){__uint_as_float(q.z << 16), __uint_as_float(q.z & 0xffff0000u), __uint_as_float(q.w << 16), __uint_as_float(q.w & 0xffff0000u)};
                    }
                    const i32x4 a0 = acc[ai][bj][m][0], a1 = acc[ai][bj][m][1];
                    const f32x4 v0 = r0 + (gv[bj][0] * s) * (f32x4){(float)a0.x, (float)a0.y, (float)a0.z, (float)a0.w};
                    const f32x4 v1 = r1 + (gv[bj][1] * s) * (f32x4){(float)a1.x, (float)a1.y, (float)a1.z, (float)a1.w};
                    u32x4 w; w.x = cvt_pk_bf16(v0[0], v0[1]); w.y = cvt_pk_bf16(v0[2], v0[3]); w.z = cvt_pk_bf16(v1[0], v1[1]); w.w = cvt_pk_bf16(v1[2], v1[3]);
                    *(u32x4*)(hp + bj * HALF) = w;
                }
            }
    }
};
}
#ifndef USE_PG8
#define USE_PG8 1
#endif

__device__ __forceinline__ float sum16(float v) { v += __shfl_xor(v, 1); v += __shfl_xor(v, 2); v += __shfl_xor(v, 4); v += __shfl_xor(v, 8); return v; }
__device__ __forceinline__ void ph_prep(const Params& p, int l, const bool dry) {
    const int tid = threadIdx.x, lane = tid & 63, wave = tid >> 6, sub = lane >> 4, li = lane & 15;
    const int gw = blockIdx.x * NWAVES + wave, NGW = gridDim.x * NWAVES;
    bf16_t* P = (bf16_t*)(p.ws + WS_P);
    const float* rope = (const float*)(p.ws + WS_ROPE);
    const bool last = (l == DEPTH - 1);
    const int f0 = (li >= 8 ? 32 : 0) + 8 * (li & 3);
    const float sg = (li & 4) ? 1.f : -1.f;
#pragma unroll 1
    for (int r = gw; r < MTOT; r += NGW) {
        bf16_t* row = P + (size_t)r * INW;
        bf16_t* wrow = dry ? (bf16_t*)(p.ws + WS_DUMMY) + (size_t)r * INW : row;
        const bool isctx = r >= NLAT;
        const int t = r & (SEQ - 1);
        float cs[8], sn[8];
        if (!isctx) {
            const f32x4* rp = (const f32x4*)(rope + ((size_t)t * 64 + f0) * 2);
            const f32x4 a = rp[0], b = rp[1], c = rp[2], d = rp[3];
            cs[0] = a.x; sn[0] = a.y; cs[1] = a.z; sn[1] = a.w; cs[2] = b.x; sn[2] = b.y; cs[3] = b.z; sn[3] = b.w;
            cs[4] = c.x; sn[4] = c.y; cs[5] = c.z; sn[5] = c.w; cs[6] = d.x; sn[6] = d.y; cs[7] = d.z; sn[7] = d.w;
        } else {
#pragma unroll
            for (int i = 0; i < 8; ++i) { cs[i] = 1.f; sn[i] = 0.f; }
        }
        u32x4 raw[7];
#pragma unroll
        for (int gI = 0; gI < 7; ++gI) raw[gI] = *(const u32x4*)(row + (gI * 4 + sub) * 128 + li * 8);
#pragma unroll
        for (int gI = 0; gI < 7; ++gI) {
            const int slot = gI * 4 + sub;
            const int kind = slot < 8 ? 0 : slot < 10 ? 1 : slot < 18 ? 0 : slot < 20 ? 1 : slot < 24 ? 2 : 3;
            const bool isq = slot < 6 || (slot >= 10 && slot < 16);
            float x[8];
            x[0] = bflo(raw[gI].x); x[1] = bfhi(raw[gI].x); x[2] = bflo(raw[gI].y); x[3] = bfhi(raw[gI].y);
            x[4] = bflo(raw[gI].z); x[5] = bfhi(raw[gI].z); x[6] = bflo(raw[gI].w); x[7] = bfhi(raw[gI].w);
            if (kind >= 2) {
#pragma unroll
                for (int i = 0; i < 8; ++i) x[i] = gelu_tanh(x[i]);
            }
            float ss = 0.f;
#pragma unroll
            for (int i = 0; i < 8; ++i) ss += x[i] * x[i];
            ss = sum16(ss);
            const float rstd = rsqrtf(ss * (1.f / 128.f) + EPS);
            const float* gain = slot < 6 ? p.qn_a + l * 128 : slot < 8 ? p.kn_a + l * 128 : slot < 16 ? p.qn_b + l * 128 : slot < 20 ? p.kn_b + l * 128 : p.vn_c + l * 512 + (slot - 24) * 128;
            if (kind == 0 || kind == 3) {
                const f32x4 g0 = *(const f32x4*)(gain + li * 8), g1 = *(const f32x4*)(gain + li * 8 + 4);
                x[0] *= rstd * g0.x; x[1] *= rstd * g0.y; x[2] *= rstd * g0.z; x[3] *= rstd * g0.w;
                x[4] *= rstd * g1.x; x[5] *= rstd * g1.y; x[6] *= rstd * g1.z; x[7] *= rstd * g1.w;
            }
            float px[8];
#pragma unroll
            for (int i = 0; i < 8; ++i) px[i] = __shfl_xor(x[i], 4);
            if (kind == 0) {
#pragma unroll
                for (int i = 0; i < 8; ++i) x[i] = x[i] * cs[i] + sg * px[i] * sn[i];
            }
            bool wr = kind != 1;
            if (isctx && last && (isq || kind >= 2)) wr = false;
            if (wr) { u32x4 o; o.x = pk2(x[0], x[1]); o.y = pk2(x[2], x[3]); o.z = pk2(x[4], x[5]); o.w = pk2(x[6], x[7]); *(u32x4*)(wrow + slot * 128 + li * 8) = o; }
        }
    }
}

__device__ __forceinline__ void attn_row_naive(const bf16_t* q, const bf16_t* kc, const bf16_t* vc, const bf16_t* kl, const bf16_t* vl, int j0, int j1,
                                               bool has_sink, float sink, bf16_t* o, int lane) {
    const unsigned qq = *(const unsigned*)(q + 2 * lane);
    const float q0 = bflo(qq), q1 = bfhi(qq);
    float m = -INFINITY, lsum = 0.f, o0 = 0.f, o1 = 0.f;
    const int ntot = NCTX + (j1 - j0);
    for (int j = 0; j < ntot; ++j) {
        const bf16_t* kp = j < NCTX ? kc + (size_t)j * INW : kl + (size_t)(j0 + j - NCTX) * INW;
        const bf16_t* vp = j < NCTX ? vc + (size_t)j * INW : vl + (size_t)(j0 + j - NCTX) * INW;
        const unsigned kk = *(const unsigned*)(kp + 2 * lane), vv = *(const unsigned*)(vp + 2 * lane);
        const float s = wave_sum(q0 * bflo(kk) + q1 * bfhi(kk)) * ATT_SCALE;
        const float mn = fmaxf(m, s);
        const float a = __expf(m - mn), pp = __expf(s - mn);
        lsum = lsum * a + pp; o0 = o0 * a + pp * bflo(vv); o1 = o1 * a + pp * bfhi(vv);
        m = mn;
    }
    if (has_sink) {
        const float mn = fmaxf(m, sink);
        const float a = __expf(m - mn);
        lsum = lsum * a + __expf(sink - mn); o0 *= a; o1 *= a;
    }
    const float inv = 1.f / lsum;
    *(unsigned*)(o + 2 * lane) = pk2(o0 * inv, o1 * inv);
}

__device__ __forceinline__ void ph_mixers_naive(const Params& p, int l, unsigned char* lds) {
    const int tid = threadIdx.x, lane = tid & 63, wave = tid >> 6;
    const int gw = blockIdx.x * NWAVES + wave, NGW = gridDim.x * NWAVES;
    const bf16_t* P = (const bf16_t*)(p.ws + WS_P);
    bf16_t* Y = (bf16_t*)(p.ws + WS_Y);
    const bool last = (l == DEPTH - 1);
    const int T_LA = NLAT * 6, T_LB = NLAT * 6, T_CA = last ? 0 : NCT * 6, T_CB = last ? 0 : NCT * 6;
    const int ntask = T_LA + T_LB + T_CA + T_CB;
    for (int tk = gw; tk < ntask; tk += NGW) {
        int r = tk;
        if (r < T_LA + T_LB) {
            const bool isB = r >= T_LA; if (isB) r -= T_LA;
            const int b = r / (6 * SEQ), h = (r / SEQ) % 6, t = r % SEQ, kv = h / 3;
            const size_t row = (size_t)b * SEQ + t, crow0 = (size_t)NLAT + (size_t)b * NCTX, lrow0 = (size_t)b * SEQ;
            const int cq = isB ? C_QB : C_QA, ck = isB ? C_KB : C_KA, cvv = isB ? C_VB : C_VA;
            int j0 = 0, j1 = SEQ;
            if (isB) { j0 = t - 128 < 0 ? 0 : t - 128; j1 = t + 129 > SEQ ? SEQ : t + 129; }
            attn_row_naive(P + row * INW + cq + h * 128, P + crow0 * INW + ck + kv * 128, P + crow0 * INW + cvv + kv * 128,
                           P + lrow0 * INW + ck + kv * 128, P + lrow0 * INW + cvv + kv * 128, j0, j1, isB, isB ? p.sink_b[l * 6 + h] : 0.f,
                           Y + row * DM + (isB ? 768 : 0) + h * 128, lane);
        } else {
            r -= T_LA + T_LB;
            const bool isB = r >= T_CA; if (isB) r -= T_CA;
            const int b = r / (6 * NCTX), h = (r / NCTX) % 6, t = r % NCTX, kv = h / 3;
            const size_t crow0 = (size_t)NLAT + (size_t)b * NCTX, row = crow0 + t;
            const int cq = isB ? C_QB : C_QA, ck = isB ? C_KB : C_KA, cvv = isB ? C_VB : C_VA;
            attn_row_naive(P + row * INW + cq + h * 128, P + crow0 * INW + ck + kv * 128, P + crow0 * INW + cvv + kv * 128,
                           P, P, 0, 0, isB, isB ? p.sink_b[l * 6 + h] : 0.f, Y + row * DM + (isB ? 768 : 0) + h * 128, lane);
        }
    }
    __syncthreads();
    float* Wl = (float*)lds;
    float* Vl = Wl + 128 * 128;
    const int nchunk = last ? NLAT / 128 : MTOT / 128;
    for (int u = blockIdx.x; u < nchunk * 4; u += gridDim.x) {
        const int ch = u >> 2, g = u & 3; const size_t row0 = (size_t)ch * 128;
        __syncthreads();
        for (int i = tid; i < 128 * 128; i += NTHREADS) {
            Wl[i] = p.ws_c[((size_t)l * 4 + g) * 16384 + i];
            const int q = i >> 7, c = i & 127;
            Vl[i] = bf2f(P[(row0 + q) * INW + C_VC + g * 128 + c]);
        }
        __syncthreads();
        const int c = tid & 127, pg = tid >> 7;
        for (int pp = pg * 32; pp < pg * 32 + 32; ++pp) {
            float s = 0.f;
#pragma unroll 8
            for (int q = 0; q < 128; ++q) s += Wl[pp * 128 + q] * Vl[q * 128 + c];
            s += p.bs_c[((size_t)l * 4 + g) * 128 + pp];
            const float uu = bf2f(P[(row0 + pp) * INW + C_UC + g * 128 + c]);
            Y[(row0 + pp) * DM + 1536 + g * 128 + c] = (bf16_t)f2bf(uu * s);
        }
    }
}


namespace att {
constexpr float SCALE = 0.088388347648318440f;
constexpr float THR = 8.f;
constexpr int D = 128, NW = 8, QBLK = 32, KVBLK = 64;
#ifndef ATT_SDEPTH
#define ATT_SDEPTH 2
#endif
constexpr int SDEPTH = ATT_SDEPTH;
constexpr int LDQ = INW, LDK = INW, LDO = DM;
constexpr size_t SHM_V = KVBLK * D * 2, SHM_K = KVBLK * D * 2, SHM_ATTN = 2 * SHM_V + 2 * SHM_K + NW * 64 * 4;
using bf16x8 = __attribute__((ext_vector_type(8))) short;
using s16x4  = __attribute__((ext_vector_type(4))) short;
using f32x16 = __attribute__((ext_vector_type(16))) float;
using f32x8  = __attribute__((ext_vector_type(8))) float;

#define KSWZ(row, colB) ((row) * 256 + ((colB) ^ (((row) & 7) << 4)))
#define SBAR() __builtin_amdgcn_sched_barrier(0)
__device__ __forceinline__ int crow(int r, int hi) { return (r & 3) + 8 * (r >> 2) + 4 * hi; }
__device__ __forceinline__ unsigned cvtpk(float lo, float hi) {
  unsigned r; asm volatile("v_cvt_pk_bf16_f32 %0, %1, %2" : "=v"(r) : "v"(lo), "v"(hi)); return r;
}

__device__ __forceinline__ void partialSM(f32x16& p0, f32x16& p1, float& m_reg, float& mn, float& alpha) {
  constexpr float C = SCALE * 1.4426950408889634f;
  float pmax = p0[0]; for (int r = 1; r < 16; ++r) pmax = fmaxf(pmax, p0[r]); for (int r = 0; r < 16; ++r) pmax = fmaxf(pmax, p1[r]);
  { auto rr = __builtin_amdgcn_permlane32_swap(__float_as_uint(pmax), __float_as_uint(pmax), false, false);
    pmax = fmaxf(__uint_as_float(rr[0]), __uint_as_float(rr[1])); }
  if (__builtin_expect(__all(pmax - m_reg <= THR / SCALE), 1)) { mn = m_reg; alpha = 1.f; }
  else { mn = fmaxf(m_reg, pmax); alpha = __builtin_amdgcn_exp2f((m_reg - mn) * C); m_reg = mn; }
  float mnC = -mn * C;
  for (int r = 0; r < 16; ++r) p0[r] = fmaf(p0[r], C, mnC); for (int r = 0; r < 16; ++r) p1[r] = fmaf(p1[r], C, mnC);
  for (int r = 0; r < 16; ++r) p0[r] = __builtin_amdgcn_exp2f(p0[r]);
}
__device__ __forceinline__ void finishSM(f32x16& p0, f32x16& p1, float alpha, float& l_reg, bf16x8& pa0, bf16x8& pa1, bf16x8& pa2, bf16x8& pa3) {
  for (int r = 0; r < 16; ++r) p1[r] = __builtin_amdgcn_exp2f(p1[r]);
  float ps = 0; for (int r = 0; r < 16; ++r) ps += p0[r]; for (int r = 0; r < 16; ++r) ps += p1[r];
  { auto rr = __builtin_amdgcn_permlane32_swap(__float_as_uint(ps), __float_as_uint(ps), false, false);
    ps = __uint_as_float(rr[0]) + __uint_as_float(rr[1]); }
  l_reg = l_reg * alpha + ps;
#define PK4(P, BASE, OUT) do { unsigned a0 = cvtpk(P[BASE + 0], P[BASE + 1]), a1 = cvtpk(P[BASE + 2], P[BASE + 3]);   \
    unsigned b0 = cvtpk(P[BASE + 4], P[BASE + 5]), b1 = cvtpk(P[BASE + 6], P[BASE + 7]);                              \
    auto r0 = __builtin_amdgcn_permlane32_swap(a0, b0, false, false); auto r1 = __builtin_amdgcn_permlane32_swap(a1, b1, false, false); \
    u32x4 w = {r0[0], r1[0], r0[1], r1[1]}; OUT = *reinterpret_cast<bf16x8*>(&w); } while (0)
  PK4(p0, 0, pa0); PK4(p0, 8, pa1); PK4(p1, 0, pa2); PK4(p1, 8, pa3);
#undef PK4
}
__device__ __forceinline__ void qkt(f32x16& p0, f32x16& p1, const bf16_t* Ks, const bf16x8* qr, int r32, int hi) {
  p0 = f32x16{}; p1 = f32x16{};
  for (int d0 = 0; d0 < 8; ++d0) { int cb = (d0 * 16 + hi * 8) * 2;
    bf16x8 b0 = *reinterpret_cast<const bf16x8*>((const char*)Ks + KSWZ(r32, cb));
    bf16x8 b1 = *reinterpret_cast<const bf16x8*>((const char*)Ks + KSWZ(32 + r32, cb));
    p0 = __builtin_amdgcn_mfma_f32_32x32x16_bf16(b0, qr[d0], p0, 0, 0, 0);
    p1 = __builtin_amdgcn_mfma_f32_32x32x16_bf16(b1, qr[d0], p1, 0, 0, 0); }
}
__device__ __forceinline__ int v_st(int k, int c) { const int kk = (k & ~0xC) | ((k & 4) << 1) | ((k & 8) >> 1); return ((kk >> 3) * 4 + (c >> 5)) * 512 + ((kk & 7) * 32 + (c & 31)) * 2; }
__device__ __forceinline__ int v_rd_base(int lane) { return ((lane & 3) << 3) | (((lane >> 2) & 3) << 6) | (((lane >> 4) & 1) << 5) | (((lane >> 5) & 1) << 8); }
constexpr int v_rd_off(int d0, int ks, int half) { return d0 * 512 + ks * 4096 + half * 2048; }
template <int OFF> __device__ __forceinline__ s16x4 tr_read(int vb) {
  s16x4 r; asm volatile("ds_read_b64_tr_b16 %0, %1 offset:%2" : "=&v"(r) : "v"(vb), "i"(OFF) : "memory"); return r;
}
template <int D0> __device__ __forceinline__ void pv_one(f32x16& od, int vb, bf16x8 pa0, bf16x8 pa1, bf16x8 pa2, bf16x8 pa3) {
  const s16x4 l0 = tr_read<v_rd_off(D0, 0, 0)>(vb), h0 = tr_read<v_rd_off(D0, 0, 1)>(vb), l1 = tr_read<v_rd_off(D0, 1, 0)>(vb), h1 = tr_read<v_rd_off(D0, 1, 1)>(vb);
  const s16x4 l2 = tr_read<v_rd_off(D0, 2, 0)>(vb), h2 = tr_read<v_rd_off(D0, 2, 1)>(vb), l3 = tr_read<v_rd_off(D0, 3, 0)>(vb), h3 = tr_read<v_rd_off(D0, 3, 1)>(vb);
  asm volatile("s_waitcnt lgkmcnt(0)" ::: "memory"); SBAR();
#define PK(L, H) (bf16x8){L[0], L[1], L[2], L[3], H[0], H[1], H[2], H[3]}
  od = __builtin_amdgcn_mfma_f32_32x32x16_bf16(pa0, PK(l0, h0), od, 0, 0, 0);
  od = __builtin_amdgcn_mfma_f32_32x32x16_bf16(pa1, PK(l1, h1), od, 0, 0, 0);
  od = __builtin_amdgcn_mfma_f32_32x32x16_bf16(pa2, PK(l2, h2), od, 0, 0, 0);
  od = __builtin_amdgcn_mfma_f32_32x32x16_bf16(pa3, PK(l3, h3), od, 0, 0, 0);
#undef PK
}
__device__ __forceinline__ void pv_d0(f32x16* o, int vb, bf16x8 pa0, bf16x8 pa1, bf16x8 pa2, bf16x8 pa3) {
  pv_one<0>(o[0], vb, pa0, pa1, pa2, pa3); pv_one<1>(o[1], vb, pa0, pa1, pa2, pa3); pv_one<2>(o[2], vb, pa0, pa1, pa2, pa3); pv_one<3>(o[3], vb, pa0, pa1, pa2, pa3);
}

__device__ __forceinline__ void attn_unit(const bool MASK, const bf16_t* __restrict__ Qb, const bf16_t* __restrict__ Kc, const bf16_t* __restrict__ Vc,
                                          const bf16_t* __restrict__ Kl, const bf16_t* __restrict__ Vl, int nlt, int qpos0, int kpos0,
                                          bool has_sink, float sink, bf16_t* __restrict__ Ob, char* lds) {
  int tid_ = threadIdx.x; asm volatile("" : "+v"(tid_));
  const int tid = tid_, wid = tid >> 6, lane = tid & 63, r32 = lane & 31, hi = lane >> 5;
  bf16_t* V_lds = (bf16_t*)lds; bf16_t* K_lds = (bf16_t*)(lds + 2 * SHM_V);
  float* ws = (float*)(lds + 2 * SHM_V + 2 * SHM_K) + wid * 64; float* li_l = ws; float* al_l = ws + 32;
  float m_reg = -1e30f, l_reg = 0; f32x16 o[4] = {}; bf16x8 qr[8];
  const bf16_t* Qw = Qb + (long)(wid * QBLK + r32) * LDQ + hi * 8;
#pragma unroll
  for (int d0 = 0; d0 < 8; ++d0) qr[d0] = *reinterpret_cast<const bf16x8*>(Qw + d0 * 16);
  const int sr = tid >> 4, sc = (tid & 15) * 8, vst0 = v_st(sr, sc), vst1 = v_st(32 + sr, sc);
  const int vb0 = (int)(uintptr_t)V_lds + v_rd_base(lane);
  struct { bf16x8 vs0, vs1, ks0, ks1; } sr_[SDEPTH];
  const int qpos = qpos0 + wid * QBLK + r32;
#define KVP(t, KP, VP) const bf16_t* KP = ((t) < 4 ? Kc + (long)(t) * KVBLK * LDK : Kl + (long)((t) - 4) * KVBLK * LDK); const bf16_t* VP = ((t) < 4 ? Vc + (long)(t) * KVBLK * LDK : Vl + (long)((t) - 4) * KVBLK * LDK)
#define SLOAD(i, t) do { KVP(t, kp_, vp_); sr_[i].vs0 = *reinterpret_cast<const bf16x8*>(&vp_[(long)sr * LDK + sc]); sr_[i].vs1 = *reinterpret_cast<const bf16x8*>(&vp_[(long)(32 + sr) * LDK + sc]); \
    sr_[i].ks0 = *reinterpret_cast<const bf16x8*>(&kp_[(long)sr * LDK + sc]); sr_[i].ks1 = *reinterpret_cast<const bf16x8*>(&kp_[(long)(32 + sr) * LDK + sc]); } while (0)
#define SWRITE(b, i) do { *(bf16x8*)((char*)V_lds + (b) * SHM_V + vst0) = sr_[i].vs0;          \
    *(bf16x8*)((char*)V_lds + (b) * SHM_V + vst1) = sr_[i].vs1; int kc = sc * 2;               \
    *(bf16x8*)((char*)K_lds + (b) * SHM_K + KSWZ(sr, kc)) = sr_[i].ks0;                       \
    *(bf16x8*)((char*)K_lds + (b) * SHM_K + KSWZ(32 + sr, kc)) = sr_[i].ks1; } while (0)
#define SWAIT() do { if constexpr (SDEPTH == 2) asm volatile("s_waitcnt vmcnt(4)" ::: "memory"); else asm volatile("s_waitcnt vmcnt(0)" ::: "memory"); } while (0)
#define RESC(a) do { if (__any((a) < 1.f)) { if (hi == 0) al_l[r32] = (a); asm volatile("s_waitcnt lgkmcnt(0)" ::: "memory"); \
    for (int d = 0; d < 4; ++d) for (int r = 0; r < 16; ++r) o[d][r] *= al_l[crow(r, hi)]; } } while (0)
#define WMASK(P0, P1, t) do { if (MASK && (t) >= 4) { const int kb_ = kpos0 + ((t) - 4) * KVBLK + 4 * hi - qpos; \
    _Pragma("unroll") for (int r = 0; r < 16; ++r) { const int dk = kb_ + (r & 3) + 8 * (r >> 2); \
      if (dk > 128 || dk < -128) P0[r] = -1e30f; if (dk + 32 > 128 || dk + 32 < -128) P1[r] = -1e30f; } } } while (0)
  f32x16 pA0, pA1, pB0, pB1; float mnA, mnB, alA, alB; bf16x8 pa0, pa1, pa2, pa3; const int NT = 4 + nlt;
  constexpr int SE = 0, SO = SDEPTH - 1;
  SLOAD(SE, 0); asm volatile("s_waitcnt vmcnt(0)" ::: "memory"); SWRITE(0, SE); __syncthreads();
  qkt(pA0, pA1, K_lds, qr, r32, hi); partialSM(pA0, pA1, m_reg, mnA, alA);
  SLOAD(SO, 1); if constexpr (SDEPTH == 2) { if (2 < NT) SLOAD(SE, 2); }
  SWAIT(); SWRITE(1, SO); __syncthreads();
  for (int j = 1; j + 1 < NT; j += 2) {
    SBAR(); qkt(pB0, pB1, (bf16_t*)((char*)K_lds + SHM_K), qr, r32, hi); WMASK(pB0, pB1, j);
    finishSM(pA0, pA1, alA, l_reg, pa0, pa1, pa2, pa3); SBAR();
    SLOAD(SO, j + SDEPTH); SBAR();
    pv_d0(o, vb0, pa0, pa1, pa2, pa3); partialSM(pB0, pB1, m_reg, mnB, alB);
    __syncthreads(); SWAIT(); SWRITE(0, SE);
    RESC(alB); __syncthreads();
    SBAR(); qkt(pA0, pA1, K_lds, qr, r32, hi); WMASK(pA0, pA1, j + 1);
    finishSM(pB0, pB1, alB, l_reg, pa0, pa1, pa2, pa3); SBAR();
    if (SDEPTH == 1 || j + 3 < NT) SLOAD(SE, j + 1 + SDEPTH); SBAR();
    pv_d0(o, vb0 + (int)SHM_V, pa0, pa1, pa2, pa3); partialSM(pA0, pA1, m_reg, mnA, alA);
    __syncthreads(); SWAIT(); SWRITE(1, SO);
    RESC(alA); __syncthreads();
  }
  SBAR(); qkt(pB0, pB1, (bf16_t*)((char*)K_lds + SHM_K), qr, r32, hi); WMASK(pB0, pB1, NT - 1);
  finishSM(pA0, pA1, alA, l_reg, pa0, pa1, pa2, pa3); SBAR();
  pv_d0(o, vb0, pa0, pa1, pa2, pa3); partialSM(pB0, pB1, m_reg, mnB, alB);
  __syncthreads(); RESC(alB);
  finishSM(pB0, pB1, alB, l_reg, pa0, pa1, pa2, pa3); SBAR();
  pv_d0(o, vb0 + (int)SHM_V, pa0, pa1, pa2, pa3);
  if (has_sink) l_reg += __builtin_amdgcn_exp2f(sink * 1.4426950408889634f - m_reg * (SCALE * 1.4426950408889634f));
  if (hi == 0) li_l[r32] = l_reg; asm volatile("s_waitcnt lgkmcnt(0)" ::: "memory");
  float rli[16];
#pragma unroll
  for (int r = 0; r < 16; ++r) rli[r] = __builtin_amdgcn_rcpf(li_l[crow(r, hi)]);
  bf16_t* Ow = Ob + (long)(wid * QBLK) * LDO;
#pragma unroll
  for (int r = 0; r < 16; ++r) { int orow = crow(r, hi);
#pragma unroll
    for (int d0 = 0; d0 < 4; ++d0) Ow[(long)orow * LDO + d0 * 32 + r32] = (bf16_t)f2bf(o[d0][r] * rli[r]); }
  __syncthreads();
#undef KVP
#undef SLOAD
#undef SWRITE
#undef SWAIT
#undef RESC
#undef WMASK
}
#undef KSWZ
#undef SBAR
}


__device__ __forceinline__ void cmlp_unit_naive(const Params& p, int l, int ch, int g, unsigned char* lds) {
    int tid_ = threadIdx.x; asm volatile("" : "+v"(tid_));
    const int tid = tid_;
    const bf16_t* P = (const bf16_t*)(p.ws + WS_P);
    bf16_t* Y = (bf16_t*)(p.ws + WS_Y);
    float* Wl = (float*)lds;
    float* Vl = Wl + 128 * 128;
    const size_t row0 = (size_t)ch * 128;
    __syncthreads();
    for (int i = tid; i < 128 * 128; i += NTHREADS) {
        Wl[i] = p.ws_c[((size_t)l * 4 + g) * 16384 + i];
        const int q = i >> 7, c = i & 127;
        Vl[i] = bf2f(P[(row0 + q) * INW + C_VC + g * 128 + c]);
    }
    __syncthreads();
    const int c = tid & 127, pg = tid >> 7;
    for (int pp = pg * 32; pp < pg * 32 + 32; ++pp) {
        float s = 0.f;
#pragma unroll 8
        for (int q = 0; q < 128; ++q) s += Wl[pp * 128 + q] * Vl[q * 128 + c];
        s += p.bs_c[((size_t)l * 4 + g) * 128 + pp];
        const float uu = bf2f(P[(row0 + pp) * INW + C_UC + g * 128 + c]);
        Y[(row0 + pp) * DM + 1536 + g * 128 + c] = (bf16_t)f2bf(uu * s);
    }
    __syncthreads();
}


__device__ __forceinline__ void cmlp_unit_fast(const Params& p, int l, int ch, int g, unsigned char* lds) {
    typedef short bf16x8 __attribute__((ext_vector_type(8)));
    typedef float f32x16 __attribute__((ext_vector_type(16)));
    int tid_ = threadIdx.x; asm volatile("" : "+v"(tid_));
    const int tid = tid_, lane = tid & 63, wave = tid >> 6, r32 = lane & 31, hh = lane >> 5;
    const bf16_t* P = (const bf16_t*)(p.ws + WS_P);
    bf16_t* Y = (bf16_t*)(p.ws + WS_Y);
    const bf16_t* W = (const bf16_t*)(p.ws + WS_WSC) + ((size_t)l * 4 + g) * 16384;
    bf16_t* VT = (bf16_t*)lds;
    const size_t row0 = (size_t)ch * 128;
    __syncthreads();
#pragma unroll
    for (int it = 0; it < 4; ++it) {
        const int q = it * 32 + (tid >> 4), c0 = (tid & 15) * 8;
        const u32x4 v = *(const u32x4*)(P + (row0 + q) * INW + C_VC + g * 128 + c0);
        const unsigned w[4] = {v.x, v.y, v.z, v.w};
#pragma unroll
        for (int i = 0; i < 4; ++i) { VT[(c0 + 2 * i) * 136 + q] = (bf16_t)(w[i] & 0xffffu); VT[(c0 + 2 * i + 1) * 136 + q] = (bf16_t)(w[i] >> 16); }
    }
    __syncthreads();
    const int cb = wave & 3, pb0 = (wave >> 2) * 2;
    f32x16 acc0 = {}, acc1 = {};
#pragma unroll
    for (int s = 0; s < 8; ++s) {
        const bf16x8 b = *(const bf16x8*)(VT + (cb * 32 + r32) * 136 + 16 * s + 8 * hh);
        const bf16x8 a0 = *(const bf16x8*)(W + (size_t)(pb0 * 32 + r32) * 128 + 16 * s + 8 * hh);
        const bf16x8 a1 = *(const bf16x8*)(W + (size_t)(pb0 * 32 + 32 + r32) * 128 + 16 * s + 8 * hh);
        acc0 = __builtin_amdgcn_mfma_f32_32x32x16_bf16(a0, b, acc0, 0, 0, 0);
        acc1 = __builtin_amdgcn_mfma_f32_32x32x16_bf16(a1, b, acc1, 0, 0, 0);
    }
    const int c = cb * 32 + r32;
    const float* bs = p.bs_c + ((size_t)l * 4 + g) * 128;
#pragma unroll
    for (int r = 0; r < 16; ++r) {
        const int pr = (r & 3) + 8 * (r >> 2) + 4 * hh;
        const int p0 = pb0 * 32 + pr, p1 = p0 + 32;
        const float u0 = bf2f(P[(row0 + p0) * INW + C_UC + g * 128 + c]), u1 = bf2f(P[(row0 + p1) * INW + C_UC + g * 128 + c]);
        Y[(row0 + p0) * DM + 1536 + g * 128 + c] = (bf16_t)f2bf(u0 * (acc0[r] + bs[p0]));
        Y[(row0 + p1) * DM + 1536 + g * 128 + c] = (bf16_t)f2bf(u1 * (acc1[r] + bs[p1]));
    }
}
#ifndef USE_FAST_CMLP
#define USE_FAST_CMLP 1
#endif

__device__ __forceinline__ void ph_mixers_fast(const Params& p, int l, unsigned char* lds, const bool dry) {
    const int tid = threadIdx.x;
    const bf16_t* P = (const bf16_t*)(p.ws + WS_P);
    bf16_t* Y = (bf16_t*)(p.ws + WS_Y);
    const bool last = (l == DEPTH - 1);
    const int b = blockIdx.x & 7;
    unsigned* ctr = (unsigned*)(p.ws + WS_CTL) + (dry ? 2048 : 0) + (l * 8 + b) * 64;
    volatile unsigned* shw = (volatile unsigned*)(lds + LDS_BYTES - 64);
    const int nAttn = last ? 96 : 108, nC = last ? 64 : 72, total = nAttn + nC;
    const size_t lrow0 = (size_t)b * SEQ, crow0 = (size_t)NLAT + (size_t)b * NCTX;
    for (;;) {
        __syncthreads();
        if (tid == 0) *shw = atomicAdd(ctr, 1u);
        __syncthreads();
        const int u = (int)*shw + ((dry && DRY_MODE == 7) ? 48 : 0);
        if (u >= ((dry && DRY_MODE == 6) ? 48 : total)) break;
        if (u < nAttn) {
            const bf16_t *Qb, *Kc, *Vc, *Kl, *Vl; bf16_t* Ob; int nlt = 0, qpos0 = 0, kpos0 = 0; bool mask = false, has_sink = false; int hsink = 0;
            if (u < 48) {
                const int h = u >> 3, qb = u & 7, kv = h / 3;
                Qb = P + (lrow0 + qb * 256) * INW + C_QA + h * 128; Kc = P + crow0 * INW + C_KA + kv * 128; Vc = P + crow0 * INW + C_VA + kv * 128;
                Kl = P + lrow0 * INW + C_KA + kv * 128; Vl = P + lrow0 * INW + C_VA + kv * 128; nlt = 32;
                Ob = Y + (lrow0 + qb * 256) * DM + h * 128;
            } else if (u < 96) {
                const int v = u - 48, h = v >> 3, qb = v & 7, kv = h / 3;
                const int kstart = qb == 0 ? 0 : qb * 256 - 128; nlt = (qb == 0 || qb == 7) ? 6 : 8;
                Qb = P + (lrow0 + qb * 256) * INW + C_QB + h * 128; Kc = P + crow0 * INW + C_KB + kv * 128; Vc = P + crow0 * INW + C_VB + kv * 128;
                Kl = P + (lrow0 + kstart) * INW + C_KB + kv * 128; Vl = P + (lrow0 + kstart) * INW + C_VB + kv * 128;
                qpos0 = qb * 256; kpos0 = kstart; mask = true; has_sink = true; hsink = h;
                Ob = Y + (lrow0 + qb * 256) * DM + 768 + h * 128;
            } else {
                const int v = u - 96; const bool isB = v >= 6; const int h = isB ? v - 6 : v, kv = h / 3;
                const int cq = isB ? C_QB : C_QA, ck = isB ? C_KB : C_KA, cv = isB ? C_VB : C_VA;
                Qb = P + crow0 * INW + cq + h * 128; Kc = P + crow0 * INW + ck + kv * 128; Vc = P + crow0 * INW + cv + kv * 128; Kl = Kc; Vl = Vc;
                has_sink = isB; hsink = h; Ob = Y + crow0 * DM + (isB ? 768 : 0) + h * 128;
            }
            att::attn_unit(mask, Qb, Kc, Vc, Kl, Vl, nlt, qpos0, kpos0, has_sink, has_sink ? p.sink_b[l * 6 + hsink] : 0.f, Ob, (char*)lds);
        } else {
            const int v = u - nAttn;
            const int ch = v < 64 ? b * 16 + (v >> 2) : 128 + b * 2 + ((v - 64) >> 2);
#if USE_FAST_CMLP
            cmlp_unit_fast(p, l, ch, v & 3, lds);
#else
            cmlp_unit_naive(p, l, ch, v & 3, lds);
#endif
        }
    }
#if GATHER_I8 && GATHER_4BIT
    if (TABLES_IN_GAPS && !dry) conv4_tables(p, last ? 3 * NEXP : NEXP, last ? 4 * NEXP : 2 * NEXP, (unsigned*)(p.ws + WS_CTL) + 6272 + (last ? 64 : 0), lds);
#endif
}
#ifndef USE_FAST_ATT
#define USE_FAST_ATT 1
#endif

__device__ __forceinline__ void ynorm_row(bf16_t* yrow, const u32x4 (&v)[4], int lane, unsigned char* y8row, float* sdst) {
    float sq[4];
#pragma unroll
    for (int j = 0; j < 4; ++j) {
        const float a0 = bflo(v[j].x), a1 = bfhi(v[j].x), a2 = bflo(v[j].y), a3 = bfhi(v[j].y), a4 = bflo(v[j].z), a5 = bfhi(v[j].z), a6 = bflo(v[j].w), a7 = bfhi(v[j].w);
        sq[j] = a0 * a0 + a1 * a1 + a2 * a2 + a3 * a3 + a4 * a4 + a5 * a5 + a6 * a6 + a7 * a7;
    }
    const float sA = wave_sum(sq[0] + (lane < 32 ? sq[1] : 0.f));
    const float sB = wave_sum((lane >= 32 ? sq[1] : 0.f) + sq[2]);
    const float sC = wave_sum(sq[3]);
    const float rA = rsqrtf(sA * (1.f / 768.f) + EPS), rB = rsqrtf(sB * (1.f / 768.f) + EPS), rC = rsqrtf(sC * (1.f / 512.f) + EPS);
    if (GEMM_I8) {
        float x[4][8]; float am = 0.f;
#pragma unroll
        for (int j = 0; j < 4; ++j) {
            const float sc = (j == 0) ? rA : (j == 1) ? (lane < 32 ? rA : rB) : (j == 2) ? rB : rC;
            x[j][0] = bflo(v[j].x) * sc; x[j][1] = bfhi(v[j].x) * sc; x[j][2] = bflo(v[j].y) * sc; x[j][3] = bfhi(v[j].y) * sc;
            x[j][4] = bflo(v[j].z) * sc; x[j][5] = bfhi(v[j].z) * sc; x[j][6] = bflo(v[j].w) * sc; x[j][7] = bfhi(v[j].w) * sc;
#pragma unroll
            for (int i = 0; i < 8; ++i) am = fmaxf(am, fabsf(x[j][i]));
        }
        am = wave_max(am);
        const float s = am > 0.f ? am * (1.f / 127.f) : 1.f, inv = 1.f / s;
#pragma unroll
        for (int j = 0; j < 4; ++j) {
            u32x2 o; o.x = q8pack4(x[j][0], x[j][1], x[j][2], x[j][3], inv); o.y = q8pack4(x[j][4], x[j][5], x[j][6], x[j][7], inv);
            *(u32x2*)(y8row + j * 512 + lane * 8) = o;
        }
        if (lane == 0) *sdst = s;
        return;
    }
#pragma unroll
    for (int j = 0; j < 4; ++j) {
        const float sc = (j == 0) ? rA : (j == 1) ? (lane < 32 ? rA : rB) : (j == 2) ? rB : rC;
        u32x4 o;
        o.x = pk2(bflo(v[j].x) * sc, bfhi(v[j].x) * sc); o.y = pk2(bflo(v[j].y) * sc, bfhi(v[j].y) * sc);
        o.z = pk2(bflo(v[j].z) * sc, bfhi(v[j].z) * sc); o.w = pk2(bflo(v[j].w) * sc, bfhi(v[j].w) * sc);
        *(u32x4*)(yrow + j * 512 + lane * 8) = o;
    }
}
__device__ __forceinline__ void ph_ynorm(const Params& p, int l) {
    const int tid = threadIdx.x, lane = tid & 63, wave = tid >> 6;
    const int gw = blockIdx.x * NWAVES + wave, NGW = gridDim.x * NWAVES;
    bf16_t* Y = (bf16_t*)(p.ws + WS_Y);
    const int nrows = (l == DEPTH - 1) ? NLAT : MTOT;
#pragma unroll 1
    for (int r = gw; r < nrows; r += 2 * NGW) {
        const int r2 = r + NGW; const bool has2 = r2 < nrows; const int rb = has2 ? r2 : r;
        u32x4 va[4], vb[4];
#pragma unroll
        for (int j = 0; j < 4; ++j) { va[j] = *(const u32x4*)(Y + (size_t)r * DM + j * 512 + lane * 8); vb[j] = *(const u32x4*)(Y + (size_t)rb * DM + j * 512 + lane * 8); }
        unsigned char* Y8 = (unsigned char*)(p.ws + WS_XN8); float* SY = (float*)(p.ws + WS_SCL) + SCL_Y;
        ynorm_row(Y + (size_t)r * DM, va, lane, Y8 + (size_t)r * DM, SY + r);
        if (has2) ynorm_row(Y + (size_t)r2 * DM, vb, lane, Y8 + (size_t)r2 * DM, SY + r2);
    }
}

__device__ __forceinline__ void wave_argmax(float& bv, int& bi) {
#pragma unroll
    for (int o = 32; o >= 1; o >>= 1) {
        const float ov = __shfl_xor(bv, o); const int oi = __shfl_xor(bi, o);
        if (ov > bv || (ov == bv && oi < bi)) { bv = ov; bi = oi; }
    }
}
__device__ __forceinline__ void route_half(const bf16_t* qh, const bf16_t* kh, int lane, float& tv, int& ti) {
    const unsigned qq = *(const unsigned*)(qh + 2 * lane);
    const float qa = bflo(qq), qb = bfhi(qq);
    const bf16_t* k0 = kh + (size_t)lane * 128;
    const bf16_t* k1 = k0 + 64 * 128;
    float d0 = 0.f, d1 = 0.f;
#pragma unroll 2
    for (int cb = 0; cb < 16; ++cb) {
        const u32x4 a = *(const u32x4*)(k0 + cb * 8), b = *(const u32x4*)(k1 + cb * 8);
        const unsigned aw[4] = {a.x, a.y, a.z, a.w}, bw[4] = {b.x, b.y, b.z, b.w};
#pragma unroll
        for (int i = 0; i < 4; ++i) {
            const int src = cb * 4 + i;
            const float x0 = __shfl(qa, src), x1 = __shfl(qb, src);
            d0 += x0 * bflo(aw[i]) + x1 * bfhi(aw[i]);
            d1 += x0 * bflo(bw[i]) + x1 * bfhi(bw[i]);
        }
    }
    float va = d0, vb = d1; tv = 0.f; ti = 0;
#pragma unroll 1
    for (int r = 0; r < 16; ++r) {
        float bv; int bi;
        if (va >= vb) { bv = va; bi = lane; } else { bv = vb; bi = lane + 64; }
        wave_argmax(bv, bi);
        if (lane == r) { tv = bv; ti = bi; }
        if (bi == lane) va = -INFINITY; else if (bi == lane + 64) vb = -INFINITY;
    }
}
__device__ __forceinline__ void ph_route_naive(const Params& p, int l) {
    const int tid = threadIdx.x, lane = tid & 63, wave = tid >> 6;
    const int gw = blockIdx.x * NWAVES + wave, NGW = gridDim.x * NWAVES;
    const bf16_t* QP = (const bf16_t*)(p.ws + WS_P);
    const bf16_t* KEYS = (const bf16_t*)(p.ws + WS_KEYS) + (size_t)l * 8 * 2 * 128 * 128;
    int* EID = (int*)(p.ws + WS_EID); float* GATE = (float*)(p.ws + WS_GATE);
    const int nrows = (l == DEPTH - 1) ? NLAT : MTOT;
#pragma unroll 1
    for (int tk = gw; tk < nrows * 8; tk += NGW) {
        const int t = tk >> 3, h = tk & 7;
        const bf16_t* qrow = QP + (size_t)t * DM + h * 256;
        float tv0, tv1; int ti0, ti1;
        route_half(qrow, KEYS + (size_t)(h * 2 + 0) * 128 * 128, lane, tv0, ti0);
        route_half(qrow + 128, KEYS + (size_t)(h * 2 + 1) * 128 * 128, lane, tv1, ti1);
        const float v1 = __shfl(tv0, lane >> 2);
        float c0 = v1 + __shfl(tv1, (lane & 3) * 4 + 0), c1 = v1 + __shfl(tv1, (lane & 3) * 4 + 1);
        float c2 = v1 + __shfl(tv1, (lane & 3) * 4 + 2), c3 = v1 + __shfl(tv1, (lane & 3) * 4 + 3);
        float myv = 0.f; int myc = 0;
#pragma unroll 1
        for (int r = 0; r < 16; ++r) {
            float bv = c0; int bi = lane * 4;
            if (c1 > bv) { bv = c1; bi = lane * 4 + 1; }
            if (c2 > bv) { bv = c2; bi = lane * 4 + 2; }
            if (c3 > bv) { bv = c3; bi = lane * 4 + 3; }
            wave_argmax(bv, bi);
            if (lane == r) { myv = bv; myc = bi; }
            if ((bi >> 2) == lane) {
                const int u = bi & 3;
                if (u == 0) c0 = -INFINITY; else if (u == 1) c1 = -INFINITY; else if (u == 2) c2 = -INFINITY; else c3 = -INFINITY;
            }
        }
        float mx = lane < 16 ? myv : -INFINITY;
        mx = fmaxf(mx, __shfl_xor(mx, 8)); mx = fmaxf(mx, __shfl_xor(mx, 4)); mx = fmaxf(mx, __shfl_xor(mx, 2)); mx = fmaxf(mx, __shfl_xor(mx, 1));
        const float e = lane < 16 ? __expf(myv - mx) : 0.f;
        float sm = e; sm += __shfl_xor(sm, 8); sm += __shfl_xor(sm, 4); sm += __shfl_xor(sm, 2); sm += __shfl_xor(sm, 1);
        const int i1 = __shfl(ti0, myc >> 4), i2 = __shfl(ti1, myc & 15);
        if (lane < 16) { EID[(size_t)t * 128 + h * 16 + lane] = i1 * 128 + i2; GATE[(size_t)t * 128 + h * 16 + lane] = e / sm; }
    }
}


namespace rt {
typedef short bf16x8 __attribute__((ext_vector_type(8)));
typedef float f32x16 __attribute__((ext_vector_type(16)));
__device__ __forceinline__ void insert16(float (&t)[16], float x) {
#pragma unroll
    for (int j = 15; j >= 1; --j) t[j] = __builtin_amdgcn_fmed3f(t[j - 1], t[j], x);
    t[0] = fmaxf(t[0], x);
}
__device__ __forceinline__ void half_top16(const unsigned char* klds, const bf16_t* qrow, int r32, int hh, float (&t)[16]) {
    bf16x8 qf[8];
#pragma unroll
    for (int s = 0; s < 8; ++s) qf[s] = *(const bf16x8*)(qrow + 16 * s);
#pragma unroll
    for (int k = 0; k < 16; ++k) t[k] = -3.0e38f;
    const unsigned hh4 = (unsigned)hh << 2;
#pragma unroll
    for (int kb = 0; kb < 4; ++kb) {
        f32x16 acc = {};
        const int row = kb * 32 + r32;
#pragma unroll
        for (int s = 0; s < 8; ++s) {
            const bf16x8 a = *(const bf16x8*)(klds + row * 256 + ((32 * s + 16 * hh) ^ ((row & 7) << 4)));
            acc = __builtin_amdgcn_mfma_f32_32x32x16_bf16(a, qf[s], acc, 0, 0, 0);
        }
#pragma unroll
        for (int r = 0; r < 16; ++r) {
            const unsigned key = (unsigned)(kb * 32 + (r & 3) + 8 * (r >> 2)) | hh4;
            insert16(t, __uint_as_float((__float_as_uint(acc[r]) & ~127u) | key));
        }
    }
    float o[16];
#pragma unroll
    for (int k = 0; k < 16; ++k) o[k] = __shfl_xor(t[k], 32);
#pragma unroll
    for (int k = 0; k < 16; ++k) insert16(t, o[k]);
}
}
template <bool OWN_UNITS>
__device__ __forceinline__ void ph_route_fast(const Params& p, int l, unsigned char* lds) {
    int tid_ = threadIdx.x; asm volatile("" : "+v"(tid_));
    const int tid = tid_, lane = tid & 63, wave = tid >> 6, r32 = lane & 31, hh = lane >> 5;
    const bf16_t* QP = (const bf16_t*)(p.ws + WS_P);
    const bf16_t* KEYS = (const bf16_t*)(p.ws + WS_KEYS) + (size_t)l * 8 * 2 * 128 * 128;
    int* EID = (int*)(p.ws + WS_EID); float* GATE = (float*)(p.ws + WS_GATE);
    const int ntile = ((l == DEPTH - 1) ? NLAT : MTOT) / 256;
    unsigned* tab = (unsigned*)(lds + 65536) + wave * 2048;
    pg8::StaticOrder So; So.init(ntile * 256, DM, (int)gridDim.x, (int)blockIdx.x);
#pragma unroll 1
    for (int ui = 0;; ++ui) {
        int tile, h;
        if (OWN_UNITS) { pg8::Unit uu; if (!So.next(ui, uu)) break; tile = uu.pm; h = uu.pn; }
        else { const int u = blockIdx.x + ui * (int)gridDim.x; if (u >= ntile * 8) break; tile = u >> 3; h = u & 7; }
        __syncthreads();
        const u32x4* ksrc = (const u32x4*)(KEYS + (size_t)h * 2 * 128 * 128);
#pragma unroll
        for (int i = 0; i < 8; ++i) { const int c = tid + i * 512, row = c >> 4, cc = c & 15; *(u32x4*)(lds + row * 256 + ((cc * 16) ^ ((row & 7) << 4))) = ksrc[c]; }
        __syncthreads();
        const int tok = tile * 256 + wave * 32 + r32;
        const bf16_t* qrow = QP + (size_t)tok * DM + h * 256 + hh * 8;
        float v1[16], v2[16];
        rt::half_top16(lds, qrow, r32, hh, v1);
        rt::half_top16(lds + 32768, qrow + 128, r32, hh, v2);
        float c[16];
#pragma unroll
        for (int k = 0; k < 16; ++k) c[k] = -3.0e38f;
#pragma unroll
        for (int i = 0; i < 16; ++i)
#pragma unroll
            for (int j = 0; j < 16; ++j)
                if ((i + 1) * (j + 1) <= 16) rt::insert16(c, __uint_as_float((__float_as_uint(v1[i] + v2[j]) & ~255u) | (unsigned)(i * 16 + j)));
#pragma unroll
        for (int k = 0; k < 16; ++k) { tab[k * 64 + lane] = __float_as_uint(v1[k]); tab[(16 + k) * 64 + lane] = __float_as_uint(v2[k]); }
        LDS_WAIT();
        float e[16], sum = 0.f;
#pragma unroll
        for (int k = 0; k < 16; ++k) { e[k] = __expf(c[k] - c[0]); sum += e[k]; }
        const float inv = 1.f / sum;
        unsigned out[16];
#pragma unroll
        for (int k = 0; k < 16; ++k) {
            const unsigned code = __float_as_uint(c[k]) & 255u;
            const unsigned i1 = tab[(code >> 4) * 64 + lane] & 127u, i2 = tab[(16 + (code & 15u)) * 64 + lane] & 127u;
            out[k] = hh == 0 ? (i1 * 128u + i2) : __float_as_uint(e[k] * inv);
        }
        unsigned* dst = (hh == 0 ? (unsigned*)EID : (unsigned*)GATE) + (size_t)tok * 128 + h * 16;
#pragma unroll
        for (int k = 0; k < 4; ++k) { u32x4 w; w.x = out[4 * k]; w.y = out[4 * k + 1]; w.z = out[4 * k + 2]; w.w = out[4 * k + 3]; *(u32x4*)(dst + 4 * k) = w; }
        LDS_WAIT();
    }
}
#ifndef USE_FAST_ROUTE
#define USE_FAST_ROUTE 1
#endif


#if GATHER_I8
__device__ __forceinline__ float dpp_shr(float v, int n) {
    const int iv = __builtin_bit_cast(int, v); int r;
    switch (n) { case 1: r = __builtin_amdgcn_update_dpp(0, iv, 0x111, 0xf, 0xf, true); break; case 2: r = __builtin_amdgcn_update_dpp(0, iv, 0x112, 0xf, 0xf, true); break;
                 case 4: r = __builtin_amdgcn_update_dpp(0, iv, 0x114, 0xf, 0xf, true); break; default: r = __builtin_amdgcn_update_dpp(0, iv, 0x118, 0xf, 0xf, true); break; }
    return __builtin_bit_cast(float, r);
}
__device__ __forceinline__ float wave_total(float v) {
    v += dpp_shr(v, 1); v += dpp_shr(v, 2); v += dpp_shr(v, 4); v += dpp_shr(v, 8);
    v += __builtin_bit_cast(float, __builtin_amdgcn_update_dpp(0, __builtin_bit_cast(int, v), 0x142, 0xa, 0xf, false));
    v += __builtin_bit_cast(float, __builtin_amdgcn_update_dpp(0, __builtin_bit_cast(int, v), 0x143, 0xc, 0xf, false));
    return __uint_as_float(__builtin_amdgcn_readlane(__float_as_uint(v), 63));
}
#define UB0(w) ((float)((w) & 0xffu))
#define UB1(w) ((float)(((w) >> 8) & 0xffu))
#define UB2(w) ((float)(((w) >> 16) & 0xffu))
#define UB3(w) ((float)((w) >> 24))

__device__ __forceinline__ float dpp_xor1(float v) { return __builtin_bit_cast(float, __builtin_amdgcn_update_dpp(0, __builtin_bit_cast(int, v), 0xB1, 0xf, 0xf, false)); }
__device__ __forceinline__ float dpp_xor2(float v) { return __builtin_bit_cast(float, __builtin_amdgcn_update_dpp(0, __builtin_bit_cast(int, v), 0x4E, 0xf, 0xf, false)); }
__device__ __forceinline__ float dpp_xor8(float v) { return __builtin_bit_cast(float, __builtin_amdgcn_update_dpp(0, __builtin_bit_cast(int, v), 0x128, 0xf, 0xf, false)); }
__device__ __forceinline__ float reduce8_rows(const float (&d)[8], int lane) {
    const bool b0 = lane & 1, b1 = lane & 2, b2 = lane & 4;
    float r[4];
#pragma unroll
    for (int k = 0; k < 4; ++k) r[k] = (b0 ? d[2 * k + 1] : d[2 * k]) + dpp_xor1(b0 ? d[2 * k] : d[2 * k + 1]);
    float t[2];
#pragma unroll
    for (int k = 0; k < 2; ++k) t[k] = (b1 ? r[2 * k + 1] : r[2 * k]) + dpp_xor2(b1 ? r[2 * k] : r[2 * k + 1]);
    float u = (b2 ? t[1] : t[0]) + __shfl_xor(b2 ? t[0] : t[1], 4);
    u += dpp_xor8(u);
    u += __shfl_xor(u, 16);
    u += __shfl_xor(u, 32);
    return u;
}
#if GATHER_4BIT
#ifndef DRY_MODE
#define DRY_MODE 0
#endif
typedef float f32x2 __attribute__((ext_vector_type(2)));
__device__ __forceinline__ void ph_gather(const Params& p, int l, const bool dry) {
    const int tid = threadIdx.x, lane = tid & 63, wave = tid >> 6;
    const int gw = blockIdx.x * NWAVES + wave, NGW = gridDim.x * NWAVES;
    const bf16_t* XN = (const bf16_t*)(p.ws + WS_XN);
    const unsigned char* UT = (const unsigned char*)(p.ws + WS_UT) + (size_t)l * NEXP * ROW4;
    const unsigned char* VT = (const unsigned char*)(p.ws + WS_VT) + (size_t)l * NEXP * ROW4;
    const int* EID = (const int*)(p.ws + WS_EID); const float* GATE = (const float*)(p.ws + WS_GATE);
    const float* mod = (const float*)(p.ws + WS_MOD) + (size_t)l * 9 * 12288;
    const int nrows = (l == DEPTH - 1) ? NLAT : MTOT;
#pragma unroll 1
    for (int t = gw; t < nrows; t += NGW) {
        int xh[4], xl[4]; float sxl;
#if GEMM_I8 && GEMM3_I8
        {
            sxl = ((const float*)(p.ws + WS_SCL))[SCL_XN + t];
            const unsigned char* x8 = (const unsigned char*)(p.ws + WS_XN8) + (size_t)t * DM;
#pragma unroll
            for (int j = 0; j < 2; ++j) {
                const u32x4 q4 = *(const u32x4*)(x8 + j * 1024 + lane * 16);
                const unsigned ww[4] = {q4.x, q4.y, q4.z, q4.w};
#pragma unroll
                for (int dd = 0; dd < 2; ++dd) {
                    unsigned h = 0u, lo = 0u;
#pragma unroll
                    for (int k = 0; k < 8; ++k) {
                        const int q = (int)(signed char)((ww[dd * 2 + (k >> 2)] >> (8 * (k & 3))) & 0xffu);
                        const int ql = ((q + 8) & 15) - 8, qh = (q - ql) >> 4;
                        h |= ((unsigned)qh & 15u) << (4 * k); lo |= ((unsigned)ql & 15u) << (4 * k);
                    }
                    xh[j * 2 + dd] = (int)h; xl[j * 2 + dd] = (int)lo;
                }
            }
        }
#else
        {
            float x[32]; float am = 0.f;
#pragma unroll
            for (int j = 0; j < 2; ++j)
#pragma unroll
                for (int k = 0; k < 2; ++k) {
                    const u32x4 q = *(const u32x4*)(XN + (size_t)t * DM + j * 1024 + lane * 16 + k * 8);
                    float* xx = x + j * 16 + k * 8;
                    xx[0] = bflo(q.x); xx[1] = bfhi(q.x); xx[2] = bflo(q.y); xx[3] = bfhi(q.y); xx[4] = bflo(q.z); xx[5] = bfhi(q.z); xx[6] = bflo(q.w); xx[7] = bfhi(q.w);
                }
#pragma unroll
            for (int i = 0; i < 32; ++i) am = fmaxf(am, fabsf(x[i]));
            sxl = am > 0.f ? am * (1.f / 119.f) : 1.f;
            const float inv = 1.f / sxl;
#pragma unroll
            for (int d = 0; d < 4; ++d) {
                unsigned h = 0u, lo = 0u;
#pragma unroll
                for (int k = 0; k < 8; ++k) {
                    const int q = (int)rintf(x[8 * d + k] * inv);
                    const int ql = ((q + 8) & 15) - 8, qh = (q - ql) >> 4;
                    h |= ((unsigned)qh & 15u) << (4 * k); lo |= ((unsigned)ql & 15u) << (4 * k);
                }
                xh[d] = (int)h; xl[d] = (int)lo;
            }
        }
#endif
        const int e0 = EID[(size_t)t * 128 + lane], e1 = EID[(size_t)t * 128 + 64 + lane];
        const float g0 = GATE[(size_t)t * 128 + lane], g1 = GATE[(size_t)t * 128 + 64 + lane];
        float hid0 = 0.f, hid1 = 0.f;
        constexpr int GB = 8;
#define G_LOAD(W, S, TAB, EB) do { _Pragma("unroll") for (int i = 0; i < GB; ++i) { \
            const int id_ = __builtin_amdgcn_readlane((EB) < 64 ? e0 : e1, ((EB) + i) & 63); \
            const unsigned char* row_ = (TAB) + (size_t)id_ * ROW4; \
            W[i] = *(const u32x4*)(row_ + lane * 16); S[i] = *(const unsigned short*)(row_ + 1024 + lane * 2); } } while (0)
#define G_DOT(W, S, EB) do { float dd_[8]; _Pragma("unroll") for (int i = 0; i < GB; ++i) { int sh_ = 0, sl_ = 0; \
            const unsigned ww[4] = {W[i].x, W[i].y, W[i].z, W[i].w}; \
            _Pragma("unroll") for (int d = 0; d < 4; ++d) { \
                sh_ = __builtin_amdgcn_sdot8((int)ww[d], xh[d], sh_, false); \
                sl_ = __builtin_amdgcn_sdot8((int)ww[d], xl[d], sl_, false); } \
            dd_[i] = (float)((sh_ << 4) + sl_) * (sxl * bf2f(S[i])); } \
            const float tot = reduce8_rows(dd_, lane);              \
            if ((lane & 56) == ((EB) & 63)) { if ((EB) < 64) hid0 = tot; else hid1 = tot; } } while (0)
#define G_AXPY(W, S, EB) do { _Pragma("unroll") for (int i = 0; i < GB; ++i) { \
            const float m_ = __uint_as_float(__builtin_amdgcn_readlane(__float_as_uint((EB) < 64 ? cf0 : cf1), ((EB) + i) & 63)) * bf2f(S[i]); \
            const f32x2 mm = {m_, m_}; \
            const unsigned ww[4] = {W[i].x, W[i].y, W[i].z, W[i].w}; \
            _Pragma("unroll") for (int d = 0; d < 4; ++d) { \
                acc[4 * d + 0] += mm * __builtin_amdgcn_cvt_scalef32_pk_f32_fp4(ww[d], 1.0f, 0); \
                acc[4 * d + 1] += mm * __builtin_amdgcn_cvt_scalef32_pk_f32_fp4(ww[d], 1.0f, 1); \
                acc[4 * d + 2] += mm * __builtin_amdgcn_cvt_scalef32_pk_f32_fp4(ww[d], 1.0f, 2); \
                acc[4 * d + 3] += mm * __builtin_amdgcn_cvt_scalef32_pk_f32_fp4(ww[d], 1.0f, 3); } } } while (0)
        u32x4 wa[GB], wb[GB]; unsigned sa[GB], sb[GB];
        const bool do_u = !(dry && (DRY_MODE == 4 || DRY_MODE == 5)), do_v = !(dry && (DRY_MODE == 3 || DRY_MODE == 5));
        if (do_u) G_LOAD(wa, sa, UT, 0); else G_LOAD(wa, sa, VT, 0);
#pragma unroll 1
        for (int eb = 0; eb < (do_u ? 128 : 0); eb += 2 * GB) {
            G_LOAD(wb, sb, UT, eb + GB);
            G_DOT(wa, sa, eb);
            if (eb + 2 * GB < 128) G_LOAD(wa, sa, UT, eb + 2 * GB); else G_LOAD(wa, sa, VT, 0);
            G_DOT(wb, sb, eb + GB);
        }
        const float cf0 = gelu_tanh(hid0) * g0, cf1 = gelu_tanh(hid1) * g1;
        f32x2 acc[16];
#pragma unroll
        for (int i = 0; i < 16; ++i) acc[i] = (f32x2){0.f, 0.f};
#pragma unroll 1
        for (int eb = 0; eb < (do_v ? 128 : 0); eb += 2 * GB) {
            G_LOAD(wb, sb, VT, eb + GB);
            G_AXPY(wa, sa, eb);
            if (eb + 2 * GB < 128) G_LOAD(wa, sa, VT, eb + 2 * GB);
            G_AXPY(wb, sb, eb + GB);
        }
#undef G_LOAD
#undef G_DOT
#undef G_AXPY
        float hn[32];
        const int bb = t < NLAT ? (t >> 11) : 8;
        const float* gate = mod + (size_t)bb * 12288 + 5 * DM;
#if H_BF16 && GEMM_I8 && GEMM3_I8
        {
            bf16_t* hbrow = (bf16_t*)(p.ws + WS_HB) + (size_t)t * DM;
            const bool fin = (l == DEPTH - 1);
#pragma unroll
            for (int j = 0; j < 2; ++j) {
                const u32x4 q0 = *(const u32x4*)(hbrow + j * 1024 + lane * 16), q1 = *(const u32x4*)(hbrow + j * 1024 + lane * 16 + 8);
                const unsigned qq[8] = {q0.x, q0.y, q0.z, q0.w, q1.x, q1.y, q1.z, q1.w};
#pragma unroll
                for (int k = 0; k < 4; ++k) {
                    const f32x4 gv = *(const f32x4*)(gate + j * 1024 + lane * 16 + k * 4);
                    const f32x2 a0 = acc[j * 8 + k * 2], a1 = acc[j * 8 + k * 2 + 1];
                    hn[j * 16 + k * 4 + 0] = bflo(qq[2 * k]) + gv.x * a0.x; hn[j * 16 + k * 4 + 1] = bfhi(qq[2 * k]) + gv.y * a0.y;
                    hn[j * 16 + k * 4 + 2] = bflo(qq[2 * k + 1]) + gv.z * a1.x; hn[j * 16 + k * 4 + 3] = bfhi(qq[2 * k + 1]) + gv.w * a1.y;
                }
                if (fin) {
                    float* orow = (dry ? (float*)(p.ws + WS_DUMMY) + (size_t)(t & 16383) * DM : p.out + (size_t)t * DM) + j * 1024 + lane * 16;
#pragma unroll
                    for (int k = 0; k < 4; ++k) *(f32x4*)(orow + k * 4) = (f32x4){hn[j * 16 + k * 4], hn[j * 16 + k * 4 + 1], hn[j * 16 + k * 4 + 2], hn[j * 16 + k * 4 + 3]};
                } else {
                    bf16_t* orow = (dry ? (bf16_t*)(p.ws + WS_DUMMY) + (size_t)(t & 16383) * DM : hbrow) + j * 1024 + lane * 16;
                    u32x4 w0, w1;
                    w0.x = pk2(hn[j * 16 + 0], hn[j * 16 + 1]); w0.y = pk2(hn[j * 16 + 2], hn[j * 16 + 3]); w0.z = pk2(hn[j * 16 + 4], hn[j * 16 + 5]); w0.w = pk2(hn[j * 16 + 6], hn[j * 16 + 7]);
                    w1.x = pk2(hn[j * 16 + 8], hn[j * 16 + 9]); w1.y = pk2(hn[j * 16 + 10], hn[j * 16 + 11]); w1.z = pk2(hn[j * 16 + 12], hn[j * 16 + 13]); w1.w = pk2(hn[j * 16 + 14], hn[j * 16 + 15]);
                    *(u32x4*)orow = w0; *(u32x4*)(orow + 8) = w1;
                }
            }
        }
#else
        float* hrow = t < NLAT ? p.out + (size_t)t * DM : (float*)(p.ws + WS_HC) + (size_t)(t - NLAT) * DM;
#pragma unroll
        for (int j = 0; j < 2; ++j)
#pragma unroll
            for (int k = 0; k < 4; ++k) {
                const int col = j * 1024 + lane * 16 + k * 4;
                const f32x4 hv = *(const f32x4*)(hrow + col), gv = *(const f32x4*)(gate + col);
                const f32x2 a0 = acc[j * 8 + k * 2], a1 = acc[j * 8 + k * 2 + 1];
                f32x4 o;
                o.x = hv.x + gv.x * a0.x; o.y = hv.y + gv.y * a0.y; o.z = hv.z + gv.z * a1.x; o.w = hv.w + gv.w * a1.y;
                *(f32x4*)((dry ? (float*)(p.ws + WS_DUMMY) + (size_t)(t & 16383) * DM : hrow) + col) = o;
                hn[j * 16 + k * 4 + 0] = o.x; hn[j * 16 + k * 4 + 1] = o.y; hn[j * 16 + k * 4 + 2] = o.z; hn[j * 16 + k * 4 + 3] = o.w;
            }
#endif
        if (l + 1 < DEPTH) {
            float ss = 0.f;
#pragma unroll
            for (int i = 0; i < 32; ++i) ss += hn[i] * hn[i];
            const float rstd = rsqrtf(wave_total(ss) * (1.f / DM) + EPS);
            const float* g1n = p.norm1_g + (l + 1) * DM;
            const float* shift = mod + (size_t)9 * 12288 + (size_t)bb * 12288;
            const float* scale = shift + DM;
            if (GEMM_I8) {
                float am = 0.f;
#pragma unroll
                for (int j = 0; j < 2; ++j)
#pragma unroll
                    for (int i = 0; i < 16; ++i) { const int col = j * 1024 + lane * 16 + i; hn[j * 16 + i] = hn[j * 16 + i] * rstd * g1n[col] * (1.f + scale[col]) + shift[col]; am = fmaxf(am, fabsf(hn[j * 16 + i])); }
                am = wave_max(am);
                const float s8 = am > 0.f ? am * (1.f / 127.f) : 1.f, inv8 = 1.f / s8;
                unsigned char* xo8 = (dry ? (unsigned char*)(p.ws + WS_DUMMY) + (size_t)(t & 16383) * DM : (unsigned char*)(p.ws + WS_XN8) + (size_t)t * DM);
#pragma unroll
                for (int j = 0; j < 2; ++j) {
                    u32x4 w;
                    w.x = q8pack4(hn[j * 16 + 0], hn[j * 16 + 1], hn[j * 16 + 2], hn[j * 16 + 3], inv8); w.y = q8pack4(hn[j * 16 + 4], hn[j * 16 + 5], hn[j * 16 + 6], hn[j * 16 + 7], inv8);
                    w.z = q8pack4(hn[j * 16 + 8], hn[j * 16 + 9], hn[j * 16 + 10], hn[j * 16 + 11], inv8); w.w = q8pack4(hn[j * 16 + 12], hn[j * 16 + 13], hn[j * 16 + 14], hn[j * 16 + 15], inv8);
                    *(u32x4*)(xo8 + j * 1024 + lane * 16) = w;
                }
                if (lane == 0 && !dry) ((float*)(p.ws + WS_SCL))[SCL_XN + t] = s8;
            } else {
            bf16_t* xo = (dry ? (bf16_t*)(p.ws + WS_DUMMY) + (size_t)(t & 16383) * DM : (bf16_t*)(p.ws + WS_XN) + (size_t)t * DM);
#pragma unroll
            for (int j = 0; j < 2; ++j)
#pragma unroll
                for (int k = 0; k < 2; ++k) {
                    const int col = j * 1024 + lane * 16 + k * 8;
                    float xv[8];
#pragma unroll
                    for (int i = 0; i < 8; ++i) xv[i] = hn[j * 16 + k * 8 + i] * rstd * g1n[col + i] * (1.f + scale[col + i]) + shift[col + i];
                    u32x4 w; w.x = pk2(xv[0], xv[1]); w.y = pk2(xv[2], xv[3]); w.z = pk2(xv[4], xv[5]); w.w = pk2(xv[6], xv[7]);
                    *(u32x4*)(xo + col) = w;
                }
            }
        }
    }
}
#else
#ifndef DRY_MODE
#define DRY_MODE 0
#endif
typedef float f32x2 __attribute__((ext_vector_type(2)));
__device__ __forceinline__ void ph_gather(const Params& p, int l, const bool dry) {
    const int tid = threadIdx.x, lane = tid & 63, wave = tid >> 6;
    const int gw = blockIdx.x * NWAVES + wave, NGW = gridDim.x * NWAVES;
    const bf16_t* XN = (const bf16_t*)(p.ws + WS_XN);
    const unsigned char* UT = (const unsigned char*)(p.ws + WS_UT) + (size_t)l * NEXP * DM;
    const unsigned char* VT = (const unsigned char*)(p.ws + WS_VT) + (size_t)l * NEXP * DM;
    const float* USC = (const float*)(p.ws + WS_USC) + l * NEXP; const float* VSC = (const float*)(p.ws + WS_VSC) + l * NEXP;
    const int* EID = (const int*)(p.ws + WS_EID); const float* GATE = (const float*)(p.ws + WS_GATE);
    const float* mod = (const float*)(p.ws + WS_MOD) + (size_t)l * 9 * 12288;
    const int nrows = (l == DEPTH - 1) ? NLAT : MTOT;
#pragma unroll 1
    for (int t = gw; t < nrows; t += NGW) {
        int xq[8]; float sxl;
        {
            float x[32]; float am = 0.f;
#pragma unroll
            for (int j = 0; j < 2; ++j)
#pragma unroll
                for (int k = 0; k < 2; ++k) {
                    const u32x4 q = *(const u32x4*)(XN + (size_t)t * DM + j * 1024 + lane * 16 + k * 8);
                    float* xx = x + j * 16 + k * 8;
                    xx[0] = bflo(q.x); xx[1] = bfhi(q.x); xx[2] = bflo(q.y); xx[3] = bfhi(q.y); xx[4] = bflo(q.z); xx[5] = bfhi(q.z); xx[6] = bflo(q.w); xx[7] = bfhi(q.w);
                }
#pragma unroll
            for (int i = 0; i < 32; ++i) am = fmaxf(am, fabsf(x[i]));
            sxl = am > 0.f ? am * (1.f / 127.f) : 1.f;
            const float inv = 1.f / sxl;
#pragma unroll
            for (int d = 0; d < 8; ++d) {
                const int q0 = (int)rintf(x[4 * d] * inv), q1 = (int)rintf(x[4 * d + 1] * inv), q2 = (int)rintf(x[4 * d + 2] * inv), q3 = (int)rintf(x[4 * d + 3] * inv);
                xq[d] = (int)(((unsigned)q0 & 0xffu) | (((unsigned)q1 & 0xffu) << 8) | (((unsigned)q2 & 0xffu) << 16) | ((unsigned)q3 << 24));
            }
        }
        const int e0 = EID[(size_t)t * 128 + lane], e1 = EID[(size_t)t * 128 + 64 + lane];
        const float g0 = GATE[(size_t)t * 128 + lane], g1 = GATE[(size_t)t * 128 + 64 + lane];
        const float us0 = USC[e0], us1 = USC[e1], vs0 = VSC[e0], vs1 = VSC[e1];
        float hid0 = 0.f, hid1 = 0.f;
        constexpr int GBU = 8, GBV = 4;
#define G_LOAD(W, TAB, EB, NB) do { _Pragma("unroll") for (int i = 0; i < NB; ++i) { \
            const int id_ = __builtin_amdgcn_readlane((EB) < 64 ? e0 : e1, ((EB) + i) & 63); \
            const unsigned char* row_ = (TAB) + (size_t)id_ * DM + lane * 16; \
            W[i][0] = *(const u32x4*)row_; W[i][1] = *(const u32x4*)(row_ + 1024); } } while (0)
#define G_DOT(W, EB) do { _Pragma("unroll") for (int i = 0; i < GBU; ++i) { int s_ = 0; \
            s_ = __builtin_amdgcn_sdot4((int)W[i][0].x, xq[0], s_, false); s_ = __builtin_amdgcn_sdot4((int)W[i][0].y, xq[1], s_, false); \
            s_ = __builtin_amdgcn_sdot4((int)W[i][0].z, xq[2], s_, false); s_ = __builtin_amdgcn_sdot4((int)W[i][0].w, xq[3], s_, false); \
            s_ = __builtin_amdgcn_sdot4((int)W[i][1].x, xq[4], s_, false); s_ = __builtin_amdgcn_sdot4((int)W[i][1].y, xq[5], s_, false); \
            s_ = __builtin_amdgcn_sdot4((int)W[i][1].z, xq[6], s_, false); s_ = __builtin_amdgcn_sdot4((int)W[i][1].w, xq[7], s_, false); \
            const float tot = wave_total((float)s_ * sxl); \
            if ((((EB) + i) & 63) == lane) { if ((EB) < 64) hid0 = tot; else hid1 = tot; } } } while (0)
#define G_AXPY(W, EB) do { _Pragma("unroll") for (int i = 0; i < GBV; ++i) { \
            const float cf_ = __uint_as_float(__builtin_amdgcn_readlane(__float_as_uint((EB) < 64 ? cf0 : cf1), ((EB) + i) & 63)); \
            const f32x2 mm = {cf_, cf_}; \
            _Pragma("unroll") for (int j = 0; j < 2; ++j) { const unsigned ww[4] = {W[i][j].x, W[i][j].y, W[i][j].z, W[i][j].w}; \
                _Pragma("unroll") for (int k = 0; k < 4; ++k) { \
                    acc[j * 8 + k * 2] += mm * __builtin_amdgcn_cvt_pk_f32_fp8((int)ww[k], false); \
                    acc[j * 8 + k * 2 + 1] += mm * __builtin_amdgcn_cvt_pk_f32_fp8((int)ww[k], true); } } } } while (0)
        u32x4 wa[GBU][2], wb[GBU][2];
        const bool do_u = !(dry && (DRY_MODE == 4 || DRY_MODE == 5)), do_v = !(dry && (DRY_MODE == 3 || DRY_MODE == 5));
        if (do_u) G_LOAD(wa, UT, 0, GBU); else G_LOAD(wa, VT, 0, GBV);
#pragma unroll 1
        for (int eb = 0; eb < (do_u ? 128 : 0); eb += 2 * GBU) {
            G_LOAD(wb, UT, eb + GBU, GBU);
            G_DOT(wa, eb);
            if (eb + 2 * GBU < 128) G_LOAD(wa, UT, eb + 2 * GBU, GBU); else G_LOAD(wa, VT, 0, GBV);
            G_DOT(wb, eb + GBU);
        }
        const float cf0 = gelu_tanh(hid0 * us0) * g0 * vs0, cf1 = gelu_tanh(hid1 * us1) * g1 * vs1;
        f32x2 acc[16];
#pragma unroll
        for (int i = 0; i < 16; ++i) acc[i] = (f32x2){0.f, 0.f};
#pragma unroll 1
        for (int eb = 0; eb < (do_v ? 128 : 0); eb += 2 * GBV) {
            G_LOAD(wb, VT, eb + GBV, GBV);
            G_AXPY(wa, eb);
            if (eb + 2 * GBV < 128) G_LOAD(wa, VT, eb + 2 * GBV, GBV);
            G_AXPY(wb, eb + GBV);
        }
#undef G_LOAD
#undef G_DOT
#undef G_AXPY
        float hn[32];
        float* hrow = t < NLAT ? p.out + (size_t)t * DM : (float*)(p.ws + WS_HC) + (size_t)(t - NLAT) * DM;
        const int bb = t < NLAT ? (t >> 11) : 8;
        const float* gate = mod + (size_t)bb * 12288 + 5 * DM;
#pragma unroll
        for (int j = 0; j < 2; ++j)
#pragma unroll
            for (int k = 0; k < 4; ++k) {
                const int col = j * 1024 + lane * 16 + k * 4;
                const f32x4 hv = *(const f32x4*)(hrow + col), gv = *(const f32x4*)(gate + col);
                const f32x2 a0 = acc[j * 8 + k * 2], a1 = acc[j * 8 + k * 2 + 1];
                f32x4 o;
                o.x = hv.x + gv.x * a0.x; o.y = hv.y + gv.y * a0.y; o.z = hv.z + gv.z * a1.x; o.w = hv.w + gv.w * a1.y;
                *(f32x4*)((dry ? (float*)(p.ws + WS_DUMMY) + (size_t)(t & 16383) * DM : hrow) + col) = o;
                hn[j * 16 + k * 4 + 0] = o.x; hn[j * 16 + k * 4 + 1] = o.y; hn[j * 16 + k * 4 + 2] = o.z; hn[j * 16 + k * 4 + 3] = o.w;
            }
        if (l + 1 < DEPTH) {
            float ss = 0.f;
#pragma unroll
            for (int i = 0; i < 32; ++i) ss += hn[i] * hn[i];
            const float rstd = rsqrtf(wave_total(ss) * (1.f / DM) + EPS);
            const float* g1n = p.norm1_g + (l + 1) * DM;
            const float* shift = mod + (size_t)9 * 12288 + (size_t)bb * 12288;
            const float* scale = shift + DM;
            bf16_t* xo = (dry ? (bf16_t*)(p.ws + WS_DUMMY) + (size_t)(t & 16383) * DM : (bf16_t*)(p.ws + WS_XN) + (size_t)t * DM);
#pragma unroll
            for (int j = 0; j < 2; ++j)
#pragma unroll
                for (int k = 0; k < 2; ++k) {
                    const int col = j * 1024 + lane * 16 + k * 8;
                    float xv[8];
#pragma unroll
                    for (int i = 0; i < 8; ++i) xv[i] = hn[j * 16 + k * 8 + i] * rstd * g1n[col + i] * (1.f + scale[col + i]) + shift[col + i];
                    u32x4 w; w.x = pk2(xv[0], xv[1]); w.y = pk2(xv[2], xv[3]); w.z = pk2(xv[4], xv[5]); w.w = pk2(xv[6], xv[7]);
                    *(u32x4*)(xo + col) = w;
                }
        }
    }
}
#endif
#else
__device__ __forceinline__ float dot8(const u32x4 u, const u32x4 x) {
    float d = bflo(u.x) * bflo(x.x) + bfhi(u.x) * bfhi(x.x);
    d += bflo(u.y) * bflo(x.y) + bfhi(u.y) * bfhi(x.y);
    d += bflo(u.z) * bflo(x.z) + bfhi(u.z) * bfhi(x.z);
    d += bflo(u.w) * bflo(x.w) + bfhi(u.w) * bfhi(x.w);
    return d;
}
__device__ __forceinline__ void ph_gather(const Params& p, int l, const bool dry) {
    const int tid = threadIdx.x, lane = tid & 63, wave = tid >> 6;
    const int gw = blockIdx.x * NWAVES + wave, NGW = gridDim.x * NWAVES;
    const bf16_t* XN = (const bf16_t*)(p.ws + WS_XN);
    const bf16_t* UT = (const bf16_t*)(p.ws + WS_UT) + (size_t)l * NEXP * DM;
    const bf16_t* VT = (const bf16_t*)(p.ws + WS_VT) + (size_t)l * NEXP * DM;
    const int* EID = (const int*)(p.ws + WS_EID); const float* GATE = (const float*)(p.ws + WS_GATE);
    const float* mod = (const float*)(p.ws + WS_MOD) + (size_t)l * 9 * 12288;
    const int nrows = (l == DEPTH - 1) ? NLAT : MTOT;
    for (int t = gw; t < nrows; t += NGW) {
        u32x4 xq[4];
#pragma unroll
        for (int j = 0; j < 4; ++j) xq[j] = *(const u32x4*)(XN + (size_t)t * DM + j * 512 + lane * 8);
        const int e0 = EID[(size_t)t * 128 + lane], e1 = EID[(size_t)t * 128 + 64 + lane];
        const float g0 = GATE[(size_t)t * 128 + lane], g1 = GATE[(size_t)t * 128 + 64 + lane];
        float hid0 = 0.f, hid1 = 0.f;
#pragma unroll 1
        for (int eb = 0; eb < 128; eb += 4) {
            u32x4 uu[4][4];
#pragma unroll
            for (int i = 0; i < 4; ++i) {
                const int e = eb + i;
                const int id = __builtin_amdgcn_readlane(eb < 64 ? e0 : e1, e & 63);
                const u32x4* ur = (const u32x4*)(UT + (size_t)id * DM) + lane;
#pragma unroll
                for (int j = 0; j < 4; ++j) uu[i][j] = ur[j * 64];
            }
#pragma unroll
            for (int i = 0; i < 4; ++i) {
                const int e = eb + i;
                float d = dot8(uu[i][0], xq[0]) + dot8(uu[i][1], xq[1]) + dot8(uu[i][2], xq[2]) + dot8(uu[i][3], xq[3]);
                d = wave_sum(d);
                if ((e & 63) == lane) { if (eb < 64) hid0 = d; else hid1 = d; }
            }
        }
        const float cf0 = gelu_tanh(hid0) * g0, cf1 = gelu_tanh(hid1) * g1;
        float acc[32];
#pragma unroll
        for (int i = 0; i < 32; ++i) acc[i] = 0.f;
#pragma unroll 1
        for (int eb = 0; eb < 128; eb += 4) {
            u32x4 vv[4][4]; float cf[4];
#pragma unroll
            for (int i = 0; i < 4; ++i) {
                const int e = eb + i;
                const int id = __builtin_amdgcn_readlane(eb < 64 ? e0 : e1, e & 63);
                cf[i] = __uint_as_float(__builtin_amdgcn_readlane(__float_as_uint(eb < 64 ? cf0 : cf1), e & 63));
                const u32x4* vr = (const u32x4*)(VT + (size_t)id * DM) + lane;
#pragma unroll
                for (int j = 0; j < 4; ++j) vv[i][j] = vr[j * 64];
            }
#pragma unroll
            for (int i = 0; i < 4; ++i)
#pragma unroll
                for (int j = 0; j < 4; ++j) {
                    acc[j * 8 + 0] += cf[i] * bflo(vv[i][j].x); acc[j * 8 + 1] += cf[i] * bfhi(vv[i][j].x);
                    acc[j * 8 + 2] += cf[i] * bflo(vv[i][j].y); acc[j * 8 + 3] += cf[i] * bfhi(vv[i][j].y);
                    acc[j * 8 + 4] += cf[i] * bflo(vv[i][j].z); acc[j * 8 + 5] += cf[i] * bfhi(vv[i][j].z);
                    acc[j * 8 + 6] += cf[i] * bflo(vv[i][j].w); acc[j * 8 + 7] += cf[i] * bfhi(vv[i][j].w);
                }
        }
        float* hrow = t < NLAT ? p.out + (size_t)t * DM : (float*)(p.ws + WS_HC) + (size_t)(t - NLAT) * DM;
        const int bb = t < NLAT ? (t >> 11) : 8;
        const float* gate = mod + (size_t)bb * 12288 + 5 * DM;
#pragma unroll
        for (int j = 0; j < 4; ++j) {
            const int col = j * 512 + lane * 8;
#pragma unroll
            for (int hh = 0; hh < 2; ++hh) {
                const f32x4 hv = *(const f32x4*)(hrow + col + hh * 4), gv = *(const f32x4*)(gate + col + hh * 4);
                f32x4 o;
                o.x = hv.x + gv.x * acc[j * 8 + hh * 4 + 0]; o.y = hv.y + gv.y * acc[j * 8 + hh * 4 + 1];
                o.z = hv.z + gv.z * acc[j * 8 + hh * 4 + 2]; o.w = hv.w + gv.w * acc[j * 8 + hh * 4 + 3];
                *(f32x4*)(hrow + col + hh * 4) = o;
            }
        }
    }
}

#endif

#define LAS __attribute__((address_space(3)))
#define XB_TMO      128
#define XB_XCNT(j)  (256  + 64 * (j))
#define XB_XSUB(j)  (1280 + 64 * (j))
#define XB_XGEN(j)  (2304 + 64 * (j))
#define XB_TOP      3328
#define XB_TOPGEN   3392
#define XCD_BAR_WORDS 3456
#define XB_SPIN_CAP (1u << 18)

__device__ __forceinline__ unsigned xb_ld(unsigned* p)              { return __hip_atomic_load(p, __ATOMIC_RELAXED, __HIP_MEMORY_SCOPE_AGENT); }
__device__ __forceinline__ unsigned xb_add(unsigned* p, unsigned v) { return __hip_atomic_fetch_add(p, v, __ATOMIC_RELAXED, __HIP_MEMORY_SCOPE_AGENT); }
__device__ __forceinline__ unsigned xb_xcc_id() { return (unsigned)__builtin_amdgcn_s_getreg((3 << 11) | 20) & 0xFu; }
#define XB_SPIN(cond, bar) do { unsigned _sp = 0; while (cond) { __builtin_amdgcn_s_sleep(1); \
    if ((++_sp & 255u) == 0u) { if (xb_ld(&(bar)[XB_TMO])) break; if (_sp > XB_SPIN_CAP) { atomicAdd(&(bar)[XB_TMO], 1u); break; } } } } while (0)

struct XcdBarrier {
    unsigned* bar; unsigned x;
    volatile LAS unsigned* st;
};

__device__ __forceinline__ XcdBarrier xcd_barrier_post(unsigned* bar, volatile LAS unsigned* st) {
    XcdBarrier b; b.bar = bar; b.x = xb_xcc_id(); b.st = st;
    if (threadIdx.x == 0) (void)xb_add(&bar[XB_XCNT(b.x)], 1u);
    return b;
}
__device__ __forceinline__ void xcd_barrier_complete(unsigned* bar, unsigned x, unsigned& nloc, unsigned& nx) {
    const unsigned G = gridDim.x * gridDim.y * gridDim.z;
    unsigned sum, cnt, mine, sp = 0u;
    for (;;) {
        sum = 0u; cnt = 0u; mine = 0u;
#pragma unroll
        for (unsigned j = 0; j < 16; ++j) { const unsigned c = xb_ld(&bar[XB_XCNT(j)]); sum += c; cnt += (c > 0u) ? 1u : 0u; mine = (j == x) ? c : mine; }
        if (sum == G) break;
        __builtin_amdgcn_s_sleep(1);
        if ((++sp & 255u) == 0u) { if (xb_ld(&bar[XB_TMO])) break; if (sp > XB_SPIN_CAP) { atomicAdd(&bar[XB_TMO], 1u); break; } }
    }
    nloc = mine > 0u ? mine : 1u; nx = cnt > 0u ? cnt : 1u;
}

__device__ __forceinline__ void xcd_barrier(const XcdBarrier& b) {
    asm volatile("s_waitcnt vmcnt(0)" ::: "memory");
    __syncthreads();
    if (threadIdx.x == 0) {
        unsigned* bar = b.bar;
        __builtin_amdgcn_s_waitcnt(0);
        unsigned nloc = b.st[0], nx = b.st[1];
        if (nloc == 0u) { xcd_barrier_complete(bar, b.x, nloc, nx); b.st[0] = nloc; b.st[1] = nx; }
        const unsigned old = xb_add(&bar[XB_XSUB(b.x)], 1u);
        const unsigned gen = old / nloc;
        if (old + 1u == (gen + 1u) * nloc) {
            __builtin_amdgcn_fence(__ATOMIC_RELEASE, "agent");
            asm volatile("s_waitcnt vmcnt(0)" ::: "memory");
            const unsigned og = xb_add(&bar[XB_TOP], 1u);
            const unsigned tg = og / nx;
            if (og + 1u == (tg + 1u) * nx) xb_add(&bar[XB_TOPGEN], 1u);
            else XB_SPIN(xb_ld(&bar[XB_TOPGEN]) == tg, bar);
            __builtin_amdgcn_fence(__ATOMIC_ACQUIRE, "agent");
            xb_add(&bar[XB_XGEN(b.x)], 1u);
            asm volatile("s_waitcnt vmcnt(0)" ::: "memory");
        } else {
            XB_SPIN(xb_ld(&bar[XB_XGEN(b.x)]) == gen, bar);
            __builtin_amdgcn_fence(__ATOMIC_ACQUIRE, "agent");
            asm volatile("s_waitcnt vmcnt(0)" ::: "memory");
        }
    }
    __syncthreads();
}

constexpr int NPHASE = 1 + 10 * DEPTH;
template <int S>
__device__ __forceinline__ void run_stage(const Params& p, int l, unsigned char* lds, const bool dry) {
    const bool last = (l == DEPTH - 1);
    const float* mod = (const float*)(p.ws + WS_MOD) + (size_t)l * 9 * 12288;
    if constexpr (S == 1) { if (l == 0) { ph_modulate(p, l, 0); if (GEMM_I8 && !(GEMM3_I8 && W8_ONEPASS) && !dry) ph_weights_i8(p, lds); } }
    if constexpr (S == 2) {
#if USE_PG8
        pg8::StaticOrder So; So.init(MTOT, INW, (int)gridDim.x, (int)blockIdx.x);
#if GEMM_I8
        pg8::Gemm g{(const bf16_t*)(p.ws + WS_XN8), (const bf16_t*)(p.ws + WS_WIN + (size_t)l * INW * DM), MTOT, INW, DM / 2};
        pg8::EpiBf16I8 E{(bf16_t*)(p.ws + WS_P), INW, (const float*)(p.ws + WS_SCL) + SCL_XN, (const float*)(p.ws + WS_SCL) + SCL_WIN + l * INW};
        pg8::gemm_phase<pg8::EpiBf16I8, pg8::StaticOrder, true, true, true>((PG8_LAS unsigned char*)lds, g, So, E);
#else
        pg8::Gemm g{(const bf16_t*)(p.ws + WS_XN), (const bf16_t*)(p.ws + WS_WIN) + (size_t)l * INW * DM, MTOT, INW, DM};
        pg8::EpiBf16<0> E{(bf16_t*)(p.ws + WS_P), INW, nullptr, 0, 0, 1.f};
        pg8::gemm_phase<pg8::EpiBf16<0>, pg8::StaticOrder, true, true>((PG8_LAS unsigned char*)lds, g, So, E);
#endif
#else
        EpiBf16Store E{(bf16_t*)(p.ws + WS_P), INW};
        gemm_naive(lds, (const bf16_t*)(p.ws + WS_XN), (const bf16_t*)(p.ws + WS_WIN) + (size_t)l * INW * DM, MTOT, INW, DM, E);
#endif
    }
    if constexpr (S == 3) ph_prep(p, l, dry);
    if constexpr (S == 4) {
#if USE_FAST_ATT
        ph_mixers_fast(p, l, lds, dry);
#else
        ph_mixers_naive(p, l, lds);
#endif
    }
    if constexpr (S == 5) ph_ynorm(p, l);
    if constexpr (S == 6) {
#if USE_PG8
        const int M = last ? NLAT : MTOT;
        pg8::StaticOrder So; So.init(M, DM, (int)gridDim.x, (int)blockIdx.x);
#if GEMM_I8
        pg8::Gemm g{(const bf16_t*)(p.ws + WS_XN8), (const bf16_t*)(p.ws + WS_WOUT + (size_t)l * DM * DM), M, DM, DM / 2};
#if H_BF16 && GEMM3_I8
        pg8::EpiResGateI8B E{l == 0 ? p.x : nullptr, p.ctx, (bf16_t*)(p.ws + (dry ? WS_DUMMY : WS_HB)), mod + 2 * DM,
                             (const float*)(p.ws + WS_SCL) + SCL_Y, (const float*)(p.ws + WS_SCL) + SCL_WOUT + l * DM};
        pg8::gemm_phase<pg8::EpiResGateI8B, pg8::StaticOrder, true, true, true>((PG8_LAS unsigned char*)lds, g, So, E);
#else
        pg8::EpiResGateI8 E{l == 0 ? p.x : p.out, l == 0 ? p.ctx : (const float*)(p.ws + WS_HC), dry ? (float*)(p.ws + WS_DUMMY) : p.out, dry ? (float*)(p.ws + WS_DUMMY) : (float*)(p.ws + WS_HC), mod + 2 * DM,
                            (const float*)(p.ws + WS_SCL) + SCL_Y, (const float*)(p.ws + WS_SCL) + SCL_WOUT + l * DM};
        pg8::gemm_phase<pg8::EpiResGateI8, pg8::StaticOrder, true, true, true>((PG8_LAS unsigned char*)lds, g, So, E);
#endif
#else
        pg8::Gemm g{(const bf16_t*)(p.ws + WS_Y), (const bf16_t*)(p.ws + WS_WOUT) + (size_t)l * DM * DM, M, DM, DM};
        pg8::EpiResGateT E{l == 0 ? p.x : p.out, l == 0 ? p.ctx : (const float*)(p.ws + WS_HC), dry ? (float*)(p.ws + WS_DUMMY) : p.out, dry ? (float*)(p.ws + WS_DUMMY) : (float*)(p.ws + WS_HC), mod + 2 * DM};
        pg8::gemm_phase<pg8::EpiResGateT, pg8::StaticOrder, true, true>((PG8_LAS unsigned char*)lds, g, So, E);
#endif
#if GATHER_I8 && GATHER_4BIT
        if (TABLES_IN_GAPS && l == 0 && !dry) conv4_tables(p, 0, NEXP, (unsigned*)(p.ws + WS_CTL) + 6144, lds);
#endif
#else
        EpiResGate E{l == 0 ? p.x : p.out, l == 0 ? p.ctx : (const float*)(p.ws + WS_HC), p.out, (float*)(p.ws + WS_HC), mod + 2 * DM};
        gemm_naive(lds, (const bf16_t*)(p.ws + WS_Y), (const bf16_t*)(p.ws + WS_WOUT) + (size_t)l * DM * DM, last ? NLAT : MTOT, DM, DM, E);
#endif
    }
    if constexpr (S == 7) ph_modulate(p, l, 1);
    if constexpr (S == 8) {
#if USE_PG8
        const int M = last ? NLAT : MTOT;
        pg8::StaticOrder So; So.init(M, DM, (int)gridDim.x, (int)blockIdx.x);
#if GEMM_I8 && GEMM3_I8
        pg8::Gemm g{(const bf16_t*)(p.ws + WS_XN8), (const bf16_t*)(p.ws + WS_WQ + (size_t)l * DM * DM), M, DM, DM / 2};
        pg8::EpiBf16I8 E{(bf16_t*)(p.ws + WS_P), DM, (const float*)(p.ws + WS_SCL) + SCL_XN, (const float*)(p.ws + WS_SCL) + SCL_WQ + l * DM};
        pg8::gemm_phase<pg8::EpiBf16I8, pg8::StaticOrder, true, true, true>((PG8_LAS unsigned char*)lds, g, So, E);
#else
        pg8::Gemm g{(const bf16_t*)(p.ws + WS_XN), (const bf16_t*)(p.ws + WS_WQ) + (size_t)l * DM * DM, M, DM, DM};
        pg8::EpiBf16<0> E{(bf16_t*)(p.ws + WS_P), DM, nullptr, 0, 0, 1.f};
        pg8::gemm_phase<pg8::EpiBf16<0>, pg8::StaticOrder, true, true>((PG8_LAS unsigned char*)lds, g, So, E);
#endif
#if FUSE_ROUTE
        asm volatile("s_waitcnt vmcnt(0)" ::: "memory");
        __syncthreads();
        ph_route_fast<true>(p, l, lds);
#endif
#if GATHER_I8 && GATHER_4BIT
        if (TABLES_IN_GAPS && l == 0 && !dry) conv4_tables(p, 2 * NEXP, 3 * NEXP, (unsigned*)(p.ws + WS_CTL) + 6208, lds);
#endif
#else
        EpiBf16Store E{(bf16_t*)(p.ws + WS_P), DM};
        gemm_naive(lds, (const bf16_t*)(p.ws + WS_XN), (const bf16_t*)(p.ws + WS_WQ) + (size_t)l * DM * DM, last ? NLAT : MTOT, DM, DM, E);
#endif
    }
    if constexpr (S == 9) {
#if USE_FAST_ROUTE
        if (!FUSE_ROUTE) ph_route_fast<false>(p, l, lds);
#else
        ph_route_naive(p, l);
#endif
    }
    if constexpr (S == 10) ph_gather(p, l, dry);
}
__global__ void __launch_bounds__(NTHREADS) fwd_kernel(Params p) {
    extern __shared__ __attribute__((aligned(16))) unsigned char lds[];
    cg::grid_group grid = cg::this_grid();
    const int lo = p.ph_lo, hi = p.ph_hi;
    volatile LAS unsigned* stw = (volatile LAS unsigned*)((LAS unsigned char*)lds + (LDS_BYTES - 128));
    if (threadIdx.x < 2) stw[threadIdx.x] = 0u;
    __syncthreads();
    const XcdBarrier bar = xcd_barrier_post((unsigned*)(p.ws + WS_CTL + 32768), stw);
#define IN(k) (lo <= (k) && (k) < hi)
#define SEAM(k) do { if (IN(k) && IN((k) + 1)) xcd_barrier(bar); } while (0)
#define STAGE(S, l) do { constexpr int k_ = 1 + 10 * (l) + (S) - 1; if (IN(k_)) { if constexpr ((REP_MASK >> k_) & 1) { run_stage<S>(p, l, lds, true); xcd_barrier(bar); } run_stage<S>(p, l, lds, false); } SEAM(k_); } while (0)
#define LAYER(l) do { if ((l) == 0) { STAGE(1, l); } STAGE(2, l); STAGE(3, l); STAGE(4, l); STAGE(5, l); STAGE(6, l); STAGE(7, l); STAGE(8, l); if (!FUSE_ROUTE) { STAGE(9, l); } STAGE(10, l); } while (0)
    if (hi > NPHASE) grid.sync();
    if (IN(0)) { if constexpr (REP_MASK & 1) { ph_prologue(p, lds); xcd_barrier(bar); } ph_prologue(p, lds); }
    SEAM(0);
    LAYER(0);
    LAYER(1);
#undef IN
#undef SEAM
#undef STAGE
#undef LAYER
}

extern "C" void kernel_launch(void* const* d_in, const int* in_sizes, int n_in, void* d_out, int out_size, void* d_ws, size_t ws_size, hipStream_t stream) {
    static int grid_blocks = 0;
    if (grid_blocks == 0) {
        if (n_in != 23 || out_size != NLAT * DM || ws_size < WS_END) { fprintf(stderr, "kernel_launch: unexpected shapes n_in %d out %d ws %zu\n", n_in, out_size, ws_size); grid_blocks = -1; return; }
        if (hipFuncSetAttribute((const void*)fwd_kernel, hipFuncAttributeMaxDynamicSharedMemorySize, LDS_BYTES) != hipSuccess) { fprintf(stderr, "kernel_launch: hipFuncSetAttribute failed\n"); grid_blocks = -1; return; }
        int dev = 0, cus = 0, per_cu = 0;
        hipGetDevice(&dev);
        hipDeviceGetAttribute(&cus, hipDeviceAttributeMultiprocessorCount, dev);
        hipOccupancyMaxActiveBlocksPerMultiprocessor(&per_cu, (const void*)fwd_kernel, NTHREADS, LDS_BYTES);
        if (per_cu < 1 || cus < 1) { fprintf(stderr, "kernel_launch: occupancy query failed (%d per CU, %d CUs)\n", per_cu, cus); grid_blocks = -1; return; }
        grid_blocks = cus * per_cu;
    }
    if (grid_blocks < 0) return;
    Params p{};
    const float** pp = (const float**)&p;
    for (int i = 0; i < 23; ++i) pp[i] = (const float*)d_in[i];
    p.out = (float*)d_out; p.ws = (unsigned char*)d_ws;
    p.ph_lo = 0; p.ph_hi = NPHASE;
    hipMemsetAsync((char*)d_ws + WS_CTL, 0, 131072, stream);
    void* args[] = {&p};
    hipError_t e = hipLaunchCooperativeKernel((const void*)fwd_kernel, dim3(grid_blocks), dim3(NTHREADS), args, LDS_BYTES, stream);
    if (e != hipSuccess) fprintf(stderr, "cooperative launch failed: %s (grid %d)\n", hipGetErrorString(e), grid_blocks);
}
```

```cpp
#include <hip/hip_runtime.h>
#include <hip/hip_cooperative_groups.h>
#include <cstdio>
#include <cstdint>
namespace cg = cooperative_groups;

constexpr int DM = 2048, NB = 8, SEQ = 2048, NCTX = 256, DEPTH = 2;
constexpr int NLAT = NB * SEQ;
constexpr int NCT = NB * NCTX;
constexpr int MTOT = NLAT + NCT;
constexpr int INW = 3584;
constexpr int C_QA = 0, C_KA = 768, C_VA = 1024, C_QB = 1280, C_KB = 2048, C_VB = 2304, C_UC = 2560, C_VC = 3072;
constexpr int NEXP = 16384;
constexpr float EPS = 1e-6f;
constexpr float ATT_SCALE = 0.088388347648318440f;
constexpr int NTHREADS = 512, NWAVES = 8;

constexpr size_t MiB = 1u << 20;
constexpr size_t WS_CTL = 0;
constexpr size_t WS_MOD = 1 * MiB;
constexpr size_t WS_ROPE = 2 * MiB;
constexpr size_t WS_KEYS = 3 * MiB;
constexpr size_t WS_WSC = 4 * MiB;
constexpr size_t WS_USC = 5 * MiB;
constexpr size_t WS_VSC = 6 * MiB;
constexpr size_t WS_WIN = 8 * MiB;
constexpr size_t WS_WOUT = 36 * MiB;
constexpr size_t WS_WQ = 52 * MiB;
constexpr size_t WS_HC = 68 * MiB;
constexpr size_t WS_EID = 84 * MiB;
constexpr size_t WS_GATE = 93 * MiB;
constexpr size_t WS_XN = 104 * MiB;
constexpr size_t WS_HB = WS_XN;
constexpr size_t WS_Y = 176 * MiB;
constexpr size_t WS_P = 248 * MiB;
constexpr size_t WS_UT = 376 * MiB;
constexpr size_t WS_VT = 504 * MiB;
constexpr size_t WS_SCL = 102 * MiB;
constexpr size_t SCL_WIN = 0, SCL_WOUT = 2 * 3584, SCL_XN = SCL_WOUT + 2 * 2048, SCL_Y = SCL_XN + 18432, SCL_WQ = SCL_Y + 18432;
constexpr int NCM = 3584 + 2048 + 2048;
constexpr size_t WS_XN8 = 784 * MiB;
constexpr size_t CTL_COLMAX = 65536;
constexpr size_t WS_DUMMY = 640 * MiB;
constexpr size_t WS_END = 820 * MiB;

constexpr int LDS_BYTES = 147456;

typedef unsigned short bf16_t;
typedef float f32x4 __attribute__((ext_vector_type(4)));
typedef unsigned u32x4 __attribute__((ext_vector_type(4)));
typedef unsigned u32x2 __attribute__((ext_vector_type(2)));

struct Params {
    const float *x, *c, *ctx, *c_ctx, *w_ada, *b_ada, *norm1_g, *norm2_g, *w_in, *qn_a, *kn_a, *qn_b, *kn_b, *sink_b, *vn_c, *ws_c, *bs_c,
        *g_group, *w_out, *peer_wq, *peer_keys, *peer_u, *peer_v;
    float* out;
    unsigned char* ws;
    int ph_lo, ph_hi;
};

__device__ __forceinline__ float bf2f(unsigned v) { return __uint_as_float(v << 16); }
__device__ __forceinline__ float bflo(unsigned w) { return __uint_as_float(w << 16); }
__device__ __forceinline__ float bfhi(unsigned w) { return __uint_as_float(w & 0xffff0000u); }
__device__ __forceinline__ unsigned f2bf(float f) { unsigned u = __float_as_uint(f); return (u + 0x7fffu + ((u >> 16) & 1u)) >> 16; }
__device__ __forceinline__ unsigned pk2(float lo, float hi) { return f2bf(lo) | (f2bf(hi) << 16); }
__device__ __forceinline__ float wave_sum(float v) {
#pragma unroll
    for (int o = 32; o >= 1; o >>= 1) v += __shfl_xor(v, o);
    return v;
}
__device__ __forceinline__ float wave_max(float v) {
#pragma unroll
    for (int o = 32; o >= 1; o >>= 1) v = fmaxf(v, __shfl_xor(v, o));
    return v;
}
__device__ __forceinline__ float gelu_tanh(float x) {
    const float y = 0.7978845608028654f * (x + 0.044715f * x * x * x);
    const float t = 1.f - 2.f / (__expf(2.f * y) + 1.f);
    return 0.5f * x * (1.f + t);
}
__device__ __forceinline__ float silu(float x) { return x / (1.f + __expf(-x)); }
#define LDS_WAIT() asm volatile("s_waitcnt lgkmcnt(0)" ::: "memory")
#ifndef GATHER_I8
#define GATHER_I8 1
#endif
#ifndef GATHER_4BIT
#define GATHER_4BIT 1
#endif
constexpr int ROW4 = 1152;
#ifndef FUSE_ROUTE
#define FUSE_ROUTE 1
#endif
#ifndef GEMM_I8
#define GEMM_I8 1
#endif
#ifndef GEMM3_I8
#define GEMM3_I8 1
#endif
#ifndef H_BF16
#define H_BF16 1
#endif
#ifndef W8_ONEPASS
#define W8_ONEPASS 1
#endif
#ifndef DRY_MODE
#define DRY_MODE 0
#endif
#ifndef REP_MASK
#define REP_MASK 0
#endif

__device__ __forceinline__ unsigned q8pack4(float a, float b, float c, float d, float inv) {
    const int q0 = (int)rintf(a * inv), q1 = (int)rintf(b * inv), q2 = (int)rintf(c * inv), q3 = (int)rintf(d * inv);
    return ((unsigned)q0 & 0xffu) | (((unsigned)q1 & 0xffu) << 8) | (((unsigned)q2 & 0xffu) << 16) | ((unsigned)q3 << 24);
}

__device__ __forceinline__ void transpose_item(const float* W, int K, int N, bf16_t* WT, const float* gk, float* scr, int item, int lane) {
    const int nblk = N / 32, kb = item / nblk, nb = item % nblk, k0 = 64 * kb, n0 = 32 * nb;
#pragma unroll 8
    for (int i = 0; i < 32; ++i) {
        const int kk = 2 * i + (lane >> 5);
        float v = W[(size_t)(k0 + kk) * N + n0 + (lane & 31)];
        if (gk) v *= gk[k0 + kk];
        scr[kk * 33 + (lane & 31)] = v;
    }
    LDS_WAIT();
    const int c = lane & 7;
#pragma unroll
    for (int j = 0; j < 4; ++j) {
        const int n = (lane >> 3) + 8 * j;
        const float* s = scr + (8 * c) * 33 + n;
        u32x4 o;
        o.x = pk2(s[0 * 33], s[1 * 33]); o.y = pk2(s[2 * 33], s[3 * 33]); o.z = pk2(s[4 * 33], s[5 * 33]); o.w = pk2(s[6 * 33], s[7 * 33]);
        *(u32x4*)(WT + (size_t)(n0 + n) * K + k0 + 8 * c) = o;
    }
    LDS_WAIT();
}

__device__ __forceinline__ void colmax_item(const float* W, int N, const float* gk, unsigned* cmax, int item, int lane) {
    const int nblk = N / 32, kb = item / nblk, nb = item % nblk, k0 = 64 * kb, n0 = 32 * nb;
    f32x4 v[8];
#pragma unroll
    for (int i = 0; i < 8; ++i) v[i] = *(const f32x4*)(W + (size_t)(k0 + 8 * i + (lane >> 3)) * N + n0 + 4 * (lane & 7));
    float m0 = 0.f, m1 = 0.f, m2 = 0.f, m3 = 0.f;
#pragma unroll
    for (int i = 0; i < 8; ++i) {
        const float g = gk ? fabsf(gk[k0 + 8 * i + (lane >> 3)]) : 1.f;
        m0 = fmaxf(m0, fabsf(v[i].x) * g); m1 = fmaxf(m1, fabsf(v[i].y) * g); m2 = fmaxf(m2, fabsf(v[i].z) * g); m3 = fmaxf(m3, fabsf(v[i].w) * g);
    }
#pragma unroll
    for (int o = 8; o <= 32; o <<= 1) { m0 = fmaxf(m0, __shfl_xor(m0, o)); m1 = fmaxf(m1, __shfl_xor(m1, o)); m2 = fmaxf(m2, __shfl_xor(m2, o)); m3 = fmaxf(m3, __shfl_xor(m3, o)); }
    if (lane < 8) {
        unsigned* c = cmax + n0 + 4 * lane;
        atomicMax(c + 0, __float_as_uint(m0)); atomicMax(c + 1, __float_as_uint(m1)); atomicMax(c + 2, __float_as_uint(m2)); atomicMax(c + 3, __float_as_uint(m3));
    }
}
__device__ __forceinline__ void transpose_item_i8(const float* W, int K, int N, unsigned char* W8, const float* gk, const unsigned* cmax, float* scr, int item, int lane) {
    const int nblk = N / 32, kb = item / nblk, nb = item % nblk, k0 = 64 * kb, n0 = 32 * nb;
    f32x4 v[8];
#pragma unroll
    for (int i = 0; i < 8; ++i) v[i] = *(const f32x4*)(W + (size_t)(k0 + 8 * i + (lane >> 3)) * N + n0 + 4 * (lane & 7));
    float inv[4];
#pragma unroll
    for (int c = 0; c < 4; ++c) { const float m = __uint_as_float(cmax[n0 + 4 * (lane & 7) + c]); inv[c] = m > 0.f ? 127.f / m : 0.f; }
#pragma unroll
    for (int i = 0; i < 8; ++i) {
        const int kk = 8 * i + (lane >> 3);
        const float g = gk ? gk[k0 + kk] : 1.f;
        float* d = scr + kk * 33 + 4 * (lane & 7);
        d[0] = rintf(v[i].x * g * inv[0]); d[1] = rintf(v[i].y * g * inv[1]); d[2] = rintf(v[i].z * g * inv[2]); d[3] = rintf(v[i].w * g * inv[3]);
    }
    LDS_WAIT();
    const int c = lane & 7;
#pragma unroll
    for (int j = 0; j < 4; ++j) {
        const int n = (lane >> 3) + 8 * j;
        const float* s = scr + (8 * c) * 33 + n;
        unsigned lo = 0u, hi = 0u;
#pragma unroll
        for (int i = 0; i < 4; ++i) { lo |= ((unsigned)(int)s[i * 33] & 0xffu) << (8 * i); hi |= ((unsigned)(int)s[(4 + i) * 33] & 0xffu) << (8 * i); }
        u32x2 o; o.x = lo; o.y = hi;
        *(u32x2*)(W8 + (size_t)(n0 + n) * K + k0 + 8 * c) = o;
    }
    LDS_WAIT();
}
__device__ __forceinline__ void ph_weights_i8(const Params& p, unsigned char* lds) {
    const int tid = threadIdx.x, lane = tid & 63, wave = tid >> 6;
    const int gw = blockIdx.x * NWAVES + wave, NGW = gridDim.x * NWAVES;
    float* scr = (float*)(lds + wave * 8704);
    const unsigned* cm = (const unsigned*)(p.ws + WS_CTL + CTL_COLMAX);
    constexpr int I_IN = 32 * 112, I_SQ = 32 * 64, I_L = I_IN + I_SQ + (GEMM3_I8 ? I_SQ : 0);
    for (int it = gw; it < 2 * I_L; it += NGW) {
        const int l = it / I_L; const int r = it % I_L;
        if (r < I_IN) transpose_item_i8(p.w_in + (size_t)l * DM * INW, DM, INW, (unsigned char*)(p.ws + WS_WIN) + (size_t)l * INW * DM, nullptr, cm + l * NCM, scr, r, lane);
        else if (r < I_IN + I_SQ) transpose_item_i8(p.w_out + (size_t)l * DM * DM, DM, DM, (unsigned char*)(p.ws + WS_WOUT) + (size_t)l * DM * DM, p.g_group + l * DM, cm + l * NCM + INW, scr, r - I_IN, lane);
        else transpose_item_i8(p.peer_wq + (size_t)l * DM * DM, DM, DM, (unsigned char*)(p.ws + WS_WQ) + (size_t)l * DM * DM, nullptr, cm + l * NCM + INW + DM, scr, r - I_IN - I_SQ, lane);
    }
    float* S = (float*)(p.ws + WS_SCL);
    for (int i = blockIdx.x * NTHREADS + tid; i < 2 * NCM; i += gridDim.x * NTHREADS) {
        const int l = i / NCM, n = i % NCM;
        const float m = __uint_as_float(cm[i]); const float s = m > 0.f ? m * (1.f / 127.f) : 1.f;
        if (n < INW) S[SCL_WIN + l * INW + n] = s; else if (n < INW + DM) S[SCL_WOUT + l * DM + (n - INW)] = s; else S[SCL_WQ + l * DM + (n - INW - DM)] = s;
    }
}

__device__ __forceinline__ void w8_strip(const float* W, int N, int n0, const float* gk, unsigned char* W8, float* scl, unsigned char* lds) {
    constexpr int TP = 2048 + 8;
    bf16_t* T = (bf16_t*)lds;
    unsigned* cmx = (unsigned*)(lds + 32 * TP * 2);
    const int tid = threadIdx.x, nq = tid & 7, kr = tid >> 3;
    __syncthreads();
    if (tid < 32) cmx[tid] = 0u;
    float m0 = 0.f, m1 = 0.f, m2 = 0.f, m3 = 0.f;
#pragma unroll 1
    for (int s0 = 0; s0 < 32; s0 += 8) {
        f32x4 v[8];
#pragma unroll
        for (int i = 0; i < 8; ++i) v[i] = *(const f32x4*)(W + (size_t)((s0 + i) * 64 + kr) * N + n0 + 4 * nq);
#pragma unroll
        for (int i = 0; i < 8; ++i) {
            const int k = (s0 + i) * 64 + kr;
            const float g = gk ? gk[k] : 1.f;
            const float a = v[i].x * g, b = v[i].y * g, c = v[i].z * g, d = v[i].w * g;
            m0 = fmaxf(m0, fabsf(a)); m1 = fmaxf(m1, fabsf(b)); m2 = fmaxf(m2, fabsf(c)); m3 = fmaxf(m3, fabsf(d));
            T[(4 * nq + 0) * TP + k] = (bf16_t)f2bf(a); T[(4 * nq + 1) * TP + k] = (bf16_t)f2bf(b); T[(4 * nq + 2) * TP + k] = (bf16_t)f2bf(c); T[(4 * nq + 3) * TP + k] = (bf16_t)f2bf(d);
        }
    }
    __syncthreads();
    atomicMax(cmx + 4 * nq + 0, __float_as_uint(m0)); atomicMax(cmx + 4 * nq + 1, __float_as_uint(m1));
    atomicMax(cmx + 4 * nq + 2, __float_as_uint(m2)); atomicMax(cmx + 4 * nq + 3, __float_as_uint(m3));
    __syncthreads();
    const int n = tid >> 4, kc = tid & 15;
    const float cm = __uint_as_float(cmx[n]); const float inv = cm > 0.f ? 127.f / cm : 0.f;
    if (kc == 0) scl[n0 + n] = cm > 0.f ? cm * (1.f / 127.f) : 1.f;
#pragma unroll 4
    for (int s = 0; s < 16; ++s) {
        const int k = s * 128 + kc * 8;
        const u32x4 q = *(const u32x4*)(T + n * TP + k);
        u32x2 o;
        o.x = q8pack4(bflo(q.x), bfhi(q.x), bflo(q.y), bfhi(q.y), inv); o.y = q8pack4(bflo(q.z), bfhi(q.z), bflo(q.w), bfhi(q.w), inv);
        *(u32x2*)(W8 + (size_t)(n0 + n) * 2048 + k) = o;
    }
}
__device__ __forceinline__ void cvt_range(const float* src, bf16_t* dst, size_t n8, size_t gtid, size_t gthreads) {
    for (size_t i = gtid; i < n8; i += gthreads) {
        const f32x4 a = *(const f32x4*)(src + i * 8), b = *(const f32x4*)(src + i * 8 + 4);
        u32x4 o; o.x = pk2(a.x, a.y); o.y = pk2(a.z, a.w); o.z = pk2(b.x, b.y); o.w = pk2(b.z, b.w);
        *(u32x4*)(dst + i * 8) = o;
    }
}

#if GATHER_I8 && GATHER_4BIT
__device__ __forceinline__ void conv4_row(const f32x4 (&v)[8], const bool isv, unsigned char* drow, int lane) {
    float am = 0.f;
#pragma unroll
    for (int i = 0; i < 8; ++i) am = fmaxf(am, fmaxf(fmaxf(fabsf(v[i].x), fabsf(v[i].y)), fmaxf(fabsf(v[i].z), fabsf(v[i].w))));
    const float s0 = am > 0.f ? am * (isv ? (1.f / 6.f) : (1.f / 7.f)) : 1.f;
    const unsigned sb = (__float_as_uint(s0) + 0xffffu) >> 16;
    const float inv = 1.f / __uint_as_float(sb << 16);
    u32x4 o; unsigned w[4];
#pragma unroll
    for (int d = 0; d < 4; ++d) {
        const f32x4 a = v[2 * d], b = v[2 * d + 1];
        const float e[8] = {a.x * inv, a.y * inv, a.z * inv, a.w * inv, b.x * inv, b.y * inv, b.z * inv, b.w * inv};
        unsigned acc = 0u;
        if (isv) {
            acc = __builtin_amdgcn_cvt_scalef32_pk_fp4_f32(acc, e[0], e[1], 1.0f, 0);
            acc = __builtin_amdgcn_cvt_scalef32_pk_fp4_f32(acc, e[2], e[3], 1.0f, 1);
            acc = __builtin_amdgcn_cvt_scalef32_pk_fp4_f32(acc, e[4], e[5], 1.0f, 2);
            acc = __builtin_amdgcn_cvt_scalef32_pk_fp4_f32(acc, e[6], e[7], 1.0f, 3);
        } else {
#pragma unroll
            for (int i = 0; i < 8; ++i) {
                const int q = (int)fminf(fmaxf(rintf(e[i]), -7.f), 7.f);
                acc |= ((unsigned)q & 0xFu) << (8 * (i >> 1) + 4 * (i & 1));
            }
        }
        w[d] = acc;
    }
    o.x = w[0]; o.y = w[1]; o.z = w[2]; o.w = w[3];
    *(u32x4*)(drow + lane * 16) = o;
    *(unsigned short*)(drow + 1024 + lane * 2) = (unsigned short)sb;
}
#endif
#if GATHER_I8 && GATHER_4BIT
#ifndef TABLES_IN_GAPS
#define TABLES_IN_GAPS 1
#endif
__device__ __forceinline__ void conv4_tables(const Params& p, int r0, int r1, unsigned* ctr, unsigned char* lds) {
    const int tid = threadIdx.x, lane = tid & 63, wave = tid >> 6;
    unsigned char* ws = p.ws;
    volatile unsigned* shw = (volatile unsigned*)(lds + LDS_BYTES - 64);
    const int nchunk = (r1 - r0) / 64;
    for (int it = 0;; ++it) {
        int cbeg, cstep, cend;
        if (ctr) {
            __syncthreads();
            if (tid == 0) *shw = atomicAdd(ctr, 1u);
            __syncthreads();
            const int c = (int)*shw; if (c >= nchunk) break;
            cbeg = r0 + c * 64 + wave; cstep = NWAVES; cend = r0 + c * 64 + 64;
        } else {
            if (it > 0) break;
            cbeg = r0 + blockIdx.x * NWAVES + wave; cstep = gridDim.x * NWAVES; cend = r1;
        }
        for (int r = cbeg; r < cend; r += 2 * cstep) {
            const int r2 = r + cstep; const bool has2 = r2 < cend; const int rb = has2 ? r2 : r;
            const bool isvA = r >= 2 * NEXP, isvB = rb >= 2 * NEXP; const int rrA = isvA ? r - 2 * NEXP : r, rrB = isvB ? rb - 2 * NEXP : rb;
            const float* srowA = (isvA ? p.peer_v : p.peer_u) + (size_t)rrA * DM;
            const float* srowB = (isvB ? p.peer_v : p.peer_u) + (size_t)rrB * DM;
            f32x4 va[8], vb[8];
#pragma unroll
            for (int j = 0; j < 2; ++j)
#pragma unroll
                for (int k = 0; k < 4; ++k) { va[j * 4 + k] = *(const f32x4*)(srowA + j * 1024 + lane * 16 + k * 4); vb[j * 4 + k] = *(const f32x4*)(srowB + j * 1024 + lane * 16 + k * 4); }
            conv4_row(va, isvA, (unsigned char*)(ws + (isvA ? WS_VT : WS_UT)) + (size_t)rrA * ROW4, lane);
            if (has2) conv4_row(vb, isvB, (unsigned char*)(ws + (isvB ? WS_VT : WS_UT)) + (size_t)rrB * ROW4, lane);
        }
    }
}
#endif
__device__ __forceinline__ void ph_prologue(const Params& p, unsigned char* lds) {
    const int tid = threadIdx.x, lane = tid & 63, wave = tid >> 6;
    const int gw = blockIdx.x * NWAVES + wave, NGW = gridDim.x * NWAVES;
    unsigned char* ws = p.ws;
    {
        float* sT = (float*)lds;
        float* red = (float*)(lds + 2048 * 12 * 4);
        for (int i = tid; i < 2048 * 9; i += NTHREADS) {
            const int k = i / 9, bb = i % 9;
            const float v = bb < 8 ? p.c[bb * DM + k] : p.c_ctx[k];
            sT[k * 12 + bb] = silu(v);
        }
        __syncthreads();
        const int cq = lane & 7, ks = tid >> 3;
        for (int u = blockIdx.x; u < 768; u += gridDim.x) {
            const int l = u / 384, n0 = (u % 384) * 32;
            const float* W = p.w_ada + (size_t)l * DM * 12288 + n0 + cq * 4;
            float acc[9][4];
#pragma unroll
            for (int b = 0; b < 9; ++b)
#pragma unroll
                for (int j = 0; j < 4; ++j) acc[b][j] = 0.f;
#pragma unroll 8
            for (int i = 0; i < 32; ++i) {
                const int k = ks + 64 * i;
                const f32x4 w = *(const f32x4*)(W + (size_t)k * 12288);
                const f32x4 s0 = *(const f32x4*)(sT + k * 12), s1 = *(const f32x4*)(sT + k * 12 + 4);
                const float s8 = sT[k * 12 + 8];
                const float sv[9] = {s0.x, s0.y, s0.z, s0.w, s1.x, s1.y, s1.z, s1.w, s8};
#pragma unroll
                for (int b = 0; b < 9; ++b) { acc[b][0] += sv[b] * w.x; acc[b][1] += sv[b] * w.y; acc[b][2] += sv[b] * w.z; acc[b][3] += sv[b] * w.w; }
            }
#pragma unroll
            for (int b = 0; b < 9; ++b)
#pragma unroll
                for (int j = 0; j < 4; ++j) {
                    float v = acc[b][j];
                    v += __shfl_xor(v, 8); v += __shfl_xor(v, 16); v += __shfl_xor(v, 32);
                    acc[b][j] = v;
                }
            if (lane < 8) {
#pragma unroll
                for (int b = 0; b < 9; ++b)
#pragma unroll
                    for (int j = 0; j < 4; ++j) red[(wave * 8 + cq) * 36 + b * 4 + j] = acc[b][j];
            }
            __syncthreads();
            if (tid < 288) {
                const int b = tid / 32, col = tid % 32, q = col >> 2, j = col & 3;
                float s = 0.f;
#pragma unroll
                for (int w = 0; w < 8; ++w) s += red[(w * 8 + q) * 36 + b * 4 + j];
                const int n = n0 + col;
                ((float*)(ws + WS_MOD))[(size_t)(l * 9 + b) * 12288 + n] = s + p.b_ada[l * 12288 + n];
            }
            __syncthreads();
        }
    }
    __syncthreads();
#if GEMM_I8 && GEMM3_I8 && W8_ONEPASS
    {
        float* S = (float*)(ws + WS_SCL);
        constexpr int ST_IN = INW / 32, ST_SQ = DM / 32, ST_L = ST_IN + 2 * ST_SQ;
        for (int it = blockIdx.x; it < 2 * ST_L; it += gridDim.x) {
            const int l = it / ST_L; int r = it % ST_L;
            if (r < ST_IN) { w8_strip(p.w_in + (size_t)l * DM * INW, INW, r * 32, nullptr, (unsigned char*)(ws + WS_WIN) + (size_t)l * INW * DM, S + SCL_WIN + l * INW, lds); continue; }
            r -= ST_IN;
            if (r < ST_SQ) { w8_strip(p.w_out + (size_t)l * DM * DM, DM, r * 32, p.g_group + l * DM, (unsigned char*)(ws + WS_WOUT) + (size_t)l * DM * DM, S + SCL_WOUT + l * DM, lds); continue; }
            r -= ST_SQ;
            w8_strip(p.peer_wq + (size_t)l * DM * DM, DM, r * 32, nullptr, (unsigned char*)(ws + WS_WQ) + (size_t)l * DM * DM, S + SCL_WQ + l * DM, lds);
        }
        __syncthreads();
    }
#else
    {
        float* scr = (float*)(lds + wave * 8704);
        constexpr int I_IN = 32 * 112, I_SQ = 32 * 64, I_L = I_IN + 2 * I_SQ;
        unsigned* cm = (unsigned*)(ws + WS_CTL + CTL_COLMAX);
        for (int it = gw; it < 2 * I_L; it += NGW) {
            const int l = it / I_L; int r = it % I_L;
            if (r < I_IN) {
                if (GEMM_I8) colmax_item(p.w_in + (size_t)l * DM * INW, INW, nullptr, cm + l * NCM, r, lane);
                else transpose_item(p.w_in + (size_t)l * DM * INW, DM, INW, (bf16_t*)(ws + WS_WIN) + (size_t)l * INW * DM, nullptr, scr, r, lane);
                continue; }
            r -= I_IN;
            if (r < I_SQ) {
                if (GEMM_I8) colmax_item(p.w_out + (size_t)l * DM * DM, DM, p.g_group + l * DM, cm + l * NCM + INW, r, lane);
                else transpose_item(p.w_out + (size_t)l * DM * DM, DM, DM, (bf16_t*)(ws + WS_WOUT) + (size_t)l * DM * DM, p.g_group + l * DM, scr, r, lane);
                continue; }
            r -= I_SQ;
            if (GEMM_I8 && GEMM3_I8) colmax_item(p.peer_wq + (size_t)l * DM * DM, DM, nullptr, cm + l * NCM + INW + DM, r, lane);
            else transpose_item(p.peer_wq + (size_t)l * DM * DM, DM, DM, (bf16_t*)(ws + WS_WQ) + (size_t)l * DM * DM, nullptr, scr, r, lane);
        }
    }
#endif
    {
        const size_t gtid = (size_t)blockIdx.x * NTHREADS + tid, gth = (size_t)gridDim.x * NTHREADS;
        cvt_range(p.peer_keys, (bf16_t*)(ws + WS_KEYS), (size_t)2 * 8 * 2 * 128 * 128 / 8, gtid, gth);
        cvt_range(p.ws_c, (bf16_t*)(ws + WS_WSC), (size_t)2 * 4 * 128 * 128 / 8, gtid, gth);
#if GATHER_I8 && GATHER_4BIT
        if (!TABLES_IN_GAPS) conv4_tables(p, 0, 4 * NEXP, nullptr, lds);
#elif GATHER_I8
        for (int r = gw; r < 4 * NEXP; r += NGW) {
            const bool isv = r >= 2 * NEXP; const int rr = isv ? r - 2 * NEXP : r;
            const float* srow = (isv ? p.peer_v : p.peer_u) + (size_t)rr * DM;
            f32x4 v[8]; float am = 0.f;
#pragma unroll
            for (int j = 0; j < 2; ++j)
#pragma unroll
                for (int k = 0; k < 4; ++k) {
                    v[j * 4 + k] = *(const f32x4*)(srow + j * 1024 + lane * 16 + k * 4);
                    am = fmaxf(am, fmaxf(fmaxf(fabsf(v[j * 4 + k].x), fabsf(v[j * 4 + k].y)), fmaxf(fabsf(v[j * 4 + k].z), fabsf(v[j * 4 + k].w))));
                }
            am = wave_max(am);
            const float s = am > 0.f ? am * (isv ? (1.f / 443.f) : (1.f / 127.f)) : 1.f, inv = 1.f / s;
            unsigned char* drow = (unsigned char*)(ws + (isv ? WS_VT : WS_UT)) + (size_t)rr * DM;
#pragma unroll
            for (int j = 0; j < 2; ++j) {
                u32x4 o; unsigned w[4];
#pragma unroll
                for (int k = 0; k < 4; ++k) {
                    const f32x4 a = v[j * 4 + k];
                    if (isv) {
                        int pk = __builtin_amdgcn_cvt_pk_fp8_f32(a.x * inv, a.y * inv, 0, false);
                        pk = __builtin_amdgcn_cvt_pk_fp8_f32(a.z * inv, a.w * inv, pk, true);
                        w[k] = (unsigned)pk;
                    } else {
                        const int q0 = (int)rintf(a.x * inv), q1 = (int)rintf(a.y * inv), q2 = (int)rintf(a.z * inv), q3 = (int)rintf(a.w * inv);
                        w[k] = ((unsigned)q0 & 0xffu) | (((unsigned)q1 & 0xffu) << 8) | (((unsigned)q2 & 0xffu) << 16) | ((unsigned)q3 << 24);
                    }
                }
                o.x = w[0]; o.y = w[1]; o.z = w[2]; o.w = w[3];
                *(u32x4*)(drow + j * 1024 + lane * 16) = o;
            }
            if (lane == 0) ((float*)(ws + (isv ? WS_VSC : WS_USC)))[rr] = s;
        }
#else
        cvt_range(p.peer_u, (bf16_t*)(ws + WS_UT), (size_t)2 * NEXP * DM / 8, gtid, gth);
        cvt_range(p.peer_v, (bf16_t*)(ws + WS_VT), (size_t)2 * NEXP * DM / 8, gtid, gth);
#endif
        float* rope = (float*)(ws + WS_ROPE);
        for (size_t i = gtid; i < (size_t)2048 * 64; i += gth) {
            const int t = (int)(i >> 6), f = (int)(i & 63), fi = f & 31;
            const float pos = (f < 32) ? (float)(t >> 6) : (float)(t & 63);
            const float inv = powf(10000.0f, -(float)fi / 32.0f);
            const float ang = pos * inv;
            rope[i * 2] = cosf(ang); rope[i * 2 + 1] = sinf(ang);
        }
    }
}


__device__ __forceinline__ void modulate_store(const f32x4 (&v)[8], float rstd, const float* g, const float* shift, const float* scale, bf16_t* dst, int lane) {
#pragma unroll
    for (int j = 0; j < 8; ++j) {
        const int col = j * 256 + lane * 4;
        const f32x4 gg = *(const f32x4*)(g + col), sc = *(const f32x4*)(scale + col), sh = *(const f32x4*)(shift + col);
        const f32x4 o = v[j] * rstd * gg * (1.f + sc) + sh;
        u32x2 w; w.x = pk2(o.x, o.y); w.y = pk2(o.z, o.w);
        *(u32x2*)(dst + col) = w;
    }
}
__device__ __forceinline__ void modulate_store_i8(const f32x4 (&v)[8], float rstd, const float* g, const float* shift, const float* scale, unsigned char* dst, float* sdst, int lane, const float levels) {
    f32x4 o[8]; float am = 0.f;
#pragma unroll
    for (int j = 0; j < 8; ++j) {
        const int col = j * 256 + lane * 4;
        const f32x4 gg = *(const f32x4*)(g + col), sc = *(const f32x4*)(scale + col), sh = *(const f32x4*)(shift + col);
        o[j] = v[j] * rstd * gg * (1.f + sc) + sh;
        am = fmaxf(am, fmaxf(fmaxf(fabsf(o[j].x), fabsf(o[j].y)), fmaxf(fabsf(o[j].z), fabsf(o[j].w))));
    }
    am = wave_max(am);
    const float s = am > 0.f ? am / levels : 1.f, inv = 1.f / s;
#pragma unroll
    for (int j = 0; j < 8; ++j) *(unsigned*)(dst + j * 256 + lane * 4) = q8pack4(o[j].x, o[j].y, o[j].z, o[j].w, inv);
    if (lane == 0) *sdst = s;
}
__device__ __forceinline__ void ph_modulate(const Params& p, int l, int which) {
    const int tid = threadIdx.x, lane = tid & 63, wave = tid >> 6;
    const int gw = blockIdx.x * NWAVES + wave, NGW = gridDim.x * NWAVES;
    const int nrows = (which == 1 && l == DEPTH - 1) ? NLAT : MTOT;
    const float* g = (which == 0 ? p.norm1_g : p.norm2_g) + l * DM;
    const float* mod = (const float*)(p.ws + WS_MOD) + (size_t)l * 9 * 12288;
    const float* srcLat = (which == 0 && l == 0) ? p.x : p.out;
    const float* srcCtx = (which == 0 && l == 0) ? p.ctx : (const float*)(p.ws + WS_HC);
    bf16_t* XN = (bf16_t*)(p.ws + WS_XN);
    const int moff = (which == 0 ? 0 : 3) * DM;
#pragma unroll 1
    for (int r = gw; r < nrows; r += 2 * NGW) {
        const int r2 = r + NGW; const bool has2 = r2 < nrows; const int rb = has2 ? r2 : r;
        const float* srcA = r < NLAT ? srcLat + (size_t)r * DM : srcCtx + (size_t)(r - NLAT) * DM;
        const float* srcB = rb < NLAT ? srcLat + (size_t)rb * DM : srcCtx + (size_t)(rb - NLAT) * DM;
        f32x4 va[8], vb[8]; float sa = 0.f, sb = 0.f;
        if (H_BF16 && GEMM_I8 && GEMM3_I8 && which == 1) {
            const bf16_t* HB = (const bf16_t*)(p.ws + WS_HB);
#pragma unroll
            for (int j = 0; j < 8; ++j) {
                const u32x2 ra = *(const u32x2*)(HB + (size_t)r * DM + j * 256 + lane * 4), rb2 = *(const u32x2*)(HB + (size_t)rb * DM + j * 256 + lane * 4);
                va[j] = (f32x4){bflo(ra.x), bfhi(ra.x), bflo(ra.y), bfhi(ra.y)}; vb[j] = (f32x4){bflo(rb2.x), bfhi(rb2.x), bflo(rb2.y), bfhi(rb2.y)};
            }
        } else {
#pragma unroll
        for (int j = 0; j < 8; ++j) { va[j] = *(const f32x4*)(srcA + j * 256 + lane * 4); vb[j] = *(const f32x4*)(srcB + j * 256 + lane * 4); }
        }
#pragma unroll
        for (int j = 0; j < 8; ++j) { sa += va[j].x * va[j].x + va[j].y * va[j].y + va[j].z * va[j].z + va[j].w * va[j].w; sb += vb[j].x * vb[j].x + vb[j].y * vb[j].y + vb[j].z * vb[j].z + vb[j].w * vb[j].w; }
        sa = wave_sum(sa); sb = wave_sum(sb);
        const float* shA = mod + (size_t)(r < NLAT ? (r >> 11) : 8) * 12288 + moff;
        const bool i8 = GEMM_I8 && (which == 0 || GEMM3_I8); const float lv = which == 0 ? 127.f : 119.f;
        unsigned char* XN8 = (unsigned char*)(p.ws + WS_XN8); float* SXN = (float*)(p.ws + WS_SCL) + SCL_XN;
        if (i8) modulate_store_i8(va, rsqrtf(sa * (1.f / DM) + EPS), g, shA, shA + DM, XN8 + (size_t)r * DM, SXN + r, lane, lv);
        else modulate_store(va, rsqrtf(sa * (1.f / DM) + EPS), g, shA, shA + DM, XN + (size_t)r * DM, lane);
        if (has2) {
            const float* shB = mod + (size_t)(r2 < NLAT ? (r2 >> 11) : 8) * 12288 + moff;
            if (i8) modulate_store_i8(vb, rsqrtf(sb * (1.f / DM) + EPS), g, shB, shB + DM, XN8 + (size_t)r2 * DM, SXN + r2, lane, lv);
            else modulate_store(vb, rsqrtf(sb * (1.f / DM) + EPS), g, shB, shB + DM, XN + (size_t)r2 * DM, lane);
        }
    }
}

struct EpiBf16Store {
    bf16_t* O; int ldc;
    __device__ __forceinline__ void operator()(int row, int col, const float* a) const {
        u32x4 w; w.x = pk2(a[0], a[1]); w.y = pk2(a[2], a[3]); w.z = pk2(a[4], a[5]); w.w = pk2(a[6], a[7]);
        *(u32x4*)(O + (size_t)row * ldc + col) = w;
    }
};
struct EpiResGate {
    const float *resLat, *resCtx; float *outLat, *outCtx; const float* gate;
    __device__ __forceinline__ void operator()(int row, int col, const float* a) const {
        const int bb = row < NLAT ? (row >> 11) : 8;
        const float* gp = gate + (size_t)bb * 12288 + col;
        const float* rp = row < NLAT ? resLat + (size_t)row * DM + col : resCtx + (size_t)(row - NLAT) * DM + col;
        float* op = row < NLAT ? outLat + (size_t)row * DM + col : outCtx + (size_t)(row - NLAT) * DM + col;
        const f32x4 g0 = *(const f32x4*)gp, g1 = *(const f32x4*)(gp + 4), r0 = *(const f32x4*)rp, r1 = *(const f32x4*)(rp + 4);
        f32x4 o0, o1;
        o0.x = r0.x + g0.x * a[0]; o0.y = r0.y + g0.y * a[1]; o0.z = r0.z + g0.z * a[2]; o0.w = r0.w + g0.w * a[3];
        o1.x = r1.x + g1.x * a[4]; o1.y = r1.y + g1.y * a[5]; o1.z = r1.z + g1.z * a[6]; o1.w = r1.w + g1.w * a[7];
        *(f32x4*)op = o0; *(f32x4*)(op + 4) = o1;
    }
};
template <class Epi>
__device__ __forceinline__ void gemm_naive(unsigned char* lds, const bf16_t* A, const bf16_t* Bt, int M, int N, int K, const Epi& E) {
    float* As = (float*)lds;
    float* Bs = As + 32 * 132;
    const int tid = threadIdx.x, tx = tid & 15, ty = tid >> 4;
    const int lrow = tid >> 2, lkc = (tid & 3) * 8;
    const int nM = M / 128, nN = N / 128;
    for (int u = blockIdx.x; u < nM * nN; u += gridDim.x) {
        const int pm = u / nN, pn = u % nN, m0 = pm * 128, n0 = pn * 128;
        float acc[4][8];
#pragma unroll
        for (int i = 0; i < 4; ++i)
#pragma unroll
            for (int j = 0; j < 8; ++j) acc[i][j] = 0.f;
        for (int k0 = 0; k0 < K; k0 += 32) {
            const u32x4 av = *(const u32x4*)(A + (size_t)(m0 + lrow) * K + k0 + lkc);
            const u32x4 bv = *(const u32x4*)(Bt + (size_t)(n0 + lrow) * K + k0 + lkc);
            __syncthreads();
            As[(lkc + 0) * 132 + lrow] = bflo(av.x); As[(lkc + 1) * 132 + lrow] = bfhi(av.x);
            As[(lkc + 2) * 132 + lrow] = bflo(av.y); As[(lkc + 3) * 132 + lrow] = bfhi(av.y);
            As[(lkc + 4) * 132 + lrow] = bflo(av.z); As[(lkc + 5) * 132 + lrow] = bfhi(av.z);
            As[(lkc + 6) * 132 + lrow] = bflo(av.w); As[(lkc + 7) * 132 + lrow] = bfhi(av.w);
            Bs[(lkc + 0) * 132 + lrow] = bflo(bv.x); Bs[(lkc + 1) * 132 + lrow] = bfhi(bv.x);
            Bs[(lkc + 2) * 132 + lrow] = bflo(bv.y); Bs[(lkc + 3) * 132 + lrow] = bfhi(bv.y);
            Bs[(lkc + 4) * 132 + lrow] = bflo(bv.z); Bs[(lkc + 5) * 132 + lrow] = bfhi(bv.z);
            Bs[(lkc + 6) * 132 + lrow] = bflo(bv.w); Bs[(lkc + 7) * 132 + lrow] = bfhi(bv.w);
            __syncthreads();
#pragma unroll 8
            for (int k = 0; k < 32; ++k) {
                const f32x4 a = *(const f32x4*)(As + k * 132 + ty * 4);
                const f32x4 b0 = *(const f32x4*)(Bs + k * 132 + tx * 8), b1 = *(const f32x4*)(Bs + k * 132 + tx * 8 + 4);
                const float av4[4] = {a.x, a.y, a.z, a.w};
                const float bv8[8] = {b0.x, b0.y, b0.z, b0.w, b1.x, b1.y, b1.z, b1.w};
#pragma unroll
                for (int i = 0; i < 4; ++i)
#pragma unroll
                    for (int j = 0; j < 8; ++j) acc[i][j] += av4[i] * bv8[j];
            }
        }
#pragma unroll
        for (int i = 0; i < 4; ++i) E(m0 + ty * 4 + i, n0 + tx * 8, acc[i]);
    }
}

namespace pg8 {
#define PG8_LAS __attribute__((address_space(3)))
typedef unsigned short bf16_t;
typedef short bf16x8 __attribute__((ext_vector_type(8)));
typedef float f32x4 __attribute__((ext_vector_type(4)));
typedef unsigned u32x4 __attribute__((ext_vector_type(4)));
constexpr int BM = 256, BK = 64, HALF = 128, HTB = HALF * BK * 2  , STAGE_BYTES = 8 * HTB, NXCD = 8, WGM = 8;

__host__ __device__ __forceinline__ int lds_byte(int r, int c) { const int st = (r >> 4) * 2 + (c >> 5), rr = r & 15, cc = c & 31, ob = rr * 64 + cc * 2; return st * 1024 + (ob ^ (((ob >> 9) & 1) << 5)); }
__host__ __device__ __forceinline__ void stage_rc(int b, int& R, int& C) { const int st = b / 1024, sb = b % 1024, swz = sb ^ (((sb >> 9) & 1) << 5); R = (st >> 1) * 16 + swz / 64; C = (st & 1) * 32 + (swz % 64) / 2; }
__host__ __device__ __forceinline__ int perm32(int rho) { const int n = rho >> 4, i = rho & 15; return 8 * (i >> 2) + 4 * n + (i & 3); }

struct Unit { int pm, pn; };
struct Gemm { const bf16_t* A; const bf16_t* Bt; int M, N, K; };

struct StaticOrder {
    int nM, nN, nwg, G, c;
    __host__ __device__ void init(int M, int N, int G_, int c_) { nM = M / BM; nN = N / BM; nwg = nM * nN; G = G_; c = c_; }
    __host__ __device__ bool next(int i, Unit& u) const {
        const long L = (long)i * G + c; if (L >= nwg) return false;
        int wgid = (int)L; { const int q = nwg / NXCD, r = nwg % NXCD, xcd = wgid % NXCD, off = wgid / NXCD; wgid = (xcd < r ? xcd * (q + 1) : r * (q + 1) + (xcd - r) * q) + off; }
        const int nig = WGM * nN, gid = wgid / nig, fm = gid * WGM, gsz = (nM - fm) < WGM ? (nM - fm) : WGM;
        u.pm = fm + ((wgid % nig) % gsz); u.pn = (wgid % nig) / gsz; return true;
    }
    __device__ __forceinline__ void a_ready(const Unit&) const {}
    __device__ __forceinline__ void done(const Unit&) const {}
};

__device__ __forceinline__ unsigned cvt_pk_bf16(float lo, float hi) { unsigned r; asm volatile("v_cvt_pk_bf16_f32 %0, %1, %2" : "=v"(r) : "v"(lo), "v"(hi)); return r; }
typedef float f32x2 __attribute__((ext_vector_type(2)));
__device__ __forceinline__ f32x2 gelu_pk(f32x2 v) {
    const f32x2 av = __builtin_elementwise_abs(v), d = av * 0.2316418882f + 1.0f;
    f32x2 t; t.x = __builtin_amdgcn_rcpf(d.x); t.y = __builtin_amdgcn_rcpf(d.y);
    f32x2 q = t * 0.5307027145f + (-0.7265760135f); q = q * t + 0.7107068705f; q = q * t + (-0.142248368f); q = q * t + 0.127414796f; q = q * t;
    const f32x2 s = (v * v) * (-0.72134752044f);
    f32x2 e; e.x = __builtin_amdgcn_exp2f(s.x); e.y = __builtin_amdgcn_exp2f(s.y);
    const f32x2 m = v * (q * e), r = v - m;
    f32x2 o; o.x = v.x < 0.f ? m.x : r.x; o.y = v.y < 0.f ? m.y : r.y; return o;
}

template <int ACT  > struct EpiBf16 {
    static constexpr bool PERM = true, AFTER_DRAIN = false; static_assert(ACT == 0 || ACT == 1, "EpiBf16: ACT is 0 (none) or 1 (gelu_pk)");
    bf16_t* O; int ldc; const float* bias; int split_cols; size_t split_stride; float scale0;
    __device__ __forceinline__ void operator()(const f32x4 (&acc)[2][2][4][2], const Unit& u, int wr, int wc, int fr, int fq) const {
        const int row0 = u.pm * BM + wr * 64 + fr; int colt = u.pn * BM; bf16_t* base = O;
        float sc = 1.f; if (split_cols) { const int t = colt / split_cols; base += (size_t)t * split_stride; colt -= t * split_cols; if (t == 0) sc = scale0; }
        const int col0 = colt + wc * 32 + 8 * fq, bcol0 = u.pn * BM + wc * 32 + 8 * fq;
        f32x4 bv[2][2];
#pragma unroll
        for (int bj = 0; bj < 2; ++bj)
#pragma unroll
            for (int n = 0; n < 2; ++n) bv[bj][n] = bias ? *(const f32x4*)(bias + bcol0 + bj * HALF + 4 * n) : (f32x4){0.f, 0.f, 0.f, 0.f};
#pragma unroll
        for (int ai = 0; ai < 2; ++ai)
#pragma unroll
            for (int m = 0; m < 4; ++m) { bf16_t* rowp = base + (size_t)(row0 + ai * HALF + m * 16) * ldc + col0;
#pragma unroll
                for (int bj = 0; bj < 2; ++bj) { f32x4 v0 = acc[ai][bj][m][0] + bv[bj][0], v1 = acc[ai][bj][m][1] + bv[bj][1];
                    if (ACT == 1) { f32x2 a = gelu_pk((f32x2){v0[0], v0[1]}), b = gelu_pk((f32x2){v0[2], v0[3]}), c = gelu_pk((f32x2){v1[0], v1[1]}), d = gelu_pk((f32x2){v1[2], v1[3]});
                        v0 = (f32x4){a.x, a.y, b.x, b.y}; v1 = (f32x4){c.x, c.y, d.x, d.y}; }
                    v0 = v0 * sc; v1 = v1 * sc; u32x4 w; w.x = cvt_pk_bf16(v0[0], v0[1]); w.y = cvt_pk_bf16(v0[2], v0[3]); w.z = cvt_pk_bf16(v1[0], v1[1]); w.w = cvt_pk_bf16(v1[2], v1[3]);
                    *(u32x4*)(rowp + bj * HALF) = w; } }
    }
};
typedef int i32x4 __attribute__((ext_vector_type(4)));
template <bool I8> struct AccSel { typedef f32x4 type; };
template <> struct AccSel<true> { typedef i32x4 type; };
template <class Epi, class Sched, bool ALIGN_EPI = false, bool SP2 = false, bool I8 = false>
__device__ __forceinline__ void gemm_phase(PG8_LAS unsigned char* lds, const Gemm g, const Sched& S, const Epi& E) {
    const int tid = threadIdx.x, wid = __builtin_amdgcn_readfirstlane(tid >> 6), lane = tid & 63, wr = wid >> 2, wc = wid & 3, fr = lane & 15, fq = lane >> 4;
    const int K = g.K, nt = K / BK;
    unsigned voffA[2], voffB[2];
#pragma unroll
    for (int i = 0; i < 2; ++i) { int R, C; stage_rc(tid * 16 + i * 8192, R, C); const int Rb = Epi::PERM ? ((R & ~31) + perm32(R & 31)) : R;
        voffA[i] = (unsigned)(R * K + C) * 2u; voffB[i] = (unsigned)(Rb * K + C) * 2u; }
    const size_t kstep = (size_t)(BK * 2);
    const size_t hstep = (size_t)HALF * K * 2;
    const size_t tstep = 2 * hstep;
    const unsigned ldsw = (unsigned)wid * 1024u;
    const int aoff = lds_byte(wr * 64 + fr, fq * 8), boff = lds_byte(wc * 32 + fr, fq * 8);
#define PG8_SA(b, h) (((b) * 2 + (h)) * HTB)
#define PG8_SB(b, h) ((4 + (b) * 2 + (h)) * HTB)
#define PG8_STAGE(bufoff, gbase, voff) do { _Pragma("unroll") for (int _i = 0; _i < 2; ++_i) \
        __builtin_amdgcn_global_load_lds((const unsigned*)((const char*)(gbase) + (voff)[_i]), (PG8_LAS unsigned*)(lds + (bufoff) + ldsw + _i * 8192), 16, 0, 0); } while (0)
#define PG8_LDA(dst, b, h) do { _Pragma("unroll") for (int m = 0; m < 4; ++m) _Pragma("unroll") for (int k = 0; k < 2; ++k) dst[m][k] = *(const PG8_LAS bf16x8*)(lds + PG8_SA(b, h) + aoff + m * 2048 + k * 1024); } while (0)
#define PG8_LDB(dst, b, h) do { _Pragma("unroll") for (int n = 0; n < 2; ++n) _Pragma("unroll") for (int k = 0; k < 2; ++k) dst[n][k] = *(const PG8_LAS bf16x8*)(lds + PG8_SB(b, h) + boff + n * 2048 + k * 1024); } while (0)
#define PG8_MMA(ai, bj, At, Bt) do { __builtin_amdgcn_s_setprio(1); _Pragma("unroll") for (int m = 0; m < 4; ++m) _Pragma("unroll") for (int n = 0; n < 2; ++n) _Pragma("unroll") for (int k = 0; k < 2; ++k) \
        { if constexpr (I8) acc[ai][bj][m][n] = __builtin_amdgcn_mfma_i32_16x16x64_i8(__builtin_bit_cast(i32x4, Bt[n][k]), __builtin_bit_cast(i32x4, At[m][k]), acc[ai][bj][m][n], 0, 0, 0); \
          else acc[ai][bj][m][n] = __builtin_amdgcn_mfma_f32_16x16x32_bf16(Bt[n][k], At[m][k], acc[ai][bj][m][n], 0, 0, 0); } __builtin_amdgcn_s_setprio(0); } while (0)
#define PG8_WAIT_V(n) asm volatile("s_waitcnt vmcnt(" #n ")" ::: "memory")
#define PG8_WAIT_L(n) asm volatile("s_waitcnt lgkmcnt(" #n ")" ::: "memory")
#define PG8_BAR __builtin_amdgcn_s_barrier()
#define PG8_SCHED __builtin_amdgcn_sched_barrier(0)
    Unit cur, nxt; int ui = 0;
    if (!S.next(0, cur)) return;
    typedef typename AccSel<I8>::type acc_t; const acc_t zero_ = {};
    acc_t acc[2][2][4][2];
#pragma unroll
    for (int a = 0; a < 2; ++a)
#pragma unroll
        for (int b = 0; b < 2; ++b)
#pragma unroll
            for (int m = 0; m < 4; ++m)
#pragma unroll
                for (int n = 0; n < 2; ++n) acc[a][b][m][n] = zero_;
    bf16x8 At[4][2], B0[2][2], B1[2][2];
    const char* cA = (const char*)g.A + (size_t)cur.pm * tstep; const char* cB = (const char*)g.Bt + (size_t)cur.pn * tstep;
    S.a_ready(cur);
    if constexpr (SP2) {
        PG8_STAGE(PG8_SB(0, 0), cB, voffB); PG8_STAGE(PG8_SB(0, 1), cB + hstep, voffB); PG8_STAGE(PG8_SA(0, 0), cA, voffA); PG8_STAGE(PG8_SA(0, 1), cA + hstep, voffA);
        if (wr == 1) PG8_BAR;
        PG8_WAIT_V(2); PG8_BAR;
        PG8_STAGE(PG8_SB(1, 0), cB + kstep, voffB); PG8_STAGE(PG8_SA(1, 0), cA + kstep, voffA); PG8_STAGE(PG8_SB(1, 1), cB + hstep + kstep, voffB);
        PG8_WAIT_V(6); PG8_BAR;
    } else {
        PG8_STAGE(PG8_SB(0, 0), cB, voffB); PG8_STAGE(PG8_SA(0, 0), cA, voffA); PG8_STAGE(PG8_SB(0, 1), cB + hstep, voffB); PG8_STAGE(PG8_SA(0, 1), cA + hstep, voffA);
        if (wr == 1) PG8_BAR;
        PG8_WAIT_V(4); PG8_BAR;
        PG8_STAGE(PG8_SB(1, 0), cB + kstep, voffB); PG8_STAGE(PG8_SA(1, 0), cA + kstep, voffA); PG8_STAGE(PG8_SB(1, 1), cB + hstep + kstep, voffB);
        PG8_WAIT_V(6); PG8_BAR;
    }
    for (;;) {
        const bool has_next = S.next(ui + 1, nxt);
        const char* nA = has_next ? (const char*)g.A + (size_t)nxt.pm * tstep : cA; const char* nB = has_next ? (const char*)g.Bt + (size_t)nxt.pn * tstep : cB;
        for (int t = 0; t < nt; t += 2) {
            const bool last = (t == nt - 2);
            const char* a1 = cA + (size_t)(t + 1) * kstep;
            const char* a2 = last ? nA : cA + (size_t)(t + 2) * kstep; const char* b2 = last ? nB : cB + (size_t)(t + 2) * kstep;
            const char* a3 = a2 + kstep; const char* b3 = b2 + kstep;
            if (last && has_next) S.a_ready(nxt);
            if constexpr (SP2) {
            PG8_LDB(B0, 0, 0); PG8_LDB(B1, 0, 1); PG8_SCHED; PG8_LDA(At, 0, 0); PG8_STAGE(PG8_SA(1, 1), a1 + hstep, voffA);
            PG8_WAIT_V(8); PG8_WAIT_L(0); PG8_BAR; PG8_MMA(0, 0, At, B0); PG8_MMA(0, 1, At, B1); PG8_BAR; PG8_SCHED;
            PG8_LDA(At, 0, 1); PG8_STAGE(PG8_SB(0, 0), b2, voffB); PG8_STAGE(PG8_SB(0, 1), b2 + hstep, voffB); PG8_STAGE(PG8_SA(0, 0), a2, voffA);
            PG8_WAIT_V(8); PG8_WAIT_L(0); PG8_BAR; PG8_MMA(1, 0, At, B0); PG8_MMA(1, 1, At, B1); PG8_BAR; PG8_SCHED;
            PG8_LDB(B0, 1, 0); PG8_LDB(B1, 1, 1); PG8_SCHED; PG8_LDA(At, 1, 0); PG8_STAGE(PG8_SA(0, 1), a2 + hstep, voffA);
            PG8_WAIT_V(8); PG8_WAIT_L(0); PG8_BAR; PG8_MMA(0, 0, At, B0); PG8_MMA(0, 1, At, B1); PG8_BAR; PG8_SCHED;
            PG8_LDA(At, 1, 1); PG8_STAGE(PG8_SB(1, 0), b3, voffB); PG8_STAGE(PG8_SB(1, 1), b3 + hstep, voffB); PG8_STAGE(PG8_SA(1, 0), a3, voffA);
            PG8_WAIT_V(8); PG8_WAIT_L(0); PG8_BAR; PG8_MMA(1, 0, At, B0); PG8_MMA(1, 1, At, B1); PG8_BAR; PG8_SCHED;
            } else {
            PG8_LDB(B0, 0, 0); PG8_SCHED; PG8_LDA(At, 0, 0); PG8_STAGE(PG8_SA(1, 1), a1 + hstep, voffA);
            PG8_WAIT_L(8); PG8_BAR; PG8_WAIT_L(0); PG8_MMA(0, 0, At, B0); PG8_BAR; PG8_SCHED;
            PG8_LDB(B1, 0, 1); PG8_STAGE(PG8_SB(0, 0), b2, voffB);
            PG8_BAR; PG8_WAIT_L(0); PG8_MMA(0, 1, At, B1); PG8_BAR;
            PG8_LDA(At, 0, 1); PG8_STAGE(PG8_SA(0, 0), a2, voffA);
            PG8_BAR; PG8_WAIT_L(0); PG8_MMA(1, 0, At, B0); PG8_BAR; PG8_SCHED;
            PG8_STAGE(PG8_SB(0, 1), b2 + hstep, voffB);
            PG8_WAIT_V(6); PG8_BAR; PG8_MMA(1, 1, At, B1); PG8_BAR;
            PG8_LDB(B0, 1, 0); PG8_SCHED; PG8_LDA(At, 1, 0); PG8_STAGE(PG8_SA(0, 1), a2 + hstep, voffA);
            PG8_WAIT_L(8); PG8_BAR; PG8_WAIT_L(0); PG8_MMA(0, 0, At, B0); PG8_BAR; PG8_SCHED;
            PG8_LDB(B1, 1, 1); PG8_STAGE(PG8_SB(1, 0), b3, voffB);
            PG8_BAR; PG8_WAIT_L(0); PG8_MMA(0, 1, At, B1); PG8_BAR;
            PG8_LDA(At, 1, 1); PG8_STAGE(PG8_SA(1, 0), a3, voffA);
            PG8_BAR; PG8_WAIT_L(0); PG8_MMA(1, 0, At, B0); PG8_BAR; PG8_SCHED;
            PG8_STAGE(PG8_SB(1, 1), b3 + hstep, voffB);
            PG8_WAIT_V(6); PG8_BAR; PG8_MMA(1, 1, At, B1); PG8_BAR;
            }
        }
        if constexpr (ALIGN_EPI) { if (wr == 0) PG8_BAR; }
        if constexpr (!Epi::AFTER_DRAIN) { E(acc, cur, wr, wc, fr, fq); S.done(cur); }
        if (!has_next) break;
#pragma unroll
        for (int a = 0; a < 2; ++a)
#pragma unroll
            for (int b = 0; b < 2; ++b)
#pragma unroll
                for (int m = 0; m < 4; ++m)
#pragma unroll
                    for (int n = 0; n < 2; ++n) acc[a][b][m][n] = zero_;
        cur = nxt; cA = nA; cB = nB; ++ui;
        if constexpr (ALIGN_EPI) { if (wr == 1) PG8_BAR; }
    }
    PG8_WAIT_V(0);
    if constexpr (!ALIGN_EPI) { if (wr == 0) PG8_BAR; }
    PG8_BAR;
    if constexpr (Epi::AFTER_DRAIN) { E.fused(acc, cur, wr, wc, fr, fq, lds, wid, lane); S.done(cur); }
#undef PG8_SA
#undef PG8_SB
#undef PG8_STAGE
#undef PG8_LDA
#undef PG8_LDB
#undef PG8_MMA
#undef PG8_WAIT_V
#undef PG8_WAIT_L
#undef PG8_BAR
#undef PG8_SCHED
}

struct EpiResGateT {
    static constexpr bool PERM = false, AFTER_DRAIN = false;
    const float *resLat, *resCtx; float *outLat, *outCtx; const float* gate;
    __device__ __forceinline__ void operator()(const f32x4 (&acc)[2][2][4][2], const Unit& u, int wr, int wc, int fr, int fq) const {
        const int trow = u.pm * BM, row0 = trow + wr * 64 + fr, col0 = u.pn * BM + wc * 32 + 4 * fq;
        const bool lat = trow < 16384;
        const int bb = lat ? (trow >> 11) : 8;
        const float* rbase = lat ? resLat + (size_t)row0 * 2048 : resCtx + (size_t)(row0 - 16384) * 2048;
        float* obase = lat ? outLat + (size_t)row0 * 2048 : outCtx + (size_t)(row0 - 16384) * 2048;
        f32x4 gv[2][2];
#pragma unroll
        for (int bj = 0; bj < 2; ++bj)
#pragma unroll
            for (int n = 0; n < 2; ++n) gv[bj][n] = *(const f32x4*)(gate + (size_t)bb * 12288 + col0 + bj * HALF + n * 16);
#pragma unroll
        for (int ai = 0; ai < 2; ++ai)
#pragma unroll
            for (int m = 0; m < 4; ++m) {
                const size_t off = (size_t)(ai * HALF + m * 16) * 2048 + col0;
#pragma unroll
                for (int bj = 0; bj < 2; ++bj)
#pragma unroll
                    for (int n = 0; n < 2; ++n) {
                        const f32x4 r = *(const f32x4*)(rbase + off + bj * HALF + n * 16);
                        *(f32x4*)(obase + off + bj * HALF + n * 16) = r + gv[bj][n] * acc[ai][bj][m][n];
                    }
            }
    }
};

struct EpiBf16I8 {
    static constexpr bool PERM = true, AFTER_DRAIN = false;
    bf16_t* O; int ldc; const float* sa; const float* sb;
    __device__ __forceinline__ void operator()(const i32x4 (&acc)[2][2][4][2], const Unit& u, int wr, int wc, int fr, int fq) const {
        const int row0 = u.pm * BM + wr * 64 + fr, col0 = u.pn * BM + wc * 32 + 8 * fq;
        f32x4 sv[2][2];
#pragma unroll
        for (int bj = 0; bj < 2; ++bj)
#pragma unroll
            for (int n = 0; n < 2; ++n) sv[bj][n] = *(const f32x4*)(sb + col0 + bj * HALF + 4 * n);
#pragma unroll
        for (int ai = 0; ai < 2; ++ai)
#pragma unroll
            for (int m = 0; m < 4; ++m) {
                const int row = row0 + ai * HALF + m * 16; const float s = sa[row];
                bf16_t* rowp = O + (size_t)row * ldc + col0;
#pragma unroll
                for (int bj = 0; bj < 2; ++bj) {
                    const i32x4 a0 = acc[ai][bj][m][0], a1 = acc[ai][bj][m][1];
                    const f32x4 v0 = (f32x4){(float)a0.x, (float)a0.y, (float)a0.z, (float)a0.w} * s * sv[bj][0];
                    const f32x4 v1 = (f32x4){(float)a1.x, (float)a1.y, (float)a1.z, (float)a1.w} * s * sv[bj][1];
                    u32x4 w; w.x = cvt_pk_bf16(v0[0], v0[1]); w.y = cvt_pk_bf16(v0[2], v0[3]); w.z = cvt_pk_bf16(v1[0], v1[1]); w.w = cvt_pk_bf16(v1[2], v1[3]);
                    *(u32x4*)(rowp + bj * HALF) = w;
                }
            }
    }
};
struct EpiResGateI8 {
    static constexpr bool PERM = false, AFTER_DRAIN = false;
    const float *resLat, *resCtx; float *outLat, *outCtx; const float* gate; const float* sa; const float* sb;
    __device__ __forceinline__ void operator()(const i32x4 (&acc)[2][2][4][2], const Unit& u, int wr, int wc, int fr, int fq) const {
        const int trow = u.pm * BM, row0 = trow + wr * 64 + fr, col0 = u.pn * BM + wc * 32 + 4 * fq;
        const bool lat = trow < 16384;
        const int bb = lat ? (trow >> 11) : 8;
        const float* rbase = lat ? resLat + (size_t)row0 * 2048 : resCtx + (size_t)(row0 - 16384) * 2048;
        float* obase = lat ? outLat + (size_t)row0 * 2048 : outCtx + (size_t)(row0 - 16384) * 2048;
        f32x4 gv[2][2];
#pragma unroll
        for (int bj = 0; bj < 2; ++bj)
#pragma unroll
            for (int n = 0; n < 2; ++n) gv[bj][n] = *(const f32x4*)(gate + (size_t)bb * 12288 + col0 + bj * HALF + n * 16) * *(const f32x4*)(sb + col0 + bj * HALF + n * 16);
#pragma unroll
        for (int ai = 0; ai < 2; ++ai)
#pragma unroll
            for (int m = 0; m < 4; ++m) {
                const size_t off = (size_t)(ai * HALF + m * 16) * 2048 + col0;
                const float s = sa[row0 + ai * HALF + m * 16];
#pragma unroll
                for (int bj = 0; bj < 2; ++bj)
#pragma unroll
                    for (int n = 0; n < 2; ++n) {
                        const f32x4 r = *(const f32x4*)(rbase + off + bj * HALF + n * 16);
                        const i32x4 a = acc[ai][bj][m][n];
                        *(f32x4*)(obase + off + bj * HALF + n * 16) = r + gv[bj][n] * ((f32x4){(float)a.x, (float)a.y, (float)a.z, (float)a.w} * s);
                    }
            }
    }
};

struct EpiResGateI8B {
    static constexpr bool PERM = true, AFTER_DRAIN = false;
    const float *resLat, *resCtx;
    bf16_t* hb; const float* gate; const float* sa; const float* sb;
    __device__ __forceinline__ void operator()(const i32x4 (&acc)[2][2][4][2], const Unit& u, int wr, int wc, int fr, int fq) const {
        const int trow = u.pm * BM, row0 = trow + wr * 64 + fr, col0 = u.pn * BM + wc * 32 + 8 * fq;
        const bool lat = trow < 16384;
        const int bb = lat ? (trow >> 11) : 8;
        f32x4 gv[2][2];
#pragma unroll
        for (int bj = 0; bj < 2; ++bj)
#pragma unroll
            for (int n = 0; n < 2; ++n) gv[bj][n] = *(const f32x4*)(gate + (size_t)bb * 12288 + col0 + bj * HALF + 4 * n) * *(const f32x4*)(sb + col0 + bj * HALF + 4 * n);
#pragma unroll
        for (int ai = 0; ai < 2; ++ai)
#pragma unroll
            for (int m = 0; m < 4; ++m) {
                const int row = row0 + ai * HALF + m * 16; const float s = sa[row];
                bf16_t* hp = hb + (size_t)row * 2048 + col0;
#pragma unroll
                for (int bj = 0; bj < 2; ++bj) {
                    f32x4 r0, r1;
                    if (resLat) {
                        const float* rp = (lat ? resLat + (size_t)row * 2048 : resCtx + (size_t)(row - 16384) * 2048) + col0 + bj * HALF;
                        r0 = *(const f32x4*)rp; r1 = *(const f32x4*)(rp + 4);
                    } else {
                        const u32x4 q = *(const u32x4*)(hp + bj * HALF);
                        r0 = (f32x4){__uint_as_float(q.x << 16), __uint_as_float(q.x & 0xffff0000u), __uint_as_float(q.y << 16), __uint_as_float(q.y & 0xffff0000u)};
                        r1 = (f32x4){__uint_as_float(q.z << 16), __uint_as_float(q.z & 0xffff0000u), __uint_as_float(q.w << 16), __uint_as_float(q.w & 0xffff0000u)};
                    }
                    const i32x4 a0 = acc[ai][bj][m][0], a1 = acc[ai][bj][m][1];
                    const f32x4 v0 = r0 + (gv[bj][0] * s) * (f32x4){(float)a0.x, (float)a0.y, (float)a0.z, (float)a0.w};
                    const f32x4 v1 = r1 + (gv[bj][1] * s) * (f32x4){(float)a1.x, (float)a1.y, (float)a1.z, (float)a1.w};
                    u32x4 w; w.x = cvt_pk_bf16(v0[0], v0[1]); w.y = cvt_pk_bf16(v0[2], v0[3]); w.z = cvt_pk_bf16(v1[0], v1[1]); w.w = cvt_pk_bf16(v1[2], v1[3]);
                    *(u32x4*)(hp + bj * HALF) = w;
                }
            }
    }
};
}
#ifndef USE_PG8
#define USE_PG8 1
#endif

__device__ __forceinline__ float sum16(float v) { v += __shfl_xor(v, 1); v += __shfl_xor(v, 2); v += __shfl_xor(v, 4); v += __shfl_xor(v, 8); return v; }
__device__ __forceinline__ void ph_prep(const Params& p, int l, const bool dry) {
    const int tid = threadIdx.x, lane = tid & 63, wave = tid >> 6, sub = lane >> 4, li = lane & 15;
    const int gw = blockIdx.x * NWAVES + wave, NGW = gridDim.x * NWAVES;
    bf16_t* P = (bf16_t*)(p.ws + WS_P);
    const float* rope = (const float*)(p.ws + WS_ROPE);
    const bool last = (l == DEPTH - 1);
    const int f0 = (li >= 8 ? 32 : 0) + 8 * (li & 3);
    const float sg = (li & 4) ? 1.f : -1.f;
#pragma unroll 1
    for (int r = gw; r < MTOT; r += NGW) {
        bf16_t* row = P + (size_t)r * INW;
        bf16_t* wrow = dry ? (bf16_t*)(p.ws + WS_DUMMY) + (size_t)r * INW : row;
        const bool isctx = r >= NLAT;
        const int t = r & (SEQ - 1);
        float cs[8], sn[8];
        if (!isctx) {
            const f32x4* rp = (const f32x4*)(rope + ((size_t)t * 64 + f0) * 2);
            const f32x4 a = rp[0], b = rp[1], c = rp[2], d = rp[3];
            cs[0] = a.x; sn[0] = a.y; cs[1] = a.z; sn[1] = a.w; cs[2] = b.x; sn[2] = b.y; cs[3] = b.z; sn[3] = b.w;
            cs[4] = c.x; sn[4] = c.y; cs[5] = c.z; sn[5] = c.w; cs[6] = d.x; sn[6] = d.y; cs[7] = d.z; sn[7] = d.w;
        } else {
#pragma unroll
            for (int i = 0; i < 8; ++i) { cs[i] = 1.f; sn[i] = 0.f; }
        }
        u32x4 raw[7];
#pragma unroll
        for (int gI = 0; gI < 7; ++gI) raw[gI] = *(const u32x4*)(row + (gI * 4 + sub) * 128 + li * 8);
#pragma unroll
        for (int gI = 0; gI < 7; ++gI) {
            const int slot = gI * 4 + sub;
            const int kind = slot < 8 ? 0 : slot < 10 ? 1 : slot < 18 ? 0 : slot < 20 ? 1 : slot < 24 ? 2 : 3;
            const bool isq = slot < 6 || (slot >= 10 && slot < 16);
            float x[8];
            x[0] = bflo(raw[gI].x); x[1] = bfhi(raw[gI].x); x[2] = bflo(raw[gI].y); x[3] = bfhi(raw[gI].y);
            x[4] = bflo(raw[gI].z); x[5] = bfhi(raw[gI].z); x[6] = bflo(raw[gI].w); x[7] = bfhi(raw[gI].w);
            if (kind >= 2) {
#pragma unroll
                for (int i = 0; i < 8; ++i) x[i] = gelu_tanh(x[i]);
            }
            float ss = 0.f;
#pragma unroll
            for (int i = 0; i < 8; ++i) ss += x[i] * x[i];
            ss = sum16(ss);
            const float rstd = rsqrtf(ss * (1.f / 128.f) + EPS);
            const float* gain = slot < 6 ? p.qn_a + l * 128 : slot < 8 ? p.kn_a + l * 128 : slot < 16 ? p.qn_b + l * 128 : slot < 20 ? p.kn_b + l * 128 : p.vn_c + l * 512 + (slot - 24) * 128;
            if (kind == 0 || kind == 3) {
                const f32x4 g0 = *(const f32x4*)(gain + li * 8), g1 = *(const f32x4*)(gain + li * 8 + 4);
                x[0] *= rstd * g0.x; x[1] *= rstd * g0.y; x[2] *= rstd * g0.z; x[3] *= rstd * g0.w;
                x[4] *= rstd * g1.x; x[5] *= rstd * g1.y; x[6] *= rstd * g1.z; x[7] *= rstd * g1.w;
            }
            float px[8];
#pragma unroll
            for (int i = 0; i < 8; ++i) px[i] = __shfl_xor(x[i], 4);
            if (kind == 0) {
#pragma unroll
                for (int i = 0; i < 8; ++i) x[i] = x[i] * cs[i] + sg * px[i] * sn[i];
            }
            bool wr = kind != 1;
            if (isctx && last && (isq || kind >= 2)) wr = false;
            if (wr) { u32x4 o; o.x = pk2(x[0], x[1]); o.y = pk2(x[2], x[3]); o.z = pk2(x[4], x[5]); o.w = pk2(x[6], x[7]); *(u32x4*)(wrow + slot * 128 + li * 8) = o; }
        }
    }
}

__device__ __forceinline__ void attn_row_naive(const bf16_t* q, const bf16_t* kc, const bf16_t* vc, const bf16_t* kl, const bf16_t* vl, int j0, int j1,
                                               bool has_sink, float sink, bf16_t* o, int lane) {
    const unsigned qq = *(const unsigned*)(q + 2 * lane);
    const float q0 = bflo(qq), q1 = bfhi(qq);
    float m = -INFINITY, lsum = 0.f, o0 = 0.f, o1 = 0.f;
    const int ntot = NCTX + (j1 - j0);
    for (int j = 0; j < ntot; ++j) {
        const bf16_t* kp = j < NCTX ? kc + (size_t)j * INW : kl + (size_t)(j0 + j - NCTX) * INW;
        const bf16_t* vp = j < NCTX ? vc + (size_t)j * INW : vl + (size_t)(j0 + j - NCTX) * INW;
        const unsigned kk = *(const unsigned*)(kp + 2 * lane), vv = *(const unsigned*)(vp + 2 * lane);
        const float s = wave_sum(q0 * bflo(kk) + q1 * bfhi(kk)) * ATT_SCALE;
        const float mn = fmaxf(m, s);
        const float a = __expf(m - mn), pp = __expf(s - mn);
        lsum = lsum * a + pp; o0 = o0 * a + pp * bflo(vv); o1 = o1 * a + pp * bfhi(vv);
        m = mn;
    }
    if (has_sink) {
        const float mn = fmaxf(m, sink);
        const float a = __expf(m - mn);
        lsum = lsum * a + __expf(sink - mn); o0 *= a; o1 *= a;
    }
    const float inv = 1.f / lsum;
    *(unsigned*)(o + 2 * lane) = pk2(o0 * inv, o1 * inv);
}

__device__ __forceinline__ void ph_mixers_naive(const Params& p, int l, unsigned char* lds) {
    const int tid = threadIdx.x, lane = tid & 63, wave = tid >> 6;
    const int gw = blockIdx.x * NWAVES + wave, NGW = gridDim.x * NWAVES;
    const bf16_t* P = (const bf16_t*)(p.ws + WS_P);
    bf16_t* Y = (bf16_t*)(p.ws + WS_Y);
    const bool last = (l == DEPTH - 1);
    const int T_LA = NLAT * 6, T_LB = NLAT * 6, T_CA = last ? 0 : NCT * 6, T_CB = last ? 0 : NCT * 6;
    const int ntask = T_LA + T_LB + T_CA + T_CB;
    for (int tk = gw; tk < ntask; tk += NGW) {
        int r = tk;
        if (r < T_LA + T_LB) {
            const bool isB = r >= T_LA; if (isB) r -= T_LA;
            const int b = r / (6 * SEQ), h = (r / SEQ) % 6, t = r % SEQ, kv = h / 3;
            const size_t row = (size_t)b * SEQ + t, crow0 = (size_t)NLAT + (size_t)b * NCTX, lrow0 = (size_t)b * SEQ;
            const int cq = isB ? C_QB : C_QA, ck = isB ? C_KB : C_KA, cvv = isB ? C_VB : C_VA;
            int j0 = 0, j1 = SEQ;
            if (isB) { j0 = t - 128 < 0 ? 0 : t - 128; j1 = t + 129 > SEQ ? SEQ : t + 129; }
            attn_row_naive(P + row * INW + cq + h * 128, P + crow0 * INW + ck + kv * 128, P + crow0 * INW + cvv + kv * 128,
                           P + lrow0 * INW + ck + kv * 128, P + lrow0 * INW + cvv + kv * 128, j0, j1, isB, isB ? p.sink_b[l * 6 + h] : 0.f,
                           Y + row * DM + (isB ? 768 : 0) + h * 128, lane);
        } else {
            r -= T_LA + T_LB;
            const bool isB = r >= T_CA; if (isB) r -= T_CA;
            const int b = r / (6 * NCTX), h = (r / NCTX) % 6, t = r % NCTX, kv = h / 3;
            const size_t crow0 = (size_t)NLAT + (size_t)b * NCTX, row = crow0 + t;
            const int cq = isB ? C_QB : C_QA, ck = isB ? C_KB : C_KA, cvv = isB ? C_VB : C_VA;
            attn_row_naive(P + row * INW + cq + h * 128, P + crow0 * INW + ck + kv * 128, P + crow0 * INW + cvv + kv * 128,
                           P, P, 0, 0, isB, isB ? p.sink_b[l * 6 + h] : 0.f, Y + row * DM + (isB ? 768 : 0) + h * 128, lane);
        }
    }
    __syncthreads();
    float* Wl = (float*)lds;
    float* Vl = Wl + 128 * 128;
    const int nchunk = last ? NLAT / 128 : MTOT / 128;
    for (int u = blockIdx.x; u < nchunk * 4; u += gridDim.x) {
        const int ch = u >> 2, g = u & 3; const size_t row0 = (size_t)ch * 128;
        __syncthreads();
        for (int i = tid; i < 128 * 128; i += NTHREADS) {
            Wl[i] = p.ws_c[((size_t)l * 4 + g) * 16384 + i];
            const int q = i >> 7, c = i & 127;
            Vl[i] = bf2f(P[(row0 + q) * INW + C_VC + g * 128 + c]);
        }
        __syncthreads();
        const int c = tid & 127, pg = tid >> 7;
        for (int pp = pg * 32; pp < pg * 32 + 32; ++pp) {
            float s = 0.f;
#pragma unroll 8
            for (int q = 0; q < 128; ++q) s += Wl[pp * 128 + q] * Vl[q * 128 + c];
            s += p.bs_c[((size_t)l * 4 + g) * 128 + pp];
            const float uu = bf2f(P[(row0 + pp) * INW + C_UC + g * 128 + c]);
            Y[(row0 + pp) * DM + 1536 + g * 128 + c] = (bf16_t)f2bf(uu * s);
        }
    }
}


namespace att {
constexpr float SCALE = 0.088388347648318440f;
constexpr float THR = 8.f;
constexpr int D = 128, NW = 8, QBLK = 32, KVBLK = 64;
#ifndef ATT_SDEPTH
#define ATT_SDEPTH 2
#endif
constexpr int SDEPTH = ATT_SDEPTH;
constexpr int LDQ = INW, LDK = INW, LDO = DM;
constexpr size_t SHM_V = KVBLK * D * 2, SHM_K = KVBLK * D * 2, SHM_ATTN = 2 * SHM_V + 2 * SHM_K + NW * 64 * 4;
using bf16x8 = __attribute__((ext_vector_type(8))) short;
using s16x4  = __attribute__((ext_vector_type(4))) short;
using f32x16 = __attribute__((ext_vector_type(16))) float;
using f32x8  = __attribute__((ext_vector_type(8))) float;

#define KSWZ(row, colB) ((row) * 256 + ((colB) ^ (((row) & 7) << 4)))
#define SBAR() __builtin_amdgcn_sched_barrier(0)
__device__ __forceinline__ int crow(int r, int hi) { return (r & 3) + 8 * (r >> 2) + 4 * hi; }
__device__ __forceinline__ unsigned cvtpk(float lo, float hi) {
  unsigned r; asm volatile("v_cvt_pk_bf16_f32 %0, %1, %2" : "=v"(r) : "v"(lo), "v"(hi)); return r;
}

__device__ __forceinline__ void partialSM(f32x16& p0, f32x16& p1, float& m_reg, float& mn, float& alpha) {
  constexpr float C = SCALE * 1.4426950408889634f;
  float pmax = p0[0]; for (int r = 1; r < 16; ++r) pmax = fmaxf(pmax, p0[r]); for (int r = 0; r < 16; ++r) pmax = fmaxf(pmax, p1[r]);
  { auto rr = __builtin_amdgcn_permlane32_swap(__float_as_uint(pmax), __float_as_uint(pmax), false, false);
    pmax = fmaxf(__uint_as_float(rr[0]), __uint_as_float(rr[1])); }
  if (__builtin_expect(__all(pmax - m_reg <= THR / SCALE), 1)) { mn = m_reg; alpha = 1.f; }
  else { mn = fmaxf(m_reg, pmax); alpha = __builtin_amdgcn_exp2f((m_reg - mn) * C); m_reg = mn; }
  float mnC = -mn * C;
  for (int r = 0; r < 16; ++r) p0[r] = fmaf(p0[r], C, mnC); for (int r = 0; r < 16; ++r) p1[r] = fmaf(p1[r], C, mnC);
  for (int r = 0; r < 16; ++r) p0[r] = __builtin_amdgcn_exp2f(p0[r]);
}
__device__ __forceinline__ void finishSM(f32x16& p0, f32x16& p1, float alpha, float& l_reg, bf16x8& pa0, bf16x8& pa1, bf16x8& pa2, bf16x8& pa3) {
  for (int r = 0; r < 16; ++r) p1[r] = __builtin_amdgcn_exp2f(p1[r]);
  float ps = 0; for (int r = 0; r < 16; ++r) ps += p0[r]; for (int r = 0; r < 16; ++r) ps += p1[r];
  { auto rr = __builtin_amdgcn_permlane32_swap(__float_as_uint(ps), __float_as_uint(ps), false, false);
    ps = __uint_as_float(rr[0]) + __uint_as_float(rr[1]); }
  l_reg = l_reg * alpha + ps;
#define PK4(P, BASE, OUT) do { unsigned a0 = cvtpk(P[BASE + 0], P[BASE + 1]), a1 = cvtpk(P[BASE + 2], P[BASE + 3]);   \
    unsigned b0 = cvtpk(P[BASE + 4], P[BASE + 5]), b1 = cvtpk(P[BASE + 6], P[BASE + 7]);                              \
    auto r0 = __builtin_amdgcn_permlane32_swap(a0, b0, false, false); auto r1 = __builtin_amdgcn_permlane32_swap(a1, b1, false, false); \
    u32x4 w = {r0[0], r1[0], r0[1], r1[1]}; OUT = *reinterpret_cast<bf16x8*>(&w); } while (0)
  PK4(p0, 0, pa0); PK4(p0, 8, pa1); PK4(p1, 0, pa2); PK4(p1, 8, pa3);
#undef PK4
}
__device__ __forceinline__ void qkt(f32x16& p0, f32x16& p1, const bf16_t* Ks, const bf16x8* qr, int r32, int hi) {
  p0 = f32x16{}; p1 = f32x16{};
  for (int d0 = 0; d0 < 8; ++d0) { int cb = (d0 * 16 + hi * 8) * 2;
    bf16x8 b0 = *reinterpret_cast<const bf16x8*>((const char*)Ks + KSWZ(r32, cb));
    bf16x8 b1 = *reinterpret_cast<const bf16x8*>((const char*)Ks + KSWZ(32 + r32, cb));
    p0 = __builtin_amdgcn_mfma_f32_32x32x16_bf16(b0, qr[d0], p0, 0, 0, 0);
    p1 = __builtin_amdgcn_mfma_f32_32x32x16_bf16(b1, qr[d0], p1, 0, 0, 0); }
}
__device__ __forceinline__ int v_st(int k, int c) { const int kk = (k & ~0xC) | ((k & 4) << 1) | ((k & 8) >> 1); return ((kk >> 3) * 4 + (c >> 5)) * 512 + ((kk & 7) * 32 + (c & 31)) * 2; }
__device__ __forceinline__ int v_rd_base(int lane) { return ((lane & 3) << 3) | (((lane >> 2) & 3) << 6) | (((lane >> 4) & 1) << 5) | (((lane >> 5) & 1) << 8); }
constexpr int v_rd_off(int d0, int ks, int half) { return d0 * 512 + ks * 4096 + half * 2048; }
template <int OFF> __device__ __forceinline__ s16x4 tr_read(int vb) {
  s16x4 r; asm volatile("ds_read_b64_tr_b16 %0, %1 offset:%2" : "=&v"(r) : "v"(vb), "i"(OFF) : "memory"); return r;
}
template <int D0> __device__ __forceinline__ void pv_one(f32x16& od, int vb, bf16x8 pa0, bf16x8 pa1, bf16x8 pa2, bf16x8 pa3) {
  const s16x4 l0 = tr_read<v_rd_off(D0, 0, 0)>(vb), h0 = tr_read<v_rd_off(D0, 0, 1)>(vb), l1 = tr_read<v_rd_off(D0, 1, 0)>(vb), h1 = tr_read<v_rd_off(D0, 1, 1)>(vb);
  const s16x4 l2 = tr_read<v_rd_off(D0, 2, 0)>(vb), h2 = tr_read<v_rd_off(D0, 2, 1)>(vb), l3 = tr_read<v_rd_off(D0, 3, 0)>(vb), h3 = tr_read<v_rd_off(D0, 3, 1)>(vb);
  asm volatile("s_waitcnt lgkmcnt(0)" ::: "memory"); SBAR();
#define PK(L, H) (bf16x8){L[0], L[1], L[2], L[3], H[0], H[1], H[2], H[3]}
  od = __builtin_amdgcn_mfma_f32_32x32x16_bf16(pa0, PK(l0, h0), od, 0, 0, 0);
  od = __builtin_amdgcn_mfma_f32_32x32x16_bf16(pa1, PK(l1, h1), od, 0, 0, 0);
  od = __builtin_amdgcn_mfma_f32_32x32x16_bf16(pa2, PK(l2, h2), od, 0, 0, 0);
  od = __builtin_amdgcn_mfma_f32_32x32x16_bf16(pa3, PK(l3, h3), od, 0, 0, 0);
#undef PK
}
__device__ __forceinline__ void pv_d0(f32x16* o, int vb, bf16x8 pa0, bf16x8 pa1, bf16x8 pa2, bf16x8 pa3) {
  pv_one<0>(o[0], vb, pa0, pa1, pa2, pa3); pv_one<1>(o[1], vb, pa0, pa1, pa2, pa3); pv_one<2>(o[2], vb, pa0, pa1, pa2, pa3); pv_one<3>(o[3], vb, pa0, pa1, pa2, pa3);
}

__device__ __forceinline__ void attn_unit(const bool MASK, const bf16_t* __restrict__ Qb, const bf16_t* __restrict__ Kc, const bf16_t* __restrict__ Vc,
                                          const bf16_t* __restrict__ Kl, const bf16_t* __restrict__ Vl, int nlt, int qpos0, int kpos0,
                                          bool has_sink, float sink, bf16_t* __restrict__ Ob, char* lds) {
  int tid_ = threadIdx.x; asm volatile("" : "+v"(tid_));
  const int tid = tid_, wid = tid >> 6, lane = tid & 63, r32 = lane & 31, hi = lane >> 5;
  bf16_t* V_lds = (bf16_t*)lds; bf16_t* K_lds = (bf16_t*)(lds + 2 * SHM_V);
  float* ws = (float*)(lds + 2 * SHM_V + 2 * SHM_K) + wid * 64; float* li_l = ws; float* al_l = ws + 32;
  float m_reg = -1e30f, l_reg = 0; f32x16 o[4] = {}; bf16x8 qr[8];
  const bf16_t* Qw = Qb + (long)(wid * QBLK + r32) * LDQ + hi * 8;
#pragma unroll
  for (int d0 = 0; d0 < 8; ++d0) qr[d0] = *reinterpret_cast<const bf16x8*>(Qw + d0 * 16);
  const int sr = tid >> 4, sc = (tid & 15) * 8, vst0 = v_st(sr, sc), vst1 = v_st(32 + sr, sc);
  const int vb0 = (int)(uintptr_t)V_lds + v_rd_base(lane);
  struct { bf16x8 vs0, vs1, ks0, ks1; } sr_[SDEPTH];
  const int qpos = qpos0 + wid * QBLK + r32;
#define KVP(t, KP, VP) const bf16_t* KP = ((t) < 4 ? Kc + (long)(t) * KVBLK * LDK : Kl + (long)((t) - 4) * KVBLK * LDK); const bf16_t* VP = ((t) < 4 ? Vc + (long)(t) * KVBLK * LDK : Vl + (long)((t) - 4) * KVBLK * LDK)
#define SLOAD(i, t) do { KVP(t, kp_, vp_); sr_[i].vs0 = *reinterpret_cast<const bf16x8*>(&vp_[(long)sr * LDK + sc]); sr_[i].vs1 = *reinterpret_cast<const bf16x8*>(&vp_[(long)(32 + sr) * LDK + sc]); \
    sr_[i].ks0 = *reinterpret_cast<const bf16x8*>(&kp_[(long)sr * LDK + sc]); sr_[i].ks1 = *reinterpret_cast<const bf16x8*>(&kp_[(long)(32 + sr) * LDK + sc]); } while (0)
#define SWRITE(b, i) do { *(bf16x8*)((char*)V_lds + (b) * SHM_V + vst0) = sr_[i].vs0;          \
    *(bf16x8*)((char*)V_lds + (b) * SHM_V + vst1) = sr_[i].vs1; int kc = sc * 2;               \
    *(bf16x8*)((char*)K_lds + (b) * SHM_K + KSWZ(sr, kc)) = sr_[i].ks0;                       \
    *(bf16x8*)((char*)K_lds + (b) * SHM_K + KSWZ(32 + sr, kc)) = sr_[i].ks1; } while (0)
#define SWAIT() do { if constexpr (SDEPTH == 2) asm volatile("s_waitcnt vmcnt(4)" ::: "memory"); else asm volatile("s_waitcnt vmcnt(0)" ::: "memory"); } while (0)
#define RESC(a) do { if (__any((a) < 1.f)) { if (hi == 0) al_l[r32] = (a); asm volatile("s_waitcnt lgkmcnt(0)" ::: "memory"); \
    for (int d = 0; d < 4; ++d) for (int r = 0; r < 16; ++r) o[d][r] *= al_l[crow(r, hi)]; } } while (0)
#define WMASK(P0, P1, t) do { if (MASK && (t) >= 4) { const int kb_ = kpos0 + ((t) - 4) * KVBLK + 4 * hi - qpos; \
    _Pragma("unroll") for (int r = 0; r < 16; ++r) { const int dk = kb_ + (r & 3) + 8 * (r >> 2); \
      if (dk > 128 || dk < -128) P0[r] = -1e30f; if (dk + 32 > 128 || dk + 32 < -128) P1[r] = -1e30f; } } } while (0)
  f32x16 pA0, pA1, pB0, pB1; float mnA, mnB, alA, alB; bf16x8 pa0, pa1, pa2, pa3; const int NT = 4 + nlt;
  constexpr int SE = 0, SO = SDEPTH - 1;
  SLOAD(SE, 0); asm volatile("s_waitcnt vmcnt(0)" ::: "memory"); SWRITE(0, SE); __syncthreads();
  qkt(pA0, pA1, K_lds, qr, r32, hi); partialSM(pA0, pA1, m_reg, mnA, alA);
  SLOAD(SO, 1); if constexpr (SDEPTH == 2) { if (2 < NT) SLOAD(SE, 2); }
  SWAIT(); SWRITE(1, SO); __syncthreads();
  for (int j = 1; j + 1 < NT; j += 2) {
    SBAR(); qkt(pB0, pB1, (bf16_t*)((char*)K_lds + SHM_K), qr, r32, hi); WMASK(pB0, pB1, j);
    finishSM(pA0, pA1, alA, l_reg, pa0, pa1, pa2, pa3); SBAR();
    SLOAD(SO, j + SDEPTH); SBAR();
    pv_d0(o, vb0, pa0, pa1, pa2, pa3); partialSM(pB0, pB1, m_reg, mnB, alB);
    __syncthreads(); SWAIT(); SWRITE(0, SE);
    RESC(alB); __syncthreads();
    SBAR(); qkt(pA0, pA1, K_lds, qr, r32, hi); WMASK(pA0, pA1, j + 1);
    finishSM(pB0, pB1, alB, l_reg, pa0, pa1, pa2, pa3); SBAR();
    if (SDEPTH == 1 || j + 3 < NT) SLOAD(SE, j + 1 + SDEPTH); SBAR();
    pv_d0(o, vb0 + (int)SHM_V, pa0, pa1, pa2, pa3); partialSM(pA0, pA1, m_reg, mnA, alA);
    __syncthreads(); SWAIT(); SWRITE(1, SO);
    RESC(alA); __syncthreads();
  }
  SBAR(); qkt(pB0, pB1, (bf16_t*)((char*)K_lds + SHM_K), qr, r32, hi); WMASK(pB0, pB1, NT - 1);
  finishSM(pA0, pA1, alA, l_reg, pa0, pa1, pa2, pa3); SBAR();
  pv_d0(o, vb0, pa0, pa1, pa2, pa3); partialSM(pB0, pB1, m_reg, mnB, alB);
  __syncthreads(); RESC(alB);
  finishSM(pB0, pB1, alB, l_reg, pa0, pa1, pa2, pa3); SBAR();
  pv_d0(o, vb0 + (int)SHM_V, pa0, pa1, pa2, pa3);
  if (has_sink) l_reg += __builtin_amdgcn_exp2f(sink * 1.4426950408889634f - m_reg * (SCALE * 1.4426950408889634f));
  if (hi == 0) li_l[r32] = l_reg; asm volatile("s_waitcnt lgkmcnt(0)" ::: "memory");
  float rli[16];
#pragma unroll
  for (int r = 0; r < 16; ++r) rli[r] = __builtin_amdgcn_rcpf(li_l[crow(r, hi)]);
  bf16_t* Ow = Ob + (long)(wid * QBLK) * LDO;
  char* stg = (char*)K_lds + wid * 4096;
#pragma unroll
  for (int hf = 0; hf < 2; ++hf) {
#pragma unroll
    for (int r = 0; r < 16; ++r) { const int orow = crow(r, hi);
#pragma unroll
      for (int dd = 0; dd < 2; ++dd) *(bf16_t*)(stg + orow * 128 + (dd * 32 + r32) * 2) = (bf16_t)f2bf(o[hf * 2 + dd][r] * rli[r]); }
    asm volatile("s_waitcnt lgkmcnt(0)" ::: "memory");
    const int rr = lane >> 1, hb = lane & 1;
    const u32x4 v0 = *(const u32x4*)(stg + rr * 128 + hb * 64), v1 = *(const u32x4*)(stg + rr * 128 + hb * 64 + 16);
    const u32x4 v2 = *(const u32x4*)(stg + rr * 128 + hb * 64 + 32), v3 = *(const u32x4*)(stg + rr * 128 + hb * 64 + 48);
    bf16_t* dst = Ow + (long)rr * LDO + hf * 64 + hb * 32;
    *(u32x4*)dst = v0; *(u32x4*)(dst + 8) = v1; *(u32x4*)(dst + 16) = v2; *(u32x4*)(dst + 24) = v3;
  }
  __syncthreads();
#undef KVP
#undef SLOAD
#undef SWRITE
#undef SWAIT
#undef RESC
#undef WMASK
}
#undef KSWZ
#undef SBAR
}


__device__ __forceinline__ void cmlp_unit_naive(const Params& p, int l, int ch, int g, unsigned char* lds) {
    int tid_ = threadIdx.x; asm volatile("" : "+v"(tid_));
    const int tid = tid_;
    const bf16_t* P = (const bf16_t*)(p.ws + WS_P);
    bf16_t* Y = (bf16_t*)(p.ws + WS_Y);
    float* Wl = (float*)lds;
    float* Vl = Wl + 128 * 128;
    const size_t row0 = (size_t)ch * 128;
    __syncthreads();
    for (int i = tid; i < 128 * 128; i += NTHREADS) {
        Wl[i] = p.ws_c[((size_t)l * 4 + g) * 16384 + i];
        const int q = i >> 7, c = i & 127;
        Vl[i] = bf2f(P[(row0 + q) * INW + C_VC + g * 128 + c]);
    }
    __syncthreads();
    const int c = tid & 127, pg = tid >> 7;
    for (int pp = pg * 32; pp < pg * 32 + 32; ++pp) {
        float s = 0.f;
#pragma unroll 8
        for (int q = 0; q < 128; ++q) s += Wl[pp * 128 + q] * Vl[q * 128 + c];
        s += p.bs_c[((size_t)l * 4 + g) * 128 + pp];
        const float uu = bf2f(P[(row0 + pp) * INW + C_UC + g * 128 + c]);
        Y[(row0 + pp) * DM + 1536 + g * 128 + c] = (bf16_t)f2bf(uu * s);
    }
    __syncthreads();
}


__device__ __forceinline__ void cmlp_unit_fast(const Params& p, int l, int ch, int g, unsigned char* lds) {
    typedef short bf16x8 __attribute__((ext_vector_type(8)));
    typedef float f32x16 __attribute__((ext_vector_type(16)));
    int tid_ = threadIdx.x; asm volatile("" : "+v"(tid_));
    const int tid = tid_, lane = tid & 63, wave = tid >> 6, r32 = lane & 31, hh = lane >> 5;
    const bf16_t* P = (const bf16_t*)(p.ws + WS_P);
    bf16_t* Y = (bf16_t*)(p.ws + WS_Y);
    const bf16_t* W = (const bf16_t*)(p.ws + WS_WSC) + ((size_t)l * 4 + g) * 16384;
    bf16_t* VT = (bf16_t*)lds;
    const size_t row0 = (size_t)ch * 128;
    __syncthreads();
#pragma unroll
    for (int it = 0; it < 4; ++it) {
        const int q = it * 32 + (tid >> 4), c0 = (tid & 15) * 8;
        const u32x4 v = *(const u32x4*)(P + (row0 + q) * INW + C_VC + g * 128 + c0);
        const unsigned w[4] = {v.x, v.y, v.z, v.w};
#pragma unroll
        for (int i = 0; i < 4; ++i) { VT[(c0 + 2 * i) * 136 + q] = (bf16_t)(w[i] & 0xffffu); VT[(c0 + 2 * i + 1) * 136 + q] = (bf16_t)(w[i] >> 16); }
    }
    __syncthreads();
    const int cb = wave & 3, pb0 = (wave >> 2) * 2;
    f32x16 acc0 = {}, acc1 = {};
#pragma unroll
    for (int s = 0; s < 8; ++s) {
        const bf16x8 b = *(const bf16x8*)(VT + (cb * 32 + r32) * 136 + 16 * s + 8 * hh);
        const bf16x8 a0 = *(const bf16x8*)(W + (size_t)(pb0 * 32 + r32) * 128 + 16 * s + 8 * hh);
        const bf16x8 a1 = *(const bf16x8*)(W + (size_t)(pb0 * 32 + 32 + r32) * 128 + 16 * s + 8 * hh);
        acc0 = __builtin_amdgcn_mfma_f32_32x32x16_bf16(a0, b, acc0, 0, 0, 0);
        acc1 = __builtin_amdgcn_mfma_f32_32x32x16_bf16(a1, b, acc1, 0, 0, 0);
    }
    const int c = cb * 32 + r32;
    const float* bs = p.bs_c + ((size_t)l * 4 + g) * 128;
#pragma unroll
    for (int r = 0; r < 16; ++r) {
        const int pr = (r & 3) + 8 * (r >> 2) + 4 * hh;
        const int p0 = pb0 * 32 + pr, p1 = p0 + 32;
        const float u0 = bf2f(P[(row0 + p0) * INW + C_UC + g * 128 + c]), u1 = bf2f(P[(row0 + p1) * INW + C_UC + g * 128 + c]);
        Y[(row0 + p0) * DM + 1536 + g * 128 + c] = (bf16_t)f2bf(u0 * (acc0[r] + bs[p0]));
        Y[(row0 + p1) * DM + 1536 + g * 128 + c] = (bf16_t)f2bf(u1 * (acc1[r] + bs[p1]));
    }
}
#ifndef USE_FAST_CMLP
#define USE_FAST_CMLP 1
#endif

__device__ __forceinline__ void ph_mixers_fast(const Params& p, int l, unsigned char* lds, const bool dry) {
    const int tid = threadIdx.x;
    const bf16_t* P = (const bf16_t*)(p.ws + WS_P);
    bf16_t* Y = (bf16_t*)(p.ws + WS_Y);
    const bool last = (l == DEPTH - 1);
    const int b = blockIdx.x & 7;
    unsigned* ctr = (unsigned*)(p.ws + WS_CTL) + (dry ? 2048 : 0) + (l * 8 + b) * 64;
    volatile unsigned* shw = (volatile unsigned*)(lds + LDS_BYTES - 64);
    const int nAttn = last ? 96 : 108, nC = last ? 64 : 72, total = nAttn + nC;
    const size_t lrow0 = (size_t)b * SEQ, crow0 = (size_t)NLAT + (size_t)b * NCTX;
    unsigned nxt_ = 0u;
    if (tid == 0) nxt_ = atomicAdd(ctr, 1u);
    for (;;) {
        __syncthreads();
        if (tid == 0) *shw = nxt_;
        __syncthreads();
        const int u = (int)*shw + ((dry && DRY_MODE == 7) ? 48 : 0);
        if (u >= ((dry && DRY_MODE == 6) ? 48 : total)) break;
        if (tid == 0) nxt_ = atomicAdd(ctr, 1u);
        if (u < nAttn) {
            const bf16_t *Qb, *Kc, *Vc, *Kl, *Vl; bf16_t* Ob; int nlt = 0, qpos0 = 0, kpos0 = 0; bool mask = false, has_sink = false; int hsink = 0;
            if (u < 48) {
                const int h = u >> 3, qb = u & 7, kv = h / 3;
                Qb = P + (lrow0 + qb * 256) * INW + C_QA + h * 128; Kc = P + crow0 * INW + C_KA + kv * 128; Vc = P + crow0 * INW + C_VA + kv * 128;
                Kl = P + lrow0 * INW + C_KA + kv * 128; Vl = P + lrow0 * INW + C_VA + kv * 128; nlt = 32;
                Ob = Y + (lrow0 + qb * 256) * DM + h * 128;
            } else if (u < 96) {
                const int v = u - 48, h = v >> 3, qb = v & 7, kv = h / 3;
                const int kstart = qb == 0 ? 0 : qb * 256 - 128; nlt = (qb == 0 || qb == 7) ? 6 : 8;
                Qb = P + (lrow0 + qb * 256) * INW + C_QB + h * 128; Kc = P + crow0 * INW + C_KB + kv * 128; Vc = P + crow0 * INW + C_VB + kv * 128;
                Kl = P + (lrow0 + kstart) * INW + C_KB + kv * 128; Vl = P + (lrow0 + kstart) * INW + C_VB + kv * 128;
                qpos0 = qb * 256; kpos0 = kstart; mask = true; has_sink = true; hsink = h;
                Ob = Y + (lrow0 + qb * 256) * DM + 768 + h * 128;
            } else {
                const int v = u - 96; const bool isB = v >= 6; const int h = isB ? v - 6 : v, kv = h / 3;
                const int cq = isB ? C_QB : C_QA, ck = isB ? C_KB : C_KA, cv = isB ? C_VB : C_VA;
                Qb = P + crow0 * INW + cq + h * 128; Kc = P + crow0 * INW + ck + kv * 128; Vc = P + crow0 * INW + cv + kv * 128; Kl = Kc; Vl = Vc;
                has_sink = isB; hsink = h; Ob = Y + crow0 * DM + (isB ? 768 : 0) + h * 128;
            }
            att::attn_unit(mask, Qb, Kc, Vc, Kl, Vl, nlt, qpos0, kpos0, has_sink, has_sink ? p.sink_b[l * 6 + hsink] : 0.f, Ob, (char*)lds);
        } else {
            const int v = u - nAttn;
            const int ch = v < 64 ? b * 16 + (v >> 2) : 128 + b * 2 + ((v - 64) >> 2);
#if USE_FAST_CMLP
            cmlp_unit_fast(p, l, ch, v & 3, lds);
#else
            cmlp_unit_naive(p, l, ch, v & 3, lds);
#endif
        }
    }
#if GATHER_I8 && GATHER_4BIT
    if (TABLES_IN_GAPS && !dry) conv4_tables(p, last ? 3 * NEXP : NEXP, last ? 4 * NEXP : 2 * NEXP, (unsigned*)(p.ws + WS_CTL) + 6272 + (last ? 64 : 0), lds);
#endif
}
#ifndef USE_FAST_ATT
#define USE_FAST_ATT 1
#endif

__device__ __forceinline__ void ynorm_row(bf16_t* yrow, const u32x4 (&v)[4], int lane, unsigned char* y8row, float* sdst) {
    float sq[4];
#pragma unroll
    for (int j = 0; j < 4; ++j) {
        const float a0 = bflo(v[j].x), a1 = bfhi(v[j].x), a2 = bflo(v[j].y), a3 = bfhi(v[j].y), a4 = bflo(v[j].z), a5 = bfhi(v[j].z), a6 = bflo(v[j].w), a7 = bfhi(v[j].w);
        sq[j] = a0 * a0 + a1 * a1 + a2 * a2 + a3 * a3 + a4 * a4 + a5 * a5 + a6 * a6 + a7 * a7;
    }
    const float sA = wave_sum(sq[0] + (lane < 32 ? sq[1] : 0.f));
    const float sB = wave_sum((lane >= 32 ? sq[1] : 0.f) + sq[2]);
    const float sC = wave_sum(sq[3]);
    const float rA = rsqrtf(sA * (1.f / 768.f) + EPS), rB = rsqrtf(sB * (1.f / 768.f) + EPS), rC = rsqrtf(sC * (1.f / 512.f) + EPS);
    if (GEMM_I8) {
        float x[4][8]; float am = 0.f;
#pragma unroll
        for (int j = 0; j < 4; ++j) {
            const float sc = (j == 0) ? rA : (j == 1) ? (lane < 32 ? rA : rB) : (j == 2) ? rB : rC;
            x[j][0] = bflo(v[j].x) * sc; x[j][1] = bfhi(v[j].x) * sc; x[j][2] = bflo(v[j].y) * sc; x[j][3] = bfhi(v[j].y) * sc;
            x[j][4] = bflo(v[j].z) * sc; x[j][5] = bfhi(v[j].z) * sc; x[j][6] = bflo(v[j].w) * sc; x[j][7] = bfhi(v[j].w) * sc;
#pragma unroll
            for (int i = 0; i < 8; ++i) am = fmaxf(am, fabsf(x[j][i]));
        }
        am = wave_max(am);
        const float s = am > 0.f ? am * (1.f / 127.f) : 1.f, inv = 1.f / s;
#pragma unroll
        for (int j = 0; j < 4; ++j) {
            u32x2 o; o.x = q8pack4(x[j][0], x[j][1], x[j][2], x[j][3], inv); o.y = q8pack4(x[j][4], x[j][5], x[j][6], x[j][7], inv);
            *(u32x2*)(y8row + j * 512 + lane * 8) = o;
        }
        if (lane == 0) *sdst = s;
        return;
    }
#pragma unroll
    for (int j = 0; j < 4; ++j) {
        const float sc = (j == 0) ? rA : (j == 1) ? (lane < 32 ? rA : rB) : (j == 2) ? rB : rC;
        u32x4 o;
        o.x = pk2(bflo(v[j].x) * sc, bfhi(v[j].x) * sc); o.y = pk2(bflo(v[j].y) * sc, bfhi(v[j].y) * sc);
        o.z = pk2(bflo(v[j].z) * sc, bfhi(v[j].z) * sc); o.w = pk2(bflo(v[j].w) * sc, bfhi(v[j].w) * sc);
        *(u32x4*)(yrow + j * 512 + lane * 8) = o;
    }
}
__device__ __forceinline__ void ph_ynorm(const Params& p, int l) {
    const int tid = threadIdx.x, lane = tid & 63, wave = tid >> 6;
    const int gw = blockIdx.x * NWAVES + wave, NGW = gridDim.x * NWAVES;
    bf16_t* Y = (bf16_t*)(p.ws + WS_Y);
    const int nrows = (l == DEPTH - 1) ? NLAT : MTOT;
#pragma unroll 1
    for (int r = gw; r < nrows; r += 2 * NGW) {
        const int r2 = r + NGW; const bool has2 = r2 < nrows; const int rb = has2 ? r2 : r;
        u32x4 va[4], vb[4];
#pragma unroll
        for (int j = 0; j < 4; ++j) { va[j] = *(const u32x4*)(Y + (size_t)r * DM + j * 512 + lane * 8); vb[j] = *(const u32x4*)(Y + (size_t)rb * DM + j * 512 + lane * 8); }
        unsigned char* Y8 = (unsigned char*)(p.ws + WS_XN8); float* SY = (float*)(p.ws + WS_SCL) + SCL_Y;
        ynorm_row(Y + (size_t)r * DM, va, lane, Y8 + (size_t)r * DM, SY + r);
        if (has2) ynorm_row(Y + (size_t)r2 * DM, vb, lane, Y8 + (size_t)r2 * DM, SY + r2);
    }
}

__device__ __forceinline__ void wave_argmax(float& bv, int& bi) {
#pragma unroll
    for (int o = 32; o >= 1; o >>= 1) {
        const float ov = __shfl_xor(bv, o); const int oi = __shfl_xor(bi, o);
        if (ov > bv || (ov == bv && oi < bi)) { bv = ov; bi = oi; }
    }
}
__device__ __forceinline__ void route_half(const bf16_t* qh, const bf16_t* kh, int lane, float& tv, int& ti) {
    const unsigned qq = *(const unsigned*)(qh + 2 * lane);
    const float qa = bflo(qq), qb = bfhi(qq);
    const bf16_t* k0 = kh + (size_t)lane * 128;
    const bf16_t* k1 = k0 + 64 * 128;
    float d0 = 0.f, d1 = 0.f;
#pragma unroll 2
    for (int cb = 0; cb < 16; ++cb) {
        const u32x4 a = *(const u32x4*)(k0 + cb * 8), b = *(const u32x4*)(k1 + cb * 8);
        const unsigned aw[4] = {a.x, a.y, a.z, a.w}, bw[4] = {b.x, b.y, b.z, b.w};
#pragma unroll
        for (int i = 0; i < 4; ++i) {
            const int src = cb * 4 + i;
            const float x0 = __shfl(qa, src), x1 = __shfl(qb, src);
            d0 += x0 * bflo(aw[i]) + x1 * bfhi(aw[i]);
            d1 += x0 * bflo(bw[i]) + x1 * bfhi(bw[i]);
        }
    }
    float va = d0, vb = d1; tv = 0.f; ti = 0;
#pragma unroll 1
    for (int r = 0; r < 16; ++r) {
        float bv; int bi;
        if (va >= vb) { bv = va; bi = lane; } else { bv = vb; bi = lane + 64; }
        wave_argmax(bv, bi);
        if (lane == r) { tv = bv; ti = bi; }
        if (bi == lane) va = -INFINITY; else if (bi == lane + 64) vb = -INFINITY;
    }
}
__device__ __forceinline__ void ph_route_naive(const Params& p, int l) {
    const int tid = threadIdx.x, lane = tid & 63, wave = tid >> 6;
    const int gw = blockIdx.x * NWAVES + wave, NGW = gridDim.x * NWAVES;
    const bf16_t* QP = (const bf16_t*)(p.ws + WS_P);
    const bf16_t* KEYS = (const bf16_t*)(p.ws + WS_KEYS) + (size_t)l * 8 * 2 * 128 * 128;
    int* EID = (int*)(p.ws + WS_EID); float* GATE = (float*)(p.ws + WS_GATE);
    const int nrows = (l == DEPTH - 1) ? NLAT : MTOT;
#pragma unroll 1
    for (int tk = gw; tk < nrows * 8; tk += NGW) {
        const int t = tk >> 3, h = tk & 7;
        const bf16_t* qrow = QP + (size_t)t * DM + h * 256;
        float tv0, tv1; int ti0, ti1;
        route_half(qrow, KEYS + (size_t)(h * 2 + 0) * 128 * 128, lane, tv0, ti0);
        route_half(qrow + 128, KEYS + (size_t)(h * 2 + 1) * 128 * 128, lane, tv1, ti1);
        const float v1 = __shfl(tv0, lane >> 2);
        float c0 = v1 + __shfl(tv1, (lane & 3) * 4 + 0), c1 = v1 + __shfl(tv1, (lane & 3) * 4 + 1);
        float c2 = v1 + __shfl(tv1, (lane & 3) * 4 + 2), c3 = v1 + __shfl(tv1, (lane & 3) * 4 + 3);
        float myv = 0.f; int myc = 0;
#pragma unroll 1
        for (int r = 0; r < 16; ++r) {
            float bv = c0; int bi = lane * 4;
            if (c1 > bv) { bv = c1; bi = lane * 4 + 1; }
            if (c2 > bv) { bv = c2; bi = lane * 4 + 2; }
            if (c3 > bv) { bv = c3; bi = lane * 4 + 3; }
            wave_argmax(bv, bi);
            if (lane == r) { myv = bv; myc = bi; }
            if ((bi >> 2) == lane) {
                const int u = bi & 3;
                if (u == 0) c0 = -INFINITY; else if (u == 1) c1 = -INFINITY; else if (u == 2) c2 = -INFINITY; else c3 = -INFINITY;
            }
        }
        float mx = lane < 16 ? myv : -INFINITY;
        mx = fmaxf(mx, __shfl_xor(mx, 8)); mx = fmaxf(mx, __shfl_xor(mx, 4)); mx = fmaxf(mx, __shfl_xor(mx, 2)); mx = fmaxf(mx, __shfl_xor(mx, 1));
        const float e = lane < 16 ? __expf(myv - mx) : 0.f;
        float sm = e; sm += __shfl_xor(sm, 8); sm += __shfl_xor(sm, 4); sm += __shfl_xor(sm, 2); sm += __shfl_xor(sm, 1);
        const int i1 = __shfl(ti0, myc >> 4), i2 = __shfl(ti1, myc & 15);
        if (lane < 16) { EID[(size_t)t * 128 + h * 16 + lane] = i1 * 128 + i2; GATE[(size_t)t * 128 + h * 16 + lane] = e / sm; }
    }
}


namespace rt {
typedef short bf16x8 __attribute__((ext_vector_type(8)));
typedef float f32x16 __attribute__((ext_vector_type(16)));
__device__ __forceinline__ void insert16(float (&t)[16], float x) {
#pragma unroll
    for (int j = 15; j >= 1; --j) t[j] = __builtin_amdgcn_fmed3f(t[j - 1], t[j], x);
    t[0] = fmaxf(t[0], x);
}
__device__ __forceinline__ void half_top16(const unsigned char* klds, const bf16_t* qrow, int r32, int hh, float (&t)[16]) {
    bf16x8 qf[8];
#pragma unroll
    for (int s = 0; s < 8; ++s) qf[s] = *(const bf16x8*)(qrow + 16 * s);
#pragma unroll
    for (int k = 0; k < 16; ++k) t[k] = -3.0e38f;
    const unsigned hh4 = (unsigned)hh << 2;
#pragma unroll
    for (int kb = 0; kb < 4; ++kb) {
        f32x16 acc = {};
        const int row = kb * 32 + r32;
#pragma unroll
        for (int s = 0; s < 8; ++s) {
            const bf16x8 a = *(const bf16x8*)(klds + row * 256 + ((32 * s + 16 * hh) ^ ((row & 7) << 4)));
            acc = __builtin_amdgcn_mfma_f32_32x32x16_bf16(a, qf[s], acc, 0, 0, 0);
        }
#pragma unroll
        for (int r = 0; r < 16; ++r) {
            const unsigned key = (unsigned)(kb * 32 + (r & 3) + 8 * (r >> 2)) | hh4;
            insert16(t, __uint_as_float((__float_as_uint(acc[r]) & ~127u) | key));
        }
    }
    float o[16];
#pragma unroll
    for (int k = 0; k < 16; ++k) o[k] = __shfl_xor(t[k], 32);
#pragma unroll
    for (int k = 0; k < 16; ++k) insert16(t, o[k]);
}
}
template <bool OWN_UNITS>
__device__ __forceinline__ void ph_route_fast(const Params& p, int l, unsigned char* lds) {
    int tid_ = threadIdx.x; asm volatile("" : "+v"(tid_));
    const int tid = tid_, lane = tid & 63, wave = tid >> 6, r32 = lane & 31, hh = lane >> 5;
    const bf16_t* QP = (const bf16_t*)(p.ws + WS_P);
    const bf16_t* KEYS = (const bf16_t*)(p.ws + WS_KEYS) + (size_t)l * 8 * 2 * 128 * 128;
    int* EID = (int*)(p.ws + WS_EID); float* GATE = (float*)(p.ws + WS_GATE);
    const int ntile = ((l == DEPTH - 1) ? NLAT : MTOT) / 256;
    unsigned* tab = (unsigned*)(lds + 65536) + wave * 2048;
    pg8::StaticOrder So; So.init(ntile * 256, DM, (int)gridDim.x, (int)blockIdx.x);
#pragma unroll 1
    for (int ui = 0;; ++ui) {
        int tile, h;
        if (OWN_UNITS) { pg8::Unit uu; if (!So.next(ui, uu)) break; tile = uu.pm; h = uu.pn; }
        else { const int u = blockIdx.x + ui * (int)gridDim.x; if (u >= ntile * 8) break; tile = u >> 3; h = u & 7; }
        __syncthreads();
        const u32x4* ksrc = (const u32x4*)(KEYS + (size_t)h * 2 * 128 * 128);
#pragma unroll
        for (int i = 0; i < 8; ++i) { const int c = tid + i * 512, row = c >> 4, cc = c & 15; *(u32x4*)(lds + row * 256 + ((cc * 16) ^ ((row & 7) << 4))) = ksrc[c]; }
        __syncthreads();
        const int tok = tile * 256 + wave * 32 + r32;
        const bf16_t* qrow = QP + (size_t)tok * DM + h * 256 + hh * 8;
        float v1[16], v2[16];
        rt::half_top16(lds, qrow, r32, hh, v1);
        rt::half_top16(lds + 32768, qrow + 128, r32, hh, v2);
        float c[16];
#pragma unroll
        for (int k = 0; k < 16; ++k) c[k] = -3.0e38f;
#pragma unroll
        for (int i = 0; i < 16; ++i)
#pragma unroll
            for (int j = 0; j < 16; ++j)
                if ((i + 1) * (j + 1) <= 16) rt::insert16(c, __uint_as_float((__float_as_uint(v1[i] + v2[j]) & ~255u) | (unsigned)(i * 16 + j)));
#pragma unroll
        for (int k = 0; k < 16; ++k) { tab[k * 64 + lane] = __float_as_uint(v1[k]); tab[(16 + k) * 64 + lane] = __float_as_uint(v2[k]); }
        LDS_WAIT();
        float e[16], sum = 0.f;
#pragma unroll
        for (int k = 0; k < 16; ++k) { e[k] = __expf(c[k] - c[0]); sum += e[k]; }
        const float inv = 1.f / sum;
        unsigned out[16];
#pragma unroll
        for (int k = 0; k < 16; ++k) {
            const unsigned code = __float_as_uint(c[k]) & 255u;
            const unsigned i1 = tab[(code >> 4) * 64 + lane] & 127u, i2 = tab[(16 + (code & 15u)) * 64 + lane] & 127u;
            out[k] = hh == 0 ? (i1 * 128u + i2) : __float_as_uint(e[k] * inv);
        }
        unsigned* dst = (hh == 0 ? (unsigned*)EID : (unsigned*)GATE) + (size_t)tok * 128 + h * 16;
#pragma unroll
        for (int k = 0; k < 4; ++k) { u32x4 w; w.x = out[4 * k]; w.y = out[4 * k + 1]; w.z = out[4 * k + 2]; w.w = out[4 * k + 3]; *(u32x4*)(dst + 4 * k) = w; }
        LDS_WAIT();
    }
}
#ifndef USE_FAST_ROUTE
#define USE_FAST_ROUTE 1
#endif


#if GATHER_I8
__device__ __forceinline__ float dpp_shr(float v, int n) {
    const int iv = __builtin_bit_cast(int, v); int r;
    switch (n) { case 1: r = __builtin_amdgcn_update_dpp(0, iv, 0x111, 0xf, 0xf, true); break; case 2: r = __builtin_amdgcn_update_dpp(0, iv, 0x112, 0xf, 0xf, true); break;
                 case 4: r = __builtin_amdgcn_update_dpp(0, iv, 0x114, 0xf, 0xf, true); break; default: r = __builtin_amdgcn_update_dpp(0, iv, 0x118, 0xf, 0xf, true); break; }
    return __builtin_bit_cast(float, r);
}
__device__ __forceinline__ float wave_total(float v) {
    v += dpp_shr(v, 1); v += dpp_shr(v, 2); v += dpp_shr(v, 4); v += dpp_shr(v, 8);
    v += __builtin_bit_cast(float, __builtin_amdgcn_update_dpp(0, __builtin_bit_cast(int, v), 0x142, 0xa, 0xf, false));
    v += __builtin_bit_cast(float, __builtin_amdgcn_update_dpp(0, __builtin_bit_cast(int, v), 0x143, 0xc, 0xf, false));
    return __uint_as_float(__builtin_amdgcn_readlane(__float_as_uint(v), 63));
}
#define UB0(w) ((float)((w) & 0xffu))
#define UB1(w) ((float)(((w) >> 8) & 0xffu))
#define UB2(w) ((float)(((w) >> 16) & 0xffu))
#define UB3(w) ((float)((w) >> 24))

__device__ __forceinline__ float dpp_xor1(float v) { return __builtin_bit_cast(float, __builtin_amdgcn_update_dpp(0, __builtin_bit_cast(int, v), 0xB1, 0xf, 0xf, false)); }
__device__ __forceinline__ float dpp_xor2(float v) { return __builtin_bit_cast(float, __builtin_amdgcn_update_dpp(0, __builtin_bit_cast(int, v), 0x4E, 0xf, 0xf, false)); }
__device__ __forceinline__ float dpp_xor8(float v) { return __builtin_bit_cast(float, __builtin_amdgcn_update_dpp(0, __builtin_bit_cast(int, v), 0x128, 0xf, 0xf, false)); }
__device__ __forceinline__ float reduce8_rows(const float (&d)[8], int lane) {
    const bool b0 = lane & 1, b1 = lane & 2, b2 = lane & 4;
    float r[4];
#pragma unroll
    for (int k = 0; k < 4; ++k) r[k] = (b0 ? d[2 * k + 1] : d[2 * k]) + dpp_xor1(b0 ? d[2 * k] : d[2 * k + 1]);
    float t[2];
#pragma unroll
    for (int k = 0; k < 2; ++k) t[k] = (b1 ? r[2 * k + 1] : r[2 * k]) + dpp_xor2(b1 ? r[2 * k] : r[2 * k + 1]);
    float u = (b2 ? t[1] : t[0]) + __shfl_xor(b2 ? t[0] : t[1], 4);
    u += dpp_xor8(u);
    u += __shfl_xor(u, 16);
    u += __shfl_xor(u, 32);
    return u;
}
#if GATHER_4BIT
#ifndef DRY_MODE
#define DRY_MODE 0
#endif
typedef float f32x2 __attribute__((ext_vector_type(2)));
__device__ __forceinline__ void ph_gather(const Params& p, int l, const bool dry) {
    const int tid = threadIdx.x, lane = tid & 63, wave = tid >> 6;
    const int gw = blockIdx.x * NWAVES + wave, NGW = gridDim.x * NWAVES;
    const bf16_t* XN = (const bf16_t*)(p.ws + WS_XN);
    const unsigned char* UT = (const unsigned char*)(p.ws + WS_UT) + (size_t)l * NEXP * ROW4;
    const unsigned char* VT = (const unsigned char*)(p.ws + WS_VT) + (size_t)l * NEXP * ROW4;
    const int* EID = (const int*)(p.ws + WS_EID); const float* GATE = (const float*)(p.ws + WS_GATE);
    const float* mod = (const float*)(p.ws + WS_MOD) + (size_t)l * 9 * 12288;
    const int nrows = (l == DEPTH - 1) ? NLAT : MTOT;
#pragma unroll 1
    for (int t = gw; t < nrows; t += NGW) {
        int xh[4], xl[4]; float sxl;
#if GEMM_I8 && GEMM3_I8
        {
            sxl = ((const float*)(p.ws + WS_SCL))[SCL_XN + t];
            const unsigned char* x8 = (const unsigned char*)(p.ws + WS_XN8) + (size_t)t * DM;
#pragma unroll
            for (int j = 0; j < 2; ++j) {
                const u32x4 q4 = *(const u32x4*)(x8 + j * 1024 + lane * 16);
                const unsigned ww[4] = {q4.x, q4.y, q4.z, q4.w};
#pragma unroll
                for (int dd = 0; dd < 2; ++dd) {
                    unsigned h = 0u, lo = 0u;
#pragma unroll
                    for (int k = 0; k < 8; ++k) {
                        const int q = (int)(signed char)((ww[dd * 2 + (k >> 2)] >> (8 * (k & 3))) & 0xffu);
                        const int ql = ((q + 8) & 15) - 8, qh = (q - ql) >> 4;
                        h |= ((unsigned)qh & 15u) << (4 * k); lo |= ((unsigned)ql & 15u) << (4 * k);
                    }
                    xh[j * 2 + dd] = (int)h; xl[j * 2 + dd] = (int)lo;
                }
            }
        }
#else
        {
            float x[32]; float am = 0.f;
#pragma unroll
            for (int j = 0; j < 2; ++j)
#pragma unroll
                for (int k = 0; k < 2; ++k) {
                    const u32x4 q = *(const u32x4*)(XN + (size_t)t * DM + j * 1024 + lane * 16 + k * 8);
                    float* xx = x + j * 16 + k * 8;
                    xx[0] = bflo(q.x); xx[1] = bfhi(q.x); xx[2] = bflo(q.y); xx[3] = bfhi(q.y); xx[4] = bflo(q.z); xx[5] = bfhi(q.z); xx[6] = bflo(q.w); xx[7] = bfhi(q.w);
                }
#pragma unroll
            for (int i = 0; i < 32; ++i) am = fmaxf(am, fabsf(x[i]));
            sxl = am > 0.f ? am * (1.f / 119.f) : 1.f;
            const float inv = 1.f / sxl;
#pragma unroll
            for (int d = 0; d < 4; ++d) {
                unsigned h = 0u, lo = 0u;
#pragma unroll
                for (int k = 0; k < 8; ++k) {
                    const int q = (int)rintf(x[8 * d + k] * inv);
                    const int ql = ((q + 8) & 15) - 8, qh = (q - ql) >> 4;
                    h |= ((unsigned)qh & 15u) << (4 * k); lo |= ((unsigned)ql & 15u) << (4 * k);
                }
                xh[d] = (int)h; xl[d] = (int)lo;
            }
        }
#endif
        const int e0 = EID[(size_t)t * 128 + lane], e1 = EID[(size_t)t * 128 + 64 + lane];
        const float g0 = GATE[(size_t)t * 128 + lane], g1 = GATE[(size_t)t * 128 + 64 + lane];
        float hid0 = 0.f, hid1 = 0.f;
        constexpr int GB = 8;
#define G_LOAD(W, S, TAB, EB) do { _Pragma("unroll") for (int i = 0; i < GB; ++i) { \
            const int id_ = __builtin_amdgcn_readlane((EB) < 64 ? e0 : e1, ((EB) + i) & 63); \
            const unsigned char* row_ = (TAB) + (size_t)id_ * ROW4; \
            W[i] = *(const u32x4*)(row_ + lane * 16); S[i] = *(const unsigned short*)(row_ + 1024 + lane * 2); } } while (0)
#define G_DOT(W, S, EB) do { float dd_[8]; _Pragma("unroll") for (int i = 0; i < GB; ++i) { int sh_ = 0, sl_ = 0; \
            const unsigned ww[4] = {W[i].x, W[i].y, W[i].z, W[i].w}; \
            _Pragma("unroll") for (int d = 0; d < 4; ++d) { \
                sh_ = __builtin_amdgcn_sdot8((int)ww[d], xh[d], sh_, false); \
                sl_ = __builtin_amdgcn_sdot8((int)ww[d], xl[d], sl_, false); } \
            dd_[i] = (float)((sh_ << 4) + sl_) * (sxl * bf2f(S[i])); } \
            const float tot = reduce8_rows(dd_, lane);              \
            if ((lane & 56) == ((EB) & 63)) { if ((EB) < 64) hid0 = tot; else hid1 = tot; } } while (0)
#define G_AXPY(W, S, EB) do { _Pragma("unroll") for (int i = 0; i < GB; ++i) { \
            const float m_ = __uint_as_float(__builtin_amdgcn_readlane(__float_as_uint((EB) < 64 ? cf0 : cf1), ((EB) + i) & 63)) * bf2f(S[i]); \
            const f32x2 mm = {m_, m_}; \
            const unsigned ww[4] = {W[i].x, W[i].y, W[i].z, W[i].w}; \
            _Pragma("unroll") for (int d = 0; d < 4; ++d) { \
                acc[4 * d + 0] += mm * __builtin_amdgcn_cvt_scalef32_pk_f32_fp4(ww[d], 1.0f, 0); \
                acc[4 * d + 1] += mm * __builtin_amdgcn_cvt_scalef32_pk_f32_fp4(ww[d], 1.0f, 1); \
                acc[4 * d + 2] += mm * __builtin_amdgcn_cvt_scalef32_pk_f32_fp4(ww[d], 1.0f, 2); \
                acc[4 * d + 3] += mm * __builtin_amdgcn_cvt_scalef32_pk_f32_fp4(ww[d], 1.0f, 3); } } } while (0)
        u32x4 wa[GB], wb[GB]; unsigned sa[GB], sb[GB];
        const bool do_u = !(dry && (DRY_MODE == 4 || DRY_MODE == 5)), do_v = !(dry && (DRY_MODE == 3 || DRY_MODE == 5));
        if (do_u) G_LOAD(wa, sa, UT, 0); else G_LOAD(wa, sa, VT, 0);
#pragma unroll 1
        for (int eb = 0; eb < (do_u ? 128 : 0); eb += 2 * GB) {
            G_LOAD(wb, sb, UT, eb + GB);
            G_DOT(wa, sa, eb);
            if (eb + 2 * GB < 128) G_LOAD(wa, sa, UT, eb + 2 * GB); else G_LOAD(wa, sa, VT, 0);
            G_DOT(wb, sb, eb + GB);
        }
        const float cf0 = gelu_tanh(hid0) * g0, cf1 = gelu_tanh(hid1) * g1;
        f32x2 acc[16];
#pragma unroll
        for (int i = 0; i < 16; ++i) acc[i] = (f32x2){0.f, 0.f};
#pragma unroll 1
        for (int eb = 0; eb < (do_v ? 128 : 0); eb += 2 * GB) {
            G_LOAD(wb, sb, VT, eb + GB);
            G_AXPY(wa, sa, eb);
            if (eb + 2 * GB < 128) G_LOAD(wa, sa, VT, eb + 2 * GB);
            G_AXPY(wb, sb, eb + GB);
        }
#undef G_LOAD
#undef G_DOT
#undef G_AXPY
        float hn[32];
        const int bb = t < NLAT ? (t >> 11) : 8;
        const float* gate = mod + (size_t)bb * 12288 + 5 * DM;
#if H_BF16 && GEMM_I8 && GEMM3_I8
        {
            bf16_t* hbrow = (bf16_t*)(p.ws + WS_HB) + (size_t)t * DM;
            const bool fin = (l == DEPTH - 1);
#pragma unroll
            for (int j = 0; j < 2; ++j) {
                const u32x4 q0 = *(const u32x4*)(hbrow + j * 1024 + lane * 16), q1 = *(const u32x4*)(hbrow + j * 1024 + lane * 16 + 8);
                const unsigned qq[8] = {q0.x, q0.y, q0.z, q0.w, q1.x, q1.y, q1.z, q1.w};
#pragma unroll
                for (int k = 0; k < 4; ++k) {
                    const f32x4 gv = *(const f32x4*)(gate + j * 1024 + lane * 16 + k * 4);
                    const f32x2 a0 = acc[j * 8 + k * 2], a1 = acc[j * 8 + k * 2 + 1];
                    hn[j * 16 + k * 4 + 0] = bflo(qq[2 * k]) + gv.x * a0.x; hn[j * 16 + k * 4 + 1] = bfhi(qq[2 * k]) + gv.y * a0.y;
                    hn[j * 16 + k * 4 + 2] = bflo(qq[2 * k + 1]) + gv.z * a1.x; hn[j * 16 + k * 4 + 3] = bfhi(qq[2 * k + 1]) + gv.w * a1.y;
                }
                if (fin) {
                    float* orow = (dry ? (float*)(p.ws + WS_DUMMY) + (size_t)(t & 16383) * DM : p.out + (size_t)t * DM) + j * 1024 + lane * 16;
#pragma unroll
                    for (int k = 0; k < 4; ++k) *(f32x4*)(orow + k * 4) = (f32x4){hn[j * 16 + k * 4], hn[j * 16 + k * 4 + 1], hn[j * 16 + k * 4 + 2], hn[j * 16 + k * 4 + 3]};
                } else {
                    bf16_t* orow = (dry ? (bf16_t*)(p.ws + WS_DUMMY) + (size_t)(t & 16383) * DM : hbrow) + j * 1024 + lane * 16;
                    u32x4 w0, w1;
                    w0.x = pk2(hn[j * 16 + 0], hn[j * 16 + 1]); w0.y = pk2(hn[j * 16 + 2], hn[j * 16 + 3]); w0.z = pk2(hn[j * 16 + 4], hn[j * 16 + 5]); w0.w = pk2(hn[j * 16 + 6], hn[j * 16 + 7]);
                    w1.x = pk2(hn[j * 16 + 8], hn[j * 16 + 9]); w1.y = pk2(hn[j * 16 + 10], hn[j * 16 + 11]); w1.z = pk2(hn[j * 16 + 12], hn[j * 16 + 13]); w1.w = pk2(hn[j * 16 + 14], hn[j * 16 + 15]);
                    *(u32x4*)orow = w0; *(u32x4*)(orow + 8) = w1;
                }
            }
        }
#else
        float* hrow = t < NLAT ? p.out + (size_t)t * DM : (float*)(p.ws + WS_HC) + (size_t)(t - NLAT) * DM;
#pragma unroll
        for (int j = 0; j < 2; ++j)
#pragma unroll
            for (int k = 0; k < 4; ++k) {
                const int col = j * 1024 + lane * 16 + k * 4;
                const f32x4 hv = *(const f32x4*)(hrow + col), gv = *(const f32x4*)(gate + col);
                const f32x2 a0 = acc[j * 8 + k * 2], a1 = acc[j * 8 + k * 2 + 1];
                f32x4 o;
                o.x = hv.x + gv.x * a0.x; o.y = hv.y + gv.y * a0.y; o.z = hv.z + gv.z * a1.x; o.w = hv.w + gv.w * a1.y;
                *(f32x4*)((dry ? (float*)(p.ws + WS_DUMMY) + (size_t)(t & 16383) * DM : hrow) + col) = o;
                hn[j * 16 + k * 4 + 0] = o.x; hn[j * 16 + k * 4 + 1] = o.y; hn[j * 16 + k * 4 + 2] = o.z; hn[j * 16 + k * 4 + 3] = o.w;
            }
#endif
        if (l + 1 < DEPTH) {
            float ss = 0.f;
#pragma unroll
            for (int i = 0; i < 32; ++i) ss += hn[i] * hn[i];
            const float rstd = rsqrtf(wave_total(ss) * (1.f / DM) + EPS);
            const float* g1n = p.norm1_g + (l + 1) * DM;
            const float* shift = mod + (size_t)9 * 12288 + (size_t)bb * 12288;
            const float* scale = shift + DM;
            if (GEMM_I8) {
                float am = 0.f;
#pragma unroll
                for (int j = 0; j < 2; ++j)
#pragma unroll
                    for (int i = 0; i < 16; ++i) { const int col = j * 1024 + lane * 16 + i; hn[j * 16 + i] = hn[j * 16 + i] * rstd * g1n[col] * (1.f + scale[col]) + shift[col]; am = fmaxf(am, fabsf(hn[j * 16 + i])); }
                am = wave_max(am);
                const float s8 = am > 0.f ? am * (1.f / 127.f) : 1.f, inv8 = 1.f / s8;
                unsigned char* xo8 = (dry ? (unsigned char*)(p.ws + WS_DUMMY) + (size_t)(t & 16383) * DM : (unsigned char*)(p.ws + WS_XN8) + (size_t)t * DM);
#pragma unroll
                for (int j = 0; j < 2; ++j) {
                    u32x4 w;
                    w.x = q8pack4(hn[j * 16 + 0], hn[j * 16 + 1], hn[j * 16 + 2], hn[j * 16 + 3], inv8); w.y = q8pack4(hn[j * 16 + 4], hn[j * 16 + 5], hn[j * 16 + 6], hn[j * 16 + 7], inv8);
                    w.z = q8pack4(hn[j * 16 + 8], hn[j * 16 + 9], hn[j * 16 + 10], hn[j * 16 + 11], inv8); w.w = q8pack4(hn[j * 16 + 12], hn[j * 16 + 13], hn[j * 16 + 14], hn[j * 16 + 15], inv8);
                    *(u32x4*)(xo8 + j * 1024 + lane * 16) = w;
                }
                if (lane == 0 && !dry) ((float*)(p.ws + WS_SCL))[SCL_XN + t] = s8;
            } else {
            bf16_t* xo = (dry ? (bf16_t*)(p.ws + WS_DUMMY) + (size_t)(t & 16383) * DM : (bf16_t*)(p.ws + WS_XN) + (size_t)t * DM);
#pragma unroll
            for (int j = 0; j < 2; ++j)
#pragma unroll
                for (int k = 0; k < 2; ++k) {
                    const int col = j * 1024 + lane * 16 + k * 8;
                    float xv[8];
#pragma unroll
                    for (int i = 0; i < 8; ++i) xv[i] = hn[j * 16 + k * 8 + i] * rstd * g1n[col + i] * (1.f + scale[col + i]) + shift[col + i];
                    u32x4 w; w.x = pk2(xv[0], xv[1]); w.y = pk2(xv[2], xv[3]); w.z = pk2(xv[4], xv[5]); w.w = pk2(xv[6], xv[7]);
                    *(u32x4*)(xo + col) = w;
                }
            }
        }
    }
}
#else
#ifndef DRY_MODE
#define DRY_MODE 0
#endif
typedef float f32x2 __attribute__((ext_vector_type(2)));
__device__ __forceinline__ void ph_gather(const Params& p, int l, const bool dry) {
    const int tid = threadIdx.x, lane = tid & 63, wave = tid >> 6;
    const int gw = blockIdx.x * NWAVES + wave, NGW = gridDim.x * NWAVES;
    const bf16_t* XN = (const bf16_t*)(p.ws + WS_XN);
    const unsigned char* UT = (const unsigned char*)(p.ws + WS_UT) + (size_t)l * NEXP * DM;
    const unsigned char* VT = (const unsigned char*)(p.ws + WS_VT) + (size_t)l * NEXP * DM;
    const float* USC = (const float*)(p.ws + WS_USC) + l * NEXP; const float* VSC = (const float*)(p.ws + WS_VSC) + l * NEXP;
    const int* EID = (const int*)(p.ws + WS_EID); const float* GATE = (const float*)(p.ws + WS_GATE);
    const float* mod = (const float*)(p.ws + WS_MOD) + (size_t)l * 9 * 12288;
    const int nrows = (l == DEPTH - 1) ? NLAT : MTOT;
#pragma unroll 1
    for (int t = gw; t < nrows; t += NGW) {
        int xq[8]; float sxl;
        {
            float x[32]; float am = 0.f;
#pragma unroll
            for (int j = 0; j < 2; ++j)
#pragma unroll
                for (int k = 0; k < 2; ++k) {
                    const u32x4 q = *(const u32x4*)(XN + (size_t)t * DM + j * 1024 + lane * 16 + k * 8);
                    float* xx = x + j * 16 + k * 8;
                    xx[0] = bflo(q.x); xx[1] = bfhi(q.x); xx[2] = bflo(q.y); xx[3] = bfhi(q.y); xx[4] = bflo(q.z); xx[5] = bfhi(q.z); xx[6] = bflo(q.w); xx[7] = bfhi(q.w);
                }
#pragma unroll
            for (int i = 0; i < 32; ++i) am = fmaxf(am, fabsf(x[i]));
            sxl = am > 0.f ? am * (1.f / 127.f) : 1.f;
            const float inv = 1.f / sxl;
#pragma unroll
            for (int d = 0; d < 8; ++d) {
                const int q0 = (int)rintf(x[4 * d] * inv), q1 = (int)rintf(x[4 * d + 1] * inv), q2 = (int)rintf(x[4 * d + 2] * inv), q3 = (int)rintf(x[4 * d + 3] * inv);
                xq[d] = (int)(((unsigned)q0 & 0xffu) | (((unsigned)q1 & 0xffu) << 8) | (((unsigned)q2 & 0xffu) << 16) | ((unsigned)q3 << 24));
            }
        }
        const int e0 = EID[(size_t)t * 128 + lane], e1 = EID[(size_t)t * 128 + 64 + lane];
        const float g0 = GATE[(size_t)t * 128 + lane], g1 = GATE[(size_t)t * 128 + 64 + lane];
        const float us0 = USC[e0], us1 = USC[e1], vs0 = VSC[e0], vs1 = VSC[e1];
        float hid0 = 0.f, hid1 = 0.f;
        constexpr int GBU = 8, GBV = 4;
#define G_LOAD(W, TAB, EB, NB) do { _Pragma("unroll") for (int i = 0; i < NB; ++i) { \
            const int id_ = __builtin_amdgcn_readlane((EB) < 64 ? e0 : e1, ((EB) + i) & 63); \
            const unsigned char* row_ = (TAB) + (size_t)id_ * DM + lane * 16; \
            W[i][0] = *(const u32x4*)row_; W[i][1] = *(const u32x4*)(row_ + 1024); } } while (0)
#define G_DOT(W, EB) do { _Pragma("unroll") for (int i = 0; i < GBU; ++i) { int s_ = 0; \
            s_ = __builtin_amdgcn_sdot4((int)W[i][0].x, xq[0], s_, false); s_ = __builtin_amdgcn_sdot4((int)W[i][0].y, xq[1], s_, false); \
            s_ = __builtin_amdgcn_sdot4((int)W[i][0].z, xq[2], s_, false); s_ = __builtin_amdgcn_sdot4((int)W[i][0].w, xq[3], s_, false); \
            s_ = __builtin_amdgcn_sdot4((int)W[i][1].x, xq[4], s_, false); s_ = __builtin_amdgcn_sdot4((int)W[i][1].y, xq[5], s_, false); \
            s_ = __builtin_amdgcn_sdot4((int)W[i][1].z, xq[6], s_, false); s_ = __builtin_amdgcn_sdot4((int)W[i][1].w, xq[7], s_, false); \
            const float tot = wave_total((float)s_ * sxl); \
            if ((((EB) + i) & 63) == lane) { if ((EB) < 64) hid0 = tot; else hid1 = tot; } } } while (0)
#define G_AXPY(W, EB) do { _Pragma("unroll") for (int i = 0; i < GBV; ++i) { \
            const float cf_ = __uint_as_float(__builtin_amdgcn_readlane(__float_as_uint((EB) < 64 ? cf0 : cf1), ((EB) + i) & 63)); \
            const f32x2 mm = {cf_, cf_}; \
            _Pragma("unroll") for (int j = 0; j < 2; ++j) { const unsigned ww[4] = {W[i][j].x, W[i][j].y, W[i][j].z, W[i][j].w}; \
                _Pragma("unroll") for (int k = 0; k < 4; ++k) { \
                    acc[j * 8 + k * 2] += mm * __builtin_amdgcn_cvt_pk_f32_fp8((int)ww[k], false); \
                    acc[j * 8 + k * 2 + 1] += mm * __builtin_amdgcn_cvt_pk_f32_fp8((int)ww[k], true); } } } } while (0)
        u32x4 wa[GBU][2], wb[GBU][2];
        const bool do_u = !(dry && (DRY_MODE == 4 || DRY_MODE == 5)), do_v = !(dry && (DRY_MODE == 3 || DRY_MODE == 5));
        if (do_u) G_LOAD(wa, UT, 0, GBU); else G_LOAD(wa, VT, 0, GBV);
#pragma unroll 1
        for (int eb = 0; eb < (do_u ? 128 : 0); eb += 2 * GBU) {
            G_LOAD(wb, UT, eb + GBU, GBU);
            G_DOT(wa, eb);
            if (eb + 2 * GBU < 128) G_LOAD(wa, UT, eb + 2 * GBU, GBU); else G_LOAD(wa, VT, 0, GBV);
            G_DOT(wb, eb + GBU);
        }
        const float cf0 = gelu_tanh(hid0 * us0) * g0 * vs0, cf1 = gelu_tanh(hid1 * us1) * g1 * vs1;
        f32x2 acc[16];
#pragma unroll
        for (int i = 0; i < 16; ++i) acc[i] = (f32x2){0.f, 0.f};
#pragma unroll 1
        for (int eb = 0; eb < (do_v ? 128 : 0); eb += 2 * GBV) {
            G_LOAD(wb, VT, eb + GBV, GBV);
            G_AXPY(wa, eb);
            if (eb + 2 * GBV < 128) G_LOAD(wa, VT, eb + 2 * GBV, GBV);
            G_AXPY(wb, eb + GBV);
        }
#undef G_LOAD
#undef G_DOT
#undef G_AXPY
        float hn[32];
        float* hrow = t < NLAT ? p.out + (size_t)t * DM : (float*)(p.ws + WS_HC) + (size_t)(t - NLAT) * DM;
        const int bb = t < NLAT ? (t >> 11) : 8;
        const float* gate = mod + (size_t)bb * 12288 + 5 * DM;
#pragma unroll
        for (int j = 0; j < 2; ++j)
#pragma unroll
            for (int k = 0; k < 4; ++k) {
                const int col = j * 1024 + lane * 16 + k * 4;
                const f32x4 hv = *(const f32x4*)(hrow + col), gv = *(const f32x4*)(gate + col);
                const f32x2 a0 = acc[j * 8 + k * 2], a1 = acc[j * 8 + k * 2 + 1];
                f32x4 o;
                o.x = hv.x + gv.x * a0.x; o.y = hv.y + gv.y * a0.y; o.z = hv.z + gv.z * a1.x; o.w = hv.w + gv.w * a1.y;
                *(f32x4*)((dry ? (float*)(p.ws + WS_DUMMY) + (size_t)(t & 16383) * DM : hrow) + col) = o;
                hn[j * 16 + k * 4 + 0] = o.x; hn[j * 16 + k * 4 + 1] = o.y; hn[j * 16 + k * 4 + 2] = o.z; hn[j * 16 + k * 4 + 3] = o.w;
            }
        if (l + 1 < DEPTH) {
            float ss = 0.f;
#pragma unroll
            for (int i = 0; i < 32; ++i) ss += hn[i] * hn[i];
            const float rstd = rsqrtf(wave_total(ss) * (1.f / DM) + EPS);
            const float* g1n = p.norm1_g + (l + 1) * DM;
            const float* shift = mod + (size_t)9 * 12288 + (size_t)bb * 12288;
            const float* scale = shift + DM;
            bf16_t* xo = (dry ? (bf16_t*)(p.ws + WS_DUMMY) + (size_t)(t & 16383) * DM : (bf16_t*)(p.ws + WS_XN) + (size_t)t * DM);
#pragma unroll
            for (int j = 0; j < 2; ++j)
#pragma unroll
                for (int k = 0; k < 2; ++k) {
                    const int col = j * 1024 + lane * 16 + k * 8;
                    float xv[8];
#pragma unroll
                    for (int i = 0; i < 8; ++i) xv[i] = hn[j * 16 + k * 8 + i] * rstd * g1n[col + i] * (1.f + scale[col + i]) + shift[col + i];
                    u32x4 w; w.x = pk2(xv[0], xv[1]); w.y = pk2(xv[2], xv[3]); w.z = pk2(xv[4], xv[5]); w.w = pk2(xv[6], xv[7]);
                    *(u32x4*)(xo + col) = w;
                }
        }
    }
}
#endif
#else
__device__ __forceinline__ float dot8(const u32x4 u, const u32x4 x) {
    float d = bflo(u.x) * bflo(x.x) + bfhi(u.x) * bfhi(x.x);
    d += bflo(u.y) * bflo(x.y) + bfhi(u.y) * bfhi(x.y);
    d += bflo(u.z) * bflo(x.z) + bfhi(u.z) * bfhi(x.z);
    d += bflo(u.w) * bflo(x.w) + bfhi(u.w) * bfhi(x.w);
    return d;
}
__device__ __forceinline__ void ph_gather(const Params& p, int l, const bool dry) {
    const int tid = threadIdx.x, lane = tid & 63, wave = tid >> 6;
    const int gw = blockIdx.x * NWAVES + wave, NGW = gridDim.x * NWAVES;
    const bf16_t* XN = (const bf16_t*)(p.ws + WS_XN);
    const bf16_t* UT = (const bf16_t*)(p.ws + WS_UT) + (size_t)l * NEXP * DM;
    const bf16_t* VT = (const bf16_t*)(p.ws + WS_VT) + (size_t)l * NEXP * DM;
    const int* EID = (const int*)(p.ws + WS_EID); const float* GATE = (const float*)(p.ws + WS_GATE);
    const float* mod = (const float*)(p.ws + WS_MOD) + (size_t)l * 9 * 12288;
    const int nrows = (l == DEPTH - 1) ? NLAT : MTOT;
    for (int t = gw; t < nrows; t += NGW) {
        u32x4 xq[4];
#pragma unroll
        for (int j = 0; j < 4; ++j) xq[j] = *(const u32x4*)(XN + (size_t)t * DM + j * 512 + lane * 8);
        const int e0 = EID[(size_t)t * 128 + lane], e1 = EID[(size_t)t * 128 + 64 + lane];
        const float g0 = GATE[(size_t)t * 128 + lane], g1 = GATE[(size_t)t * 128 + 64 + lane];
        float hid0 = 0.f, hid1 = 0.f;
#pragma unroll 1
        for (int eb = 0; eb < 128; eb += 4) {
            u32x4 uu[4][4];
#pragma unroll
            for (int i = 0; i < 4; ++i) {
                const int e = eb + i;
                const int id = __builtin_amdgcn_readlane(eb < 64 ? e0 : e1, e & 63);
                const u32x4* ur = (const u32x4*)(UT + (size_t)id * DM) + lane;
#pragma unroll
                for (int j = 0; j < 4; ++j) uu[i][j] = ur[j * 64];
            }
#pragma unroll
            for (int i = 0; i < 4; ++i) {
                const int e = eb + i;
                float d = dot8(uu[i][0], xq[0]) + dot8(uu[i][1], xq[1]) + dot8(uu[i][2], xq[2]) + dot8(uu[i][3], xq[3]);
                d = wave_sum(d);
                if ((e & 63) == lane) { if (eb < 64) hid0 = d; else hid1 = d; }
            }
        }
        const float cf0 = gelu_tanh(hid0) * g0, cf1 = gelu_tanh(hid1) * g1;
        float acc[32];
#pragma unroll
        for (int i = 0; i < 32; ++i) acc[i] = 0.f;
#pragma unroll 1
        for (int eb = 0; eb < 128; eb += 4) {
            u32x4 vv[4][4]; float cf[4];
#pragma unroll
            for (int i = 0; i < 4; ++i) {
                const int e = eb + i;
                const int id = __builtin_amdgcn_readlane(eb < 64 ? e0 : e1, e & 63);
                cf[i] = __uint_as_float(__builtin_amdgcn_readlane(__float_as_uint(eb < 64 ? cf0 : cf1), e & 63));
                const u32x4* vr = (const u32x4*)(VT + (size_t)id * DM) + lane;
#pragma unroll
                for (int j = 0; j < 4; ++j) vv[i][j] = vr[j * 64];
            }
#pragma unroll
            for (int i = 0; i < 4; ++i)
#pragma unroll
                for (int j = 0; j < 4; ++j) {
                    acc[j * 8 + 0] += cf[i] * bflo(vv[i][j].x); acc[j * 8 + 1] += cf[i] * bfhi(vv[i][j].x);
                    acc[j * 8 + 2] += cf[i] * bflo(vv[i][j].y); acc[j * 8 + 3] += cf[i] * bfhi(vv[i][j].y);
                    acc[j * 8 + 4] += cf[i] * bflo(vv[i][j].z); acc[j * 8 + 5] += cf[i] * bfhi(vv[i][j].z);
                    acc[j * 8 + 6] += cf[i] * bflo(vv[i][j].w); acc[j * 8 + 7] += cf[i] * bfhi(vv[i][j].w);
                }
        }
        float* hrow = t < NLAT ? p.out + (size_t)t * DM : (float*)(p.ws + WS_HC) + (size_t)(t - NLAT) * DM;
        const int bb = t < NLAT ? (t >> 11) : 8;
        const float* gate = mod + (size_t)bb * 12288 + 5 * DM;
#pragma unroll
        for (int j = 0; j < 4; ++j) {
            const int col = j * 512 + lane * 8;
#pragma unroll
            for (int hh = 0; hh < 2; ++hh) {
                const f32x4 hv = *(const f32x4*)(hrow + col + hh * 4), gv = *(const f32x4*)(gate + col + hh * 4);
                f32x4 o;
                o.x = hv.x + gv.x * acc[j * 8 + hh * 4 + 0]; o.y = hv.y + gv.y * acc[j * 8 + hh * 4 + 1];
                o.z = hv.z + gv.z * acc[j * 8 + hh * 4 + 2]; o.w = hv.w + gv.w * acc[j * 8 + hh * 4 + 3];
                *(f32x4*)(hrow + col + hh * 4) = o;
            }
        }
    }
}

#endif

#define LAS __attribute__((address_space(3)))
#define XB_TMO      128
#define XB_XCNT(j)  (256  + 64 * (j))
#define XB_XSUB(j)  (1280 + 64 * (j))
#define XB_XGEN(j)  (2304 + 64 * (j))
#define XB_TOP      3328
#define XB_TOPGEN   3392
#define XCD_BAR_WORDS 3456
#define XB_SPIN_CAP (1u << 18)

__device__ __forceinline__ unsigned xb_ld(unsigned* p)              { return __hip_atomic_load(p, __ATOMIC_RELAXED, __HIP_MEMORY_SCOPE_AGENT); }
__device__ __forceinline__ unsigned xb_add(unsigned* p, unsigned v) { return __hip_atomic_fetch_add(p, v, __ATOMIC_RELAXED, __HIP_MEMORY_SCOPE_AGENT); }
__device__ __forceinline__ unsigned xb_xcc_id() { return (unsigned)__builtin_amdgcn_s_getreg((3 << 11) | 20) & 0xFu; }
#define XB_SPIN(cond, bar) do { unsigned _sp = 0; while (cond) { __builtin_amdgcn_s_sleep(1); \
    if ((++_sp & 255u) == 0u) { if (xb_ld(&(bar)[XB_TMO])) break; if (_sp > XB_SPIN_CAP) { atomicAdd(&(bar)[XB_TMO], 1u); break; } } } } while (0)

struct XcdBarrier {
    unsigned* bar; unsigned x;
    volatile LAS unsigned* st;
};

__device__ __forceinline__ XcdBarrier xcd_barrier_post(unsigned* bar, volatile LAS unsigned* st) {
    XcdBarrier b; b.bar = bar; b.x = xb_xcc_id(); b.st = st;
    if (threadIdx.x == 0) (void)xb_add(&bar[XB_XCNT(b.x)], 1u);
    return b;
}
__device__ __forceinline__ void xcd_barrier_complete(unsigned* bar, unsigned x, unsigned& nloc, unsigned& nx) {
    const unsigned G = gridDim.x * gridDim.y * gridDim.z;
    unsigned sum, cnt, mine, sp = 0u;
    for (;;) {
        sum = 0u; cnt = 0u; mine = 0u;
#pragma unroll
        for (unsigned j = 0; j < 16; ++j) { const unsigned c = xb_ld(&bar[XB_XCNT(j)]); sum += c; cnt += (c > 0u) ? 1u : 0u; mine = (j == x) ? c : mine; }
        if (sum == G) break;
        __builtin_amdgcn_s_sleep(1);
        if ((++sp & 255u) == 0u) { if (xb_ld(&bar[XB_TMO])) break; if (sp > XB_SPIN_CAP) { atomicAdd(&bar[XB_TMO], 1u); break; } }
    }
    nloc = mine > 0u ? mine : 1u; nx = cnt > 0u ? cnt : 1u;
}

__device__ __forceinline__ void xcd_barrier(const XcdBarrier& b) {
    asm volatile("s_waitcnt vmcnt(0)" ::: "memory");
    __syncthreads();
    if (threadIdx.x == 0) {
        unsigned* bar = b.bar;
        __builtin_amdgcn_s_waitcnt(0);
        unsigned nloc = b.st[0], nx = b.st[1];
        if (nloc == 0u) { xcd_barrier_complete(bar, b.x, nloc, nx); b.st[0] = nloc; b.st[1] = nx; }
        const unsigned old = xb_add(&bar[XB_XSUB(b.x)], 1u);
        const unsigned gen = old / nloc;
        if (old + 1u == (gen + 1u) * nloc) {
            __builtin_amdgcn_fence(__ATOMIC_RELEASE, "agent");
            asm volatile("s_waitcnt vmcnt(0)" ::: "memory");
            const unsigned og = xb_add(&bar[XB_TOP], 1u);
            const unsigned tg = og / nx;
            if (og + 1u == (tg + 1u) * nx) xb_add(&bar[XB_TOPGEN], 1u);
            else XB_SPIN(xb_ld(&bar[XB_TOPGEN]) == tg, bar);
            __builtin_amdgcn_fence(__ATOMIC_ACQUIRE, "agent");
            xb_add(&bar[XB_XGEN(b.x)], 1u);
            asm volatile("s_waitcnt vmcnt(0)" ::: "memory");
        } else {
            XB_SPIN(xb_ld(&bar[XB_XGEN(b.x)]) == gen, bar);
            __builtin_amdgcn_fence(__ATOMIC_ACQUIRE, "agent");
            asm volatile("s_waitcnt vmcnt(0)" ::: "memory");
        }
    }
    __syncthreads();
}

constexpr int NPHASE = 1 + 10 * DEPTH;
template <int S>
__device__ __forceinline__ void run_stage(const Params& p, int l, unsigned char* lds, const bool dry) {
    const bool last = (l == DEPTH - 1);
    const float* mod = (const float*)(p.ws + WS_MOD) + (size_t)l * 9 * 12288;
    if constexpr (S == 1) { if (l == 0) { ph_modulate(p, l, 0); if (GEMM_I8 && !(GEMM3_I8 && W8_ONEPASS) && !dry) ph_weights_i8(p, lds); } }
    if constexpr (S == 2) {
#if USE_PG8
        pg8::StaticOrder So; So.init(MTOT, INW, (int)gridDim.x, (int)blockIdx.x);
#if GEMM_I8
        pg8::Gemm g{(const bf16_t*)(p.ws + WS_XN8), (const bf16_t*)(p.ws + WS_WIN + (size_t)l * INW * DM), MTOT, INW, DM / 2};
        pg8::EpiBf16I8 E{(bf16_t*)(p.ws + WS_P), INW, (const float*)(p.ws + WS_SCL) + SCL_XN, (const float*)(p.ws + WS_SCL) + SCL_WIN + l * INW};
        pg8::gemm_phase<pg8::EpiBf16I8, pg8::StaticOrder, true, true, true>((PG8_LAS unsigned char*)lds, g, So, E);
#else
        pg8::Gemm g{(const bf16_t*)(p.ws + WS_XN), (const bf16_t*)(p.ws + WS_WIN) + (size_t)l * INW * DM, MTOT, INW, DM};
        pg8::EpiBf16<0> E{(bf16_t*)(p.ws + WS_P), INW, nullptr, 0, 0, 1.f};
        pg8::gemm_phase<pg8::EpiBf16<0>, pg8::StaticOrder, true, true>((PG8_LAS unsigned char*)lds, g, So, E);
#endif
#else
        EpiBf16Store E{(bf16_t*)(p.ws + WS_P), INW};
        gemm_naive(lds, (const bf16_t*)(p.ws + WS_XN), (const bf16_t*)(p.ws + WS_WIN) + (size_t)l * INW * DM, MTOT, INW, DM, E);
#endif
    }
    if constexpr (S == 3) ph_prep(p, l, dry);
    if constexpr (S == 4) {
#if USE_FAST_ATT
        ph_mixers_fast(p, l, lds, dry);
#else
        ph_mixers_naive(p, l, lds);
#endif
    }
    if constexpr (S == 5) ph_ynorm(p, l);
    if constexpr (S == 6) {
#if USE_PG8
        const int M = last ? NLAT : MTOT;
        pg8::StaticOrder So; So.init(M, DM, (int)gridDim.x, (int)blockIdx.x);
#if GEMM_I8
        pg8::Gemm g{(const bf16_t*)(p.ws + WS_XN8), (const bf16_t*)(p.ws + WS_WOUT + (size_t)l * DM * DM), M, DM, DM / 2};
#if H_BF16 && GEMM3_I8
        pg8::EpiResGateI8B E{l == 0 ? p.x : nullptr, p.ctx, (bf16_t*)(p.ws + (dry ? WS_DUMMY : WS_HB)), mod + 2 * DM,
                             (const float*)(p.ws + WS_SCL) + SCL_Y, (const float*)(p.ws + WS_SCL) + SCL_WOUT + l * DM};
        pg8::gemm_phase<pg8::EpiResGateI8B, pg8::StaticOrder, true, true, true>((PG8_LAS unsigned char*)lds, g, So, E);
#else
        pg8::EpiResGateI8 E{l == 0 ? p.x : p.out, l == 0 ? p.ctx : (const float*)(p.ws + WS_HC), dry ? (float*)(p.ws + WS_DUMMY) : p.out, dry ? (float*)(p.ws + WS_DUMMY) : (float*)(p.ws + WS_HC), mod + 2 * DM,
                            (const float*)(p.ws + WS_SCL) + SCL_Y, (const float*)(p.ws + WS_SCL) + SCL_WOUT + l * DM};
        pg8::gemm_phase<pg8::EpiResGateI8, pg8::StaticOrder, true, true, true>((PG8_LAS unsigned char*)lds, g, So, E);
#endif
#else
        pg8::Gemm g{(const bf16_t*)(p.ws + WS_Y), (const bf16_t*)(p.ws + WS_WOUT) + (size_t)l * DM * DM, M, DM, DM};
        pg8::EpiResGateT E{l == 0 ? p.x : p.out, l == 0 ? p.ctx : (const float*)(p.ws + WS_HC), dry ? (float*)(p.ws + WS_DUMMY) : p.out, dry ? (float*)(p.ws + WS_DUMMY) : (float*)(p.ws + WS_HC), mod + 2 * DM};
        pg8::gemm_phase<pg8::EpiResGateT, pg8::StaticOrder, true, true>((PG8_LAS unsigned char*)lds, g, So, E);
#endif
#if GATHER_I8 && GATHER_4BIT
        if (TABLES_IN_GAPS && l == 0 && !dry) conv4_tables(p, 0, NEXP, (unsigned*)(p.ws + WS_CTL) + 6144, lds);
#endif
#else
        EpiResGate E{l == 0 ? p.x : p.out, l == 0 ? p.ctx : (const float*)(p.ws + WS_HC), p.out, (float*)(p.ws + WS_HC), mod + 2 * DM};
        gemm_naive(lds, (const bf16_t*)(p.ws + WS_Y), (const bf16_t*)(p.ws + WS_WOUT) + (size_t)l * DM * DM, last ? NLAT : MTOT, DM, DM, E);
#endif
    }
    if constexpr (S == 7) ph_modulate(p, l, 1);
    if constexpr (S == 8) {
#if USE_PG8
        const int M = last ? NLAT : MTOT;
        pg8::StaticOrder So; So.init(M, DM, (int)gridDim.x, (int)blockIdx.x);
#if GEMM_I8 && GEMM3_I8
        pg8::Gemm g{(const bf16_t*)(p.ws + WS_XN8), (const bf16_t*)(p.ws + WS_WQ + (size_t)l * DM * DM), M, DM, DM / 2};
        pg8::EpiBf16I8 E{(bf16_t*)(p.ws + WS_P), DM, (const float*)(p.ws + WS_SCL) + SCL_XN, (const float*)(p.ws + WS_SCL) + SCL_WQ + l * DM};
        pg8::gemm_phase<pg8::EpiBf16I8, pg8::StaticOrder, true, true, true>((PG8_LAS unsigned char*)lds, g, So, E);
#else
        pg8::Gemm g{(const bf16_t*)(p.ws + WS_XN), (const bf16_t*)(p.ws + WS_WQ) + (size_t)l * DM * DM, M, DM, DM};
        pg8::EpiBf16<0> E{(bf16_t*)(p.ws + WS_P), DM, nullptr, 0, 0, 1.f};
        pg8::gemm_phase<pg8::EpiBf16<0>, pg8::StaticOrder, true, true>((PG8_LAS unsigned char*)lds, g, So, E);
#endif
#if FUSE_ROUTE
        asm volatile("s_waitcnt vmcnt(0)" ::: "memory");
        __syncthreads();
        ph_route_fast<true>(p, l, lds);
#endif
#if GATHER_I8 && GATHER_4BIT
        if (TABLES_IN_GAPS && l == 0 && !dry) conv4_tables(p, 2 * NEXP, 3 * NEXP, (unsigned*)(p.ws + WS_CTL) + 6208, lds);
#endif
#else
        EpiBf16Store E{(bf16_t*)(p.ws + WS_P), DM};
        gemm_naive(lds, (const bf16_t*)(p.ws + WS_XN), (const bf16_t*)(p.ws + WS_WQ) + (size_t)l * DM * DM, last ? NLAT : MTOT, DM, DM, E);
#endif
    }
    if constexpr (S == 9) {
#if USE_FAST_ROUTE
        if (!FUSE_ROUTE) ph_route_fast<false>(p, l, lds);
#else
        ph_route_naive(p, l);
#endif
    }
    if constexpr (S == 10) ph_gather(p, l, dry);
}
__global__ void __launch_bounds__(NTHREADS) fwd_kernel(Params p) {
    extern __shared__ __attribute__((aligned(16))) unsigned char lds[];
    cg::grid_group grid = cg::this_grid();
    const int lo = p.ph_lo, hi = p.ph_hi;
    volatile LAS unsigned* stw = (volatile LAS unsigned*)((LAS unsigned char*)lds + (LDS_BYTES - 128));
    if (threadIdx.x < 2) stw[threadIdx.x] = 0u;
    __syncthreads();
    const XcdBarrier bar = xcd_barrier_post((unsigned*)(p.ws + WS_CTL + 32768), stw);
#define IN(k) (lo <= (k) && (k) < hi)
#define SEAM(k) do { if (IN(k) && IN((k) + 1)) xcd_barrier(bar); } while (0)
#define STAGE(S, l) do { constexpr int k_ = 1 + 10 * (l) + (S) - 1; if (IN(k_)) { if constexpr ((REP_MASK >> k_) & 1) { run_stage<S>(p, l, lds, true); xcd_barrier(bar); } run_stage<S>(p, l, lds, false); } SEAM(k_); } while (0)
#define LAYER(l) do { if ((l) == 0) { STAGE(1, l); } STAGE(2, l); STAGE(3, l); STAGE(4, l); STAGE(5, l); STAGE(6, l); STAGE(7, l); STAGE(8, l); if (!FUSE_ROUTE) { STAGE(9, l); } STAGE(10, l); } while (0)
    if (hi > NPHASE) grid.sync();
    if (IN(0)) { if constexpr (REP_MASK & 1) { ph_prologue(p, lds); xcd_barrier(bar); } ph_prologue(p, lds); }
    SEAM(0);
    LAYER(0);
    LAYER(1);
#undef IN
#undef SEAM
#undef STAGE
#undef LAYER
}

extern "C" void kernel_launch(void* const* d_in, const int* in_sizes, int n_in, void* d_out, int out_size, void* d_ws, size_t ws_size, hipStream_t stream) {
    static int grid_blocks = 0;
    if (grid_blocks == 0) {
        if (n_in != 23 || out_size != NLAT * DM || ws_size < WS_END) { fprintf(stderr, "kernel_launch: unexpected shapes n_in %d out %d ws %zu\n", n_in, out_size, ws_size); grid_blocks = -1; return; }
        if (hipFuncSetAttribute((const void*)fwd_kernel, hipFuncAttributeMaxDynamicSharedMemorySize, LDS_BYTES) != hipSuccess) { fprintf(stderr, "kernel_launch: hipFuncSetAttribute failed\n"); grid_blocks = -1; return; }
        int dev = 0, cus = 0, per_cu = 0;
        hipGetDevice(&dev);
        hipDeviceGetAttribute(&cus, hipDeviceAttributeMultiprocessorCount, dev);
        hipOccupancyMaxActiveBlocksPerMultiprocessor(&per_cu, (const void*)fwd_kernel, NTHREADS, LDS_BYTES);
        if (per_cu < 1 || cus < 1) { fprintf(stderr, "kernel_launch: occupancy query failed (%d per CU, %d CUs)\n", per_cu, cus); grid_blocks = -1; return; }
        grid_blocks = cus * per_cu;
    }
    if (grid_blocks < 0) return;
    Params p{};
    const float** pp = (const float**)&p;
    for (int i = 0; i < 23; ++i) pp[i] = (const float*)d_in[i];
    p.out = (float*)d_out; p.ws = (unsigned char*)d_ws;
    p.ph_lo = 0; p.ph_hi = NPHASE;
    hipMemsetAsync((char*)d_ws + WS_CTL, 0, 131072, stream);
    void* args[] = {&p};
    hipError_t e = hipLaunchCooperativeKernel((const void*)fwd_kernel, dim3(grid_blocks), dim3(NTHREADS), args, LDS_BYTES, stream);
    if (e != hipSuccess) fprintf(stderr, "cooperative launch failed: %s (grid %d)\n", hipGetErrorString(e), grid_blocks);
}
```

```cpp
#include <hip/hip_runtime.h>
#include <hip/hip_cooperative_groups.h>
#include <cstdio>
#include <cstdint>
namespace cg = cooperative_groups;

constexpr int DM = 2048, NB = 8, SEQ = 2048, NCTX = 256, DEPTH = 2;
constexpr int NLAT = NB * SEQ;
constexpr int NCT = NB * NCTX;
constexpr int MTOT = NLAT + NCT;
constexpr int INW = 3584;
constexpr int C_QA = 0, C_KA = 768, C_VA = 1024, C_QB = 1280, C_KB = 2048, C_VB = 2304, C_UC = 2560, C_VC = 3072;
constexpr int NEXP = 16384;
constexpr float EPS = 1e-6f;
constexpr float ATT_SCALE = 0.088388347648318440f;
constexpr int NTHREADS = 512, NWAVES = 8;

constexpr size_t MiB = 1u << 20;
constexpr size_t WS_CTL = 0;
constexpr size_t WS_MOD = 1 * MiB;
constexpr size_t WS_ROPE = 2 * MiB;
constexpr size_t WS_KEYS = 3 * MiB;
constexpr size_t WS_WSC = 4 * MiB;
constexpr size_t WS_USC = 5 * MiB;
constexpr size_t WS_VSC = 6 * MiB;
constexpr size_t WS_WIN = 8 * MiB;
constexpr size_t WS_WOUT = 36 * MiB;
constexpr size_t WS_WQ = 52 * MiB;
constexpr size_t WS_HC = 68 * MiB;
constexpr size_t WS_EID = 84 * MiB;
constexpr size_t WS_GATE = 93 * MiB;
constexpr size_t WS_XN = 104 * MiB;
constexpr size_t WS_HB = WS_XN;
constexpr size_t WS_Y = 176 * MiB;
constexpr size_t WS_P = 248 * MiB;
constexpr size_t WS_UT = 376 * MiB;
constexpr size_t WS_VT = 504 * MiB;
constexpr size_t WS_SCL = 102 * MiB;
constexpr size_t SCL_WIN = 0, SCL_WOUT = 2 * 3584, SCL_XN = SCL_WOUT + 2 * 2048, SCL_Y = SCL_XN + 18432, SCL_WQ = SCL_Y + 18432;
constexpr int NCM = 3584 + 2048 + 2048;
constexpr size_t WS_XN8 = 784 * MiB;
constexpr size_t CTL_COLMAX = 65536;
constexpr size_t WS_DUMMY = 640 * MiB;
constexpr size_t WS_END = 820 * MiB;

constexpr int LDS_BYTES = 147456;

typedef unsigned short bf16_t;
typedef float f32x4 __attribute__((ext_vector_type(4)));
typedef unsigned u32x4 __attribute__((ext_vector_type(4)));
typedef unsigned u32x2 __attribute__((ext_vector_type(2)));

struct Params {
    const float *x, *c, *ctx, *c_ctx, *w_ada, *b_ada, *norm1_g, *norm2_g, *w_in, *qn_a, *kn_a, *qn_b, *kn_b, *sink_b, *vn_c, *ws_c, *bs_c,
        *g_group, *w_out, *peer_wq, *peer_keys, *peer_u, *peer_v;
    float* out;
    unsigned char* ws;
    int ph_lo, ph_hi;
};

__device__ __forceinline__ float bf2f(unsigned v) { return __uint_as_float(v << 16); }
__device__ __forceinline__ float bflo(unsigned w) { return __uint_as_float(w << 16); }
__device__ __forceinline__ float bfhi(unsigned w) { return __uint_as_float(w & 0xffff0000u); }
__device__ __forceinline__ unsigned f2bf(float f) { unsigned u = __float_as_uint(f); return (u + 0x7fffu + ((u >> 16) & 1u)) >> 16; }
__device__ __forceinline__ unsigned pk2(float lo, float hi) { return f2bf(lo) | (f2bf(hi) << 16); }
__device__ __forceinline__ float wave_sum(float v) {
#pragma unroll
    for (int o = 32; o >= 1; o >>= 1) v += __shfl_xor(v, o);
    return v;
}
__device__ __forceinline__ float wave_max(float v) {
#pragma unroll
    for (int o = 32; o >= 1; o >>= 1) v = fmaxf(v, __shfl_xor(v, o));
    return v;
}
__device__ __forceinline__ float gelu_tanh(float x) {
    const float y = 0.7978845608028654f * (x + 0.044715f * x * x * x);
    const float t = 1.f - 2.f / (__expf(2.f * y) + 1.f);
    return 0.5f * x * (1.f + t);
}
__device__ __forceinline__ float silu(float x) { return x / (1.f + __expf(-x)); }
#define LDS_WAIT() asm volatile("s_waitcnt lgkmcnt(0)" ::: "memory")
#ifndef GATHER_I8
#define GATHER_I8 1
#endif
#ifndef GATHER_4BIT
#define GATHER_4BIT 1
#endif
constexpr int ROW4 = 1152;
#ifndef V_ROWSCALE
#define V_ROWSCALE 1
#endif
constexpr int ROWV = V_ROWSCALE ? 1024 : ROW4;
#ifndef FUSE_ROUTE
#define FUSE_ROUTE 1
#endif
#ifndef GEMM_I8
#define GEMM_I8 1
#endif
#ifndef GEMM3_I8
#define GEMM3_I8 1
#endif
#ifndef H_BF16
#define H_BF16 1
#endif
#ifndef W8_ONEPASS
#define W8_ONEPASS 1
#endif
#ifndef DRY_MODE
#define DRY_MODE 0
#endif
#ifndef REP_MASK
#define REP_MASK 0
#endif

__device__ __forceinline__ unsigned q8pack4(float a, float b, float c, float d, float inv) {
    const int q0 = (int)rintf(a * inv), q1 = (int)rintf(b * inv), q2 = (int)rintf(c * inv), q3 = (int)rintf(d * inv);
    return ((unsigned)q0 & 0xffu) | (((unsigned)q1 & 0xffu) << 8) | (((unsigned)q2 & 0xffu) << 16) | ((unsigned)q3 << 24);
}

__device__ __forceinline__ void transpose_item(const float* W, int K, int N, bf16_t* WT, const float* gk, float* scr, int item, int lane) {
    const int nblk = N / 32, kb = item / nblk, nb = item % nblk, k0 = 64 * kb, n0 = 32 * nb;
#pragma unroll 8
    for (int i = 0; i < 32; ++i) {
        const int kk = 2 * i + (lane >> 5);
        float v = W[(size_t)(k0 + kk) * N + n0 + (lane & 31)];
        if (gk) v *= gk[k0 + kk];
        scr[kk * 33 + (lane & 31)] = v;
    }
    LDS_WAIT();
    const int c = lane & 7;
#pragma unroll
    for (int j = 0; j < 4; ++j) {
        const int n = (lane >> 3) + 8 * j;
        const float* s = scr + (8 * c) * 33 + n;
        u32x4 o;
        o.x = pk2(s[0 * 33], s[1 * 33]); o.y = pk2(s[2 * 33], s[3 * 33]); o.z = pk2(s[4 * 33], s[5 * 33]); o.w = pk2(s[6 * 33], s[7 * 33]);
        *(u32x4*)(WT + (size_t)(n0 + n) * K + k0 + 8 * c) = o;
    }
    LDS_WAIT();
}

__device__ __forceinline__ void colmax_item(const float* W, int N, const float* gk, unsigned* cmax, int item, int lane) {
    const int nblk = N / 32, kb = item / nblk, nb = item % nblk, k0 = 64 * kb, n0 = 32 * nb;
    f32x4 v[8];
#pragma unroll
    for (int i = 0; i < 8; ++i) v[i] = *(const f32x4*)(W + (size_t)(k0 + 8 * i + (lane >> 3)) * N + n0 + 4 * (lane & 7));
    float m0 = 0.f, m1 = 0.f, m2 = 0.f, m3 = 0.f;
#pragma unroll
    for (int i = 0; i < 8; ++i) {
        const float g = gk ? fabsf(gk[k0 + 8 * i + (lane >> 3)]) : 1.f;
        m0 = fmaxf(m0, fabsf(v[i].x) * g); m1 = fmaxf(m1, fabsf(v[i].y) * g); m2 = fmaxf(m2, fabsf(v[i].z) * g); m3 = fmaxf(m3, fabsf(v[i].w) * g);
    }
#pragma unroll
    for (int o = 8; o <= 32; o <<= 1) { m0 = fmaxf(m0, __shfl_xor(m0, o)); m1 = fmaxf(m1, __shfl_xor(m1, o)); m2 = fmaxf(m2, __shfl_xor(m2, o)); m3 = fmaxf(m3, __shfl_xor(m3, o)); }
    if (lane < 8) {
        unsigned* c = cmax + n0 + 4 * lane;
        atomicMax(c + 0, __float_as_uint(m0)); atomicMax(c + 1, __float_as_uint(m1)); atomicMax(c + 2, __float_as_uint(m2)); atomicMax(c + 3, __float_as_uint(m3));
    }
}
__device__ __forceinline__ void transpose_item_i8(const float* W, int K, int N, unsigned char* W8, const float* gk, const unsigned* cmax, float* scr, int item, int lane) {
    const int nblk = N / 32, kb = item / nblk, nb = item % nblk, k0 = 64 * kb, n0 = 32 * nb;
    f32x4 v[8];
#pragma unroll
    for (int i = 0; i < 8; ++i) v[i] = *(const f32x4*)(W + (size_t)(k0 + 8 * i + (lane >> 3)) * N + n0 + 4 * (lane & 7));
    float inv[4];
#pragma unroll
    for (int c = 0; c < 4; ++c) { const float m = __uint_as_float(cmax[n0 + 4 * (lane & 7) + c]); inv[c] = m > 0.f ? 127.f / m : 0.f; }
#pragma unroll
    for (int i = 0; i < 8; ++i) {
        const int kk = 8 * i + (lane >> 3);
        const float g = gk ? gk[k0 + kk] : 1.f;
        float* d = scr + kk * 33 + 4 * (lane & 7);
        d[0] = rintf(v[i].x * g * inv[0]); d[1] = rintf(v[i].y * g * inv[1]); d[2] = rintf(v[i].z * g * inv[2]); d[3] = rintf(v[i].w * g * inv[3]);
    }
    LDS_WAIT();
    const int c = lane & 7;
#pragma unroll
    for (int j = 0; j < 4; ++j) {
        const int n = (lane >> 3) + 8 * j;
        const float* s = scr + (8 * c) * 33 + n;
        unsigned lo = 0u, hi = 0u;
#pragma unroll
        for (int i = 0; i < 4; ++i) { lo |= ((unsigned)(int)s[i * 33] & 0xffu) << (8 * i); hi |= ((unsigned)(int)s[(4 + i) * 33] & 0xffu) << (8 * i); }
        u32x2 o; o.x = lo; o.y = hi;
        *(u32x2*)(W8 + (size_t)(n0 + n) * K + k0 + 8 * c) = o;
    }
    LDS_WAIT();
}
__device__ __forceinline__ void ph_weights_i8(const Params& p, unsigned char* lds) {
    const int tid = threadIdx.x, lane = tid & 63, wave = tid >> 6;
    const int gw = blockIdx.x * NWAVES + wave, NGW = gridDim.x * NWAVES;
    float* scr = (float*)(lds + wave * 8704);
    const unsigned* cm = (const unsigned*)(p.ws + WS_CTL + CTL_COLMAX);
    constexpr int I_IN = 32 * 112, I_SQ = 32 * 64, I_L = I_IN + I_SQ + (GEMM3_I8 ? I_SQ : 0);
    for (int it = gw; it < 2 * I_L; it += NGW) {
        const int l = it / I_L; const int r = it % I_L;
        if (r < I_IN) transpose_item_i8(p.w_in + (size_t)l * DM * INW, DM, INW, (unsigned char*)(p.ws + WS_WIN) + (size_t)l * INW * DM, nullptr, cm + l * NCM, scr, r, lane);
        else if (r < I_IN + I_SQ) transpose_item_i8(p.w_out + (size_t)l * DM * DM, DM, DM, (unsigned char*)(p.ws + WS_WOUT) + (size_t)l * DM * DM, p.g_group + l * DM, cm + l * NCM + INW, scr, r - I_IN, lane);
        else transpose_item_i8(p.peer_wq + (size_t)l * DM * DM, DM, DM, (unsigned char*)(p.ws + WS_WQ) + (size_t)l * DM * DM, nullptr, cm + l * NCM + INW + DM, scr, r - I_IN - I_SQ, lane);
    }
    float* S = (float*)(p.ws + WS_SCL);
    for (int i = blockIdx.x * NTHREADS + tid; i < 2 * NCM; i += gridDim.x * NTHREADS) {
        const int l = i / NCM, n = i % NCM;
        const float m = __uint_as_float(cm[i]); const float s = m > 0.f ? m * (1.f / 127.f) : 1.f;
        if (n < INW) S[SCL_WIN + l * INW + n] = s; else if (n < INW + DM) S[SCL_WOUT + l * DM + (n - INW)] = s; else S[SCL_WQ + l * DM + (n - INW - DM)] = s;
    }
}

__device__ __forceinline__ void w8_strip(const float* W, int N, int n0, const float* gk, unsigned char* W8, float* scl, unsigned char* lds) {
    constexpr int TP = 2048 + 8;
    bf16_t* T = (bf16_t*)lds;
    unsigned* cmx = (unsigned*)(lds + 32 * TP * 2);
    const int tid = threadIdx.x, nq = tid & 7, kr = tid >> 3;
    __syncthreads();
    if (tid < 32) cmx[tid] = 0u;
    float m0 = 0.f, m1 = 0.f, m2 = 0.f, m3 = 0.f;
#pragma unroll 1
    for (int s0 = 0; s0 < 32; s0 += 8) {
        f32x4 v[8];
#pragma unroll
        for (int i = 0; i < 8; ++i) v[i] = *(const f32x4*)(W + (size_t)((s0 + i) * 64 + kr) * N + n0 + 4 * nq);
#pragma unroll
        for (int i = 0; i < 8; ++i) {
            const int k = (s0 + i) * 64 + kr;
            const float g = gk ? gk[k] : 1.f;
            const float a = v[i].x * g, b = v[i].y * g, c = v[i].z * g, d = v[i].w * g;
            m0 = fmaxf(m0, fabsf(a)); m1 = fmaxf(m1, fabsf(b)); m2 = fmaxf(m2, fabsf(c)); m3 = fmaxf(m3, fabsf(d));
            T[(4 * nq + 0) * TP + k] = (bf16_t)f2bf(a); T[(4 * nq + 1) * TP + k] = (bf16_t)f2bf(b); T[(4 * nq + 2) * TP + k] = (bf16_t)f2bf(c); T[(4 * nq + 3) * TP + k] = (bf16_t)f2bf(d);
        }
    }
    __syncthreads();
    atomicMax(cmx + 4 * nq + 0, __float_as_uint(m0)); atomicMax(cmx + 4 * nq + 1, __float_as_uint(m1));
    atomicMax(cmx + 4 * nq + 2, __float_as_uint(m2)); atomicMax(cmx + 4 * nq + 3, __float_as_uint(m3));
    __syncthreads();
    const int n = tid >> 4, kc = tid & 15;
    const float cm = __uint_as_float(cmx[n]); const float inv = cm > 0.f ? 127.f / cm : 0.f;
    if (kc == 0) scl[n0 + n] = cm > 0.f ? cm * (1.f / 127.f) : 1.f;
#pragma unroll 4
    for (int s = 0; s < 16; ++s) {
        const int k = s * 128 + kc * 8;
        const u32x4 q = *(const u32x4*)(T + n * TP + k);
        u32x2 o;
        o.x = q8pack4(bflo(q.x), bfhi(q.x), bflo(q.y), bfhi(q.y), inv); o.y = q8pack4(bflo(q.z), bfhi(q.z), bflo(q.w), bfhi(q.w), inv);
        *(u32x2*)(W8 + (size_t)(n0 + n) * 2048 + k) = o;
    }
}
__device__ __forceinline__ void cvt_range(const float* src, bf16_t* dst, size_t n8, size_t gtid, size_t gthreads) {
    for (size_t i = gtid; i < n8; i += gthreads) {
        const f32x4 a = *(const f32x4*)(src + i * 8), b = *(const f32x4*)(src + i * 8 + 4);
        u32x4 o; o.x = pk2(a.x, a.y); o.y = pk2(a.z, a.w); o.z = pk2(b.x, b.y); o.w = pk2(b.z, b.w);
        *(u32x4*)(dst + i * 8) = o;
    }
}

#if GATHER_I8 && GATHER_4BIT
__device__ __forceinline__ void conv4_row(const f32x4 (&v)[8], const bool isv, unsigned char* drow, int lane, float* rowscale) {
    float am = 0.f;
#pragma unroll
    for (int i = 0; i < 8; ++i) am = fmaxf(am, fmaxf(fmaxf(fabsf(v[i].x), fabsf(v[i].y)), fmaxf(fabsf(v[i].z), fabsf(v[i].w))));
    if (V_ROWSCALE && isv) am = wave_max(am);
    const float s0 = am > 0.f ? am * (isv ? (1.f / 6.f) : (1.f / 7.f)) : 1.f;
    const unsigned sb = (__float_as_uint(s0) + 0xffffu) >> 16;
    const float inv = 1.f / __uint_as_float(sb << 16);
    u32x4 o; unsigned w[4];
#pragma unroll
    for (int d = 0; d < 4; ++d) {
        const f32x4 a = v[2 * d], b = v[2 * d + 1];
        const float e[8] = {a.x * inv, a.y * inv, a.z * inv, a.w * inv, b.x * inv, b.y * inv, b.z * inv, b.w * inv};
        unsigned acc = 0u;
        if (isv) {
            acc = __builtin_amdgcn_cvt_scalef32_pk_fp4_f32(acc, e[0], e[1], 1.0f, 0);
            acc = __builtin_amdgcn_cvt_scalef32_pk_fp4_f32(acc, e[2], e[3], 1.0f, 1);
            acc = __builtin_amdgcn_cvt_scalef32_pk_fp4_f32(acc, e[4], e[5], 1.0f, 2);
            acc = __builtin_amdgcn_cvt_scalef32_pk_fp4_f32(acc, e[6], e[7], 1.0f, 3);
        } else {
#pragma unroll
            for (int i = 0; i < 8; ++i) {
                const int q = (int)fminf(fmaxf(rintf(e[i]), -7.f), 7.f);
                acc |= ((unsigned)q & 0xFu) << (8 * (i >> 1) + 4 * (i & 1));
            }
        }
        w[d] = acc;
    }
    o.x = w[0]; o.y = w[1]; o.z = w[2]; o.w = w[3];
    *(u32x4*)(drow + lane * 16) = o;
    if (V_ROWSCALE && isv) { if (lane == 0) *rowscale = __uint_as_float(sb << 16); }
    else *(unsigned short*)(drow + 1024 + lane * 2) = (unsigned short)sb;
}
#endif
#if GATHER_I8 && GATHER_4BIT
#ifndef TABLES_IN_GAPS
#define TABLES_IN_GAPS 1
#endif
__device__ __forceinline__ void conv4_tables(const Params& p, int r0, int r1, unsigned* ctr, unsigned char* lds) {
    const int tid = threadIdx.x, lane = tid & 63, wave = tid >> 6;
    unsigned char* ws = p.ws;
    volatile unsigned* shw = (volatile unsigned*)(lds + LDS_BYTES - 64);
    const int nchunk = (r1 - r0) / 64;
    for (int it = 0;; ++it) {
        int cbeg, cstep, cend;
        if (ctr) {
            __syncthreads();
            if (tid == 0) *shw = atomicAdd(ctr, 1u);
            __syncthreads();
            const int c = (int)*shw; if (c >= nchunk) break;
            cbeg = r0 + c * 64 + wave; cstep = NWAVES; cend = r0 + c * 64 + 64;
        } else {
            if (it > 0) break;
            cbeg = r0 + blockIdx.x * NWAVES + wave; cstep = gridDim.x * NWAVES; cend = r1;
        }
        for (int r = cbeg; r < cend; r += 2 * cstep) {
            const int r2 = r + cstep; const bool has2 = r2 < cend; const int rb = has2 ? r2 : r;
            const bool isvA = r >= 2 * NEXP, isvB = rb >= 2 * NEXP; const int rrA = isvA ? r - 2 * NEXP : r, rrB = isvB ? rb - 2 * NEXP : rb;
            const float* srowA = (isvA ? p.peer_v : p.peer_u) + (size_t)rrA * DM;
            const float* srowB = (isvB ? p.peer_v : p.peer_u) + (size_t)rrB * DM;
            f32x4 va[8], vb[8];
#pragma unroll
            for (int j = 0; j < 2; ++j)
#pragma unroll
                for (int k = 0; k < 4; ++k) { va[j * 4 + k] = *(const f32x4*)(srowA + j * 1024 + lane * 16 + k * 4); vb[j * 4 + k] = *(const f32x4*)(srowB + j * 1024 + lane * 16 + k * 4); }
            conv4_row(va, isvA, (unsigned char*)(ws + (isvA ? WS_VT : WS_UT)) + (size_t)rrA * (isvA ? ROWV : ROW4), lane, (float*)(ws + WS_VSC) + rrA);
            if (has2) conv4_row(vb, isvB, (unsigned char*)(ws + (isvB ? WS_VT : WS_UT)) + (size_t)rrB * (isvB ? ROWV : ROW4), lane, (float*)(ws + WS_VSC) + rrB);
        }
    }
}
#endif
__device__ __forceinline__ void ph_prologue(const Params& p, unsigned char* lds) {
    const int tid = threadIdx.x, lane = tid & 63, wave = tid >> 6;
    const int gw = blockIdx.x * NWAVES + wave, NGW = gridDim.x * NWAVES;
    unsigned char* ws = p.ws;
    {
        float* sT = (float*)lds;
        float* red = (float*)(lds + 2048 * 12 * 4);
        for (int i = tid; i < 2048 * 9; i += NTHREADS) {
            const int k = i / 9, bb = i % 9;
            const float v = bb < 8 ? p.c[bb * DM + k] : p.c_ctx[k];
            sT[k * 12 + bb] = silu(v);
        }
        __syncthreads();
        const int cq = lane & 7, ks = tid >> 3;
        for (int u = blockIdx.x; u < 768; u += gridDim.x) {
            const int l = u / 384, n0 = (u % 384) * 32;
            const float* W = p.w_ada + (size_t)l * DM * 12288 + n0 + cq * 4;
            float acc[9][4];
#pragma unroll
            for (int b = 0; b < 9; ++b)
#pragma unroll
                for (int j = 0; j < 4; ++j) acc[b][j] = 0.f;
#pragma unroll 8
            for (int i = 0; i < 32; ++i) {
                const int k = ks + 64 * i;
                const f32x4 w = *(const f32x4*)(W + (size_t)k * 12288);
                const f32x4 s0 = *(const f32x4*)(sT + k * 12), s1 = *(const f32x4*)(sT + k * 12 + 4);
                const float s8 = sT[k * 12 + 8];
                const float sv[9] = {s0.x, s0.y, s0.z, s0.w, s1.x, s1.y, s1.z, s1.w, s8};
#pragma unroll
                for (int b = 0; b < 9; ++b) { acc[b][0] += sv[b] * w.x; acc[b][1] += sv[b] * w.y; acc[b][2] += sv[b] * w.z; acc[b][3] += sv[b] * w.w; }
            }
#pragma unroll
            for (int b = 0; b < 9; ++b)
#pragma unroll
                for (int j = 0; j < 4; ++j) {
                    float v = acc[b][j];
                    v += __shfl_xor(v, 8); v += __shfl_xor(v, 16); v += __shfl_xor(v, 32);
                    acc[b][j] = v;
                }
            if (lane < 8) {
#pragma unroll
                for (int b = 0; b < 9; ++b)
#pragma unroll
                    for (int j = 0; j < 4; ++j) red[(wave * 8 + cq) * 36 + b * 4 + j] = acc[b][j];
            }
            __syncthreads();
            if (tid < 288) {
                const int b = tid / 32, col = tid % 32, q = col >> 2, j = col & 3;
                float s = 0.f;
#pragma unroll
                for (int w = 0; w < 8; ++w) s += red[(w * 8 + q) * 36 + b * 4 + j];
                const int n = n0 + col;
                ((float*)(ws + WS_MOD))[(size_t)(l * 9 + b) * 12288 + n] = s + p.b_ada[l * 12288 + n];
            }
            __syncthreads();
        }
    }
    __syncthreads();
#if GEMM_I8 && GEMM3_I8 && W8_ONEPASS
    {
        float* S = (float*)(ws + WS_SCL);
        constexpr int ST_IN = INW / 32, ST_SQ = DM / 32, ST_L = ST_IN + 2 * ST_SQ;
        for (int it = blockIdx.x; it < 2 * ST_L; it += gridDim.x) {
            const int l = it / ST_L; int r = it % ST_L;
            if (r < ST_IN) { w8_strip(p.w_in + (size_t)l * DM * INW, INW, r * 32, nullptr, (unsigned char*)(ws + WS_WIN) + (size_t)l * INW * DM, S + SCL_WIN + l * INW, lds); continue; }
            r -= ST_IN;
            if (r < ST_SQ) { w8_strip(p.w_out + (size_t)l * DM * DM, DM, r * 32, p.g_group + l * DM, (unsigned char*)(ws + WS_WOUT) + (size_t)l * DM * DM, S + SCL_WOUT + l * DM, lds); continue; }
            r -= ST_SQ;
            w8_strip(p.peer_wq + (size_t)l * DM * DM, DM, r * 32, nullptr, (unsigned char*)(ws + WS_WQ) + (size_t)l * DM * DM, S + SCL_WQ + l * DM, lds);
        }
        __syncthreads();
    }
#else
    {
        float* scr = (float*)(lds + wave * 8704);
        constexpr int I_IN = 32 * 112, I_SQ = 32 * 64, I_L = I_IN + 2 * I_SQ;
        unsigned* cm = (unsigned*)(ws + WS_CTL + CTL_COLMAX);
        for (int it = gw; it < 2 * I_L; it += NGW) {
            const int l = it / I_L; int r = it % I_L;
            if (r < I_IN) {
                if (GEMM_I8) colmax_item(p.w_in + (size_t)l * DM * INW, INW, nullptr, cm + l * NCM, r, lane);
                else transpose_item(p.w_in + (size_t)l * DM * INW, DM, INW, (bf16_t*)(ws + WS_WIN) + (size_t)l * INW * DM, nullptr, scr, r, lane);
                continue; }
            r -= I_IN;
            if (r < I_SQ) {
                if (GEMM_I8) colmax_item(p.w_out + (size_t)l * DM * DM, DM, p.g_group + l * DM, cm + l * NCM + INW, r, lane);
                else transpose_item(p.w_out + (size_t)l * DM * DM, DM, DM, (bf16_t*)(ws + WS_WOUT) + (size_t)l * DM * DM, p.g_group + l * DM, scr, r, lane);
                continue; }
            r -= I_SQ;
            if (GEMM_I8 && GEMM3_I8) colmax_item(p.peer_wq + (size_t)l * DM * DM, DM, nullptr, cm + l * NCM + INW + DM, r, lane);
            else transpose_item(p.peer_wq + (size_t)l * DM * DM, DM, DM, (bf16_t*)(ws + WS_WQ) + (size_t)l * DM * DM, nullptr, scr, r, lane);
        }
    }
#endif
    {
        const size_t gtid = (size_t)blockIdx.x * NTHREADS + tid, gth = (size_t)gridDim.x * NTHREADS;
        cvt_range(p.peer_keys, (bf16_t*)(ws + WS_KEYS), (size_t)2 * 8 * 2 * 128 * 128 / 8, gtid, gth);
        cvt_range(p.ws_c, (bf16_t*)(ws + WS_WSC), (size_t)2 * 4 * 128 * 128 / 8, gtid, gth);
#if GATHER_I8 && GATHER_4BIT
        if (!TABLES_IN_GAPS) conv4_tables(p, 0, 4 * NEXP, nullptr, lds);
#elif GATHER_I8
        for (int r = gw; r < 4 * NEXP; r += NGW) {
            const bool isv = r >= 2 * NEXP; const int rr = isv ? r - 2 * NEXP : r;
            const float* srow = (isv ? p.peer_v : p.peer_u) + (size_t)rr * DM;
            f32x4 v[8]; float am = 0.f;
#pragma unroll
            for (int j = 0; j < 2; ++j)
#pragma unroll
                for (int k = 0; k < 4; ++k) {
                    v[j * 4 + k] = *(const f32x4*)(srow + j * 1024 + lane * 16 + k * 4);
                    am = fmaxf(am, fmaxf(fmaxf(fabsf(v[j * 4 + k].x), fabsf(v[j * 4 + k].y)), fmaxf(fabsf(v[j * 4 + k].z), fabsf(v[j * 4 + k].w))));
                }
            am = wave_max(am);
            const float s = am > 0.f ? am * (isv ? (1.f / 443.f) : (1.f / 127.f)) : 1.f, inv = 1.f / s;
            unsigned char* drow = (unsigned char*)(ws + (isv ? WS_VT : WS_UT)) + (size_t)rr * DM;
#pragma unroll
            for (int j = 0; j < 2; ++j) {
                u32x4 o; unsigned w[4];
#pragma unroll
                for (int k = 0; k < 4; ++k) {
                    const f32x4 a = v[j * 4 + k];
                    if (isv) {
                        int pk = __builtin_amdgcn_cvt_pk_fp8_f32(a.x * inv, a.y * inv, 0, false);
                        pk = __builtin_amdgcn_cvt_pk_fp8_f32(a.z * inv, a.w * inv, pk, true);
                        w[k] = (unsigned)pk;
                    } else {
                        const int q0 = (int)rintf(a.x * inv), q1 = (int)rintf(a.y * inv), q2 = (int)rintf(a.z * inv), q3 = (int)rintf(a.w * inv);
                        w[k] = ((unsigned)q0 & 0xffu) | (((unsigned)q1 & 0xffu) << 8) | (((unsigned)q2 & 0xffu) << 16) | ((unsigned)q3 << 24);
                    }
                }
                o.x = w[0]; o.y = w[1]; o.z = w[2]; o.w = w[3];
                *(u32x4*)(drow + j * 1024 + lane * 16) = o;
            }
            if (lane == 0) ((float*)(ws + (isv ? WS_VSC : WS_USC)))[rr] = s;
        }
#else
        cvt_range(p.peer_u, (bf16_t*)(ws + WS_UT), (size_t)2 * NEXP * DM / 8, gtid, gth);
        cvt_range(p.peer_v, (bf16_t*)(ws + WS_VT), (size_t)2 * NEXP * DM / 8, gtid, gth);
#endif
        float* rope = (float*)(ws + WS_ROPE);
        for (size_t i = gtid; i < (size_t)2048 * 64; i += gth) {
            const int t = (int)(i >> 6), f = (int)(i & 63), fi = f & 31;
            const float pos = (f < 32) ? (float)(t >> 6) : (float)(t & 63);
            const float inv = powf(10000.0f, -(float)fi / 32.0f);
            const float ang = pos * inv;
            rope[i * 2] = cosf(ang); rope[i * 2 + 1] = sinf(ang);
        }
    }
}


__device__ __forceinline__ void modulate_store(const f32x4 (&v)[8], float rstd, const float* g, const float* shift, const float* scale, bf16_t* dst, int lane) {
#pragma unroll
    for (int j = 0; j < 8; ++j) {
        const int col = j * 256 + lane * 4;
        const f32x4 gg = *(const f32x4*)(g + col), sc = *(const f32x4*)(scale + col), sh = *(const f32x4*)(shift + col);
        const f32x4 o = v[j] * rstd * gg * (1.f + sc) + sh;
        u32x2 w; w.x = pk2(o.x, o.y); w.y = pk2(o.z, o.w);
        *(u32x2*)(dst + col) = w;
    }
}
__device__ __forceinline__ void modulate_store_i8(const f32x4 (&v)[8], float rstd, const float* g, const float* shift, const float* scale, unsigned char* dst, float* sdst, int lane, const float levels) {
    f32x4 o[8]; float am = 0.f;
#pragma unroll
    for (int j = 0; j < 8; ++j) {
        const int col = j * 256 + lane * 4;
        const f32x4 gg = *(const f32x4*)(g + col), sc = *(const f32x4*)(scale + col), sh = *(const f32x4*)(shift + col);
        o[j] = v[j] * rstd * gg * (1.f + sc) + sh;
        am = fmaxf(am, fmaxf(fmaxf(fabsf(o[j].x), fabsf(o[j].y)), fmaxf(fabsf(o[j].z), fabsf(o[j].w))));
    }
    am = wave_max(am);
    const float s = am > 0.f ? am / levels : 1.f, inv = 1.f / s;
#pragma unroll
    for (int j = 0; j < 8; ++j) *(unsigned*)(dst + j * 256 + lane * 4) = q8pack4(o[j].x, o[j].y, o[j].z, o[j].w, inv);
    if (lane == 0) *sdst = s;
}
__device__ __forceinline__ void ph_modulate(const Params& p, int l, int which) {
    const int tid = threadIdx.x, lane = tid & 63, wave = tid >> 6;
    const int gw = blockIdx.x * NWAVES + wave, NGW = gridDim.x * NWAVES;
    const int nrows = (which == 1 && l == DEPTH - 1) ? NLAT : MTOT;
    const float* g = (which == 0 ? p.norm1_g : p.norm2_g) + l * DM;
    const float* mod = (const float*)(p.ws + WS_MOD) + (size_t)l * 9 * 12288;
    const float* srcLat = (which == 0 && l == 0) ? p.x : p.out;
    const float* srcCtx = (which == 0 && l == 0) ? p.ctx : (const float*)(p.ws + WS_HC);
    bf16_t* XN = (bf16_t*)(p.ws + WS_XN);
    const int moff = (which == 0 ? 0 : 3) * DM;
#pragma unroll 1
    for (int r = gw; r < nrows; r += 2 * NGW) {
        const int r2 = r + NGW; const bool has2 = r2 < nrows; const int rb = has2 ? r2 : r;
        const float* srcA = r < NLAT ? srcLat + (size_t)r * DM : srcCtx + (size_t)(r - NLAT) * DM;
        const float* srcB = rb < NLAT ? srcLat + (size_t)rb * DM : srcCtx + (size_t)(rb - NLAT) * DM;
        f32x4 va[8], vb[8]; float sa = 0.f, sb = 0.f;
        if (H_BF16 && GEMM_I8 && GEMM3_I8 && which == 1) {
            const bf16_t* HB = (const bf16_t*)(p.ws + WS_HB);
#pragma unroll
            for (int j = 0; j < 8; ++j) {
                const u32x2 ra = *(const u32x2*)(HB + (size_t)r * DM + j * 256 + lane * 4), rb2 = *(const u32x2*)(HB + (size_t)rb * DM + j * 256 + lane * 4);
                va[j] = (f32x4){bflo(ra.x), bfhi(ra.x), bflo(ra.y), bfhi(ra.y)}; vb[j] = (f32x4){bflo(rb2.x), bfhi(rb2.x), bflo(rb2.y), bfhi(rb2.y)};
            }
        } else {
#pragma unroll
        for (int j = 0; j < 8; ++j) { va[j] = *(const f32x4*)(srcA + j * 256 + lane * 4); vb[j] = *(const f32x4*)(srcB + j * 256 + lane * 4); }
        }
#pragma unroll
        for (int j = 0; j < 8; ++j) { sa += va[j].x * va[j].x + va[j].y * va[j].y + va[j].z * va[j].z + va[j].w * va[j].w; sb += vb[j].x * vb[j].x + vb[j].y * vb[j].y + vb[j].z * vb[j].z + vb[j].w * vb[j].w; }
        sa = wave_sum(sa); sb = wave_sum(sb);
        const float* shA = mod + (size_t)(r < NLAT ? (r >> 11) : 8) * 12288 + moff;
        const bool i8 = GEMM_I8 && (which == 0 || GEMM3_I8); const float lv = which == 0 ? 127.f : 119.f;
        unsigned char* XN8 = (unsigned char*)(p.ws + WS_XN8); float* SXN = (float*)(p.ws + WS_SCL) + SCL_XN;
        if (i8) modulate_store_i8(va, rsqrtf(sa * (1.f / DM) + EPS), g, shA, shA + DM, XN8 + (size_t)r * DM, SXN + r, lane, lv);
        else modulate_store(va, rsqrtf(sa * (1.f / DM) + EPS), g, shA, shA + DM, XN + (size_t)r * DM, lane);
        if (has2) {
            const float* shB = mod + (size_t)(r2 < NLAT ? (r2 >> 11) : 8) * 12288 + moff;
            if (i8) modulate_store_i8(vb, rsqrtf(sb * (1.f / DM) + EPS), g, shB, shB + DM, XN8 + (size_t)r2 * DM, SXN + r2, lane, lv);
            else modulate_store(vb, rsqrtf(sb * (1.f / DM) + EPS), g, shB, shB + DM, XN + (size_t)r2 * DM, lane);
        }
    }
}

struct EpiBf16Store {
    bf16_t* O; int ldc;
    __device__ __forceinline__ void operator()(int row, int col, const float* a) const {
        u32x4 w; w.x = pk2(a[0], a[1]); w.y = pk2(a[2], a[3]); w.z = pk2(a[4], a[5]); w.w = pk2(a[6], a[7]);
        *(u32x4*)(O + (size_t)row * ldc + col) = w;
    }
};
struct EpiResGate {
    const float *resLat, *resCtx; float *outLat, *outCtx; const float* gate;
    __device__ __forceinline__ void operator()(int row, int col, const float* a) const {
        const int bb = row < NLAT ? (row >> 11) : 8;
        const float* gp = gate + (size_t)bb * 12288 + col;
        const float* rp = row < NLAT ? resLat + (size_t)row * DM + col : resCtx + (size_t)(row - NLAT) * DM + col;
        float* op = row < NLAT ? outLat + (size_t)row * DM + col : outCtx + (size_t)(row - NLAT) * DM + col;
        const f32x4 g0 = *(const f32x4*)gp, g1 = *(const f32x4*)(gp + 4), r0 = *(const f32x4*)rp, r1 = *(const f32x4*)(rp + 4);
        f32x4 o0, o1;
        o0.x = r0.x + g0.x * a[0]; o0.y = r0.y + g0.y * a[1]; o0.z = r0.z + g0.z * a[2]; o0.w = r0.w + g0.w * a[3];
        o1.x = r1.x + g1.x * a[4]; o1.y = r1.y + g1.y * a[5]; o1.z = r1.z + g1.z * a[6]; o1.w = r1.w + g1.w * a[7];
        *(f32x4*)op = o0; *(f32x4*)(op + 4) = o1;
    }
};
template <class Epi>
__device__ __forceinline__ void gemm_naive(unsigned char* lds, const bf16_t* A, const bf16_t* Bt, int M, int N, int K, const Epi& E) {
    float* As = (float*)lds;
    float* Bs = As + 32 * 132;
    const int tid = threadIdx.x, tx = tid & 15, ty = tid >> 4;
    const int lrow = tid >> 2, lkc = (tid & 3) * 8;
    const int nM = M / 128, nN = N / 128;
    for (int u = blockIdx.x; u < nM * nN; u += gridDim.x) {
        const int pm = u / nN, pn = u % nN, m0 = pm * 128, n0 = pn * 128;
        float acc[4][8];
#pragma unroll
        for (int i = 0; i < 4; ++i)
#pragma unroll
            for (int j = 0; j < 8; ++j) acc[i][j] = 0.f;
        for (int k0 = 0; k0 < K; k0 += 32) {
            const u32x4 av = *(const u32x4*)(A + (size_t)(m0 + lrow) * K + k0 + lkc);
            const u32x4 bv = *(const u32x4*)(Bt + (size_t)(n0 + lrow) * K + k0 + lkc);
            __syncthreads();
            As[(lkc + 0) * 132 + lrow] = bflo(av.x); As[(lkc + 1) * 132 + lrow] = bfhi(av.x);
            As[(lkc + 2) * 132 + lrow] = bflo(av.y); As[(lkc + 3) * 132 + lrow] = bfhi(av.y);
            As[(lkc + 4) * 132 + lrow] = bflo(av.z); As[(lkc + 5) * 132 + lrow] = bfhi(av.z);
            As[(lkc + 6) * 132 + lrow] = bflo(av.w); As[(lkc + 7) * 132 + lrow] = bfhi(av.w);
            Bs[(lkc + 0) * 132 + lrow] = bflo(bv.x); Bs[(lkc + 1) * 132 + lrow] = bfhi(bv.x);
            Bs[(lkc + 2) * 132 + lrow] = bflo(bv.y); Bs[(lkc + 3) * 132 + lrow] = bfhi(bv.y);
            Bs[(lkc + 4) * 132 + lrow] = bflo(bv.z); Bs[(lkc + 5) * 132 + lrow] = bfhi(bv.z);
            Bs[(lkc + 6) * 132 + lrow] = bflo(bv.w); Bs[(lkc + 7) * 132 + lrow] = bfhi(bv.w);
            __syncthreads();
#pragma unroll 8
            for (int k = 0; k < 32; ++k) {
                const f32x4 a = *(const f32x4*)(As + k * 132 + ty * 4);
                const f32x4 b0 = *(const f32x4*)(Bs + k * 132 + tx * 8), b1 = *(const f32x4*)(Bs + k * 132 + tx * 8 + 4);
                const float av4[4] = {a.x, a.y, a.z, a.w};
                const float bv8[8] = {b0.x, b0.y, b0.z, b0.w, b1.x, b1.y, b1.z, b1.w};
#pragma unroll
                for (int i = 0; i < 4; ++i)
#pragma unroll
                    for (int j = 0; j < 8; ++j) acc[i][j] += av4[i] * bv8[j];
            }
        }
#pragma unroll
        for (int i = 0; i < 4; ++i) E(m0 + ty * 4 + i, n0 + tx * 8, acc[i]);
    }
}

namespace pg8 {
#define PG8_LAS __attribute__((address_space(3)))
typedef unsigned short bf16_t;
typedef short bf16x8 __attribute__((ext_vector_type(8)));
typedef float f32x4 __attribute__((ext_vector_type(4)));
typedef unsigned u32x4 __attribute__((ext_vector_type(4)));
constexpr int BM = 256, BK = 64, HALF = 128, HTB = HALF * BK * 2  , STAGE_BYTES = 8 * HTB, NXCD = 8, WGM = 8;

__host__ __device__ __forceinline__ int lds_byte(int r, int c) { const int st = (r >> 4) * 2 + (c >> 5), rr = r & 15, cc = c & 31, ob = rr * 64 + cc * 2; return st * 1024 + (ob ^ (((ob >> 9) & 1) << 5)); }
__host__ __device__ __forceinline__ void stage_rc(int b, int& R, int& C) { const int st = b / 1024, sb = b % 1024, swz = sb ^ (((sb >> 9) & 1) << 5); R = (st >> 1) * 16 + swz / 64; C = (st & 1) * 32 + (swz % 64) / 2; }
__host__ __device__ __forceinline__ int perm32(int rho) { const int n = rho >> 4, i = rho & 15; return 8 * (i >> 2) + 4 * n + (i & 3); }

struct Unit { int pm, pn; };
struct Gemm { const bf16_t* A; const bf16_t* Bt; int M, N, K; };

struct StaticOrder {
    int nM, nN, nwg, G, c;
    __host__ __device__ void init(int M, int N, int G_, int c_) { nM = M / BM; nN = N / BM; nwg = nM * nN; G = G_; c = c_; }
    __host__ __device__ bool next(int i, Unit& u) const {
        const long L = (long)i * G + c; if (L >= nwg) return false;
        int wgid = (int)L; { const int q = nwg / NXCD, r = nwg % NXCD, xcd = wgid % NXCD, off = wgid / NXCD; wgid = (xcd < r ? xcd * (q + 1) : r * (q + 1) + (xcd - r) * q) + off; }
        const int nig = WGM * nN, gid = wgid / nig, fm = gid * WGM, gsz = (nM - fm) < WGM ? (nM - fm) : WGM;
        u.pm = fm + ((wgid % nig) % gsz); u.pn = (wgid % nig) / gsz; return true;
    }
    __device__ __forceinline__ void a_ready(const Unit&) const {}
    __device__ __forceinline__ void done(const Unit&) const {}
};

__device__ __forceinline__ unsigned cvt_pk_bf16(float lo, float hi) { unsigned r; asm volatile("v_cvt_pk_bf16_f32 %0, %1, %2" : "=v"(r) : "v"(lo), "v"(hi)); return r; }
typedef float f32x2 __attribute__((ext_vector_type(2)));
__device__ __forceinline__ f32x2 gelu_pk(f32x2 v) {
    const f32x2 av = __builtin_elementwise_abs(v), d = av * 0.2316418882f + 1.0f;
    f32x2 t; t.x = __builtin_amdgcn_rcpf(d.x); t.y = __builtin_amdgcn_rcpf(d.y);
    f32x2 q = t * 0.5307027145f + (-0.7265760135f); q = q * t + 0.7107068705f; q = q * t + (-0.142248368f); q = q * t + 0.127414796f; q = q * t;
    const f32x2 s = (v * v) * (-0.72134752044f);
    f32x2 e; e.x = __builtin_amdgcn_exp2f(s.x); e.y = __builtin_amdgcn_exp2f(s.y);
    const f32x2 m = v * (q * e), r = v - m;
    f32x2 o; o.x = v.x < 0.f ? m.x : r.x; o.y = v.y < 0.f ? m.y : r.y; return o;
}

template <int ACT  > struct EpiBf16 {
    static constexpr bool PERM = true, AFTER_DRAIN = false; static_assert(ACT == 0 || ACT == 1, "EpiBf16: ACT is 0 (none) or 1 (gelu_pk)");
    bf16_t* O; int ldc; const float* bias; int split_cols; size_t split_stride; float scale0;
    __device__ __forceinline__ void operator()(const f32x4 (&acc)[2][2][4][2], const Unit& u, int wr, int wc, int fr, int fq) const {
        const int row0 = u.pm * BM + wr * 64 + fr; int colt = u.pn * BM; bf16_t* base = O;
        float sc = 1.f; if (split_cols) { const int t = colt / split_cols; base += (size_t)t * split_stride; colt -= t * split_cols; if (t == 0) sc = scale0; }
        const int col0 = colt + wc * 32 + 8 * fq, bcol0 = u.pn * BM + wc * 32 + 8 * fq;
        f32x4 bv[2][2];
#pragma unroll
        for (int bj = 0; bj < 2; ++bj)
#pragma unroll
            for (int n = 0; n < 2; ++n) bv[bj][n] = bias ? *(const f32x4*)(bias + bcol0 + bj * HALF + 4 * n) : (f32x4){0.f, 0.f, 0.f, 0.f};
#pragma unroll
        for (int ai = 0; ai < 2; ++ai)
#pragma unroll
            for (int m = 0; m < 4; ++m) { bf16_t* rowp = base + (size_t)(row0 + ai * HALF + m * 16) * ldc + col0;
#pragma unroll
                for (int bj = 0; bj < 2; ++bj) { f32x4 v0 = acc[ai][bj][m][0] + bv[bj][0], v1 = acc[ai][bj][m][1] + bv[bj][1];
                    if (ACT == 1) { f32x2 a = gelu_pk((f32x2){v0[0], v0[1]}), b = gelu_pk((f32x2){v0[2], v0[3]}), c = gelu_pk((f32x2){v1[0], v1[1]}), d = gelu_pk((f32x2){v1[2], v1[3]});
                        v0 = (f32x4){a.x, a.y, b.x, b.y}; v1 = (f32x4){c.x, c.y, d.x, d.y}; }
                    v0 = v0 * sc; v1 = v1 * sc; u32x4 w; w.x = cvt_pk_bf16(v0[0], v0[1]); w.y = cvt_pk_bf16(v0[2], v0[3]); w.z = cvt_pk_bf16(v1[0], v1[1]); w.w = cvt_pk_bf16(v1[2], v1[3]);
                    *(u32x4*)(rowp + bj * HALF) = w; } }
    }
};
typedef int i32x4 __attribute__((ext_vector_type(4)));
template <bool I8> struct AccSel { typedef f32x4 type; };
template <> struct AccSel<true> { typedef i32x4 type; };
template <class Epi, class Sched, bool ALIGN_EPI = false, bool SP2 = false, bool I8 = false>
__device__ __forceinline__ void gemm_phase(PG8_LAS unsigned char* lds, const Gemm g, const Sched& S, const Epi& E) {
    const int tid = threadIdx.x, wid = __builtin_amdgcn_readfirstlane(tid >> 6), lane = tid & 63, wr = wid >> 2, wc = wid & 3, fr = lane & 15, fq = lane >> 4;
    const int K = g.K, nt = K / BK;
    unsigned voffA[2], voffB[2];
#pragma unroll
    for (int i = 0; i < 2; ++i) { int R, C; stage_rc(tid * 16 + i * 8192, R, C); const int Rb = Epi::PERM ? ((R & ~31) + perm32(R & 31)) : R;
        voffA[i] = (unsigned)(R * K + C) * 2u; voffB[i] = (unsigned)(Rb * K + C) * 2u; }
    const size_t kstep = (size_t)(BK * 2);
    const size_t hstep = (size_t)HALF * K * 2;
    const size_t tstep = 2 * hstep;
    const unsigned ldsw = (unsigned)wid * 1024u;
    const int aoff = lds_byte(wr * 64 + fr, fq * 8), boff = lds_byte(wc * 32 + fr, fq * 8);
#define PG8_SA(b, h) (((b) * 2 + (h)) * HTB)
#define PG8_SB(b, h) ((4 + (b) * 2 + (h)) * HTB)
#define PG8_STAGE(bufoff, gbase, voff) do { _Pragma("unroll") for (int _i = 0; _i < 2; ++_i) \
        __builtin_amdgcn_global_load_lds((const unsigned*)((const char*)(gbase) + (voff)[_i]), (PG8_LAS unsigned*)(lds + (bufoff) + ldsw + _i * 8192), 16, 0, 0); } while (0)
#define PG8_LDA(dst, b, h) do { _Pragma("unroll") for (int m = 0; m < 4; ++m) _Pragma("unroll") for (int k = 0; k < 2; ++k) dst[m][k] = *(const PG8_LAS bf16x8*)(lds + PG8_SA(b, h) + aoff + m * 2048 + k * 1024); } while (0)
#define PG8_LDB(dst, b, h) do { _Pragma("unroll") for (int n = 0; n < 2; ++n) _Pragma("unroll") for (int k = 0; k < 2; ++k) dst[n][k] = *(const PG8_LAS bf16x8*)(lds + PG8_SB(b, h) + boff + n * 2048 + k * 1024); } while (0)
#define PG8_MMA(ai, bj, At, Bt) do { __builtin_amdgcn_s_setprio(1); _Pragma("unroll") for (int m = 0; m < 4; ++m) _Pragma("unroll") for (int n = 0; n < 2; ++n) _Pragma("unroll") for (int k = 0; k < 2; ++k) \
        { if constexpr (I8) acc[ai][bj][m][n] = __builtin_amdgcn_mfma_i32_16x16x64_i8(__builtin_bit_cast(i32x4, Bt[n][k]), __builtin_bit_cast(i32x4, At[m][k]), acc[ai][bj][m][n], 0, 0, 0); \
          else acc[ai][bj][m][n] = __builtin_amdgcn_mfma_f32_16x16x32_bf16(Bt[n][k], At[m][k], acc[ai][bj][m][n], 0, 0, 0); } __builtin_amdgcn_s_setprio(0); } while (0)
#define PG8_WAIT_V(n) asm volatile("s_waitcnt vmcnt(" #n ")" ::: "memory")
#define PG8_WAIT_L(n) asm volatile("s_waitcnt lgkmcnt(" #n ")" ::: "memory")
#define PG8_BAR __builtin_amdgcn_s_barrier()
#define PG8_SCHED __builtin_amdgcn_sched_barrier(0)
    Unit cur, nxt; int ui = 0;
    if (!S.next(0, cur)) return;
    typedef typename AccSel<I8>::type acc_t; const acc_t zero_ = {};
    acc_t acc[2][2][4][2];
#pragma unroll
    for (int a = 0; a < 2; ++a)
#pragma unroll
        for (int b = 0; b < 2; ++b)
#pragma unroll
            for (int m = 0; m < 4; ++m)
#pragma unroll
                for (int n = 0; n < 2; ++n) acc[a][b][m][n] = zero_;
    bf16x8 At[4][2], B0[2][2], B1[2][2];
    const char* cA = (const char*)g.A + (size_t)cur.pm * tstep; const char* cB = (const char*)g.Bt + (size_t)cur.pn * tstep;
    S.a_ready(cur);
    if constexpr (SP2) {
        PG8_STAGE(PG8_SB(0, 0), cB, voffB); PG8_STAGE(PG8_SB(0, 1), cB + hstep, voffB); PG8_STAGE(PG8_SA(0, 0), cA, voffA); PG8_STAGE(PG8_SA(0, 1), cA + hstep, voffA);
        if (wr == 1) PG8_BAR;
        PG8_WAIT_V(2); PG8_BAR;
        PG8_STAGE(PG8_SB(1, 0), cB + kstep, voffB); PG8_STAGE(PG8_SA(1, 0), cA + kstep, voffA); PG8_STAGE(PG8_SB(1, 1), cB + hstep + kstep, voffB);
        PG8_WAIT_V(6); PG8_BAR;
    } else {
        PG8_STAGE(PG8_SB(0, 0), cB, voffB); PG8_STAGE(PG8_SA(0, 0), cA, voffA); PG8_STAGE(PG8_SB(0, 1), cB + hstep, voffB); PG8_STAGE(PG8_SA(0, 1), cA + hstep, voffA);
        if (wr == 1) PG8_BAR;
        PG8_WAIT_V(4); PG8_BAR;
        PG8_STAGE(PG8_SB(1, 0), cB + kstep, voffB); PG8_STAGE(PG8_SA(1, 0), cA + kstep, voffA); PG8_STAGE(PG8_SB(1, 1), cB + hstep + kstep, voffB);
        PG8_WAIT_V(6); PG8_BAR;
    }
    for (;;) {
        const bool has_next = S.next(ui + 1, nxt);
        const char* nA = has_next ? (const char*)g.A + (size_t)nxt.pm * tstep : cA; const char* nB = has_next ? (const char*)g.Bt + (size_t)nxt.pn * tstep : cB;
        for (int t = 0; t < nt; t += 2) {
            const bool last = (t == nt - 2);
            const char* a1 = cA + (size_t)(t + 1) * kstep;
            const char* a2 = last ? nA : cA + (size_t)(t + 2) * kstep; const char* b2 = last ? nB : cB + (size_t)(t + 2) * kstep;
            const char* a3 = a2 + kstep; const char* b3 = b2 + kstep;
            if (last && has_next) S.a_ready(nxt);
            if constexpr (SP2) {
            PG8_LDB(B0, 0, 0); PG8_LDB(B1, 0, 1); PG8_SCHED; PG8_LDA(At, 0, 0); PG8_STAGE(PG8_SA(1, 1), a1 + hstep, voffA);
            PG8_WAIT_V(8); PG8_WAIT_L(0); PG8_BAR; PG8_MMA(0, 0, At, B0); PG8_MMA(0, 1, At, B1); PG8_BAR; PG8_SCHED;
            PG8_LDA(At, 0, 1); PG8_STAGE(PG8_SB(0, 0), b2, voffB); PG8_STAGE(PG8_SB(0, 1), b2 + hstep, voffB); PG8_STAGE(PG8_SA(0, 0), a2, voffA);
            PG8_WAIT_V(8); PG8_WAIT_L(0); PG8_BAR; PG8_MMA(1, 0, At, B0); PG8_MMA(1, 1, At, B1); PG8_BAR; PG8_SCHED;
            PG8_LDB(B0, 1, 0); PG8_LDB(B1, 1, 1); PG8_SCHED; PG8_LDA(At, 1, 0); PG8_STAGE(PG8_SA(0, 1), a2 + hstep, voffA);
            PG8_WAIT_V(8); PG8_WAIT_L(0); PG8_BAR; PG8_MMA(0, 0, At, B0); PG8_MMA(0, 1, At, B1); PG8_BAR; PG8_SCHED;
            PG8_LDA(At, 1, 1); PG8_STAGE(PG8_SB(1, 0), b3, voffB); PG8_STAGE(PG8_SB(1, 1), b3 + hstep, voffB); PG8_STAGE(PG8_SA(1, 0), a3, voffA);
            PG8_WAIT_V(8); PG8_WAIT_L(0); PG8_BAR; PG8_MMA(1, 0, At, B0); PG8_MMA(1, 1, At, B1); PG8_BAR; PG8_SCHED;
            } else {
            PG8_LDB(B0, 0, 0); PG8_SCHED; PG8_LDA(At, 0, 0); PG8_STAGE(PG8_SA(1, 1), a1 + hstep, voffA);
            PG8_WAIT_L(8); PG8_BAR; PG8_WAIT_L(0); PG8_MMA(0, 0, At, B0); PG8_BAR; PG8_SCHED;
            PG8_LDB(B1, 0, 1); PG8_STAGE(PG8_SB(0, 0), b2, voffB);
            PG8_BAR; PG8_WAIT_L(0); PG8_MMA(0, 1, At, B1); PG8_BAR;
            PG8_LDA(At, 0, 1); PG8_STAGE(PG8_SA(0, 0), a2, voffA);
            PG8_BAR; PG8_WAIT_L(0); PG8_MMA(1, 0, At, B0); PG8_BAR; PG8_SCHED;
            PG8_STAGE(PG8_SB(0, 1), b2 + hstep, voffB);
            PG8_WAIT_V(6); PG8_BAR; PG8_MMA(1, 1, At, B1); PG8_BAR;
            PG8_LDB(B0, 1, 0); PG8_SCHED; PG8_LDA(At, 1, 0); PG8_STAGE(PG8_SA(0, 1), a2 + hstep, voffA);
            PG8_WAIT_L(8); PG8_BAR; PG8_WAIT_L(0); PG8_MMA(0, 0, At, B0); PG8_BAR; PG8_SCHED;
            PG8_LDB(B1, 1, 1); PG8_STAGE(PG8_SB(1, 0), b3, voffB);
            PG8_BAR; PG8_WAIT_L(0); PG8_MMA(0, 1, At, B1); PG8_BAR;
            PG8_LDA(At, 1, 1); PG8_STAGE(PG8_SA(1, 0), a3, voffA);
            PG8_BAR; PG8_WAIT_L(0); PG8_MMA(1, 0, At, B0); PG8_BAR; PG8_SCHED;
            PG8_STAGE(PG8_SB(1, 1), b3 + hstep, voffB);
            PG8_WAIT_V(6); PG8_BAR; PG8_MMA(1, 1, At, B1); PG8_BAR;
            }
        }
        if constexpr (ALIGN_EPI) { if (wr == 0) PG8_BAR; }
        if constexpr (!Epi::AFTER_DRAIN) { E(acc, cur, wr, wc, fr, fq); S.done(cur); }
        if (!has_next) break;
#pragma unroll
        for (int a = 0; a < 2; ++a)
#pragma unroll
            for (int b = 0; b < 2; ++b)
#pragma unroll
                for (int m = 0; m < 4; ++m)
#pragma unroll
                    for (int n = 0; n < 2; ++n) acc[a][b][m][n] = zero_;
        cur = nxt; cA = nA; cB = nB; ++ui;
        if constexpr (ALIGN_EPI) { if (wr == 1) PG8_BAR; }
    }
    PG8_WAIT_V(0);
    if constexpr (!ALIGN_EPI) { if (wr == 0) PG8_BAR; }
    PG8_BAR;
    if constexpr (Epi::AFTER_DRAIN) { E.fused(acc, cur, wr, wc, fr, fq, lds, wid, lane); S.done(cur); }
#undef PG8_SA
#undef PG8_SB
#undef PG8_STAGE
#undef PG8_LDA
#undef PG8_LDB
#undef PG8_MMA
#undef PG8_WAIT_V
#undef PG8_WAIT_L
#undef PG8_BAR
#undef PG8_SCHED
}

struct EpiResGateT {
    static constexpr bool PERM = false, AFTER_DRAIN = false;
    const float *resLat, *resCtx; float *outLat, *outCtx; const float* gate;
    __device__ __forceinline__ void operator()(const f32x4 (&acc)[2][2][4][2], const Unit& u, int wr, int wc, int fr, int fq) const {
        const int trow = u.pm * BM, row0 = trow + wr * 64 + fr, col0 = u.pn * BM + wc * 32 + 4 * fq;
        const bool lat = trow < 16384;
        const int bb = lat ? (trow >> 11) : 8;
        const float* rbase = lat ? resLat + (size_t)row0 * 2048 : resCtx + (size_t)(row0 - 16384) * 2048;
        float* obase = lat ? outLat + (size_t)row0 * 2048 : outCtx + (size_t)(row0 - 16384) * 2048;
        f32x4 gv[2][2];
#pragma unroll
        for (int bj = 0; bj < 2; ++bj)
#pragma unroll
            for (int n = 0; n < 2; ++n) gv[bj][n] = *(const f32x4*)(gate + (size_t)bb * 12288 + col0 + bj * HALF + n * 16);
#pragma unroll
        for (int ai = 0; ai < 2; ++ai)
#pragma unroll
            for (int m = 0; m < 4; ++m) {
                const size_t off = (size_t)(ai * HALF + m * 16) * 2048 + col0;
#pragma unroll
                for (int bj = 0; bj < 2; ++bj)
#pragma unroll
                    for (int n = 0; n < 2; ++n) {
                        const f32x4 r = *(const f32x4*)(rbase + off + bj * HALF + n * 16);
                        *(f32x4*)(obase + off + bj * HALF + n * 16) = r + gv[bj][n] * acc[ai][bj][m][n];
                    }
            }
    }
};

struct EpiBf16I8 {
    static constexpr bool PERM = true, AFTER_DRAIN = false;
    bf16_t* O; int ldc; const float* sa; const float* sb;
    __device__ __forceinline__ void operator()(const i32x4 (&acc)[2][2][4][2], const Unit& u, int wr, int wc, int fr, int fq) const {
        const int row0 = u.pm * BM + wr * 64 + fr, col0 = u.pn * BM + wc * 32 + 8 * fq;
        f32x4 sv[2][2];
#pragma unroll
        for (int bj = 0; bj < 2; ++bj)
#pragma unroll
            for (int n = 0; n < 2; ++n) sv[bj][n] = *(const f32x4*)(sb + col0 + bj * HALF + 4 * n);
#pragma unroll
        for (int ai = 0; ai < 2; ++ai)
#pragma unroll
            for (int m = 0; m < 4; ++m) {
                const int row = row0 + ai * HALF + m * 16; const float s = sa[row];
                bf16_t* rowp = O + (size_t)row * ldc + col0;
#pragma unroll
                for (int bj = 0; bj < 2; ++bj) {
                    const i32x4 a0 = acc[ai][bj][m][0], a1 = acc[ai][bj][m][1];
                    const f32x4 v0 = (f32x4){(float)a0.x, (float)a0.y, (float)a0.z, (float)a0.w} * s * sv[bj][0];
                    const f32x4 v1 = (f32x4){(float)a1.x, (float)a1.y, (float)a1.z, (float)a1.w} * s * sv[bj][1];
                    u32x4 w; w.x = cvt_pk_bf16(v0[0], v0[1]); w.y = cvt_pk_bf16(v0[2], v0[3]); w.z = cvt_pk_bf16(v1[0], v1[1]); w.w = cvt_pk_bf16(v1[2], v1[3]);
                    *(u32x4*)(rowp + bj * HALF) = w;
                }
            }
    }
};
struct EpiResGateI8 {
    static constexpr bool PERM = false, AFTER_DRAIN = false;
    const float *resLat, *resCtx; float *outLat, *outCtx; const float* gate; const float* sa; const float* sb;
    __device__ __forceinline__ void operator()(const i32x4 (&acc)[2][2][4][2], const Unit& u, int wr, int wc, int fr, int fq) const {
        const int trow = u.pm * BM, row0 = trow + wr * 64 + fr, col0 = u.pn * BM + wc * 32 + 4 * fq;
        const bool lat = trow < 16384;
        const int bb = lat ? (trow >> 11) : 8;
        const float* rbase = lat ? resLat + (size_t)row0 * 2048 : resCtx + (size_t)(row0 - 16384) * 2048;
        float* obase = lat ? outLat + (size_t)row0 * 2048 : outCtx + (size_t)(row0 - 16384) * 2048;
        f32x4 gv[2][2];
#pragma unroll
        for (int bj = 0; bj < 2; ++bj)
#pragma unroll
            for (int n = 0; n < 2; ++n) gv[bj][n] = *(const f32x4*)(gate + (size_t)bb * 12288 + col0 + bj * HALF + n * 16) * *(const f32x4*)(sb + col0 + bj * HALF + n * 16);
#pragma unroll
        for (int ai = 0; ai < 2; ++ai)
#pragma unroll
            for (int m = 0; m < 4; ++m) {
                const size_t off = (size_t)(ai * HALF + m * 16) * 2048 + col0;
                const float s = sa[row0 + ai * HALF + m * 16];
#pragma unroll
                for (int bj = 0; bj < 2; ++bj)
#pragma unroll
                    for (int n = 0; n < 2; ++n) {
                        const f32x4 r = *(const f32x4*)(rbase + off + bj * HALF + n * 16);
                        const i32x4 a = acc[ai][bj][m][n];
                        *(f32x4*)(obase + off + bj * HALF + n * 16) = r + gv[bj][n] * ((f32x4){(float)a.x, (float)a.y, (float)a.z, (float)a.w} * s);
                    }
            }
    }
};

struct EpiResGateI8B {
    static constexpr bool PERM = true, AFTER_DRAIN = false;
    const float *resLat, *resCtx;
    bf16_t* hb; const float* gate; const float* sa; const float* sb;
    __device__ __forceinline__ void operator()(const i32x4 (&acc)[2][2][4][2], const Unit& u, int wr, int wc, int fr, int fq) const {
        const int trow = u.pm * BM, row0 = trow + wr * 64 + fr, col0 = u.pn * BM + wc * 32 + 8 * fq;
        const bool lat = trow < 16384;
        const int bb = lat ? (trow >> 11) : 8;
        f32x4 gv[2][2];
#pragma unroll
        for (int bj = 0; bj < 2; ++bj)
#pragma unroll
            for (int n = 0; n < 2; ++n) gv[bj][n] = *(const f32x4*)(gate + (size_t)bb * 12288 + col0 + bj * HALF + 4 * n) * *(const f32x4*)(sb + col0 + bj * HALF + 4 * n);
#pragma unroll
        for (int ai = 0; ai < 2; ++ai)
#pragma unroll
            for (int m = 0; m < 4; ++m) {
                const int row = row0 + ai * HALF + m * 16; const float s = sa[row];
                bf16_t* hp = hb + (size_t)row * 2048 + col0;
#pragma unroll
                for (int bj = 0; bj < 2; ++bj) {
                    f32x4 r0, r1;
                    if (resLat) {
                        const float* rp = (lat ? resLat + (size_t)row * 2048 : resCtx + (size_t)(row - 16384) * 2048) + col0 + bj * HALF;
                        r0 = *(const f32x4*)rp; r1 = *(const f32x4*)(rp + 4);
                    } else {
                        const u32x4 q = *(const u32x4*)(hp + bj * HALF);
                        r0 = (f32x4){__uint_as_float(q.x << 16), __uint_as_float(q.x & 0xffff0000u), __uint_as_float(q.y << 16), __uint_as_float(q.y & 0xffff0000u)};
                        r1 = (f32x4){__uint_as_float(q.z << 16), __uint_as_float(q.z & 0xffff0000u), __uint_as_float(q.w << 16), __uint_as_float(q.w & 0xffff0000u)};
                    }
                    const i32x4 a0 = acc[ai][bj][m][0], a1 = acc[ai][bj][m][1];
                    const f32x4 v0 = r0 + (gv[bj][0] * s) * (f32x4){(float)a0.x, (float)a0.y, (float)a0.z, (float)a0.w};
                    const f32x4 v1 = r1 + (gv[bj][1] * s) * (f32x4){(float)a1.x, (float)a1.y, (float)a1.z, (float)a1.w};
                    u32x4 w; w.x = cvt_pk_bf16(v0[0], v0[1]); w.y = cvt_pk_bf16(v0[2], v0[3]); w.z = cvt_pk_bf16(v1[0], v1[1]); w.w = cvt_pk_bf16(v1[2], v1[3]);
                    *(u32x4*)(hp + bj * HALF) = w;
                }
            }
    }
};
}
#ifndef USE_PG8
#define USE_PG8 1
#endif

__device__ __forceinline__ float sum16(float v) { v += __shfl_xor(v, 1); v += __shfl_xor(v, 2); v += __shfl_xor(v, 4); v += __shfl_xor(v, 8); return v; }
__device__ __forceinline__ void ph_prep(const Params& p, int l, const bool dry) {
    const int tid = threadIdx.x, lane = tid & 63, wave = tid >> 6, sub = lane >> 4, li = lane & 15;
    const int gw = blockIdx.x * NWAVES + wave, NGW = gridDim.x * NWAVES;
    bf16_t* P = (bf16_t*)(p.ws + WS_P);
    const float* rope = (const float*)(p.ws + WS_ROPE);
    const bool last = (l == DEPTH - 1);
    const int f0 = (li >= 8 ? 32 : 0) + 8 * (li & 3);
    const float sg = (li & 4) ? 1.f : -1.f;
#pragma unroll 1
    for (int r = gw; r < MTOT; r += NGW) {
        bf16_t* row = P + (size_t)r * INW;
        bf16_t* wrow = dry ? (bf16_t*)(p.ws + WS_DUMMY) + (size_t)r * INW : row;
        const bool isctx = r >= NLAT;
        const int t = r & (SEQ - 1);
        float cs[8], sn[8];
        if (!isctx) {
            const f32x4* rp = (const f32x4*)(rope + ((size_t)t * 64 + f0) * 2);
            const f32x4 a = rp[0], b = rp[1], c = rp[2], d = rp[3];
            cs[0] = a.x; sn[0] = a.y; cs[1] = a.z; sn[1] = a.w; cs[2] = b.x; sn[2] = b.y; cs[3] = b.z; sn[3] = b.w;
            cs[4] = c.x; sn[4] = c.y; cs[5] = c.z; sn[5] = c.w; cs[6] = d.x; sn[6] = d.y; cs[7] = d.z; sn[7] = d.w;
        } else {
#pragma unroll
            for (int i = 0; i < 8; ++i) { cs[i] = 1.f; sn[i] = 0.f; }
        }
        u32x4 raw[7];
#pragma unroll
        for (int gI = 0; gI < 7; ++gI) raw[gI] = *(const u32x4*)(row + (gI * 4 + sub) * 128 + li * 8);
#pragma unroll
        for (int gI = 0; gI < 7; ++gI) {
            const int slot = gI * 4 + sub;
            const int kind = slot < 8 ? 0 : slot < 10 ? 1 : slot < 18 ? 0 : slot < 20 ? 1 : slot < 24 ? 2 : 3;
            const bool isq = slot < 6 || (slot >= 10 && slot < 16);
            float x[8];
            x[0] = bflo(raw[gI].x); x[1] = bfhi(raw[gI].x); x[2] = bflo(raw[gI].y); x[3] = bfhi(raw[gI].y);
            x[4] = bflo(raw[gI].z); x[5] = bfhi(raw[gI].z); x[6] = bflo(raw[gI].w); x[7] = bfhi(raw[gI].w);
            if (kind >= 2) {
#pragma unroll
                for (int i = 0; i < 8; ++i) x[i] = gelu_tanh(x[i]);
            }
            float ss = 0.f;
#pragma unroll
            for (int i = 0; i < 8; ++i) ss += x[i] * x[i];
            ss = sum16(ss);
            const float rstd = rsqrtf(ss * (1.f / 128.f) + EPS);
            const float* gain = slot < 6 ? p.qn_a + l * 128 : slot < 8 ? p.kn_a + l * 128 : slot < 16 ? p.qn_b + l * 128 : slot < 20 ? p.kn_b + l * 128 : p.vn_c + l * 512 + (slot - 24) * 128;
            if (kind == 0 || kind == 3) {
                const f32x4 g0 = *(const f32x4*)(gain + li * 8), g1 = *(const f32x4*)(gain + li * 8 + 4);
                x[0] *= rstd * g0.x; x[1] *= rstd * g0.y; x[2] *= rstd * g0.z; x[3] *= rstd * g0.w;
                x[4] *= rstd * g1.x; x[5] *= rstd * g1.y; x[6] *= rstd * g1.z; x[7] *= rstd * g1.w;
            }
            float px[8];
#pragma unroll
            for (int i = 0; i < 8; ++i) px[i] = __shfl_xor(x[i], 4);
            if (kind == 0) {
#pragma unroll
                for (int i = 0; i < 8; ++i) x[i] = x[i] * cs[i] + sg * px[i] * sn[i];
            }
            bool wr = kind != 1;
            if (isctx && last && (isq || kind >= 2)) wr = false;
            if (wr) { u32x4 o; o.x = pk2(x[0], x[1]); o.y = pk2(x[2], x[3]); o.z = pk2(x[4], x[5]); o.w = pk2(x[6], x[7]); *(u32x4*)(wrow + slot * 128 + li * 8) = o; }
        }
    }
}

__device__ __forceinline__ void attn_row_naive(const bf16_t* q, const bf16_t* kc, const bf16_t* vc, const bf16_t* kl, const bf16_t* vl, int j0, int j1,
                                               bool has_sink, float sink, bf16_t* o, int lane) {
    const unsigned qq = *(const unsigned*)(q + 2 * lane);
    const float q0 = bflo(qq), q1 = bfhi(qq);
    float m = -INFINITY, lsum = 0.f, o0 = 0.f, o1 = 0.f;
    const int ntot = NCTX + (j1 - j0);
    for (int j = 0; j < ntot; ++j) {
        const bf16_t* kp = j < NCTX ? kc + (size_t)j * INW : kl + (size_t)(j0 + j - NCTX) * INW;
        const bf16_t* vp = j < NCTX ? vc + (size_t)j * INW : vl + (size_t)(j0 + j - NCTX) * INW;
        const unsigned kk = *(const unsigned*)(kp + 2 * lane), vv = *(const unsigned*)(vp + 2 * lane);
        const float s = wave_sum(q0 * bflo(kk) + q1 * bfhi(kk)) * ATT_SCALE;
        const float mn = fmaxf(m, s);
        const float a = __expf(m - mn), pp = __expf(s - mn);
        lsum = lsum * a + pp; o0 = o0 * a + pp * bflo(vv); o1 = o1 * a + pp * bfhi(vv);
        m = mn;
    }
    if (has_sink) {
        const float mn = fmaxf(m, sink);
        const float a = __expf(m - mn);
        lsum = lsum * a + __expf(sink - mn); o0 *= a; o1 *= a;
    }
    const float inv = 1.f / lsum;
    *(unsigned*)(o + 2 * lane) = pk2(o0 * inv, o1 * inv);
}

__device__ __forceinline__ void ph_mixers_naive(const Params& p, int l, unsigned char* lds) {
    const int tid = threadIdx.x, lane = tid & 63, wave = tid >> 6;
    const int gw = blockIdx.x * NWAVES + wave, NGW = gridDim.x * NWAVES;
    const bf16_t* P = (const bf16_t*)(p.ws + WS_P);
    bf16_t* Y = (bf16_t*)(p.ws + WS_Y);
    const bool last = (l == DEPTH - 1);
    const int T_LA = NLAT * 6, T_LB = NLAT * 6, T_CA = last ? 0 : NCT * 6, T_CB = last ? 0 : NCT * 6;
    const int ntask = T_LA + T_LB + T_CA + T_CB;
    for (int tk = gw; tk < ntask; tk += NGW) {
        int r = tk;
        if (r < T_LA + T_LB) {
            const bool isB = r >= T_LA; if (isB) r -= T_LA;
            const int b = r / (6 * SEQ), h = (r / SEQ) % 6, t = r % SEQ, kv = h / 3;
            const size_t row = (size_t)b * SEQ + t, crow0 = (size_t)NLAT + (size_t)b * NCTX, lrow0 = (size_t)b * SEQ;
            const int cq = isB ? C_QB : C_QA, ck = isB ? C_KB : C_KA, cvv = isB ? C_VB : C_VA;
            int j0 = 0, j1 = SEQ;
            if (isB) { j0 = t - 128 < 0 ? 0 : t - 128; j1 = t + 129 > SEQ ? SEQ : t + 129; }
            attn_row_naive(P + row * INW + cq + h * 128, P + crow0 * INW + ck + kv * 128, P + crow0 * INW + cvv + kv * 128,
                           P + lrow0 * INW + ck + kv * 128, P + lrow0 * INW + cvv + kv * 128, j0, j1, isB, isB ? p.sink_b[l * 6 + h] : 0.f,
                           Y + row * DM + (isB ? 768 : 0) + h * 128, lane);
        } else {
            r -= T_LA + T_LB;
            const bool isB = r >= T_CA; if (isB) r -= T_CA;
            const int b = r / (6 * NCTX), h = (r / NCTX) % 6, t = r % NCTX, kv = h / 3;
            const size_t crow0 = (size_t)NLAT + (size_t)b * NCTX, row = crow0 + t;
            const int cq = isB ? C_QB : C_QA, ck = isB ? C_KB : C_KA, cvv = isB ? C_VB : C_VA;
            attn_row_naive(P + row * INW + cq + h * 128, P + crow0 * INW + ck + kv * 128, P + crow0 * INW + cvv + kv * 128,
                           P, P, 0, 0, isB, isB ? p.sink_b[l * 6 + h] : 0.f, Y + row * DM + (isB ? 768 : 0) + h * 128, lane);
        }
    }
    __syncthreads();
    float* Wl = (float*)lds;
    float* Vl = Wl + 128 * 128;
    const int nchunk = last ? NLAT / 128 : MTOT / 128;
    for (int u = blockIdx.x; u < nchunk * 4; u += gridDim.x) {
        const int ch = u >> 2, g = u & 3; const size_t row0 = (size_t)ch * 128;
        __syncthreads();
        for (int i = tid; i < 128 * 128; i += NTHREADS) {
            Wl[i] = p.ws_c[((size_t)l * 4 + g) * 16384 + i];
            const int q = i >> 7, c = i & 127;
            Vl[i] = bf2f(P[(row0 + q) * INW + C_VC + g * 128 + c]);
        }
        __syncthreads();
        const int c = tid & 127, pg = tid >> 7;
        for (int pp = pg * 32; pp < pg * 32 + 32; ++pp) {
            float s = 0.f;
#pragma unroll 8
            for (int q = 0; q < 128; ++q) s += Wl[pp * 128 + q] * Vl[q * 128 + c];
            s += p.bs_c[((size_t)l * 4 + g) * 128 + pp];
            const float uu = bf2f(P[(row0 + pp) * INW + C_UC + g * 128 + c]);
            Y[(row0 + pp) * DM + 1536 + g * 128 + c] = (bf16_t)f2bf(uu * s);
        }
    }
}


namespace att {
constexpr float SCALE = 0.088388347648318440f;
constexpr float THR = 8.f;
constexpr int D = 128, NW = 8, QBLK = 32, KVBLK = 64;
#ifndef ATT_SDEPTH
#define ATT_SDEPTH 2
#endif
constexpr int SDEPTH = ATT_SDEPTH;
constexpr int LDQ = INW, LDK = INW, LDO = DM;
constexpr size_t SHM_V = KVBLK * D * 2, SHM_K = KVBLK * D * 2, SHM_ATTN = 2 * SHM_V + 2 * SHM_K + NW * 64 * 4;
using bf16x8 = __attribute__((ext_vector_type(8))) short;
using s16x4  = __attribute__((ext_vector_type(4))) short;
using f32x16 = __attribute__((ext_vector_type(16))) float;
using f32x8  = __attribute__((ext_vector_type(8))) float;

#define KSWZ(row, colB) ((row) * 256 + ((colB) ^ (((row) & 7) << 4)))
#define SBAR() __builtin_amdgcn_sched_barrier(0)
__device__ __forceinline__ int crow(int r, int hi) { return (r & 3) + 8 * (r >> 2) + 4 * hi; }
__device__ __forceinline__ unsigned cvtpk(float lo, float hi) {
  unsigned r; asm volatile("v_cvt_pk_bf16_f32 %0, %1, %2" : "=v"(r) : "v"(lo), "v"(hi)); return r;
}

__device__ __forceinline__ void partialSM(f32x16& p0, f32x16& p1, float& m_reg, float& mn, float& alpha) {
  constexpr float C = SCALE * 1.4426950408889634f;
  float pmax = p0[0]; for (int r = 1; r < 16; ++r) pmax = fmaxf(pmax, p0[r]); for (int r = 0; r < 16; ++r) pmax = fmaxf(pmax, p1[r]);
  { auto rr = __builtin_amdgcn_permlane32_swap(__float_as_uint(pmax), __float_as_uint(pmax), false, false);
    pmax = fmaxf(__uint_as_float(rr[0]), __uint_as_float(rr[1])); }
  if (__builtin_expect(__all(pmax - m_reg <= THR / SCALE), 1)) { mn = m_reg; alpha = 1.f; }
  else { mn = fmaxf(m_reg, pmax); alpha = __builtin_amdgcn_exp2f((m_reg - mn) * C); m_reg = mn; }
  float mnC = -mn * C;
  for (int r = 0; r < 16; ++r) p0[r] = fmaf(p0[r], C, mnC); for (int r = 0; r < 16; ++r) p1[r] = fmaf(p1[r], C, mnC);
  for (int r = 0; r < 16; ++r) p0[r] = __builtin_amdgcn_exp2f(p0[r]);
}
__device__ __forceinline__ void finishSM(f32x16& p0, f32x16& p1, float alpha, float& l_reg, bf16x8& pa0, bf16x8& pa1, bf16x8& pa2, bf16x8& pa3) {
  for (int r = 0; r < 16; ++r) p1[r] = __builtin_amdgcn_exp2f(p1[r]);
  float ps = 0; for (int r = 0; r < 16; ++r) ps += p0[r]; for (int r = 0; r < 16; ++r) ps += p1[r];
  { auto rr = __builtin_amdgcn_permlane32_swap(__float_as_uint(ps), __float_as_uint(ps), false, false);
    ps = __uint_as_float(rr[0]) + __uint_as_float(rr[1]); }
  l_reg = l_reg * alpha + ps;
#define PK4(P, BASE, OUT) do { unsigned a0 = cvtpk(P[BASE + 0], P[BASE + 1]), a1 = cvtpk(P[BASE + 2], P[BASE + 3]);   \
    unsigned b0 = cvtpk(P[BASE + 4], P[BASE + 5]), b1 = cvtpk(P[BASE + 6], P[BASE + 7]);                              \
    auto r0 = __builtin_amdgcn_permlane32_swap(a0, b0, false, false); auto r1 = __builtin_amdgcn_permlane32_swap(a1, b1, false, false); \
    u32x4 w = {r0[0], r1[0], r0[1], r1[1]}; OUT = *reinterpret_cast<bf16x8*>(&w); } while (0)
  PK4(p0, 0, pa0); PK4(p0, 8, pa1); PK4(p1, 0, pa2); PK4(p1, 8, pa3);
#undef PK4
}
__device__ __forceinline__ void qkt(f32x16& p0, f32x16& p1, const bf16_t* Ks, const bf16x8* qr, int r32, int hi) {
  p0 = f32x16{}; p1 = f32x16{};
  for (int d0 = 0; d0 < 8; ++d0) { int cb = (d0 * 16 + hi * 8) * 2;
    bf16x8 b0 = *reinterpret_cast<const bf16x8*>((const char*)Ks + KSWZ(r32, cb));
    bf16x8 b1 = *reinterpret_cast<const bf16x8*>((const char*)Ks + KSWZ(32 + r32, cb));
    p0 = __builtin_amdgcn_mfma_f32_32x32x16_bf16(b0, qr[d0], p0, 0, 0, 0);
    p1 = __builtin_amdgcn_mfma_f32_32x32x16_bf16(b1, qr[d0], p1, 0, 0, 0); }
}
__device__ __forceinline__ int v_st(int k, int c) { const int kk = (k & ~0xC) | ((k & 4) << 1) | ((k & 8) >> 1); return ((kk >> 3) * 4 + (c >> 5)) * 512 + ((kk & 7) * 32 + (c & 31)) * 2; }
__device__ __forceinline__ int v_rd_base(int lane) { return ((lane & 3) << 3) | (((lane >> 2) & 3) << 6) | (((lane >> 4) & 1) << 5) | (((lane >> 5) & 1) << 8); }
constexpr int v_rd_off(int d0, int ks, int half) { return d0 * 512 + ks * 4096 + half * 2048; }
template <int OFF> __device__ __forceinline__ s16x4 tr_read(int vb) {
  s16x4 r; asm volatile("ds_read_b64_tr_b16 %0, %1 offset:%2" : "=&v"(r) : "v"(vb), "i"(OFF) : "memory"); return r;
}
template <int D0> __device__ __forceinline__ void pv_one(f32x16& od, int vb, bf16x8 pa0, bf16x8 pa1, bf16x8 pa2, bf16x8 pa3) {
  const s16x4 l0 = tr_read<v_rd_off(D0, 0, 0)>(vb), h0 = tr_read<v_rd_off(D0, 0, 1)>(vb), l1 = tr_read<v_rd_off(D0, 1, 0)>(vb), h1 = tr_read<v_rd_off(D0, 1, 1)>(vb);
  const s16x4 l2 = tr_read<v_rd_off(D0, 2, 0)>(vb), h2 = tr_read<v_rd_off(D0, 2, 1)>(vb), l3 = tr_read<v_rd_off(D0, 3, 0)>(vb), h3 = tr_read<v_rd_off(D0, 3, 1)>(vb);
  asm volatile("s_waitcnt lgkmcnt(0)" ::: "memory"); SBAR();
#define PK(L, H) (bf16x8){L[0], L[1], L[2], L[3], H[0], H[1], H[2], H[3]}
  od = __builtin_amdgcn_mfma_f32_32x32x16_bf16(pa0, PK(l0, h0), od, 0, 0, 0);
  od = __builtin_amdgcn_mfma_f32_32x32x16_bf16(pa1, PK(l1, h1), od, 0, 0, 0);
  od = __builtin_amdgcn_mfma_f32_32x32x16_bf16(pa2, PK(l2, h2), od, 0, 0, 0);
  od = __builtin_amdgcn_mfma_f32_32x32x16_bf16(pa3, PK(l3, h3), od, 0, 0, 0);
#undef PK
}
__device__ __forceinline__ void pv_d0(f32x16* o, int vb, bf16x8 pa0, bf16x8 pa1, bf16x8 pa2, bf16x8 pa3) {
  pv_one<0>(o[0], vb, pa0, pa1, pa2, pa3); pv_one<1>(o[1], vb, pa0, pa1, pa2, pa3); pv_one<2>(o[2], vb, pa0, pa1, pa2, pa3); pv_one<3>(o[3], vb, pa0, pa1, pa2, pa3);
}

__device__ __forceinline__ void attn_unit(const bool MASK, const bf16_t* __restrict__ Qb, const bf16_t* __restrict__ Kc, const bf16_t* __restrict__ Vc,
                                          const bf16_t* __restrict__ Kl, const bf16_t* __restrict__ Vl, int nlt, int qpos0, int kpos0,
                                          bool has_sink, float sink, bf16_t* __restrict__ Ob, char* lds) {
  int tid_ = threadIdx.x; asm volatile("" : "+v"(tid_));
  const int tid = tid_, wid = tid >> 6, lane = tid & 63, r32 = lane & 31, hi = lane >> 5;
  bf16_t* V_lds = (bf16_t*)lds; bf16_t* K_lds = (bf16_t*)(lds + 2 * SHM_V);
  float* ws = (float*)(lds + 2 * SHM_V + 2 * SHM_K) + wid * 64; float* li_l = ws; float* al_l = ws + 32;
  float m_reg = -1e30f, l_reg = 0; f32x16 o[4] = {}; bf16x8 qr[8];
  const bf16_t* Qw = Qb + (long)(wid * QBLK + r32) * LDQ + hi * 8;
#pragma unroll
  for (int d0 = 0; d0 < 8; ++d0) qr[d0] = *reinterpret_cast<const bf16x8*>(Qw + d0 * 16);
  const int sr = tid >> 4, sc = (tid & 15) * 8, vst0 = v_st(sr, sc), vst1 = v_st(32 + sr, sc);
  const int vb0 = (int)(uintptr_t)V_lds + v_rd_base(lane);
  struct { bf16x8 vs0, vs1, ks0, ks1; } sr_[SDEPTH];
  const int qpos = qpos0 + wid * QBLK + r32;
#define KVP(t, KP, VP) const bf16_t* KP = ((t) < 4 ? Kc + (long)(t) * KVBLK * LDK : Kl + (long)((t) - 4) * KVBLK * LDK); const bf16_t* VP = ((t) < 4 ? Vc + (long)(t) * KVBLK * LDK : Vl + (long)((t) - 4) * KVBLK * LDK)
#define SLOAD(i, t) do { KVP(t, kp_, vp_); sr_[i].vs0 = *reinterpret_cast<const bf16x8*>(&vp_[(long)sr * LDK + sc]); sr_[i].vs1 = *reinterpret_cast<const bf16x8*>(&vp_[(long)(32 + sr) * LDK + sc]); \
    sr_[i].ks0 = *reinterpret_cast<const bf16x8*>(&kp_[(long)sr * LDK + sc]); sr_[i].ks1 = *reinterpret_cast<const bf16x8*>(&kp_[(long)(32 + sr) * LDK + sc]); } while (0)
#define SWRITE(b, i) do { *(bf16x8*)((char*)V_lds + (b) * SHM_V + vst0) = sr_[i].vs0;          \
    *(bf16x8*)((char*)V_lds + (b) * SHM_V + vst1) = sr_[i].vs1; int kc = sc * 2;               \
    *(bf16x8*)((char*)K_lds + (b) * SHM_K + KSWZ(sr, kc)) = sr_[i].ks0;                       \
    *(bf16x8*)((char*)K_lds + (b) * SHM_K + KSWZ(32 + sr, kc)) = sr_[i].ks1; } while (0)
#define SWAIT() do { if constexpr (SDEPTH == 2) asm volatile("s_waitcnt vmcnt(4)" ::: "memory"); else asm volatile("s_waitcnt vmcnt(0)" ::: "memory"); } while (0)
#define RESC(a) do { if (__any((a) < 1.f)) { if (hi == 0) al_l[r32] = (a); asm volatile("s_waitcnt lgkmcnt(0)" ::: "memory"); \
    for (int d = 0; d < 4; ++d) for (int r = 0; r < 16; ++r) o[d][r] *= al_l[crow(r, hi)]; } } while (0)
#define WMASK(P0, P1, t) do { if (MASK && (t) >= 4) { const int kb_ = kpos0 + ((t) - 4) * KVBLK + 4 * hi - qpos; \
    _Pragma("unroll") for (int r = 0; r < 16; ++r) { const int dk = kb_ + (r & 3) + 8 * (r >> 2); \
      if (dk > 128 || dk < -128) P0[r] = -1e30f; if (dk + 32 > 128 || dk + 32 < -128) P1[r] = -1e30f; } } } while (0)
  f32x16 pA0, pA1, pB0, pB1; float mnA, mnB, alA, alB; bf16x8 pa0, pa1, pa2, pa3; const int NT = 4 + nlt;
  constexpr int SE = 0, SO = SDEPTH - 1;
  SLOAD(SE, 0); asm volatile("s_waitcnt vmcnt(0)" ::: "memory"); SWRITE(0, SE); __syncthreads();
  qkt(pA0, pA1, K_lds, qr, r32, hi); partialSM(pA0, pA1, m_reg, mnA, alA);
  SLOAD(SO, 1); if constexpr (SDEPTH == 2) { if (2 < NT) SLOAD(SE, 2); }
  SWAIT(); SWRITE(1, SO); __syncthreads();
  for (int j = 1; j + 1 < NT; j += 2) {
    SBAR(); qkt(pB0, pB1, (bf16_t*)((char*)K_lds + SHM_K), qr, r32, hi); WMASK(pB0, pB1, j);
    finishSM(pA0, pA1, alA, l_reg, pa0, pa1, pa2, pa3); SBAR();
    SLOAD(SO, j + SDEPTH); SBAR();
    pv_d0(o, vb0, pa0, pa1, pa2, pa3); partialSM(pB0, pB1, m_reg, mnB, alB);
    __syncthreads(); SWAIT(); SWRITE(0, SE);
    RESC(alB); __syncthreads();
    SBAR(); qkt(pA0, pA1, K_lds, qr, r32, hi); WMASK(pA0, pA1, j + 1);
    finishSM(pB0, pB1, alB, l_reg, pa0, pa1, pa2, pa3); SBAR();
    if (SDEPTH == 1 || j + 3 < NT) SLOAD(SE, j + 1 + SDEPTH); SBAR();
    pv_d0(o, vb0 + (int)SHM_V, pa0, pa1, pa2, pa3); partialSM(pA0, pA1, m_reg, mnA, alA);
    __syncthreads(); SWAIT(); SWRITE(1, SO);
    RESC(alA); __syncthreads();
  }
  SBAR(); qkt(pB0, pB1, (bf16_t*)((char*)K_lds + SHM_K), qr, r32, hi); WMASK(pB0, pB1, NT - 1);
  finishSM(pA0, pA1, alA, l_reg, pa0, pa1, pa2, pa3); SBAR();
  pv_d0(o, vb0, pa0, pa1, pa2, pa3); partialSM(pB0, pB1, m_reg, mnB, alB);
  __syncthreads(); RESC(alB);
  finishSM(pB0, pB1, alB, l_reg, pa0, pa1, pa2, pa3); SBAR();
  pv_d0(o, vb0 + (int)SHM_V, pa0, pa1, pa2, pa3);
  if (has_sink) l_reg += __builtin_amdgcn_exp2f(sink * 1.4426950408889634f - m_reg * (SCALE * 1.4426950408889634f));
  if (hi == 0) li_l[r32] = l_reg; asm volatile("s_waitcnt lgkmcnt(0)" ::: "memory");
  float rli[16];
#pragma unroll
  for (int r = 0; r < 16; ++r) rli[r] = __builtin_amdgcn_rcpf(li_l[crow(r, hi)]);
  bf16_t* Ow = Ob + (long)(wid * QBLK) * LDO;
  char* stg = (char*)K_lds + wid * 4096;
#pragma unroll
  for (int hf = 0; hf < 2; ++hf) {
#pragma unroll
    for (int r = 0; r < 16; ++r) { const int orow = crow(r, hi);
#pragma unroll
      for (int dd = 0; dd < 2; ++dd) *(bf16_t*)(stg + orow * 128 + (dd * 32 + r32) * 2) = (bf16_t)f2bf(o[hf * 2 + dd][r] * rli[r]); }
    asm volatile("s_waitcnt lgkmcnt(0)" ::: "memory");
    const int rr = lane >> 1, hb = lane & 1;
    const u32x4 v0 = *(const u32x4*)(stg + rr * 128 + hb * 64), v1 = *(const u32x4*)(stg + rr * 128 + hb * 64 + 16);
    const u32x4 v2 = *(const u32x4*)(stg + rr * 128 + hb * 64 + 32), v3 = *(const u32x4*)(stg + rr * 128 + hb * 64 + 48);
    bf16_t* dst = Ow + (long)rr * LDO + hf * 64 + hb * 32;
    *(u32x4*)dst = v0; *(u32x4*)(dst + 8) = v1; *(u32x4*)(dst + 16) = v2; *(u32x4*)(dst + 24) = v3;
  }
  __syncthreads();
#undef KVP
#undef SLOAD
#undef SWRITE
#undef SWAIT
#undef RESC
#undef WMASK
}
#undef KSWZ
#undef SBAR
}


__device__ __forceinline__ void cmlp_unit_naive(const Params& p, int l, int ch, int g, unsigned char* lds) {
    int tid_ = threadIdx.x; asm volatile("" : "+v"(tid_));
    const int tid = tid_;
    const bf16_t* P = (const bf16_t*)(p.ws + WS_P);
    bf16_t* Y = (bf16_t*)(p.ws + WS_Y);
    float* Wl = (float*)lds;
    float* Vl = Wl + 128 * 128;
    const size_t row0 = (size_t)ch * 128;
    __syncthreads();
    for (int i = tid; i < 128 * 128; i += NTHREADS) {
        Wl[i] = p.ws_c[((size_t)l * 4 + g) * 16384 + i];
        const int q = i >> 7, c = i & 127;
        Vl[i] = bf2f(P[(row0 + q) * INW + C_VC + g * 128 + c]);
    }
    __syncthreads();
    const int c = tid & 127, pg = tid >> 7;
    for (int pp = pg * 32; pp < pg * 32 + 32; ++pp) {
        float s = 0.f;
#pragma unroll 8
        for (int q = 0; q < 128; ++q) s += Wl[pp * 128 + q] * Vl[q * 128 + c];
        s += p.bs_c[((size_t)l * 4 + g) * 128 + pp];
        const float uu = bf2f(P[(row0 + pp) * INW + C_UC + g * 128 + c]);
        Y[(row0 + pp) * DM + 1536 + g * 128 + c] = (bf16_t)f2bf(uu * s);
    }
    __syncthreads();
}


__device__ __forceinline__ void cmlp_unit_fast(const Params& p, int l, int ch, int g, unsigned char* lds) {
    typedef short bf16x8 __attribute__((ext_vector_type(8)));
    typedef float f32x16 __attribute__((ext_vector_type(16)));
    int tid_ = threadIdx.x; asm volatile("" : "+v"(tid_));
    const int tid = tid_, lane = tid & 63, wave = tid >> 6, r32 = lane & 31, hh = lane >> 5;
    const bf16_t* P = (const bf16_t*)(p.ws + WS_P);
    bf16_t* Y = (bf16_t*)(p.ws + WS_Y);
    const bf16_t* W = (const bf16_t*)(p.ws + WS_WSC) + ((size_t)l * 4 + g) * 16384;
    bf16_t* VT = (bf16_t*)lds;
    const size_t row0 = (size_t)ch * 128;
    __syncthreads();
#pragma unroll
    for (int it = 0; it < 4; ++it) {
        const int q = it * 32 + (tid >> 4), c0 = (tid & 15) * 8;
        const u32x4 v = *(const u32x4*)(P + (row0 + q) * INW + C_VC + g * 128 + c0);
        const unsigned w[4] = {v.x, v.y, v.z, v.w};
#pragma unroll
        for (int i = 0; i < 4; ++i) { VT[(c0 + 2 * i) * 136 + q] = (bf16_t)(w[i] & 0xffffu); VT[(c0 + 2 * i + 1) * 136 + q] = (bf16_t)(w[i] >> 16); }
    }
    __syncthreads();
    const int cb = wave & 3, pb0 = (wave >> 2) * 2;
    f32x16 acc0 = {}, acc1 = {};
#pragma unroll
    for (int s = 0; s < 8; ++s) {
        const bf16x8 b = *(const bf16x8*)(VT + (cb * 32 + r32) * 136 + 16 * s + 8 * hh);
        const bf16x8 a0 = *(const bf16x8*)(W + (size_t)(pb0 * 32 + r32) * 128 + 16 * s + 8 * hh);
        const bf16x8 a1 = *(const bf16x8*)(W + (size_t)(pb0 * 32 + 32 + r32) * 128 + 16 * s + 8 * hh);
        acc0 = __builtin_amdgcn_mfma_f32_32x32x16_bf16(a0, b, acc0, 0, 0, 0);
        acc1 = __builtin_amdgcn_mfma_f32_32x32x16_bf16(a1, b, acc1, 0, 0, 0);
    }
    const int c = cb * 32 + r32;
    const float* bs = p.bs_c + ((size_t)l * 4 + g) * 128;
#pragma unroll
    for (int r = 0; r < 16; ++r) {
        const int pr = (r & 3) + 8 * (r >> 2) + 4 * hh;
        const int p0 = pb0 * 32 + pr, p1 = p0 + 32;
        const float u0 = bf2f(P[(row0 + p0) * INW + C_UC + g * 128 + c]), u1 = bf2f(P[(row0 + p1) * INW + C_UC + g * 128 + c]);
        Y[(row0 + p0) * DM + 1536 + g * 128 + c] = (bf16_t)f2bf(u0 * (acc0[r] + bs[p0]));
        Y[(row0 + p1) * DM + 1536 + g * 128 + c] = (bf16_t)f2bf(u1 * (acc1[r] + bs[p1]));
    }
}
#ifndef USE_FAST_CMLP
#define USE_FAST_CMLP 1
#endif

__device__ __forceinline__ void ph_mixers_fast(const Params& p, int l, unsigned char* lds, const bool dry) {
    const int tid = threadIdx.x;
    const bf16_t* P = (const bf16_t*)(p.ws + WS_P);
    bf16_t* Y = (bf16_t*)(p.ws + WS_Y);
    const bool last = (l == DEPTH - 1);
    const int b = blockIdx.x & 7;
    unsigned* ctr = (unsigned*)(p.ws + WS_CTL) + (dry ? 2048 : 0) + (l * 8 + b) * 64;
    volatile unsigned* shw = (volatile unsigned*)(lds + LDS_BYTES - 64);
    const int nAttn = last ? 96 : 108, nC = last ? 64 : 72, total = nAttn + nC;
    const size_t lrow0 = (size_t)b * SEQ, crow0 = (size_t)NLAT + (size_t)b * NCTX;
    unsigned nxt_ = 0u;
    if (tid == 0) nxt_ = atomicAdd(ctr, 1u);
    for (;;) {
        __syncthreads();
        if (tid == 0) *shw = nxt_;
        __syncthreads();
        const int u = (int)*shw + ((dry && DRY_MODE == 7) ? 48 : 0);
        if (u >= ((dry && DRY_MODE == 6) ? 48 : total)) break;
        if (tid == 0) nxt_ = atomicAdd(ctr, 1u);
        if (u < nAttn) {
            const bf16_t *Qb, *Kc, *Vc, *Kl, *Vl; bf16_t* Ob; int nlt = 0, qpos0 = 0, kpos0 = 0; bool mask = false, has_sink = false; int hsink = 0;
            if (u < 48) {
                const int h = u >> 3, qb = u & 7, kv = h / 3;
                Qb = P + (lrow0 + qb * 256) * INW + C_QA + h * 128; Kc = P + crow0 * INW + C_KA + kv * 128; Vc = P + crow0 * INW + C_VA + kv * 128;
                Kl = P + lrow0 * INW + C_KA + kv * 128; Vl = P + lrow0 * INW + C_VA + kv * 128; nlt = 32;
                Ob = Y + (lrow0 + qb * 256) * DM + h * 128;
            } else if (u < 96) {
                const int v = u - 48, h = v >> 3, qb = v & 7, kv = h / 3;
                const int kstart = qb == 0 ? 0 : qb * 256 - 128; nlt = (qb == 0 || qb == 7) ? 6 : 8;
                Qb = P + (lrow0 + qb * 256) * INW + C_QB + h * 128; Kc = P + crow0 * INW + C_KB + kv * 128; Vc = P + crow0 * INW + C_VB + kv * 128;
                Kl = P + (lrow0 + kstart) * INW + C_KB + kv * 128; Vl = P + (lrow0 + kstart) * INW + C_VB + kv * 128;
                qpos0 = qb * 256; kpos0 = kstart; mask = true; has_sink = true; hsink = h;
                Ob = Y + (lrow0 + qb * 256) * DM + 768 + h * 128;
            } else {
                const int v = u - 96; const bool isB = v >= 6; const int h = isB ? v - 6 : v, kv = h / 3;
                const int cq = isB ? C_QB : C_QA, ck = isB ? C_KB : C_KA, cv = isB ? C_VB : C_VA;
                Qb = P + crow0 * INW + cq + h * 128; Kc = P + crow0 * INW + ck + kv * 128; Vc = P + crow0 * INW + cv + kv * 128; Kl = Kc; Vl = Vc;
                has_sink = isB; hsink = h; Ob = Y + crow0 * DM + (isB ? 768 : 0) + h * 128;
            }
            att::attn_unit(mask, Qb, Kc, Vc, Kl, Vl, nlt, qpos0, kpos0, has_sink, has_sink ? p.sink_b[l * 6 + hsink] : 0.f, Ob, (char*)lds);
        } else {
            const int v = u - nAttn;
            const int ch = v < 64 ? b * 16 + (v >> 2) : 128 + b * 2 + ((v - 64) >> 2);
#if USE_FAST_CMLP
            cmlp_unit_fast(p, l, ch, v & 3, lds);
#else
            cmlp_unit_naive(p, l, ch, v & 3, lds);
#endif
        }
    }
#if GATHER_I8 && GATHER_4BIT
    if (TABLES_IN_GAPS && !dry) conv4_tables(p, last ? 3 * NEXP : NEXP, last ? 4 * NEXP : 2 * NEXP, (unsigned*)(p.ws + WS_CTL) + 6272 + (last ? 64 : 0), lds);
#endif
}
#ifndef USE_FAST_ATT
#define USE_FAST_ATT 1
#endif

__device__ __forceinline__ void ynorm_row(bf16_t* yrow, const u32x4 (&v)[4], int lane, unsigned char* y8row, float* sdst) {
    float sq[4];
#pragma unroll
    for (int j = 0; j < 4; ++j) {
        const float a0 = bflo(v[j].x), a1 = bfhi(v[j].x), a2 = bflo(v[j].y), a3 = bfhi(v[j].y), a4 = bflo(v[j].z), a5 = bfhi(v[j].z), a6 = bflo(v[j].w), a7 = bfhi(v[j].w);
        sq[j] = a0 * a0 + a1 * a1 + a2 * a2 + a3 * a3 + a4 * a4 + a5 * a5 + a6 * a6 + a7 * a7;
    }
    const float sA = wave_sum(sq[0] + (lane < 32 ? sq[1] : 0.f));
    const float sB = wave_sum((lane >= 32 ? sq[1] : 0.f) + sq[2]);
    const float sC = wave_sum(sq[3]);
    const float rA = rsqrtf(sA * (1.f / 768.f) + EPS), rB = rsqrtf(sB * (1.f / 768.f) + EPS), rC = rsqrtf(sC * (1.f / 512.f) + EPS);
    if (GEMM_I8) {
        float x[4][8]; float am = 0.f;
#pragma unroll
        for (int j = 0; j < 4; ++j) {
            const float sc = (j == 0) ? rA : (j == 1) ? (lane < 32 ? rA : rB) : (j == 2) ? rB : rC;
            x[j][0] = bflo(v[j].x) * sc; x[j][1] = bfhi(v[j].x) * sc; x[j][2] = bflo(v[j].y) * sc; x[j][3] = bfhi(v[j].y) * sc;
            x[j][4] = bflo(v[j].z) * sc; x[j][5] = bfhi(v[j].z) * sc; x[j][6] = bflo(v[j].w) * sc; x[j][7] = bfhi(v[j].w) * sc;
#pragma unroll
            for (int i = 0; i < 8; ++i) am = fmaxf(am, fabsf(x[j][i]));
        }
        am = wave_max(am);
        const float s = am > 0.f ? am * (1.f / 127.f) : 1.f, inv = 1.f / s;
#pragma unroll
        for (int j = 0; j < 4; ++j) {
            u32x2 o; o.x = q8pack4(x[j][0], x[j][1], x[j][2], x[j][3], inv); o.y = q8pack4(x[j][4], x[j][5], x[j][6], x[j][7], inv);
            *(u32x2*)(y8row + j * 512 + lane * 8) = o;
        }
        if (lane == 0) *sdst = s;
        return;
    }
#pragma unroll
    for (int j = 0; j < 4; ++j) {
        const float sc = (j == 0) ? rA : (j == 1) ? (lane < 32 ? rA : rB) : (j == 2) ? rB : rC;
        u32x4 o;
        o.x = pk2(bflo(v[j].x) * sc, bfhi(v[j].x) * sc); o.y = pk2(bflo(v[j].y) * sc, bfhi(v[j].y) * sc);
        o.z = pk2(bflo(v[j].z) * sc, bfhi(v[j].z) * sc); o.w = pk2(bflo(v[j].w) * sc, bfhi(v[j].w) * sc);
        *(u32x4*)(yrow + j * 512 + lane * 8) = o;
    }
}
__device__ __forceinline__ void ph_ynorm(const Params& p, int l) {
    const int tid = threadIdx.x, lane = tid & 63, wave = tid >> 6;
    const int gw = blockIdx.x * NWAVES + wave, NGW = gridDim.x * NWAVES;
    bf16_t* Y = (bf16_t*)(p.ws + WS_Y);
    const int nrows = (l == DEPTH - 1) ? NLAT : MTOT;
#pragma unroll 1
    for (int r = gw; r < nrows; r += 2 * NGW) {
        const int r2 = r + NGW; const bool has2 = r2 < nrows; const int rb = has2 ? r2 : r;
        u32x4 va[4], vb[4];
#pragma unroll
        for (int j = 0; j < 4; ++j) { va[j] = *(const u32x4*)(Y + (size_t)r * DM + j * 512 + lane * 8); vb[j] = *(const u32x4*)(Y + (size_t)rb * DM + j * 512 + lane * 8); }
        unsigned char* Y8 = (unsigned char*)(p.ws + WS_XN8); float* SY = (float*)(p.ws + WS_SCL) + SCL_Y;
        ynorm_row(Y + (size_t)r * DM, va, lane, Y8 + (size_t)r * DM, SY + r);
        if (has2) ynorm_row(Y + (size_t)r2 * DM, vb, lane, Y8 + (size_t)r2 * DM, SY + r2);
    }
}

__device__ __forceinline__ void wave_argmax(float& bv, int& bi) {
#pragma unroll
    for (int o = 32; o >= 1; o >>= 1) {
        const float ov = __shfl_xor(bv, o); const int oi = __shfl_xor(bi, o);
        if (ov > bv || (ov == bv && oi < bi)) { bv = ov; bi = oi; }
    }
}
__device__ __forceinline__ void route_half(const bf16_t* qh, const bf16_t* kh, int lane, float& tv, int& ti) {
    const unsigned qq = *(const unsigned*)(qh + 2 * lane);
    const float qa = bflo(qq), qb = bfhi(qq);
    const bf16_t* k0 = kh + (size_t)lane * 128;
    const bf16_t* k1 = k0 + 64 * 128;
    float d0 = 0.f, d1 = 0.f;
#pragma unroll 2
    for (int cb = 0; cb < 16; ++cb) {
        const u32x4 a = *(const u32x4*)(k0 + cb * 8), b = *(const u32x4*)(k1 + cb * 8);
        const unsigned aw[4] = {a.x, a.y, a.z, a.w}, bw[4] = {b.x, b.y, b.z, b.w};
#pragma unroll
        for (int i = 0; i < 4; ++i) {
            const int src = cb * 4 + i;
            const float x0 = __shfl(qa, src), x1 = __shfl(qb, src);
            d0 += x0 * bflo(aw[i]) + x1 * bfhi(aw[i]);
            d1 += x0 * bflo(bw[i]) + x1 * bfhi(bw[i]);
        }
    }
    float va = d0, vb = d1; tv = 0.f; ti = 0;
#pragma unroll 1
    for (int r = 0; r < 16; ++r) {
        float bv; int bi;
        if (va >= vb) { bv = va; bi = lane; } else { bv = vb; bi = lane + 64; }
        wave_argmax(bv, bi);
        if (lane == r) { tv = bv; ti = bi; }
        if (bi == lane) va = -INFINITY; else if (bi == lane + 64) vb = -INFINITY;
    }
}
__device__ __forceinline__ void ph_route_naive(const Params& p, int l) {
    const int tid = threadIdx.x, lane = tid & 63, wave = tid >> 6;
    const int gw = blockIdx.x * NWAVES + wave, NGW = gridDim.x * NWAVES;
    const bf16_t* QP = (const bf16_t*)(p.ws + WS_P);
    const bf16_t* KEYS = (const bf16_t*)(p.ws + WS_KEYS) + (size_t)l * 8 * 2 * 128 * 128;
    int* EID = (int*)(p.ws + WS_EID); float* GATE = (float*)(p.ws + WS_GATE);
    const int nrows = (l == DEPTH - 1) ? NLAT : MTOT;
#pragma unroll 1
    for (int tk = gw; tk < nrows * 8; tk += NGW) {
        const int t = tk >> 3, h = tk & 7;
        const bf16_t* qrow = QP + (size_t)t * DM + h * 256;
        float tv0, tv1; int ti0, ti1;
        route_half(qrow, KEYS + (size_t)(h * 2 + 0) * 128 * 128, lane, tv0, ti0);
        route_half(qrow + 128, KEYS + (size_t)(h * 2 + 1) * 128 * 128, lane, tv1, ti1);
        const float v1 = __shfl(tv0, lane >> 2);
        float c0 = v1 + __shfl(tv1, (lane & 3) * 4 + 0), c1 = v1 + __shfl(tv1, (lane & 3) * 4 + 1);
        float c2 = v1 + __shfl(tv1, (lane & 3) * 4 + 2), c3 = v1 + __shfl(tv1, (lane & 3) * 4 + 3);
        float myv = 0.f; int myc = 0;
#pragma unroll 1
        for (int r = 0; r < 16; ++r) {
            float bv = c0; int bi = lane * 4;
            if (c1 > bv) { bv = c1; bi = lane * 4 + 1; }
            if (c2 > bv) { bv = c2; bi = lane * 4 + 2; }
            if (c3 > bv) { bv = c3; bi = lane * 4 + 3; }
            wave_argmax(bv, bi);
            if (lane == r) { myv = bv; myc = bi; }
            if ((bi >> 2) == lane) {
                const int u = bi & 3;
                if (u == 0) c0 = -INFINITY; else if (u == 1) c1 = -INFINITY; else if (u == 2) c2 = -INFINITY; else c3 = -INFINITY;
            }
        }
        float mx = lane < 16 ? myv : -INFINITY;
        mx = fmaxf(mx, __shfl_xor(mx, 8)); mx = fmaxf(mx, __shfl_xor(mx, 4)); mx = fmaxf(mx, __shfl_xor(mx, 2)); mx = fmaxf(mx, __shfl_xor(mx, 1));
        const float e = lane < 16 ? __expf(myv - mx) : 0.f;
        float sm = e; sm += __shfl_xor(sm, 8); sm += __shfl_xor(sm, 4); sm += __shfl_xor(sm, 2); sm += __shfl_xor(sm, 1);
        const int i1 = __shfl(ti0, myc >> 4), i2 = __shfl(ti1, myc & 15);
        if (lane < 16) { EID[(size_t)t * 128 + h * 16 + lane] = i1 * 128 + i2; GATE[(size_t)t * 128 + h * 16 + lane] = e / sm; }
    }
}


namespace rt {
typedef short bf16x8 __attribute__((ext_vector_type(8)));
typedef float f32x16 __attribute__((ext_vector_type(16)));
__device__ __forceinline__ void insert16(float (&t)[16], float x) {
#pragma unroll
    for (int j = 15; j >= 1; --j) t[j] = __builtin_amdgcn_fmed3f(t[j - 1], t[j], x);
    t[0] = fmaxf(t[0], x);
}
__device__ __forceinline__ void half_top16(const unsigned char* klds, const bf16_t* qrow, int r32, int hh, float (&t)[16]) {
    bf16x8 qf[8];
#pragma unroll
    for (int s = 0; s < 8; ++s) qf[s] = *(const bf16x8*)(qrow + 16 * s);
#pragma unroll
    for (int k = 0; k < 16; ++k) t[k] = -3.0e38f;
    const unsigned hh4 = (unsigned)hh << 2;
#pragma unroll
    for (int kb = 0; kb < 4; ++kb) {
        f32x16 acc = {};
        const int row = kb * 32 + r32;
#pragma unroll
        for (int s = 0; s < 8; ++s) {
            const bf16x8 a = *(const bf16x8*)(klds + row * 256 + ((32 * s + 16 * hh) ^ ((row & 7) << 4)));
            acc = __builtin_amdgcn_mfma_f32_32x32x16_bf16(a, qf[s], acc, 0, 0, 0);
        }
#pragma unroll
        for (int r = 0; r < 16; ++r) {
            const unsigned key = (unsigned)(kb * 32 + (r & 3) + 8 * (r >> 2)) | hh4;
            insert16(t, __uint_as_float((__float_as_uint(acc[r]) & ~127u) | key));
        }
    }
    float o[16];
#pragma unroll
    for (int k = 0; k < 16; ++k) o[k] = __shfl_xor(t[k], 32);
#pragma unroll
    for (int k = 0; k < 16; ++k) insert16(t, o[k]);
}
}
template <bool OWN_UNITS>
__device__ __forceinline__ void ph_route_fast(const Params& p, int l, unsigned char* lds) {
    int tid_ = threadIdx.x; asm volatile("" : "+v"(tid_));
    const int tid = tid_, lane = tid & 63, wave = tid >> 6, r32 = lane & 31, hh = lane >> 5;
    const bf16_t* QP = (const bf16_t*)(p.ws + WS_P);
    const bf16_t* KEYS = (const bf16_t*)(p.ws + WS_KEYS) + (size_t)l * 8 * 2 * 128 * 128;
    int* EID = (int*)(p.ws + WS_EID); float* GATE = (float*)(p.ws + WS_GATE);
    const int ntile = ((l == DEPTH - 1) ? NLAT : MTOT) / 256;
    unsigned* tab = (unsigned*)(lds + 65536) + wave * 2048;
    pg8::StaticOrder So; So.init(ntile * 256, DM, (int)gridDim.x, (int)blockIdx.x);
#pragma unroll 1
    for (int ui = 0;; ++ui) {
        int tile, h;
        if (OWN_UNITS) { pg8::Unit uu; if (!So.next(ui, uu)) break; tile = uu.pm; h = uu.pn; }
        else { const int u = blockIdx.x + ui * (int)gridDim.x; if (u >= ntile * 8) break; tile = u >> 3; h = u & 7; }
        __syncthreads();
        const u32x4* ksrc = (const u32x4*)(KEYS + (size_t)h * 2 * 128 * 128);
#pragma unroll
        for (int i = 0; i < 8; ++i) { const int c = tid + i * 512, row = c >> 4, cc = c & 15; *(u32x4*)(lds + row * 256 + ((cc * 16) ^ ((row & 7) << 4))) = ksrc[c]; }
        __syncthreads();
        const int tok = tile * 256 + wave * 32 + r32;
        const bf16_t* qrow = QP + (size_t)tok * DM + h * 256 + hh * 8;
        float v1[16], v2[16];
        rt::half_top16(lds, qrow, r32, hh, v1);
        rt::half_top16(lds + 32768, qrow + 128, r32, hh, v2);
        float c[16];
#pragma unroll
        for (int k = 0; k < 16; ++k) c[k] = -3.0e38f;
#pragma unroll
        for (int i = 0; i < 16; ++i)
#pragma unroll
            for (int j = 0; j < 16; ++j)
                if ((i + 1) * (j + 1) <= 16) rt::insert16(c, __uint_as_float((__float_as_uint(v1[i] + v2[j]) & ~255u) | (unsigned)(i * 16 + j)));
#pragma unroll
        for (int k = 0; k < 16; ++k) { tab[k * 64 + lane] = __float_as_uint(v1[k]); tab[(16 + k) * 64 + lane] = __float_as_uint(v2[k]); }
        LDS_WAIT();
        float e[16], sum = 0.f;
#pragma unroll
        for (int k = 0; k < 16; ++k) { e[k] = __expf(c[k] - c[0]); sum += e[k]; }
        const float inv = 1.f / sum;
        unsigned out[16];
#pragma unroll
        for (int k = 0; k < 16; ++k) {
            const unsigned code = __float_as_uint(c[k]) & 255u;
            const unsigned i1 = tab[(code >> 4) * 64 + lane] & 127u, i2 = tab[(16 + (code & 15u)) * 64 + lane] & 127u;
            out[k] = hh == 0 ? (i1 * 128u + i2) : __float_as_uint(e[k] * inv);
        }
        unsigned* dst = (hh == 0 ? (unsigned*)EID : (unsigned*)GATE) + (size_t)tok * 128 + h * 16;
#pragma unroll
        for (int k = 0; k < 4; ++k) { u32x4 w; w.x = out[4 * k]; w.y = out[4 * k + 1]; w.z = out[4 * k + 2]; w.w = out[4 * k + 3]; *(u32x4*)(dst + 4 * k) = w; }
        LDS_WAIT();
    }
}
#ifndef USE_FAST_ROUTE
#define USE_FAST_ROUTE 1
#endif


#if GATHER_I8
__device__ __forceinline__ float dpp_shr(float v, int n) {
    const int iv = __builtin_bit_cast(int, v); int r;
    switch (n) { case 1: r = __builtin_amdgcn_update_dpp(0, iv, 0x111, 0xf, 0xf, true); break; case 2: r = __builtin_amdgcn_update_dpp(0, iv, 0x112, 0xf, 0xf, true); break;
                 case 4: r = __builtin_amdgcn_update_dpp(0, iv, 0x114, 0xf, 0xf, true); break; default: r = __builtin_amdgcn_update_dpp(0, iv, 0x118, 0xf, 0xf, true); break; }
    return __builtin_bit_cast(float, r);
}
__device__ __forceinline__ float wave_total(float v) {
    v += dpp_shr(v, 1); v += dpp_shr(v, 2); v += dpp_shr(v, 4); v += dpp_shr(v, 8);
    v += __builtin_bit_cast(float, __builtin_amdgcn_update_dpp(0, __builtin_bit_cast(int, v), 0x142, 0xa, 0xf, false));
    v += __builtin_bit_cast(float, __builtin_amdgcn_update_dpp(0, __builtin_bit_cast(int, v), 0x143, 0xc, 0xf, false));
    return __uint_as_float(__builtin_amdgcn_readlane(__float_as_uint(v), 63));
}
#define UB0(w) ((float)((w) & 0xffu))
#define UB1(w) ((float)(((w) >> 8) & 0xffu))
#define UB2(w) ((float)(((w) >> 16) & 0xffu))
#define UB3(w) ((float)((w) >> 24))

__device__ __forceinline__ float dpp_xor1(float v) { return __builtin_bit_cast(float, __builtin_amdgcn_update_dpp(0, __builtin_bit_cast(int, v), 0xB1, 0xf, 0xf, false)); }
__device__ __forceinline__ float dpp_xor2(float v) { return __builtin_bit_cast(float, __builtin_amdgcn_update_dpp(0, __builtin_bit_cast(int, v), 0x4E, 0xf, 0xf, false)); }
__device__ __forceinline__ float dpp_xor8(float v) { return __builtin_bit_cast(float, __builtin_amdgcn_update_dpp(0, __builtin_bit_cast(int, v), 0x128, 0xf, 0xf, false)); }
__device__ __forceinline__ float reduce8_rows(const float (&d)[8], int lane) {
    const bool b0 = lane & 1, b1 = lane & 2, b2 = lane & 4;
    float r[4];
#pragma unroll
    for (int k = 0; k < 4; ++k) r[k] = (b0 ? d[2 * k + 1] : d[2 * k]) + dpp_xor1(b0 ? d[2 * k] : d[2 * k + 1]);
    float t[2];
#pragma unroll
    for (int k = 0; k < 2; ++k) t[k] = (b1 ? r[2 * k + 1] : r[2 * k]) + dpp_xor2(b1 ? r[2 * k] : r[2 * k + 1]);
    float u = (b2 ? t[1] : t[0]) + __shfl_xor(b2 ? t[0] : t[1], 4);
    u += dpp_xor8(u);
    u += __shfl_xor(u, 16);
    u += __shfl_xor(u, 32);
    return u;
}
#if GATHER_4BIT
#ifndef DRY_MODE
#define DRY_MODE 0
#endif
typedef float f32x2 __attribute__((ext_vector_type(2)));
__device__ __forceinline__ void ph_gather(const Params& p, int l, const bool dry) {
    const int tid = threadIdx.x, lane = tid & 63, wave = tid >> 6;
    const int gw = blockIdx.x * NWAVES + wave, NGW = gridDim.x * NWAVES;
    const bf16_t* XN = (const bf16_t*)(p.ws + WS_XN);
    const unsigned char* UT = (const unsigned char*)(p.ws + WS_UT) + (size_t)l * NEXP * ROW4;
    const unsigned char* VT = (const unsigned char*)(p.ws + WS_VT) + (size_t)l * NEXP * ROWV;
    const int* EID = (const int*)(p.ws + WS_EID); const float* GATE = (const float*)(p.ws + WS_GATE);
    const float* mod = (const float*)(p.ws + WS_MOD) + (size_t)l * 9 * 12288;
    const int nrows = (l == DEPTH - 1) ? NLAT : MTOT;
#pragma unroll 1
    for (int t = gw; t < nrows; t += NGW) {
        int xh[4], xl[4]; float sxl;
#if GEMM_I8 && GEMM3_I8
        {
            sxl = ((const float*)(p.ws + WS_SCL))[SCL_XN + t];
            const unsigned char* x8 = (const unsigned char*)(p.ws + WS_XN8) + (size_t)t * DM;
#pragma unroll
            for (int j = 0; j < 2; ++j) {
                const u32x4 q4 = *(const u32x4*)(x8 + j * 1024 + lane * 16);
                const unsigned ww[4] = {q4.x, q4.y, q4.z, q4.w};
#pragma unroll
                for (int dd = 0; dd < 2; ++dd) {
                    unsigned h = 0u, lo = 0u;
#pragma unroll
                    for (int k = 0; k < 8; ++k) {
                        const int q = (int)(signed char)((ww[dd * 2 + (k >> 2)] >> (8 * (k & 3))) & 0xffu);
                        const int ql = ((q + 8) & 15) - 8, qh = (q - ql) >> 4;
                        h |= ((unsigned)qh & 15u) << (4 * k); lo |= ((unsigned)ql & 15u) << (4 * k);
                    }
                    xh[j * 2 + dd] = (int)h; xl[j * 2 + dd] = (int)lo;
                }
            }
        }
#else
        {
            float x[32]; float am = 0.f;
#pragma unroll
            for (int j = 0; j < 2; ++j)
#pragma unroll
                for (int k = 0; k < 2; ++k) {
                    const u32x4 q = *(const u32x4*)(XN + (size_t)t * DM + j * 1024 + lane * 16 + k * 8);
                    float* xx = x + j * 16 + k * 8;
                    xx[0] = bflo(q.x); xx[1] = bfhi(q.x); xx[2] = bflo(q.y); xx[3] = bfhi(q.y); xx[4] = bflo(q.z); xx[5] = bfhi(q.z); xx[6] = bflo(q.w); xx[7] = bfhi(q.w);
                }
#pragma unroll
            for (int i = 0; i < 32; ++i) am = fmaxf(am, fabsf(x[i]));
            sxl = am > 0.f ? am * (1.f / 119.f) : 1.f;
            const float inv = 1.f / sxl;
#pragma unroll
            for (int d = 0; d < 4; ++d) {
                unsigned h = 0u, lo = 0u;
#pragma unroll
                for (int k = 0; k < 8; ++k) {
                    const int q = (int)rintf(x[8 * d + k] * inv);
                    const int ql = ((q + 8) & 15) - 8, qh = (q - ql) >> 4;
                    h |= ((unsigned)qh & 15u) << (4 * k); lo |= ((unsigned)ql & 15u) << (4 * k);
                }
                xh[d] = (int)h; xl[d] = (int)lo;
            }
        }
#endif
        const int e0 = EID[(size_t)t * 128 + lane], e1 = EID[(size_t)t * 128 + 64 + lane];
        const float g0 = GATE[(size_t)t * 128 + lane], g1 = GATE[(size_t)t * 128 + 64 + lane];
        float hid0 = 0.f, hid1 = 0.f;
        constexpr int GB = 8;
#define G_LOAD(W, S, TAB, EB, ISV) do { _Pragma("unroll") for (int i = 0; i < GB; ++i) { \
            const int id_ = __builtin_amdgcn_readlane((EB) < 64 ? e0 : e1, ((EB) + i) & 63); \
            const unsigned char* row_ = (TAB) + (size_t)id_ * ((ISV) ? ROWV : ROW4); \
            W[i] = *(const u32x4*)(row_ + lane * 16); if (!(V_ROWSCALE && (ISV))) S[i] = *(const unsigned short*)(row_ + 1024 + lane * 2); } } while (0)
#define G_DOT(W, S, EB) do { float dd_[8]; _Pragma("unroll") for (int i = 0; i < GB; ++i) { int sh_ = 0, sl_ = 0; \
            const unsigned ww[4] = {W[i].x, W[i].y, W[i].z, W[i].w}; \
            _Pragma("unroll") for (int d = 0; d < 4; ++d) { \
                sh_ = __builtin_amdgcn_sdot8((int)ww[d], xh[d], sh_, false); \
                sl_ = __builtin_amdgcn_sdot8((int)ww[d], xl[d], sl_, false); } \
            dd_[i] = (float)((sh_ << 4) + sl_) * (sxl * bf2f(S[i])); } \
            const float tot = reduce8_rows(dd_, lane);              \
            if ((lane & 56) == ((EB) & 63)) { if ((EB) < 64) hid0 = tot; else hid1 = tot; } } while (0)
#define G_AXPY(W, S, EB) do { _Pragma("unroll") for (int i = 0; i < GB; ++i) { \
            const float m_ = __uint_as_float(__builtin_amdgcn_readlane(__float_as_uint((EB) < 64 ? cf0 : cf1), ((EB) + i) & 63)) * (V_ROWSCALE ? 1.f : bf2f(S[i])); \
            const f32x2 mm = {m_, m_}; \
            const unsigned ww[4] = {W[i].x, W[i].y, W[i].z, W[i].w}; \
            _Pragma("unroll") for (int d = 0; d < 4; ++d) { \
                acc[4 * d + 0] += mm * __builtin_amdgcn_cvt_scalef32_pk_f32_fp4(ww[d], 1.0f, 0); \
                acc[4 * d + 1] += mm * __builtin_amdgcn_cvt_scalef32_pk_f32_fp4(ww[d], 1.0f, 1); \
                acc[4 * d + 2] += mm * __builtin_amdgcn_cvt_scalef32_pk_f32_fp4(ww[d], 1.0f, 2); \
                acc[4 * d + 3] += mm * __builtin_amdgcn_cvt_scalef32_pk_f32_fp4(ww[d], 1.0f, 3); } } } while (0)
        u32x4 wa[GB], wb[GB]; unsigned sa[GB], sb[GB];
        const bool do_u = !(dry && (DRY_MODE == 4 || DRY_MODE == 5)), do_v = !(dry && (DRY_MODE == 3 || DRY_MODE == 5));
#if V_ROWSCALE
        const float vs0 = ((const float*)(p.ws + WS_VSC))[(size_t)l * NEXP + e0], vs1 = ((const float*)(p.ws + WS_VSC))[(size_t)l * NEXP + e1];
#else
        const float vs0 = 1.f, vs1 = 1.f;
#endif
        if (do_u) G_LOAD(wa, sa, UT, 0, false); else G_LOAD(wa, sa, VT, 0, true);
#pragma unroll 1
        for (int eb = 0; eb < (do_u ? 128 : 0); eb += 2 * GB) {
            G_LOAD(wb, sb, UT, eb + GB, false);
            G_DOT(wa, sa, eb);
            if (eb + 2 * GB < 128) G_LOAD(wa, sa, UT, eb + 2 * GB, false); else G_LOAD(wa, sa, VT, 0, true);
            G_DOT(wb, sb, eb + GB);
        }
        const float cf0 = gelu_tanh(hid0) * g0 * vs0, cf1 = gelu_tanh(hid1) * g1 * vs1;
        f32x2 acc[16];
#pragma unroll
        for (int i = 0; i < 16; ++i) acc[i] = (f32x2){0.f, 0.f};
#pragma unroll 1
        for (int eb = 0; eb < (do_v ? 128 : 0); eb += 2 * GB) {
            G_LOAD(wb, sb, VT, eb + GB, true);
            G_AXPY(wa, sa, eb);
            if (eb + 2 * GB < 128) G_LOAD(wa, sa, VT, eb + 2 * GB, true);
            G_AXPY(wb, sb, eb + GB);
        }
#undef G_LOAD
#undef G_DOT
#undef G_AXPY
        float hn[32];
        const int bb = t < NLAT ? (t >> 11) : 8;
        const float* gate = mod + (size_t)bb * 12288 + 5 * DM;
#if H_BF16 && GEMM_I8 && GEMM3_I8
        {
            bf16_t* hbrow = (bf16_t*)(p.ws + WS_HB) + (size_t)t * DM;
            const bool fin = (l == DEPTH - 1);
#pragma unroll
            for (int j = 0; j < 2; ++j) {
                const u32x4 q0 = *(const u32x4*)(hbrow + j * 1024 + lane * 16), q1 = *(const u32x4*)(hbrow + j * 1024 + lane * 16 + 8);
                const unsigned qq[8] = {q0.x, q0.y, q0.z, q0.w, q1.x, q1.y, q1.z, q1.w};
#pragma unroll
                for (int k = 0; k < 4; ++k) {
                    const f32x4 gv = *(const f32x4*)(gate + j * 1024 + lane * 16 + k * 4);
                    const f32x2 a0 = acc[j * 8 + k * 2], a1 = acc[j * 8 + k * 2 + 1];
                    hn[j * 16 + k * 4 + 0] = bflo(qq[2 * k]) + gv.x * a0.x; hn[j * 16 + k * 4 + 1] = bfhi(qq[2 * k]) + gv.y * a0.y;
                    hn[j * 16 + k * 4 + 2] = bflo(qq[2 * k + 1]) + gv.z * a1.x; hn[j * 16 + k * 4 + 3] = bfhi(qq[2 * k + 1]) + gv.w * a1.y;
                }
                if (fin) {
                    float* orow = (dry ? (float*)(p.ws + WS_DUMMY) + (size_t)(t & 16383) * DM : p.out + (size_t)t * DM) + j * 1024 + lane * 16;
#pragma unroll
                    for (int k = 0; k < 4; ++k) *(f32x4*)(orow + k * 4) = (f32x4){hn[j * 16 + k * 4], hn[j * 16 + k * 4 + 1], hn[j * 16 + k * 4 + 2], hn[j * 16 + k * 4 + 3]};
                } else {
                    bf16_t* orow = (dry ? (bf16_t*)(p.ws + WS_DUMMY) + (size_t)(t & 16383) * DM : hbrow) + j * 1024 + lane * 16;
                    u32x4 w0, w1;
                    w0.x = pk2(hn[j * 16 + 0], hn[j * 16 + 1]); w0.y = pk2(hn[j * 16 + 2], hn[j * 16 + 3]); w0.z = pk2(hn[j * 16 + 4], hn[j * 16 + 5]); w0.w = pk2(hn[j * 16 + 6], hn[j * 16 + 7]);
                    w1.x = pk2(hn[j * 16 + 8], hn[j * 16 + 9]); w1.y = pk2(hn[j * 16 + 10], hn[j * 16 + 11]); w1.z = pk2(hn[j * 16 + 12], hn[j * 16 + 13]); w1.w = pk2(hn[j * 16 + 14], hn[j * 16 + 15]);
                    *(u32x4*)orow = w0; *(u32x4*)(orow + 8) = w1;
                }
            }
        }
#else
        float* hrow = t < NLAT ? p.out + (size_t)t * DM : (float*)(p.ws + WS_HC) + (size_t)(t - NLAT) * DM;
#pragma unroll
        for (int j = 0; j < 2; ++j)
#pragma unroll
            for (int k = 0; k < 4; ++k) {
                const int col = j * 1024 + lane * 16 + k * 4;
                const f32x4 hv = *(const f32x4*)(hrow + col), gv = *(const f32x4*)(gate + col);
                const f32x2 a0 = acc[j * 8 + k * 2], a1 = acc[j * 8 + k * 2 + 1];
                f32x4 o;
                o.x = hv.x + gv.x * a0.x; o.y = hv.y + gv.y * a0.y; o.z = hv.z + gv.z * a1.x; o.w = hv.w + gv.w * a1.y;
                *(f32x4*)((dry ? (float*)(p.ws + WS_DUMMY) + (size_t)(t & 16383) * DM : hrow) + col) = o;
                hn[j * 16 + k * 4 + 0] = o.x; hn[j * 16 + k * 4 + 1] = o.y; hn[j * 16 + k * 4 + 2] = o.z; hn[j * 16 + k * 4 + 3] = o.w;
            }
#endif
        if (l + 1 < DEPTH) {
            float ss = 0.f;
#pragma unroll
            for (int i = 0; i < 32; ++i) ss += hn[i] * hn[i];
            const float rstd = rsqrtf(wave_total(ss) * (1.f / DM) + EPS);
            const float* g1n = p.norm1_g + (l + 1) * DM;
            const float* shift = mod + (size_t)9 * 12288 + (size_t)bb * 12288;
            const float* scale = shift + DM;
            if (GEMM_I8) {
                float am = 0.f;
#pragma unroll
                for (int j = 0; j < 2; ++j)
#pragma unroll
                    for (int i = 0; i < 16; ++i) { const int col = j * 1024 + lane * 16 + i; hn[j * 16 + i] = hn[j * 16 + i] * rstd * g1n[col] * (1.f + scale[col]) + shift[col]; am = fmaxf(am, fabsf(hn[j * 16 + i])); }
                am = wave_max(am);
                const float s8 = am > 0.f ? am * (1.f / 127.f) : 1.f, inv8 = 1.f / s8;
                unsigned char* xo8 = (dry ? (unsigned char*)(p.ws + WS_DUMMY) + (size_t)(t & 16383) * DM : (unsigned char*)(p.ws + WS_XN8) + (size_t)t * DM);
#pragma unroll
                for (int j = 0; j < 2; ++j) {
                    u32x4 w;
                    w.x = q8pack4(hn[j * 16 + 0], hn[j * 16 + 1], hn[j * 16 + 2], hn[j * 16 + 3], inv8); w.y = q8pack4(hn[j * 16 + 4], hn[j * 16 + 5], hn[j * 16 + 6], hn[j * 16 + 7], inv8);
                    w.z = q8pack4(hn[j * 16 + 8], hn[j * 16 + 9], hn[j * 16 + 10], hn[j * 16 + 11], inv8); w.w = q8pack4(hn[j * 16 + 12], hn[j * 16 + 13], hn[j * 16 + 14], hn[j * 16 + 15], inv8);
                    *(u32x4*)(xo8 + j * 1024 + lane * 16) = w;
                }
                if (lane == 0 && !dry) ((float*)(p.ws + WS_SCL))[SCL_XN + t] = s8;
            } else {
            bf16_t* xo = (dry ? (bf16_t*)(p.ws + WS_DUMMY) + (size_t)(t & 16383) * DM : (bf16_t*)(p.ws + WS_XN) + (size_t)t * DM);
#pragma unroll
            for (int j = 0; j < 2; ++j)
#pragma unroll
                for (int k = 0; k < 2; ++k) {
                    const int col = j * 1024 + lane * 16 + k * 8;
                    float xv[8];
#pragma unroll
                    for (int i = 0; i < 8; ++i) xv[i] = hn[j * 16 + k * 8 + i] * rstd * g1n[col + i] * (1.f + scale[col + i]) + shift[col + i];
                    u32x4 w; w.x = pk2(xv[0], xv[1]); w.y = pk2(xv[2], xv[3]); w.z = pk2(xv[4], xv[5]); w.w = pk2(xv[6], xv[7]);
                    *(u32x4*)(xo + col) = w;
                }
            }
        }
    }
}
#else
#ifndef DRY_MODE
#define DRY_MODE 0
#endif
typedef float f32x2 __attribute__((ext_vector_type(2)));
__device__ __forceinline__ void ph_gather(const Params& p, int l, const bool dry) {
    const int tid = threadIdx.x, lane = tid & 63, wave = tid >> 6;
    const int gw = blockIdx.x * NWAVES + wave, NGW = gridDim.x * NWAVES;
    const bf16_t* XN = (const bf16_t*)(p.ws + WS_XN);
    const unsigned char* UT = (const unsigned char*)(p.ws + WS_UT) + (size_t)l * NEXP * DM;
    const unsigned char* VT = (const unsigned char*)(p.ws + WS_VT) + (size_t)l * NEXP * DM;
    const float* USC = (const float*)(p.ws + WS_USC) + l * NEXP; const float* VSC = (const float*)(p.ws + WS_VSC) + l * NEXP;
    const int* EID = (const int*)(p.ws + WS_EID); const float* GATE = (const float*)(p.ws + WS_GATE);
    const float* mod = (const float*)(p.ws + WS_MOD) + (size_t)l * 9 * 12288;
    const int nrows = (l == DEPTH - 1) ? NLAT : MTOT;
#pragma unroll 1
    for (int t = gw; t < nrows; t += NGW) {
        int xq[8]; float sxl;
        {
            float x[32]; float am = 0.f;
#pragma unroll
            for (int j = 0; j < 2; ++j)
#pragma unroll
                for (int k = 0; k < 2; ++k) {
                    const u32x4 q = *(const u32x4*)(XN + (size_t)t * DM + j * 1024 + lane * 16 + k * 8);
                    float* xx = x + j * 16 + k * 8;
                    xx[0] = bflo(q.x); xx[1] = bfhi(q.x); xx[2] = bflo(q.y); xx[3] = bfhi(q.y); xx[4] = bflo(q.z); xx[5] = bfhi(q.z); xx[6] = bflo(q.w); xx[7] = bfhi(q.w);
                }
#pragma unroll
            for (int i = 0; i < 32; ++i) am = fmaxf(am, fabsf(x[i]));
            sxl = am > 0.f ? am * (1.f / 127.f) : 1.f;
            const float inv = 1.f / sxl;
#pragma unroll
            for (int d = 0; d < 8; ++d) {
                const int q0 = (int)rintf(x[4 * d] * inv), q1 = (int)rintf(x[4 * d + 1] * inv), q2 = (int)rintf(x[4 * d + 2] * inv), q3 = (int)rintf(x[4 * d + 3] * inv);
                xq[d] = (int)(((unsigned)q0 & 0xffu) | (((unsigned)q1 & 0xffu) << 8) | (((unsigned)q2 & 0xffu) << 16) | ((unsigned)q3 << 24));
            }
        }
        const int e0 = EID[(size_t)t * 128 + lane], e1 = EID[(size_t)t * 128 + 64 + lane];
        const float g0 = GATE[(size_t)t * 128 + lane], g1 = GATE[(size_t)t * 128 + 64 + lane];
        const float us0 = USC[e0], us1 = USC[e1], vs0 = VSC[e0], vs1 = VSC[e1];
        float hid0 = 0.f, hid1 = 0.f;
        constexpr int GBU = 8, GBV = 4;
#define G_LOAD(W, TAB, EB, NB) do { _Pragma("unroll") for (int i = 0; i < NB; ++i) { \
            const int id_ = __builtin_amdgcn_readlane((EB) < 64 ? e0 : e1, ((EB) + i) & 63); \
            const unsigned char* row_ = (TAB) + (size_t)id_ * DM + lane * 16; \
            W[i][0] = *(const u32x4*)row_; W[i][1] = *(const u32x4*)(row_ + 1024); } } while (0)
#define G_DOT(W, EB) do { _Pragma("unroll") for (int i = 0; i < GBU; ++i) { int s_ = 0; \
            s_ = __builtin_amdgcn_sdot4((int)W[i][0].x, xq[0], s_, false); s_ = __builtin_amdgcn_sdot4((int)W[i][0].y, xq[1], s_, false); \
            s_ = __builtin_amdgcn_sdot4((int)W[i][0].z, xq[2], s_, false); s_ = __builtin_amdgcn_sdot4((int)W[i][0].w, xq[3], s_, false); \
            s_ = __builtin_amdgcn_sdot4((int)W[i][1].x, xq[4], s_, false); s_ = __builtin_amdgcn_sdot4((int)W[i][1].y, xq[5], s_, false); \
            s_ = __builtin_amdgcn_sdot4((int)W[i][1].z, xq[6], s_, false); s_ = __builtin_amdgcn_sdot4((int)W[i][1].w, xq[7], s_, false); \
            const float tot = wave_total((float)s_ * sxl); \
            if ((((EB) + i) & 63) == lane) { if ((EB) < 64) hid0 = tot; else hid1 = tot; } } } while (0)
#define G_AXPY(W, EB) do { _Pragma("unroll") for (int i = 0; i < GBV; ++i) { \
            const float cf_ = __uint_as_float(__builtin_amdgcn_readlane(__float_as_uint((EB) < 64 ? cf0 : cf1), ((EB) + i) & 63)); \
            const f32x2 mm = {cf_, cf_}; \
            _Pragma("unroll") for (int j = 0; j < 2; ++j) { const unsigned ww[4] = {W[i][j].x, W[i][j].y, W[i][j].z, W[i][j].w}; \
                _Pragma("unroll") for (int k = 0; k < 4; ++k) { \
                    acc[j * 8 + k * 2] += mm * __builtin_amdgcn_cvt_pk_f32_fp8((int)ww[k], false); \
                    acc[j * 8 + k * 2 + 1] += mm * __builtin_amdgcn_cvt_pk_f32_fp8((int)ww[k], true); } } } } while (0)
        u32x4 wa[GBU][2], wb[GBU][2];
        const bool do_u = !(dry && (DRY_MODE == 4 || DRY_MODE == 5)), do_v = !(dry && (DRY_MODE == 3 || DRY_MODE == 5));
        if (do_u) G_LOAD(wa, UT, 0, GBU); else G_LOAD(wa, VT, 0, GBV);
#pragma unroll 1
        for (int eb = 0; eb < (do_u ? 128 : 0); eb += 2 * GBU) {
            G_LOAD(wb, UT, eb + GBU, GBU);
            G_DOT(wa, eb);
            if (eb + 2 * GBU < 128) G_LOAD(wa, UT, eb + 2 * GBU, GBU); else G_LOAD(wa, VT, 0, GBV);
            G_DOT(wb, eb + GBU);
        }
        const float cf0 = gelu_tanh(hid0 * us0) * g0 * vs0, cf1 = gelu_tanh(hid1 * us1) * g1 * vs1;
        f32x2 acc[16];
#pragma unroll
        for (int i = 0; i < 16; ++i) acc[i] = (f32x2){0.f, 0.f};
#pragma unroll 1
        for (int eb = 0; eb < (do_v ? 128 : 0); eb += 2 * GBV) {
            G_LOAD(wb, VT, eb + GBV, GBV);
            G_AXPY(wa, eb);
            if (eb + 2 * GBV < 128) G_LOAD(wa, VT, eb + 2 * GBV, GBV);
            G_AXPY(wb, eb + GBV);
        }
#undef G_LOAD
#undef G_DOT
#undef G_AXPY
        float hn[32];
        float* hrow = t < NLAT ? p.out + (size_t)t * DM : (float*)(p.ws + WS_HC) + (size_t)(t - NLAT) * DM;
        const int bb = t < NLAT ? (t >> 11) : 8;
        const float* gate = mod + (size_t)bb * 12288 + 5 * DM;
#pragma unroll
        for (int j = 0; j < 2; ++j)
#pragma unroll
            for (int k = 0; k < 4; ++k) {
                const int col = j * 1024 + lane * 16 + k * 4;
                const f32x4 hv = *(const f32x4*)(hrow + col), gv = *(const f32x4*)(gate + col);
                const f32x2 a0 = acc[j * 8 + k * 2], a1 = acc[j * 8 + k * 2 + 1];
                f32x4 o;
                o.x = hv.x + gv.x * a0.x; o.y = hv.y + gv.y * a0.y; o.z = hv.z + gv.z * a1.x; o.w = hv.w + gv.w * a1.y;
                *(f32x4*)((dry ? (float*)(p.ws + WS_DUMMY) + (size_t)(t & 16383) * DM : hrow) + col) = o;
                hn[j * 16 + k * 4 + 0] = o.x; hn[j * 16 + k * 4 + 1] = o.y; hn[j * 16 + k * 4 + 2] = o.z; hn[j * 16 + k * 4 + 3] = o.w;
            }
        if (l + 1 < DEPTH) {
            float ss = 0.f;
#pragma unroll
            for (int i = 0; i < 32; ++i) ss += hn[i] * hn[i];
            const float rstd = rsqrtf(wave_total(ss) * (1.f / DM) + EPS);
            const float* g1n = p.norm1_g + (l + 1) * DM;
            const float* shift = mod + (size_t)9 * 12288 + (size_t)bb * 12288;
            const float* scale = shift + DM;
            bf16_t* xo = (dry ? (bf16_t*)(p.ws + WS_DUMMY) + (size_t)(t & 16383) * DM : (bf16_t*)(p.ws + WS_XN) + (size_t)t * DM);
#pragma unroll
            for (int j = 0; j < 2; ++j)
#pragma unroll
                for (int k = 0; k < 2; ++k) {
                    const int col = j * 1024 + lane * 16 + k * 8;
                    float xv[8];
#pragma unroll
                    for (int i = 0; i < 8; ++i) xv[i] = hn[j * 16 + k * 8 + i] * rstd * g1n[col + i] * (1.f + scale[col + i]) + shift[col + i];
                    u32x4 w; w.x = pk2(xv[0], xv[1]); w.y = pk2(xv[2], xv[3]); w.z = pk2(xv[4], xv[5]); w.w = pk2(xv[6], xv[7]);
                    *(u32x4*)(xo + col) = w;
                }
        }
    }
}
#endif
#else
__device__ __forceinline__ float dot8(const u32x4 u, const u32x4 x) {
    float d = bflo(u.x) * bflo(x.x) + bfhi(u.x) * bfhi(x.x);
    d += bflo(u.y) * bflo(x.y) + bfhi(u.y) * bfhi(x.y);
    d += bflo(u.z) * bflo(x.z) + bfhi(u.z) * bfhi(x.z);
    d += bflo(u.w) * bflo(x.w) + bfhi(u.w) * bfhi(x.w);
    return d;
}
__device__ __forceinline__ void ph_gather(const Params& p, int l, const bool dry) {
    const int tid = threadIdx.x, lane = tid & 63, wave = tid >> 6;
    const int gw = blockIdx.x * NWAVES + wave, NGW = gridDim.x * NWAVES;
    const bf16_t* XN = (const bf16_t*)(p.ws + WS_XN);
    const bf16_t* UT = (const bf16_t*)(p.ws + WS_UT) + (size_t)l * NEXP * DM;
    const bf16_t* VT = (const bf16_t*)(p.ws + WS_VT) + (size_t)l * NEXP * DM;
    const int* EID = (const int*)(p.ws + WS_EID); const float* GATE = (const float*)(p.ws + WS_GATE);
    const float* mod = (const float*)(p.ws + WS_MOD) + (size_t)l * 9 * 12288;
    const int nrows = (l == DEPTH - 1) ? NLAT : MTOT;
    for (int t = gw; t < nrows; t += NGW) {
        u32x4 xq[4];
#pragma unroll
        for (int j = 0; j < 4; ++j) xq[j] = *(const u32x4*)(XN + (size_t)t * DM + j * 512 + lane * 8);
        const int e0 = EID[(size_t)t * 128 + lane], e1 = EID[(size_t)t * 128 + 64 + lane];
        const float g0 = GATE[(size_t)t * 128 + lane], g1 = GATE[(size_t)t * 128 + 64 + lane];
        float hid0 = 0.f, hid1 = 0.f;
#pragma unroll 1
        for (int eb = 0; eb < 128; eb += 4) {
            u32x4 uu[4][4];
#pragma unroll
            for (int i = 0; i < 4; ++i) {
                const int e = eb + i;
                const int id = __builtin_amdgcn_readlane(eb < 64 ? e0 : e1, e & 63);
                const u32x4* ur = (const u32x4*)(UT + (size_t)id * DM) + lane;
#pragma unroll
                for (int j = 0; j < 4; ++j) uu[i][j] = ur[j * 64];
            }
#pragma unroll
            for (int i = 0; i < 4; ++i) {
                const int e = eb + i;
                float d = dot8(uu[i][0], xq[0]) + dot8(uu[i][1], xq[1]) + dot8(uu[i][2], xq[2]) + dot8(uu[i][3], xq[3]);
                d = wave_sum(d);
                if ((e & 63) == lane) { if (eb < 64) hid0 = d; else hid1 = d; }
            }
        }
        const float cf0 = gelu_tanh(hid0) * g0, cf1 = gelu_tanh(hid1) * g1;
        float acc[32];
#pragma unroll
        for (int i = 0; i < 32; ++i) acc[i] = 0.f;
#pragma unroll 1
        for (int eb = 0; eb < 128; eb += 4) {
            u32x4 vv[4][4]; float cf[4];
#pragma unroll
            for (int i = 0; i < 4; ++i) {
                const int e = eb + i;
                const int id = __builtin_amdgcn_readlane(eb < 64 ? e0 : e1, e & 63);
                cf[i] = __uint_as_float(__builtin_amdgcn_readlane(__float_as_uint(eb < 64 ? cf0 : cf1), e & 63));
                const u32x4* vr = (const u32x4*)(VT + (size_t)id * DM) + lane;
#pragma unroll
                for (int j = 0; j < 4; ++j) vv[i][j] = vr[j * 64];
            }
#pragma unroll
            for (int i = 0; i < 4; ++i)
#pragma unroll
                for (int j = 0; j < 4; ++j) {
                    acc[j * 8 + 0] += cf[i] * bflo(vv[i][j].x); acc[j * 8 + 1] += cf[i] * bfhi(vv[i][j].x);
                    acc[j * 8 + 2] += cf[i] * bflo(vv[i][j].y); acc[j * 8 + 3] += cf[i] * bfhi(vv[i][j].y);
                    acc[j * 8 + 4] += cf[i] * bflo(vv[i][j].z); acc[j * 8 + 5] += cf[i] * bfhi(vv[i][j].z);
                    acc[j * 8 + 6] += cf[i] * bflo(vv[i][j].w); acc[j * 8 + 7] += cf[i] * bfhi(vv[i][j].w);
                }
        }
        float* hrow = t < NLAT ? p.out + (size_t)t * DM : (float*)(p.ws + WS_HC) + (size_t)(t - NLAT) * DM;
        const int bb = t < NLAT ? (t >> 11) : 8;
        const float* gate = mod + (size_t)bb * 12288 + 5 * DM;
#pragma unroll
        for (int j = 0; j < 4; ++j) {
            const int col = j * 512 + lane * 8;
#pragma unroll
            for (int hh = 0; hh < 2; ++hh) {
                const f32x4 hv = *(const f32x4*)(hrow + col + hh * 4), gv = *(const f32x4*)(gate + col + hh * 4);
                f32x4 o;
                o.x = hv.x + gv.x * acc[j * 8 + hh * 4 + 0]; o.y = hv.y + gv.y * acc[j * 8 + hh * 4 + 1];
                o.z = hv.z + gv.z * acc[j * 8 + hh * 4 + 2]; o.w = hv.w + gv.w * acc[j * 8 + hh * 4 + 3];
                *(f32x4*)(hrow + col + hh * 4) = o;
            }
        }
    }
}

#endif

#define LAS __attribute__((address_space(3)))
#define XB_TMO      128
#define XB_XCNT(j)  (256  + 64 * (j))
#define XB_XSUB(j)  (1280 + 64 * (j))
#define XB_XGEN(j)  (2304 + 64 * (j))
#define XB_TOP      3328
#define XB_TOPGEN   3392
#define XCD_BAR_WORDS 3456
#define XB_SPIN_CAP (1u << 18)

__device__ __forceinline__ unsigned xb_ld(unsigned* p)              { return __hip_atomic_load(p, __ATOMIC_RELAXED, __HIP_MEMORY_SCOPE_AGENT); }
__device__ __forceinline__ unsigned xb_add(unsigned* p, unsigned v) { return __hip_atomic_fetch_add(p, v, __ATOMIC_RELAXED, __HIP_MEMORY_SCOPE_AGENT); }
__device__ __forceinline__ unsigned xb_xcc_id() { return (unsigned)__builtin_amdgcn_s_getreg((3 << 11) | 20) & 0xFu; }
#define XB_SPIN(cond, bar) do { unsigned _sp = 0; while (cond) { __builtin_amdgcn_s_sleep(1); \
    if ((++_sp & 255u) == 0u) { if (xb_ld(&(bar)[XB_TMO])) break; if (_sp > XB_SPIN_CAP) { atomicAdd(&(bar)[XB_TMO], 1u); break; } } } } while (0)

struct XcdBarrier {
    unsigned* bar; unsigned x;
    volatile LAS unsigned* st;
};

__device__ __forceinline__ XcdBarrier xcd_barrier_post(unsigned* bar, volatile LAS unsigned* st) {
    XcdBarrier b; b.bar = bar; b.x = xb_xcc_id(); b.st = st;
    if (threadIdx.x == 0) (void)xb_add(&bar[XB_XCNT(b.x)], 1u);
    return b;
}
__device__ __forceinline__ void xcd_barrier_complete(unsigned* bar, unsigned x, unsigned& nloc, unsigned& nx) {
    const unsigned G = gridDim.x * gridDim.y * gridDim.z;
    unsigned sum, cnt, mine, sp = 0u;
    for (;;) {
        sum = 0u; cnt = 0u; mine = 0u;
#pragma unroll
        for (unsigned j = 0; j < 16; ++j) { const unsigned c = xb_ld(&bar[XB_XCNT(j)]); sum += c; cnt += (c > 0u) ? 1u : 0u; mine = (j == x) ? c : mine; }
        if (sum == G) break;
        __builtin_amdgcn_s_sleep(1);
        if ((++sp & 255u) == 0u) { if (xb_ld(&bar[XB_TMO])) break; if (sp > XB_SPIN_CAP) { atomicAdd(&bar[XB_TMO], 1u); break; } }
    }
    nloc = mine > 0u ? mine : 1u; nx = cnt > 0u ? cnt : 1u;
}

__device__ __forceinline__ void xcd_barrier(const XcdBarrier& b) {
    asm volatile("s_waitcnt vmcnt(0)" ::: "memory");
    __syncthreads();
    if (threadIdx.x == 0) {
        unsigned* bar = b.bar;
        __builtin_amdgcn_s_waitcnt(0);
        unsigned nloc = b.st[0], nx = b.st[1];
        if (nloc == 0u) { xcd_barrier_complete(bar, b.x, nloc, nx); b.st[0] = nloc; b.st[1] = nx; }
        const unsigned old = xb_add(&bar[XB_XSUB(b.x)], 1u);
        const unsigned gen = old / nloc;
        if (old + 1u == (gen + 1u) * nloc) {
            __builtin_amdgcn_fence(__ATOMIC_RELEASE, "agent");
            asm volatile("s_waitcnt vmcnt(0)" ::: "memory");
            const unsigned og = xb_add(&bar[XB_TOP], 1u);
            const unsigned tg = og / nx;
            if (og + 1u == (tg + 1u) * nx) xb_add(&bar[XB_TOPGEN], 1u);
            else XB_SPIN(xb_ld(&bar[XB_TOPGEN]) == tg, bar);
            __builtin_amdgcn_fence(__ATOMIC_ACQUIRE, "agent");
            xb_add(&bar[XB_XGEN(b.x)], 1u);
            asm volatile("s_waitcnt vmcnt(0)" ::: "memory");
        } else {
            XB_SPIN(xb_ld(&bar[XB_XGEN(b.x)]) == gen, bar);
            __builtin_amdgcn_fence(__ATOMIC_ACQUIRE, "agent");
            asm volatile("s_waitcnt vmcnt(0)" ::: "memory");
        }
    }
    __syncthreads();
}

constexpr int NPHASE = 1 + 10 * DEPTH;
template <int S>
__device__ __forceinline__ void run_stage(const Params& p, int l, unsigned char* lds, const bool dry) {
    const bool last = (l == DEPTH - 1);
    const float* mod = (const float*)(p.ws + WS_MOD) + (size_t)l * 9 * 12288;
    if constexpr (S == 1) { if (l == 0) { ph_modulate(p, l, 0); if (GEMM_I8 && !(GEMM3_I8 && W8_ONEPASS) && !dry) ph_weights_i8(p, lds); } }
    if constexpr (S == 2) {
#if USE_PG8
        pg8::StaticOrder So; So.init(MTOT, INW, (int)gridDim.x, (int)blockIdx.x);
#if GEMM_I8
        pg8::Gemm g{(const bf16_t*)(p.ws + WS_XN8), (const bf16_t*)(p.ws + WS_WIN + (size_t)l * INW * DM), MTOT, INW, DM / 2};
        pg8::EpiBf16I8 E{(bf16_t*)(p.ws + WS_P), INW, (const float*)(p.ws + WS_SCL) + SCL_XN, (const float*)(p.ws + WS_SCL) + SCL_WIN + l * INW};
        pg8::gemm_phase<pg8::EpiBf16I8, pg8::StaticOrder, true, true, true>((PG8_LAS unsigned char*)lds, g, So, E);
#else
        pg8::Gemm g{(const bf16_t*)(p.ws + WS_XN), (const bf16_t*)(p.ws + WS_WIN) + (size_t)l * INW * DM, MTOT, INW, DM};
        pg8::EpiBf16<0> E{(bf16_t*)(p.ws + WS_P), INW, nullptr, 0, 0, 1.f};
        pg8::gemm_phase<pg8::EpiBf16<0>, pg8::StaticOrder, true, true>((PG8_LAS unsigned char*)lds, g, So, E);
#endif
#else
        EpiBf16Store E{(bf16_t*)(p.ws + WS_P), INW};
        gemm_naive(lds, (const bf16_t*)(p.ws + WS_XN), (const bf16_t*)(p.ws + WS_WIN) + (size_t)l * INW * DM, MTOT, INW, DM, E);
#endif
    }
    if constexpr (S == 3) ph_prep(p, l, dry);
    if constexpr (S == 4) {
#if USE_FAST_ATT
        ph_mixers_fast(p, l, lds, dry);
#else
        ph_mixers_naive(p, l, lds);
#endif
    }
    if constexpr (S == 5) ph_ynorm(p, l);
    if constexpr (S == 6) {
#if USE_PG8
        const int M = last ? NLAT : MTOT;
        pg8::StaticOrder So; So.init(M, DM, (int)gridDim.x, (int)blockIdx.x);
#if GEMM_I8
        pg8::Gemm g{(const bf16_t*)(p.ws + WS_XN8), (const bf16_t*)(p.ws + WS_WOUT + (size_t)l * DM * DM), M, DM, DM / 2};
#if H_BF16 && GEMM3_I8
        pg8::EpiResGateI8B E{l == 0 ? p.x : nullptr, p.ctx, (bf16_t*)(p.ws + (dry ? WS_DUMMY : WS_HB)), mod + 2 * DM,
                             (const float*)(p.ws + WS_SCL) + SCL_Y, (const float*)(p.ws + WS_SCL) + SCL_WOUT + l * DM};
        pg8::gemm_phase<pg8::EpiResGateI8B, pg8::StaticOrder, true, true, true>((PG8_LAS unsigned char*)lds, g, So, E);
#else
        pg8::EpiResGateI8 E{l == 0 ? p.x : p.out, l == 0 ? p.ctx : (const float*)(p.ws + WS_HC), dry ? (float*)(p.ws + WS_DUMMY) : p.out, dry ? (float*)(p.ws + WS_DUMMY) : (float*)(p.ws + WS_HC), mod + 2 * DM,
                            (const float*)(p.ws + WS_SCL) + SCL_Y, (const float*)(p.ws + WS_SCL) + SCL_WOUT + l * DM};
        pg8::gemm_phase<pg8::EpiResGateI8, pg8::StaticOrder, true, true, true>((PG8_LAS unsigned char*)lds, g, So, E);
#endif
#else
        pg8::Gemm g{(const bf16_t*)(p.ws + WS_Y), (const bf16_t*)(p.ws + WS_WOUT) + (size_t)l * DM * DM, M, DM, DM};
        pg8::EpiResGateT E{l == 0 ? p.x : p.out, l == 0 ? p.ctx : (const float*)(p.ws + WS_HC), dry ? (float*)(p.ws + WS_DUMMY) : p.out, dry ? (float*)(p.ws + WS_DUMMY) : (float*)(p.ws + WS_HC), mod + 2 * DM};
        pg8::gemm_phase<pg8::EpiResGateT, pg8::StaticOrder, true, true>((PG8_LAS unsigned char*)lds, g, So, E);
#endif
#if GATHER_I8 && GATHER_4BIT
        if (TABLES_IN_GAPS && l == 0 && !dry) conv4_tables(p, 0, NEXP, (unsigned*)(p.ws + WS_CTL) + 6144, lds);
#endif
#else
        EpiResGate E{l == 0 ? p.x : p.out, l == 0 ? p.ctx : (const float*)(p.ws + WS_HC), p.out, (float*)(p.ws + WS_HC), mod + 2 * DM};
        gemm_naive(lds, (const bf16_t*)(p.ws + WS_Y), (const bf16_t*)(p.ws + WS_WOUT) + (size_t)l * DM * DM, last ? NLAT : MTOT, DM, DM, E);
#endif
    }
    if constexpr (S == 7) ph_modulate(p, l, 1);
    if constexpr (S == 8) {
#if USE_PG8
        const int M = last ? NLAT : MTOT;
        pg8::StaticOrder So; So.init(M, DM, (int)gridDim.x, (int)blockIdx.x);
#if GEMM_I8 && GEMM3_I8
        pg8::Gemm g{(const bf16_t*)(p.ws + WS_XN8), (const bf16_t*)(p.ws + WS_WQ + (size_t)l * DM * DM), M, DM, DM / 2};
        pg8::EpiBf16I8 E{(bf16_t*)(p.ws + WS_P), DM, (const float*)(p.ws + WS_SCL) + SCL_XN, (const float*)(p.ws + WS_SCL) + SCL_WQ + l * DM};
        pg8::gemm_phase<pg8::EpiBf16I8, pg8::StaticOrder, true, true, true>((PG8_LAS unsigned char*)lds, g, So, E);
#else
        pg8::Gemm g{(const bf16_t*)(p.ws + WS_XN), (const bf16_t*)(p.ws + WS_WQ) + (size_t)l * DM * DM, M, DM, DM};
        pg8::EpiBf16<0> E{(bf16_t*)(p.ws + WS_P), DM, nullptr, 0, 0, 1.f};
        pg8::gemm_phase<pg8::EpiBf16<0>, pg8::StaticOrder, true, true>((PG8_LAS unsigned char*)lds, g, So, E);
#endif
#if FUSE_ROUTE
        asm volatile("s_waitcnt vmcnt(0)" ::: "memory");
        __syncthreads();
        ph_route_fast<true>(p, l, lds);
#endif
#if GATHER_I8 && GATHER_4BIT
        if (TABLES_IN_GAPS && l == 0 && !dry) conv4_tables(p, 2 * NEXP, 3 * NEXP, (unsigned*)(p.ws + WS_CTL) + 6208, lds);
#endif
#else
        EpiBf16Store E{(bf16_t*)(p.ws + WS_P), DM};
        gemm_naive(lds, (const bf16_t*)(p.ws + WS_XN), (const bf16_t*)(p.ws + WS_WQ) + (size_t)l * DM * DM, last ? NLAT : MTOT, DM, DM, E);
#endif
    }
    if constexpr (S == 9) {
#if USE_FAST_ROUTE
        if (!FUSE_ROUTE) ph_route_fast<false>(p, l, lds);
#else
        ph_route_naive(p, l);
#endif
    }
    if constexpr (S == 10) ph_gather(p, l, dry);
}
__global__ void __launch_bounds__(NTHREADS) fwd_kernel(Params p) {
    extern __shared__ __attribute__((aligned(16))) unsigned char lds[];
    cg::grid_group grid = cg::this_grid();
    const int lo = p.ph_lo, hi = p.ph_hi;
    volatile LAS unsigned* stw = (volatile LAS unsigned*)((LAS unsigned char*)lds + (LDS_BYTES - 128));
    if (threadIdx.x < 2) stw[threadIdx.x] = 0u;
    __syncthreads();
    const XcdBarrier bar = xcd_barrier_post((unsigned*)(p.ws + WS_CTL + 32768), stw);
#define IN(k) (lo <= (k) && (k) < hi)
#define SEAM(k) do { if (IN(k) && IN((k) + 1)) xcd_barrier(bar); } while (0)
#define STAGE(S, l) do { constexpr int k_ = 1 + 10 * (l) + (S) - 1; if (IN(k_)) { if constexpr ((REP_MASK >> k_) & 1) { run_stage<S>(p, l, lds, true); xcd_barrier(bar); } run_stage<S>(p, l, lds, false); } SEAM(k_); } while (0)
#define LAYER(l) do { if ((l) == 0) { STAGE(1, l); } STAGE(2, l); STAGE(3, l); STAGE(4, l); STAGE(5, l); STAGE(6, l); STAGE(7, l); STAGE(8, l); if (!FUSE_ROUTE) { STAGE(9, l); } STAGE(10, l); } while (0)
    if (hi > NPHASE) grid.sync();
    if (IN(0)) { if constexpr (REP_MASK & 1) { ph_prologue(p, lds); xcd_barrier(bar); } ph_prologue(p, lds); }
    SEAM(0);
    LAYER(0);
    LAYER(1);
#undef IN
#undef SEAM
#undef STAGE
#undef LAYER
}

extern "C" void kernel_launch(void* const* d_in, const int* in_sizes, int n_in, void* d_out, int out_size, void* d_ws, size_t ws_size, hipStream_t stream) {
    static int grid_blocks = 0;
    if (grid_blocks == 0) {
        if (n_in != 23 || out_size != NLAT * DM || ws_size < WS_END) { fprintf(stderr, "kernel_launch: unexpected shapes n_in %d out %d ws %zu\n", n_in, out_size, ws_size); grid_blocks = -1; return; }
        if (hipFuncSetAttribute((const void*)fwd_kernel, hipFuncAttributeMaxDynamicSharedMemorySize, LDS_BYTES) != hipSuccess) { fprintf(stderr, "kernel_launch: hipFuncSetAttribute failed\n"); grid_blocks = -1; return; }
        int dev = 0, cus = 0, per_cu = 0;
        hipGetDevice(&dev);
        hipDeviceGetAttribute(&cus, hipDeviceAttributeMultiprocessorCount, dev);
        hipOccupancyMaxActiveBlocksPerMultiprocessor(&per_cu, (const void*)fwd_kernel, NTHREADS, LDS_BYTES);
        if (per_cu < 1 || cus < 1) { fprintf(stderr, "kernel_launch: occupancy query failed (%d per CU, %d CUs)\n", per_cu, cus); grid_blocks = -1; return; }
        grid_blocks = cus * per_cu;
    }
    if (grid_blocks < 0) return;
    Params p{};
    const float** pp = (const float**)&p;
    for (int i = 0; i < 23; ++i) pp[i] = (const float*)d_in[i];
    p.out = (float*)d_out; p.ws = (unsigned char*)d_ws;
    p.ph_lo = 0; p.ph_hi = NPHASE;
    hipMemsetAsync((char*)d_ws + WS_CTL, 0, 131072, stream);
    void* args[] = {&p};
    hipError_t e = hipLaunchCooperativeKernel((const void*)fwd_kernel, dim3(grid_blocks), dim3(NTHREADS), args, LDS_BYTES, stream);
    if (e != hipSuccess) fprintf(stderr, "cooperative launch failed: %s (grid %d)\n", hipGetErrorString(e), grid_blocks);
}
```

```cpp
#include <hip/hip_runtime.h>
#include <hip/hip_cooperative_groups.h>
#include <cstdio>
#include <cstdint>
namespace cg = cooperative_groups;

constexpr int DM = 2048, NB = 8, SEQ = 2048, NCTX = 256, DEPTH = 2;
constexpr int NLAT = NB * SEQ;
constexpr int NCT = NB * NCTX;
constexpr int MTOT = NLAT + NCT;
constexpr int INW = 3584;
constexpr int C_QA = 0, C_KA = 768, C_VA = 1024, C_QB = 1280, C_KB = 2048, C_VB = 2304, C_UC = 2560, C_VC = 3072;
constexpr int NEXP = 16384;
constexpr float EPS = 1e-6f;
constexpr float ATT_SCALE = 0.088388347648318440f;
constexpr int NTHREADS = 512, NWAVES = 8;

constexpr size_t MiB = 1u << 20;
constexpr size_t WS_CTL = 0;
constexpr size_t WS_MOD = 1 * MiB;
constexpr size_t WS_ROPE = 2 * MiB;
constexpr size_t WS_KEYS = 3 * MiB;
constexpr size_t WS_WSC = 4 * MiB;
constexpr size_t WS_USC = 5 * MiB;
constexpr size_t WS_VSC = 6 * MiB;
constexpr size_t WS_WIN = 8 * MiB;
constexpr size_t WS_WOUT = 36 * MiB;
constexpr size_t WS_WQ = 52 * MiB;
constexpr size_t WS_HC = 68 * MiB;
constexpr size_t WS_EID = 84 * MiB;
constexpr size_t WS_GATE = 93 * MiB;
constexpr size_t WS_XN = 104 * MiB;
constexpr size_t WS_HB = WS_XN;
constexpr size_t WS_Y = 176 * MiB;
constexpr size_t WS_P = 248 * MiB;
constexpr size_t WS_UT = 376 * MiB;
constexpr size_t WS_VT = 504 * MiB;
constexpr size_t WS_SCL = 102 * MiB;
constexpr size_t SCL_WIN = 0, SCL_WOUT = 2 * 3584, SCL_XN = SCL_WOUT + 2 * 2048, SCL_Y = SCL_XN + 18432, SCL_WQ = SCL_Y + 18432;
constexpr int NCM = 3584 + 2048 + 2048;
constexpr size_t WS_XN8 = 784 * MiB;
constexpr size_t CTL_COLMAX = 65536;
constexpr size_t WS_DUMMY = 640 * MiB;
constexpr size_t WS_END = 820 * MiB;

constexpr int LDS_BYTES = 147456;

typedef unsigned short bf16_t;
typedef float f32x4 __attribute__((ext_vector_type(4)));
typedef unsigned u32x4 __attribute__((ext_vector_type(4)));
typedef unsigned u32x2 __attribute__((ext_vector_type(2)));

struct Params {
    const float *x, *c, *ctx, *c_ctx, *w_ada, *b_ada, *norm1_g, *norm2_g, *w_in, *qn_a, *kn_a, *qn_b, *kn_b, *sink_b, *vn_c, *ws_c, *bs_c,
        *g_group, *w_out, *peer_wq, *peer_keys, *peer_u, *peer_v;
    float* out;
    unsigned char* ws;
    int ph_lo, ph_hi;
};

__device__ __forceinline__ float bf2f(unsigned v) { return __uint_as_float(v << 16); }
__device__ __forceinline__ float bflo(unsigned w) { return __uint_as_float(w << 16); }
__device__ __forceinline__ float bfhi(unsigned w) { return __uint_as_float(w & 0xffff0000u); }
__device__ __forceinline__ unsigned f2bf(float f) { unsigned u = __float_as_uint(f); return (u + 0x7fffu + ((u >> 16) & 1u)) >> 16; }
__device__ __forceinline__ unsigned pk2(float lo, float hi) { return f2bf(lo) | (f2bf(hi) << 16); }
__device__ __forceinline__ float wave_sum(float v) {
#pragma unroll
    for (int o = 32; o >= 1; o >>= 1) v += __shfl_xor(v, o);
    return v;
}
__device__ __forceinline__ float wave_max(float v) {
#pragma unroll
    for (int o = 32; o >= 1; o >>= 1) v = fmaxf(v, __shfl_xor(v, o));
    return v;
}
__device__ __forceinline__ float gelu_tanh(float x) {
    const float y = 0.7978845608028654f * (x + 0.044715f * x * x * x);
    const float t = 1.f - 2.f / (__expf(2.f * y) + 1.f);
    return 0.5f * x * (1.f + t);
}
__device__ __forceinline__ float silu(float x) { return x / (1.f + __expf(-x)); }
#define LDS_WAIT() asm volatile("s_waitcnt lgkmcnt(0)" ::: "memory")
#ifndef GATHER_I8
#define GATHER_I8 1
#endif
#ifndef GATHER_4BIT
#define GATHER_4BIT 1
#endif
constexpr int ROW4 = 1152;
#ifndef V_ROWSCALE
#define V_ROWSCALE 1
#endif
constexpr int ROWV = V_ROWSCALE ? 1024 : ROW4;
#ifndef U_ROWSCALE
#define U_ROWSCALE 1
#endif
constexpr int ROWU = U_ROWSCALE ? 1024 : ROW4;
#ifndef FUSE_ROUTE
#define FUSE_ROUTE 1
#endif
#ifndef GEMM_I8
#define GEMM_I8 1
#endif
#ifndef GEMM3_I8
#define GEMM3_I8 1
#endif
#ifndef H_BF16
#define H_BF16 1
#endif
#ifndef W8_ONEPASS
#define W8_ONEPASS 1
#endif
#ifndef DRY_MODE
#define DRY_MODE 0
#endif
#ifndef REP_MASK
#define REP_MASK 0
#endif

__device__ __forceinline__ unsigned q8pack4(float a, float b, float c, float d, float inv) {
    const int q0 = (int)rintf(a * inv), q1 = (int)rintf(b * inv), q2 = (int)rintf(c * inv), q3 = (int)rintf(d * inv);
    return ((unsigned)q0 & 0xffu) | (((unsigned)q1 & 0xffu) << 8) | (((unsigned)q2 & 0xffu) << 16) | ((unsigned)q3 << 24);
}

__device__ __forceinline__ void transpose_item(const float* W, int K, int N, bf16_t* WT, const float* gk, float* scr, int item, int lane) {
    const int nblk = N / 32, kb = item / nblk, nb = item % nblk, k0 = 64 * kb, n0 = 32 * nb;
#pragma unroll 8
    for (int i = 0; i < 32; ++i) {
        const int kk = 2 * i + (lane >> 5);
        float v = W[(size_t)(k0 + kk) * N + n0 + (lane & 31)];
        if (gk) v *= gk[k0 + kk];
        scr[kk * 33 + (lane & 31)] = v;
    }
    LDS_WAIT();
    const int c = lane & 7;
#pragma unroll
    for (int j = 0; j < 4; ++j) {
        const int n = (lane >> 3) + 8 * j;
        const float* s = scr + (8 * c) * 33 + n;
        u32x4 o;
        o.x = pk2(s[0 * 33], s[1 * 33]); o.y = pk2(s[2 * 33], s[3 * 33]); o.z = pk2(s[4 * 33], s[5 * 33]); o.w = pk2(s[6 * 33], s[7 * 33]);
        *(u32x4*)(WT + (size_t)(n0 + n) * K + k0 + 8 * c) = o;
    }
    LDS_WAIT();
}

__device__ __forceinline__ void colmax_item(const float* W, int N, const float* gk, unsigned* cmax, int item, int lane) {
    const int nblk = N / 32, kb = item / nblk, nb = item % nblk, k0 = 64 * kb, n0 = 32 * nb;
    f32x4 v[8];
#pragma unroll
    for (int i = 0; i < 8; ++i) v[i] = *(const f32x4*)(W + (size_t)(k0 + 8 * i + (lane >> 3)) * N + n0 + 4 * (lane & 7));
    float m0 = 0.f, m1 = 0.f, m2 = 0.f, m3 = 0.f;
#pragma unroll
    for (int i = 0; i < 8; ++i) {
        const float g = gk ? fabsf(gk[k0 + 8 * i + (lane >> 3)]) : 1.f;
        m0 = fmaxf(m0, fabsf(v[i].x) * g); m1 = fmaxf(m1, fabsf(v[i].y) * g); m2 = fmaxf(m2, fabsf(v[i].z) * g); m3 = fmaxf(m3, fabsf(v[i].w) * g);
    }
#pragma unroll
    for (int o = 8; o <= 32; o <<= 1) { m0 = fmaxf(m0, __shfl_xor(m0, o)); m1 = fmaxf(m1, __shfl_xor(m1, o)); m2 = fmaxf(m2, __shfl_xor(m2, o)); m3 = fmaxf(m3, __shfl_xor(m3, o)); }
    if (lane < 8) {
        unsigned* c = cmax + n0 + 4 * lane;
        atomicMax(c + 0, __float_as_uint(m0)); atomicMax(c + 1, __float_as_uint(m1)); atomicMax(c + 2, __float_as_uint(m2)); atomicMax(c + 3, __float_as_uint(m3));
    }
}
__device__ __forceinline__ void transpose_item_i8(const float* W, int K, int N, unsigned char* W8, const float* gk, const unsigned* cmax, float* scr, int item, int lane) {
    const int nblk = N / 32, kb = item / nblk, nb = item % nblk, k0 = 64 * kb, n0 = 32 * nb;
    f32x4 v[8];
#pragma unroll
    for (int i = 0; i < 8; ++i) v[i] = *(const f32x4*)(W + (size_t)(k0 + 8 * i + (lane >> 3)) * N + n0 + 4 * (lane & 7));
    float inv[4];
#pragma unroll
    for (int c = 0; c < 4; ++c) { const float m = __uint_as_float(cmax[n0 + 4 * (lane & 7) + c]); inv[c] = m > 0.f ? 127.f / m : 0.f; }
#pragma unroll
    for (int i = 0; i < 8; ++i) {
        const int kk = 8 * i + (lane >> 3);
        const float g = gk ? gk[k0 + kk] : 1.f;
        float* d = scr + kk * 33 + 4 * (lane & 7);
        d[0] = rintf(v[i].x * g * inv[0]); d[1] = rintf(v[i].y * g * inv[1]); d[2] = rintf(v[i].z * g * inv[2]); d[3] = rintf(v[i].w * g * inv[3]);
    }
    LDS_WAIT();
    const int c = lane & 7;
#pragma unroll
    for (int j = 0; j < 4; ++j) {
        const int n = (lane >> 3) + 8 * j;
        const float* s = scr + (8 * c) * 33 + n;
        unsigned lo = 0u, hi = 0u;
#pragma unroll
        for (int i = 0; i < 4; ++i) { lo |= ((unsigned)(int)s[i * 33] & 0xffu) << (8 * i); hi |= ((unsigned)(int)s[(4 + i) * 33] & 0xffu) << (8 * i); }
        u32x2 o; o.x = lo; o.y = hi;
        *(u32x2*)(W8 + (size_t)(n0 + n) * K + k0 + 8 * c) = o;
    }
    LDS_WAIT();
}
__device__ __forceinline__ void ph_weights_i8(const Params& p, unsigned char* lds) {
    const int tid = threadIdx.x, lane = tid & 63, wave = tid >> 6;
    const int gw = blockIdx.x * NWAVES + wave, NGW = gridDim.x * NWAVES;
    float* scr = (float*)(lds + wave * 8704);
    const unsigned* cm = (const unsigned*)(p.ws + WS_CTL + CTL_COLMAX);
    constexpr int I_IN = 32 * 112, I_SQ = 32 * 64, I_L = I_IN + I_SQ + (GEMM3_I8 ? I_SQ : 0);
    for (int it = gw; it < 2 * I_L; it += NGW) {
        const int l = it / I_L; const int r = it % I_L;
        if (r < I_IN) transpose_item_i8(p.w_in + (size_t)l * DM * INW, DM, INW, (unsigned char*)(p.ws + WS_WIN) + (size_t)l * INW * DM, nullptr, cm + l * NCM, scr, r, lane);
        else if (r < I_IN + I_SQ) transpose_item_i8(p.w_out + (size_t)l * DM * DM, DM, DM, (unsigned char*)(p.ws + WS_WOUT) + (size_t)l * DM * DM, p.g_group + l * DM, cm + l * NCM + INW, scr, r - I_IN, lane);
        else transpose_item_i8(p.peer_wq + (size_t)l * DM * DM, DM, DM, (unsigned char*)(p.ws + WS_WQ) + (size_t)l * DM * DM, nullptr, cm + l * NCM + INW + DM, scr, r - I_IN - I_SQ, lane);
    }
    float* S = (float*)(p.ws + WS_SCL);
    for (int i = blockIdx.x * NTHREADS + tid; i < 2 * NCM; i += gridDim.x * NTHREADS) {
        const int l = i / NCM, n = i % NCM;
        const float m = __uint_as_float(cm[i]); const float s = m > 0.f ? m * (1.f / 127.f) : 1.f;
        if (n < INW) S[SCL_WIN + l * INW + n] = s; else if (n < INW + DM) S[SCL_WOUT + l * DM + (n - INW)] = s; else S[SCL_WQ + l * DM + (n - INW - DM)] = s;
    }
}

__device__ __forceinline__ void w8_strip(const float* W, int N, int n0, const float* gk, unsigned char* W8, float* scl, unsigned char* lds) {
    constexpr int TP = 2048 + 8;
    bf16_t* T = (bf16_t*)lds;
    unsigned* cmx = (unsigned*)(lds + 32 * TP * 2);
    const int tid = threadIdx.x, nq = tid & 7, kr = tid >> 3;
    __syncthreads();
    if (tid < 32) cmx[tid] = 0u;
    float m0 = 0.f, m1 = 0.f, m2 = 0.f, m3 = 0.f;
#pragma unroll 1
    for (int s0 = 0; s0 < 32; s0 += 8) {
        f32x4 v[8];
#pragma unroll
        for (int i = 0; i < 8; ++i) v[i] = *(const f32x4*)(W + (size_t)((s0 + i) * 64 + kr) * N + n0 + 4 * nq);
#pragma unroll
        for (int i = 0; i < 8; ++i) {
            const int k = (s0 + i) * 64 + kr;
            const float g = gk ? gk[k] : 1.f;
            const float a = v[i].x * g, b = v[i].y * g, c = v[i].z * g, d = v[i].w * g;
            m0 = fmaxf(m0, fabsf(a)); m1 = fmaxf(m1, fabsf(b)); m2 = fmaxf(m2, fabsf(c)); m3 = fmaxf(m3, fabsf(d));
            T[(4 * nq + 0) * TP + k] = (bf16_t)f2bf(a); T[(4 * nq + 1) * TP + k] = (bf16_t)f2bf(b); T[(4 * nq + 2) * TP + k] = (bf16_t)f2bf(c); T[(4 * nq + 3) * TP + k] = (bf16_t)f2bf(d);
        }
    }
    __syncthreads();
    atomicMax(cmx + 4 * nq + 0, __float_as_uint(m0)); atomicMax(cmx + 4 * nq + 1, __float_as_uint(m1));
    atomicMax(cmx + 4 * nq + 2, __float_as_uint(m2)); atomicMax(cmx + 4 * nq + 3, __float_as_uint(m3));
    __syncthreads();
    const int n = tid >> 4, kc = tid & 15;
    const float cm = __uint_as_float(cmx[n]); const float inv = cm > 0.f ? 127.f / cm : 0.f;
    if (kc == 0) scl[n0 + n] = cm > 0.f ? cm * (1.f / 127.f) : 1.f;
#pragma unroll 4
    for (int s = 0; s < 16; ++s) {
        const int k = s * 128 + kc * 8;
        const u32x4 q = *(const u32x4*)(T + n * TP + k);
        u32x2 o;
        o.x = q8pack4(bflo(q.x), bfhi(q.x), bflo(q.y), bfhi(q.y), inv); o.y = q8pack4(bflo(q.z), bfhi(q.z), bflo(q.w), bfhi(q.w), inv);
        *(u32x2*)(W8 + (size_t)(n0 + n) * 2048 + k) = o;
    }
}
__device__ __forceinline__ void cvt_range(const float* src, bf16_t* dst, size_t n8, size_t gtid, size_t gthreads) {
    for (size_t i = gtid; i < n8; i += gthreads) {
        const f32x4 a = *(const f32x4*)(src + i * 8), b = *(const f32x4*)(src + i * 8 + 4);
        u32x4 o; o.x = pk2(a.x, a.y); o.y = pk2(a.z, a.w); o.z = pk2(b.x, b.y); o.w = pk2(b.z, b.w);
        *(u32x4*)(dst + i * 8) = o;
    }
}

#if GATHER_I8 && GATHER_4BIT
__device__ __forceinline__ void conv4_row(const f32x4 (&v)[8], const bool isv, unsigned char* drow, int lane, float* rowscale) {
    float am = 0.f;
#pragma unroll
    for (int i = 0; i < 8; ++i) am = fmaxf(am, fmaxf(fmaxf(fabsf(v[i].x), fabsf(v[i].y)), fmaxf(fabsf(v[i].z), fabsf(v[i].w))));
    if (V_ROWSCALE && isv) am = wave_max(am);
    float s0 = am > 0.f ? am * (isv ? (1.f / 6.f) : (1.f / 7.f)) : 1.f;
    if (U_ROWSCALE && !isv) {
        float ss = 0.f;
#pragma unroll
        for (int i = 0; i < 8; ++i) ss += v[i].x * v[i].x + v[i].y * v[i].y + v[i].z * v[i].z + v[i].w * v[i].w;
        ss = wave_sum(ss);
        s0 = ss > 0.f ? 0.35f * sqrtf(ss * (1.f / 2048.f)) : 1.f;
    }
    const unsigned sb = (__float_as_uint(s0) + 0xffffu) >> 16;
    const float inv = 1.f / __uint_as_float(sb << 16);
    u32x4 o; unsigned w[4];
#pragma unroll
    for (int d = 0; d < 4; ++d) {
        const f32x4 a = v[2 * d], b = v[2 * d + 1];
        const float e[8] = {a.x * inv, a.y * inv, a.z * inv, a.w * inv, b.x * inv, b.y * inv, b.z * inv, b.w * inv};
        unsigned acc = 0u;
        if (isv) {
            acc = __builtin_amdgcn_cvt_scalef32_pk_fp4_f32(acc, e[0], e[1], 1.0f, 0);
            acc = __builtin_amdgcn_cvt_scalef32_pk_fp4_f32(acc, e[2], e[3], 1.0f, 1);
            acc = __builtin_amdgcn_cvt_scalef32_pk_fp4_f32(acc, e[4], e[5], 1.0f, 2);
            acc = __builtin_amdgcn_cvt_scalef32_pk_fp4_f32(acc, e[6], e[7], 1.0f, 3);
        } else {
#pragma unroll
            for (int i = 0; i < 8; ++i) {
                const int q = (int)fminf(fmaxf(rintf(e[i]), -7.f), 7.f);
                acc |= ((unsigned)q & 0xFu) << (8 * (i >> 1) + 4 * (i & 1));
            }
        }
        w[d] = acc;
    }
    o.x = w[0]; o.y = w[1]; o.z = w[2]; o.w = w[3];
    *(u32x4*)(drow + lane * 16) = o;
    if ((V_ROWSCALE && isv) || (U_ROWSCALE && !isv)) { if (lane == 0) *rowscale = __uint_as_float(sb << 16); }
    else *(unsigned short*)(drow + 1024 + lane * 2) = (unsigned short)sb;
}
#endif
#if GATHER_I8 && GATHER_4BIT
#ifndef TABLES_IN_GAPS
#define TABLES_IN_GAPS 1
#endif
__device__ __forceinline__ void conv4_tables(const Params& p, int r0, int r1, unsigned* ctr, unsigned char* lds) {
    const int tid = threadIdx.x, lane = tid & 63, wave = tid >> 6;
    unsigned char* ws = p.ws;
    volatile unsigned* shw = (volatile unsigned*)(lds + LDS_BYTES - 64);
    const int nchunk = (r1 - r0) / 64;
    for (int it = 0;; ++it) {
        int cbeg, cstep, cend;
        if (ctr) {
            __syncthreads();
            if (tid == 0) *shw = atomicAdd(ctr, 1u);
            __syncthreads();
            const int c = (int)*shw; if (c >= nchunk) break;
            cbeg = r0 + c * 64 + wave; cstep = NWAVES; cend = r0 + c * 64 + 64;
        } else {
            if (it > 0) break;
            cbeg = r0 + blockIdx.x * NWAVES + wave; cstep = gridDim.x * NWAVES; cend = r1;
        }
        for (int r = cbeg; r < cend; r += 2 * cstep) {
            const int r2 = r + cstep; const bool has2 = r2 < cend; const int rb = has2 ? r2 : r;
            const bool isvA = r >= 2 * NEXP, isvB = rb >= 2 * NEXP; const int rrA = isvA ? r - 2 * NEXP : r, rrB = isvB ? rb - 2 * NEXP : rb;
            const float* srowA = (isvA ? p.peer_v : p.peer_u) + (size_t)rrA * DM;
            const float* srowB = (isvB ? p.peer_v : p.peer_u) + (size_t)rrB * DM;
            f32x4 va[8], vb[8];
#pragma unroll
            for (int j = 0; j < 2; ++j)
#pragma unroll
                for (int k = 0; k < 4; ++k) { va[j * 4 + k] = *(const f32x4*)(srowA + j * 1024 + lane * 16 + k * 4); vb[j * 4 + k] = *(const f32x4*)(srowB + j * 1024 + lane * 16 + k * 4); }
            conv4_row(va, isvA, (unsigned char*)(ws + (isvA ? WS_VT : WS_UT)) + (size_t)rrA * (isvA ? ROWV : ROWU), lane, (float*)(ws + (isvA ? WS_VSC : WS_USC)) + rrA);
            if (has2) conv4_row(vb, isvB, (unsigned char*)(ws + (isvB ? WS_VT : WS_UT)) + (size_t)rrB * (isvB ? ROWV : ROWU), lane, (float*)(ws + (isvB ? WS_VSC : WS_USC)) + rrB);
        }
    }
}
#endif
__device__ __forceinline__ void ph_prologue(const Params& p, unsigned char* lds) {
    const int tid = threadIdx.x, lane = tid & 63, wave = tid >> 6;
    const int gw = blockIdx.x * NWAVES + wave, NGW = gridDim.x * NWAVES;
    unsigned char* ws = p.ws;
    {
        float* sT = (float*)lds;
        float* red = (float*)(lds + 2048 * 12 * 4);
        for (int i = tid; i < 2048 * 9; i += NTHREADS) {
            const int k = i / 9, bb = i % 9;
            const float v = bb < 8 ? p.c[bb * DM + k] : p.c_ctx[k];
            sT[k * 12 + bb] = silu(v);
        }
        __syncthreads();
        const int cq = lane & 7, ks = tid >> 3;
        for (int u = blockIdx.x; u < 768; u += gridDim.x) {
            const int l = u / 384, n0 = (u % 384) * 32;
            const float* W = p.w_ada + (size_t)l * DM * 12288 + n0 + cq * 4;
            float acc[9][4];
#pragma unroll
            for (int b = 0; b < 9; ++b)
#pragma unroll
                for (int j = 0; j < 4; ++j) acc[b][j] = 0.f;
#pragma unroll 8
            for (int i = 0; i < 32; ++i) {
                const int k = ks + 64 * i;
                const f32x4 w = *(const f32x4*)(W + (size_t)k * 12288);
                const f32x4 s0 = *(const f32x4*)(sT + k * 12), s1 = *(const f32x4*)(sT + k * 12 + 4);
                const float s8 = sT[k * 12 + 8];
                const float sv[9] = {s0.x, s0.y, s0.z, s0.w, s1.x, s1.y, s1.z, s1.w, s8};
#pragma unroll
                for (int b = 0; b < 9; ++b) { acc[b][0] += sv[b] * w.x; acc[b][1] += sv[b] * w.y; acc[b][2] += sv[b] * w.z; acc[b][3] += sv[b] * w.w; }
            }
#pragma unroll
            for (int b = 0; b < 9; ++b)
#pragma unroll
                for (int j = 0; j < 4; ++j) {
                    float v = acc[b][j];
                    v += __shfl_xor(v, 8); v += __shfl_xor(v, 16); v += __shfl_xor(v, 32);
                    acc[b][j] = v;
                }
            if (lane < 8) {
#pragma unroll
                for (int b = 0; b < 9; ++b)
#pragma unroll
                    for (int j = 0; j < 4; ++j) red[(wave * 8 + cq) * 36 + b * 4 + j] = acc[b][j];
            }
            __syncthreads();
            if (tid < 288) {
                const int b = tid / 32, col = tid % 32, q = col >> 2, j = col & 3;
                float s = 0.f;
#pragma unroll
                for (int w = 0; w < 8; ++w) s += red[(w * 8 + q) * 36 + b * 4 + j];
                const int n = n0 + col;
                ((float*)(ws + WS_MOD))[(size_t)(l * 9 + b) * 12288 + n] = s + p.b_ada[l * 12288 + n];
            }
            __syncthreads();
        }
    }
    __syncthreads();
#if GEMM_I8 && GEMM3_I8 && W8_ONEPASS
    {
        float* S = (float*)(ws + WS_SCL);
        constexpr int ST_IN = INW / 32, ST_SQ = DM / 32, ST_L = ST_IN + 2 * ST_SQ;
        for (int it = blockIdx.x; it < 2 * ST_L; it += gridDim.x) {
            const int l = it / ST_L; int r = it % ST_L;
            if (r < ST_IN) { w8_strip(p.w_in + (size_t)l * DM * INW, INW, r * 32, nullptr, (unsigned char*)(ws + WS_WIN) + (size_t)l * INW * DM, S + SCL_WIN + l * INW, lds); continue; }
            r -= ST_IN;
            if (r < ST_SQ) { w8_strip(p.w_out + (size_t)l * DM * DM, DM, r * 32, p.g_group + l * DM, (unsigned char*)(ws + WS_WOUT) + (size_t)l * DM * DM, S + SCL_WOUT + l * DM, lds); continue; }
            r -= ST_SQ;
            w8_strip(p.peer_wq + (size_t)l * DM * DM, DM, r * 32, nullptr, (unsigned char*)(ws + WS_WQ) + (size_t)l * DM * DM, S + SCL_WQ + l * DM, lds);
        }
        __syncthreads();
    }
#else
    {
        float* scr = (float*)(lds + wave * 8704);
        constexpr int I_IN = 32 * 112, I_SQ = 32 * 64, I_L = I_IN + 2 * I_SQ;
        unsigned* cm = (unsigned*)(ws + WS_CTL + CTL_COLMAX);
        for (int it = gw; it < 2 * I_L; it += NGW) {
            const int l = it / I_L; int r = it % I_L;
            if (r < I_IN) {
                if (GEMM_I8) colmax_item(p.w_in + (size_t)l * DM * INW, INW, nullptr, cm + l * NCM, r, lane);
                else transpose_item(p.w_in + (size_t)l * DM * INW, DM, INW, (bf16_t*)(ws + WS_WIN) + (size_t)l * INW * DM, nullptr, scr, r, lane);
                continue; }
            r -= I_IN;
            if (r < I_SQ) {
                if (GEMM_I8) colmax_item(p.w_out + (size_t)l * DM * DM, DM, p.g_group + l * DM, cm + l * NCM + INW, r, lane);
                else transpose_item(p.w_out + (size_t)l * DM * DM, DM, DM, (bf16_t*)(ws + WS_WOUT) + (size_t)l * DM * DM, p.g_group + l * DM, scr, r, lane);
                continue; }
            r -= I_SQ;
            if (GEMM_I8 && GEMM3_I8) colmax_item(p.peer_wq + (size_t)l * DM * DM, DM, nullptr, cm + l * NCM + INW + DM, r, lane);
            else transpose_item(p.peer_wq + (size_t)l * DM * DM, DM, DM, (bf16_t*)(ws + WS_WQ) + (size_t)l * DM * DM, nullptr, scr, r, lane);
        }
    }
#endif
    {
        const size_t gtid = (size_t)blockIdx.x * NTHREADS + tid, gth = (size_t)gridDim.x * NTHREADS;
        cvt_range(p.peer_keys, (bf16_t*)(ws + WS_KEYS), (size_t)2 * 8 * 2 * 128 * 128 / 8, gtid, gth);
        cvt_range(p.ws_c, (bf16_t*)(ws + WS_WSC), (size_t)2 * 4 * 128 * 128 / 8, gtid, gth);
#if GATHER_I8 && GATHER_4BIT
        if (!TABLES_IN_GAPS) conv4_tables(p, 0, 4 * NEXP, nullptr, lds);
#elif GATHER_I8
        for (int r = gw; r < 4 * NEXP; r += NGW) {
            const bool isv = r >= 2 * NEXP; const int rr = isv ? r - 2 * NEXP : r;
            const float* srow = (isv ? p.peer_v : p.peer_u) + (size_t)rr * DM;
            f32x4 v[8]; float am = 0.f;
#pragma unroll
            for (int j = 0; j < 2; ++j)
#pragma unroll
                for (int k = 0; k < 4; ++k) {
                    v[j * 4 + k] = *(const f32x4*)(srow + j * 1024 + lane * 16 + k * 4);
                    am = fmaxf(am, fmaxf(fmaxf(fabsf(v[j * 4 + k].x), fabsf(v[j * 4 + k].y)), fmaxf(fabsf(v[j * 4 + k].z), fabsf(v[j * 4 + k].w))));
                }
            am = wave_max(am);
            const float s = am > 0.f ? am * (isv ? (1.f / 443.f) : (1.f / 127.f)) : 1.f, inv = 1.f / s;
            unsigned char* drow = (unsigned char*)(ws + (isv ? WS_VT : WS_UT)) + (size_t)rr * DM;
#pragma unroll
            for (int j = 0; j < 2; ++j) {
                u32x4 o; unsigned w[4];
#pragma unroll
                for (int k = 0; k < 4; ++k) {
                    const f32x4 a = v[j * 4 + k];
                    if (isv) {
                        int pk = __builtin_amdgcn_cvt_pk_fp8_f32(a.x * inv, a.y * inv, 0, false);
                        pk = __builtin_amdgcn_cvt_pk_fp8_f32(a.z * inv, a.w * inv, pk, true);
                        w[k] = (unsigned)pk;
                    } else {
                        const int q0 = (int)rintf(a.x * inv), q1 = (int)rintf(a.y * inv), q2 = (int)rintf(a.z * inv), q3 = (int)rintf(a.w * inv);
                        w[k] = ((unsigned)q0 & 0xffu) | (((unsigned)q1 & 0xffu) << 8) | (((unsigned)q2 & 0xffu) << 16) | ((unsigned)q3 << 24);
                    }
                }
                o.x = w[0]; o.y = w[1]; o.z = w[2]; o.w = w[3];
                *(u32x4*)(drow + j * 1024 + lane * 16) = o;
            }
            if (lane == 0) ((float*)(ws + (isv ? WS_VSC : WS_USC)))[rr] = s;
        }
#else
        cvt_range(p.peer_u, (bf16_t*)(ws + WS_UT), (size_t)2 * NEXP * DM / 8, gtid, gth);
        cvt_range(p.peer_v, (bf16_t*)(ws + WS_VT), (size_t)2 * NEXP * DM / 8, gtid, gth);
#endif
        float* rope = (float*)(ws + WS_ROPE);
        for (size_t i = gtid; i < (size_t)2048 * 64; i += gth) {
            const int t = (int)(i >> 6), f = (int)(i & 63), fi = f & 31;
            const float pos = (f < 32) ? (float)(t >> 6) : (float)(t & 63);
            const float inv = powf(10000.0f, -(float)fi / 32.0f);
            const float ang = pos * inv;
            rope[i * 2] = cosf(ang); rope[i * 2 + 1] = sinf(ang);
        }
    }
}


__device__ __forceinline__ void modulate_store(const f32x4 (&v)[8], float rstd, const float* g, const float* shift, const float* scale, bf16_t* dst, int lane) {
#pragma unroll
    for (int j = 0; j < 8; ++j) {
        const int col = j * 256 + lane * 4;
        const f32x4 gg = *(const f32x4*)(g + col), sc = *(const f32x4*)(scale + col), sh = *(const f32x4*)(shift + col);
        const f32x4 o = v[j] * rstd * gg * (1.f + sc) + sh;
        u32x2 w; w.x = pk2(o.x, o.y); w.y = pk2(o.z, o.w);
        *(u32x2*)(dst + col) = w;
    }
}
__device__ __forceinline__ void modulate_store_i8(const f32x4 (&v)[8], float rstd, const float* g, const float* shift, const float* scale, unsigned char* dst, float* sdst, int lane, const float levels) {
    f32x4 o[8]; float am = 0.f;
#pragma unroll
    for (int j = 0; j < 8; ++j) {
        const int col = j * 256 + lane * 4;
        const f32x4 gg = *(const f32x4*)(g + col), sc = *(const f32x4*)(scale + col), sh = *(const f32x4*)(shift + col);
        o[j] = v[j] * rstd * gg * (1.f + sc) + sh;
        am = fmaxf(am, fmaxf(fmaxf(fabsf(o[j].x), fabsf(o[j].y)), fmaxf(fabsf(o[j].z), fabsf(o[j].w))));
    }
    am = wave_max(am);
    const float s = am > 0.f ? am / levels : 1.f, inv = 1.f / s;
#pragma unroll
    for (int j = 0; j < 8; ++j) *(unsigned*)(dst + j * 256 + lane * 4) = q8pack4(o[j].x, o[j].y, o[j].z, o[j].w, inv);
    if (lane == 0) *sdst = s;
}
__device__ __forceinline__ void ph_modulate(const Params& p, int l, int which) {
    const int tid = threadIdx.x, lane = tid & 63, wave = tid >> 6;
    const int gw = blockIdx.x * NWAVES + wave, NGW = gridDim.x * NWAVES;
    const int nrows = (which == 1 && l == DEPTH - 1) ? NLAT : MTOT;
    const float* g = (which == 0 ? p.norm1_g : p.norm2_g) + l * DM;
    const float* mod = (const float*)(p.ws + WS_MOD) + (size_t)l * 9 * 12288;
    const float* srcLat = (which == 0 && l == 0) ? p.x : p.out;
    const float* srcCtx = (which == 0 && l == 0) ? p.ctx : (const float*)(p.ws + WS_HC);
    bf16_t* XN = (bf16_t*)(p.ws + WS_XN);
    const int moff = (which == 0 ? 0 : 3) * DM;
#pragma unroll 1
    for (int r = gw; r < nrows; r += 2 * NGW) {
        const int r2 = r + NGW; const bool has2 = r2 < nrows; const int rb = has2 ? r2 : r;
        const float* srcA = r < NLAT ? srcLat + (size_t)r * DM : srcCtx + (size_t)(r - NLAT) * DM;
        const float* srcB = rb < NLAT ? srcLat + (size_t)rb * DM : srcCtx + (size_t)(rb - NLAT) * DM;
        f32x4 va[8], vb[8]; float sa = 0.f, sb = 0.f;
        if (H_BF16 && GEMM_I8 && GEMM3_I8 && which == 1) {
            const bf16_t* HB = (const bf16_t*)(p.ws + WS_HB);
#pragma unroll
            for (int j = 0; j < 8; ++j) {
                const u32x2 ra = *(const u32x2*)(HB + (size_t)r * DM + j * 256 + lane * 4), rb2 = *(const u32x2*)(HB + (size_t)rb * DM + j * 256 + lane * 4);
                va[j] = (f32x4){bflo(ra.x), bfhi(ra.x), bflo(ra.y), bfhi(ra.y)}; vb[j] = (f32x4){bflo(rb2.x), bfhi(rb2.x), bflo(rb2.y), bfhi(rb2.y)};
            }
        } else {
#pragma unroll
        for (int j = 0; j < 8; ++j) { va[j] = *(const f32x4*)(srcA + j * 256 + lane * 4); vb[j] = *(const f32x4*)(srcB + j * 256 + lane * 4); }
        }
#pragma unroll
        for (int j = 0; j < 8; ++j) { sa += va[j].x * va[j].x + va[j].y * va[j].y + va[j].z * va[j].z + va[j].w * va[j].w; sb += vb[j].x * vb[j].x + vb[j].y * vb[j].y + vb[j].z * vb[j].z + vb[j].w * vb[j].w; }
        sa = wave_sum(sa); sb = wave_sum(sb);
        const float* shA = mod + (size_t)(r < NLAT ? (r >> 11) : 8) * 12288 + moff;
        const bool i8 = GEMM_I8 && (which == 0 || GEMM3_I8); const float lv = which == 0 ? 127.f : 119.f;
        unsigned char* XN8 = (unsigned char*)(p.ws + WS_XN8); float* SXN = (float*)(p.ws + WS_SCL) + SCL_XN;
        if (i8) modulate_store_i8(va, rsqrtf(sa * (1.f / DM) + EPS), g, shA, shA + DM, XN8 + (size_t)r * DM, SXN + r, lane, lv);
        else modulate_store(va, rsqrtf(sa * (1.f / DM) + EPS), g, shA, shA + DM, XN + (size_t)r * DM, lane);
        if (has2) {
            const float* shB = mod + (size_t)(r2 < NLAT ? (r2 >> 11) : 8) * 12288 + moff;
            if (i8) modulate_store_i8(vb, rsqrtf(sb * (1.f / DM) + EPS), g, shB, shB + DM, XN8 + (size_t)r2 * DM, SXN + r2, lane, lv);
            else modulate_store(vb, rsqrtf(sb * (1.f / DM) + EPS), g, shB, shB + DM, XN + (size_t)r2 * DM, lane);
        }
    }
}

struct EpiBf16Store {
    bf16_t* O; int ldc;
    __device__ __forceinline__ void operator()(int row, int col, const float* a) const {
        u32x4 w; w.x = pk2(a[0], a[1]); w.y = pk2(a[2], a[3]); w.z = pk2(a[4], a[5]); w.w = pk2(a[6], a[7]);
        *(u32x4*)(O + (size_t)row * ldc + col) = w;
    }
};
struct EpiResGate {
    const float *resLat, *resCtx; float *outLat, *outCtx; const float* gate;
    __device__ __forceinline__ void operator()(int row, int col, const float* a) const {
        const int bb = row < NLAT ? (row >> 11) : 8;
        const float* gp = gate + (size_t)bb * 12288 + col;
        const float* rp = row < NLAT ? resLat + (size_t)row * DM + col : resCtx + (size_t)(row - NLAT) * DM + col;
        float* op = row < NLAT ? outLat + (size_t)row * DM + col : outCtx + (size_t)(row - NLAT) * DM + col;
        const f32x4 g0 = *(const f32x4*)gp, g1 = *(const f32x4*)(gp + 4), r0 = *(const f32x4*)rp, r1 = *(const f32x4*)(rp + 4);
        f32x4 o0, o1;
        o0.x = r0.x + g0.x * a[0]; o0.y = r0.y + g0.y * a[1]; o0.z = r0.z + g0.z * a[2]; o0.w = r0.w + g0.w * a[3];
        o1.x = r1.x + g1.x * a[4]; o1.y = r1.y + g1.y * a[5]; o1.z = r1.z + g1.z * a[6]; o1.w = r1.w + g1.w * a[7];
        *(f32x4*)op = o0; *(f32x4*)(op + 4) = o1;
    }
};
template <class Epi>
__device__ __forceinline__ void gemm_naive(unsigned char* lds, const bf16_t* A, const bf16_t* Bt, int M, int N, int K, const Epi& E) {
    float* As = (float*)lds;
    float* Bs = As + 32 * 132;
    const int tid = threadIdx.x, tx = tid & 15, ty = tid >> 4;
    const int lrow = tid >> 2, lkc = (tid & 3) * 8;
    const int nM = M / 128, nN = N / 128;
    for (int u = blockIdx.x; u < nM * nN; u += gridDim.x) {
        const int pm = u / nN, pn = u % nN, m0 = pm * 128, n0 = pn * 128;
        float acc[4][8];
#pragma unroll
        for (int i = 0; i < 4; ++i)
#pragma unroll
            for (int j = 0; j < 8; ++j) acc[i][j] = 0.f;
        for (int k0 = 0; k0 < K; k0 += 32) {
            const u32x4 av = *(const u32x4*)(A + (size_t)(m0 + lrow) * K + k0 + lkc);
            const u32x4 bv = *(const u32x4*)(Bt + (size_t)(n0 + lrow) * K + k0 + lkc);
            __syncthreads();
            As[(lkc + 0) * 132 + lrow] = bflo(av.x); As[(lkc + 1) * 132 + lrow] = bfhi(av.x);
            As[(lkc + 2) * 132 + lrow] = bflo(av.y); As[(lkc + 3) * 132 + lrow] = bfhi(av.y);
            As[(lkc + 4) * 132 + lrow] = bflo(av.z); As[(lkc + 5) * 132 + lrow] = bfhi(av.z);
            As[(lkc + 6) * 132 + lrow] = bflo(av.w); As[(lkc + 7) * 132 + lrow] = bfhi(av.w);
            Bs[(lkc + 0) * 132 + lrow] = bflo(bv.x); Bs[(lkc + 1) * 132 + lrow] = bfhi(bv.x);
            Bs[(lkc + 2) * 132 + lrow] = bflo(bv.y); Bs[(lkc + 3) * 132 + lrow] = bfhi(bv.y);
            Bs[(lkc + 4) * 132 + lrow] = bflo(bv.z); Bs[(lkc + 5) * 132 + lrow] = bfhi(bv.z);
            Bs[(lkc + 6) * 132 + lrow] = bflo(bv.w); Bs[(lkc + 7) * 132 + lrow] = bfhi(bv.w);
            __syncthreads();
#pragma unroll 8
            for (int k = 0; k < 32; ++k) {
                const f32x4 a = *(const f32x4*)(As + k * 132 + ty * 4);
                const f32x4 b0 = *(const f32x4*)(Bs + k * 132 + tx * 8), b1 = *(const f32x4*)(Bs + k * 132 + tx * 8 + 4);
                const float av4[4] = {a.x, a.y, a.z, a.w};
                const float bv8[8] = {b0.x, b0.y, b0.z, b0.w, b1.x, b1.y, b1.z, b1.w};
#pragma unroll
                for (int i = 0; i < 4; ++i)
#pragma unroll
                    for (int j = 0; j < 8; ++j) acc[i][j] += av4[i] * bv8[j];
            }
        }
#pragma unroll
        for (int i = 0; i < 4; ++i) E(m0 + ty * 4 + i, n0 + tx * 8, acc[i]);
    }
}

namespace pg8 {
#define PG8_LAS __attribute__((address_space(3)))
typedef unsigned short bf16_t;
typedef short bf16x8 __attribute__((ext_vector_type(8)));
typedef float f32x4 __attribute__((ext_vector_type(4)));
typedef unsigned u32x4 __attribute__((ext_vector_type(4)));
constexpr int BM = 256, BK = 64, HALF = 128, HTB = HALF * BK * 2  , STAGE_BYTES = 8 * HTB, NXCD = 8, WGM = 8;

__host__ __device__ __forceinline__ int lds_byte(int r, int c) { const int st = (r >> 4) * 2 + (c >> 5), rr = r & 15, cc = c & 31, ob = rr * 64 + cc * 2; return st * 1024 + (ob ^ (((ob >> 9) & 1) << 5)); }
__host__ __device__ __forceinline__ void stage_rc(int b, int& R, int& C) { const int st = b / 1024, sb = b % 1024, swz = sb ^ (((sb >> 9) & 1) << 5); R = (st >> 1) * 16 + swz / 64; C = (st & 1) * 32 + (swz % 64) / 2; }
__host__ __device__ __forceinline__ int perm32(int rho) { const int n = rho >> 4, i = rho & 15; return 8 * (i >> 2) + 4 * n + (i & 3); }

struct Unit { int pm, pn; };
struct Gemm { const bf16_t* A; const bf16_t* Bt; int M, N, K; };

struct StaticOrder {
    int nM, nN, nwg, G, c;
    __host__ __device__ void init(int M, int N, int G_, int c_) { nM = M / BM; nN = N / BM; nwg = nM * nN; G = G_; c = c_; }
    __host__ __device__ bool next(int i, Unit& u) const {
        const long L = (long)i * G + c; if (L >= nwg) return false;
        int wgid = (int)L; { const int q = nwg / NXCD, r = nwg % NXCD, xcd = wgid % NXCD, off = wgid / NXCD; wgid = (xcd < r ? xcd * (q + 1) : r * (q + 1) + (xcd - r) * q) + off; }
        const int nig = WGM * nN, gid = wgid / nig, fm = gid * WGM, gsz = (nM - fm) < WGM ? (nM - fm) : WGM;
        u.pm = fm + ((wgid % nig) % gsz); u.pn = (wgid % nig) / gsz; return true;
    }
    __device__ __forceinline__ void a_ready(const Unit&) const {}
    __device__ __forceinline__ void done(const Unit&) const {}
};

__device__ __forceinline__ unsigned cvt_pk_bf16(float lo, float hi) { unsigned r; asm volatile("v_cvt_pk_bf16_f32 %0, %1, %2" : "=v"(r) : "v"(lo), "v"(hi)); return r; }
typedef float f32x2 __attribute__((ext_vector_type(2)));
__device__ __forceinline__ f32x2 gelu_pk(f32x2 v) {
    const f32x2 av = __builtin_elementwise_abs(v), d = av * 0.2316418882f + 1.0f;
    f32x2 t; t.x = __builtin_amdgcn_rcpf(d.x); t.y = __builtin_amdgcn_rcpf(d.y);
    f32x2 q = t * 0.5307027145f + (-0.7265760135f); q = q * t + 0.7107068705f; q = q * t + (-0.142248368f); q = q * t + 0.127414796f; q = q * t;
    const f32x2 s = (v * v) * (-0.72134752044f);
    f32x2 e; e.x = __builtin_amdgcn_exp2f(s.x); e.y = __builtin_amdgcn_exp2f(s.y);
    const f32x2 m = v * (q * e), r = v - m;
    f32x2 o; o.x = v.x < 0.f ? m.x : r.x; o.y = v.y < 0.f ? m.y : r.y; return o;
}

template <int ACT  > struct EpiBf16 {
    static constexpr bool PERM = true, AFTER_DRAIN = false; static_assert(ACT == 0 || ACT == 1, "EpiBf16: ACT is 0 (none) or 1 (gelu_pk)");
    bf16_t* O; int ldc; const float* bias; int split_cols; size_t split_stride; float scale0;
    __device__ __forceinline__ void operator()(const f32x4 (&acc)[2][2][4][2], const Unit& u, int wr, int wc, int fr, int fq) const {
        const int row0 = u.pm * BM + wr * 64 + fr; int colt = u.pn * BM; bf16_t* base = O;
        float sc = 1.f; if (split_cols) { const int t = colt / split_cols; base += (size_t)t * split_stride; colt -= t * split_cols; if (t == 0) sc = scale0; }
        const int col0 = colt + wc * 32 + 8 * fq, bcol0 = u.pn * BM + wc * 32 + 8 * fq;
        f32x4 bv[2][2];
#pragma unroll
        for (int bj = 0; bj < 2; ++bj)
#pragma unroll
            for (int n = 0; n < 2; ++n) bv[bj][n] = bias ? *(const f32x4*)(bias + bcol0 + bj * HALF + 4 * n) : (f32x4){0.f, 0.f, 0.f, 0.f};
#pragma unroll
        for (int ai = 0; ai < 2; ++ai)
#pragma unroll
            for (int m = 0; m < 4; ++m) { bf16_t* rowp = base + (size_t)(row0 + ai * HALF + m * 16) * ldc + col0;
#pragma unroll
                for (int bj = 0; bj < 2; ++bj) { f32x4 v0 = acc[ai][bj][m][0] + bv[bj][0], v1 = acc[ai][bj][m][1] + bv[bj][1];
                    if (ACT == 1) { f32x2 a = gelu_pk((f32x2){v0[0], v0[1]}), b = gelu_pk((f32x2){v0[2], v0[3]}), c = gelu_pk((f32x2){v1[0], v1[1]}), d = gelu_pk((f32x2){v1[2], v1[3]});
                        v0 = (f32x4){a.x, a.y, b.x, b.y}; v1 = (f32x4){c.x, c.y, d.x, d.y}; }
                    v0 = v0 * sc; v1 = v1 * sc; u32x4 w; w.x = cvt_pk_bf16(v0[0], v0[1]); w.y = cvt_pk_bf16(v0[2], v0[3]); w.z = cvt_pk_bf16(v1[0], v1[1]); w.w = cvt_pk_bf16(v1[2], v1[3]);
                    *(u32x4*)(rowp + bj * HALF) = w; } }
    }
};
typedef int i32x4 __attribute__((ext_vector_type(4)));
template <bool I8> struct AccSel { typedef f32x4 type; };
template <> struct AccSel<true> { typedef i32x4 type; };
template <class Epi, class Sched, bool ALIGN_EPI = false, bool SP2 = false, bool I8 = false>
__device__ __forceinline__ void gemm_phase(PG8_LAS unsigned char* lds, const Gemm g, const Sched& S, const Epi& E) {
    const int tid = threadIdx.x, wid = __builtin_amdgcn_readfirstlane(tid >> 6), lane = tid & 63, wr = wid >> 2, wc = wid & 3, fr = lane & 15, fq = lane >> 4;
    const int K = g.K, nt = K / BK;
    unsigned voffA[2], voffB[2];
#pragma unroll
    for (int i = 0; i < 2; ++i) { int R, C; stage_rc(tid * 16 + i * 8192, R, C); const int Rb = Epi::PERM ? ((R & ~31) + perm32(R & 31)) : R;
        voffA[i] = (unsigned)(R * K + C) * 2u; voffB[i] = (unsigned)(Rb * K + C) * 2u; }
    const size_t kstep = (size_t)(BK * 2);
    const size_t hstep = (size_t)HALF * K * 2;
    const size_t tstep = 2 * hstep;
    const unsigned ldsw = (unsigned)wid * 1024u;
    const int aoff = lds_byte(wr * 64 + fr, fq * 8), boff = lds_byte(wc * 32 + fr, fq * 8);
#define PG8_SA(b, h) (((b) * 2 + (h)) * HTB)
#define PG8_SB(b, h) ((4 + (b) * 2 + (h)) * HTB)
#define PG8_STAGE(bufoff, gbase, voff) do { _Pragma("unroll") for (int _i = 0; _i < 2; ++_i) \
        __builtin_amdgcn_global_load_lds((const unsigned*)((const char*)(gbase) + (voff)[_i]), (PG8_LAS unsigned*)(lds + (bufoff) + ldsw + _i * 8192), 16, 0, 0); } while (0)
#define PG8_LDA(dst, b, h) do { _Pragma("unroll") for (int m = 0; m < 4; ++m) _Pragma("unroll") for (int k = 0; k < 2; ++k) dst[m][k] = *(const PG8_LAS bf16x8*)(lds + PG8_SA(b, h) + aoff + m * 2048 + k * 1024); } while (0)
#define PG8_LDB(dst, b, h) do { _Pragma("unroll") for (int n = 0; n < 2; ++n) _Pragma("unroll") for (int k = 0; k < 2; ++k) dst[n][k] = *(const PG8_LAS bf16x8*)(lds + PG8_SB(b, h) + boff + n * 2048 + k * 1024); } while (0)
#define PG8_MMA(ai, bj, At, Bt) do { __builtin_amdgcn_s_setprio(1); _Pragma("unroll") for (int m = 0; m < 4; ++m) _Pragma("unroll") for (int n = 0; n < 2; ++n) _Pragma("unroll") for (int k = 0; k < 2; ++k) \
        { if constexpr (I8) acc[ai][bj][m][n] = __builtin_amdgcn_mfma_i32_16x16x64_i8(__builtin_bit_cast(i32x4, Bt[n][k]), __builtin_bit_cast(i32x4, At[m][k]), acc[ai][bj][m][n], 0, 0, 0); \
          else acc[ai][bj][m][n] = __builtin_amdgcn_mfma_f32_16x16x32_bf16(Bt[n][k], At[m][k], acc[ai][bj][m][n], 0, 0, 0); } __builtin_amdgcn_s_setprio(0); } while (0)
#define PG8_WAIT_V(n) asm volatile("s_waitcnt vmcnt(" #n ")" ::: "memory")
#define PG8_WAIT_L(n) asm volatile("s_waitcnt lgkmcnt(" #n ")" ::: "memory")
#define PG8_BAR __builtin_amdgcn_s_barrier()
#define PG8_SCHED __builtin_amdgcn_sched_barrier(0)
    Unit cur, nxt; int ui = 0;
    if (!S.next(0, cur)) return;
    typedef typename AccSel<I8>::type acc_t; const acc_t zero_ = {};
    acc_t acc[2][2][4][2];
#pragma unroll
    for (int a = 0; a < 2; ++a)
#pragma unroll
        for (int b = 0; b < 2; ++b)
#pragma unroll
            for (int m = 0; m < 4; ++m)
#pragma unroll
                for (int n = 0; n < 2; ++n) acc[a][b][m][n] = zero_;
    bf16x8 At[4][2], B0[2][2], B1[2][2];
    const char* cA = (const char*)g.A + (size_t)cur.pm * tstep; const char* cB = (const char*)g.Bt + (size_t)cur.pn * tstep;
    S.a_ready(cur);
    if constexpr (SP2) {
        PG8_STAGE(PG8_SB(0, 0), cB, voffB); PG8_STAGE(PG8_SB(0, 1), cB + hstep, voffB); PG8_STAGE(PG8_SA(0, 0), cA, voffA); PG8_STAGE(PG8_SA(0, 1), cA + hstep, voffA);
        if (wr == 1) PG8_BAR;
        PG8_WAIT_V(2); PG8_BAR;
        PG8_STAGE(PG8_SB(1, 0), cB + kstep, voffB); PG8_STAGE(PG8_SA(1, 0), cA + kstep, voffA); PG8_STAGE(PG8_SB(1, 1), cB + hstep + kstep, voffB);
        PG8_WAIT_V(6); PG8_BAR;
    } else {
        PG8_STAGE(PG8_SB(0, 0), cB, voffB); PG8_STAGE(PG8_SA(0, 0), cA, voffA); PG8_STAGE(PG8_SB(0, 1), cB + hstep, voffB); PG8_STAGE(PG8_SA(0, 1), cA + hstep, voffA);
        if (wr == 1) PG8_BAR;
        PG8_WAIT_V(4); PG8_BAR;
        PG8_STAGE(PG8_SB(1, 0), cB + kstep, voffB); PG8_STAGE(PG8_SA(1, 0), cA + kstep, voffA); PG8_STAGE(PG8_SB(1, 1), cB + hstep + kstep, voffB);
        PG8_WAIT_V(6); PG8_BAR;
    }
    for (;;) {
        const bool has_next = S.next(ui + 1, nxt);
        const char* nA = has_next ? (const char*)g.A + (size_t)nxt.pm * tstep : cA; const char* nB = has_next ? (const char*)g.Bt + (size_t)nxt.pn * tstep : cB;
        for (int t = 0; t < nt; t += 2) {
            const bool last = (t == nt - 2);
            const char* a1 = cA + (size_t)(t + 1) * kstep;
            const char* a2 = last ? nA : cA + (size_t)(t + 2) * kstep; const char* b2 = last ? nB : cB + (size_t)(t + 2) * kstep;
            const char* a3 = a2 + kstep; const char* b3 = b2 + kstep;
            if (last && has_next) S.a_ready(nxt);
            if constexpr (SP2) {
            PG8_LDB(B0, 0, 0); PG8_LDB(B1, 0, 1); PG8_SCHED; PG8_LDA(At, 0, 0); PG8_STAGE(PG8_SA(1, 1), a1 + hstep, voffA);
            PG8_WAIT_V(8); PG8_WAIT_L(0); PG8_BAR; PG8_MMA(0, 0, At, B0); PG8_MMA(0, 1, At, B1); PG8_BAR; PG8_SCHED;
            PG8_LDA(At, 0, 1); PG8_STAGE(PG8_SB(0, 0), b2, voffB); PG8_STAGE(PG8_SB(0, 1), b2 + hstep, voffB); PG8_STAGE(PG8_SA(0, 0), a2, voffA);
            PG8_WAIT_V(8); PG8_WAIT_L(0); PG8_BAR; PG8_MMA(1, 0, At, B0); PG8_MMA(1, 1, At, B1); PG8_BAR; PG8_SCHED;
            PG8_LDB(B0, 1, 0); PG8_LDB(B1, 1, 1); PG8_SCHED; PG8_LDA(At, 1, 0); PG8_STAGE(PG8_SA(0, 1), a2 + hstep, voffA);
            PG8_WAIT_V(8); PG8_WAIT_L(0); PG8_BAR; PG8_MMA(0, 0, At, B0); PG8_MMA(0, 1, At, B1); PG8_BAR; PG8_SCHED;
            PG8_LDA(At, 1, 1); PG8_STAGE(PG8_SB(1, 0), b3, voffB); PG8_STAGE(PG8_SB(1, 1), b3 + hstep, voffB); PG8_STAGE(PG8_SA(1, 0), a3, voffA);
            PG8_WAIT_V(8); PG8_WAIT_L(0); PG8_BAR; PG8_MMA(1, 0, At, B0); PG8_MMA(1, 1, At, B1); PG8_BAR; PG8_SCHED;
            } else {
            PG8_LDB(B0, 0, 0); PG8_SCHED; PG8_LDA(At, 0, 0); PG8_STAGE(PG8_SA(1, 1), a1 + hstep, voffA);
            PG8_WAIT_L(8); PG8_BAR; PG8_WAIT_L(0); PG8_MMA(0, 0, At, B0); PG8_BAR; PG8_SCHED;
            PG8_LDB(B1, 0, 1); PG8_STAGE(PG8_SB(0, 0), b2, voffB);
            PG8_BAR; PG8_WAIT_L(0); PG8_MMA(0, 1, At, B1); PG8_BAR;
            PG8_LDA(At, 0, 1); PG8_STAGE(PG8_SA(0, 0), a2, voffA);
            PG8_BAR; PG8_WAIT_L(0); PG8_MMA(1, 0, At, B0); PG8_BAR; PG8_SCHED;
            PG8_STAGE(PG8_SB(0, 1), b2 + hstep, voffB);
            PG8_WAIT_V(6); PG8_BAR; PG8_MMA(1, 1, At, B1); PG8_BAR;
            PG8_LDB(B0, 1, 0); PG8_SCHED; PG8_LDA(At, 1, 0); PG8_STAGE(PG8_SA(0, 1), a2 + hstep, voffA);
            PG8_WAIT_L(8); PG8_BAR; PG8_WAIT_L(0); PG8_MMA(0, 0, At, B0); PG8_BAR; PG8_SCHED;
            PG8_LDB(B1, 1, 1); PG8_STAGE(PG8_SB(1, 0), b3, voffB);
            PG8_BAR; PG8_WAIT_L(0); PG8_MMA(0, 1, At, B1); PG8_BAR;
            PG8_LDA(At, 1, 1); PG8_STAGE(PG8_SA(1, 0), a3, voffA);
            PG8_BAR; PG8_WAIT_L(0); PG8_MMA(1, 0, At, B0); PG8_BAR; PG8_SCHED;
            PG8_STAGE(PG8_SB(1, 1), b3 + hstep, voffB);
            PG8_WAIT_V(6); PG8_BAR; PG8_MMA(1, 1, At, B1); PG8_BAR;
            }
        }
        if constexpr (ALIGN_EPI) { if (wr == 0) PG8_BAR; }
        if constexpr (!Epi::AFTER_DRAIN) { E(acc, cur, wr, wc, fr, fq); S.done(cur); }
        if (!has_next) break;
#pragma unroll
        for (int a = 0; a < 2; ++a)
#pragma unroll
            for (int b = 0; b < 2; ++b)
#pragma unroll
                for (int m = 0; m < 4; ++m)
#pragma unroll
                    for (int n = 0; n < 2; ++n) acc[a][b][m][n] = zero_;
        cur = nxt; cA = nA; cB = nB; ++ui;
        if constexpr (ALIGN_EPI) { if (wr == 1) PG8_BAR; }
    }
    PG8_WAIT_V(0);
    if constexpr (!ALIGN_EPI) { if (wr == 0) PG8_BAR; }
    PG8_BAR;
    if constexpr (Epi::AFTER_DRAIN) { E.fused(acc, cur, wr, wc, fr, fq, lds, wid, lane); S.done(cur); }
#undef PG8_SA
#undef PG8_SB
#undef PG8_STAGE
#undef PG8_LDA
#undef PG8_LDB
#undef PG8_MMA
#undef PG8_WAIT_V
#undef PG8_WAIT_L
#undef PG8_BAR
#undef PG8_SCHED
}

struct EpiResGateT {
    static constexpr bool PERM = false, AFTER_DRAIN = false;
    const float *resLat, *resCtx; float *outLat, *outCtx; const float* gate;
    __device__ __forceinline__ void operator()(const f32x4 (&acc)[2][2][4][2], const Unit& u, int wr, int wc, int fr, int fq) const {
        const int trow = u.pm * BM, row0 = trow + wr * 64 + fr, col0 = u.pn * BM + wc * 32 + 4 * fq;
        const bool lat = trow < 16384;
        const int bb = lat ? (trow >> 11) : 8;
        const float* rbase = lat ? resLat + (size_t)row0 * 2048 : resCtx + (size_t)(row0 - 16384) * 2048;
        float* obase = lat ? outLat + (size_t)row0 * 2048 : outCtx + (size_t)(row0 - 16384) * 2048;
        f32x4 gv[2][2];
#pragma unroll
        for (int bj = 0; bj < 2; ++bj)
#pragma unroll
            for (int n = 0; n < 2; ++n) gv[bj][n] = *(const f32x4*)(gate + (size_t)bb * 12288 + col0 + bj * HALF + n * 16);
#pragma unroll
        for (int ai = 0; ai < 2; ++ai)
#pragma unroll
            for (int m = 0; m < 4; ++m) {
                const size_t off = (size_t)(ai * HALF + m * 16) * 2048 + col0;
#pragma unroll
                for (int bj = 0; bj < 2; ++bj)
#pragma unroll
                    for (int n = 0; n < 2; ++n) {
                        const f32x4 r = *(const f32x4*)(rbase + off + bj * HALF + n * 16);
                        *(f32x4*)(obase + off + bj * HALF + n * 16) = r + gv[bj][n] * acc[ai][bj][m][n];
                    }
            }
    }
};

struct EpiBf16I8 {
    static constexpr bool PERM = true, AFTER_DRAIN = false;
    bf16_t* O; int ldc; const float* sa; const float* sb;
    __device__ __forceinline__ void operator()(const i32x4 (&acc)[2][2][4][2], const Unit& u, int wr, int wc, int fr, int fq) const {
        const int row0 = u.pm * BM + wr * 64 + fr, col0 = u.pn * BM + wc * 32 + 8 * fq;
        f32x4 sv[2][2];
#pragma unroll
        for (int bj = 0; bj < 2; ++bj)
#pragma unroll
            for (int n = 0; n < 2; ++n) sv[bj][n] = *(const f32x4*)(sb + col0 + bj * HALF + 4 * n);
#pragma unroll
        for (int ai = 0; ai < 2; ++ai)
#pragma unroll
            for (int m = 0; m < 4; ++m) {
                const int row = row0 + ai * HALF + m * 16; const float s = sa[row];
                bf16_t* rowp = O + (size_t)row * ldc + col0;
#pragma unroll
                for (int bj = 0; bj < 2; ++bj) {
                    const i32x4 a0 = acc[ai][bj][m][0], a1 = acc[ai][bj][m][1];
                    const f32x4 v0 = (f32x4){(float)a0.x, (float)a0.y, (float)a0.z, (float)a0.w} * s * sv[bj][0];
                    const f32x4 v1 = (f32x4){(float)a1.x, (float)a1.y, (float)a1.z, (float)a1.w} * s * sv[bj][1];
                    u32x4 w; w.x = cvt_pk_bf16(v0[0], v0[1]); w.y = cvt_pk_bf16(v0[2], v0[3]); w.z = cvt_pk_bf16(v1[0], v1[1]); w.w = cvt_pk_bf16(v1[2], v1[3]);
                    *(u32x4*)(rowp + bj * HALF) = w;
                }
            }
    }
};
struct EpiResGateI8 {
    static constexpr bool PERM = false, AFTER_DRAIN = false;
    const float *resLat, *resCtx; float *outLat, *outCtx; const float* gate; const float* sa; const float* sb;
    __device__ __forceinline__ void operator()(const i32x4 (&acc)[2][2][4][2], const Unit& u, int wr, int wc, int fr, int fq) const {
        const int trow = u.pm * BM, row0 = trow + wr * 64 + fr, col0 = u.pn * BM + wc * 32 + 4 * fq;
        const bool lat = trow < 16384;
        const int bb = lat ? (trow >> 11) : 8;
        const float* rbase = lat ? resLat + (size_t)row0 * 2048 : resCtx + (size_t)(row0 - 16384) * 2048;
        float* obase = lat ? outLat + (size_t)row0 * 2048 : outCtx + (size_t)(row0 - 16384) * 2048;
        f32x4 gv[2][2];
#pragma unroll
        for (int bj = 0; bj < 2; ++bj)
#pragma unroll
            for (int n = 0; n < 2; ++n) gv[bj][n] = *(const f32x4*)(gate + (size_t)bb * 12288 + col0 + bj * HALF + n * 16) * *(const f32x4*)(sb + col0 + bj * HALF + n * 16);
#pragma unroll
        for (int ai = 0; ai < 2; ++ai)
#pragma unroll
            for (int m = 0; m < 4; ++m) {
                const size_t off = (size_t)(ai * HALF + m * 16) * 2048 + col0;
                const float s = sa[row0 + ai * HALF + m * 16];
#pragma unroll
                for (int bj = 0; bj < 2; ++bj)
#pragma unroll
                    for (int n = 0; n < 2; ++n) {
                        const f32x4 r = *(const f32x4*)(rbase + off + bj * HALF + n * 16);
                        const i32x4 a = acc[ai][bj][m][n];
                        *(f32x4*)(obase + off + bj * HALF + n * 16) = r + gv[bj][n] * ((f32x4){(float)a.x, (float)a.y, (float)a.z, (float)a.w} * s);
                    }
            }
    }
};

struct EpiResGateI8B {
    static constexpr bool PERM = true, AFTER_DRAIN = false;
    const float *resLat, *resCtx;
    bf16_t* hb; const float* gate; const float* sa; const float* sb;
    __device__ __forceinline__ void operator()(const i32x4 (&acc)[2][2][4][2], const Unit& u, int wr, int wc, int fr, int fq) const {
        const int trow = u.pm * BM, row0 = trow + wr * 64 + fr, col0 = u.pn * BM + wc * 32 + 8 * fq;
        const bool lat = trow < 16384;
        const int bb = lat ? (trow >> 11) : 8;
        f32x4 gv[2][2];
#pragma unroll
        for (int bj = 0; bj < 2; ++bj)
#pragma unroll
            for (int n = 0; n < 2; ++n) gv[bj][n] = *(const f32x4*)(gate + (size_t)bb * 12288 + col0 + bj * HALF + 4 * n) * *(const f32x4*)(sb + col0 + bj * HALF + 4 * n);
#pragma unroll
        for (int ai = 0; ai < 2; ++ai)
#pragma unroll
            for (int m = 0; m < 4; ++m) {
                const int row = row0 + ai * HALF + m * 16; const float s = sa[row];
                bf16_t* hp = hb + (size_t)row * 2048 + col0;
#pragma unroll
                for (int bj = 0; bj < 2; ++bj) {
                    f32x4 r0, r1;
                    if (resLat) {
                        const float* rp = (lat ? resLat + (size_t)row * 2048 : resCtx + (size_t)(row - 16384) * 2048) + col0 + bj * HALF;
                        r0 = *(const f32x4*)rp; r1 = *(const f32x4*)(rp + 4);
                    } else {
                        const u32x4 q = *(const u32x4*)(hp + bj * HALF);
                        r0 = (f32x4){__uint_as_float(q.x << 16), __uint_as_float(q.x & 0xffff0000u), __uint_as_float(q.y << 16), __uint_as_float(q.y & 0xffff0000u)};
                        r1 = (f32x4){__uint_as_float(q.z << 16), __uint_as_float(q.z & 0xffff0000u), __uint_as_float(q.w << 16), __uint_as_float(q.w & 0xffff0000u)};
                    }
                    const i32x4 a0 = acc[ai][bj][m][0], a1 = acc[ai][bj][m][1];
                    const f32x4 v0 = r0 + (gv[bj][0] * s) * (f32x4){(float)a0.x, (float)a0.y, (float)a0.z, (float)a0.w};
                    const f32x4 v1 = r1 + (gv[bj][1] * s) * (f32x4){(float)a1.x, (float)a1.y, (float)a1.z, (float)a1.w};
                    u32x4 w; w.x = cvt_pk_bf16(v0[0], v0[1]); w.y = cvt_pk_bf16(v0[2], v0[3]); w.z = cvt_pk_bf16(v1[0], v1[1]); w.w = cvt_pk_bf16(v1[2], v1[3]);
                    *(u32x4*)(hp + bj * HALF) = w;
                }
            }
    }
};
}
#ifndef USE_PG8
#define USE_PG8 1
#endif

__device__ __forceinline__ float sum16(float v) { v += __shfl_xor(v, 1); v += __shfl_xor(v, 2); v += __shfl_xor(v, 4); v += __shfl_xor(v, 8); return v; }
__device__ __forceinline__ void ph_prep(const Params& p, int l, const bool dry) {
    const int tid = threadIdx.x, lane = tid & 63, wave = tid >> 6, sub = lane >> 4, li = lane & 15;
    const int gw = blockIdx.x * NWAVES + wave, NGW = gridDim.x * NWAVES;
    bf16_t* P = (bf16_t*)(p.ws + WS_P);
    const float* rope = (const float*)(p.ws + WS_ROPE);
    const bool last = (l == DEPTH - 1);
    const int f0 = (li >= 8 ? 32 : 0) + 8 * (li & 3);
    const float sg = (li & 4) ? 1.f : -1.f;
#pragma unroll 1
    for (int r = gw; r < MTOT; r += NGW) {
        bf16_t* row = P + (size_t)r * INW;
        bf16_t* wrow = dry ? (bf16_t*)(p.ws + WS_DUMMY) + (size_t)r * INW : row;
        const bool isctx = r >= NLAT;
        const int t = r & (SEQ - 1);
        float cs[8], sn[8];
        if (!isctx) {
            const f32x4* rp = (const f32x4*)(rope + ((size_t)t * 64 + f0) * 2);
            const f32x4 a = rp[0], b = rp[1], c = rp[2], d = rp[3];
            cs[0] = a.x; sn[0] = a.y; cs[1] = a.z; sn[1] = a.w; cs[2] = b.x; sn[2] = b.y; cs[3] = b.z; sn[3] = b.w;
            cs[4] = c.x; sn[4] = c.y; cs[5] = c.z; sn[5] = c.w; cs[6] = d.x; sn[6] = d.y; cs[7] = d.z; sn[7] = d.w;
        } else {
#pragma unroll
            for (int i = 0; i < 8; ++i) { cs[i] = 1.f; sn[i] = 0.f; }
        }
        u32x4 raw[7];
#pragma unroll
        for (int gI = 0; gI < 7; ++gI) raw[gI] = *(const u32x4*)(row + (gI * 4 + sub) * 128 + li * 8);
#pragma unroll
        for (int gI = 0; gI < 7; ++gI) {
            const int slot = gI * 4 + sub;
            const int kind = slot < 8 ? 0 : slot < 10 ? 1 : slot < 18 ? 0 : slot < 20 ? 1 : slot < 24 ? 2 : 3;
            const bool isq = slot < 6 || (slot >= 10 && slot < 16);
            float x[8];
            x[0] = bflo(raw[gI].x); x[1] = bfhi(raw[gI].x); x[2] = bflo(raw[gI].y); x[3] = bfhi(raw[gI].y);
            x[4] = bflo(raw[gI].z); x[5] = bfhi(raw[gI].z); x[6] = bflo(raw[gI].w); x[7] = bfhi(raw[gI].w);
            if (kind >= 2) {
#pragma unroll
                for (int i = 0; i < 8; ++i) x[i] = gelu_tanh(x[i]);
            }
            float ss = 0.f;
#pragma unroll
            for (int i = 0; i < 8; ++i) ss += x[i] * x[i];
            ss = sum16(ss);
            const float rstd = rsqrtf(ss * (1.f / 128.f) + EPS);
            const float* gain = slot < 6 ? p.qn_a + l * 128 : slot < 8 ? p.kn_a + l * 128 : slot < 16 ? p.qn_b + l * 128 : slot < 20 ? p.kn_b + l * 128 : p.vn_c + l * 512 + (slot - 24) * 128;
            if (kind == 0 || kind == 3) {
                const f32x4 g0 = *(const f32x4*)(gain + li * 8), g1 = *(const f32x4*)(gain + li * 8 + 4);
                x[0] *= rstd * g0.x; x[1] *= rstd * g0.y; x[2] *= rstd * g0.z; x[3] *= rstd * g0.w;
                x[4] *= rstd * g1.x; x[5] *= rstd * g1.y; x[6] *= rstd * g1.z; x[7] *= rstd * g1.w;
            }
            float px[8];
#pragma unroll
            for (int i = 0; i < 8; ++i) px[i] = __shfl_xor(x[i], 4);
            if (kind == 0) {
#pragma unroll
                for (int i = 0; i < 8; ++i) x[i] = x[i] * cs[i] + sg * px[i] * sn[i];
            }
            bool wr = kind != 1;
            if (isctx && last && (isq || kind >= 2)) wr = false;
            if (wr) { u32x4 o; o.x = pk2(x[0], x[1]); o.y = pk2(x[2], x[3]); o.z = pk2(x[4], x[5]); o.w = pk2(x[6], x[7]); *(u32x4*)(wrow + slot * 128 + li * 8) = o; }
        }
    }
}

__device__ __forceinline__ void attn_row_naive(const bf16_t* q, const bf16_t* kc, const bf16_t* vc, const bf16_t* kl, const bf16_t* vl, int j0, int j1,
                                               bool has_sink, float sink, bf16_t* o, int lane) {
    const unsigned qq = *(const unsigned*)(q + 2 * lane);
    const float q0 = bflo(qq), q1 = bfhi(qq);
    float m = -INFINITY, lsum = 0.f, o0 = 0.f, o1 = 0.f;
    const int ntot = NCTX + (j1 - j0);
    for (int j = 0; j < ntot; ++j) {
        const bf16_t* kp = j < NCTX ? kc + (size_t)j * INW : kl + (size_t)(j0 + j - NCTX) * INW;
        const bf16_t* vp = j < NCTX ? vc + (size_t)j * INW : vl + (size_t)(j0 + j - NCTX) * INW;
        const unsigned kk = *(const unsigned*)(kp + 2 * lane), vv = *(const unsigned*)(vp + 2 * lane);
        const float s = wave_sum(q0 * bflo(kk) + q1 * bfhi(kk)) * ATT_SCALE;
        const float mn = fmaxf(m, s);
        const float a = __expf(m - mn), pp = __expf(s - mn);
        lsum = lsum * a + pp; o0 = o0 * a + pp * bflo(vv); o1 = o1 * a + pp * bfhi(vv);
        m = mn;
    }
    if (has_sink) {
        const float mn = fmaxf(m, sink);
        const float a = __expf(m - mn);
        lsum = lsum * a + __expf(sink - mn); o0 *= a; o1 *= a;
    }
    const float inv = 1.f / lsum;
    *(unsigned*)(o + 2 * lane) = pk2(o0 * inv, o1 * inv);
}

__device__ __forceinline__ void ph_mixers_naive(const Params& p, int l, unsigned char* lds) {
    const int tid = threadIdx.x, lane = tid & 63, wave = tid >> 6;
    const int gw = blockIdx.x * NWAVES + wave, NGW = gridDim.x * NWAVES;
    const bf16_t* P = (const bf16_t*)(p.ws + WS_P);
    bf16_t* Y = (bf16_t*)(p.ws + WS_Y);
    const bool last = (l == DEPTH - 1);
    const int T_LA = NLAT * 6, T_LB = NLAT * 6, T_CA = last ? 0 : NCT * 6, T_CB = last ? 0 : NCT * 6;
    const int ntask = T_LA + T_LB + T_CA + T_CB;
    for (int tk = gw; tk < ntask; tk += NGW) {
        int r = tk;
        if (r < T_LA + T_LB) {
            const bool isB = r >= T_LA; if (isB) r -= T_LA;
            const int b = r / (6 * SEQ), h = (r / SEQ) % 6, t = r % SEQ, kv = h / 3;
            const size_t row = (size_t)b * SEQ + t, crow0 = (size_t)NLAT + (size_t)b * NCTX, lrow0 = (size_t)b * SEQ;
            const int cq = isB ? C_QB : C_QA, ck = isB ? C_KB : C_KA, cvv = isB ? C_VB : C_VA;
            int j0 = 0, j1 = SEQ;
            if (isB) { j0 = t - 128 < 0 ? 0 : t - 128; j1 = t + 129 > SEQ ? SEQ : t + 129; }
            attn_row_naive(P + row * INW + cq + h * 128, P + crow0 * INW + ck + kv * 128, P + crow0 * INW + cvv + kv * 128,
                           P + lrow0 * INW + ck + kv * 128, P + lrow0 * INW + cvv + kv * 128, j0, j1, isB, isB ? p.sink_b[l * 6 + h] : 0.f,
                           Y + row * DM + (isB ? 768 : 0) + h * 128, lane);
        } else {
            r -= T_LA + T_LB;
            const bool isB = r >= T_CA; if (isB) r -= T_CA;
            const int b = r / (6 * NCTX), h = (r / NCTX) % 6, t = r % NCTX, kv = h / 3;
            const size_t crow0 = (size_t)NLAT + (size_t)b * NCTX, row = crow0 + t;
            const int cq = isB ? C_QB : C_QA, ck = isB ? C_KB : C_KA, cvv = isB ? C_VB : C_VA;
            attn_row_naive(P + row * INW + cq + h * 128, P + crow0 * INW + ck + kv * 128, P + crow0 * INW + cvv + kv * 128,
                           P, P, 0, 0, isB, isB ? p.sink_b[l * 6 + h] : 0.f, Y + row * DM + (isB ? 768 : 0) + h * 128, lane);
        }
    }
    __syncthreads();
    float* Wl = (float*)lds;
    float* Vl = Wl + 128 * 128;
    const int nchunk = last ? NLAT / 128 : MTOT / 128;
    for (int u = blockIdx.x; u < nchunk * 4; u += gridDim.x) {
        const int ch = u >> 2, g = u & 3; const size_t row0 = (size_t)ch * 128;
        __syncthreads();
        for (int i = tid; i < 128 * 128; i += NTHREADS) {
            Wl[i] = p.ws_c[((size_t)l * 4 + g) * 16384 + i];
            const int q = i >> 7, c = i & 127;
            Vl[i] = bf2f(P[(row0 + q) * INW + C_VC + g * 128 + c]);
        }
        __syncthreads();
        const int c = tid & 127, pg = tid >> 7;
        for (int pp = pg * 32; pp < pg * 32 + 32; ++pp) {
            float s = 0.f;
#pragma unroll 8
            for (int q = 0; q < 128; ++q) s += Wl[pp * 128 + q] * Vl[q * 128 + c];
            s += p.bs_c[((size_t)l * 4 + g) * 128 + pp];
            const float uu = bf2f(P[(row0 + pp) * INW + C_UC + g * 128 + c]);
            Y[(row0 + pp) * DM + 1536 + g * 128 + c] = (bf16_t)f2bf(uu * s);
        }
    }
}


namespace att {
constexpr float SCALE = 0.088388347648318440f;
constexpr float THR = 8.f;
constexpr int D = 128, NW = 8, QBLK = 32, KVBLK = 64;
#ifndef ATT_SDEPTH
#define ATT_SDEPTH 2
#endif
constexpr int SDEPTH = ATT_SDEPTH;
constexpr int LDQ = INW, LDK = INW, LDO = DM;
constexpr size_t SHM_V = KVBLK * D * 2, SHM_K = KVBLK * D * 2, SHM_ATTN = 2 * SHM_V + 2 * SHM_K + NW * 64 * 4;
using bf16x8 = __attribute__((ext_vector_type(8))) short;
using s16x4  = __attribute__((ext_vector_type(4))) short;
using f32x16 = __attribute__((ext_vector_type(16))) float;
using f32x8  = __attribute__((ext_vector_type(8))) float;

#define KSWZ(row, colB) ((row) * 256 + ((colB) ^ (((row) & 7) << 4)))
#define SBAR() __builtin_amdgcn_sched_barrier(0)
__device__ __forceinline__ int crow(int r, int hi) { return (r & 3) + 8 * (r >> 2) + 4 * hi; }
__device__ __forceinline__ unsigned cvtpk(float lo, float hi) {
  unsigned r; asm volatile("v_cvt_pk_bf16_f32 %0, %1, %2" : "=v"(r) : "v"(lo), "v"(hi)); return r;
}

__device__ __forceinline__ void partialSM(f32x16& p0, f32x16& p1, float& m_reg, float& mn, float& alpha) {
  constexpr float C = SCALE * 1.4426950408889634f;
  float pmax = p0[0]; for (int r = 1; r < 16; ++r) pmax = fmaxf(pmax, p0[r]); for (int r = 0; r < 16; ++r) pmax = fmaxf(pmax, p1[r]);
  { auto rr = __builtin_amdgcn_permlane32_swap(__float_as_uint(pmax), __float_as_uint(pmax), false, false);
    pmax = fmaxf(__uint_as_float(rr[0]), __uint_as_float(rr[1])); }
  if (__builtin_expect(__all(pmax - m_reg <= THR / SCALE), 1)) { mn = m_reg; alpha = 1.f; }
  else { mn = fmaxf(m_reg, pmax); alpha = __builtin_amdgcn_exp2f((m_reg - mn) * C); m_reg = mn; }
  float mnC = -mn * C;
  for (int r = 0; r < 16; ++r) p0[r] = fmaf(p0[r], C, mnC); for (int r = 0; r < 16; ++r) p1[r] = fmaf(p1[r], C, mnC);
  for (int r = 0; r < 16; ++r) p0[r] = __builtin_amdgcn_exp2f(p0[r]);
}
__device__ __forceinline__ void finishSM(f32x16& p0, f32x16& p1, float alpha, float& l_reg, bf16x8& pa0, bf16x8& pa1, bf16x8& pa2, bf16x8& pa3) {
  for (int r = 0; r < 16; ++r) p1[r] = __builtin_amdgcn_exp2f(p1[r]);
  float ps = 0; for (int r = 0; r < 16; ++r) ps += p0[r]; for (int r = 0; r < 16; ++r) ps += p1[r];
  { auto rr = __builtin_amdgcn_permlane32_swap(__float_as_uint(ps), __float_as_uint(ps), false, false);
    ps = __uint_as_float(rr[0]) + __uint_as_float(rr[1]); }
  l_reg = l_reg * alpha + ps;
#define PK4(P, BASE, OUT) do { unsigned a0 = cvtpk(P[BASE + 0], P[BASE + 1]), a1 = cvtpk(P[BASE + 2], P[BASE + 3]);   \
    unsigned b0 = cvtpk(P[BASE + 4], P[BASE + 5]), b1 = cvtpk(P[BASE + 6], P[BASE + 7]);                              \
    auto r0 = __builtin_amdgcn_permlane32_swap(a0, b0, false, false); auto r1 = __builtin_amdgcn_permlane32_swap(a1, b1, false, false); \
    u32x4 w = {r0[0], r1[0], r0[1], r1[1]}; OUT = *reinterpret_cast<bf16x8*>(&w); } while (0)
  PK4(p0, 0, pa0); PK4(p0, 8, pa1); PK4(p1, 0, pa2); PK4(p1, 8, pa3);
#undef PK4
}
__device__ __forceinline__ void qkt(f32x16& p0, f32x16& p1, const bf16_t* Ks, const bf16x8* qr, int r32, int hi) {
  p0 = f32x16{}; p1 = f32x16{};
  for (int d0 = 0; d0 < 8; ++d0) { int cb = (d0 * 16 + hi * 8) * 2;
    bf16x8 b0 = *reinterpret_cast<const bf16x8*>((const char*)Ks + KSWZ(r32, cb));
    bf16x8 b1 = *reinterpret_cast<const bf16x8*>((const char*)Ks + KSWZ(32 + r32, cb));
    p0 = __builtin_amdgcn_mfma_f32_32x32x16_bf16(b0, qr[d0], p0, 0, 0, 0);
    p1 = __builtin_amdgcn_mfma_f32_32x32x16_bf16(b1, qr[d0], p1, 0, 0, 0); }
}
__device__ __forceinline__ int v_st(int k, int c) { const int kk = (k & ~0xC) | ((k & 4) << 1) | ((k & 8) >> 1); return ((kk >> 3) * 4 + (c >> 5)) * 512 + ((kk & 7) * 32 + (c & 31)) * 2; }
__device__ __forceinline__ int v_rd_base(int lane) { return ((lane & 3) << 3) | (((lane >> 2) & 3) << 6) | (((lane >> 4) & 1) << 5) | (((lane >> 5) & 1) << 8); }
constexpr int v_rd_off(int d0, int ks, int half) { return d0 * 512 + ks * 4096 + half * 2048; }
template <int OFF> __device__ __forceinline__ s16x4 tr_read(int vb) {
  s16x4 r; asm volatile("ds_read_b64_tr_b16 %0, %1 offset:%2" : "=&v"(r) : "v"(vb), "i"(OFF) : "memory"); return r;
}
template <int D0> __device__ __forceinline__ void pv_one(f32x16& od, int vb, bf16x8 pa0, bf16x8 pa1, bf16x8 pa2, bf16x8 pa3) {
  const s16x4 l0 = tr_read<v_rd_off(D0, 0, 0)>(vb), h0 = tr_read<v_rd_off(D0, 0, 1)>(vb), l1 = tr_read<v_rd_off(D0, 1, 0)>(vb), h1 = tr_read<v_rd_off(D0, 1, 1)>(vb);
  const s16x4 l2 = tr_read<v_rd_off(D0, 2, 0)>(vb), h2 = tr_read<v_rd_off(D0, 2, 1)>(vb), l3 = tr_read<v_rd_off(D0, 3, 0)>(vb), h3 = tr_read<v_rd_off(D0, 3, 1)>(vb);
  asm volatile("s_waitcnt lgkmcnt(0)" ::: "memory"); SBAR();
#define PK(L, H) (bf16x8){L[0], L[1], L[2], L[3], H[0], H[1], H[2], H[3]}
  od = __builtin_amdgcn_mfma_f32_32x32x16_bf16(pa0, PK(l0, h0), od, 0, 0, 0);
  od = __builtin_amdgcn_mfma_f32_32x32x16_bf16(pa1, PK(l1, h1), od, 0, 0, 0);
  od = __builtin_amdgcn_mfma_f32_32x32x16_bf16(pa2, PK(l2, h2), od, 0, 0, 0);
  od = __builtin_amdgcn_mfma_f32_32x32x16_bf16(pa3, PK(l3, h3), od, 0, 0, 0);
#undef PK
}
__device__ __forceinline__ void pv_d0(f32x16* o, int vb, bf16x8 pa0, bf16x8 pa1, bf16x8 pa2, bf16x8 pa3) {
  pv_one<0>(o[0], vb, pa0, pa1, pa2, pa3); pv_one<1>(o[1], vb, pa0, pa1, pa2, pa3); pv_one<2>(o[2], vb, pa0, pa1, pa2, pa3); pv_one<3>(o[3], vb, pa0, pa1, pa2, pa3);
}

__device__ __forceinline__ void attn_unit(const bool MASK, const bf16_t* __restrict__ Qb, const bf16_t* __restrict__ Kc, const bf16_t* __restrict__ Vc,
                                          const bf16_t* __restrict__ Kl, const bf16_t* __restrict__ Vl, int nlt, int qpos0, int kpos0,
                                          bool has_sink, float sink, bf16_t* __restrict__ Ob, char* lds) {
  int tid_ = threadIdx.x; asm volatile("" : "+v"(tid_));
  const int tid = tid_, wid = tid >> 6, lane = tid & 63, r32 = lane & 31, hi = lane >> 5;
  bf16_t* V_lds = (bf16_t*)lds; bf16_t* K_lds = (bf16_t*)(lds + 2 * SHM_V);
  float* ws = (float*)(lds + 2 * SHM_V + 2 * SHM_K) + wid * 64; float* li_l = ws; float* al_l = ws + 32;
  float m_reg = -1e30f, l_reg = 0; f32x16 o[4] = {}; bf16x8 qr[8];
  const bf16_t* Qw = Qb + (long)(wid * QBLK + r32) * LDQ + hi * 8;
#pragma unroll
  for (int d0 = 0; d0 < 8; ++d0) qr[d0] = *reinterpret_cast<const bf16x8*>(Qw + d0 * 16);
  const int sr = tid >> 4, sc = (tid & 15) * 8, vst0 = v_st(sr, sc), vst1 = v_st(32 + sr, sc);
  const int vb0 = (int)(uintptr_t)V_lds + v_rd_base(lane);
  struct { bf16x8 vs0, vs1, ks0, ks1; } sr_[SDEPTH];
  const int qpos = qpos0 + wid * QBLK + r32;
#define KVP(t, KP, VP) const bf16_t* KP = ((t) < 4 ? Kc + (long)(t) * KVBLK * LDK : Kl + (long)((t) - 4) * KVBLK * LDK); const bf16_t* VP = ((t) < 4 ? Vc + (long)(t) * KVBLK * LDK : Vl + (long)((t) - 4) * KVBLK * LDK)
#define SLOAD(i, t) do { KVP(t, kp_, vp_); sr_[i].vs0 = *reinterpret_cast<const bf16x8*>(&vp_[(long)sr * LDK + sc]); sr_[i].vs1 = *reinterpret_cast<const bf16x8*>(&vp_[(long)(32 + sr) * LDK + sc]); \
    sr_[i].ks0 = *reinterpret_cast<const bf16x8*>(&kp_[(long)sr * LDK + sc]); sr_[i].ks1 = *reinterpret_cast<const bf16x8*>(&kp_[(long)(32 + sr) * LDK + sc]); } while (0)
#define SWRITE(b, i) do { *(bf16x8*)((char*)V_lds + (b) * SHM_V + vst0) = sr_[i].vs0;          \
    *(bf16x8*)((char*)V_lds + (b) * SHM_V + vst1) = sr_[i].vs1; int kc = sc * 2;               \
    *(bf16x8*)((char*)K_lds + (b) * SHM_K + KSWZ(sr, kc)) = sr_[i].ks0;                       \
    *(bf16x8*)((char*)K_lds + (b) * SHM_K + KSWZ(32 + sr, kc)) = sr_[i].ks1; } while (0)
#define SWAIT() do { if constexpr (SDEPTH == 2) asm volatile("s_waitcnt vmcnt(4)" ::: "memory"); else asm volatile("s_waitcnt vmcnt(0)" ::: "memory"); } while (0)
#define RESC(a) do { if (__any((a) < 1.f)) { if (hi == 0) al_l[r32] = (a); asm volatile("s_waitcnt lgkmcnt(0)" ::: "memory"); \
    for (int d = 0; d < 4; ++d) for (int r = 0; r < 16; ++r) o[d][r] *= al_l[crow(r, hi)]; } } while (0)
#define WMASK(P0, P1, t) do { if (MASK && (t) >= 4) { const int kb_ = kpos0 + ((t) - 4) * KVBLK + 4 * hi - qpos; \
    _Pragma("unroll") for (int r = 0; r < 16; ++r) { const int dk = kb_ + (r & 3) + 8 * (r >> 2); \
      if (dk > 128 || dk < -128) P0[r] = -1e30f; if (dk + 32 > 128 || dk + 32 < -128) P1[r] = -1e30f; } } } while (0)
  f32x16 pA0, pA1, pB0, pB1; float mnA, mnB, alA, alB; bf16x8 pa0, pa1, pa2, pa3; const int NT = 4 + nlt;
  constexpr int SE = 0, SO = SDEPTH - 1;
  SLOAD(SE, 0); asm volatile("s_waitcnt vmcnt(0)" ::: "memory"); SWRITE(0, SE); __syncthreads();
  qkt(pA0, pA1, K_lds, qr, r32, hi); partialSM(pA0, pA1, m_reg, mnA, alA);
  SLOAD(SO, 1); if constexpr (SDEPTH == 2) { if (2 < NT) SLOAD(SE, 2); }
  SWAIT(); SWRITE(1, SO); __syncthreads();
  for (int j = 1; j + 1 < NT; j += 2) {
    SBAR(); qkt(pB0, pB1, (bf16_t*)((char*)K_lds + SHM_K), qr, r32, hi); WMASK(pB0, pB1, j);
    finishSM(pA0, pA1, alA, l_reg, pa0, pa1, pa2, pa3); SBAR();
    SLOAD(SO, j + SDEPTH); SBAR();
    pv_d0(o, vb0, pa0, pa1, pa2, pa3); partialSM(pB0, pB1, m_reg, mnB, alB);
    __syncthreads(); SWAIT(); SWRITE(0, SE);
    RESC(alB); __syncthreads();
    SBAR(); qkt(pA0, pA1, K_lds, qr, r32, hi); WMASK(pA0, pA1, j + 1);
    finishSM(pB0, pB1, alB, l_reg, pa0, pa1, pa2, pa3); SBAR();
    if (SDEPTH == 1 || j + 3 < NT) SLOAD(SE, j + 1 + SDEPTH); SBAR();
    pv_d0(o, vb0 + (int)SHM_V, pa0, pa1, pa2, pa3); partialSM(pA0, pA1, m_reg, mnA, alA);
    __syncthreads(); SWAIT(); SWRITE(1, SO);
    RESC(alA); __syncthreads();
  }
  SBAR(); qkt(pB0, pB1, (bf16_t*)((char*)K_lds + SHM_K), qr, r32, hi); WMASK(pB0, pB1, NT - 1);
  finishSM(pA0, pA1, alA, l_reg, pa0, pa1, pa2, pa3); SBAR();
  pv_d0(o, vb0, pa0, pa1, pa2, pa3); partialSM(pB0, pB1, m_reg, mnB, alB);
  __syncthreads(); RESC(alB);
  finishSM(pB0, pB1, alB, l_reg, pa0, pa1, pa2, pa3); SBAR();
  pv_d0(o, vb0 + (int)SHM_V, pa0, pa1, pa2, pa3);
  if (has_sink) l_reg += __builtin_amdgcn_exp2f(sink * 1.4426950408889634f - m_reg * (SCALE * 1.4426950408889634f));
  if (hi == 0) li_l[r32] = l_reg; asm volatile("s_waitcnt lgkmcnt(0)" ::: "memory");
  float rli[16];
#pragma unroll
  for (int r = 0; r < 16; ++r) rli[r] = __builtin_amdgcn_rcpf(li_l[crow(r, hi)]);
  bf16_t* Ow = Ob + (long)(wid * QBLK) * LDO;
  char* stg = (char*)K_lds + wid * 4096;
#pragma unroll
  for (int hf = 0; hf < 2; ++hf) {
#pragma unroll
    for (int r = 0; r < 16; ++r) { const int orow = crow(r, hi);
#pragma unroll
      for (int dd = 0; dd < 2; ++dd) *(bf16_t*)(stg + orow * 128 + (dd * 32 + r32) * 2) = (bf16_t)f2bf(o[hf * 2 + dd][r] * rli[r]); }
    asm volatile("s_waitcnt lgkmcnt(0)" ::: "memory");
    const int rr = lane >> 1, hb = lane & 1;
    const u32x4 v0 = *(const u32x4*)(stg + rr * 128 + hb * 64), v1 = *(const u32x4*)(stg + rr * 128 + hb * 64 + 16);
    const u32x4 v2 = *(const u32x4*)(stg + rr * 128 + hb * 64 + 32), v3 = *(const u32x4*)(stg + rr * 128 + hb * 64 + 48);
    bf16_t* dst = Ow + (long)rr * LDO + hf * 64 + hb * 32;
    *(u32x4*)dst = v0; *(u32x4*)(dst + 8) = v1; *(u32x4*)(dst + 16) = v2; *(u32x4*)(dst + 24) = v3;
  }
  __syncthreads();
#undef KVP
#undef SLOAD
#undef SWRITE
#undef SWAIT
#undef RESC
#undef WMASK
}
#undef KSWZ
#undef SBAR
}


__device__ __forceinline__ void cmlp_unit_naive(const Params& p, int l, int ch, int g, unsigned char* lds) {
    int tid_ = threadIdx.x; asm volatile("" : "+v"(tid_));
    const int tid = tid_;
    const bf16_t* P = (const bf16_t*)(p.ws + WS_P);
    bf16_t* Y = (bf16_t*)(p.ws + WS_Y);
    float* Wl = (float*)lds;
    float* Vl = Wl + 128 * 128;
    const size_t row0 = (size_t)ch * 128;
    __syncthreads();
    for (int i = tid; i < 128 * 128; i += NTHREADS) {
        Wl[i] = p.ws_c[((size_t)l * 4 + g) * 16384 + i];
        const int q = i >> 7, c = i & 127;
        Vl[i] = bf2f(P[(row0 + q) * INW + C_VC + g * 128 + c]);
    }
    __syncthreads();
    const int c = tid & 127, pg = tid >> 7;
    for (int pp = pg * 32; pp < pg * 32 + 32; ++pp) {
        float s = 0.f;
#pragma unroll 8
        for (int q = 0; q < 128; ++q) s += Wl[pp * 128 + q] * Vl[q * 128 + c];
        s += p.bs_c[((size_t)l * 4 + g) * 128 + pp];
        const float uu = bf2f(P[(row0 + pp) * INW + C_UC + g * 128 + c]);
        Y[(row0 + pp) * DM + 1536 + g * 128 + c] = (bf16_t)f2bf(uu * s);
    }
    __syncthreads();
}


__device__ __forceinline__ void cmlp_unit_fast(const Params& p, int l, int ch, int g, unsigned char* lds) {
    typedef short bf16x8 __attribute__((ext_vector_type(8)));
    typedef float f32x16 __attribute__((ext_vector_type(16)));
    int tid_ = threadIdx.x; asm volatile("" : "+v"(tid_));
    const int tid = tid_, lane = tid & 63, wave = tid >> 6, r32 = lane & 31, hh = lane >> 5;
    const bf16_t* P = (const bf16_t*)(p.ws + WS_P);
    bf16_t* Y = (bf16_t*)(p.ws + WS_Y);
    const bf16_t* W = (const bf16_t*)(p.ws + WS_WSC) + ((size_t)l * 4 + g) * 16384;
    bf16_t* VT = (bf16_t*)lds;
    const size_t row0 = (size_t)ch * 128;
    __syncthreads();
#pragma unroll
    for (int it = 0; it < 4; ++it) {
        const int q = it * 32 + (tid >> 4), c0 = (tid & 15) * 8;
        const u32x4 v = *(const u32x4*)(P + (row0 + q) * INW + C_VC + g * 128 + c0);
        const unsigned w[4] = {v.x, v.y, v.z, v.w};
#pragma unroll
        for (int i = 0; i < 4; ++i) { VT[(c0 + 2 * i) * 136 + q] = (bf16_t)(w[i] & 0xffffu); VT[(c0 + 2 * i + 1) * 136 + q] = (bf16_t)(w[i] >> 16); }
    }
    __syncthreads();
    const int cb = wave & 3, pb0 = (wave >> 2) * 2;
    f32x16 acc0 = {}, acc1 = {};
#pragma unroll
    for (int s = 0; s < 8; ++s) {
        const bf16x8 b = *(const bf16x8*)(VT + (cb * 32 + r32) * 136 + 16 * s + 8 * hh);
        const bf16x8 a0 = *(const bf16x8*)(W + (size_t)(pb0 * 32 + r32) * 128 + 16 * s + 8 * hh);
        const bf16x8 a1 = *(const bf16x8*)(W + (size_t)(pb0 * 32 + 32 + r32) * 128 + 16 * s + 8 * hh);
        acc0 = __builtin_amdgcn_mfma_f32_32x32x16_bf16(a0, b, acc0, 0, 0, 0);
        acc1 = __builtin_amdgcn_mfma_f32_32x32x16_bf16(a1, b, acc1, 0, 0, 0);
    }
    const int c = cb * 32 + r32;
    const float* bs = p.bs_c + ((size_t)l * 4 + g) * 128;
#pragma unroll
    for (int r = 0; r < 16; ++r) {
        const int pr = (r & 3) + 8 * (r >> 2) + 4 * hh;
        const int p0 = pb0 * 32 + pr, p1 = p0 + 32;
        const float u0 = bf2f(P[(row0 + p0) * INW + C_UC + g * 128 + c]), u1 = bf2f(P[(row0 + p1) * INW + C_UC + g * 128 + c]);
        Y[(row0 + p0) * DM + 1536 + g * 128 + c] = (bf16_t)f2bf(u0 * (acc0[r] + bs[p0]));
        Y[(row0 + p1) * DM + 1536 + g * 128 + c] = (bf16_t)f2bf(u1 * (acc1[r] + bs[p1]));
    }
}
#ifndef USE_FAST_CMLP
#define USE_FAST_CMLP 1
#endif

__device__ __forceinline__ void ph_mixers_fast(const Params& p, int l, unsigned char* lds, const bool dry) {
    const int tid = threadIdx.x;
    const bf16_t* P = (const bf16_t*)(p.ws + WS_P);
    bf16_t* Y = (bf16_t*)(p.ws + WS_Y);
    const bool last = (l == DEPTH - 1);
    const int b = blockIdx.x & 7;
    unsigned* ctr = (unsigned*)(p.ws + WS_CTL) + (dry ? 2048 : 0) + (l * 8 + b) * 64;
    volatile unsigned* shw = (volatile unsigned*)(lds + LDS_BYTES - 64);
    const int nAttn = last ? 96 : 108, nC = last ? 64 : 72, total = nAttn + nC;
    const size_t lrow0 = (size_t)b * SEQ, crow0 = (size_t)NLAT + (size_t)b * NCTX;
    unsigned nxt_ = 0u;
    if (tid == 0) nxt_ = atomicAdd(ctr, 1u);
    for (;;) {
        __syncthreads();
        if (tid == 0) *shw = nxt_;
        __syncthreads();
        const int u = (int)*shw + ((dry && DRY_MODE == 7) ? 48 : 0);
        if (u >= ((dry && DRY_MODE == 6) ? 48 : total)) break;
        if (tid == 0) nxt_ = atomicAdd(ctr, 1u);
        if (u < nAttn) {
            const bf16_t *Qb, *Kc, *Vc, *Kl, *Vl; bf16_t* Ob; int nlt = 0, qpos0 = 0, kpos0 = 0; bool mask = false, has_sink = false; int hsink = 0;
            if (u < 48) {
                const int h = u >> 3, qb = u & 7, kv = h / 3;
                Qb = P + (lrow0 + qb * 256) * INW + C_QA + h * 128; Kc = P + crow0 * INW + C_KA + kv * 128; Vc = P + crow0 * INW + C_VA + kv * 128;
                Kl = P + lrow0 * INW + C_KA + kv * 128; Vl = P + lrow0 * INW + C_VA + kv * 128; nlt = 32;
                Ob = Y + (lrow0 + qb * 256) * DM + h * 128;
            } else if (u < 96) {
                const int v = u - 48, h = v >> 3, qb = v & 7, kv = h / 3;
                const int kstart = qb == 0 ? 0 : qb * 256 - 128; nlt = (qb == 0 || qb == 7) ? 6 : 8;
                Qb = P + (lrow0 + qb * 256) * INW + C_QB + h * 128; Kc = P + crow0 * INW + C_KB + kv * 128; Vc = P + crow0 * INW + C_VB + kv * 128;
                Kl = P + (lrow0 + kstart) * INW + C_KB + kv * 128; Vl = P + (lrow0 + kstart) * INW + C_VB + kv * 128;
                qpos0 = qb * 256; kpos0 = kstart; mask = true; has_sink = true; hsink = h;
                Ob = Y + (lrow0 + qb * 256) * DM + 768 + h * 128;
            } else {
                const int v = u - 96; const bool isB = v >= 6; const int h = isB ? v - 6 : v, kv = h / 3;
                const int cq = isB ? C_QB : C_QA, ck = isB ? C_KB : C_KA, cv = isB ? C_VB : C_VA;
                Qb = P + crow0 * INW + cq + h * 128; Kc = P + crow0 * INW + ck + kv * 128; Vc = P + crow0 * INW + cv + kv * 128; Kl = Kc; Vl = Vc;
                has_sink = isB; hsink = h; Ob = Y + crow0 * DM + (isB ? 768 : 0) + h * 128;
            }
            att::attn_unit(mask, Qb, Kc, Vc, Kl, Vl, nlt, qpos0, kpos0, has_sink, has_sink ? p.sink_b[l * 6 + hsink] : 0.f, Ob, (char*)lds);
        } else {
            const int v = u - nAttn;
            const int ch = v < 64 ? b * 16 + (v >> 2) : 128 + b * 2 + ((v - 64) >> 2);
#if USE_FAST_CMLP
            cmlp_unit_fast(p, l, ch, v & 3, lds);
#else
            cmlp_unit_naive(p, l, ch, v & 3, lds);
#endif
        }
    }
#if GATHER_I8 && GATHER_4BIT
    if (TABLES_IN_GAPS && !dry) conv4_tables(p, last ? 3 * NEXP : NEXP, last ? 4 * NEXP : 2 * NEXP, (unsigned*)(p.ws + WS_CTL) + 6272 + (last ? 64 : 0), lds);
#endif
}
#ifndef USE_FAST_ATT
#define USE_FAST_ATT 1
#endif

__device__ __forceinline__ void ynorm_row(bf16_t* yrow, const u32x4 (&v)[4], int lane, unsigned char* y8row, float* sdst) {
    float sq[4];
#pragma unroll
    for (int j = 0; j < 4; ++j) {
        const float a0 = bflo(v[j].x), a1 = bfhi(v[j].x), a2 = bflo(v[j].y), a3 = bfhi(v[j].y), a4 = bflo(v[j].z), a5 = bfhi(v[j].z), a6 = bflo(v[j].w), a7 = bfhi(v[j].w);
        sq[j] = a0 * a0 + a1 * a1 + a2 * a2 + a3 * a3 + a4 * a4 + a5 * a5 + a6 * a6 + a7 * a7;
    }
    const float sA = wave_sum(sq[0] + (lane < 32 ? sq[1] : 0.f));
    const float sB = wave_sum((lane >= 32 ? sq[1] : 0.f) + sq[2]);
    const float sC = wave_sum(sq[3]);
    const float rA = rsqrtf(sA * (1.f / 768.f) + EPS), rB = rsqrtf(sB * (1.f / 768.f) + EPS), rC = rsqrtf(sC * (1.f / 512.f) + EPS);
    if (GEMM_I8) {
        float x[4][8]; float am = 0.f;
#pragma unroll
        for (int j = 0; j < 4; ++j) {
            const float sc = (j == 0) ? rA : (j == 1) ? (lane < 32 ? rA : rB) : (j == 2) ? rB : rC;
            x[j][0] = bflo(v[j].x) * sc; x[j][1] = bfhi(v[j].x) * sc; x[j][2] = bflo(v[j].y) * sc; x[j][3] = bfhi(v[j].y) * sc;
            x[j][4] = bflo(v[j].z) * sc; x[j][5] = bfhi(v[j].z) * sc; x[j][6] = bflo(v[j].w) * sc; x[j][7] = bfhi(v[j].w) * sc;
#pragma unroll
            for (int i = 0; i < 8; ++i) am = fmaxf(am, fabsf(x[j][i]));
        }
        am = wave_max(am);
        const float s = am > 0.f ? am * (1.f / 127.f) : 1.f, inv = 1.f / s;
#pragma unroll
        for (int j = 0; j < 4; ++j) {
            u32x2 o; o.x = q8pack4(x[j][0], x[j][1], x[j][2], x[j][3], inv); o.y = q8pack4(x[j][4], x[j][5], x[j][6], x[j][7], inv);
            *(u32x2*)(y8row + j * 512 + lane * 8) = o;
        }
        if (lane == 0) *sdst = s;
        return;
    }
#pragma unroll
    for (int j = 0; j < 4; ++j) {
        const float sc = (j == 0) ? rA : (j == 1) ? (lane < 32 ? rA : rB) : (j == 2) ? rB : rC;
        u32x4 o;
        o.x = pk2(bflo(v[j].x) * sc, bfhi(v[j].x) * sc); o.y = pk2(bflo(v[j].y) * sc, bfhi(v[j].y) * sc);
        o.z = pk2(bflo(v[j].z) * sc, bfhi(v[j].z) * sc); o.w = pk2(bflo(v[j].w) * sc, bfhi(v[j].w) * sc);
        *(u32x4*)(yrow + j * 512 + lane * 8) = o;
    }
}
__device__ __forceinline__ void ph_ynorm(const Params& p, int l) {
    const int tid = threadIdx.x, lane = tid & 63, wave = tid >> 6;
    const int gw = blockIdx.x * NWAVES + wave, NGW = gridDim.x * NWAVES;
    bf16_t* Y = (bf16_t*)(p.ws + WS_Y);
    const int nrows = (l == DEPTH - 1) ? NLAT : MTOT;
#pragma unroll 1
    for (int r = gw; r < nrows; r += 2 * NGW) {
        const int r2 = r + NGW; const bool has2 = r2 < nrows; const int rb = has2 ? r2 : r;
        u32x4 va[4], vb[4];
#pragma unroll
        for (int j = 0; j < 4; ++j) { va[j] = *(const u32x4*)(Y + (size_t)r * DM + j * 512 + lane * 8); vb[j] = *(const u32x4*)(Y + (size_t)rb * DM + j * 512 + lane * 8); }
        unsigned char* Y8 = (unsigned char*)(p.ws + WS_XN8); float* SY = (float*)(p.ws + WS_SCL) + SCL_Y;
        ynorm_row(Y + (size_t)r * DM, va, lane, Y8 + (size_t)r * DM, SY + r);
        if (has2) ynorm_row(Y + (size_t)r2 * DM, vb, lane, Y8 + (size_t)r2 * DM, SY + r2);
    }
}

__device__ __forceinline__ void wave_argmax(float& bv, int& bi) {
#pragma unroll
    for (int o = 32; o >= 1; o >>= 1) {
        const float ov = __shfl_xor(bv, o); const int oi = __shfl_xor(bi, o);
        if (ov > bv || (ov == bv && oi < bi)) { bv = ov; bi = oi; }
    }
}
__device__ __forceinline__ void route_half(const bf16_t* qh, const bf16_t* kh, int lane, float& tv, int& ti) {
    const unsigned qq = *(const unsigned*)(qh + 2 * lane);
    const float qa = bflo(qq), qb = bfhi(qq);
    const bf16_t* k0 = kh + (size_t)lane * 128;
    const bf16_t* k1 = k0 + 64 * 128;
    float d0 = 0.f, d1 = 0.f;
#pragma unroll 2
    for (int cb = 0; cb < 16; ++cb) {
        const u32x4 a = *(const u32x4*)(k0 + cb * 8), b = *(const u32x4*)(k1 + cb * 8);
        const unsigned aw[4] = {a.x, a.y, a.z, a.w}, bw[4] = {b.x, b.y, b.z, b.w};
#pragma unroll
        for (int i = 0; i < 4; ++i) {
            const int src = cb * 4 + i;
            const float x0 = __shfl(qa, src), x1 = __shfl(qb, src);
            d0 += x0 * bflo(aw[i]) + x1 * bfhi(aw[i]);
            d1 += x0 * bflo(bw[i]) + x1 * bfhi(bw[i]);
        }
    }
    float va = d0, vb = d1; tv = 0.f; ti = 0;
#pragma unroll 1
    for (int r = 0; r < 16; ++r) {
        float bv; int bi;
        if (va >= vb) { bv = va; bi = lane; } else { bv = vb; bi = lane + 64; }
        wave_argmax(bv, bi);
        if (lane == r) { tv = bv; ti = bi; }
        if (bi == lane) va = -INFINITY; else if (bi == lane + 64) vb = -INFINITY;
    }
}
__device__ __forceinline__ void ph_route_naive(const Params& p, int l) {
    const int tid = threadIdx.x, lane = tid & 63, wave = tid >> 6;
    const int gw = blockIdx.x * NWAVES + wave, NGW = gridDim.x * NWAVES;
    const bf16_t* QP = (const bf16_t*)(p.ws + WS_P);
    const bf16_t* KEYS = (const bf16_t*)(p.ws + WS_KEYS) + (size_t)l * 8 * 2 * 128 * 128;
    int* EID = (int*)(p.ws + WS_EID); float* GATE = (float*)(p.ws + WS_GATE);
    const int nrows = (l == DEPTH - 1) ? NLAT : MTOT;
#pragma unroll 1
    for (int tk = gw; tk < nrows * 8; tk += NGW) {
        const int t = tk >> 3, h = tk & 7;
        const bf16_t* qrow = QP + (size_t)t * DM + h * 256;
        float tv0, tv1; int ti0, ti1;
        route_half(qrow, KEYS + (size_t)(h * 2 + 0) * 128 * 128, lane, tv0, ti0);
        route_half(qrow + 128, KEYS + (size_t)(h * 2 + 1) * 128 * 128, lane, tv1, ti1);
        const float v1 = __shfl(tv0, lane >> 2);
        float c0 = v1 + __shfl(tv1, (lane & 3) * 4 + 0), c1 = v1 + __shfl(tv1, (lane & 3) * 4 + 1);
        float c2 = v1 + __shfl(tv1, (lane & 3) * 4 + 2), c3 = v1 + __shfl(tv1, (lane & 3) * 4 + 3);
        float myv = 0.f; int myc = 0;
#pragma unroll 1
        for (int r = 0; r < 16; ++r) {
            float bv = c0; int bi = lane * 4;
            if (c1 > bv) { bv = c1; bi = lane * 4 + 1; }
            if (c2 > bv) { bv = c2; bi = lane * 4 + 2; }
            if (c3 > bv) { bv = c3; bi = lane * 4 + 3; }
            wave_argmax(bv, bi);
            if (lane == r) { myv = bv; myc = bi; }
            if ((bi >> 2) == lane) {
                const int u = bi & 3;
                if (u == 0) c0 = -INFINITY; else if (u == 1) c1 = -INFINITY; else if (u == 2) c2 = -INFINITY; else c3 = -INFINITY;
            }
        }
        float mx = lane < 16 ? myv : -INFINITY;
        mx = fmaxf(mx, __shfl_xor(mx, 8)); mx = fmaxf(mx, __shfl_xor(mx, 4)); mx = fmaxf(mx, __shfl_xor(mx, 2)); mx = fmaxf(mx, __shfl_xor(mx, 1));
        const float e = lane < 16 ? __expf(myv - mx) : 0.f;
        float sm = e; sm += __shfl_xor(sm, 8); sm += __shfl_xor(sm, 4); sm += __shfl_xor(sm, 2); sm += __shfl_xor(sm, 1);
        const int i1 = __shfl(ti0, myc >> 4), i2 = __shfl(ti1, myc & 15);
        if (lane < 16) { EID[(size_t)t * 128 + h * 16 + lane] = i1 * 128 + i2; GATE[(size_t)t * 128 + h * 16 + lane] = e / sm; }
    }
}


namespace rt {
typedef short bf16x8 __attribute__((ext_vector_type(8)));
typedef float f32x16 __attribute__((ext_vector_type(16)));
__device__ __forceinline__ void insert16(float (&t)[16], float x) {
#pragma unroll
    for (int j = 15; j >= 1; --j) t[j] = __builtin_amdgcn_fmed3f(t[j - 1], t[j], x);
    t[0] = fmaxf(t[0], x);
}
__device__ __forceinline__ void half_top16(const unsigned char* klds, const bf16_t* qrow, int r32, int hh, float (&t)[16]) {
    bf16x8 qf[8];
#pragma unroll
    for (int s = 0; s < 8; ++s) qf[s] = *(const bf16x8*)(qrow + 16 * s);
#pragma unroll
    for (int k = 0; k < 16; ++k) t[k] = -3.0e38f;
    const unsigned hh4 = (unsigned)hh << 2;
#pragma unroll
    for (int kb = 0; kb < 4; ++kb) {
        f32x16 acc = {};
        const int row = kb * 32 + r32;
#pragma unroll
        for (int s = 0; s < 8; ++s) {
            const bf16x8 a = *(const bf16x8*)(klds + row * 256 + ((32 * s + 16 * hh) ^ ((row & 7) << 4)));
            acc = __builtin_amdgcn_mfma_f32_32x32x16_bf16(a, qf[s], acc, 0, 0, 0);
        }
#pragma unroll
        for (int r = 0; r < 16; ++r) {
            const unsigned key = (unsigned)(kb * 32 + (r & 3) + 8 * (r >> 2)) | hh4;
            insert16(t, __uint_as_float((__float_as_uint(acc[r]) & ~127u) | key));
        }
    }
    float o[16];
#pragma unroll
    for (int k = 0; k < 16; ++k) o[k] = __shfl_xor(t[k], 32);
#pragma unroll
    for (int k = 0; k < 16; ++k) insert16(t, o[k]);
}
}
template <bool OWN_UNITS>
__device__ __forceinline__ void ph_route_fast(const Params& p, int l, unsigned char* lds) {
    int tid_ = threadIdx.x; asm volatile("" : "+v"(tid_));
    const int tid = tid_, lane = tid & 63, wave = tid >> 6, r32 = lane & 31, hh = lane >> 5;
    const bf16_t* QP = (const bf16_t*)(p.ws + WS_P);
    const bf16_t* KEYS = (const bf16_t*)(p.ws + WS_KEYS) + (size_t)l * 8 * 2 * 128 * 128;
    int* EID = (int*)(p.ws + WS_EID); float* GATE = (float*)(p.ws + WS_GATE);
    const int ntile = ((l == DEPTH - 1) ? NLAT : MTOT) / 256;
    unsigned* tab = (unsigned*)(lds + 65536) + wave * 2048;
    pg8::StaticOrder So; So.init(ntile * 256, DM, (int)gridDim.x, (int)blockIdx.x);
#pragma unroll 1
    for (int ui = 0;; ++ui) {
        int tile, h;
        if (OWN_UNITS) { pg8::Unit uu; if (!So.next(ui, uu)) break; tile = uu.pm; h = uu.pn; }
        else { const int u = blockIdx.x + ui * (int)gridDim.x; if (u >= ntile * 8) break; tile = u >> 3; h = u & 7; }
        __syncthreads();
        const u32x4* ksrc = (const u32x4*)(KEYS + (size_t)h * 2 * 128 * 128);
#pragma unroll
        for (int i = 0; i < 8; ++i) { const int c = tid + i * 512, row = c >> 4, cc = c & 15; *(u32x4*)(lds + row * 256 + ((cc * 16) ^ ((row & 7) << 4))) = ksrc[c]; }
        __syncthreads();
        const int tok = tile * 256 + wave * 32 + r32;
        const bf16_t* qrow = QP + (size_t)tok * DM + h * 256 + hh * 8;
        float v1[16], v2[16];
        rt::half_top16(lds, qrow, r32, hh, v1);
        rt::half_top16(lds + 32768, qrow + 128, r32, hh, v2);
        float c[16];
#pragma unroll
        for (int k = 0; k < 16; ++k) c[k] = -3.0e38f;
#pragma unroll
        for (int i = 0; i < 16; ++i)
#pragma unroll
            for (int j = 0; j < 16; ++j)
                if ((i + 1) * (j + 1) <= 16) rt::insert16(c, __uint_as_float((__float_as_uint(v1[i] + v2[j]) & ~255u) | (unsigned)(i * 16 + j)));
#pragma unroll
        for (int k = 0; k < 16; ++k) { tab[k * 64 + lane] = __float_as_uint(v1[k]); tab[(16 + k) * 64 + lane] = __float_as_uint(v2[k]); }
        LDS_WAIT();
        float e[16], sum = 0.f;
#pragma unroll
        for (int k = 0; k < 16; ++k) { e[k] = __expf(c[k] - c[0]); sum += e[k]; }
        const float inv = 1.f / sum;
        unsigned out[16];
#pragma unroll
        for (int k = 0; k < 16; ++k) {
            const unsigned code = __float_as_uint(c[k]) & 255u;
            const unsigned i1 = tab[(code >> 4) * 64 + lane] & 127u, i2 = tab[(16 + (code & 15u)) * 64 + lane] & 127u;
            out[k] = hh == 0 ? (i1 * 128u + i2) : __float_as_uint(e[k] * inv);
        }
        unsigned* dst = (hh == 0 ? (unsigned*)EID : (unsigned*)GATE) + (size_t)tok * 128 + h * 16;
#pragma unroll
        for (int k = 0; k < 4; ++k) { u32x4 w; w.x = out[4 * k]; w.y = out[4 * k + 1]; w.z = out[4 * k + 2]; w.w = out[4 * k + 3]; *(u32x4*)(dst + 4 * k) = w; }
        LDS_WAIT();
    }
}
#ifndef USE_FAST_ROUTE
#define USE_FAST_ROUTE 1
#endif


#if GATHER_I8
__device__ __forceinline__ float dpp_shr(float v, int n) {
    const int iv = __builtin_bit_cast(int, v); int r;
    switch (n) { case 1: r = __builtin_amdgcn_update_dpp(0, iv, 0x111, 0xf, 0xf, true); break; case 2: r = __builtin_amdgcn_update_dpp(0, iv, 0x112, 0xf, 0xf, true); break;
                 case 4: r = __builtin_amdgcn_update_dpp(0, iv, 0x114, 0xf, 0xf, true); break; default: r = __builtin_amdgcn_update_dpp(0, iv, 0x118, 0xf, 0xf, true); break; }
    return __builtin_bit_cast(float, r);
}
__device__ __forceinline__ float wave_total(float v) {
    v += dpp_shr(v, 1); v += dpp_shr(v, 2); v += dpp_shr(v, 4); v += dpp_shr(v, 8);
    v += __builtin_bit_cast(float, __builtin_amdgcn_update_dpp(0, __builtin_bit_cast(int, v), 0x142, 0xa, 0xf, false));
    v += __builtin_bit_cast(float, __builtin_amdgcn_update_dpp(0, __builtin_bit_cast(int, v), 0x143, 0xc, 0xf, false));
    return __uint_as_float(__builtin_amdgcn_readlane(__float_as_uint(v), 63));
}
#define UB0(w) ((float)((w) & 0xffu))
#define UB1(w) ((float)(((w) >> 8) & 0xffu))
#define UB2(w) ((float)(((w) >> 16) & 0xffu))
#define UB3(w) ((float)((w) >> 24))

__device__ __forceinline__ float dpp_xor1(float v) { return __builtin_bit_cast(float, __builtin_amdgcn_update_dpp(0, __builtin_bit_cast(int, v), 0xB1, 0xf, 0xf, false)); }
__device__ __forceinline__ float dpp_xor2(float v) { return __builtin_bit_cast(float, __builtin_amdgcn_update_dpp(0, __builtin_bit_cast(int, v), 0x4E, 0xf, 0xf, false)); }
__device__ __forceinline__ float dpp_xor8(float v) { return __builtin_bit_cast(float, __builtin_amdgcn_update_dpp(0, __builtin_bit_cast(int, v), 0x128, 0xf, 0xf, false)); }
__device__ __forceinline__ float reduce8_rows(const float (&d)[8], int lane) {
    const bool b0 = lane & 1, b1 = lane & 2, b2 = lane & 4;
    float r[4];
#pragma unroll
    for (int k = 0; k < 4; ++k) r[k] = (b0 ? d[2 * k + 1] : d[2 * k]) + dpp_xor1(b0 ? d[2 * k] : d[2 * k + 1]);
    float t[2];
#pragma unroll
    for (int k = 0; k < 2; ++k) t[k] = (b1 ? r[2 * k + 1] : r[2 * k]) + dpp_xor2(b1 ? r[2 * k] : r[2 * k + 1]);
    float u = (b2 ? t[1] : t[0]) + __shfl_xor(b2 ? t[0] : t[1], 4);
    u += dpp_xor8(u);
    u += __shfl_xor(u, 16);
    u += __shfl_xor(u, 32);
    return u;
}
#if GATHER_4BIT
#ifndef DRY_MODE
#define DRY_MODE 0
#endif
typedef float f32x2 __attribute__((ext_vector_type(2)));
__device__ __forceinline__ void ph_gather(const Params& p, int l, const bool dry) {
    const int tid = threadIdx.x, lane = tid & 63, wave = tid >> 6;
    const int gw = blockIdx.x * NWAVES + wave, NGW = gridDim.x * NWAVES;
    const bf16_t* XN = (const bf16_t*)(p.ws + WS_XN);
    const unsigned char* UT = (const unsigned char*)(p.ws + WS_UT) + (size_t)l * NEXP * ROWU;
    const unsigned char* VT = (const unsigned char*)(p.ws + WS_VT) + (size_t)l * NEXP * ROWV;
    const int* EID = (const int*)(p.ws + WS_EID); const float* GATE = (const float*)(p.ws + WS_GATE);
    const float* mod = (const float*)(p.ws + WS_MOD) + (size_t)l * 9 * 12288;
    const int nrows = (l == DEPTH - 1) ? NLAT : MTOT;
#pragma unroll 1
    for (int t = gw; t < nrows; t += NGW) {
        int xh[4], xl[4]; float sxl;
#if GEMM_I8 && GEMM3_I8
        {
            sxl = ((const float*)(p.ws + WS_SCL))[SCL_XN + t];
            const unsigned char* x8 = (const unsigned char*)(p.ws + WS_XN8) + (size_t)t * DM;
#pragma unroll
            for (int j = 0; j < 2; ++j) {
                const u32x4 q4 = *(const u32x4*)(x8 + j * 1024 + lane * 16);
                const unsigned ww[4] = {q4.x, q4.y, q4.z, q4.w};
#pragma unroll
                for (int dd = 0; dd < 2; ++dd) {
                    unsigned h = 0u, lo = 0u;
#pragma unroll
                    for (int k = 0; k < 8; ++k) {
                        const int q = (int)(signed char)((ww[dd * 2 + (k >> 2)] >> (8 * (k & 3))) & 0xffu);
                        const int ql = ((q + 8) & 15) - 8, qh = (q - ql) >> 4;
                        h |= ((unsigned)qh & 15u) << (4 * k); lo |= ((unsigned)ql & 15u) << (4 * k);
                    }
                    xh[j * 2 + dd] = (int)h; xl[j * 2 + dd] = (int)lo;
                }
            }
        }
#else
        {
            float x[32]; float am = 0.f;
#pragma unroll
            for (int j = 0; j < 2; ++j)
#pragma unroll
                for (int k = 0; k < 2; ++k) {
                    const u32x4 q = *(const u32x4*)(XN + (size_t)t * DM + j * 1024 + lane * 16 + k * 8);
                    float* xx = x + j * 16 + k * 8;
                    xx[0] = bflo(q.x); xx[1] = bfhi(q.x); xx[2] = bflo(q.y); xx[3] = bfhi(q.y); xx[4] = bflo(q.z); xx[5] = bfhi(q.z); xx[6] = bflo(q.w); xx[7] = bfhi(q.w);
                }
#pragma unroll
            for (int i = 0; i < 32; ++i) am = fmaxf(am, fabsf(x[i]));
            sxl = am > 0.f ? am * (1.f / 119.f) : 1.f;
            const float inv = 1.f / sxl;
#pragma unroll
            for (int d = 0; d < 4; ++d) {
                unsigned h = 0u, lo = 0u;
#pragma unroll
                for (int k = 0; k < 8; ++k) {
                    const int q = (int)rintf(x[8 * d + k] * inv);
                    const int ql = ((q + 8) & 15) - 8, qh = (q - ql) >> 4;
                    h |= ((unsigned)qh & 15u) << (4 * k); lo |= ((unsigned)ql & 15u) << (4 * k);
                }
                xh[d] = (int)h; xl[d] = (int)lo;
            }
        }
#endif
        const int e0 = EID[(size_t)t * 128 + lane], e1 = EID[(size_t)t * 128 + 64 + lane];
        const float g0 = GATE[(size_t)t * 128 + lane], g1 = GATE[(size_t)t * 128 + 64 + lane];
        float hid0 = 0.f, hid1 = 0.f;
        constexpr int GB = 8;
#define G_LOAD(W, S, TAB, EB, ISV) do { _Pragma("unroll") for (int i = 0; i < GB; ++i) { \
            const int id_ = __builtin_amdgcn_readlane((EB) < 64 ? e0 : e1, ((EB) + i) & 63); \
            const unsigned char* row_ = (TAB) + (size_t)id_ * ((ISV) ? ROWV : ROWU); \
            W[i] = *(const u32x4*)(row_ + lane * 16); if (!((ISV) ? V_ROWSCALE : U_ROWSCALE)) S[i] = *(const unsigned short*)(row_ + 1024 + lane * 2); } } while (0)
#define G_DOT(W, S, EB) do { float dd_[8]; _Pragma("unroll") for (int i = 0; i < GB; ++i) { int sh_ = 0, sl_ = 0; \
            const unsigned ww[4] = {W[i].x, W[i].y, W[i].z, W[i].w}; \
            _Pragma("unroll") for (int d = 0; d < 4; ++d) { \
                sh_ = __builtin_amdgcn_sdot8((int)ww[d], xh[d], sh_, false); \
                sl_ = __builtin_amdgcn_sdot8((int)ww[d], xl[d], sl_, false); } \
            dd_[i] = (float)((sh_ << 4) + sl_) * (U_ROWSCALE ? sxl : sxl * bf2f(S[i])); } \
            const float tot = reduce8_rows(dd_, lane);              \
            if ((lane & 56) == ((EB) & 63)) { if ((EB) < 64) hid0 = tot; else hid1 = tot; } } while (0)
#define G_AXPY(W, S, EB) do { _Pragma("unroll") for (int i = 0; i < GB; ++i) { \
            const float m_ = __uint_as_float(__builtin_amdgcn_readlane(__float_as_uint((EB) < 64 ? cf0 : cf1), ((EB) + i) & 63)) * (V_ROWSCALE ? 1.f : bf2f(S[i])); \
            const f32x2 mm = {m_, m_}; \
            const unsigned ww[4] = {W[i].x, W[i].y, W[i].z, W[i].w}; \
            _Pragma("unroll") for (int d = 0; d < 4; ++d) { \
                acc[4 * d + 0] += mm * __builtin_amdgcn_cvt_scalef32_pk_f32_fp4(ww[d], 1.0f, 0); \
                acc[4 * d + 1] += mm * __builtin_amdgcn_cvt_scalef32_pk_f32_fp4(ww[d], 1.0f, 1); \
                acc[4 * d + 2] += mm * __builtin_amdgcn_cvt_scalef32_pk_f32_fp4(ww[d], 1.0f, 2); \
                acc[4 * d + 3] += mm * __builtin_amdgcn_cvt_scalef32_pk_f32_fp4(ww[d], 1.0f, 3); } } } while (0)
        u32x4 wa[GB], wb[GB]; unsigned sa[GB], sb[GB];
        const bool do_u = !(dry && (DRY_MODE == 4 || DRY_MODE == 5)), do_v = !(dry && (DRY_MODE == 3 || DRY_MODE == 5));
#if V_ROWSCALE
        const float vs0 = ((const float*)(p.ws + WS_VSC))[(size_t)l * NEXP + e0], vs1 = ((const float*)(p.ws + WS_VSC))[(size_t)l * NEXP + e1];
#else
        const float vs0 = 1.f, vs1 = 1.f;
#endif
        if (do_u) G_LOAD(wa, sa, UT, 0, false); else G_LOAD(wa, sa, VT, 0, true);
#pragma unroll 1
        for (int eb = 0; eb < (do_u ? 128 : 0); eb += 2 * GB) {
            G_LOAD(wb, sb, UT, eb + GB, false);
            G_DOT(wa, sa, eb);
            if (eb + 2 * GB < 128) G_LOAD(wa, sa, UT, eb + 2 * GB, false); else G_LOAD(wa, sa, VT, 0, true);
            G_DOT(wb, sb, eb + GB);
        }
#if U_ROWSCALE
        hid0 *= ((const float*)(p.ws + WS_USC))[(size_t)l * NEXP + e0]; hid1 *= ((const float*)(p.ws + WS_USC))[(size_t)l * NEXP + e1];
#endif
        const float cf0 = gelu_tanh(hid0) * g0 * vs0, cf1 = gelu_tanh(hid1) * g1 * vs1;
        f32x2 acc[16];
#pragma unroll
        for (int i = 0; i < 16; ++i) acc[i] = (f32x2){0.f, 0.f};
#pragma unroll 1
        for (int eb = 0; eb < (do_v ? 128 : 0); eb += 2 * GB) {
            G_LOAD(wb, sb, VT, eb + GB, true);
            G_AXPY(wa, sa, eb);
            if (eb + 2 * GB < 128) G_LOAD(wa, sa, VT, eb + 2 * GB, true);
            G_AXPY(wb, sb, eb + GB);
        }
#undef G_LOAD
#undef G_DOT
#undef G_AXPY
        float hn[32];
        const int bb = t < NLAT ? (t >> 11) : 8;
        const float* gate = mod + (size_t)bb * 12288 + 5 * DM;
#if H_BF16 && GEMM_I8 && GEMM3_I8
        {
            bf16_t* hbrow = (bf16_t*)(p.ws + WS_HB) + (size_t)t * DM;
            const bool fin = (l == DEPTH - 1);
#pragma unroll
            for (int j = 0; j < 2; ++j) {
                const u32x4 q0 = *(const u32x4*)(hbrow + j * 1024 + lane * 16), q1 = *(const u32x4*)(hbrow + j * 1024 + lane * 16 + 8);
                const unsigned qq[8] = {q0.x, q0.y, q0.z, q0.w, q1.x, q1.y, q1.z, q1.w};
#pragma unroll
                for (int k = 0; k < 4; ++k) {
                    const f32x4 gv = *(const f32x4*)(gate + j * 1024 + lane * 16 + k * 4);
                    const f32x2 a0 = acc[j * 8 + k * 2], a1 = acc[j * 8 + k * 2 + 1];
                    hn[j * 16 + k * 4 + 0] = bflo(qq[2 * k]) + gv.x * a0.x; hn[j * 16 + k * 4 + 1] = bfhi(qq[2 * k]) + gv.y * a0.y;
                    hn[j * 16 + k * 4 + 2] = bflo(qq[2 * k + 1]) + gv.z * a1.x; hn[j * 16 + k * 4 + 3] = bfhi(qq[2 * k + 1]) + gv.w * a1.y;
                }
                if (fin) {
                    float* orow = (dry ? (float*)(p.ws + WS_DUMMY) + (size_t)(t & 16383) * DM : p.out + (size_t)t * DM) + j * 1024 + lane * 16;
#pragma unroll
                    for (int k = 0; k < 4; ++k) *(f32x4*)(orow + k * 4) = (f32x4){hn[j * 16 + k * 4], hn[j * 16 + k * 4 + 1], hn[j * 16 + k * 4 + 2], hn[j * 16 + k * 4 + 3]};
                } else {
                    bf16_t* orow = (dry ? (bf16_t*)(p.ws + WS_DUMMY) + (size_t)(t & 16383) * DM : hbrow) + j * 1024 + lane * 16;
                    u32x4 w0, w1;
                    w0.x = pk2(hn[j * 16 + 0], hn[j * 16 + 1]); w0.y = pk2(hn[j * 16 + 2], hn[j * 16 + 3]); w0.z = pk2(hn[j * 16 + 4], hn[j * 16 + 5]); w0.w = pk2(hn[j * 16 + 6], hn[j * 16 + 7]);
                    w1.x = pk2(hn[j * 16 + 8], hn[j * 16 + 9]); w1.y = pk2(hn[j * 16 + 10], hn[j * 16 + 11]); w1.z = pk2(hn[j * 16 + 12], hn[j * 16 + 13]); w1.w = pk2(hn[j * 16 + 14], hn[j * 16 + 15]);
                    *(u32x4*)orow = w0; *(u32x4*)(orow + 8) = w1;
                }
            }
        }
#else
        float* hrow = t < NLAT ? p.out + (size_t)t * DM : (float*)(p.ws + WS_HC) + (size_t)(t - NLAT) * DM;
#pragma unroll
        for (int j = 0; j < 2; ++j)
#pragma unroll
            for (int k = 0; k < 4; ++k) {
                const int col = j * 1024 + lane * 16 + k * 4;
                const f32x4 hv = *(const f32x4*)(hrow + col), gv = *(const f32x4*)(gate + col);
                const f32x2 a0 = acc[j * 8 + k * 2], a1 = acc[j * 8 + k * 2 + 1];
                f32x4 o;
                o.x = hv.x + gv.x * a0.x; o.y = hv.y + gv.y * a0.y; o.z = hv.z + gv.z * a1.x; o.w = hv.w + gv.w * a1.y;
                *(f32x4*)((dry ? (float*)(p.ws + WS_DUMMY) + (size_t)(t & 16383) * DM : hrow) + col) = o;
                hn[j * 16 + k * 4 + 0] = o.x; hn[j * 16 + k * 4 + 1] = o.y; hn[j * 16 + k * 4 + 2] = o.z; hn[j * 16 + k * 4 + 3] = o.w;
            }
#endif
        if (l + 1 < DEPTH) {
            float ss = 0.f;
#pragma unroll
            for (int i = 0; i < 32; ++i) ss += hn[i] * hn[i];
            const float rstd = rsqrtf(wave_total(ss) * (1.f / DM) + EPS);
            const float* g1n = p.norm1_g + (l + 1) * DM;
            const float* shift = mod + (size_t)9 * 12288 + (size_t)bb * 12288;
            const float* scale = shift + DM;
            if (GEMM_I8) {
                float am = 0.f;
#pragma unroll
                for (int j = 0; j < 2; ++j)
#pragma unroll
                    for (int i = 0; i < 16; ++i) { const int col = j * 1024 + lane * 16 + i; hn[j * 16 + i] = hn[j * 16 + i] * rstd * g1n[col] * (1.f + scale[col]) + shift[col]; am = fmaxf(am, fabsf(hn[j * 16 + i])); }
                am = wave_max(am);
                const float s8 = am > 0.f ? am * (1.f / 127.f) : 1.f, inv8 = 1.f / s8;
                unsigned char* xo8 = (dry ? (unsigned char*)(p.ws + WS_DUMMY) + (size_t)(t & 16383) * DM : (unsigned char*)(p.ws + WS_XN8) + (size_t)t * DM);
#pragma unroll
                for (int j = 0; j < 2; ++j) {
                    u32x4 w;
                    w.x = q8pack4(hn[j * 16 + 0], hn[j * 16 + 1], hn[j * 16 + 2], hn[j * 16 + 3], inv8); w.y = q8pack4(hn[j * 16 + 4], hn[j * 16 + 5], hn[j * 16 + 6], hn[j * 16 + 7], inv8);
                    w.z = q8pack4(hn[j * 16 + 8], hn[j * 16 + 9], hn[j * 16 + 10], hn[j * 16 + 11], inv8); w.w = q8pack4(hn[j * 16 + 12], hn[j * 16 + 13], hn[j * 16 + 14], hn[j * 16 + 15], inv8);
                    *(u32x4*)(xo8 + j * 1024 + lane * 16) = w;
                }
                if (lane == 0 && !dry) ((float*)(p.ws + WS_SCL))[SCL_XN + t] = s8;
            } else {
            bf16_t* xo = (dry ? (bf16_t*)(p.ws + WS_DUMMY) + (size_t)(t & 16383) * DM : (bf16_t*)(p.ws + WS_XN) + (size_t)t * DM);
#pragma unroll
            for (int j = 0; j < 2; ++j)
#pragma unroll
                for (int k = 0; k < 2; ++k) {
                    const int col = j * 1024 + lane * 16 + k * 8;
                    float xv[8];
#pragma unroll
                    for (int i = 0; i < 8; ++i) xv[i] = hn[j * 16 + k * 8 + i] * rstd * g1n[col + i] * (1.f + scale[col + i]) + shift[col + i];
                    u32x4 w; w.x = pk2(xv[0], xv[1]); w.y = pk2(xv[2], xv[3]); w.z = pk2(xv[4], xv[5]); w.w = pk2(xv[6], xv[7]);
                    *(u32x4*)(xo + col) = w;
                }
            }
        }
    }
}
#else
#ifndef DRY_MODE
#define DRY_MODE 0
#endif
typedef float f32x2 __attribute__((ext_vector_type(2)));
__device__ __forceinline__ void ph_gather(const Params& p, int l, const bool dry) {
    const int tid = threadIdx.x, lane = tid & 63, wave = tid >> 6;
    const int gw = blockIdx.x * NWAVES + wave, NGW = gridDim.x * NWAVES;
    const bf16_t* XN = (const bf16_t*)(p.ws + WS_XN);
    const unsigned char* UT = (const unsigned char*)(p.ws + WS_UT) + (size_t)l * NEXP * DM;
    const unsigned char* VT = (const unsigned char*)(p.ws + WS_VT) + (size_t)l * NEXP * DM;
    const float* USC = (const float*)(p.ws + WS_USC) + l * NEXP; const float* VSC = (const float*)(p.ws + WS_VSC) + l * NEXP;
    const int* EID = (const int*)(p.ws + WS_EID); const float* GATE = (const float*)(p.ws + WS_GATE);
    const float* mod = (const float*)(p.ws + WS_MOD) + (size_t)l * 9 * 12288;
    const int nrows = (l == DEPTH - 1) ? NLAT : MTOT;
#pragma unroll 1
    for (int t = gw; t < nrows; t += NGW) {
        int xq[8]; float sxl;
        {
            float x[32]; float am = 0.f;
#pragma unroll
            for (int j = 0; j < 2; ++j)
#pragma unroll
                for (int k = 0; k < 2; ++k) {
                    const u32x4 q = *(const u32x4*)(XN + (size_t)t * DM + j * 1024 + lane * 16 + k * 8);
                    float* xx = x + j * 16 + k * 8;
                    xx[0] = bflo(q.x); xx[1] = bfhi(q.x); xx[2] = bflo(q.y); xx[3] = bfhi(q.y); xx[4] = bflo(q.z); xx[5] = bfhi(q.z); xx[6] = bflo(q.w); xx[7] = bfhi(q.w);
                }
#pragma unroll
            for (int i = 0; i < 32; ++i) am = fmaxf(am, fabsf(x[i]));
            sxl = am > 0.f ? am * (1.f / 127.f) : 1.f;
            const float inv = 1.f / sxl;
#pragma unroll
            for (int d = 0; d < 8; ++d) {
                const int q0 = (int)rintf(x[4 * d] * inv), q1 = (int)rintf(x[4 * d + 1] * inv), q2 = (int)rintf(x[4 * d + 2] * inv), q3 = (int)rintf(x[4 * d + 3] * inv);
                xq[d] = (int)(((unsigned)q0 & 0xffu) | (((unsigned)q1 & 0xffu) << 8) | (((unsigned)q2 & 0xffu) << 16) | ((unsigned)q3 << 24));
            }
        }
        const int e0 = EID[(size_t)t * 128 + lane], e1 = EID[(size_t)t * 128 + 64 + lane];
        const float g0 = GATE[(size_t)t * 128 + lane], g1 = GATE[(size_t)t * 128 + 64 + lane];
        const float us0 = USC[e0], us1 = USC[e1], vs0 = VSC[e0], vs1 = VSC[e1];
        float hid0 = 0.f, hid1 = 0.f;
        constexpr int GBU = 8, GBV = 4;
#define G_LOAD(W, TAB, EB, NB) do { _Pragma("unroll") for (int i = 0; i < NB; ++i) { \
            const int id_ = __builtin_amdgcn_readlane((EB) < 64 ? e0 : e1, ((EB) + i) & 63); \
            const unsigned char* row_ = (TAB) + (size_t)id_ * DM + lane * 16; \
            W[i][0] = *(const u32x4*)row_; W[i][1] = *(const u32x4*)(row_ + 1024); } } while (0)
#define G_DOT(W, EB) do { _Pragma("unroll") for (int i = 0; i < GBU; ++i) { int s_ = 0; \
            s_ = __builtin_amdgcn_sdot4((int)W[i][0].x, xq[0], s_, false); s_ = __builtin_amdgcn_sdot4((int)W[i][0].y, xq[1], s_, false); \
            s_ = __builtin_amdgcn_sdot4((int)W[i][0].z, xq[2], s_, false); s_ = __builtin_amdgcn_sdot4((int)W[i][0].w, xq[3], s_, false); \
            s_ = __builtin_amdgcn_sdot4((int)W[i][1].x, xq[4], s_, false); s_ = __builtin_amdgcn_sdot4((int)W[i][1].y, xq[5], s_, false); \
            s_ = __builtin_amdgcn_sdot4((int)W[i][1].z, xq[6], s_, false); s_ = __builtin_amdgcn_sdot4((int)W[i][1].w, xq[7], s_, false); \
            const float tot = wave_total((float)s_ * sxl); \
            if ((((EB) + i) & 63) == lane) { if ((EB) < 64) hid0 = tot; else hid1 = tot; } } } while (0)
#define G_AXPY(W, EB) do { _Pragma("unroll") for (int i = 0; i < GBV; ++i) { \
            const float cf_ = __uint_as_float(__builtin_amdgcn_readlane(__float_as_uint((EB) < 64 ? cf0 : cf1), ((EB) + i) & 63)); \
            const f32x2 mm = {cf_, cf_}; \
            _Pragma("unroll") for (int j = 0; j < 2; ++j) { const unsigned ww[4] = {W[i][j].x, W[i][j].y, W[i][j].z, W[i][j].w}; \
                _Pragma("unroll") for (int k = 0; k < 4; ++k) { \
                    acc[j * 8 + k * 2] += mm * __builtin_amdgcn_cvt_pk_f32_fp8((int)ww[k], false); \
                    acc[j * 8 + k * 2 + 1] += mm * __builtin_amdgcn_cvt_pk_f32_fp8((int)ww[k], true); } } } } while (0)
        u32x4 wa[GBU][2], wb[GBU][2];
        const bool do_u = !(dry && (DRY_MODE == 4 || DRY_MODE == 5)), do_v = !(dry && (DRY_MODE == 3 || DRY_MODE == 5));
        if (do_u) G_LOAD(wa, UT, 0, GBU); else G_LOAD(wa, VT, 0, GBV);
#pragma unroll 1
        for (int eb = 0; eb < (do_u ? 128 : 0); eb += 2 * GBU) {
            G_LOAD(wb, UT, eb + GBU, GBU);
            G_DOT(wa, eb);
            if (eb + 2 * GBU < 128) G_LOAD(wa, UT, eb + 2 * GBU, GBU); else G_LOAD(wa, VT, 0, GBV);
            G_DOT(wb, eb + GBU);
        }
        const float cf0 = gelu_tanh(hid0 * us0) * g0 * vs0, cf1 = gelu_tanh(hid1 * us1) * g1 * vs1;
        f32x2 acc[16];
#pragma unroll
        for (int i = 0; i < 16; ++i) acc[i] = (f32x2){0.f, 0.f};
#pragma unroll 1
        for (int eb = 0; eb < (do_v ? 128 : 0); eb += 2 * GBV) {
            G_LOAD(wb, VT, eb + GBV, GBV);
            G_AXPY(wa, eb);
            if (eb + 2 * GBV < 128) G_LOAD(wa, VT, eb + 2 * GBV, GBV);
            G_AXPY(wb, eb + GBV);
        }
#undef G_LOAD
#undef G_DOT
#undef G_AXPY
        float hn[32];
        float* hrow = t < NLAT ? p.out + (size_t)t * DM : (float*)(p.ws + WS_HC) + (size_t)(t - NLAT) * DM;
        const int bb = t < NLAT ? (t >> 11) : 8;
        const float* gate = mod + (size_t)bb * 12288 + 5 * DM;
#pragma unroll
        for (int j = 0; j < 2; ++j)
#pragma unroll
            for (int k = 0; k < 4; ++k) {
                const int col = j * 1024 + lane * 16 + k * 4;
                const f32x4 hv = *(const f32x4*)(hrow + col), gv = *(const f32x4*)(gate + col);
                const f32x2 a0 = acc[j * 8 + k * 2], a1 = acc[j * 8 + k * 2 + 1];
                f32x4 o;
                o.x = hv.x + gv.x * a0.x; o.y = hv.y + gv.y * a0.y; o.z = hv.z + gv.z * a1.x; o.w = hv.w + gv.w * a1.y;
                *(f32x4*)((dry ? (float*)(p.ws + WS_DUMMY) + (size_t)(t & 16383) * DM : hrow) + col) = o;
                hn[j * 16 + k * 4 + 0] = o.x; hn[j * 16 + k * 4 + 1] = o.y; hn[j * 16 + k * 4 + 2] = o.z; hn[j * 16 + k * 4 + 3] = o.w;
            }
        if (l + 1 < DEPTH) {
            float ss = 0.f;
#pragma unroll
            for (int i = 0; i < 32; ++i) ss += hn[i] * hn[i];
            const float rstd = rsqrtf(wave_total(ss) * (1.f / DM) + EPS);
            const float* g1n = p.norm1_g + (l + 1) * DM;
            const float* shift = mod + (size_t)9 * 12288 + (size_t)bb * 12288;
            const float* scale = shift + DM;
            bf16_t* xo = (dry ? (bf16_t*)(p.ws + WS_DUMMY) + (size_t)(t & 16383) * DM : (bf16_t*)(p.ws + WS_XN) + (size_t)t * DM);
#pragma unroll
            for (int j = 0; j < 2; ++j)
#pragma unroll
                for (int k = 0; k < 2; ++k) {
                    const int col = j * 1024 + lane * 16 + k * 8;
                    float xv[8];
#pragma unroll
                    for (int i = 0; i < 8; ++i) xv[i] = hn[j * 16 + k * 8 + i] * rstd * g1n[col + i] * (1.f + scale[col + i]) + shift[col + i];
                    u32x4 w; w.x = pk2(xv[0], xv[1]); w.y = pk2(xv[2], xv[3]); w.z = pk2(xv[4], xv[5]); w.w = pk2(xv[6], xv[7]);
                    *(u32x4*)(xo + col) = w;
                }
        }
    }
}
#endif
#else
__device__ __forceinline__ float dot8(const u32x4 u, const u32x4 x) {
    float d = bflo(u.x) * bflo(x.x) + bfhi(u.x) * bfhi(x.x);
    d += bflo(u.y) * bflo(x.y) + bfhi(u.y) * bfhi(x.y);
    d += bflo(u.z) * bflo(x.z) + bfhi(u.z) * bfhi(x.z);
    d += bflo(u.w) * bflo(x.w) + bfhi(u.w) * bfhi(x.w);
    return d;
}
__device__ __forceinline__ void ph_gather(const Params& p, int l, const bool dry) {
    const int tid = threadIdx.x, lane = tid & 63, wave = tid >> 6;
    const int gw = blockIdx.x * NWAVES + wave, NGW = gridDim.x * NWAVES;
    const bf16_t* XN = (const bf16_t*)(p.ws + WS_XN);
    const bf16_t* UT = (const bf16_t*)(p.ws + WS_UT) + (size_t)l * NEXP * DM;
    const bf16_t* VT = (const bf16_t*)(p.ws + WS_VT) + (size_t)l * NEXP * DM;
    const int* EID = (const int*)(p.ws + WS_EID); const float* GATE = (const float*)(p.ws + WS_GATE);
    const float* mod = (const float*)(p.ws + WS_MOD) + (size_t)l * 9 * 12288;
    const int nrows = (l == DEPTH - 1) ? NLAT : MTOT;
    for (int t = gw; t < nrows; t += NGW) {
        u32x4 xq[4];
#pragma unroll
        for (int j = 0; j < 4; ++j) xq[j] = *(const u32x4*)(XN + (size_t)t * DM + j * 512 + lane * 8);
        const int e0 = EID[(size_t)t * 128 + lane], e1 = EID[(size_t)t * 128 + 64 + lane];
        const float g0 = GATE[(size_t)t * 128 + lane], g1 = GATE[(size_t)t * 128 + 64 + lane];
        float hid0 = 0.f, hid1 = 0.f;
#pragma unroll 1
        for (int eb = 0; eb < 128; eb += 4) {
            u32x4 uu[4][4];
#pragma unroll
            for (int i = 0; i < 4; ++i) {
                const int e = eb + i;
                const int id = __builtin_amdgcn_readlane(eb < 64 ? e0 : e1, e & 63);
                const u32x4* ur = (const u32x4*)(UT + (size_t)id * DM) + lane;
#pragma unroll
                for (int j = 0; j < 4; ++j) uu[i][j] = ur[j * 64];
            }
#pragma unroll
            for (int i = 0; i < 4; ++i) {
                const int e = eb + i;
                float d = dot8(uu[i][0], xq[0]) + dot8(uu[i][1], xq[1]) + dot8(uu[i][2], xq[2]) + dot8(uu[i][3], xq[3]);
                d = wave_sum(d);
                if ((e & 63) == lane) { if (eb < 64) hid0 = d; else hid1 = d; }
            }
        }
        const float cf0 = gelu_tanh(hid0) * g0, cf1 = gelu_tanh(hid1) * g1;
        float acc[32];
#pragma unroll
        for (int i = 0; i < 32; ++i) acc[i] = 0.f;
#pragma unroll 1
        for (int eb = 0; eb < 128; eb += 4) {
            u32x4 vv[4][4]; float cf[4];
#pragma unroll
            for (int i = 0; i < 4; ++i) {
                const int e = eb + i;
                const int id = __builtin_amdgcn_readlane(eb < 64 ? e0 : e1, e & 63);
                cf[i] = __uint_as_float(__builtin_amdgcn_readlane(__float_as_uint(eb < 64 ? cf0 : cf1), e & 63));
                const u32x4* vr = (const u32x4*)(VT + (size_t)id * DM) + lane;
#pragma unroll
                for (int j = 0; j < 4; ++j) vv[i][j] = vr[j * 64];
            }
#pragma unroll
            for (int i = 0; i < 4; ++i)
#pragma unroll
                for (int j = 0; j < 4; ++j) {
                    acc[j * 8 + 0] += cf[i] * bflo(vv[i][j].x); acc[j * 8 + 1] += cf[i] * bfhi(vv[i][j].x);
                    acc[j * 8 + 2] += cf[i] * bflo(vv[i][j].y); acc[j * 8 + 3] += cf[i] * bfhi(vv[i][j].y);
                    acc[j * 8 + 4] += cf[i] * bflo(vv[i][j].z); acc[j * 8 + 5] += cf[i] * bfhi(vv[i][j].z);
                    acc[j * 8 + 6] += cf[i] * bflo(vv[i][j].w); acc[j * 8 + 7] += cf[i] * bfhi(vv[i][j].w);
                }
        }
        float* hrow = t < NLAT ? p.out + (size_t)t * DM : (float*)(p.ws + WS_HC) + (size_t)(t - NLAT) * DM;
        const int bb = t < NLAT ? (t >> 11) : 8;
        const float* gate = mod + (size_t)bb * 12288 + 5 * DM;
#pragma unroll
        for (int j = 0; j < 4; ++j) {
            const int col = j * 512 + lane * 8;
#pragma unroll
            for (int hh = 0; hh < 2; ++hh) {
                const f32x4 hv = *(const f32x4*)(hrow + col + hh * 4), gv = *(const f32x4*)(gate + col + hh * 4);
                f32x4 o;
                o.x = hv.x + gv.x * acc[j * 8 + hh * 4 + 0]; o.y = hv.y + gv.y * acc[j * 8 + hh * 4 + 1];
                o.z = hv.z + gv.z * acc[j * 8 + hh * 4 + 2]; o.w = hv.w + gv.w * acc[j * 8 + hh * 4 + 3];
                *(f32x4*)(hrow + col + hh * 4) = o;
            }
        }
    }
}

#endif

#define LAS __attribute__((address_space(3)))
#define XB_TMO      128
#define XB_XCNT(j)  (256  + 64 * (j))
#define XB_XSUB(j)  (1280 + 64 * (j))
#define XB_XGEN(j)  (2304 + 64 * (j))
#define XB_TOP      3328
#define XB_TOPGEN   3392
#define XCD_BAR_WORDS 3456
#define XB_SPIN_CAP (1u << 18)

__device__ __forceinline__ unsigned xb_ld(unsigned* p)              { return __hip_atomic_load(p, __ATOMIC_RELAXED, __HIP_MEMORY_SCOPE_AGENT); }
__device__ __forceinline__ unsigned xb_add(unsigned* p, unsigned v) { return __hip_atomic_fetch_add(p, v, __ATOMIC_RELAXED, __HIP_MEMORY_SCOPE_AGENT); }
__device__ __forceinline__ unsigned xb_xcc_id() { return (unsigned)__builtin_amdgcn_s_getreg((3 << 11) | 20) & 0xFu; }
#define XB_SPIN(cond, bar) do { unsigned _sp = 0; while (cond) { __builtin_amdgcn_s_sleep(1); \
    if ((++_sp & 255u) == 0u) { if (xb_ld(&(bar)[XB_TMO])) break; if (_sp > XB_SPIN_CAP) { atomicAdd(&(bar)[XB_TMO], 1u); break; } } } } while (0)

struct XcdBarrier {
    unsigned* bar; unsigned x;
    volatile LAS unsigned* st;
};

__device__ __forceinline__ XcdBarrier xcd_barrier_post(unsigned* bar, volatile LAS unsigned* st) {
    XcdBarrier b; b.bar = bar; b.x = xb_xcc_id(); b.st = st;
    if (threadIdx.x == 0) (void)xb_add(&bar[XB_XCNT(b.x)], 1u);
    return b;
}
__device__ __forceinline__ void xcd_barrier_complete(unsigned* bar, unsigned x, unsigned& nloc, unsigned& nx) {
    const unsigned G = gridDim.x * gridDim.y * gridDim.z;
    unsigned sum, cnt, mine, sp = 0u;
    for (;;) {
        sum = 0u; cnt = 0u; mine = 0u;
#pragma unroll
        for (unsigned j = 0; j < 16; ++j) { const unsigned c = xb_ld(&bar[XB_XCNT(j)]); sum += c; cnt += (c > 0u) ? 1u : 0u; mine = (j == x) ? c : mine; }
        if (sum == G) break;
        __builtin_amdgcn_s_sleep(1);
        if ((++sp & 255u) == 0u) { if (xb_ld(&bar[XB_TMO])) break; if (sp > XB_SPIN_CAP) { atomicAdd(&bar[XB_TMO], 1u); break; } }
    }
    nloc = mine > 0u ? mine : 1u; nx = cnt > 0u ? cnt : 1u;
}

__device__ __forceinline__ void xcd_barrier(const XcdBarrier& b) {
    asm volatile("s_waitcnt vmcnt(0)" ::: "memory");
    __syncthreads();
    if (threadIdx.x == 0) {
        unsigned* bar = b.bar;
        __builtin_amdgcn_s_waitcnt(0);
        unsigned nloc = b.st[0], nx = b.st[1];
        if (nloc == 0u) { xcd_barrier_complete(bar, b.x, nloc, nx); b.st[0] = nloc; b.st[1] = nx; }
        const unsigned old = xb_add(&bar[XB_XSUB(b.x)], 1u);
        const unsigned gen = old / nloc;
        if (old + 1u == (gen + 1u) * nloc) {
            __builtin_amdgcn_fence(__ATOMIC_RELEASE, "agent");
            asm volatile("s_waitcnt vmcnt(0)" ::: "memory");
            const unsigned og = xb_add(&bar[XB_TOP], 1u);
            const unsigned tg = og / nx;
            if (og + 1u == (tg + 1u) * nx) xb_add(&bar[XB_TOPGEN], 1u);
            else XB_SPIN(xb_ld(&bar[XB_TOPGEN]) == tg, bar);
            __builtin_amdgcn_fence(__ATOMIC_ACQUIRE, "agent");
            xb_add(&bar[XB_XGEN(b.x)], 1u);
            asm volatile("s_waitcnt vmcnt(0)" ::: "memory");
        } else {
            XB_SPIN(xb_ld(&bar[XB_XGEN(b.x)]) == gen, bar);
            __builtin_amdgcn_fence(__ATOMIC_ACQUIRE, "agent");
            asm volatile("s_waitcnt vmcnt(0)" ::: "memory");
        }
    }
    __syncthreads();
}

constexpr int NPHASE = 1 + 10 * DEPTH;
template <int S>
__device__ __forceinline__ void run_stage(const Params& p, int l, unsigned char* lds, const bool dry) {
    const bool last = (l == DEPTH - 1);
    const float* mod = (const float*)(p.ws + WS_MOD) + (size_t)l * 9 * 12288;
    if constexpr (S == 1) { if (l == 0) { ph_modulate(p, l, 0); if (GEMM_I8 && !(GEMM3_I8 && W8_ONEPASS) && !dry) ph_weights_i8(p, lds); } }
    if constexpr (S == 2) {
#if USE_PG8
        pg8::StaticOrder So; So.init(MTOT, INW, (int)gridDim.x, (int)blockIdx.x);
#if GEMM_I8
        pg8::Gemm g{(const bf16_t*)(p.ws + WS_XN8), (const bf16_t*)(p.ws + WS_WIN + (size_t)l * INW * DM), MTOT, INW, DM / 2};
        pg8::EpiBf16I8 E{(bf16_t*)(p.ws + WS_P), INW, (const float*)(p.ws + WS_SCL) + SCL_XN, (const float*)(p.ws + WS_SCL) + SCL_WIN + l * INW};
        pg8::gemm_phase<pg8::EpiBf16I8, pg8::StaticOrder, true, true, true>((PG8_LAS unsigned char*)lds, g, So, E);
#else
        pg8::Gemm g{(const bf16_t*)(p.ws + WS_XN), (const bf16_t*)(p.ws + WS_WIN) + (size_t)l * INW * DM, MTOT, INW, DM};
        pg8::EpiBf16<0> E{(bf16_t*)(p.ws + WS_P), INW, nullptr, 0, 0, 1.f};
        pg8::gemm_phase<pg8::EpiBf16<0>, pg8::StaticOrder, true, true>((PG8_LAS unsigned char*)lds, g, So, E);
#endif
#else
        EpiBf16Store E{(bf16_t*)(p.ws + WS_P), INW};
        gemm_naive(lds, (const bf16_t*)(p.ws + WS_XN), (const bf16_t*)(p.ws + WS_WIN) + (size_t)l * INW * DM, MTOT, INW, DM, E);
#endif
    }
    if constexpr (S == 3) ph_prep(p, l, dry);
    if constexpr (S == 4) {
#if USE_FAST_ATT
        ph_mixers_fast(p, l, lds, dry);
#else
        ph_mixers_naive(p, l, lds);
#endif
    }
    if constexpr (S == 5) ph_ynorm(p, l);
    if constexpr (S == 6) {
#if USE_PG8
        const int M = last ? NLAT : MTOT;
        pg8::StaticOrder So; So.init(M, DM, (int)gridDim.x, (int)blockIdx.x);
#if GEMM_I8
        pg8::Gemm g{(const bf16_t*)(p.ws + WS_XN8), (const bf16_t*)(p.ws + WS_WOUT + (size_t)l * DM * DM), M, DM, DM / 2};
#if H_BF16 && GEMM3_I8
        pg8::EpiResGateI8B E{l == 0 ? p.x : nullptr, p.ctx, (bf16_t*)(p.ws + (dry ? WS_DUMMY : WS_HB)), mod + 2 * DM,
                             (const float*)(p.ws + WS_SCL) + SCL_Y, (const float*)(p.ws + WS_SCL) + SCL_WOUT + l * DM};
        pg8::gemm_phase<pg8::EpiResGateI8B, pg8::StaticOrder, true, true, true>((PG8_LAS unsigned char*)lds, g, So, E);
#else
        pg8::EpiResGateI8 E{l == 0 ? p.x : p.out, l == 0 ? p.ctx : (const float*)(p.ws + WS_HC), dry ? (float*)(p.ws + WS_DUMMY) : p.out, dry ? (float*)(p.ws + WS_DUMMY) : (float*)(p.ws + WS_HC), mod + 2 * DM,
                            (const float*)(p.ws + WS_SCL) + SCL_Y, (const float*)(p.ws + WS_SCL) + SCL_WOUT + l * DM};
        pg8::gemm_phase<pg8::EpiResGateI8, pg8::StaticOrder, true, true, true>((PG8_LAS unsigned char*)lds, g, So, E);
#endif
#else
        pg8::Gemm g{(const bf16_t*)(p.ws + WS_Y), (const bf16_t*)(p.ws + WS_WOUT) + (size_t)l * DM * DM, M, DM, DM};
        pg8::EpiResGateT E{l == 0 ? p.x : p.out, l == 0 ? p.ctx : (const float*)(p.ws + WS_HC), dry ? (float*)(p.ws + WS_DUMMY) : p.out, dry ? (float*)(p.ws + WS_DUMMY) : (float*)(p.ws + WS_HC), mod + 2 * DM};
        pg8::gemm_phase<pg8::EpiResGateT, pg8::StaticOrder, true, true>((PG8_LAS unsigned char*)lds, g, So, E);
#endif
#if GATHER_I8 && GATHER_4BIT
        if (TABLES_IN_GAPS && l == 0 && !dry) conv4_tables(p, 0, NEXP, (unsigned*)(p.ws + WS_CTL) + 6144, lds);
#endif
#else
        EpiResGate E{l == 0 ? p.x : p.out, l == 0 ? p.ctx : (const float*)(p.ws + WS_HC), p.out, (float*)(p.ws + WS_HC), mod + 2 * DM};
        gemm_naive(lds, (const bf16_t*)(p.ws + WS_Y), (const bf16_t*)(p.ws + WS_WOUT) + (size_t)l * DM * DM, last ? NLAT : MTOT, DM, DM, E);
#endif
    }
    if constexpr (S == 7) ph_modulate(p, l, 1);
    if constexpr (S == 8) {
#if USE_PG8
        const int M = last ? NLAT : MTOT;
        pg8::StaticOrder So; So.init(M, DM, (int)gridDim.x, (int)blockIdx.x);
#if GEMM_I8 && GEMM3_I8
        pg8::Gemm g{(const bf16_t*)(p.ws + WS_XN8), (const bf16_t*)(p.ws + WS_WQ + (size_t)l * DM * DM), M, DM, DM / 2};
        pg8::EpiBf16I8 E{(bf16_t*)(p.ws + WS_P), DM, (const float*)(p.ws + WS_SCL) + SCL_XN, (const float*)(p.ws + WS_SCL) + SCL_WQ + l * DM};
        pg8::gemm_phase<pg8::EpiBf16I8, pg8::StaticOrder, true, true, true>((PG8_LAS unsigned char*)lds, g, So, E);
#else
        pg8::Gemm g{(const bf16_t*)(p.ws + WS_XN), (const bf16_t*)(p.ws + WS_WQ) + (size_t)l * DM * DM, M, DM, DM};
        pg8::EpiBf16<0> E{(bf16_t*)(p.ws + WS_P), DM, nullptr, 0, 0, 1.f};
        pg8::gemm_phase<pg8::EpiBf16<0>, pg8::StaticOrder, true, true>((PG8_LAS unsigned char*)lds, g, So, E);
#endif
#if FUSE_ROUTE
        asm volatile("s_waitcnt vmcnt(0)" ::: "memory");
        __syncthreads();
        ph_route_fast<true>(p, l, lds);
#endif
#if GATHER_I8 && GATHER_4BIT
        if (TABLES_IN_GAPS && l == 0 && !dry) conv4_tables(p, 2 * NEXP, 3 * NEXP, (unsigned*)(p.ws + WS_CTL) + 6208, lds);
#endif
#else
        EpiBf16Store E{(bf16_t*)(p.ws + WS_P), DM};
        gemm_naive(lds, (const bf16_t*)(p.ws + WS_XN), (const bf16_t*)(p.ws + WS_WQ) + (size_t)l * DM * DM, last ? NLAT : MTOT, DM, DM, E);
#endif
    }
    if constexpr (S == 9) {
#if USE_FAST_ROUTE
        if (!FUSE_ROUTE) ph_route_fast<false>(p, l, lds);
#else
        ph_route_naive(p, l);
#endif
    }
    if constexpr (S == 10) ph_gather(p, l, dry);
}
__global__ void __launch_bounds__(NTHREADS) fwd_kernel(Params p) {
    extern __shared__ __attribute__((aligned(16))) unsigned char lds[];
    cg::grid_group grid = cg::this_grid();
    const int lo = p.ph_lo, hi = p.ph_hi;
    volatile LAS unsigned* stw = (volatile LAS unsigned*)((LAS unsigned char*)lds + (LDS_BYTES - 128));
    if (threadIdx.x < 2) stw[threadIdx.x] = 0u;
    __syncthreads();
    const XcdBarrier bar = xcd_barrier_post((unsigned*)(p.ws + WS_CTL + 32768), stw);
#define IN(k) (lo <= (k) && (k) < hi)
#define SEAM(k) do { if (IN(k) && IN((k) + 1)) xcd_barrier(bar); } while (0)
#define STAGE(S, l) do { constexpr int k_ = 1 + 10 * (l) + (S) - 1; if (IN(k_)) { if constexpr ((REP_MASK >> k_) & 1) { run_stage<S>(p, l, lds, true); xcd_barrier(bar); } run_stage<S>(p, l, lds, false); } SEAM(k_); } while (0)
#define LAYER(l) do { if ((l) == 0) { STAGE(1, l); } STAGE(2, l); STAGE(3, l); STAGE(4, l); STAGE(5, l); STAGE(6, l); STAGE(7, l); STAGE(8, l); if (!FUSE_ROUTE) { STAGE(9, l); } STAGE(10, l); } while (0)
    if (hi > NPHASE) grid.sync();
    if (IN(0)) { if constexpr (REP_MASK & 1) { ph_prologue(p, lds); xcd_barrier(bar); } ph_prologue(p, lds); }
    SEAM(0);
    LAYER(0);
    LAYER(1);
#undef IN
#undef SEAM
#undef STAGE
#undef LAYER
}

extern "C" void kernel_launch(void* const* d_in, const int* in_sizes, int n_in, void* d_out, int out_size, void* d_ws, size_t ws_size, hipStream_t stream) {
    static int grid_blocks = 0;
    if (grid_blocks == 0) {
        if (n_in != 23 || out_size != NLAT * DM || ws_size < WS_END) { fprintf(stderr, "kernel_launch: unexpected shapes n_in %d out %d ws %zu\n", n_in, out_size, ws_size); grid_blocks = -1; return; }
        if (hipFuncSetAttribute((const void*)fwd_kernel, hipFuncAttributeMaxDynamicSharedMemorySize, LDS_BYTES) != hipSuccess) { fprintf(stderr, "kernel_launch: hipFuncSetAttribute failed\n"); grid_blocks = -1; return; }
        int dev = 0, cus = 0, per_cu = 0;
        hipGetDevice(&dev);
        hipDeviceGetAttribute(&cus, hipDeviceAttributeMultiprocessorCount, dev);
        hipOccupancyMaxActiveBlocksPerMultiprocessor(&per_cu, (const void*)fwd_kernel, NTHREADS, LDS_BYTES);
        if (per_cu < 1 || cus < 1) { fprintf(stderr, "kernel_launch: occupancy query failed (%d per CU, %d CUs)\n", per_cu, cus); grid_blocks = -1; return; }
        grid_blocks = cus * per_cu;
    }
    if (grid_blocks < 0) return;
    Params p{};
    const float** pp = (const float**)&p;
    for (int i = 0; i < 23; ++i) pp[i] = (const float*)d_in[i];
    p.out = (float*)d_out; p.ws = (unsigned char*)d_ws;
    p.ph_lo = 0; p.ph_hi = NPHASE;
    hipMemsetAsync((char*)d_ws + WS_CTL, 0, 131072, stream);
    void* args[] = {&p};
    hipError_t e = hipLaunchCooperativeKernel((const void*)fwd_kernel, dim3(grid_blocks), dim3(NTHREADS), args, LDS_BYTES, stream);
    if (e != hipSuccess) fprintf(stderr, "cooperative launch failed: %s (grid %d)\n", hipGetErrorString(e), grid_blocks);
}
```

```cpp
#include <hip/hip_runtime.h>
#include <hip/hip_cooperative_groups.h>
#include <cstdio>
#include <cstdint>
namespace cg = cooperative_groups;

constexpr int DM = 2048, NB = 8, SEQ = 2048, NCTX = 256, DEPTH = 2;
constexpr int NLAT = NB * SEQ;
constexpr int NCT = NB * NCTX;
constexpr int MTOT = NLAT + NCT;
constexpr int INW = 3584;
constexpr int C_QA = 0, C_KA = 768, C_VA = 1024, C_QB = 1280, C_KB = 2048, C_VB = 2304, C_UC = 2560, C_VC = 3072;
constexpr int NEXP = 16384;
constexpr float EPS = 1e-6f;
constexpr float ATT_SCALE = 0.088388347648318440f;
constexpr int NTHREADS = 512, NWAVES = 8;

constexpr size_t MiB = 1u << 20;
constexpr size_t WS_CTL = 0;
constexpr size_t WS_MOD = 1 * MiB;
constexpr size_t WS_ROPE = 2 * MiB;
constexpr size_t WS_KEYS = 3 * MiB;
constexpr size_t WS_WSC = 4 * MiB;
constexpr size_t WS_USC = 5 * MiB;
constexpr size_t WS_VSC = 6 * MiB;
constexpr size_t WS_WIN = 8 * MiB;
constexpr size_t WS_WOUT = 36 * MiB;
constexpr size_t WS_WQ = 52 * MiB;
constexpr size_t WS_HC = 68 * MiB;
constexpr size_t WS_EID = 84 * MiB;
constexpr size_t WS_GATE = 93 * MiB;
constexpr size_t WS_XN = 104 * MiB;
constexpr size_t WS_HB = WS_XN;
constexpr size_t WS_Y = 176 * MiB;
constexpr size_t WS_P = 248 * MiB;
constexpr size_t WS_UT = 376 * MiB;
constexpr size_t WS_VT = 504 * MiB;
constexpr size_t WS_SCL = 102 * MiB;
constexpr size_t SCL_WIN = 0, SCL_WOUT = 2 * 3584, SCL_XN = SCL_WOUT + 2 * 2048, SCL_Y = SCL_XN + 18432, SCL_WQ = SCL_Y + 18432;
constexpr int NCM = 3584 + 2048 + 2048;
constexpr size_t WS_XN8 = 784 * MiB;
constexpr size_t CTL_COLMAX = 65536;
constexpr size_t WS_DUMMY = 640 * MiB;
constexpr size_t WS_END = 820 * MiB;

constexpr int LDS_BYTES = 147456;

typedef unsigned short bf16_t;
typedef float f32x4 __attribute__((ext_vector_type(4)));
typedef unsigned u32x4 __attribute__((ext_vector_type(4)));
typedef unsigned u32x2 __attribute__((ext_vector_type(2)));

struct Params {
    const float *x, *c, *ctx, *c_ctx, *w_ada, *b_ada, *norm1_g, *norm2_g, *w_in, *qn_a, *kn_a, *qn_b, *kn_b, *sink_b, *vn_c, *ws_c, *bs_c,
        *g_group, *w_out, *peer_wq, *peer_keys, *peer_u, *peer_v;
    float* out;
    unsigned char* ws;
    int ph_lo, ph_hi;
};

__device__ __forceinline__ float bf2f(unsigned v) { return __uint_as_float(v << 16); }
__device__ __forceinline__ float bflo(unsigned w) { return __uint_as_float(w << 16); }
__device__ __forceinline__ float bfhi(unsigned w) { return __uint_as_float(w & 0xffff0000u); }
__device__ __forceinline__ unsigned f2bf(float f) { unsigned u = __float_as_uint(f); return (u + 0x7fffu + ((u >> 16) & 1u)) >> 16; }
__device__ __forceinline__ unsigned pk2(float lo, float hi) { return f2bf(lo) | (f2bf(hi) << 16); }
__device__ __forceinline__ float wave_sum(float v) {
#pragma unroll
    for (int o = 32; o >= 1; o >>= 1) v += __shfl_xor(v, o);
    return v;
}
__device__ __forceinline__ float wave_max(float v) {
#pragma unroll
    for (int o = 32; o >= 1; o >>= 1) v = fmaxf(v, __shfl_xor(v, o));
    return v;
}
__device__ __forceinline__ float gelu_tanh(float x) {
    const float y = 0.7978845608028654f * (x + 0.044715f * x * x * x);
    const float t = 1.f - 2.f / (__expf(2.f * y) + 1.f);
    return 0.5f * x * (1.f + t);
}
__device__ __forceinline__ float silu(float x) { return x / (1.f + __expf(-x)); }
#define LDS_WAIT() asm volatile("s_waitcnt lgkmcnt(0)" ::: "memory")
#ifndef GATHER_I8
#define GATHER_I8 1
#endif
#ifndef GATHER_4BIT
#define GATHER_4BIT 1
#endif
constexpr int ROW4 = 1152;
#ifndef V_ROWSCALE
#define V_ROWSCALE 1
#endif
constexpr int ROWV = V_ROWSCALE ? 1024 : ROW4;
#ifndef GVEC_LDS
#define GVEC_LDS 1
#endif
#ifndef U_ROWSCALE
#define U_ROWSCALE 1
#endif
constexpr int ROWU = U_ROWSCALE ? 1024 : ROW4;
#ifndef FUSE_ROUTE
#define FUSE_ROUTE 1
#endif
#ifndef GEMM_I8
#define GEMM_I8 1
#endif
#ifndef GEMM3_I8
#define GEMM3_I8 1
#endif
#ifndef H_BF16
#define H_BF16 1
#endif
#ifndef W8_ONEPASS
#define W8_ONEPASS 1
#endif
#ifndef DRY_MODE
#define DRY_MODE 0
#endif
#ifndef REP_MASK
#define REP_MASK 0
#endif

__device__ __forceinline__ unsigned q8pack4(float a, float b, float c, float d, float inv) {
    const int q0 = (int)rintf(a * inv), q1 = (int)rintf(b * inv), q2 = (int)rintf(c * inv), q3 = (int)rintf(d * inv);
    return ((unsigned)q0 & 0xffu) | (((unsigned)q1 & 0xffu) << 8) | (((unsigned)q2 & 0xffu) << 16) | ((unsigned)q3 << 24);
}

__device__ __forceinline__ void transpose_item(const float* W, int K, int N, bf16_t* WT, const float* gk, float* scr, int item, int lane) {
    const int nblk = N / 32, kb = item / nblk, nb = item % nblk, k0 = 64 * kb, n0 = 32 * nb;
#pragma unroll 8
    for (int i = 0; i < 32; ++i) {
        const int kk = 2 * i + (lane >> 5);
        float v = W[(size_t)(k0 + kk) * N + n0 + (lane & 31)];
        if (gk) v *= gk[k0 + kk];
        scr[kk * 33 + (lane & 31)] = v;
    }
    LDS_WAIT();
    const int c = lane & 7;
#pragma unroll
    for (int j = 0; j < 4; ++j) {
        const int n = (lane >> 3) + 8 * j;
        const float* s = scr + (8 * c) * 33 + n;
        u32x4 o;
        o.x = pk2(s[0 * 33], s[1 * 33]); o.y = pk2(s[2 * 33], s[3 * 33]); o.z = pk2(s[4 * 33], s[5 * 33]); o.w = pk2(s[6 * 33], s[7 * 33]);
        *(u32x4*)(WT + (size_t)(n0 + n) * K + k0 + 8 * c) = o;
    }
    LDS_WAIT();
}

__device__ __forceinline__ void colmax_item(const float* W, int N, const float* gk, unsigned* cmax, int item, int lane) {
    const int nblk = N / 32, kb = item / nblk, nb = item % nblk, k0 = 64 * kb, n0 = 32 * nb;
    f32x4 v[8];
#pragma unroll
    for (int i = 0; i < 8; ++i) v[i] = *(const f32x4*)(W + (size_t)(k0 + 8 * i + (lane >> 3)) * N + n0 + 4 * (lane & 7));
    float m0 = 0.f, m1 = 0.f, m2 = 0.f, m3 = 0.f;
#pragma unroll
    for (int i = 0; i < 8; ++i) {
        const float g = gk ? fabsf(gk[k0 + 8 * i + (lane >> 3)]) : 1.f;
        m0 = fmaxf(m0, fabsf(v[i].x) * g); m1 = fmaxf(m1, fabsf(v[i].y) * g); m2 = fmaxf(m2, fabsf(v[i].z) * g); m3 = fmaxf(m3, fabsf(v[i].w) * g);
    }
#pragma unroll
    for (int o = 8; o <= 32; o <<= 1) { m0 = fmaxf(m0, __shfl_xor(m0, o)); m1 = fmaxf(m1, __shfl_xor(m1, o)); m2 = fmaxf(m2, __shfl_xor(m2, o)); m3 = fmaxf(m3, __shfl_xor(m3, o)); }
    if (lane < 8) {
        unsigned* c = cmax + n0 + 4 * lane;
        atomicMax(c + 0, __float_as_uint(m0)); atomicMax(c + 1, __float_as_uint(m1)); atomicMax(c + 2, __float_as_uint(m2)); atomicMax(c + 3, __float_as_uint(m3));
    }
}
__device__ __forceinline__ void transpose_item_i8(const float* W, int K, int N, unsigned char* W8, const float* gk, const unsigned* cmax, float* scr, int item, int lane) {
    const int nblk = N / 32, kb = item / nblk, nb = item % nblk, k0 = 64 * kb, n0 = 32 * nb;
    f32x4 v[8];
#pragma unroll
    for (int i = 0; i < 8; ++i) v[i] = *(const f32x4*)(W + (size_t)(k0 + 8 * i + (lane >> 3)) * N + n0 + 4 * (lane & 7));
    float inv[4];
#pragma unroll
    for (int c = 0; c < 4; ++c) { const float m = __uint_as_float(cmax[n0 + 4 * (lane & 7) + c]); inv[c] = m > 0.f ? 127.f / m : 0.f; }
#pragma unroll
    for (int i = 0; i < 8; ++i) {
        const int kk = 8 * i + (lane >> 3);
        const float g = gk ? gk[k0 + kk] : 1.f;
        float* d = scr + kk * 33 + 4 * (lane & 7);
        d[0] = rintf(v[i].x * g * inv[0]); d[1] = rintf(v[i].y * g * inv[1]); d[2] = rintf(v[i].z * g * inv[2]); d[3] = rintf(v[i].w * g * inv[3]);
    }
    LDS_WAIT();
    const int c = lane & 7;
#pragma unroll
    for (int j = 0; j < 4; ++j) {
        const int n = (lane >> 3) + 8 * j;
        const float* s = scr + (8 * c) * 33 + n;
        unsigned lo = 0u, hi = 0u;
#pragma unroll
        for (int i = 0; i < 4; ++i) { lo |= ((unsigned)(int)s[i * 33] & 0xffu) << (8 * i); hi |= ((unsigned)(int)s[(4 + i) * 33] & 0xffu) << (8 * i); }
        u32x2 o; o.x = lo; o.y = hi;
        *(u32x2*)(W8 + (size_t)(n0 + n) * K + k0 + 8 * c) = o;
    }
    LDS_WAIT();
}
__device__ __forceinline__ void ph_weights_i8(const Params& p, unsigned char* lds) {
    const int tid = threadIdx.x, lane = tid & 63, wave = tid >> 6;
    const int gw = blockIdx.x * NWAVES + wave, NGW = gridDim.x * NWAVES;
    float* scr = (float*)(lds + wave * 8704);
    const unsigned* cm = (const unsigned*)(p.ws + WS_CTL + CTL_COLMAX);
    constexpr int I_IN = 32 * 112, I_SQ = 32 * 64, I_L = I_IN + I_SQ + (GEMM3_I8 ? I_SQ : 0);
    for (int it = gw; it < 2 * I_L; it += NGW) {
        const int l = it / I_L; const int r = it % I_L;
        if (r < I_IN) transpose_item_i8(p.w_in + (size_t)l * DM * INW, DM, INW, (unsigned char*)(p.ws + WS_WIN) + (size_t)l * INW * DM, nullptr, cm + l * NCM, scr, r, lane);
        else if (r < I_IN + I_SQ) transpose_item_i8(p.w_out + (size_t)l * DM * DM, DM, DM, (unsigned char*)(p.ws + WS_WOUT) + (size_t)l * DM * DM, p.g_group + l * DM, cm + l * NCM + INW, scr, r - I_IN, lane);
        else transpose_item_i8(p.peer_wq + (size_t)l * DM * DM, DM, DM, (unsigned char*)(p.ws + WS_WQ) + (size_t)l * DM * DM, nullptr, cm + l * NCM + INW + DM, scr, r - I_IN - I_SQ, lane);
    }
    float* S = (float*)(p.ws + WS_SCL);
    for (int i = blockIdx.x * NTHREADS + tid; i < 2 * NCM; i += gridDim.x * NTHREADS) {
        const int l = i / NCM, n = i % NCM;
        const float m = __uint_as_float(cm[i]); const float s = m > 0.f ? m * (1.f / 127.f) : 1.f;
        if (n < INW) S[SCL_WIN + l * INW + n] = s; else if (n < INW + DM) S[SCL_WOUT + l * DM + (n - INW)] = s; else S[SCL_WQ + l * DM + (n - INW - DM)] = s;
    }
}

__device__ __forceinline__ void w8_strip(const float* W, int N, int n0, const float* gk, unsigned char* W8, float* scl, unsigned char* lds) {
    constexpr int TP = 2048 + 8;
    bf16_t* T = (bf16_t*)lds;
    unsigned* cmx = (unsigned*)(lds + 32 * TP * 2);
    const int tid = threadIdx.x, nq = tid & 7, kr = tid >> 3;
    __syncthreads();
    if (tid < 32) cmx[tid] = 0u;
    float m0 = 0.f, m1 = 0.f, m2 = 0.f, m3 = 0.f;
#pragma unroll 1
    for (int s0 = 0; s0 < 32; s0 += 8) {
        f32x4 v[8];
#pragma unroll
        for (int i = 0; i < 8; ++i) v[i] = *(const f32x4*)(W + (size_t)((s0 + i) * 64 + kr) * N + n0 + 4 * nq);
#pragma unroll
        for (int i = 0; i < 8; ++i) {
            const int k = (s0 + i) * 64 + kr;
            const float g = gk ? gk[k] : 1.f;
            const float a = v[i].x * g, b = v[i].y * g, c = v[i].z * g, d = v[i].w * g;
            m0 = fmaxf(m0, fabsf(a)); m1 = fmaxf(m1, fabsf(b)); m2 = fmaxf(m2, fabsf(c)); m3 = fmaxf(m3, fabsf(d));
            T[(4 * nq + 0) * TP + k] = (bf16_t)f2bf(a); T[(4 * nq + 1) * TP + k] = (bf16_t)f2bf(b); T[(4 * nq + 2) * TP + k] = (bf16_t)f2bf(c); T[(4 * nq + 3) * TP + k] = (bf16_t)f2bf(d);
        }
    }
    __syncthreads();
    atomicMax(cmx + 4 * nq + 0, __float_as_uint(m0)); atomicMax(cmx + 4 * nq + 1, __float_as_uint(m1));
    atomicMax(cmx + 4 * nq + 2, __float_as_uint(m2)); atomicMax(cmx + 4 * nq + 3, __float_as_uint(m3));
    __syncthreads();
    const int n = tid >> 4, kc = tid & 15;
    const float cm = __uint_as_float(cmx[n]); const float inv = cm > 0.f ? 127.f / cm : 0.f;
    if (kc == 0) scl[n0 + n] = cm > 0.f ? cm * (1.f / 127.f) : 1.f;
#pragma unroll 4
    for (int s = 0; s < 16; ++s) {
        const int k = s * 128 + kc * 8;
        const u32x4 q = *(const u32x4*)(T + n * TP + k);
        u32x2 o;
        o.x = q8pack4(bflo(q.x), bfhi(q.x), bflo(q.y), bfhi(q.y), inv); o.y = q8pack4(bflo(q.z), bfhi(q.z), bflo(q.w), bfhi(q.w), inv);
        *(u32x2*)(W8 + (size_t)(n0 + n) * 2048 + k) = o;
    }
}
__device__ __forceinline__ void cvt_range(const float* src, bf16_t* dst, size_t n8, size_t gtid, size_t gthreads) {
    for (size_t i = gtid; i < n8; i += gthreads) {
        const f32x4 a = *(const f32x4*)(src + i * 8), b = *(const f32x4*)(src + i * 8 + 4);
        u32x4 o; o.x = pk2(a.x, a.y); o.y = pk2(a.z, a.w); o.z = pk2(b.x, b.y); o.w = pk2(b.z, b.w);
        *(u32x4*)(dst + i * 8) = o;
    }
}

#if GATHER_I8 && GATHER_4BIT
__device__ __forceinline__ void conv4_row(const f32x4 (&v)[8], const bool isv, unsigned char* drow, int lane, float* rowscale) {
    float am = 0.f;
#pragma unroll
    for (int i = 0; i < 8; ++i) am = fmaxf(am, fmaxf(fmaxf(fabsf(v[i].x), fabsf(v[i].y)), fmaxf(fabsf(v[i].z), fabsf(v[i].w))));
    if (V_ROWSCALE && isv) am = wave_max(am);
    float s0 = am > 0.f ? am * (isv ? (1.f / 6.f) : (1.f / 7.f)) : 1.f;
    if (U_ROWSCALE && !isv) {
        float ss = 0.f;
#pragma unroll
        for (int i = 0; i < 8; ++i) ss += v[i].x * v[i].x + v[i].y * v[i].y + v[i].z * v[i].z + v[i].w * v[i].w;
        ss = wave_sum(ss);
        s0 = ss > 0.f ? 0.35f * sqrtf(ss * (1.f / 2048.f)) : 1.f;
    }
    const unsigned sb = (__float_as_uint(s0) + 0xffffu) >> 16;
    const float inv = 1.f / __uint_as_float(sb << 16);
    u32x4 o; unsigned w[4];
#pragma unroll
    for (int d = 0; d < 4; ++d) {
        const f32x4 a = v[2 * d], b = v[2 * d + 1];
        const float e[8] = {a.x * inv, a.y * inv, a.z * inv, a.w * inv, b.x * inv, b.y * inv, b.z * inv, b.w * inv};
        unsigned acc = 0u;
        if (isv) {
            acc = __builtin_amdgcn_cvt_scalef32_pk_fp4_f32(acc, e[0], e[1], 1.0f, 0);
            acc = __builtin_amdgcn_cvt_scalef32_pk_fp4_f32(acc, e[2], e[3], 1.0f, 1);
            acc = __builtin_amdgcn_cvt_scalef32_pk_fp4_f32(acc, e[4], e[5], 1.0f, 2);
            acc = __builtin_amdgcn_cvt_scalef32_pk_fp4_f32(acc, e[6], e[7], 1.0f, 3);
        } else {
#pragma unroll
            for (int i = 0; i < 8; ++i) {
                const int q = (int)fminf(fmaxf(rintf(e[i]), -7.f), 7.f);
                acc |= ((unsigned)q & 0xFu) << (8 * (i >> 1) + 4 * (i & 1));
            }
        }
        w[d] = acc;
    }
    o.x = w[0]; o.y = w[1]; o.z = w[2]; o.w = w[3];
    *(u32x4*)(drow + lane * 16) = o;
    if ((V_ROWSCALE && isv) || (U_ROWSCALE && !isv)) { if (lane == 0) *rowscale = __uint_as_float(sb << 16); }
    else *(unsigned short*)(drow + 1024 + lane * 2) = (unsigned short)sb;
}
#endif
#if GATHER_I8 && GATHER_4BIT
#ifndef TABLES_IN_GAPS
#define TABLES_IN_GAPS 1
#endif
__device__ __forceinline__ void conv4_tables(const Params& p, int r0, int r1, unsigned* ctr, unsigned char* lds) {
    const int tid = threadIdx.x, lane = tid & 63, wave = tid >> 6;
    unsigned char* ws = p.ws;
    volatile unsigned* shw = (volatile unsigned*)(lds + LDS_BYTES - 64);
    const int nchunk = (r1 - r0) / 64;
    for (int it = 0;; ++it) {
        int cbeg, cstep, cend;
        if (ctr) {
            __syncthreads();
            if (tid == 0) *shw = atomicAdd(ctr, 1u);
            __syncthreads();
            const int c = (int)*shw; if (c >= nchunk) break;
            cbeg = r0 + c * 64 + wave; cstep = NWAVES; cend = r0 + c * 64 + 64;
        } else {
            if (it > 0) break;
            cbeg = r0 + blockIdx.x * NWAVES + wave; cstep = gridDim.x * NWAVES; cend = r1;
        }
        for (int r = cbeg; r < cend; r += 2 * cstep) {
            const int r2 = r + cstep; const bool has2 = r2 < cend; const int rb = has2 ? r2 : r;
            const bool isvA = r >= 2 * NEXP, isvB = rb >= 2 * NEXP; const int rrA = isvA ? r - 2 * NEXP : r, rrB = isvB ? rb - 2 * NEXP : rb;
            const float* srowA = (isvA ? p.peer_v : p.peer_u) + (size_t)rrA * DM;
            const float* srowB = (isvB ? p.peer_v : p.peer_u) + (size_t)rrB * DM;
            f32x4 va[8], vb[8];
#pragma unroll
            for (int j = 0; j < 2; ++j)
#pragma unroll
                for (int k = 0; k < 4; ++k) { va[j * 4 + k] = *(const f32x4*)(srowA + j * 1024 + lane * 16 + k * 4); vb[j * 4 + k] = *(const f32x4*)(srowB + j * 1024 + lane * 16 + k * 4); }
            conv4_row(va, isvA, (unsigned char*)(ws + (isvA ? WS_VT : WS_UT)) + (size_t)rrA * (isvA ? ROWV : ROWU), lane, (float*)(ws + (isvA ? WS_VSC : WS_USC)) + rrA);
            if (has2) conv4_row(vb, isvB, (unsigned char*)(ws + (isvB ? WS_VT : WS_UT)) + (size_t)rrB * (isvB ? ROWV : ROWU), lane, (float*)(ws + (isvB ? WS_VSC : WS_USC)) + rrB);
        }
    }
}
#endif
__device__ __forceinline__ void ph_prologue(const Params& p, unsigned char* lds) {
    const int tid = threadIdx.x, lane = tid & 63, wave = tid >> 6;
    const int gw = blockIdx.x * NWAVES + wave, NGW = gridDim.x * NWAVES;
    unsigned char* ws = p.ws;
    {
        float* sT = (float*)lds;
        float* red = (float*)(lds + 2048 * 12 * 4);
        for (int i = tid; i < 2048 * 9; i += NTHREADS) {
            const int k = i / 9, bb = i % 9;
            const float v = bb < 8 ? p.c[bb * DM + k] : p.c_ctx[k];
            sT[k * 12 + bb] = silu(v);
        }
        __syncthreads();
        const int cq = lane & 7, ks = tid >> 3;
        for (int u = blockIdx.x; u < 768; u += gridDim.x) {
            const int l = u / 384, n0 = (u % 384) * 32;
            const float* W = p.w_ada + (size_t)l * DM * 12288 + n0 + cq * 4;
            float acc[9][4];
#pragma unroll
            for (int b = 0; b < 9; ++b)
#pragma unroll
                for (int j = 0; j < 4; ++j) acc[b][j] = 0.f;
#pragma unroll 8
            for (int i = 0; i < 32; ++i) {
                const int k = ks + 64 * i;
                const f32x4 w = *(const f32x4*)(W + (size_t)k * 12288);
                const f32x4 s0 = *(const f32x4*)(sT + k * 12), s1 = *(const f32x4*)(sT + k * 12 + 4);
                const float s8 = sT[k * 12 + 8];
                const float sv[9] = {s0.x, s0.y, s0.z, s0.w, s1.x, s1.y, s1.z, s1.w, s8};
#pragma unroll
                for (int b = 0; b < 9; ++b) { acc[b][0] += sv[b] * w.x; acc[b][1] += sv[b] * w.y; acc[b][2] += sv[b] * w.z; acc[b][3] += sv[b] * w.w; }
            }
#pragma unroll
            for (int b = 0; b < 9; ++b)
#pragma unroll
                for (int j = 0; j < 4; ++j) {
                    float v = acc[b][j];
                    v += __shfl_xor(v, 8); v += __shfl_xor(v, 16); v += __shfl_xor(v, 32);
                    acc[b][j] = v;
                }
            if (lane < 8) {
#pragma unroll
                for (int b = 0; b < 9; ++b)
#pragma unroll
                    for (int j = 0; j < 4; ++j) red[(wave * 8 + cq) * 36 + b * 4 + j] = acc[b][j];
            }
            __syncthreads();
            if (tid < 288) {
                const int b = tid / 32, col = tid % 32, q = col >> 2, j = col & 3;
                float s = 0.f;
#pragma unroll
                for (int w = 0; w < 8; ++w) s += red[(w * 8 + q) * 36 + b * 4 + j];
                const int n = n0 + col;
                ((float*)(ws + WS_MOD))[(size_t)(l * 9 + b) * 12288 + n] = s + p.b_ada[l * 12288 + n];
            }
            __syncthreads();
        }
    }
    __syncthreads();
#if GEMM_I8 && GEMM3_I8 && W8_ONEPASS
    {
        float* S = (float*)(ws + WS_SCL);
        constexpr int ST_IN = INW / 32, ST_SQ = DM / 32, ST_L = ST_IN + 2 * ST_SQ;
        for (int it = blockIdx.x; it < 2 * ST_L; it += gridDim.x) {
            const int l = it / ST_L; int r = it % ST_L;
            if (r < ST_IN) { w8_strip(p.w_in + (size_t)l * DM * INW, INW, r * 32, nullptr, (unsigned char*)(ws + WS_WIN) + (size_t)l * INW * DM, S + SCL_WIN + l * INW, lds); continue; }
            r -= ST_IN;
            if (r < ST_SQ) { w8_strip(p.w_out + (size_t)l * DM * DM, DM, r * 32, p.g_group + l * DM, (unsigned char*)(ws + WS_WOUT) + (size_t)l * DM * DM, S + SCL_WOUT + l * DM, lds); continue; }
            r -= ST_SQ;
            w8_strip(p.peer_wq + (size_t)l * DM * DM, DM, r * 32, nullptr, (unsigned char*)(ws + WS_WQ) + (size_t)l * DM * DM, S + SCL_WQ + l * DM, lds);
        }
        __syncthreads();
    }
#else
    {
        float* scr = (float*)(lds + wave * 8704);
        constexpr int I_IN = 32 * 112, I_SQ = 32 * 64, I_L = I_IN + 2 * I_SQ;
        unsigned* cm = (unsigned*)(ws + WS_CTL + CTL_COLMAX);
        for (int it = gw; it < 2 * I_L; it += NGW) {
            const int l = it / I_L; int r = it % I_L;
            if (r < I_IN) {
                if (GEMM_I8) colmax_item(p.w_in + (size_t)l * DM * INW, INW, nullptr, cm + l * NCM, r, lane);
                else transpose_item(p.w_in + (size_t)l * DM * INW, DM, INW, (bf16_t*)(ws + WS_WIN) + (size_t)l * INW * DM, nullptr, scr, r, lane);
                continue; }
            r -= I_IN;
            if (r < I_SQ) {
                if (GEMM_I8) colmax_item(p.w_out + (size_t)l * DM * DM, DM, p.g_group + l * DM, cm + l * NCM + INW, r, lane);
                else transpose_item(p.w_out + (size_t)l * DM * DM, DM, DM, (bf16_t*)(ws + WS_WOUT) + (size_t)l * DM * DM, p.g_group + l * DM, scr, r, lane);
                continue; }
            r -= I_SQ;
            if (GEMM_I8 && GEMM3_I8) colmax_item(p.peer_wq + (size_t)l * DM * DM, DM, nullptr, cm + l * NCM + INW + DM, r, lane);
            else transpose_item(p.peer_wq + (size_t)l * DM * DM, DM, DM, (bf16_t*)(ws + WS_WQ) + (size_t)l * DM * DM, nullptr, scr, r, lane);
        }
    }
#endif
    {
        const size_t gtid = (size_t)blockIdx.x * NTHREADS + tid, gth = (size_t)gridDim.x * NTHREADS;
        cvt_range(p.peer_keys, (bf16_t*)(ws + WS_KEYS), (size_t)2 * 8 * 2 * 128 * 128 / 8, gtid, gth);
        cvt_range(p.ws_c, (bf16_t*)(ws + WS_WSC), (size_t)2 * 4 * 128 * 128 / 8, gtid, gth);
#if GATHER_I8 && GATHER_4BIT
        if (!TABLES_IN_GAPS) conv4_tables(p, 0, 4 * NEXP, nullptr, lds);
#elif GATHER_I8
        for (int r = gw; r < 4 * NEXP; r += NGW) {
            const bool isv = r >= 2 * NEXP; const int rr = isv ? r - 2 * NEXP : r;
            const float* srow = (isv ? p.peer_v : p.peer_u) + (size_t)rr * DM;
            f32x4 v[8]; float am = 0.f;
#pragma unroll
            for (int j = 0; j < 2; ++j)
#pragma unroll
                for (int k = 0; k < 4; ++k) {
                    v[j * 4 + k] = *(const f32x4*)(srow + j * 1024 + lane * 16 + k * 4);
                    am = fmaxf(am, fmaxf(fmaxf(fabsf(v[j * 4 + k].x), fabsf(v[j * 4 + k].y)), fmaxf(fabsf(v[j * 4 + k].z), fabsf(v[j * 4 + k].w))));
                }
            am = wave_max(am);
            const float s = am > 0.f ? am * (isv ? (1.f / 443.f) : (1.f / 127.f)) : 1.f, inv = 1.f / s;
            unsigned char* drow = (unsigned char*)(ws + (isv ? WS_VT : WS_UT)) + (size_t)rr * DM;
#pragma unroll
            for (int j = 0; j < 2; ++j) {
                u32x4 o; unsigned w[4];
#pragma unroll
                for (int k = 0; k < 4; ++k) {
                    const f32x4 a = v[j * 4 + k];
                    if (isv) {
                        int pk = __builtin_amdgcn_cvt_pk_fp8_f32(a.x * inv, a.y * inv, 0, false);
                        pk = __builtin_amdgcn_cvt_pk_fp8_f32(a.z * inv, a.w * inv, pk, true);
                        w[k] = (unsigned)pk;
                    } else {
                        const int q0 = (int)rintf(a.x * inv), q1 = (int)rintf(a.y * inv), q2 = (int)rintf(a.z * inv), q3 = (int)rintf(a.w * inv);
                        w[k] = ((unsigned)q0 & 0xffu) | (((unsigned)q1 & 0xffu) << 8) | (((unsigned)q2 & 0xffu) << 16) | ((unsigned)q3 << 24);
                    }
                }
                o.x = w[0]; o.y = w[1]; o.z = w[2]; o.w = w[3];
                *(u32x4*)(drow + j * 1024 + lane * 16) = o;
            }
            if (lane == 0) ((float*)(ws + (isv ? WS_VSC : WS_USC)))[rr] = s;
        }
#else
        cvt_range(p.peer_u, (bf16_t*)(ws + WS_UT), (size_t)2 * NEXP * DM / 8, gtid, gth);
        cvt_range(p.peer_v, (bf16_t*)(ws + WS_VT), (size_t)2 * NEXP * DM / 8, gtid, gth);
#endif
        float* rope = (float*)(ws + WS_ROPE);
        for (size_t i = gtid; i < (size_t)2048 * 64; i += gth) {
            const int t = (int)(i >> 6), f = (int)(i & 63), fi = f & 31;
            const float pos = (f < 32) ? (float)(t >> 6) : (float)(t & 63);
            const float inv = powf(10000.0f, -(float)fi / 32.0f);
            const float ang = pos * inv;
            rope[i * 2] = cosf(ang); rope[i * 2 + 1] = sinf(ang);
        }
    }
}


__device__ __forceinline__ void modulate_store(const f32x4 (&v)[8], float rstd, const float* g, const float* shift, const float* scale, bf16_t* dst, int lane) {
#pragma unroll
    for (int j = 0; j < 8; ++j) {
        const int col = j * 256 + lane * 4;
        const f32x4 gg = *(const f32x4*)(g + col), sc = *(const f32x4*)(scale + col), sh = *(const f32x4*)(shift + col);
        const f32x4 o = v[j] * rstd * gg * (1.f + sc) + sh;
        u32x2 w; w.x = pk2(o.x, o.y); w.y = pk2(o.z, o.w);
        *(u32x2*)(dst + col) = w;
    }
}
__device__ __forceinline__ void modulate_store_i8(const f32x4 (&v)[8], float rstd, const float* g, const float* shift, const float* scale, unsigned char* dst, float* sdst, int lane, const float levels) {
    f32x4 o[8]; float am = 0.f;
#pragma unroll
    for (int j = 0; j < 8; ++j) {
        const int col = j * 256 + lane * 4;
        const f32x4 gg = *(const f32x4*)(g + col), sc = *(const f32x4*)(scale + col), sh = *(const f32x4*)(shift + col);
        o[j] = v[j] * rstd * gg * (1.f + sc) + sh;
        am = fmaxf(am, fmaxf(fmaxf(fabsf(o[j].x), fabsf(o[j].y)), fmaxf(fabsf(o[j].z), fabsf(o[j].w))));
    }
    am = wave_max(am);
    const float s = am > 0.f ? am / levels : 1.f, inv = 1.f / s;
#pragma unroll
    for (int j = 0; j < 8; ++j) *(unsigned*)(dst + j * 256 + lane * 4) = q8pack4(o[j].x, o[j].y, o[j].z, o[j].w, inv);
    if (lane == 0) *sdst = s;
}
__device__ __forceinline__ void ph_modulate(const Params& p, int l, int which) {
    const int tid = threadIdx.x, lane = tid & 63, wave = tid >> 6;
    const int gw = blockIdx.x * NWAVES + wave, NGW = gridDim.x * NWAVES;
    const int nrows = (which == 1 && l == DEPTH - 1) ? NLAT : MTOT;
    const float* g = (which == 0 ? p.norm1_g : p.norm2_g) + l * DM;
    const float* mod = (const float*)(p.ws + WS_MOD) + (size_t)l * 9 * 12288;
    const float* srcLat = (which == 0 && l == 0) ? p.x : p.out;
    const float* srcCtx = (which == 0 && l == 0) ? p.ctx : (const float*)(p.ws + WS_HC);
    bf16_t* XN = (bf16_t*)(p.ws + WS_XN);
    const int moff = (which == 0 ? 0 : 3) * DM;
#pragma unroll 1
    for (int r = gw; r < nrows; r += 2 * NGW) {
        const int r2 = r + NGW; const bool has2 = r2 < nrows; const int rb = has2 ? r2 : r;
        const float* srcA = r < NLAT ? srcLat + (size_t)r * DM : srcCtx + (size_t)(r - NLAT) * DM;
        const float* srcB = rb < NLAT ? srcLat + (size_t)rb * DM : srcCtx + (size_t)(rb - NLAT) * DM;
        f32x4 va[8], vb[8]; float sa = 0.f, sb = 0.f;
        if (H_BF16 && GEMM_I8 && GEMM3_I8 && which == 1) {
            const bf16_t* HB = (const bf16_t*)(p.ws + WS_HB);
#pragma unroll
            for (int j = 0; j < 8; ++j) {
                const u32x2 ra = *(const u32x2*)(HB + (size_t)r * DM + j * 256 + lane * 4), rb2 = *(const u32x2*)(HB + (size_t)rb * DM + j * 256 + lane * 4);
                va[j] = (f32x4){bflo(ra.x), bfhi(ra.x), bflo(ra.y), bfhi(ra.y)}; vb[j] = (f32x4){bflo(rb2.x), bfhi(rb2.x), bflo(rb2.y), bfhi(rb2.y)};
            }
        } else {
#pragma unroll
        for (int j = 0; j < 8; ++j) { va[j] = *(const f32x4*)(srcA + j * 256 + lane * 4); vb[j] = *(const f32x4*)(srcB + j * 256 + lane * 4); }
        }
#pragma unroll
        for (int j = 0; j < 8; ++j) { sa += va[j].x * va[j].x + va[j].y * va[j].y + va[j].z * va[j].z + va[j].w * va[j].w; sb += vb[j].x * vb[j].x + vb[j].y * vb[j].y + vb[j].z * vb[j].z + vb[j].w * vb[j].w; }
        sa = wave_sum(sa); sb = wave_sum(sb);
        const float* shA = mod + (size_t)(r < NLAT ? (r >> 11) : 8) * 12288 + moff;
        const bool i8 = GEMM_I8 && (which == 0 || GEMM3_I8); const float lv = which == 0 ? 127.f : 119.f;
        unsigned char* XN8 = (unsigned char*)(p.ws + WS_XN8); float* SXN = (float*)(p.ws + WS_SCL) + SCL_XN;
        if (i8) modulate_store_i8(va, rsqrtf(sa * (1.f / DM) + EPS), g, shA, shA + DM, XN8 + (size_t)r * DM, SXN + r, lane, lv);
        else modulate_store(va, rsqrtf(sa * (1.f / DM) + EPS), g, shA, shA + DM, XN + (size_t)r * DM, lane);
        if (has2) {
            const float* shB = mod + (size_t)(r2 < NLAT ? (r2 >> 11) : 8) * 12288 + moff;
            if (i8) modulate_store_i8(vb, rsqrtf(sb * (1.f / DM) + EPS), g, shB, shB + DM, XN8 + (size_t)r2 * DM, SXN + r2, lane, lv);
            else modulate_store(vb, rsqrtf(sb * (1.f / DM) + EPS), g, shB, shB + DM, XN + (size_t)r2 * DM, lane);
        }
    }
}

struct EpiBf16Store {
    bf16_t* O; int ldc;
    __device__ __forceinline__ void operator()(int row, int col, const float* a) const {
        u32x4 w; w.x = pk2(a[0], a[1]); w.y = pk2(a[2], a[3]); w.z = pk2(a[4], a[5]); w.w = pk2(a[6], a[7]);
        *(u32x4*)(O + (size_t)row * ldc + col) = w;
    }
};
struct EpiResGate {
    const float *resLat, *resCtx; float *outLat, *outCtx; const float* gate;
    __device__ __forceinline__ void operator()(int row, int col, const float* a) const {
        const int bb = row < NLAT ? (row >> 11) : 8;
        const float* gp = gate + (size_t)bb * 12288 + col;
        const float* rp = row < NLAT ? resLat + (size_t)row * DM + col : resCtx + (size_t)(row - NLAT) * DM + col;
        float* op = row < NLAT ? outLat + (size_t)row * DM + col : outCtx + (size_t)(row - NLAT) * DM + col;
        const f32x4 g0 = *(const f32x4*)gp, g1 = *(const f32x4*)(gp + 4), r0 = *(const f32x4*)rp, r1 = *(const f32x4*)(rp + 4);
        f32x4 o0, o1;
        o0.x = r0.x + g0.x * a[0]; o0.y = r0.y + g0.y * a[1]; o0.z = r0.z + g0.z * a[2]; o0.w = r0.w + g0.w * a[3];
        o1.x = r1.x + g1.x * a[4]; o1.y = r1.y + g1.y * a[5]; o1.z = r1.z + g1.z * a[6]; o1.w = r1.w + g1.w * a[7];
        *(f32x4*)op = o0; *(f32x4*)(op + 4) = o1;
    }
};
template <class Epi>
__device__ __forceinline__ void gemm_naive(unsigned char* lds, const bf16_t* A, const bf16_t* Bt, int M, int N, int K, const Epi& E) {
    float* As = (float*)lds;
    float* Bs = As + 32 * 132;
    const int tid = threadIdx.x, tx = tid & 15, ty = tid >> 4;
    const int lrow = tid >> 2, lkc = (tid & 3) * 8;
    const int nM = M / 128, nN = N / 128;
    for (int u = blockIdx.x; u < nM * nN; u += gridDim.x) {
        const int pm = u / nN, pn = u % nN, m0 = pm * 128, n0 = pn * 128;
        float acc[4][8];
#pragma unroll
        for (int i = 0; i < 4; ++i)
#pragma unroll
            for (int j = 0; j < 8; ++j) acc[i][j] = 0.f;
        for (int k0 = 0; k0 < K; k0 += 32) {
            const u32x4 av = *(const u32x4*)(A + (size_t)(m0 + lrow) * K + k0 + lkc);
            const u32x4 bv = *(const u32x4*)(Bt + (size_t)(n0 + lrow) * K + k0 + lkc);
            __syncthreads();
            As[(lkc + 0) * 132 + lrow] = bflo(av.x); As[(lkc + 1) * 132 + lrow] = bfhi(av.x);
            As[(lkc + 2) * 132 + lrow] = bflo(av.y); As[(lkc + 3) * 132 + lrow] = bfhi(av.y);
            As[(lkc + 4) * 132 + lrow] = bflo(av.z); As[(lkc + 5) * 132 + lrow] = bfhi(av.z);
            As[(lkc + 6) * 132 + lrow] = bflo(av.w); As[(lkc + 7) * 132 + lrow] = bfhi(av.w);
            Bs[(lkc + 0) * 132 + lrow] = bflo(bv.x); Bs[(lkc + 1) * 132 + lrow] = bfhi(bv.x);
            Bs[(lkc + 2) * 132 + lrow] = bflo(bv.y); Bs[(lkc + 3) * 132 + lrow] = bfhi(bv.y);
            Bs[(lkc + 4) * 132 + lrow] = bflo(bv.z); Bs[(lkc + 5) * 132 + lrow] = bfhi(bv.z);
            Bs[(lkc + 6) * 132 + lrow] = bflo(bv.w); Bs[(lkc + 7) * 132 + lrow] = bfhi(bv.w);
            __syncthreads();
#pragma unroll 8
            for (int k = 0; k < 32; ++k) {
                const f32x4 a = *(const f32x4*)(As + k * 132 + ty * 4);
                const f32x4 b0 = *(const f32x4*)(Bs + k * 132 + tx * 8), b1 = *(const f32x4*)(Bs + k * 132 + tx * 8 + 4);
                const float av4[4] = {a.x, a.y, a.z, a.w};
                const float bv8[8] = {b0.x, b0.y, b0.z, b0.w, b1.x, b1.y, b1.z, b1.w};
#pragma unroll
                for (int i = 0; i < 4; ++i)
#pragma unroll
                    for (int j = 0; j < 8; ++j) acc[i][j] += av4[i] * bv8[j];
            }
        }
#pragma unroll
        for (int i = 0; i < 4; ++i) E(m0 + ty * 4 + i, n0 + tx * 8, acc[i]);
    }
}

namespace pg8 {
#define PG8_LAS __attribute__((address_space(3)))
typedef unsigned short bf16_t;
typedef short bf16x8 __attribute__((ext_vector_type(8)));
typedef float f32x4 __attribute__((ext_vector_type(4)));
typedef unsigned u32x4 __attribute__((ext_vector_type(4)));
constexpr int BM = 256, BK = 64, HALF = 128, HTB = HALF * BK * 2  , STAGE_BYTES = 8 * HTB, NXCD = 8, WGM = 8;

__host__ __device__ __forceinline__ int lds_byte(int r, int c) { const int st = (r >> 4) * 2 + (c >> 5), rr = r & 15, cc = c & 31, ob = rr * 64 + cc * 2; return st * 1024 + (ob ^ (((ob >> 9) & 1) << 5)); }
__host__ __device__ __forceinline__ void stage_rc(int b, int& R, int& C) { const int st = b / 1024, sb = b % 1024, swz = sb ^ (((sb >> 9) & 1) << 5); R = (st >> 1) * 16 + swz / 64; C = (st & 1) * 32 + (swz % 64) / 2; }
__host__ __device__ __forceinline__ int perm32(int rho) { const int n = rho >> 4, i = rho & 15; return 8 * (i >> 2) + 4 * n + (i & 3); }

struct Unit { int pm, pn; };
struct Gemm { const bf16_t* A; const bf16_t* Bt; int M, N, K; };

struct StaticOrder {
    int nM, nN, nwg, G, c;
    __host__ __device__ void init(int M, int N, int G_, int c_) { nM = M / BM; nN = N / BM; nwg = nM * nN; G = G_; c = c_; }
    __host__ __device__ bool next(int i, Unit& u) const {
        const long L = (long)i * G + c; if (L >= nwg) return false;
        int wgid = (int)L; { const int q = nwg / NXCD, r = nwg % NXCD, xcd = wgid % NXCD, off = wgid / NXCD; wgid = (xcd < r ? xcd * (q + 1) : r * (q + 1) + (xcd - r) * q) + off; }
        const int nig = WGM * nN, gid = wgid / nig, fm = gid * WGM, gsz = (nM - fm) < WGM ? (nM - fm) : WGM;
        u.pm = fm + ((wgid % nig) % gsz); u.pn = (wgid % nig) / gsz; return true;
    }
    __device__ __forceinline__ void a_ready(const Unit&) const {}
    __device__ __forceinline__ void done(const Unit&) const {}
};

__device__ __forceinline__ unsigned cvt_pk_bf16(float lo, float hi) { unsigned r; asm volatile("v_cvt_pk_bf16_f32 %0, %1, %2" : "=v"(r) : "v"(lo), "v"(hi)); return r; }
typedef float f32x2 __attribute__((ext_vector_type(2)));
__device__ __forceinline__ f32x2 gelu_pk(f32x2 v) {
    const f32x2 av = __builtin_elementwise_abs(v), d = av * 0.2316418882f + 1.0f;
    f32x2 t; t.x = __builtin_amdgcn_rcpf(d.x); t.y = __builtin_amdgcn_rcpf(d.y);
    f32x2 q = t * 0.5307027145f + (-0.7265760135f); q = q * t + 0.7107068705f; q = q * t + (-0.142248368f); q = q * t + 0.127414796f; q = q * t;
    const f32x2 s = (v * v) * (-0.72134752044f);
    f32x2 e; e.x = __builtin_amdgcn_exp2f(s.x); e.y = __builtin_amdgcn_exp2f(s.y);
    const f32x2 m = v * (q * e), r = v - m;
    f32x2 o; o.x = v.x < 0.f ? m.x : r.x; o.y = v.y < 0.f ? m.y : r.y; return o;
}

template <int ACT  > struct EpiBf16 {
    static constexpr bool PERM = true, AFTER_DRAIN = false; static_assert(ACT == 0 || ACT == 1, "EpiBf16: ACT is 0 (none) or 1 (gelu_pk)");
    bf16_t* O; int ldc; const float* bias; int split_cols; size_t split_stride; float scale0;
    __device__ __forceinline__ void operator()(const f32x4 (&acc)[2][2][4][2], const Unit& u, int wr, int wc, int fr, int fq) const {
        const int row0 = u.pm * BM + wr * 64 + fr; int colt = u.pn * BM; bf16_t* base = O;
        float sc = 1.f; if (split_cols) { const int t = colt / split_cols; base += (size_t)t * split_stride; colt -= t * split_cols; if (t == 0) sc = scale0; }
        const int col0 = colt + wc * 32 + 8 * fq, bcol0 = u.pn * BM + wc * 32 + 8 * fq;
        f32x4 bv[2][2];
#pragma unroll
        for (int bj = 0; bj < 2; ++bj)
#pragma unroll
            for (int n = 0; n < 2; ++n) bv[bj][n] = bias ? *(const f32x4*)(bias + bcol0 + bj * HALF + 4 * n) : (f32x4){0.f, 0.f, 0.f, 0.f};
#pragma unroll
        for (int ai = 0; ai < 2; ++ai)
#pragma unroll
            for (int m = 0; m < 4; ++m) { bf16_t* rowp = base + (size_t)(row0 + ai * HALF + m * 16) * ldc + col0;
#pragma unroll
                for (int bj = 0; bj < 2; ++bj) { f32x4 v0 = acc[ai][bj][m][0] + bv[bj][0], v1 = acc[ai][bj][m][1] + bv[bj][1];
                    if (ACT == 1) { f32x2 a = gelu_pk((f32x2){v0[0], v0[1]}), b = gelu_pk((f32x2){v0[2], v0[3]}), c = gelu_pk((f32x2){v1[0], v1[1]}), d = gelu_pk((f32x2){v1[2], v1[3]});
                        v0 = (f32x4){a.x, a.y, b.x, b.y}; v1 = (f32x4){c.x, c.y, d.x, d.y}; }
                    v0 = v0 * sc; v1 = v1 * sc; u32x4 w; w.x = cvt_pk_bf16(v0[0], v0[1]); w.y = cvt_pk_bf16(v0[2], v0[3]); w.z = cvt_pk_bf16(v1[0], v1[1]); w.w = cvt_pk_bf16(v1[2], v1[3]);
                    *(u32x4*)(rowp + bj * HALF) = w; } }
    }
};
typedef int i32x4 __attribute__((ext_vector_type(4)));
template <bool I8> struct AccSel { typedef f32x4 type; };
template <> struct AccSel<true> { typedef i32x4 type; };
template <class Epi, class Sched, bool ALIGN_EPI = false, bool SP2 = false, bool I8 = false>
__device__ __forceinline__ void gemm_phase(PG8_LAS unsigned char* lds, const Gemm g, const Sched& S, const Epi& E) {
    const int tid = threadIdx.x, wid = __builtin_amdgcn_readfirstlane(tid >> 6), lane = tid & 63, wr = wid >> 2, wc = wid & 3, fr = lane & 15, fq = lane >> 4;
    const int K = g.K, nt = K / BK;
    unsigned voffA[2], voffB[2];
#pragma unroll
    for (int i = 0; i < 2; ++i) { int R, C; stage_rc(tid * 16 + i * 8192, R, C); const int Rb = Epi::PERM ? ((R & ~31) + perm32(R & 31)) : R;
        voffA[i] = (unsigned)(R * K + C) * 2u; voffB[i] = (unsigned)(Rb * K + C) * 2u; }
    const size_t kstep = (size_t)(BK * 2);
    const size_t hstep = (size_t)HALF * K * 2;
    const size_t tstep = 2 * hstep;
    const unsigned ldsw = (unsigned)wid * 1024u;
    const int aoff = lds_byte(wr * 64 + fr, fq * 8), boff = lds_byte(wc * 32 + fr, fq * 8);
#define PG8_SA(b, h) (((b) * 2 + (h)) * HTB)
#define PG8_SB(b, h) ((4 + (b) * 2 + (h)) * HTB)
#define PG8_STAGE(bufoff, gbase, voff) do { _Pragma("unroll") for (int _i = 0; _i < 2; ++_i) \
        __builtin_amdgcn_global_load_lds((const unsigned*)((const char*)(gbase) + (voff)[_i]), (PG8_LAS unsigned*)(lds + (bufoff) + ldsw + _i * 8192), 16, 0, 0); } while (0)
#define PG8_LDA(dst, b, h) do { _Pragma("unroll") for (int m = 0; m < 4; ++m) _Pragma("unroll") for (int k = 0; k < 2; ++k) dst[m][k] = *(const PG8_LAS bf16x8*)(lds + PG8_SA(b, h) + aoff + m * 2048 + k * 1024); } while (0)
#define PG8_LDB(dst, b, h) do { _Pragma("unroll") for (int n = 0; n < 2; ++n) _Pragma("unroll") for (int k = 0; k < 2; ++k) dst[n][k] = *(const PG8_LAS bf16x8*)(lds + PG8_SB(b, h) + boff + n * 2048 + k * 1024); } while (0)
#define PG8_MMA(ai, bj, At, Bt) do { __builtin_amdgcn_s_setprio(1); _Pragma("unroll") for (int m = 0; m < 4; ++m) _Pragma("unroll") for (int n = 0; n < 2; ++n) _Pragma("unroll") for (int k = 0; k < 2; ++k) \
        { if constexpr (I8) acc[ai][bj][m][n] = __builtin_amdgcn_mfma_i32_16x16x64_i8(__builtin_bit_cast(i32x4, Bt[n][k]), __builtin_bit_cast(i32x4, At[m][k]), acc[ai][bj][m][n], 0, 0, 0); \
          else acc[ai][bj][m][n] = __builtin_amdgcn_mfma_f32_16x16x32_bf16(Bt[n][k], At[m][k], acc[ai][bj][m][n], 0, 0, 0); } __builtin_amdgcn_s_setprio(0); } while (0)
#define PG8_WAIT_V(n) asm volatile("s_waitcnt vmcnt(" #n ")" ::: "memory")
#define PG8_WAIT_L(n) asm volatile("s_waitcnt lgkmcnt(" #n ")" ::: "memory")
#define PG8_BAR __builtin_amdgcn_s_barrier()
#define PG8_SCHED __builtin_amdgcn_sched_barrier(0)
    Unit cur, nxt; int ui = 0;
    if (!S.next(0, cur)) return;
    typedef typename AccSel<I8>::type acc_t; const acc_t zero_ = {};
    acc_t acc[2][2][4][2];
#pragma unroll
    for (int a = 0; a < 2; ++a)
#pragma unroll
        for (int b = 0; b < 2; ++b)
#pragma unroll
            for (int m = 0; m < 4; ++m)
#pragma unroll
                for (int n = 0; n < 2; ++n) acc[a][b][m][n] = zero_;
    bf16x8 At[4][2], B0[2][2], B1[2][2];
    const char* cA = (const char*)g.A + (size_t)cur.pm * tstep; const char* cB = (const char*)g.Bt + (size_t)cur.pn * tstep;
    S.a_ready(cur);
    if constexpr (SP2) {
        PG8_STAGE(PG8_SB(0, 0), cB, voffB); PG8_STAGE(PG8_SB(0, 1), cB + hstep, voffB); PG8_STAGE(PG8_SA(0, 0), cA, voffA); PG8_STAGE(PG8_SA(0, 1), cA + hstep, voffA);
        if (wr == 1) PG8_BAR;
        PG8_WAIT_V(2); PG8_BAR;
        PG8_STAGE(PG8_SB(1, 0), cB + kstep, voffB); PG8_STAGE(PG8_SA(1, 0), cA + kstep, voffA); PG8_STAGE(PG8_SB(1, 1), cB + hstep + kstep, voffB);
        PG8_WAIT_V(6); PG8_BAR;
    } else {
        PG8_STAGE(PG8_SB(0, 0), cB, voffB); PG8_STAGE(PG8_SA(0, 0), cA, voffA); PG8_STAGE(PG8_SB(0, 1), cB + hstep, voffB); PG8_STAGE(PG8_SA(0, 1), cA + hstep, voffA);
        if (wr == 1) PG8_BAR;
        PG8_WAIT_V(4); PG8_BAR;
        PG8_STAGE(PG8_SB(1, 0), cB + kstep, voffB); PG8_STAGE(PG8_SA(1, 0), cA + kstep, voffA); PG8_STAGE(PG8_SB(1, 1), cB + hstep + kstep, voffB);
        PG8_WAIT_V(6); PG8_BAR;
    }
    for (;;) {
        const bool has_next = S.next(ui + 1, nxt);
        const char* nA = has_next ? (const char*)g.A + (size_t)nxt.pm * tstep : cA; const char* nB = has_next ? (const char*)g.Bt + (size_t)nxt.pn * tstep : cB;
        for (int t = 0; t < nt; t += 2) {
            const bool last = (t == nt - 2);
            const char* a1 = cA + (size_t)(t + 1) * kstep;
            const char* a2 = last ? nA : cA + (size_t)(t + 2) * kstep; const char* b2 = last ? nB : cB + (size_t)(t + 2) * kstep;
            const char* a3 = a2 + kstep; const char* b3 = b2 + kstep;
            if (last && has_next) S.a_ready(nxt);
            if constexpr (SP2) {
            PG8_LDB(B0, 0, 0); PG8_LDB(B1, 0, 1); PG8_SCHED; PG8_LDA(At, 0, 0); PG8_STAGE(PG8_SA(1, 1), a1 + hstep, voffA);
            PG8_WAIT_V(8); PG8_WAIT_L(0); PG8_BAR; PG8_MMA(0, 0, At, B0); PG8_MMA(0, 1, At, B1); PG8_BAR; PG8_SCHED;
            PG8_LDA(At, 0, 1); PG8_STAGE(PG8_SB(0, 0), b2, voffB); PG8_STAGE(PG8_SB(0, 1), b2 + hstep, voffB); PG8_STAGE(PG8_SA(0, 0), a2, voffA);
            PG8_WAIT_V(8); PG8_WAIT_L(0); PG8_BAR; PG8_MMA(1, 0, At, B0); PG8_MMA(1, 1, At, B1); PG8_BAR; PG8_SCHED;
            PG8_LDB(B0, 1, 0); PG8_LDB(B1, 1, 1); PG8_SCHED; PG8_LDA(At, 1, 0); PG8_STAGE(PG8_SA(0, 1), a2 + hstep, voffA);
            PG8_WAIT_V(8); PG8_WAIT_L(0); PG8_BAR; PG8_MMA(0, 0, At, B0); PG8_MMA(0, 1, At, B1); PG8_BAR; PG8_SCHED;
            PG8_LDA(At, 1, 1); PG8_STAGE(PG8_SB(1, 0), b3, voffB); PG8_STAGE(PG8_SB(1, 1), b3 + hstep, voffB); PG8_STAGE(PG8_SA(1, 0), a3, voffA);
            PG8_WAIT_V(8); PG8_WAIT_L(0); PG8_BAR; PG8_MMA(1, 0, At, B0); PG8_MMA(1, 1, At, B1); PG8_BAR; PG8_SCHED;
            } else {
            PG8_LDB(B0, 0, 0); PG8_SCHED; PG8_LDA(At, 0, 0); PG8_STAGE(PG8_SA(1, 1), a1 + hstep, voffA);
            PG8_WAIT_L(8); PG8_BAR; PG8_WAIT_L(0); PG8_MMA(0, 0, At, B0); PG8_BAR; PG8_SCHED;
            PG8_LDB(B1, 0, 1); PG8_STAGE(PG8_SB(0, 0), b2, voffB);
            PG8_BAR; PG8_WAIT_L(0); PG8_MMA(0, 1, At, B1); PG8_BAR;
            PG8_LDA(At, 0, 1); PG8_STAGE(PG8_SA(0, 0), a2, voffA);
            PG8_BAR; PG8_WAIT_L(0); PG8_MMA(1, 0, At, B0); PG8_BAR; PG8_SCHED;
            PG8_STAGE(PG8_SB(0, 1), b2 + hstep, voffB);
            PG8_WAIT_V(6); PG8_BAR; PG8_MMA(1, 1, At, B1); PG8_BAR;
            PG8_LDB(B0, 1, 0); PG8_SCHED; PG8_LDA(At, 1, 0); PG8_STAGE(PG8_SA(0, 1), a2 + hstep, voffA);
            PG8_WAIT_L(8); PG8_BAR; PG8_WAIT_L(0); PG8_MMA(0, 0, At, B0); PG8_BAR; PG8_SCHED;
            PG8_LDB(B1, 1, 1); PG8_STAGE(PG8_SB(1, 0), b3, voffB);
            PG8_BAR; PG8_WAIT_L(0); PG8_MMA(0, 1, At, B1); PG8_BAR;
            PG8_LDA(At, 1, 1); PG8_STAGE(PG8_SA(1, 0), a3, voffA);
            PG8_BAR; PG8_WAIT_L(0); PG8_MMA(1, 0, At, B0); PG8_BAR; PG8_SCHED;
            PG8_STAGE(PG8_SB(1, 1), b3 + hstep, voffB);
            PG8_WAIT_V(6); PG8_BAR; PG8_MMA(1, 1, At, B1); PG8_BAR;
            }
        }
        if constexpr (ALIGN_EPI) { if (wr == 0) PG8_BAR; }
        if constexpr (!Epi::AFTER_DRAIN) { E(acc, cur, wr, wc, fr, fq); S.done(cur); }
        if (!has_next) break;
#pragma unroll
        for (int a = 0; a < 2; ++a)
#pragma unroll
            for (int b = 0; b < 2; ++b)
#pragma unroll
                for (int m = 0; m < 4; ++m)
#pragma unroll
                    for (int n = 0; n < 2; ++n) acc[a][b][m][n] = zero_;
        cur = nxt; cA = nA; cB = nB; ++ui;
        if constexpr (ALIGN_EPI) { if (wr == 1) PG8_BAR; }
    }
    PG8_WAIT_V(0);
    if constexpr (!ALIGN_EPI) { if (wr == 0) PG8_BAR; }
    PG8_BAR;
    if constexpr (Epi::AFTER_DRAIN) { E.fused(acc, cur, wr, wc, fr, fq, lds, wid, lane); S.done(cur); }
#undef PG8_SA
#undef PG8_SB
#undef PG8_STAGE
#undef PG8_LDA
#undef PG8_LDB
#undef PG8_MMA
#undef PG8_WAIT_V
#undef PG8_WAIT_L
#undef PG8_BAR
#undef PG8_SCHED
}

struct EpiResGateT {
    static constexpr bool PERM = false, AFTER_DRAIN = false;
    const float *resLat, *resCtx; float *outLat, *outCtx; const float* gate;
    __device__ __forceinline__ void operator()(const f32x4 (&acc)[2][2][4][2], const Unit& u, int wr, int wc, int fr, int fq) const {
        const int trow = u.pm * BM, row0 = trow + wr * 64 + fr, col0 = u.pn * BM + wc * 32 + 4 * fq;
        const bool lat = trow < 16384;
        const int bb = lat ? (trow >> 11) : 8;
        const float* rbase = lat ? resLat + (size_t)row0 * 2048 : resCtx + (size_t)(row0 - 16384) * 2048;
        float* obase = lat ? outLat + (size_t)row0 * 2048 : outCtx + (size_t)(row0 - 16384) * 2048;
        f32x4 gv[2][2];
#pragma unroll
        for (int bj = 0; bj < 2; ++bj)
#pragma unroll
            for (int n = 0; n < 2; ++n) gv[bj][n] = *(const f32x4*)(gate + (size_t)bb * 12288 + col0 + bj * HALF + n * 16);
#pragma unroll
        for (int ai = 0; ai < 2; ++ai)
#pragma unroll
            for (int m = 0; m < 4; ++m) {
                const size_t off = (size_t)(ai * HALF + m * 16) * 2048 + col0;
#pragma unroll
                for (int bj = 0; bj < 2; ++bj)
#pragma unroll
                    for (int n = 0; n < 2; ++n) {
                        const f32x4 r = *(const f32x4*)(rbase + off + bj * HALF + n * 16);
                        *(f32x4*)(obase + off + bj * HALF + n * 16) = r + gv[bj][n] * acc[ai][bj][m][n];
                    }
            }
    }
};

struct EpiBf16I8 {
    static constexpr bool PERM = true, AFTER_DRAIN = false;
    bf16_t* O; int ldc; const float* sa; const float* sb;
    __device__ __forceinline__ void operator()(const i32x4 (&acc)[2][2][4][2], const Unit& u, int wr, int wc, int fr, int fq) const {
        const int row0 = u.pm * BM + wr * 64 + fr, col0 = u.pn * BM + wc * 32 + 8 * fq;
        f32x4 sv[2][2];
#pragma unroll
        for (int bj = 0; bj < 2; ++bj)
#pragma unroll
            for (int n = 0; n < 2; ++n) sv[bj][n] = *(const f32x4*)(sb + col0 + bj * HALF + 4 * n);
#pragma unroll
        for (int ai = 0; ai < 2; ++ai)
#pragma unroll
            for (int m = 0; m < 4; ++m) {
                const int row = row0 + ai * HALF + m * 16; const float s = sa[row];
                bf16_t* rowp = O + (size_t)row * ldc + col0;
#pragma unroll
                for (int bj = 0; bj < 2; ++bj) {
                    const i32x4 a0 = acc[ai][bj][m][0], a1 = acc[ai][bj][m][1];
                    const f32x4 v0 = (f32x4){(float)a0.x, (float)a0.y, (float)a0.z, (float)a0.w} * s * sv[bj][0];
                    const f32x4 v1 = (f32x4){(float)a1.x, (float)a1.y, (float)a1.z, (float)a1.w} * s * sv[bj][1];
                    u32x4 w; w.x = cvt_pk_bf16(v0[0], v0[1]); w.y = cvt_pk_bf16(v0[2], v0[3]); w.z = cvt_pk_bf16(v1[0], v1[1]); w.w = cvt_pk_bf16(v1[2], v1[3]);
                    *(u32x4*)(rowp + bj * HALF) = w;
                }
            }
    }
};
struct EpiResGateI8 {
    static constexpr bool PERM = false, AFTER_DRAIN = false;
    const float *resLat, *resCtx; float *outLat, *outCtx; const float* gate; const float* sa; const float* sb;
    __device__ __forceinline__ void operator()(const i32x4 (&acc)[2][2][4][2], const Unit& u, int wr, int wc, int fr, int fq) const {
        const int trow = u.pm * BM, row0 = trow + wr * 64 + fr, col0 = u.pn * BM + wc * 32 + 4 * fq;
        const bool lat = trow < 16384;
        const int bb = lat ? (trow >> 11) : 8;
        const float* rbase = lat ? resLat + (size_t)row0 * 2048 : resCtx + (size_t)(row0 - 16384) * 2048;
        float* obase = lat ? outLat + (size_t)row0 * 2048 : outCtx + (size_t)(row0 - 16384) * 2048;
        f32x4 gv[2][2];
#pragma unroll
        for (int bj = 0; bj < 2; ++bj)
#pragma unroll
            for (int n = 0; n < 2; ++n) gv[bj][n] = *(const f32x4*)(gate + (size_t)bb * 12288 + col0 + bj * HALF + n * 16) * *(const f32x4*)(sb + col0 + bj * HALF + n * 16);
#pragma unroll
        for (int ai = 0; ai < 2; ++ai)
#pragma unroll
            for (int m = 0; m < 4; ++m) {
                const size_t off = (size_t)(ai * HALF + m * 16) * 2048 + col0;
                const float s = sa[row0 + ai * HALF + m * 16];
#pragma unroll
                for (int bj = 0; bj < 2; ++bj)
#pragma unroll
                    for (int n = 0; n < 2; ++n) {
                        const f32x4 r = *(const f32x4*)(rbase + off + bj * HALF + n * 16);
                        const i32x4 a = acc[ai][bj][m][n];
                        *(f32x4*)(obase + off + bj * HALF + n * 16) = r + gv[bj][n] * ((f32x4){(float)a.x, (float)a.y, (float)a.z, (float)a.w} * s);
                    }
            }
    }
};

struct EpiResGateI8B {
    static constexpr bool PERM = true, AFTER_DRAIN = false;
    const float *resLat, *resCtx;
    bf16_t* hb; const float* gate; const float* sa; const float* sb;
    __device__ __forceinline__ void operator()(const i32x4 (&acc)[2][2][4][2], const Unit& u, int wr, int wc, int fr, int fq) const {
        const int trow = u.pm * BM, row0 = trow + wr * 64 + fr, col0 = u.pn * BM + wc * 32 + 8 * fq;
        const bool lat = trow < 16384;
        const int bb = lat ? (trow >> 11) : 8;
        f32x4 gv[2][2];
#pragma unroll
        for (int bj = 0; bj < 2; ++bj)
#pragma unroll
            for (int n = 0; n < 2; ++n) gv[bj][n] = *(const f32x4*)(gate + (size_t)bb * 12288 + col0 + bj * HALF + 4 * n) * *(const f32x4*)(sb + col0 + bj * HALF + 4 * n);
#pragma unroll
        for (int ai = 0; ai < 2; ++ai)
#pragma unroll
            for (int m = 0; m < 4; ++m) {
                const int row = row0 + ai * HALF + m * 16; const float s = sa[row];
                bf16_t* hp = hb + (size_t)row * 2048 + col0;
#pragma unroll
                for (int bj = 0; bj < 2; ++bj) {
                    f32x4 r0, r1;
                    if (resLat) {
                        const float* rp = (lat ? resLat + (size_t)row * 2048 : resCtx + (size_t)(row - 16384) * 2048) + col0 + bj * HALF;
                        r0 = *(const f32x4*)rp; r1 = *(const f32x4*)(rp + 4);
                    } else {
                        const u32x4 q = *(const u32x4*)(hp + bj * HALF);
                        r0 = (f32x4){__uint_as_float(q.x << 16), __uint_as_float(q.x & 0xffff0000u), __uint_as_float(q.y << 16), __uint_as_float(q.y & 0xffff0000u)};
                        r1 = (f32x4){__uint_as_float(q.z << 16), __uint_as_float(q.z & 0xffff0000u), __uint_as_float(q.w << 16), __uint_as_float(q.w & 0xffff0000u)};
                    }
                    const i32x4 a0 = acc[ai][bj][m][0], a1 = acc[ai][bj][m][1];
                    const f32x4 v0 = r0 + (gv[bj][0] * s) * (f32x4){(float)a0.x, (float)a0.y, (float)a0.z, (float)a0.w};
                    const f32x4 v1 = r1 + (gv[bj][1] * s) * (f32x4){(float)a1.x, (float)a1.y, (float)a1.z, (float)a1.w};
                    u32x4 w; w.x = cvt_pk_bf16(v0[0], v0[1]); w.y = cvt_pk_bf16(v0[2], v0[3]); w.z = cvt_pk_bf16(v1[0], v1[1]); w.w = cvt_pk_bf16(v1[2], v1[3]);
                    *(u32x4*)(hp + bj * HALF) = w;
                }
            }
    }
};
}
#ifndef USE_PG8
#define USE_PG8 1
#endif

__device__ __forceinline__ float sum16(float v) { v += __shfl_xor(v, 1); v += __shfl_xor(v, 2); v += __shfl_xor(v, 4); v += __shfl_xor(v, 8); return v; }
__device__ __forceinline__ void ph_prep(const Params& p, int l, const bool dry) {
    const int tid = threadIdx.x, lane = tid & 63, wave = tid >> 6, sub = lane >> 4, li = lane & 15;
    const int gw = blockIdx.x * NWAVES + wave, NGW = gridDim.x * NWAVES;
    bf16_t* P = (bf16_t*)(p.ws + WS_P);
    const float* rope = (const float*)(p.ws + WS_ROPE);
    const bool last = (l == DEPTH - 1);
    const int f0 = (li >= 8 ? 32 : 0) + 8 * (li & 3);
    const float sg = (li & 4) ? 1.f : -1.f;
#pragma unroll 1
    for (int r = gw; r < MTOT; r += NGW) {
        bf16_t* row = P + (size_t)r * INW;
        bf16_t* wrow = dry ? (bf16_t*)(p.ws + WS_DUMMY) + (size_t)r * INW : row;
        const bool isctx = r >= NLAT;
        const int t = r & (SEQ - 1);
        float cs[8], sn[8];
        if (!isctx) {
            const f32x4* rp = (const f32x4*)(rope + ((size_t)t * 64 + f0) * 2);
            const f32x4 a = rp[0], b = rp[1], c = rp[2], d = rp[3];
            cs[0] = a.x; sn[0] = a.y; cs[1] = a.z; sn[1] = a.w; cs[2] = b.x; sn[2] = b.y; cs[3] = b.z; sn[3] = b.w;
            cs[4] = c.x; sn[4] = c.y; cs[5] = c.z; sn[5] = c.w; cs[6] = d.x; sn[6] = d.y; cs[7] = d.z; sn[7] = d.w;
        } else {
#pragma unroll
            for (int i = 0; i < 8; ++i) { cs[i] = 1.f; sn[i] = 0.f; }
        }
        u32x4 raw[7];
#pragma unroll
        for (int gI = 0; gI < 7; ++gI) raw[gI] = *(const u32x4*)(row + (gI * 4 + sub) * 128 + li * 8);
#pragma unroll
        for (int gI = 0; gI < 7; ++gI) {
            const int slot = gI * 4 + sub;
            const int kind = slot < 8 ? 0 : slot < 10 ? 1 : slot < 18 ? 0 : slot < 20 ? 1 : slot < 24 ? 2 : 3;
            const bool isq = slot < 6 || (slot >= 10 && slot < 16);
            float x[8];
            x[0] = bflo(raw[gI].x); x[1] = bfhi(raw[gI].x); x[2] = bflo(raw[gI].y); x[3] = bfhi(raw[gI].y);
            x[4] = bflo(raw[gI].z); x[5] = bfhi(raw[gI].z); x[6] = bflo(raw[gI].w); x[7] = bfhi(raw[gI].w);
            if (kind >= 2) {
#pragma unroll
                for (int i = 0; i < 8; ++i) x[i] = gelu_tanh(x[i]);
            }
            float ss = 0.f;
#pragma unroll
            for (int i = 0; i < 8; ++i) ss += x[i] * x[i];
            ss = sum16(ss);
            const float rstd = rsqrtf(ss * (1.f / 128.f) + EPS);
            const float* gain = slot < 6 ? p.qn_a + l * 128 : slot < 8 ? p.kn_a + l * 128 : slot < 16 ? p.qn_b + l * 128 : slot < 20 ? p.kn_b + l * 128 : p.vn_c + l * 512 + (slot - 24) * 128;
            if (kind == 0 || kind == 3) {
                const f32x4 g0 = *(const f32x4*)(gain + li * 8), g1 = *(const f32x4*)(gain + li * 8 + 4);
                x[0] *= rstd * g0.x; x[1] *= rstd * g0.y; x[2] *= rstd * g0.z; x[3] *= rstd * g0.w;
                x[4] *= rstd * g1.x; x[5] *= rstd * g1.y; x[6] *= rstd * g1.z; x[7] *= rstd * g1.w;
            }
            float px[8];
#pragma unroll
            for (int i = 0; i < 8; ++i) px[i] = __shfl_xor(x[i], 4);
            if (kind == 0) {
#pragma unroll
                for (int i = 0; i < 8; ++i) x[i] = x[i] * cs[i] + sg * px[i] * sn[i];
            }
            bool wr = kind != 1;
            if (isctx && last && (isq || kind >= 2)) wr = false;
            if (wr) { u32x4 o; o.x = pk2(x[0], x[1]); o.y = pk2(x[2], x[3]); o.z = pk2(x[4], x[5]); o.w = pk2(x[6], x[7]); *(u32x4*)(wrow + slot * 128 + li * 8) = o; }
        }
    }
}

__device__ __forceinline__ void attn_row_naive(const bf16_t* q, const bf16_t* kc, const bf16_t* vc, const bf16_t* kl, const bf16_t* vl, int j0, int j1,
                                               bool has_sink, float sink, bf16_t* o, int lane) {
    const unsigned qq = *(const unsigned*)(q + 2 * lane);
    const float q0 = bflo(qq), q1 = bfhi(qq);
    float m = -INFINITY, lsum = 0.f, o0 = 0.f, o1 = 0.f;
    const int ntot = NCTX + (j1 - j0);
    for (int j = 0; j < ntot; ++j) {
        const bf16_t* kp = j < NCTX ? kc + (size_t)j * INW : kl + (size_t)(j0 + j - NCTX) * INW;
        const bf16_t* vp = j < NCTX ? vc + (size_t)j * INW : vl + (size_t)(j0 + j - NCTX) * INW;
        const unsigned kk = *(const unsigned*)(kp + 2 * lane), vv = *(const unsigned*)(vp + 2 * lane);
        const float s = wave_sum(q0 * bflo(kk) + q1 * bfhi(kk)) * ATT_SCALE;
        const float mn = fmaxf(m, s);
        const float a = __expf(m - mn), pp = __expf(s - mn);
        lsum = lsum * a + pp; o0 = o0 * a + pp * bflo(vv); o1 = o1 * a + pp * bfhi(vv);
        m = mn;
    }
    if (has_sink) {
        const float mn = fmaxf(m, sink);
        const float a = __expf(m - mn);
        lsum = lsum * a + __expf(sink - mn); o0 *= a; o1 *= a;
    }
    const float inv = 1.f / lsum;
    *(unsigned*)(o + 2 * lane) = pk2(o0 * inv, o1 * inv);
}

__device__ __forceinline__ void ph_mixers_naive(const Params& p, int l, unsigned char* lds) {
    const int tid = threadIdx.x, lane = tid & 63, wave = tid >> 6;
    const int gw = blockIdx.x * NWAVES + wave, NGW = gridDim.x * NWAVES;
    const bf16_t* P = (const bf16_t*)(p.ws + WS_P);
    bf16_t* Y = (bf16_t*)(p.ws + WS_Y);
    const bool last = (l == DEPTH - 1);
    const int T_LA = NLAT * 6, T_LB = NLAT * 6, T_CA = last ? 0 : NCT * 6, T_CB = last ? 0 : NCT * 6;
    const int ntask = T_LA + T_LB + T_CA + T_CB;
    for (int tk = gw; tk < ntask; tk += NGW) {
        int r = tk;
        if (r < T_LA + T_LB) {
            const bool isB = r >= T_LA; if (isB) r -= T_LA;
            const int b = r / (6 * SEQ), h = (r / SEQ) % 6, t = r % SEQ, kv = h / 3;
            const size_t row = (size_t)b * SEQ + t, crow0 = (size_t)NLAT + (size_t)b * NCTX, lrow0 = (size_t)b * SEQ;
            const int cq = isB ? C_QB : C_QA, ck = isB ? C_KB : C_KA, cvv = isB ? C_VB : C_VA;
            int j0 = 0, j1 = SEQ;
            if (isB) { j0 = t - 128 < 0 ? 0 : t - 128; j1 = t + 129 > SEQ ? SEQ : t + 129; }
            attn_row_naive(P + row * INW + cq + h * 128, P + crow0 * INW + ck + kv * 128, P + crow0 * INW + cvv + kv * 128,
                           P + lrow0 * INW + ck + kv * 128, P + lrow0 * INW + cvv + kv * 128, j0, j1, isB, isB ? p.sink_b[l * 6 + h] : 0.f,
                           Y + row * DM + (isB ? 768 : 0) + h * 128, lane);
        } else {
            r -= T_LA + T_LB;
            const bool isB = r >= T_CA; if (isB) r -= T_CA;
            const int b = r / (6 * NCTX), h = (r / NCTX) % 6, t = r % NCTX, kv = h / 3;
            const size_t crow0 = (size_t)NLAT + (size_t)b * NCTX, row = crow0 + t;
            const int cq = isB ? C_QB : C_QA, ck = isB ? C_KB : C_KA, cvv = isB ? C_VB : C_VA;
            attn_row_naive(P + row * INW + cq + h * 128, P + crow0 * INW + ck + kv * 128, P + crow0 * INW + cvv + kv * 128,
                           P, P, 0, 0, isB, isB ? p.sink_b[l * 6 + h] : 0.f, Y + row * DM + (isB ? 768 : 0) + h * 128, lane);
        }
    }
    __syncthreads();
    float* Wl = (float*)lds;
    float* Vl = Wl + 128 * 128;
    const int nchunk = last ? NLAT / 128 : MTOT / 128;
    for (int u = blockIdx.x; u < nchunk * 4; u += gridDim.x) {
        const int ch = u >> 2, g = u & 3; const size_t row0 = (size_t)ch * 128;
        __syncthreads();
        for (int i = tid; i < 128 * 128; i += NTHREADS) {
            Wl[i] = p.ws_c[((size_t)l * 4 + g) * 16384 + i];
            const int q = i >> 7, c = i & 127;
            Vl[i] = bf2f(P[(row0 + q) * INW + C_VC + g * 128 + c]);
        }
        __syncthreads();
        const int c = tid & 127, pg = tid >> 7;
        for (int pp = pg * 32; pp < pg * 32 + 32; ++pp) {
            float s = 0.f;
#pragma unroll 8
            for (int q = 0; q < 128; ++q) s += Wl[pp * 128 + q] * Vl[q * 128 + c];
            s += p.bs_c[((size_t)l * 4 + g) * 128 + pp];
            const float uu = bf2f(P[(row0 + pp) * INW + C_UC + g * 128 + c]);
            Y[(row0 + pp) * DM + 1536 + g * 128 + c] = (bf16_t)f2bf(uu * s);
        }
    }
}


namespace att {
constexpr float SCALE = 0.088388347648318440f;
constexpr float THR = 8.f;
constexpr int D = 128, NW = 8, QBLK = 32, KVBLK = 64;
#ifndef ATT_SDEPTH
#define ATT_SDEPTH 2
#endif
constexpr int SDEPTH = ATT_SDEPTH;
constexpr int LDQ = INW, LDK = INW, LDO = DM;
constexpr size_t SHM_V = KVBLK * D * 2, SHM_K = KVBLK * D * 2, SHM_ATTN = 2 * SHM_V + 2 * SHM_K + NW * 64 * 4;
using bf16x8 = __attribute__((ext_vector_type(8))) short;
using s16x4  = __attribute__((ext_vector_type(4))) short;
using f32x16 = __attribute__((ext_vector_type(16))) float;
using f32x8  = __attribute__((ext_vector_type(8))) float;

#define KSWZ(row, colB) ((row) * 256 + ((colB) ^ (((row) & 7) << 4)))
#define SBAR() __builtin_amdgcn_sched_barrier(0)
__device__ __forceinline__ int crow(int r, int hi) { return (r & 3) + 8 * (r >> 2) + 4 * hi; }
__device__ __forceinline__ unsigned cvtpk(float lo, float hi) {
  unsigned r; asm volatile("v_cvt_pk_bf16_f32 %0, %1, %2" : "=v"(r) : "v"(lo), "v"(hi)); return r;
}

__device__ __forceinline__ void partialSM(f32x16& p0, f32x16& p1, float& m_reg, float& mn, float& alpha) {
  constexpr float C = SCALE * 1.4426950408889634f;
  float pmax = p0[0]; for (int r = 1; r < 16; ++r) pmax = fmaxf(pmax, p0[r]); for (int r = 0; r < 16; ++r) pmax = fmaxf(pmax, p1[r]);
  { auto rr = __builtin_amdgcn_permlane32_swap(__float_as_uint(pmax), __float_as_uint(pmax), false, false);
    pmax = fmaxf(__uint_as_float(rr[0]), __uint_as_float(rr[1])); }
  if (__builtin_expect(__all(pmax - m_reg <= THR / SCALE), 1)) { mn = m_reg; alpha = 1.f; }
  else { mn = fmaxf(m_reg, pmax); alpha = __builtin_amdgcn_exp2f((m_reg - mn) * C); m_reg = mn; }
  float mnC = -mn * C;
  for (int r = 0; r < 16; ++r) p0[r] = fmaf(p0[r], C, mnC); for (int r = 0; r < 16; ++r) p1[r] = fmaf(p1[r], C, mnC);
  for (int r = 0; r < 16; ++r) p0[r] = __builtin_amdgcn_exp2f(p0[r]);
}
__device__ __forceinline__ void finishSM(f32x16& p0, f32x16& p1, float alpha, float& l_reg, bf16x8& pa0, bf16x8& pa1, bf16x8& pa2, bf16x8& pa3) {
  for (int r = 0; r < 16; ++r) p1[r] = __builtin_amdgcn_exp2f(p1[r]);
  float ps = 0; for (int r = 0; r < 16; ++r) ps += p0[r]; for (int r = 0; r < 16; ++r) ps += p1[r];
  { auto rr = __builtin_amdgcn_permlane32_swap(__float_as_uint(ps), __float_as_uint(ps), false, false);
    ps = __uint_as_float(rr[0]) + __uint_as_float(rr[1]); }
  l_reg = l_reg * alpha + ps;
#define PK4(P, BASE, OUT) do { unsigned a0 = cvtpk(P[BASE + 0], P[BASE + 1]), a1 = cvtpk(P[BASE + 2], P[BASE + 3]);   \
    unsigned b0 = cvtpk(P[BASE + 4], P[BASE + 5]), b1 = cvtpk(P[BASE + 6], P[BASE + 7]);                              \
    auto r0 = __builtin_amdgcn_permlane32_swap(a0, b0, false, false); auto r1 = __builtin_amdgcn_permlane32_swap(a1, b1, false, false); \
    u32x4 w = {r0[0], r1[0], r0[1], r1[1]}; OUT = *reinterpret_cast<bf16x8*>(&w); } while (0)
  PK4(p0, 0, pa0); PK4(p0, 8, pa1); PK4(p1, 0, pa2); PK4(p1, 8, pa3);
#undef PK4
}
__device__ __forceinline__ void qkt(f32x16& p0, f32x16& p1, const bf16_t* Ks, const bf16x8* qr, int r32, int hi) {
  p0 = f32x16{}; p1 = f32x16{};
  for (int d0 = 0; d0 < 8; ++d0) { int cb = (d0 * 16 + hi * 8) * 2;
    bf16x8 b0 = *reinterpret_cast<const bf16x8*>((const char*)Ks + KSWZ(r32, cb));
    bf16x8 b1 = *reinterpret_cast<const bf16x8*>((const char*)Ks + KSWZ(32 + r32, cb));
    p0 = __builtin_amdgcn_mfma_f32_32x32x16_bf16(b0, qr[d0], p0, 0, 0, 0);
    p1 = __builtin_amdgcn_mfma_f32_32x32x16_bf16(b1, qr[d0], p1, 0, 0, 0); }
}
__device__ __forceinline__ int v_st(int k, int c) { const int kk = (k & ~0xC) | ((k & 4) << 1) | ((k & 8) >> 1); return ((kk >> 3) * 4 + (c >> 5)) * 512 + ((kk & 7) * 32 + (c & 31)) * 2; }
__device__ __forceinline__ int v_rd_base(int lane) { return ((lane & 3) << 3) | (((lane >> 2) & 3) << 6) | (((lane >> 4) & 1) << 5) | (((lane >> 5) & 1) << 8); }
constexpr int v_rd_off(int d0, int ks, int half) { return d0 * 512 + ks * 4096 + half * 2048; }
template <int OFF> __device__ __forceinline__ s16x4 tr_read(int vb) {
  s16x4 r; asm volatile("ds_read_b64_tr_b16 %0, %1 offset:%2" : "=&v"(r) : "v"(vb), "i"(OFF) : "memory"); return r;
}
template <int D0> __device__ __forceinline__ void pv_one(f32x16& od, int vb, bf16x8 pa0, bf16x8 pa1, bf16x8 pa2, bf16x8 pa3) {
  const s16x4 l0 = tr_read<v_rd_off(D0, 0, 0)>(vb), h0 = tr_read<v_rd_off(D0, 0, 1)>(vb), l1 = tr_read<v_rd_off(D0, 1, 0)>(vb), h1 = tr_read<v_rd_off(D0, 1, 1)>(vb);
  const s16x4 l2 = tr_read<v_rd_off(D0, 2, 0)>(vb), h2 = tr_read<v_rd_off(D0, 2, 1)>(vb), l3 = tr_read<v_rd_off(D0, 3, 0)>(vb), h3 = tr_read<v_rd_off(D0, 3, 1)>(vb);
  asm volatile("s_waitcnt lgkmcnt(0)" ::: "memory"); SBAR();
#define PK(L, H) (bf16x8){L[0], L[1], L[2], L[3], H[0], H[1], H[2], H[3]}
  od = __builtin_amdgcn_mfma_f32_32x32x16_bf16(pa0, PK(l0, h0), od, 0, 0, 0);
  od = __builtin_amdgcn_mfma_f32_32x32x16_bf16(pa1, PK(l1, h1), od, 0, 0, 0);
  od = __builtin_amdgcn_mfma_f32_32x32x16_bf16(pa2, PK(l2, h2), od, 0, 0, 0);
  od = __builtin_amdgcn_mfma_f32_32x32x16_bf16(pa3, PK(l3, h3), od, 0, 0, 0);
#undef PK
}
__device__ __forceinline__ void pv_d0(f32x16* o, int vb, bf16x8 pa0, bf16x8 pa1, bf16x8 pa2, bf16x8 pa3) {
  pv_one<0>(o[0], vb, pa0, pa1, pa2, pa3); pv_one<1>(o[1], vb, pa0, pa1, pa2, pa3); pv_one<2>(o[2], vb, pa0, pa1, pa2, pa3); pv_one<3>(o[3], vb, pa0, pa1, pa2, pa3);
}

__device__ __forceinline__ void attn_unit(const bool MASK, const bf16_t* __restrict__ Qb, const bf16_t* __restrict__ Kc, const bf16_t* __restrict__ Vc,
                                          const bf16_t* __restrict__ Kl, const bf16_t* __restrict__ Vl, int nlt, int qpos0, int kpos0,
                                          bool has_sink, float sink, bf16_t* __restrict__ Ob, char* lds) {
  int tid_ = threadIdx.x; asm volatile("" : "+v"(tid_));
  const int tid = tid_, wid = tid >> 6, lane = tid & 63, r32 = lane & 31, hi = lane >> 5;
  bf16_t* V_lds = (bf16_t*)lds; bf16_t* K_lds = (bf16_t*)(lds + 2 * SHM_V);
  float* ws = (float*)(lds + 2 * SHM_V + 2 * SHM_K) + wid * 64; float* li_l = ws; float* al_l = ws + 32;
  float m_reg = -1e30f, l_reg = 0; f32x16 o[4] = {}; bf16x8 qr[8];
  const bf16_t* Qw = Qb + (long)(wid * QBLK + r32) * LDQ + hi * 8;
#pragma unroll
  for (int d0 = 0; d0 < 8; ++d0) qr[d0] = *reinterpret_cast<const bf16x8*>(Qw + d0 * 16);
  const int sr = tid >> 4, sc = (tid & 15) * 8, vst0 = v_st(sr, sc), vst1 = v_st(32 + sr, sc);
  const int vb0 = (int)(uintptr_t)V_lds + v_rd_base(lane);
  struct { bf16x8 vs0, vs1, ks0, ks1; } sr_[SDEPTH];
  const int qpos = qpos0 + wid * QBLK + r32;
#define KVP(t, KP, VP) const bf16_t* KP = ((t) < 4 ? Kc + (long)(t) * KVBLK * LDK : Kl + (long)((t) - 4) * KVBLK * LDK); const bf16_t* VP = ((t) < 4 ? Vc + (long)(t) * KVBLK * LDK : Vl + (long)((t) - 4) * KVBLK * LDK)
#define SLOAD(i, t) do { KVP(t, kp_, vp_); sr_[i].vs0 = *reinterpret_cast<const bf16x8*>(&vp_[(long)sr * LDK + sc]); sr_[i].vs1 = *reinterpret_cast<const bf16x8*>(&vp_[(long)(32 + sr) * LDK + sc]); \
    sr_[i].ks0 = *reinterpret_cast<const bf16x8*>(&kp_[(long)sr * LDK + sc]); sr_[i].ks1 = *reinterpret_cast<const bf16x8*>(&kp_[(long)(32 + sr) * LDK + sc]); } while (0)
#define SWRITE(b, i) do { *(bf16x8*)((char*)V_lds + (b) * SHM_V + vst0) = sr_[i].vs0;          \
    *(bf16x8*)((char*)V_lds + (b) * SHM_V + vst1) = sr_[i].vs1; int kc = sc * 2;               \
    *(bf16x8*)((char*)K_lds + (b) * SHM_K + KSWZ(sr, kc)) = sr_[i].ks0;                       \
    *(bf16x8*)((char*)K_lds + (b) * SHM_K + KSWZ(32 + sr, kc)) = sr_[i].ks1; } while (0)
#define SWAIT() do { if constexpr (SDEPTH == 2) asm volatile("s_waitcnt vmcnt(4)" ::: "memory"); else asm volatile("s_waitcnt vmcnt(0)" ::: "memory"); } while (0)
#define RESC(a) do { if (__any((a) < 1.f)) { if (hi == 0) al_l[r32] = (a); asm volatile("s_waitcnt lgkmcnt(0)" ::: "memory"); \
    for (int d = 0; d < 4; ++d) for (int r = 0; r < 16; ++r) o[d][r] *= al_l[crow(r, hi)]; } } while (0)
#define WMASK(P0, P1, t) do { if (MASK && (t) >= 4) { const int kb_ = kpos0 + ((t) - 4) * KVBLK + 4 * hi - qpos; \
    _Pragma("unroll") for (int r = 0; r < 16; ++r) { const int dk = kb_ + (r & 3) + 8 * (r >> 2); \
      if (dk > 128 || dk < -128) P0[r] = -1e30f; if (dk + 32 > 128 || dk + 32 < -128) P1[r] = -1e30f; } } } while (0)
  f32x16 pA0, pA1, pB0, pB1; float mnA, mnB, alA, alB; bf16x8 pa0, pa1, pa2, pa3; const int NT = 4 + nlt;
  constexpr int SE = 0, SO = SDEPTH - 1;
  SLOAD(SE, 0); asm volatile("s_waitcnt vmcnt(0)" ::: "memory"); SWRITE(0, SE); __syncthreads();
  qkt(pA0, pA1, K_lds, qr, r32, hi); partialSM(pA0, pA1, m_reg, mnA, alA);
  SLOAD(SO, 1); if constexpr (SDEPTH == 2) { if (2 < NT) SLOAD(SE, 2); }
  SWAIT(); SWRITE(1, SO); __syncthreads();
  for (int j = 1; j + 1 < NT; j += 2) {
    SBAR(); qkt(pB0, pB1, (bf16_t*)((char*)K_lds + SHM_K), qr, r32, hi); WMASK(pB0, pB1, j);
    finishSM(pA0, pA1, alA, l_reg, pa0, pa1, pa2, pa3); SBAR();
    SLOAD(SO, j + SDEPTH); SBAR();
    pv_d0(o, vb0, pa0, pa1, pa2, pa3); partialSM(pB0, pB1, m_reg, mnB, alB);
    __syncthreads(); SWAIT(); SWRITE(0, SE);
    RESC(alB); __syncthreads();
    SBAR(); qkt(pA0, pA1, K_lds, qr, r32, hi); WMASK(pA0, pA1, j + 1);
    finishSM(pB0, pB1, alB, l_reg, pa0, pa1, pa2, pa3); SBAR();
    if (SDEPTH == 1 || j + 3 < NT) SLOAD(SE, j + 1 + SDEPTH); SBAR();
    pv_d0(o, vb0 + (int)SHM_V, pa0, pa1, pa2, pa3); partialSM(pA0, pA1, m_reg, mnA, alA);
    __syncthreads(); SWAIT(); SWRITE(1, SO);
    RESC(alA); __syncthreads();
  }
  SBAR(); qkt(pB0, pB1, (bf16_t*)((char*)K_lds + SHM_K), qr, r32, hi); WMASK(pB0, pB1, NT - 1);
  finishSM(pA0, pA1, alA, l_reg, pa0, pa1, pa2, pa3); SBAR();
  pv_d0(o, vb0, pa0, pa1, pa2, pa3); partialSM(pB0, pB1, m_reg, mnB, alB);
  __syncthreads(); RESC(alB);
  finishSM(pB0, pB1, alB, l_reg, pa0, pa1, pa2, pa3); SBAR();
  pv_d0(o, vb0 + (int)SHM_V, pa0, pa1, pa2, pa3);
  if (has_sink) l_reg += __builtin_amdgcn_exp2f(sink * 1.4426950408889634f - m_reg * (SCALE * 1.4426950408889634f));
  if (hi == 0) li_l[r32] = l_reg; asm volatile("s_waitcnt lgkmcnt(0)" ::: "memory");
  float rli[16];
#pragma unroll
  for (int r = 0; r < 16; ++r) rli[r] = __builtin_amdgcn_rcpf(li_l[crow(r, hi)]);
  bf16_t* Ow = Ob + (long)(wid * QBLK) * LDO;
  char* stg = (char*)K_lds + wid * 4096;
#pragma unroll
  for (int hf = 0; hf < 2; ++hf) {
#pragma unroll
    for (int r = 0; r < 16; ++r) { const int orow = crow(r, hi);
#pragma unroll
      for (int dd = 0; dd < 2; ++dd) *(bf16_t*)(stg + orow * 128 + (dd * 32 + r32) * 2) = (bf16_t)f2bf(o[hf * 2 + dd][r] * rli[r]); }
    asm volatile("s_waitcnt lgkmcnt(0)" ::: "memory");
    const int rr = lane >> 1, hb = lane & 1;
    const u32x4 v0 = *(const u32x4*)(stg + rr * 128 + hb * 64), v1 = *(const u32x4*)(stg + rr * 128 + hb * 64 + 16);
    const u32x4 v2 = *(const u32x4*)(stg + rr * 128 + hb * 64 + 32), v3 = *(const u32x4*)(stg + rr * 128 + hb * 64 + 48);
    bf16_t* dst = Ow + (long)rr * LDO + hf * 64 + hb * 32;
    *(u32x4*)dst = v0; *(u32x4*)(dst + 8) = v1; *(u32x4*)(dst + 16) = v2; *(u32x4*)(dst + 24) = v3;
  }
  __syncthreads();
#undef KVP
#undef SLOAD
#undef SWRITE
#undef SWAIT
#undef RESC
#undef WMASK
}
#undef KSWZ
#undef SBAR
}


__device__ __forceinline__ void cmlp_unit_naive(const Params& p, int l, int ch, int g, unsigned char* lds) {
    int tid_ = threadIdx.x; asm volatile("" : "+v"(tid_));
    const int tid = tid_;
    const bf16_t* P = (const bf16_t*)(p.ws + WS_P);
    bf16_t* Y = (bf16_t*)(p.ws + WS_Y);
    float* Wl = (float*)lds;
    float* Vl = Wl + 128 * 128;
    const size_t row0 = (size_t)ch * 128;
    __syncthreads();
    for (int i = tid; i < 128 * 128; i += NTHREADS) {
        Wl[i] = p.ws_c[((size_t)l * 4 + g) * 16384 + i];
        const int q = i >> 7, c = i & 127;
        Vl[i] = bf2f(P[(row0 + q) * INW + C_VC + g * 128 + c]);
    }
    __syncthreads();
    const int c = tid & 127, pg = tid >> 7;
    for (int pp = pg * 32; pp < pg * 32 + 32; ++pp) {
        float s = 0.f;
#pragma unroll 8
        for (int q = 0; q < 128; ++q) s += Wl[pp * 128 + q] * Vl[q * 128 + c];
        s += p.bs_c[((size_t)l * 4 + g) * 128 + pp];
        const float uu = bf2f(P[(row0 + pp) * INW + C_UC + g * 128 + c]);
        Y[(row0 + pp) * DM + 1536 + g * 128 + c] = (bf16_t)f2bf(uu * s);
    }
    __syncthreads();
}


__device__ __forceinline__ void cmlp_unit_fast(const Params& p, int l, int ch, int g, unsigned char* lds) {
    typedef short bf16x8 __attribute__((ext_vector_type(8)));
    typedef float f32x16 __attribute__((ext_vector_type(16)));
    int tid_ = threadIdx.x; asm volatile("" : "+v"(tid_));
    const int tid = tid_, lane = tid & 63, wave = tid >> 6, r32 = lane & 31, hh = lane >> 5;
    const bf16_t* P = (const bf16_t*)(p.ws + WS_P);
    bf16_t* Y = (bf16_t*)(p.ws + WS_Y);
    const bf16_t* W = (const bf16_t*)(p.ws + WS_WSC) + ((size_t)l * 4 + g) * 16384;
    bf16_t* VT = (bf16_t*)lds;
    const size_t row0 = (size_t)ch * 128;
    __syncthreads();
#pragma unroll
    for (int it = 0; it < 4; ++it) {
        const int q = it * 32 + (tid >> 4), c0 = (tid & 15) * 8;
        const u32x4 v = *(const u32x4*)(P + (row0 + q) * INW + C_VC + g * 128 + c0);
        const unsigned w[4] = {v.x, v.y, v.z, v.w};
#pragma unroll
        for (int i = 0; i < 4; ++i) { VT[(c0 + 2 * i) * 136 + q] = (bf16_t)(w[i] & 0xffffu); VT[(c0 + 2 * i + 1) * 136 + q] = (bf16_t)(w[i] >> 16); }
    }
    __syncthreads();
    const int cb = wave & 3, pb0 = (wave >> 2) * 2;
    f32x16 acc0 = {}, acc1 = {};
#pragma unroll
    for (int s = 0; s < 8; ++s) {
        const bf16x8 b = *(const bf16x8*)(VT + (cb * 32 + r32) * 136 + 16 * s + 8 * hh);
        const bf16x8 a0 = *(const bf16x8*)(W + (size_t)(pb0 * 32 + r32) * 128 + 16 * s + 8 * hh);
        const bf16x8 a1 = *(const bf16x8*)(W + (size_t)(pb0 * 32 + 32 + r32) * 128 + 16 * s + 8 * hh);
        acc0 = __builtin_amdgcn_mfma_f32_32x32x16_bf16(a0, b, acc0, 0, 0, 0);
        acc1 = __builtin_amdgcn_mfma_f32_32x32x16_bf16(a1, b, acc1, 0, 0, 0);
    }
    const int c = cb * 32 + r32;
    const float* bs = p.bs_c + ((size_t)l * 4 + g) * 128;
#pragma unroll
    for (int r = 0; r < 16; ++r) {
        const int pr = (r & 3) + 8 * (r >> 2) + 4 * hh;
        const int p0 = pb0 * 32 + pr, p1 = p0 + 32;
        const float u0 = bf2f(P[(row0 + p0) * INW + C_UC + g * 128 + c]), u1 = bf2f(P[(row0 + p1) * INW + C_UC + g * 128 + c]);
        Y[(row0 + p0) * DM + 1536 + g * 128 + c] = (bf16_t)f2bf(u0 * (acc0[r] + bs[p0]));
        Y[(row0 + p1) * DM + 1536 + g * 128 + c] = (bf16_t)f2bf(u1 * (acc1[r] + bs[p1]));
    }
}
#ifndef USE_FAST_CMLP
#define USE_FAST_CMLP 1
#endif

__device__ __forceinline__ void ph_mixers_fast(const Params& p, int l, unsigned char* lds, const bool dry) {
    const int tid = threadIdx.x;
    const bf16_t* P = (const bf16_t*)(p.ws + WS_P);
    bf16_t* Y = (bf16_t*)(p.ws + WS_Y);
    const bool last = (l == DEPTH - 1);
    const int b = blockIdx.x & 7;
    unsigned* ctr = (unsigned*)(p.ws + WS_CTL) + (dry ? 2048 : 0) + (l * 8 + b) * 64;
    volatile unsigned* shw = (volatile unsigned*)(lds + LDS_BYTES - 64);
    const int nAttn = last ? 96 : 108, nC = last ? 64 : 72, total = nAttn + nC;
    const size_t lrow0 = (size_t)b * SEQ, crow0 = (size_t)NLAT + (size_t)b * NCTX;
    unsigned nxt_ = 0u;
    if (tid == 0) nxt_ = atomicAdd(ctr, 1u);
    for (;;) {
        __syncthreads();
        if (tid == 0) *shw = nxt_;
        __syncthreads();
        const int u = (int)*shw + ((dry && DRY_MODE == 7) ? 48 : 0);
        if (u >= ((dry && DRY_MODE == 6) ? 48 : total)) break;
        if (tid == 0) nxt_ = atomicAdd(ctr, 1u);
        if (u < nAttn) {
            const bf16_t *Qb, *Kc, *Vc, *Kl, *Vl; bf16_t* Ob; int nlt = 0, qpos0 = 0, kpos0 = 0; bool mask = false, has_sink = false; int hsink = 0;
            if (u < 48) {
                const int h = u >> 3, qb = u & 7, kv = h / 3;
                Qb = P + (lrow0 + qb * 256) * INW + C_QA + h * 128; Kc = P + crow0 * INW + C_KA + kv * 128; Vc = P + crow0 * INW + C_VA + kv * 128;
                Kl = P + lrow0 * INW + C_KA + kv * 128; Vl = P + lrow0 * INW + C_VA + kv * 128; nlt = 32;
                Ob = Y + (lrow0 + qb * 256) * DM + h * 128;
            } else if (u < 96) {
                const int v = u - 48, h = v >> 3, qb = v & 7, kv = h / 3;
                const int kstart = qb == 0 ? 0 : qb * 256 - 128; nlt = (qb == 0 || qb == 7) ? 6 : 8;
                Qb = P + (lrow0 + qb * 256) * INW + C_QB + h * 128; Kc = P + crow0 * INW + C_KB + kv * 128; Vc = P + crow0 * INW + C_VB + kv * 128;
                Kl = P + (lrow0 + kstart) * INW + C_KB + kv * 128; Vl = P + (lrow0 + kstart) * INW + C_VB + kv * 128;
                qpos0 = qb * 256; kpos0 = kstart; mask = true; has_sink = true; hsink = h;
                Ob = Y + (lrow0 + qb * 256) * DM + 768 + h * 128;
            } else {
                const int v = u - 96; const bool isB = v >= 6; const int h = isB ? v - 6 : v, kv = h / 3;
                const int cq = isB ? C_QB : C_QA, ck = isB ? C_KB : C_KA, cv = isB ? C_VB : C_VA;
                Qb = P + crow0 * INW + cq + h * 128; Kc = P + crow0 * INW + ck + kv * 128; Vc = P + crow0 * INW + cv + kv * 128; Kl = Kc; Vl = Vc;
                has_sink = isB; hsink = h; Ob = Y + crow0 * DM + (isB ? 768 : 0) + h * 128;
            }
            att::attn_unit(mask, Qb, Kc, Vc, Kl, Vl, nlt, qpos0, kpos0, has_sink, has_sink ? p.sink_b[l * 6 + hsink] : 0.f, Ob, (char*)lds);
        } else {
            const int v = u - nAttn;
            const int ch = v < 64 ? b * 16 + (v >> 2) : 128 + b * 2 + ((v - 64) >> 2);
#if USE_FAST_CMLP
            cmlp_unit_fast(p, l, ch, v & 3, lds);
#else
            cmlp_unit_naive(p, l, ch, v & 3, lds);
#endif
        }
    }
#if GATHER_I8 && GATHER_4BIT
    if (TABLES_IN_GAPS && !dry) conv4_tables(p, last ? 3 * NEXP : NEXP, last ? 4 * NEXP : 2 * NEXP, (unsigned*)(p.ws + WS_CTL) + 6272 + (last ? 64 : 0), lds);
#endif
}
#ifndef USE_FAST_ATT
#define USE_FAST_ATT 1
#endif

__device__ __forceinline__ void ynorm_row(bf16_t* yrow, const u32x4 (&v)[4], int lane, unsigned char* y8row, float* sdst) {
    float sq[4];
#pragma unroll
    for (int j = 0; j < 4; ++j) {
        const float a0 = bflo(v[j].x), a1 = bfhi(v[j].x), a2 = bflo(v[j].y), a3 = bfhi(v[j].y), a4 = bflo(v[j].z), a5 = bfhi(v[j].z), a6 = bflo(v[j].w), a7 = bfhi(v[j].w);
        sq[j] = a0 * a0 + a1 * a1 + a2 * a2 + a3 * a3 + a4 * a4 + a5 * a5 + a6 * a6 + a7 * a7;
    }
    const float sA = wave_sum(sq[0] + (lane < 32 ? sq[1] : 0.f));
    const float sB = wave_sum((lane >= 32 ? sq[1] : 0.f) + sq[2]);
    const float sC = wave_sum(sq[3]);
    const float rA = rsqrtf(sA * (1.f / 768.f) + EPS), rB = rsqrtf(sB * (1.f / 768.f) + EPS), rC = rsqrtf(sC * (1.f / 512.f) + EPS);
    if (GEMM_I8) {
        float x[4][8]; float am = 0.f;
#pragma unroll
        for (int j = 0; j < 4; ++j) {
            const float sc = (j == 0) ? rA : (j == 1) ? (lane < 32 ? rA : rB) : (j == 2) ? rB : rC;
            x[j][0] = bflo(v[j].x) * sc; x[j][1] = bfhi(v[j].x) * sc; x[j][2] = bflo(v[j].y) * sc; x[j][3] = bfhi(v[j].y) * sc;
            x[j][4] = bflo(v[j].z) * sc; x[j][5] = bfhi(v[j].z) * sc; x[j][6] = bflo(v[j].w) * sc; x[j][7] = bfhi(v[j].w) * sc;
#pragma unroll
            for (int i = 0; i < 8; ++i) am = fmaxf(am, fabsf(x[j][i]));
        }
        am = wave_max(am);
        const float s = am > 0.f ? am * (1.f / 127.f) : 1.f, inv = 1.f / s;
#pragma unroll
        for (int j = 0; j < 4; ++j) {
            u32x2 o; o.x = q8pack4(x[j][0], x[j][1], x[j][2], x[j][3], inv); o.y = q8pack4(x[j][4], x[j][5], x[j][6], x[j][7], inv);
            *(u32x2*)(y8row + j * 512 + lane * 8) = o;
        }
        if (lane == 0) *sdst = s;
        return;
    }
#pragma unroll
    for (int j = 0; j < 4; ++j) {
        const float sc = (j == 0) ? rA : (j == 1) ? (lane < 32 ? rA : rB) : (j == 2) ? rB : rC;
        u32x4 o;
        o.x = pk2(bflo(v[j].x) * sc, bfhi(v[j].x) * sc); o.y = pk2(bflo(v[j].y) * sc, bfhi(v[j].y) * sc);
        o.z = pk2(bflo(v[j].z) * sc, bfhi(v[j].z) * sc); o.w = pk2(bflo(v[j].w) * sc, bfhi(v[j].w) * sc);
        *(u32x4*)(yrow + j * 512 + lane * 8) = o;
    }
}
__device__ __forceinline__ void ph_ynorm(const Params& p, int l) {
    const int tid = threadIdx.x, lane = tid & 63, wave = tid >> 6;
    const int gw = blockIdx.x * NWAVES + wave, NGW = gridDim.x * NWAVES;
    bf16_t* Y = (bf16_t*)(p.ws + WS_Y);
    const int nrows = (l == DEPTH - 1) ? NLAT : MTOT;
#pragma unroll 1
    for (int r = gw; r < nrows; r += 2 * NGW) {
        const int r2 = r + NGW; const bool has2 = r2 < nrows; const int rb = has2 ? r2 : r;
        u32x4 va[4], vb[4];
#pragma unroll
        for (int j = 0; j < 4; ++j) { va[j] = *(const u32x4*)(Y + (size_t)r * DM + j * 512 + lane * 8); vb[j] = *(const u32x4*)(Y + (size_t)rb * DM + j * 512 + lane * 8); }
        unsigned char* Y8 = (unsigned char*)(p.ws + WS_XN8); float* SY = (float*)(p.ws + WS_SCL) + SCL_Y;
        ynorm_row(Y + (size_t)r * DM, va, lane, Y8 + (size_t)r * DM, SY + r);
        if (has2) ynorm_row(Y + (size_t)r2 * DM, vb, lane, Y8 + (size_t)r2 * DM, SY + r2);
    }
}

__device__ __forceinline__ void wave_argmax(float& bv, int& bi) {
#pragma unroll
    for (int o = 32; o >= 1; o >>= 1) {
        const float ov = __shfl_xor(bv, o); const int oi = __shfl_xor(bi, o);
        if (ov > bv || (ov == bv && oi < bi)) { bv = ov; bi = oi; }
    }
}
__device__ __forceinline__ void route_half(const bf16_t* qh, const bf16_t* kh, int lane, float& tv, int& ti) {
    const unsigned qq = *(const unsigned*)(qh + 2 * lane);
    const float qa = bflo(qq), qb = bfhi(qq);
    const bf16_t* k0 = kh + (size_t)lane * 128;
    const bf16_t* k1 = k0 + 64 * 128;
    float d0 = 0.f, d1 = 0.f;
#pragma unroll 2
    for (int cb = 0; cb < 16; ++cb) {
        const u32x4 a = *(const u32x4*)(k0 + cb * 8), b = *(const u32x4*)(k1 + cb * 8);
        const unsigned aw[4] = {a.x, a.y, a.z, a.w}, bw[4] = {b.x, b.y, b.z, b.w};
#pragma unroll
        for (int i = 0; i < 4; ++i) {
            const int src = cb * 4 + i;
            const float x0 = __shfl(qa, src), x1 = __shfl(qb, src);
            d0 += x0 * bflo(aw[i]) + x1 * bfhi(aw[i]);
            d1 += x0 * bflo(bw[i]) + x1 * bfhi(bw[i]);
        }
    }
    float va = d0, vb = d1; tv = 0.f; ti = 0;
#pragma unroll 1
    for (int r = 0; r < 16; ++r) {
        float bv; int bi;
        if (va >= vb) { bv = va; bi = lane; } else { bv = vb; bi = lane + 64; }
        wave_argmax(bv, bi);
        if (lane == r) { tv = bv; ti = bi; }
        if (bi == lane) va = -INFINITY; else if (bi == lane + 64) vb = -INFINITY;
    }
}
__device__ __forceinline__ void ph_route_naive(const Params& p, int l) {
    const int tid = threadIdx.x, lane = tid & 63, wave = tid >> 6;
    const int gw = blockIdx.x * NWAVES + wave, NGW = gridDim.x * NWAVES;
    const bf16_t* QP = (const bf16_t*)(p.ws + WS_P);
    const bf16_t* KEYS = (const bf16_t*)(p.ws + WS_KEYS) + (size_t)l * 8 * 2 * 128 * 128;
    int* EID = (int*)(p.ws + WS_EID); float* GATE = (float*)(p.ws + WS_GATE);
    const int nrows = (l == DEPTH - 1) ? NLAT : MTOT;
#pragma unroll 1
    for (int tk = gw; tk < nrows * 8; tk += NGW) {
        const int t = tk >> 3, h = tk & 7;
        const bf16_t* qrow = QP + (size_t)t * DM + h * 256;
        float tv0, tv1; int ti0, ti1;
        route_half(qrow, KEYS + (size_t)(h * 2 + 0) * 128 * 128, lane, tv0, ti0);
        route_half(qrow + 128, KEYS + (size_t)(h * 2 + 1) * 128 * 128, lane, tv1, ti1);
        const float v1 = __shfl(tv0, lane >> 2);
        float c0 = v1 + __shfl(tv1, (lane & 3) * 4 + 0), c1 = v1 + __shfl(tv1, (lane & 3) * 4 + 1);
        float c2 = v1 + __shfl(tv1, (lane & 3) * 4 + 2), c3 = v1 + __shfl(tv1, (lane & 3) * 4 + 3);
        float myv = 0.f; int myc = 0;
#pragma unroll 1
        for (int r = 0; r < 16; ++r) {
            float bv = c0; int bi = lane * 4;
            if (c1 > bv) { bv = c1; bi = lane * 4 + 1; }
            if (c2 > bv) { bv = c2; bi = lane * 4 + 2; }
            if (c3 > bv) { bv = c3; bi = lane * 4 + 3; }
            wave_argmax(bv, bi);
            if (lane == r) { myv = bv; myc = bi; }
            if ((bi >> 2) == lane) {
                const int u = bi & 3;
                if (u == 0) c0 = -INFINITY; else if (u == 1) c1 = -INFINITY; else if (u == 2) c2 = -INFINITY; else c3 = -INFINITY;
            }
        }
        float mx = lane < 16 ? myv : -INFINITY;
        mx = fmaxf(mx, __shfl_xor(mx, 8)); mx = fmaxf(mx, __shfl_xor(mx, 4)); mx = fmaxf(mx, __shfl_xor(mx, 2)); mx = fmaxf(mx, __shfl_xor(mx, 1));
        const float e = lane < 16 ? __expf(myv - mx) : 0.f;
        float sm = e; sm += __shfl_xor(sm, 8); sm += __shfl_xor(sm, 4); sm += __shfl_xor(sm, 2); sm += __shfl_xor(sm, 1);
        const int i1 = __shfl(ti0, myc >> 4), i2 = __shfl(ti1, myc & 15);
        if (lane < 16) { EID[(size_t)t * 128 + h * 16 + lane] = i1 * 128 + i2; GATE[(size_t)t * 128 + h * 16 + lane] = e / sm; }
    }
}


namespace rt {
typedef short bf16x8 __attribute__((ext_vector_type(8)));
typedef float f32x16 __attribute__((ext_vector_type(16)));
__device__ __forceinline__ void insert16(float (&t)[16], float x) {
#pragma unroll
    for (int j = 15; j >= 1; --j) t[j] = __builtin_amdgcn_fmed3f(t[j - 1], t[j], x);
    t[0] = fmaxf(t[0], x);
}
__device__ __forceinline__ void half_top16(const unsigned char* klds, const bf16_t* qrow, int r32, int hh, float (&t)[16]) {
    bf16x8 qf[8];
#pragma unroll
    for (int s = 0; s < 8; ++s) qf[s] = *(const bf16x8*)(qrow + 16 * s);
#pragma unroll
    for (int k = 0; k < 16; ++k) t[k] = -3.0e38f;
    const unsigned hh4 = (unsigned)hh << 2;
#pragma unroll
    for (int kb = 0; kb < 4; ++kb) {
        f32x16 acc = {};
        const int row = kb * 32 + r32;
#pragma unroll
        for (int s = 0; s < 8; ++s) {
            const bf16x8 a = *(const bf16x8*)(klds + row * 256 + ((32 * s + 16 * hh) ^ ((row & 7) << 4)));
            acc = __builtin_amdgcn_mfma_f32_32x32x16_bf16(a, qf[s], acc, 0, 0, 0);
        }
#pragma unroll
        for (int r = 0; r < 16; ++r) {
            const unsigned key = (unsigned)(kb * 32 + (r & 3) + 8 * (r >> 2)) | hh4;
            insert16(t, __uint_as_float((__float_as_uint(acc[r]) & ~127u) | key));
        }
    }
    float o[16];
#pragma unroll
    for (int k = 0; k < 16; ++k) o[k] = __shfl_xor(t[k], 32);
#pragma unroll
    for (int k = 0; k < 16; ++k) insert16(t, o[k]);
}
}
template <bool OWN_UNITS>
__device__ __forceinline__ void ph_route_fast(const Params& p, int l, unsigned char* lds) {
    int tid_ = threadIdx.x; asm volatile("" : "+v"(tid_));
    const int tid = tid_, lane = tid & 63, wave = tid >> 6, r32 = lane & 31, hh = lane >> 5;
    const bf16_t* QP = (const bf16_t*)(p.ws + WS_P);
    const bf16_t* KEYS = (const bf16_t*)(p.ws + WS_KEYS) + (size_t)l * 8 * 2 * 128 * 128;
    int* EID = (int*)(p.ws + WS_EID); float* GATE = (float*)(p.ws + WS_GATE);
    const int ntile = ((l == DEPTH - 1) ? NLAT : MTOT) / 256;
    unsigned* tab = (unsigned*)(lds + 65536) + wave * 2048;
    pg8::StaticOrder So; So.init(ntile * 256, DM, (int)gridDim.x, (int)blockIdx.x);
#pragma unroll 1
    for (int ui = 0;; ++ui) {
        int tile, h;
        if (OWN_UNITS) { pg8::Unit uu; if (!So.next(ui, uu)) break; tile = uu.pm; h = uu.pn; }
        else { const int u = blockIdx.x + ui * (int)gridDim.x; if (u >= ntile * 8) break; tile = u >> 3; h = u & 7; }
        __syncthreads();
        const u32x4* ksrc = (const u32x4*)(KEYS + (size_t)h * 2 * 128 * 128);
#pragma unroll
        for (int i = 0; i < 8; ++i) { const int c = tid + i * 512, row = c >> 4, cc = c & 15; *(u32x4*)(lds + row * 256 + ((cc * 16) ^ ((row & 7) << 4))) = ksrc[c]; }
        __syncthreads();
        const int tok = tile * 256 + wave * 32 + r32;
        const bf16_t* qrow = QP + (size_t)tok * DM + h * 256 + hh * 8;
        float v1[16], v2[16];
        rt::half_top16(lds, qrow, r32, hh, v1);
        rt::half_top16(lds + 32768, qrow + 128, r32, hh, v2);
        float c[16];
#pragma unroll
        for (int k = 0; k < 16; ++k) c[k] = -3.0e38f;
#pragma unroll
        for (int i = 0; i < 16; ++i)
#pragma unroll
            for (int j = 0; j < 16; ++j)
                if ((i + 1) * (j + 1) <= 16) rt::insert16(c, __uint_as_float((__float_as_uint(v1[i] + v2[j]) & ~255u) | (unsigned)(i * 16 + j)));
#pragma unroll
        for (int k = 0; k < 16; ++k) { tab[k * 64 + lane] = __float_as_uint(v1[k]); tab[(16 + k) * 64 + lane] = __float_as_uint(v2[k]); }
        LDS_WAIT();
        float e[16], sum = 0.f;
#pragma unroll
        for (int k = 0; k < 16; ++k) { e[k] = __expf(c[k] - c[0]); sum += e[k]; }
        const float inv = 1.f / sum;
        unsigned out[16];
#pragma unroll
        for (int k = 0; k < 16; ++k) {
            const unsigned code = __float_as_uint(c[k]) & 255u;
            const unsigned i1 = tab[(code >> 4) * 64 + lane] & 127u, i2 = tab[(16 + (code & 15u)) * 64 + lane] & 127u;
            out[k] = hh == 0 ? (i1 * 128u + i2) : __float_as_uint(e[k] * inv);
        }
        unsigned* dst = (hh == 0 ? (unsigned*)EID : (unsigned*)GATE) + (size_t)tok * 128 + h * 16;
#pragma unroll
        for (int k = 0; k < 4; ++k) { u32x4 w; w.x = out[4 * k]; w.y = out[4 * k + 1]; w.z = out[4 * k + 2]; w.w = out[4 * k + 3]; *(u32x4*)(dst + 4 * k) = w; }
        LDS_WAIT();
    }
}
#ifndef USE_FAST_ROUTE
#define USE_FAST_ROUTE 1
#endif


#if GATHER_I8
__device__ __forceinline__ float dpp_shr(float v, int n) {
    const int iv = __builtin_bit_cast(int, v); int r;
    switch (n) { case 1: r = __builtin_amdgcn_update_dpp(0, iv, 0x111, 0xf, 0xf, true); break; case 2: r = __builtin_amdgcn_update_dpp(0, iv, 0x112, 0xf, 0xf, true); break;
                 case 4: r = __builtin_amdgcn_update_dpp(0, iv, 0x114, 0xf, 0xf, true); break; default: r = __builtin_amdgcn_update_dpp(0, iv, 0x118, 0xf, 0xf, true); break; }
    return __builtin_bit_cast(float, r);
}
__device__ __forceinline__ float wave_total(float v) {
    v += dpp_shr(v, 1); v += dpp_shr(v, 2); v += dpp_shr(v, 4); v += dpp_shr(v, 8);
    v += __builtin_bit_cast(float, __builtin_amdgcn_update_dpp(0, __builtin_bit_cast(int, v), 0x142, 0xa, 0xf, false));
    v += __builtin_bit_cast(float, __builtin_amdgcn_update_dpp(0, __builtin_bit_cast(int, v), 0x143, 0xc, 0xf, false));
    return __uint_as_float(__builtin_amdgcn_readlane(__float_as_uint(v), 63));
}
#define UB0(w) ((float)((w) & 0xffu))
#define UB1(w) ((float)(((w) >> 8) & 0xffu))
#define UB2(w) ((float)(((w) >> 16) & 0xffu))
#define UB3(w) ((float)((w) >> 24))

__device__ __forceinline__ float dpp_xor1(float v) { return __builtin_bit_cast(float, __builtin_amdgcn_update_dpp(0, __builtin_bit_cast(int, v), 0xB1, 0xf, 0xf, false)); }
__device__ __forceinline__ float dpp_xor2(float v) { return __builtin_bit_cast(float, __builtin_amdgcn_update_dpp(0, __builtin_bit_cast(int, v), 0x4E, 0xf, 0xf, false)); }
__device__ __forceinline__ float dpp_xor8(float v) { return __builtin_bit_cast(float, __builtin_amdgcn_update_dpp(0, __builtin_bit_cast(int, v), 0x128, 0xf, 0xf, false)); }
__device__ __forceinline__ float reduce8_rows(const float (&d)[8], int lane) {
    const bool b0 = lane & 1, b1 = lane & 2, b2 = lane & 4;
    float r[4];
#pragma unroll
    for (int k = 0; k < 4; ++k) r[k] = (b0 ? d[2 * k + 1] : d[2 * k]) + dpp_xor1(b0 ? d[2 * k] : d[2 * k + 1]);
    float t[2];
#pragma unroll
    for (int k = 0; k < 2; ++k) t[k] = (b1 ? r[2 * k + 1] : r[2 * k]) + dpp_xor2(b1 ? r[2 * k] : r[2 * k + 1]);
    float u = (b2 ? t[1] : t[0]) + __shfl_xor(b2 ? t[0] : t[1], 4);
    u += dpp_xor8(u);
    u += __shfl_xor(u, 16);
    u += __shfl_xor(u, 32);
    return u;
}
#if GATHER_4BIT
#ifndef DRY_MODE
#define DRY_MODE 0
#endif
typedef float f32x2 __attribute__((ext_vector_type(2)));
__device__ __forceinline__ void ph_gather(const Params& p, int l, const bool dry, unsigned char* lds) {
    const int tid = threadIdx.x, lane = tid & 63, wave = __builtin_amdgcn_readfirstlane(tid >> 6);
    const int gw = blockIdx.x * NWAVES + wave, NGW = gridDim.x * NWAVES;
    const bf16_t* XN = (const bf16_t*)(p.ws + WS_XN);
    const unsigned char* UT = (const unsigned char*)(p.ws + WS_UT) + (size_t)l * NEXP * ROWU;
    const unsigned char* VT = (const unsigned char*)(p.ws + WS_VT) + (size_t)l * NEXP * ROWV;
    const int* EID = (const int*)(p.ws + WS_EID); const float* GATE = (const float*)(p.ws + WS_GATE);
    const float* mod = (const float*)(p.ws + WS_MOD) + (size_t)l * 9 * 12288;
    const int nrows = (l == DEPTH - 1) ? NLAT : MTOT;
    const bool vlds = (NGW == 2048) && GVEC_LDS;
    typedef __attribute__((address_space(3))) unsigned lds_u32;
    auto stage_vecs = [&](int trip) {
        const int tt = gw + trip * NGW; if (tt >= nrows) return;
        const int bq = tt < NLAT ? (tt >> 11) : 8;
        const int vec = wave >> 1;
        if (l == DEPTH - 1 && vec > 0) return;
        const float* src = vec == 0 ? mod + (size_t)bq * 12288 + 5 * DM : vec == 1 ? p.norm1_g + (l + 1) * DM : mod + (size_t)9 * 12288 + (size_t)bq * 12288 + (vec == 3 ? DM : 0);
#pragma unroll
        for (int i = 0; i < 4; ++i) {
            const int c = (wave & 1) * 4 + i, j = c >> 2, k = c & 3;
            __builtin_amdgcn_global_load_lds((const unsigned*)(src + j * 1024 + lane * 16 + k * 4), (lds_u32*)(lds + (trip & 1) * 32768 + (vec * 8 + c) * 1024), 16, 0, 0);
        }
    };
    if (vlds) stage_vecs(0);
    int trip = 0;
#pragma unroll 1
    for (int t = gw; t < nrows; t += NGW, ++trip) {
        if (vlds) { asm volatile("s_waitcnt vmcnt(0)" ::: "memory"); __syncthreads(); stage_vecs(trip + 1); }
        const float* vb_ = (const float*)(lds + (trip & 1) * 32768);
#define GVEC(vec, j, k, glob) (vlds ? *(const f32x4*)(vb_ + (((vec) * 8 + (j) * 4 + (k)) * 64 + lane) * 4) : *(const f32x4*)(glob))
        int xh[4], xl[4]; float sxl;
#if GEMM_I8 && GEMM3_I8
        {
            sxl = ((const float*)(p.ws + WS_SCL))[SCL_XN + t];
            const unsigned char* x8 = (const unsigned char*)(p.ws + WS_XN8) + (size_t)t * DM;
#pragma unroll
            for (int j = 0; j < 2; ++j) {
                const u32x4 q4 = *(const u32x4*)(x8 + j * 1024 + lane * 16);
                const unsigned ww[4] = {q4.x, q4.y, q4.z, q4.w};
#pragma unroll
                for (int dd = 0; dd < 2; ++dd) {
                    unsigned h = 0u, lo = 0u;
#pragma unroll
                    for (int k = 0; k < 8; ++k) {
                        const int q = (int)(signed char)((ww[dd * 2 + (k >> 2)] >> (8 * (k & 3))) & 0xffu);
                        const int ql = ((q + 8) & 15) - 8, qh = (q - ql) >> 4;
                        h |= ((unsigned)qh & 15u) << (4 * k); lo |= ((unsigned)ql & 15u) << (4 * k);
                    }
                    xh[j * 2 + dd] = (int)h; xl[j * 2 + dd] = (int)lo;
                }
            }
        }
#else
        {
            float x[32]; float am = 0.f;
#pragma unroll
            for (int j = 0; j < 2; ++j)
#pragma unroll
                for (int k = 0; k < 2; ++k) {
                    const u32x4 q = *(const u32x4*)(XN + (size_t)t * DM + j * 1024 + lane * 16 + k * 8);
                    float* xx = x + j * 16 + k * 8;
                    xx[0] = bflo(q.x); xx[1] = bfhi(q.x); xx[2] = bflo(q.y); xx[3] = bfhi(q.y); xx[4] = bflo(q.z); xx[5] = bfhi(q.z); xx[6] = bflo(q.w); xx[7] = bfhi(q.w);
                }
#pragma unroll
            for (int i = 0; i < 32; ++i) am = fmaxf(am, fabsf(x[i]));
            sxl = am > 0.f ? am * (1.f / 119.f) : 1.f;
            const float inv = 1.f / sxl;
#pragma unroll
            for (int d = 0; d < 4; ++d) {
                unsigned h = 0u, lo = 0u;
#pragma unroll
                for (int k = 0; k < 8; ++k) {
                    const int q = (int)rintf(x[8 * d + k] * inv);
                    const int ql = ((q + 8) & 15) - 8, qh = (q - ql) >> 4;
                    h |= ((unsigned)qh & 15u) << (4 * k); lo |= ((unsigned)ql & 15u) << (4 * k);
                }
                xh[d] = (int)h; xl[d] = (int)lo;
            }
        }
#endif
        const int e0 = EID[(size_t)t * 128 + lane], e1 = EID[(size_t)t * 128 + 64 + lane];
        const float g0 = GATE[(size_t)t * 128 + lane], g1 = GATE[(size_t)t * 128 + 64 + lane];
        float hid0 = 0.f, hid1 = 0.f;
        constexpr int GB = 8;
#define G_LOAD(W, S, TAB, EB, ISV) do { _Pragma("unroll") for (int i = 0; i < GB; ++i) { \
            const int id_ = __builtin_amdgcn_readlane((EB) < 64 ? e0 : e1, ((EB) + i) & 63); \
            const unsigned char* row_ = (TAB) + (size_t)id_ * ((ISV) ? ROWV : ROWU); \
            W[i] = *(const u32x4*)(row_ + lane * 16); if (!((ISV) ? V_ROWSCALE : U_ROWSCALE)) S[i] = *(const unsigned short*)(row_ + 1024 + lane * 2); } } while (0)
#define G_DOT(W, S, EB) do { float dd_[8]; _Pragma("unroll") for (int i = 0; i < GB; ++i) { int sh_ = 0, sl_ = 0; \
            const unsigned ww[4] = {W[i].x, W[i].y, W[i].z, W[i].w}; \
            _Pragma("unroll") for (int d = 0; d < 4; ++d) { \
                sh_ = __builtin_amdgcn_sdot8((int)ww[d], xh[d], sh_, false); \
                sl_ = __builtin_amdgcn_sdot8((int)ww[d], xl[d], sl_, false); } \
            dd_[i] = (float)((sh_ << 4) + sl_) * (U_ROWSCALE ? sxl : sxl * bf2f(S[i])); } \
            const float tot = reduce8_rows(dd_, lane);              \
            if ((lane & 56) == ((EB) & 63)) { if ((EB) < 64) hid0 = tot; else hid1 = tot; } } while (0)
#define G_AXPY(W, S, EB) do { _Pragma("unroll") for (int i = 0; i < GB; ++i) { \
            const float m_ = __uint_as_float(__builtin_amdgcn_readlane(__float_as_uint((EB) < 64 ? cf0 : cf1), ((EB) + i) & 63)) * (V_ROWSCALE ? 1.f : bf2f(S[i])); \
            const f32x2 mm = {m_, m_}; \
            const unsigned ww[4] = {W[i].x, W[i].y, W[i].z, W[i].w}; \
            _Pragma("unroll") for (int d = 0; d < 4; ++d) { \
                acc[4 * d + 0] += mm * __builtin_amdgcn_cvt_scalef32_pk_f32_fp4(ww[d], 1.0f, 0); \
                acc[4 * d + 1] += mm * __builtin_amdgcn_cvt_scalef32_pk_f32_fp4(ww[d], 1.0f, 1); \
                acc[4 * d + 2] += mm * __builtin_amdgcn_cvt_scalef32_pk_f32_fp4(ww[d], 1.0f, 2); \
                acc[4 * d + 3] += mm * __builtin_amdgcn_cvt_scalef32_pk_f32_fp4(ww[d], 1.0f, 3); } } } while (0)
        u32x4 wa[GB], wb[GB]; unsigned sa[GB], sb[GB];
        const bool do_u = !(dry && (DRY_MODE == 4 || DRY_MODE == 5)), do_v = !(dry && (DRY_MODE == 3 || DRY_MODE == 5));
#if V_ROWSCALE
        const float vs0 = ((const float*)(p.ws + WS_VSC))[(size_t)l * NEXP + e0], vs1 = ((const float*)(p.ws + WS_VSC))[(size_t)l * NEXP + e1];
#else
        const float vs0 = 1.f, vs1 = 1.f;
#endif
        if (do_u) G_LOAD(wa, sa, UT, 0, false); else G_LOAD(wa, sa, VT, 0, true);
#pragma unroll 1
        for (int eb = 0; eb < (do_u ? 128 : 0); eb += 2 * GB) {
            G_LOAD(wb, sb, UT, eb + GB, false);
            G_DOT(wa, sa, eb);
            if (eb + 2 * GB < 128) G_LOAD(wa, sa, UT, eb + 2 * GB, false); else G_LOAD(wa, sa, VT, 0, true);
            G_DOT(wb, sb, eb + GB);
        }
#if U_ROWSCALE
        hid0 *= ((const float*)(p.ws + WS_USC))[(size_t)l * NEXP + e0]; hid1 *= ((const float*)(p.ws + WS_USC))[(size_t)l * NEXP + e1];
#endif
        const float cf0 = gelu_tanh(hid0) * g0 * vs0, cf1 = gelu_tanh(hid1) * g1 * vs1;
        f32x2 acc[16];
#pragma unroll
        for (int i = 0; i < 16; ++i) acc[i] = (f32x2){0.f, 0.f};
#pragma unroll 1
        for (int eb = 0; eb < (do_v ? 128 : 0); eb += 2 * GB) {
            G_LOAD(wb, sb, VT, eb + GB, true);
            G_AXPY(wa, sa, eb);
            if (eb + 2 * GB < 128) G_LOAD(wa, sa, VT, eb + 2 * GB, true);
            G_AXPY(wb, sb, eb + GB);
        }
#undef G_LOAD
#undef G_DOT
#undef G_AXPY
        float hn[32];
        const int bb = t < NLAT ? (t >> 11) : 8;
        const float* gate = mod + (size_t)bb * 12288 + 5 * DM;
#if H_BF16 && GEMM_I8 && GEMM3_I8
        {
            bf16_t* hbrow = (bf16_t*)(p.ws + WS_HB) + (size_t)t * DM;
            const bool fin = (l == DEPTH - 1);
#pragma unroll
            for (int j = 0; j < 2; ++j) {
                const u32x4 q0 = *(const u32x4*)(hbrow + j * 1024 + lane * 16), q1 = *(const u32x4*)(hbrow + j * 1024 + lane * 16 + 8);
                const unsigned qq[8] = {q0.x, q0.y, q0.z, q0.w, q1.x, q1.y, q1.z, q1.w};
#pragma unroll
                for (int k = 0; k < 4; ++k) {
                    const f32x4 gv = GVEC(0, j, k, gate + j * 1024 + lane * 16 + k * 4);
                    const f32x2 a0 = acc[j * 8 + k * 2], a1 = acc[j * 8 + k * 2 + 1];
                    hn[j * 16 + k * 4 + 0] = bflo(qq[2 * k]) + gv.x * a0.x; hn[j * 16 + k * 4 + 1] = bfhi(qq[2 * k]) + gv.y * a0.y;
                    hn[j * 16 + k * 4 + 2] = bflo(qq[2 * k + 1]) + gv.z * a1.x; hn[j * 16 + k * 4 + 3] = bfhi(qq[2 * k + 1]) + gv.w * a1.y;
                }
                if (fin) {
                    float* orow = (dry ? (float*)(p.ws + WS_DUMMY) + (size_t)(t & 16383) * DM : p.out + (size_t)t * DM) + j * 1024 + lane * 16;
#pragma unroll
                    for (int k = 0; k < 4; ++k) *(f32x4*)(orow + k * 4) = (f32x4){hn[j * 16 + k * 4], hn[j * 16 + k * 4 + 1], hn[j * 16 + k * 4 + 2], hn[j * 16 + k * 4 + 3]};
                } else {
                    bf16_t* orow = (dry ? (bf16_t*)(p.ws + WS_DUMMY) + (size_t)(t & 16383) * DM : hbrow) + j * 1024 + lane * 16;
                    u32x4 w0, w1;
                    w0.x = pk2(hn[j * 16 + 0], hn[j * 16 + 1]); w0.y = pk2(hn[j * 16 + 2], hn[j * 16 + 3]); w0.z = pk2(hn[j * 16 + 4], hn[j * 16 + 5]); w0.w = pk2(hn[j * 16 + 6], hn[j * 16 + 7]);
                    w1.x = pk2(hn[j * 16 + 8], hn[j * 16 + 9]); w1.y = pk2(hn[j * 16 + 10], hn[j * 16 + 11]); w1.z = pk2(hn[j * 16 + 12], hn[j * 16 + 13]); w1.w = pk2(hn[j * 16 + 14], hn[j * 16 + 15]);
                    *(u32x4*)orow = w0; *(u32x4*)(orow + 8) = w1;
                }
            }
        }
#else
        float* hrow = t < NLAT ? p.out + (size_t)t * DM : (float*)(p.ws + WS_HC) + (size_t)(t - NLAT) * DM;
#pragma unroll
        for (int j = 0; j < 2; ++j)
#pragma unroll
            for (int k = 0; k < 4; ++k) {
                const int col = j * 1024 + lane * 16 + k * 4;
                const f32x4 hv = *(const f32x4*)(hrow + col), gv = *(const f32x4*)(gate + col);
                const f32x2 a0 = acc[j * 8 + k * 2], a1 = acc[j * 8 + k * 2 + 1];
                f32x4 o;
                o.x = hv.x + gv.x * a0.x; o.y = hv.y + gv.y * a0.y; o.z = hv.z + gv.z * a1.x; o.w = hv.w + gv.w * a1.y;
                *(f32x4*)((dry ? (float*)(p.ws + WS_DUMMY) + (size_t)(t & 16383) * DM : hrow) + col) = o;
                hn[j * 16 + k * 4 + 0] = o.x; hn[j * 16 + k * 4 + 1] = o.y; hn[j * 16 + k * 4 + 2] = o.z; hn[j * 16 + k * 4 + 3] = o.w;
            }
#endif
        if (l + 1 < DEPTH) {
            float ss = 0.f;
#pragma unroll
            for (int i = 0; i < 32; ++i) ss += hn[i] * hn[i];
            const float rstd = rsqrtf(wave_total(ss) * (1.f / DM) + EPS);
            const float* g1n = p.norm1_g + (l + 1) * DM;
            const float* shift = mod + (size_t)9 * 12288 + (size_t)bb * 12288;
            const float* scale = shift + DM;
            if (GEMM_I8) {
                float am = 0.f;
#pragma unroll
                for (int j = 0; j < 2; ++j)
#pragma unroll
                    for (int k = 0; k < 4; ++k) {
                        const int col = j * 1024 + lane * 16 + k * 4;
                        const f32x4 gg = GVEC(1, j, k, g1n + col), sh = GVEC(2, j, k, shift + col), sc = GVEC(3, j, k, scale + col);
                        float* h4 = hn + j * 16 + k * 4;
                        h4[0] = h4[0] * rstd * gg.x * (1.f + sc.x) + sh.x; h4[1] = h4[1] * rstd * gg.y * (1.f + sc.y) + sh.y;
                        h4[2] = h4[2] * rstd * gg.z * (1.f + sc.z) + sh.z; h4[3] = h4[3] * rstd * gg.w * (1.f + sc.w) + sh.w;
                        am = fmaxf(am, fmaxf(fmaxf(fabsf(h4[0]), fabsf(h4[1])), fmaxf(fabsf(h4[2]), fabsf(h4[3]))));
                    }
                am = wave_max(am);
                const float s8 = am > 0.f ? am * (1.f / 127.f) : 1.f, inv8 = 1.f / s8;
                unsigned char* xo8 = (dry ? (unsigned char*)(p.ws + WS_DUMMY) + (size_t)(t & 16383) * DM : (unsigned char*)(p.ws + WS_XN8) + (size_t)t * DM);
#pragma unroll
                for (int j = 0; j < 2; ++j) {
                    u32x4 w;
                    w.x = q8pack4(hn[j * 16 + 0], hn[j * 16 + 1], hn[j * 16 + 2], hn[j * 16 + 3], inv8); w.y = q8pack4(hn[j * 16 + 4], hn[j * 16 + 5], hn[j * 16 + 6], hn[j * 16 + 7], inv8);
                    w.z = q8pack4(hn[j * 16 + 8], hn[j * 16 + 9], hn[j * 16 + 10], hn[j * 16 + 11], inv8); w.w = q8pack4(hn[j * 16 + 12], hn[j * 16 + 13], hn[j * 16 + 14], hn[j * 16 + 15], inv8);
                    *(u32x4*)(xo8 + j * 1024 + lane * 16) = w;
                }
                if (lane == 0 && !dry) ((float*)(p.ws + WS_SCL))[SCL_XN + t] = s8;
            } else {
            bf16_t* xo = (dry ? (bf16_t*)(p.ws + WS_DUMMY) + (size_t)(t & 16383) * DM : (bf16_t*)(p.ws + WS_XN) + (size_t)t * DM);
#pragma unroll
            for (int j = 0; j < 2; ++j)
#pragma unroll
                for (int k = 0; k < 2; ++k) {
                    const int col = j * 1024 + lane * 16 + k * 8;
                    float xv[8];
#pragma unroll
                    for (int i = 0; i < 8; ++i) xv[i] = hn[j * 16 + k * 8 + i] * rstd * g1n[col + i] * (1.f + scale[col + i]) + shift[col + i];
                    u32x4 w; w.x = pk2(xv[0], xv[1]); w.y = pk2(xv[2], xv[3]); w.z = pk2(xv[4], xv[5]); w.w = pk2(xv[6], xv[7]);
                    *(u32x4*)(xo + col) = w;
                }
            }
        }
#undef GVEC
    }
}
#else
#ifndef DRY_MODE
#define DRY_MODE 0
#endif
typedef float f32x2 __attribute__((ext_vector_type(2)));
__device__ __forceinline__ void ph_gather(const Params& p, int l, const bool dry, unsigned char* lds) {
    const int tid = threadIdx.x, lane = tid & 63, wave = tid >> 6;
    const int gw = blockIdx.x * NWAVES + wave, NGW = gridDim.x * NWAVES;
    const bf16_t* XN = (const bf16_t*)(p.ws + WS_XN);
    const unsigned char* UT = (const unsigned char*)(p.ws + WS_UT) + (size_t)l * NEXP * DM;
    const unsigned char* VT = (const unsigned char*)(p.ws + WS_VT) + (size_t)l * NEXP * DM;
    const float* USC = (const float*)(p.ws + WS_USC) + l * NEXP; const float* VSC = (const float*)(p.ws + WS_VSC) + l * NEXP;
    const int* EID = (const int*)(p.ws + WS_EID); const float* GATE = (const float*)(p.ws + WS_GATE);
    const float* mod = (const float*)(p.ws + WS_MOD) + (size_t)l * 9 * 12288;
    const int nrows = (l == DEPTH - 1) ? NLAT : MTOT;
#pragma unroll 1
    for (int t = gw; t < nrows; t += NGW) {
        int xq[8]; float sxl;
        {
            float x[32]; float am = 0.f;
#pragma unroll
            for (int j = 0; j < 2; ++j)
#pragma unroll
                for (int k = 0; k < 2; ++k) {
                    const u32x4 q = *(const u32x4*)(XN + (size_t)t * DM + j * 1024 + lane * 16 + k * 8);
                    float* xx = x + j * 16 + k * 8;
                    xx[0] = bflo(q.x); xx[1] = bfhi(q.x); xx[2] = bflo(q.y); xx[3] = bfhi(q.y); xx[4] = bflo(q.z); xx[5] = bfhi(q.z); xx[6] = bflo(q.w); xx[7] = bfhi(q.w);
                }
#pragma unroll
            for (int i = 0; i < 32; ++i) am = fmaxf(am, fabsf(x[i]));
            sxl = am > 0.f ? am * (1.f / 127.f) : 1.f;
            const float inv = 1.f / sxl;
#pragma unroll
            for (int d = 0; d < 8; ++d) {
                const int q0 = (int)rintf(x[4 * d] * inv), q1 = (int)rintf(x[4 * d + 1] * inv), q2 = (int)rintf(x[4 * d + 2] * inv), q3 = (int)rintf(x[4 * d + 3] * inv);
                xq[d] = (int)(((unsigned)q0 & 0xffu) | (((unsigned)q1 & 0xffu) << 8) | (((unsigned)q2 & 0xffu) << 16) | ((unsigned)q3 << 24));
            }
        }
        const int e0 = EID[(size_t)t * 128 + lane], e1 = EID[(size_t)t * 128 + 64 + lane];
        const float g0 = GATE[(size_t)t * 128 + lane], g1 = GATE[(size_t)t * 128 + 64 + lane];
        const float us0 = USC[e0], us1 = USC[e1], vs0 = VSC[e0], vs1 = VSC[e1];
        float hid0 = 0.f, hid1 = 0.f;
        constexpr int GBU = 8, GBV = 4;
#define G_LOAD(W, TAB, EB, NB) do { _Pragma("unroll") for (int i = 0; i < NB; ++i) { \
            const int id_ = __builtin_amdgcn_readlane((EB) < 64 ? e0 : e1, ((EB) + i) & 63); \
            const unsigned char* row_ = (TAB) + (size_t)id_ * DM + lane * 16; \
            W[i][0] = *(const u32x4*)row_; W[i][1] = *(const u32x4*)(row_ + 1024); } } while (0)
#define G_DOT(W, EB) do { _Pragma("unroll") for (int i = 0; i < GBU; ++i) { int s_ = 0; \
            s_ = __builtin_amdgcn_sdot4((int)W[i][0].x, xq[0], s_, false); s_ = __builtin_amdgcn_sdot4((int)W[i][0].y, xq[1], s_, false); \
            s_ = __builtin_amdgcn_sdot4((int)W[i][0].z, xq[2], s_, false); s_ = __builtin_amdgcn_sdot4((int)W[i][0].w, xq[3], s_, false); \
            s_ = __builtin_amdgcn_sdot4((int)W[i][1].x, xq[4], s_, false); s_ = __builtin_amdgcn_sdot4((int)W[i][1].y, xq[5], s_, false); \
            s_ = __builtin_amdgcn_sdot4((int)W[i][1].z, xq[6], s_, false); s_ = __builtin_amdgcn_sdot4((int)W[i][1].w, xq[7], s_, false); \
            const float tot = wave_total((float)s_ * sxl); \
            if ((((EB) + i) & 63) == lane) { if ((EB) < 64) hid0 = tot; else hid1 = tot; } } } while (0)
#define G_AXPY(W, EB) do { _Pragma("unroll") for (int i = 0; i < GBV; ++i) { \
            const float cf_ = __uint_as_float(__builtin_amdgcn_readlane(__float_as_uint((EB) < 64 ? cf0 : cf1), ((EB) + i) & 63)); \
            const f32x2 mm = {cf_, cf_}; \
            _Pragma("unroll") for (int j = 0; j < 2; ++j) { const unsigned ww[4] = {W[i][j].x, W[i][j].y, W[i][j].z, W[i][j].w}; \
                _Pragma("unroll") for (int k = 0; k < 4; ++k) { \
                    acc[j * 8 + k * 2] += mm * __builtin_amdgcn_cvt_pk_f32_fp8((int)ww[k], false); \
                    acc[j * 8 + k * 2 + 1] += mm * __builtin_amdgcn_cvt_pk_f32_fp8((int)ww[k], true); } } } } while (0)
        u32x4 wa[GBU][2], wb[GBU][2];
        const bool do_u = !(dry && (DRY_MODE == 4 || DRY_MODE == 5)), do_v = !(dry && (DRY_MODE == 3 || DRY_MODE == 5));
        if (do_u) G_LOAD(wa, UT, 0, GBU); else G_LOAD(wa, VT, 0, GBV);
#pragma unroll 1
        for (int eb = 0; eb < (do_u ? 128 : 0); eb += 2 * GBU) {
            G_LOAD(wb, UT, eb + GBU, GBU);
            G_DOT(wa, eb);
            if (eb + 2 * GBU < 128) G_LOAD(wa, UT, eb + 2 * GBU, GBU); else G_LOAD(wa, VT, 0, GBV);
            G_DOT(wb, eb + GBU);
        }
        const float cf0 = gelu_tanh(hid0 * us0) * g0 * vs0, cf1 = gelu_tanh(hid1 * us1) * g1 * vs1;
        f32x2 acc[16];
#pragma unroll
        for (int i = 0; i < 16; ++i) acc[i] = (f32x2){0.f, 0.f};
#pragma unroll 1
        for (int eb = 0; eb < (do_v ? 128 : 0); eb += 2 * GBV) {
            G_LOAD(wb, VT, eb + GBV, GBV);
            G_AXPY(wa, eb);
            if (eb + 2 * GBV < 128) G_LOAD(wa, VT, eb + 2 * GBV, GBV);
            G_AXPY(wb, eb + GBV);
        }
#undef G_LOAD
#undef G_DOT
#undef G_AXPY
        float hn[32];
        float* hrow = t < NLAT ? p.out + (size_t)t * DM : (float*)(p.ws + WS_HC) + (size_t)(t - NLAT) * DM;
        const int bb = t < NLAT ? (t >> 11) : 8;
        const float* gate = mod + (size_t)bb * 12288 + 5 * DM;
#pragma unroll
        for (int j = 0; j < 2; ++j)
#pragma unroll
            for (int k = 0; k < 4; ++k) {
                const int col = j * 1024 + lane * 16 + k * 4;
                const f32x4 hv = *(const f32x4*)(hrow + col), gv = *(const f32x4*)(gate + col);
                const f32x2 a0 = acc[j * 8 + k * 2], a1 = acc[j * 8 + k * 2 + 1];
                f32x4 o;
                o.x = hv.x + gv.x * a0.x; o.y = hv.y + gv.y * a0.y; o.z = hv.z + gv.z * a1.x; o.w = hv.w + gv.w * a1.y;
                *(f32x4*)((dry ? (float*)(p.ws + WS_DUMMY) + (size_t)(t & 16383) * DM : hrow) + col) = o;
                hn[j * 16 + k * 4 + 0] = o.x; hn[j * 16 + k * 4 + 1] = o.y; hn[j * 16 + k * 4 + 2] = o.z; hn[j * 16 + k * 4 + 3] = o.w;
            }
        if (l + 1 < DEPTH) {
            float ss = 0.f;
#pragma unroll
            for (int i = 0; i < 32; ++i) ss += hn[i] * hn[i];
            const float rstd = rsqrtf(wave_total(ss) * (1.f / DM) + EPS);
            const float* g1n = p.norm1_g + (l + 1) * DM;
            const float* shift = mod + (size_t)9 * 12288 + (size_t)bb * 12288;
            const float* scale = shift + DM;
            bf16_t* xo = (dry ? (bf16_t*)(p.ws + WS_DUMMY) + (size_t)(t & 16383) * DM : (bf16_t*)(p.ws + WS_XN) + (size_t)t * DM);
#pragma unroll
            for (int j = 0; j < 2; ++j)
#pragma unroll
                for (int k = 0; k < 2; ++k) {
                    const int col = j * 1024 + lane * 16 + k * 8;
                    float xv[8];
#pragma unroll
                    for (int i = 0; i < 8; ++i) xv[i] = hn[j * 16 + k * 8 + i] * rstd * g1n[col + i] * (1.f + scale[col + i]) + shift[col + i];
                    u32x4 w; w.x = pk2(xv[0], xv[1]); w.y = pk2(xv[2], xv[3]); w.z = pk2(xv[4], xv[5]); w.w = pk2(xv[6], xv[7]);
                    *(u32x4*)(xo + col) = w;
                }
        }
    }
}
#endif
#else
__device__ __forceinline__ float dot8(const u32x4 u, const u32x4 x) {
    float d = bflo(u.x) * bflo(x.x) + bfhi(u.x) * bfhi(x.x);
    d += bflo(u.y) * bflo(x.y) + bfhi(u.y) * bfhi(x.y);
    d += bflo(u.z) * bflo(x.z) + bfhi(u.z) * bfhi(x.z);
    d += bflo(u.w) * bflo(x.w) + bfhi(u.w) * bfhi(x.w);
    return d;
}
__device__ __forceinline__ void ph_gather(const Params& p, int l, const bool dry, unsigned char* lds) {
    const int tid = threadIdx.x, lane = tid & 63, wave = tid >> 6;
    const int gw = blockIdx.x * NWAVES + wave, NGW = gridDim.x * NWAVES;
    const bf16_t* XN = (const bf16_t*)(p.ws + WS_XN);
    const bf16_t* UT = (const bf16_t*)(p.ws + WS_UT) + (size_t)l * NEXP * DM;
    const bf16_t* VT = (const bf16_t*)(p.ws + WS_VT) + (size_t)l * NEXP * DM;
    const int* EID = (const int*)(p.ws + WS_EID); const float* GATE = (const float*)(p.ws + WS_GATE);
    const float* mod = (const float*)(p.ws + WS_MOD) + (size_t)l * 9 * 12288;
    const int nrows = (l == DEPTH - 1) ? NLAT : MTOT;
    for (int t = gw; t < nrows; t += NGW) {
        u32x4 xq[4];
#pragma unroll
        for (int j = 0; j < 4; ++j) xq[j] = *(const u32x4*)(XN + (size_t)t * DM + j * 512 + lane * 8);
        const int e0 = EID[(size_t)t * 128 + lane], e1 = EID[(size_t)t * 128 + 64 + lane];
        const float g0 = GATE[(size_t)t * 128 + lane], g1 = GATE[(size_t)t * 128 + 64 + lane];
        float hid0 = 0.f, hid1 = 0.f;
#pragma unroll 1
        for (int eb = 0; eb < 128; eb += 4) {
            u32x4 uu[4][4];
#pragma unroll
            for (int i = 0; i < 4; ++i) {
                const int e = eb + i;
                const int id = __builtin_amdgcn_readlane(eb < 64 ? e0 : e1, e & 63);
                const u32x4* ur = (const u32x4*)(UT + (size_t)id * DM) + lane;
#pragma unroll
                for (int j = 0; j < 4; ++j) uu[i][j] = ur[j * 64];
            }
#pragma unroll
            for (int i = 0; i < 4; ++i) {
                const int e = eb + i;
                float d = dot8(uu[i][0], xq[0]) + dot8(uu[i][1], xq[1]) + dot8(uu[i][2], xq[2]) + dot8(uu[i][3], xq[3]);
                d = wave_sum(d);
                if ((e & 63) == lane) { if (eb < 64) hid0 = d; else hid1 = d; }
            }
        }
        const float cf0 = gelu_tanh(hid0) * g0, cf1 = gelu_tanh(hid1) * g1;
        float acc[32];
#pragma unroll
        for (int i = 0; i < 32; ++i) acc[i] = 0.f;
#pragma unroll 1
        for (int eb = 0; eb < 128; eb += 4) {
            u32x4 vv[4][4]; float cf[4];
#pragma unroll
            for (int i = 0; i < 4; ++i) {
                const int e = eb + i;
                const int id = __builtin_amdgcn_readlane(eb < 64 ? e0 : e1, e & 63);
                cf[i] = __uint_as_float(__builtin_amdgcn_readlane(__float_as_uint(eb < 64 ? cf0 : cf1), e & 63));
                const u32x4* vr = (const u32x4*)(VT + (size_t)id * DM) + lane;
#pragma unroll
                for (int j = 0; j < 4; ++j) vv[i][j] = vr[j * 64];
            }
#pragma unroll
            for (int i = 0; i < 4; ++i)
#pragma unroll
                for (int j = 0; j < 4; ++j) {
                    acc[j * 8 + 0] += cf[i] * bflo(vv[i][j].x); acc[j * 8 + 1] += cf[i] * bfhi(vv[i][j].x);
                    acc[j * 8 + 2] += cf[i] * bflo(vv[i][j].y); acc[j * 8 + 3] += cf[i] * bfhi(vv[i][j].y);
                    acc[j * 8 + 4] += cf[i] * bflo(vv[i][j].z); acc[j * 8 + 5] += cf[i] * bfhi(vv[i][j].z);
                    acc[j * 8 + 6] += cf[i] * bflo(vv[i][j].w); acc[j * 8 + 7] += cf[i] * bfhi(vv[i][j].w);
                }
        }
        float* hrow = t < NLAT ? p.out + (size_t)t * DM : (float*)(p.ws + WS_HC) + (size_t)(t - NLAT) * DM;
        const int bb = t < NLAT ? (t >> 11) : 8;
        const float* gate = mod + (size_t)bb * 12288 + 5 * DM;
#pragma unroll
        for (int j = 0; j < 4; ++j) {
            const int col = j * 512 + lane * 8;
#pragma unroll
            for (int hh = 0; hh < 2; ++hh) {
                const f32x4 hv = *(const f32x4*)(hrow + col + hh * 4), gv = *(const f32x4*)(gate + col + hh * 4);
                f32x4 o;
                o.x = hv.x + gv.x * acc[j * 8 + hh * 4 + 0]; o.y = hv.y + gv.y * acc[j * 8 + hh * 4 + 1];
                o.z = hv.z + gv.z * acc[j * 8 + hh * 4 + 2]; o.w = hv.w + gv.w * acc[j * 8 + hh * 4 + 3];
                *(f32x4*)(hrow + col + hh * 4) = o;
            }
        }
    }
}

#endif

#define LAS __attribute__((address_space(3)))
#define XB_TMO      128
#define XB_XCNT(j)  (256  + 64 * (j))
#define XB_XSUB(j)  (1280 + 64 * (j))
#define XB_XGEN(j)  (2304 + 64 * (j))
#define XB_TOP      3328
#define XB_TOPGEN   3392
#define XCD_BAR_WORDS 3456
#define XB_SPIN_CAP (1u << 18)

__device__ __forceinline__ unsigned xb_ld(unsigned* p)              { return __hip_atomic_load(p, __ATOMIC_RELAXED, __HIP_MEMORY_SCOPE_AGENT); }
__device__ __forceinline__ unsigned xb_add(unsigned* p, unsigned v) { return __hip_atomic_fetch_add(p, v, __ATOMIC_RELAXED, __HIP_MEMORY_SCOPE_AGENT); }
__device__ __forceinline__ unsigned xb_xcc_id() { return (unsigned)__builtin_amdgcn_s_getreg((3 << 11) | 20) & 0xFu; }
#define XB_SPIN(cond, bar) do { unsigned _sp = 0; while (cond) { __builtin_amdgcn_s_sleep(1); \
    if ((++_sp & 255u) == 0u) { if (xb_ld(&(bar)[XB_TMO])) break; if (_sp > XB_SPIN_CAP) { atomicAdd(&(bar)[XB_TMO], 1u); break; } } } } while (0)

struct XcdBarrier {
    unsigned* bar; unsigned x;
    volatile LAS unsigned* st;
};

__device__ __forceinline__ XcdBarrier xcd_barrier_post(unsigned* bar, volatile LAS unsigned* st) {
    XcdBarrier b; b.bar = bar; b.x = xb_xcc_id(); b.st = st;
    if (threadIdx.x == 0) (void)xb_add(&bar[XB_XCNT(b.x)], 1u);
    return b;
}
__device__ __forceinline__ void xcd_barrier_complete(unsigned* bar, unsigned x, unsigned& nloc, unsigned& nx) {
    const unsigned G = gridDim.x * gridDim.y * gridDim.z;
    unsigned sum, cnt, mine, sp = 0u;
    for (;;) {
        sum = 0u; cnt = 0u; mine = 0u;
#pragma unroll
        for (unsigned j = 0; j < 16; ++j) { const unsigned c = xb_ld(&bar[XB_XCNT(j)]); sum += c; cnt += (c > 0u) ? 1u : 0u; mine = (j == x) ? c : mine; }
        if (sum == G) break;
        __builtin_amdgcn_s_sleep(1);
        if ((++sp & 255u) == 0u) { if (xb_ld(&bar[XB_TMO])) break; if (sp > XB_SPIN_CAP) { atomicAdd(&bar[XB_TMO], 1u); break; } }
    }
    nloc = mine > 0u ? mine : 1u; nx = cnt > 0u ? cnt : 1u;
}

__device__ __forceinline__ void xcd_barrier(const XcdBarrier& b) {
    asm volatile("s_waitcnt vmcnt(0)" ::: "memory");
    __syncthreads();
    if (threadIdx.x == 0) {
        unsigned* bar = b.bar;
        __builtin_amdgcn_s_waitcnt(0);
        unsigned nloc = b.st[0], nx = b.st[1];
        if (nloc == 0u) { xcd_barrier_complete(bar, b.x, nloc, nx); b.st[0] = nloc; b.st[1] = nx; }
        const unsigned old = xb_add(&bar[XB_XSUB(b.x)], 1u);
        const unsigned gen = old / nloc;
        if (old + 1u == (gen + 1u) * nloc) {
            __builtin_amdgcn_fence(__ATOMIC_RELEASE, "agent");
            asm volatile("s_waitcnt vmcnt(0)" ::: "memory");
            const unsigned og = xb_add(&bar[XB_TOP], 1u);
            const unsigned tg = og / nx;
            if (og + 1u == (tg + 1u) * nx) xb_add(&bar[XB_TOPGEN], 1u);
            else XB_SPIN(xb_ld(&bar[XB_TOPGEN]) == tg, bar);
            __builtin_amdgcn_fence(__ATOMIC_ACQUIRE, "agent");
            xb_add(&bar[XB_XGEN(b.x)], 1u);
            asm volatile("s_waitcnt vmcnt(0)" ::: "memory");
        } else {
            XB_SPIN(xb_ld(&bar[XB_XGEN(b.x)]) == gen, bar);
            __builtin_amdgcn_fence(__ATOMIC_ACQUIRE, "agent");
            asm volatile("s_waitcnt vmcnt(0)" ::: "memory");
        }
    }
    __syncthreads();
}

constexpr int NPHASE = 1 + 10 * DEPTH;
template <int S>
__device__ __forceinline__ void run_stage(const Params& p, int l, unsigned char* lds, const bool dry) {
    const bool last = (l == DEPTH - 1);
    const float* mod = (const float*)(p.ws + WS_MOD) + (size_t)l * 9 * 12288;
    if constexpr (S == 1) { if (l == 0) { ph_modulate(p, l, 0); if (GEMM_I8 && !(GEMM3_I8 && W8_ONEPASS) && !dry) ph_weights_i8(p, lds); } }
    if constexpr (S == 2) {
#if USE_PG8
        pg8::StaticOrder So; So.init(MTOT, INW, (int)gridDim.x, (int)blockIdx.x);
#if GEMM_I8
        pg8::Gemm g{(const bf16_t*)(p.ws + WS_XN8), (const bf16_t*)(p.ws + WS_WIN + (size_t)l * INW * DM), MTOT, INW, DM / 2};
        pg8::EpiBf16I8 E{(bf16_t*)(p.ws + WS_P), INW, (const float*)(p.ws + WS_SCL) + SCL_XN, (const float*)(p.ws + WS_SCL) + SCL_WIN + l * INW};
        pg8::gemm_phase<pg8::EpiBf16I8, pg8::StaticOrder, true, true, true>((PG8_LAS unsigned char*)lds, g, So, E);
#else
        pg8::Gemm g{(const bf16_t*)(p.ws + WS_XN), (const bf16_t*)(p.ws + WS_WIN) + (size_t)l * INW * DM, MTOT, INW, DM};
        pg8::EpiBf16<0> E{(bf16_t*)(p.ws + WS_P), INW, nullptr, 0, 0, 1.f};
        pg8::gemm_phase<pg8::EpiBf16<0>, pg8::StaticOrder, true, true>((PG8_LAS unsigned char*)lds, g, So, E);
#endif
#else
        EpiBf16Store E{(bf16_t*)(p.ws + WS_P), INW};
        gemm_naive(lds, (const bf16_t*)(p.ws + WS_XN), (const bf16_t*)(p.ws + WS_WIN) + (size_t)l * INW * DM, MTOT, INW, DM, E);
#endif
    }
    if constexpr (S == 3) ph_prep(p, l, dry);
    if constexpr (S == 4) {
#if USE_FAST_ATT
        ph_mixers_fast(p, l, lds, dry);
#else
        ph_mixers_naive(p, l, lds);
#endif
    }
    if constexpr (S == 5) ph_ynorm(p, l);
    if constexpr (S == 6) {
#if USE_PG8
        const int M = last ? NLAT : MTOT;
        pg8::StaticOrder So; So.init(M, DM, (int)gridDim.x, (int)blockIdx.x);
#if GEMM_I8
        pg8::Gemm g{(const bf16_t*)(p.ws + WS_XN8), (const bf16_t*)(p.ws + WS_WOUT + (size_t)l * DM * DM), M, DM, DM / 2};
#if H_BF16 && GEMM3_I8
        pg8::EpiResGateI8B E{l == 0 ? p.x : nullptr, p.ctx, (bf16_t*)(p.ws + (dry ? WS_DUMMY : WS_HB)), mod + 2 * DM,
                             (const float*)(p.ws + WS_SCL) + SCL_Y, (const float*)(p.ws + WS_SCL) + SCL_WOUT + l * DM};
        pg8::gemm_phase<pg8::EpiResGateI8B, pg8::StaticOrder, true, true, true>((PG8_LAS unsigned char*)lds, g, So, E);
#else
        pg8::EpiResGateI8 E{l == 0 ? p.x : p.out, l == 0 ? p.ctx : (const float*)(p.ws + WS_HC), dry ? (float*)(p.ws + WS_DUMMY) : p.out, dry ? (float*)(p.ws + WS_DUMMY) : (float*)(p.ws + WS_HC), mod + 2 * DM,
                            (const float*)(p.ws + WS_SCL) + SCL_Y, (const float*)(p.ws + WS_SCL) + SCL_WOUT + l * DM};
        pg8::gemm_phase<pg8::EpiResGateI8, pg8::StaticOrder, true, true, true>((PG8_LAS unsigned char*)lds, g, So, E);
#endif
#else
        pg8::Gemm g{(const bf16_t*)(p.ws + WS_Y), (const bf16_t*)(p.ws + WS_WOUT) + (size_t)l * DM * DM, M, DM, DM};
        pg8::EpiResGateT E{l == 0 ? p.x : p.out, l == 0 ? p.ctx : (const float*)(p.ws + WS_HC), dry ? (float*)(p.ws + WS_DUMMY) : p.out, dry ? (float*)(p.ws + WS_DUMMY) : (float*)(p.ws + WS_HC), mod + 2 * DM};
        pg8::gemm_phase<pg8::EpiResGateT, pg8::StaticOrder, true, true>((PG8_LAS unsigned char*)lds, g, So, E);
#endif
#if GATHER_I8 && GATHER_4BIT
        if (TABLES_IN_GAPS && l == 0 && !dry) conv4_tables(p, 0, NEXP, (unsigned*)(p.ws + WS_CTL) + 6144, lds);
#endif
#else
        EpiResGate E{l == 0 ? p.x : p.out, l == 0 ? p.ctx : (const float*)(p.ws + WS_HC), p.out, (float*)(p.ws + WS_HC), mod + 2 * DM};
        gemm_naive(lds, (const bf16_t*)(p.ws + WS_Y), (const bf16_t*)(p.ws + WS_WOUT) + (size_t)l * DM * DM, last ? NLAT : MTOT, DM, DM, E);
#endif
    }
    if constexpr (S == 7) ph_modulate(p, l, 1);
    if constexpr (S == 8) {
#if USE_PG8
        const int M = last ? NLAT : MTOT;
        pg8::StaticOrder So; So.init(M, DM, (int)gridDim.x, (int)blockIdx.x);
#if GEMM_I8 && GEMM3_I8
        pg8::Gemm g{(const bf16_t*)(p.ws + WS_XN8), (const bf16_t*)(p.ws + WS_WQ + (size_t)l * DM * DM), M, DM, DM / 2};
        pg8::EpiBf16I8 E{(bf16_t*)(p.ws + WS_P), DM, (const float*)(p.ws + WS_SCL) + SCL_XN, (const float*)(p.ws + WS_SCL) + SCL_WQ + l * DM};
        pg8::gemm_phase<pg8::EpiBf16I8, pg8::StaticOrder, true, true, true>((PG8_LAS unsigned char*)lds, g, So, E);
#else
        pg8::Gemm g{(const bf16_t*)(p.ws + WS_XN), (const bf16_t*)(p.ws + WS_WQ) + (size_t)l * DM * DM, M, DM, DM};
        pg8::EpiBf16<0> E{(bf16_t*)(p.ws + WS_P), DM, nullptr, 0, 0, 1.f};
        pg8::gemm_phase<pg8::EpiBf16<0>, pg8::StaticOrder, true, true>((PG8_LAS unsigned char*)lds, g, So, E);
#endif
#if FUSE_ROUTE
        asm volatile("s_waitcnt vmcnt(0)" ::: "memory");
        __syncthreads();
        ph_route_fast<true>(p, l, lds);
#endif
#if GATHER_I8 && GATHER_4BIT
        if (TABLES_IN_GAPS && l == 0 && !dry) conv4_tables(p, 2 * NEXP, 3 * NEXP, (unsigned*)(p.ws + WS_CTL) + 6208, lds);
#endif
#else
        EpiBf16Store E{(bf16_t*)(p.ws + WS_P), DM};
        gemm_naive(lds, (const bf16_t*)(p.ws + WS_XN), (const bf16_t*)(p.ws + WS_WQ) + (size_t)l * DM * DM, last ? NLAT : MTOT, DM, DM, E);
#endif
    }
    if constexpr (S == 9) {
#if USE_FAST_ROUTE
        if (!FUSE_ROUTE) ph_route_fast<false>(p, l, lds);
#else
        ph_route_naive(p, l);
#endif
    }
    if constexpr (S == 10) ph_gather(p, l, dry, lds);
}
__global__ void __launch_bounds__(NTHREADS) fwd_kernel(Params p) {
    extern __shared__ __attribute__((aligned(16))) unsigned char lds[];
    cg::grid_group grid = cg::this_grid();
    const int lo = p.ph_lo, hi = p.ph_hi;
    volatile LAS unsigned* stw = (volatile LAS unsigned*)((LAS unsigned char*)lds + (LDS_BYTES - 128));
    if (threadIdx.x < 2) stw[threadIdx.x] = 0u;
    __syncthreads();
    const XcdBarrier bar = xcd_barrier_post((unsigned*)(p.ws + WS_CTL + 32768), stw);
#define IN(k) (lo <= (k) && (k) < hi)
#define SEAM(k) do { if (IN(k) && IN((k) + 1)) xcd_barrier(bar); } while (0)
#define STAGE(S, l) do { constexpr int k_ = 1 + 10 * (l) + (S) - 1; if (IN(k_)) { if constexpr ((REP_MASK >> k_) & 1) { run_stage<S>(p, l, lds, true); xcd_barrier(bar); } run_stage<S>(p, l, lds, false); } SEAM(k_); } while (0)
#define LAYER(l) do { if ((l) == 0) { STAGE(1, l); } STAGE(2, l); STAGE(3, l); STAGE(4, l); STAGE(5, l); STAGE(6, l); STAGE(7, l); STAGE(8, l); if (!FUSE_ROUTE) { STAGE(9, l); } STAGE(10, l); } while (0)
    if (hi > NPHASE) grid.sync();
    if (IN(0)) { if constexpr (REP_MASK & 1) { ph_prologue(p, lds); xcd_barrier(bar); } ph_prologue(p, lds); }
    SEAM(0);
    LAYER(0);
    LAYER(1);
#undef IN
#undef SEAM
#undef STAGE
#undef LAYER
}

extern "C" void kernel_launch(void* const* d_in, const int* in_sizes, int n_in, void* d_out, int out_size, void* d_ws, size_t ws_size, hipStream_t stream) {
    static int grid_blocks = 0;
    if (grid_blocks == 0) {
        if (n_in != 23 || out_size != NLAT * DM || ws_size < WS_END) { fprintf(stderr, "kernel_launch: unexpected shapes n_in %d out %d ws %zu\n", n_in, out_size, ws_size); grid_blocks = -1; return; }
        if (hipFuncSetAttribute((const void*)fwd_kernel, hipFuncAttributeMaxDynamicSharedMemorySize, LDS_BYTES) != hipSuccess) { fprintf(stderr, "kernel_launch: hipFuncSetAttribute failed\n"); grid_blocks = -1; return; }
        int dev = 0, cus = 0, per_cu = 0;
        hipGetDevice(&dev);
        hipDeviceGetAttribute(&cus, hipDeviceAttributeMultiprocessorCount, dev);
        hipOccupancyMaxActiveBlocksPerMultiprocessor(&per_cu, (const void*)fwd_kernel, NTHREADS, LDS_BYTES);
        if (per_cu < 1 || cus < 1) { fprintf(stderr, "kernel_launch: occupancy query failed (%d per CU, %d CUs)\n", per_cu, cus); grid_blocks = -1; return; }
        grid_blocks = cus * per_cu;
    }
    if (grid_blocks < 0) return;
    Params p{};
    const float** pp = (const float**)&p;
    for (int i = 0; i < 23; ++i) pp[i] = (const float*)d_in[i];
    p.out = (float*)d_out; p.ws = (unsigned char*)d_ws;
    p.ph_lo = 0; p.ph_hi = NPHASE;
    hipMemsetAsync((char*)d_ws + WS_CTL, 0, 131072, stream);
    void* args[] = {&p};
    hipError_t e = hipLaunchCooperativeKernel((const void*)fwd_kernel, dim3(grid_blocks), dim3(NTHREADS), args, LDS_BYTES, stream);
    if (e != hipSuccess) fprintf(stderr, "cooperative launch failed: %s (grid %d)\n", hipGetErrorString(e), grid_blocks);
}
```
